# Optimizing an MI355X kernel written in HIP

```python
import math
import jax, jax.numpy as jnp
from jax import lax
import numpy as np

D_MODEL = 2048
BATCH = 4
SEQ = 4096
DEPTH = 2

HEAD_DIM = 64
A_HEADS = 16
DILATED_BRANCHES = ((128, 1), (512, 4), (2048, 16))
B_HEADS = 16
B_KV_HEADS = 2
B_WINDOW = 128
C_HEADS = 16
N_EXPERTS = 64
N_GROUPS = 8
TOPK_GROUPS = 4
TOP_K = 8
EXPERT_DIM = 512
SHARED_DIM = 512
ROUTED_SCALE = 2.5
BAND_BLK = 128
Q_BLK = 128
MOE_BLK = 128
RMS_EPS = 1e-6
NEG_INF = -1e30
AB_IN_COLS = 3 * A_HEADS * HEAD_DIM + (B_HEADS + 2 * B_KV_HEADS) * HEAD_DIM
AB_OUT_ROWS = (A_HEADS + B_HEADS) * HEAD_DIM
C_IN_COLS = 3 * C_HEADS * 2 * HEAD_DIM
C_OUT_ROWS = C_HEADS * 2 * HEAD_DIM

kernel_name = 'hybrid_dilated_swa_diffattn_moe_trunk'


def rmsnorm(x, g):
    x32 = x.astype(jnp.float32)
    y = x32 * lax.rsqrt(jnp.mean(x32 * x32, axis=-1, keepdims=True) + RMS_EPS)
    return (y * g.astype(jnp.float32)).astype(x.dtype)


def head_rmsnorm(x, g):
    x32 = x.astype(jnp.float32)
    return x32 * lax.rsqrt(jnp.mean(x32 * x32, axis=-1, keepdims=True) + RMS_EPS) * g.astype(jnp.float32)


def alibi_slopes(n):
    return jnp.asarray(2.0 ** (-8.0 * np.arange(1, n + 1) / n), dtype=jnp.float32)


def modulate(h, shift, scale):
    return h * (1 + scale) + shift


def banded_attention(q, k, v, slopes, max_dist, pos_scale, sinks):
    Bq, Hq, L, hd = q.shape
    Hkv = k.shape[1]
    G = Hq // Hkv
    nb = -(-L // BAND_BLK)
    Lp = nb * BAND_BLK
    pad = ((0, 0), (0, 0), (0, Lp - L), (0, 0))
    q, k, v = [jnp.pad(a.astype(jnp.float32), pad) for a in (q, k, v)]
    qb = q.reshape(Bq, Hkv, G, nb, BAND_BLK, hd)
    def with_prev(a):
        a = a.reshape(Bq, Hkv, nb, BAND_BLK, hd)
        prev = jnp.pad(a[:, :, :-1], ((0, 0), (0, 0), (1, 0), (0, 0), (0, 0)))
        return jnp.concatenate([prev, a], axis=3)
    kc, vc = with_prev(k), with_prev(v)
    s = jnp.einsum('bhgnqd,bhnkd->bhgnqk', qb, kc) * (hd ** -0.5)
    qi = jnp.arange(BAND_BLK)[:, None]
    ki = jnp.arange(2 * BAND_BLK)[None, :]
    dist = BAND_BLK + qi - ki
    first = (jnp.arange(nb) == 0)[:, None, None] & (ki < BAND_BLK)[None]
    valid = (dist >= 0) & (dist <= max_dist) & (~first)
    bias = -slopes.reshape(Hkv, G)[:, :, None, None, None] * (dist.astype(jnp.float32) * pos_scale)
    s = jnp.where(valid, s + bias, NEG_INF)
    m = jnp.max(s, axis=-1)
    if sinks is not None:
        sink = sinks.astype(jnp.float32).reshape(Hkv, G)[:, :, None, None]
        m = jnp.maximum(m, sink)
    p = jnp.exp(s - m[..., None])
    denom = jnp.sum(p, axis=-1)
    if sinks is not None:
        denom = denom + jnp.exp(sink - m)
    o = jnp.einsum('bhgnqk,bhnkd->bhgnqd', p, vc) / denom[..., None]
    lse = m + jnp.log(denom)
    o = o.reshape(Bq, Hq, Lp, hd)[:, :, :L]
    lse = lse.reshape(Bq, Hq, Lp)[:, :, :L]
    return o, lse


def dilated_mixture(q, k, v, slopes):
    B, H, T, hd = q.shape
    outs, lses = [], []
    for window, dil in DILATED_BRANCHES:
        L = T // dil
        def to_sub(a):
            return a.reshape(B, H, L, dil, hd).transpose(0, 3, 1, 2, 4).reshape(B * dil, H, L, hd)
        o, lse = banded_attention(to_sub(q), to_sub(k), to_sub(v), slopes, window // dil, dil, None)
        outs.append(o.reshape(B, dil, H, L, hd).transpose(0, 2, 3, 1, 4).reshape(B, H, T, hd))
        lses.append(lse.reshape(B, dil, H, L).transpose(0, 2, 3, 1).reshape(B, H, T))
    w = jax.nn.softmax(jnp.stack(lses, axis=0), axis=0)
    return jnp.sum(w[..., None] * jnp.stack(outs, axis=0), axis=0)


def even_mixer(h, w_in, qk_norm, sinks, w_out):
    B, T, _ = h.shape
    a_w = A_HEADS * HEAD_DIM
    b_w = B_HEADS * HEAD_DIM
    kv_w = B_KV_HEADS * HEAD_DIM
    cuts = [a_w, 2 * a_w, 3 * a_w, 3 * a_w + b_w, 3 * a_w + b_w + kv_w]
    qa, ka, va, qb, kb, vb = jnp.split(h @ w_in, cuts, axis=-1)
    def heads(a, n):
        return a.reshape(B, T, n, HEAD_DIM).transpose(0, 2, 1, 3)
    qa = head_rmsnorm(heads(qa, A_HEADS), qk_norm[0])
    ka = head_rmsnorm(heads(ka, A_HEADS), qk_norm[1])
    qb = head_rmsnorm(heads(qb, B_HEADS), qk_norm[2])
    kb = head_rmsnorm(heads(kb, B_KV_HEADS), qk_norm[3])
    oa = dilated_mixture(qa, ka, heads(va, A_HEADS).astype(jnp.float32), alibi_slopes(A_HEADS))
    ob, _ = banded_attention(qb, kb, heads(vb, B_KV_HEADS), alibi_slopes(B_HEADS), B_WINDOW - 1, 1, sinks)
    o = jnp.concatenate([oa, ob], axis=1).transpose(0, 2, 1, 3).reshape(B, T, AB_OUT_ROWS)
    return o.astype(h.dtype) @ w_out


def diff_attention(q1, q2, k1, k2, v, slopes, lam):
    B, H, T, hd = q1.shape
    nb = T // Q_BLK
    scale = hd ** -0.5
    kpos = jnp.arange(T)
    def to_blocks(a):
        return a.reshape(B, H, nb, Q_BLK, hd).transpose(2, 0, 1, 3, 4)
    def one_block(args):
        q1b, q2b, i = args
        qpos = i * Q_BLK + jnp.arange(Q_BLK)
        dist = (qpos[:, None] - kpos[None, :]).astype(jnp.float32)
        causal = dist >= 0
        bias = -slopes[:, None, None] * dist
        def probs(qb, kb):
            s = jnp.einsum('bhqd,bhkd->bhqk', qb, kb) * scale + bias
            return jax.nn.softmax(jnp.where(causal, s, NEG_INF), axis=-1)
        attn = probs(q1b, k1) - lam * probs(q2b, k2)
        return jnp.einsum('bhqk,bhkd->bhqd', attn, v)
    o = lax.map(one_block, (to_blocks(q1), to_blocks(q2), jnp.arange(nb)))
    return o.transpose(1, 2, 0, 3, 4).reshape(B, H, T, 2 * hd)


def odd_mixer(h, w_in, qk_norm, lam_params, subln, w_out, layer_idx):
    B, T, _ = h.shape
    q, k, v = jnp.split(h @ w_in, 3, axis=-1)
    def pairs(a):
        return a.reshape(B, T, C_HEADS, 2, HEAD_DIM).transpose(3, 0, 2, 1, 4)
    q = head_rmsnorm(pairs(q), qk_norm[0])
    k = head_rmsnorm(pairs(k), qk_norm[1])
    v = v.reshape(B, T, C_HEADS, 2 * HEAD_DIM).transpose(0, 2, 1, 3).astype(jnp.float32)
    lam_init = 0.8 - 0.6 * math.exp(-0.3 * layer_idx)
    lp = lam_params.astype(jnp.float32)
    lam = jnp.exp(jnp.sum(lp[0] * lp[1])) - jnp.exp(jnp.sum(lp[2] * lp[3])) + lam_init
    o = diff_attention(q[0], q[1], k[0], k[1], v, alibi_slopes(C_HEADS), lam)
    o = head_rmsnorm(o, subln) * (1.0 - lam_init)
    o = o.transpose(0, 2, 1, 3).reshape(B, T, C_OUT_ROWS)
    return o.astype(h.dtype) @ w_out


def swiglu(x, w_up, w_down):
    g, u = jnp.split(x @ w_up, 2, axis=-1)
    return (jax.nn.silu(g) * u) @ w_down


def routed_experts(tok, idx, gates, experts_up, experts_down):
    n_tok, d = tok.shape
    n_assign = n_tok * TOP_K
    flat_e = idx.reshape(-1).astype(jnp.int32)
    flat_t = jnp.repeat(jnp.arange(n_tok, dtype=jnp.int32), TOP_K)
    flat_w = gates.reshape(-1)
    order = jnp.argsort(flat_e)
    e_sorted = flat_e[order]
    counts = jnp.bincount(flat_e, length=N_EXPERTS).astype(jnp.int32)
    padded = (counts + MOE_BLK - 1) // MOE_BLK * MOE_BLK
    pad_end = jnp.cumsum(padded)
    pad_start = pad_end - padded
    start = jnp.cumsum(counts) - counts
    dest = pad_start[e_sorted] + jnp.arange(n_assign, dtype=jnp.int32) - start[e_sorted]
    n_blocks = -(-(n_assign + N_EXPERTS * (MOE_BLK - 1)) // MOE_BLK)
    cap = n_blocks * MOE_BLK
    buf_tok = jnp.full((cap,), n_tok, jnp.int32).at[dest].set(flat_t[order])
    buf_w = jnp.zeros((cap,), flat_w.dtype).at[dest].set(flat_w[order])
    block_starts = jnp.arange(n_blocks, dtype=jnp.int32) * MOE_BLK
    block_expert = jnp.minimum(jnp.searchsorted(pad_end, block_starts, side='right'), N_EXPERTS - 1)
    tok_pad = jnp.concatenate([tok, jnp.zeros((1, d), tok.dtype)], axis=0)
    def expert_block(args):
        rows, e = args
        return swiglu(tok_pad[rows], experts_up[e], experts_down[e])
    ys = lax.map(expert_block, (buf_tok.reshape(n_blocks, MOE_BLK), block_expert))
    ys = ys.reshape(cap, d) * buf_w[:, None].astype(tok.dtype)
    return jnp.zeros((n_tok + 1, d), tok.dtype).at[buf_tok].add(ys)[:n_tok]


def moe_ffn(h, w_router, router_bias, experts_up, experts_down, shared_up, shared_down):
    B, T, D = h.shape
    tok = h.reshape(B * T, D)
    n_tok = tok.shape[0]
    scores = jax.nn.sigmoid(tok.astype(jnp.float32) @ w_router.astype(jnp.float32))
    sel = scores + router_bias.astype(jnp.float32)
    per_group = N_EXPERTS // N_GROUPS
    grp_score = jnp.sum(lax.top_k(sel.reshape(n_tok, N_GROUPS, per_group), 2)[0], axis=-1)
    _, top_grp = lax.top_k(grp_score, TOPK_GROUPS)
    grp_mask = jnp.any(top_grp[:, :, None] == jnp.arange(N_GROUPS)[None, None, :], axis=1)
    sel = jnp.where(jnp.repeat(grp_mask, per_group, axis=1), sel, NEG_INF)
    _, idx = lax.top_k(sel, TOP_K)
    gates = jnp.take_along_axis(scores, idx, axis=1)
    gates = gates / jnp.sum(gates, axis=-1, keepdims=True) * ROUTED_SCALE
    routed = routed_experts(tok, idx, gates, experts_up, experts_down)
    shared = swiglu(tok, shared_up, shared_down)
    return (routed + shared).reshape(B, T, D)


def setup_inputs(seed: int = 0) -> dict:
    key = jax.random.key(seed)
    ks = jax.random.split(key, 21)
    n_even = (DEPTH + 1) // 2
    n_odd = DEPTH // 2
    f32 = jnp.float32
    def nrm(k, shape, scale):
        return jax.random.normal(k, shape, f32) * scale
    def gain(k, shape):
        return 1.0 + 0.1 * jax.random.normal(k, shape, f32)
    return {
        'x': nrm(ks[0], (BATCH, SEQ, D_MODEL), 1.0),
        'c': nrm(ks[1], (BATCH, D_MODEL), 1.0),
        'norm_mix': gain(ks[2], (DEPTH, D_MODEL)),
        'norm_ffn': gain(ks[3], (DEPTH, D_MODEL)),
        'w_ada': nrm(ks[4], (DEPTH, D_MODEL, 6 * D_MODEL), 0.5 * D_MODEL ** -0.5),
        'b_ada': nrm(ks[5], (DEPTH, 6 * D_MODEL), 0.02),
        'ab_w_in': nrm(ks[6], (n_even, D_MODEL, AB_IN_COLS), D_MODEL ** -0.5),
        'ab_qk_norm': gain(ks[7], (n_even, 4, HEAD_DIM)),
        'ab_sinks': nrm(ks[8], (n_even, B_HEADS), 1.0),
        'ab_w_out': nrm(ks[9], (n_even, AB_OUT_ROWS, D_MODEL), AB_OUT_ROWS ** -0.5),
        'c_w_in': nrm(ks[10], (n_odd, D_MODEL, C_IN_COLS), D_MODEL ** -0.5),
        'c_qk_norm': gain(ks[11], (n_odd, 2, HEAD_DIM)),
        'c_lambda': nrm(ks[12], (n_odd, 4, HEAD_DIM), 0.1),
        'c_subln': gain(ks[13], (n_odd, 2 * HEAD_DIM)),
        'c_w_out': nrm(ks[14], (n_odd, C_OUT_ROWS, D_MODEL), C_OUT_ROWS ** -0.5),
        'w_router': nrm(ks[15], (DEPTH, D_MODEL, N_EXPERTS), D_MODEL ** -0.5),
        'router_bias': nrm(ks[16], (DEPTH, N_EXPERTS), 0.01),
        'experts_up': nrm(ks[17], (DEPTH, N_EXPERTS, D_MODEL, 2 * EXPERT_DIM), D_MODEL ** -0.5),
        'experts_down': nrm(ks[18], (DEPTH, N_EXPERTS, EXPERT_DIM, D_MODEL), EXPERT_DIM ** -0.5),
        'shared_up': nrm(ks[19], (DEPTH, D_MODEL, 2 * SHARED_DIM), D_MODEL ** -0.5),
        'shared_down': nrm(ks[20], (DEPTH, SHARED_DIM, D_MODEL), SHARED_DIM ** -0.5),
    }


def reference(x, c, norm_mix, norm_ffn, w_ada, b_ada, ab_w_in, ab_qk_norm, ab_sinks, ab_w_out,
              c_w_in, c_qk_norm, c_lambda, c_subln, c_w_out, w_router, router_bias,
              experts_up, experts_down, shared_up, shared_down):
    cond = jax.nn.silu(c)
    for i in range(DEPTH):
        ada = cond @ w_ada[i] + b_ada[i]
        sh_m, sc_m, g_m, sh_f, sc_f, g_f = [a[:, None, :] for a in jnp.split(ada, 6, axis=-1)]
        h = modulate(rmsnorm(x, norm_mix[i]), sh_m, sc_m)
        j = i // 2
        if i % 2 == 0:
            mix = even_mixer(h, ab_w_in[j], ab_qk_norm[j], ab_sinks[j], ab_w_out[j])
        else:
            mix = odd_mixer(h, c_w_in[j], c_qk_norm[j], c_lambda[j], c_subln[j], c_w_out[j], i)
        x = x + g_m * mix
        h = modulate(rmsnorm(x, norm_ffn[i]), sh_f, sc_f)
        x = x + g_f * moe_ffn(h, w_router[i], router_bias[i], experts_up[i], experts_down[i],
                              shared_up[i], shared_down[i])
    return x
```

```cpp
#include <hip/hip_runtime.h>
#include <cstdio>
#include <cstdint>
#include <hip/hip_bf16.h>

#ifndef USE_PG8_OUT
#define USE_PG8_OUT 1
#endif
#ifndef USE_PG8_QKV
#define USE_PG8_QKV 1
#endif
#ifndef USE_PG8_MOE
#define USE_PG8_MOE 1
#endif
#ifndef USE_ATT1
#define USE_ATT1 1
#endif
#ifndef USE_ATT0
#define USE_ATT0 1
#endif
#ifndef USE_ROUTER2
#define USE_ROUTER2 1
#endif
#ifndef REPMASK
#define REPMASK 0u
#endif
#ifndef USE_FP8_MOE
#define USE_FP8_MOE 1
#endif
#ifndef USE_CONV128
#define USE_CONV128 1
#endif
#ifndef USE_FP8_QKV
#define USE_FP8_QKV 1
#endif
#ifndef SHARED_BF16
#define SHARED_BF16 1
#endif
#ifndef Y_FP8
#define Y_FP8 1
#endif
#ifndef DEFER_CONV
#define DEFER_CONV 1
#endif
#ifndef RES_BF16
#define RES_BF16 1
#endif
#ifndef FUSE_FINISH
#define FUSE_FINISH 1
#endif
#ifndef MK_SPLIT
#define MK_SPLIT 0
#endif

constexpr int D = 2048, NB = 4, T = 4096, M = NB * T;
constexpr int HD = 64;
constexpr int AB_IN = 4352, C_IN = 6144;
constexpr int NE = 64, TOPK = 8, ED = 512;
constexpr int UPN = 2 * ED;
constexpr int NEX = NE + 1;
constexpr int CAPR = M * TOPK + NE * 256;
constexpr int CAP = CAPR + M;
constexpr int MAXTILES = CAP / 256;
constexpr float RMS_EPS = 1e-6f;
constexpr int NPHASE = 21;

typedef unsigned short bf16;
typedef short bf16x8 __attribute__((ext_vector_type(8)));
typedef float f32x4 __attribute__((ext_vector_type(4)));
typedef unsigned u32x4 __attribute__((ext_vector_type(4)));
typedef unsigned u32x2 __attribute__((ext_vector_type(2)));
#define LAS __attribute__((address_space(3)))

constexpr size_t MiB = 1u << 20;
constexpr size_t WS_CTL = 0, CTL_BYTES = 1 * MiB;
constexpr size_t WS_ADA = 1 * MiB;
constexpr size_t WS_W0IN = 2 * MiB;
constexpr size_t WS_W0OUT = WS_W0IN + (size_t)AB_IN * D * 2;
constexpr size_t WS_W1IN = WS_W0OUT + (size_t)D * D * 2;
constexpr size_t WS_W1OUT = WS_W1IN + (size_t)C_IN * D * 2;
constexpr size_t WS_WUP = WS_W1OUT + (size_t)D * D * 2;
constexpr size_t WS_WDN = WS_WUP + (size_t)2 * NEX * UPN * D * 2;
constexpr size_t WS_XN = WS_WDN + (size_t)2 * NEX * D * ED * 2;
constexpr size_t WS_QKV = WS_XN + (size_t)M * D * 2;
constexpr size_t WS_O = WS_QKV + (size_t)M * C_IN * 2;
constexpr size_t WS_X1 = WS_O + (size_t)M * D * 2;
constexpr size_t WS_HF = WS_X1 + (size_t)M * D * 4;
constexpr size_t WS_IDX = WS_HF + (size_t)M * D * 2;
constexpr size_t WS_GATE = WS_IDX + (size_t)M * 8 * 4;
constexpr size_t WS_POS = WS_GATE + (size_t)M * 8 * 4;
constexpr size_t WS_SLOTTOK = WS_POS + (size_t)M * 8 * 4;
constexpr size_t WS_TILEEXP = WS_SLOTTOK + (size_t)CAP * 4;
constexpr size_t WS_ACT = WS_TILEEXP + 4096;
constexpr size_t WS_Y = WS_ACT + (size_t)CAP * ED * 2;
constexpr size_t WS_TMP = WS_Y + (size_t)CAP * D * 2;
constexpr size_t WS_WRT = WS_TMP + (size_t)M * 16 * 2 * 128 * 4;
constexpr size_t WS_WCNT = WS_WRT + (size_t)2 * 2 * NE * D * 2;
constexpr size_t WS_HFB = WS_WCNT + (size_t)4096 * 64 * 4;
constexpr size_t WS_ACTS = WS_HFB + (size_t)M * D * 2;
constexpr size_t WS_WUPS = WS_ACTS + (size_t)M * ED * 2;
constexpr size_t WS_WDNS = WS_WUPS + (size_t)2 * UPN * D * 2;
constexpr size_t WS_END = WS_WDNS + (size_t)2 * D * ED * 2;
constexpr int CW_BAR = 4096;
constexpr int CW_CNT = 16384;
constexpr int CW_CUR = 16384 + 256;
constexpr int CW_NRT = 16384 + 512;
constexpr int CW_QCTR = 16384 + 1024;

constexpr int LDS_BYTES = 147456;

__device__ __forceinline__ unsigned pk4_fp8(float a, float b, float c2, float d);
constexpr float F8_WSCALE = 256.f, F8_HSCALE = 16.f, F8_ASCALE = 8.f, F8_YSCALE = 32.f;
__device__ __forceinline__ float bf2f(unsigned v) { return __uint_as_float(v << 16); }
__device__ __forceinline__ unsigned f2bf(float f) { unsigned u = __float_as_uint(f); return (u + 0x7fffu + ((u >> 16) & 1u)) >> 16; }
__device__ __forceinline__ unsigned pk2(float lo, float hi) { return f2bf(lo) | (f2bf(hi) << 16); }
__device__ __forceinline__ float wave_sum(float v) {
#pragma unroll
    for (int o = 1; o < 64; o <<= 1) v += __shfl_xor(v, o);
    return v;
}
__device__ __forceinline__ float siluf(float x) { return x / (1.f + __expf(-x)); }

#define XB_TMO      128
#define XB_XCNT(j)  (256  + 64 * (j))
#define XB_XSUB(j)  (1280 + 64 * (j))
#define XB_XGEN(j)  (2304 + 64 * (j))
#define XB_TOP      3328
#define XB_TOPGEN   3392
#define XCD_BAR_WORDS 3456
#define XB_SPIN_CAP (1u << 22)
__device__ __forceinline__ unsigned xb_ld(unsigned* p)              { return __hip_atomic_load(p, __ATOMIC_RELAXED, __HIP_MEMORY_SCOPE_AGENT); }
__device__ __forceinline__ unsigned xb_add(unsigned* p, unsigned v) { return __hip_atomic_fetch_add(p, v, __ATOMIC_RELAXED, __HIP_MEMORY_SCOPE_AGENT); }
__device__ __forceinline__ unsigned xb_xcc_id() { return (unsigned)__builtin_amdgcn_s_getreg((3 << 11) | 20) & 0xFu; }
#define XB_SPIN(cond, bar) do { unsigned _sp = 0; while (cond) { __builtin_amdgcn_s_sleep(1); \
    if ((++_sp & 255u) == 0u) { if (xb_ld(&(bar)[XB_TMO])) break; if (_sp > XB_SPIN_CAP) { atomicAdd(&(bar)[XB_TMO], 1u); break; } } } } while (0)
struct XcdBarrier { unsigned* bar; unsigned x; volatile LAS unsigned* st; };
__device__ __forceinline__ XcdBarrier xcd_barrier_post(unsigned* bar, volatile LAS unsigned* st) {
    XcdBarrier b; b.bar = bar; b.x = xb_xcc_id(); b.st = st;
    if (threadIdx.x == 0) (void)xb_add(&bar[XB_XCNT(b.x)], 1u);
    return b;
}
__device__ __forceinline__ void xcd_barrier_complete(unsigned* bar, unsigned x, unsigned& nloc, unsigned& nx) {
    const unsigned G = gridDim.x * gridDim.y * gridDim.z;
    unsigned sum, cnt, mine, sp = 0u;
    for (;;) {
        sum = 0u; cnt = 0u; mine = 0u;
#pragma unroll
        for (unsigned j = 0; j < 16; ++j) { const unsigned c = xb_ld(&bar[XB_XCNT(j)]); sum += c; cnt += (c > 0u) ? 1u : 0u; mine = (j == x) ? c : mine; }
        if (sum == G) break;
        __builtin_amdgcn_s_sleep(1);
        if ((++sp & 255u) == 0u) { if (xb_ld(&bar[XB_TMO])) break; if (sp > XB_SPIN_CAP) { atomicAdd(&bar[XB_TMO], 1u); break; } }
    }
    nloc = mine > 0u ? mine : 1u; nx = cnt > 0u ? cnt : 1u;
}
__device__ __forceinline__ void xcd_barrier(const XcdBarrier& b) {
    asm volatile("s_waitcnt vmcnt(0)" ::: "memory");
    __syncthreads();
    if (threadIdx.x == 0) {
        unsigned* bar = b.bar;
        __builtin_amdgcn_s_waitcnt(0);
        unsigned nloc = b.st[0], nx = b.st[1];
        if (nloc == 0u) { xcd_barrier_complete(bar, b.x, nloc, nx); b.st[0] = nloc; b.st[1] = nx; }
        const unsigned old = xb_add(&bar[XB_XSUB(b.x)], 1u);
        const unsigned gen = old / nloc;
        if (old + 1u == (gen + 1u) * nloc) {
            __builtin_amdgcn_fence(__ATOMIC_RELEASE, "agent");
            asm volatile("s_waitcnt vmcnt(0)" ::: "memory");
            const unsigned og = xb_add(&bar[XB_TOP], 1u);
            const unsigned tg = og / nx;
            if (og + 1u == (tg + 1u) * nx) xb_add(&bar[XB_TOPGEN], 1u);
            else XB_SPIN(xb_ld(&bar[XB_TOPGEN]) == tg, bar);
            __builtin_amdgcn_fence(__ATOMIC_ACQUIRE, "agent");
            xb_add(&bar[XB_XGEN(b.x)], 1u);
            asm volatile("s_waitcnt vmcnt(0)" ::: "memory");
        } else {
            XB_SPIN(xb_ld(&bar[XB_XGEN(b.x)]) == gen, bar);
            __builtin_amdgcn_fence(__ATOMIC_ACQUIRE, "agent");
            asm volatile("s_waitcnt vmcnt(0)" ::: "memory");
        }
    }
    __syncthreads();
}

struct Args {
    const float* in[21];
    float* out;
    unsigned char* ws;
    int ph_lo, ph_hi;
};

struct Ctx {
    int tid, lane, wave, gw, ngw, gsz;
    LAS unsigned char* lds;
    unsigned char* ws;
    unsigned* ctl;
};

__device__ __forceinline__ int gtid_now() { int t = (int)(blockIdx.x * 512u + threadIdx.x); asm volatile("" : "+v"(t)); return t; }
template <int MODE> __device__ __forceinline__ int perm_row(int n) {
    if (MODE == 1) { const int nl = n & 255; return (n & ~255) + 128 * ((nl >> 5) & 1) + 32 * (nl >> 6) + (nl & 31); }
    if (MODE == 2) { const int bj = n >> 9, rem = n & 511; return 256 * (rem >> 7) + 128 * bj + (rem & 127); }
    return n;
}
template <int MODE> __device__ __forceinline__ void transpose_item(const float* W, int K, int N, bf16* WT, LAS float* scr, int item, int lane) {
    const int nblk = N / 32, kb = item / nblk, nb = item % nblk, k0 = 64 * kb, n0 = 32 * nb, d0 = perm_row<MODE>(n0);
#pragma unroll 8
    for (int i = 0; i < 32; ++i) { const int kk = 2 * i + (lane >> 5); scr[kk * 33 + (lane & 31)] = W[(size_t)(k0 + kk) * N + n0 + (lane & 31)]; }
    asm volatile("s_waitcnt lgkmcnt(0)" ::: "memory");
    const int c = lane & 7;
#pragma unroll
    for (int j = 0; j < 4; ++j) { const int n = (lane >> 3) + 8 * j; const LAS float* s = scr + (8 * c) * 33 + n;
        u32x4 o; o.x = pk2(s[0 * 33], s[1 * 33]); o.y = pk2(s[2 * 33], s[3 * 33]); o.z = pk2(s[4 * 33], s[5 * 33]); o.w = pk2(s[6 * 33], s[7 * 33]);
        *(u32x4*)(WT + (size_t)(d0 + n) * K + k0 + 8 * c) = o; }
    asm volatile("s_waitcnt lgkmcnt(0)" ::: "memory");
}
template <int MODE> __device__ __forceinline__ void convert_batch(const Ctx& c, const float* src, int K, int N, bf16* dst, int nmat, size_t dst_stride) {
    LAS float* scr = (LAS float*)(c.lds + c.wave * 16384);
    const int per = (K / 64) * (N / 32); const long total = (long)per * nmat;
    for (long it = c.gw; it < total; it += c.ngw) {
        const int mat = (int)(it / per), item = (int)(it % per);
        transpose_item<MODE>(src + (size_t)mat * K * N, K, N, dst + (size_t)mat * dst_stride, scr, item, c.lane);
    }
}

__device__ __forceinline__ float clamp448(float v) { return __builtin_amdgcn_fmed3f(v, -448.f, 448.f); }
__device__ __forceinline__ unsigned pk4_fp8(float a, float b, float c2, float d) {
    unsigned w = 0u; w = __builtin_amdgcn_cvt_pk_fp8_f32(clamp448(a), clamp448(b), w, false); w = __builtin_amdgcn_cvt_pk_fp8_f32(clamp448(c2), clamp448(d), w, true); return w;
}
template <int MODE> __device__ __forceinline__ void transpose_item_f8(const float* W, int K, int N, unsigned char* WT, LAS float* scr, int item, int lane) {
    const int nblk = N / 32, kb = item / nblk, nb = item % nblk, k0 = 64 * kb, n0 = 32 * nb, d0 = perm_row<MODE>(n0);
#pragma unroll 8
    for (int i = 0; i < 32; ++i) { const int kk = 2 * i + (lane >> 5); scr[kk * 33 + (lane & 31)] = W[(size_t)(k0 + kk) * N + n0 + (lane & 31)]; }
    asm volatile("s_waitcnt lgkmcnt(0)" ::: "memory");
    const int n = lane & 31;
#pragma unroll
    for (int j = 0; j < 2; ++j) { const int ch = (lane >> 5) + 2 * j; const LAS float* s = scr + (16 * ch) * 33 + n; u32x4 o;
#pragma unroll
        for (int q = 0; q < 4; ++q) o[q] = pk4_fp8(s[(4 * q) * 33] * F8_WSCALE, s[(4 * q + 1) * 33] * F8_WSCALE, s[(4 * q + 2) * 33] * F8_WSCALE, s[(4 * q + 3) * 33] * F8_WSCALE);
        *(u32x4*)(WT + (size_t)(d0 + n) * K + k0 + 16 * ch) = o; }
    asm volatile("s_waitcnt lgkmcnt(0)" ::: "memory");
}
template <int MODE> __device__ __forceinline__ void convert_batch_f8(const Ctx& c, const float* src, int K, int N, unsigned char* dst, int nmat, size_t dst_stride) {
    LAS float* scr = (LAS float*)(c.lds + c.wave * 16384);
    const int per = (K / 64) * (N / 32); const long total = (long)per * nmat;
    for (long it = c.gw; it < total; it += c.ngw) {
        const int mat = (int)(it / per), item = (int)(it % per);
        transpose_item_f8<MODE>(src + (size_t)mat * K * N, K, N, dst + (size_t)mat * dst_stride, scr, item, c.lane);
    }
}

template <int MODE, bool F8> __device__ __forceinline__ void transpose_item128(const float* W, int K, int N, unsigned char* WT, LAS float* scr, int item, int lane, float scale) {
    const int nblk = N / 32, kb = item / nblk, nb = item % nblk, k0 = 128 * kb, n0 = 32 * nb, d0 = perm_row<MODE>(n0);
    const int kr = lane >> 3, nq = lane & 7;
    f32x4 v[16];
#pragma unroll
    for (int i = 0; i < 16; ++i) v[i] = *(const f32x4*)(W + (size_t)(k0 + 8 * i + kr) * N + n0 + 4 * nq);
#pragma unroll
    for (int i = 0; i < 16; ++i) { LAS float* s = scr + (8 * i + kr) * 33 + 4 * nq; s[0] = v[i].x; s[1] = v[i].y; s[2] = v[i].z; s[3] = v[i].w; }
    asm volatile("s_waitcnt lgkmcnt(0)" ::: "memory");
    const int n = lane & 31, half = lane >> 5; const LAS float* s0 = scr + (64 * half) * 33 + n;
    if (F8) {
        unsigned char* dst = WT + (size_t)(d0 + n) * K + k0 + 64 * half;
#pragma unroll
        for (int ch = 0; ch < 4; ++ch) { const LAS float* s = s0 + (16 * ch) * 33; u32x4 o;
#pragma unroll
            for (int q = 0; q < 4; ++q) o[q] = pk4_fp8(s[(4 * q) * 33] * scale, s[(4 * q + 1) * 33] * scale, s[(4 * q + 2) * 33] * scale, s[(4 * q + 3) * 33] * scale);
            *(u32x4*)(dst + 16 * ch) = o; }
    } else {
        bf16* dst = (bf16*)WT + (size_t)(d0 + n) * K + k0 + 64 * half;
#pragma unroll
        for (int ch = 0; ch < 8; ++ch) { const LAS float* s = s0 + (8 * ch) * 33; u32x4 o;
#pragma unroll
            for (int q = 0; q < 4; ++q) o[q] = pk2(s[(2 * q) * 33], s[(2 * q + 1) * 33]);
            *(u32x4*)(dst + 8 * ch) = o; }
    }
    asm volatile("s_waitcnt lgkmcnt(0)" ::: "memory");
}
template <int MODE, bool F8> __device__ __forceinline__ void convert_batch128(const Ctx& c, const float* src, int K, int N, void* dst, int nmat, size_t dst_stride_bytes, float scale) {
    LAS float* scr = (LAS float*)(c.lds + c.wave * 16896);
    const int per = (K / 128) * (N / 32); const long total = (long)per * nmat;
    for (long it = c.gw; it < total; it += c.ngw) {
        const int mat = (int)(it / per), item = (int)(it % per);
        transpose_item128<MODE, F8>(src + (size_t)mat * K * N, K, N, (unsigned char*)dst + (size_t)mat * dst_stride_bytes, scr, item, c.lane, scale);
    }
}

struct ExpertSrc { const float* up; const float* sup; const float* dn; const float* sdn; };
constexpr int EXP_ITEMS_UP = NE * 512, EXP_ITEMS_SUP = 512, EXP_ITEMS_DN = NE * 256, EXP_ITEMS_SDN = 256, EXP_ITEMS = EXP_ITEMS_UP + EXP_ITEMS_SUP + EXP_ITEMS_DN + EXP_ITEMS_SDN;
__device__ __forceinline__ void expert_item(const ExpertSrc& s, int l, unsigned char* ws, LAS float* scr, int it, int lane) {
    unsigned char* wup = ws + WS_WUP + (size_t)l * NEX * UPN * D; unsigned char* wdn = ws + WS_WDN + (size_t)l * NEX * D * ED;
    if (it < EXP_ITEMS_UP) { const int mat = it >> 9; transpose_item128<2, true>(s.up + ((size_t)l * NE + mat) * D * UPN, D, UPN, wup + (size_t)mat * UPN * D, scr, it & 511, lane, F8_WSCALE); return; }
    it -= EXP_ITEMS_UP;
    if (it < EXP_ITEMS_SUP) { transpose_item128<2, true>(s.sup + (size_t)l * D * UPN, D, UPN, wup + (size_t)NE * UPN * D, scr, it, lane, F8_WSCALE); return; }
    it -= EXP_ITEMS_SUP;
    if (it < EXP_ITEMS_DN) { const int mat = it >> 8; transpose_item128<0, true>(s.dn + ((size_t)l * NE + mat) * ED * D, ED, D, wdn + (size_t)mat * D * ED, scr, it & 255, lane, F8_WSCALE); return; }
    it -= EXP_ITEMS_DN;
    transpose_item128<0, true>(s.sdn + (size_t)l * ED * D, ED, D, wdn + (size_t)NE * D * ED, scr, it, lane, F8_WSCALE);
}
__device__ __forceinline__ void expert_items_block(const Ctx& c, const ExpertSrc& s, int l, unsigned char* ws, int first, int count) {
    LAS float* scr = (LAS float*)(c.lds + c.wave * 16896);
    for (int i = c.wave; i < count; i += 8) expert_item(s, l, ws, scr, first + i, c.lane);
}
__device__ __forceinline__ void ada_phase(const Ctx& c, const float* cin, const float* w_ada, const float* b_ada, float* ada) {
    LAS float* red = (LAS float*)(c.lds);
    for (int u = blockIdx.x; u < 2 * (6 * D / 256); u += gridDim.x) {
        const int l = u / (6 * D / 256), cg = u % (6 * D / 256), col = cg * 256 + c.lane * 4;
        const float* w = w_ada + (size_t)l * D * 6 * D + col;
        f32x4 acc[4];
#pragma unroll
        for (int b = 0; b < 4; ++b) acc[b] = (f32x4){0.f, 0.f, 0.f, 0.f};
        const int k0 = c.wave * 256;
        for (int k = k0; k < k0 + 256; k += 16) {
            f32x4 wv[16];
#pragma unroll
            for (int i = 0; i < 16; ++i) wv[i] = *(const f32x4*)(w + (size_t)(k + i) * 6 * D);
#pragma unroll
            for (int i = 0; i < 16; ++i)
#pragma unroll
                for (int b = 0; b < 4; ++b) { const float s = siluf(cin[b * D + k + i]); acc[b] += wv[i] * s; }
        }
#pragma unroll
        for (int b = 0; b < 4; ++b)
#pragma unroll
            for (int j = 0; j < 4; ++j) red[(c.wave * 4 + b) * 256 + c.lane * 4 + j] = acc[b][j];
        __syncthreads();
        for (int o = c.tid; o < 4 * 256; o += 512) {
            const int b = o / 256, cc = o % 256; float s = b_ada[(size_t)l * 6 * D + cg * 256 + cc];
#pragma unroll
            for (int w8 = 0; w8 < 8; ++w8) s += red[(w8 * 4 + b) * 256 + cc];
            ada[((size_t)l * 4 + b) * 6 * D + cg * 256 + cc] = s;
        }
        __syncthreads();
    }
}

__device__ __forceinline__ void load_row(const float* xrow, int lane, f32x4 (&v)[8]) {
#pragma unroll
    for (int j = 0; j < 8; ++j) v[j] = *(const f32x4*)(xrow + 4 * lane + 256 * j);
}
__device__ __forceinline__ float row_rstd(const f32x4 (&v)[8]) {
    float s = 0.f;
#pragma unroll
    for (int j = 0; j < 8; ++j) s += (v[j].x * v[j].x + v[j].y * v[j].y) + (v[j].z * v[j].z + v[j].w * v[j].w);
    return 1.f / sqrtf(wave_sum(s) * (1.f / D) + RMS_EPS);
}
__device__ __forceinline__ void modulate_row(f32x4 (&v)[8], float rstd, const float* g, const float* sh, const float* sc, int lane) {
#pragma unroll
    for (int j = 0; j < 8; ++j) { const int col = 4 * lane + 256 * j;
        const f32x4 gg = *(const f32x4*)(g + col), s1 = *(const f32x4*)(sc + col), s0 = *(const f32x4*)(sh + col);
        v[j] = v[j] * rstd * gg * (s1 + 1.f) + s0; }
}
__device__ __forceinline__ void store_row_bf16(bf16* orow, const f32x4 (&v)[8], int lane) {
#pragma unroll
    for (int j = 0; j < 8; ++j) { u32x2 w; w.x = pk2(v[j].x, v[j].y); w.y = pk2(v[j].z, v[j].w); *(u32x2*)(orow + 4 * lane + 256 * j) = w; }
}
__device__ __forceinline__ void store_row_fp8(unsigned char* orow, const f32x4 (&v)[8], int lane, float scale) {
#pragma unroll
    for (int j = 0; j < 8; ++j) *(unsigned*)(orow + 4 * lane + 256 * j) = pk4_fp8(v[j].x * scale, v[j].y * scale, v[j].z * scale, v[j].w * scale);
}
__device__ __forceinline__ void norm_phase(const Ctx& c, const float* x, const float* g, const float* ada_l  , int sh_off, int sc_off, bf16* out) {
    for (int m = c.gw; m < M; m += c.ngw) {
        const int b = m / T; f32x4 v[8]; load_row(x + (size_t)m * D, c.lane, v);
        const float rstd = row_rstd(v);
        modulate_row(v, rstd, g, ada_l + (size_t)b * 6 * D + sh_off, ada_l + (size_t)b * 6 * D + sc_off, c.lane);
#if USE_FP8_QKV
        store_row_fp8((unsigned char*)out + (size_t)m * D, v, c.lane, F8_HSCALE);
#else
        store_row_bf16(out + (size_t)m * D, v, c.lane);
#endif
    }
}

__device__ __forceinline__ void wave_gemm_32x64(const bf16* a0, const bf16* a1, const bf16* b, int K, int lane, f32x4 (&acc)[2][4]) {
    const int q8 = (lane >> 4) * 8;
    for (int k0 = 0; k0 < K; k0 += 32) {
        const bf16x8 fa0 = *(const bf16x8*)(a0 + k0 + q8), fa1 = *(const bf16x8*)(a1 + k0 + q8);
#pragma unroll
        for (int n = 0; n < 4; ++n) { const bf16x8 fb = *(const bf16x8*)(b + (size_t)n * 16 * K + k0 + q8);
            acc[0][n] = __builtin_amdgcn_mfma_f32_16x16x32_bf16(fa0, fb, acc[0][n], 0, 0, 0);
            acc[1][n] = __builtin_amdgcn_mfma_f32_16x16x32_bf16(fa1, fb, acc[1][n], 0, 0, 0); }
    }
}
#define ZERO_ACC(acc) do { _Pragma("unroll") for (int _a = 0; _a < 2; ++_a) _Pragma("unroll") for (int _b = 0; _b < 4; ++_b) acc[_a][_b] = (f32x4){0.f, 0.f, 0.f, 0.f}; } while (0)

__device__ __forceinline__ void gemm_plain_bf16(const Ctx& c, const bf16* A, const bf16* Bt, int K, int N, bf16* C) {
    const int ntn = N / 64, units = (M / 256) * ntn;
    for (int u = blockIdx.x; u < units; u += gridDim.x) {
        const int mt = u / ntn, nt = u % ntn, row0 = mt * 256 + c.wave * 32, n0 = nt * 64;
        f32x4 acc[2][4]; ZERO_ACC(acc);
        const int r = c.lane & 15;
        wave_gemm_32x64(A + (size_t)(row0 + r) * K, A + (size_t)(row0 + 16 + r) * K, Bt + (size_t)(n0 + r) * K, K, c.lane, acc);
#pragma unroll
        for (int mi = 0; mi < 2; ++mi)
#pragma unroll
            for (int n = 0; n < 4; ++n)
#pragma unroll
                for (int j = 0; j < 4; ++j) C[(size_t)(row0 + 16 * mi + 4 * (c.lane >> 4) + j) * N + n0 + 16 * n + r] = (bf16)f2bf(acc[mi][n][j]);
    }
}
__device__ __forceinline__ void gemm_outproj(const Ctx& c, const bf16* A, const bf16* Bt, const float* xin, const float* gm  , float* X1) {
    const int K = D, N = D, ntn = N / 64, units = (M / 256) * ntn;
    for (int u = blockIdx.x; u < units; u += gridDim.x) {
        const int mt = u / ntn, nt = u % ntn, row0 = mt * 256 + c.wave * 32, n0 = nt * 64;
        f32x4 acc[2][4]; ZERO_ACC(acc);
        const int r = c.lane & 15;
        wave_gemm_32x64(A + (size_t)(row0 + r) * K, A + (size_t)(row0 + 16 + r) * K, Bt + (size_t)(n0 + r) * K, K, c.lane, acc);
        const int b = row0 / T;
#pragma unroll
        for (int mi = 0; mi < 2; ++mi)
#pragma unroll
            for (int n = 0; n < 4; ++n)
#pragma unroll
                for (int j = 0; j < 4; ++j) { const size_t o = (size_t)(row0 + 16 * mi + 4 * (c.lane >> 4) + j) * N + n0 + 16 * n + r;
                    X1[o] = xin[o] + gm[(size_t)b * 6 * D + n0 + 16 * n + r] * acc[mi][n][j]; }
    }
}

__device__ __forceinline__ void qknorm_chunk(bf16* p, const float* g) {
    float v[64]; float ss = 0.f;
#pragma unroll
    for (int i = 0; i < 8; ++i) { const u32x4 w = *(const u32x4*)(p + 8 * i);
#pragma unroll
        for (int j = 0; j < 4; ++j) { v[8 * i + 2 * j] = bf2f(w[j] & 0xffffu); v[8 * i + 2 * j + 1] = bf2f(w[j] >> 16); } }
#pragma unroll
    for (int i = 0; i < 64; ++i) ss += v[i] * v[i];
    const float rs = 1.f / sqrtf(ss * (1.f / 64.f) + RMS_EPS);
#pragma unroll
    for (int i = 0; i < 8; ++i) { u32x4 w;
#pragma unroll
        for (int j = 0; j < 4; ++j) w[j] = pk2(v[8 * i + 2 * j] * rs * g[8 * i + 2 * j], v[8 * i + 2 * j + 1] * rs * g[8 * i + 2 * j + 1]);
        *(u32x4*)(p + 8 * i) = w; }
}
__device__ __forceinline__ void qknorm0_phase(const Ctx& c, bf16* qkv, const float* gains  ) {
    const long total = (long)M * 50;
    for (long id = gtid_now(); id < total; id += c.gsz) {
        const int m = (int)(id / 50), k = (int)(id % 50); int ch, gi;
        if (k < 16) { ch = k; gi = 0; } else if (k < 32) { ch = k; gi = 1; } else if (k < 48) { ch = k + 16; gi = 2; } else { ch = k + 16; gi = 3; }
        qknorm_chunk(qkv + (size_t)m * AB_IN + 64 * ch, gains + 64 * gi);
    }
}
__device__ __forceinline__ void qknorm1_phase(const Ctx& c, bf16* qkv, const float* gains  ) {
    const long total = (long)M * 64;
    for (long id = gtid_now(); id < total; id += c.gsz) {
        const int m = (int)(id / 64), ch = (int)(id % 64);
        qknorm_chunk(qkv + (size_t)m * C_IN + 64 * ch, gains + 64 * (ch >> 5));
    }
}

__device__ __forceinline__ void load64(const bf16* p, float (&v)[64], float scale) {
#pragma unroll
    for (int i = 0; i < 8; ++i) { const u32x4 w = *(const u32x4*)(p + 8 * i);
#pragma unroll
        for (int j = 0; j < 4; ++j) { v[8 * i + 2 * j] = bf2f(w[j] & 0xffffu) * scale; v[8 * i + 2 * j + 1] = bf2f(w[j] >> 16) * scale; } }
}
__device__ __forceinline__ float dot64(const float (&q)[64], const bf16* kp) {
    float s0 = 0.f, s1 = 0.f;
#pragma unroll
    for (int i = 0; i < 8; ++i) { const u32x4 w = *(const u32x4*)(kp + 8 * i);
#pragma unroll
        for (int j = 0; j < 4; ++j) { s0 += q[8 * i + 2 * j] * bf2f(w[j] & 0xffffu); s1 += q[8 * i + 2 * j + 1] * bf2f(w[j] >> 16); } }
    return s0 + s1;
}
__device__ __forceinline__ void axpy64(float (&o)[64], float a, float p, const bf16* vp) {
#pragma unroll
    for (int i = 0; i < 8; ++i) { const u32x4 w = *(const u32x4*)(vp + 8 * i);
#pragma unroll
        for (int j = 0; j < 4; ++j) { o[8 * i + 2 * j] = o[8 * i + 2 * j] * a + p * bf2f(w[j] & 0xffffu); o[8 * i + 2 * j + 1] = o[8 * i + 2 * j + 1] * a + p * bf2f(w[j] >> 16); } }
}
__device__ __forceinline__ void store64_bf16(bf16* p, const float (&o)[64], float s) {
#pragma unroll
    for (int i = 0; i < 8; ++i) { u32x4 w;
#pragma unroll
        for (int j = 0; j < 4; ++j) w[j] = pk2(o[8 * i + 2 * j] * s, o[8 * i + 2 * j + 1] * s);
        *(u32x4*)(p + 8 * i) = w; }
}
__device__ __forceinline__ void attn0_phase(const Ctx& c, const bf16* qkv, const float* sinks, bf16* O) {
    const long total = (long)32 * M;
    for (long id = gtid_now(); id < total; id += c.gsz) {
        const int hh = (int)(id / M), m = (int)(id % M), b = m / T, t = m % T;
        float q[64], o[64];
#pragma unroll
        for (int i = 0; i < 64; ++i) o[i] = 0.f;
        float mx = -1e30f, l = 0.f;
        if (hh < 16) {
            const int h = hh; const float slope = exp2f(-0.5f * (float)(h + 1));
            load64(qkv + (size_t)m * AB_IN + 64 * h, q, 0.125f);
            const bf16* kb = qkv + (size_t)b * T * AB_IN + 1024 + 64 * h;
            for (int br = 0; br < 3; ++br) {
                const int dil = br == 0 ? 1 : (br == 1 ? 4 : 16);
                for (int j = 0; j <= 128; ++j) {
                    const int s = t - dil * j; if (s < 0) break;
                    const bf16* kp = kb + (size_t)s * AB_IN;
                    const float sc = dot64(q, kp) - slope * (float)(dil * j);
                    const float mn = fmaxf(mx, sc), a = __expf(mx - mn), p = __expf(sc - mn);
                    l = l * a + p; axpy64(o, a, p, kp + 1024); mx = mn;
                }
            }
            store64_bf16(O + (size_t)m * D + 64 * h, o, 1.f / l);
        } else {
            const int h = hh - 16, kvh = h >> 3; const float slope = exp2f(-0.5f * (float)(h + 1));
            load64(qkv + (size_t)m * AB_IN + 3072 + 64 * h, q, 0.125f);
            const bf16* kb = qkv + (size_t)b * T * AB_IN + 4096 + 64 * kvh;
            for (int j = 0; j < 128; ++j) {
                const int s = t - j; if (s < 0) break;
                const bf16* kp = kb + (size_t)s * AB_IN;
                const float sc = dot64(q, kp) - slope * (float)j;
                const float mn = fmaxf(mx, sc), a = __expf(mx - mn), p = __expf(sc - mn);
                l = l * a + p; axpy64(o, a, p, kp + 128); mx = mn;
            }
            const float sk = sinks[h], mn = fmaxf(mx, sk), a = __expf(mx - mn);
            l = l * a + __expf(sk - mn);
            store64_bf16(O + (size_t)m * D + 1024 + 64 * h, o, a / l);
        }
    }
}
__device__ __forceinline__ void attn1_phase(const Ctx& c, const bf16* qkv, float* tmp) {
    const int items = NB * 16 * 2 * 2 * (T / 64);
    for (int it = c.gw; it < items; it += c.ngw) {
        const int tb = (T / 64 - 1) - it / (NB * 16 * 4); const int r = it % (NB * 16 * 4);
        const int b = r / 64, h = (r / 4) % 16, i = (r >> 1) & 1, j = r & 1;
        const int t = tb * 64 + c.lane, m = b * T + t;
        const float slope = exp2f(-0.5f * (float)(h + 1));
        float q[64], o[64];
#pragma unroll
        for (int d = 0; d < 64; ++d) o[d] = 0.f;
        float mx = -1e30f, l = 0.f;
        load64(qkv + (size_t)m * C_IN + 128 * h + 64 * i, q, 0.125f);
        const bf16* kb = qkv + (size_t)b * T * C_IN + 2048 + 128 * h + 64 * i;
        const bf16* vb = qkv + (size_t)b * T * C_IN + 4096 + 128 * h + 64 * j;
        const int smax = tb * 64 + 63;
        for (int s = 0; s <= smax; ++s) {
            const bf16* kp = kb + (size_t)s * C_IN;
            float sc = dot64(q, kp) - slope * (float)(t - s);
            if (s > t) sc = -1e30f;
            const float mn = fmaxf(mx, sc), a = __expf(mx - mn), p = (s > t) ? 0.f : __expf(sc - mn);
            l = l * a + p; axpy64(o, a, p, vb + (size_t)s * C_IN); mx = mn;
        }
        float* op = tmp + (((size_t)m * 16 + h) * 2 + i) * 128 + 64 * j; const float il = 1.f / l;
#pragma unroll
        for (int d = 0; d < 16; ++d) *(f32x4*)(op + 4 * d) = (f32x4){o[4 * d] * il, o[4 * d + 1] * il, o[4 * d + 2] * il, o[4 * d + 3] * il};
    }
}
__device__ __forceinline__ void attn1_finish_phase(const Ctx& c, const float* tmp, const float* lamp  , const float* subln  , bf16* O) {
    float s01 = 0.f, s23 = 0.f;
    for (int i = 0; i < 64; ++i) { s01 += lamp[i] * lamp[64 + i]; s23 += lamp[128 + i] * lamp[192 + i]; }
    const float lam_init = 0.8f - 0.6f * expf(-0.3f * 1.0f);
    const float lam = expf(s01) - expf(s23) + lam_init;
    const long total = (long)M * 16;
    for (long id = gtid_now(); id < total; id += c.gsz) {
        const float* p1 = tmp + (size_t)id * 256; const float* p2 = p1 + 128;
        float ss = 0.f;
        for (int d = 0; d < 128; ++d) { const float v = p1[d] - lam * p2[d]; ss += v * v; }
        const float rs = (1.f - lam_init) / sqrtf(ss * (1.f / 128.f) + RMS_EPS);
        bf16* op = O + (size_t)id * 128;
        for (int d = 0; d < 128; d += 2) { const float v0 = (p1[d] - lam * p2[d]) * rs * subln[d], v1 = (p1[d + 1] - lam * p2[d + 1]) * rs * subln[d + 1];
            *(unsigned*)(op + d) = pk2(v0, v1); }
    }
}

__device__ __forceinline__ void router_phase(const Ctx& c, const float* x1, const float* g, const float* ada_l, const float* wr  , const float* rbias  ,
                                             bf16* HF, int* idx, float* gate, unsigned* counts) {
    LAS float* hb = (LAS float*)(c.lds + c.wave * 8192);
    const int lane = c.lane;
    for (int m = c.gw; m < M; m += c.ngw) {
        const int b = m / T; f32x4 v[8]; load_row(x1 + (size_t)m * D, lane, v);
        const float rstd = row_rstd(v);
        modulate_row(v, rstd, g, ada_l + (size_t)b * 6 * D + 3 * D, ada_l + (size_t)b * 6 * D + 4 * D, lane);
        store_row_bf16(HF + (size_t)m * D, v, lane);
#pragma unroll
        for (int j = 0; j < 8; ++j) *(LAS f32x4*)(hb + 4 * lane + 256 * j) = v[j];
        asm volatile("s_waitcnt lgkmcnt(0)" ::: "memory");
        float a0 = 0.f, a1 = 0.f, a2 = 0.f, a3 = 0.f;
        for (int k = 0; k < D; k += 4) {
            const f32x4 hv = *(const LAS f32x4*)(hb + k);
            a0 += hv.x * wr[(size_t)(k + 0) * 64 + lane]; a1 += hv.y * wr[(size_t)(k + 1) * 64 + lane];
            a2 += hv.z * wr[(size_t)(k + 2) * 64 + lane]; a3 += hv.w * wr[(size_t)(k + 3) * 64 + lane];
        }
        const float logit = (a0 + a1) + (a2 + a3);
        const float score = 1.f / (1.f + expf(-logit));
        const float sel = score + rbias[lane];
        float m1 = sel;
        m1 = fmaxf(m1, __shfl_xor(m1, 1)); m1 = fmaxf(m1, __shfl_xor(m1, 2)); m1 = fmaxf(m1, __shfl_xor(m1, 4));
        const unsigned long long eqm = __ballot(sel == m1);
        const int gbase = lane & ~7;
        const unsigned grp_eq = (unsigned)((eqm >> gbase) & 0xffull);
        const int first = __builtin_ctz(grp_eq);
        float m2 = ((lane & 7) == first) ? -3e38f : sel;
        m2 = fmaxf(m2, __shfl_xor(m2, 1)); m2 = fmaxf(m2, __shfl_xor(m2, 2)); m2 = fmaxf(m2, __shfl_xor(m2, 4));
        const float gs = m1 + m2;
        int grank = 0; const int mygrp = lane >> 3;
#pragma unroll
        for (int g2 = 0; g2 < 8; ++g2) { const float o = __shfl(gs, g2 * 8); grank += (o > gs || (o == gs && g2 < mygrp)) ? 1 : 0; }
        const float msel = (grank < 4) ? sel : -1e30f;
        int rank = 0;
        for (int e2 = 0; e2 < 64; ++e2) { const float o = __shfl(msel, e2); rank += (o > msel || (o == msel && e2 < lane)) ? 1 : 0; }
        const bool chosen = rank < TOPK;
        const float gsum = wave_sum(chosen ? score : 0.f);
        if (chosen) { idx[(size_t)m * 8 + rank] = lane; gate[(size_t)m * 8 + rank] = score / gsum * 2.5f;
            __hip_atomic_fetch_add(counts + lane, 1u, __ATOMIC_RELAXED, __HIP_MEMORY_SCOPE_AGENT); }
    }
}
__device__ __forceinline__ void slot_phase(const Ctx& c, const int* idx, const unsigned* counts, unsigned* cursor, unsigned* nrt_out, int* pos, int* slot_tok, int* tile_exp) {
    LAS int* ps = (LAS int*)c.lds;
    if (c.tid == 0) { int acc = 0; for (int e = 0; e < NE; ++e) { const int cn = (int)counts[e]; ps[e] = acc; ps[64 + e] = cn; acc += (cn + 255) / 256 * 256; } ps[128] = acc; }
    __syncthreads();
    for (int a = gtid_now(); a < M * TOPK; a += c.gsz) {
        const int e = idx[a]; const unsigned r = __hip_atomic_fetch_add(cursor + e, 1u, __ATOMIC_RELAXED, __HIP_MEMORY_SCOPE_AGENT);
        const int slot = ps[e] + (int)r; slot_tok[slot] = a >> 3; pos[a] = slot;
    }
    for (int t = gtid_now(); t < M; t += c.gsz) slot_tok[CAPR + t] = t;
    if (blockIdx.x == 0) {
        if (c.tid < NE) { const int e = c.tid, s0 = ps[e], cn = ps[64 + e], pe = s0 + (cn + 255) / 256 * 256;
            for (int s = s0 + cn; s < pe; ++s) slot_tok[s] = 0;
            for (int tt = s0 / 256; tt < pe / 256; ++tt) tile_exp[tt] = e; }
        if (c.tid == 0) *nrt_out = (unsigned)(ps[128] / 256);
    }
    __syncthreads();
}
__device__ __forceinline__ void moe_up_phase(const Ctx& c, const bf16* HF, const bf16* Wup_l  , const int* slot_tok, const int* tile_exp, const unsigned* nrt_p, bf16* ACT) {
    const int nrt = (int)*nrt_p, ntiles = nrt + M / 256, units = ntiles * (ED / 64);
    for (int u = blockIdx.x; u < units; u += gridDim.x) {
        const int mt = u / (ED / 64), nt = u % (ED / 64), n0 = nt * 64;
        const int e = mt < nrt ? tile_exp[mt] : NE; const int slot0 = (mt < nrt ? mt * 256 : CAPR + (mt - nrt) * 256) + c.wave * 32;
        const int r = c.lane & 15;
        const bf16* a0 = HF + (size_t)slot_tok[slot0 + r] * D; const bf16* a1 = HF + (size_t)slot_tok[slot0 + 16 + r] * D;
        const bf16* W = Wup_l + (size_t)e * UPN * D;
        f32x4 ag[2][4], au[2][4]; ZERO_ACC(ag); ZERO_ACC(au);
        wave_gemm_32x64(a0, a1, W + (size_t)(n0 + r) * D, D, c.lane, ag);
        wave_gemm_32x64(a0, a1, W + (size_t)(ED + n0 + r) * D, D, c.lane, au);
#pragma unroll
        for (int mi = 0; mi < 2; ++mi)
#pragma unroll
            for (int n = 0; n < 4; ++n)
#pragma unroll
                for (int j = 0; j < 4; ++j) ACT[(size_t)(slot0 + 16 * mi + 4 * (c.lane >> 4) + j) * ED + n0 + 16 * n + r] = (bf16)f2bf(siluf(ag[mi][n][j]) * au[mi][n][j]);
    }
}
__device__ __forceinline__ void moe_down_phase(const Ctx& c, const bf16* ACT, const bf16* Wdn_l  , const int* tile_exp, const unsigned* nrt_p, bf16* Y) {
    const int nrt = (int)*nrt_p, ntiles = nrt + M / 256, units = ntiles * (D / 64);
    for (int u = blockIdx.x; u < units; u += gridDim.x) {
        const int mt = u / (D / 64), nt = u % (D / 64), n0 = nt * 64;
        const int e = mt < nrt ? tile_exp[mt] : NE; const int slot0 = (mt < nrt ? mt * 256 : CAPR + (mt - nrt) * 256) + c.wave * 32;
        const int r = c.lane & 15;
        const bf16* W = Wdn_l + (size_t)e * D * ED;
        f32x4 acc[2][4]; ZERO_ACC(acc);
        wave_gemm_32x64(ACT + (size_t)(slot0 + r) * ED, ACT + (size_t)(slot0 + 16 + r) * ED, W + (size_t)(n0 + r) * ED, ED, c.lane, acc);
#pragma unroll
        for (int mi = 0; mi < 2; ++mi)
#pragma unroll
            for (int n = 0; n < 4; ++n)
#pragma unroll
                for (int j = 0; j < 4; ++j) Y[(size_t)(slot0 + 16 * mi + 4 * (c.lane >> 4) + j) * D + n0 + 16 * n + r] = (bf16)f2bf(acc[mi][n][j]);
    }
}
__device__ __forceinline__ void add_row_bf16(f32x4 (&acc)[8], const bf16* yrow, float w, int lane) {
#pragma unroll
    for (int j = 0; j < 8; ++j) { const u32x2 v = *(const u32x2*)(yrow + 4 * lane + 256 * j);
        acc[j].x += w * bf2f(v.x & 0xffffu); acc[j].y += w * bf2f(v.x >> 16); acc[j].z += w * bf2f(v.y & 0xffffu); acc[j].w += w * bf2f(v.y >> 16); }
}
__device__ __forceinline__ void add_row_fp8(f32x4 (&acc)[8], const unsigned char* yrow, float w, int lane) {
#pragma unroll
    for (int j = 0; j < 8; ++j) { const unsigned v = *(const unsigned*)(yrow + 4 * lane + 256 * j);
        acc[j].x += w * __builtin_amdgcn_cvt_f32_fp8(v, 0); acc[j].y += w * __builtin_amdgcn_cvt_f32_fp8(v, 1); acc[j].z += w * __builtin_amdgcn_cvt_f32_fp8(v, 2); acc[j].w += w * __builtin_amdgcn_cvt_f32_fp8(v, 3); }
}
template <bool NEXT>
__device__ __forceinline__ void combine_phase(const Ctx& c, const float* x1, const bf16* Y, const int* pos, const float* gate, const float* ada_l, float* xo,
                                              const float* gnext, const float* ada_next, bf16* XN) {
    for (int m = c.gw; m < M; m += c.ngw) {
        const int b = m / T; f32x4 acc[8];
#pragma unroll
        for (int j = 0; j < 8; ++j) acc[j] = (f32x4){0.f, 0.f, 0.f, 0.f};
#if USE_FP8_MOE && Y_FP8
        for (int k = 0; k < TOPK; ++k) add_row_fp8(acc, (const unsigned char*)Y + (size_t)pos[(size_t)m * 8 + k] * D, gate[(size_t)m * 8 + k] * (1.f / F8_YSCALE), c.lane);
        add_row_fp8(acc, (const unsigned char*)Y + (size_t)(CAPR + m) * D, 1.f / F8_YSCALE, c.lane);
#else
        for (int k = 0; k < TOPK; ++k) add_row_bf16(acc, Y + (size_t)pos[(size_t)m * 8 + k] * D, gate[(size_t)m * 8 + k], c.lane);
        add_row_bf16(acc, Y + (size_t)(CAPR + m) * D, 1.f, c.lane);
#endif
        const float* gf = ada_l + (size_t)b * 6 * D + 5 * D;
        f32x4 v[8];
#pragma unroll
        for (int j = 0; j < 8; ++j) { const int col = 4 * c.lane + 256 * j;
#if RES_BF16
            { const u32x2 xw = *(const u32x2*)((const bf16*)x1 + (size_t)m * D + col);
              v[j] = (f32x4){bf2f(xw.x & 0xffffu), bf2f(xw.x >> 16), bf2f(xw.y & 0xffffu), bf2f(xw.y >> 16)} + *(const f32x4*)(gf + col) * acc[j]; }
            if (NEXT) { u32x2 ow; ow.x = pk2(v[j].x, v[j].y); ow.y = pk2(v[j].z, v[j].w); *(u32x2*)((bf16*)xo + (size_t)m * D + col) = ow; }
            else *(f32x4*)(xo + (size_t)m * D + col) = v[j];
#else
            v[j] = *(const f32x4*)(x1 + (size_t)m * D + col) + *(const f32x4*)(gf + col) * acc[j];
            *(f32x4*)(xo + (size_t)m * D + col) = v[j];
#endif
            }
        if (NEXT) {
            const float rstd = row_rstd(v);
            modulate_row(v, rstd, gnext, ada_next + (size_t)b * 6 * D, ada_next + (size_t)b * 6 * D + D, c.lane);
#if USE_FP8_QKV
            store_row_fp8((unsigned char*)XN + (size_t)m * D, v, c.lane, F8_HSCALE);
#else
            store_row_bf16(XN + (size_t)m * D, v, c.lane);
#endif
        }
    }
}


namespace pg8 {
constexpr int BM = 256, BK = 64, HALF = 128, HTB = HALF * BK * 2, STAGE_BYTES = 8 * HTB, NXCD = 8, WGM = 8;
__device__ __forceinline__ int lds_byte(int r, int c) { const int st = (r >> 4) * 2 + (c >> 5), rr = r & 15, cc = c & 31, ob = rr * 64 + cc * 2; return st * 1024 + (ob ^ (((ob >> 9) & 1) << 5)); }
__device__ __forceinline__ void stage_rc(int b, int& R, int& C) { const int st = b / 1024, sb = b % 1024, swz = sb ^ (((sb >> 9) & 1) << 5); R = (st >> 1) * 16 + swz / 64; C = (st & 1) * 32 + (swz % 64) / 2; }
__device__ __forceinline__ int perm32(int rho) { const int n = rho >> 4, i = rho & 15; return 8 * (i >> 2) + 4 * n + (i & 3); }
__device__ __forceinline__ unsigned cvt_pk_bf16(float lo, float hi) { unsigned r; asm volatile("v_cvt_pk_bf16_f32 %0, %1, %2" : "=v"(r) : "v"(lo), "v"(hi)); return r; }

struct Unit { int row0, pn; const char* Bp; };

struct TileOrder {
    int nM, nN, nwg, G, c;
    __device__ __forceinline__ void init(int nM_, int nN_, int G_, int c_) { nM = nM_; nN = nN_; nwg = nM * nN; G = G_; c = c_; }
    __device__ __forceinline__ bool tile(int i, int& pm, int& pn) const {
        const long L = (long)i * G + c; if (L >= nwg) return false;
        int wgid = (int)L; { const int q = nwg / NXCD, r = nwg % NXCD, xcd = wgid % NXCD, off = wgid / NXCD; wgid = (xcd < r ? xcd * (q + 1) : r * (q + 1) + (xcd - r) * q) + off; }
        const int nig = WGM * nN, gid = wgid / nig, fm = gid * WGM, gsz = (nM - fm) < WGM ? (nM - fm) : WGM;
        pm = fm + ((wgid % nig) % gsz); pn = (wgid % nig) / gsz; return true;
    }
};
struct PlainSched {
    static constexpr bool GATHER = false;
    TileOrder o; const char* Bt; int K;
    __device__ __forceinline__ bool next(int i, Unit& u) const { int pm, pn; if (!o.tile(i, pm, pn)) return false; u.row0 = pm * BM; u.pn = pn; u.Bp = Bt + (size_t)pn * BM * K * 2; return true; }
    __device__ __forceinline__ unsigned arow_off(const Unit& u, int rl) const { return (unsigned)(u.row0 + rl) * (unsigned)(K * 2); }
};
template <bool GATHER_> struct GroupSched {
    static constexpr bool GATHER = GATHER_;
    TileOrder o; const char* W; size_t wstride; int K, nrt; const int* tile_exp; const int* slot_tok;
    __device__ __forceinline__ bool next(int i, Unit& u) const { int pm, pn; if (!o.tile(i, pm, pn)) return false;
        const int e = pm < nrt ? tile_exp[pm] : NE; u.row0 = pm < nrt ? pm * BM : CAPR + (pm - nrt) * BM; u.pn = pn; u.Bp = W + (size_t)e * wstride + (size_t)pn * BM * K * 2; return true; }
    __device__ __forceinline__ unsigned arow_off(const Unit& u, int rl) const { const int r = GATHER ? slot_tok[u.row0 + rl] : (u.row0 + rl); return (unsigned)r * (unsigned)(K * 2); }
};

template <int LAYER> struct EpiQKV {
    static constexpr bool PERM = true;
    bf16* O; int ldc; const float* gains; float qscale, ascale;
    __device__ __forceinline__ void operator()(const f32x4 (&acc)[2][2][4][2], const Unit& u, int wr, int wc, int fr, int fq) const {
        const int head = 4 * u.pn + wc; int gi;
        if (LAYER == 0) gi = head < 16 ? 0 : head < 32 ? 1 : head < 48 ? -1 : head < 64 ? 2 : head < 66 ? 3 : -1;
        else gi = head < 32 ? 0 : head < 64 ? 1 : -1;
        f32x4 gv[2][2];
#pragma unroll
        for (int bj = 0; bj < 2; ++bj)
#pragma unroll
            for (int n = 0; n < 2; ++n) gv[bj][n] = gi >= 0 ? *(const f32x4*)(gains + 64 * gi + 32 * bj + 8 * fq + 4 * n) : (f32x4){1.f, 1.f, 1.f, 1.f};
        bf16* base = O + (size_t)(u.row0 + wr * 64 + fr) * ldc + 64 * head + 8 * fq;
#pragma unroll
        for (int ai = 0; ai < 2; ++ai)
#pragma unroll
            for (int m = 0; m < 4; ++m) {
                float ss = 0.f;
#pragma unroll
                for (int bj = 0; bj < 2; ++bj)
#pragma unroll
                    for (int n = 0; n < 2; ++n) { const f32x4 x = acc[ai][bj][m][n]; ss += (x[0] * x[0] + x[1] * x[1]) + (x[2] * x[2] + x[3] * x[3]); }
                ss += __shfl_xor(ss, 16); ss += __shfl_xor(ss, 32); ss *= ascale * ascale;
                const bool isq = LAYER == 0 ? (gi == 0 || gi == 2) : (gi == 0);
                const float rs = ascale * (gi >= 0 ? (isq ? qscale : 1.f) / sqrtf(ss * (1.f / 64.f) + RMS_EPS) : 1.f);
                bf16* rowp = base + (size_t)(ai * HALF + m * 16) * ldc;
#pragma unroll
                for (int bj = 0; bj < 2; ++bj) { const f32x4 v0 = acc[ai][bj][m][0] * rs * gv[bj][0], v1 = acc[ai][bj][m][1] * rs * gv[bj][1];
                    u32x4 w; w.x = cvt_pk_bf16(v0[0], v0[1]); w.y = cvt_pk_bf16(v0[2], v0[3]); w.z = cvt_pk_bf16(v1[0], v1[1]); w.w = cvt_pk_bf16(v1[2], v1[3]);
                    *(u32x4*)(rowp + 32 * bj) = w; }
            }
    }
};
struct EpiOut {
    static constexpr bool PERM = false;
    const float* xin; const float* gm; float* X1;
    __device__ __forceinline__ void operator()(const f32x4 (&acc)[2][2][4][2], const Unit& u, int wr, int wc, int fr, int fq) const {
        const int col0 = u.pn * BM + wc * 32 + 4 * fq; const float* g = gm + (size_t)(u.row0 / T) * 6 * D + col0;
        f32x4 gv[2][2];
#pragma unroll
        for (int bj = 0; bj < 2; ++bj)
#pragma unroll
            for (int n = 0; n < 2; ++n) gv[bj][n] = *(const f32x4*)(g + bj * HALF + n * 16);
#pragma unroll
        for (int ai = 0; ai < 2; ++ai)
#pragma unroll
            for (int m = 0; m < 4; ++m) { const size_t off = (size_t)(u.row0 + wr * 64 + fr + ai * HALF + m * 16) * D + col0;
#pragma unroll
                for (int bj = 0; bj < 2; ++bj)
#pragma unroll
                    for (int n = 0; n < 2; ++n) *(f32x4*)(X1 + off + bj * HALF + n * 16) = *(const f32x4*)(xin + off + bj * HALF + n * 16) + gv[bj][n] * acc[ai][bj][m][n]; }
    }
};

template <bool XIN_BF16> struct EpiOutB {
    static constexpr bool PERM = true;
    const void* xin; const float* gm; bf16* X1b;
    __device__ __forceinline__ void operator()(const f32x4 (&acc)[2][2][4][2], const Unit& u, int wr, int wc, int fr, int fq) const {
        const int col0 = u.pn * BM + wc * 32 + 8 * fq; const float* g = gm + (size_t)(u.row0 / T) * 6 * D + col0;
        f32x4 gv[2][2];
#pragma unroll
        for (int bj = 0; bj < 2; ++bj)
#pragma unroll
            for (int n = 0; n < 2; ++n) gv[bj][n] = *(const f32x4*)(g + bj * HALF + 4 * n);
        constexpr int MG = XIN_BF16 ? 4 : 2;
#pragma unroll
        for (int ai = 0; ai < 2; ++ai)
#pragma unroll
            for (int m0 = 0; m0 < 4; m0 += MG) {
                const size_t off0 = (size_t)(u.row0 + wr * 64 + fr + ai * HALF + m0 * 16) * D + col0;
                f32x4 xr[MG][2][2];
                if (XIN_BF16) {
                    u32x4 xw[MG][2];
#pragma unroll
                    for (int m = 0; m < MG; ++m)
#pragma unroll
                        for (int bj = 0; bj < 2; ++bj) xw[m][bj] = *(const u32x4*)((const bf16*)xin + off0 + (size_t)m * 16 * D + bj * HALF);
#pragma unroll
                    for (int m = 0; m < MG; ++m)
#pragma unroll
                        for (int bj = 0; bj < 2; ++bj) { const u32x4 w = xw[m][bj];
                            xr[m][bj][0] = (f32x4){bf2f(w.x & 0xffffu), bf2f(w.x >> 16), bf2f(w.y & 0xffffu), bf2f(w.y >> 16)}; xr[m][bj][1] = (f32x4){bf2f(w.z & 0xffffu), bf2f(w.z >> 16), bf2f(w.w & 0xffffu), bf2f(w.w >> 16)}; }
                } else {
#pragma unroll
                    for (int m = 0; m < MG; ++m)
#pragma unroll
                        for (int bj = 0; bj < 2; ++bj) { xr[m][bj][0] = *(const f32x4*)((const float*)xin + off0 + (size_t)m * 16 * D + bj * HALF); xr[m][bj][1] = *(const f32x4*)((const float*)xin + off0 + (size_t)m * 16 * D + bj * HALF + 4); }
                }
#pragma unroll
                for (int m = 0; m < MG; ++m)
#pragma unroll
                    for (int bj = 0; bj < 2; ++bj) { const f32x4 v0 = xr[m][bj][0] + gv[bj][0] * acc[ai][bj][m0 + m][0], v1 = xr[m][bj][1] + gv[bj][1] * acc[ai][bj][m0 + m][1];
                        u32x4 w; w.x = cvt_pk_bf16(v0[0], v0[1]); w.y = cvt_pk_bf16(v0[2], v0[3]); w.z = cvt_pk_bf16(v1[0], v1[1]); w.w = cvt_pk_bf16(v1[2], v1[3]);
                        *(u32x4*)(X1b + off0 + (size_t)m * 16 * D + bj * HALF) = w; }
            }
    }
};
__device__ __forceinline__ float silu_fast(float x) { return x * __builtin_amdgcn_rcpf(1.f + __builtin_amdgcn_exp2f(-1.4426950408889634f * x)); }
struct EpiUp {
    static constexpr bool PERM = true;
    bf16* ACT;
    __device__ __forceinline__ void operator()(const f32x4 (&acc)[2][2][4][2], const Unit& u, int wr, int wc, int fr, int fq) const {
        bf16* base = ACT + (size_t)(u.row0 + wr * 64 + fr) * ED + 128 * u.pn + 32 * wc + 8 * fq;
#pragma unroll
        for (int ai = 0; ai < 2; ++ai)
#pragma unroll
            for (int m = 0; m < 4; ++m) { f32x4 v[2];
#pragma unroll
                for (int n = 0; n < 2; ++n)
#pragma unroll
                    for (int i = 0; i < 4; ++i) v[n][i] = silu_fast(acc[ai][0][m][n][i]) * acc[ai][1][m][n][i];
                u32x4 w; w.x = cvt_pk_bf16(v[0][0], v[0][1]); w.y = cvt_pk_bf16(v[0][2], v[0][3]); w.z = cvt_pk_bf16(v[1][0], v[1][1]); w.w = cvt_pk_bf16(v[1][2], v[1][3]);
                *(u32x4*)(base + (size_t)(ai * HALF + m * 16) * ED) = w; }
    }
};
struct EpiDown {
    static constexpr bool PERM = true;
    bf16* Y; int orow = 0;
    __device__ __forceinline__ void operator()(const f32x4 (&acc)[2][2][4][2], const Unit& u, int wr, int wc, int fr, int fq) const {
        bf16* base = Y + (size_t)(orow + u.row0 + wr * 64 + fr) * D + u.pn * BM + wc * 32 + 8 * fq;
#pragma unroll
        for (int ai = 0; ai < 2; ++ai)
#pragma unroll
            for (int m = 0; m < 4; ++m) { bf16* rowp = base + (size_t)(ai * HALF + m * 16) * D;
#pragma unroll
                for (int bj = 0; bj < 2; ++bj) { const f32x4 v0 = acc[ai][bj][m][0], v1 = acc[ai][bj][m][1];
                    u32x4 w; w.x = cvt_pk_bf16(v0[0], v0[1]); w.y = cvt_pk_bf16(v0[2], v0[3]); w.z = cvt_pk_bf16(v1[0], v1[1]); w.w = cvt_pk_bf16(v1[2], v1[3]);
                    *(u32x4*)(rowp + bj * HALF) = w; } }
    }
};


struct EpiUp8 {
    static constexpr bool PERM = true;
    unsigned char* ACT8;
    __device__ __forceinline__ void operator()(const f32x4 (&acc)[2][2][4][2], const Unit& u, int wr, int wc, int fr, int fq) const {
        unsigned char* base = ACT8 + (size_t)(u.row0 + wr * 64 + fr) * ED + 128 * u.pn + 32 * wc + 8 * fq;
        constexpr float s = 1.f / (F8_HSCALE * F8_WSCALE);
#pragma unroll
        for (int ai = 0; ai < 2; ++ai)
#pragma unroll
            for (int m = 0; m < 4; ++m) { f32x4 v[2];
#pragma unroll
                for (int n = 0; n < 2; ++n)
#pragma unroll
                    for (int i = 0; i < 4; ++i) v[n][i] = silu_fast(acc[ai][0][m][n][i] * s) * (acc[ai][1][m][n][i] * (s * F8_ASCALE));
                u32x2 w; w.x = pk4_fp8(v[0][0], v[0][1], v[0][2], v[0][3]); w.y = pk4_fp8(v[1][0], v[1][1], v[1][2], v[1][3]);
                *(u32x2*)(base + (size_t)(ai * HALF + m * 16) * ED) = w; }
    }
};
struct EpiDown8 {
    static constexpr bool PERM = true;
    bf16* Y; int orow = 0; float smul = 1.f / (F8_ASCALE * F8_WSCALE);
    __device__ __forceinline__ void operator()(const f32x4 (&acc)[2][2][4][2], const Unit& u, int wr, int wc, int fr, int fq) const {
#if Y_FP8
        unsigned char* base = (unsigned char*)Y + (size_t)(orow + u.row0 + wr * 64 + fr) * D + u.pn * BM + wc * 32 + 8 * fq;
        const float s = F8_YSCALE * smul;
#pragma unroll
        for (int ai = 0; ai < 2; ++ai)
#pragma unroll
            for (int m = 0; m < 4; ++m) { unsigned char* rowp = base + (size_t)(ai * HALF + m * 16) * D;
#pragma unroll
                for (int bj = 0; bj < 2; ++bj) { const f32x4 v0 = acc[ai][bj][m][0] * s, v1 = acc[ai][bj][m][1] * s;
                    u32x2 w; w.x = pk4_fp8(v0[0], v0[1], v0[2], v0[3]); w.y = pk4_fp8(v1[0], v1[1], v1[2], v1[3]);
                    *(u32x2*)(rowp + bj * HALF) = w; } }
#else
        bf16* base = Y + (size_t)(orow + u.row0 + wr * 64 + fr) * D + u.pn * BM + wc * 32 + 8 * fq;
        const float s = smul;
#pragma unroll
        for (int ai = 0; ai < 2; ++ai)
#pragma unroll
            for (int m = 0; m < 4; ++m) { bf16* rowp = base + (size_t)(ai * HALF + m * 16) * D;
#pragma unroll
                for (int bj = 0; bj < 2; ++bj) { const f32x4 v0 = acc[ai][bj][m][0] * s, v1 = acc[ai][bj][m][1] * s;
                    u32x4 w; w.x = cvt_pk_bf16(v0[0], v0[1]); w.y = cvt_pk_bf16(v0[2], v0[3]); w.z = cvt_pk_bf16(v1[0], v1[1]); w.w = cvt_pk_bf16(v1[2], v1[3]);
                    *(u32x4*)(rowp + bj * HALF) = w; } }
#endif
    }
};
__device__ __forceinline__ void glds16s(const void* sbase, unsigned voff, unsigned lds_dst) { unsigned keep;
    asm volatile("s_mov_b32 %0, m0\n\ts_mov_b32 m0, %3\n\ts_nop 0\n\tglobal_load_lds_dwordx4 %1, %2\n\ts_mov_b32 m0, %0" : "=&s"(keep) : "v"(voff), "s"(sbase), "s"(lds_dst) : "memory"); }
__device__ __forceinline__ void glds4s(const void* sbase, unsigned voff, unsigned lds_dst) { unsigned keep;
    asm volatile("s_mov_b32 %0, m0\n\ts_mov_b32 m0, %3\n\ts_nop 0\n\tglobal_load_lds_dword %1, %2\n\ts_mov_b32 m0, %0" : "=&s"(keep) : "v"(voff), "s"(sbase), "s"(lds_dst) : "memory"); }
typedef int i32x4 __attribute__((ext_vector_type(4)));
typedef int i32x8 __attribute__((ext_vector_type(8)));
__device__ __forceinline__ i32x8 cat8(bf16x8 a, bf16x8 b) { return __builtin_shufflevector(__builtin_bit_cast(i32x4, a), __builtin_bit_cast(i32x4, b), 0, 1, 2, 3, 4, 5, 6, 7); }
__device__ __forceinline__ void mfma8_inplace(f32x4& acc, i32x8 a, i32x8 b) { asm volatile("v_mfma_f32_16x16x128_f8f6f4 %0, %1, %2, %0" : "+v"(acc) : "v"(a), "v"(b)); }
template <class Epi, class Sched, bool FP8 = false>
__device__ __forceinline__ void gemm_phase(LAS unsigned char* lds, const char* Abase, const int K, const Sched& S, const Epi& E) {
    constexpr bool GATHER = Sched::GATHER;
    const int tid = threadIdx.x, wid = __builtin_amdgcn_readfirstlane(tid >> 6), lane = tid & 63, wr = wid >> 2, wc = wid & 3, fr = lane & 15, fq = lane >> 4;
    int nt = K / BK; asm volatile("" : "+s"(nt));
    int RA[2]; unsigned CA[2], voffB[2], vC[2];
#pragma unroll
    for (int i = 0; i < 2; ++i) { int R, C; stage_rc(tid * 16 + i * 8192, R, C); const int Rb = Epi::PERM ? ((R & ~31) + perm32(R & 31)) : R;
        RA[i] = R; CA[i] = (unsigned)C * 2u; voffB[i] = (unsigned)(Rb * K + C) * 2u; vC[i] = (unsigned)(R * K + C) * 2u; }
    const size_t kstep = (size_t)(BK * 2);
    const size_t hstep = (size_t)HALF * K * 2;
    const size_t ahstep = GATHER ? 0 : hstep;
    const unsigned ldsw = (unsigned)wid * 1024u;
    const unsigned lds0 = (unsigned)(uintptr_t)lds;
    const int aoff = lds_byte(wr * 64 + fr, fq * 8), boff = lds_byte(wc * 32 + fr, fq * 8);
#define PG8_SA(b, h) (((b) * 2 + (h)) * HTB)
#define PG8_SB(b, h) ((4 + (b) * 2 + (h)) * HTB)
#define PG8_STAGE(bufoff, gbase, voff) do { _Pragma("unroll") for (int _i = 0; _i < 2; ++_i) \
        glds16s((const void*)(gbase), (voff)[_i], (unsigned)__builtin_amdgcn_readfirstlane((int)(lds0 + (unsigned)(bufoff) + ldsw + (unsigned)(_i * 8192)))); } while (0)
#define PG8_STAGE_A(bufoff, gbase, h) do { if constexpr (GATHER) { PG8_STAGE(bufoff, gbase, vA[h]); } else { PG8_STAGE(bufoff, (gbase) + (h) * ahstep, vC); } } while (0)
#define PG8_LDA(dst, b, h) do { _Pragma("unroll") for (int m = 0; m < 4; ++m) _Pragma("unroll") for (int k = 0; k < 2; ++k) dst[m][k] = *(const LAS bf16x8*)(lds + PG8_SA(b, h) + aoff + m * 2048 + k * 1024); } while (0)
#define PG8_LDB(dst, b, h) do { _Pragma("unroll") for (int n = 0; n < 2; ++n) _Pragma("unroll") for (int k = 0; k < 2; ++k) dst[n][k] = *(const LAS bf16x8*)(lds + PG8_SB(b, h) + boff + n * 2048 + k * 1024); } while (0)
#define PG8_MMA(ai, bj, At, Bt) do { __builtin_amdgcn_s_setprio(1); if constexpr (FP8) { _Pragma("unroll") for (int m = 0; m < 4; ++m) _Pragma("unroll") for (int n = 0; n < 2; ++n) \
        mfma8_inplace(acc[ai][bj][m][n], cat8(Bt[n][0], Bt[n][1]), cat8(At[m][0], At[m][1])); } else { \
        _Pragma("unroll") for (int m = 0; m < 4; ++m) _Pragma("unroll") for (int n = 0; n < 2; ++n) _Pragma("unroll") for (int k = 0; k < 2; ++k) \
        acc[ai][bj][m][n] = __builtin_amdgcn_mfma_f32_16x16x32_bf16(Bt[n][k], At[m][k], acc[ai][bj][m][n], 0, 0, 0); } __builtin_amdgcn_s_setprio(0); } while (0)
#define PG8_WAIT_V(n) asm volatile("s_waitcnt vmcnt(" #n ")" ::: "memory")
#define PG8_WAIT_L(n) asm volatile("s_waitcnt lgkmcnt(0)" ::: "memory")
#define PG8_BAR __builtin_amdgcn_s_barrier()
#define PG8_SCHED __builtin_amdgcn_sched_barrier(0)
#define PG8_SETOFF(vo, u) do { _Pragma("unroll") for (int _h = 0; _h < 2; ++_h) _Pragma("unroll") for (int _i = 0; _i < 2; ++_i) vo[_h][_i] = S.arow_off(u, _h * HALF + RA[_i]) + CA[_i]; } while (0)
    Unit cur, nxt; int ui = 0;
    if (!S.next(0, cur)) return;
    f32x4 acc[2][2][4][2];
#pragma unroll
    for (int a = 0; a < 2; ++a)
#pragma unroll
        for (int b = 0; b < 2; ++b)
#pragma unroll
            for (int m = 0; m < 4; ++m)
#pragma unroll
                for (int n = 0; n < 2; ++n) acc[a][b][m][n] = (f32x4){0.f, 0.f, 0.f, 0.f};
    bf16x8 At[4][2], B0[2][2], B1[2][2];
    unsigned vA[2][2];
    LAS int* gidx = (LAS int*)(lds + STAGE_BYTES);
#define PG8_IDX_DMA(u) do { if (wid < 4) glds4s((const void*)(S.slot_tok + (u).row0), (unsigned)((wid * 64 + lane) * 4), (unsigned)__builtin_amdgcn_readfirstlane((int)(lds0 + (unsigned)STAGE_BYTES + (unsigned)wid * 256u))); } while (0)
#define PG8_IDX_READ() do { _Pragma("unroll") for (int _h = 0; _h < 2; ++_h) _Pragma("unroll") for (int _i = 0; _i < 2; ++_i) vA[_h][_i] = (unsigned)gidx[_h * HALF + RA[_i]] * (unsigned)(K * 2) + CA[_i]; } while (0)
    if constexpr (GATHER) { PG8_IDX_DMA(cur); asm volatile("s_waitcnt vmcnt(0)" ::: "memory"); __builtin_amdgcn_s_barrier(); asm volatile("" ::: "memory"); PG8_IDX_READ();
        asm volatile("s_waitcnt lgkmcnt(0)" ::: "memory"); __builtin_amdgcn_s_barrier(); asm volatile("" ::: "memory"); }
    const char* cA = GATHER ? Abase : Abase + (size_t)cur.row0 * K * 2;
    const char* cB = cur.Bp;
    PG8_STAGE(PG8_SB(0, 0), cB, voffB); PG8_STAGE(PG8_SB(0, 1), cB + hstep, voffB); PG8_STAGE_A(PG8_SA(0, 0), cA, 0); PG8_STAGE_A(PG8_SA(0, 1), cA, 1);
    if (wr == 1) PG8_BAR;
    PG8_WAIT_V(2); PG8_BAR;
    PG8_STAGE(PG8_SB(1, 0), cB + kstep, voffB); PG8_STAGE_A(PG8_SA(1, 0), cA + kstep, 0); PG8_STAGE(PG8_SB(1, 1), cB + hstep + kstep, voffB);
    PG8_WAIT_V(6); PG8_BAR;
    for (;;) {
        const bool has_next = S.next(ui + 1, nxt);
        if constexpr (GATHER) { if (has_next) PG8_IDX_DMA(nxt); }
        const char* nA = GATHER ? Abase : (has_next ? Abase + (size_t)nxt.row0 * K * 2 : cA);
        const char* nB = has_next ? nxt.Bp : cB;
#pragma unroll 1
        for (int t = 0; t < nt; t += 2) {
            const bool last = (t == nt - 2);
            const char* a1 = cA + (size_t)(t + 1) * kstep;
            const char* a2 = last ? nA : cA + (size_t)(t + 2) * kstep; const char* b2 = last ? nB : cB + (size_t)(t + 2) * kstep;
            const char* a3 = a2 + kstep; const char* b3 = b2 + kstep;
            PG8_LDB(B0, 0, 0); PG8_LDB(B1, 0, 1); PG8_SCHED; PG8_LDA(At, 0, 0); PG8_STAGE_A(PG8_SA(1, 1), a1, 1);
            if constexpr (GATHER) { if (last && has_next) PG8_IDX_READ(); }
            PG8_WAIT_V(8); PG8_WAIT_L(0); PG8_BAR; PG8_MMA(0, 0, At, B0); PG8_MMA(0, 1, At, B1); PG8_BAR; PG8_SCHED;
            PG8_LDA(At, 0, 1); PG8_STAGE(PG8_SB(0, 0), b2, voffB); PG8_STAGE(PG8_SB(0, 1), b2 + hstep, voffB); PG8_STAGE_A(PG8_SA(0, 0), a2, 0);
            PG8_WAIT_V(8); PG8_WAIT_L(0); PG8_BAR; PG8_MMA(1, 0, At, B0); PG8_MMA(1, 1, At, B1); PG8_BAR; PG8_SCHED;
            PG8_LDB(B0, 1, 0); PG8_LDB(B1, 1, 1); PG8_SCHED; PG8_LDA(At, 1, 0); PG8_STAGE_A(PG8_SA(0, 1), a2, 1);
            PG8_WAIT_V(8); PG8_WAIT_L(0); PG8_BAR; PG8_MMA(0, 0, At, B0); PG8_MMA(0, 1, At, B1); PG8_BAR; PG8_SCHED;
            PG8_LDA(At, 1, 1); PG8_STAGE(PG8_SB(1, 0), b3, voffB); PG8_STAGE(PG8_SB(1, 1), b3 + hstep, voffB); PG8_STAGE_A(PG8_SA(1, 0), a3, 0);
            PG8_WAIT_V(8); PG8_WAIT_L(0); PG8_BAR; PG8_MMA(1, 0, At, B0); PG8_MMA(1, 1, At, B1); PG8_BAR; PG8_SCHED;
        }
        if (wr == 0) PG8_BAR;
        if constexpr (FP8) asm volatile("s_nop 15\n\ts_nop 15" ::: "memory");
        E(acc, cur, wr, wc, fr, fq);
        if (!has_next) break;
#pragma unroll
        for (int a = 0; a < 2; ++a)
#pragma unroll
            for (int b = 0; b < 2; ++b)
#pragma unroll
                for (int m = 0; m < 4; ++m)
#pragma unroll
                    for (int n = 0; n < 2; ++n) acc[a][b][m][n] = (f32x4){0.f, 0.f, 0.f, 0.f};
        cur = nxt; cA = nA; cB = nB; ++ui;
        if (wr == 1) PG8_BAR;
    }
    PG8_WAIT_V(0);
    PG8_BAR;
#undef PG8_SA
#undef PG8_SB
#undef PG8_STAGE
#undef PG8_STAGE_A
#undef PG8_LDA
#undef PG8_LDB
#undef PG8_MMA
#undef PG8_WAIT_V
#undef PG8_WAIT_L
#undef PG8_BAR
#undef PG8_SCHED
#undef PG8_SETOFF
#undef PG8_IDX_DMA
#undef PG8_IDX_READ
}
}

namespace att {
using bf16=unsigned short;
using bf16x8=__attribute__((ext_vector_type(8)))short;
using s16x4=__attribute__((ext_vector_type(4)))short;
using f32x16=__attribute__((ext_vector_type(16)))float;
using u32x4=__attribute__((ext_vector_type(4)))unsigned;
constexpr int NW=8,QBLK=32,QB=QBLK*NW,KVBLK=64;
__device__ __forceinline__ int crow(int r,int hi){return (r&3)+8*(r>>2)+4*hi;}
#define SBAR() __builtin_amdgcn_sched_barrier(0)
constexpr int NSLOT=3, SLOTB=8192;
constexpr int LDS_K=0, LDS_V=NSLOT*SLOTB, LDS_WS=2*NSLOT*SLOTB, LDS_OST=LDS_WS+NW*64*4, LDS_BYTES=LDS_OST+NW*4096;
constexpr float C2=0.125f*1.4426950408889634f;
__device__ __forceinline__ void glds16(const void*sbase,unsigned voff,unsigned lds_dst){unsigned keep;
  asm volatile("s_mov_b32 %0, m0\n\ts_mov_b32 m0, %3\n\ts_nop 0\n\tglobal_load_lds_dwordx4 %1, %2\n\ts_mov_b32 m0, %0":"=&s"(keep):"v"(voff),"s"(sbase),"s"(lds_dst):"memory");}
__device__ __forceinline__ float max3f(float a,float b,float c){float r;asm("v_max3_f32 %0, %1, %2, %3":"=v"(r):"v"(a),"v"(b),"v"(c));return r;}
__device__ __forceinline__ float max2f(float a,float b){float r;asm("v_max_f32_e32 %0, %1, %2":"=v"(r):"v"(a),"v"(b));return r;}
__device__ __forceinline__ float fsub_s(float a,float b){float r;asm("v_sub_f32_e32 %0, %1, %2":"=v"(r):"v"(a),"v"(b));return r;}
typedef float f32x2_t __attribute__((ext_vector_type(2))); typedef __bf16 bf16x2_t __attribute__((ext_vector_type(2)));
__device__ __forceinline__ unsigned cvtpk_s(float lo,float hi){f32x2_t v={lo,hi};bf16x2_t b=__builtin_convertvector(v,bf16x2_t);return __builtin_bit_cast(unsigned,b);}
#define WAIT_BAR(N) asm volatile("s_waitcnt vmcnt(" #N ") lgkmcnt(0)\n\ts_barrier":::"memory")
typedef __attribute__((address_space(3))) const char* lds_cptr;
typedef short v4i16_t __attribute__((ext_vector_type(4)));
__device__ __forceinline__ void kload8(bf16x8*kf,lds_cptr kp){
  kf[0]=*(const __attribute__((address_space(3))) bf16x8*)(kp);      kf[1]=*(const __attribute__((address_space(3))) bf16x8*)(kp+512);
  kf[2]=*(const __attribute__((address_space(3))) bf16x8*)(kp+2048); kf[3]=*(const __attribute__((address_space(3))) bf16x8*)(kp+2560);
  kf[4]=*(const __attribute__((address_space(3))) bf16x8*)(kp+4096); kf[5]=*(const __attribute__((address_space(3))) bf16x8*)(kp+4608);
  kf[6]=*(const __attribute__((address_space(3))) bf16x8*)(kp+6144); kf[7]=*(const __attribute__((address_space(3))) bf16x8*)(kp+6656);
}
__device__ __forceinline__ void kload2(bf16x8*kf,lds_cptr kp,int j){ kf[2*j]=*(const __attribute__((address_space(3))) bf16x8*)(kp+j*2048); kf[2*j+1]=*(const __attribute__((address_space(3))) bf16x8*)(kp+j*2048+512); }
__device__ __forceinline__ s16x4 vtr(lds_cptr p){ return __builtin_bit_cast(s16x4,__builtin_amdgcn_ds_read_tr16_b64_v4i16((__attribute__((address_space(3))) v4i16_t*)p)); }
__device__ __forceinline__ float rowmax(const f32x16&p0,const f32x16&p1){
  float a=max3f(p0[0],p0[1],p1[0]),b=max3f(p0[2],p0[3],p1[1]);a=max3f(a,p1[2],p1[3]);
  #pragma unroll
  for(int r=4;r<16;r+=4){a=max3f(a,p0[r],p0[r+1]);b=max3f(b,p0[r+2],p0[r+3]);a=max3f(a,p1[r],p1[r+1]);b=max3f(b,p1[r+2],p1[r+3]);}
  const float m=max2f(a,b);
  auto rr=__builtin_amdgcn_permlane32_swap(__float_as_uint(m),__float_as_uint(m),false,false);
  return max2f(__uint_as_float(rr[0]),__uint_as_float(rr[1]));
}
__device__ __forceinline__ void pv(f32x16*o,int vb,bf16x8 pa0,bf16x8 pa1,bf16x8 pa2,bf16x8 pa3){
  #pragma unroll
  for(int d0=0;d0<2;++d0){s16x4 lo[4],hi[4];
    #pragma unroll
    for(int ks=0;ks<4;++ks){
      asm volatile("ds_read_b64_tr_b16 %0,%1 offset:%c2":"=&v"(lo[ks]):"v"(vb),"i"(d0*4096+ks*1024):"memory");
      asm volatile("ds_read_b64_tr_b16 %0,%1 offset:%c2":"=&v"(hi[ks]):"v"(vb),"i"(d0*4096+ks*1024+512):"memory");}
    asm volatile("s_waitcnt lgkmcnt(0)":::"memory");SBAR();
    #define PK(k) (bf16x8){lo[k][0],lo[k][1],lo[k][2],lo[k][3],hi[k][0],hi[k][1],hi[k][2],hi[k][3]}
    o[d0]=__builtin_amdgcn_mfma_f32_32x32x16_bf16(pa0,PK(0),o[d0],0,0,0);
    o[d0]=__builtin_amdgcn_mfma_f32_32x32x16_bf16(pa1,PK(1),o[d0],0,0,0);
    o[d0]=__builtin_amdgcn_mfma_f32_32x32x16_bf16(pa2,PK(2),o[d0],0,0,0);
    o[d0]=__builtin_amdgcn_mfma_f32_32x32x16_bf16(pa3,PK(3),o[d0],0,0,0);
    #undef PK
  }
}
template<int W> __device__ __forceinline__ void wmask(f32x16&p0,f32x16&p1,int d,float NEG){
  asm volatile("":"+v"(d));
  #pragma unroll
  for(int r=0;r<16;++r){const int c=(r&3)+8*(r>>2);
    if(W==0x7fffffff){ if(d<c)p0[r]=NEG; if(d<c+32)p1[r]=NEG; }
    else{ if(d<c||d>W+c)p0[r]=NEG; if(d<c+32||d>W+c+32)p1[r]=NEG; } }
}
struct UnitDesc {
  const bf16* Q; long qs;
  const bf16* K; long ks;
  const bf16* V; long vs;
  bf16* O; long os;
  float* lse; long lses;
  int NT;
  int rel0;
  int tg0;
  int q0;
  float slope2;
  float sink2;
};
template<int MODE,int THRL> __device__ __forceinline__ void attn_unit(const UnitDesc&u,char*shm){
  constexpr int W=(MODE==0)?0x7fffffff:(MODE==1?128:127);
  const float NEG=(MODE==0)?-INFINITY:-1024.f;
  const int tid=threadIdx.x,lane=tid&63,r32=lane&31,hi=lane>>5; const int wid=__builtin_amdgcn_readfirstlane(tid>>6);
  const long qs=u.qs,ks=u.ks,vs=u.vs;
  const bf16*Qw=u.Q+(long)(wid*QBLK)*qs;
  const unsigned lds0=(unsigned)(uintptr_t)shm;
  __attribute__((address_space(3))) float*wsf=(__attribute__((address_space(3))) float*)((__attribute__((address_space(3))) char*)shm+LDS_WS)+wid*64;
  const unsigned ksoff=(unsigned)(((long)lane*ks+wid*8)*2);
  const unsigned vsoff=(unsigned)(((long)(16*(wid&3)+(lane>>2))*vs+(wid>>2)*32+(lane&3)*8)*2);
  const unsigned kdst=lds0+LDS_K+wid*1024, vdst=lds0+LDS_V+wid*1024;
  #define DMA_K(t,slot) glds16(u.K+(long)(t)*KVBLK*ks,ksoff,(unsigned)__builtin_amdgcn_readfirstlane(kdst+(slot)))
  #define DMA_V(t,slot) glds16(u.V+(long)(t)*KVBLK*vs,vsoff,(unsigned)__builtin_amdgcn_readfirstlane(vdst+(slot)))
  bf16x8 kf[8];
  const lds_cptr shm3=(lds_cptr)shm; const lds_cptr kp0=shm3+LDS_K+hi*1024+r32*16; const lds_cptr vp0=shm3+LDS_V+((lane>>4)&1)*32+(lane&3)*8+(4*hi+((lane&15)>>2))*64;
  const int NT=u.NT;
  DMA_K(0,0);DMA_V(0,0);DMA_K(1,SLOTB);
  bf16x8 qr[4];
  #pragma unroll
  for(int d0=0;d0<4;++d0)qr[d0]=*reinterpret_cast<const bf16x8*>(&Qw[(long)r32*qs+d0*16+hi*8]);
  const unsigned s2hb=__float_as_uint(u.slope2)&0xffff0000u; const float s2hf=__uint_as_float(s2hb);
  const unsigned s2lb=__float_as_uint(u.slope2-s2hf)&0xffff0000u; const float s2used=s2hf+__uint_as_float(s2lb);
  const unsigned keep=hi?0u:0xffffffffu;
  u32x4 qx; qx[0]=((__float_as_uint(64.f*s2hf)>>16)|(__float_as_uint(64.f*__uint_as_float(s2lb))&0xffff0000u))&keep; qx[1]=((s2hb>>16)|s2lb)&keep; qx[2]=0u; qx[3]=0u;
  u32x4 kx0,kx1; { const unsigned j0=__float_as_uint((float)r32)>>16, j1=__float_as_uint((float)(r32+32))>>16;
    kx0[0]=0u; kx0[1]=(j0|(j0<<16)); kx0[2]=0x3f803f80u; kx0[3]=0u; kx1[0]=0u; kx1[1]=(j1|(j1<<16)); kx1[2]=0x3f803f80u; kx1[3]=0u; }
  #define SETTG(t) do{ const unsigned tb_=__float_as_uint((float)(u.tg0+(t)))>>16; const unsigned tw_=(tb_|(tb_<<16)); kx0[0]=tw_; kx1[0]=tw_; }while(0)
  #define KX0 __builtin_bit_cast(bf16x8,kx0)
  #define KX1 __builtin_bit_cast(bf16x8,kx1)
  #define QX __builtin_bit_cast(bf16x8,qx)
  #define SETREF(m_) do{ const unsigned hb_=__float_as_uint(m_)&0xffff0000u; const float hf_=__uint_as_float(hb_); const unsigned lb_=__float_as_uint((m_)-hf_)&0xffff0000u; \
      mhat=hf_+__uint_as_float(lb_); qx[2]=(((hb_^0x80000000u)>>16)|(lb_^0x80000000u))&keep; }while(0)
  float mhat=0.f,l_reg=0.f;f32x16 o[2];o[0]=f32x16{};o[1]=f32x16{};
  const int qrel=u.rel0+wid*QBLK+r32-4*hi;
  #define CMASK(P0,P1,t) do{ if(MODE!=0||(t)>=NT-4) wmask<W>(P0,P1,qrel-64*(t),NEG); }while(0)
  bool resc=false;
  f32x16 pA0,pA1,pB0,pB1;
  int sl_prev=0,sl_cur=0,sl_next=SLOTB;
  #define ROT() do{sl_prev=sl_cur;sl_cur=sl_next;sl_next=(sl_next==(NSLOT-1)*SLOTB)?0:sl_next+SLOTB;}while(0)
  #define RESC() do{ if(resc){ asm volatile("s_waitcnt lgkmcnt(0)":::"memory"); \
      _Pragma("unroll") for(int d_=0;d_<2;++d_) _Pragma("unroll") for(int r=0;r<16;++r)o[d_][r]*=wsf[crow(r,hi)]; } }while(0)
  DMA_K(2,2*SLOTB);
  WAIT_BAR(3);
  { SETTG(0); const f32x16 z=f32x16{}; const lds_cptr kb=kp0;
    #pragma unroll
    for(int d0=0;d0<4;++d0){
      const bf16x8 b0=*(const __attribute__((address_space(3))) bf16x8*)(kb+d0*2048);
      const bf16x8 b1=*(const __attribute__((address_space(3))) bf16x8*)(kb+d0*2048+512);
      if(d0==0){pA0=__builtin_amdgcn_mfma_f32_32x32x16_bf16(b0,qr[0],z,0,0,0);pA1=__builtin_amdgcn_mfma_f32_32x32x16_bf16(b1,qr[0],z,0,0,0);}
      else{pA0=__builtin_amdgcn_mfma_f32_32x32x16_bf16(b0,qr[d0],pA0,0,0,0);pA1=__builtin_amdgcn_mfma_f32_32x32x16_bf16(b1,qr[d0],pA1,0,0,0);}}
    pA0=__builtin_amdgcn_mfma_f32_32x32x16_bf16(KX0,QX,pA0,0,0,0);pA1=__builtin_amdgcn_mfma_f32_32x32x16_bf16(KX1,QX,pA1,0,0,0); }
  asm volatile("s_nop 15\n\ts_nop 7":"+v"(pA0),"+v"(pA1));CMASK(pA0,pA1,0);
  { const float rm=rowmax(pA0,pA1); SETREF(rm); const float dl=mhat;
    _Pragma("unroll") for(int r=0;r<16;++r){pA0[r]=fsub_s(pA0[r],dl);pA1[r]=fsub_s(pA1[r],dl);}
    _Pragma("unroll") for(int r=0;r<16;++r)pA0[r]=__builtin_amdgcn_exp2f(pA0[r]); }
  _Pragma("unroll") for(int r=0;r<16;++r)pA1[r]=__builtin_amdgcn_exp2f(pA1[r]);
  WAIT_BAR(0);
  DMA_K(3,0);DMA_V(1,SLOTB);
  ROT();
  kload8(kf,kp0+sl_cur);
  WAIT_BAR(2);
  s16x4 vlo[8],vhi[8]; u32x4 pw0,pw1,pw2,pw3;
  #define PKW(P,B) cvtpk_s(P[B],P[B+1])
  #define PAF(k) __builtin_bit_cast(bf16x8,pw##k)
  #define VFR(i) (bf16x8){vlo[i][0],vlo[i][1],vlo[i][2],vlo[i][3],vhi[i][0],vhi[i][1],vhi[i][2],vhi[i][3]}
  #define PIN(x) asm volatile("":"+v"(x))
  #define MX3(a,b,c) __builtin_fmaxf(__builtin_fmaxf((a),(b)),(c))
  #define GAPA(MF,A0,A1,A2,A3,W0,W1,PW) do{ MF; sacc+=A0; sacc+=A1; sacc+=A2; sacc+=A3; PIN(sacc); W0; W1; PIN(PW); SBAR(); }while(0)
  #define EX(v) __builtin_amdgcn_exp2f(v)
  #define GAPB(MF,X,B) do{ MF; X[B]=EX(X[B]); X[B+1]=EX(X[B+1]); X[B+2]=EX(X[B+2]); X[B+3]=EX(X[B+3]); PIN(X); SBAR(); }while(0)
  #define VRD(i) do{ vlo[i]=vtr(vp_+(((i)>>2)*4096+((i)&3)*1024)); vhi[i]=vtr(vp_+(((i)>>2)*4096+((i)&3)*1024+512)); }while(0)
  #define KRD(G,j) do{ if(G){ kload2(kf,kp0+sl_next,j); SBAR(); } }while(0)
  #define STEP(C0,C1,P0,P1,t,GK,GV,GL) do{ SBAR(); SETTG(t); const f32x16 z_=f32x16{}; \
    const lds_cptr vp_=vp0+sl_prev; \
    VRD(0); SBAR(); float sacc=(P0[0]+P0[1]); \
    GAPA(C0=__builtin_amdgcn_mfma_f32_32x32x16_bf16(kf[0],qr[0],z_,0,0,0), P0[2],P0[3],P0[4],P0[5],     pw0[0]=PKW(P0,0), pw0[1]=PKW(P0,2), pw0); \
    VRD(4); SBAR(); GAPA(C1=__builtin_amdgcn_mfma_f32_32x32x16_bf16(kf[1],qr[0],z_,0,0,0), P0[6],P0[7],P0[8],P0[9],     pw0[2]=PKW(P0,4), pw0[3]=PKW(P0,6), pw0); \
    VRD(1); SBAR(); GAPA(C0=__builtin_amdgcn_mfma_f32_32x32x16_bf16(kf[2],qr[1],C0,0,0,0),   P0[10],P0[11],P0[12],P0[13], pw1[0]=PKW(P0,8), pw1[1]=PKW(P0,10), pw1); \
    VRD(5); SBAR(); GAPA(C1=__builtin_amdgcn_mfma_f32_32x32x16_bf16(kf[3],qr[1],C1,0,0,0),   P0[14],P0[15],P1[0],P1[1],   pw1[2]=PKW(P0,12),pw1[3]=PKW(P0,14), pw1); \
    VRD(2); SBAR(); GAPA(C0=__builtin_amdgcn_mfma_f32_32x32x16_bf16(kf[4],qr[2],C0,0,0,0),   P1[2],P1[3],P1[4],P1[5],     pw2[0]=PKW(P1,0), pw2[1]=PKW(P1,2), pw2); \
    VRD(6); SBAR(); GAPA(C1=__builtin_amdgcn_mfma_f32_32x32x16_bf16(kf[5],qr[2],C1,0,0,0),   P1[6],P1[7],P1[8],P1[9],     pw2[2]=PKW(P1,4), pw2[3]=PKW(P1,6), pw2); \
    VRD(3); SBAR(); GAPA(C0=__builtin_amdgcn_mfma_f32_32x32x16_bf16(kf[6],qr[3],C0,0,0,0),   P1[10],P1[11],P1[12],P1[13], pw3[0]=PKW(P1,8), pw3[1]=PKW(P1,10), pw3); \
    VRD(7); SBAR(); GAPA(C1=__builtin_amdgcn_mfma_f32_32x32x16_bf16(kf[7],qr[3],C1,0,0,0),   P1[14],P1[15],0.f,0.f,       pw3[2]=PKW(P1,12),pw3[3]=PKW(P1,14), pw3); \
    C0=__builtin_amdgcn_mfma_f32_32x32x16_bf16(KX0,QX,C0,0,0,0); C1=__builtin_amdgcn_mfma_f32_32x32x16_bf16(KX1,QX,C1,0,0,0); SBAR(); \
    l_reg+=sacc; \
    if(GK){DMA_K((t)+3,sl_cur);} if(GV){DMA_V((t)+1,sl_next);} \
    CMASK(C0,C1,t); \
    { float a=MX3(C0[0],C0[1],C1[0]),b=MX3(C0[2],C0[3],C1[1]); a=MX3(a,C1[2],C1[3]); \
      _Pragma("unroll") for(int r=4;r<16;r+=4){a=MX3(a,C0[r],C0[r+1]);b=MX3(b,C0[r+2],C0[r+3]);a=MX3(a,C1[r],C1[r+1]);b=MX3(b,C1[r+2],C1[r+3]);} \
      float rm=__builtin_fmaxf(a,b); { auto rr=__builtin_amdgcn_permlane32_swap(__float_as_uint(rm),__float_as_uint(rm),false,false); rm=__builtin_fmaxf(__uint_as_float(rr[0]),__uint_as_float(rr[1])); } \
      resc=false; \
      if(__builtin_expect(__any(rm>(float)THRL),0)){ const float mold=mhat; const float mnew=mold+__builtin_fmaxf(rm,0.f); SETREF(mnew); const float dl=mhat-mold; \
        _Pragma("unroll") for(int r=0;r<16;++r){C0[r]-=dl;C1[r]-=dl;} \
        const float f=__builtin_amdgcn_exp2f(-dl); l_reg*=f; if(hi==0)wsf[r32]=f; resc=true; } } \
    SBAR(); \
    GAPB(o[0]=__builtin_amdgcn_mfma_f32_32x32x16_bf16(PAF(0),VFR(0),o[0],0,0,0), C0,0); \
    GAPB(o[1]=__builtin_amdgcn_mfma_f32_32x32x16_bf16(PAF(0),VFR(4),o[1],0,0,0), C0,4); \
    KRD(GL,0); GAPB(o[0]=__builtin_amdgcn_mfma_f32_32x32x16_bf16(PAF(1),VFR(1),o[0],0,0,0), C0,8); \
    KRD(GL,1); GAPB(o[1]=__builtin_amdgcn_mfma_f32_32x32x16_bf16(PAF(1),VFR(5),o[1],0,0,0), C0,12); \
    KRD(GL,2); GAPB(o[0]=__builtin_amdgcn_mfma_f32_32x32x16_bf16(PAF(2),VFR(2),o[0],0,0,0), C1,0); \
    KRD(GL,3); GAPB(o[1]=__builtin_amdgcn_mfma_f32_32x32x16_bf16(PAF(2),VFR(6),o[1],0,0,0), C1,4); \
    GAPB(o[0]=__builtin_amdgcn_mfma_f32_32x32x16_bf16(PAF(3),VFR(3),o[0],0,0,0), C1,8); \
    GAPB(o[1]=__builtin_amdgcn_mfma_f32_32x32x16_bf16(PAF(3),VFR(7),o[1],0,0,0), C1,12); \
    }while(0)
  int t=1;
  if(MODE==0){
    #undef CMASK
    #define CMASK(P0,P1,t) do{}while(0)
    for(;t+5<NT;t+=2){
      STEP(pB0,pB1,pA0,pA1,t,true,true,true);     WAIT_BAR(2); RESC(); ROT();
      STEP(pA0,pA1,pB0,pB1,t+1,true,true,true);   WAIT_BAR(2); RESC(); ROT();
    }
    #undef CMASK
    #define CMASK(P0,P1,t) do{ if(MODE!=0||(t)>=NT-4) wmask<W>(P0,P1,qrel-64*(t),NEG); }while(0)
  }
  #define ENDW(tt) do{ if((tt)+3<NT){WAIT_BAR(2);} else if((tt)+2<NT){WAIT_BAR(1);} else {WAIT_BAR(0);} }while(0)
  for(;t+1<NT;t+=2){
    STEP(pB0,pB1,pA0,pA1,t,(t+3<NT),(t+1<NT),(t+1<NT));       ENDW(t);   RESC(); ROT();
    STEP(pA0,pA1,pB0,pB1,t+1,(t+4<NT),(t+2<NT),(t+2<NT));     ENDW(t+1); RESC(); ROT();
  }
  STEP(pB0,pB1,pA0,pA1,NT-1,false,false,false); RESC();
  { float sacc=pB0[0]+pB0[1]; _Pragma("unroll") for(int r=2;r<16;++r)sacc+=pB0[r]; _Pragma("unroll") for(int r=0;r<16;++r)sacc+=pB1[r]; l_reg+=sacc;
    pw0=(u32x4){PKW(pB0,0),PKW(pB0,2),PKW(pB0,4),PKW(pB0,6)};pw1=(u32x4){PKW(pB0,8),PKW(pB0,10),PKW(pB0,12),PKW(pB0,14)};pw2=(u32x4){PKW(pB1,0),PKW(pB1,2),PKW(pB1,4),PKW(pB1,6)};pw3=(u32x4){PKW(pB1,8),PKW(pB1,10),PKW(pB1,12),PKW(pB1,14)};
    SBAR(); pv(o,(int)(lds0+LDS_V)+((lane>>4)&1)*32+(lane&3)*8+(4*hi+((lane&15)>>2))*64+sl_cur,PAF(0),PAF(1),PAF(2),PAF(3)); }
  #undef PKW
  #undef PAF
  #undef VFR
  #undef PIN
  #undef MX3
  #undef GAPA
  #undef GAPB
  #undef EX
  #undef VRD
  #undef KRD
  #undef STEP
  #undef ENDW
  {auto rr=__builtin_amdgcn_permlane32_swap(__float_as_uint(l_reg),__float_as_uint(l_reg),false,false);l_reg=__uint_as_float(rr[0])+__uint_as_float(rr[1]);}
  const float qposf=(float)(u.q0+wid*QBLK+r32);
  if(MODE==2) l_reg+=__builtin_amdgcn_exp2f(u.sink2+s2used*qposf-mhat);
  if(MODE==1){ if(hi==0) u.lse[(long)(wid*QBLK+r32)*u.lses]=mhat-s2used*qposf+__builtin_amdgcn_logf(l_reg); }
  if(hi==0)wsf[32+r32]=l_reg;asm volatile("s_waitcnt lgkmcnt(0)":::"memory");
  float rli[16];
  #pragma unroll
  for(int r=0;r<16;++r)rli[r]=__builtin_amdgcn_rcpf(wsf[32+crow(r,hi)]);
  bf16*Ow=u.O+(long)(wid*QBLK)*u.os;
  { __hip_bfloat16*stg=(__hip_bfloat16*)(shm+LDS_OST)+wid*2048;
    #pragma unroll
    for(int r=0;r<16;++r){const int orow=crow(r,hi);
      #pragma unroll
      for(int d0=0;d0<2;++d0)stg[orow*64+d0*32+r32]=__float2bfloat16(o[d0][r]*rli[r]);}
    asm volatile("s_waitcnt lgkmcnt(0)":::"memory");
    #pragma unroll
    for(int i=0;i<4;++i){const int row=i*8+(lane>>3),ch=lane&7; const u32x4 v=*(const u32x4*)(stg+row*64+ch*8); *(u32x4*)(Ow+(long)row*u.os+ch*8)=v;} }
  asm volatile("s_waitcnt lgkmcnt(0)\n\ts_barrier":::"memory");
  #undef DMA_K
  #undef DMA_V
  #undef CMASK
  #undef RESC
  #undef ROT
  #undef SETTG
  #undef SETREF
  #undef KX0
  #undef KX1
  #undef QX
}
#undef SBAR
#undef WAIT_BAR
}

constexpr float LOG2E = 1.4426950408889634f;
__device__ __forceinline__ int vcu_of(int bx, int G) { return (G % 8 == 0) ? (bx % 8) * (G / 8) + bx / 8 : bx; }
constexpr int ATT1_LDS_TAB = 140288;
__device__ __forceinline__ void attn1_tuned_phase(const Ctx& c, const bf16* qkv, const float* qkg  , bf16* R, unsigned* qctr, const ExpertSrc& es, unsigned char* ws,
                                                  const float* lamp, const float* subln, bf16* Oout) {
    LAS int* order = (LAS int*)(c.lds + ATT1_LDS_TAB);
    LAS int* nts = order + 256;
    LAS int* t0s = nts + 256;
    volatile LAS unsigned* nextu = (volatile LAS unsigned*)(t0s + 256);
    LAS float* bnd = (LAS float*)(t0s + 256 + 4);
    const int G = gridDim.x;
    if (c.wave == 0) { float gq = fabsf(qkg[c.lane]), gk = fabsf(qkg[64 + c.lane]);
#pragma unroll
        for (int o = 1; o < 64; o <<= 1) { gq = fmaxf(gq, __shfl_xor(gq, o)); gk = fmaxf(gk, __shfl_xor(gk, o)); }
        if (c.lane == 0) bnd[0] = 8.f * gq * gk * 1.02f; }
    __syncthreads();
    if (c.tid < 256) { const int h = c.tid >> 4, qb = c.tid & 15; const float slope = exp2f(-0.5f * (float)(h + 1));
        const int dmax = (int)fminf(ceilf((2.f * bnd[0] + 25.f) / slope), 1.0e6f), lo_ = 256 * qb - dmax, t0 = lo_ <= 0 ? 0 : ((lo_ >> 6) & ~1);
        nts[c.tid] = 4 * (qb + 1) - t0; t0s[c.tid] = t0; }
    __syncthreads();
    if (c.tid < 256) { const int mine = nts[c.tid]; int rank = 0;
        for (int e = 0; e < 256; ++e) { const int o = nts[e]; rank += (o > mine || (o == mine && e < c.tid)) ? 1 : 0; }
        order[rank] = c.tid; }
    __syncthreads();
#if FUSE_FINISH
    constexpr int NCH = DEFER_CONV ? EXP_ITEMS / 65 : 0, NUNIT = NB * 16 * 16, NPOS = NUNIT + NCH;
    static_assert(!DEFER_CONV || EXP_ITEMS % 65 == 0, "chunking");
    if (c.tid == 0) { float s01 = 0.f, s23 = 0.f; for (int i = 0; i < 64; ++i) { s01 += lamp[i] * lamp[64 + i]; s23 += lamp[128 + i] * lamp[192 + i]; }
      const float li = 0.8f - 0.6f * expf(-0.3f * 1.0f); bnd[1] = expf(s01) - expf(s23) + li; bnd[2] = li; }
    __syncthreads();
    unsigned p = blockIdx.x;
    while (p < (unsigned)NPOS) {
        unsigned nreg = 0u;
        if (c.tid == 0) nreg = __hip_atomic_fetch_add(qctr, 1u, __ATOMIC_RELAXED, __HIP_MEMORY_SCOPE_AGENT) + (unsigned)G;
        const bool inter = p < (unsigned)(NCH * 2);
        if (inter && (p & 1u)) {
            expert_items_block(c, es, 1, ws, (int)(p >> 1) * 65, 65);
        } else {
#define ATT1_DECODE() const unsigned u = inter ? (p >> 1) : p - (unsigned)NCH; const int ent = order[u >> 2], h = ent >> 4, qb = ent & 15, b = (int)(u & 3u), t0 = t0s[ent]; \
            bf16* Rblk = R + ((size_t)(b * T + qb * 256) * 16 + h) * 256
#pragma unroll 1
            for (int pass = 0; pass < 4; ++pass) {
                ATT1_DECODE();
                const int i = pass >> 1, j = pass & 1; att::UnitDesc ud;
                ud.Q = qkv + (size_t)(b * T + qb * 256) * C_IN + 128 * h + 64 * i; ud.qs = C_IN;
                ud.K = qkv + (size_t)(b * T + 64 * t0) * C_IN + 2048 + 128 * h + 64 * i; ud.ks = C_IN;
                ud.V = qkv + (size_t)(b * T + 64 * t0) * C_IN + 4096 + 128 * h + 64 * j; ud.vs = C_IN;
                ud.O = Rblk + 128 * i + 64 * j; ud.os = 16 * 256;
                ud.lse = nullptr; ud.lses = 0; ud.NT = 4 * (qb + 1) - t0; ud.rel0 = qb * 256 - 64 * t0; ud.tg0 = t0; ud.q0 = qb * 256;
                ud.slope2 = exp2f(-0.5f * (float)(h + 1)) * LOG2E; ud.sink2 = 0.f;
                att::attn_unit<0, 8>(ud, (char*)c.lds);
            }
            asm volatile("s_waitcnt vmcnt(0)" ::: "memory"); __syncthreads();
            { ATT1_DECODE(); (void)t0; const float lam = bnd[1], lam_init = bnd[2];
              const int row = c.tid >> 1, hf = c.tid & 1; const bf16* p1 = Rblk + (size_t)row * (16 * 256) + 64 * hf; const bf16* p2 = p1 + 128;
              float xv[64]; float ss = 0.f;
#pragma unroll
              for (int q8 = 0; q8 < 8; ++q8) { const u32x4 a = *(const u32x4*)(p1 + 8 * q8), bq = *(const u32x4*)(p2 + 8 * q8);
#pragma unroll
                  for (int k = 0; k < 4; ++k) { const float x0 = bf2f(a[k] & 0xffffu) - lam * bf2f(bq[k] & 0xffffu), x1 = bf2f(a[k] >> 16) - lam * bf2f(bq[k] >> 16);
                      xv[8 * q8 + 2 * k] = x0; xv[8 * q8 + 2 * k + 1] = x1; ss += x0 * x0 + x1 * x1; } }
              ss += __shfl_xor(ss, 1);
              const float rs = (1.f - lam_init) / sqrtf(ss * (1.f / 128.f) + RMS_EPS);
              bf16* op = Oout + (size_t)(b * T + qb * 256 + row) * D + 128 * h + 64 * hf; const float* sg = subln + 64 * hf;
#pragma unroll
              for (int q8 = 0; q8 < 8; ++q8) { u32x4 w;
#pragma unroll
                  for (int k = 0; k < 4; ++k) w[k] = pk2(xv[8 * q8 + 2 * k] * rs * sg[8 * q8 + 2 * k], xv[8 * q8 + 2 * k + 1] * rs * sg[8 * q8 + 2 * k + 1]);
                  *(u32x4*)(op + 8 * q8) = w; } }
#undef ATT1_DECODE
        }
        if (c.tid == 0) nextu[0] = nreg;
        __syncthreads();
        p = nextu[0];
    }
}
#else
    constexpr int NCH = DEFER_CONV ? EXP_ITEMS / 65 : 0, NPOS = NB * 16 * 4 * 16 + NCH;
    static_assert(!DEFER_CONV || EXP_ITEMS % 65 == 0, "chunking");
    unsigned p = blockIdx.x;
    while (p < (unsigned)NPOS) {
        unsigned nreg = 0u;
        if (c.tid == 0) nreg = __hip_atomic_fetch_add(qctr, 1u, __ATOMIC_RELAXED, __HIP_MEMORY_SCOPE_AGENT) + (unsigned)G;
        const bool inter = p < (unsigned)(NCH * 6);
        if (inter && (p % 6u) == 5u) {
            expert_items_block(c, es, 1, ws, (int)(p / 6u) * 65, 65);
        } else {
            const unsigned u = inter ? p - p / 6u : p - (unsigned)NCH;
            const int ent = order[u >> 4], h = ent >> 4, qb = ent & 15, bp = (int)(u & 15u), b = bp >> 2, i = (bp >> 1) & 1, j = bp & 1, t0 = t0s[ent];
            att::UnitDesc ud;
            ud.Q = qkv + (size_t)(b * T + qb * 256) * C_IN + 128 * h + 64 * i; ud.qs = C_IN;
            ud.K = qkv + (size_t)(b * T + 64 * t0) * C_IN + 2048 + 128 * h + 64 * i; ud.ks = C_IN;
            ud.V = qkv + (size_t)(b * T + 64 * t0) * C_IN + 4096 + 128 * h + 64 * j; ud.vs = C_IN;
            ud.O = R + ((size_t)(b * T + qb * 256) * 16 + h) * 256 + 128 * i + 64 * j; ud.os = 16 * 256;
            ud.lse = nullptr; ud.lses = 0; ud.NT = 4 * (qb + 1) - t0; ud.rel0 = qb * 256 - 64 * t0; ud.tg0 = t0; ud.q0 = qb * 256;
            ud.slope2 = exp2f(-0.5f * (float)(h + 1)) * LOG2E; ud.sink2 = 0.f;
            att::attn_unit<0, 8>(ud, (char*)c.lds);
        }
        if (c.tid == 0) nextu[0] = nreg;
        __syncthreads();
        p = nextu[0];
    }
}
#endif
__device__ __forceinline__ void attn1_finish_bf16_phase(const Ctx& c, const bf16* R, const float* lamp, const float* subln, bf16* O) {
    float s01 = 0.f, s23 = 0.f;
    for (int i = 0; i < 64; ++i) { s01 += lamp[i] * lamp[64 + i]; s23 += lamp[128 + i] * lamp[192 + i]; }
    const float lam_init = 0.8f - 0.6f * expf(-0.3f * 1.0f);
    const float lam = expf(s01) - expf(s23) + lam_init;
    const long total = (long)M * 16;
    for (long id = gtid_now(); id < total; id += c.gsz) {
        const bf16* p1 = R + (size_t)id * 256; const bf16* p2 = p1 + 128;
        float ss = 0.f;
#pragma unroll 4
        for (int i = 0; i < 16; ++i) { const u32x4 a = *(const u32x4*)(p1 + 8 * i), bq = *(const u32x4*)(p2 + 8 * i);
#pragma unroll
            for (int k = 0; k < 4; ++k) { const float x0 = bf2f(a[k] & 0xffffu) - lam * bf2f(bq[k] & 0xffffu), x1 = bf2f(a[k] >> 16) - lam * bf2f(bq[k] >> 16); ss += x0 * x0 + x1 * x1; } }
        const float rs = (1.f - lam_init) / sqrtf(ss * (1.f / 128.f) + RMS_EPS);
        bf16* op = O + (size_t)id * 128;
#pragma unroll 4
        for (int i = 0; i < 16; ++i) { const u32x4 a = *(const u32x4*)(p1 + 8 * i), bq = *(const u32x4*)(p2 + 8 * i); u32x4 w;
#pragma unroll
            for (int k = 0; k < 4; ++k) { const float x0 = bf2f(a[k] & 0xffffu) - lam * bf2f(bq[k] & 0xffffu), x1 = bf2f(a[k] >> 16) - lam * bf2f(bq[k] >> 16);
                w[k] = pk2(x0 * rs * subln[8 * i + 2 * k], x1 * rs * subln[8 * i + 2 * k + 1]); }
            *(u32x4*)(op + 8 * i) = w; }
    }
}
__device__ __forceinline__ void attn0_tuned_phase(const Ctx& c, const bf16* qkv, const float* sinks, bf16* OBR  , float* LSE  , bf16* O, int xlo, int xhi) {
    const int G = gridDim.x, vcu = vcu_of(blockIdx.x, G);
    for (int gid = vcu; gid < NB * 64; gid += G) {
        const int b = gid / 64, kind = (gid % 64) / 16, h = gid % 16;
        const float slope2 = exp2f(-0.5f * (float)(h + 1)) * LOG2E;
        if (kind < 3) {
            const int dil = kind == 0 ? 1 : (kind == 1 ? 4 : 16), nblk = 16 / dil;
            for (int x = xlo; x < xhi; ++x) {
                const int r = x / nblk, blk = x % nblk, q0 = blk * 256, t0 = blk ? 4 * blk - 2 : 0; att::UnitDesc u;
                const size_t qrow = (size_t)(b * T + r + dil * q0), krow = (size_t)(b * T + r + dil * 64 * t0);
                u.Q = qkv + qrow * AB_IN + 64 * h; u.qs = (long)dil * AB_IN;
                u.K = qkv + krow * AB_IN + 1024 + 64 * h; u.ks = (long)dil * AB_IN;
                u.V = qkv + krow * AB_IN + 2048 + 64 * h; u.vs = (long)dil * AB_IN;
                u.O = OBR + ((size_t)kind * M + qrow) * 1024 + 64 * h; u.os = (long)dil * 1024;
                u.lse = LSE + ((size_t)kind * M + qrow) * 16 + h; u.lses = (long)dil * 16;
                u.NT = blk ? 6 : 4; u.rel0 = q0 - 64 * t0; u.tg0 = t0; u.q0 = q0; u.slope2 = slope2 * (float)dil; u.sink2 = 0.f;
                att::attn_unit<1, 8>(u, (char*)c.lds);
            }
        } else {
            const int kvh = h >> 3;
            for (int x = xlo; x < xhi; ++x) {
                const int q0 = x * 256, t0 = x ? 4 * x - 2 : 0; att::UnitDesc u;
                const size_t qrow = (size_t)(b * T + q0), krow = (size_t)(b * T + 64 * t0);
                u.Q = qkv + qrow * AB_IN + 3072 + 64 * h; u.qs = AB_IN;
                u.K = qkv + krow * AB_IN + 4096 + 64 * kvh; u.ks = AB_IN;
                u.V = qkv + krow * AB_IN + 4224 + 64 * kvh; u.vs = AB_IN;
                u.O = O + qrow * D + 1024 + 64 * h; u.os = D;
                u.lse = nullptr; u.lses = 0;
                u.NT = x ? 6 : 4; u.rel0 = q0 - 64 * t0; u.tg0 = t0; u.q0 = q0; u.slope2 = slope2; u.sink2 = sinks[h] * LOG2E;
                att::attn_unit<2, 8>(u, (char*)c.lds);
            }
        }
    }
}
__device__ __forceinline__ void attn0_merge_phase(const Ctx& c, const bf16* OBR, const float* LSE, bf16* O) {
    const long total = (long)M * 16;
    for (long id = gtid_now(); id < total; id += c.gsz) {
        const long m = id / 16; const int h = (int)(id % 16);
        const float l0 = LSE[id], l1 = LSE[(size_t)M * 16 + id], l2 = LSE[(size_t)2 * M * 16 + id];
        const float mx = fmaxf(l0, fmaxf(l1, l2)); float w0 = exp2f(l0 - mx), w1 = exp2f(l1 - mx), w2 = exp2f(l2 - mx); const float inv = 1.f / (w0 + w1 + w2); w0 *= inv; w1 *= inv; w2 *= inv;
        const bf16* p0 = OBR + (size_t)m * 1024 + 64 * h; const bf16* p1 = p0 + (size_t)M * 1024; const bf16* p2 = p1 + (size_t)M * 1024;
        bf16* op = O + (size_t)m * D + 64 * h;
#pragma unroll
        for (int i = 0; i < 8; ++i) { const u32x4 a = *(const u32x4*)(p0 + 8 * i), bq = *(const u32x4*)(p1 + 8 * i), cq = *(const u32x4*)(p2 + 8 * i); u32x4 w;
#pragma unroll
            for (int k = 0; k < 4; ++k) w[k] = pk2(w0 * bf2f(a[k] & 0xffffu) + w1 * bf2f(bq[k] & 0xffffu) + w2 * bf2f(cq[k] & 0xffffu), w0 * bf2f(a[k] >> 16) + w1 * bf2f(bq[k] >> 16) + w2 * bf2f(cq[k] >> 16));
            *(u32x4*)(op + 8 * i) = w; }
    }
}

__device__ __forceinline__ void convert_router(const Ctx& c, const float* wr, bf16* wrt) {
    for (int id = gtid_now(); id < NE * D; id += c.gsz) { const int n = id / D, k = id % D; const float w = wr[(size_t)k * NE + n];
        const unsigned hb = f2bf(w); const float hf = bf2f(hb); wrt[id] = (bf16)hb; wrt[NE * D + id] = (bf16)f2bf(w - hf); }
}
__device__ __forceinline__ void router2_phase(const Ctx& c, const float* x1, const float* g, const float* ada_l, const bf16* wrt, const float* rbias,
                                              bf16* HF, int* idx, float* gate, int* wcnt, bf16* HFB = nullptr) {
    LAS float* red = (LAS float*)c.lds;
    LAS float* part = (LAS float*)(c.lds + 1024);
    const int lane = c.lane, r = lane & 15, q = lane >> 4, w = c.wave;
    unsigned cnt = 0u;
    for (int u = blockIdx.x; u < M / 16; u += gridDim.x) {
        const int m0 = u * 16, b = m0 / T;
        f32x4 v[8][2]; float ss = 0.f;
#if RES_BF16
        const bf16* xr = (const bf16*)x1 + (size_t)(m0 + r) * D + 256 * w + 8 * q;
#else
        const float* xr = x1 + (size_t)(m0 + r) * D + 256 * w + 8 * q;
#endif
#pragma unroll
        for (int kk = 0; kk < 8; ++kk) {
#if RES_BF16
            { const u32x4 xw = *(const u32x4*)(xr + 32 * kk);
              v[kk][0] = (f32x4){bf2f(xw.x & 0xffffu), bf2f(xw.x >> 16), bf2f(xw.y & 0xffffu), bf2f(xw.y >> 16)}; v[kk][1] = (f32x4){bf2f(xw.z & 0xffffu), bf2f(xw.z >> 16), bf2f(xw.w & 0xffffu), bf2f(xw.w >> 16)}; }
#else
            v[kk][0] = *(const f32x4*)(xr + 32 * kk); v[kk][1] = *(const f32x4*)(xr + 32 * kk + 4);
#endif
            ss += (v[kk][0].x * v[kk][0].x + v[kk][0].y * v[kk][0].y) + (v[kk][0].z * v[kk][0].z + v[kk][0].w * v[kk][0].w);
            ss += (v[kk][1].x * v[kk][1].x + v[kk][1].y * v[kk][1].y) + (v[kk][1].z * v[kk][1].z + v[kk][1].w * v[kk][1].w); }
        ss += __shfl_xor(ss, 16); ss += __shfl_xor(ss, 32);
        if (q == 0) red[w * 16 + r] = ss;
        __syncthreads();
        float tot = 0.f;
#pragma unroll
        for (int w2 = 0; w2 < 8; ++w2) tot += red[w2 * 16 + r];
        const float rstd = 1.f / sqrtf(tot * (1.f / D) + RMS_EPS);
        f32x4 acc[4];
#pragma unroll
        for (int nt = 0; nt < 4; ++nt) acc[nt] = (f32x4){0.f, 0.f, 0.f, 0.f};
        const int cb = 256 * w + 8 * q;
        const float* gp = g + cb; const float* shp = ada_l + (size_t)b * 6 * D + 3 * D + cb; const float* scp = ada_l + (size_t)b * 6 * D + 4 * D + cb;
        bf16* hrow = HF + (size_t)(m0 + r) * D + cb;
        const bf16* wb = wrt + (size_t)r * D + cb;
#pragma unroll
        for (int kk = 0; kk < 8; ++kk) {
            f32x4 hh[2];
#pragma unroll
            for (int s = 0; s < 2; ++s) { const int col = 32 * kk + 4 * s;
                hh[s] = v[kk][s] * rstd * *(const f32x4*)(gp + col) * (*(const f32x4*)(scp + col) + 1.f) + *(const f32x4*)(shp + col); }
            u32x4 hw, lw;
#pragma unroll
            for (int s = 0; s < 2; ++s) { const unsigned h0 = f2bf(hh[s].x), h1 = f2bf(hh[s].y), h2 = f2bf(hh[s].z), h3 = f2bf(hh[s].w);
                hw[2 * s] = h0 | (h1 << 16); hw[2 * s + 1] = h2 | (h3 << 16);
                lw[2 * s] = pk2(hh[s].x - bf2f(h0), hh[s].y - bf2f(h1)); lw[2 * s + 1] = pk2(hh[s].z - bf2f(h2), hh[s].w - bf2f(h3)); }
#if USE_FP8_MOE
            { u32x2 q8; q8.x = pk4_fp8(hh[0].x * F8_HSCALE, hh[0].y * F8_HSCALE, hh[0].z * F8_HSCALE, hh[0].w * F8_HSCALE); q8.y = pk4_fp8(hh[1].x * F8_HSCALE, hh[1].y * F8_HSCALE, hh[1].z * F8_HSCALE, hh[1].w * F8_HSCALE);
              *(u32x2*)((unsigned char*)HF + (size_t)(m0 + r) * D + cb + 32 * kk) = q8; }
#if SHARED_BF16
            *(u32x4*)(HFB + (size_t)(m0 + r) * D + cb + 32 * kk) = hw;
#endif
#else
            *(u32x4*)(hrow + 32 * kk) = hw;
#endif
            const bf16x8 ah = __builtin_bit_cast(bf16x8, hw), al = __builtin_bit_cast(bf16x8, lw);
#pragma unroll
            for (int nt = 0; nt < 4; ++nt) { const bf16x8 bh = *(const bf16x8*)(wb + (size_t)16 * nt * D + 32 * kk), bl = *(const bf16x8*)(wb + (size_t)(NE + 16 * nt) * D + 32 * kk);
                acc[nt] = __builtin_amdgcn_mfma_f32_16x16x32_bf16(ah, bh, acc[nt], 0, 0, 0);
                acc[nt] = __builtin_amdgcn_mfma_f32_16x16x32_bf16(ah, bl, acc[nt], 0, 0, 0);
                acc[nt] = __builtin_amdgcn_mfma_f32_16x16x32_bf16(al, bh, acc[nt], 0, 0, 0); }
            if (kk & 1) asm volatile("" ::: "memory");
        }
#pragma unroll
        for (int nt = 0; nt < 4; ++nt)
#pragma unroll
            for (int j = 0; j < 4; ++j) part[(w * 16 + 4 * q + j) * 64 + 16 * nt + r] = acc[nt][j];
        __syncthreads();
#pragma unroll 1
        for (int rr = 0; rr < 2; ++rr) {
            const int row = 2 * w + rr, m = m0 + row; float logit = 0.f;
#pragma unroll
            for (int w2 = 0; w2 < 8; ++w2) logit += part[(w2 * 16 + row) * 64 + lane];
            const float score = 1.f / (1.f + expf(-logit));
            const float sel = score + rbias[lane];
            float m1 = sel;
            m1 = fmaxf(m1, __shfl_xor(m1, 1)); m1 = fmaxf(m1, __shfl_xor(m1, 2)); m1 = fmaxf(m1, __shfl_xor(m1, 4));
            const unsigned long long eqm = __ballot(sel == m1);
            const unsigned grp_eq = (unsigned)((eqm >> (lane & ~7)) & 0xffull);
            const int first = __builtin_ctz(grp_eq);
            float m2 = ((lane & 7) == first) ? -3e38f : sel;
            m2 = fmaxf(m2, __shfl_xor(m2, 1)); m2 = fmaxf(m2, __shfl_xor(m2, 2)); m2 = fmaxf(m2, __shfl_xor(m2, 4));
            const float gs = m1 + m2;
            int grank = 0; const int mygrp = lane >> 3;
#pragma unroll
            for (int g2 = 0; g2 < 8; ++g2) { const float o = __shfl(gs, g2 * 8); grank += (o > gs || (o == gs && g2 < mygrp)) ? 1 : 0; }
            const float msel = (grank < 4) ? sel : -1e30f;
            int rank = 0;
#pragma unroll 8
            for (int e2 = 0; e2 < 64; ++e2) { const float o = __shfl(msel, e2); rank += (o > msel || (o == msel && e2 < lane)) ? 1 : 0; }
            const bool chosen = rank < TOPK;
            const float gsum = wave_sum(chosen ? score : 0.f);
            if (chosen) { idx[(size_t)m * 8 + rank] = lane | (int)(cnt << 8); gate[(size_t)m * 8 + rank] = score / gsum * 2.5f; cnt += 1u; }
        }
        __syncthreads();
    }
    wcnt[(size_t)(blockIdx.x * 8 + w) * 64 + lane] = (int)cnt;
}
__device__ __forceinline__ void slot2_phase(const Ctx& c, const int* idx, const int* wcnt, unsigned* nrt_out, int* pos, int* slot_tok, int* tile_exp) {
    LAS int* ST = (LAS int*)c.lds;
    LAS int* SB = ST + 512;
    LAS int* SO = SB + 512;
    LAS int* tot = SO + 512;
    LAS int* bef = tot + 64;
    LAS int* ps = bef + 64;
    LAS int* base = ps + 128;
    const int e = c.tid & 63, p = c.tid >> 6, G = gridDim.x, blk = blockIdx.x;
    { int Tp = 0, Bp = 0;
#pragma unroll 8
      for (int b2 = 0; b2 < G; ++b2) { const int v = wcnt[(size_t)(b2 * 8 + p) * 64 + e]; Tp += v; Bp += (b2 < blk) ? v : 0; }
      ST[p * 64 + e] = Tp; SB[p * 64 + e] = Bp; SO[p * 64 + e] = wcnt[(size_t)(blk * 8 + p) * 64 + e]; }
    __syncthreads();
    if (c.tid < 64) { int t = 0, bb = 0;
#pragma unroll
        for (int p2 = 0; p2 < 8; ++p2) { t += ST[p2 * 64 + e]; bb += SB[p2 * 64 + e]; }
        tot[e] = t; bef[e] = bb; }
    __syncthreads();
    if (c.tid == 0) { int acc = 0; for (int e2 = 0; e2 < NE; ++e2) { ps[e2] = acc; acc += (tot[e2] + 255) / 256 * 256; } ps[64] = acc; }
    __syncthreads();
    { int o = ps[e] + bef[e];
      for (int p2 = 0; p2 < p; ++p2) o += SO[p2 * 64 + e];
      base[p * 64 + e] = o; }
    __syncthreads();
    for (int i = c.tid; i < (M / 16 / G + 1) * 128; i += 512) {
        const int u = blk + (i >> 7) * G; if (u >= M / 16) break;
        const int t7 = i & 127, row = t7 >> 3, k = t7 & 7, m = u * 16 + row, wv = row >> 1; const size_t a = (size_t)m * 8 + k;
        const int code = idx[a], ee = code & 255, rk = code >> 8, slot = base[wv * 64 + ee] + rk;
        slot_tok[slot] = m; pos[a] = slot;
    }
    for (int t = gtid_now(); t < M; t += c.gsz) slot_tok[CAPR + t] = t;
    if (blk == 0) {
        if (c.tid < NE) { const int s0 = ps[e], cn = tot[e], pe = s0 + (cn + 255) / 256 * 256;
            for (int s = s0 + cn; s < pe; ++s) slot_tok[s] = 0;
            for (int tt = s0 / 256; tt < pe / 256; ++tt) tile_exp[tt] = e; }
        if (c.tid == 0) *nrt_out = (unsigned)(ps[64] / 256);
    }
    __syncthreads();
}

template <int L> __device__ __forceinline__ void moe_up_tuned(const Ctx& c, unsigned char* ws) {
    const int nrt = (int)c.ctl[CW_NRT + L];
#if USE_FP8_MOE && SHARED_BF16
    { pg8::PlainSched S; S.o.init(M / 256, UPN / 256, gridDim.x, blockIdx.x); S.Bt = (const char*)(ws + WS_WUPS) + (size_t)L * UPN * D * 2; S.K = D;
      pg8::EpiUp E{(bf16*)(ws + WS_ACTS)}; pg8::gemm_phase(c.lds, (const char*)(ws + WS_HFB), D, S, E); }
    const int ntile = nrt;
#else
    const int ntile = nrt + M / 256;
#endif
    pg8::GroupSched<true> S; S.o.init(ntile, UPN / 256, gridDim.x, blockIdx.x);
    S.nrt = nrt; S.tile_exp = (const int*)(ws + WS_TILEEXP); S.slot_tok = (const int*)(ws + WS_SLOTTOK);
#if USE_FP8_MOE
    S.W = (const char*)(ws + WS_WUP) + (size_t)L * NEX * UPN * D; S.wstride = (size_t)UPN * D; S.K = D / 2;
    pg8::EpiUp8 E{ws + WS_ACT}; pg8::gemm_phase<pg8::EpiUp8, pg8::GroupSched<true>, true>(c.lds, (const char*)(ws + WS_HF), D / 2, S, E);
#else
    S.W = (const char*)(ws + WS_WUP) + (size_t)L * NEX * UPN * D * 2; S.wstride = (size_t)UPN * D * 2; S.K = D;
    pg8::EpiUp E{(bf16*)(ws + WS_ACT)}; pg8::gemm_phase(c.lds, (const char*)(ws + WS_HF), D, S, E);
#endif
}
template <int L> __device__ __forceinline__ void moe_down_tuned(const Ctx& c, unsigned char* ws) {
    const int nrt = (int)c.ctl[CW_NRT + L];
#if USE_FP8_MOE && SHARED_BF16
    { pg8::PlainSched S; S.o.init(M / 256, D / 256, gridDim.x, blockIdx.x); S.Bt = (const char*)(ws + WS_WDNS) + (size_t)L * D * ED * 2; S.K = ED;
      pg8::EpiDown8 E{(bf16*)(ws + WS_Y), CAPR, 1.f}; pg8::gemm_phase(c.lds, (const char*)(ws + WS_ACTS), ED, S, E); }
    const int ntile = nrt;
#else
    const int ntile = nrt + M / 256;
#endif
    pg8::GroupSched<false> S; S.o.init(ntile, D / 256, gridDim.x, blockIdx.x);
    S.nrt = nrt; S.tile_exp = (const int*)(ws + WS_TILEEXP); S.slot_tok = (const int*)(ws + WS_SLOTTOK);
#if USE_FP8_MOE
    S.W = (const char*)(ws + WS_WDN) + (size_t)L * NEX * D * ED; S.wstride = (size_t)D * ED; S.K = ED / 2;
    pg8::EpiDown8 E{(bf16*)(ws + WS_Y)}; pg8::gemm_phase<pg8::EpiDown8, pg8::GroupSched<false>, true>(c.lds, (const char*)(ws + WS_ACT), ED / 2, S, E);
#else
    S.W = (const char*)(ws + WS_WDN) + (size_t)L * NEX * D * ED * 2; S.wstride = (size_t)D * ED * 2; S.K = ED;
    pg8::EpiDown E{(bf16*)(ws + WS_Y)}; pg8::gemm_phase(c.lds, (const char*)(ws + WS_ACT), ED, S, E);
#endif
}
template <int L> __device__ __forceinline__ void qkv_tuned(const Ctx& c, unsigned char* ws, const float* gains) {
    constexpr int NCOL = L == 0 ? AB_IN : C_IN; constexpr bool TUNED_ATT = L == 0 ? (USE_ATT0 != 0) : (USE_ATT1 != 0);
    pg8::PlainSched S; S.o.init(M / 256, NCOL / 256, gridDim.x, blockIdx.x); S.Bt = (const char*)(ws + (L == 0 ? WS_W0IN : WS_W1IN));
#if USE_FP8_QKV
    S.K = D / 2; pg8::EpiQKV<L> E{(bf16*)(ws + WS_QKV), NCOL, gains, TUNED_ATT ? att::C2 : 1.f, 1.f / (F8_HSCALE * F8_WSCALE)};
    pg8::gemm_phase<pg8::EpiQKV<L>, pg8::PlainSched, true>(c.lds, (const char*)(ws + WS_XN), D / 2, S, E);
#else
    S.K = D; pg8::EpiQKV<L> E{(bf16*)(ws + WS_QKV), NCOL, gains, TUNED_ATT ? att::C2 : 1.f, 1.f};
    pg8::gemm_phase(c.lds, (const char*)(ws + WS_XN), D, S, E);
#endif
}

template <int L> __device__ __forceinline__ void outproj_epi(const Ctx& c, unsigned char* ws, const pg8::PlainSched& S, const float* xin_f32, const float* gm) {
#if RES_BF16
    if (L == 0) { pg8::EpiOutB<false> E{xin_f32, gm, (bf16*)(ws + WS_X1)}; pg8::gemm_phase(c.lds, (const char*)(ws + WS_O), D, S, E); }
    else { pg8::EpiOutB<true> E{ws + WS_X1 + (size_t)M * D * 2, gm, (bf16*)(ws + WS_X1)}; pg8::gemm_phase(c.lds, (const char*)(ws + WS_O), D, S, E); }
#else
    pg8::EpiOut E{xin_f32, gm, (float*)(ws + WS_X1)}; pg8::gemm_phase(c.lds, (const char*)(ws + WS_O), D, S, E);
#endif
}
__global__ void __launch_bounds__(512, 2) mega(Args args) {
    extern __shared__ __attribute__((aligned(16))) unsigned char lds_raw[];
    Ctx c;
    c.lds = (LAS unsigned char*)lds_raw;
    c.tid = threadIdx.x; c.lane = c.tid & 63; c.wave = __builtin_amdgcn_readfirstlane(c.tid >> 6);
    c.gw = blockIdx.x * 8 + c.wave; c.ngw = gridDim.x * 8; c.gsz = gridDim.x * 512;
    c.ws = args.ws; c.ctl = (unsigned*)(args.ws + WS_CTL);
    volatile LAS unsigned* xbw = (volatile LAS unsigned*)(c.lds + LDS_BYTES - 16);
    if (c.tid < 4) xbw[c.tid] = 0u;
    __syncthreads();
    const int lo = args.ph_lo, hi = args.ph_hi;
    XcdBarrier bar; bar.bar = c.ctl + CW_BAR; bar.x = 0; bar.st = xbw;
    if (hi - lo > 1) bar = xcd_barrier_post(c.ctl + CW_BAR, xbw);
#ifdef PHASE_ONLY
#define IN(k) ((k) == PHASE_ONLY && lo <= (k) && (k) < hi)
#else
#define IN(k) (lo <= (k) && (k) < hi)
#endif
#define PHASE(k, ...) do { if (IN(k)) { __VA_ARGS__ } if (IN(k) && ((REPMASK >> (k)) & 1u)) { __syncthreads(); __VA_ARGS__ } } while (0);
#define SEAM(k) do { if (IN(k) && IN((k) + 1)) xcd_barrier(bar); else __syncthreads(); } while (0)
    unsigned char* ws = args.ws;
#define XIN (args.in[0])
#define cin (args.in[1])
#define norm_mix (args.in[2])
#define norm_ffn (args.in[3])
#define w_ada (args.in[4])
#define b_ada (args.in[5])
#define ada ((float*)(ws + WS_ADA))
#define W0IN ((bf16*)(ws + WS_W0IN))
#define W0OUT ((bf16*)(ws + WS_W0OUT))
#define W1IN ((bf16*)(ws + WS_W1IN))
#define W1OUT ((bf16*)(ws + WS_W1OUT))
#define WUP ((bf16*)(ws + WS_WUP))
#define WDN ((bf16*)(ws + WS_WDN))
#define XN ((bf16*)(ws + WS_XN))
#define QKV ((bf16*)(ws + WS_QKV))
#define OBUF ((bf16*)(ws + WS_O))
#define X1 ((float*)(ws + WS_X1))
#define HF ((bf16*)(ws + WS_HF))
#define IDX ((int*)(ws + WS_IDX))
#define GATE ((float*)(ws + WS_GATE))
#define POS ((int*)(ws + WS_POS))
#define SLOTTOK ((int*)(ws + WS_SLOTTOK))
#define TILEEXP ((int*)(ws + WS_TILEEXP))
#define ACT ((bf16*)(ws + WS_ACT))
#define Y ((bf16*)(ws + WS_Y))
#define TMP ((float*)(ws + WS_TMP))
#define OUTP (args.out)

    PHASE(0, {
        constexpr int QM = USE_PG8_QKV ? 1 : 0, UM = USE_PG8_MOE ? 2 : 0;
#if USE_CONV128 && USE_FP8_MOE
        convert_batch128<QM, USE_FP8_QKV != 0>(c, args.in[6], D, AB_IN, W0IN, 1, 0, USE_FP8_QKV ? F8_WSCALE : 1.f);
        convert_batch128<0, false>(c, args.in[9], D, D, W0OUT, 1, 0, 1.f);
        convert_batch128<QM, USE_FP8_QKV != 0>(c, args.in[10], D, C_IN, W1IN, 1, 0, USE_FP8_QKV ? F8_WSCALE : 1.f);
        convert_batch128<0, false>(c, args.in[14], D, D, W1OUT, 1, 0, 1.f);
#if DEFER_CONV && USE_ATT0 && USE_ATT1
#if SHARED_BF16
        for (int l = 0; l < 2; ++l) {
            convert_batch128<2, false>(c, args.in[19] + (size_t)l * D * UPN, D, UPN, ws + WS_WUPS + (size_t)l * UPN * D * 2, 1, 0, 1.f);
            convert_batch128<0, false>(c, args.in[20] + (size_t)l * ED * D, ED, D, ws + WS_WDNS + (size_t)l * D * ED * 2, 1, 0, 1.f);
        }
#endif
#else
        for (int l = 0; l < 2; ++l) {
            convert_batch128<2, true>(c, args.in[17] + (size_t)l * NE * D * UPN, D, UPN, (unsigned char*)WUP + (size_t)l * NEX * UPN * D, NE, (size_t)UPN * D, F8_WSCALE);
            convert_batch128<0, true>(c, args.in[18] + (size_t)l * NE * ED * D, ED, D, (unsigned char*)WDN + (size_t)l * NEX * D * ED, NE, (size_t)D * ED, F8_WSCALE);
#if SHARED_BF16
            convert_batch128<2, false>(c, args.in[19] + (size_t)l * D * UPN, D, UPN, ws + WS_WUPS + (size_t)l * UPN * D * 2, 1, 0, 1.f);
            convert_batch128<0, false>(c, args.in[20] + (size_t)l * ED * D, ED, D, ws + WS_WDNS + (size_t)l * D * ED * 2, 1, 0, 1.f);
#else
            convert_batch128<2, true>(c, args.in[19] + (size_t)l * D * UPN, D, UPN, (unsigned char*)WUP + ((size_t)l * NEX + NE) * UPN * D, 1, 0, F8_WSCALE);
            convert_batch128<0, true>(c, args.in[20] + (size_t)l * ED * D, ED, D, (unsigned char*)WDN + ((size_t)l * NEX + NE) * D * ED, 1, 0, F8_WSCALE);
#endif
        }
#endif
#else
        convert_batch<QM>(c, args.in[6], D, AB_IN, W0IN, 1, 0);
        convert_batch<0>(c, args.in[9], D, D, W0OUT, 1, 0);
        convert_batch<QM>(c, args.in[10], D, C_IN, W1IN, 1, 0);
        convert_batch<0>(c, args.in[14], D, D, W1OUT, 1, 0);
        for (int l = 0; l < 2; ++l) {
#if USE_FP8_MOE
            convert_batch_f8<2>(c, args.in[17] + (size_t)l * NE * D * UPN, D, UPN, (unsigned char*)WUP + (size_t)l * NEX * UPN * D, NE, (size_t)UPN * D);
            convert_batch_f8<2>(c, args.in[19] + (size_t)l * D * UPN, D, UPN, (unsigned char*)WUP + ((size_t)l * NEX + NE) * UPN * D, 1, 0);
            convert_batch_f8<0>(c, args.in[18] + (size_t)l * NE * ED * D, ED, D, (unsigned char*)WDN + (size_t)l * NEX * D * ED, NE, (size_t)D * ED);
            convert_batch_f8<0>(c, args.in[20] + (size_t)l * ED * D, ED, D, (unsigned char*)WDN + ((size_t)l * NEX + NE) * D * ED, 1, 0);
#else
            convert_batch<UM>(c, args.in[17] + (size_t)l * NE * D * UPN, D, UPN, WUP + (size_t)l * NEX * UPN * D, NE, (size_t)UPN * D);
            convert_batch<UM>(c, args.in[19] + (size_t)l * D * UPN, D, UPN, WUP + ((size_t)l * NEX + NE) * UPN * D, 1, 0);
            convert_batch<0>(c, args.in[18] + (size_t)l * NE * ED * D, ED, D, WDN + (size_t)l * NEX * D * ED, NE, (size_t)D * ED);
            convert_batch<0>(c, args.in[20] + (size_t)l * ED * D, ED, D, WDN + ((size_t)l * NEX + NE) * D * ED, 1, 0);
#endif
        }
#endif
        convert_router(c, args.in[15], (bf16*)(ws + WS_WRT));
        convert_router(c, args.in[15] + (size_t)D * NE, (bf16*)(ws + WS_WRT) + (size_t)2 * NE * D);
        __syncthreads();
        ada_phase(c, cin, w_ada, b_ada, ada);
    })
    SEAM(0);
    PHASE(1, norm_phase(c, XIN, norm_mix, ada, 0, D, XN);)
    SEAM(1);
#if USE_PG8_QKV
    PHASE(2, qkv_tuned<0>(c, ws, args.in[7]);)
    SEAM(2);
#else
    PHASE(2, gemm_plain_bf16(c, XN, W0IN, D, AB_IN, QKV);)
    SEAM(2);
#endif
#if USE_ATT0
    static_assert(USE_PG8_QKV, "the tuned attention needs Q pre-scaled by the QKV epilogue");
    #if DEFER_CONV
    PHASE(3, { const int xs_ = vcu_of(blockIdx.x, gridDim.x) & 15;
        attn0_tuned_phase(c, QKV, args.in[8], (bf16*)(ws + WS_TMP), (float*)(ws + WS_TMP + (size_t)3 * M * 1024 * 2), OBUF, 0, xs_ + 1);
        { const int cshare = (EXP_ITEMS + (int)gridDim.x - 1) / (int)gridDim.x, cfirst = blockIdx.x * cshare, ccount = (cfirst + cshare <= EXP_ITEMS) ? cshare : (EXP_ITEMS > cfirst ? EXP_ITEMS - cfirst : 0);
          expert_items_block(c, ExpertSrc{args.in[17], args.in[19], args.in[18], args.in[20]}, 0, ws, cfirst, ccount); __syncthreads(); }
        attn0_tuned_phase(c, QKV, args.in[8], (bf16*)(ws + WS_TMP), (float*)(ws + WS_TMP + (size_t)3 * M * 1024 * 2), OBUF, xs_ + 1, 16); })
#else
    PHASE(3, attn0_tuned_phase(c, QKV, args.in[8], (bf16*)(ws + WS_TMP), (float*)(ws + WS_TMP + (size_t)3 * M * 1024 * 2), OBUF, 0, 16);)
#endif
    SEAM(3);
    PHASE(4, attn0_merge_phase(c, (const bf16*)(ws + WS_TMP), (const float*)(ws + WS_TMP + (size_t)3 * M * 1024 * 2), OBUF);)
    SEAM(4);
#else
#if !USE_PG8_QKV
    PHASE(3, qknorm0_phase(c, QKV, args.in[7]);)
#endif
    SEAM(3);
    PHASE(4, attn0_phase(c, QKV, args.in[8], OBUF);)
    SEAM(4);
#endif
#if USE_PG8_OUT
    PHASE(5, { pg8::PlainSched S; S.o.init(M / 256, D / 256, gridDim.x, blockIdx.x); S.Bt = (const char*)W0OUT; S.K = D;
        outproj_epi<0>(c, ws, S, XIN, ada + 2 * D); })
#else
    PHASE(5, gemm_outproj(c, OBUF, W0OUT, XIN, ada + 2 * D, X1);)
#endif
    SEAM(5);
#if USE_ROUTER2
    PHASE(6, router2_phase(c, X1, norm_ffn, ada, (const bf16*)(ws + WS_WRT), args.in[16], HF, IDX, GATE, (int*)(ws + WS_WCNT), (bf16*)(ws + WS_HFB));)
    SEAM(6);
    PHASE(7, slot2_phase(c, IDX, (const int*)(ws + WS_WCNT), c.ctl + CW_NRT, POS, SLOTTOK, TILEEXP);)
#else
    PHASE(6, router_phase(c, X1, norm_ffn, ada, args.in[15], args.in[16], HF, IDX, GATE, c.ctl + CW_CNT);)
    SEAM(6);
    PHASE(7, slot_phase(c, IDX, c.ctl + CW_CNT, c.ctl + CW_CUR, c.ctl + CW_NRT, POS, SLOTTOK, TILEEXP);)
#endif
    SEAM(7);
#if USE_PG8_MOE
    PHASE(8, moe_up_tuned<0>(c, ws);)
    SEAM(8);
    PHASE(9, moe_down_tuned<0>(c, ws);)
#else
    PHASE(8, moe_up_phase(c, HF, WUP, SLOTTOK, TILEEXP, c.ctl + CW_NRT, ACT);)
    SEAM(8);
    PHASE(9, moe_down_phase(c, ACT, WDN, TILEEXP, c.ctl + CW_NRT, Y);)
#endif
    SEAM(9);
    PHASE(10, combine_phase<true>(c, X1, Y, POS, GATE, ada, RES_BF16 ? (float*)(ws + WS_X1 + (size_t)M * D * 2) : OUTP, norm_mix + D, ada + (size_t)4 * 6 * D, XN);)
    SEAM(10);
#define ada1 (ada + (size_t)4 * 6 * D)
#if USE_PG8_QKV
    PHASE(11, qkv_tuned<1>(c, ws, args.in[11]);)
    SEAM(11);
    SEAM(12);
#else
    PHASE(11, gemm_plain_bf16(c, XN, W1IN, D, C_IN, QKV);)
    SEAM(11);
    PHASE(12, qknorm1_phase(c, QKV, args.in[11]);)
    SEAM(12);
#endif
#if USE_ATT1
    PHASE(13, attn1_tuned_phase(c, QKV, args.in[11], (bf16*)TMP, c.ctl + CW_QCTR, ExpertSrc{args.in[17], args.in[19], args.in[18], args.in[20]}, ws, args.in[12], args.in[13], OBUF);)
    SEAM(13);
#if !FUSE_FINISH
    PHASE(14, attn1_finish_bf16_phase(c, (const bf16*)TMP, args.in[12], args.in[13], OBUF);)
#endif
    SEAM(14);
#else
    PHASE(13, attn1_phase(c, QKV, TMP);)
    SEAM(13);
    PHASE(14, attn1_finish_phase(c, TMP, args.in[12], args.in[13], OBUF);)
    SEAM(14);
#endif
#if USE_PG8_OUT
    PHASE(15, { pg8::PlainSched S; S.o.init(M / 256, D / 256, gridDim.x, blockIdx.x); S.Bt = (const char*)W1OUT; S.K = D;
        outproj_epi<1>(c, ws, S, OUTP, ada1 + 2 * D); })
#else
    PHASE(15, gemm_outproj(c, OBUF, W1OUT, OUTP, ada1 + 2 * D, X1);)
#endif
    SEAM(15);
#if USE_ROUTER2
    PHASE(16, router2_phase(c, X1, norm_ffn + D, ada1, (const bf16*)(ws + WS_WRT) + (size_t)2 * NE * D, args.in[16] + NE, HF, IDX, GATE, (int*)(ws + WS_WCNT), (bf16*)(ws + WS_HFB));)
    SEAM(16);
    PHASE(17, slot2_phase(c, IDX, (const int*)(ws + WS_WCNT), c.ctl + CW_NRT + 1, POS, SLOTTOK, TILEEXP);)
#else
    PHASE(16, router_phase(c, X1, norm_ffn + D, ada1, args.in[15] + (size_t)D * NE, args.in[16] + NE, HF, IDX, GATE, c.ctl + CW_CNT + 64);)
    SEAM(16);
    PHASE(17, slot_phase(c, IDX, c.ctl + CW_CNT + 64, c.ctl + CW_CUR + 64, c.ctl + CW_NRT + 1, POS, SLOTTOK, TILEEXP);)
#endif
    SEAM(17);
#if USE_PG8_MOE
    PHASE(18, moe_up_tuned<1>(c, ws);)
    SEAM(18);
    PHASE(19, moe_down_tuned<1>(c, ws);)
#else
    PHASE(18, moe_up_phase(c, HF, WUP + (size_t)NEX * UPN * D, SLOTTOK, TILEEXP, c.ctl + CW_NRT + 1, ACT);)
    SEAM(18);
    PHASE(19, moe_down_phase(c, ACT, WDN + (size_t)NEX * D * ED, TILEEXP, c.ctl + CW_NRT + 1, Y);)
#endif
    SEAM(19);
    PHASE(20, combine_phase<false>(c, X1, Y, POS, GATE, ada1, OUTP, nullptr, nullptr, nullptr);)
#undef IN
#undef SEAM
#undef ada
#undef ada1
#undef W0IN
#undef W0OUT
#undef W1IN
#undef W1OUT
#undef WUP
#undef WDN
#undef XN
#undef QKV
#undef OBUF
#undef X1
#undef HF
#undef IDX
#undef GATE
#undef POS
#undef SLOTTOK
#undef TILEEXP
#undef ACT
#undef Y
#undef TMP
#undef XIN
#undef cin
#undef norm_mix
#undef norm_ffn
#undef w_ada
#undef b_ada
#undef OUTP
}

extern "C" void kernel_launch(void* const* d_in, const int* in_sizes, int n_in, void* d_out, int out_size, void* d_ws, size_t ws_size, hipStream_t stream) {
    static int grid = 0;
    if (grid == 0) {
        if (n_in != 21 || out_size != M * D || ws_size < WS_END) { fprintf(stderr, "kernel_launch: unexpected sizes (n_in %d out %d ws %zu need %zu)\n", n_in, out_size, ws_size, (size_t)WS_END); grid = -1; return; }
        int dev = 0, cus = 0, per_cu = 0;
        hipGetDevice(&dev); hipDeviceGetAttribute(&cus, hipDeviceAttributeMultiprocessorCount, dev);
        if (hipFuncSetAttribute((const void*)mega, hipFuncAttributeMaxDynamicSharedMemorySize, LDS_BYTES) != hipSuccess) { fprintf(stderr, "kernel_launch: hipFuncSetAttribute failed\n"); grid = -1; return; }
        hipOccupancyMaxActiveBlocksPerMultiprocessor(&per_cu, (const void*)mega, 512, LDS_BYTES);
        (void)hipGetLastError();
        if (per_cu < 1) fprintf(stderr, "kernel_launch: occupancy query says %d blocks per CU\n", per_cu);
        grid = cus;
    }
    if (grid < 0) return;
    hipMemsetAsync((char*)d_ws + WS_CTL, 0, CTL_BYTES, stream);
    Args a{};
    for (int i = 0; i < 21; ++i) a.in[i] = (const float*)d_in[i];
    a.out = (float*)d_out; a.ws = (unsigned char*)d_ws;
#if MK_SPLIT
    for (int p = 0; p < NPHASE; ++p) { a.ph_lo = p; a.ph_hi = p + 1; hipLaunchKernelGGL(mega, dim3(grid), dim3(512), LDS_BYTES, stream, a); }
#else
    a.ph_lo = 0; a.ph_hi = NPHASE; hipLaunchKernelGGL(mega, dim3(grid), dim3(512), LDS_BYTES, stream, a);
#endif
}
```

```cpp
#include <hip/hip_runtime.h>
#include <cstdio>
#include <cstdint>
#include <hip/hip_bf16.h>

#ifndef USE_PG8_OUT
#define USE_PG8_OUT 1
#endif
#ifndef USE_PG8_QKV
#define USE_PG8_QKV 1
#endif
#ifndef USE_PG8_MOE
#define USE_PG8_MOE 1
#endif
#ifndef USE_ATT1
#define USE_ATT1 1
#endif
#ifndef USE_ATT0
#define USE_ATT0 1
#endif
#ifndef USE_ROUTER2
#define USE_ROUTER2 1
#endif
#ifndef REPMASK
#define REPMASK 0u
#endif
#ifndef USE_FP8_MOE
#define USE_FP8_MOE 1
#endif
#ifndef USE_CONV128
#define USE_CONV128 1
#endif
#ifndef USE_FP8_QKV
#define USE_FP8_QKV 1
#endif
#ifndef SHARED_BF16
#define SHARED_BF16 0
#endif
#ifndef Y_FP8
#define Y_FP8 1
#endif
#ifndef DEFER_CONV
#define DEFER_CONV 1
#endif
#ifndef RES_BF16
#define RES_BF16 1
#endif
#ifndef FUSE_FINISH
#define FUSE_FINISH 1
#endif
#ifndef PROBE_SEL
#define PROBE_SEL -1
#endif
#ifndef PROBE_GAIN
#define PROBE_GAIN 4
#endif
#ifndef QKV_HEADMAJOR
#define QKV_HEADMAJOR 1
#endif
#ifndef USE_V128
#define USE_V128 1
#endif
#ifndef MK_SPLIT
#define MK_SPLIT 0
#endif

constexpr int D = 2048, NB = 4, T = 4096, M = NB * T;
constexpr int HD = 64;
constexpr int AB_IN = 4352, C_IN = 6144;
constexpr int NE = 64, TOPK = 8, ED = 512;
constexpr int UPN = 2 * ED;
constexpr int NEX = NE + 1;
constexpr int CAPR = M * TOPK + NE * 256;
constexpr int CAP = CAPR + M;
constexpr int MAXTILES = CAP / 256;
constexpr float RMS_EPS = 1e-6f;
constexpr int NPHASE = 21;

typedef unsigned short bf16;
typedef short bf16x8 __attribute__((ext_vector_type(8)));
typedef float f32x4 __attribute__((ext_vector_type(4)));
typedef unsigned u32x4 __attribute__((ext_vector_type(4)));
typedef unsigned u32x2 __attribute__((ext_vector_type(2)));
#define LAS __attribute__((address_space(3)))

constexpr size_t MiB = 1u << 20;
constexpr size_t WS_CTL = 0, CTL_BYTES = 1 * MiB;
constexpr size_t WS_ADA = 1 * MiB;
constexpr size_t WS_W0IN = 2 * MiB;
constexpr size_t WS_W0OUT = WS_W0IN + (size_t)AB_IN * D * 2;
constexpr size_t WS_W1IN = WS_W0OUT + (size_t)D * D * 2;
constexpr size_t WS_W1OUT = WS_W1IN + (size_t)C_IN * D * 2;
constexpr size_t WS_WUP = WS_W1OUT + (size_t)D * D * 2;
constexpr size_t WS_WDN = WS_WUP + (size_t)2 * NEX * UPN * D * 2;
constexpr size_t WS_XN = WS_WDN + (size_t)2 * NEX * D * ED * 2;
constexpr size_t WS_QKV = WS_XN + (size_t)M * D * 2;
constexpr size_t WS_O = WS_QKV + (size_t)M * C_IN * 2;
constexpr size_t WS_X1 = WS_O + (size_t)M * D * 2;
constexpr size_t WS_HF = WS_X1 + (size_t)M * D * 4;
constexpr size_t WS_IDX = WS_HF + (size_t)M * D * 2;
constexpr size_t WS_GATE = WS_IDX + (size_t)M * 8 * 4;
constexpr size_t WS_POS = WS_GATE + (size_t)M * 8 * 4;
constexpr size_t WS_SLOTTOK = WS_POS + (size_t)M * 8 * 4;
constexpr size_t WS_TILEEXP = WS_SLOTTOK + (size_t)CAP * 4;
constexpr size_t WS_ACT = WS_TILEEXP + 4096;
constexpr size_t WS_Y = WS_ACT + (size_t)CAP * ED * 2;
constexpr size_t WS_TMP = WS_Y + (size_t)CAP * D * 2;
constexpr size_t WS_WRT = WS_TMP + (size_t)M * 16 * 2 * 128 * 4;
constexpr size_t WS_WCNT = WS_WRT + (size_t)2 * 2 * NE * D * 2;
constexpr size_t WS_HFB = WS_WCNT + (size_t)4096 * 64 * 4;
constexpr size_t WS_ACTS = WS_HFB + (size_t)M * D * 2;
constexpr size_t WS_WUPS = WS_ACTS + (size_t)M * ED * 2;
constexpr size_t WS_WDNS = WS_WUPS + (size_t)2 * UPN * D * 2;
constexpr size_t WS_END = WS_WDNS + (size_t)2 * D * ED * 2;
constexpr int CW_BAR = 4096;
constexpr int CW_CNT = 16384;
constexpr int CW_CUR = 16384 + 256;
constexpr int CW_NRT = 16384 + 512;
constexpr int CW_QCTR = 16384 + 1024;

constexpr int LDS_BYTES = 147456;

__device__ __forceinline__ unsigned pk4_fp8(float a, float b, float c2, float d);
constexpr float F8_WSCALE = 256.f, F8_HSCALE = 16.f, F8_ASCALE = 8.f, F8_YSCALE = 32.f;
__device__ __forceinline__ float bf2f(unsigned v) { return __uint_as_float(v << 16); }
__device__ __forceinline__ unsigned f2bf(float f) { unsigned u = __float_as_uint(f); return (u + 0x7fffu + ((u >> 16) & 1u)) >> 16; }
__device__ __forceinline__ unsigned pk2(float lo, float hi) { return f2bf(lo) | (f2bf(hi) << 16); }
__device__ __forceinline__ float wave_sum(float v) {
#pragma unroll
    for (int o = 1; o < 64; o <<= 1) v += __shfl_xor(v, o);
    return v;
}
__device__ __forceinline__ float siluf(float x) { return x / (1.f + __expf(-x)); }

#define XB_TMO      128
#define XB_XCNT(j)  (256  + 64 * (j))
#define XB_XSUB(j)  (1280 + 64 * (j))
#define XB_XGEN(j)  (2304 + 64 * (j))
#define XB_TOP      3328
#define XB_TOPGEN   3392
#define XCD_BAR_WORDS 3456
#define XB_SPIN_CAP (1u << 22)
__device__ __forceinline__ unsigned xb_ld(unsigned* p)              { return __hip_atomic_load(p, __ATOMIC_RELAXED, __HIP_MEMORY_SCOPE_AGENT); }
__device__ __forceinline__ unsigned xb_add(unsigned* p, unsigned v) { return __hip_atomic_fetch_add(p, v, __ATOMIC_RELAXED, __HIP_MEMORY_SCOPE_AGENT); }
__device__ __forceinline__ unsigned xb_xcc_id() { return (unsigned)__builtin_amdgcn_s_getreg((3 << 11) | 20) & 0xFu; }
#define XB_SPIN(cond, bar) do { unsigned _sp = 0; while (cond) { __builtin_amdgcn_s_sleep(1); \
    if ((++_sp & 255u) == 0u) { if (xb_ld(&(bar)[XB_TMO])) break; if (_sp > XB_SPIN_CAP) { atomicAdd(&(bar)[XB_TMO], 1u); break; } } } } while (0)
struct XcdBarrier { unsigned* bar; unsigned x; volatile LAS unsigned* st; };
__device__ __forceinline__ XcdBarrier xcd_barrier_post(unsigned* bar, volatile LAS unsigned* st) {
    XcdBarrier b; b.bar = bar; b.x = xb_xcc_id(); b.st = st;
    if (threadIdx.x == 0) (void)xb_add(&bar[XB_XCNT(b.x)], 1u);
    return b;
}
__device__ __forceinline__ void xcd_barrier_complete(unsigned* bar, unsigned x, unsigned& nloc, unsigned& nx) {
    const unsigned G = gridDim.x * gridDim.y * gridDim.z;
    unsigned sum, cnt, mine, sp = 0u;
    for (;;) {
        sum = 0u; cnt = 0u; mine = 0u;
#pragma unroll
        for (unsigned j = 0; j < 16; ++j) { const unsigned c = xb_ld(&bar[XB_XCNT(j)]); sum += c; cnt += (c > 0u) ? 1u : 0u; mine = (j == x) ? c : mine; }
        if (sum == G) break;
        __builtin_amdgcn_s_sleep(1);
        if ((++sp & 255u) == 0u) { if (xb_ld(&bar[XB_TMO])) break; if (sp > XB_SPIN_CAP) { atomicAdd(&bar[XB_TMO], 1u); break; } }
    }
    nloc = mine > 0u ? mine : 1u; nx = cnt > 0u ? cnt : 1u;
}
__device__ __forceinline__ void xcd_barrier(const XcdBarrier& b) {
    asm volatile("s_waitcnt vmcnt(0)" ::: "memory");
    __syncthreads();
    if (threadIdx.x == 0) {
        unsigned* bar = b.bar;
        __builtin_amdgcn_s_waitcnt(0);
        unsigned nloc = b.st[0], nx = b.st[1];
        if (nloc == 0u) { xcd_barrier_complete(bar, b.x, nloc, nx); b.st[0] = nloc; b.st[1] = nx; }
        const unsigned old = xb_add(&bar[XB_XSUB(b.x)], 1u);
        const unsigned gen = old / nloc;
        if (old + 1u == (gen + 1u) * nloc) {
            __builtin_amdgcn_fence(__ATOMIC_RELEASE, "agent");
            asm volatile("s_waitcnt vmcnt(0)" ::: "memory");
            const unsigned og = xb_add(&bar[XB_TOP], 1u);
            const unsigned tg = og / nx;
            if (og + 1u == (tg + 1u) * nx) xb_add(&bar[XB_TOPGEN], 1u);
            else XB_SPIN(xb_ld(&bar[XB_TOPGEN]) == tg, bar);
            __builtin_amdgcn_fence(__ATOMIC_ACQUIRE, "agent");
            xb_add(&bar[XB_XGEN(b.x)], 1u);
            asm volatile("s_waitcnt vmcnt(0)" ::: "memory");
        } else {
            XB_SPIN(xb_ld(&bar[XB_XGEN(b.x)]) == gen, bar);
            __builtin_amdgcn_fence(__ATOMIC_ACQUIRE, "agent");
            asm volatile("s_waitcnt vmcnt(0)" ::: "memory");
        }
    }
    __syncthreads();
}

struct Args {
    const float* in[21];
    float* out;
    unsigned char* ws;
    int ph_lo, ph_hi;
};

struct Ctx {
    int tid, lane, wave, gw, ngw, gsz;
    LAS unsigned char* lds;
    unsigned char* ws;
    unsigned* ctl;
};

__device__ __forceinline__ int gtid_now() { int t = (int)(blockIdx.x * 512u + threadIdx.x); asm volatile("" : "+v"(t)); return t; }
template <int MODE> __device__ __forceinline__ int perm_row(int n) {
    if (MODE == 1) { const int nl = n & 255; return (n & ~255) + 128 * ((nl >> 5) & 1) + 32 * (nl >> 6) + (nl & 31); }
    if (MODE == 2) { const int bj = n >> 9, rem = n & 511; return 256 * (rem >> 7) + 128 * bj + (rem & 127); }
    return n;
}
template <int MODE> __device__ __forceinline__ void transpose_item(const float* W, int K, int N, bf16* WT, LAS float* scr, int item, int lane) {
    const int nblk = N / 32, kb = item / nblk, nb = item % nblk, k0 = 64 * kb, n0 = 32 * nb, d0 = perm_row<MODE>(n0);
#pragma unroll 8
    for (int i = 0; i < 32; ++i) { const int kk = 2 * i + (lane >> 5); scr[kk * 33 + (lane & 31)] = W[(size_t)(k0 + kk) * N + n0 + (lane & 31)]; }
    asm volatile("s_waitcnt lgkmcnt(0)" ::: "memory");
    const int c = lane & 7;
#pragma unroll
    for (int j = 0; j < 4; ++j) { const int n = (lane >> 3) + 8 * j; const LAS float* s = scr + (8 * c) * 33 + n;
        u32x4 o; o.x = pk2(s[0 * 33], s[1 * 33]); o.y = pk2(s[2 * 33], s[3 * 33]); o.z = pk2(s[4 * 33], s[5 * 33]); o.w = pk2(s[6 * 33], s[7 * 33]);
        *(u32x4*)(WT + (size_t)(d0 + n) * K + k0 + 8 * c) = o; }
    asm volatile("s_waitcnt lgkmcnt(0)" ::: "memory");
}
template <int MODE> __device__ __forceinline__ void convert_batch(const Ctx& c, const float* src, int K, int N, bf16* dst, int nmat, size_t dst_stride) {
    LAS float* scr = (LAS float*)(c.lds + c.wave * 16384);
    const int per = (K / 64) * (N / 32); const long total = (long)per * nmat;
    for (long it = c.gw; it < total; it += c.ngw) {
        const int mat = (int)(it / per), item = (int)(it % per);
        transpose_item<MODE>(src + (size_t)mat * K * N, K, N, dst + (size_t)mat * dst_stride, scr, item, c.lane);
    }
}

__device__ __forceinline__ float clamp448(float v) { return __builtin_amdgcn_fmed3f(v, -448.f, 448.f); }
__device__ __forceinline__ unsigned pk4_fp8(float a, float b, float c2, float d) {
    unsigned w = 0u; w = __builtin_amdgcn_cvt_pk_fp8_f32(clamp448(a), clamp448(b), w, false); w = __builtin_amdgcn_cvt_pk_fp8_f32(clamp448(c2), clamp448(d), w, true); return w;
}
template <int MODE> __device__ __forceinline__ void transpose_item_f8(const float* W, int K, int N, unsigned char* WT, LAS float* scr, int item, int lane) {
    const int nblk = N / 32, kb = item / nblk, nb = item % nblk, k0 = 64 * kb, n0 = 32 * nb, d0 = perm_row<MODE>(n0);
#pragma unroll 8
    for (int i = 0; i < 32; ++i) { const int kk = 2 * i + (lane >> 5); scr[kk * 33 + (lane & 31)] = W[(size_t)(k0 + kk) * N + n0 + (lane & 31)]; }
    asm volatile("s_waitcnt lgkmcnt(0)" ::: "memory");
    const int n = lane & 31;
#pragma unroll
    for (int j = 0; j < 2; ++j) { const int ch = (lane >> 5) + 2 * j; const LAS float* s = scr + (16 * ch) * 33 + n; u32x4 o;
#pragma unroll
        for (int q = 0; q < 4; ++q) o[q] = pk4_fp8(s[(4 * q) * 33] * F8_WSCALE, s[(4 * q + 1) * 33] * F8_WSCALE, s[(4 * q + 2) * 33] * F8_WSCALE, s[(4 * q + 3) * 33] * F8_WSCALE);
        *(u32x4*)(WT + (size_t)(d0 + n) * K + k0 + 16 * ch) = o; }
    asm volatile("s_waitcnt lgkmcnt(0)" ::: "memory");
}
template <int MODE> __device__ __forceinline__ void convert_batch_f8(const Ctx& c, const float* src, int K, int N, unsigned char* dst, int nmat, size_t dst_stride) {
    LAS float* scr = (LAS float*)(c.lds + c.wave * 16384);
    const int per = (K / 64) * (N / 32); const long total = (long)per * nmat;
    for (long it = c.gw; it < total; it += c.ngw) {
        const int mat = (int)(it / per), item = (int)(it % per);
        transpose_item_f8<MODE>(src + (size_t)mat * K * N, K, N, dst + (size_t)mat * dst_stride, scr, item, c.lane);
    }
}

__device__ __forceinline__ void t128_load(f32x4 (&v)[16], const float* W, int N, int item, int lane) {
    const int nblk = N / 32, kb = item / nblk, nb = item % nblk, k0 = 128 * kb, n0 = 32 * nb;
    const int kr = lane >> 3, nq = lane & 7;
#pragma unroll
    for (int i = 0; i < 16; ++i) v[i] = *(const f32x4*)(W + (size_t)(k0 + 8 * i + kr) * N + n0 + 4 * nq);
}
template <int MODE, bool F8> __device__ __forceinline__ void t128_finish(const f32x4 (&v)[16], int K, int N, unsigned char* WT, LAS float* scr, int item, int lane, float scale) {
    const int nblk = N / 32, kb = item / nblk, nb = item % nblk, k0 = 128 * kb, n0 = 32 * nb, d0 = perm_row<MODE>(n0);
    const int kr = lane >> 3, nq = lane & 7;
#pragma unroll
    for (int i = 0; i < 16; ++i) { LAS float* s = scr + (8 * i + kr) * 33 + 4 * nq; s[0] = v[i].x; s[1] = v[i].y; s[2] = v[i].z; s[3] = v[i].w; }
    asm volatile("s_waitcnt lgkmcnt(0)" ::: "memory");
    const int n = lane & 31, half = lane >> 5; const LAS float* s0 = scr + (64 * half) * 33 + n;
    if (F8) {
        unsigned char* dst = WT + (size_t)(d0 + n) * K + k0 + 64 * half;
#pragma unroll
        for (int ch = 0; ch < 4; ++ch) { const LAS float* s = s0 + (16 * ch) * 33; u32x4 o;
#pragma unroll
            for (int q = 0; q < 4; ++q) o[q] = pk4_fp8(s[(4 * q) * 33] * scale, s[(4 * q + 1) * 33] * scale, s[(4 * q + 2) * 33] * scale, s[(4 * q + 3) * 33] * scale);
            *(u32x4*)(dst + 16 * ch) = o; }
    } else {
        bf16* dst = (bf16*)WT + (size_t)(d0 + n) * K + k0 + 64 * half;
#pragma unroll
        for (int ch = 0; ch < 8; ++ch) { const LAS float* s = s0 + (8 * ch) * 33; u32x4 o;
#pragma unroll
            for (int q = 0; q < 4; ++q) o[q] = pk2(s[(2 * q) * 33], s[(2 * q + 1) * 33]);
            *(u32x4*)(dst + 8 * ch) = o; }
    }
    asm volatile("s_waitcnt lgkmcnt(0)" ::: "memory");
}
template <int MODE, bool F8> __device__ __forceinline__ void transpose_item128(const float* W, int K, int N, unsigned char* WT, LAS float* scr, int item, int lane, float scale) {
    asm volatile("" : "+v"(lane));
    f32x4 v[16];
    t128_load(v, W, N, item, lane);
    t128_finish<MODE, F8>(v, K, N, WT, scr, item, lane, scale);
}
template <int QM, bool F8Q> __device__ __forceinline__ void convert_dense_all(const Ctx& c, const float* w0in, const float* w1in, const float* w0out, const float* w1out,
                                                                              unsigned char* W0IN_, unsigned char* W1IN_, unsigned char* W0OUT_, unsigned char* W1OUT_, float sq) {
    constexpr int n0 = 16 * (AB_IN / 32), n1 = 16 * (C_IN / 32), n2 = 16 * (D / 32), TOT = n0 + n1 + 2 * n2;
    LAS float* scr = (LAS float*)(c.lds + c.wave * 16896);
    const int lane = c.lane, ngw = c.ngw;
#define DENSE_LOAD(v, it) do { if ((it) < n0) t128_load(v, w0in, AB_IN, (it), lane); else if ((it) < n0 + n1) t128_load(v, w1in, C_IN, (it) - n0, lane); \
        else if ((it) < n0 + n1 + n2) t128_load(v, w0out, D, (it) - n0 - n1, lane); else t128_load(v, w1out, D, (it) - n0 - n1 - n2, lane); } while (0)
#define DENSE_FIN(v, it) do { if ((it) < n0 + n1) { const bool f_ = (it) < n0; t128_finish<QM, F8Q>(v, D, f_ ? AB_IN : C_IN, f_ ? W0IN_ : W1IN_, scr, f_ ? (it) : (it) - n0, lane, sq); } \
        else { const bool f_ = (it) < n0 + n1 + n2; t128_finish<0, false>(v, D, D, f_ ? W0OUT_ : W1OUT_, scr, f_ ? (it) - n0 - n1 : (it) - n0 - n1 - n2, lane, 1.f); } } while (0)
    int it = c.gw;
    f32x4 va[16], vb[16];
    if (it < TOT) DENSE_LOAD(va, it);
    while (it < TOT) {
        const int it1 = it + ngw, it2 = it1 + ngw;
        if (it1 < TOT) DENSE_LOAD(vb, it1);
        DENSE_FIN(va, it);
        if (it2 < TOT) DENSE_LOAD(va, it2);
        if (it1 < TOT) DENSE_FIN(vb, it1);
        it = it2;
    }
#undef DENSE_LOAD
#undef DENSE_FIN
}
template <int MODE, bool F8> __device__ __forceinline__ void convert_batch128(const Ctx& c, const float* src, int K, int N, void* dst, int nmat, size_t dst_stride_bytes, float scale) {
    LAS float* scr = (LAS float*)(c.lds + c.wave * 16896);
    const int per = (K / 128) * (N / 32); const long total = (long)per * nmat;
    for (long it = c.gw; it < total; it += c.ngw) {
        const int mat = (int)(it / per), item = (int)(it % per);
        transpose_item128<MODE, F8>(src + (size_t)mat * K * N, K, N, (unsigned char*)dst + (size_t)mat * dst_stride_bytes, scr, item, c.lane, scale);
    }
}

struct ExpertSrc { const float* up; const float* sup; const float* dn; const float* sdn; };
constexpr int EXP_ITEMS_UP = NE * 512, EXP_ITEMS_SUP = 512, EXP_ITEMS_DN = NE * 256, EXP_ITEMS_SDN = 256, EXP_ITEMS = EXP_ITEMS_UP + EXP_ITEMS_SUP + EXP_ITEMS_DN + EXP_ITEMS_SDN;
__device__ __forceinline__ void expert_item(const ExpertSrc& s, int l, unsigned char* ws, LAS float* scr, int it, int lane) {
    unsigned char* wup = ws + WS_WUP + (size_t)l * NEX * UPN * D; unsigned char* wdn = ws + WS_WDN + (size_t)l * NEX * D * ED;
    if (it < EXP_ITEMS_UP) { const int mat = it >> 9; transpose_item128<2, true>(s.up + ((size_t)l * NE + mat) * D * UPN, D, UPN, wup + (size_t)mat * UPN * D, scr, it & 511, lane, F8_WSCALE); return; }
    it -= EXP_ITEMS_UP;
    if (it < EXP_ITEMS_SUP) { transpose_item128<2, true>(s.sup + (size_t)l * D * UPN, D, UPN, wup + (size_t)NE * UPN * D, scr, it, lane, F8_WSCALE); return; }
    it -= EXP_ITEMS_SUP;
    if (it < EXP_ITEMS_DN) { const int mat = it >> 8; transpose_item128<0, true>(s.dn + ((size_t)l * NE + mat) * ED * D, ED, D, wdn + (size_t)mat * D * ED, scr, it & 255, lane, F8_WSCALE); return; }
    it -= EXP_ITEMS_DN;
    transpose_item128<0, true>(s.sdn + (size_t)l * ED * D, ED, D, wdn + (size_t)NE * D * ED, scr, it, lane, F8_WSCALE);
}
struct ERef { const float* W; int N, item; };
__device__ __forceinline__ ERef expert_ref(const ExpertSrc& s, int l, int it) {
    if (it < EXP_ITEMS_UP) return ERef{s.up + ((size_t)l * NE + (it >> 9)) * D * UPN, UPN, it & 511};
    it -= EXP_ITEMS_UP;
    if (it < EXP_ITEMS_SUP) return ERef{s.sup + (size_t)l * D * UPN, UPN, it};
    it -= EXP_ITEMS_SUP;
    if (it < EXP_ITEMS_DN) return ERef{s.dn + ((size_t)l * NE + (it >> 8)) * ED * D, D, it & 255};
    it -= EXP_ITEMS_DN;
    return ERef{s.sdn + (size_t)l * ED * D, D, it};
}
__device__ __forceinline__ void expert_fin(const f32x4 (&v)[16], int l, unsigned char* ws, LAS float* scr, int it, int lane) {
    if (it < EXP_ITEMS_UP + EXP_ITEMS_SUP) { const bool r = it < EXP_ITEMS_UP; const int mat = r ? it >> 9 : NE, item = r ? it & 511 : it - EXP_ITEMS_UP;
        t128_finish<2, true>(v, D, UPN, ws + WS_WUP + ((size_t)l * NEX + mat) * UPN * D, scr, item, lane, F8_WSCALE); }
    else { it -= EXP_ITEMS_UP + EXP_ITEMS_SUP; const bool r = it < EXP_ITEMS_DN; const int mat = r ? it >> 8 : NE, item = r ? it & 255 : it - EXP_ITEMS_DN;
        t128_finish<0, true>(v, ED, D, ws + WS_WDN + ((size_t)l * NEX + mat) * D * ED, scr, item, lane, F8_WSCALE); }
}
__device__ __forceinline__ void expert_items_block(const Ctx& c, const ExpertSrc& s, int l, unsigned char* ws, int first, int count) {
    int tid = threadIdx.x; asm volatile("" : "+v"(tid));
    const int lane = tid & 63, wv = __builtin_amdgcn_readfirstlane(tid >> 6);
    LAS float* scr = (LAS float*)(c.lds + wv * 16896);
    f32x4 va[16], vb[16];
    int i = wv;
    if (i < count) { const ERef r = expert_ref(s, l, first + i); t128_load(va, r.W, r.N, r.item, lane); }
#pragma unroll 1
    while (i < count) {
        const int i1 = i + 8, i2 = i + 16;
        if (i1 < count) { const ERef r = expert_ref(s, l, first + i1); t128_load(vb, r.W, r.N, r.item, lane); }
        expert_fin(va, l, ws, scr, first + i, lane);
        if (i2 < count) { const ERef r = expert_ref(s, l, first + i2); t128_load(va, r.W, r.N, r.item, lane); }
        if (i1 < count) expert_fin(vb, l, ws, scr, first + i1, lane);
        i = i2;
    }
}
__device__ __forceinline__ void ada_phase(const Ctx& c, const float* cin, const float* w_ada, const float* b_ada, float* ada) {
    LAS float* red = (LAS float*)(c.lds);
    LAS float* sc = red + 1024;
    for (int i = c.tid; i < 4 * D; i += 512) sc[i] = siluf(cin[i]);
    __syncthreads();
    const int j = c.lane & 7, kr = c.lane >> 3;
    constexpr int NCG = 6 * D / 32;
    for (int u = blockIdx.x; u < 2 * NCG; u += gridDim.x) {
        const int l = u / NCG, cg = u % NCG;
        const int k0 = c.wave * 256 + kr;
        const float* w = w_ada + (size_t)l * D * 6 * D + (size_t)k0 * 6 * D + cg * 32 + 4 * j;
        f32x4 acc[4];
#pragma unroll
        for (int b = 0; b < 4; ++b) acc[b] = (f32x4){0.f, 0.f, 0.f, 0.f};
        f32x4 wv[32];
#pragma unroll
        for (int i = 0; i < 32; ++i) wv[i] = *(const f32x4*)(w + (size_t)(8 * i) * 6 * D);
#pragma unroll
        for (int i = 0; i < 32; ++i)
#pragma unroll
            for (int b = 0; b < 4; ++b) acc[b] += wv[i] * sc[b * D + k0 + 8 * i];
#pragma unroll
        for (int b = 0; b < 4; ++b)
#pragma unroll
            for (int q = 0; q < 4; ++q) { float t = acc[b][q]; t += __shfl_xor(t, 8); t += __shfl_xor(t, 16); t += __shfl_xor(t, 32); acc[b][q] = t; }
        if (kr == 0) {
#pragma unroll
            for (int b = 0; b < 4; ++b) *(LAS f32x4*)(red + (c.wave * 4 + b) * 32 + 4 * j) = acc[b]; }
        __syncthreads();
        if (c.tid < 128) {
            const int b = c.tid >> 5, cc = c.tid & 31; float s2 = b_ada[(size_t)l * 6 * D + cg * 32 + cc];
#pragma unroll
            for (int w8 = 0; w8 < 8; ++w8) s2 += red[(w8 * 4 + b) * 32 + cc];
            ada[((size_t)l * 4 + b) * 6 * D + cg * 32 + cc] = s2;
        }
        __syncthreads();
    }
}

__device__ __forceinline__ void load_row(const float* xrow, int lane, f32x4 (&v)[8]) {
#pragma unroll
    for (int j = 0; j < 8; ++j) v[j] = *(const f32x4*)(xrow + 4 * lane + 256 * j);
}
__device__ __forceinline__ float row_rstd(const f32x4 (&v)[8]) {
    float s = 0.f;
#pragma unroll
    for (int j = 0; j < 8; ++j) s += (v[j].x * v[j].x + v[j].y * v[j].y) + (v[j].z * v[j].z + v[j].w * v[j].w);
    return 1.f / sqrtf(wave_sum(s) * (1.f / D) + RMS_EPS);
}
__device__ __forceinline__ void modulate_row(f32x4 (&v)[8], float rstd, const float* g, const float* sh, const float* sc, int lane) {
#pragma unroll
    for (int j = 0; j < 8; ++j) { const int col = 4 * lane + 256 * j;
        const f32x4 gg = *(const f32x4*)(g + col), s1 = *(const f32x4*)(sc + col), s0 = *(const f32x4*)(sh + col);
        v[j] = v[j] * rstd * gg * (s1 + 1.f) + s0; }
}
__device__ __forceinline__ void store_row_bf16(bf16* orow, const f32x4 (&v)[8], int lane) {
#pragma unroll
    for (int j = 0; j < 8; ++j) { u32x2 w; w.x = pk2(v[j].x, v[j].y); w.y = pk2(v[j].z, v[j].w); *(u32x2*)(orow + 4 * lane + 256 * j) = w; }
}
__device__ __forceinline__ void store_row_fp8(unsigned char* orow, const f32x4 (&v)[8], int lane, float scale) {
#pragma unroll
    for (int j = 0; j < 8; ++j) *(unsigned*)(orow + 4 * lane + 256 * j) = pk4_fp8(v[j].x * scale, v[j].y * scale, v[j].z * scale, v[j].w * scale);
}
__device__ __forceinline__ void norm_phase(const Ctx& c, const float* x, const float* g, const float* ada_l  , int sh_off, int sc_off, bf16* out) {
    for (int m = c.gw; m < M; m += c.ngw) {
        const int b = m / T; f32x4 v[8]; load_row(x + (size_t)m * D, c.lane, v);
        const float rstd = row_rstd(v);
        modulate_row(v, rstd, g, ada_l + (size_t)b * 6 * D + sh_off, ada_l + (size_t)b * 6 * D + sc_off, c.lane);
#if USE_FP8_QKV
        store_row_fp8((unsigned char*)out + (size_t)m * D, v, c.lane, F8_HSCALE);
#else
        store_row_bf16(out + (size_t)m * D, v, c.lane);
#endif
    }
}

__device__ __forceinline__ void wave_gemm_32x64(const bf16* a0, const bf16* a1, const bf16* b, int K, int lane, f32x4 (&acc)[2][4]) {
    const int q8 = (lane >> 4) * 8;
    for (int k0 = 0; k0 < K; k0 += 32) {
        const bf16x8 fa0 = *(const bf16x8*)(a0 + k0 + q8), fa1 = *(const bf16x8*)(a1 + k0 + q8);
#pragma unroll
        for (int n = 0; n < 4; ++n) { const bf16x8 fb = *(const bf16x8*)(b + (size_t)n * 16 * K + k0 + q8);
            acc[0][n] = __builtin_amdgcn_mfma_f32_16x16x32_bf16(fa0, fb, acc[0][n], 0, 0, 0);
            acc[1][n] = __builtin_amdgcn_mfma_f32_16x16x32_bf16(fa1, fb, acc[1][n], 0, 0, 0); }
    }
}
#define ZERO_ACC(acc) do { _Pragma("unroll") for (int _a = 0; _a < 2; ++_a) _Pragma("unroll") for (int _b = 0; _b < 4; ++_b) acc[_a][_b] = (f32x4){0.f, 0.f, 0.f, 0.f}; } while (0)

__device__ __forceinline__ void gemm_plain_bf16(const Ctx& c, const bf16* A, const bf16* Bt, int K, int N, bf16* C) {
    const int ntn = N / 64, units = (M / 256) * ntn;
    for (int u = blockIdx.x; u < units; u += gridDim.x) {
        const int mt = u / ntn, nt = u % ntn, row0 = mt * 256 + c.wave * 32, n0 = nt * 64;
        f32x4 acc[2][4]; ZERO_ACC(acc);
        const int r = c.lane & 15;
        wave_gemm_32x64(A + (size_t)(row0 + r) * K, A + (size_t)(row0 + 16 + r) * K, Bt + (size_t)(n0 + r) * K, K, c.lane, acc);
#pragma unroll
        for (int mi = 0; mi < 2; ++mi)
#pragma unroll
            for (int n = 0; n < 4; ++n)
#pragma unroll
                for (int j = 0; j < 4; ++j) C[(size_t)(row0 + 16 * mi + 4 * (c.lane >> 4) + j) * N + n0 + 16 * n + r] = (bf16)f2bf(acc[mi][n][j]);
    }
}
__device__ __forceinline__ void gemm_outproj(const Ctx& c, const bf16* A, const bf16* Bt, const float* xin, const float* gm  , float* X1) {
    const int K = D, N = D, ntn = N / 64, units = (M / 256) * ntn;
    for (int u = blockIdx.x; u < units; u += gridDim.x) {
        const int mt = u / ntn, nt = u % ntn, row0 = mt * 256 + c.wave * 32, n0 = nt * 64;
        f32x4 acc[2][4]; ZERO_ACC(acc);
        const int r = c.lane & 15;
        wave_gemm_32x64(A + (size_t)(row0 + r) * K, A + (size_t)(row0 + 16 + r) * K, Bt + (size_t)(n0 + r) * K, K, c.lane, acc);
        const int b = row0 / T;
#pragma unroll
        for (int mi = 0; mi < 2; ++mi)
#pragma unroll
            for (int n = 0; n < 4; ++n)
#pragma unroll
                for (int j = 0; j < 4; ++j) { const size_t o = (size_t)(row0 + 16 * mi + 4 * (c.lane >> 4) + j) * N + n0 + 16 * n + r;
                    X1[o] = xin[o] + gm[(size_t)b * 6 * D + n0 + 16 * n + r] * acc[mi][n][j]; }
    }
}

__device__ __forceinline__ void qknorm_chunk(bf16* p, const float* g) {
    float v[64]; float ss = 0.f;
#pragma unroll
    for (int i = 0; i < 8; ++i) { const u32x4 w = *(const u32x4*)(p + 8 * i);
#pragma unroll
        for (int j = 0; j < 4; ++j) { v[8 * i + 2 * j] = bf2f(w[j] & 0xffffu); v[8 * i + 2 * j + 1] = bf2f(w[j] >> 16); } }
#pragma unroll
    for (int i = 0; i < 64; ++i) ss += v[i] * v[i];
    const float rs = 1.f / sqrtf(ss * (1.f / 64.f) + RMS_EPS);
#pragma unroll
    for (int i = 0; i < 8; ++i) { u32x4 w;
#pragma unroll
        for (int j = 0; j < 4; ++j) w[j] = pk2(v[8 * i + 2 * j] * rs * g[8 * i + 2 * j], v[8 * i + 2 * j + 1] * rs * g[8 * i + 2 * j + 1]);
        *(u32x4*)(p + 8 * i) = w; }
}
__device__ __forceinline__ void qknorm0_phase(const Ctx& c, bf16* qkv, const float* gains  ) {
    const long total = (long)M * 50;
    for (long id = gtid_now(); id < total; id += c.gsz) {
        const int m = (int)(id / 50), k = (int)(id % 50); int ch, gi;
        if (k < 16) { ch = k; gi = 0; } else if (k < 32) { ch = k; gi = 1; } else if (k < 48) { ch = k + 16; gi = 2; } else { ch = k + 16; gi = 3; }
        qknorm_chunk(qkv + (size_t)m * AB_IN + 64 * ch, gains + 64 * gi);
    }
}
__device__ __forceinline__ void qknorm1_phase(const Ctx& c, bf16* qkv, const float* gains  ) {
    const long total = (long)M * 64;
    for (long id = gtid_now(); id < total; id += c.gsz) {
        const int m = (int)(id / 64), ch = (int)(id % 64);
        qknorm_chunk(qkv + (size_t)m * C_IN + 64 * ch, gains + 64 * (ch >> 5));
    }
}

__device__ __forceinline__ void load64(const bf16* p, float (&v)[64], float scale) {
#pragma unroll
    for (int i = 0; i < 8; ++i) { const u32x4 w = *(const u32x4*)(p + 8 * i);
#pragma unroll
        for (int j = 0; j < 4; ++j) { v[8 * i + 2 * j] = bf2f(w[j] & 0xffffu) * scale; v[8 * i + 2 * j + 1] = bf2f(w[j] >> 16) * scale; } }
}
__device__ __forceinline__ float dot64(const float (&q)[64], const bf16* kp) {
    float s0 = 0.f, s1 = 0.f;
#pragma unroll
    for (int i = 0; i < 8; ++i) { const u32x4 w = *(const u32x4*)(kp + 8 * i);
#pragma unroll
        for (int j = 0; j < 4; ++j) { s0 += q[8 * i + 2 * j] * bf2f(w[j] & 0xffffu); s1 += q[8 * i + 2 * j + 1] * bf2f(w[j] >> 16); } }
    return s0 + s1;
}
__device__ __forceinline__ void axpy64(float (&o)[64], float a, float p, const bf16* vp) {
#pragma unroll
    for (int i = 0; i < 8; ++i) { const u32x4 w = *(const u32x4*)(vp + 8 * i);
#pragma unroll
        for (int j = 0; j < 4; ++j) { o[8 * i + 2 * j] = o[8 * i + 2 * j] * a + p * bf2f(w[j] & 0xffffu); o[8 * i + 2 * j + 1] = o[8 * i + 2 * j + 1] * a + p * bf2f(w[j] >> 16); } }
}
__device__ __forceinline__ void store64_bf16(bf16* p, const float (&o)[64], float s) {
#pragma unroll
    for (int i = 0; i < 8; ++i) { u32x4 w;
#pragma unroll
        for (int j = 0; j < 4; ++j) w[j] = pk2(o[8 * i + 2 * j] * s, o[8 * i + 2 * j + 1] * s);
        *(u32x4*)(p + 8 * i) = w; }
}
__device__ __forceinline__ void attn0_phase(const Ctx& c, const bf16* qkv, const float* sinks, bf16* O) {
    const long total = (long)32 * M;
    for (long id = gtid_now(); id < total; id += c.gsz) {
        const int hh = (int)(id / M), m = (int)(id % M), b = m / T, t = m % T;
        float q[64], o[64];
#pragma unroll
        for (int i = 0; i < 64; ++i) o[i] = 0.f;
        float mx = -1e30f, l = 0.f;
        if (hh < 16) {
            const int h = hh; const float slope = exp2f(-0.5f * (float)(h + 1));
            load64(qkv + (size_t)m * AB_IN + 64 * h, q, 0.125f);
            const bf16* kb = qkv + (size_t)b * T * AB_IN + 1024 + 64 * h;
            for (int br = 0; br < 3; ++br) {
                const int dil = br == 0 ? 1 : (br == 1 ? 4 : 16);
                for (int j = 0; j <= 128; ++j) {
                    const int s = t - dil * j; if (s < 0) break;
                    const bf16* kp = kb + (size_t)s * AB_IN;
                    const float sc = dot64(q, kp) - slope * (float)(dil * j);
                    const float mn = fmaxf(mx, sc), a = __expf(mx - mn), p = __expf(sc - mn);
                    l = l * a + p; axpy64(o, a, p, kp + 1024); mx = mn;
                }
            }
            store64_bf16(O + (size_t)m * D + 64 * h, o, 1.f / l);
        } else {
            const int h = hh - 16, kvh = h >> 3; const float slope = exp2f(-0.5f * (float)(h + 1));
            load64(qkv + (size_t)m * AB_IN + 3072 + 64 * h, q, 0.125f);
            const bf16* kb = qkv + (size_t)b * T * AB_IN + 4096 + 64 * kvh;
            for (int j = 0; j < 128; ++j) {
                const int s = t - j; if (s < 0) break;
                const bf16* kp = kb + (size_t)s * AB_IN;
                const float sc = dot64(q, kp) - slope * (float)j;
                const float mn = fmaxf(mx, sc), a = __expf(mx - mn), p = __expf(sc - mn);
                l = l * a + p; axpy64(o, a, p, kp + 128); mx = mn;
            }
            const float sk = sinks[h], mn = fmaxf(mx, sk), a = __expf(mx - mn);
            l = l * a + __expf(sk - mn);
            store64_bf16(O + (size_t)m * D + 1024 + 64 * h, o, a / l);
        }
    }
}
__device__ __forceinline__ void attn1_phase(const Ctx& c, const bf16* qkv, float* tmp) {
    const int items = NB * 16 * 2 * 2 * (T / 64);
    for (int it = c.gw; it < items; it += c.ngw) {
        const int tb = (T / 64 - 1) - it / (NB * 16 * 4); const int r = it % (NB * 16 * 4);
        const int b = r / 64, h = (r / 4) % 16, i = (r >> 1) & 1, j = r & 1;
        const int t = tb * 64 + c.lane, m = b * T + t;
        const float slope = exp2f(-0.5f * (float)(h + 1));
        float q[64], o[64];
#pragma unroll
        for (int d = 0; d < 64; ++d) o[d] = 0.f;
        float mx = -1e30f, l = 0.f;
        load64(qkv + (size_t)m * C_IN + 128 * h + 64 * i, q, 0.125f);
        const bf16* kb = qkv + (size_t)b * T * C_IN + 2048 + 128 * h + 64 * i;
        const bf16* vb = qkv + (size_t)b * T * C_IN + 4096 + 128 * h + 64 * j;
        const int smax = tb * 64 + 63;
        for (int s = 0; s <= smax; ++s) {
            const bf16* kp = kb + (size_t)s * C_IN;
            float sc = dot64(q, kp) - slope * (float)(t - s);
            if (s > t) sc = -1e30f;
            const float mn = fmaxf(mx, sc), a = __expf(mx - mn), p = (s > t) ? 0.f : __expf(sc - mn);
            l = l * a + p; axpy64(o, a, p, vb + (size_t)s * C_IN); mx = mn;
        }
        float* op = tmp + (((size_t)m * 16 + h) * 2 + i) * 128 + 64 * j; const float il = 1.f / l;
#pragma unroll
        for (int d = 0; d < 16; ++d) *(f32x4*)(op + 4 * d) = (f32x4){o[4 * d] * il, o[4 * d + 1] * il, o[4 * d + 2] * il, o[4 * d + 3] * il};
    }
}
__device__ __forceinline__ void attn1_finish_phase(const Ctx& c, const float* tmp, const float* lamp  , const float* subln  , bf16* O) {
    float s01 = 0.f, s23 = 0.f;
    for (int i = 0; i < 64; ++i) { s01 += lamp[i] * lamp[64 + i]; s23 += lamp[128 + i] * lamp[192 + i]; }
    const float lam_init = 0.8f - 0.6f * expf(-0.3f * 1.0f);
    const float lam = expf(s01) - expf(s23) + lam_init;
    const long total = (long)M * 16;
    for (long id = gtid_now(); id < total; id += c.gsz) {
        const float* p1 = tmp + (size_t)id * 256; const float* p2 = p1 + 128;
        float ss = 0.f;
        for (int d = 0; d < 128; ++d) { const float v = p1[d] - lam * p2[d]; ss += v * v; }
        const float rs = (1.f - lam_init) / sqrtf(ss * (1.f / 128.f) + RMS_EPS);
        bf16* op = O + (size_t)id * 128;
        for (int d = 0; d < 128; d += 2) { const float v0 = (p1[d] - lam * p2[d]) * rs * subln[d], v1 = (p1[d + 1] - lam * p2[d + 1]) * rs * subln[d + 1];
            *(unsigned*)(op + d) = pk2(v0, v1); }
    }
}

__device__ __forceinline__ void router_phase(const Ctx& c, const float* x1, const float* g, const float* ada_l, const float* wr  , const float* rbias  ,
                                             bf16* HF, int* idx, float* gate, unsigned* counts) {
    LAS float* hb = (LAS float*)(c.lds + c.wave * 8192);
    const int lane = c.lane;
    for (int m = c.gw; m < M; m += c.ngw) {
        const int b = m / T; f32x4 v[8]; load_row(x1 + (size_t)m * D, lane, v);
        const float rstd = row_rstd(v);
        modulate_row(v, rstd, g, ada_l + (size_t)b * 6 * D + 3 * D, ada_l + (size_t)b * 6 * D + 4 * D, lane);
        store_row_bf16(HF + (size_t)m * D, v, lane);
#pragma unroll
        for (int j = 0; j < 8; ++j) *(LAS f32x4*)(hb + 4 * lane + 256 * j) = v[j];
        asm volatile("s_waitcnt lgkmcnt(0)" ::: "memory");
        float a0 = 0.f, a1 = 0.f, a2 = 0.f, a3 = 0.f;
        for (int k = 0; k < D; k += 4) {
            const f32x4 hv = *(const LAS f32x4*)(hb + k);
            a0 += hv.x * wr[(size_t)(k + 0) * 64 + lane]; a1 += hv.y * wr[(size_t)(k + 1) * 64 + lane];
            a2 += hv.z * wr[(size_t)(k + 2) * 64 + lane]; a3 += hv.w * wr[(size_t)(k + 3) * 64 + lane];
        }
        const float logit = (a0 + a1) + (a2 + a3);
        const float score = 1.f / (1.f + expf(-logit));
        const float sel = score + rbias[lane];
        float m1 = sel;
        m1 = fmaxf(m1, __shfl_xor(m1, 1)); m1 = fmaxf(m1, __shfl_xor(m1, 2)); m1 = fmaxf(m1, __shfl_xor(m1, 4));
        const unsigned long long eqm = __ballot(sel == m1);
        const int gbase = lane & ~7;
        const unsigned grp_eq = (unsigned)((eqm >> gbase) & 0xffull);
        const int first = __builtin_ctz(grp_eq);
        float m2 = ((lane & 7) == first) ? -3e38f : sel;
        m2 = fmaxf(m2, __shfl_xor(m2, 1)); m2 = fmaxf(m2, __shfl_xor(m2, 2)); m2 = fmaxf(m2, __shfl_xor(m2, 4));
        const float gs = m1 + m2;
        int grank = 0; const int mygrp = lane >> 3;
#pragma unroll
        for (int g2 = 0; g2 < 8; ++g2) { const float o = __shfl(gs, g2 * 8); grank += (o > gs || (o == gs && g2 < mygrp)) ? 1 : 0; }
        const float msel = (grank < 4) ? sel : -1e30f;
        int rank = 0;
        for (int e2 = 0; e2 < 64; ++e2) { const float o = __shfl(msel, e2); rank += (o > msel || (o == msel && e2 < lane)) ? 1 : 0; }
        const bool chosen = rank < TOPK;
        const float gsum = wave_sum(chosen ? score : 0.f);
        if (chosen) { idx[(size_t)m * 8 + rank] = lane; gate[(size_t)m * 8 + rank] = score / gsum * 2.5f;
            __hip_atomic_fetch_add(counts + lane, 1u, __ATOMIC_RELAXED, __HIP_MEMORY_SCOPE_AGENT); }
    }
}
__device__ __forceinline__ void slot_phase(const Ctx& c, const int* idx, const unsigned* counts, unsigned* cursor, unsigned* nrt_out, int* pos, int* slot_tok, int* tile_exp) {
    LAS int* ps = (LAS int*)c.lds;
    if (c.tid == 0) { int acc = 0; for (int e = 0; e < NE; ++e) { const int cn = (int)counts[e]; ps[e] = acc; ps[64 + e] = cn; acc += (cn + 255) / 256 * 256; } ps[128] = acc; }
    __syncthreads();
    for (int a = gtid_now(); a < M * TOPK; a += c.gsz) {
        const int e = idx[a]; const unsigned r = __hip_atomic_fetch_add(cursor + e, 1u, __ATOMIC_RELAXED, __HIP_MEMORY_SCOPE_AGENT);
        const int slot = ps[e] + (int)r; slot_tok[slot] = a >> 3; pos[a] = slot;
    }
    for (int t = gtid_now(); t < M; t += c.gsz) slot_tok[CAPR + t] = t;
    if (blockIdx.x == 0) {
        if (c.tid < NE) { const int e = c.tid, s0 = ps[e], cn = ps[64 + e], pe = s0 + (cn + 255) / 256 * 256;
            for (int s = s0 + cn; s < pe; ++s) slot_tok[s] = 0;
            for (int tt = s0 / 256; tt < pe / 256; ++tt) tile_exp[tt] = e; }
        if (c.tid == 0) *nrt_out = (unsigned)(ps[128] / 256);
    }
    __syncthreads();
}
__device__ __forceinline__ void moe_up_phase(const Ctx& c, const bf16* HF, const bf16* Wup_l  , const int* slot_tok, const int* tile_exp, const unsigned* nrt_p, bf16* ACT) {
    const int nrt = (int)*nrt_p, ntiles = nrt + M / 256, units = ntiles * (ED / 64);
    for (int u = blockIdx.x; u < units; u += gridDim.x) {
        const int mt = u / (ED / 64), nt = u % (ED / 64), n0 = nt * 64;
        const int e = mt < nrt ? tile_exp[mt] : NE; const int slot0 = (mt < nrt ? mt * 256 : CAPR + (mt - nrt) * 256) + c.wave * 32;
        const int r = c.lane & 15;
        const bf16* a0 = HF + (size_t)slot_tok[slot0 + r] * D; const bf16* a1 = HF + (size_t)slot_tok[slot0 + 16 + r] * D;
        const bf16* W = Wup_l + (size_t)e * UPN * D;
        f32x4 ag[2][4], au[2][4]; ZERO_ACC(ag); ZERO_ACC(au);
        wave_gemm_32x64(a0, a1, W + (size_t)(n0 + r) * D, D, c.lane, ag);
        wave_gemm_32x64(a0, a1, W + (size_t)(ED + n0 + r) * D, D, c.lane, au);
#pragma unroll
        for (int mi = 0; mi < 2; ++mi)
#pragma unroll
            for (int n = 0; n < 4; ++n)
#pragma unroll
                for (int j = 0; j < 4; ++j) ACT[(size_t)(slot0 + 16 * mi + 4 * (c.lane >> 4) + j) * ED + n0 + 16 * n + r] = (bf16)f2bf(siluf(ag[mi][n][j]) * au[mi][n][j]);
    }
}
__device__ __forceinline__ void moe_down_phase(const Ctx& c, const bf16* ACT, const bf16* Wdn_l  , const int* tile_exp, const unsigned* nrt_p, bf16* Y) {
    const int nrt = (int)*nrt_p, ntiles = nrt + M / 256, units = ntiles * (D / 64);
    for (int u = blockIdx.x; u < units; u += gridDim.x) {
        const int mt = u / (D / 64), nt = u % (D / 64), n0 = nt * 64;
        const int e = mt < nrt ? tile_exp[mt] : NE; const int slot0 = (mt < nrt ? mt * 256 : CAPR + (mt - nrt) * 256) + c.wave * 32;
        const int r = c.lane & 15;
        const bf16* W = Wdn_l + (size_t)e * D * ED;
        f32x4 acc[2][4]; ZERO_ACC(acc);
        wave_gemm_32x64(ACT + (size_t)(slot0 + r) * ED, ACT + (size_t)(slot0 + 16 + r) * ED, W + (size_t)(n0 + r) * ED, ED, c.lane, acc);
#pragma unroll
        for (int mi = 0; mi < 2; ++mi)
#pragma unroll
            for (int n = 0; n < 4; ++n)
#pragma unroll
                for (int j = 0; j < 4; ++j) Y[(size_t)(slot0 + 16 * mi + 4 * (c.lane >> 4) + j) * D + n0 + 16 * n + r] = (bf16)f2bf(acc[mi][n][j]);
    }
}
__device__ __forceinline__ void add_row_bf16(f32x4 (&acc)[8], const bf16* yrow, float w, int lane) {
#pragma unroll
    for (int j = 0; j < 8; ++j) { const u32x2 v = *(const u32x2*)(yrow + 4 * lane + 256 * j);
        acc[j].x += w * bf2f(v.x & 0xffffu); acc[j].y += w * bf2f(v.x >> 16); acc[j].z += w * bf2f(v.y & 0xffffu); acc[j].w += w * bf2f(v.y >> 16); }
}
__device__ __forceinline__ void add_row_fp8(f32x4 (&acc)[8], const unsigned char* yrow, float w, int lane) {
#pragma unroll
    for (int j = 0; j < 8; ++j) { const unsigned v = *(const unsigned*)(yrow + 4 * lane + 256 * j);
        acc[j].x += w * __builtin_amdgcn_cvt_f32_fp8(v, 0); acc[j].y += w * __builtin_amdgcn_cvt_f32_fp8(v, 1); acc[j].z += w * __builtin_amdgcn_cvt_f32_fp8(v, 2); acc[j].w += w * __builtin_amdgcn_cvt_f32_fp8(v, 3); }
}
template <bool NEXT>
__device__ __forceinline__ void combine_phase(const Ctx& c, const float* x1, const bf16* Y, const int* pos, const float* gate, const float* ada_l, float* xo,
                                              const float* gnext, const float* ada_next, bf16* XN) {
    for (int m = c.gw; m < M; m += c.ngw) {
        const int b = m / T; f32x4 acc[8];
#pragma unroll
        for (int j = 0; j < 8; ++j) acc[j] = (f32x4){0.f, 0.f, 0.f, 0.f};
#if USE_FP8_MOE && Y_FP8
        for (int k = 0; k < TOPK; ++k) add_row_fp8(acc, (const unsigned char*)Y + (size_t)pos[(size_t)m * 8 + k] * D, gate[(size_t)m * 8 + k] * (1.f / F8_YSCALE), c.lane);
        add_row_fp8(acc, (const unsigned char*)Y + (size_t)(CAPR + m) * D, 1.f / F8_YSCALE, c.lane);
#else
        for (int k = 0; k < TOPK; ++k) add_row_bf16(acc, Y + (size_t)pos[(size_t)m * 8 + k] * D, gate[(size_t)m * 8 + k], c.lane);
        add_row_bf16(acc, Y + (size_t)(CAPR + m) * D, 1.f, c.lane);
#endif
        const float* gf = ada_l + (size_t)b * 6 * D + 5 * D;
        f32x4 v[8];
#pragma unroll
        for (int j = 0; j < 8; ++j) { const int col = 4 * c.lane + 256 * j;
#if RES_BF16
            { const u32x2 xw = *(const u32x2*)((const bf16*)x1 + (size_t)m * D + col);
              v[j] = (f32x4){bf2f(xw.x & 0xffffu), bf2f(xw.x >> 16), bf2f(xw.y & 0xffffu), bf2f(xw.y >> 16)} + *(const f32x4*)(gf + col) * acc[j]; }
            if (NEXT) { u32x2 ow; ow.x = pk2(v[j].x, v[j].y); ow.y = pk2(v[j].z, v[j].w); *(u32x2*)((bf16*)xo + (size_t)m * D + col) = ow; }
            else *(f32x4*)(xo + (size_t)m * D + col) = v[j];
#else
            v[j] = *(const f32x4*)(x1 + (size_t)m * D + col) + *(const f32x4*)(gf + col) * acc[j];
            *(f32x4*)(xo + (size_t)m * D + col) = v[j];
#endif
            }
        if (NEXT) {
            const float rstd = row_rstd(v);
            modulate_row(v, rstd, gnext, ada_next + (size_t)b * 6 * D, ada_next + (size_t)b * 6 * D + D, c.lane);
#if USE_FP8_QKV
            store_row_fp8((unsigned char*)XN + (size_t)m * D, v, c.lane, F8_HSCALE);
#else
            store_row_bf16(XN + (size_t)m * D, v, c.lane);
#endif
        }
    }
}


namespace pg8 {
constexpr int BM = 256, BK = 64, HALF = 128, HTB = HALF * BK * 2, STAGE_BYTES = 8 * HTB, NXCD = 8, WGM = 8;
__device__ __forceinline__ int lds_byte(int r, int c) { const int st = (r >> 4) * 2 + (c >> 5), rr = r & 15, cc = c & 31, ob = rr * 64 + cc * 2; return st * 1024 + (ob ^ (((ob >> 9) & 1) << 5)); }
__device__ __forceinline__ void stage_rc(int b, int& R, int& C) { const int st = b / 1024, sb = b % 1024, swz = sb ^ (((sb >> 9) & 1) << 5); R = (st >> 1) * 16 + swz / 64; C = (st & 1) * 32 + (swz % 64) / 2; }
__device__ __forceinline__ int perm32(int rho) { const int n = rho >> 4, i = rho & 15; return 8 * (i >> 2) + 4 * n + (i & 3); }
__device__ __forceinline__ unsigned cvt_pk_bf16(float lo, float hi) { unsigned r; asm volatile("v_cvt_pk_bf16_f32 %0, %1, %2" : "=v"(r) : "v"(lo), "v"(hi)); return r; }

struct Unit { int row0, pn; const char* Bp; };

struct TileOrder {
    int nM, nN, nwg, G, c;
    __device__ __forceinline__ void init(int nM_, int nN_, int G_, int c_) { nM = nM_; nN = nN_; nwg = nM * nN; G = G_; c = c_; }
    __device__ __forceinline__ bool tile(int i, int& pm, int& pn) const {
        const long L = (long)i * G + c; if (L >= nwg) return false;
        int wgid = (int)L; { const int q = nwg / NXCD, r = nwg % NXCD, xcd = wgid % NXCD, off = wgid / NXCD; wgid = (xcd < r ? xcd * (q + 1) : r * (q + 1) + (xcd - r) * q) + off; }
        const int nig = WGM * nN, gid = wgid / nig, fm = gid * WGM, gsz = (nM - fm) < WGM ? (nM - fm) : WGM;
        pm = fm + ((wgid % nig) % gsz); pn = (wgid % nig) / gsz; return true;
    }
};
struct PlainSched {
    static constexpr bool GATHER = false;
    TileOrder o; const char* Bt; int K;
    __device__ __forceinline__ bool next(int i, Unit& u) const { int pm, pn; if (!o.tile(i, pm, pn)) return false; u.row0 = pm * BM; u.pn = pn; u.Bp = Bt + (size_t)pn * BM * K * 2; return true; }
    __device__ __forceinline__ unsigned arow_off(const Unit& u, int rl) const { return (unsigned)(u.row0 + rl) * (unsigned)(K * 2); }
};
template <bool GATHER_> struct GroupSched {
    static constexpr bool GATHER = GATHER_;
    TileOrder o; const char* W; size_t wstride; int K, nrt; const LAS int* tile_exp; const int* slot_tok;
    __device__ __forceinline__ bool next(int i, Unit& u) const { int pm, pn; if (!o.tile(i, pm, pn)) return false;
        const int e = pm < nrt ? tile_exp[pm] : NE; u.row0 = pm < nrt ? pm * BM : CAPR + (pm - nrt) * BM; u.pn = pn; u.Bp = W + (size_t)e * wstride + (size_t)pn * BM * K * 2; return true; }
    __device__ __forceinline__ unsigned arow_off(const Unit& u, int rl) const { const int r = GATHER ? slot_tok[u.row0 + rl] : (u.row0 + rl); return (unsigned)r * (unsigned)(K * 2); }
};

template <int LAYER> struct EpiQKV {
    static constexpr bool PERM = true;
    bf16* O; int ldc; const float* gains; float qscale, ascale;
    __device__ __forceinline__ void operator()(const f32x4 (&acc)[2][2][4][2], const Unit& u, int wr, int wc, int fr, int fq) const {
        const int head = 4 * u.pn + wc; int gi;
        if (LAYER == 0) gi = head < 16 ? 0 : head < 32 ? 1 : head < 48 ? -1 : head < 64 ? 2 : head < 66 ? 3 : -1;
        else gi = head < 32 ? 0 : head < 64 ? 1 : -1;
        f32x4 gv[2][2];
#pragma unroll
        for (int bj = 0; bj < 2; ++bj)
#pragma unroll
            for (int n = 0; n < 2; ++n) gv[bj][n] = gi >= 0 ? *(const f32x4*)(gains + 64 * gi + 32 * bj + 8 * fq + 4 * n) : (f32x4){1.f, 1.f, 1.f, 1.f};
#if QKV_HEADMAJOR
        bf16* base = O + ((size_t)head * M + (size_t)(u.row0 + wr * 64 + fr)) * 64 + 8 * fq; const int ldo = 64;
#else
        bf16* base = O + (size_t)(u.row0 + wr * 64 + fr) * ldc + 64 * head + 8 * fq; const int ldo = ldc;
#endif
#pragma unroll
        for (int ai = 0; ai < 2; ++ai)
#pragma unroll
            for (int m = 0; m < 4; ++m) {
                float ss = 0.f;
#pragma unroll
                for (int bj = 0; bj < 2; ++bj)
#pragma unroll
                    for (int n = 0; n < 2; ++n) { const f32x4 x = acc[ai][bj][m][n]; ss += (x[0] * x[0] + x[1] * x[1]) + (x[2] * x[2] + x[3] * x[3]); }
                ss += __shfl_xor(ss, 16); ss += __shfl_xor(ss, 32); ss *= ascale * ascale;
                const bool isq = LAYER == 0 ? (gi == 0 || gi == 2) : (gi == 0);
                const float rs = ascale * (gi >= 0 ? (isq ? qscale : 1.f) / sqrtf(ss * (1.f / 64.f) + RMS_EPS) : 1.f);
                bf16* rowp = base + (size_t)(ai * HALF + m * 16) * ldo;
#pragma unroll
                for (int bj = 0; bj < 2; ++bj) { const f32x4 v0 = acc[ai][bj][m][0] * rs * gv[bj][0], v1 = acc[ai][bj][m][1] * rs * gv[bj][1];
                    u32x4 w; w.x = cvt_pk_bf16(v0[0], v0[1]); w.y = cvt_pk_bf16(v0[2], v0[3]); w.z = cvt_pk_bf16(v1[0], v1[1]); w.w = cvt_pk_bf16(v1[2], v1[3]);
                    *(u32x4*)(rowp + 32 * bj) = w; }
            }
    }
};
struct EpiOut {
    static constexpr bool PERM = false;
    const float* xin; const float* gm; float* X1;
    __device__ __forceinline__ void operator()(const f32x4 (&acc)[2][2][4][2], const Unit& u, int wr, int wc, int fr, int fq) const {
        const int col0 = u.pn * BM + wc * 32 + 4 * fq; const float* g = gm + (size_t)(u.row0 / T) * 6 * D + col0;
        f32x4 gv[2][2];
#pragma unroll
        for (int bj = 0; bj < 2; ++bj)
#pragma unroll
            for (int n = 0; n < 2; ++n) gv[bj][n] = *(const f32x4*)(g + bj * HALF + n * 16);
#pragma unroll
        for (int ai = 0; ai < 2; ++ai)
#pragma unroll
            for (int m = 0; m < 4; ++m) { const size_t off = (size_t)(u.row0 + wr * 64 + fr + ai * HALF + m * 16) * D + col0;
#pragma unroll
                for (int bj = 0; bj < 2; ++bj)
#pragma unroll
                    for (int n = 0; n < 2; ++n) *(f32x4*)(X1 + off + bj * HALF + n * 16) = *(const f32x4*)(xin + off + bj * HALF + n * 16) + gv[bj][n] * acc[ai][bj][m][n]; }
    }
};

template <bool XIN_BF16> struct EpiOutB {
    static constexpr bool PERM = true;
    const void* xin; const float* gm; bf16* X1b;
    __device__ __forceinline__ void operator()(const f32x4 (&acc)[2][2][4][2], const Unit& u, int wr, int wc, int fr, int fq) const {
        const int col0 = u.pn * BM + wc * 32 + 8 * fq; const float* g = gm + (size_t)(u.row0 / T) * 6 * D + col0;
        f32x4 gv[2][2];
#pragma unroll
        for (int bj = 0; bj < 2; ++bj)
#pragma unroll
            for (int n = 0; n < 2; ++n) gv[bj][n] = *(const f32x4*)(g + bj * HALF + 4 * n);
#pragma unroll
        for (int ai = 0; ai < 2; ++ai)
#pragma unroll
            for (int m = 0; m < 4; ++m) { const size_t off = (size_t)(u.row0 + wr * 64 + fr + ai * HALF + m * 16) * D + col0;
#pragma unroll
                for (int bj = 0; bj < 2; ++bj) { f32x4 x0, x1v;
                    if (XIN_BF16) { const u32x4 xw = *(const u32x4*)((const bf16*)xin + off + bj * HALF);
                        x0 = (f32x4){bf2f(xw.x & 0xffffu), bf2f(xw.x >> 16), bf2f(xw.y & 0xffffu), bf2f(xw.y >> 16)}; x1v = (f32x4){bf2f(xw.z & 0xffffu), bf2f(xw.z >> 16), bf2f(xw.w & 0xffffu), bf2f(xw.w >> 16)}; }
                    else { x0 = *(const f32x4*)((const float*)xin + off + bj * HALF); x1v = *(const f32x4*)((const float*)xin + off + bj * HALF + 4); }
                    const f32x4 v0 = x0 + gv[bj][0] * acc[ai][bj][m][0], v1 = x1v + gv[bj][1] * acc[ai][bj][m][1];
                    u32x4 w; w.x = cvt_pk_bf16(v0[0], v0[1]); w.y = cvt_pk_bf16(v0[2], v0[3]); w.z = cvt_pk_bf16(v1[0], v1[1]); w.w = cvt_pk_bf16(v1[2], v1[3]);
                    *(u32x4*)(X1b + off + bj * HALF) = w; } }
    }
};
__device__ __forceinline__ float silu_fast(float x) { return x * __builtin_amdgcn_rcpf(1.f + __builtin_amdgcn_exp2f(-1.4426950408889634f * x)); }
struct EpiUp {
    static constexpr bool PERM = true;
    bf16* ACT;
    __device__ __forceinline__ void operator()(const f32x4 (&acc)[2][2][4][2], const Unit& u, int wr, int wc, int fr, int fq) const {
        bf16* base = ACT + (size_t)(u.row0 + wr * 64 + fr) * ED + 128 * u.pn + 32 * wc + 8 * fq;
#pragma unroll
        for (int ai = 0; ai < 2; ++ai)
#pragma unroll
            for (int m = 0; m < 4; ++m) { f32x4 v[2];
#pragma unroll
                for (int n = 0; n < 2; ++n)
#pragma unroll
                    for (int i = 0; i < 4; ++i) v[n][i] = silu_fast(acc[ai][0][m][n][i]) * acc[ai][1][m][n][i];
                u32x4 w; w.x = cvt_pk_bf16(v[0][0], v[0][1]); w.y = cvt_pk_bf16(v[0][2], v[0][3]); w.z = cvt_pk_bf16(v[1][0], v[1][1]); w.w = cvt_pk_bf16(v[1][2], v[1][3]);
                *(u32x4*)(base + (size_t)(ai * HALF + m * 16) * ED) = w; }
    }
};
struct EpiDown {
    static constexpr bool PERM = true;
    bf16* Y; int orow = 0;
    __device__ __forceinline__ void operator()(const f32x4 (&acc)[2][2][4][2], const Unit& u, int wr, int wc, int fr, int fq) const {
        bf16* base = Y + (size_t)(orow + u.row0 + wr * 64 + fr) * D + u.pn * BM + wc * 32 + 8 * fq;
#pragma unroll
        for (int ai = 0; ai < 2; ++ai)
#pragma unroll
            for (int m = 0; m < 4; ++m) { bf16* rowp = base + (size_t)(ai * HALF + m * 16) * D;
#pragma unroll
                for (int bj = 0; bj < 2; ++bj) { const f32x4 v0 = acc[ai][bj][m][0], v1 = acc[ai][bj][m][1];
                    u32x4 w; w.x = cvt_pk_bf16(v0[0], v0[1]); w.y = cvt_pk_bf16(v0[2], v0[3]); w.z = cvt_pk_bf16(v1[0], v1[1]); w.w = cvt_pk_bf16(v1[2], v1[3]);
                    *(u32x4*)(rowp + bj * HALF) = w; } }
    }
};


struct EpiUp8 {
    static constexpr bool PERM = true;
    unsigned char* ACT8;
    __device__ __forceinline__ void operator()(const f32x4 (&acc)[2][2][4][2], const Unit& u, int wr, int wc, int fr, int fq) const {
        unsigned char* base = ACT8 + (size_t)(u.row0 + wr * 64 + fr) * ED + 128 * u.pn + 32 * wc + 8 * fq;
        constexpr float s = 1.f / (F8_HSCALE * F8_WSCALE);
#pragma unroll
        for (int ai = 0; ai < 2; ++ai)
#pragma unroll
            for (int m = 0; m < 4; ++m) { f32x4 v[2];
#pragma unroll
                for (int n = 0; n < 2; ++n)
#pragma unroll
                    for (int i = 0; i < 4; ++i) v[n][i] = silu_fast(acc[ai][0][m][n][i] * s) * (acc[ai][1][m][n][i] * (s * F8_ASCALE));
                u32x2 w; w.x = pk4_fp8(v[0][0], v[0][1], v[0][2], v[0][3]); w.y = pk4_fp8(v[1][0], v[1][1], v[1][2], v[1][3]);
                *(u32x2*)(base + (size_t)(ai * HALF + m * 16) * ED) = w; }
    }
};
struct EpiDown8 {
    static constexpr bool PERM = true;
    bf16* Y;
    __device__ __forceinline__ void operator()(const f32x4 (&acc)[2][2][4][2], const Unit& u, int wr, int wc, int fr, int fq) const {
#if Y_FP8
        unsigned char* base = (unsigned char*)Y + (size_t)(u.row0 + wr * 64 + fr) * D + u.pn * BM + wc * 32 + 8 * fq;
        constexpr float s = F8_YSCALE / (F8_ASCALE * F8_WSCALE);
#pragma unroll
        for (int ai = 0; ai < 2; ++ai)
#pragma unroll
            for (int m = 0; m < 4; ++m) { unsigned char* rowp = base + (size_t)(ai * HALF + m * 16) * D;
#pragma unroll
                for (int bj = 0; bj < 2; ++bj) { const f32x4 v0 = acc[ai][bj][m][0] * s, v1 = acc[ai][bj][m][1] * s;
                    u32x2 w; w.x = pk4_fp8(v0[0], v0[1], v0[2], v0[3]); w.y = pk4_fp8(v1[0], v1[1], v1[2], v1[3]);
                    *(u32x2*)(rowp + bj * HALF) = w; } }
#else
        bf16* base = Y + (size_t)(u.row0 + wr * 64 + fr) * D + u.pn * BM + wc * 32 + 8 * fq;
        constexpr float s = 1.f / (F8_ASCALE * F8_WSCALE);
#pragma unroll
        for (int ai = 0; ai < 2; ++ai)
#pragma unroll
            for (int m = 0; m < 4; ++m) { bf16* rowp = base + (size_t)(ai * HALF + m * 16) * D;
#pragma unroll
                for (int bj = 0; bj < 2; ++bj) { const f32x4 v0 = acc[ai][bj][m][0] * s, v1 = acc[ai][bj][m][1] * s;
                    u32x4 w; w.x = cvt_pk_bf16(v0[0], v0[1]); w.y = cvt_pk_bf16(v0[2], v0[3]); w.z = cvt_pk_bf16(v1[0], v1[1]); w.w = cvt_pk_bf16(v1[2], v1[3]);
                    *(u32x4*)(rowp + bj * HALF) = w; } }
#endif
    }
};
__device__ __forceinline__ void glds16s(const void* sbase, unsigned voff, unsigned lds_dst) { unsigned keep;
    asm volatile("s_mov_b32 %0, m0\n\ts_mov_b32 m0, %3\n\ts_nop 0\n\tglobal_load_lds_dwordx4 %1, %2\n\ts_mov_b32 m0, %0" : "=&s"(keep) : "v"(voff), "s"(sbase), "s"(lds_dst) : "memory"); }
__device__ __forceinline__ void glds4s(const void* sbase, unsigned voff, unsigned lds_dst) { unsigned keep;
    asm volatile("s_mov_b32 %0, m0\n\ts_mov_b32 m0, %3\n\ts_nop 0\n\tglobal_load_lds_dword %1, %2\n\ts_mov_b32 m0, %0" : "=&s"(keep) : "v"(voff), "s"(sbase), "s"(lds_dst) : "memory"); }
typedef int i32x4 __attribute__((ext_vector_type(4)));
typedef int i32x8 __attribute__((ext_vector_type(8)));
__device__ __forceinline__ i32x8 cat8(bf16x8 a, bf16x8 b) { return __builtin_shufflevector(__builtin_bit_cast(i32x4, a), __builtin_bit_cast(i32x4, b), 0, 1, 2, 3, 4, 5, 6, 7); }
__device__ __forceinline__ void mfma8_inplace(f32x4& acc, i32x8 a, i32x8 b) { asm volatile("v_mfma_f32_16x16x128_f8f6f4 %0, %1, %2, %0" : "+v"(acc) : "v"(a), "v"(b)); }
template <class Epi, class Sched, bool FP8 = false>
__device__ __forceinline__ void gemm_phase(LAS unsigned char* lds, const char* Abase, const int K, const Sched& S, const Epi& E) {
    constexpr bool GATHER = Sched::GATHER;
    const int tid = threadIdx.x, wid = __builtin_amdgcn_readfirstlane(tid >> 6), lane = tid & 63, wr = wid >> 2, wc = wid & 3, fr = lane & 15, fq = lane >> 4;
    int nt = K / BK; asm volatile("" : "+s"(nt));
    int RA[2]; unsigned CA[2], voffB[2], vC[2];
#pragma unroll
    for (int i = 0; i < 2; ++i) { int R, C; stage_rc(tid * 16 + i * 8192, R, C); const int Rb = Epi::PERM ? ((R & ~31) + perm32(R & 31)) : R;
        RA[i] = R; CA[i] = (unsigned)C * 2u; voffB[i] = (unsigned)(Rb * K + C) * 2u; vC[i] = (unsigned)(R * K + C) * 2u; }
    const size_t kstep = (size_t)(BK * 2);
    const size_t hstep = (size_t)HALF * K * 2;
    const size_t ahstep = GATHER ? 0 : hstep;
    const unsigned ldsw = (unsigned)wid * 1024u;
    const unsigned lds0 = (unsigned)(uintptr_t)lds;
    const int aoff = lds_byte(wr * 64 + fr, fq * 8), boff = lds_byte(wc * 32 + fr, fq * 8);
#define PG8_SA(b, h) (((b) * 2 + (h)) * HTB)
#define PG8_SB(b, h) ((4 + (b) * 2 + (h)) * HTB)
#define PG8_STAGE(bufoff, gbase, voff) do { _Pragma("unroll") for (int _i = 0; _i < 2; ++_i) \
        glds16s((const void*)(gbase), (voff)[_i], (unsigned)__builtin_amdgcn_readfirstlane((int)(lds0 + (unsigned)(bufoff) + ldsw + (unsigned)(_i * 8192)))); } while (0)
#define PG8_STAGE_A(bufoff, gbase, h) do { if constexpr (GATHER) { PG8_STAGE(bufoff, gbase, vA[h]); } else { PG8_STAGE(bufoff, (gbase) + (h) * ahstep, vC); } } while (0)
#define PG8_LDA(dst, b, h) do { _Pragma("unroll") for (int m = 0; m < 4; ++m) _Pragma("unroll") for (int k = 0; k < 2; ++k) dst[m][k] = *(const LAS bf16x8*)(lds + PG8_SA(b, h) + aoff + m * 2048 + k * 1024); } while (0)
#define PG8_LDB(dst, b, h) do { _Pragma("unroll") for (int n = 0; n < 2; ++n) _Pragma("unroll") for (int k = 0; k < 2; ++k) dst[n][k] = *(const LAS bf16x8*)(lds + PG8_SB(b, h) + boff + n * 2048 + k * 1024); } while (0)
#define PG8_MMA(ai, bj, At, Bt) do { __builtin_amdgcn_s_setprio(1); if constexpr (FP8) { _Pragma("unroll") for (int m = 0; m < 4; ++m) _Pragma("unroll") for (int n = 0; n < 2; ++n) \
        mfma8_inplace(acc[ai][bj][m][n], cat8(Bt[n][0], Bt[n][1]), cat8(At[m][0], At[m][1])); } else { \
        _Pragma("unroll") for (int m = 0; m < 4; ++m) _Pragma("unroll") for (int n = 0; n < 2; ++n) _Pragma("unroll") for (int k = 0; k < 2; ++k) \
        acc[ai][bj][m][n] = __builtin_amdgcn_mfma_f32_16x16x32_bf16(Bt[n][k], At[m][k], acc[ai][bj][m][n], 0, 0, 0); } __builtin_amdgcn_s_setprio(0); } while (0)
#define PG8_WAIT_V(n) asm volatile("s_waitcnt vmcnt(" #n ")" ::: "memory")
#define PG8_WAIT_L(n) asm volatile("s_waitcnt lgkmcnt(0)" ::: "memory")
#define PG8_BAR __builtin_amdgcn_s_barrier()
#define PG8_SCHED __builtin_amdgcn_sched_barrier(0)
#define PG8_SETOFF(vo, u) do { _Pragma("unroll") for (int _h = 0; _h < 2; ++_h) _Pragma("unroll") for (int _i = 0; _i < 2; ++_i) vo[_h][_i] = S.arow_off(u, _h * HALF + RA[_i]) + CA[_i]; } while (0)
    Unit cur, nxt; int ui = 0;
    if (!S.next(0, cur)) return;
    f32x4 acc[2][2][4][2];
#pragma unroll
    for (int a = 0; a < 2; ++a)
#pragma unroll
        for (int b = 0; b < 2; ++b)
#pragma unroll
            for (int m = 0; m < 4; ++m)
#pragma unroll
                for (int n = 0; n < 2; ++n) acc[a][b][m][n] = (f32x4){0.f, 0.f, 0.f, 0.f};
    bf16x8 At[4][2], B0[2][2], B1[2][2];
    unsigned vA[2][2];
    LAS int* gidx = (LAS int*)(lds + STAGE_BYTES);
#define PG8_IDX_DMA(u) do { if (wid < 4) glds4s((const void*)(S.slot_tok + (u).row0), (unsigned)((wid * 64 + lane) * 4), (unsigned)__builtin_amdgcn_readfirstlane((int)(lds0 + (unsigned)STAGE_BYTES + (unsigned)wid * 256u))); } while (0)
#define PG8_IDX_READ() do { _Pragma("unroll") for (int _h = 0; _h < 2; ++_h) _Pragma("unroll") for (int _i = 0; _i < 2; ++_i) vA[_h][_i] = (unsigned)gidx[_h * HALF + RA[_i]] * (unsigned)(K * 2) + CA[_i]; } while (0)
    if constexpr (GATHER) { PG8_IDX_DMA(cur); asm volatile("s_waitcnt vmcnt(0)" ::: "memory"); __builtin_amdgcn_s_barrier(); asm volatile("" ::: "memory"); PG8_IDX_READ();
        asm volatile("s_waitcnt lgkmcnt(0)" ::: "memory"); __builtin_amdgcn_s_barrier(); asm volatile("" ::: "memory"); }
    const char* cA = GATHER ? Abase : Abase + (size_t)cur.row0 * K * 2;
    const char* cB = cur.Bp;
    PG8_STAGE(PG8_SB(0, 0), cB, voffB); PG8_STAGE(PG8_SB(0, 1), cB + hstep, voffB); PG8_STAGE_A(PG8_SA(0, 0), cA, 0); PG8_STAGE_A(PG8_SA(0, 1), cA, 1);
    if (wr == 1) PG8_BAR;
    PG8_WAIT_V(2); PG8_BAR;
    PG8_STAGE(PG8_SB(1, 0), cB + kstep, voffB); PG8_STAGE_A(PG8_SA(1, 0), cA + kstep, 0); PG8_STAGE(PG8_SB(1, 1), cB + hstep + kstep, voffB);
    PG8_WAIT_V(6); PG8_BAR;
    for (;;) {
        const bool has_next = S.next(ui + 1, nxt);
        if constexpr (GATHER) { if (has_next) PG8_IDX_DMA(nxt); }
        const char* nA = GATHER ? Abase : (has_next ? Abase + (size_t)nxt.row0 * K * 2 : cA);
        const char* nB = has_next ? nxt.Bp : cB;
#pragma unroll 1
        for (int t = 0; t < nt; t += 2) {
            const bool last = (t == nt - 2);
            const char* a1 = cA + (size_t)(t + 1) * kstep;
            const char* a2 = last ? nA : cA + (size_t)(t + 2) * kstep; const char* b2 = last ? nB : cB + (size_t)(t + 2) * kstep;
            const char* a3 = a2 + kstep; const char* b3 = b2 + kstep;
            PG8_LDB(B0, 0, 0); PG8_LDB(B1, 0, 1); PG8_SCHED; PG8_LDA(At, 0, 0); PG8_STAGE_A(PG8_SA(1, 1), a1, 1);
            if constexpr (GATHER) { if (last && has_next) PG8_IDX_READ(); }
            PG8_WAIT_V(8); PG8_WAIT_L(0); PG8_BAR; PG8_MMA(0, 0, At, B0); PG8_MMA(0, 1, At, B1); PG8_BAR; PG8_SCHED;
            PG8_LDA(At, 0, 1); PG8_STAGE(PG8_SB(0, 0), b2, voffB); PG8_STAGE(PG8_SB(0, 1), b2 + hstep, voffB); PG8_STAGE_A(PG8_SA(0, 0), a2, 0);
            PG8_WAIT_V(8); PG8_WAIT_L(0); PG8_BAR; PG8_MMA(1, 0, At, B0); PG8_MMA(1, 1, At, B1); PG8_BAR; PG8_SCHED;
            PG8_LDB(B0, 1, 0); PG8_LDB(B1, 1, 1); PG8_SCHED; PG8_LDA(At, 1, 0); PG8_STAGE_A(PG8_SA(0, 1), a2, 1);
            PG8_WAIT_V(8); PG8_WAIT_L(0); PG8_BAR; PG8_MMA(0, 0, At, B0); PG8_MMA(0, 1, At, B1); PG8_BAR; PG8_SCHED;
            PG8_LDA(At, 1, 1); PG8_STAGE(PG8_SB(1, 0), b3, voffB); PG8_STAGE(PG8_SB(1, 1), b3 + hstep, voffB); PG8_STAGE_A(PG8_SA(1, 0), a3, 0);
            PG8_WAIT_V(8); PG8_WAIT_L(0); PG8_BAR; PG8_MMA(1, 0, At, B0); PG8_MMA(1, 1, At, B1); PG8_BAR; PG8_SCHED;
        }
        if (wr == 0) PG8_BAR;
        if constexpr (FP8) asm volatile("s_nop 15\n\ts_nop 15" ::: "memory");
        E(acc, cur, wr, wc, fr, fq);
        if (!has_next) break;
#pragma unroll
        for (int a = 0; a < 2; ++a)
#pragma unroll
            for (int b = 0; b < 2; ++b)
#pragma unroll
                for (int m = 0; m < 4; ++m)
#pragma unroll
                    for (int n = 0; n < 2; ++n) acc[a][b][m][n] = (f32x4){0.f, 0.f, 0.f, 0.f};
        cur = nxt; cA = nA; cB = nB; ++ui;
        if (wr == 1) PG8_BAR;
    }
    PG8_WAIT_V(0);
    PG8_BAR;
#undef PG8_SA
#undef PG8_SB
#undef PG8_STAGE
#undef PG8_STAGE_A
#undef PG8_LDA
#undef PG8_LDB
#undef PG8_MMA
#undef PG8_WAIT_V
#undef PG8_WAIT_L
#undef PG8_BAR
#undef PG8_SCHED
#undef PG8_SETOFF
#undef PG8_IDX_DMA
#undef PG8_IDX_READ
}
}

namespace att {
using bf16=unsigned short;
using bf16x8=__attribute__((ext_vector_type(8)))short;
using s16x4=__attribute__((ext_vector_type(4)))short;
using f32x16=__attribute__((ext_vector_type(16)))float;
using u32x4=__attribute__((ext_vector_type(4)))unsigned;
constexpr int NW=8,QBLK=32,QB=QBLK*NW,KVBLK=64;
__device__ __forceinline__ int crow(int r,int hi){return (r&3)+8*(r>>2)+4*hi;}
#define SBAR() __builtin_amdgcn_sched_barrier(0)
constexpr int NSLOT=6, SLOTB=8192;
constexpr int LDS_K=0, LDS_V=NSLOT*SLOTB, LDS_WS=2*NSLOT*SLOTB, LDS_OST=LDS_WS+NW*64*4, LDS_BYTES=LDS_OST+NW*4096;
constexpr float C2=0.125f*1.4426950408889634f;
__device__ __forceinline__ void glds16(const void*sbase,unsigned voff,unsigned lds_dst){unsigned keep;
  asm volatile("s_mov_b32 %0, m0\n\ts_mov_b32 m0, %3\n\ts_nop 0\n\tglobal_load_lds_dwordx4 %1, %2\n\ts_mov_b32 m0, %0":"=&s"(keep):"v"(voff),"s"(sbase),"s"(lds_dst):"memory");}
__device__ __forceinline__ float max3f(float a,float b,float c){float r;asm("v_max3_f32 %0, %1, %2, %3":"=v"(r):"v"(a),"v"(b),"v"(c));return r;}
__device__ __forceinline__ float max2f(float a,float b){float r;asm("v_max_f32_e32 %0, %1, %2":"=v"(r):"v"(a),"v"(b));return r;}
__device__ __forceinline__ float fsub_s(float a,float b){float r;asm("v_sub_f32_e32 %0, %1, %2":"=v"(r):"v"(a),"v"(b));return r;}
typedef float f32x2_t __attribute__((ext_vector_type(2))); typedef __bf16 bf16x2_t __attribute__((ext_vector_type(2)));
__device__ __forceinline__ unsigned cvtpk_s(float lo,float hi){f32x2_t v={lo,hi};bf16x2_t b=__builtin_convertvector(v,bf16x2_t);return __builtin_bit_cast(unsigned,b);}
#define WAIT_BAR(N) asm volatile("s_waitcnt vmcnt(" #N ") lgkmcnt(0)\n\ts_barrier":::"memory")
typedef __attribute__((address_space(3))) const char* lds_cptr;
typedef short v4i16_t __attribute__((ext_vector_type(4)));
__device__ __forceinline__ void kload8(bf16x8*kf,lds_cptr kp,int bo){
  #pragma unroll
  for(int d0=0;d0<4;++d0){ const lds_cptr p=kp+((d0*32)^bo); kf[2*d0]=*(const __attribute__((address_space(3))) bf16x8*)(p); kf[2*d0+1]=*(const __attribute__((address_space(3))) bf16x8*)(p+4096); }
}
__device__ __forceinline__ void kload2(bf16x8*kf,lds_cptr kp,int j,int bo){ const lds_cptr p=kp+((j*32)^bo); kf[2*j]=*(const __attribute__((address_space(3))) bf16x8*)(p); kf[2*j+1]=*(const __attribute__((address_space(3))) bf16x8*)(p+4096); }
__device__ __forceinline__ s16x4 vtr(lds_cptr p){ return __builtin_bit_cast(s16x4,__builtin_amdgcn_ds_read_tr16_b64_v4i16((__attribute__((address_space(3))) v4i16_t*)p)); }
__device__ __forceinline__ float rowmax(const f32x16&p0,const f32x16&p1){
  float a=max3f(p0[0],p0[1],p1[0]),b=max3f(p0[2],p0[3],p1[1]);a=max3f(a,p1[2],p1[3]);
  #pragma unroll
  for(int r=4;r<16;r+=4){a=max3f(a,p0[r],p0[r+1]);b=max3f(b,p0[r+2],p0[r+3]);a=max3f(a,p1[r],p1[r+1]);b=max3f(b,p1[r+2],p1[r+3]);}
  const float m=max2f(a,b);
  auto rr=__builtin_amdgcn_permlane32_swap(__float_as_uint(m),__float_as_uint(m),false,false);
  return max2f(__uint_as_float(rr[0]),__uint_as_float(rr[1]));
}
__device__ __forceinline__ void pv(f32x16*o,int vb,bf16x8 pa0,bf16x8 pa1,bf16x8 pa2,bf16x8 pa3){
  #pragma unroll
  for(int d0=0;d0<2;++d0){s16x4 lo[4],hi[4];
    #pragma unroll
    for(int ks=0;ks<4;++ks){
      asm volatile("ds_read_b64_tr_b16 %0,%1 offset:%c2":"=&v"(lo[ks]):"v"(vb),"i"(d0*4096+ks*1024):"memory");
      asm volatile("ds_read_b64_tr_b16 %0,%1 offset:%c2":"=&v"(hi[ks]):"v"(vb),"i"(d0*4096+ks*1024+512):"memory");}
    asm volatile("s_waitcnt lgkmcnt(0)":::"memory");SBAR();
    #define PK(k) (bf16x8){lo[k][0],lo[k][1],lo[k][2],lo[k][3],hi[k][0],hi[k][1],hi[k][2],hi[k][3]}
    o[d0]=__builtin_amdgcn_mfma_f32_32x32x16_bf16(pa0,PK(0),o[d0],0,0,0);
    o[d0]=__builtin_amdgcn_mfma_f32_32x32x16_bf16(pa1,PK(1),o[d0],0,0,0);
    o[d0]=__builtin_amdgcn_mfma_f32_32x32x16_bf16(pa2,PK(2),o[d0],0,0,0);
    o[d0]=__builtin_amdgcn_mfma_f32_32x32x16_bf16(pa3,PK(3),o[d0],0,0,0);
    #undef PK
  }
}
template<int W> __device__ __forceinline__ void wmask(f32x16&p0,f32x16&p1,int d,float NEG){
  asm volatile("":"+v"(d));
  #pragma unroll
  for(int r=0;r<16;++r){const int c=(r&3)+8*(r>>2);
    if(W==0x7fffffff){ if(d<c)p0[r]=NEG; if(d<c+32)p1[r]=NEG; }
    else{ if((unsigned)(d-c)>(unsigned)W)p0[r]=NEG; if((unsigned)(d-c-32)>(unsigned)W)p1[r]=NEG; } }
}
struct UnitDesc {
  const bf16* Q; long qs;
  const bf16* K; long ks;
  const bf16* V; long vs;
  bf16* O; long os;
  float* lse; long lses;
  int NT;
  int rel0;
  int tg0;
  int q0;
  float slope2;
  float sink2;
};
template<int MODE,int THRL,int DIL,int OS> __device__ __forceinline__ void attn_unit(const UnitDesc&u,char*shm){
  constexpr int W=(MODE==0)?0x7fffffff:(MODE==1?128:127);
  const float NEG=(MODE==0)?-INFINITY:-1024.f;
  int tid=threadIdx.x; asm volatile("":"+v"(tid));
  const int lane=tid&63,r32=lane&31,hi=lane>>5; const int wid=__builtin_amdgcn_readfirstlane(tid>>6);
  constexpr long qs=64L*DIL,ks=64L*DIL,vs=64L*DIL;
  const bf16*Qw=u.Q+(long)(wid*QBLK)*qs;
  const unsigned lds0=(unsigned)(uintptr_t)shm;
  __attribute__((address_space(3))) float*wsf=(__attribute__((address_space(3))) float*)((__attribute__((address_space(3))) char*)shm+LDS_WS)+wid*64;
  const unsigned ksoff=(unsigned)(((long)(8*wid+(lane>>3))*ks+(((lane&7)^(lane>>3))*8))*2);
  const unsigned vsoff=(unsigned)(((long)(16*(wid&3)+(lane>>2))*vs+(wid>>2)*32+(lane&3)*8)*2);
  const unsigned kdst=lds0+LDS_K+wid*1024, vdst=lds0+LDS_V+wid*1024;
  #define DMA_K(t,slot) glds16(u.K+(long)(t)*KVBLK*ks,ksoff,(unsigned)__builtin_amdgcn_readfirstlane(kdst+(slot)))
  #define DMA_V(t,slot) glds16(u.V+(long)(t)*KVBLK*vs,vsoff,(unsigned)__builtin_amdgcn_readfirstlane(vdst+(slot)))
  bf16x8 kf[8];
  const lds_cptr shm3=(lds_cptr)shm; const lds_cptr kp0=shm3+LDS_K+r32*128+((hi^(r32&1))*16); const int kbo=((r32>>1)&3)<<5; const lds_cptr vp0=shm3+LDS_V+((lane>>4)&1)*32+(lane&3)*8+(4*hi+((lane&15)>>2))*64;
  const int NT=u.NT;
  if(MODE==0){DMA_K(0,0);DMA_V(0,0);DMA_K(1,SLOTB);} else {DMA_K(0,0);}
  bf16x8 qr[4];
  #pragma unroll
  for(int d0=0;d0<4;++d0)qr[d0]=*reinterpret_cast<const bf16x8*>(&Qw[(long)r32*qs+d0*16+hi*8]);
  const unsigned s2hb=__float_as_uint(u.slope2)&0xffff0000u; const float s2hf=__uint_as_float(s2hb);
  const unsigned s2lb=__float_as_uint(u.slope2-s2hf)&0xffff0000u; const float s2used=s2hf+__uint_as_float(s2lb);
  u32x4 qx; qx[0]=hi?0u:((__float_as_uint(64.f*s2hf)>>16)|(__float_as_uint(64.f*__uint_as_float(s2lb))&0xffff0000u)); qx[1]=hi?0u:((s2hb>>16)|s2lb); qx[2]=0u; qx[3]=0u;
  u32x4 kx0; unsigned jp0,jp1; { const unsigned j0=__float_as_uint((float)r32)>>16, j1=__float_as_uint((float)(r32+32))>>16; jp0=j0|(j0<<16); jp1=j1|(j1<<16);
    kx0[0]=0u; kx0[1]=jp0; kx0[2]=0x3f803f80u; kx0[3]=0u; }
  #define SETTG(t) do{ const unsigned tb_=__float_as_uint((float)(u.tg0+(t)))>>16; kx0[0]=(tb_|(tb_<<16)); }while(0)
  #define KX0 __builtin_bit_cast(bf16x8,kx0)
  #define QX __builtin_bit_cast(bf16x8,qx)
  #define SETREF(m_) do{ const unsigned hb_=__float_as_uint(m_)&0xffff0000u; const float hf_=__uint_as_float(hb_); const unsigned lb_=__float_as_uint((m_)-hf_)&0xffff0000u; \
      mhat=hf_+__uint_as_float(lb_); qx[2]=hi?0u:(((hb_^0x80000000u)>>16)|(lb_^0x80000000u)); }while(0)
  float mhat=0.f,l_reg=0.f;f32x16 o[2];o[0]=f32x16{};o[1]=f32x16{};
  const int qrel=u.rel0+wid*QBLK+r32-4*hi;
  #define CMASK(P0,P1,t) do{ if(MODE!=0||(t)>=NT-4) wmask<W>(P0,P1,qrel-64*(t),NEG); }while(0)
  bool resc=false;
  f32x16 pA0,pA1,pB0,pB1;
  int sl_prev=0,sl_cur=0,sl_next=SLOTB;
  #define ROT() do{sl_prev=sl_cur;sl_cur=sl_next;sl_next=(sl_next==(NSLOT-1)*SLOTB)?0:sl_next+SLOTB;}while(0)
  #define RESC() do{ if(resc){ asm volatile("s_waitcnt lgkmcnt(0)":::"memory"); \
      _Pragma("unroll") for(int d_=0;d_<2;++d_) _Pragma("unroll") for(int r=0;r<16;++r)o[d_][r]*=wsf[crow(r,hi)]; } }while(0)
  if(MODE==0){ DMA_K(2,2*SLOTB); WAIT_BAR(3); }
  else{ DMA_K(1,SLOTB);DMA_V(0,0);DMA_K(2,2*SLOTB);DMA_V(1,SLOTB);DMA_K(3,3*SLOTB);DMA_V(2,2*SLOTB);DMA_V(3,3*SLOTB);
    if(NT>4){DMA_K(4,4*SLOTB);DMA_K(5,5*SLOTB);DMA_V(4,4*SLOTB);DMA_V(5,5*SLOTB);}
    WAIT_BAR(0); }
  { SETTG(0); const f32x16 z=f32x16{}; const lds_cptr kb=kp0;
    #pragma unroll
    for(int d0=0;d0<4;++d0){
      const bf16x8 b0=*(const __attribute__((address_space(3))) bf16x8*)(kb+((d0*32)^kbo));
      const bf16x8 b1=*(const __attribute__((address_space(3))) bf16x8*)(kb+((d0*32)^kbo)+4096);
      if(d0==0){pA0=__builtin_amdgcn_mfma_f32_32x32x16_bf16(b0,qr[0],z,0,0,0);pA1=__builtin_amdgcn_mfma_f32_32x32x16_bf16(b1,qr[0],z,0,0,0);}
      else{pA0=__builtin_amdgcn_mfma_f32_32x32x16_bf16(b0,qr[d0],pA0,0,0,0);pA1=__builtin_amdgcn_mfma_f32_32x32x16_bf16(b1,qr[d0],pA1,0,0,0);}}
    pA0=__builtin_amdgcn_mfma_f32_32x32x16_bf16(KX0,QX,pA0,0,0,0); kx0[1]=jp1; pA1=__builtin_amdgcn_mfma_f32_32x32x16_bf16(KX0,QX,pA1,0,0,0); kx0[1]=jp0; }
  asm volatile("s_nop 15\n\ts_nop 7":"+v"(pA0),"+v"(pA1));CMASK(pA0,pA1,0);
  { const float rm=rowmax(pA0,pA1); SETREF(rm); const float dl=mhat;
    _Pragma("unroll") for(int r=0;r<16;++r){pA0[r]=fsub_s(pA0[r],dl);pA1[r]=fsub_s(pA1[r],dl);}
    _Pragma("unroll") for(int r=0;r<16;++r)pA0[r]=__builtin_amdgcn_exp2f(pA0[r]); }
  _Pragma("unroll") for(int r=0;r<16;++r)pA1[r]=__builtin_amdgcn_exp2f(pA1[r]);
  if(MODE==0){ WAIT_BAR(0); DMA_K(3,0);DMA_V(1,SLOTB); }
  ROT();
  kload8(kf,kp0+sl_cur,kbo);
  if(MODE==0){ WAIT_BAR(2); }
  s16x4 vlo[8],vhi[8]; u32x4 pw0,pw1,pw2,pw3;
  #define PKW(P,B) cvtpk_s(P[B],P[B+1])
  #define PAF(k) __builtin_bit_cast(bf16x8,pw##k)
  #define VFR(i) (bf16x8){vlo[i][0],vlo[i][1],vlo[i][2],vlo[i][3],vhi[i][0],vhi[i][1],vhi[i][2],vhi[i][3]}
  #define PIN(x) asm volatile("":"+v"(x))
  #define MX3(a,b,c) __builtin_fmaxf(__builtin_fmaxf((a),(b)),(c))
  #define GAPA(MF,A0,A1,A2,A3,W0,W1,PW) do{ MF; sacc+=A0; sacc+=A1; sacc+=A2; sacc+=A3; PIN(sacc); W0; W1; PIN(PW); SBAR(); }while(0)
  #define EX(v) __builtin_amdgcn_exp2f(v)
  #define GAPB(MF,X,B) do{ MF; X[B]=EX(X[B]); X[B+1]=EX(X[B+1]); X[B+2]=EX(X[B+2]); X[B+3]=EX(X[B+3]); PIN(X); SBAR(); }while(0)
  #define VRD(i) do{ vlo[i]=vtr(vp_+(((i)>>2)*4096+((i)&3)*1024)); vhi[i]=vtr(vp_+(((i)>>2)*4096+((i)&3)*1024+512)); }while(0)
  #define KRD(G,j) do{ if(G){ kload2(kf,kp0+sl_next,j,kbo); SBAR(); } }while(0)
  #define STEP(C0,C1,P0,P1,t,GK,GV,GL) do{ SBAR(); SETTG(t); const f32x16 z_=f32x16{}; \
    const lds_cptr vp_=vp0+sl_prev; \
    VRD(0); SBAR(); float sacc=(P0[0]+P0[1]); \
    GAPA(C0=__builtin_amdgcn_mfma_f32_32x32x16_bf16(kf[0],qr[0],z_,0,0,0), P0[2],P0[3],P0[4],P0[5],     pw0[0]=PKW(P0,0), pw0[1]=PKW(P0,2), pw0); \
    VRD(4); SBAR(); GAPA(C1=__builtin_amdgcn_mfma_f32_32x32x16_bf16(kf[1],qr[0],z_,0,0,0), P0[6],P0[7],P0[8],P0[9],     pw0[2]=PKW(P0,4), pw0[3]=PKW(P0,6), pw0); \
    VRD(1); SBAR(); GAPA(C0=__builtin_amdgcn_mfma_f32_32x32x16_bf16(kf[2],qr[1],C0,0,0,0),   P0[10],P0[11],P0[12],P0[13], pw1[0]=PKW(P0,8), pw1[1]=PKW(P0,10), pw1); \
    VRD(5); SBAR(); GAPA(C1=__builtin_amdgcn_mfma_f32_32x32x16_bf16(kf[3],qr[1],C1,0,0,0),   P0[14],P0[15],P1[0],P1[1],   pw1[2]=PKW(P0,12),pw1[3]=PKW(P0,14), pw1); \
    VRD(2); SBAR(); GAPA(C0=__builtin_amdgcn_mfma_f32_32x32x16_bf16(kf[4],qr[2],C0,0,0,0),   P1[2],P1[3],P1[4],P1[5],     pw2[0]=PKW(P1,0), pw2[1]=PKW(P1,2), pw2); \
    VRD(6); SBAR(); GAPA(C1=__builtin_amdgcn_mfma_f32_32x32x16_bf16(kf[5],qr[2],C1,0,0,0),   P1[6],P1[7],P1[8],P1[9],     pw2[2]=PKW(P1,4), pw2[3]=PKW(P1,6), pw2); \
    VRD(3); SBAR(); GAPA(C0=__builtin_amdgcn_mfma_f32_32x32x16_bf16(kf[6],qr[3],C0,0,0,0),   P1[10],P1[11],P1[12],P1[13], pw3[0]=PKW(P1,8), pw3[1]=PKW(P1,10), pw3); \
    VRD(7); SBAR(); GAPA(C1=__builtin_amdgcn_mfma_f32_32x32x16_bf16(kf[7],qr[3],C1,0,0,0),   P1[14],P1[15],0.f,0.f,       pw3[2]=PKW(P1,12),pw3[3]=PKW(P1,14), pw3); \
    C0=__builtin_amdgcn_mfma_f32_32x32x16_bf16(KX0,QX,C0,0,0,0); kx0[1]=jp1; C1=__builtin_amdgcn_mfma_f32_32x32x16_bf16(KX0,QX,C1,0,0,0); kx0[1]=jp0; SBAR(); \
    l_reg+=sacc; \
    if(GK){DMA_K((t)+3,sl_cur);} if(GV){DMA_V((t)+1,sl_next);} \
    CMASK(C0,C1,t); \
    { float a=MX3(C0[0],C0[1],C1[0]),b=MX3(C0[2],C0[3],C1[1]); a=MX3(a,C1[2],C1[3]); \
      _Pragma("unroll") for(int r=4;r<16;r+=4){a=MX3(a,C0[r],C0[r+1]);b=MX3(b,C0[r+2],C0[r+3]);a=MX3(a,C1[r],C1[r+1]);b=MX3(b,C1[r+2],C1[r+3]);} \
      float rm=__builtin_fmaxf(a,b); { auto rr=__builtin_amdgcn_permlane32_swap(__float_as_uint(rm),__float_as_uint(rm),false,false); rm=__builtin_fmaxf(__uint_as_float(rr[0]),__uint_as_float(rr[1])); } \
      resc=false; \
      if(__builtin_expect(__any(rm>(float)THRL),0)){ const float mold=mhat; const float mnew=mold+__builtin_fmaxf(rm,0.f); SETREF(mnew); const float dl=mhat-mold; \
        _Pragma("unroll") for(int r=0;r<16;++r){C0[r]-=dl;C1[r]-=dl;} \
        const float f=__builtin_amdgcn_exp2f(-dl); l_reg*=f; if(hi==0)wsf[r32]=f; resc=true; } } \
    SBAR(); \
    GAPB(o[0]=__builtin_amdgcn_mfma_f32_32x32x16_bf16(PAF(0),VFR(0),o[0],0,0,0), C0,0); \
    GAPB(o[1]=__builtin_amdgcn_mfma_f32_32x32x16_bf16(PAF(0),VFR(4),o[1],0,0,0), C0,4); \
    KRD(GL,0); GAPB(o[0]=__builtin_amdgcn_mfma_f32_32x32x16_bf16(PAF(1),VFR(1),o[0],0,0,0), C0,8); \
    KRD(GL,1); GAPB(o[1]=__builtin_amdgcn_mfma_f32_32x32x16_bf16(PAF(1),VFR(5),o[1],0,0,0), C0,12); \
    KRD(GL,2); GAPB(o[0]=__builtin_amdgcn_mfma_f32_32x32x16_bf16(PAF(2),VFR(2),o[0],0,0,0), C1,0); \
    KRD(GL,3); GAPB(o[1]=__builtin_amdgcn_mfma_f32_32x32x16_bf16(PAF(2),VFR(6),o[1],0,0,0), C1,4); \
    GAPB(o[0]=__builtin_amdgcn_mfma_f32_32x32x16_bf16(PAF(3),VFR(3),o[0],0,0,0), C1,8); \
    GAPB(o[1]=__builtin_amdgcn_mfma_f32_32x32x16_bf16(PAF(3),VFR(7),o[1],0,0,0), C1,12); \
    }while(0)
  int t=1;
  if(MODE==0){
    #undef CMASK
    #define CMASK(P0,P1,t) do{}while(0)
    for(;t+5<NT;t+=2){
      STEP(pB0,pB1,pA0,pA1,t,true,true,true);     WAIT_BAR(2); RESC(); ROT();
      STEP(pA0,pA1,pB0,pB1,t+1,true,true,true);   WAIT_BAR(2); RESC(); ROT();
    }
    #undef CMASK
    #define CMASK(P0,P1,t) do{ if(MODE!=0||(t)>=NT-4) wmask<W>(P0,P1,qrel-64*(t),NEG); }while(0)
  }
  #define ENDW(tt) do{ if(MODE==0){ if((tt)+3<NT){WAIT_BAR(2);} else if((tt)+2<NT){WAIT_BAR(1);} else {WAIT_BAR(0);} } }while(0)
  for(;t+1<NT;t+=2){
    STEP(pB0,pB1,pA0,pA1,t,(MODE==0&&t+3<NT),(MODE==0&&t+1<NT),(t+1<NT));       ENDW(t);   RESC(); ROT();
    STEP(pA0,pA1,pB0,pB1,t+1,(MODE==0&&t+4<NT),(MODE==0&&t+2<NT),(t+2<NT));     ENDW(t+1); RESC(); ROT();
  }
  STEP(pB0,pB1,pA0,pA1,NT-1,false,false,false); RESC();
  { float sacc=pB0[0]+pB0[1]; _Pragma("unroll") for(int r=2;r<16;++r)sacc+=pB0[r]; _Pragma("unroll") for(int r=0;r<16;++r)sacc+=pB1[r]; l_reg+=sacc;
    pw0=(u32x4){PKW(pB0,0),PKW(pB0,2),PKW(pB0,4),PKW(pB0,6)};pw1=(u32x4){PKW(pB0,8),PKW(pB0,10),PKW(pB0,12),PKW(pB0,14)};pw2=(u32x4){PKW(pB1,0),PKW(pB1,2),PKW(pB1,4),PKW(pB1,6)};pw3=(u32x4){PKW(pB1,8),PKW(pB1,10),PKW(pB1,12),PKW(pB1,14)};
    SBAR(); pv(o,(int)(lds0+LDS_V)+((lane>>4)&1)*32+(lane&3)*8+(4*hi+((lane&15)>>2))*64+sl_cur,PAF(0),PAF(1),PAF(2),PAF(3)); }
  #undef PKW
  #undef PAF
  #undef VFR
  #undef PIN
  #undef MX3
  #undef GAPA
  #undef GAPB
  #undef EX
  #undef VRD
  #undef KRD
  #undef STEP
  #undef ENDW
  {auto rr=__builtin_amdgcn_permlane32_swap(__float_as_uint(l_reg),__float_as_uint(l_reg),false,false);l_reg=__uint_as_float(rr[0])+__uint_as_float(rr[1]);}
  const float qposf=(float)(u.q0+wid*QBLK+r32);
  if(MODE==2) l_reg+=__builtin_amdgcn_exp2f(u.sink2+s2used*qposf-mhat);
  if(MODE==1){ if(hi==0) u.lse[(long)(wid*QBLK+r32)*(16*DIL)]=mhat-s2used*qposf+__builtin_amdgcn_logf(l_reg); }
  if(hi==0)wsf[32+r32]=l_reg;asm volatile("s_waitcnt lgkmcnt(0)":::"memory");
  float rli[16];
  #pragma unroll
  for(int r=0;r<16;++r)rli[r]=__builtin_amdgcn_rcpf(wsf[32+crow(r,hi)]);
  bf16*Ow=u.O+(long)(wid*QBLK)*OS;
  { int le=lane; asm volatile("":"+v"(le));
    const int r32e=le&31,hie=le>>5;
    __hip_bfloat16*stg=(__hip_bfloat16*)(shm+LDS_OST)+wid*2048;
    #pragma unroll
    for(int r=0;r<16;++r){const int orow=crow(r,hie);
      #pragma unroll
      for(int d0=0;d0<2;++d0)stg[orow*64+d0*32+r32e]=__float2bfloat16(o[d0][r]*rli[r]);}
    asm volatile("s_waitcnt lgkmcnt(0)":::"memory");
    #pragma unroll
    for(int i=0;i<4;++i){const int row=i*8+(le>>3),ch=le&7; const u32x4 v=*(const u32x4*)(stg+row*64+ch*8); *(u32x4*)(Ow+(long)row*OS+ch*8)=v;} }
  asm volatile("s_waitcnt lgkmcnt(0)\n\ts_barrier":::"memory");
  #undef DMA_K
  #undef DMA_V
  #undef CMASK
  #undef RESC
  #undef ROT
  #undef SETTG
  #undef SETREF
  #undef KX0
  #undef QX
}
#undef SBAR
#undef WAIT_BAR
}

namespace att128 {
using att::UnitDesc; using att::crow; using att::glds16; using att::max3f; using att::max2f; using att::fsub_s; using att::cvtpk_s; using att::kload8; using att::kload2; using att::vtr; using att::rowmax; using att::wmask; using att::lds_cptr;
using bf16=unsigned short;
using bf16x8=__attribute__((ext_vector_type(8)))short;
using s16x4=__attribute__((ext_vector_type(4)))short;
using f32x16=__attribute__((ext_vector_type(16)))float;
using u32x4=__attribute__((ext_vector_type(4)))unsigned;
constexpr int NW=8,QBLK=32,QB=QBLK*NW,KVBLK=64;
#define SBAR() __builtin_amdgcn_sched_barrier(0)
constexpr int NSLOT=3, SLOTB=8192, SLOTV=16384;
constexpr int LDS_K=0, LDS_V=NSLOT*SLOTB, LDS_WS=LDS_V+NSLOT*SLOTV, LDS_OST=LDS_WS+NW*64*4, LDS_BYTES=LDS_OST+NW*8192;
#define WAIT_BAR(N) asm volatile("s_waitcnt vmcnt(" #N ") lgkmcnt(0)\n\ts_barrier":::"memory")
__device__ __forceinline__ void pv4(f32x16*o,int vb,bf16x8 pa0,bf16x8 pa1,bf16x8 pa2,bf16x8 pa3){
  #pragma unroll
  for(int d0=0;d0<4;++d0){s16x4 lo[4],hi[4];
    #pragma unroll
    for(int ks=0;ks<4;++ks){
      asm volatile("ds_read_b64_tr_b16 %0,%1 offset:%c2":"=&v"(lo[ks]):"v"(vb),"i"(d0*4096+ks*1024):"memory");
      asm volatile("ds_read_b64_tr_b16 %0,%1 offset:%c2":"=&v"(hi[ks]):"v"(vb),"i"(d0*4096+ks*1024+512):"memory");}
    asm volatile("s_waitcnt lgkmcnt(0)":::"memory");SBAR();
    #define PK(k) (bf16x8){lo[k][0],lo[k][1],lo[k][2],lo[k][3],hi[k][0],hi[k][1],hi[k][2],hi[k][3]}
    o[d0]=__builtin_amdgcn_mfma_f32_32x32x16_bf16(pa0,PK(0),o[d0],0,0,0);
    o[d0]=__builtin_amdgcn_mfma_f32_32x32x16_bf16(pa1,PK(1),o[d0],0,0,0);
    o[d0]=__builtin_amdgcn_mfma_f32_32x32x16_bf16(pa2,PK(2),o[d0],0,0,0);
    o[d0]=__builtin_amdgcn_mfma_f32_32x32x16_bf16(pa3,PK(3),o[d0],0,0,0);
    #undef PK
  }
}
template<int MODE,int THRL,int DIL,int OS> __device__ __forceinline__ void attn_unit(const UnitDesc&u,char*shm){
  static_assert(MODE==0,"att128: causal mode only");
  constexpr int W=(MODE==0)?0x7fffffff:(MODE==1?128:127);
  const float NEG=(MODE==0)?-INFINITY:-1024.f;
  int tid=threadIdx.x; asm volatile("":"+v"(tid));
  const int lane=tid&63,r32=lane&31,hi=lane>>5; const int wid=__builtin_amdgcn_readfirstlane(tid>>6);
  constexpr long qs=64L*DIL,ks=64L*DIL,vs=64L*DIL;
  const bf16*Qw=u.Q+(long)(wid*QBLK)*qs;
  const unsigned lds0=(unsigned)(uintptr_t)shm;
  __attribute__((address_space(3))) float*wsf=(__attribute__((address_space(3))) float*)((__attribute__((address_space(3))) char*)shm+LDS_WS)+wid*64;
  const unsigned ksoff=(unsigned)(((long)(8*wid+(lane>>3))*ks+(((lane&7)^(lane>>3))*8))*2);
  const unsigned vsoff=(unsigned)(((long)(16*(wid&3)+(lane>>2))*vs+(wid>>2)*32+(lane&3)*8)*2);
  const unsigned kdst=lds0+LDS_K+wid*1024, vdst=lds0+LDS_V+wid*1024;
  #define DMA_K(t,slot) glds16(u.K+(long)(t)*KVBLK*ks,ksoff,(unsigned)__builtin_amdgcn_readfirstlane(kdst+(slot)))
  #define DMA_V(t,slot) do{ glds16(u.V+(long)(t)*KVBLK*vs,vsoff,(unsigned)__builtin_amdgcn_readfirstlane(vdst+2*(slot))); glds16(u.V+(long)(t)*KVBLK*vs+64*(long)M,vsoff,(unsigned)__builtin_amdgcn_readfirstlane(vdst+2*(slot)+8192)); }while(0)
  bf16x8 kf[8];
  const lds_cptr shm3=(lds_cptr)shm; const lds_cptr kp0=shm3+LDS_K+r32*128+((hi^(r32&1))*16); const int kbo=((r32>>1)&3)<<5; const lds_cptr vp0=shm3+LDS_V+((lane>>4)&1)*32+(lane&3)*8+(4*hi+((lane&15)>>2))*64;
  const int NT=u.NT;
  DMA_K(0,0);DMA_V(0,0);DMA_K(1,SLOTB);
  bf16x8 qr[4];
  #pragma unroll
  for(int d0=0;d0<4;++d0)qr[d0]=*reinterpret_cast<const bf16x8*>(&Qw[(long)r32*qs+d0*16+hi*8]);
  const unsigned s2hb=__float_as_uint(u.slope2)&0xffff0000u; const float s2hf=__uint_as_float(s2hb);
  const unsigned s2lb=__float_as_uint(u.slope2-s2hf)&0xffff0000u; const float s2used=s2hf+__uint_as_float(s2lb);
  u32x4 qx; qx[0]=hi?0u:((__float_as_uint(64.f*s2hf)>>16)|(__float_as_uint(64.f*__uint_as_float(s2lb))&0xffff0000u)); qx[1]=hi?0u:((s2hb>>16)|s2lb); qx[2]=0u; qx[3]=0u;
  u32x4 kx0; unsigned jp0,jp1; { const unsigned j0=__float_as_uint((float)r32)>>16, j1=__float_as_uint((float)(r32+32))>>16; jp0=j0|(j0<<16); jp1=j1|(j1<<16);
    kx0[0]=0u; kx0[1]=jp0; kx0[2]=0x3f803f80u; kx0[3]=0u; }
  #define SETTG(t) do{ const unsigned tb_=__float_as_uint((float)(u.tg0+(t)))>>16; kx0[0]=(tb_|(tb_<<16)); }while(0)
  #define KX0 __builtin_bit_cast(bf16x8,kx0)
  #define QX __builtin_bit_cast(bf16x8,qx)
  #define SETREF(m_) do{ const unsigned hb_=__float_as_uint(m_)&0xffff0000u; const float hf_=__uint_as_float(hb_); const unsigned lb_=__float_as_uint((m_)-hf_)&0xffff0000u; \
      mhat=hf_+__uint_as_float(lb_); qx[2]=hi?0u:(((hb_^0x80000000u)>>16)|(lb_^0x80000000u)); }while(0)
  float mhat=0.f,l_reg=0.f;f32x16 o[4];o[0]=f32x16{};o[1]=f32x16{};o[2]=f32x16{};o[3]=f32x16{};
  const int qrel=u.rel0+wid*QBLK+r32-4*hi;
  #define CMASK(P0,P1,t) do{ if(MODE!=0||(t)>=NT-4) wmask<W>(P0,P1,qrel-64*(t),NEG); }while(0)
  bool resc=false;
  f32x16 pA0,pA1,pB0,pB1;
  int sl_prev=0,sl_cur=0,sl_next=SLOTB;
  #define ROT() do{sl_prev=sl_cur;sl_cur=sl_next;sl_next=(sl_next==(NSLOT-1)*SLOTB)?0:sl_next+SLOTB;}while(0)
  #define RESC() do{ if(resc){ asm volatile("s_waitcnt lgkmcnt(0)":::"memory"); \
      _Pragma("unroll") for(int d_=0;d_<4;++d_) _Pragma("unroll") for(int r=0;r<16;++r)o[d_][r]*=wsf[crow(r,hi)]; } }while(0)
  DMA_K(2,2*SLOTB);
  WAIT_BAR(4);
  { SETTG(0); const f32x16 z=f32x16{}; const lds_cptr kb=kp0;
    #pragma unroll
    for(int d0=0;d0<4;++d0){
      const bf16x8 b0=*(const __attribute__((address_space(3))) bf16x8*)(kb+((d0*32)^kbo));
      const bf16x8 b1=*(const __attribute__((address_space(3))) bf16x8*)(kb+((d0*32)^kbo)+4096);
      if(d0==0){pA0=__builtin_amdgcn_mfma_f32_32x32x16_bf16(b0,qr[0],z,0,0,0);pA1=__builtin_amdgcn_mfma_f32_32x32x16_bf16(b1,qr[0],z,0,0,0);}
      else{pA0=__builtin_amdgcn_mfma_f32_32x32x16_bf16(b0,qr[d0],pA0,0,0,0);pA1=__builtin_amdgcn_mfma_f32_32x32x16_bf16(b1,qr[d0],pA1,0,0,0);}}
    pA0=__builtin_amdgcn_mfma_f32_32x32x16_bf16(KX0,QX,pA0,0,0,0); kx0[1]=jp1; pA1=__builtin_amdgcn_mfma_f32_32x32x16_bf16(KX0,QX,pA1,0,0,0); kx0[1]=jp0; }
  asm volatile("s_nop 15\n\ts_nop 7":"+v"(pA0),"+v"(pA1));CMASK(pA0,pA1,0);
  { const float rm=rowmax(pA0,pA1); SETREF(rm); const float dl=mhat;
    _Pragma("unroll") for(int r=0;r<16;++r){pA0[r]=fsub_s(pA0[r],dl);pA1[r]=fsub_s(pA1[r],dl);}
    _Pragma("unroll") for(int r=0;r<16;++r)pA0[r]=__builtin_amdgcn_exp2f(pA0[r]); }
  _Pragma("unroll") for(int r=0;r<16;++r)pA1[r]=__builtin_amdgcn_exp2f(pA1[r]);
  WAIT_BAR(0);
  DMA_K(3,0);DMA_V(1,SLOTB);
  ROT();
  kload8(kf,kp0+sl_cur,kbo);
  WAIT_BAR(3);
  s16x4 vlo[3],vhi[3]; u32x4 pw0,pw1,pw2,pw3;
  #define PKW(P,B) cvtpk_s(P[B],P[B+1])
  #define PAF(k) __builtin_bit_cast(bf16x8,pw##k)
  #define VFJ(b) (bf16x8){vlo[b][0],vlo[b][1],vlo[b][2],vlo[b][3],vhi[b][0],vhi[b][1],vhi[b][2],vhi[b][3]}
  #define PIN(x) asm volatile("":"+v"(x))
  #define MX3(a,b,c) __builtin_fmaxf(__builtin_fmaxf((a),(b)),(c))
  #define GAPA(MF,A0,A1,A2,A3,W0,W1,PW) do{ MF; sacc+=A0; sacc+=A1; sacc+=A2; sacc+=A3; PIN(sacc); W0; W1; PIN(PW); SBAR(); }while(0)
  #define EX(v) __builtin_amdgcn_exp2f(v)
  #define GAPB2(MF,X,B) do{ MF; X[B]=EX(X[B]); X[B+1]=EX(X[B+1]); PIN(X); SBAR(); }while(0)
  #define VRJ(b,n) do{ vlo[b]=vtr(vp_+(((n)&3)*4096+((n)>>2)*1024)); vhi[b]=vtr(vp_+(((n)&3)*4096+((n)>>2)*1024+512)); SBAR(); }while(0)
  #define KRD(G,j) do{ if(G){ kload2(kf,kp0+sl_next,j,kbo); SBAR(); } }while(0)
  #define STEP(C0,C1,P0,P1,t,GK,GV,GL) do{ SBAR(); SETTG(t); const f32x16 z_=f32x16{}; \
    const lds_cptr vp_=vp0+2*sl_prev; \
    float sacc=(P0[0]+P0[1]); \
    GAPA(C0=__builtin_amdgcn_mfma_f32_32x32x16_bf16(kf[0],qr[0],z_,0,0,0), P0[2],P0[3],P0[4],P0[5],     pw0[0]=PKW(P0,0), pw0[1]=PKW(P0,2), pw0); \
    GAPA(C1=__builtin_amdgcn_mfma_f32_32x32x16_bf16(kf[1],qr[0],z_,0,0,0), P0[6],P0[7],P0[8],P0[9],     pw0[2]=PKW(P0,4), pw0[3]=PKW(P0,6), pw0); \
    GAPA(C0=__builtin_amdgcn_mfma_f32_32x32x16_bf16(kf[2],qr[1],C0,0,0,0),   P0[10],P0[11],P0[12],P0[13], pw1[0]=PKW(P0,8), pw1[1]=PKW(P0,10), pw1); \
    GAPA(C1=__builtin_amdgcn_mfma_f32_32x32x16_bf16(kf[3],qr[1],C1,0,0,0),   P0[14],P0[15],P1[0],P1[1],   pw1[2]=PKW(P0,12),pw1[3]=PKW(P0,14), pw1); \
    GAPA(C0=__builtin_amdgcn_mfma_f32_32x32x16_bf16(kf[4],qr[2],C0,0,0,0),   P1[2],P1[3],P1[4],P1[5],     pw2[0]=PKW(P1,0), pw2[1]=PKW(P1,2), pw2); \
    GAPA(C1=__builtin_amdgcn_mfma_f32_32x32x16_bf16(kf[5],qr[2],C1,0,0,0),   P1[6],P1[7],P1[8],P1[9],     pw2[2]=PKW(P1,4), pw2[3]=PKW(P1,6), pw2); \
    VRJ(0,0); GAPA(C0=__builtin_amdgcn_mfma_f32_32x32x16_bf16(kf[6],qr[3],C0,0,0,0),   P1[10],P1[11],P1[12],P1[13], pw3[0]=PKW(P1,8), pw3[1]=PKW(P1,10), pw3); \
    VRJ(1,1); GAPA(C1=__builtin_amdgcn_mfma_f32_32x32x16_bf16(kf[7],qr[3],C1,0,0,0),   P1[14],P1[15],0.f,0.f,       pw3[2]=PKW(P1,12),pw3[3]=PKW(P1,14), pw3); \
    C0=__builtin_amdgcn_mfma_f32_32x32x16_bf16(KX0,QX,C0,0,0,0); kx0[1]=jp1; C1=__builtin_amdgcn_mfma_f32_32x32x16_bf16(KX0,QX,C1,0,0,0); kx0[1]=jp0; SBAR(); \
    l_reg+=sacc; \
    if(GK){DMA_K((t)+3,sl_cur);} if(GV){DMA_V((t)+1,sl_next);} \
    CMASK(C0,C1,t); \
    { float a=MX3(C0[0],C0[1],C1[0]),b=MX3(C0[2],C0[3],C1[1]); a=MX3(a,C1[2],C1[3]); \
      _Pragma("unroll") for(int r=4;r<16;r+=4){a=MX3(a,C0[r],C0[r+1]);b=MX3(b,C0[r+2],C0[r+3]);a=MX3(a,C1[r],C1[r+1]);b=MX3(b,C1[r+2],C1[r+3]);} \
      float rm=__builtin_fmaxf(a,b); { auto rr=__builtin_amdgcn_permlane32_swap(__float_as_uint(rm),__float_as_uint(rm),false,false); rm=__builtin_fmaxf(__uint_as_float(rr[0]),__uint_as_float(rr[1])); } \
      resc=false; \
      if(__builtin_expect(__any(rm>(float)THRL),0)){ const float mold=mhat; const float mnew=mold+__builtin_fmaxf(rm,0.f); SETREF(mnew); const float dl=mhat-mold; \
        _Pragma("unroll") for(int r=0;r<16;++r){C0[r]-=dl;C1[r]-=dl;} \
        const float f=__builtin_amdgcn_exp2f(-dl); l_reg*=f; if(hi==0)wsf[r32]=f; resc=true; } } \
    SBAR(); \
    VRJ(2,2);             GAPB2(o[0]=__builtin_amdgcn_mfma_f32_32x32x16_bf16(PAF(0),VFJ(0),o[0],0,0,0), C0,0); \
    VRJ(0,3);             GAPB2(o[1]=__builtin_amdgcn_mfma_f32_32x32x16_bf16(PAF(0),VFJ(1),o[1],0,0,0), C0,2); \
    VRJ(1,4);             GAPB2(o[2]=__builtin_amdgcn_mfma_f32_32x32x16_bf16(PAF(0),VFJ(2),o[2],0,0,0), C0,4); \
    VRJ(2,5);             GAPB2(o[3]=__builtin_amdgcn_mfma_f32_32x32x16_bf16(PAF(0),VFJ(0),o[3],0,0,0), C0,6); \
    VRJ(0,6);  KRD(GL,0); GAPB2(o[0]=__builtin_amdgcn_mfma_f32_32x32x16_bf16(PAF(1),VFJ(1),o[0],0,0,0), C0,8); \
    VRJ(1,7);             GAPB2(o[1]=__builtin_amdgcn_mfma_f32_32x32x16_bf16(PAF(1),VFJ(2),o[1],0,0,0), C0,10); \
    VRJ(2,8);  KRD(GL,1); GAPB2(o[2]=__builtin_amdgcn_mfma_f32_32x32x16_bf16(PAF(1),VFJ(0),o[2],0,0,0), C0,12); \
    VRJ(0,9);             GAPB2(o[3]=__builtin_amdgcn_mfma_f32_32x32x16_bf16(PAF(1),VFJ(1),o[3],0,0,0), C0,14); \
    VRJ(1,10); KRD(GL,2); GAPB2(o[0]=__builtin_amdgcn_mfma_f32_32x32x16_bf16(PAF(2),VFJ(2),o[0],0,0,0), C1,0); \
    VRJ(2,11);            GAPB2(o[1]=__builtin_amdgcn_mfma_f32_32x32x16_bf16(PAF(2),VFJ(0),o[1],0,0,0), C1,2); \
    VRJ(0,12); KRD(GL,3); GAPB2(o[2]=__builtin_amdgcn_mfma_f32_32x32x16_bf16(PAF(2),VFJ(1),o[2],0,0,0), C1,4); \
    VRJ(1,13);            GAPB2(o[3]=__builtin_amdgcn_mfma_f32_32x32x16_bf16(PAF(2),VFJ(2),o[3],0,0,0), C1,6); \
    VRJ(2,14);            GAPB2(o[0]=__builtin_amdgcn_mfma_f32_32x32x16_bf16(PAF(3),VFJ(0),o[0],0,0,0), C1,8); \
    VRJ(0,15);            GAPB2(o[1]=__builtin_amdgcn_mfma_f32_32x32x16_bf16(PAF(3),VFJ(1),o[1],0,0,0), C1,10); \
                          GAPB2(o[2]=__builtin_amdgcn_mfma_f32_32x32x16_bf16(PAF(3),VFJ(2),o[2],0,0,0), C1,12); \
                          GAPB2(o[3]=__builtin_amdgcn_mfma_f32_32x32x16_bf16(PAF(3),VFJ(0),o[3],0,0,0), C1,14); \
    }while(0)
  int t=1;
  if(MODE==0){
    #undef CMASK
    #define CMASK(P0,P1,t) do{}while(0)
    for(;t+5<NT;t+=2){
      STEP(pB0,pB1,pA0,pA1,t,true,true,true);     WAIT_BAR(3); RESC(); ROT();
      STEP(pA0,pA1,pB0,pB1,t+1,true,true,true);   WAIT_BAR(3); RESC(); ROT();
    }
    #undef CMASK
    #define CMASK(P0,P1,t) do{ if(MODE!=0||(t)>=NT-4) wmask<W>(P0,P1,qrel-64*(t),NEG); }while(0)
  }
  #define ENDW(tt) do{ if((tt)+3<NT){WAIT_BAR(3);} else if((tt)+2<NT){WAIT_BAR(2);} else {WAIT_BAR(0);} }while(0)
  for(;t+1<NT;t+=2){
    STEP(pB0,pB1,pA0,pA1,t,(t+3<NT),(t+1<NT),(t+1<NT));       ENDW(t);   RESC(); ROT();
    STEP(pA0,pA1,pB0,pB1,t+1,(t+4<NT),(t+2<NT),(t+2<NT));     ENDW(t+1); RESC(); ROT();
  }
  STEP(pB0,pB1,pA0,pA1,NT-1,false,false,false); RESC();
  { float sacc=pB0[0]+pB0[1]; _Pragma("unroll") for(int r=2;r<16;++r)sacc+=pB0[r]; _Pragma("unroll") for(int r=0;r<16;++r)sacc+=pB1[r]; l_reg+=sacc;
    pw0=(u32x4){PKW(pB0,0),PKW(pB0,2),PKW(pB0,4),PKW(pB0,6)};pw1=(u32x4){PKW(pB0,8),PKW(pB0,10),PKW(pB0,12),PKW(pB0,14)};pw2=(u32x4){PKW(pB1,0),PKW(pB1,2),PKW(pB1,4),PKW(pB1,6)};pw3=(u32x4){PKW(pB1,8),PKW(pB1,10),PKW(pB1,12),PKW(pB1,14)};
    SBAR(); pv4(o,(int)(lds0+LDS_V)+((lane>>4)&1)*32+(lane&3)*8+(4*hi+((lane&15)>>2))*64+2*sl_cur,PAF(0),PAF(1),PAF(2),PAF(3)); }
  #undef PKW
  #undef PAF
  #undef VFJ
  #undef PIN
  #undef MX3
  #undef GAPA
  #undef GAPB2
  #undef EX
  #undef VRJ
  #undef KRD
  #undef STEP
  #undef ENDW
  {auto rr=__builtin_amdgcn_permlane32_swap(__float_as_uint(l_reg),__float_as_uint(l_reg),false,false);l_reg=__uint_as_float(rr[0])+__uint_as_float(rr[1]);}
  const float qposf=(float)(u.q0+wid*QBLK+r32);
  if(MODE==2) l_reg+=__builtin_amdgcn_exp2f(u.sink2+s2used*qposf-mhat);
  if(MODE==1){ if(hi==0) u.lse[(long)(wid*QBLK+r32)*(16*DIL)]=mhat-s2used*qposf+__builtin_amdgcn_logf(l_reg); }
  if(hi==0)wsf[32+r32]=l_reg;asm volatile("s_waitcnt lgkmcnt(0)":::"memory");
  float rli[16];
  #pragma unroll
  for(int r=0;r<16;++r)rli[r]=__builtin_amdgcn_rcpf(wsf[32+crow(r,hi)]);
  bf16*Ow=u.O+(long)(wid*QBLK)*OS;
  { int le=lane; asm volatile("":"+v"(le));
    const int r32e=le&31,hie=le>>5;
    __hip_bfloat16*stg=(__hip_bfloat16*)(shm+LDS_OST)+wid*4096;
    #pragma unroll
    for(int r=0;r<16;++r){const int orow=crow(r,hie);
      #pragma unroll
      for(int d0=0;d0<4;++d0)stg[orow*128+d0*32+r32e]=__float2bfloat16(o[d0][r]*rli[r]);}
    asm volatile("s_waitcnt lgkmcnt(0)":::"memory");
    #pragma unroll
    for(int i=0;i<8;++i){const int row=i*4+(le>>4),ch=le&15; const u32x4 v=*(const u32x4*)(stg+row*128+ch*8); *(u32x4*)(Ow+(long)row*OS+ch*8)=v;} }
  asm volatile("s_waitcnt lgkmcnt(0)\n\ts_barrier":::"memory");
  #undef DMA_K
  #undef DMA_V
  #undef CMASK
  #undef RESC
  #undef ROT
  #undef SETTG
  #undef SETREF
  #undef KX0
  #undef QX
}
#undef SBAR
#undef WAIT_BAR
}

constexpr float LOG2E = 1.4426950408889634f;
__device__ __forceinline__ int vcu_of(int bx, int G) { return (G % 8 == 0) ? (bx % 8) * (G / 8) + bx / 8 : bx; }
constexpr int ATT1_LDS_TAB = 141312;
__device__ __forceinline__ void attn1_tuned_phase(const Ctx& c, const bf16* qkv, const float* qkg  , bf16* R, unsigned* qctr, const ExpertSrc& es, unsigned char* ws,
                                                  const float* lamp, const float* subln, bf16* Oout) {
    LAS int* order = (LAS int*)(c.lds + ATT1_LDS_TAB);
    LAS int* nts = order + 256;
    LAS int* t0s = nts + 256;
    volatile LAS unsigned* nextu = (volatile LAS unsigned*)(t0s + 256);
    LAS float* bnd = (LAS float*)(t0s + 256 + 4);
    const int G = gridDim.x;
    if (c.wave == 0) { float gq = fabsf(qkg[c.lane]), gk = fabsf(qkg[64 + c.lane]);
#pragma unroll
        for (int o = 1; o < 64; o <<= 1) { gq = fmaxf(gq, __shfl_xor(gq, o)); gk = fmaxf(gk, __shfl_xor(gk, o)); }
        if (c.lane == 0) bnd[0] = 8.f * gq * gk * 1.02f; }
    __syncthreads();
    if (c.tid < 256) { const int h = c.tid >> 4, qb = c.tid & 15; const float slope = exp2f(-0.5f * (float)(h + 1));
        const int dmax = (int)fminf(ceilf((2.f * bnd[0] + 25.f) / slope), 1.0e6f), lo_ = 256 * qb - dmax, t0 = lo_ <= 0 ? 0 : ((lo_ >> 6) & ~1);
        nts[c.tid] = 4 * (qb + 1) - t0; t0s[c.tid] = t0; }
    __syncthreads();
    if (c.tid < 256) { const int mine = nts[c.tid]; int rank = 0;
        for (int e = 0; e < 256; ++e) { const int o = nts[e]; rank += (o > mine || (o == mine && e < c.tid)) ? 1 : 0; }
        order[rank] = c.tid; }
    __syncthreads();
#if FUSE_FINISH
    constexpr int NCH = DEFER_CONV ? EXP_ITEMS / 65 : 0, NUNIT = NB * 16 * 16, NPOS = NUNIT + NCH;
    static_assert(!DEFER_CONV || EXP_ITEMS % 65 == 0, "chunking");
    if (c.tid == 0) { float s01 = 0.f, s23 = 0.f; for (int i = 0; i < 64; ++i) { s01 += lamp[i] * lamp[64 + i]; s23 += lamp[128 + i] * lamp[192 + i]; }
      const float li = 0.8f - 0.6f * expf(-0.3f * 1.0f); bnd[1] = expf(s01) - expf(s23) + li; bnd[2] = li; }
    __syncthreads();
    unsigned p = blockIdx.x;
    while (p < (unsigned)NPOS) {
        unsigned nreg = 0u;
        if (c.tid == 0) nreg = __hip_atomic_fetch_add(qctr, 1u, __ATOMIC_RELAXED, __HIP_MEMORY_SCOPE_AGENT) + (unsigned)G;
        const bool inter = p < (unsigned)(NCH * 2);
        if (inter && (p & 1u)) {
            expert_items_block(c, es, 1, ws, (int)(p >> 1) * 65, 65);
        } else {
#define ATT1_DECODE() const unsigned u = inter ? (p >> 1) : p - (unsigned)NCH; const int ent = order[u >> 2], h = ent >> 4, qb = ent & 15, b = (int)(u & 3u), t0 = t0s[ent]; \
            bf16* Rblk = R + ((size_t)(b * T + qb * 256) * 16 + h) * 256
#if USE_V128
#pragma unroll 1
            for (int pass = 0; pass < 2; ++pass) {
                ATT1_DECODE();
                const int i = pass; att::UnitDesc ud;
                ud.Q = qkv + ((size_t)(2 * h + i) * M + (size_t)(b * T + qb * 256)) * 64; ud.qs = 64;
                ud.K = qkv + ((size_t)(32 + 2 * h + i) * M + (size_t)(b * T + 64 * t0)) * 64; ud.ks = 64;
                ud.V = qkv + ((size_t)(64 + 2 * h) * M + (size_t)(b * T + 64 * t0)) * 64; ud.vs = 64;
                ud.O = Rblk + 128 * i; ud.os = 16 * 256;
                ud.lse = nullptr; ud.lses = 0; ud.NT = 4 * (qb + 1) - t0; ud.rel0 = qb * 256 - 64 * t0; ud.tg0 = t0; ud.q0 = qb * 256;
                ud.slope2 = exp2f(-0.5f * (float)(h + 1)) * LOG2E; ud.sink2 = 0.f;
                att128::attn_unit<0, 8, 1, 16 * 256>(ud, (char*)c.lds);
            }
#else
#pragma unroll 1
            for (int pass = 0; pass < 4; ++pass) {
                ATT1_DECODE();
                const int i = pass >> 1, j = pass & 1; att::UnitDesc ud;
#if QKV_HEADMAJOR
                ud.Q = qkv + ((size_t)(2 * h + i) * M + (size_t)(b * T + qb * 256)) * 64; ud.qs = 64;
                ud.K = qkv + ((size_t)(32 + 2 * h + i) * M + (size_t)(b * T + 64 * t0)) * 64; ud.ks = 64;
                ud.V = qkv + ((size_t)(64 + 2 * h + j) * M + (size_t)(b * T + 64 * t0)) * 64; ud.vs = 64;
#else
                ud.Q = qkv + (size_t)(b * T + qb * 256) * C_IN + 128 * h + 64 * i; ud.qs = C_IN;
                ud.K = qkv + (size_t)(b * T + 64 * t0) * C_IN + 2048 + 128 * h + 64 * i; ud.ks = C_IN;
                ud.V = qkv + (size_t)(b * T + 64 * t0) * C_IN + 4096 + 128 * h + 64 * j; ud.vs = C_IN;
#endif
                ud.O = Rblk + 128 * i + 64 * j; ud.os = 16 * 256;
                ud.lse = nullptr; ud.lses = 0; ud.NT = 4 * (qb + 1) - t0; ud.rel0 = qb * 256 - 64 * t0; ud.tg0 = t0; ud.q0 = qb * 256;
                ud.slope2 = exp2f(-0.5f * (float)(h + 1)) * LOG2E; ud.sink2 = 0.f;
                att::attn_unit<0, 8, 1, 16 * 256>(ud, (char*)c.lds);
            }
#endif
            asm volatile("s_waitcnt vmcnt(0)" ::: "memory"); __syncthreads();
            { ATT1_DECODE(); (void)t0; const float lam = bnd[1], lam_init = bnd[2];
              int ft_ = threadIdx.x; asm volatile("" : "+v"(ft_));
              const int row = ft_ >> 1, hf = ft_ & 1; const bf16* p1 = Rblk + (size_t)row * (16 * 256) + 64 * hf; const bf16* p2 = p1 + 128;
              float xv[64]; float ss = 0.f;
#pragma unroll
              for (int q8 = 0; q8 < 8; ++q8) { const u32x4 a = *(const u32x4*)(p1 + 8 * q8), bq = *(const u32x4*)(p2 + 8 * q8);
#pragma unroll
                  for (int k = 0; k < 4; ++k) { const float x0 = bf2f(a[k] & 0xffffu) - lam * bf2f(bq[k] & 0xffffu), x1 = bf2f(a[k] >> 16) - lam * bf2f(bq[k] >> 16);
                      xv[8 * q8 + 2 * k] = x0; xv[8 * q8 + 2 * k + 1] = x1; ss += x0 * x0 + x1 * x1; } }
              ss += __shfl_xor(ss, 1);
              const float rs = (1.f - lam_init) / sqrtf(ss * (1.f / 128.f) + RMS_EPS);
              bf16* op = Oout + (size_t)(b * T + qb * 256 + row) * D + 128 * h + 64 * hf; const float* sg = subln + 64 * hf;
#pragma unroll
              for (int q8 = 0; q8 < 8; ++q8) { u32x4 w;
#pragma unroll
                  for (int k = 0; k < 4; ++k) w[k] = pk2(xv[8 * q8 + 2 * k] * rs * sg[8 * q8 + 2 * k], xv[8 * q8 + 2 * k + 1] * rs * sg[8 * q8 + 2 * k + 1]);
                  *(u32x4*)(op + 8 * q8) = w; } }
#undef ATT1_DECODE
        }
        if (c.tid == 0) nextu[0] = nreg;
        __syncthreads();
        p = nextu[0];
    }
}
#else
    constexpr int NCH = DEFER_CONV ? EXP_ITEMS / 65 : 0, NPOS = NB * 16 * 4 * 16 + NCH;
    static_assert(!DEFER_CONV || EXP_ITEMS % 65 == 0, "chunking");
    unsigned p = blockIdx.x;
    while (p < (unsigned)NPOS) {
        unsigned nreg = 0u;
        if (c.tid == 0) nreg = __hip_atomic_fetch_add(qctr, 1u, __ATOMIC_RELAXED, __HIP_MEMORY_SCOPE_AGENT) + (unsigned)G;
        const bool inter = p < (unsigned)(NCH * 6);
        if (inter && (p % 6u) == 5u) {
            expert_items_block(c, es, 1, ws, (int)(p / 6u) * 65, 65);
        } else {
            const unsigned u = inter ? p - p / 6u : p - (unsigned)NCH;
            const int ent = order[u >> 4], h = ent >> 4, qb = ent & 15, bp = (int)(u & 15u), b = bp >> 2, i = (bp >> 1) & 1, j = bp & 1, t0 = t0s[ent];
            att::UnitDesc ud;
#if QKV_HEADMAJOR
            ud.Q = qkv + ((size_t)(2 * h + i) * M + (size_t)(b * T + qb * 256)) * 64; ud.qs = 64;
            ud.K = qkv + ((size_t)(32 + 2 * h + i) * M + (size_t)(b * T + 64 * t0)) * 64; ud.ks = 64;
            ud.V = qkv + ((size_t)(64 + 2 * h + j) * M + (size_t)(b * T + 64 * t0)) * 64; ud.vs = 64;
#else
            ud.Q = qkv + (size_t)(b * T + qb * 256) * C_IN + 128 * h + 64 * i; ud.qs = C_IN;
            ud.K = qkv + (size_t)(b * T + 64 * t0) * C_IN + 2048 + 128 * h + 64 * i; ud.ks = C_IN;
            ud.V = qkv + (size_t)(b * T + 64 * t0) * C_IN + 4096 + 128 * h + 64 * j; ud.vs = C_IN;
#endif
            ud.O = R + ((size_t)(b * T + qb * 256) * 16 + h) * 256 + 128 * i + 64 * j; ud.os = 16 * 256;
            ud.lse = nullptr; ud.lses = 0; ud.NT = 4 * (qb + 1) - t0; ud.rel0 = qb * 256 - 64 * t0; ud.tg0 = t0; ud.q0 = qb * 256;
            ud.slope2 = exp2f(-0.5f * (float)(h + 1)) * LOG2E; ud.sink2 = 0.f;
            att::attn_unit<0, 8, 1, 16 * 256>(ud, (char*)c.lds);
        }
        if (c.tid == 0) nextu[0] = nreg;
        __syncthreads();
        p = nextu[0];
    }
}
#endif
__device__ __forceinline__ void attn1_finish_bf16_phase(const Ctx& c, const bf16* R, const float* lamp, const float* subln, bf16* O) {
    float s01 = 0.f, s23 = 0.f;
    for (int i = 0; i < 64; ++i) { s01 += lamp[i] * lamp[64 + i]; s23 += lamp[128 + i] * lamp[192 + i]; }
    const float lam_init = 0.8f - 0.6f * expf(-0.3f * 1.0f);
    const float lam = expf(s01) - expf(s23) + lam_init;
    const long total = (long)M * 16;
    for (long id = gtid_now(); id < total; id += c.gsz) {
        const bf16* p1 = R + (size_t)id * 256; const bf16* p2 = p1 + 128;
        float ss = 0.f;
#pragma unroll 4
        for (int i = 0; i < 16; ++i) { const u32x4 a = *(const u32x4*)(p1 + 8 * i), bq = *(const u32x4*)(p2 + 8 * i);
#pragma unroll
            for (int k = 0; k < 4; ++k) { const float x0 = bf2f(a[k] & 0xffffu) - lam * bf2f(bq[k] & 0xffffu), x1 = bf2f(a[k] >> 16) - lam * bf2f(bq[k] >> 16); ss += x0 * x0 + x1 * x1; } }
        const float rs = (1.f - lam_init) / sqrtf(ss * (1.f / 128.f) + RMS_EPS);
        bf16* op = O + (size_t)id * 128;
#pragma unroll 4
        for (int i = 0; i < 16; ++i) { const u32x4 a = *(const u32x4*)(p1 + 8 * i), bq = *(const u32x4*)(p2 + 8 * i); u32x4 w;
#pragma unroll
            for (int k = 0; k < 4; ++k) { const float x0 = bf2f(a[k] & 0xffffu) - lam * bf2f(bq[k] & 0xffffu), x1 = bf2f(a[k] >> 16) - lam * bf2f(bq[k] >> 16);
                w[k] = pk2(x0 * rs * subln[8 * i + 2 * k], x1 * rs * subln[8 * i + 2 * k + 1]); }
            *(u32x4*)(op + 8 * i) = w; }
    }
}
__device__ __forceinline__ void attn0_tuned_phase(const Ctx& c, const bf16* qkv, const float* sinks, bf16* OBR  , float* LSE  , bf16* O, int xlo, int xhi) {
    const int G = gridDim.x, vcu = vcu_of(blockIdx.x, G);
    for (int gid = vcu; gid < NB * 64; gid += G) {
        const int b = gid / 64, kind = (gid % 64) / 16, h = gid % 16;
        const float slope2 = exp2f(-0.5f * (float)(h + 1)) * LOG2E;
        if (kind < 3) {
            const int dil = kind == 0 ? 1 : (kind == 1 ? 4 : 16), nblk = 16 / dil;
            for (int x = xlo; x < xhi; ++x) {
                const int r = x / nblk, blk = x % nblk, q0 = blk * 256, t0 = blk ? 4 * blk - 2 : 0; att::UnitDesc u;
                const size_t qrow = (size_t)(b * T + r + dil * q0), krow = (size_t)(b * T + r + dil * 64 * t0);
#if QKV_HEADMAJOR
                u.Q = qkv + ((size_t)(h) * M + qrow) * 64; u.qs = (long)dil * 64;
                u.K = qkv + ((size_t)(16 + h) * M + krow) * 64; u.ks = (long)dil * 64;
                u.V = qkv + ((size_t)(32 + h) * M + krow) * 64; u.vs = (long)dil * 64;
#else
                u.Q = qkv + qrow * AB_IN + 64 * h; u.qs = (long)dil * AB_IN;
                u.K = qkv + krow * AB_IN + 1024 + 64 * h; u.ks = (long)dil * AB_IN;
                u.V = qkv + krow * AB_IN + 2048 + 64 * h; u.vs = (long)dil * AB_IN;
#endif
                u.O = OBR + ((size_t)kind * M + qrow) * 1024 + 64 * h; u.os = (long)dil * 1024;
                u.lse = LSE + ((size_t)kind * M + qrow) * 16 + h; u.lses = (long)dil * 16;
                u.NT = blk ? 6 : 4; u.rel0 = q0 - 64 * t0; u.tg0 = t0; u.q0 = q0; u.slope2 = slope2 * (float)dil; u.sink2 = 0.f;
                if (dil == 1) att::attn_unit<1, 8, 1, 1024>(u, (char*)c.lds); else if (dil == 4) att::attn_unit<1, 8, 4, 4096>(u, (char*)c.lds); else att::attn_unit<1, 8, 16, 16384>(u, (char*)c.lds);
            }
        } else {
            const int kvh = h >> 3;
            for (int x = xlo; x < xhi; ++x) {
                const int q0 = x * 256, t0 = x ? 4 * x - 2 : 0; att::UnitDesc u;
                const size_t qrow = (size_t)(b * T + q0), krow = (size_t)(b * T + 64 * t0);
#if QKV_HEADMAJOR
                u.Q = qkv + ((size_t)(48 + h) * M + qrow) * 64; u.qs = 64;
                u.K = qkv + ((size_t)(64 + kvh) * M + krow) * 64; u.ks = 64;
                u.V = qkv + ((size_t)(66 + kvh) * M + krow) * 64; u.vs = 64;
#else
                u.Q = qkv + qrow * AB_IN + 3072 + 64 * h; u.qs = AB_IN;
                u.K = qkv + krow * AB_IN + 4096 + 64 * kvh; u.ks = AB_IN;
                u.V = qkv + krow * AB_IN + 4224 + 64 * kvh; u.vs = AB_IN;
#endif
                u.O = O + qrow * D + 1024 + 64 * h; u.os = D;
                u.lse = nullptr; u.lses = 0;
                u.NT = x ? 6 : 4; u.rel0 = q0 - 64 * t0; u.tg0 = t0; u.q0 = q0; u.slope2 = slope2; u.sink2 = sinks[h] * LOG2E;
                att::attn_unit<2, 8, 1, D>(u, (char*)c.lds);
            }
        }
    }
}
__device__ __forceinline__ void attn0_merge_phase(const Ctx& c, const bf16* OBR, const float* LSE, bf16* O) {
    const long total = (long)M * 16;
    for (long id = gtid_now(); id < total; id += c.gsz) {
        const long m = id / 16; const int h = (int)(id % 16);
        const float l0 = LSE[id], l1 = LSE[(size_t)M * 16 + id], l2 = LSE[(size_t)2 * M * 16 + id];
        const float mx = fmaxf(l0, fmaxf(l1, l2)); float w0 = exp2f(l0 - mx), w1 = exp2f(l1 - mx), w2 = exp2f(l2 - mx); const float inv = 1.f / (w0 + w1 + w2); w0 *= inv; w1 *= inv; w2 *= inv;
        const bf16* p0 = OBR + (size_t)m * 1024 + 64 * h; const bf16* p1 = p0 + (size_t)M * 1024; const bf16* p2 = p1 + (size_t)M * 1024;
        bf16* op = O + (size_t)m * D + 64 * h;
#pragma unroll
        for (int i = 0; i < 8; ++i) { const u32x4 a = *(const u32x4*)(p0 + 8 * i), bq = *(const u32x4*)(p1 + 8 * i), cq = *(const u32x4*)(p2 + 8 * i); u32x4 w;
#pragma unroll
            for (int k = 0; k < 4; ++k) w[k] = pk2(w0 * bf2f(a[k] & 0xffffu) + w1 * bf2f(bq[k] & 0xffffu) + w2 * bf2f(cq[k] & 0xffffu), w0 * bf2f(a[k] >> 16) + w1 * bf2f(bq[k] >> 16) + w2 * bf2f(cq[k] >> 16));
            *(u32x4*)(op + 8 * i) = w; }
    }
}

__device__ __forceinline__ void convert_router(const Ctx& c, const float* wr, bf16* wrt) {
    for (int id2 = gtid_now(); id2 < 2 * NE * D; id2 += c.gsz) { const int l = id2 / (NE * D), id = id2 % (NE * D), k = id / NE, n = id % NE; const float w = wr[id2];
        const unsigned hb = f2bf(w); const float hf = bf2f(hb);
        const int off = l * 2 * NE * D + (((((k >> 8) * 8 + ((k >> 5) & 7)) * 4 + (n >> 4)) * 2) * 64 + ((n & 15) + 16 * ((k >> 3) & 3))) * 8 + (k & 7);
        wrt[off] = (bf16)hb; wrt[off + 512] = (bf16)f2bf(w - hf); }
}
#define DPPF(old, v, ctrl, rm) __int_as_float(__builtin_amdgcn_update_dpp(__float_as_int(old), __float_as_int(v), ctrl, rm, 0xf, false))
__device__ __forceinline__ float dpp_max8(float v) {
    v = fmaxf(v, DPPF(v, v, 0xB1, 0xf)); v = fmaxf(v, DPPF(v, v, 0x4E, 0xf)); v = fmaxf(v, DPPF(v, v, 0x141, 0xf)); return v; }
__device__ __forceinline__ float wave_max_u(float v) {
    v = dpp_max8(v); v = fmaxf(v, DPPF(v, v, 0x140, 0xf)); v = fmaxf(v, DPPF(v, v, 0x142, 0xa)); v = fmaxf(v, DPPF(v, v, 0x143, 0xc));
    return __int_as_float(__builtin_amdgcn_readlane(__float_as_int(v), 63)); }
__device__ __forceinline__ float wave_sum_u(float v) {
    v += DPPF(0.f, v, 0xB1, 0xf); v += DPPF(0.f, v, 0x4E, 0xf); v += DPPF(0.f, v, 0x141, 0xf); v += DPPF(0.f, v, 0x140, 0xf); v += DPPF(0.f, v, 0x142, 0xa); v += DPPF(0.f, v, 0x143, 0xc);
    return __int_as_float(__builtin_amdgcn_readlane(__float_as_int(v), 63)); }
constexpr int RT_ROUTER = 2;
__device__ __forceinline__ void router2_phase(const Ctx& c, const float* x1, const float* g, const float* ada_l, const bf16* wrt, const float* rbias,
                                              bf16* HF, int* idx, float* gate, int* wcnt, bf16* HFB = nullptr) {
    constexpr int RT = RT_ROUTER, RU = 16 * RT, NU = M / RU;
    LAS float* red = (LAS float*)c.lds;
    LAS float* part = (LAS float*)(c.lds + 1024);
    LAS float* GA = (LAS float*)(c.lds + 1024 + RT * 32768);
    LAS float* GB = GA + D;
    const int w = __builtin_amdgcn_readfirstlane((int)threadIdx.x >> 6);
    const float rb = rbias[threadIdx.x & 63];
    unsigned cnt = 0u;
    const int per = (NU + (int)gridDim.x - 1) / (int)gridDim.x, u0 = blockIdx.x * per, u1 = (u0 + per < NU) ? u0 + per : NU;
    int bcur = -1;
#pragma unroll 1
    for (int u = u0; u < u1; ++u) {
        int tid = threadIdx.x; asm volatile("" : "+v"(tid));
        const int lane = tid & 63, r = lane & 15, q = lane >> 4, cb = 256 * w + 8 * q;
        const bf16* wf = wrt + (size_t)w * (8 * 4 * 2 * 512) + lane * 8;
        const int m0 = u * RU, b = m0 / T;
        if (b != bcur) { bcur = b; __syncthreads();
            for (int col = 4 * tid; col < D; col += 2048) { const f32x4 gg = *(const f32x4*)(g + col), sc = *(const f32x4*)(ada_l + (size_t)b * 6 * D + 4 * D + col), sh = *(const f32x4*)(ada_l + (size_t)b * 6 * D + 3 * D + col);
                *(LAS f32x4*)(GA + col) = gg * (sc + 1.f); *(LAS f32x4*)(GB + col) = sh; } }
        u32x4 xv[RT][8]; float rstd[RT];
#pragma unroll
        for (int t = 0; t < RT; ++t) { const bf16* xr = (const bf16*)x1 + (size_t)(m0 + 16 * t + r) * D + cb;
#pragma unroll
            for (int kk = 0; kk < 8; ++kk) xv[t][kk] = *(const u32x4*)(xr + 32 * kk); }
#pragma unroll
        for (int t = 0; t < RT; ++t) { float ss = 0.f;
#pragma unroll
            for (int kk = 0; kk < 8; ++kk)
#pragma unroll
                for (int j = 0; j < 4; ++j) { const float a0 = bf2f(xv[t][kk][j] & 0xffffu), a1 = bf2f(xv[t][kk][j] >> 16); ss += a0 * a0 + a1 * a1; }
            ss += __shfl_xor(ss, 16); ss += __shfl_xor(ss, 32);
            if (q == 0) red[(t * 8 + w) * 16 + r] = ss; }
        __syncthreads();
        f32x4 acc[RT][4];
#pragma unroll
        for (int t = 0; t < RT; ++t) { float tot = 0.f;
#pragma unroll
            for (int w2 = 0; w2 < 8; ++w2) tot += red[(t * 8 + w2) * 16 + r];
            rstd[t] = 1.f / sqrtf(tot * (1.f / D) + RMS_EPS);
#pragma unroll
            for (int nt = 0; nt < 4; ++nt) acc[t][nt] = (f32x4){0.f, 0.f, 0.f, 0.f}; }
#pragma unroll
        for (int kk = 0; kk < 8; ++kk) {
            const f32x4 ga0 = *(LAS f32x4*)(GA + cb + 32 * kk), ga1 = *(LAS f32x4*)(GA + cb + 32 * kk + 4), gb0 = *(LAS f32x4*)(GB + cb + 32 * kk), gb1 = *(LAS f32x4*)(GB + cb + 32 * kk + 4);
            bf16x8 ah[RT], al[RT];
#pragma unroll
            for (int t = 0; t < RT; ++t) { const u32x4 xw = xv[t][kk]; f32x4 hh[2];
                hh[0] = (f32x4){bf2f(xw.x & 0xffffu), bf2f(xw.x >> 16), bf2f(xw.y & 0xffffu), bf2f(xw.y >> 16)} * rstd[t] * ga0 + gb0;
                hh[1] = (f32x4){bf2f(xw.z & 0xffffu), bf2f(xw.z >> 16), bf2f(xw.w & 0xffffu), bf2f(xw.w >> 16)} * rstd[t] * ga1 + gb1;
                u32x4 hw, lw;
#pragma unroll
                for (int s2 = 0; s2 < 2; ++s2) { const unsigned h0 = f2bf(hh[s2].x), h1 = f2bf(hh[s2].y), h2 = f2bf(hh[s2].z), h3 = f2bf(hh[s2].w);
                    hw[2 * s2] = h0 | (h1 << 16); hw[2 * s2 + 1] = h2 | (h3 << 16);
                    lw[2 * s2] = pk2(hh[s2].x - bf2f(h0), hh[s2].y - bf2f(h1)); lw[2 * s2 + 1] = pk2(hh[s2].z - bf2f(h2), hh[s2].w - bf2f(h3)); }
#if USE_FP8_MOE
                { u32x2 q8; q8.x = pk4_fp8(hh[0].x * F8_HSCALE, hh[0].y * F8_HSCALE, hh[0].z * F8_HSCALE, hh[0].w * F8_HSCALE); q8.y = pk4_fp8(hh[1].x * F8_HSCALE, hh[1].y * F8_HSCALE, hh[1].z * F8_HSCALE, hh[1].w * F8_HSCALE);
                  *(u32x2*)((unsigned char*)HF + (size_t)(m0 + 16 * t + r) * D + cb + 32 * kk) = q8; }
#if SHARED_BF16
                *(u32x4*)(HFB + (size_t)(m0 + 16 * t + r) * D + cb + 32 * kk) = hw;
#endif
#else
                *(u32x4*)(HF + (size_t)(m0 + 16 * t + r) * D + cb + 32 * kk) = hw;
#endif
                ah[t] = __builtin_bit_cast(bf16x8, hw); al[t] = __builtin_bit_cast(bf16x8, lw); }
#pragma unroll
            for (int nt = 0; nt < 4; ++nt) { const bf16x8 bh = *(const bf16x8*)(wf + ((kk * 4 + nt) * 2) * 512), bl = *(const bf16x8*)(wf + ((kk * 4 + nt) * 2 + 1) * 512);
#pragma unroll
                for (int t = 0; t < RT; ++t) {
                    acc[t][nt] = __builtin_amdgcn_mfma_f32_16x16x32_bf16(ah[t], bh, acc[t][nt], 0, 0, 0);
                    acc[t][nt] = __builtin_amdgcn_mfma_f32_16x16x32_bf16(ah[t], bl, acc[t][nt], 0, 0, 0);
                    acc[t][nt] = __builtin_amdgcn_mfma_f32_16x16x32_bf16(al[t], bh, acc[t][nt], 0, 0, 0); } }
            if (kk & 1) asm volatile("" ::: "memory");
        }
#pragma unroll
        for (int t = 0; t < RT; ++t)
#pragma unroll
            for (int nt = 0; nt < 4; ++nt)
#pragma unroll
                for (int j = 0; j < 4; ++j) part[((t * 8 + w) * 16 + 4 * q + j) * 64 + 16 * nt + r] = acc[t][nt][j];
        __syncthreads();
#pragma unroll 1
        for (int rp = 0; rp < RT; ++rp) {
            float score[2], cur[2]; int rank[2];
#pragma unroll
            for (int x = 0; x < 2; ++x) { const int row = 2 * RT * w + 2 * rp + x; float logit = 0.f;
#pragma unroll
                for (int w2 = 0; w2 < 8; ++w2) logit += part[(((row >> 4) * 8 + w2) * 16 + (row & 15)) * 64 + lane];
                score[x] = 1.f / (1.f + expf(-logit));
                const float sel = score[x] + rb;
                const float m1 = dpp_max8(sel);
                const unsigned long long eqm = __ballot(sel == m1);
                const unsigned grp_eq = (unsigned)((eqm >> (lane & ~7)) & 0xffull);
                const int first = __builtin_ctz(grp_eq);
                const float m2 = dpp_max8(((lane & 7) == first) ? -3e38f : sel);
                const float gs = m1 + m2;
                int grank = 0; const int mygrp = lane >> 3;
#pragma unroll
                for (int g2 = 0; g2 < 8; ++g2) { const float o = __int_as_float(__builtin_amdgcn_readlane(__float_as_int(gs), g2 * 8)); grank += (o > gs || (o == gs && g2 < mygrp)) ? 1 : 0; }
                cur[x] = (grank < 4) ? sel : -1e30f; rank[x] = 64; }
#pragma unroll
            for (int it = 0; it < TOPK; ++it)
#pragma unroll
                for (int x = 0; x < 2; ++x) { const float mx = wave_max_u(cur[x]); const int f = (int)__builtin_ctzll(__ballot(cur[x] == mx));
                    if (lane == f) { rank[x] = it; cur[x] = -3e38f; } }
#pragma unroll
            for (int x = 0; x < 2; ++x) { const int m = m0 + 2 * RT * w + 2 * rp + x; const bool chosen = rank[x] < TOPK;
                const float gsum = wave_sum_u(chosen ? score[x] : 0.f);
                if (chosen) { idx[(size_t)m * 8 + rank[x]] = lane | (int)(cnt << 8); gate[(size_t)m * 8 + rank[x]] = score[x] / gsum * 2.5f; cnt += 1u; } }
        }
        __syncthreads();
    }
    wcnt[(size_t)(blockIdx.x * 8 + w) * 64 + (threadIdx.x & 63)] = (int)cnt;
}
__device__ __forceinline__ void slot2_phase(const Ctx& c, const int* idx, const int* wcnt, unsigned* nrt_out, int* pos, int* slot_tok, int* tile_exp) {
    LAS int* ST = (LAS int*)c.lds;
    LAS int* SB = ST + 512;
    LAS int* SO = SB + 512;
    LAS int* tot = SO + 512;
    LAS int* bef = tot + 64;
    LAS int* ps = bef + 64;
    LAS int* base = ps + 128;
    const int e = c.tid & 63, p = c.tid >> 6, G = gridDim.x, blk = blockIdx.x;
    { int Tp = 0, Bp = 0;
#pragma unroll 32
      for (int b2 = 0; b2 < G; ++b2) { const int v = wcnt[(size_t)(b2 * 8 + p) * 64 + e]; Tp += v; Bp += (b2 < blk) ? v : 0; }
      ST[p * 64 + e] = Tp; SB[p * 64 + e] = Bp; SO[p * 64 + e] = wcnt[(size_t)(blk * 8 + p) * 64 + e]; }
    __syncthreads();
    if (c.tid < 64) { int t = 0, bb = 0;
#pragma unroll
        for (int p2 = 0; p2 < 8; ++p2) { t += ST[p2 * 64 + e]; bb += SB[p2 * 64 + e]; }
        tot[e] = t; bef[e] = bb; }
    __syncthreads();
    if (c.tid == 0) { int acc = 0; for (int e2 = 0; e2 < NE; ++e2) { ps[e2] = acc; acc += (tot[e2] + 255) / 256 * 256; } ps[64] = acc; }
    __syncthreads();
    { int o = ps[e] + bef[e];
      for (int p2 = 0; p2 < p; ++p2) o += SO[p2 * 64 + e];
      base[p * 64 + e] = o; }
    __syncthreads();
    {
        constexpr int RU = 16 * RT_ROUTER, NU = M / RU; const int per = (NU + G - 1) / G, mlo = blk * per * RU, mhi = (mlo + per * RU < M) ? mlo + per * RU : M;
        for (int i = c.tid; i < (mhi - mlo) * 8; i += 512) {
            const int m = mlo + (i >> 3), k = i & 7, wv = (m % RU) / (2 * RT_ROUTER); const size_t a = (size_t)m * 8 + k;
            const int code = idx[a], ee = code & 255, rk = code >> 8, slot = base[wv * 64 + ee] + rk;
            slot_tok[slot] = m; pos[a] = slot; }
    }
    for (int t = gtid_now(); t < M; t += c.gsz) slot_tok[CAPR + t] = t;
    if (blk == 0) {
        if (c.tid < NE) { const int s0 = ps[e], cn = tot[e], pe = s0 + (cn + 255) / 256 * 256;
            for (int s = s0 + cn; s < pe; ++s) slot_tok[s] = 0;
            for (int tt = s0 / 256; tt < pe / 256; ++tt) tile_exp[tt] = e; }
        if (c.tid == 0) *nrt_out = (unsigned)(ps[64] / 256);
    }
    __syncthreads();
}

template <int L> __device__ __forceinline__ void moe_up_tuned(const Ctx& c, unsigned char* ws) {
    const int nrt = (int)c.ctl[CW_NRT + L];
#if USE_FP8_MOE && SHARED_BF16
    { pg8::PlainSched S; S.o.init(M / 256, UPN / 256, gridDim.x, blockIdx.x); S.Bt = (const char*)(ws + WS_WUPS) + (size_t)L * UPN * D * 2; S.K = D;
      pg8::EpiUp E{(bf16*)(ws + WS_ACTS)}; pg8::gemm_phase(c.lds, (const char*)(ws + WS_HFB), D, S, E); }
    const int ntile = nrt;
#else
    const int ntile = nrt + M / 256;
#endif
    pg8::GroupSched<true> S; S.o.init(ntile, UPN / 256, gridDim.x, blockIdx.x);
    { LAS int* te = (LAS int*)(c.lds + 132096);
      for (int i = threadIdx.x; i < nrt; i += 512) te[i] = ((const int*)(ws + WS_TILEEXP))[i];
      __syncthreads(); S.tile_exp = te; }
    S.nrt = nrt; S.slot_tok = (const int*)(ws + WS_SLOTTOK);
#if USE_FP8_MOE
    S.W = (const char*)(ws + WS_WUP) + (size_t)L * NEX * UPN * D; S.wstride = (size_t)UPN * D; S.K = D / 2;
    pg8::EpiUp8 E{ws + WS_ACT}; pg8::gemm_phase<pg8::EpiUp8, pg8::GroupSched<true>, true>(c.lds, (const char*)(ws + WS_HF), D / 2, S, E);
#else
    S.W = (const char*)(ws + WS_WUP) + (size_t)L * NEX * UPN * D * 2; S.wstride = (size_t)UPN * D * 2; S.K = D;
    pg8::EpiUp E{(bf16*)(ws + WS_ACT)}; pg8::gemm_phase(c.lds, (const char*)(ws + WS_HF), D, S, E);
#endif
}
template <int L> __device__ __forceinline__ void moe_down_tuned(const Ctx& c, unsigned char* ws) {
    const int nrt = (int)c.ctl[CW_NRT + L];
#if USE_FP8_MOE && SHARED_BF16
    { pg8::PlainSched S; S.o.init(M / 256, D / 256, gridDim.x, blockIdx.x); S.Bt = (const char*)(ws + WS_WDNS) + (size_t)L * D * ED * 2; S.K = ED;
      pg8::EpiDown E{(bf16*)(ws + WS_Y), CAPR}; pg8::gemm_phase(c.lds, (const char*)(ws + WS_ACTS), ED, S, E); }
    const int ntile = nrt;
#else
    const int ntile = nrt + M / 256;
#endif
    pg8::GroupSched<false> S; S.o.init(ntile, D / 256, gridDim.x, blockIdx.x);
    { LAS int* te = (LAS int*)(c.lds + 132096);
      for (int i = threadIdx.x; i < nrt; i += 512) te[i] = ((const int*)(ws + WS_TILEEXP))[i];
      __syncthreads(); S.tile_exp = te; }
    S.nrt = nrt; S.slot_tok = (const int*)(ws + WS_SLOTTOK);
#if USE_FP8_MOE
    S.W = (const char*)(ws + WS_WDN) + (size_t)L * NEX * D * ED; S.wstride = (size_t)D * ED; S.K = ED / 2;
    pg8::EpiDown8 E{(bf16*)(ws + WS_Y)}; pg8::gemm_phase<pg8::EpiDown8, pg8::GroupSched<false>, true>(c.lds, (const char*)(ws + WS_ACT), ED / 2, S, E);
#else
    S.W = (const char*)(ws + WS_WDN) + (size_t)L * NEX * D * ED * 2; S.wstride = (size_t)D * ED * 2; S.K = ED;
    pg8::EpiDown E{(bf16*)(ws + WS_Y)}; pg8::gemm_phase(c.lds, (const char*)(ws + WS_ACT), ED, S, E);
#endif
}
template <int L> __device__ __forceinline__ void qkv_tuned(const Ctx& c, unsigned char* ws, const float* gains) {
    constexpr int NCOL = L == 0 ? AB_IN : C_IN; constexpr bool TUNED_ATT = L == 0 ? (USE_ATT0 != 0) : (USE_ATT1 != 0);
    pg8::PlainSched S; S.o.init(M / 256, NCOL / 256, gridDim.x, blockIdx.x); S.Bt = (const char*)(ws + (L == 0 ? WS_W0IN : WS_W1IN));
#if USE_FP8_QKV
    S.K = D / 2; pg8::EpiQKV<L> E{(bf16*)(ws + WS_QKV), NCOL, gains, TUNED_ATT ? att::C2 : 1.f, 1.f / (F8_HSCALE * F8_WSCALE)};
    pg8::gemm_phase<pg8::EpiQKV<L>, pg8::PlainSched, true>(c.lds, (const char*)(ws + WS_XN), D / 2, S, E);
#else
    S.K = D; pg8::EpiQKV<L> E{(bf16*)(ws + WS_QKV), NCOL, gains, TUNED_ATT ? att::C2 : 1.f, 1.f};
    pg8::gemm_phase(c.lds, (const char*)(ws + WS_XN), D, S, E);
#endif
}

template <int L> __device__ __forceinline__ void outproj_epi(const Ctx& c, unsigned char* ws, const pg8::PlainSched& S, const float* xin_f32, const float* gm) {
#if RES_BF16
    if (L == 0) { pg8::EpiOutB<false> E{xin_f32, gm, (bf16*)(ws + WS_X1)}; pg8::gemm_phase(c.lds, (const char*)(ws + WS_O), D, S, E); }
    else { pg8::EpiOutB<true> E{ws + WS_X1 + (size_t)M * D * 2, gm, (bf16*)(ws + WS_X1)}; pg8::gemm_phase(c.lds, (const char*)(ws + WS_O), D, S, E); }
#else
    pg8::EpiOut E{xin_f32, gm, (float*)(ws + WS_X1)}; pg8::gemm_phase(c.lds, (const char*)(ws + WS_O), D, S, E);
#endif
}
__global__ void __launch_bounds__(512, 2) mega(Args args) {
    extern __shared__ __attribute__((aligned(16))) unsigned char lds_raw[];
    Ctx c;
    c.lds = (LAS unsigned char*)lds_raw;
    c.tid = threadIdx.x; c.lane = c.tid & 63; c.wave = __builtin_amdgcn_readfirstlane(c.tid >> 6);
    c.gw = blockIdx.x * 8 + c.wave; c.ngw = gridDim.x * 8; c.gsz = gridDim.x * 512;
    c.ws = args.ws; c.ctl = (unsigned*)(args.ws + WS_CTL);
    volatile LAS unsigned* xbw = (volatile LAS unsigned*)(c.lds + LDS_BYTES - 16);
    if (c.tid < 4) xbw[c.tid] = 0u;
    __syncthreads();
    const int lo = args.ph_lo, hi = args.ph_hi;
    XcdBarrier bar; bar.bar = c.ctl + CW_BAR; bar.x = 0; bar.st = xbw;
    if (hi - lo > 1) bar = xcd_barrier_post(c.ctl + CW_BAR, xbw);
#ifdef PHASE_ONLY
#define IN(k) ((k) == PHASE_ONLY && lo <= (k) && (k) < hi)
#else
#define IN(k) (lo <= (k) && (k) < hi)
#endif
#define PHASE(k, ...) do { if (IN(k)) { __VA_ARGS__ } if (IN(k) && ((REPMASK >> (k)) & 1u)) { __syncthreads(); __VA_ARGS__ } } while (0);
#if PROBE_SEL >= 0
    volatile LAS unsigned long long* stamp_ = (volatile LAS unsigned long long*)(c.lds + 146000);
    if (c.tid == 0) stamp_[0] = __builtin_amdgcn_s_memrealtime();
#define SEAM(k) do { if (c.tid == 0) stamp_[1 + 2 * (k)] = __builtin_amdgcn_s_memrealtime(); if (IN(k) && IN((k) + 1)) xcd_barrier(bar); else __syncthreads(); \
        if (c.tid == 0) stamp_[2 + 2 * (k)] = __builtin_amdgcn_s_memrealtime(); } while (0)
#else
#define SEAM(k) do { if (IN(k) && IN((k) + 1)) xcd_barrier(bar); else __syncthreads(); } while (0)
#endif
    unsigned char* ws = args.ws;
#define XIN (args.in[0])
#define cin (args.in[1])
#define norm_mix (args.in[2])
#define norm_ffn (args.in[3])
#define w_ada (args.in[4])
#define b_ada (args.in[5])
#define ada ((float*)(ws + WS_ADA))
#define W0IN ((bf16*)(ws + WS_W0IN))
#define W0OUT ((bf16*)(ws + WS_W0OUT))
#define W1IN ((bf16*)(ws + WS_W1IN))
#define W1OUT ((bf16*)(ws + WS_W1OUT))
#define WUP ((bf16*)(ws + WS_WUP))
#define WDN ((bf16*)(ws + WS_WDN))
#define XN ((bf16*)(ws + WS_XN))
#define QKV ((bf16*)(ws + WS_QKV))
#define OBUF ((bf16*)(ws + WS_O))
#define X1 ((float*)(ws + WS_X1))
#define HF ((bf16*)(ws + WS_HF))
#define IDX ((int*)(ws + WS_IDX))
#define GATE ((float*)(ws + WS_GATE))
#define POS ((int*)(ws + WS_POS))
#define SLOTTOK ((int*)(ws + WS_SLOTTOK))
#define TILEEXP ((int*)(ws + WS_TILEEXP))
#define ACT ((bf16*)(ws + WS_ACT))
#define Y ((bf16*)(ws + WS_Y))
#define TMP ((float*)(ws + WS_TMP))
#define OUTP (args.out)

    PHASE(0, {
        constexpr int QM = USE_PG8_QKV ? 1 : 0, UM = USE_PG8_MOE ? 2 : 0;
#if USE_CONV128 && USE_FP8_MOE
        convert_dense_all<QM, USE_FP8_QKV != 0>(c, args.in[6], args.in[10], args.in[9], args.in[14], (unsigned char*)W0IN, (unsigned char*)W1IN, (unsigned char*)W0OUT, (unsigned char*)W1OUT, USE_FP8_QKV ? F8_WSCALE : 1.f);
#if !(DEFER_CONV && USE_ATT0 && USE_ATT1 && !SHARED_BF16)
        for (int l = 0; l < 2; ++l) {
            convert_batch128<2, true>(c, args.in[17] + (size_t)l * NE * D * UPN, D, UPN, (unsigned char*)WUP + (size_t)l * NEX * UPN * D, NE, (size_t)UPN * D, F8_WSCALE);
            convert_batch128<0, true>(c, args.in[18] + (size_t)l * NE * ED * D, ED, D, (unsigned char*)WDN + (size_t)l * NEX * D * ED, NE, (size_t)D * ED, F8_WSCALE);
#if SHARED_BF16
            convert_batch128<2, false>(c, args.in[19] + (size_t)l * D * UPN, D, UPN, ws + WS_WUPS + (size_t)l * UPN * D * 2, 1, 0, 1.f);
            convert_batch128<0, false>(c, args.in[20] + (size_t)l * ED * D, ED, D, ws + WS_WDNS + (size_t)l * D * ED * 2, 1, 0, 1.f);
#else
            convert_batch128<2, true>(c, args.in[19] + (size_t)l * D * UPN, D, UPN, (unsigned char*)WUP + ((size_t)l * NEX + NE) * UPN * D, 1, 0, F8_WSCALE);
            convert_batch128<0, true>(c, args.in[20] + (size_t)l * ED * D, ED, D, (unsigned char*)WDN + ((size_t)l * NEX + NE) * D * ED, 1, 0, F8_WSCALE);
#endif
        }
#endif
#else
        convert_batch<QM>(c, args.in[6], D, AB_IN, W0IN, 1, 0);
        convert_batch<0>(c, args.in[9], D, D, W0OUT, 1, 0);
        convert_batch<QM>(c, args.in[10], D, C_IN, W1IN, 1, 0);
        convert_batch<0>(c, args.in[14], D, D, W1OUT, 1, 0);
        for (int l = 0; l < 2; ++l) {
#if USE_FP8_MOE
            convert_batch_f8<2>(c, args.in[17] + (size_t)l * NE * D * UPN, D, UPN, (unsigned char*)WUP + (size_t)l * NEX * UPN * D, NE, (size_t)UPN * D);
            convert_batch_f8<2>(c, args.in[19] + (size_t)l * D * UPN, D, UPN, (unsigned char*)WUP + ((size_t)l * NEX + NE) * UPN * D, 1, 0);
            convert_batch_f8<0>(c, args.in[18] + (size_t)l * NE * ED * D, ED, D, (unsigned char*)WDN + (size_t)l * NEX * D * ED, NE, (size_t)D * ED);
            convert_batch_f8<0>(c, args.in[20] + (size_t)l * ED * D, ED, D, (unsigned char*)WDN + ((size_t)l * NEX + NE) * D * ED, 1, 0);
#else
            convert_batch<UM>(c, args.in[17] + (size_t)l * NE * D * UPN, D, UPN, WUP + (size_t)l * NEX * UPN * D, NE, (size_t)UPN * D);
            convert_batch<UM>(c, args.in[19] + (size_t)l * D * UPN, D, UPN, WUP + ((size_t)l * NEX + NE) * UPN * D, 1, 0);
            convert_batch<0>(c, args.in[18] + (size_t)l * NE * ED * D, ED, D, WDN + (size_t)l * NEX * D * ED, NE, (size_t)D * ED);
            convert_batch<0>(c, args.in[20] + (size_t)l * ED * D, ED, D, WDN + ((size_t)l * NEX + NE) * D * ED, 1, 0);
#endif
        }
#endif
        convert_router(c, args.in[15], (bf16*)(ws + WS_WRT));
        __syncthreads();
        ada_phase(c, cin, w_ada, b_ada, ada);
    })
    SEAM(0);
    PHASE(1, norm_phase(c, XIN, norm_mix, ada, 0, D, XN);)
    SEAM(1);
#if USE_PG8_QKV
    PHASE(2, qkv_tuned<0>(c, ws, args.in[7]);)
    SEAM(2);
#else
    PHASE(2, gemm_plain_bf16(c, XN, W0IN, D, AB_IN, QKV);)
    SEAM(2);
#endif
#if USE_ATT0
    static_assert(USE_PG8_QKV, "the tuned attention needs Q pre-scaled by the QKV epilogue");
    #if DEFER_CONV
    PHASE(3, { const int xs_ = vcu_of(blockIdx.x, gridDim.x) & 15;
        attn0_tuned_phase(c, QKV, args.in[8], (bf16*)(ws + WS_TMP), (float*)(ws + WS_TMP + (size_t)3 * M * 1024 * 2), OBUF, 0, xs_ + 1);
        { const int cshare = (EXP_ITEMS + (int)gridDim.x - 1) / (int)gridDim.x, cfirst = blockIdx.x * cshare, ccount = (cfirst + cshare <= EXP_ITEMS) ? cshare : (EXP_ITEMS > cfirst ? EXP_ITEMS - cfirst : 0);
          expert_items_block(c, ExpertSrc{args.in[17], args.in[19], args.in[18], args.in[20]}, 0, ws, cfirst, ccount); __syncthreads(); }
        attn0_tuned_phase(c, QKV, args.in[8], (bf16*)(ws + WS_TMP), (float*)(ws + WS_TMP + (size_t)3 * M * 1024 * 2), OBUF, xs_ + 1, 16); })
#else
    PHASE(3, attn0_tuned_phase(c, QKV, args.in[8], (bf16*)(ws + WS_TMP), (float*)(ws + WS_TMP + (size_t)3 * M * 1024 * 2), OBUF, 0, 16);)
#endif
    SEAM(3);
    PHASE(4, attn0_merge_phase(c, (const bf16*)(ws + WS_TMP), (const float*)(ws + WS_TMP + (size_t)3 * M * 1024 * 2), OBUF);)
    SEAM(4);
#else
#if !USE_PG8_QKV
    PHASE(3, qknorm0_phase(c, QKV, args.in[7]);)
#endif
    SEAM(3);
    PHASE(4, attn0_phase(c, QKV, args.in[8], OBUF);)
    SEAM(4);
#endif
#if USE_PG8_OUT
    PHASE(5, { pg8::PlainSched S; S.o.init(M / 256, D / 256, gridDim.x, blockIdx.x); S.Bt = (const char*)W0OUT; S.K = D;
        outproj_epi<0>(c, ws, S, XIN, ada + 2 * D); })
#else
    PHASE(5, gemm_outproj(c, OBUF, W0OUT, XIN, ada + 2 * D, X1);)
#endif
    SEAM(5);
#if USE_ROUTER2
    PHASE(6, router2_phase(c, X1, norm_ffn, ada, (const bf16*)(ws + WS_WRT), args.in[16], HF, IDX, GATE, (int*)(ws + WS_WCNT), (bf16*)(ws + WS_HFB));)
    SEAM(6);
    PHASE(7, slot2_phase(c, IDX, (const int*)(ws + WS_WCNT), c.ctl + CW_NRT, POS, SLOTTOK, TILEEXP);)
#else
    PHASE(6, router_phase(c, X1, norm_ffn, ada, args.in[15], args.in[16], HF, IDX, GATE, c.ctl + CW_CNT);)
    SEAM(6);
    PHASE(7, slot_phase(c, IDX, c.ctl + CW_CNT, c.ctl + CW_CUR, c.ctl + CW_NRT, POS, SLOTTOK, TILEEXP);)
#endif
    SEAM(7);
#if USE_PG8_MOE
    PHASE(8, moe_up_tuned<0>(c, ws);)
    SEAM(8);
    PHASE(9, moe_down_tuned<0>(c, ws);)
#else
    PHASE(8, moe_up_phase(c, HF, WUP, SLOTTOK, TILEEXP, c.ctl + CW_NRT, ACT);)
    SEAM(8);
    PHASE(9, moe_down_phase(c, ACT, WDN, TILEEXP, c.ctl + CW_NRT, Y);)
#endif
    SEAM(9);
    PHASE(10, combine_phase<true>(c, X1, Y, POS, GATE, ada, RES_BF16 ? (float*)(ws + WS_X1 + (size_t)M * D * 2) : OUTP, norm_mix + D, ada + (size_t)4 * 6 * D, XN);)
    SEAM(10);
#define ada1 (ada + (size_t)4 * 6 * D)
#if USE_PG8_QKV
    PHASE(11, qkv_tuned<1>(c, ws, args.in[11]);)
    SEAM(11);
    SEAM(12);
#else
    PHASE(11, gemm_plain_bf16(c, XN, W1IN, D, C_IN, QKV);)
    SEAM(11);
    PHASE(12, qknorm1_phase(c, QKV, args.in[11]);)
    SEAM(12);
#endif
#if USE_ATT1
    PHASE(13, attn1_tuned_phase(c, QKV, args.in[11], (bf16*)TMP, c.ctl + CW_QCTR, ExpertSrc{args.in[17], args.in[19], args.in[18], args.in[20]}, ws, args.in[12], args.in[13], OBUF);)
    SEAM(13);
#if !FUSE_FINISH
    PHASE(14, attn1_finish_bf16_phase(c, (const bf16*)TMP, args.in[12], args.in[13], OBUF);)
#endif
    SEAM(14);
#else
    PHASE(13, attn1_phase(c, QKV, TMP);)
    SEAM(13);
    PHASE(14, attn1_finish_phase(c, TMP, args.in[12], args.in[13], OBUF);)
    SEAM(14);
#endif
#if USE_PG8_OUT
    PHASE(15, { pg8::PlainSched S; S.o.init(M / 256, D / 256, gridDim.x, blockIdx.x); S.Bt = (const char*)W1OUT; S.K = D;
        outproj_epi<1>(c, ws, S, OUTP, ada1 + 2 * D); })
#else
    PHASE(15, gemm_outproj(c, OBUF, W1OUT, OUTP, ada1 + 2 * D, X1);)
#endif
    SEAM(15);
#if USE_ROUTER2
    PHASE(16, router2_phase(c, X1, norm_ffn + D, ada1, (const bf16*)(ws + WS_WRT) + (size_t)2 * NE * D, args.in[16] + NE, HF, IDX, GATE, (int*)(ws + WS_WCNT), (bf16*)(ws + WS_HFB));)
    SEAM(16);
    PHASE(17, slot2_phase(c, IDX, (const int*)(ws + WS_WCNT), c.ctl + CW_NRT + 1, POS, SLOTTOK, TILEEXP);)
#else
    PHASE(16, router_phase(c, X1, norm_ffn + D, ada1, args.in[15] + (size_t)D * NE, args.in[16] + NE, HF, IDX, GATE, c.ctl + CW_CNT + 64);)
    SEAM(16);
    PHASE(17, slot_phase(c, IDX, c.ctl + CW_CNT + 64, c.ctl + CW_CUR + 64, c.ctl + CW_NRT + 1, POS, SLOTTOK, TILEEXP);)
#endif
    SEAM(17);
#if USE_PG8_MOE
    PHASE(18, moe_up_tuned<1>(c, ws);)
    SEAM(18);
    PHASE(19, moe_down_tuned<1>(c, ws);)
#else
    PHASE(18, moe_up_phase(c, HF, WUP + (size_t)NEX * UPN * D, SLOTTOK, TILEEXP, c.ctl + CW_NRT + 1, ACT);)
    SEAM(18);
    PHASE(19, moe_down_phase(c, ACT, WDN + (size_t)NEX * D * ED, TILEEXP, c.ctl + CW_NRT + 1, Y);)
#endif
    SEAM(19);
    PHASE(20, combine_phase<false>(c, X1, Y, POS, GATE, ada1, OUTP, nullptr, nullptr, nullptr);)
#if PROBE_SEL >= 0
    {
        __syncthreads();
        unsigned long long v = 0ull;
        if (c.tid == 0) {
            if (PROBE_SEL >= 100) { const int k = PROBE_SEL - 100; v = stamp_[2 + 2 * k] - (k == 0 ? stamp_[0] : stamp_[2 + 2 * (k - 1)]); }
            else if (PROBE_SEL == 1 || PROBE_SEL == 2) { for (int k = 0; k < NPHASE - 1; ++k) v += stamp_[2 + 2 * k] - stamp_[1 + 2 * k]; }
            else if (PROBE_SEL == 3) { v = stamp_[1 + 2 * 19] - stamp_[0]; }
        }
        if (PROBE_SEL == 2) {
            if (c.tid == 0) __hip_atomic_fetch_add((unsigned long long*)(c.ctl + CW_QCTR + 64), v, __ATOMIC_RELAXED, __HIP_MEMORY_SCOPE_AGENT);
            xcd_barrier(bar);
            if (c.tid == 0) v = __hip_atomic_load((unsigned long long*)(c.ctl + CW_QCTR + 64), __ATOMIC_RELAXED, __HIP_MEMORY_SCOPE_AGENT) / gridDim.x;
        }
        if (blockIdx.x == 0 && c.tid == 0) { const unsigned long long t0 = __builtin_amdgcn_s_memrealtime(), w = v * PROBE_GAIN;
            while (__builtin_amdgcn_s_memrealtime() - t0 < w) __builtin_amdgcn_s_sleep(8); }
    }
#endif
#undef IN
#undef SEAM
#undef ada
#undef ada1
#undef W0IN
#undef W0OUT
#undef W1IN
#undef W1OUT
#undef WUP
#undef WDN
#undef XN
#undef QKV
#undef OBUF
#undef X1
#undef HF
#undef IDX
#undef GATE
#undef POS
#undef SLOTTOK
#undef TILEEXP
#undef ACT
#undef Y
#undef TMP
#undef XIN
#undef cin
#undef norm_mix
#undef norm_ffn
#undef w_ada
#undef b_ada
#undef OUTP
}

extern "C" void kernel_launch(void* const* d_in, const int* in_sizes, int n_in, void* d_out, int out_size, void* d_ws, size_t ws_size, hipStream_t stream) {
    static int grid = 0;
    if (grid == 0) {
        if (n_in != 21 || out_size != M * D || ws_size < WS_END) { fprintf(stderr, "kernel_launch: unexpected sizes (n_in %d out %d ws %zu need %zu)\n", n_in, out_size, ws_size, (size_t)WS_END); grid = -1; return; }
        int dev = 0, cus = 0, per_cu = 0;
        hipGetDevice(&dev); hipDeviceGetAttribute(&cus, hipDeviceAttributeMultiprocessorCount, dev);
        if (hipFuncSetAttribute((const void*)mega, hipFuncAttributeMaxDynamicSharedMemorySize, LDS_BYTES) != hipSuccess) { fprintf(stderr, "kernel_launch: hipFuncSetAttribute failed\n"); grid = -1; return; }
        hipOccupancyMaxActiveBlocksPerMultiprocessor(&per_cu, (const void*)mega, 512, LDS_BYTES);
        (void)hipGetLastError();
        if (per_cu < 1) fprintf(stderr, "kernel_launch: occupancy query says %d blocks per CU\n", per_cu);
        grid = cus;
    }
    if (grid < 0) return;
    hipMemsetAsync((char*)d_ws + WS_CTL, 0, CTL_BYTES, stream);
    Args a{};
    for (int i = 0; i < 21; ++i) a.in[i] = (const float*)d_in[i];
    a.out = (float*)d_out; a.ws = (unsigned char*)d_ws;
#if MK_SPLIT
    for (int p = 0; p < NPHASE; ++p) { a.ph_lo = p; a.ph_hi = p + 1; hipLaunchKernelGGL(mega, dim3(grid), dim3(512), LDS_BYTES, stream, a); }
#else
    a.ph_lo = 0; a.ph_hi = NPHASE; hipLaunchKernelGGL(mega, dim3(grid), dim3(512), LDS_BYTES, stream, a);
#endif
}
```

```cpp
#include <hip/hip_runtime.h>
#include <cstdio>
#include <cstdint>
#include <hip/hip_bf16.h>

#ifndef USE_PG8_OUT
#define USE_PG8_OUT 1
#endif
#ifndef USE_PG8_QKV
#define USE_PG8_QKV 1
#endif
#ifndef USE_PG8_MOE
#define USE_PG8_MOE 1
#endif
#ifndef USE_ATT1
#define USE_ATT1 1
#endif
#ifndef USE_ATT0
#define USE_ATT0 1
#endif
#ifndef USE_ROUTER2
#define USE_ROUTER2 1
#endif
#ifndef REPMASK
#define REPMASK 0u
#endif
#ifndef USE_FP8_MOE
#define USE_FP8_MOE 1
#endif
#ifndef USE_CONV128
#define USE_CONV128 1
#endif
#ifndef USE_FP8_QKV
#define USE_FP8_QKV 1
#endif
#ifndef SHARED_BF16
#define SHARED_BF16 0
#endif
#ifndef Y_FP8
#define Y_FP8 1
#endif
#ifndef DEFER_CONV
#define DEFER_CONV 1
#endif
#ifndef RES_BF16
#define RES_BF16 1
#endif
#ifndef FUSE_FINISH
#define FUSE_FINISH 1
#endif
#ifndef PROBE_SEL
#define PROBE_SEL -1
#endif
#ifndef PROBE_GAIN
#define PROBE_GAIN 4
#endif
#ifndef QKV_HEADMAJOR
#define QKV_HEADMAJOR 1
#endif
#ifndef USE_V128
#define USE_V128 1
#endif
#ifndef MK_SPLIT
#define MK_SPLIT 0
#endif

constexpr int D = 2048, NB = 4, T = 4096, M = NB * T;
constexpr int HD = 64;
constexpr int AB_IN = 4352, C_IN = 6144;
constexpr int NE = 64, TOPK = 8, ED = 512;
constexpr int UPN = 2 * ED;
constexpr int NEX = NE + 1;
constexpr int CAPR = M * TOPK + NE * 256;
constexpr int CAP = CAPR + M;
constexpr int MAXTILES = CAP / 256;
constexpr float RMS_EPS = 1e-6f;
constexpr int NPHASE = 21;

typedef unsigned short bf16;
typedef short bf16x8 __attribute__((ext_vector_type(8)));
typedef float f32x4 __attribute__((ext_vector_type(4)));
typedef unsigned u32x4 __attribute__((ext_vector_type(4)));
typedef unsigned u32x2 __attribute__((ext_vector_type(2)));
#define LAS __attribute__((address_space(3)))

constexpr size_t MiB = 1u << 20;
constexpr size_t WS_CTL = 0, CTL_BYTES = 1 * MiB;
constexpr size_t WS_ADA = 1 * MiB;
constexpr size_t WS_W0IN = 2 * MiB;
constexpr size_t WS_W0OUT = WS_W0IN + (size_t)AB_IN * D * 2;
constexpr size_t WS_W1IN = WS_W0OUT + (size_t)D * D * 2;
constexpr size_t WS_W1OUT = WS_W1IN + (size_t)C_IN * D * 2;
constexpr size_t WS_WUP = WS_W1OUT + (size_t)D * D * 2;
constexpr size_t WS_WDN = WS_WUP + (size_t)2 * NEX * UPN * D * 2;
constexpr size_t WS_XN = WS_WDN + (size_t)2 * NEX * D * ED * 2;
constexpr size_t WS_QKV = WS_XN + (size_t)M * D * 2;
constexpr size_t WS_O = WS_QKV + (size_t)M * C_IN * 2;
constexpr size_t WS_X1 = WS_O + (size_t)M * D * 2;
constexpr size_t WS_HF = WS_X1 + (size_t)M * D * 4;
constexpr size_t WS_IDX = WS_HF + (size_t)M * D * 2;
constexpr size_t WS_GATE = WS_IDX + (size_t)M * 8 * 4;
constexpr size_t WS_POS = WS_GATE + (size_t)M * 8 * 4;
constexpr size_t WS_SLOTTOK = WS_POS + (size_t)M * 8 * 4;
constexpr size_t WS_TILEEXP = WS_SLOTTOK + (size_t)CAP * 4;
constexpr size_t WS_ACT = WS_TILEEXP + 4096;
constexpr size_t WS_Y = WS_ACT + (size_t)CAP * ED * 2;
constexpr size_t WS_TMP = WS_Y + (size_t)CAP * D * 2;
constexpr size_t WS_WRT = WS_TMP + (size_t)M * 16 * 2 * 128 * 4;
constexpr size_t WS_WCNT = WS_WRT + (size_t)2 * 2 * NE * D * 2;
constexpr size_t WS_HFB = WS_WCNT + (size_t)4096 * 64 * 4;
constexpr size_t WS_ACTS = WS_HFB + (size_t)M * D * 2;
constexpr size_t WS_WUPS = WS_ACTS + (size_t)M * ED * 2;
constexpr size_t WS_WDNS = WS_WUPS + (size_t)2 * UPN * D * 2;
constexpr size_t WS_END = WS_WDNS + (size_t)2 * D * ED * 2;
constexpr int CW_BAR = 4096;
constexpr int CW_CNT = 16384;
constexpr int CW_CUR = 16384 + 256;
constexpr int CW_NRT = 16384 + 512;
constexpr int CW_QCTR = 16384 + 1024;

constexpr int LDS_BYTES = 147456;

__device__ __forceinline__ unsigned pk4_fp8(float a, float b, float c2, float d);
constexpr float F8_WSCALE = 256.f, F8_HSCALE = 16.f, F8_ASCALE = 8.f, F8_YSCALE = 32.f;
__device__ __forceinline__ float bf2f(unsigned v) { return __uint_as_float(v << 16); }
__device__ __forceinline__ unsigned f2bf(float f) { unsigned u = __float_as_uint(f); return (u + 0x7fffu + ((u >> 16) & 1u)) >> 16; }
__device__ __forceinline__ unsigned pk2(float lo, float hi) { return f2bf(lo) | (f2bf(hi) << 16); }
__device__ __forceinline__ float wave_sum(float v) {
#pragma unroll
    for (int o = 1; o < 64; o <<= 1) v += __shfl_xor(v, o);
    return v;
}
__device__ __forceinline__ float siluf(float x) { return x / (1.f + __expf(-x)); }

#define XB_TMO      128
#define XB_XCNT(j)  (256  + 64 * (j))
#define XB_XSUB(j)  (1280 + 64 * (j))
#define XB_XGEN(j)  (2304 + 64 * (j))
#define XB_TOP      3328
#define XB_TOPGEN   3392
#define XCD_BAR_WORDS 3456
#define XB_SPIN_CAP (1u << 22)
__device__ __forceinline__ unsigned xb_ld(unsigned* p)              { return __hip_atomic_load(p, __ATOMIC_RELAXED, __HIP_MEMORY_SCOPE_AGENT); }
__device__ __forceinline__ unsigned xb_add(unsigned* p, unsigned v) { return __hip_atomic_fetch_add(p, v, __ATOMIC_RELAXED, __HIP_MEMORY_SCOPE_AGENT); }
__device__ __forceinline__ unsigned xb_xcc_id() { return (unsigned)__builtin_amdgcn_s_getreg((3 << 11) | 20) & 0xFu; }
#define XB_SPIN(cond, bar) do { unsigned _sp = 0; while (cond) { __builtin_amdgcn_s_sleep(1); \
    if ((++_sp & 255u) == 0u) { if (xb_ld(&(bar)[XB_TMO])) break; if (_sp > XB_SPIN_CAP) { atomicAdd(&(bar)[XB_TMO], 1u); break; } } } } while (0)
struct XcdBarrier { unsigned* bar; unsigned x; volatile LAS unsigned* st; };
__device__ __forceinline__ XcdBarrier xcd_barrier_post(unsigned* bar, volatile LAS unsigned* st) {
    XcdBarrier b; b.bar = bar; b.x = xb_xcc_id(); b.st = st;
    if (threadIdx.x == 0) (void)xb_add(&bar[XB_XCNT(b.x)], 1u);
    return b;
}
__device__ __forceinline__ void xcd_barrier_complete(unsigned* bar, unsigned x, unsigned& nloc, unsigned& nx) {
    const unsigned G = gridDim.x * gridDim.y * gridDim.z;
    unsigned sum, cnt, mine, sp = 0u;
    for (;;) {
        sum = 0u; cnt = 0u; mine = 0u;
#pragma unroll
        for (unsigned j = 0; j < 16; ++j) { const unsigned c = xb_ld(&bar[XB_XCNT(j)]); sum += c; cnt += (c > 0u) ? 1u : 0u; mine = (j == x) ? c : mine; }
        if (sum == G) break;
        __builtin_amdgcn_s_sleep(1);
        if ((++sp & 255u) == 0u) { if (xb_ld(&bar[XB_TMO])) break; if (sp > XB_SPIN_CAP) { atomicAdd(&bar[XB_TMO], 1u); break; } }
    }
    nloc = mine > 0u ? mine : 1u; nx = cnt > 0u ? cnt : 1u;
}
__device__ __forceinline__ void xcd_barrier(const XcdBarrier& b) {
    asm volatile("s_waitcnt vmcnt(0)" ::: "memory");
    __syncthreads();
    if (threadIdx.x == 0) {
        unsigned* bar = b.bar;
        __builtin_amdgcn_s_waitcnt(0);
        unsigned nloc = b.st[0], nx = b.st[1];
        if (nloc == 0u) { xcd_barrier_complete(bar, b.x, nloc, nx); b.st[0] = nloc; b.st[1] = nx; }
        const unsigned old = xb_add(&bar[XB_XSUB(b.x)], 1u);
        const unsigned gen = old / nloc;
        if (old + 1u == (gen + 1u) * nloc) {
            __builtin_amdgcn_fence(__ATOMIC_RELEASE, "agent");
            asm volatile("s_waitcnt vmcnt(0)" ::: "memory");
            const unsigned og = xb_add(&bar[XB_TOP], 1u);
            const unsigned tg = og / nx;
            if (og + 1u == (tg + 1u) * nx) xb_add(&bar[XB_TOPGEN], 1u);
            else XB_SPIN(xb_ld(&bar[XB_TOPGEN]) == tg, bar);
            __builtin_amdgcn_fence(__ATOMIC_ACQUIRE, "agent");
            xb_add(&bar[XB_XGEN(b.x)], 1u);
            asm volatile("s_waitcnt vmcnt(0)" ::: "memory");
        } else {
            XB_SPIN(xb_ld(&bar[XB_XGEN(b.x)]) == gen, bar);
            __builtin_amdgcn_fence(__ATOMIC_ACQUIRE, "agent");
            asm volatile("s_waitcnt vmcnt(0)" ::: "memory");
        }
    }
    __syncthreads();
}

struct Args {
    const float* in[21];
    float* out;
    unsigned char* ws;
    int ph_lo, ph_hi;
};

struct Ctx {
    int tid, lane, wave, gw, ngw, gsz;
    LAS unsigned char* lds;
    unsigned char* ws;
    unsigned* ctl;
};

__device__ __forceinline__ int gtid_now() { int t = (int)(blockIdx.x * 512u + threadIdx.x); asm volatile("" : "+v"(t)); return t; }
template <int MODE> __device__ __forceinline__ int perm_row(int n) {
    if (MODE == 1) { const int nl = n & 255; return (n & ~255) + 128 * ((nl >> 5) & 1) + 32 * (nl >> 6) + (nl & 31); }
    if (MODE == 2) { const int bj = n >> 9, rem = n & 511; return 256 * (rem >> 7) + 128 * bj + (rem & 127); }
    return n;
}
template <int MODE> __device__ __forceinline__ void transpose_item(const float* W, int K, int N, bf16* WT, LAS float* scr, int item, int lane) {
    const int nblk = N / 32, kb = item / nblk, nb = item % nblk, k0 = 64 * kb, n0 = 32 * nb, d0 = perm_row<MODE>(n0);
#pragma unroll 8
    for (int i = 0; i < 32; ++i) { const int kk = 2 * i + (lane >> 5); scr[kk * 33 + (lane & 31)] = W[(size_t)(k0 + kk) * N + n0 + (lane & 31)]; }
    asm volatile("s_waitcnt lgkmcnt(0)" ::: "memory");
    const int c = lane & 7;
#pragma unroll
    for (int j = 0; j < 4; ++j) { const int n = (lane >> 3) + 8 * j; const LAS float* s = scr + (8 * c) * 33 + n;
        u32x4 o; o.x = pk2(s[0 * 33], s[1 * 33]); o.y = pk2(s[2 * 33], s[3 * 33]); o.z = pk2(s[4 * 33], s[5 * 33]); o.w = pk2(s[6 * 33], s[7 * 33]);
        *(u32x4*)(WT + (size_t)(d0 + n) * K + k0 + 8 * c) = o; }
    asm volatile("s_waitcnt lgkmcnt(0)" ::: "memory");
}
template <int MODE> __device__ __forceinline__ void convert_batch(const Ctx& c, const float* src, int K, int N, bf16* dst, int nmat, size_t dst_stride) {
    LAS float* scr = (LAS float*)(c.lds + c.wave * 16384);
    const int per = (K / 64) * (N / 32); const long total = (long)per * nmat;
    for (long it = c.gw; it < total; it += c.ngw) {
        const int mat = (int)(it / per), item = (int)(it % per);
        transpose_item<MODE>(src + (size_t)mat * K * N, K, N, dst + (size_t)mat * dst_stride, scr, item, c.lane);
    }
}

__device__ __forceinline__ float clamp448(float v) { return __builtin_amdgcn_fmed3f(v, -448.f, 448.f); }
__device__ __forceinline__ unsigned pk4_fp8(float a, float b, float c2, float d) {
    unsigned w = 0u; w = __builtin_amdgcn_cvt_pk_fp8_f32(clamp448(a), clamp448(b), w, false); w = __builtin_amdgcn_cvt_pk_fp8_f32(clamp448(c2), clamp448(d), w, true); return w;
}
template <int MODE> __device__ __forceinline__ void transpose_item_f8(const float* W, int K, int N, unsigned char* WT, LAS float* scr, int item, int lane) {
    const int nblk = N / 32, kb = item / nblk, nb = item % nblk, k0 = 64 * kb, n0 = 32 * nb, d0 = perm_row<MODE>(n0);
#pragma unroll 8
    for (int i = 0; i < 32; ++i) { const int kk = 2 * i + (lane >> 5); scr[kk * 33 + (lane & 31)] = W[(size_t)(k0 + kk) * N + n0 + (lane & 31)]; }
    asm volatile("s_waitcnt lgkmcnt(0)" ::: "memory");
    const int n = lane & 31;
#pragma unroll
    for (int j = 0; j < 2; ++j) { const int ch = (lane >> 5) + 2 * j; const LAS float* s = scr + (16 * ch) * 33 + n; u32x4 o;
#pragma unroll
        for (int q = 0; q < 4; ++q) o[q] = pk4_fp8(s[(4 * q) * 33] * F8_WSCALE, s[(4 * q + 1) * 33] * F8_WSCALE, s[(4 * q + 2) * 33] * F8_WSCALE, s[(4 * q + 3) * 33] * F8_WSCALE);
        *(u32x4*)(WT + (size_t)(d0 + n) * K + k0 + 16 * ch) = o; }
    asm volatile("s_waitcnt lgkmcnt(0)" ::: "memory");
}
template <int MODE> __device__ __forceinline__ void convert_batch_f8(const Ctx& c, const float* src, int K, int N, unsigned char* dst, int nmat, size_t dst_stride) {
    LAS float* scr = (LAS float*)(c.lds + c.wave * 16384);
    const int per = (K / 64) * (N / 32); const long total = (long)per * nmat;
    for (long it = c.gw; it < total; it += c.ngw) {
        const int mat = (int)(it / per), item = (int)(it % per);
        transpose_item_f8<MODE>(src + (size_t)mat * K * N, K, N, dst + (size_t)mat * dst_stride, scr, item, c.lane);
    }
}

__device__ __forceinline__ void t128_load(f32x4 (&v)[16], const float* W, int N, int item, int lane) {
    const int nblk = N / 32, kb = item / nblk, nb = item % nblk, k0 = 128 * kb, n0 = 32 * nb;
    const int kr = lane >> 3, nq = lane & 7;
#pragma unroll
    for (int i = 0; i < 16; ++i) v[i] = *(const f32x4*)(W + (size_t)(k0 + 8 * i + kr) * N + n0 + 4 * nq);
}
template <int MODE, bool F8> __device__ __forceinline__ void t128_finish(const f32x4 (&v)[16], int K, int N, unsigned char* WT, LAS float* scr, int item, int lane, float scale) {
    const int nblk = N / 32, kb = item / nblk, nb = item % nblk, k0 = 128 * kb, n0 = 32 * nb, d0 = perm_row<MODE>(n0);
    const int kr = lane >> 3, nq = lane & 7;
#pragma unroll
    for (int i = 0; i < 16; ++i) { LAS float* s = scr + (8 * i + kr) * 33 + 4 * nq; s[0] = v[i].x; s[1] = v[i].y; s[2] = v[i].z; s[3] = v[i].w; }
    asm volatile("s_waitcnt lgkmcnt(0)" ::: "memory");
    const int n = lane & 31, half = lane >> 5; const LAS float* s0 = scr + (64 * half) * 33 + n;
    if (F8) {
        unsigned char* dst = WT + (size_t)(d0 + n) * K + k0 + 64 * half;
#pragma unroll
        for (int ch = 0; ch < 4; ++ch) { const LAS float* s = s0 + (16 * ch) * 33; u32x4 o;
#pragma unroll
            for (int q = 0; q < 4; ++q) o[q] = pk4_fp8(s[(4 * q) * 33] * scale, s[(4 * q + 1) * 33] * scale, s[(4 * q + 2) * 33] * scale, s[(4 * q + 3) * 33] * scale);
            *(u32x4*)(dst + 16 * ch) = o; }
    } else {
        bf16* dst = (bf16*)WT + (size_t)(d0 + n) * K + k0 + 64 * half;
#pragma unroll
        for (int ch = 0; ch < 8; ++ch) { const LAS float* s = s0 + (8 * ch) * 33; u32x4 o;
#pragma unroll
            for (int q = 0; q < 4; ++q) o[q] = pk2(s[(2 * q) * 33], s[(2 * q + 1) * 33]);
            *(u32x4*)(dst + 8 * ch) = o; }
    }
    asm volatile("s_waitcnt lgkmcnt(0)" ::: "memory");
}
template <int MODE, bool F8> __device__ __forceinline__ void transpose_item128(const float* W, int K, int N, unsigned char* WT, LAS float* scr, int item, int lane, float scale) {
    asm volatile("" : "+v"(lane));
    f32x4 v[16];
    t128_load(v, W, N, item, lane);
    t128_finish<MODE, F8>(v, K, N, WT, scr, item, lane, scale);
}
template <int QM, bool F8Q> __device__ __forceinline__ void convert_dense_all(const Ctx& c, const float* w0in, const float* w1in, const float* w0out, const float* w1out,
                                                                              unsigned char* W0IN_, unsigned char* W1IN_, unsigned char* W0OUT_, unsigned char* W1OUT_, float sq) {
    constexpr int n0 = 16 * (AB_IN / 32), n1 = 16 * (C_IN / 32), n2 = 16 * (D / 32), TOT = n0 + n1 + 2 * n2;
    LAS float* scr = (LAS float*)(c.lds + c.wave * 16896);
    const int lane = c.lane, ngw = c.ngw;
#define DENSE_LOAD(v, it) do { if ((it) < n0) t128_load(v, w0in, AB_IN, (it), lane); else if ((it) < n0 + n1) t128_load(v, w1in, C_IN, (it) - n0, lane); \
        else if ((it) < n0 + n1 + n2) t128_load(v, w0out, D, (it) - n0 - n1, lane); else t128_load(v, w1out, D, (it) - n0 - n1 - n2, lane); } while (0)
#define DENSE_FIN(v, it) do { if ((it) < n0 + n1) { const bool f_ = (it) < n0; t128_finish<QM, F8Q>(v, D, f_ ? AB_IN : C_IN, f_ ? W0IN_ : W1IN_, scr, f_ ? (it) : (it) - n0, lane, sq); } \
        else { const bool f_ = (it) < n0 + n1 + n2; t128_finish<0, false>(v, D, D, f_ ? W0OUT_ : W1OUT_, scr, f_ ? (it) - n0 - n1 : (it) - n0 - n1 - n2, lane, 1.f); } } while (0)
    int it = c.gw;
    f32x4 va[16], vb[16];
    if (it < TOT) DENSE_LOAD(va, it);
    while (it < TOT) {
        const int it1 = it + ngw, it2 = it1 + ngw;
        if (it1 < TOT) DENSE_LOAD(vb, it1);
        DENSE_FIN(va, it);
        if (it2 < TOT) DENSE_LOAD(va, it2);
        if (it1 < TOT) DENSE_FIN(vb, it1);
        it = it2;
    }
#undef DENSE_LOAD
#undef DENSE_FIN
}
template <int MODE, bool F8> __device__ __forceinline__ void convert_batch128(const Ctx& c, const float* src, int K, int N, void* dst, int nmat, size_t dst_stride_bytes, float scale) {
    LAS float* scr = (LAS float*)(c.lds + c.wave * 16896);
    const int per = (K / 128) * (N / 32); const long total = (long)per * nmat;
    for (long it = c.gw; it < total; it += c.ngw) {
        const int mat = (int)(it / per), item = (int)(it % per);
        transpose_item128<MODE, F8>(src + (size_t)mat * K * N, K, N, (unsigned char*)dst + (size_t)mat * dst_stride_bytes, scr, item, c.lane, scale);
    }
}

struct ExpertSrc { const float* up; const float* sup; const float* dn; const float* sdn; };
constexpr int EXP_ITEMS_UP = NE * 512, EXP_ITEMS_SUP = 512, EXP_ITEMS_DN = NE * 256, EXP_ITEMS_SDN = 256, EXP_ITEMS = EXP_ITEMS_UP + EXP_ITEMS_SUP + EXP_ITEMS_DN + EXP_ITEMS_SDN;
__device__ __forceinline__ void expert_item(const ExpertSrc& s, int l, unsigned char* ws, LAS float* scr, int it, int lane) {
    unsigned char* wup = ws + WS_WUP + (size_t)l * NEX * UPN * D; unsigned char* wdn = ws + WS_WDN + (size_t)l * NEX * D * ED;
    if (it < EXP_ITEMS_UP) { const int mat = it >> 9; transpose_item128<2, true>(s.up + ((size_t)l * NE + mat) * D * UPN, D, UPN, wup + (size_t)mat * UPN * D, scr, it & 511, lane, F8_WSCALE); return; }
    it -= EXP_ITEMS_UP;
    if (it < EXP_ITEMS_SUP) { transpose_item128<2, true>(s.sup + (size_t)l * D * UPN, D, UPN, wup + (size_t)NE * UPN * D, scr, it, lane, F8_WSCALE); return; }
    it -= EXP_ITEMS_SUP;
    if (it < EXP_ITEMS_DN) { const int mat = it >> 8; transpose_item128<0, true>(s.dn + ((size_t)l * NE + mat) * ED * D, ED, D, wdn + (size_t)mat * D * ED, scr, it & 255, lane, F8_WSCALE); return; }
    it -= EXP_ITEMS_DN;
    transpose_item128<0, true>(s.sdn + (size_t)l * ED * D, ED, D, wdn + (size_t)NE * D * ED, scr, it, lane, F8_WSCALE);
}
struct ERef { const float* W; int N, item; };
__device__ __forceinline__ ERef expert_ref(const ExpertSrc& s, int l, int it) {
    if (it < EXP_ITEMS_UP) return ERef{s.up + ((size_t)l * NE + (it >> 9)) * D * UPN, UPN, it & 511};
    it -= EXP_ITEMS_UP;
    if (it < EXP_ITEMS_SUP) return ERef{s.sup + (size_t)l * D * UPN, UPN, it};
    it -= EXP_ITEMS_SUP;
    if (it < EXP_ITEMS_DN) return ERef{s.dn + ((size_t)l * NE + (it >> 8)) * ED * D, D, it & 255};
    it -= EXP_ITEMS_DN;
    return ERef{s.sdn + (size_t)l * ED * D, D, it};
}
__device__ __forceinline__ void expert_fin(const f32x4 (&v)[16], int l, unsigned char* ws, LAS float* scr, int it, int lane) {
    if (it < EXP_ITEMS_UP + EXP_ITEMS_SUP) { const bool r = it < EXP_ITEMS_UP; const int mat = r ? it >> 9 : NE, item = r ? it & 511 : it - EXP_ITEMS_UP;
        t128_finish<2, true>(v, D, UPN, ws + WS_WUP + ((size_t)l * NEX + mat) * UPN * D, scr, item, lane, F8_WSCALE); }
    else { it -= EXP_ITEMS_UP + EXP_ITEMS_SUP; const bool r = it < EXP_ITEMS_DN; const int mat = r ? it >> 8 : NE, item = r ? it & 255 : it - EXP_ITEMS_DN;
        t128_finish<0, true>(v, ED, D, ws + WS_WDN + ((size_t)l * NEX + mat) * D * ED, scr, item, lane, F8_WSCALE); }
}
__device__ __forceinline__ void expert_items_block(const Ctx& c, const ExpertSrc& s, int l, unsigned char* ws, int first, int count) {
    int tid = threadIdx.x; asm volatile("" : "+v"(tid));
    const int lane = tid & 63, wv = __builtin_amdgcn_readfirstlane(tid >> 6);
    LAS float* scr = (LAS float*)(c.lds + wv * 16896);
    f32x4 va[16], vb[16];
    int i = wv;
    if (i < count) { const ERef r = expert_ref(s, l, first + i); t128_load(va, r.W, r.N, r.item, lane); }
#pragma unroll 1
    while (i < count) {
        const int i1 = i + 8, i2 = i + 16;
        if (i1 < count) { const ERef r = expert_ref(s, l, first + i1); t128_load(vb, r.W, r.N, r.item, lane); }
        expert_fin(va, l, ws, scr, first + i, lane);
        if (i2 < count) { const ERef r = expert_ref(s, l, first + i2); t128_load(va, r.W, r.N, r.item, lane); }
        if (i1 < count) expert_fin(vb, l, ws, scr, first + i1, lane);
        i = i2;
    }
}
__device__ __forceinline__ void ada_phase(const Ctx& c, const float* cin, const float* w_ada, const float* b_ada, float* ada) {
    LAS float* red = (LAS float*)(c.lds);
    LAS float* sc = red + 1024;
    for (int i = c.tid; i < 4 * D; i += 512) sc[i] = siluf(cin[i]);
    __syncthreads();
    const int j = c.lane & 7, kr = c.lane >> 3;
    constexpr int NCG = 6 * D / 32;
    for (int u = blockIdx.x; u < 2 * NCG; u += gridDim.x) {
        const int l = u / NCG, cg = u % NCG;
        const int k0 = c.wave * 256 + kr;
        const float* w = w_ada + (size_t)l * D * 6 * D + (size_t)k0 * 6 * D + cg * 32 + 4 * j;
        f32x4 acc[4];
#pragma unroll
        for (int b = 0; b < 4; ++b) acc[b] = (f32x4){0.f, 0.f, 0.f, 0.f};
        f32x4 wv[32];
#pragma unroll
        for (int i = 0; i < 32; ++i) wv[i] = *(const f32x4*)(w + (size_t)(8 * i) * 6 * D);
#pragma unroll
        for (int i = 0; i < 32; ++i)
#pragma unroll
            for (int b = 0; b < 4; ++b) acc[b] += wv[i] * sc[b * D + k0 + 8 * i];
#pragma unroll
        for (int b = 0; b < 4; ++b)
#pragma unroll
            for (int q = 0; q < 4; ++q) { float t = acc[b][q]; t += __shfl_xor(t, 8); t += __shfl_xor(t, 16); t += __shfl_xor(t, 32); acc[b][q] = t; }
        if (kr == 0) {
#pragma unroll
            for (int b = 0; b < 4; ++b) *(LAS f32x4*)(red + (c.wave * 4 + b) * 32 + 4 * j) = acc[b]; }
        __syncthreads();
        if (c.tid < 128) {
            const int b = c.tid >> 5, cc = c.tid & 31; float s2 = b_ada[(size_t)l * 6 * D + cg * 32 + cc];
#pragma unroll
            for (int w8 = 0; w8 < 8; ++w8) s2 += red[(w8 * 4 + b) * 32 + cc];
            ada[((size_t)l * 4 + b) * 6 * D + cg * 32 + cc] = s2;
        }
        __syncthreads();
    }
}

__device__ __forceinline__ void load_row(const float* xrow, int lane, f32x4 (&v)[8]) {
#pragma unroll
    for (int j = 0; j < 8; ++j) v[j] = *(const f32x4*)(xrow + 4 * lane + 256 * j);
}
__device__ __forceinline__ float row_rstd(const f32x4 (&v)[8]) {
    float s = 0.f;
#pragma unroll
    for (int j = 0; j < 8; ++j) s += (v[j].x * v[j].x + v[j].y * v[j].y) + (v[j].z * v[j].z + v[j].w * v[j].w);
    return 1.f / sqrtf(wave_sum(s) * (1.f / D) + RMS_EPS);
}
__device__ __forceinline__ void modulate_row(f32x4 (&v)[8], float rstd, const float* g, const float* sh, const float* sc, int lane) {
#pragma unroll
    for (int j = 0; j < 8; ++j) { const int col = 4 * lane + 256 * j;
        const f32x4 gg = *(const f32x4*)(g + col), s1 = *(const f32x4*)(sc + col), s0 = *(const f32x4*)(sh + col);
        v[j] = v[j] * rstd * gg * (s1 + 1.f) + s0; }
}
__device__ __forceinline__ void store_row_bf16(bf16* orow, const f32x4 (&v)[8], int lane) {
#pragma unroll
    for (int j = 0; j < 8; ++j) { u32x2 w; w.x = pk2(v[j].x, v[j].y); w.y = pk2(v[j].z, v[j].w); *(u32x2*)(orow + 4 * lane + 256 * j) = w; }
}
__device__ __forceinline__ void store_row_fp8(unsigned char* orow, const f32x4 (&v)[8], int lane, float scale) {
#pragma unroll
    for (int j = 0; j < 8; ++j) *(unsigned*)(orow + 4 * lane + 256 * j) = pk4_fp8(v[j].x * scale, v[j].y * scale, v[j].z * scale, v[j].w * scale);
}
__device__ __forceinline__ void norm_phase(const Ctx& c, const float* x, const float* g, const float* ada_l  , int sh_off, int sc_off, bf16* out) {
    for (int m = c.gw; m < M; m += c.ngw) {
        const int b = m / T; f32x4 v[8]; load_row(x + (size_t)m * D, c.lane, v);
        const float rstd = row_rstd(v);
        modulate_row(v, rstd, g, ada_l + (size_t)b * 6 * D + sh_off, ada_l + (size_t)b * 6 * D + sc_off, c.lane);
#if USE_FP8_QKV
        store_row_fp8((unsigned char*)out + (size_t)m * D, v, c.lane, F8_HSCALE);
#else
        store_row_bf16(out + (size_t)m * D, v, c.lane);
#endif
    }
}

__device__ __forceinline__ void wave_gemm_32x64(const bf16* a0, const bf16* a1, const bf16* b, int K, int lane, f32x4 (&acc)[2][4]) {
    const int q8 = (lane >> 4) * 8;
    for (int k0 = 0; k0 < K; k0 += 32) {
        const bf16x8 fa0 = *(const bf16x8*)(a0 + k0 + q8), fa1 = *(const bf16x8*)(a1 + k0 + q8);
#pragma unroll
        for (int n = 0; n < 4; ++n) { const bf16x8 fb = *(const bf16x8*)(b + (size_t)n * 16 * K + k0 + q8);
            acc[0][n] = __builtin_amdgcn_mfma_f32_16x16x32_bf16(fa0, fb, acc[0][n], 0, 0, 0);
            acc[1][n] = __builtin_amdgcn_mfma_f32_16x16x32_bf16(fa1, fb, acc[1][n], 0, 0, 0); }
    }
}
#define ZERO_ACC(acc) do { _Pragma("unroll") for (int _a = 0; _a < 2; ++_a) _Pragma("unroll") for (int _b = 0; _b < 4; ++_b) acc[_a][_b] = (f32x4){0.f, 0.f, 0.f, 0.f}; } while (0)

__device__ __forceinline__ void gemm_plain_bf16(const Ctx& c, const bf16* A, const bf16* Bt, int K, int N, bf16* C) {
    const int ntn = N / 64, units = (M / 256) * ntn;
    for (int u = blockIdx.x; u < units; u += gridDim.x) {
        const int mt = u / ntn, nt = u % ntn, row0 = mt * 256 + c.wave * 32, n0 = nt * 64;
        f32x4 acc[2][4]; ZERO_ACC(acc);
        const int r = c.lane & 15;
        wave_gemm_32x64(A + (size_t)(row0 + r) * K, A + (size_t)(row0 + 16 + r) * K, Bt + (size_t)(n0 + r) * K, K, c.lane, acc);
#pragma unroll
        for (int mi = 0; mi < 2; ++mi)
#pragma unroll
            for (int n = 0; n < 4; ++n)
#pragma unroll
                for (int j = 0; j < 4; ++j) C[(size_t)(row0 + 16 * mi + 4 * (c.lane >> 4) + j) * N + n0 + 16 * n + r] = (bf16)f2bf(acc[mi][n][j]);
    }
}
__device__ __forceinline__ void gemm_outproj(const Ctx& c, const bf16* A, const bf16* Bt, const float* xin, const float* gm  , float* X1) {
    const int K = D, N = D, ntn = N / 64, units = (M / 256) * ntn;
    for (int u = blockIdx.x; u < units; u += gridDim.x) {
        const int mt = u / ntn, nt = u % ntn, row0 = mt * 256 + c.wave * 32, n0 = nt * 64;
        f32x4 acc[2][4]; ZERO_ACC(acc);
        const int r = c.lane & 15;
        wave_gemm_32x64(A + (size_t)(row0 + r) * K, A + (size_t)(row0 + 16 + r) * K, Bt + (size_t)(n0 + r) * K, K, c.lane, acc);
        const int b = row0 / T;
#pragma unroll
        for (int mi = 0; mi < 2; ++mi)
#pragma unroll
            for (int n = 0; n < 4; ++n)
#pragma unroll
                for (int j = 0; j < 4; ++j) { const size_t o = (size_t)(row0 + 16 * mi + 4 * (c.lane >> 4) + j) * N + n0 + 16 * n + r;
                    X1[o] = xin[o] + gm[(size_t)b * 6 * D + n0 + 16 * n + r] * acc[mi][n][j]; }
    }
}

__device__ __forceinline__ void qknorm_chunk(bf16* p, const float* g) {
    float v[64]; float ss = 0.f;
#pragma unroll
    for (int i = 0; i < 8; ++i) { const u32x4 w = *(const u32x4*)(p + 8 * i);
#pragma unroll
        for (int j = 0; j < 4; ++j) { v[8 * i + 2 * j] = bf2f(w[j] & 0xffffu); v[8 * i + 2 * j + 1] = bf2f(w[j] >> 16); } }
#pragma unroll
    for (int i = 0; i < 64; ++i) ss += v[i] * v[i];
    const float rs = 1.f / sqrtf(ss * (1.f / 64.f) + RMS_EPS);
#pragma unroll
    for (int i = 0; i < 8; ++i) { u32x4 w;
#pragma unroll
        for (int j = 0; j < 4; ++j) w[j] = pk2(v[8 * i + 2 * j] * rs * g[8 * i + 2 * j], v[8 * i + 2 * j + 1] * rs * g[8 * i + 2 * j + 1]);
        *(u32x4*)(p + 8 * i) = w; }
}
__device__ __forceinline__ void qknorm0_phase(const Ctx& c, bf16* qkv, const float* gains  ) {
    const long total = (long)M * 50;
    for (long id = gtid_now(); id < total; id += c.gsz) {
        const int m = (int)(id / 50), k = (int)(id % 50); int ch, gi;
        if (k < 16) { ch = k; gi = 0; } else if (k < 32) { ch = k; gi = 1; } else if (k < 48) { ch = k + 16; gi = 2; } else { ch = k + 16; gi = 3; }
        qknorm_chunk(qkv + (size_t)m * AB_IN + 64 * ch, gains + 64 * gi);
    }
}
__device__ __forceinline__ void qknorm1_phase(const Ctx& c, bf16* qkv, const float* gains  ) {
    const long total = (long)M * 64;
    for (long id = gtid_now(); id < total; id += c.gsz) {
        const int m = (int)(id / 64), ch = (int)(id % 64);
        qknorm_chunk(qkv + (size_t)m * C_IN + 64 * ch, gains + 64 * (ch >> 5));
    }
}

__device__ __forceinline__ void load64(const bf16* p, float (&v)[64], float scale) {
#pragma unroll
    for (int i = 0; i < 8; ++i) { const u32x4 w = *(const u32x4*)(p + 8 * i);
#pragma unroll
        for (int j = 0; j < 4; ++j) { v[8 * i + 2 * j] = bf2f(w[j] & 0xffffu) * scale; v[8 * i + 2 * j + 1] = bf2f(w[j] >> 16) * scale; } }
}
__device__ __forceinline__ float dot64(const float (&q)[64], const bf16* kp) {
    float s0 = 0.f, s1 = 0.f;
#pragma unroll
    for (int i = 0; i < 8; ++i) { const u32x4 w = *(const u32x4*)(kp + 8 * i);
#pragma unroll
        for (int j = 0; j < 4; ++j) { s0 += q[8 * i + 2 * j] * bf2f(w[j] & 0xffffu); s1 += q[8 * i + 2 * j + 1] * bf2f(w[j] >> 16); } }
    return s0 + s1;
}
__device__ __forceinline__ void axpy64(float (&o)[64], float a, float p, const bf16* vp) {
#pragma unroll
    for (int i = 0; i < 8; ++i) { const u32x4 w = *(const u32x4*)(vp + 8 * i);
#pragma unroll
        for (int j = 0; j < 4; ++j) { o[8 * i + 2 * j] = o[8 * i + 2 * j] * a + p * bf2f(w[j] & 0xffffu); o[8 * i + 2 * j + 1] = o[8 * i + 2 * j + 1] * a + p * bf2f(w[j] >> 16); } }
}
__device__ __forceinline__ void store64_bf16(bf16* p, const float (&o)[64], float s) {
#pragma unroll
    for (int i = 0; i < 8; ++i) { u32x4 w;
#pragma unroll
        for (int j = 0; j < 4; ++j) w[j] = pk2(o[8 * i + 2 * j] * s, o[8 * i + 2 * j + 1] * s);
        *(u32x4*)(p + 8 * i) = w; }
}
__device__ __forceinline__ void attn0_phase(const Ctx& c, const bf16* qkv, const float* sinks, bf16* O) {
    const long total = (long)32 * M;
    for (long id = gtid_now(); id < total; id += c.gsz) {
        const int hh = (int)(id / M), m = (int)(id % M), b = m / T, t = m % T;
        float q[64], o[64];
#pragma unroll
        for (int i = 0; i < 64; ++i) o[i] = 0.f;
        float mx = -1e30f, l = 0.f;
        if (hh < 16) {
            const int h = hh; const float slope = exp2f(-0.5f * (float)(h + 1));
            load64(qkv + (size_t)m * AB_IN + 64 * h, q, 0.125f);
            const bf16* kb = qkv + (size_t)b * T * AB_IN + 1024 + 64 * h;
            for (int br = 0; br < 3; ++br) {
                const int dil = br == 0 ? 1 : (br == 1 ? 4 : 16);
                for (int j = 0; j <= 128; ++j) {
                    const int s = t - dil * j; if (s < 0) break;
                    const bf16* kp = kb + (size_t)s * AB_IN;
                    const float sc = dot64(q, kp) - slope * (float)(dil * j);
                    const float mn = fmaxf(mx, sc), a = __expf(mx - mn), p = __expf(sc - mn);
                    l = l * a + p; axpy64(o, a, p, kp + 1024); mx = mn;
                }
            }
            store64_bf16(O + (size_t)m * D + 64 * h, o, 1.f / l);
        } else {
            const int h = hh - 16, kvh = h >> 3; const float slope = exp2f(-0.5f * (float)(h + 1));
            load64(qkv + (size_t)m * AB_IN + 3072 + 64 * h, q, 0.125f);
            const bf16* kb = qkv + (size_t)b * T * AB_IN + 4096 + 64 * kvh;
            for (int j = 0; j < 128; ++j) {
                const int s = t - j; if (s < 0) break;
                const bf16* kp = kb + (size_t)s * AB_IN;
                const float sc = dot64(q, kp) - slope * (float)j;
                const float mn = fmaxf(mx, sc), a = __expf(mx - mn), p = __expf(sc - mn);
                l = l * a + p; axpy64(o, a, p, kp + 128); mx = mn;
            }
            const float sk = sinks[h], mn = fmaxf(mx, sk), a = __expf(mx - mn);
            l = l * a + __expf(sk - mn);
            store64_bf16(O + (size_t)m * D + 1024 + 64 * h, o, a / l);
        }
    }
}
__device__ __forceinline__ void attn1_phase(const Ctx& c, const bf16* qkv, float* tmp) {
    const int items = NB * 16 * 2 * 2 * (T / 64);
    for (int it = c.gw; it < items; it += c.ngw) {
        const int tb = (T / 64 - 1) - it / (NB * 16 * 4); const int r = it % (NB * 16 * 4);
        const int b = r / 64, h = (r / 4) % 16, i = (r >> 1) & 1, j = r & 1;
        const int t = tb * 64 + c.lane, m = b * T + t;
        const float slope = exp2f(-0.5f * (float)(h + 1));
        float q[64], o[64];
#pragma unroll
        for (int d = 0; d < 64; ++d) o[d] = 0.f;
        float mx = -1e30f, l = 0.f;
        load64(qkv + (size_t)m * C_IN + 128 * h + 64 * i, q, 0.125f);
        const bf16* kb = qkv + (size_t)b * T * C_IN + 2048 + 128 * h + 64 * i;
        const bf16* vb = qkv + (size_t)b * T * C_IN + 4096 + 128 * h + 64 * j;
        const int smax = tb * 64 + 63;
        for (int s = 0; s <= smax; ++s) {
            const bf16* kp = kb + (size_t)s * C_IN;
            float sc = dot64(q, kp) - slope * (float)(t - s);
            if (s > t) sc = -1e30f;
            const float mn = fmaxf(mx, sc), a = __expf(mx - mn), p = (s > t) ? 0.f : __expf(sc - mn);
            l = l * a + p; axpy64(o, a, p, vb + (size_t)s * C_IN); mx = mn;
        }
        float* op = tmp + (((size_t)m * 16 + h) * 2 + i) * 128 + 64 * j; const float il = 1.f / l;
#pragma unroll
        for (int d = 0; d < 16; ++d) *(f32x4*)(op + 4 * d) = (f32x4){o[4 * d] * il, o[4 * d + 1] * il, o[4 * d + 2] * il, o[4 * d + 3] * il};
    }
}
__device__ __forceinline__ void attn1_finish_phase(const Ctx& c, const float* tmp, const float* lamp  , const float* subln  , bf16* O) {
    float s01 = 0.f, s23 = 0.f;
    for (int i = 0; i < 64; ++i) { s01 += lamp[i] * lamp[64 + i]; s23 += lamp[128 + i] * lamp[192 + i]; }
    const float lam_init = 0.8f - 0.6f * expf(-0.3f * 1.0f);
    const float lam = expf(s01) - expf(s23) + lam_init;
    const long total = (long)M * 16;
    for (long id = gtid_now(); id < total; id += c.gsz) {
        const float* p1 = tmp + (size_t)id * 256; const float* p2 = p1 + 128;
        float ss = 0.f;
        for (int d = 0; d < 128; ++d) { const float v = p1[d] - lam * p2[d]; ss += v * v; }
        const float rs = (1.f - lam_init) / sqrtf(ss * (1.f / 128.f) + RMS_EPS);
        bf16* op = O + (size_t)id * 128;
        for (int d = 0; d < 128; d += 2) { const float v0 = (p1[d] - lam * p2[d]) * rs * subln[d], v1 = (p1[d + 1] - lam * p2[d + 1]) * rs * subln[d + 1];
            *(unsigned*)(op + d) = pk2(v0, v1); }
    }
}

__device__ __forceinline__ void router_phase(const Ctx& c, const float* x1, const float* g, const float* ada_l, const float* wr  , const float* rbias  ,
                                             bf16* HF, int* idx, float* gate, unsigned* counts) {
    LAS float* hb = (LAS float*)(c.lds + c.wave * 8192);
    const int lane = c.lane;
    for (int m = c.gw; m < M; m += c.ngw) {
        const int b = m / T; f32x4 v[8]; load_row(x1 + (size_t)m * D, lane, v);
        const float rstd = row_rstd(v);
        modulate_row(v, rstd, g, ada_l + (size_t)b * 6 * D + 3 * D, ada_l + (size_t)b * 6 * D + 4 * D, lane);
        store_row_bf16(HF + (size_t)m * D, v, lane);
#pragma unroll
        for (int j = 0; j < 8; ++j) *(LAS f32x4*)(hb + 4 * lane + 256 * j) = v[j];
        asm volatile("s_waitcnt lgkmcnt(0)" ::: "memory");
        float a0 = 0.f, a1 = 0.f, a2 = 0.f, a3 = 0.f;
        for (int k = 0; k < D; k += 4) {
            const f32x4 hv = *(const LAS f32x4*)(hb + k);
            a0 += hv.x * wr[(size_t)(k + 0) * 64 + lane]; a1 += hv.y * wr[(size_t)(k + 1) * 64 + lane];
            a2 += hv.z * wr[(size_t)(k + 2) * 64 + lane]; a3 += hv.w * wr[(size_t)(k + 3) * 64 + lane];
        }
        const float logit = (a0 + a1) + (a2 + a3);
        const float score = 1.f / (1.f + expf(-logit));
        const float sel = score + rbias[lane];
        float m1 = sel;
        m1 = fmaxf(m1, __shfl_xor(m1, 1)); m1 = fmaxf(m1, __shfl_xor(m1, 2)); m1 = fmaxf(m1, __shfl_xor(m1, 4));
        const unsigned long long eqm = __ballot(sel == m1);
        const int gbase = lane & ~7;
        const unsigned grp_eq = (unsigned)((eqm >> gbase) & 0xffull);
        const int first = __builtin_ctz(grp_eq);
        float m2 = ((lane & 7) == first) ? -3e38f : sel;
        m2 = fmaxf(m2, __shfl_xor(m2, 1)); m2 = fmaxf(m2, __shfl_xor(m2, 2)); m2 = fmaxf(m2, __shfl_xor(m2, 4));
        const float gs = m1 + m2;
        int grank = 0; const int mygrp = lane >> 3;
#pragma unroll
        for (int g2 = 0; g2 < 8; ++g2) { const float o = __shfl(gs, g2 * 8); grank += (o > gs || (o == gs && g2 < mygrp)) ? 1 : 0; }
        const float msel = (grank < 4) ? sel : -1e30f;
        int rank = 0;
        for (int e2 = 0; e2 < 64; ++e2) { const float o = __shfl(msel, e2); rank += (o > msel || (o == msel && e2 < lane)) ? 1 : 0; }
        const bool chosen = rank < TOPK;
        const float gsum = wave_sum(chosen ? score : 0.f);
        if (chosen) { idx[(size_t)m * 8 + rank] = lane; gate[(size_t)m * 8 + rank] = score / gsum * 2.5f;
            __hip_atomic_fetch_add(counts + lane, 1u, __ATOMIC_RELAXED, __HIP_MEMORY_SCOPE_AGENT); }
    }
}
__device__ __forceinline__ void slot_phase(const Ctx& c, const int* idx, const unsigned* counts, unsigned* cursor, unsigned* nrt_out, int* pos, int* slot_tok, int* tile_exp) {
    LAS int* ps = (LAS int*)c.lds;
    if (c.tid == 0) { int acc = 0; for (int e = 0; e < NE; ++e) { const int cn = (int)counts[e]; ps[e] = acc; ps[64 + e] = cn; acc += (cn + 255) / 256 * 256; } ps[128] = acc; }
    __syncthreads();
    for (int a = gtid_now(); a < M * TOPK; a += c.gsz) {
        const int e = idx[a]; const unsigned r = __hip_atomic_fetch_add(cursor + e, 1u, __ATOMIC_RELAXED, __HIP_MEMORY_SCOPE_AGENT);
        const int slot = ps[e] + (int)r; slot_tok[slot] = a >> 3; pos[a] = slot;
    }
    for (int t = gtid_now(); t < M; t += c.gsz) slot_tok[CAPR + t] = t;
    if (blockIdx.x == 0) {
        if (c.tid < NE) { const int e = c.tid, s0 = ps[e], cn = ps[64 + e], pe = s0 + (cn + 255) / 256 * 256;
            for (int s = s0 + cn; s < pe; ++s) slot_tok[s] = 0;
            for (int tt = s0 / 256; tt < pe / 256; ++tt) tile_exp[tt] = e; }
        if (c.tid == 0) *nrt_out = (unsigned)(ps[128] / 256);
    }
    __syncthreads();
}
__device__ __forceinline__ void moe_up_phase(const Ctx& c, const bf16* HF, const bf16* Wup_l  , const int* slot_tok, const int* tile_exp, const unsigned* nrt_p, bf16* ACT) {
    const int nrt = (int)*nrt_p, ntiles = nrt + M / 256, units = ntiles * (ED / 64);
    for (int u = blockIdx.x; u < units; u += gridDim.x) {
        const int mt = u / (ED / 64), nt = u % (ED / 64), n0 = nt * 64;
        const int e = mt < nrt ? tile_exp[mt] : NE; const int slot0 = (mt < nrt ? mt * 256 : CAPR + (mt - nrt) * 256) + c.wave * 32;
        const int r = c.lane & 15;
        const bf16* a0 = HF + (size_t)slot_tok[slot0 + r] * D; const bf16* a1 = HF + (size_t)slot_tok[slot0 + 16 + r] * D;
        const bf16* W = Wup_l + (size_t)e * UPN * D;
        f32x4 ag[2][4], au[2][4]; ZERO_ACC(ag); ZERO_ACC(au);
        wave_gemm_32x64(a0, a1, W + (size_t)(n0 + r) * D, D, c.lane, ag);
        wave_gemm_32x64(a0, a1, W + (size_t)(ED + n0 + r) * D, D, c.lane, au);
#pragma unroll
        for (int mi = 0; mi < 2; ++mi)
#pragma unroll
            for (int n = 0; n < 4; ++n)
#pragma unroll
                for (int j = 0; j < 4; ++j) ACT[(size_t)(slot0 + 16 * mi + 4 * (c.lane >> 4) + j) * ED + n0 + 16 * n + r] = (bf16)f2bf(siluf(ag[mi][n][j]) * au[mi][n][j]);
    }
}
__device__ __forceinline__ void moe_down_phase(const Ctx& c, const bf16* ACT, const bf16* Wdn_l  , const int* tile_exp, const unsigned* nrt_p, bf16* Y) {
    const int nrt = (int)*nrt_p, ntiles = nrt + M / 256, units = ntiles * (D / 64);
    for (int u = blockIdx.x; u < units; u += gridDim.x) {
        const int mt = u / (D / 64), nt = u % (D / 64), n0 = nt * 64;
        const int e = mt < nrt ? tile_exp[mt] : NE; const int slot0 = (mt < nrt ? mt * 256 : CAPR + (mt - nrt) * 256) + c.wave * 32;
        const int r = c.lane & 15;
        const bf16* W = Wdn_l + (size_t)e * D * ED;
        f32x4 acc[2][4]; ZERO_ACC(acc);
        wave_gemm_32x64(ACT + (size_t)(slot0 + r) * ED, ACT + (size_t)(slot0 + 16 + r) * ED, W + (size_t)(n0 + r) * ED, ED, c.lane, acc);
#pragma unroll
        for (int mi = 0; mi < 2; ++mi)
#pragma unroll
            for (int n = 0; n < 4; ++n)
#pragma unroll
                for (int j = 0; j < 4; ++j) Y[(size_t)(slot0 + 16 * mi + 4 * (c.lane >> 4) + j) * D + n0 + 16 * n + r] = (bf16)f2bf(acc[mi][n][j]);
    }
}
__device__ __forceinline__ void add_row_bf16(f32x4 (&acc)[8], const bf16* yrow, float w, int lane) {
#pragma unroll
    for (int j = 0; j < 8; ++j) { const u32x2 v = *(const u32x2*)(yrow + 4 * lane + 256 * j);
        acc[j].x += w * bf2f(v.x & 0xffffu); acc[j].y += w * bf2f(v.x >> 16); acc[j].z += w * bf2f(v.y & 0xffffu); acc[j].w += w * bf2f(v.y >> 16); }
}
__device__ __forceinline__ void add_row_fp8(f32x4 (&acc)[8], const unsigned char* yrow, float w, int lane) {
#pragma unroll
    for (int j = 0; j < 8; ++j) { const unsigned v = *(const unsigned*)(yrow + 4 * lane + 256 * j);
        acc[j].x += w * __builtin_amdgcn_cvt_f32_fp8(v, 0); acc[j].y += w * __builtin_amdgcn_cvt_f32_fp8(v, 1); acc[j].z += w * __builtin_amdgcn_cvt_f32_fp8(v, 2); acc[j].w += w * __builtin_amdgcn_cvt_f32_fp8(v, 3); }
}
template <bool NEXT>
__device__ __forceinline__ void combine_phase(const Ctx& c, const float* x1, const bf16* Y, const int* pos, const float* gate, const float* ada_l, float* xo,
                                              const float* gnext, const float* ada_next, bf16* XN) {
    for (int m = c.gw; m < M; m += c.ngw) {
        const int b = m / T; f32x4 acc[8];
#pragma unroll
        for (int j = 0; j < 8; ++j) acc[j] = (f32x4){0.f, 0.f, 0.f, 0.f};
#if USE_FP8_MOE && Y_FP8
        for (int k = 0; k < TOPK; ++k) add_row_fp8(acc, (const unsigned char*)Y + (size_t)pos[(size_t)m * 8 + k] * D, gate[(size_t)m * 8 + k] * (1.f / F8_YSCALE), c.lane);
        add_row_fp8(acc, (const unsigned char*)Y + (size_t)(CAPR + m) * D, 1.f / F8_YSCALE, c.lane);
#else
        for (int k = 0; k < TOPK; ++k) add_row_bf16(acc, Y + (size_t)pos[(size_t)m * 8 + k] * D, gate[(size_t)m * 8 + k], c.lane);
        add_row_bf16(acc, Y + (size_t)(CAPR + m) * D, 1.f, c.lane);
#endif
        const float* gf = ada_l + (size_t)b * 6 * D + 5 * D;
        f32x4 v[8];
#pragma unroll
        for (int j = 0; j < 8; ++j) { const int col = 4 * c.lane + 256 * j;
#if RES_BF16
            { const u32x2 xw = *(const u32x2*)((const bf16*)x1 + (size_t)m * D + col);
              v[j] = (f32x4){bf2f(xw.x & 0xffffu), bf2f(xw.x >> 16), bf2f(xw.y & 0xffffu), bf2f(xw.y >> 16)} + *(const f32x4*)(gf + col) * acc[j]; }
            if (NEXT) { u32x2 ow; ow.x = pk2(v[j].x, v[j].y); ow.y = pk2(v[j].z, v[j].w); *(u32x2*)((bf16*)xo + (size_t)m * D + col) = ow; }
            else *(f32x4*)(xo + (size_t)m * D + col) = v[j];
#else
            v[j] = *(const f32x4*)(x1 + (size_t)m * D + col) + *(const f32x4*)(gf + col) * acc[j];
            *(f32x4*)(xo + (size_t)m * D + col) = v[j];
#endif
            }
        if (NEXT) {
            const float rstd = row_rstd(v);
            modulate_row(v, rstd, gnext, ada_next + (size_t)b * 6 * D, ada_next + (size_t)b * 6 * D + D, c.lane);
#if USE_FP8_QKV
            store_row_fp8((unsigned char*)XN + (size_t)m * D, v, c.lane, F8_HSCALE);
#else
            store_row_bf16(XN + (size_t)m * D, v, c.lane);
#endif
        }
    }
}


namespace pg8 {
constexpr int BM = 256, BK = 64, HALF = 128, HTB = HALF * BK * 2, STAGE_BYTES = 8 * HTB, NXCD = 8, WGM = 8;
__device__ __forceinline__ int lds_byte(int r, int c) { const int st = (r >> 4) * 2 + (c >> 5), rr = r & 15, cc = c & 31, ob = rr * 64 + cc * 2; return st * 1024 + (ob ^ (((ob >> 9) & 1) << 5)); }
__device__ __forceinline__ void stage_rc(int b, int& R, int& C) { const int st = b / 1024, sb = b % 1024, swz = sb ^ (((sb >> 9) & 1) << 5); R = (st >> 1) * 16 + swz / 64; C = (st & 1) * 32 + (swz % 64) / 2; }
__device__ __forceinline__ int perm32(int rho) { const int n = rho >> 4, i = rho & 15; return 8 * (i >> 2) + 4 * n + (i & 3); }
__device__ __forceinline__ unsigned cvt_pk_bf16(float lo, float hi) { unsigned r; asm volatile("v_cvt_pk_bf16_f32 %0, %1, %2" : "=v"(r) : "v"(lo), "v"(hi)); return r; }

struct Unit { int row0, pn; const char* Bp; };

struct TileOrder {
    int nM, nN, nwg, G, c;
    __device__ __forceinline__ void init(int nM_, int nN_, int G_, int c_) { nM = nM_; nN = nN_; nwg = nM * nN; G = G_; c = c_; }
    __device__ __forceinline__ bool tile(int i, int& pm, int& pn) const {
        const long L = (long)i * G + c; if (L >= nwg) return false;
        int wgid = (int)L; { const int q = nwg / NXCD, r = nwg % NXCD, xcd = wgid % NXCD, off = wgid / NXCD; wgid = (xcd < r ? xcd * (q + 1) : r * (q + 1) + (xcd - r) * q) + off; }
        const int nig = WGM * nN, gid = wgid / nig, fm = gid * WGM, gsz = (nM - fm) < WGM ? (nM - fm) : WGM;
        pm = fm + ((wgid % nig) % gsz); pn = (wgid % nig) / gsz; return true;
    }
};
struct PlainSched {
    static constexpr bool GATHER = false;
    TileOrder o; const char* Bt; int K;
    __device__ __forceinline__ bool next(int i, Unit& u) const { int pm, pn; if (!o.tile(i, pm, pn)) return false; u.row0 = pm * BM; u.pn = pn; u.Bp = Bt + (size_t)pn * BM * K * 2; return true; }
    __device__ __forceinline__ unsigned arow_off(const Unit& u, int rl) const { return (unsigned)(u.row0 + rl) * (unsigned)(K * 2); }
};
template <bool GATHER_> struct GroupSched {
    static constexpr bool GATHER = GATHER_;
    TileOrder o; const char* W; size_t wstride; int K, nrt; const LAS int* tile_exp; const int* slot_tok;
    __device__ __forceinline__ bool next(int i, Unit& u) const { int pm, pn; if (!o.tile(i, pm, pn)) return false;
        const int e = pm < nrt ? tile_exp[pm] : NE; u.row0 = pm < nrt ? pm * BM : CAPR + (pm - nrt) * BM; u.pn = pn; u.Bp = W + (size_t)e * wstride + (size_t)pn * BM * K * 2; return true; }
    __device__ __forceinline__ unsigned arow_off(const Unit& u, int rl) const { const int r = GATHER ? slot_tok[u.row0 + rl] : (u.row0 + rl); return (unsigned)r * (unsigned)(K * 2); }
};

template <int LAYER> struct EpiQKV {
    static constexpr bool PERM = true;
    bf16* O; int ldc; const float* gains; float qscale, ascale;
    __device__ __forceinline__ void operator()(const f32x4 (&acc)[2][2][4][2], const Unit& u, int wr, int wc, int fr, int fq) const {
        const int head = 4 * u.pn + wc; int gi;
        if (LAYER == 0) gi = head < 16 ? 0 : head < 32 ? 1 : head < 48 ? -1 : head < 64 ? 2 : head < 66 ? 3 : -1;
        else gi = head < 32 ? 0 : head < 64 ? 1 : -1;
        f32x4 gv[2][2];
#pragma unroll
        for (int bj = 0; bj < 2; ++bj)
#pragma unroll
            for (int n = 0; n < 2; ++n) gv[bj][n] = gi >= 0 ? *(const f32x4*)(gains + 64 * gi + 32 * bj + 8 * fq + 4 * n) : (f32x4){1.f, 1.f, 1.f, 1.f};
#if QKV_HEADMAJOR
        bf16* base = O + ((size_t)head * M + (size_t)(u.row0 + wr * 64 + fr)) * 64 + 8 * fq; const int ldo = 64;
#else
        bf16* base = O + (size_t)(u.row0 + wr * 64 + fr) * ldc + 64 * head + 8 * fq; const int ldo = ldc;
#endif
#pragma unroll
        for (int ai = 0; ai < 2; ++ai)
#pragma unroll
            for (int m = 0; m < 4; ++m) {
                float ss = 0.f;
#pragma unroll
                for (int bj = 0; bj < 2; ++bj)
#pragma unroll
                    for (int n = 0; n < 2; ++n) { const f32x4 x = acc[ai][bj][m][n]; ss += (x[0] * x[0] + x[1] * x[1]) + (x[2] * x[2] + x[3] * x[3]); }
                ss += __shfl_xor(ss, 16); ss += __shfl_xor(ss, 32); ss *= ascale * ascale;
                const bool isq = LAYER == 0 ? (gi == 0 || gi == 2) : (gi == 0);
                const float rs = ascale * (gi >= 0 ? (isq ? qscale : 1.f) / sqrtf(ss * (1.f / 64.f) + RMS_EPS) : 1.f);
                bf16* rowp = base + (size_t)(ai * HALF + m * 16) * ldo;
#pragma unroll
                for (int bj = 0; bj < 2; ++bj) { const f32x4 v0 = acc[ai][bj][m][0] * rs * gv[bj][0], v1 = acc[ai][bj][m][1] * rs * gv[bj][1];
                    u32x4 w; w.x = cvt_pk_bf16(v0[0], v0[1]); w.y = cvt_pk_bf16(v0[2], v0[3]); w.z = cvt_pk_bf16(v1[0], v1[1]); w.w = cvt_pk_bf16(v1[2], v1[3]);
                    *(u32x4*)(rowp + 32 * bj) = w; }
            }
    }
};
struct EpiOut {
    static constexpr bool PERM = false;
    const float* xin; const float* gm; float* X1;
    __device__ __forceinline__ void operator()(const f32x4 (&acc)[2][2][4][2], const Unit& u, int wr, int wc, int fr, int fq) const {
        const int col0 = u.pn * BM + wc * 32 + 4 * fq; const float* g = gm + (size_t)(u.row0 / T) * 6 * D + col0;
        f32x4 gv[2][2];
#pragma unroll
        for (int bj = 0; bj < 2; ++bj)
#pragma unroll
            for (int n = 0; n < 2; ++n) gv[bj][n] = *(const f32x4*)(g + bj * HALF + n * 16);
#pragma unroll
        for (int ai = 0; ai < 2; ++ai)
#pragma unroll
            for (int m = 0; m < 4; ++m) { const size_t off = (size_t)(u.row0 + wr * 64 + fr + ai * HALF + m * 16) * D + col0;
#pragma unroll
                for (int bj = 0; bj < 2; ++bj)
#pragma unroll
                    for (int n = 0; n < 2; ++n) *(f32x4*)(X1 + off + bj * HALF + n * 16) = *(const f32x4*)(xin + off + bj * HALF + n * 16) + gv[bj][n] * acc[ai][bj][m][n]; }
    }
};

template <bool XIN_BF16> struct EpiOutB {
    static constexpr bool PERM = true;
    const void* xin; const float* gm; bf16* X1b;
    __device__ __forceinline__ void operator()(const f32x4 (&acc)[2][2][4][2], const Unit& u, int wr, int wc, int fr, int fq) const {
        const int col0 = u.pn * BM + wc * 32 + 8 * fq; const float* g = gm + (size_t)(u.row0 / T) * 6 * D + col0;
        f32x4 gv[2][2];
#pragma unroll
        for (int bj = 0; bj < 2; ++bj)
#pragma unroll
            for (int n = 0; n < 2; ++n) gv[bj][n] = *(const f32x4*)(g + bj * HALF + 4 * n);
#pragma unroll
        for (int ai = 0; ai < 2; ++ai)
#pragma unroll
            for (int m = 0; m < 4; ++m) { const size_t off = (size_t)(u.row0 + wr * 64 + fr + ai * HALF + m * 16) * D + col0;
#pragma unroll
                for (int bj = 0; bj < 2; ++bj) { f32x4 x0, x1v;
                    if (XIN_BF16) { const u32x4 xw = *(const u32x4*)((const bf16*)xin + off + bj * HALF);
                        x0 = (f32x4){bf2f(xw.x & 0xffffu), bf2f(xw.x >> 16), bf2f(xw.y & 0xffffu), bf2f(xw.y >> 16)}; x1v = (f32x4){bf2f(xw.z & 0xffffu), bf2f(xw.z >> 16), bf2f(xw.w & 0xffffu), bf2f(xw.w >> 16)}; }
                    else { x0 = *(const f32x4*)((const float*)xin + off + bj * HALF); x1v = *(const f32x4*)((const float*)xin + off + bj * HALF + 4); }
                    const f32x4 v0 = x0 + gv[bj][0] * acc[ai][bj][m][0], v1 = x1v + gv[bj][1] * acc[ai][bj][m][1];
                    u32x4 w; w.x = cvt_pk_bf16(v0[0], v0[1]); w.y = cvt_pk_bf16(v0[2], v0[3]); w.z = cvt_pk_bf16(v1[0], v1[1]); w.w = cvt_pk_bf16(v1[2], v1[3]);
                    *(u32x4*)(X1b + off + bj * HALF) = w; } }
    }
};
__device__ __forceinline__ float silu_fast(float x) { return x * __builtin_amdgcn_rcpf(1.f + __builtin_amdgcn_exp2f(-1.4426950408889634f * x)); }
struct EpiUp {
    static constexpr bool PERM = true;
    bf16* ACT;
    __device__ __forceinline__ void operator()(const f32x4 (&acc)[2][2][4][2], const Unit& u, int wr, int wc, int fr, int fq) const {
        bf16* base = ACT + (size_t)(u.row0 + wr * 64 + fr) * ED + 128 * u.pn + 32 * wc + 8 * fq;
#pragma unroll
        for (int ai = 0; ai < 2; ++ai)
#pragma unroll
            for (int m = 0; m < 4; ++m) { f32x4 v[2];
#pragma unroll
                for (int n = 0; n < 2; ++n)
#pragma unroll
                    for (int i = 0; i < 4; ++i) v[n][i] = silu_fast(acc[ai][0][m][n][i]) * acc[ai][1][m][n][i];
                u32x4 w; w.x = cvt_pk_bf16(v[0][0], v[0][1]); w.y = cvt_pk_bf16(v[0][2], v[0][3]); w.z = cvt_pk_bf16(v[1][0], v[1][1]); w.w = cvt_pk_bf16(v[1][2], v[1][3]);
                *(u32x4*)(base + (size_t)(ai * HALF + m * 16) * ED) = w; }
    }
};
struct EpiDown {
    static constexpr bool PERM = true;
    bf16* Y; int orow = 0;
    __device__ __forceinline__ void operator()(const f32x4 (&acc)[2][2][4][2], const Unit& u, int wr, int wc, int fr, int fq) const {
        bf16* base = Y + (size_t)(orow + u.row0 + wr * 64 + fr) * D + u.pn * BM + wc * 32 + 8 * fq;
#pragma unroll
        for (int ai = 0; ai < 2; ++ai)
#pragma unroll
            for (int m = 0; m < 4; ++m) { bf16* rowp = base + (size_t)(ai * HALF + m * 16) * D;
#pragma unroll
                for (int bj = 0; bj < 2; ++bj) { const f32x4 v0 = acc[ai][bj][m][0], v1 = acc[ai][bj][m][1];
                    u32x4 w; w.x = cvt_pk_bf16(v0[0], v0[1]); w.y = cvt_pk_bf16(v0[2], v0[3]); w.z = cvt_pk_bf16(v1[0], v1[1]); w.w = cvt_pk_bf16(v1[2], v1[3]);
                    *(u32x4*)(rowp + bj * HALF) = w; } }
    }
};


struct EpiUp8 {
    static constexpr bool PERM = true;
    unsigned char* ACT8;
    __device__ __forceinline__ void operator()(const f32x4 (&acc)[2][2][4][2], const Unit& u, int wr, int wc, int fr, int fq) const {
        unsigned char* base = ACT8 + (size_t)(u.row0 + wr * 64 + fr) * ED + 128 * u.pn + 32 * wc + 8 * fq;
        constexpr float s = 1.f / (F8_HSCALE * F8_WSCALE);
#pragma unroll
        for (int ai = 0; ai < 2; ++ai)
#pragma unroll
            for (int m = 0; m < 4; ++m) { f32x4 v[2];
#pragma unroll
                for (int n = 0; n < 2; ++n)
#pragma unroll
                    for (int i = 0; i < 4; ++i) v[n][i] = silu_fast(acc[ai][0][m][n][i] * s) * (acc[ai][1][m][n][i] * (s * F8_ASCALE));
                u32x2 w; w.x = pk4_fp8(v[0][0], v[0][1], v[0][2], v[0][3]); w.y = pk4_fp8(v[1][0], v[1][1], v[1][2], v[1][3]);
                *(u32x2*)(base + (size_t)(ai * HALF + m * 16) * ED) = w; }
    }
};
struct EpiDown8 {
    static constexpr bool PERM = true;
    bf16* Y;
    __device__ __forceinline__ void operator()(const f32x4 (&acc)[2][2][4][2], const Unit& u, int wr, int wc, int fr, int fq) const {
#if Y_FP8
        unsigned char* base = (unsigned char*)Y + (size_t)(u.row0 + wr * 64 + fr) * D + u.pn * BM + wc * 32 + 8 * fq;
        constexpr float s = F8_YSCALE / (F8_ASCALE * F8_WSCALE);
#pragma unroll
        for (int ai = 0; ai < 2; ++ai)
#pragma unroll
            for (int m = 0; m < 4; ++m) { unsigned char* rowp = base + (size_t)(ai * HALF + m * 16) * D;
#pragma unroll
                for (int bj = 0; bj < 2; ++bj) { const f32x4 v0 = acc[ai][bj][m][0] * s, v1 = acc[ai][bj][m][1] * s;
                    u32x2 w; w.x = pk4_fp8(v0[0], v0[1], v0[2], v0[3]); w.y = pk4_fp8(v1[0], v1[1], v1[2], v1[3]);
                    *(u32x2*)(rowp + bj * HALF) = w; } }
#else
        bf16* base = Y + (size_t)(u.row0 + wr * 64 + fr) * D + u.pn * BM + wc * 32 + 8 * fq;
        constexpr float s = 1.f / (F8_ASCALE * F8_WSCALE);
#pragma unroll
        for (int ai = 0; ai < 2; ++ai)
#pragma unroll
            for (int m = 0; m < 4; ++m) { bf16* rowp = base + (size_t)(ai * HALF + m * 16) * D;
#pragma unroll
                for (int bj = 0; bj < 2; ++bj) { const f32x4 v0 = acc[ai][bj][m][0] * s, v1 = acc[ai][bj][m][1] * s;
                    u32x4 w; w.x = cvt_pk_bf16(v0[0], v0[1]); w.y = cvt_pk_bf16(v0[2], v0[3]); w.z = cvt_pk_bf16(v1[0], v1[1]); w.w = cvt_pk_bf16(v1[2], v1[3]);
                    *(u32x4*)(rowp + bj * HALF) = w; } }
#endif
    }
};
__device__ __forceinline__ void glds16s(const void* sbase, unsigned voff, unsigned lds_dst) { unsigned keep;
    asm volatile("s_mov_b32 %0, m0\n\ts_mov_b32 m0, %3\n\ts_nop 0\n\tglobal_load_lds_dwordx4 %1, %2\n\ts_mov_b32 m0, %0" : "=&s"(keep) : "v"(voff), "s"(sbase), "s"(lds_dst) : "memory"); }
__device__ __forceinline__ void glds4s(const void* sbase, unsigned voff, unsigned lds_dst) { unsigned keep;
    asm volatile("s_mov_b32 %0, m0\n\ts_mov_b32 m0, %3\n\ts_nop 0\n\tglobal_load_lds_dword %1, %2\n\ts_mov_b32 m0, %0" : "=&s"(keep) : "v"(voff), "s"(sbase), "s"(lds_dst) : "memory"); }
typedef int i32x4 __attribute__((ext_vector_type(4)));
typedef int i32x8 __attribute__((ext_vector_type(8)));
__device__ __forceinline__ i32x8 cat8(bf16x8 a, bf16x8 b) { return __builtin_shufflevector(__builtin_bit_cast(i32x4, a), __builtin_bit_cast(i32x4, b), 0, 1, 2, 3, 4, 5, 6, 7); }
__device__ __forceinline__ void mfma8_inplace(f32x4& acc, i32x8 a, i32x8 b) { asm volatile("v_mfma_f32_16x16x128_f8f6f4 %0, %1, %2, %0" : "+v"(acc) : "v"(a), "v"(b)); }
template <class Epi, class Sched, bool FP8 = false>
__device__ __forceinline__ void gemm_phase(LAS unsigned char* lds, const char* Abase, const int K, const Sched& S, const Epi& E) {
    constexpr bool GATHER = Sched::GATHER;
    const int tid = threadIdx.x, wid = __builtin_amdgcn_readfirstlane(tid >> 6), lane = tid & 63, wr = wid >> 2, wc = wid & 3, fr = lane & 15, fq = lane >> 4;
    int nt = K / BK; asm volatile("" : "+s"(nt));
    int RA[2]; unsigned CA[2], voffB[2], vC[2];
#pragma unroll
    for (int i = 0; i < 2; ++i) { int R, C; stage_rc(tid * 16 + i * 8192, R, C); const int Rb = Epi::PERM ? ((R & ~31) + perm32(R & 31)) : R;
        RA[i] = R; CA[i] = (unsigned)C * 2u; voffB[i] = (unsigned)(Rb * K + C) * 2u; vC[i] = (unsigned)(R * K + C) * 2u; }
    const size_t kstep = (size_t)(BK * 2);
    const size_t hstep = (size_t)HALF * K * 2;
    const size_t ahstep = GATHER ? 0 : hstep;
    const unsigned ldsw = (unsigned)wid * 1024u;
    const unsigned lds0 = (unsigned)(uintptr_t)lds;
    const int aoff = lds_byte(wr * 64 + fr, fq * 8), boff = lds_byte(wc * 32 + fr, fq * 8);
#define PG8_SA(b, h) (((b) * 2 + (h)) * HTB)
#define PG8_SB(b, h) ((4 + (b) * 2 + (h)) * HTB)
#define PG8_STAGE(bufoff, gbase, voff) do { _Pragma("unroll") for (int _i = 0; _i < 2; ++_i) \
        glds16s((const void*)(gbase), (voff)[_i], (unsigned)__builtin_amdgcn_readfirstlane((int)(lds0 + (unsigned)(bufoff) + ldsw + (unsigned)(_i * 8192)))); } while (0)
#define PG8_STAGE_A(bufoff, gbase, h) do { if constexpr (GATHER) { PG8_STAGE(bufoff, gbase, vA[h]); } else { PG8_STAGE(bufoff, (gbase) + (h) * ahstep, vC); } } while (0)
#define PG8_LDA(dst, b, h) do { _Pragma("unroll") for (int m = 0; m < 4; ++m) _Pragma("unroll") for (int k = 0; k < 2; ++k) dst[m][k] = *(const LAS bf16x8*)(lds + PG8_SA(b, h) + aoff + m * 2048 + k * 1024); } while (0)
#define PG8_LDB(dst, b, h) do { _Pragma("unroll") for (int n = 0; n < 2; ++n) _Pragma("unroll") for (int k = 0; k < 2; ++k) dst[n][k] = *(const LAS bf16x8*)(lds + PG8_SB(b, h) + boff + n * 2048 + k * 1024); } while (0)
#define PG8_MMA(ai, bj, At, Bt) do { __builtin_amdgcn_s_setprio(1); if constexpr (FP8) { _Pragma("unroll") for (int m = 0; m < 4; ++m) _Pragma("unroll") for (int n = 0; n < 2; ++n) \
        mfma8_inplace(acc[ai][bj][m][n], cat8(Bt[n][0], Bt[n][1]), cat8(At[m][0], At[m][1])); } else { \
        _Pragma("unroll") for (int m = 0; m < 4; ++m) _Pragma("unroll") for (int n = 0; n < 2; ++n) _Pragma("unroll") for (int k = 0; k < 2; ++k) \
        acc[ai][bj][m][n] = __builtin_amdgcn_mfma_f32_16x16x32_bf16(Bt[n][k], At[m][k], acc[ai][bj][m][n], 0, 0, 0); } __builtin_amdgcn_s_setprio(0); } while (0)
#define PG8_WAIT_V(n) asm volatile("s_waitcnt vmcnt(" #n ")" ::: "memory")
#define PG8_WAIT_L(n) asm volatile("s_waitcnt lgkmcnt(0)" ::: "memory")
#define PG8_BAR __builtin_amdgcn_s_barrier()
#define PG8_SCHED __builtin_amdgcn_sched_barrier(0)
#define PG8_SETOFF(vo, u) do { _Pragma("unroll") for (int _h = 0; _h < 2; ++_h) _Pragma("unroll") for (int _i = 0; _i < 2; ++_i) vo[_h][_i] = S.arow_off(u, _h * HALF + RA[_i]) + CA[_i]; } while (0)
    Unit cur, nxt; int ui = 0;
    if (!S.next(0, cur)) return;
    f32x4 acc[2][2][4][2];
#pragma unroll
    for (int a = 0; a < 2; ++a)
#pragma unroll
        for (int b = 0; b < 2; ++b)
#pragma unroll
            for (int m = 0; m < 4; ++m)
#pragma unroll
                for (int n = 0; n < 2; ++n) acc[a][b][m][n] = (f32x4){0.f, 0.f, 0.f, 0.f};
    bf16x8 At[4][2], B0[2][2], B1[2][2];
    unsigned vA[2][2];
    LAS int* gidx = (LAS int*)(lds + STAGE_BYTES);
#define PG8_IDX_DMA(u) do { if (wid < 4) glds4s((const void*)(S.slot_tok + (u).row0), (unsigned)((wid * 64 + lane) * 4), (unsigned)__builtin_amdgcn_readfirstlane((int)(lds0 + (unsigned)STAGE_BYTES + (unsigned)wid * 256u))); } while (0)
#define PG8_IDX_READ() do { _Pragma("unroll") for (int _h = 0; _h < 2; ++_h) _Pragma("unroll") for (int _i = 0; _i < 2; ++_i) vA[_h][_i] = (unsigned)gidx[_h * HALF + RA[_i]] * (unsigned)(K * 2) + CA[_i]; } while (0)
    if constexpr (GATHER) { PG8_IDX_DMA(cur); asm volatile("s_waitcnt vmcnt(0)" ::: "memory"); __builtin_amdgcn_s_barrier(); asm volatile("" ::: "memory"); PG8_IDX_READ();
        asm volatile("s_waitcnt lgkmcnt(0)" ::: "memory"); __builtin_amdgcn_s_barrier(); asm volatile("" ::: "memory"); }
    const char* cA = GATHER ? Abase : Abase + (size_t)cur.row0 * K * 2;
    const char* cB = cur.Bp;
    PG8_STAGE(PG8_SB(0, 0), cB, voffB); PG8_STAGE(PG8_SB(0, 1), cB + hstep, voffB); PG8_STAGE_A(PG8_SA(0, 0), cA, 0); PG8_STAGE_A(PG8_SA(0, 1), cA, 1);
    if (wr == 1) PG8_BAR;
    PG8_WAIT_V(2); PG8_BAR;
    PG8_STAGE(PG8_SB(1, 0), cB + kstep, voffB); PG8_STAGE_A(PG8_SA(1, 0), cA + kstep, 0); PG8_STAGE(PG8_SB(1, 1), cB + hstep + kstep, voffB);
    PG8_WAIT_V(6); PG8_BAR;
    for (;;) {
        const bool has_next = S.next(ui + 1, nxt);
        if constexpr (GATHER) { if (has_next) PG8_IDX_DMA(nxt); }
        const char* nA = GATHER ? Abase : (has_next ? Abase + (size_t)nxt.row0 * K * 2 : cA);
        const char* nB = has_next ? nxt.Bp : cB;
#pragma unroll 1
        for (int t = 0; t < nt; t += 2) {
            const bool last = (t == nt - 2);
            const char* a1 = cA + (size_t)(t + 1) * kstep;
            const char* a2 = last ? nA : cA + (size_t)(t + 2) * kstep; const char* b2 = last ? nB : cB + (size_t)(t + 2) * kstep;
            const char* a3 = a2 + kstep; const char* b3 = b2 + kstep;
            PG8_LDB(B0, 0, 0); PG8_LDB(B1, 0, 1); PG8_SCHED; PG8_LDA(At, 0, 0); PG8_STAGE_A(PG8_SA(1, 1), a1, 1);
            if constexpr (GATHER) { if (last && has_next) PG8_IDX_READ(); }
            PG8_WAIT_V(8); PG8_WAIT_L(0); PG8_BAR; PG8_MMA(0, 0, At, B0); PG8_MMA(0, 1, At, B1); PG8_BAR; PG8_SCHED;
            PG8_LDA(At, 0, 1); PG8_STAGE(PG8_SB(0, 0), b2, voffB); PG8_STAGE(PG8_SB(0, 1), b2 + hstep, voffB); PG8_STAGE_A(PG8_SA(0, 0), a2, 0);
            PG8_WAIT_V(8); PG8_WAIT_L(0); PG8_BAR; PG8_MMA(1, 0, At, B0); PG8_MMA(1, 1, At, B1); PG8_BAR; PG8_SCHED;
            PG8_LDB(B0, 1, 0); PG8_LDB(B1, 1, 1); PG8_SCHED; PG8_LDA(At, 1, 0); PG8_STAGE_A(PG8_SA(0, 1), a2, 1);
            PG8_WAIT_V(8); PG8_WAIT_L(0); PG8_BAR; PG8_MMA(0, 0, At, B0); PG8_MMA(0, 1, At, B1); PG8_BAR; PG8_SCHED;
            PG8_LDA(At, 1, 1); PG8_STAGE(PG8_SB(1, 0), b3, voffB); PG8_STAGE(PG8_SB(1, 1), b3 + hstep, voffB); PG8_STAGE_A(PG8_SA(1, 0), a3, 0);
            PG8_WAIT_V(8); PG8_WAIT_L(0); PG8_BAR; PG8_MMA(1, 0, At, B0); PG8_MMA(1, 1, At, B1); PG8_BAR; PG8_SCHED;
        }
        if (wr == 0) PG8_BAR;
        if constexpr (FP8) asm volatile("s_nop 15\n\ts_nop 15" ::: "memory");
        E(acc, cur, wr, wc, fr, fq);
        if (!has_next) break;
#pragma unroll
        for (int a = 0; a < 2; ++a)
#pragma unroll
            for (int b = 0; b < 2; ++b)
#pragma unroll
                for (int m = 0; m < 4; ++m)
#pragma unroll
                    for (int n = 0; n < 2; ++n) acc[a][b][m][n] = (f32x4){0.f, 0.f, 0.f, 0.f};
        cur = nxt; cA = nA; cB = nB; ++ui;
        if (wr == 1) PG8_BAR;
    }
    PG8_WAIT_V(0);
    PG8_BAR;
#undef PG8_SA
#undef PG8_SB
#undef PG8_STAGE
#undef PG8_STAGE_A
#undef PG8_LDA
#undef PG8_LDB
#undef PG8_MMA
#undef PG8_WAIT_V
#undef PG8_WAIT_L
#undef PG8_BAR
#undef PG8_SCHED
#undef PG8_SETOFF
#undef PG8_IDX_DMA
#undef PG8_IDX_READ
}
}

namespace att {
using bf16=unsigned short;
using bf16x8=__attribute__((ext_vector_type(8)))short;
using s16x4=__attribute__((ext_vector_type(4)))short;
using f32x16=__attribute__((ext_vector_type(16)))float;
using u32x4=__attribute__((ext_vector_type(4)))unsigned;
constexpr int NW=8,QBLK=32,QB=QBLK*NW,KVBLK=64;
__device__ __forceinline__ int crow(int r,int hi){return (r&3)+8*(r>>2)+4*hi;}
#define SBAR() __builtin_amdgcn_sched_barrier(0)
constexpr int NSLOT=6, SLOTB=8192;
constexpr int LDS_K=0, LDS_V=NSLOT*SLOTB, LDS_WS=2*NSLOT*SLOTB, LDS_OST=LDS_WS+NW*64*4, LDS_BYTES=LDS_OST+NW*4096;
constexpr float C2=0.125f*1.4426950408889634f;
__device__ __forceinline__ void glds16(const void*sbase,unsigned voff,unsigned lds_dst){unsigned keep;
  asm volatile("s_mov_b32 %0, m0\n\ts_mov_b32 m0, %3\n\ts_nop 0\n\tglobal_load_lds_dwordx4 %1, %2\n\ts_mov_b32 m0, %0":"=&s"(keep):"v"(voff),"s"(sbase),"s"(lds_dst):"memory");}
__device__ __forceinline__ float max3f(float a,float b,float c){float r;asm("v_max3_f32 %0, %1, %2, %3":"=v"(r):"v"(a),"v"(b),"v"(c));return r;}
__device__ __forceinline__ float max2f(float a,float b){float r;asm("v_max_f32_e32 %0, %1, %2":"=v"(r):"v"(a),"v"(b));return r;}
__device__ __forceinline__ float fsub_s(float a,float b){float r;asm("v_sub_f32_e32 %0, %1, %2":"=v"(r):"v"(a),"v"(b));return r;}
typedef float f32x2_t __attribute__((ext_vector_type(2))); typedef __bf16 bf16x2_t __attribute__((ext_vector_type(2)));
__device__ __forceinline__ unsigned cvtpk_s(float lo,float hi){f32x2_t v={lo,hi};bf16x2_t b=__builtin_convertvector(v,bf16x2_t);return __builtin_bit_cast(unsigned,b);}
#define WAIT_BAR(N) asm volatile("s_waitcnt vmcnt(" #N ") lgkmcnt(0)\n\ts_barrier":::"memory")
typedef __attribute__((address_space(3))) const char* lds_cptr;
typedef short v4i16_t __attribute__((ext_vector_type(4)));
__device__ __forceinline__ void kload8(bf16x8*kf,lds_cptr kp,int bo){
  #pragma unroll
  for(int d0=0;d0<4;++d0){ const lds_cptr p=kp+((d0*32)^bo); kf[2*d0]=*(const __attribute__((address_space(3))) bf16x8*)(p); kf[2*d0+1]=*(const __attribute__((address_space(3))) bf16x8*)(p+4096); }
}
__device__ __forceinline__ void kload2(bf16x8*kf,lds_cptr kp,int j,int bo){ const lds_cptr p=kp+((j*32)^bo); kf[2*j]=*(const __attribute__((address_space(3))) bf16x8*)(p); kf[2*j+1]=*(const __attribute__((address_space(3))) bf16x8*)(p+4096); }
__device__ __forceinline__ s16x4 vtr(lds_cptr p){ return __builtin_bit_cast(s16x4,__builtin_amdgcn_ds_read_tr16_b64_v4i16((__attribute__((address_space(3))) v4i16_t*)p)); }
__device__ __forceinline__ float rowmax(const f32x16&p0,const f32x16&p1){
  float a=max3f(p0[0],p0[1],p1[0]),b=max3f(p0[2],p0[3],p1[1]);a=max3f(a,p1[2],p1[3]);
  #pragma unroll
  for(int r=4;r<16;r+=4){a=max3f(a,p0[r],p0[r+1]);b=max3f(b,p0[r+2],p0[r+3]);a=max3f(a,p1[r],p1[r+1]);b=max3f(b,p1[r+2],p1[r+3]);}
  const float m=max2f(a,b);
  auto rr=__builtin_amdgcn_permlane32_swap(__float_as_uint(m),__float_as_uint(m),false,false);
  return max2f(__uint_as_float(rr[0]),__uint_as_float(rr[1]));
}
__device__ __forceinline__ void pv(f32x16*o,int vb,bf16x8 pa0,bf16x8 pa1,bf16x8 pa2,bf16x8 pa3){
  #pragma unroll
  for(int d0=0;d0<2;++d0){s16x4 lo[4],hi[4];
    #pragma unroll
    for(int ks=0;ks<4;++ks){
      asm volatile("ds_read_b64_tr_b16 %0,%1 offset:%c2":"=&v"(lo[ks]):"v"(vb),"i"(d0*4096+ks*1024):"memory");
      asm volatile("ds_read_b64_tr_b16 %0,%1 offset:%c2":"=&v"(hi[ks]):"v"(vb),"i"(d0*4096+ks*1024+512):"memory");}
    asm volatile("s_waitcnt lgkmcnt(0)":::"memory");SBAR();
    #define PK(k) (bf16x8){lo[k][0],lo[k][1],lo[k][2],lo[k][3],hi[k][0],hi[k][1],hi[k][2],hi[k][3]}
    o[d0]=__builtin_amdgcn_mfma_f32_32x32x16_bf16(pa0,PK(0),o[d0],0,0,0);
    o[d0]=__builtin_amdgcn_mfma_f32_32x32x16_bf16(pa1,PK(1),o[d0],0,0,0);
    o[d0]=__builtin_amdgcn_mfma_f32_32x32x16_bf16(pa2,PK(2),o[d0],0,0,0);
    o[d0]=__builtin_amdgcn_mfma_f32_32x32x16_bf16(pa3,PK(3),o[d0],0,0,0);
    #undef PK
  }
}
template<int W> __device__ __forceinline__ void wmask(f32x16&p0,f32x16&p1,int d,float NEG){
  asm volatile("":"+v"(d));
  #pragma unroll
  for(int r=0;r<16;++r){const int c=(r&3)+8*(r>>2);
    if(W==0x7fffffff){ if(d<c)p0[r]=NEG; if(d<c+32)p1[r]=NEG; }
    else{ if((unsigned)(d-c)>(unsigned)W)p0[r]=NEG; if((unsigned)(d-c-32)>(unsigned)W)p1[r]=NEG; } }
}
struct UnitDesc {
  const bf16* Q; long qs;
  const bf16* K; long ks;
  const bf16* V; long vs;
  bf16* O; long os;
  float* lse; long lses;
  int NT;
  int rel0;
  int tg0;
  int q0;
  float slope2;
  float sink2;
};
template<int MODE,int THRL,int DIL,int OS> __device__ __forceinline__ void attn_unit(const UnitDesc&u,char*shm){
  constexpr int W=(MODE==0)?0x7fffffff:(MODE==1?128:127);
  const float NEG=(MODE==0)?-INFINITY:-1024.f;
  int tid=threadIdx.x; asm volatile("":"+v"(tid));
  const int lane=tid&63,r32=lane&31,hi=lane>>5; const int wid=__builtin_amdgcn_readfirstlane(tid>>6);
  constexpr long qs=64L*DIL,ks=64L*DIL,vs=64L*DIL;
  const bf16*Qw=u.Q+(long)(wid*QBLK)*qs;
  const unsigned lds0=(unsigned)(uintptr_t)shm;
  __attribute__((address_space(3))) float*wsf=(__attribute__((address_space(3))) float*)((__attribute__((address_space(3))) char*)shm+LDS_WS)+wid*64;
  const unsigned ksoff=(unsigned)(((long)(8*wid+(lane>>3))*ks+(((lane&7)^(lane>>3))*8))*2);
  const unsigned vsoff=(unsigned)(((long)(16*(wid&3)+(lane>>2))*vs+(wid>>2)*32+(lane&3)*8)*2);
  const unsigned kdst=lds0+LDS_K+wid*1024, vdst=lds0+LDS_V+wid*1024;
  #define DMA_K(t,slot) glds16(u.K+(long)(t)*KVBLK*ks,ksoff,(unsigned)__builtin_amdgcn_readfirstlane(kdst+(slot)))
  #define DMA_V(t,slot) glds16(u.V+(long)(t)*KVBLK*vs,vsoff,(unsigned)__builtin_amdgcn_readfirstlane(vdst+(slot)))
  bf16x8 kf[8];
  const lds_cptr shm3=(lds_cptr)shm; const lds_cptr kp0=shm3+LDS_K+r32*128+((hi^(r32&1))*16); const int kbo=((r32>>1)&3)<<5; const lds_cptr vp0=shm3+LDS_V+((lane>>4)&1)*32+(lane&3)*8+(4*hi+((lane&15)>>2))*64;
  const int NT=u.NT;
  if(MODE==0){DMA_K(0,0);DMA_V(0,0);DMA_K(1,SLOTB);} else {DMA_K(0,0);}
  bf16x8 qr[4];
  #pragma unroll
  for(int d0=0;d0<4;++d0)qr[d0]=*reinterpret_cast<const bf16x8*>(&Qw[(long)r32*qs+d0*16+hi*8]);
  const unsigned s2hb=__float_as_uint(u.slope2)&0xffff0000u; const float s2hf=__uint_as_float(s2hb);
  const unsigned s2lb=__float_as_uint(u.slope2-s2hf)&0xffff0000u; const float s2used=s2hf+__uint_as_float(s2lb);
  u32x4 qx; qx[0]=hi?0u:((__float_as_uint(64.f*s2hf)>>16)|(__float_as_uint(64.f*__uint_as_float(s2lb))&0xffff0000u)); qx[1]=hi?0u:((s2hb>>16)|s2lb); qx[2]=0u; qx[3]=0u;
  u32x4 kx0; unsigned jp0,jp1; { const unsigned j0=__float_as_uint((float)r32)>>16, j1=__float_as_uint((float)(r32+32))>>16; jp0=j0|(j0<<16); jp1=j1|(j1<<16);
    kx0[0]=0u; kx0[1]=jp0; kx0[2]=0x3f803f80u; kx0[3]=0u; }
  #define SETTG(t) do{ const unsigned tb_=__float_as_uint((float)(u.tg0+(t)))>>16; kx0[0]=(tb_|(tb_<<16)); }while(0)
  #define KX0 __builtin_bit_cast(bf16x8,kx0)
  #define QX __builtin_bit_cast(bf16x8,qx)
  #define SETREF(m_) do{ const unsigned hb_=__float_as_uint(m_)&0xffff0000u; const float hf_=__uint_as_float(hb_); const unsigned lb_=__float_as_uint((m_)-hf_)&0xffff0000u; \
      mhat=hf_+__uint_as_float(lb_); qx[2]=hi?0u:(((hb_^0x80000000u)>>16)|(lb_^0x80000000u)); }while(0)
  float mhat=0.f,l_reg=0.f;f32x16 o[2];o[0]=f32x16{};o[1]=f32x16{};
  const int qrel=u.rel0+wid*QBLK+r32-4*hi;
  #define CMASK(P0,P1,t) do{ if(MODE!=0||(t)>=NT-4) wmask<W>(P0,P1,qrel-64*(t),NEG); }while(0)
  bool resc=false;
  f32x16 pA0,pA1,pB0,pB1;
  int sl_prev=0,sl_cur=0,sl_next=SLOTB;
  #define ROT() do{sl_prev=sl_cur;sl_cur=sl_next;sl_next=(sl_next==(NSLOT-1)*SLOTB)?0:sl_next+SLOTB;}while(0)
  #define RESC() do{ if(resc){ asm volatile("s_waitcnt lgkmcnt(0)":::"memory"); \
      _Pragma("unroll") for(int d_=0;d_<2;++d_) _Pragma("unroll") for(int r=0;r<16;++r)o[d_][r]*=wsf[crow(r,hi)]; } }while(0)
  if(MODE==0){ DMA_K(2,2*SLOTB); WAIT_BAR(3); }
  else{ DMA_K(1,SLOTB);DMA_V(0,0);DMA_K(2,2*SLOTB);DMA_V(1,SLOTB);DMA_K(3,3*SLOTB);DMA_V(2,2*SLOTB);DMA_V(3,3*SLOTB);
    if(NT>4){DMA_K(4,4*SLOTB);DMA_K(5,5*SLOTB);DMA_V(4,4*SLOTB);DMA_V(5,5*SLOTB);}
    WAIT_BAR(0); }
  { SETTG(0); const f32x16 z=f32x16{}; const lds_cptr kb=kp0;
    #pragma unroll
    for(int d0=0;d0<4;++d0){
      const bf16x8 b0=*(const __attribute__((address_space(3))) bf16x8*)(kb+((d0*32)^kbo));
      const bf16x8 b1=*(const __attribute__((address_space(3))) bf16x8*)(kb+((d0*32)^kbo)+4096);
      if(d0==0){pA0=__builtin_amdgcn_mfma_f32_32x32x16_bf16(b0,qr[0],z,0,0,0);pA1=__builtin_amdgcn_mfma_f32_32x32x16_bf16(b1,qr[0],z,0,0,0);}
      else{pA0=__builtin_amdgcn_mfma_f32_32x32x16_bf16(b0,qr[d0],pA0,0,0,0);pA1=__builtin_amdgcn_mfma_f32_32x32x16_bf16(b1,qr[d0],pA1,0,0,0);}}
    pA0=__builtin_amdgcn_mfma_f32_32x32x16_bf16(KX0,QX,pA0,0,0,0); kx0[1]=jp1; pA1=__builtin_amdgcn_mfma_f32_32x32x16_bf16(KX0,QX,pA1,0,0,0); kx0[1]=jp0; }
  asm volatile("s_nop 15\n\ts_nop 7":"+v"(pA0),"+v"(pA1));CMASK(pA0,pA1,0);
  { const float rm=rowmax(pA0,pA1); SETREF(rm); const float dl=mhat;
    _Pragma("unroll") for(int r=0;r<16;++r){pA0[r]=fsub_s(pA0[r],dl);pA1[r]=fsub_s(pA1[r],dl);}
    _Pragma("unroll") for(int r=0;r<16;++r)pA0[r]=__builtin_amdgcn_exp2f(pA0[r]); }
  _Pragma("unroll") for(int r=0;r<16;++r)pA1[r]=__builtin_amdgcn_exp2f(pA1[r]);
  if(MODE==0){ WAIT_BAR(0); DMA_K(3,0);DMA_V(1,SLOTB); }
  ROT();
  kload8(kf,kp0+sl_cur,kbo);
  if(MODE==0){ WAIT_BAR(2); }
  s16x4 vlo[8],vhi[8]; u32x4 pw0,pw1,pw2,pw3;
  #define PKW(P,B) cvtpk_s(P[B],P[B+1])
  #define PAF(k) __builtin_bit_cast(bf16x8,pw##k)
  #define VFR(i) (bf16x8){vlo[i][0],vlo[i][1],vlo[i][2],vlo[i][3],vhi[i][0],vhi[i][1],vhi[i][2],vhi[i][3]}
  #define PIN(x) asm volatile("":"+v"(x))
  #define MX3(a,b,c) __builtin_fmaxf(__builtin_fmaxf((a),(b)),(c))
  #define GAPA(MF,A0,A1,A2,A3,W0,W1,PW) do{ MF; sacc+=A0; sacc+=A1; sacc+=A2; sacc+=A3; PIN(sacc); W0; W1; PIN(PW); SBAR(); }while(0)
  #define EX(v) __builtin_amdgcn_exp2f(v)
  #define GAPB(MF,X,B) do{ MF; X[B]=EX(X[B]); X[B+1]=EX(X[B+1]); X[B+2]=EX(X[B+2]); X[B+3]=EX(X[B+3]); PIN(X); SBAR(); }while(0)
  #define VRD(i) do{ vlo[i]=vtr(vp_+(((i)>>2)*4096+((i)&3)*1024)); vhi[i]=vtr(vp_+(((i)>>2)*4096+((i)&3)*1024+512)); }while(0)
  #define KRD(G,j) do{ if(G){ kload2(kf,kp0+sl_next,j,kbo); SBAR(); } }while(0)
  #define STEP(C0,C1,P0,P1,t,GK,GV,GL) do{ SBAR(); SETTG(t); const f32x16 z_=f32x16{}; \
    const lds_cptr vp_=vp0+sl_prev; \
    VRD(0); SBAR(); float sacc=(P0[0]+P0[1]); \
    GAPA(C0=__builtin_amdgcn_mfma_f32_32x32x16_bf16(kf[0],qr[0],z_,0,0,0), P0[2],P0[3],P0[4],P0[5],     pw0[0]=PKW(P0,0), pw0[1]=PKW(P0,2), pw0); \
    VRD(4); SBAR(); GAPA(C1=__builtin_amdgcn_mfma_f32_32x32x16_bf16(kf[1],qr[0],z_,0,0,0), P0[6],P0[7],P0[8],P0[9],     pw0[2]=PKW(P0,4), pw0[3]=PKW(P0,6), pw0); \
    VRD(1); SBAR(); GAPA(C0=__builtin_amdgcn_mfma_f32_32x32x16_bf16(kf[2],qr[1],C0,0,0,0),   P0[10],P0[11],P0[12],P0[13], pw1[0]=PKW(P0,8), pw1[1]=PKW(P0,10), pw1); \
    VRD(5); SBAR(); GAPA(C1=__builtin_amdgcn_mfma_f32_32x32x16_bf16(kf[3],qr[1],C1,0,0,0),   P0[14],P0[15],P1[0],P1[1],   pw1[2]=PKW(P0,12),pw1[3]=PKW(P0,14), pw1); \
    VRD(2); SBAR(); GAPA(C0=__builtin_amdgcn_mfma_f32_32x32x16_bf16(kf[4],qr[2],C0,0,0,0),   P1[2],P1[3],P1[4],P1[5],     pw2[0]=PKW(P1,0), pw2[1]=PKW(P1,2), pw2); \
    VRD(6); SBAR(); GAPA(C1=__builtin_amdgcn_mfma_f32_32x32x16_bf16(kf[5],qr[2],C1,0,0,0),   P1[6],P1[7],P1[8],P1[9],     pw2[2]=PKW(P1,4), pw2[3]=PKW(P1,6), pw2); \
    VRD(3); SBAR(); GAPA(C0=__builtin_amdgcn_mfma_f32_32x32x16_bf16(kf[6],qr[3],C0,0,0,0),   P1[10],P1[11],P1[12],P1[13], pw3[0]=PKW(P1,8), pw3[1]=PKW(P1,10), pw3); \
    VRD(7); SBAR(); GAPA(C1=__builtin_amdgcn_mfma_f32_32x32x16_bf16(kf[7],qr[3],C1,0,0,0),   P1[14],P1[15],0.f,0.f,       pw3[2]=PKW(P1,12),pw3[3]=PKW(P1,14), pw3); \
    C0=__builtin_amdgcn_mfma_f32_32x32x16_bf16(KX0,QX,C0,0,0,0); kx0[1]=jp1; C1=__builtin_amdgcn_mfma_f32_32x32x16_bf16(KX0,QX,C1,0,0,0); kx0[1]=jp0; SBAR(); \
    l_reg+=sacc; \
    if(GK){DMA_K((t)+3,sl_cur);} if(GV){DMA_V((t)+1,sl_next);} \
    CMASK(C0,C1,t); \
    { float a=MX3(C0[0],C0[1],C1[0]),b=MX3(C0[2],C0[3],C1[1]); a=MX3(a,C1[2],C1[3]); \
      _Pragma("unroll") for(int r=4;r<16;r+=4){a=MX3(a,C0[r],C0[r+1]);b=MX3(b,C0[r+2],C0[r+3]);a=MX3(a,C1[r],C1[r+1]);b=MX3(b,C1[r+2],C1[r+3]);} \
      float rm=__builtin_fmaxf(a,b); { auto rr=__builtin_amdgcn_permlane32_swap(__float_as_uint(rm),__float_as_uint(rm),false,false); rm=__builtin_fmaxf(__uint_as_float(rr[0]),__uint_as_float(rr[1])); } \
      resc=false; \
      if(__builtin_expect(__any(rm>(float)THRL),0)){ const float mold=mhat; const float mnew=mold+__builtin_fmaxf(rm,0.f); SETREF(mnew); const float dl=mhat-mold; \
        _Pragma("unroll") for(int r=0;r<16;++r){C0[r]-=dl;C1[r]-=dl;} \
        const float f=__builtin_amdgcn_exp2f(-dl); l_reg*=f; if(hi==0)wsf[r32]=f; resc=true; } } \
    SBAR(); \
    GAPB(o[0]=__builtin_amdgcn_mfma_f32_32x32x16_bf16(PAF(0),VFR(0),o[0],0,0,0), C0,0); \
    GAPB(o[1]=__builtin_amdgcn_mfma_f32_32x32x16_bf16(PAF(0),VFR(4),o[1],0,0,0), C0,4); \
    KRD(GL,0); GAPB(o[0]=__builtin_amdgcn_mfma_f32_32x32x16_bf16(PAF(1),VFR(1),o[0],0,0,0), C0,8); \
    KRD(GL,1); GAPB(o[1]=__builtin_amdgcn_mfma_f32_32x32x16_bf16(PAF(1),VFR(5),o[1],0,0,0), C0,12); \
    KRD(GL,2); GAPB(o[0]=__builtin_amdgcn_mfma_f32_32x32x16_bf16(PAF(2),VFR(2),o[0],0,0,0), C1,0); \
    KRD(GL,3); GAPB(o[1]=__builtin_amdgcn_mfma_f32_32x32x16_bf16(PAF(2),VFR(6),o[1],0,0,0), C1,4); \
    GAPB(o[0]=__builtin_amdgcn_mfma_f32_32x32x16_bf16(PAF(3),VFR(3),o[0],0,0,0), C1,8); \
    GAPB(o[1]=__builtin_amdgcn_mfma_f32_32x32x16_bf16(PAF(3),VFR(7),o[1],0,0,0), C1,12); \
    }while(0)
  int t=1;
  if(MODE==0){
    #undef CMASK
    #define CMASK(P0,P1,t) do{}while(0)
    for(;t+5<NT;t+=2){
      STEP(pB0,pB1,pA0,pA1,t,true,true,true);     WAIT_BAR(2); RESC(); ROT();
      STEP(pA0,pA1,pB0,pB1,t+1,true,true,true);   WAIT_BAR(2); RESC(); ROT();
    }
    #undef CMASK
    #define CMASK(P0,P1,t) do{ if(MODE!=0||(t)>=NT-4) wmask<W>(P0,P1,qrel-64*(t),NEG); }while(0)
  }
  #define ENDW(tt) do{ if(MODE==0){ if((tt)+3<NT){WAIT_BAR(2);} else if((tt)+2<NT){WAIT_BAR(1);} else {WAIT_BAR(0);} } }while(0)
  for(;t+1<NT;t+=2){
    STEP(pB0,pB1,pA0,pA1,t,(MODE==0&&t+3<NT),(MODE==0&&t+1<NT),(t+1<NT));       ENDW(t);   RESC(); ROT();
    STEP(pA0,pA1,pB0,pB1,t+1,(MODE==0&&t+4<NT),(MODE==0&&t+2<NT),(t+2<NT));     ENDW(t+1); RESC(); ROT();
  }
  STEP(pB0,pB1,pA0,pA1,NT-1,false,false,false); RESC();
  { float sacc=pB0[0]+pB0[1]; _Pragma("unroll") for(int r=2;r<16;++r)sacc+=pB0[r]; _Pragma("unroll") for(int r=0;r<16;++r)sacc+=pB1[r]; l_reg+=sacc;
    pw0=(u32x4){PKW(pB0,0),PKW(pB0,2),PKW(pB0,4),PKW(pB0,6)};pw1=(u32x4){PKW(pB0,8),PKW(pB0,10),PKW(pB0,12),PKW(pB0,14)};pw2=(u32x4){PKW(pB1,0),PKW(pB1,2),PKW(pB1,4),PKW(pB1,6)};pw3=(u32x4){PKW(pB1,8),PKW(pB1,10),PKW(pB1,12),PKW(pB1,14)};
    SBAR(); pv(o,(int)(lds0+LDS_V)+((lane>>4)&1)*32+(lane&3)*8+(4*hi+((lane&15)>>2))*64+sl_cur,PAF(0),PAF(1),PAF(2),PAF(3)); }
  #undef PKW
  #undef PAF
  #undef VFR
  #undef PIN
  #undef MX3
  #undef GAPA
  #undef GAPB
  #undef EX
  #undef VRD
  #undef KRD
  #undef STEP
  #undef ENDW
  {auto rr=__builtin_amdgcn_permlane32_swap(__float_as_uint(l_reg),__float_as_uint(l_reg),false,false);l_reg=__uint_as_float(rr[0])+__uint_as_float(rr[1]);}
  const float qposf=(float)(u.q0+wid*QBLK+r32);
  if(MODE==2) l_reg+=__builtin_amdgcn_exp2f(u.sink2+s2used*qposf-mhat);
  if(MODE==1){ if(hi==0) u.lse[(long)(wid*QBLK+r32)*(16*DIL)]=mhat-s2used*qposf+__builtin_amdgcn_logf(l_reg); }
  if(hi==0)wsf[32+r32]=l_reg;asm volatile("s_waitcnt lgkmcnt(0)":::"memory");
  float rli[16];
  #pragma unroll
  for(int r=0;r<16;++r)rli[r]=__builtin_amdgcn_rcpf(wsf[32+crow(r,hi)]);
  bf16*Ow=u.O+(long)(wid*QBLK)*OS;
  { int le=lane; asm volatile("":"+v"(le));
    const int r32e=le&31,hie=le>>5;
    __hip_bfloat16*stg=(__hip_bfloat16*)(shm+LDS_OST)+wid*2048;
    #pragma unroll
    for(int r=0;r<16;++r){const int orow=crow(r,hie);
      #pragma unroll
      for(int d0=0;d0<2;++d0)stg[orow*64+d0*32+r32e]=__float2bfloat16(o[d0][r]*rli[r]);}
    asm volatile("s_waitcnt lgkmcnt(0)":::"memory");
    #pragma unroll
    for(int i=0;i<4;++i){const int row=i*8+(le>>3),ch=le&7; const u32x4 v=*(const u32x4*)(stg+row*64+ch*8); *(u32x4*)(Ow+(long)row*OS+ch*8)=v;} }
  asm volatile("s_waitcnt lgkmcnt(0)\n\ts_barrier":::"memory");
  #undef DMA_K
  #undef DMA_V
  #undef CMASK
  #undef RESC
  #undef ROT
  #undef SETTG
  #undef SETREF
  #undef KX0
  #undef QX
}
#undef SBAR
#undef WAIT_BAR
}

namespace att128 {
using att::UnitDesc; using att::crow; using att::glds16; using att::max3f; using att::max2f; using att::fsub_s; using att::cvtpk_s; using att::kload8; using att::kload2; using att::vtr; using att::rowmax; using att::wmask; using att::lds_cptr;
using bf16=unsigned short;
using bf16x8=__attribute__((ext_vector_type(8)))short;
using s16x4=__attribute__((ext_vector_type(4)))short;
using f32x16=__attribute__((ext_vector_type(16)))float;
using u32x4=__attribute__((ext_vector_type(4)))unsigned;
constexpr int NW=8,QBLK=32,QB=QBLK*NW,KVBLK=64;
#define SBAR() __builtin_amdgcn_sched_barrier(0)
constexpr int NSLOT=3, SLOTB=8192, SLOTV=16384;
constexpr int LDS_K=0, LDS_V=NSLOT*SLOTB, LDS_WS=LDS_V+NSLOT*SLOTV, LDS_OST=LDS_WS+NW*64*4, LDS_BYTES=LDS_OST+NW*8192;
#define WAIT_BAR(N) asm volatile("s_waitcnt vmcnt(" #N ") lgkmcnt(0)\n\ts_barrier":::"memory")
__device__ __forceinline__ void pv4(f32x16*o,int vb,bf16x8 pa0,bf16x8 pa1,bf16x8 pa2,bf16x8 pa3){
  #pragma unroll
  for(int d0=0;d0<4;++d0){s16x4 lo[4],hi[4];
    #pragma unroll
    for(int ks=0;ks<4;++ks){
      asm volatile("ds_read_b64_tr_b16 %0,%1 offset:%c2":"=&v"(lo[ks]):"v"(vb),"i"(d0*4096+ks*1024):"memory");
      asm volatile("ds_read_b64_tr_b16 %0,%1 offset:%c2":"=&v"(hi[ks]):"v"(vb),"i"(d0*4096+ks*1024+512):"memory");}
    asm volatile("s_waitcnt lgkmcnt(0)":::"memory");SBAR();
    #define PK(k) (bf16x8){lo[k][0],lo[k][1],lo[k][2],lo[k][3],hi[k][0],hi[k][1],hi[k][2],hi[k][3]}
    o[d0]=__builtin_amdgcn_mfma_f32_32x32x16_bf16(pa0,PK(0),o[d0],0,0,0);
    o[d0]=__builtin_amdgcn_mfma_f32_32x32x16_bf16(pa1,PK(1),o[d0],0,0,0);
    o[d0]=__builtin_amdgcn_mfma_f32_32x32x16_bf16(pa2,PK(2),o[d0],0,0,0);
    o[d0]=__builtin_amdgcn_mfma_f32_32x32x16_bf16(pa3,PK(3),o[d0],0,0,0);
    #undef PK
  }
}
template<int MODE,int THRL,int DIL,int OS> __device__ __forceinline__ void attn_unit(const UnitDesc&u,char*shm){
  static_assert(MODE==0,"att128: causal mode only");
  constexpr int W=(MODE==0)?0x7fffffff:(MODE==1?128:127);
  const float NEG=(MODE==0)?-INFINITY:-1024.f;
  int tid=threadIdx.x; asm volatile("":"+v"(tid));
  const int lane=tid&63,r32=lane&31,hi=lane>>5; const int wid=__builtin_amdgcn_readfirstlane(tid>>6);
  constexpr long qs=64L*DIL,ks=64L*DIL,vs=64L*DIL;
  const bf16*Qw=u.Q+(long)(wid*QBLK)*qs;
  const unsigned lds0=(unsigned)(uintptr_t)shm;
  __attribute__((address_space(3))) float*wsf=(__attribute__((address_space(3))) float*)((__attribute__((address_space(3))) char*)shm+LDS_WS)+wid*64;
  const unsigned ksoff=(unsigned)(((long)(8*wid+(lane>>3))*ks+(((lane&7)^(lane>>3))*8))*2);
  const unsigned vsoff=(unsigned)(((long)(16*(wid&3)+(lane>>2))*vs+(wid>>2)*32+(lane&3)*8)*2);
  const unsigned kdst=lds0+LDS_K+wid*1024, vdst=lds0+LDS_V+wid*1024;
  #define DMA_K(t,slot) glds16(u.K+(long)(t)*KVBLK*ks,ksoff,(unsigned)__builtin_amdgcn_readfirstlane(kdst+(slot)))
  #define DMA_V(t,slot) do{ glds16(u.V+(long)(t)*KVBLK*vs,vsoff,(unsigned)__builtin_amdgcn_readfirstlane(vdst+2*(slot))); glds16(u.V+(long)(t)*KVBLK*vs+64*(long)M,vsoff,(unsigned)__builtin_amdgcn_readfirstlane(vdst+2*(slot)+8192)); }while(0)
  bf16x8 kf[8];
  const lds_cptr shm3=(lds_cptr)shm; const lds_cptr kp0=shm3+LDS_K+r32*128+((hi^(r32&1))*16); const int kbo=((r32>>1)&3)<<5; const lds_cptr vp0=shm3+LDS_V+((lane>>4)&1)*32+(lane&3)*8+(4*hi+((lane&15)>>2))*64;
  const int NT=u.NT;
  DMA_K(0,0);DMA_V(0,0);DMA_K(1,SLOTB);
  bf16x8 qr[4];
  #pragma unroll
  for(int d0=0;d0<4;++d0)qr[d0]=*reinterpret_cast<const bf16x8*>(&Qw[(long)r32*qs+d0*16+hi*8]);
  const unsigned s2hb=__float_as_uint(u.slope2)&0xffff0000u; const float s2hf=__uint_as_float(s2hb);
  const unsigned s2lb=__float_as_uint(u.slope2-s2hf)&0xffff0000u; const float s2used=s2hf+__uint_as_float(s2lb);
  u32x4 qx; qx[0]=hi?0u:((__float_as_uint(64.f*s2hf)>>16)|(__float_as_uint(64.f*__uint_as_float(s2lb))&0xffff0000u)); qx[1]=hi?0u:((s2hb>>16)|s2lb); qx[2]=0u; qx[3]=0u;
  u32x4 kx0; unsigned jp0,jp1; { const unsigned j0=__float_as_uint((float)r32)>>16, j1=__float_as_uint((float)(r32+32))>>16; jp0=j0|(j0<<16); jp1=j1|(j1<<16);
    kx0[0]=0u; kx0[1]=jp0; kx0[2]=0x3f803f80u; kx0[3]=0u; }
  #define SETTG(t) do{ const unsigned tb_=__float_as_uint((float)(u.tg0+(t)))>>16; kx0[0]=(tb_|(tb_<<16)); }while(0)
  #define KX0 __builtin_bit_cast(bf16x8,kx0)
  #define QX __builtin_bit_cast(bf16x8,qx)
  #define SETREF(m_) do{ const unsigned hb_=__float_as_uint(m_)&0xffff0000u; const float hf_=__uint_as_float(hb_); const unsigned lb_=__float_as_uint((m_)-hf_)&0xffff0000u; \
      mhat=hf_+__uint_as_float(lb_); qx[2]=hi?0u:(((hb_^0x80000000u)>>16)|(lb_^0x80000000u)); }while(0)
  float mhat=0.f,l_reg=0.f;f32x16 o[4];o[0]=f32x16{};o[1]=f32x16{};o[2]=f32x16{};o[3]=f32x16{};
  const int qrel=u.rel0+wid*QBLK+r32-4*hi;
  #define CMASK(P0,P1,t) do{ if(MODE!=0||(t)>=NT-4) wmask<W>(P0,P1,qrel-64*(t),NEG); }while(0)
  bool resc=false;
  f32x16 pA0,pA1,pB0,pB1;
  int sl_prev=0,sl_cur=0,sl_next=SLOTB;
  #define ROT() do{sl_prev=sl_cur;sl_cur=sl_next;sl_next=(sl_next==(NSLOT-1)*SLOTB)?0:sl_next+SLOTB;}while(0)
  #define RESC() do{ if(resc){ asm volatile("s_waitcnt lgkmcnt(0)":::"memory"); \
      _Pragma("unroll") for(int d_=0;d_<4;++d_) _Pragma("unroll") for(int r=0;r<16;++r)o[d_][r]*=wsf[crow(r,hi)]; } }while(0)
  DMA_K(2,2*SLOTB);
  WAIT_BAR(4);
  { SETTG(0); const f32x16 z=f32x16{}; const lds_cptr kb=kp0;
    #pragma unroll
    for(int d0=0;d0<4;++d0){
      const bf16x8 b0=*(const __attribute__((address_space(3))) bf16x8*)(kb+((d0*32)^kbo));
      const bf16x8 b1=*(const __attribute__((address_space(3))) bf16x8*)(kb+((d0*32)^kbo)+4096);
      if(d0==0){pA0=__builtin_amdgcn_mfma_f32_32x32x16_bf16(b0,qr[0],z,0,0,0);pA1=__builtin_amdgcn_mfma_f32_32x32x16_bf16(b1,qr[0],z,0,0,0);}
      else{pA0=__builtin_amdgcn_mfma_f32_32x32x16_bf16(b0,qr[d0],pA0,0,0,0);pA1=__builtin_amdgcn_mfma_f32_32x32x16_bf16(b1,qr[d0],pA1,0,0,0);}}
    pA0=__builtin_amdgcn_mfma_f32_32x32x16_bf16(KX0,QX,pA0,0,0,0); kx0[1]=jp1; pA1=__builtin_amdgcn_mfma_f32_32x32x16_bf16(KX0,QX,pA1,0,0,0); kx0[1]=jp0; }
  asm volatile("s_nop 15\n\ts_nop 7":"+v"(pA0),"+v"(pA1));CMASK(pA0,pA1,0);
  { const float rm=rowmax(pA0,pA1); SETREF(rm); const float dl=mhat;
    _Pragma("unroll") for(int r=0;r<16;++r){pA0[r]=fsub_s(pA0[r],dl);pA1[r]=fsub_s(pA1[r],dl);}
    _Pragma("unroll") for(int r=0;r<16;++r)pA0[r]=__builtin_amdgcn_exp2f(pA0[r]); }
  _Pragma("unroll") for(int r=0;r<16;++r)pA1[r]=__builtin_amdgcn_exp2f(pA1[r]);
  WAIT_BAR(0);
  DMA_K(3,0);DMA_V(1,SLOTB);
  ROT();
  kload8(kf,kp0+sl_cur,kbo);
  WAIT_BAR(3);
  s16x4 vlo[3],vhi[3]; u32x4 pw0,pw1,pw2,pw3;
  #define PKW(P,B) cvtpk_s(P[B],P[B+1])
  #define PAF(k) __builtin_bit_cast(bf16x8,pw##k)
  #define VFJ(b) (bf16x8){vlo[b][0],vlo[b][1],vlo[b][2],vlo[b][3],vhi[b][0],vhi[b][1],vhi[b][2],vhi[b][3]}
  #define PIN(x) asm volatile("":"+v"(x))
  #define MX3(a,b,c) __builtin_fmaxf(__builtin_fmaxf((a),(b)),(c))
  #define GAPA(MF,A0,A1,A2,A3,W0,W1,PW) do{ MF; sacc+=A0; sacc+=A1; sacc+=A2; sacc+=A3; PIN(sacc); W0; W1; PIN(PW); SBAR(); }while(0)
  #define EX(v) __builtin_amdgcn_exp2f(v)
  #define GAPB2(MF,X,B) do{ MF; X[B]=EX(X[B]); X[B+1]=EX(X[B+1]); PIN(X); SBAR(); }while(0)
  #define VRJ(b,n) do{ vlo[b]=vtr(vp_+(((n)&3)*4096+((n)>>2)*1024)); vhi[b]=vtr(vp_+(((n)&3)*4096+((n)>>2)*1024+512)); SBAR(); }while(0)
  #define KRD(G,j) do{ if(G){ kload2(kf,kp0+sl_next,j,kbo); SBAR(); } }while(0)
  #define STEP(C0,C1,P0,P1,t,GK,GV,GL) do{ SBAR(); SETTG(t); const f32x16 z_=f32x16{}; \
    const lds_cptr vp_=vp0+2*sl_prev; \
    float sacc=(P0[0]+P0[1]); \
    GAPA(C0=__builtin_amdgcn_mfma_f32_32x32x16_bf16(kf[0],qr[0],z_,0,0,0), P0[2],P0[3],P0[4],P0[5],     pw0[0]=PKW(P0,0), pw0[1]=PKW(P0,2), pw0); \
    GAPA(C1=__builtin_amdgcn_mfma_f32_32x32x16_bf16(kf[1],qr[0],z_,0,0,0), P0[6],P0[7],P0[8],P0[9],     pw0[2]=PKW(P0,4), pw0[3]=PKW(P0,6), pw0); \
    GAPA(C0=__builtin_amdgcn_mfma_f32_32x32x16_bf16(kf[2],qr[1],C0,0,0,0),   P0[10],P0[11],P0[12],P0[13], pw1[0]=PKW(P0,8), pw1[1]=PKW(P0,10), pw1); \
    GAPA(C1=__builtin_amdgcn_mfma_f32_32x32x16_bf16(kf[3],qr[1],C1,0,0,0),   P0[14],P0[15],P1[0],P1[1],   pw1[2]=PKW(P0,12),pw1[3]=PKW(P0,14), pw1); \
    GAPA(C0=__builtin_amdgcn_mfma_f32_32x32x16_bf16(kf[4],qr[2],C0,0,0,0),   P1[2],P1[3],P1[4],P1[5],     pw2[0]=PKW(P1,0), pw2[1]=PKW(P1,2), pw2); \
    GAPA(C1=__builtin_amdgcn_mfma_f32_32x32x16_bf16(kf[5],qr[2],C1,0,0,0),   P1[6],P1[7],P1[8],P1[9],     pw2[2]=PKW(P1,4), pw2[3]=PKW(P1,6), pw2); \
    VRJ(0,0); GAPA(C0=__builtin_amdgcn_mfma_f32_32x32x16_bf16(kf[6],qr[3],C0,0,0,0),   P1[10],P1[11],P1[12],P1[13], pw3[0]=PKW(P1,8), pw3[1]=PKW(P1,10), pw3); \
    VRJ(1,1); GAPA(C1=__builtin_amdgcn_mfma_f32_32x32x16_bf16(kf[7],qr[3],C1,0,0,0),   P1[14],P1[15],0.f,0.f,       pw3[2]=PKW(P1,12),pw3[3]=PKW(P1,14), pw3); \
    C0=__builtin_amdgcn_mfma_f32_32x32x16_bf16(KX0,QX,C0,0,0,0); kx0[1]=jp1; C1=__builtin_amdgcn_mfma_f32_32x32x16_bf16(KX0,QX,C1,0,0,0); kx0[1]=jp0; SBAR(); \
    l_reg+=sacc; \
    if(GK){DMA_K((t)+3,sl_cur);} if(GV){DMA_V((t)+1,sl_next);} \
    CMASK(C0,C1,t); \
    { float a=MX3(C0[0],C0[1],C1[0]),b=MX3(C0[2],C0[3],C1[1]); a=MX3(a,C1[2],C1[3]); \
      _Pragma("unroll") for(int r=4;r<16;r+=4){a=MX3(a,C0[r],C0[r+1]);b=MX3(b,C0[r+2],C0[r+3]);a=MX3(a,C1[r],C1[r+1]);b=MX3(b,C1[r+2],C1[r+3]);} \
      float rm=__builtin_fmaxf(a,b); { auto rr=__builtin_amdgcn_permlane32_swap(__float_as_uint(rm),__float_as_uint(rm),false,false); rm=__builtin_fmaxf(__uint_as_float(rr[0]),__uint_as_float(rr[1])); } \
      resc=false; \
      if(__builtin_expect(__any(rm>(float)THRL),0)){ const float mold=mhat; const float mnew=mold+__builtin_fmaxf(rm,0.f); SETREF(mnew); const float dl=mhat-mold; \
        _Pragma("unroll") for(int r=0;r<16;++r){C0[r]-=dl;C1[r]-=dl;} \
        const float f=__builtin_amdgcn_exp2f(-dl); l_reg*=f; if(hi==0)wsf[r32]=f; resc=true; } } \
    SBAR(); \
    VRJ(2,2);             GAPB2(o[0]=__builtin_amdgcn_mfma_f32_32x32x16_bf16(PAF(0),VFJ(0),o[0],0,0,0), C0,0); \
    VRJ(0,3);             GAPB2(o[1]=__builtin_amdgcn_mfma_f32_32x32x16_bf16(PAF(0),VFJ(1),o[1],0,0,0), C0,2); \
    VRJ(1,4);             GAPB2(o[2]=__builtin_amdgcn_mfma_f32_32x32x16_bf16(PAF(0),VFJ(2),o[2],0,0,0), C0,4); \
    VRJ(2,5);             GAPB2(o[3]=__builtin_amdgcn_mfma_f32_32x32x16_bf16(PAF(0),VFJ(0),o[3],0,0,0), C0,6); \
    VRJ(0,6);  KRD(GL,0); GAPB2(o[0]=__builtin_amdgcn_mfma_f32_32x32x16_bf16(PAF(1),VFJ(1),o[0],0,0,0), C0,8); \
    VRJ(1,7);             GAPB2(o[1]=__builtin_amdgcn_mfma_f32_32x32x16_bf16(PAF(1),VFJ(2),o[1],0,0,0), C0,10); \
    VRJ(2,8);  KRD(GL,1); GAPB2(o[2]=__builtin_amdgcn_mfma_f32_32x32x16_bf16(PAF(1),VFJ(0),o[2],0,0,0), C0,12); \
    VRJ(0,9);             GAPB2(o[3]=__builtin_amdgcn_mfma_f32_32x32x16_bf16(PAF(1),VFJ(1),o[3],0,0,0), C0,14); \
    VRJ(1,10); KRD(GL,2); GAPB2(o[0]=__builtin_amdgcn_mfma_f32_32x32x16_bf16(PAF(2),VFJ(2),o[0],0,0,0), C1,0); \
    VRJ(2,11);            GAPB2(o[1]=__builtin_amdgcn_mfma_f32_32x32x16_bf16(PAF(2),VFJ(0),o[1],0,0,0), C1,2); \
    VRJ(0,12); KRD(GL,3); GAPB2(o[2]=__builtin_amdgcn_mfma_f32_32x32x16_bf16(PAF(2),VFJ(1),o[2],0,0,0), C1,4); \
    VRJ(1,13);            GAPB2(o[3]=__builtin_amdgcn_mfma_f32_32x32x16_bf16(PAF(2),VFJ(2),o[3],0,0,0), C1,6); \
    VRJ(2,14);            GAPB2(o[0]=__builtin_amdgcn_mfma_f32_32x32x16_bf16(PAF(3),VFJ(0),o[0],0,0,0), C1,8); \
    VRJ(0,15);            GAPB2(o[1]=__builtin_amdgcn_mfma_f32_32x32x16_bf16(PAF(3),VFJ(1),o[1],0,0,0), C1,10); \
                          GAPB2(o[2]=__builtin_amdgcn_mfma_f32_32x32x16_bf16(PAF(3),VFJ(2),o[2],0,0,0), C1,12); \
                          GAPB2(o[3]=__builtin_amdgcn_mfma_f32_32x32x16_bf16(PAF(3),VFJ(0),o[3],0,0,0), C1,14); \
    }while(0)
  int t=1;
  if(MODE==0){
    #undef CMASK
    #define CMASK(P0,P1,t) do{}while(0)
    for(;t+5<NT;t+=2){
      STEP(pB0,pB1,pA0,pA1,t,true,true,true);     WAIT_BAR(3); RESC(); ROT();
      STEP(pA0,pA1,pB0,pB1,t+1,true,true,true);   WAIT_BAR(3); RESC(); ROT();
    }
    #undef CMASK
    #define CMASK(P0,P1,t) do{ if(MODE!=0||(t)>=NT-4) wmask<W>(P0,P1,qrel-64*(t),NEG); }while(0)
  }
  #define ENDW(tt) do{ if((tt)+3<NT){WAIT_BAR(3);} else if((tt)+2<NT){WAIT_BAR(2);} else {WAIT_BAR(0);} }while(0)
  for(;t+1<NT;t+=2){
    STEP(pB0,pB1,pA0,pA1,t,(t+3<NT),(t+1<NT),(t+1<NT));       ENDW(t);   RESC(); ROT();
    STEP(pA0,pA1,pB0,pB1,t+1,(t+4<NT),(t+2<NT),(t+2<NT));     ENDW(t+1); RESC(); ROT();
  }
  STEP(pB0,pB1,pA0,pA1,NT-1,false,false,false); RESC();
  { float sacc=pB0[0]+pB0[1]; _Pragma("unroll") for(int r=2;r<16;++r)sacc+=pB0[r]; _Pragma("unroll") for(int r=0;r<16;++r)sacc+=pB1[r]; l_reg+=sacc;
    pw0=(u32x4){PKW(pB0,0),PKW(pB0,2),PKW(pB0,4),PKW(pB0,6)};pw1=(u32x4){PKW(pB0,8),PKW(pB0,10),PKW(pB0,12),PKW(pB0,14)};pw2=(u32x4){PKW(pB1,0),PKW(pB1,2),PKW(pB1,4),PKW(pB1,6)};pw3=(u32x4){PKW(pB1,8),PKW(pB1,10),PKW(pB1,12),PKW(pB1,14)};
    SBAR(); pv4(o,(int)(lds0+LDS_V)+((lane>>4)&1)*32+(lane&3)*8+(4*hi+((lane&15)>>2))*64+2*sl_cur,PAF(0),PAF(1),PAF(2),PAF(3)); }
  #undef PKW
  #undef PAF
  #undef VFJ
  #undef PIN
  #undef MX3
  #undef GAPA
  #undef GAPB2
  #undef EX
  #undef VRJ
  #undef KRD
  #undef STEP
  #undef ENDW
  {auto rr=__builtin_amdgcn_permlane32_swap(__float_as_uint(l_reg),__float_as_uint(l_reg),false,false);l_reg=__uint_as_float(rr[0])+__uint_as_float(rr[1]);}
  const float qposf=(float)(u.q0+wid*QBLK+r32);
  if(MODE==2) l_reg+=__builtin_amdgcn_exp2f(u.sink2+s2used*qposf-mhat);
  if(MODE==1){ if(hi==0) u.lse[(long)(wid*QBLK+r32)*(16*DIL)]=mhat-s2used*qposf+__builtin_amdgcn_logf(l_reg); }
  if(hi==0)wsf[32+r32]=l_reg;asm volatile("s_waitcnt lgkmcnt(0)":::"memory");
  float rli[16];
  #pragma unroll
  for(int r=0;r<16;++r)rli[r]=__builtin_amdgcn_rcpf(wsf[32+crow(r,hi)]);
  bf16*Ow=u.O+(long)(wid*QBLK)*OS;
  { int le=lane; asm volatile("":"+v"(le));
    const int r32e=le&31,hie=le>>5;
    __hip_bfloat16*stg=(__hip_bfloat16*)(shm+LDS_OST)+wid*4096;
    #pragma unroll
    for(int r=0;r<16;++r){const int orow=crow(r,hie);
      #pragma unroll
      for(int d0=0;d0<4;++d0)stg[orow*128+d0*32+r32e]=__float2bfloat16(o[d0][r]*rli[r]);}
    asm volatile("s_waitcnt lgkmcnt(0)":::"memory");
    #pragma unroll
    for(int i=0;i<8;++i){const int row=i*4+(le>>4),ch=le&15; const u32x4 v=*(const u32x4*)(stg+row*128+ch*8); *(u32x4*)(Ow+(long)row*OS+ch*8)=v;} }
  asm volatile("s_waitcnt lgkmcnt(0)\n\ts_barrier":::"memory");
  #undef DMA_K
  #undef DMA_V
  #undef CMASK
  #undef RESC
  #undef ROT
  #undef SETTG
  #undef SETREF
  #undef KX0
  #undef QX
}
#undef SBAR
#undef WAIT_BAR
}

constexpr float LOG2E = 1.4426950408889634f;
__device__ __forceinline__ int vcu_of(int bx, int G) { return (G % 8 == 0) ? (bx % 8) * (G / 8) + bx / 8 : bx; }
constexpr int ATT1_LDS_TAB = 141312;
__device__ __forceinline__ void attn1_tuned_phase(const Ctx& c, const bf16* qkv, const float* qkg  , bf16* R, unsigned* qctr, const ExpertSrc& es, unsigned char* ws,
                                                  const float* lamp, const float* subln, bf16* Oout) {
    LAS int* order = (LAS int*)(c.lds + ATT1_LDS_TAB);
    LAS int* nts = order + 256;
    LAS int* t0s = nts + 256;
    volatile LAS unsigned* nextu = (volatile LAS unsigned*)(t0s + 256);
    LAS float* bnd = (LAS float*)(t0s + 256 + 4);
    const int G = gridDim.x;
    if (c.wave == 0) { float gq = fabsf(qkg[c.lane]), gk = fabsf(qkg[64 + c.lane]);
#pragma unroll
        for (int o = 1; o < 64; o <<= 1) { gq = fmaxf(gq, __shfl_xor(gq, o)); gk = fmaxf(gk, __shfl_xor(gk, o)); }
        if (c.lane == 0) bnd[0] = 8.f * gq * gk * 1.02f; }
    __syncthreads();
    if (c.tid < 256) { const int h = c.tid >> 4, qb = c.tid & 15; const float slope = exp2f(-0.5f * (float)(h + 1));
        const int dmax = (int)fminf(ceilf((2.f * bnd[0] + 25.f) / slope), 1.0e6f), lo_ = 256 * qb - dmax, t0 = lo_ <= 0 ? 0 : ((lo_ >> 6) & ~1);
        nts[c.tid] = 4 * (qb + 1) - t0; t0s[c.tid] = t0; }
    __syncthreads();
    if (c.tid < 256) { const int mine = nts[c.tid]; int rank = 0;
        for (int e = 0; e < 256; ++e) { const int o = nts[e]; rank += (o > mine || (o == mine && e < c.tid)) ? 1 : 0; }
        order[rank] = c.tid; }
    __syncthreads();
#if FUSE_FINISH
    constexpr int NCH = DEFER_CONV ? EXP_ITEMS / 65 : 0, NUNIT = NB * 16 * 16, NPOS = NUNIT + NCH;
    static_assert(!DEFER_CONV || EXP_ITEMS % 65 == 0, "chunking");
    if (c.tid == 0) { float s01 = 0.f, s23 = 0.f; for (int i = 0; i < 64; ++i) { s01 += lamp[i] * lamp[64 + i]; s23 += lamp[128 + i] * lamp[192 + i]; }
      const float li = 0.8f - 0.6f * expf(-0.3f * 1.0f); bnd[1] = expf(s01) - expf(s23) + li; bnd[2] = li; }
    __syncthreads();
    unsigned p = blockIdx.x;
    while (p < (unsigned)NPOS) {
        unsigned nreg = 0u;
        if (c.tid == 0) nreg = __hip_atomic_fetch_add(qctr, 1u, __ATOMIC_RELAXED, __HIP_MEMORY_SCOPE_AGENT) + (unsigned)G;
        const bool inter = p < (unsigned)(NCH * 2);
        if (inter && (p & 1u)) {
            expert_items_block(c, es, 1, ws, (int)(p >> 1) * 65, 65);
        } else {
#define ATT1_DECODE() const unsigned u = inter ? (p >> 1) : p - (unsigned)NCH; const int ent = order[u >> 2], h = ent >> 4, qb = ent & 15, b = (int)(u & 3u), t0 = t0s[ent]; \
            bf16* Rblk = R + ((size_t)(b * T + qb * 256) * 16 + h) * 256
#if USE_V128
#pragma unroll 1
            for (int pass = 0; pass < 2; ++pass) {
                ATT1_DECODE();
                const int i = pass; att::UnitDesc ud;
                ud.Q = qkv + ((size_t)(2 * h + i) * M + (size_t)(b * T + qb * 256)) * 64; ud.qs = 64;
                ud.K = qkv + ((size_t)(32 + 2 * h + i) * M + (size_t)(b * T + 64 * t0)) * 64; ud.ks = 64;
                ud.V = qkv + ((size_t)(64 + 2 * h) * M + (size_t)(b * T + 64 * t0)) * 64; ud.vs = 64;
                ud.O = Rblk + 128 * i; ud.os = 16 * 256;
                ud.lse = nullptr; ud.lses = 0; ud.NT = 4 * (qb + 1) - t0; ud.rel0 = qb * 256 - 64 * t0; ud.tg0 = t0; ud.q0 = qb * 256;
                ud.slope2 = exp2f(-0.5f * (float)(h + 1)) * LOG2E; ud.sink2 = 0.f;
                att128::attn_unit<0, 8, 1, 16 * 256>(ud, (char*)c.lds);
            }
#else
#pragma unroll 1
            for (int pass = 0; pass < 4; ++pass) {
                ATT1_DECODE();
                const int i = pass >> 1, j = pass & 1; att::UnitDesc ud;
#if QKV_HEADMAJOR
                ud.Q = qkv + ((size_t)(2 * h + i) * M + (size_t)(b * T + qb * 256)) * 64; ud.qs = 64;
                ud.K = qkv + ((size_t)(32 + 2 * h + i) * M + (size_t)(b * T + 64 * t0)) * 64; ud.ks = 64;
                ud.V = qkv + ((size_t)(64 + 2 * h + j) * M + (size_t)(b * T + 64 * t0)) * 64; ud.vs = 64;
#else
                ud.Q = qkv + (size_t)(b * T + qb * 256) * C_IN + 128 * h + 64 * i; ud.qs = C_IN;
                ud.K = qkv + (size_t)(b * T + 64 * t0) * C_IN + 2048 + 128 * h + 64 * i; ud.ks = C_IN;
                ud.V = qkv + (size_t)(b * T + 64 * t0) * C_IN + 4096 + 128 * h + 64 * j; ud.vs = C_IN;
#endif
                ud.O = Rblk + 128 * i + 64 * j; ud.os = 16 * 256;
                ud.lse = nullptr; ud.lses = 0; ud.NT = 4 * (qb + 1) - t0; ud.rel0 = qb * 256 - 64 * t0; ud.tg0 = t0; ud.q0 = qb * 256;
                ud.slope2 = exp2f(-0.5f * (float)(h + 1)) * LOG2E; ud.sink2 = 0.f;
                att::attn_unit<0, 8, 1, 16 * 256>(ud, (char*)c.lds);
            }
#endif
            asm volatile("s_waitcnt vmcnt(0)" ::: "memory"); __syncthreads();
            { ATT1_DECODE(); (void)t0; const float lam = bnd[1], lam_init = bnd[2];
              int ft_ = threadIdx.x; asm volatile("" : "+v"(ft_));
              const int row = ft_ >> 1, hf = ft_ & 1; const bf16* p1 = Rblk + (size_t)row * (16 * 256) + 64 * hf; const bf16* p2 = p1 + 128;
              float xv[64]; float ss = 0.f;
#pragma unroll
              for (int q8 = 0; q8 < 8; ++q8) { const u32x4 a = *(const u32x4*)(p1 + 8 * q8), bq = *(const u32x4*)(p2 + 8 * q8);
#pragma unroll
                  for (int k = 0; k < 4; ++k) { const float x0 = bf2f(a[k] & 0xffffu) - lam * bf2f(bq[k] & 0xffffu), x1 = bf2f(a[k] >> 16) - lam * bf2f(bq[k] >> 16);
                      xv[8 * q8 + 2 * k] = x0; xv[8 * q8 + 2 * k + 1] = x1; ss += x0 * x0 + x1 * x1; } }
              ss += __shfl_xor(ss, 1);
              const float rs = (1.f - lam_init) / sqrtf(ss * (1.f / 128.f) + RMS_EPS);
              bf16* op = Oout + (size_t)(b * T + qb * 256 + row) * D + 128 * h + 64 * hf; const float* sg = subln + 64 * hf;
#pragma unroll
              for (int q8 = 0; q8 < 8; ++q8) { u32x4 w;
#pragma unroll
                  for (int k = 0; k < 4; ++k) w[k] = pk2(xv[8 * q8 + 2 * k] * rs * sg[8 * q8 + 2 * k], xv[8 * q8 + 2 * k + 1] * rs * sg[8 * q8 + 2 * k + 1]);
                  *(u32x4*)(op + 8 * q8) = w; } }
#undef ATT1_DECODE
        }
        if (c.tid == 0) nextu[0] = nreg;
        __syncthreads();
        p = nextu[0];
    }
}
#else
    constexpr int NCH = DEFER_CONV ? EXP_ITEMS / 65 : 0, NPOS = NB * 16 * 4 * 16 + NCH;
    static_assert(!DEFER_CONV || EXP_ITEMS % 65 == 0, "chunking");
    unsigned p = blockIdx.x;
    while (p < (unsigned)NPOS) {
        unsigned nreg = 0u;
        if (c.tid == 0) nreg = __hip_atomic_fetch_add(qctr, 1u, __ATOMIC_RELAXED, __HIP_MEMORY_SCOPE_AGENT) + (unsigned)G;
        const bool inter = p < (unsigned)(NCH * 6);
        if (inter && (p % 6u) == 5u) {
            expert_items_block(c, es, 1, ws, (int)(p / 6u) * 65, 65);
        } else {
            const unsigned u = inter ? p - p / 6u : p - (unsigned)NCH;
            const int ent = order[u >> 4], h = ent >> 4, qb = ent & 15, bp = (int)(u & 15u), b = bp >> 2, i = (bp >> 1) & 1, j = bp & 1, t0 = t0s[ent];
            att::UnitDesc ud;
#if QKV_HEADMAJOR
            ud.Q = qkv + ((size_t)(2 * h + i) * M + (size_t)(b * T + qb * 256)) * 64; ud.qs = 64;
            ud.K = qkv + ((size_t)(32 + 2 * h + i) * M + (size_t)(b * T + 64 * t0)) * 64; ud.ks = 64;
            ud.V = qkv + ((size_t)(64 + 2 * h + j) * M + (size_t)(b * T + 64 * t0)) * 64; ud.vs = 64;
#else
            ud.Q = qkv + (size_t)(b * T + qb * 256) * C_IN + 128 * h + 64 * i; ud.qs = C_IN;
            ud.K = qkv + (size_t)(b * T + 64 * t0) * C_IN + 2048 + 128 * h + 64 * i; ud.ks = C_IN;
            ud.V = qkv + (size_t)(b * T + 64 * t0) * C_IN + 4096 + 128 * h + 64 * j; ud.vs = C_IN;
#endif
            ud.O = R + ((size_t)(b * T + qb * 256) * 16 + h) * 256 + 128 * i + 64 * j; ud.os = 16 * 256;
            ud.lse = nullptr; ud.lses = 0; ud.NT = 4 * (qb + 1) - t0; ud.rel0 = qb * 256 - 64 * t0; ud.tg0 = t0; ud.q0 = qb * 256;
            ud.slope2 = exp2f(-0.5f * (float)(h + 1)) * LOG2E; ud.sink2 = 0.f;
            att::attn_unit<0, 8, 1, 16 * 256>(ud, (char*)c.lds);
        }
        if (c.tid == 0) nextu[0] = nreg;
        __syncthreads();
        p = nextu[0];
    }
}
#endif
__device__ __forceinline__ void attn1_finish_bf16_phase(const Ctx& c, const bf16* R, const float* lamp, const float* subln, bf16* O) {
    float s01 = 0.f, s23 = 0.f;
    for (int i = 0; i < 64; ++i) { s01 += lamp[i] * lamp[64 + i]; s23 += lamp[128 + i] * lamp[192 + i]; }
    const float lam_init = 0.8f - 0.6f * expf(-0.3f * 1.0f);
    const float lam = expf(s01) - expf(s23) + lam_init;
    const long total = (long)M * 16;
    for (long id = gtid_now(); id < total; id += c.gsz) {
        const bf16* p1 = R + (size_t)id * 256; const bf16* p2 = p1 + 128;
        float ss = 0.f;
#pragma unroll 4
        for (int i = 0; i < 16; ++i) { const u32x4 a = *(const u32x4*)(p1 + 8 * i), bq = *(const u32x4*)(p2 + 8 * i);
#pragma unroll
            for (int k = 0; k < 4; ++k) { const float x0 = bf2f(a[k] & 0xffffu) - lam * bf2f(bq[k] & 0xffffu), x1 = bf2f(a[k] >> 16) - lam * bf2f(bq[k] >> 16); ss += x0 * x0 + x1 * x1; } }
        const float rs = (1.f - lam_init) / sqrtf(ss * (1.f / 128.f) + RMS_EPS);
        bf16* op = O + (size_t)id * 128;
#pragma unroll 4
        for (int i = 0; i < 16; ++i) { const u32x4 a = *(const u32x4*)(p1 + 8 * i), bq = *(const u32x4*)(p2 + 8 * i); u32x4 w;
#pragma unroll
            for (int k = 0; k < 4; ++k) { const float x0 = bf2f(a[k] & 0xffffu) - lam * bf2f(bq[k] & 0xffffu), x1 = bf2f(a[k] >> 16) - lam * bf2f(bq[k] >> 16);
                w[k] = pk2(x0 * rs * subln[8 * i + 2 * k], x1 * rs * subln[8 * i + 2 * k + 1]); }
            *(u32x4*)(op + 8 * i) = w; }
    }
}
__device__ __forceinline__ void attn0_tuned_phase(const Ctx& c, const bf16* qkv, const float* sinks, bf16* OBR  , float* LSE  , bf16* O, int xlo, int xhi) {
    const int G = gridDim.x, vcu = vcu_of(blockIdx.x, G);
    for (int gid = vcu; gid < NB * 64; gid += G) {
        const int b = gid / 64, kind = (gid % 64) / 16, h = gid % 16;
        const float slope2 = exp2f(-0.5f * (float)(h + 1)) * LOG2E;
        if (kind < 3) {
            const int dil = kind == 0 ? 1 : (kind == 1 ? 4 : 16), nblk = 16 / dil;
            for (int x = xlo; x < xhi; ++x) {
                const int r = x / nblk, blk = x % nblk, q0 = blk * 256, t0 = blk ? 4 * blk - 2 : 0; att::UnitDesc u;
                const size_t qrow = (size_t)(b * T + r + dil * q0), krow = (size_t)(b * T + r + dil * 64 * t0);
#if QKV_HEADMAJOR
                u.Q = qkv + ((size_t)(h) * M + qrow) * 64; u.qs = (long)dil * 64;
                u.K = qkv + ((size_t)(16 + h) * M + krow) * 64; u.ks = (long)dil * 64;
                u.V = qkv + ((size_t)(32 + h) * M + krow) * 64; u.vs = (long)dil * 64;
#else
                u.Q = qkv + qrow * AB_IN + 64 * h; u.qs = (long)dil * AB_IN;
                u.K = qkv + krow * AB_IN + 1024 + 64 * h; u.ks = (long)dil * AB_IN;
                u.V = qkv + krow * AB_IN + 2048 + 64 * h; u.vs = (long)dil * AB_IN;
#endif
                u.O = OBR + ((size_t)kind * M + qrow) * 1024 + 64 * h; u.os = (long)dil * 1024;
                u.lse = LSE + ((size_t)kind * M + qrow) * 16 + h; u.lses = (long)dil * 16;
                u.NT = blk ? 6 : 4; u.rel0 = q0 - 64 * t0; u.tg0 = t0; u.q0 = q0; u.slope2 = slope2 * (float)dil; u.sink2 = 0.f;
                if (dil == 1) att::attn_unit<1, 8, 1, 1024>(u, (char*)c.lds); else if (dil == 4) att::attn_unit<1, 8, 4, 4096>(u, (char*)c.lds); else att::attn_unit<1, 8, 16, 16384>(u, (char*)c.lds);
            }
        } else {
            const int kvh = h >> 3;
            for (int x = xlo; x < xhi; ++x) {
                const int q0 = x * 256, t0 = x ? 4 * x - 2 : 0; att::UnitDesc u;
                const size_t qrow = (size_t)(b * T + q0), krow = (size_t)(b * T + 64 * t0);
#if QKV_HEADMAJOR
                u.Q = qkv + ((size_t)(48 + h) * M + qrow) * 64; u.qs = 64;
                u.K = qkv + ((size_t)(64 + kvh) * M + krow) * 64; u.ks = 64;
                u.V = qkv + ((size_t)(66 + kvh) * M + krow) * 64; u.vs = 64;
#else
                u.Q = qkv + qrow * AB_IN + 3072 + 64 * h; u.qs = AB_IN;
                u.K = qkv + krow * AB_IN + 4096 + 64 * kvh; u.ks = AB_IN;
                u.V = qkv + krow * AB_IN + 4224 + 64 * kvh; u.vs = AB_IN;
#endif
                u.O = O + qrow * D + 1024 + 64 * h; u.os = D;
                u.lse = nullptr; u.lses = 0;
                u.NT = x ? 6 : 4; u.rel0 = q0 - 64 * t0; u.tg0 = t0; u.q0 = q0; u.slope2 = slope2; u.sink2 = sinks[h] * LOG2E;
                att::attn_unit<2, 8, 1, D>(u, (char*)c.lds);
            }
        }
    }
}
__device__ __forceinline__ void attn0_merge_phase(const Ctx& c, const bf16* OBR, const float* LSE, bf16* O) {
    const long total = (long)M * 16;
    for (long id = gtid_now(); id < total; id += c.gsz) {
        const long m = id / 16; const int h = (int)(id % 16);
        const float l0 = LSE[id], l1 = LSE[(size_t)M * 16 + id], l2 = LSE[(size_t)2 * M * 16 + id];
        const float mx = fmaxf(l0, fmaxf(l1, l2)); float w0 = exp2f(l0 - mx), w1 = exp2f(l1 - mx), w2 = exp2f(l2 - mx); const float inv = 1.f / (w0 + w1 + w2); w0 *= inv; w1 *= inv; w2 *= inv;
        const bf16* p0 = OBR + (size_t)m * 1024 + 64 * h; const bf16* p1 = p0 + (size_t)M * 1024; const bf16* p2 = p1 + (size_t)M * 1024;
        bf16* op = O + (size_t)m * D + 64 * h;
#pragma unroll
        for (int i = 0; i < 8; ++i) { const u32x4 a = *(const u32x4*)(p0 + 8 * i), bq = *(const u32x4*)(p1 + 8 * i), cq = *(const u32x4*)(p2 + 8 * i); u32x4 w;
#pragma unroll
            for (int k = 0; k < 4; ++k) w[k] = pk2(w0 * bf2f(a[k] & 0xffffu) + w1 * bf2f(bq[k] & 0xffffu) + w2 * bf2f(cq[k] & 0xffffu), w0 * bf2f(a[k] >> 16) + w1 * bf2f(bq[k] >> 16) + w2 * bf2f(cq[k] >> 16));
            *(u32x4*)(op + 8 * i) = w; }
    }
}

__device__ __forceinline__ void convert_router(const Ctx& c, const float* wr, bf16* wrt) {
    for (int id2 = gtid_now(); id2 < 2 * NE * D; id2 += c.gsz) { const int l = id2 / (NE * D), id = id2 % (NE * D), k = id / NE, n = id % NE; const float w = wr[id2];
        const unsigned hb = f2bf(w); const float hf = bf2f(hb);
        const int off = l * 2 * NE * D + (((((k >> 8) * 8 + ((k >> 5) & 7)) * 4 + (n >> 4)) * 2) * 64 + ((n & 15) + 16 * ((k >> 3) & 3))) * 8 + (k & 7);
        wrt[off] = (bf16)hb; wrt[off + 512] = (bf16)f2bf(w - hf); }
}
#define DPPF(old, v, ctrl, rm) __int_as_float(__builtin_amdgcn_update_dpp(__float_as_int(old), __float_as_int(v), ctrl, rm, 0xf, false))
__device__ __forceinline__ float dpp_max8(float v) {
    v = fmaxf(v, DPPF(v, v, 0xB1, 0xf)); v = fmaxf(v, DPPF(v, v, 0x4E, 0xf)); v = fmaxf(v, DPPF(v, v, 0x141, 0xf)); return v; }
__device__ __forceinline__ float wave_max_u(float v) {
    v = dpp_max8(v); v = fmaxf(v, DPPF(v, v, 0x140, 0xf)); v = fmaxf(v, DPPF(v, v, 0x142, 0xa)); v = fmaxf(v, DPPF(v, v, 0x143, 0xc));
    return __int_as_float(__builtin_amdgcn_readlane(__float_as_int(v), 63)); }
__device__ __forceinline__ float wave_sum_u(float v) {
    v += DPPF(0.f, v, 0xB1, 0xf); v += DPPF(0.f, v, 0x4E, 0xf); v += DPPF(0.f, v, 0x141, 0xf); v += DPPF(0.f, v, 0x140, 0xf); v += DPPF(0.f, v, 0x142, 0xa); v += DPPF(0.f, v, 0x143, 0xc);
    return __int_as_float(__builtin_amdgcn_readlane(__float_as_int(v), 63)); }
constexpr int RT_ROUTER = 2;
__device__ __forceinline__ void router2_phase(const Ctx& c, const float* x1, const float* g, const float* ada_l, const bf16* wrt, const float* rbias,
                                              bf16* HF, int* idx, float* gate, int* wcnt, bf16* HFB = nullptr) {
    constexpr int RT = RT_ROUTER, RU = 16 * RT, NU = M / RU;
    LAS float* red = (LAS float*)c.lds;
    LAS float* part = (LAS float*)(c.lds + 1024);
    LAS float* GA = (LAS float*)(c.lds + 1024 + RT * 32768);
    LAS float* GB = GA + D;
    const int w = __builtin_amdgcn_readfirstlane((int)threadIdx.x >> 6);
    const float rb = rbias[threadIdx.x & 63];
    unsigned cnt = 0u;
    const int per = (NU + (int)gridDim.x - 1) / (int)gridDim.x, u0 = blockIdx.x * per, u1 = (u0 + per < NU) ? u0 + per : NU;
    int bcur = -1;
#pragma unroll 1
    for (int u = u0; u < u1; ++u) {
        int tid = threadIdx.x; asm volatile("" : "+v"(tid));
        const int lane = tid & 63, r = lane & 15, q = lane >> 4, cb = 256 * w + 8 * q;
        const bf16* wf = wrt + (size_t)w * (8 * 4 * 2 * 512) + lane * 8;
        const int m0 = u * RU, b = m0 / T;
        if (b != bcur) { bcur = b; __syncthreads();
            for (int col = 4 * tid; col < D; col += 2048) { const f32x4 gg = *(const f32x4*)(g + col), sc = *(const f32x4*)(ada_l + (size_t)b * 6 * D + 4 * D + col), sh = *(const f32x4*)(ada_l + (size_t)b * 6 * D + 3 * D + col);
                *(LAS f32x4*)(GA + col) = gg * (sc + 1.f); *(LAS f32x4*)(GB + col) = sh; } }
        u32x4 xv[RT][8]; float rstd[RT];
#pragma unroll
        for (int t = 0; t < RT; ++t) { const bf16* xr = (const bf16*)x1 + (size_t)(m0 + 16 * t + r) * D + cb;
#pragma unroll
            for (int kk = 0; kk < 8; ++kk) xv[t][kk] = *(const u32x4*)(xr + 32 * kk); }
#pragma unroll
        for (int t = 0; t < RT; ++t) { float ss = 0.f;
#pragma unroll
            for (int kk = 0; kk < 8; ++kk)
#pragma unroll
                for (int j = 0; j < 4; ++j) { const float a0 = bf2f(xv[t][kk][j] & 0xffffu), a1 = bf2f(xv[t][kk][j] >> 16); ss += a0 * a0 + a1 * a1; }
            ss += __shfl_xor(ss, 16); ss += __shfl_xor(ss, 32);
            if (q == 0) red[(t * 8 + w) * 16 + r] = ss; }
        __syncthreads();
        f32x4 acc[RT][4];
#pragma unroll
        for (int t = 0; t < RT; ++t) { float tot = 0.f;
#pragma unroll
            for (int w2 = 0; w2 < 8; ++w2) tot += red[(t * 8 + w2) * 16 + r];
            rstd[t] = 1.f / sqrtf(tot * (1.f / D) + RMS_EPS);
#pragma unroll
            for (int nt = 0; nt < 4; ++nt) acc[t][nt] = (f32x4){0.f, 0.f, 0.f, 0.f}; }
#pragma unroll
        for (int kk = 0; kk < 8; ++kk) {
            const f32x4 ga0 = *(LAS f32x4*)(GA + cb + 32 * kk), ga1 = *(LAS f32x4*)(GA + cb + 32 * kk + 4), gb0 = *(LAS f32x4*)(GB + cb + 32 * kk), gb1 = *(LAS f32x4*)(GB + cb + 32 * kk + 4);
            bf16x8 ah[RT], al[RT];
#pragma unroll
            for (int t = 0; t < RT; ++t) { const u32x4 xw = xv[t][kk]; f32x4 hh[2];
                hh[0] = (f32x4){bf2f(xw.x & 0xffffu), bf2f(xw.x >> 16), bf2f(xw.y & 0xffffu), bf2f(xw.y >> 16)} * rstd[t] * ga0 + gb0;
                hh[1] = (f32x4){bf2f(xw.z & 0xffffu), bf2f(xw.z >> 16), bf2f(xw.w & 0xffffu), bf2f(xw.w >> 16)} * rstd[t] * ga1 + gb1;
                u32x4 hw, lw;
#pragma unroll
                for (int s2 = 0; s2 < 2; ++s2) { const unsigned h0 = f2bf(hh[s2].x), h1 = f2bf(hh[s2].y), h2 = f2bf(hh[s2].z), h3 = f2bf(hh[s2].w);
                    hw[2 * s2] = h0 | (h1 << 16); hw[2 * s2 + 1] = h2 | (h3 << 16);
                    lw[2 * s2] = pk2(hh[s2].x - bf2f(h0), hh[s2].y - bf2f(h1)); lw[2 * s2 + 1] = pk2(hh[s2].z - bf2f(h2), hh[s2].w - bf2f(h3)); }
#if USE_FP8_MOE
                { u32x2 q8; q8.x = pk4_fp8(hh[0].x * F8_HSCALE, hh[0].y * F8_HSCALE, hh[0].z * F8_HSCALE, hh[0].w * F8_HSCALE); q8.y = pk4_fp8(hh[1].x * F8_HSCALE, hh[1].y * F8_HSCALE, hh[1].z * F8_HSCALE, hh[1].w * F8_HSCALE);
                  *(u32x2*)((unsigned char*)HF + (size_t)(m0 + 16 * t + r) * D + cb + 32 * kk) = q8; }
#if SHARED_BF16
                *(u32x4*)(HFB + (size_t)(m0 + 16 * t + r) * D + cb + 32 * kk) = hw;
#endif
#else
                *(u32x4*)(HF + (size_t)(m0 + 16 * t + r) * D + cb + 32 * kk) = hw;
#endif
                ah[t] = __builtin_bit_cast(bf16x8, hw); al[t] = __builtin_bit_cast(bf16x8, lw); }
#pragma unroll
            for (int nt = 0; nt < 4; ++nt) { const bf16x8 bh = *(const bf16x8*)(wf + ((kk * 4 + nt) * 2) * 512), bl = *(const bf16x8*)(wf + ((kk * 4 + nt) * 2 + 1) * 512);
#pragma unroll
                for (int t = 0; t < RT; ++t) {
                    acc[t][nt] = __builtin_amdgcn_mfma_f32_16x16x32_bf16(ah[t], bh, acc[t][nt], 0, 0, 0);
                    acc[t][nt] = __builtin_amdgcn_mfma_f32_16x16x32_bf16(ah[t], bl, acc[t][nt], 0, 0, 0);
                    acc[t][nt] = __builtin_amdgcn_mfma_f32_16x16x32_bf16(al[t], bh, acc[t][nt], 0, 0, 0); } }
            if (kk & 1) asm volatile("" ::: "memory");
        }
#pragma unroll
        for (int t = 0; t < RT; ++t)
#pragma unroll
            for (int nt = 0; nt < 4; ++nt)
#pragma unroll
                for (int j = 0; j < 4; ++j) part[((t * 8 + w) * 16 + 4 * q + j) * 64 + 16 * nt + r] = acc[t][nt][j];
        __syncthreads();
#pragma unroll 1
        for (int rp = 0; rp < RT; ++rp) {
            float score[2], cur[2]; int rank[2];
#pragma unroll
            for (int x = 0; x < 2; ++x) { const int row = 2 * RT * w + 2 * rp + x; float logit = 0.f;
#pragma unroll
                for (int w2 = 0; w2 < 8; ++w2) logit += part[(((row >> 4) * 8 + w2) * 16 + (row & 15)) * 64 + lane];
                score[x] = 1.f / (1.f + expf(-logit));
                const float sel = score[x] + rb;
                const float m1 = dpp_max8(sel);
                const unsigned long long eqm = __ballot(sel == m1);
                const unsigned grp_eq = (unsigned)((eqm >> (lane & ~7)) & 0xffull);
                const int first = __builtin_ctz(grp_eq);
                const float m2 = dpp_max8(((lane & 7) == first) ? -3e38f : sel);
                const float gs = m1 + m2;
                int grank = 0; const int mygrp = lane >> 3;
#pragma unroll
                for (int g2 = 0; g2 < 8; ++g2) { const float o = __int_as_float(__builtin_amdgcn_readlane(__float_as_int(gs), g2 * 8)); grank += (o > gs || (o == gs && g2 < mygrp)) ? 1 : 0; }
                cur[x] = (grank < 4) ? sel : -1e30f; rank[x] = 64; }
#pragma unroll
            for (int it = 0; it < TOPK; ++it)
#pragma unroll
                for (int x = 0; x < 2; ++x) { const float mx = wave_max_u(cur[x]); const int f = (int)__builtin_ctzll(__ballot(cur[x] == mx));
                    if (lane == f) { rank[x] = it; cur[x] = -3e38f; } }
#pragma unroll
            for (int x = 0; x < 2; ++x) { const int m = m0 + 2 * RT * w + 2 * rp + x; const bool chosen = rank[x] < TOPK;
                const float gsum = wave_sum_u(chosen ? score[x] : 0.f);
                if (chosen) { idx[(size_t)m * 8 + rank[x]] = lane | (int)(cnt << 8); gate[(size_t)m * 8 + rank[x]] = score[x] / gsum * 2.5f; cnt += 1u; } }
        }
        __syncthreads();
    }
    wcnt[(size_t)(blockIdx.x * 8 + w) * 64 + (threadIdx.x & 63)] = (int)cnt;
}
__device__ __forceinline__ void slot2_phase(const Ctx& c, const int* idx, const int* wcnt, unsigned* nrt_out, int* pos, int* slot_tok, int* tile_exp) {
    LAS int* ST = (LAS int*)c.lds;
    LAS int* SB = ST + 512;
    LAS int* SO = SB + 512;
    LAS int* tot = SO + 512;
    LAS int* bef = tot + 64;
    LAS int* ps = bef + 64;
    LAS int* base = ps + 128;
    const int e = c.tid & 63, p = c.tid >> 6, G = gridDim.x, blk = blockIdx.x;
    { int Tp = 0, Bp = 0;
#pragma unroll 8
      for (int b2 = 0; b2 < G; ++b2) { const int v = wcnt[(size_t)(b2 * 8 + p) * 64 + e]; Tp += v; Bp += (b2 < blk) ? v : 0; }
      ST[p * 64 + e] = Tp; SB[p * 64 + e] = Bp; SO[p * 64 + e] = wcnt[(size_t)(blk * 8 + p) * 64 + e]; }
    __syncthreads();
    if (c.tid < 64) { int t = 0, bb = 0;
#pragma unroll
        for (int p2 = 0; p2 < 8; ++p2) { t += ST[p2 * 64 + e]; bb += SB[p2 * 64 + e]; }
        tot[e] = t; bef[e] = bb; }
    __syncthreads();
    if (c.tid == 0) { int acc = 0; for (int e2 = 0; e2 < NE; ++e2) { ps[e2] = acc; acc += (tot[e2] + 255) / 256 * 256; } ps[64] = acc; }
    __syncthreads();
    { int o = ps[e] + bef[e];
      for (int p2 = 0; p2 < p; ++p2) o += SO[p2 * 64 + e];
      base[p * 64 + e] = o; }
    __syncthreads();
    {
        constexpr int RU = 16 * RT_ROUTER, NU = M / RU; const int per = (NU + G - 1) / G, mlo = blk * per * RU, mhi = (mlo + per * RU < M) ? mlo + per * RU : M;
        for (int i = c.tid; i < (mhi - mlo) * 8; i += 512) {
            const int m = mlo + (i >> 3), k = i & 7, wv = (m % RU) / (2 * RT_ROUTER); const size_t a = (size_t)m * 8 + k;
            const int code = idx[a], ee = code & 255, rk = code >> 8, slot = base[wv * 64 + ee] + rk;
            slot_tok[slot] = m; pos[a] = slot; }
    }
    for (int t = gtid_now(); t < M; t += c.gsz) slot_tok[CAPR + t] = t;
    if (blk == 0) {
        if (c.tid < NE) { const int s0 = ps[e], cn = tot[e], pe = s0 + (cn + 255) / 256 * 256;
            for (int s = s0 + cn; s < pe; ++s) slot_tok[s] = 0;
            for (int tt = s0 / 256; tt < pe / 256; ++tt) tile_exp[tt] = e; }
        if (c.tid == 0) *nrt_out = (unsigned)(ps[64] / 256);
    }
    __syncthreads();
}

template <int L> __device__ __forceinline__ void moe_up_tuned(const Ctx& c, unsigned char* ws) {
    const int nrt = (int)c.ctl[CW_NRT + L];
#if USE_FP8_MOE && SHARED_BF16
    { pg8::PlainSched S; S.o.init(M / 256, UPN / 256, gridDim.x, blockIdx.x); S.Bt = (const char*)(ws + WS_WUPS) + (size_t)L * UPN * D * 2; S.K = D;
      pg8::EpiUp E{(bf16*)(ws + WS_ACTS)}; pg8::gemm_phase(c.lds, (const char*)(ws + WS_HFB), D, S, E); }
    const int ntile = nrt;
#else
    const int ntile = nrt + M / 256;
#endif
    pg8::GroupSched<true> S; S.o.init(ntile, UPN / 256, gridDim.x, blockIdx.x);
    { LAS int* te = (LAS int*)(c.lds + 132096);
      for (int i = threadIdx.x; i < nrt; i += 512) te[i] = ((const int*)(ws + WS_TILEEXP))[i];
      __syncthreads(); S.tile_exp = te; }
    S.nrt = nrt; S.slot_tok = (const int*)(ws + WS_SLOTTOK);
#if USE_FP8_MOE
    S.W = (const char*)(ws + WS_WUP) + (size_t)L * NEX * UPN * D; S.wstride = (size_t)UPN * D; S.K = D / 2;
    pg8::EpiUp8 E{ws + WS_ACT}; pg8::gemm_phase<pg8::EpiUp8, pg8::GroupSched<true>, true>(c.lds, (const char*)(ws + WS_HF), D / 2, S, E);
#else
    S.W = (const char*)(ws + WS_WUP) + (size_t)L * NEX * UPN * D * 2; S.wstride = (size_t)UPN * D * 2; S.K = D;
    pg8::EpiUp E{(bf16*)(ws + WS_ACT)}; pg8::gemm_phase(c.lds, (const char*)(ws + WS_HF), D, S, E);
#endif
}
template <int L> __device__ __forceinline__ void moe_down_tuned(const Ctx& c, unsigned char* ws) {
    const int nrt = (int)c.ctl[CW_NRT + L];
#if USE_FP8_MOE && SHARED_BF16
    { pg8::PlainSched S; S.o.init(M / 256, D / 256, gridDim.x, blockIdx.x); S.Bt = (const char*)(ws + WS_WDNS) + (size_t)L * D * ED * 2; S.K = ED;
      pg8::EpiDown E{(bf16*)(ws + WS_Y), CAPR}; pg8::gemm_phase(c.lds, (const char*)(ws + WS_ACTS), ED, S, E); }
    const int ntile = nrt;
#else
    const int ntile = nrt + M / 256;
#endif
    pg8::GroupSched<false> S; S.o.init(ntile, D / 256, gridDim.x, blockIdx.x);
    { LAS int* te = (LAS int*)(c.lds + 132096);
      for (int i = threadIdx.x; i < nrt; i += 512) te[i] = ((const int*)(ws + WS_TILEEXP))[i];
      __syncthreads(); S.tile_exp = te; }
    S.nrt = nrt; S.slot_tok = (const int*)(ws + WS_SLOTTOK);
#if USE_FP8_MOE
    S.W = (const char*)(ws + WS_WDN) + (size_t)L * NEX * D * ED; S.wstride = (size_t)D * ED; S.K = ED / 2;
    pg8::EpiDown8 E{(bf16*)(ws + WS_Y)}; pg8::gemm_phase<pg8::EpiDown8, pg8::GroupSched<false>, true>(c.lds, (const char*)(ws + WS_ACT), ED / 2, S, E);
#else
    S.W = (const char*)(ws + WS_WDN) + (size_t)L * NEX * D * ED * 2; S.wstride = (size_t)D * ED * 2; S.K = ED;
    pg8::EpiDown E{(bf16*)(ws + WS_Y)}; pg8::gemm_phase(c.lds, (const char*)(ws + WS_ACT), ED, S, E);
#endif
}
template <int L> __device__ __forceinline__ void qkv_tuned(const Ctx& c, unsigned char* ws, const float* gains) {
    constexpr int NCOL = L == 0 ? AB_IN : C_IN; constexpr bool TUNED_ATT = L == 0 ? (USE_ATT0 != 0) : (USE_ATT1 != 0);
    pg8::PlainSched S; S.o.init(M / 256, NCOL / 256, gridDim.x, blockIdx.x); S.Bt = (const char*)(ws + (L == 0 ? WS_W0IN : WS_W1IN));
#if USE_FP8_QKV
    S.K = D / 2; pg8::EpiQKV<L> E{(bf16*)(ws + WS_QKV), NCOL, gains, TUNED_ATT ? att::C2 : 1.f, 1.f / (F8_HSCALE * F8_WSCALE)};
    pg8::gemm_phase<pg8::EpiQKV<L>, pg8::PlainSched, true>(c.lds, (const char*)(ws + WS_XN), D / 2, S, E);
#else
    S.K = D; pg8::EpiQKV<L> E{(bf16*)(ws + WS_QKV), NCOL, gains, TUNED_ATT ? att::C2 : 1.f, 1.f};
    pg8::gemm_phase(c.lds, (const char*)(ws + WS_XN), D, S, E);
#endif
}

template <int L> __device__ __forceinline__ void outproj_epi(const Ctx& c, unsigned char* ws, const pg8::PlainSched& S, const float* xin_f32, const float* gm) {
#if RES_BF16
    if (L == 0) { pg8::EpiOutB<false> E{xin_f32, gm, (bf16*)(ws + WS_X1)}; pg8::gemm_phase(c.lds, (const char*)(ws + WS_O), D, S, E); }
    else { pg8::EpiOutB<true> E{ws + WS_X1 + (size_t)M * D * 2, gm, (bf16*)(ws + WS_X1)}; pg8::gemm_phase(c.lds, (const char*)(ws + WS_O), D, S, E); }
#else
    pg8::EpiOut E{xin_f32, gm, (float*)(ws + WS_X1)}; pg8::gemm_phase(c.lds, (const char*)(ws + WS_O), D, S, E);
#endif
}
__global__ void __launch_bounds__(512, 2) mega(Args args) {
    extern __shared__ __attribute__((aligned(16))) unsigned char lds_raw[];
    Ctx c;
    c.lds = (LAS unsigned char*)lds_raw;
    c.tid = threadIdx.x; c.lane = c.tid & 63; c.wave = __builtin_amdgcn_readfirstlane(c.tid >> 6);
    c.gw = blockIdx.x * 8 + c.wave; c.ngw = gridDim.x * 8; c.gsz = gridDim.x * 512;
    c.ws = args.ws; c.ctl = (unsigned*)(args.ws + WS_CTL);
    volatile LAS unsigned* xbw = (volatile LAS unsigned*)(c.lds + LDS_BYTES - 16);
    if (c.tid < 4) xbw[c.tid] = 0u;
    __syncthreads();
    const int lo = args.ph_lo, hi = args.ph_hi;
    XcdBarrier bar; bar.bar = c.ctl + CW_BAR; bar.x = 0; bar.st = xbw;
    if (hi - lo > 1) bar = xcd_barrier_post(c.ctl + CW_BAR, xbw);
#ifdef PHASE_ONLY
#define IN(k) ((k) == PHASE_ONLY && lo <= (k) && (k) < hi)
#else
#define IN(k) (lo <= (k) && (k) < hi)
#endif
#define PHASE(k, ...) do { if (IN(k)) { __VA_ARGS__ } if (IN(k) && ((REPMASK >> (k)) & 1u)) { __syncthreads(); __VA_ARGS__ } } while (0);
#if PROBE_SEL >= 0
    volatile LAS unsigned long long* stamp_ = (volatile LAS unsigned long long*)(c.lds + 146000);
    if (c.tid == 0) stamp_[0] = __builtin_amdgcn_s_memrealtime();
#define SEAM(k) do { if (c.tid == 0) stamp_[1 + 2 * (k)] = __builtin_amdgcn_s_memrealtime(); if (IN(k) && IN((k) + 1)) xcd_barrier(bar); else __syncthreads(); \
        if (c.tid == 0) stamp_[2 + 2 * (k)] = __builtin_amdgcn_s_memrealtime(); } while (0)
#else
#define SEAM(k) do { if (IN(k) && IN((k) + 1)) xcd_barrier(bar); else __syncthreads(); } while (0)
#endif
    unsigned char* ws = args.ws;
#define XIN (args.in[0])
#define cin (args.in[1])
#define norm_mix (args.in[2])
#define norm_ffn (args.in[3])
#define w_ada (args.in[4])
#define b_ada (args.in[5])
#define ada ((float*)(ws + WS_ADA))
#define W0IN ((bf16*)(ws + WS_W0IN))
#define W0OUT ((bf16*)(ws + WS_W0OUT))
#define W1IN ((bf16*)(ws + WS_W1IN))
#define W1OUT ((bf16*)(ws + WS_W1OUT))
#define WUP ((bf16*)(ws + WS_WUP))
#define WDN ((bf16*)(ws + WS_WDN))
#define XN ((bf16*)(ws + WS_XN))
#define QKV ((bf16*)(ws + WS_QKV))
#define OBUF ((bf16*)(ws + WS_O))
#define X1 ((float*)(ws + WS_X1))
#define HF ((bf16*)(ws + WS_HF))
#define IDX ((int*)(ws + WS_IDX))
#define GATE ((float*)(ws + WS_GATE))
#define POS ((int*)(ws + WS_POS))
#define SLOTTOK ((int*)(ws + WS_SLOTTOK))
#define TILEEXP ((int*)(ws + WS_TILEEXP))
#define ACT ((bf16*)(ws + WS_ACT))
#define Y ((bf16*)(ws + WS_Y))
#define TMP ((float*)(ws + WS_TMP))
#define OUTP (args.out)

    PHASE(0, {
        constexpr int QM = USE_PG8_QKV ? 1 : 0, UM = USE_PG8_MOE ? 2 : 0;
#if USE_CONV128 && USE_FP8_MOE
        convert_dense_all<QM, USE_FP8_QKV != 0>(c, args.in[6], args.in[10], args.in[9], args.in[14], (unsigned char*)W0IN, (unsigned char*)W1IN, (unsigned char*)W0OUT, (unsigned char*)W1OUT, USE_FP8_QKV ? F8_WSCALE : 1.f);
#if !(DEFER_CONV && USE_ATT0 && USE_ATT1 && !SHARED_BF16)
        for (int l = 0; l < 2; ++l) {
            convert_batch128<2, true>(c, args.in[17] + (size_t)l * NE * D * UPN, D, UPN, (unsigned char*)WUP + (size_t)l * NEX * UPN * D, NE, (size_t)UPN * D, F8_WSCALE);
            convert_batch128<0, true>(c, args.in[18] + (size_t)l * NE * ED * D, ED, D, (unsigned char*)WDN + (size_t)l * NEX * D * ED, NE, (size_t)D * ED, F8_WSCALE);
#if SHARED_BF16
            convert_batch128<2, false>(c, args.in[19] + (size_t)l * D * UPN, D, UPN, ws + WS_WUPS + (size_t)l * UPN * D * 2, 1, 0, 1.f);
            convert_batch128<0, false>(c, args.in[20] + (size_t)l * ED * D, ED, D, ws + WS_WDNS + (size_t)l * D * ED * 2, 1, 0, 1.f);
#else
            convert_batch128<2, true>(c, args.in[19] + (size_t)l * D * UPN, D, UPN, (unsigned char*)WUP + ((size_t)l * NEX + NE) * UPN * D, 1, 0, F8_WSCALE);
            convert_batch128<0, true>(c, args.in[20] + (size_t)l * ED * D, ED, D, (unsigned char*)WDN + ((size_t)l * NEX + NE) * D * ED, 1, 0, F8_WSCALE);
#endif
        }
#endif
#else
        convert_batch<QM>(c, args.in[6], D, AB_IN, W0IN, 1, 0);
        convert_batch<0>(c, args.in[9], D, D, W0OUT, 1, 0);
        convert_batch<QM>(c, args.in[10], D, C_IN, W1IN, 1, 0);
        convert_batch<0>(c, args.in[14], D, D, W1OUT, 1, 0);
        for (int l = 0; l < 2; ++l) {
#if USE_FP8_MOE
            convert_batch_f8<2>(c, args.in[17] + (size_t)l * NE * D * UPN, D, UPN, (unsigned char*)WUP + (size_t)l * NEX * UPN * D, NE, (size_t)UPN * D);
            convert_batch_f8<2>(c, args.in[19] + (size_t)l * D * UPN, D, UPN, (unsigned char*)WUP + ((size_t)l * NEX + NE) * UPN * D, 1, 0);
            convert_batch_f8<0>(c, args.in[18] + (size_t)l * NE * ED * D, ED, D, (unsigned char*)WDN + (size_t)l * NEX * D * ED, NE, (size_t)D * ED);
            convert_batch_f8<0>(c, args.in[20] + (size_t)l * ED * D, ED, D, (unsigned char*)WDN + ((size_t)l * NEX + NE) * D * ED, 1, 0);
#else
            convert_batch<UM>(c, args.in[17] + (size_t)l * NE * D * UPN, D, UPN, WUP + (size_t)l * NEX * UPN * D, NE, (size_t)UPN * D);
            convert_batch<UM>(c, args.in[19] + (size_t)l * D * UPN, D, UPN, WUP + ((size_t)l * NEX + NE) * UPN * D, 1, 0);
            convert_batch<0>(c, args.in[18] + (size_t)l * NE * ED * D, ED, D, WDN + (size_t)l * NEX * D * ED, NE, (size_t)D * ED);
            convert_batch<0>(c, args.in[20] + (size_t)l * ED * D, ED, D, WDN + ((size_t)l * NEX + NE) * D * ED, 1, 0);
#endif
        }
#endif
        convert_router(c, args.in[15], (bf16*)(ws + WS_WRT));
        __syncthreads();
        ada_phase(c, cin, w_ada, b_ada, ada);
    })
    SEAM(0);
    PHASE(1, norm_phase(c, XIN, norm_mix, ada, 0, D, XN);)
    SEAM(1);
#if USE_PG8_QKV
    PHASE(2, qkv_tuned<0>(c, ws, args.in[7]);)
    SEAM(2);
#else
    PHASE(2, gemm_plain_bf16(c, XN, W0IN, D, AB_IN, QKV);)
    SEAM(2);
#endif
#if USE_ATT0
    static_assert(USE_PG8_QKV, "the tuned attention needs Q pre-scaled by the QKV epilogue");
    #if DEFER_CONV
    PHASE(3, { const int xs_ = vcu_of(blockIdx.x, gridDim.x) & 15;
        attn0_tuned_phase(c, QKV, args.in[8], (bf16*)(ws + WS_TMP), (float*)(ws + WS_TMP + (size_t)3 * M * 1024 * 2), OBUF, 0, xs_ + 1);
        { const int cshare = (EXP_ITEMS + (int)gridDim.x - 1) / (int)gridDim.x, cfirst = blockIdx.x * cshare, ccount = (cfirst + cshare <= EXP_ITEMS) ? cshare : (EXP_ITEMS > cfirst ? EXP_ITEMS - cfirst : 0);
          expert_items_block(c, ExpertSrc{args.in[17], args.in[19], args.in[18], args.in[20]}, 0, ws, cfirst, ccount); __syncthreads(); }
        attn0_tuned_phase(c, QKV, args.in[8], (bf16*)(ws + WS_TMP), (float*)(ws + WS_TMP + (size_t)3 * M * 1024 * 2), OBUF, xs_ + 1, 16); })
#else
    PHASE(3, attn0_tuned_phase(c, QKV, args.in[8], (bf16*)(ws + WS_TMP), (float*)(ws + WS_TMP + (size_t)3 * M * 1024 * 2), OBUF, 0, 16);)
#endif
    SEAM(3);
    PHASE(4, attn0_merge_phase(c, (const bf16*)(ws + WS_TMP), (const float*)(ws + WS_TMP + (size_t)3 * M * 1024 * 2), OBUF);)
    SEAM(4);
#else
#if !USE_PG8_QKV
    PHASE(3, qknorm0_phase(c, QKV, args.in[7]);)
#endif
    SEAM(3);
    PHASE(4, attn0_phase(c, QKV, args.in[8], OBUF);)
    SEAM(4);
#endif
#if USE_PG8_OUT
    PHASE(5, { pg8::PlainSched S; S.o.init(M / 256, D / 256, gridDim.x, blockIdx.x); S.Bt = (const char*)W0OUT; S.K = D;
        outproj_epi<0>(c, ws, S, XIN, ada + 2 * D); })
#else
    PHASE(5, gemm_outproj(c, OBUF, W0OUT, XIN, ada + 2 * D, X1);)
#endif
    SEAM(5);
#if USE_ROUTER2
    PHASE(6, router2_phase(c, X1, norm_ffn, ada, (const bf16*)(ws + WS_WRT), args.in[16], HF, IDX, GATE, (int*)(ws + WS_WCNT), (bf16*)(ws + WS_HFB));)
    SEAM(6);
    PHASE(7, slot2_phase(c, IDX, (const int*)(ws + WS_WCNT), c.ctl + CW_NRT, POS, SLOTTOK, TILEEXP);)
#else
    PHASE(6, router_phase(c, X1, norm_ffn, ada, args.in[15], args.in[16], HF, IDX, GATE, c.ctl + CW_CNT);)
    SEAM(6);
    PHASE(7, slot_phase(c, IDX, c.ctl + CW_CNT, c.ctl + CW_CUR, c.ctl + CW_NRT, POS, SLOTTOK, TILEEXP);)
#endif
    SEAM(7);
#if USE_PG8_MOE
    PHASE(8, moe_up_tuned<0>(c, ws);)
    SEAM(8);
    PHASE(9, moe_down_tuned<0>(c, ws);)
#else
    PHASE(8, moe_up_phase(c, HF, WUP, SLOTTOK, TILEEXP, c.ctl + CW_NRT, ACT);)
    SEAM(8);
    PHASE(9, moe_down_phase(c, ACT, WDN, TILEEXP, c.ctl + CW_NRT, Y);)
#endif
    SEAM(9);
    PHASE(10, combine_phase<true>(c, X1, Y, POS, GATE, ada, RES_BF16 ? (float*)(ws + WS_X1 + (size_t)M * D * 2) : OUTP, norm_mix + D, ada + (size_t)4 * 6 * D, XN);)
    SEAM(10);
#define ada1 (ada + (size_t)4 * 6 * D)
#if USE_PG8_QKV
    PHASE(11, qkv_tuned<1>(c, ws, args.in[11]);)
    SEAM(11);
    SEAM(12);
#else
    PHASE(11, gemm_plain_bf16(c, XN, W1IN, D, C_IN, QKV);)
    SEAM(11);
    PHASE(12, qknorm1_phase(c, QKV, args.in[11]);)
    SEAM(12);
#endif
#if USE_ATT1
    PHASE(13, attn1_tuned_phase(c, QKV, args.in[11], (bf16*)TMP, c.ctl + CW_QCTR, ExpertSrc{args.in[17], args.in[19], args.in[18], args.in[20]}, ws, args.in[12], args.in[13], OBUF);)
    SEAM(13);
#if !FUSE_FINISH
    PHASE(14, attn1_finish_bf16_phase(c, (const bf16*)TMP, args.in[12], args.in[13], OBUF);)
#endif
    SEAM(14);
#else
    PHASE(13, attn1_phase(c, QKV, TMP);)
    SEAM(13);
    PHASE(14, attn1_finish_phase(c, TMP, args.in[12], args.in[13], OBUF);)
    SEAM(14);
#endif
#if USE_PG8_OUT
    PHASE(15, { pg8::PlainSched S; S.o.init(M / 256, D / 256, gridDim.x, blockIdx.x); S.Bt = (const char*)W1OUT; S.K = D;
        outproj_epi<1>(c, ws, S, OUTP, ada1 + 2 * D); })
#else
    PHASE(15, gemm_outproj(c, OBUF, W1OUT, OUTP, ada1 + 2 * D, X1);)
#endif
    SEAM(15);
#if USE_ROUTER2
    PHASE(16, router2_phase(c, X1, norm_ffn + D, ada1, (const bf16*)(ws + WS_WRT) + (size_t)2 * NE * D, args.in[16] + NE, HF, IDX, GATE, (int*)(ws + WS_WCNT), (bf16*)(ws + WS_HFB));)
    SEAM(16);
    PHASE(17, slot2_phase(c, IDX, (const int*)(ws + WS_WCNT), c.ctl + CW_NRT + 1, POS, SLOTTOK, TILEEXP);)
#else
    PHASE(16, router_phase(c, X1, norm_ffn + D, ada1, args.in[15] + (size_t)D * NE, args.in[16] + NE, HF, IDX, GATE, c.ctl + CW_CNT + 64);)
    SEAM(16);
    PHASE(17, slot_phase(c, IDX, c.ctl + CW_CNT + 64, c.ctl + CW_CUR + 64, c.ctl + CW_NRT + 1, POS, SLOTTOK, TILEEXP);)
#endif
    SEAM(17);
#if USE_PG8_MOE
    PHASE(18, moe_up_tuned<1>(c, ws);)
    SEAM(18);
    PHASE(19, moe_down_tuned<1>(c, ws);)
#else
    PHASE(18, moe_up_phase(c, HF, WUP + (size_t)NEX * UPN * D, SLOTTOK, TILEEXP, c.ctl + CW_NRT + 1, ACT);)
    SEAM(18);
    PHASE(19, moe_down_phase(c, ACT, WDN + (size_t)NEX * D * ED, TILEEXP, c.ctl + CW_NRT + 1, Y);)
#endif
    SEAM(19);
    PHASE(20, combine_phase<false>(c, X1, Y, POS, GATE, ada1, OUTP, nullptr, nullptr, nullptr);)
#if PROBE_SEL >= 0
    {
        __syncthreads();
        unsigned long long v = 0ull;
        if (c.tid == 0) {
            if (PROBE_SEL >= 100) { const int k = PROBE_SEL - 100; v = stamp_[2 + 2 * k] - (k == 0 ? stamp_[0] : stamp_[2 + 2 * (k - 1)]); }
            else if (PROBE_SEL == 1 || PROBE_SEL == 2) { for (int k = 0; k < NPHASE - 1; ++k) v += stamp_[2 + 2 * k] - stamp_[1 + 2 * k]; }
            else if (PROBE_SEL == 3) { v = stamp_[1 + 2 * 19] - stamp_[0]; }
        }
        if (PROBE_SEL == 2) {
            if (c.tid == 0) __hip_atomic_fetch_add((unsigned long long*)(c.ctl + CW_QCTR + 64), v, __ATOMIC_RELAXED, __HIP_MEMORY_SCOPE_AGENT);
            xcd_barrier(bar);
            if (c.tid == 0) v = __hip_atomic_load((unsigned long long*)(c.ctl + CW_QCTR + 64), __ATOMIC_RELAXED, __HIP_MEMORY_SCOPE_AGENT) / gridDim.x;
        }
        if (blockIdx.x == 0 && c.tid == 0) { const unsigned long long t0 = __builtin_amdgcn_s_memrealtime(), w = v * PROBE_GAIN;
            while (__builtin_amdgcn_s_memrealtime() - t0 < w) __builtin_amdgcn_s_sleep(8); }
    }
#endif
#undef IN
#undef SEAM
#undef ada
#undef ada1
#undef W0IN
#undef W0OUT
#undef W1IN
#undef W1OUT
#undef WUP
#undef WDN
#undef XN
#undef QKV
#undef OBUF
#undef X1
#undef HF
#undef IDX
#undef GATE
#undef POS
#undef SLOTTOK
#undef TILEEXP
#undef ACT
#undef Y
#undef TMP
#undef XIN
#undef cin
#undef norm_mix
#undef norm_ffn
#undef w_ada
#undef b_ada
#undef OUTP
}

extern "C" void kernel_launch(void* const* d_in, const int* in_sizes, int n_in, void* d_out, int out_size, void* d_ws, size_t ws_size, hipStream_t stream) {
    static int grid = 0;
    if (grid == 0) {
        if (n_in != 21 || out_size != M * D || ws_size < WS_END) { fprintf(stderr, "kernel_launch: unexpected sizes (n_in %d out %d ws %zu need %zu)\n", n_in, out_size, ws_size, (size_t)WS_END); grid = -1; return; }
        int dev = 0, cus = 0, per_cu = 0;
        hipGetDevice(&dev); hipDeviceGetAttribute(&cus, hipDeviceAttributeMultiprocessorCount, dev);
        if (hipFuncSetAttribute((const void*)mega, hipFuncAttributeMaxDynamicSharedMemorySize, LDS_BYTES) != hipSuccess) { fprintf(stderr, "kernel_launch: hipFuncSetAttribute failed\n"); grid = -1; return; }
        hipOccupancyMaxActiveBlocksPerMultiprocessor(&per_cu, (const void*)mega, 512, LDS_BYTES);
        (void)hipGetLastError();
        if (per_cu < 1) fprintf(stderr, "kernel_launch: occupancy query says %d blocks per CU\n", per_cu);
        grid = cus;
    }
    if (grid < 0) return;
    hipMemsetAsync((char*)d_ws + WS_CTL, 0, CTL_BYTES, stream);
    Args a{};
    for (int i = 0; i < 21; ++i) a.in[i] = (const float*)d_in[i];
    a.out = (float*)d_out; a.ws = (unsigned char*)d_ws;
#if MK_SPLIT
    for (int p = 0; p < NPHASE; ++p) { a.ph_lo = p; a.ph_hi = p + 1; hipLaunchKernelGGL(mega, dim3(grid), dim3(512), LDS_BYTES, stream, a); }
#else
    a.ph_lo = 0; a.ph_hi = NPHASE; hipLaunchKernelGGL(mega, dim3(grid), dim3(512), LDS_BYTES, stream, a);
#endif
}
```

```cpp
#include <hip/hip_runtime.h>
#include <cstdio>
#include <cstdint>
#include <hip/hip_bf16.h>

#ifndef USE_PG8_OUT
#define USE_PG8_OUT 1
#endif
#ifndef USE_PG8_QKV
#define USE_PG8_QKV 1
#endif
#ifndef USE_PG8_MOE
#define USE_PG8_MOE 1
#endif
#ifndef USE_ATT1
#define USE_ATT1 1
#endif
#ifndef USE_ATT0
#define USE_ATT0 1
#endif
#ifndef USE_ROUTER2
#define USE_ROUTER2 1
#endif
#ifndef REPMASK
#define REPMASK 0u
#endif
#ifndef USE_FP8_MOE
#define USE_FP8_MOE 1
#endif
#ifndef USE_CONV128
#define USE_CONV128 1
#endif
#ifndef USE_FP8_QKV
#define USE_FP8_QKV 1
#endif
#ifndef SHARED_BF16
#define SHARED_BF16 0
#endif
#ifndef Y_FP8
#define Y_FP8 1
#endif
#ifndef DEFER_CONV
#define DEFER_CONV 1
#endif
#ifndef RES_BF16
#define RES_BF16 1
#endif
#ifndef FUSE_FINISH
#define FUSE_FINISH 1
#endif
#ifndef PROBE_SEL
#define PROBE_SEL -1
#endif
#ifndef PROBE_GAIN
#define PROBE_GAIN 4
#endif
#ifndef QKV_HEADMAJOR
#define QKV_HEADMAJOR 1
#endif
#ifndef USE_V128
#define USE_V128 1
#endif
#ifndef MK_SPLIT
#define MK_SPLIT 0
#endif

constexpr int D = 2048, NB = 4, T = 4096, M = NB * T;
constexpr int HD = 64;
constexpr int AB_IN = 4352, C_IN = 6144;
constexpr int NE = 64, TOPK = 8, ED = 512;
constexpr int UPN = 2 * ED;
constexpr int NEX = NE + 1;
constexpr int CAPR = M * TOPK + NE * 256;
constexpr int CAP = CAPR + M;
constexpr int MAXTILES = CAP / 256;
constexpr float RMS_EPS = 1e-6f;
constexpr int NPHASE = 21;

typedef unsigned short bf16;
typedef short bf16x8 __attribute__((ext_vector_type(8)));
typedef float f32x4 __attribute__((ext_vector_type(4)));
typedef unsigned u32x4 __attribute__((ext_vector_type(4)));
typedef unsigned u32x2 __attribute__((ext_vector_type(2)));
#define LAS __attribute__((address_space(3)))

constexpr size_t MiB = 1u << 20;
constexpr size_t WS_CTL = 0, CTL_BYTES = 1 * MiB;
constexpr size_t WS_ADA = 1 * MiB;
constexpr size_t WS_W0IN = 2 * MiB;
constexpr size_t WS_W0OUT = WS_W0IN + (size_t)AB_IN * D * 2;
constexpr size_t WS_W1IN = WS_W0OUT + (size_t)D * D * 2;
constexpr size_t WS_W1OUT = WS_W1IN + (size_t)C_IN * D * 2;
constexpr size_t WS_WUP = WS_W1OUT + (size_t)D * D * 2;
constexpr size_t WS_WDN = WS_WUP + (size_t)2 * NEX * UPN * D * 2;
constexpr size_t WS_XN = WS_WDN + (size_t)2 * NEX * D * ED * 2;
constexpr size_t WS_QKV = WS_XN + (size_t)M * D * 2;
constexpr size_t WS_O = WS_QKV + (size_t)M * C_IN * 2;
constexpr size_t WS_X1 = WS_O + (size_t)M * D * 2;
constexpr size_t WS_HF = WS_X1 + (size_t)M * D * 4;
constexpr size_t WS_IDX = WS_HF + (size_t)M * D * 2;
constexpr size_t WS_GATE = WS_IDX + (size_t)M * 8 * 4;
constexpr size_t WS_POS = WS_GATE + (size_t)M * 8 * 4;
constexpr size_t WS_SLOTTOK = WS_POS + (size_t)M * 8 * 4;
constexpr size_t WS_TILEEXP = WS_SLOTTOK + (size_t)CAP * 4;
constexpr size_t WS_ACT = WS_TILEEXP + 4096;
constexpr size_t WS_Y = WS_ACT + (size_t)CAP * ED * 2;
constexpr size_t WS_TMP = WS_Y + (size_t)CAP * D * 2;
constexpr size_t WS_WRT = WS_TMP + (size_t)M * 16 * 2 * 128 * 4;
constexpr size_t WS_WCNT = WS_WRT + (size_t)2 * 2 * NE * D * 2;
constexpr size_t WS_HFB = WS_WCNT + (size_t)4096 * 64 * 4;
constexpr size_t WS_ACTS = WS_HFB + (size_t)M * D * 2;
constexpr size_t WS_WUPS = WS_ACTS + (size_t)M * ED * 2;
constexpr size_t WS_WDNS = WS_WUPS + (size_t)2 * UPN * D * 2;
constexpr size_t WS_END = WS_WDNS + (size_t)2 * D * ED * 2;
constexpr int CW_BAR = 4096;
constexpr int CW_CNT = 16384;
constexpr int CW_CUR = 16384 + 256;
constexpr int CW_NRT = 16384 + 512;
constexpr int CW_QCTR = 16384 + 1024;

constexpr int LDS_BYTES = 147456;

__device__ __forceinline__ unsigned pk4_fp8(float a, float b, float c2, float d);
constexpr float F8_WSCALE = 256.f, F8_HSCALE = 16.f, F8_ASCALE = 8.f, F8_YSCALE = 32.f;
__device__ __forceinline__ float bf2f(unsigned v) { return __uint_as_float(v << 16); }
__device__ __forceinline__ unsigned f2bf(float f) { unsigned u = __float_as_uint(f); return (u + 0x7fffu + ((u >> 16) & 1u)) >> 16; }
__device__ __forceinline__ unsigned pk2(float lo, float hi) { return f2bf(lo) | (f2bf(hi) << 16); }
__device__ __forceinline__ float wave_sum(float v) {
#pragma unroll
    for (int o = 1; o < 64; o <<= 1) v += __shfl_xor(v, o);
    return v;
}
__device__ __forceinline__ float siluf(float x) { return x / (1.f + __expf(-x)); }

#define XB_TMO      128
#define XB_XCNT(j)  (256  + 64 * (j))
#define XB_XSUB(j)  (1280 + 64 * (j))
#define XB_XGEN(j)  (2304 + 64 * (j))
#define XB_TOP      3328
#define XB_TOPGEN   3392
#define XCD_BAR_WORDS 3456
#define XB_SPIN_CAP (1u << 22)
__device__ __forceinline__ unsigned xb_ld(unsigned* p)              { return __hip_atomic_load(p, __ATOMIC_RELAXED, __HIP_MEMORY_SCOPE_AGENT); }
__device__ __forceinline__ unsigned xb_add(unsigned* p, unsigned v) { return __hip_atomic_fetch_add(p, v, __ATOMIC_RELAXED, __HIP_MEMORY_SCOPE_AGENT); }
__device__ __forceinline__ unsigned xb_xcc_id() { return (unsigned)__builtin_amdgcn_s_getreg((3 << 11) | 20) & 0xFu; }
#define XB_SPIN(cond, bar) do { unsigned _sp = 0; while (cond) { __builtin_amdgcn_s_sleep(1); \
    if ((++_sp & 255u) == 0u) { if (xb_ld(&(bar)[XB_TMO])) break; if (_sp > XB_SPIN_CAP) { atomicAdd(&(bar)[XB_TMO], 1u); break; } } } } while (0)
struct XcdBarrier { unsigned* bar; unsigned x; volatile LAS unsigned* st; };
__device__ __forceinline__ XcdBarrier xcd_barrier_post(unsigned* bar, volatile LAS unsigned* st) {
    XcdBarrier b; b.bar = bar; b.x = xb_xcc_id(); b.st = st;
    if (threadIdx.x == 0) (void)xb_add(&bar[XB_XCNT(b.x)], 1u);
    return b;
}
__device__ __forceinline__ void xcd_barrier_complete(unsigned* bar, unsigned x, unsigned& nloc, unsigned& nx) {
    const unsigned G = gridDim.x * gridDim.y * gridDim.z;
    unsigned sum, cnt, mine, sp = 0u;
    for (;;) {
        sum = 0u; cnt = 0u; mine = 0u;
#pragma unroll
        for (unsigned j = 0; j < 16; ++j) { const unsigned c = xb_ld(&bar[XB_XCNT(j)]); sum += c; cnt += (c > 0u) ? 1u : 0u; mine = (j == x) ? c : mine; }
        if (sum == G) break;
        __builtin_amdgcn_s_sleep(1);
        if ((++sp & 255u) == 0u) { if (xb_ld(&bar[XB_TMO])) break; if (sp > XB_SPIN_CAP) { atomicAdd(&bar[XB_TMO], 1u); break; } }
    }
    nloc = mine > 0u ? mine : 1u; nx = cnt > 0u ? cnt : 1u;
}
__device__ __forceinline__ void xcd_barrier(const XcdBarrier& b) {
    asm volatile("s_waitcnt vmcnt(0)" ::: "memory");
    __syncthreads();
    if (threadIdx.x == 0) {
        unsigned* bar = b.bar;
        __builtin_amdgcn_s_waitcnt(0);
        unsigned nloc = b.st[0], nx = b.st[1];
        if (nloc == 0u) { xcd_barrier_complete(bar, b.x, nloc, nx); b.st[0] = nloc; b.st[1] = nx; }
        const unsigned old = xb_add(&bar[XB_XSUB(b.x)], 1u);
        const unsigned gen = old / nloc;
        if (old + 1u == (gen + 1u) * nloc) {
            __builtin_amdgcn_fence(__ATOMIC_RELEASE, "agent");
            asm volatile("s_waitcnt vmcnt(0)" ::: "memory");
            const unsigned og = xb_add(&bar[XB_TOP], 1u);
            const unsigned tg = og / nx;
            if (og + 1u == (tg + 1u) * nx) xb_add(&bar[XB_TOPGEN], 1u);
            else XB_SPIN(xb_ld(&bar[XB_TOPGEN]) == tg, bar);
            __builtin_amdgcn_fence(__ATOMIC_ACQUIRE, "agent");
            xb_add(&bar[XB_XGEN(b.x)], 1u);
            asm volatile("s_waitcnt vmcnt(0)" ::: "memory");
        } else {
            XB_SPIN(xb_ld(&bar[XB_XGEN(b.x)]) == gen, bar);
            __builtin_amdgcn_fence(__ATOMIC_ACQUIRE, "agent");
            asm volatile("s_waitcnt vmcnt(0)" ::: "memory");
        }
    }
    __syncthreads();
}

struct Args {
    const float* in[21];
    float* out;
    unsigned char* ws;
    int ph_lo, ph_hi;
};

struct Ctx {
    int tid, lane, wave, gw, ngw, gsz;
    LAS unsigned char* lds;
    unsigned char* ws;
    unsigned* ctl;
};

__device__ __forceinline__ int gtid_now() { int t = (int)(blockIdx.x * 512u + threadIdx.x); asm volatile("" : "+v"(t)); return t; }
template <int MODE> __device__ __forceinline__ int perm_row(int n) {
    if (MODE == 1) { const int nl = n & 255; return (n & ~255) + 128 * ((nl >> 5) & 1) + 32 * (nl >> 6) + (nl & 31); }
    if (MODE == 2) { const int bj = n >> 9, rem = n & 511; return 256 * (rem >> 7) + 128 * bj + (rem & 127); }
    if (MODE == 3) { const int cl = n & 255; return (n & ~255) + 128 * ((cl >> 3) & 1) + 32 * (cl >> 6) + 8 * ((cl >> 4) & 3) + (cl & 7); }
    return n;
}
template <int MODE> __device__ __forceinline__ void transpose_item(const float* W, int K, int N, bf16* WT, LAS float* scr, int item, int lane) {
    const int nblk = N / 32, kb = item / nblk, nb = item % nblk, k0 = 64 * kb, n0 = 32 * nb, d0 = perm_row<MODE>(n0);
#pragma unroll 8
    for (int i = 0; i < 32; ++i) { const int kk = 2 * i + (lane >> 5); scr[kk * 33 + (lane & 31)] = W[(size_t)(k0 + kk) * N + n0 + (lane & 31)]; }
    asm volatile("s_waitcnt lgkmcnt(0)" ::: "memory");
    const int c = lane & 7;
#pragma unroll
    for (int j = 0; j < 4; ++j) { const int n = (lane >> 3) + 8 * j; const LAS float* s = scr + (8 * c) * 33 + n;
        u32x4 o; o.x = pk2(s[0 * 33], s[1 * 33]); o.y = pk2(s[2 * 33], s[3 * 33]); o.z = pk2(s[4 * 33], s[5 * 33]); o.w = pk2(s[6 * 33], s[7 * 33]);
        *(u32x4*)(WT + (size_t)(d0 + n) * K + k0 + 8 * c) = o; }
    asm volatile("s_waitcnt lgkmcnt(0)" ::: "memory");
}
template <int MODE> __device__ __forceinline__ void convert_batch(const Ctx& c, const float* src, int K, int N, bf16* dst, int nmat, size_t dst_stride) {
    LAS float* scr = (LAS float*)(c.lds + c.wave * 16384);
    const int per = (K / 64) * (N / 32); const long total = (long)per * nmat;
    for (long it = c.gw; it < total; it += c.ngw) {
        const int mat = (int)(it / per), item = (int)(it % per);
        transpose_item<MODE>(src + (size_t)mat * K * N, K, N, dst + (size_t)mat * dst_stride, scr, item, c.lane);
    }
}

__device__ __forceinline__ float clamp448(float v) { return __builtin_amdgcn_fmed3f(v, -448.f, 448.f); }
__device__ __forceinline__ unsigned pk4_fp8(float a, float b, float c2, float d) {
    unsigned w = 0u; w = __builtin_amdgcn_cvt_pk_fp8_f32(clamp448(a), clamp448(b), w, false); w = __builtin_amdgcn_cvt_pk_fp8_f32(clamp448(c2), clamp448(d), w, true); return w;
}
template <int MODE> __device__ __forceinline__ void transpose_item_f8(const float* W, int K, int N, unsigned char* WT, LAS float* scr, int item, int lane) {
    const int nblk = N / 32, kb = item / nblk, nb = item % nblk, k0 = 64 * kb, n0 = 32 * nb, d0 = perm_row<MODE>(n0);
#pragma unroll 8
    for (int i = 0; i < 32; ++i) { const int kk = 2 * i + (lane >> 5); scr[kk * 33 + (lane & 31)] = W[(size_t)(k0 + kk) * N + n0 + (lane & 31)]; }
    asm volatile("s_waitcnt lgkmcnt(0)" ::: "memory");
    const int n = lane & 31;
#pragma unroll
    for (int j = 0; j < 2; ++j) { const int ch = (lane >> 5) + 2 * j; const LAS float* s = scr + (16 * ch) * 33 + n; u32x4 o;
#pragma unroll
        for (int q = 0; q < 4; ++q) o[q] = pk4_fp8(s[(4 * q) * 33] * F8_WSCALE, s[(4 * q + 1) * 33] * F8_WSCALE, s[(4 * q + 2) * 33] * F8_WSCALE, s[(4 * q + 3) * 33] * F8_WSCALE);
        *(u32x4*)(WT + (size_t)(d0 + n) * K + k0 + 16 * ch) = o; }
    asm volatile("s_waitcnt lgkmcnt(0)" ::: "memory");
}
template <int MODE> __device__ __forceinline__ void convert_batch_f8(const Ctx& c, const float* src, int K, int N, unsigned char* dst, int nmat, size_t dst_stride) {
    LAS float* scr = (LAS float*)(c.lds + c.wave * 16384);
    const int per = (K / 64) * (N / 32); const long total = (long)per * nmat;
    for (long it = c.gw; it < total; it += c.ngw) {
        const int mat = (int)(it / per), item = (int)(it % per);
        transpose_item_f8<MODE>(src + (size_t)mat * K * N, K, N, dst + (size_t)mat * dst_stride, scr, item, c.lane);
    }
}

__device__ __forceinline__ void t128_load(f32x4 (&v)[16], const float* W, int N, int item, int lane) {
    const int nblk = N / 32, kb = item / nblk, nb = item % nblk, k0 = 128 * kb, n0 = 32 * nb;
    const int kr = lane >> 3, nq = lane & 7;
#pragma unroll
    for (int i = 0; i < 16; ++i) v[i] = *(const f32x4*)(W + (size_t)(k0 + 8 * i + kr) * N + n0 + 4 * nq);
}
template <int MODE, bool F8> __device__ __forceinline__ void t128_finish(const f32x4 (&v)[16], int K, int N, unsigned char* WT, LAS float* scr, int item, int lane, float scale) {
    const int nblk = N / 32, kb = item / nblk, nb = item % nblk, k0 = 128 * kb, n0 = 32 * nb, d0 = perm_row<MODE>(n0);
    const int kr = lane >> 3, nq = lane & 7;
#pragma unroll
    for (int i = 0; i < 16; ++i) { LAS float* s = scr + (8 * i + kr) * 33 + 4 * nq; s[0] = v[i].x; s[1] = v[i].y; s[2] = v[i].z; s[3] = v[i].w; }
    asm volatile("s_waitcnt lgkmcnt(0)" ::: "memory");
    const int n = lane & 31, half = lane >> 5; const LAS float* s0 = scr + (64 * half) * 33 + n;
    if (F8) {
        unsigned char* dst = WT + (size_t)(MODE == 3 ? perm_row<MODE>(n0 + n) : d0 + n) * K + k0 + 64 * half;
#pragma unroll
        for (int ch = 0; ch < 4; ++ch) { const LAS float* s = s0 + (16 * ch) * 33; u32x4 o;
#pragma unroll
            for (int q = 0; q < 4; ++q) o[q] = pk4_fp8(s[(4 * q) * 33] * scale, s[(4 * q + 1) * 33] * scale, s[(4 * q + 2) * 33] * scale, s[(4 * q + 3) * 33] * scale);
            *(u32x4*)(dst + 16 * ch) = o; }
    } else {
        bf16* dst = (bf16*)WT + (size_t)(d0 + n) * K + k0 + 64 * half;
#pragma unroll
        for (int ch = 0; ch < 8; ++ch) { const LAS float* s = s0 + (8 * ch) * 33; u32x4 o;
#pragma unroll
            for (int q = 0; q < 4; ++q) o[q] = pk2(s[(2 * q) * 33], s[(2 * q + 1) * 33]);
            *(u32x4*)(dst + 8 * ch) = o; }
    }
    asm volatile("s_waitcnt lgkmcnt(0)" ::: "memory");
}
template <int MODE, bool F8> __device__ __forceinline__ void transpose_item128(const float* W, int K, int N, unsigned char* WT, LAS float* scr, int item, int lane, float scale) {
    asm volatile("" : "+v"(lane));
    f32x4 v[16];
    t128_load(v, W, N, item, lane);
    t128_finish<MODE, F8>(v, K, N, WT, scr, item, lane, scale);
}
template <int QM, bool F8Q> __device__ __forceinline__ void convert_dense_all(const Ctx& c, const float* w0in, const float* w1in, const float* w0out, const float* w1out,
                                                                              unsigned char* W0IN_, unsigned char* W1IN_, unsigned char* W0OUT_, unsigned char* W1OUT_, float sq) {
    constexpr int n0 = 16 * (AB_IN / 32), n1 = 16 * (C_IN / 32), n2 = 16 * (D / 32), TOT = n0 + n1 + 2 * n2;
    LAS float* scr = (LAS float*)(c.lds + c.wave * 16896);
    const int lane = c.lane, ngw = c.ngw;
#define DENSE_LOAD(v, it) do { if ((it) < n0) t128_load(v, w0in, AB_IN, (it), lane); else if ((it) < n0 + n1) t128_load(v, w1in, C_IN, (it) - n0, lane); \
        else if ((it) < n0 + n1 + n2) t128_load(v, w0out, D, (it) - n0 - n1, lane); else t128_load(v, w1out, D, (it) - n0 - n1 - n2, lane); } while (0)
#define DENSE_FIN(v, it) do { if ((it) < n0 + n1) { const bool f_ = (it) < n0; t128_finish<QM, F8Q>(v, D, f_ ? AB_IN : C_IN, f_ ? W0IN_ : W1IN_, scr, f_ ? (it) : (it) - n0, lane, sq); } \
        else { const bool f_ = (it) < n0 + n1 + n2; t128_finish<0, false>(v, D, D, f_ ? W0OUT_ : W1OUT_, scr, f_ ? (it) - n0 - n1 : (it) - n0 - n1 - n2, lane, 1.f); } } while (0)
    int it = c.gw;
    f32x4 va[16], vb[16];
    if (it < TOT) DENSE_LOAD(va, it);
    while (it < TOT) {
        const int it1 = it + ngw, it2 = it1 + ngw;
        if (it1 < TOT) DENSE_LOAD(vb, it1);
        DENSE_FIN(va, it);
        if (it2 < TOT) DENSE_LOAD(va, it2);
        if (it1 < TOT) DENSE_FIN(vb, it1);
        it = it2;
    }
#undef DENSE_LOAD
#undef DENSE_FIN
}
template <int MODE, bool F8> __device__ __forceinline__ void convert_batch128(const Ctx& c, const float* src, int K, int N, void* dst, int nmat, size_t dst_stride_bytes, float scale) {
    LAS float* scr = (LAS float*)(c.lds + c.wave * 16896);
    const int per = (K / 128) * (N / 32); const long total = (long)per * nmat;
    for (long it = c.gw; it < total; it += c.ngw) {
        const int mat = (int)(it / per), item = (int)(it % per);
        transpose_item128<MODE, F8>(src + (size_t)mat * K * N, K, N, (unsigned char*)dst + (size_t)mat * dst_stride_bytes, scr, item, c.lane, scale);
    }
}

struct ExpertSrc { const float* up; const float* sup; const float* dn; const float* sdn; };
constexpr int EXP_ITEMS_UP = NE * 512, EXP_ITEMS_SUP = 512, EXP_ITEMS_DN = NE * 256, EXP_ITEMS_SDN = 256, EXP_ITEMS = EXP_ITEMS_UP + EXP_ITEMS_SUP + EXP_ITEMS_DN + EXP_ITEMS_SDN;
__device__ __forceinline__ void expert_item(const ExpertSrc& s, int l, unsigned char* ws, LAS float* scr, int it, int lane) {
    unsigned char* wup = ws + WS_WUP + (size_t)l * NEX * UPN * D; unsigned char* wdn = ws + WS_WDN + (size_t)l * NEX * D * ED;
    if (it < EXP_ITEMS_UP) { const int mat = it >> 9; transpose_item128<2, true>(s.up + ((size_t)l * NE + mat) * D * UPN, D, UPN, wup + (size_t)mat * UPN * D, scr, it & 511, lane, F8_WSCALE); return; }
    it -= EXP_ITEMS_UP;
    if (it < EXP_ITEMS_SUP) { transpose_item128<2, true>(s.sup + (size_t)l * D * UPN, D, UPN, wup + (size_t)NE * UPN * D, scr, it, lane, F8_WSCALE); return; }
    it -= EXP_ITEMS_SUP;
    if (it < EXP_ITEMS_DN) { const int mat = it >> 8; transpose_item128<0, true>(s.dn + ((size_t)l * NE + mat) * ED * D, ED, D, wdn + (size_t)mat * D * ED, scr, it & 255, lane, F8_WSCALE); return; }
    it -= EXP_ITEMS_DN;
    transpose_item128<0, true>(s.sdn + (size_t)l * ED * D, ED, D, wdn + (size_t)NE * D * ED, scr, it, lane, F8_WSCALE);
}
struct ERef { const float* W; int N, item; };
__device__ __forceinline__ ERef expert_ref(const ExpertSrc& s, int l, int it) {
    if (it < EXP_ITEMS_UP) return ERef{s.up + ((size_t)l * NE + (it >> 9)) * D * UPN, UPN, it & 511};
    it -= EXP_ITEMS_UP;
    if (it < EXP_ITEMS_SUP) return ERef{s.sup + (size_t)l * D * UPN, UPN, it};
    it -= EXP_ITEMS_SUP;
    if (it < EXP_ITEMS_DN) return ERef{s.dn + ((size_t)l * NE + (it >> 8)) * ED * D, D, it & 255};
    it -= EXP_ITEMS_DN;
    return ERef{s.sdn + (size_t)l * ED * D, D, it};
}
__device__ __forceinline__ void expert_fin(const f32x4 (&v)[16], int l, unsigned char* ws, LAS float* scr, int it, int lane) {
    if (it < EXP_ITEMS_UP + EXP_ITEMS_SUP) { const bool r = it < EXP_ITEMS_UP; const int mat = r ? it >> 9 : NE, item = r ? it & 511 : it - EXP_ITEMS_UP;
        t128_finish<2, true>(v, D, UPN, ws + WS_WUP + ((size_t)l * NEX + mat) * UPN * D, scr, item, lane, F8_WSCALE); }
    else { it -= EXP_ITEMS_UP + EXP_ITEMS_SUP; const bool r = it < EXP_ITEMS_DN; const int mat = r ? it >> 8 : NE, item = r ? it & 255 : it - EXP_ITEMS_DN;
        t128_finish<Y_FP8 ? 3 : 0, true>(v, ED, D, ws + WS_WDN + ((size_t)l * NEX + mat) * D * ED, scr, item, lane, F8_WSCALE); }
}
__device__ __forceinline__ void expert_items_block(const Ctx& c, const ExpertSrc& s, int l, unsigned char* ws, int first, int count) {
    int tid = threadIdx.x; asm volatile("" : "+v"(tid));
    const int lane = tid & 63, wv = __builtin_amdgcn_readfirstlane(tid >> 6);
    LAS float* scr = (LAS float*)(c.lds + wv * 16896);
    f32x4 va[16], vb[16];
    int i = wv;
    if (i < count) { const ERef r = expert_ref(s, l, first + i); t128_load(va, r.W, r.N, r.item, lane); }
#pragma unroll 1
    while (i < count) {
        const int i1 = i + 8, i2 = i + 16;
        if (i1 < count) { const ERef r = expert_ref(s, l, first + i1); t128_load(vb, r.W, r.N, r.item, lane); }
        expert_fin(va, l, ws, scr, first + i, lane);
        if (i2 < count) { const ERef r = expert_ref(s, l, first + i2); t128_load(va, r.W, r.N, r.item, lane); }
        if (i1 < count) expert_fin(vb, l, ws, scr, first + i1, lane);
        i = i2;
    }
}
__device__ __forceinline__ void ada_phase(const Ctx& c, const float* cin, const float* w_ada, const float* b_ada, float* ada) {
    LAS float* red = (LAS float*)(c.lds);
    LAS float* sc = red + 1024;
    for (int i = c.tid; i < 4 * D; i += 512) sc[i] = siluf(cin[i]);
    __syncthreads();
    const int j = c.lane & 7, kr = c.lane >> 3;
    constexpr int NCG = 6 * D / 32;
    for (int u = blockIdx.x; u < 2 * NCG; u += gridDim.x) {
        const int l = u / NCG, cg = u % NCG;
        const int k0 = c.wave * 256 + kr;
        const float* w = w_ada + (size_t)l * D * 6 * D + (size_t)k0 * 6 * D + cg * 32 + 4 * j;
        f32x4 acc[4];
#pragma unroll
        for (int b = 0; b < 4; ++b) acc[b] = (f32x4){0.f, 0.f, 0.f, 0.f};
        f32x4 wv[32];
#pragma unroll
        for (int i = 0; i < 32; ++i) wv[i] = *(const f32x4*)(w + (size_t)(8 * i) * 6 * D);
#pragma unroll
        for (int i = 0; i < 32; ++i)
#pragma unroll
            for (int b = 0; b < 4; ++b) acc[b] += wv[i] * sc[b * D + k0 + 8 * i];
#pragma unroll
        for (int b = 0; b < 4; ++b)
#pragma unroll
            for (int q = 0; q < 4; ++q) { float t = acc[b][q]; t += __shfl_xor(t, 8); t += __shfl_xor(t, 16); t += __shfl_xor(t, 32); acc[b][q] = t; }
        if (kr == 0) {
#pragma unroll
            for (int b = 0; b < 4; ++b) *(LAS f32x4*)(red + (c.wave * 4 + b) * 32 + 4 * j) = acc[b]; }
        __syncthreads();
        if (c.tid < 128) {
            const int b = c.tid >> 5, cc = c.tid & 31; float s2 = b_ada[(size_t)l * 6 * D + cg * 32 + cc];
#pragma unroll
            for (int w8 = 0; w8 < 8; ++w8) s2 += red[(w8 * 4 + b) * 32 + cc];
            ada[((size_t)l * 4 + b) * 6 * D + cg * 32 + cc] = s2;
        }
        __syncthreads();
    }
}

__device__ __forceinline__ void load_row(const float* xrow, int lane, f32x4 (&v)[8]) {
#pragma unroll
    for (int j = 0; j < 8; ++j) v[j] = *(const f32x4*)(xrow + 4 * lane + 256 * j);
}
__device__ __forceinline__ float row_rstd(const f32x4 (&v)[8]) {
    float s = 0.f;
#pragma unroll
    for (int j = 0; j < 8; ++j) s += (v[j].x * v[j].x + v[j].y * v[j].y) + (v[j].z * v[j].z + v[j].w * v[j].w);
    return 1.f / sqrtf(wave_sum(s) * (1.f / D) + RMS_EPS);
}
__device__ __forceinline__ void modulate_row(f32x4 (&v)[8], float rstd, const float* g, const float* sh, const float* sc, int lane) {
#pragma unroll
    for (int j = 0; j < 8; ++j) { const int col = 4 * lane + 256 * j;
        const f32x4 gg = *(const f32x4*)(g + col), s1 = *(const f32x4*)(sc + col), s0 = *(const f32x4*)(sh + col);
        v[j] = v[j] * rstd * gg * (s1 + 1.f) + s0; }
}
__device__ __forceinline__ void store_row_bf16(bf16* orow, const f32x4 (&v)[8], int lane) {
#pragma unroll
    for (int j = 0; j < 8; ++j) { u32x2 w; w.x = pk2(v[j].x, v[j].y); w.y = pk2(v[j].z, v[j].w); *(u32x2*)(orow + 4 * lane + 256 * j) = w; }
}
__device__ __forceinline__ void store_row_fp8(unsigned char* orow, const f32x4 (&v)[8], int lane, float scale) {
#pragma unroll
    for (int j = 0; j < 8; ++j) *(unsigned*)(orow + 4 * lane + 256 * j) = pk4_fp8(v[j].x * scale, v[j].y * scale, v[j].z * scale, v[j].w * scale);
}
__device__ __forceinline__ void norm_phase(const Ctx& c, const float* x, const float* g, const float* ada_l  , int sh_off, int sc_off, bf16* out) {
    for (int m = c.gw; m < M; m += c.ngw) {
        const int b = m / T; f32x4 v[8]; load_row(x + (size_t)m * D, c.lane, v);
        const float rstd = row_rstd(v);
        modulate_row(v, rstd, g, ada_l + (size_t)b * 6 * D + sh_off, ada_l + (size_t)b * 6 * D + sc_off, c.lane);
#if USE_FP8_QKV
        store_row_fp8((unsigned char*)out + (size_t)m * D, v, c.lane, F8_HSCALE);
#else
        store_row_bf16(out + (size_t)m * D, v, c.lane);
#endif
    }
}

__device__ __forceinline__ void wave_gemm_32x64(const bf16* a0, const bf16* a1, const bf16* b, int K, int lane, f32x4 (&acc)[2][4]) {
    const int q8 = (lane >> 4) * 8;
    for (int k0 = 0; k0 < K; k0 += 32) {
        const bf16x8 fa0 = *(const bf16x8*)(a0 + k0 + q8), fa1 = *(const bf16x8*)(a1 + k0 + q8);
#pragma unroll
        for (int n = 0; n < 4; ++n) { const bf16x8 fb = *(const bf16x8*)(b + (size_t)n * 16 * K + k0 + q8);
            acc[0][n] = __builtin_amdgcn_mfma_f32_16x16x32_bf16(fa0, fb, acc[0][n], 0, 0, 0);
            acc[1][n] = __builtin_amdgcn_mfma_f32_16x16x32_bf16(fa1, fb, acc[1][n], 0, 0, 0); }
    }
}
#define ZERO_ACC(acc) do { _Pragma("unroll") for (int _a = 0; _a < 2; ++_a) _Pragma("unroll") for (int _b = 0; _b < 4; ++_b) acc[_a][_b] = (f32x4){0.f, 0.f, 0.f, 0.f}; } while (0)

__device__ __forceinline__ void gemm_plain_bf16(const Ctx& c, const bf16* A, const bf16* Bt, int K, int N, bf16* C) {
    const int ntn = N / 64, units = (M / 256) * ntn;
    for (int u = blockIdx.x; u < units; u += gridDim.x) {
        const int mt = u / ntn, nt = u % ntn, row0 = mt * 256 + c.wave * 32, n0 = nt * 64;
        f32x4 acc[2][4]; ZERO_ACC(acc);
        const int r = c.lane & 15;
        wave_gemm_32x64(A + (size_t)(row0 + r) * K, A + (size_t)(row0 + 16 + r) * K, Bt + (size_t)(n0 + r) * K, K, c.lane, acc);
#pragma unroll
        for (int mi = 0; mi < 2; ++mi)
#pragma unroll
            for (int n = 0; n < 4; ++n)
#pragma unroll
                for (int j = 0; j < 4; ++j) C[(size_t)(row0 + 16 * mi + 4 * (c.lane >> 4) + j) * N + n0 + 16 * n + r] = (bf16)f2bf(acc[mi][n][j]);
    }
}
__device__ __forceinline__ void gemm_outproj(const Ctx& c, const bf16* A, const bf16* Bt, const float* xin, const float* gm  , float* X1) {
    const int K = D, N = D, ntn = N / 64, units = (M / 256) * ntn;
    for (int u = blockIdx.x; u < units; u += gridDim.x) {
        const int mt = u / ntn, nt = u % ntn, row0 = mt * 256 + c.wave * 32, n0 = nt * 64;
        f32x4 acc[2][4]; ZERO_ACC(acc);
        const int r = c.lane & 15;
        wave_gemm_32x64(A + (size_t)(row0 + r) * K, A + (size_t)(row0 + 16 + r) * K, Bt + (size_t)(n0 + r) * K, K, c.lane, acc);
        const int b = row0 / T;
#pragma unroll
        for (int mi = 0; mi < 2; ++mi)
#pragma unroll
            for (int n = 0; n < 4; ++n)
#pragma unroll
                for (int j = 0; j < 4; ++j) { const size_t o = (size_t)(row0 + 16 * mi + 4 * (c.lane >> 4) + j) * N + n0 + 16 * n + r;
                    X1[o] = xin[o] + gm[(size_t)b * 6 * D + n0 + 16 * n + r] * acc[mi][n][j]; }
    }
}

__device__ __forceinline__ void qknorm_chunk(bf16* p, const float* g) {
    float v[64]; float ss = 0.f;
#pragma unroll
    for (int i = 0; i < 8; ++i) { const u32x4 w = *(const u32x4*)(p + 8 * i);
#pragma unroll
        for (int j = 0; j < 4; ++j) { v[8 * i + 2 * j] = bf2f(w[j] & 0xffffu); v[8 * i + 2 * j + 1] = bf2f(w[j] >> 16); } }
#pragma unroll
    for (int i = 0; i < 64; ++i) ss += v[i] * v[i];
    const float rs = 1.f / sqrtf(ss * (1.f / 64.f) + RMS_EPS);
#pragma unroll
    for (int i = 0; i < 8; ++i) { u32x4 w;
#pragma unroll
        for (int j = 0; j < 4; ++j) w[j] = pk2(v[8 * i + 2 * j] * rs * g[8 * i + 2 * j], v[8 * i + 2 * j + 1] * rs * g[8 * i + 2 * j + 1]);
        *(u32x4*)(p + 8 * i) = w; }
}
__device__ __forceinline__ void qknorm0_phase(const Ctx& c, bf16* qkv, const float* gains  ) {
    const long total = (long)M * 50;
    for (long id = gtid_now(); id < total; id += c.gsz) {
        const int m = (int)(id / 50), k = (int)(id % 50); int ch, gi;
        if (k < 16) { ch = k; gi = 0; } else if (k < 32) { ch = k; gi = 1; } else if (k < 48) { ch = k + 16; gi = 2; } else { ch = k + 16; gi = 3; }
        qknorm_chunk(qkv + (size_t)m * AB_IN + 64 * ch, gains + 64 * gi);
    }
}
__device__ __forceinline__ void qknorm1_phase(const Ctx& c, bf16* qkv, const float* gains  ) {
    const long total = (long)M * 64;
    for (long id = gtid_now(); id < total; id += c.gsz) {
        const int m = (int)(id / 64), ch = (int)(id % 64);
        qknorm_chunk(qkv + (size_t)m * C_IN + 64 * ch, gains + 64 * (ch >> 5));
    }
}

__device__ __forceinline__ void load64(const bf16* p, float (&v)[64], float scale) {
#pragma unroll
    for (int i = 0; i < 8; ++i) { const u32x4 w = *(const u32x4*)(p + 8 * i);
#pragma unroll
        for (int j = 0; j < 4; ++j) { v[8 * i + 2 * j] = bf2f(w[j] & 0xffffu) * scale; v[8 * i + 2 * j + 1] = bf2f(w[j] >> 16) * scale; } }
}
__device__ __forceinline__ float dot64(const float (&q)[64], const bf16* kp) {
    float s0 = 0.f, s1 = 0.f;
#pragma unroll
    for (int i = 0; i < 8; ++i) { const u32x4 w = *(const u32x4*)(kp + 8 * i);
#pragma unroll
        for (int j = 0; j < 4; ++j) { s0 += q[8 * i + 2 * j] * bf2f(w[j] & 0xffffu); s1 += q[8 * i + 2 * j + 1] * bf2f(w[j] >> 16); } }
    return s0 + s1;
}
__device__ __forceinline__ void axpy64(float (&o)[64], float a, float p, const bf16* vp) {
#pragma unroll
    for (int i = 0; i < 8; ++i) { const u32x4 w = *(const u32x4*)(vp + 8 * i);
#pragma unroll
        for (int j = 0; j < 4; ++j) { o[8 * i + 2 * j] = o[8 * i + 2 * j] * a + p * bf2f(w[j] & 0xffffu); o[8 * i + 2 * j + 1] = o[8 * i + 2 * j + 1] * a + p * bf2f(w[j] >> 16); } }
}
__device__ __forceinline__ void store64_bf16(bf16* p, const float (&o)[64], float s) {
#pragma unroll
    for (int i = 0; i < 8; ++i) { u32x4 w;
#pragma unroll
        for (int j = 0; j < 4; ++j) w[j] = pk2(o[8 * i + 2 * j] * s, o[8 * i + 2 * j + 1] * s);
        *(u32x4*)(p + 8 * i) = w; }
}
__device__ __forceinline__ void attn0_phase(const Ctx& c, const bf16* qkv, const float* sinks, bf16* O) {
    const long total = (long)32 * M;
    for (long id = gtid_now(); id < total; id += c.gsz) {
        const int hh = (int)(id / M), m = (int)(id % M), b = m / T, t = m % T;
        float q[64], o[64];
#pragma unroll
        for (int i = 0; i < 64; ++i) o[i] = 0.f;
        float mx = -1e30f, l = 0.f;
        if (hh < 16) {
            const int h = hh; const float slope = exp2f(-0.5f * (float)(h + 1));
            load64(qkv + (size_t)m * AB_IN + 64 * h, q, 0.125f);
            const bf16* kb = qkv + (size_t)b * T * AB_IN + 1024 + 64 * h;
            for (int br = 0; br < 3; ++br) {
                const int dil = br == 0 ? 1 : (br == 1 ? 4 : 16);
                for (int j = 0; j <= 128; ++j) {
                    const int s = t - dil * j; if (s < 0) break;
                    const bf16* kp = kb + (size_t)s * AB_IN;
                    const float sc = dot64(q, kp) - slope * (float)(dil * j);
                    const float mn = fmaxf(mx, sc), a = __expf(mx - mn), p = __expf(sc - mn);
                    l = l * a + p; axpy64(o, a, p, kp + 1024); mx = mn;
                }
            }
            store64_bf16(O + (size_t)m * D + 64 * h, o, 1.f / l);
        } else {
            const int h = hh - 16, kvh = h >> 3; const float slope = exp2f(-0.5f * (float)(h + 1));
            load64(qkv + (size_t)m * AB_IN + 3072 + 64 * h, q, 0.125f);
            const bf16* kb = qkv + (size_t)b * T * AB_IN + 4096 + 64 * kvh;
            for (int j = 0; j < 128; ++j) {
                const int s = t - j; if (s < 0) break;
                const bf16* kp = kb + (size_t)s * AB_IN;
                const float sc = dot64(q, kp) - slope * (float)j;
                const float mn = fmaxf(mx, sc), a = __expf(mx - mn), p = __expf(sc - mn);
                l = l * a + p; axpy64(o, a, p, kp + 128); mx = mn;
            }
            const float sk = sinks[h], mn = fmaxf(mx, sk), a = __expf(mx - mn);
            l = l * a + __expf(sk - mn);
            store64_bf16(O + (size_t)m * D + 1024 + 64 * h, o, a / l);
        }
    }
}
__device__ __forceinline__ void attn1_phase(const Ctx& c, const bf16* qkv, float* tmp) {
    const int items = NB * 16 * 2 * 2 * (T / 64);
    for (int it = c.gw; it < items; it += c.ngw) {
        const int tb = (T / 64 - 1) - it / (NB * 16 * 4); const int r = it % (NB * 16 * 4);
        const int b = r / 64, h = (r / 4) % 16, i = (r >> 1) & 1, j = r & 1;
        const int t = tb * 64 + c.lane, m = b * T + t;
        const float slope = exp2f(-0.5f * (float)(h + 1));
        float q[64], o[64];
#pragma unroll
        for (int d = 0; d < 64; ++d) o[d] = 0.f;
        float mx = -1e30f, l = 0.f;
        load64(qkv + (size_t)m * C_IN + 128 * h + 64 * i, q, 0.125f);
        const bf16* kb = qkv + (size_t)b * T * C_IN + 2048 + 128 * h + 64 * i;
        const bf16* vb = qkv + (size_t)b * T * C_IN + 4096 + 128 * h + 64 * j;
        const int smax = tb * 64 + 63;
        for (int s = 0; s <= smax; ++s) {
            const bf16* kp = kb + (size_t)s * C_IN;
            float sc = dot64(q, kp) - slope * (float)(t - s);
            if (s > t) sc = -1e30f;
            const float mn = fmaxf(mx, sc), a = __expf(mx - mn), p = (s > t) ? 0.f : __expf(sc - mn);
            l = l * a + p; axpy64(o, a, p, vb + (size_t)s * C_IN); mx = mn;
        }
        float* op = tmp + (((size_t)m * 16 + h) * 2 + i) * 128 + 64 * j; const float il = 1.f / l;
#pragma unroll
        for (int d = 0; d < 16; ++d) *(f32x4*)(op + 4 * d) = (f32x4){o[4 * d] * il, o[4 * d + 1] * il, o[4 * d + 2] * il, o[4 * d + 3] * il};
    }
}
__device__ __forceinline__ void attn1_finish_phase(const Ctx& c, const float* tmp, const float* lamp  , const float* subln  , bf16* O) {
    float s01 = 0.f, s23 = 0.f;
    for (int i = 0; i < 64; ++i) { s01 += lamp[i] * lamp[64 + i]; s23 += lamp[128 + i] * lamp[192 + i]; }
    const float lam_init = 0.8f - 0.6f * expf(-0.3f * 1.0f);
    const float lam = expf(s01) - expf(s23) + lam_init;
    const long total = (long)M * 16;
    for (long id = gtid_now(); id < total; id += c.gsz) {
        const float* p1 = tmp + (size_t)id * 256; const float* p2 = p1 + 128;
        float ss = 0.f;
        for (int d = 0; d < 128; ++d) { const float v = p1[d] - lam * p2[d]; ss += v * v; }
        const float rs = (1.f - lam_init) / sqrtf(ss * (1.f / 128.f) + RMS_EPS);
        bf16* op = O + (size_t)id * 128;
        for (int d = 0; d < 128; d += 2) { const float v0 = (p1[d] - lam * p2[d]) * rs * subln[d], v1 = (p1[d + 1] - lam * p2[d + 1]) * rs * subln[d + 1];
            *(unsigned*)(op + d) = pk2(v0, v1); }
    }
}

__device__ __forceinline__ void router_phase(const Ctx& c, const float* x1, const float* g, const float* ada_l, const float* wr  , const float* rbias  ,
                                             bf16* HF, int* idx, float* gate, unsigned* counts) {
    LAS float* hb = (LAS float*)(c.lds + c.wave * 8192);
    const int lane = c.lane;
    for (int m = c.gw; m < M; m += c.ngw) {
        const int b = m / T; f32x4 v[8]; load_row(x1 + (size_t)m * D, lane, v);
        const float rstd = row_rstd(v);
        modulate_row(v, rstd, g, ada_l + (size_t)b * 6 * D + 3 * D, ada_l + (size_t)b * 6 * D + 4 * D, lane);
        store_row_bf16(HF + (size_t)m * D, v, lane);
#pragma unroll
        for (int j = 0; j < 8; ++j) *(LAS f32x4*)(hb + 4 * lane + 256 * j) = v[j];
        asm volatile("s_waitcnt lgkmcnt(0)" ::: "memory");
        float a0 = 0.f, a1 = 0.f, a2 = 0.f, a3 = 0.f;
        for (int k = 0; k < D; k += 4) {
            const f32x4 hv = *(const LAS f32x4*)(hb + k);
            a0 += hv.x * wr[(size_t)(k + 0) * 64 + lane]; a1 += hv.y * wr[(size_t)(k + 1) * 64 + lane];
            a2 += hv.z * wr[(size_t)(k + 2) * 64 + lane]; a3 += hv.w * wr[(size_t)(k + 3) * 64 + lane];
        }
        const float logit = (a0 + a1) + (a2 + a3);
        const float score = 1.f / (1.f + expf(-logit));
        const float sel = score + rbias[lane];
        float m1 = sel;
        m1 = fmaxf(m1, __shfl_xor(m1, 1)); m1 = fmaxf(m1, __shfl_xor(m1, 2)); m1 = fmaxf(m1, __shfl_xor(m1, 4));
        const unsigned long long eqm = __ballot(sel == m1);
        const int gbase = lane & ~7;
        const unsigned grp_eq = (unsigned)((eqm >> gbase) & 0xffull);
        const int first = __builtin_ctz(grp_eq);
        float m2 = ((lane & 7) == first) ? -3e38f : sel;
        m2 = fmaxf(m2, __shfl_xor(m2, 1)); m2 = fmaxf(m2, __shfl_xor(m2, 2)); m2 = fmaxf(m2, __shfl_xor(m2, 4));
        const float gs = m1 + m2;
        int grank = 0; const int mygrp = lane >> 3;
#pragma unroll
        for (int g2 = 0; g2 < 8; ++g2) { const float o = __shfl(gs, g2 * 8); grank += (o > gs || (o == gs && g2 < mygrp)) ? 1 : 0; }
        const float msel = (grank < 4) ? sel : -1e30f;
        int rank = 0;
        for (int e2 = 0; e2 < 64; ++e2) { const float o = __shfl(msel, e2); rank += (o > msel || (o == msel && e2 < lane)) ? 1 : 0; }
        const bool chosen = rank < TOPK;
        const float gsum = wave_sum(chosen ? score : 0.f);
        if (chosen) { idx[(size_t)m * 8 + rank] = lane; gate[(size_t)m * 8 + rank] = score / gsum * 2.5f;
            __hip_atomic_fetch_add(counts + lane, 1u, __ATOMIC_RELAXED, __HIP_MEMORY_SCOPE_AGENT); }
    }
}
__device__ __forceinline__ void slot_phase(const Ctx& c, const int* idx, const unsigned* counts, unsigned* cursor, unsigned* nrt_out, int* pos, int* slot_tok, int* tile_exp) {
    LAS int* ps = (LAS int*)c.lds;
    if (c.tid == 0) { int acc = 0; for (int e = 0; e < NE; ++e) { const int cn = (int)counts[e]; ps[e] = acc; ps[64 + e] = cn; acc += (cn + 255) / 256 * 256; } ps[128] = acc; }
    __syncthreads();
    for (int a = gtid_now(); a < M * TOPK; a += c.gsz) {
        const int e = idx[a]; const unsigned r = __hip_atomic_fetch_add(cursor + e, 1u, __ATOMIC_RELAXED, __HIP_MEMORY_SCOPE_AGENT);
        const int slot = ps[e] + (int)r; slot_tok[slot] = a >> 3; pos[a] = slot;
    }
    for (int t = gtid_now(); t < M; t += c.gsz) slot_tok[CAPR + t] = t;
    if (blockIdx.x == 0) {
        if (c.tid < NE) { const int e = c.tid, s0 = ps[e], cn = ps[64 + e], pe = s0 + (cn + 255) / 256 * 256;
            for (int s = s0 + cn; s < pe; ++s) slot_tok[s] = 0;
            for (int tt = s0 / 256; tt < pe / 256; ++tt) tile_exp[tt] = e; }
        if (c.tid == 0) *nrt_out = (unsigned)(ps[128] / 256);
    }
    __syncthreads();
}
__device__ __forceinline__ void moe_up_phase(const Ctx& c, const bf16* HF, const bf16* Wup_l  , const int* slot_tok, const int* tile_exp, const unsigned* nrt_p, bf16* ACT) {
    const int nrt = (int)*nrt_p, ntiles = nrt + M / 256, units = ntiles * (ED / 64);
    for (int u = blockIdx.x; u < units; u += gridDim.x) {
        const int mt = u / (ED / 64), nt = u % (ED / 64), n0 = nt * 64;
        const int e = mt < nrt ? tile_exp[mt] : NE; const int slot0 = (mt < nrt ? mt * 256 : CAPR + (mt - nrt) * 256) + c.wave * 32;
        const int r = c.lane & 15;
        const bf16* a0 = HF + (size_t)slot_tok[slot0 + r] * D; const bf16* a1 = HF + (size_t)slot_tok[slot0 + 16 + r] * D;
        const bf16* W = Wup_l + (size_t)e * UPN * D;
        f32x4 ag[2][4], au[2][4]; ZERO_ACC(ag); ZERO_ACC(au);
        wave_gemm_32x64(a0, a1, W + (size_t)(n0 + r) * D, D, c.lane, ag);
        wave_gemm_32x64(a0, a1, W + (size_t)(ED + n0 + r) * D, D, c.lane, au);
#pragma unroll
        for (int mi = 0; mi < 2; ++mi)
#pragma unroll
            for (int n = 0; n < 4; ++n)
#pragma unroll
                for (int j = 0; j < 4; ++j) ACT[(size_t)(slot0 + 16 * mi + 4 * (c.lane >> 4) + j) * ED + n0 + 16 * n + r] = (bf16)f2bf(siluf(ag[mi][n][j]) * au[mi][n][j]);
    }
}
__device__ __forceinline__ void moe_down_phase(const Ctx& c, const bf16* ACT, const bf16* Wdn_l  , const int* tile_exp, const unsigned* nrt_p, bf16* Y) {
    const int nrt = (int)*nrt_p, ntiles = nrt + M / 256, units = ntiles * (D / 64);
    for (int u = blockIdx.x; u < units; u += gridDim.x) {
        const int mt = u / (D / 64), nt = u % (D / 64), n0 = nt * 64;
        const int e = mt < nrt ? tile_exp[mt] : NE; const int slot0 = (mt < nrt ? mt * 256 : CAPR + (mt - nrt) * 256) + c.wave * 32;
        const int r = c.lane & 15;
        const bf16* W = Wdn_l + (size_t)e * D * ED;
        f32x4 acc[2][4]; ZERO_ACC(acc);
        wave_gemm_32x64(ACT + (size_t)(slot0 + r) * ED, ACT + (size_t)(slot0 + 16 + r) * ED, W + (size_t)(n0 + r) * ED, ED, c.lane, acc);
#pragma unroll
        for (int mi = 0; mi < 2; ++mi)
#pragma unroll
            for (int n = 0; n < 4; ++n)
#pragma unroll
                for (int j = 0; j < 4; ++j) Y[(size_t)(slot0 + 16 * mi + 4 * (c.lane >> 4) + j) * D + n0 + 16 * n + r] = (bf16)f2bf(acc[mi][n][j]);
    }
}
__device__ __forceinline__ void add_row_bf16(f32x4 (&acc)[8], const bf16* yrow, float w, int lane) {
#pragma unroll
    for (int j = 0; j < 8; ++j) { const u32x2 v = *(const u32x2*)(yrow + 4 * lane + 256 * j);
        acc[j].x += w * bf2f(v.x & 0xffffu); acc[j].y += w * bf2f(v.x >> 16); acc[j].z += w * bf2f(v.y & 0xffffu); acc[j].w += w * bf2f(v.y >> 16); }
}
__device__ __forceinline__ void add_row_fp8(f32x4 (&acc)[8], const unsigned char* yrow, float w, int lane) {
#pragma unroll
    for (int j = 0; j < 8; ++j) { const unsigned v = *(const unsigned*)(yrow + 4 * lane + 256 * j);
        acc[j].x += w * __builtin_amdgcn_cvt_f32_fp8(v, 0); acc[j].y += w * __builtin_amdgcn_cvt_f32_fp8(v, 1); acc[j].z += w * __builtin_amdgcn_cvt_f32_fp8(v, 2); acc[j].w += w * __builtin_amdgcn_cvt_f32_fp8(v, 3); }
}
template <bool NEXT>
__device__ __forceinline__ void combine_phase(const Ctx& c, const float* x1, const bf16* Y, const int* pos, const float* gate, const float* ada_l, float* xo,
                                              const float* gnext, const float* ada_next, bf16* XN) {
    for (int m = c.gw; m < M; m += c.ngw) {
        const int b = m / T; f32x4 acc[8];
#pragma unroll
        for (int j = 0; j < 8; ++j) acc[j] = (f32x4){0.f, 0.f, 0.f, 0.f};
#if USE_FP8_MOE && Y_FP8
        for (int k = 0; k < TOPK; ++k) add_row_fp8(acc, (const unsigned char*)Y + (size_t)pos[(size_t)m * 8 + k] * D, gate[(size_t)m * 8 + k] * (1.f / F8_YSCALE), c.lane);
        add_row_fp8(acc, (const unsigned char*)Y + (size_t)(CAPR + m) * D, 1.f / F8_YSCALE, c.lane);
#else
        for (int k = 0; k < TOPK; ++k) add_row_bf16(acc, Y + (size_t)pos[(size_t)m * 8 + k] * D, gate[(size_t)m * 8 + k], c.lane);
        add_row_bf16(acc, Y + (size_t)(CAPR + m) * D, 1.f, c.lane);
#endif
        const float* gf = ada_l + (size_t)b * 6 * D + 5 * D;
        f32x4 v[8];
#pragma unroll
        for (int j = 0; j < 8; ++j) { const int col = 4 * c.lane + 256 * j;
#if RES_BF16
            { const u32x2 xw = *(const u32x2*)((const bf16*)x1 + (size_t)m * D + col);
              v[j] = (f32x4){bf2f(xw.x & 0xffffu), bf2f(xw.x >> 16), bf2f(xw.y & 0xffffu), bf2f(xw.y >> 16)} + *(const f32x4*)(gf + col) * acc[j]; }
            if (NEXT) { u32x2 ow; ow.x = pk2(v[j].x, v[j].y); ow.y = pk2(v[j].z, v[j].w); *(u32x2*)((bf16*)xo + (size_t)m * D + col) = ow; }
            else *(f32x4*)(xo + (size_t)m * D + col) = v[j];
#else
            v[j] = *(const f32x4*)(x1 + (size_t)m * D + col) + *(const f32x4*)(gf + col) * acc[j];
            *(f32x4*)(xo + (size_t)m * D + col) = v[j];
#endif
            }
        if (NEXT) {
            const float rstd = row_rstd(v);
            modulate_row(v, rstd, gnext, ada_next + (size_t)b * 6 * D, ada_next + (size_t)b * 6 * D + D, c.lane);
#if USE_FP8_QKV
            store_row_fp8((unsigned char*)XN + (size_t)m * D, v, c.lane, F8_HSCALE);
#else
            store_row_bf16(XN + (size_t)m * D, v, c.lane);
#endif
        }
    }
}


namespace pg8 {
constexpr int BM = 256, BK = 64, HALF = 128, HTB = HALF * BK * 2, STAGE_BYTES = 8 * HTB, NXCD = 8, WGM = 8;
__device__ __forceinline__ int lds_byte(int r, int c) { const int st = (r >> 4) * 2 + (c >> 5), rr = r & 15, cc = c & 31, ob = rr * 64 + cc * 2; return st * 1024 + (ob ^ (((ob >> 9) & 1) << 5)); }
__device__ __forceinline__ void stage_rc(int b, int& R, int& C) { const int st = b / 1024, sb = b % 1024, swz = sb ^ (((sb >> 9) & 1) << 5); R = (st >> 1) * 16 + swz / 64; C = (st & 1) * 32 + (swz % 64) / 2; }
__device__ __forceinline__ int perm32(int rho) { const int n = rho >> 4, i = rho & 15; return 8 * (i >> 2) + 4 * n + (i & 3); }
__device__ __forceinline__ unsigned cvt_pk_bf16(float lo, float hi) { unsigned r; asm volatile("v_cvt_pk_bf16_f32 %0, %1, %2" : "=v"(r) : "v"(lo), "v"(hi)); return r; }

struct Unit { int row0, pn; const char* Bp; };

struct TileOrder {
    int nM, nN, nwg, G, c;
    __device__ __forceinline__ void init(int nM_, int nN_, int G_, int c_) { nM = nM_; nN = nN_; nwg = nM * nN; G = G_; c = c_; }
    __device__ __forceinline__ bool tile(int i, int& pm, int& pn) const {
        const long L = (long)i * G + c; if (L >= nwg) return false;
        int wgid = (int)L; { const int q = nwg / NXCD, r = nwg % NXCD, xcd = wgid % NXCD, off = wgid / NXCD; wgid = (xcd < r ? xcd * (q + 1) : r * (q + 1) + (xcd - r) * q) + off; }
        const int nig = WGM * nN, gid = wgid / nig, fm = gid * WGM, gsz = (nM - fm) < WGM ? (nM - fm) : WGM;
        pm = fm + ((wgid % nig) % gsz); pn = (wgid % nig) / gsz; return true;
    }
};
struct PlainSched {
    static constexpr bool GATHER = false;
    TileOrder o; const char* Bt; int K;
    __device__ __forceinline__ bool next(int i, Unit& u) const { int pm, pn; if (!o.tile(i, pm, pn)) return false; u.row0 = pm * BM; u.pn = pn; u.Bp = Bt + (size_t)pn * BM * K * 2; return true; }
    __device__ __forceinline__ unsigned arow_off(const Unit& u, int rl) const { return (unsigned)(u.row0 + rl) * (unsigned)(K * 2); }
};
template <bool GATHER_> struct GroupSched {
    static constexpr bool GATHER = GATHER_;
    TileOrder o; const char* W; size_t wstride; int K, nrt; const LAS int* tile_exp; const int* slot_tok;
    __device__ __forceinline__ bool next(int i, Unit& u) const { int pm, pn; if (!o.tile(i, pm, pn)) return false;
        const int e = pm < nrt ? tile_exp[pm] : NE; u.row0 = pm < nrt ? pm * BM : CAPR + (pm - nrt) * BM; u.pn = pn; u.Bp = W + (size_t)e * wstride + (size_t)pn * BM * K * 2; return true; }
    __device__ __forceinline__ unsigned arow_off(const Unit& u, int rl) const { const int r = GATHER ? slot_tok[u.row0 + rl] : (u.row0 + rl); return (unsigned)r * (unsigned)(K * 2); }
};

template <int LAYER> struct EpiQKV {
    static constexpr bool PERM = true;
    bf16* O; int ldc; const float* gains; float qscale, ascale;
    __device__ __forceinline__ void operator()(const f32x4 (&acc)[2][2][4][2], const Unit& u, int wr, int wc, int fr, int fq) const {
        const int head = 4 * u.pn + wc; int gi;
        if (LAYER == 0) gi = head < 16 ? 0 : head < 32 ? 1 : head < 48 ? -1 : head < 64 ? 2 : head < 66 ? 3 : -1;
        else gi = head < 32 ? 0 : head < 64 ? 1 : -1;
        f32x4 gv[2][2];
#pragma unroll
        for (int bj = 0; bj < 2; ++bj)
#pragma unroll
            for (int n = 0; n < 2; ++n) gv[bj][n] = gi >= 0 ? *(const f32x4*)(gains + 64 * gi + 32 * bj + 8 * fq + 4 * n) : (f32x4){1.f, 1.f, 1.f, 1.f};
#if QKV_HEADMAJOR
        bf16* base = O + ((size_t)head * M + (size_t)(u.row0 + wr * 64 + fr)) * 64 + 8 * fq; const int ldo = 64;
#else
        bf16* base = O + (size_t)(u.row0 + wr * 64 + fr) * ldc + 64 * head + 8 * fq; const int ldo = ldc;
#endif
#pragma unroll
        for (int ai = 0; ai < 2; ++ai)
#pragma unroll
            for (int m = 0; m < 4; ++m) {
                float ss = 0.f;
#pragma unroll
                for (int bj = 0; bj < 2; ++bj)
#pragma unroll
                    for (int n = 0; n < 2; ++n) { const f32x4 x = acc[ai][bj][m][n]; ss += (x[0] * x[0] + x[1] * x[1]) + (x[2] * x[2] + x[3] * x[3]); }
                ss += __shfl_xor(ss, 16); ss += __shfl_xor(ss, 32); ss *= ascale * ascale;
                const bool isq = LAYER == 0 ? (gi == 0 || gi == 2) : (gi == 0);
                const float rs = ascale * (gi >= 0 ? (isq ? qscale : 1.f) / sqrtf(ss * (1.f / 64.f) + RMS_EPS) : 1.f);
                bf16* rowp = base + (size_t)(ai * HALF + m * 16) * ldo;
#pragma unroll
                for (int bj = 0; bj < 2; ++bj) { const f32x4 v0 = acc[ai][bj][m][0] * rs * gv[bj][0], v1 = acc[ai][bj][m][1] * rs * gv[bj][1];
                    u32x4 w; w.x = cvt_pk_bf16(v0[0], v0[1]); w.y = cvt_pk_bf16(v0[2], v0[3]); w.z = cvt_pk_bf16(v1[0], v1[1]); w.w = cvt_pk_bf16(v1[2], v1[3]);
                    *(u32x4*)(rowp + 32 * bj) = w; }
            }
    }
};
struct EpiOut {
    static constexpr bool PERM = false;
    const float* xin; const float* gm; float* X1;
    __device__ __forceinline__ void operator()(const f32x4 (&acc)[2][2][4][2], const Unit& u, int wr, int wc, int fr, int fq) const {
        const int col0 = u.pn * BM + wc * 32 + 4 * fq; const float* g = gm + (size_t)(u.row0 / T) * 6 * D + col0;
        f32x4 gv[2][2];
#pragma unroll
        for (int bj = 0; bj < 2; ++bj)
#pragma unroll
            for (int n = 0; n < 2; ++n) gv[bj][n] = *(const f32x4*)(g + bj * HALF + n * 16);
#pragma unroll
        for (int ai = 0; ai < 2; ++ai)
#pragma unroll
            for (int m = 0; m < 4; ++m) { const size_t off = (size_t)(u.row0 + wr * 64 + fr + ai * HALF + m * 16) * D + col0;
#pragma unroll
                for (int bj = 0; bj < 2; ++bj)
#pragma unroll
                    for (int n = 0; n < 2; ++n) *(f32x4*)(X1 + off + bj * HALF + n * 16) = *(const f32x4*)(xin + off + bj * HALF + n * 16) + gv[bj][n] * acc[ai][bj][m][n]; }
    }
};

template <bool XIN_BF16> struct EpiOutB {
    static constexpr bool PERM = true;
    const void* xin; const float* gm; bf16* X1b;
    __device__ __forceinline__ void operator()(const f32x4 (&acc)[2][2][4][2], const Unit& u, int wr, int wc, int fr, int fq) const {
        const int col0 = u.pn * BM + wc * 32 + 8 * fq; const float* g = gm + (size_t)(u.row0 / T) * 6 * D + col0;
        f32x4 gv[2][2];
#pragma unroll
        for (int bj = 0; bj < 2; ++bj)
#pragma unroll
            for (int n = 0; n < 2; ++n) gv[bj][n] = *(const f32x4*)(g + bj * HALF + 4 * n);
#pragma unroll
        for (int ai = 0; ai < 2; ++ai)
#pragma unroll
            for (int m = 0; m < 4; ++m) { const size_t off = (size_t)(u.row0 + wr * 64 + fr + ai * HALF + m * 16) * D + col0;
#pragma unroll
                for (int bj = 0; bj < 2; ++bj) { f32x4 x0, x1v;
                    if (XIN_BF16) { const u32x4 xw = *(const u32x4*)((const bf16*)xin + off + bj * HALF);
                        x0 = (f32x4){bf2f(xw.x & 0xffffu), bf2f(xw.x >> 16), bf2f(xw.y & 0xffffu), bf2f(xw.y >> 16)}; x1v = (f32x4){bf2f(xw.z & 0xffffu), bf2f(xw.z >> 16), bf2f(xw.w & 0xffffu), bf2f(xw.w >> 16)}; }
                    else { x0 = *(const f32x4*)((const float*)xin + off + bj * HALF); x1v = *(const f32x4*)((const float*)xin + off + bj * HALF + 4); }
                    const f32x4 v0 = x0 + gv[bj][0] * acc[ai][bj][m][0], v1 = x1v + gv[bj][1] * acc[ai][bj][m][1];
                    u32x4 w; w.x = cvt_pk_bf16(v0[0], v0[1]); w.y = cvt_pk_bf16(v0[2], v0[3]); w.z = cvt_pk_bf16(v1[0], v1[1]); w.w = cvt_pk_bf16(v1[2], v1[3]);
                    *(u32x4*)(X1b + off + bj * HALF) = w; } }
    }
};
__device__ __forceinline__ float silu_fast(float x) { return x * __builtin_amdgcn_rcpf(1.f + __builtin_amdgcn_exp2f(-1.4426950408889634f * x)); }
struct EpiUp {
    static constexpr bool PERM = true;
    bf16* ACT;
    __device__ __forceinline__ void operator()(const f32x4 (&acc)[2][2][4][2], const Unit& u, int wr, int wc, int fr, int fq) const {
        bf16* base = ACT + (size_t)(u.row0 + wr * 64 + fr) * ED + 128 * u.pn + 32 * wc + 8 * fq;
#pragma unroll
        for (int ai = 0; ai < 2; ++ai)
#pragma unroll
            for (int m = 0; m < 4; ++m) { f32x4 v[2];
#pragma unroll
                for (int n = 0; n < 2; ++n)
#pragma unroll
                    for (int i = 0; i < 4; ++i) v[n][i] = silu_fast(acc[ai][0][m][n][i]) * acc[ai][1][m][n][i];
                u32x4 w; w.x = cvt_pk_bf16(v[0][0], v[0][1]); w.y = cvt_pk_bf16(v[0][2], v[0][3]); w.z = cvt_pk_bf16(v[1][0], v[1][1]); w.w = cvt_pk_bf16(v[1][2], v[1][3]);
                *(u32x4*)(base + (size_t)(ai * HALF + m * 16) * ED) = w; }
    }
};
struct EpiDown {
    static constexpr bool PERM = true;
    bf16* Y; int orow = 0;
    __device__ __forceinline__ void operator()(const f32x4 (&acc)[2][2][4][2], const Unit& u, int wr, int wc, int fr, int fq) const {
        bf16* base = Y + (size_t)(orow + u.row0 + wr * 64 + fr) * D + u.pn * BM + wc * 32 + 8 * fq;
#pragma unroll
        for (int ai = 0; ai < 2; ++ai)
#pragma unroll
            for (int m = 0; m < 4; ++m) { bf16* rowp = base + (size_t)(ai * HALF + m * 16) * D;
#pragma unroll
                for (int bj = 0; bj < 2; ++bj) { const f32x4 v0 = acc[ai][bj][m][0], v1 = acc[ai][bj][m][1];
                    u32x4 w; w.x = cvt_pk_bf16(v0[0], v0[1]); w.y = cvt_pk_bf16(v0[2], v0[3]); w.z = cvt_pk_bf16(v1[0], v1[1]); w.w = cvt_pk_bf16(v1[2], v1[3]);
                    *(u32x4*)(rowp + bj * HALF) = w; } }
    }
};


struct EpiUp8 {
    static constexpr bool PERM = true;
    unsigned char* ACT8;
    __device__ __forceinline__ void operator()(const f32x4 (&acc)[2][2][4][2], const Unit& u, int wr, int wc, int fr, int fq) const {
        unsigned char* base = ACT8 + (size_t)(u.row0 + wr * 64 + fr) * ED + 128 * u.pn + 32 * wc + 8 * fq;
        constexpr float s = 1.f / (F8_HSCALE * F8_WSCALE);
#pragma unroll
        for (int ai = 0; ai < 2; ++ai)
#pragma unroll
            for (int m = 0; m < 4; ++m) { f32x4 v[2];
#pragma unroll
                for (int n = 0; n < 2; ++n)
#pragma unroll
                    for (int i = 0; i < 4; ++i) v[n][i] = silu_fast(acc[ai][0][m][n][i] * s) * (acc[ai][1][m][n][i] * (s * F8_ASCALE));
                u32x2 w; w.x = pk4_fp8(v[0][0], v[0][1], v[0][2], v[0][3]); w.y = pk4_fp8(v[1][0], v[1][1], v[1][2], v[1][3]);
                *(u32x2*)(base + (size_t)(ai * HALF + m * 16) * ED) = w; }
    }
};
struct EpiDown8 {
    static constexpr bool PERM = true;
    bf16* Y;
    __device__ __forceinline__ void operator()(const f32x4 (&acc)[2][2][4][2], const Unit& u, int wr, int wc, int fr, int fq) const {
#if Y_FP8
        unsigned char* base = (unsigned char*)Y + (size_t)(u.row0 + wr * 64 + fr) * D + u.pn * BM + wc * 64 + 16 * fq;
        constexpr float s = F8_YSCALE / (F8_ASCALE * F8_WSCALE);
#pragma unroll
        for (int ai = 0; ai < 2; ++ai)
#pragma unroll
            for (int m = 0; m < 4; ++m) { unsigned char* rowp = base + (size_t)(ai * HALF + m * 16) * D; u32x4 w;
#pragma unroll
                for (int bj = 0; bj < 2; ++bj) { const f32x4 v0 = acc[ai][bj][m][0] * s, v1 = acc[ai][bj][m][1] * s;
                    w[2 * bj] = pk4_fp8(v0[0], v0[1], v0[2], v0[3]); w[2 * bj + 1] = pk4_fp8(v1[0], v1[1], v1[2], v1[3]); }
                *(u32x4*)rowp = w; }
#else
        bf16* base = Y + (size_t)(u.row0 + wr * 64 + fr) * D + u.pn * BM + wc * 32 + 8 * fq;
        constexpr float s = 1.f / (F8_ASCALE * F8_WSCALE);
#pragma unroll
        for (int ai = 0; ai < 2; ++ai)
#pragma unroll
            for (int m = 0; m < 4; ++m) { bf16* rowp = base + (size_t)(ai * HALF + m * 16) * D;
#pragma unroll
                for (int bj = 0; bj < 2; ++bj) { const f32x4 v0 = acc[ai][bj][m][0] * s, v1 = acc[ai][bj][m][1] * s;
                    u32x4 w; w.x = cvt_pk_bf16(v0[0], v0[1]); w.y = cvt_pk_bf16(v0[2], v0[3]); w.z = cvt_pk_bf16(v1[0], v1[1]); w.w = cvt_pk_bf16(v1[2], v1[3]);
                    *(u32x4*)(rowp + bj * HALF) = w; } }
#endif
    }
};
__device__ __forceinline__ void glds16s(const void* sbase, unsigned voff, unsigned lds_dst) { unsigned keep;
    asm volatile("s_mov_b32 %0, m0\n\ts_mov_b32 m0, %3\n\ts_nop 0\n\tglobal_load_lds_dwordx4 %1, %2\n\ts_mov_b32 m0, %0" : "=&s"(keep) : "v"(voff), "s"(sbase), "s"(lds_dst) : "memory"); }
__device__ __forceinline__ void glds4s(const void* sbase, unsigned voff, unsigned lds_dst) { unsigned keep;
    asm volatile("s_mov_b32 %0, m0\n\ts_mov_b32 m0, %3\n\ts_nop 0\n\tglobal_load_lds_dword %1, %2\n\ts_mov_b32 m0, %0" : "=&s"(keep) : "v"(voff), "s"(sbase), "s"(lds_dst) : "memory"); }
typedef int i32x4 __attribute__((ext_vector_type(4)));
typedef int i32x8 __attribute__((ext_vector_type(8)));
__device__ __forceinline__ i32x8 cat8(bf16x8 a, bf16x8 b) { return __builtin_shufflevector(__builtin_bit_cast(i32x4, a), __builtin_bit_cast(i32x4, b), 0, 1, 2, 3, 4, 5, 6, 7); }
__device__ __forceinline__ void mfma8_inplace(f32x4& acc, i32x8 a, i32x8 b) { asm volatile("v_mfma_f32_16x16x128_f8f6f4 %0, %1, %2, %0" : "+v"(acc) : "v"(a), "v"(b)); }
template <class Epi, class Sched, bool FP8 = false>
__device__ __forceinline__ void gemm_phase(LAS unsigned char* lds, const char* Abase, const int K, const Sched& S, const Epi& E) {
    constexpr bool GATHER = Sched::GATHER;
    const int tid = threadIdx.x, wid = __builtin_amdgcn_readfirstlane(tid >> 6), lane = tid & 63, wr = wid >> 2, wc = wid & 3, fr = lane & 15, fq = lane >> 4;
    int nt = K / BK; asm volatile("" : "+s"(nt));
    int RA[2]; unsigned CA[2], voffB[2], vC[2];
#pragma unroll
    for (int i = 0; i < 2; ++i) { int R, C; stage_rc(tid * 16 + i * 8192, R, C); const int Rb = Epi::PERM ? ((R & ~31) + perm32(R & 31)) : R;
        RA[i] = R; CA[i] = (unsigned)C * 2u; voffB[i] = (unsigned)(Rb * K + C) * 2u; vC[i] = (unsigned)(R * K + C) * 2u; }
    const size_t kstep = (size_t)(BK * 2);
    const size_t hstep = (size_t)HALF * K * 2;
    const size_t ahstep = GATHER ? 0 : hstep;
    const unsigned ldsw = (unsigned)wid * 1024u;
    const unsigned lds0 = (unsigned)(uintptr_t)lds;
    const int aoff = lds_byte(wr * 64 + fr, fq * 8), boff = lds_byte(wc * 32 + fr, fq * 8);
#define PG8_SA(b, h) (((b) * 2 + (h)) * HTB)
#define PG8_SB(b, h) ((4 + (b) * 2 + (h)) * HTB)
#define PG8_STAGE(bufoff, gbase, voff) do { _Pragma("unroll") for (int _i = 0; _i < 2; ++_i) \
        glds16s((const void*)(gbase), (voff)[_i], (unsigned)__builtin_amdgcn_readfirstlane((int)(lds0 + (unsigned)(bufoff) + ldsw + (unsigned)(_i * 8192)))); } while (0)
#define PG8_STAGE_A(bufoff, gbase, h) do { if constexpr (GATHER) { PG8_STAGE(bufoff, gbase, vA[h]); } else { PG8_STAGE(bufoff, (gbase) + (h) * ahstep, vC); } } while (0)
#define PG8_LDA(dst, b, h) do { _Pragma("unroll") for (int m = 0; m < 4; ++m) _Pragma("unroll") for (int k = 0; k < 2; ++k) dst[m][k] = *(const LAS bf16x8*)(lds + PG8_SA(b, h) + aoff + m * 2048 + k * 1024); } while (0)
#define PG8_LDB(dst, b, h) do { _Pragma("unroll") for (int n = 0; n < 2; ++n) _Pragma("unroll") for (int k = 0; k < 2; ++k) dst[n][k] = *(const LAS bf16x8*)(lds + PG8_SB(b, h) + boff + n * 2048 + k * 1024); } while (0)
#define PG8_MMA(ai, bj, At, Bt) do { __builtin_amdgcn_s_setprio(1); if constexpr (FP8) { _Pragma("unroll") for (int m = 0; m < 4; ++m) _Pragma("unroll") for (int n = 0; n < 2; ++n) \
        mfma8_inplace(acc[ai][bj][m][n], cat8(Bt[n][0], Bt[n][1]), cat8(At[m][0], At[m][1])); } else { \
        _Pragma("unroll") for (int m = 0; m < 4; ++m) _Pragma("unroll") for (int n = 0; n < 2; ++n) _Pragma("unroll") for (int k = 0; k < 2; ++k) \
        acc[ai][bj][m][n] = __builtin_amdgcn_mfma_f32_16x16x32_bf16(Bt[n][k], At[m][k], acc[ai][bj][m][n], 0, 0, 0); } __builtin_amdgcn_s_setprio(0); } while (0)
#define PG8_WAIT_V(n) asm volatile("s_waitcnt vmcnt(" #n ")" ::: "memory")
#define PG8_WAIT_L(n) asm volatile("s_waitcnt lgkmcnt(0)" ::: "memory")
#define PG8_BAR __builtin_amdgcn_s_barrier()
#define PG8_SCHED __builtin_amdgcn_sched_barrier(0)
#define PG8_SETOFF(vo, u) do { _Pragma("unroll") for (int _h = 0; _h < 2; ++_h) _Pragma("unroll") for (int _i = 0; _i < 2; ++_i) vo[_h][_i] = S.arow_off(u, _h * HALF + RA[_i]) + CA[_i]; } while (0)
    Unit cur, nxt; int ui = 0;
    if (!S.next(0, cur)) return;
    f32x4 acc[2][2][4][2];
#pragma unroll
    for (int a = 0; a < 2; ++a)
#pragma unroll
        for (int b = 0; b < 2; ++b)
#pragma unroll
            for (int m = 0; m < 4; ++m)
#pragma unroll
                for (int n = 0; n < 2; ++n) acc[a][b][m][n] = (f32x4){0.f, 0.f, 0.f, 0.f};
    bf16x8 At[4][2], B0[2][2], B1[2][2];
    unsigned vA[2][2];
    LAS int* gidx = (LAS int*)(lds + STAGE_BYTES);
#define PG8_IDX_DMA(u) do { if (wid < 4) glds4s((const void*)(S.slot_tok + (u).row0), (unsigned)((wid * 64 + lane) * 4), (unsigned)__builtin_amdgcn_readfirstlane((int)(lds0 + (unsigned)STAGE_BYTES + (unsigned)wid * 256u))); } while (0)
#define PG8_IDX_READ() do { _Pragma("unroll") for (int _h = 0; _h < 2; ++_h) _Pragma("unroll") for (int _i = 0; _i < 2; ++_i) vA[_h][_i] = (unsigned)gidx[_h * HALF + RA[_i]] * (unsigned)(K * 2) + CA[_i]; } while (0)
    if constexpr (GATHER) { PG8_IDX_DMA(cur); asm volatile("s_waitcnt vmcnt(0)" ::: "memory"); __builtin_amdgcn_s_barrier(); asm volatile("" ::: "memory"); PG8_IDX_READ();
        asm volatile("s_waitcnt lgkmcnt(0)" ::: "memory"); __builtin_amdgcn_s_barrier(); asm volatile("" ::: "memory"); }
    const char* cA = GATHER ? Abase : Abase + (size_t)cur.row0 * K * 2;
    const char* cB = cur.Bp;
    PG8_STAGE(PG8_SB(0, 0), cB, voffB); PG8_STAGE(PG8_SB(0, 1), cB + hstep, voffB); PG8_STAGE_A(PG8_SA(0, 0), cA, 0); PG8_STAGE_A(PG8_SA(0, 1), cA, 1);
    if (wr == 1) PG8_BAR;
    PG8_WAIT_V(2); PG8_BAR;
    PG8_STAGE(PG8_SB(1, 0), cB + kstep, voffB); PG8_STAGE_A(PG8_SA(1, 0), cA + kstep, 0); PG8_STAGE(PG8_SB(1, 1), cB + hstep + kstep, voffB);
    PG8_WAIT_V(6); PG8_BAR;
    for (;;) {
        const bool has_next = S.next(ui + 1, nxt);
        if constexpr (GATHER) { if (has_next) PG8_IDX_DMA(nxt); }
        const char* nA = GATHER ? Abase : (has_next ? Abase + (size_t)nxt.row0 * K * 2 : cA);
        const char* nB = has_next ? nxt.Bp : cB;
#pragma unroll 1
        for (int t = 0; t < nt; t += 2) {
            const bool last = (t == nt - 2);
            const char* a1 = cA + (size_t)(t + 1) * kstep;
            const char* a2 = last ? nA : cA + (size_t)(t + 2) * kstep; const char* b2 = last ? nB : cB + (size_t)(t + 2) * kstep;
            const char* a3 = a2 + kstep; const char* b3 = b2 + kstep;
            PG8_LDB(B0, 0, 0); PG8_LDB(B1, 0, 1); PG8_SCHED; PG8_LDA(At, 0, 0); PG8_STAGE_A(PG8_SA(1, 1), a1, 1);
            if constexpr (GATHER) { if (last && has_next) PG8_IDX_READ(); }
            PG8_WAIT_V(8); PG8_WAIT_L(0); PG8_BAR; PG8_MMA(0, 0, At, B0); PG8_MMA(0, 1, At, B1); PG8_BAR; PG8_SCHED;
            PG8_LDA(At, 0, 1); PG8_STAGE(PG8_SB(0, 0), b2, voffB); PG8_STAGE(PG8_SB(0, 1), b2 + hstep, voffB); PG8_STAGE_A(PG8_SA(0, 0), a2, 0);
            PG8_WAIT_V(8); PG8_WAIT_L(0); PG8_BAR; PG8_MMA(1, 0, At, B0); PG8_MMA(1, 1, At, B1); PG8_BAR; PG8_SCHED;
            PG8_LDB(B0, 1, 0); PG8_LDB(B1, 1, 1); PG8_SCHED; PG8_LDA(At, 1, 0); PG8_STAGE_A(PG8_SA(0, 1), a2, 1);
            PG8_WAIT_V(8); PG8_WAIT_L(0); PG8_BAR; PG8_MMA(0, 0, At, B0); PG8_MMA(0, 1, At, B1); PG8_BAR; PG8_SCHED;
            PG8_LDA(At, 1, 1); PG8_STAGE(PG8_SB(1, 0), b3, voffB); PG8_STAGE(PG8_SB(1, 1), b3 + hstep, voffB); PG8_STAGE_A(PG8_SA(1, 0), a3, 0);
            PG8_WAIT_V(8); PG8_WAIT_L(0); PG8_BAR; PG8_MMA(1, 0, At, B0); PG8_MMA(1, 1, At, B1); PG8_BAR; PG8_SCHED;
        }
        if (wr == 0) PG8_BAR;
        if constexpr (FP8) asm volatile("s_nop 15\n\ts_nop 15" ::: "memory");
        E(acc, cur, wr, wc, fr, fq);
        if (!has_next) break;
#pragma unroll
        for (int a = 0; a < 2; ++a)
#pragma unroll
            for (int b = 0; b < 2; ++b)
#pragma unroll
                for (int m = 0; m < 4; ++m)
#pragma unroll
                    for (int n = 0; n < 2; ++n) acc[a][b][m][n] = (f32x4){0.f, 0.f, 0.f, 0.f};
        cur = nxt; cA = nA; cB = nB; ++ui;
        if (wr == 1) PG8_BAR;
    }
    PG8_WAIT_V(0);
    PG8_BAR;
#undef PG8_SA
#undef PG8_SB
#undef PG8_STAGE
#undef PG8_STAGE_A
#undef PG8_LDA
#undef PG8_LDB
#undef PG8_MMA
#undef PG8_WAIT_V
#undef PG8_WAIT_L
#undef PG8_BAR
#undef PG8_SCHED
#undef PG8_SETOFF
#undef PG8_IDX_DMA
#undef PG8_IDX_READ
}
}

namespace att {
using bf16=unsigned short;
using bf16x8=__attribute__((ext_vector_type(8)))short;
using s16x4=__attribute__((ext_vector_type(4)))short;
using f32x16=__attribute__((ext_vector_type(16)))float;
using u32x4=__attribute__((ext_vector_type(4)))unsigned;
constexpr int NW=8,QBLK=32,QB=QBLK*NW,KVBLK=64;
__device__ __forceinline__ int crow(int r,int hi){return (r&3)+8*(r>>2)+4*hi;}
#define SBAR() __builtin_amdgcn_sched_barrier(0)
constexpr int NSLOT=6, SLOTB=8192;
constexpr int LDS_K=0, LDS_V=NSLOT*SLOTB, LDS_WS=2*NSLOT*SLOTB, LDS_OST=LDS_WS+NW*64*4, LDS_BYTES=LDS_OST+NW*4096;
constexpr float C2=0.125f*1.4426950408889634f;
__device__ __forceinline__ void glds16(const void*sbase,unsigned voff,unsigned lds_dst){unsigned keep;
  asm volatile("s_mov_b32 %0, m0\n\ts_mov_b32 m0, %3\n\ts_nop 0\n\tglobal_load_lds_dwordx4 %1, %2\n\ts_mov_b32 m0, %0":"=&s"(keep):"v"(voff),"s"(sbase),"s"(lds_dst):"memory");}
__device__ __forceinline__ float max3f(float a,float b,float c){float r;asm("v_max3_f32 %0, %1, %2, %3":"=v"(r):"v"(a),"v"(b),"v"(c));return r;}
__device__ __forceinline__ float max2f(float a,float b){float r;asm("v_max_f32_e32 %0, %1, %2":"=v"(r):"v"(a),"v"(b));return r;}
__device__ __forceinline__ float fsub_s(float a,float b){float r;asm("v_sub_f32_e32 %0, %1, %2":"=v"(r):"v"(a),"v"(b));return r;}
typedef float f32x2_t __attribute__((ext_vector_type(2))); typedef __bf16 bf16x2_t __attribute__((ext_vector_type(2)));
__device__ __forceinline__ unsigned cvtpk_s(float lo,float hi){f32x2_t v={lo,hi};bf16x2_t b=__builtin_convertvector(v,bf16x2_t);return __builtin_bit_cast(unsigned,b);}
#define WAIT_BAR(N) asm volatile("s_waitcnt vmcnt(" #N ") lgkmcnt(0)\n\ts_barrier":::"memory")
typedef __attribute__((address_space(3))) const char* lds_cptr;
typedef short v4i16_t __attribute__((ext_vector_type(4)));
__device__ __forceinline__ void kload8(bf16x8*kf,lds_cptr kp,int bo){
  #pragma unroll
  for(int d0=0;d0<4;++d0){ const lds_cptr p=kp+((d0*32)^bo); kf[2*d0]=*(const __attribute__((address_space(3))) bf16x8*)(p); kf[2*d0+1]=*(const __attribute__((address_space(3))) bf16x8*)(p+4096); }
}
__device__ __forceinline__ void kload2(bf16x8*kf,lds_cptr kp,int j,int bo){ const lds_cptr p=kp+((j*32)^bo); kf[2*j]=*(const __attribute__((address_space(3))) bf16x8*)(p); kf[2*j+1]=*(const __attribute__((address_space(3))) bf16x8*)(p+4096); }
__device__ __forceinline__ s16x4 vtr(lds_cptr p){ return __builtin_bit_cast(s16x4,__builtin_amdgcn_ds_read_tr16_b64_v4i16((__attribute__((address_space(3))) v4i16_t*)p)); }
__device__ __forceinline__ float rowmax(const f32x16&p0,const f32x16&p1){
  float a=max3f(p0[0],p0[1],p1[0]),b=max3f(p0[2],p0[3],p1[1]);a=max3f(a,p1[2],p1[3]);
  #pragma unroll
  for(int r=4;r<16;r+=4){a=max3f(a,p0[r],p0[r+1]);b=max3f(b,p0[r+2],p0[r+3]);a=max3f(a,p1[r],p1[r+1]);b=max3f(b,p1[r+2],p1[r+3]);}
  const float m=max2f(a,b);
  auto rr=__builtin_amdgcn_permlane32_swap(__float_as_uint(m),__float_as_uint(m),false,false);
  return max2f(__uint_as_float(rr[0]),__uint_as_float(rr[1]));
}
__device__ __forceinline__ void pv(f32x16*o,int vb,bf16x8 pa0,bf16x8 pa1,bf16x8 pa2,bf16x8 pa3){
  #pragma unroll
  for(int d0=0;d0<2;++d0){s16x4 lo[4],hi[4];
    #pragma unroll
    for(int ks=0;ks<4;++ks){
      asm volatile("ds_read_b64_tr_b16 %0,%1 offset:%c2":"=&v"(lo[ks]):"v"(vb),"i"(d0*4096+ks*1024):"memory");
      asm volatile("ds_read_b64_tr_b16 %0,%1 offset:%c2":"=&v"(hi[ks]):"v"(vb),"i"(d0*4096+ks*1024+512):"memory");}
    asm volatile("s_waitcnt lgkmcnt(0)":::"memory");SBAR();
    #define PK(k) (bf16x8){lo[k][0],lo[k][1],lo[k][2],lo[k][3],hi[k][0],hi[k][1],hi[k][2],hi[k][3]}
    o[d0]=__builtin_amdgcn_mfma_f32_32x32x16_bf16(pa0,PK(0),o[d0],0,0,0);
    o[d0]=__builtin_amdgcn_mfma_f32_32x32x16_bf16(pa1,PK(1),o[d0],0,0,0);
    o[d0]=__builtin_amdgcn_mfma_f32_32x32x16_bf16(pa2,PK(2),o[d0],0,0,0);
    o[d0]=__builtin_amdgcn_mfma_f32_32x32x16_bf16(pa3,PK(3),o[d0],0,0,0);
    #undef PK
  }
}
template<int W> __device__ __forceinline__ void wmask(f32x16&p0,f32x16&p1,int d,float NEG){
  asm volatile("":"+v"(d));
  #pragma unroll
  for(int r=0;r<16;++r){const int c=(r&3)+8*(r>>2);
    if(W==0x7fffffff){ if(d<c)p0[r]=NEG; if(d<c+32)p1[r]=NEG; }
    else{ if((unsigned)(d-c)>(unsigned)W)p0[r]=NEG; if((unsigned)(d-c-32)>(unsigned)W)p1[r]=NEG; } }
}
struct UnitDesc {
  const bf16* Q; long qs;
  const bf16* K; long ks;
  const bf16* V; long vs;
  bf16* O; long os;
  float* lse; long lses;
  int NT;
  int rel0;
  int tg0;
  int q0;
  float slope2;
  float sink2;
};
template<int MODE,int THRL,int DIL,int OS> __device__ __forceinline__ void attn_unit(const UnitDesc&u,char*shm){
  constexpr int W=(MODE==0)?0x7fffffff:(MODE==1?128:127);
  const float NEG=(MODE==0)?-INFINITY:-1024.f;
  int tid=threadIdx.x; asm volatile("":"+v"(tid));
  const int lane=tid&63,r32=lane&31,hi=lane>>5; const int wid=__builtin_amdgcn_readfirstlane(tid>>6);
  constexpr long qs=64L*DIL,ks=64L*DIL,vs=64L*DIL;
  const bf16*Qw=u.Q+(long)(wid*QBLK)*qs;
  const unsigned lds0=(unsigned)(uintptr_t)shm;
  __attribute__((address_space(3))) float*wsf=(__attribute__((address_space(3))) float*)((__attribute__((address_space(3))) char*)shm+LDS_WS)+wid*64;
  const unsigned ksoff=(unsigned)(((long)(8*wid+(lane>>3))*ks+(((lane&7)^(lane>>3))*8))*2);
  const unsigned vsoff=(unsigned)(((long)(16*(wid&3)+(lane>>2))*vs+(wid>>2)*32+(lane&3)*8)*2);
  const unsigned kdst=lds0+LDS_K+wid*1024, vdst=lds0+LDS_V+wid*1024;
  #define DMA_K(t,slot) glds16(u.K+(long)(t)*KVBLK*ks,ksoff,(unsigned)__builtin_amdgcn_readfirstlane(kdst+(slot)))
  #define DMA_V(t,slot) glds16(u.V+(long)(t)*KVBLK*vs,vsoff,(unsigned)__builtin_amdgcn_readfirstlane(vdst+(slot)))
  bf16x8 kf[8];
  const lds_cptr shm3=(lds_cptr)shm; const lds_cptr kp0=shm3+LDS_K+r32*128+((hi^(r32&1))*16); const int kbo=((r32>>1)&3)<<5; const lds_cptr vp0=shm3+LDS_V+((lane>>4)&1)*32+(lane&3)*8+(4*hi+((lane&15)>>2))*64;
  const int NT=u.NT;
  if(MODE==0){DMA_K(0,0);DMA_V(0,0);DMA_K(1,SLOTB);} else {DMA_K(0,0);}
  bf16x8 qr[4];
  #pragma unroll
  for(int d0=0;d0<4;++d0)qr[d0]=*reinterpret_cast<const bf16x8*>(&Qw[(long)r32*qs+d0*16+hi*8]);
  const unsigned s2hb=__float_as_uint(u.slope2)&0xffff0000u; const float s2hf=__uint_as_float(s2hb);
  const unsigned s2lb=__float_as_uint(u.slope2-s2hf)&0xffff0000u; const float s2used=s2hf+__uint_as_float(s2lb);
  u32x4 qx; qx[0]=hi?0u:((__float_as_uint(64.f*s2hf)>>16)|(__float_as_uint(64.f*__uint_as_float(s2lb))&0xffff0000u)); qx[1]=hi?0u:((s2hb>>16)|s2lb); qx[2]=0u; qx[3]=0u;
  u32x4 kx0; unsigned jp0,jp1; { const unsigned j0=__float_as_uint((float)r32)>>16, j1=__float_as_uint((float)(r32+32))>>16; jp0=j0|(j0<<16); jp1=j1|(j1<<16);
    kx0[0]=0u; kx0[1]=jp0; kx0[2]=0x3f803f80u; kx0[3]=0u; }
  #define SETTG(t) do{ const unsigned tb_=__float_as_uint((float)(u.tg0+(t)))>>16; kx0[0]=(tb_|(tb_<<16)); }while(0)
  #define KX0 __builtin_bit_cast(bf16x8,kx0)
  #define QX __builtin_bit_cast(bf16x8,qx)
  #define SETREF(m_) do{ const unsigned hb_=__float_as_uint(m_)&0xffff0000u; const float hf_=__uint_as_float(hb_); const unsigned lb_=__float_as_uint((m_)-hf_)&0xffff0000u; \
      mhat=hf_+__uint_as_float(lb_); qx[2]=hi?0u:(((hb_^0x80000000u)>>16)|(lb_^0x80000000u)); }while(0)
  float mhat=0.f,l_reg=0.f;f32x16 o[2];o[0]=f32x16{};o[1]=f32x16{};
  const int qrel=u.rel0+wid*QBLK+r32-4*hi;
  #define CMASK(P0,P1,t) do{ if(MODE!=0||(t)>=NT-4) wmask<W>(P0,P1,qrel-64*(t),NEG); }while(0)
  bool resc=false;
  f32x16 pA0,pA1,pB0,pB1;
  int sl_prev=0,sl_cur=0,sl_next=SLOTB;
  #define ROT() do{sl_prev=sl_cur;sl_cur=sl_next;sl_next=(sl_next==(NSLOT-1)*SLOTB)?0:sl_next+SLOTB;}while(0)
  #define RESC() do{ if(resc){ asm volatile("s_waitcnt lgkmcnt(0)":::"memory"); \
      _Pragma("unroll") for(int d_=0;d_<2;++d_) _Pragma("unroll") for(int r=0;r<16;++r)o[d_][r]*=wsf[crow(r,hi)]; } }while(0)
  if(MODE==0){ DMA_K(2,2*SLOTB); WAIT_BAR(3); }
  else{ DMA_K(1,SLOTB);DMA_V(0,0);DMA_K(2,2*SLOTB);DMA_V(1,SLOTB);DMA_K(3,3*SLOTB);DMA_V(2,2*SLOTB);DMA_V(3,3*SLOTB);
    if(NT>4){DMA_K(4,4*SLOTB);DMA_K(5,5*SLOTB);DMA_V(4,4*SLOTB);DMA_V(5,5*SLOTB);}
    WAIT_BAR(0); }
  { SETTG(0); const f32x16 z=f32x16{}; const lds_cptr kb=kp0;
    #pragma unroll
    for(int d0=0;d0<4;++d0){
      const bf16x8 b0=*(const __attribute__((address_space(3))) bf16x8*)(kb+((d0*32)^kbo));
      const bf16x8 b1=*(const __attribute__((address_space(3))) bf16x8*)(kb+((d0*32)^kbo)+4096);
      if(d0==0){pA0=__builtin_amdgcn_mfma_f32_32x32x16_bf16(b0,qr[0],z,0,0,0);pA1=__builtin_amdgcn_mfma_f32_32x32x16_bf16(b1,qr[0],z,0,0,0);}
      else{pA0=__builtin_amdgcn_mfma_f32_32x32x16_bf16(b0,qr[d0],pA0,0,0,0);pA1=__builtin_amdgcn_mfma_f32_32x32x16_bf16(b1,qr[d0],pA1,0,0,0);}}
    pA0=__builtin_amdgcn_mfma_f32_32x32x16_bf16(KX0,QX,pA0,0,0,0); kx0[1]=jp1; pA1=__builtin_amdgcn_mfma_f32_32x32x16_bf16(KX0,QX,pA1,0,0,0); kx0[1]=jp0; }
  asm volatile("s_nop 15\n\ts_nop 7":"+v"(pA0),"+v"(pA1));CMASK(pA0,pA1,0);
  { const float rm=rowmax(pA0,pA1); SETREF(rm); const float dl=mhat;
    _Pragma("unroll") for(int r=0;r<16;++r){pA0[r]=fsub_s(pA0[r],dl);pA1[r]=fsub_s(pA1[r],dl);}
    _Pragma("unroll") for(int r=0;r<16;++r)pA0[r]=__builtin_amdgcn_exp2f(pA0[r]); }
  _Pragma("unroll") for(int r=0;r<16;++r)pA1[r]=__builtin_amdgcn_exp2f(pA1[r]);
  if(MODE==0){ WAIT_BAR(0); DMA_K(3,0);DMA_V(1,SLOTB); }
  ROT();
  kload8(kf,kp0+sl_cur,kbo);
  if(MODE==0){ WAIT_BAR(2); }
  s16x4 vlo[8],vhi[8]; u32x4 pw0,pw1,pw2,pw3;
  #define PKW(P,B) cvtpk_s(P[B],P[B+1])
  #define PAF(k) __builtin_bit_cast(bf16x8,pw##k)
  #define VFR(i) (bf16x8){vlo[i][0],vlo[i][1],vlo[i][2],vlo[i][3],vhi[i][0],vhi[i][1],vhi[i][2],vhi[i][3]}
  #define PIN(x) asm volatile("":"+v"(x))
  #define MX3(a,b,c) __builtin_fmaxf(__builtin_fmaxf((a),(b)),(c))
  #define GAPA(MF,A0,A1,A2,A3,W0,W1,PW) do{ MF; sacc+=A0; sacc+=A1; sacc+=A2; sacc+=A3; PIN(sacc); W0; W1; PIN(PW); SBAR(); }while(0)
  #define EX(v) __builtin_amdgcn_exp2f(v)
  #define GAPB(MF,X,B) do{ MF; X[B]=EX(X[B]); X[B+1]=EX(X[B+1]); X[B+2]=EX(X[B+2]); X[B+3]=EX(X[B+3]); PIN(X); SBAR(); }while(0)
  #define VRD(i) do{ vlo[i]=vtr(vp_+(((i)>>2)*4096+((i)&3)*1024)); vhi[i]=vtr(vp_+(((i)>>2)*4096+((i)&3)*1024+512)); }while(0)
  #define KRD(G,j) do{ if(G){ kload2(kf,kp0+sl_next,j,kbo); SBAR(); } }while(0)
  #define STEP(C0,C1,P0,P1,t,GK,GV,GL) do{ SBAR(); SETTG(t); const f32x16 z_=f32x16{}; \
    const lds_cptr vp_=vp0+sl_prev; \
    VRD(0); SBAR(); float sacc=(P0[0]+P0[1]); \
    GAPA(C0=__builtin_amdgcn_mfma_f32_32x32x16_bf16(kf[0],qr[0],z_,0,0,0), P0[2],P0[3],P0[4],P0[5],     pw0[0]=PKW(P0,0), pw0[1]=PKW(P0,2), pw0); \
    VRD(4); SBAR(); GAPA(C1=__builtin_amdgcn_mfma_f32_32x32x16_bf16(kf[1],qr[0],z_,0,0,0), P0[6],P0[7],P0[8],P0[9],     pw0[2]=PKW(P0,4), pw0[3]=PKW(P0,6), pw0); \
    VRD(1); SBAR(); GAPA(C0=__builtin_amdgcn_mfma_f32_32x32x16_bf16(kf[2],qr[1],C0,0,0,0),   P0[10],P0[11],P0[12],P0[13], pw1[0]=PKW(P0,8), pw1[1]=PKW(P0,10), pw1); \
    VRD(5); SBAR(); GAPA(C1=__builtin_amdgcn_mfma_f32_32x32x16_bf16(kf[3],qr[1],C1,0,0,0),   P0[14],P0[15],P1[0],P1[1],   pw1[2]=PKW(P0,12),pw1[3]=PKW(P0,14), pw1); \
    VRD(2); SBAR(); GAPA(C0=__builtin_amdgcn_mfma_f32_32x32x16_bf16(kf[4],qr[2],C0,0,0,0),   P1[2],P1[3],P1[4],P1[5],     pw2[0]=PKW(P1,0), pw2[1]=PKW(P1,2), pw2); \
    VRD(6); SBAR(); GAPA(C1=__builtin_amdgcn_mfma_f32_32x32x16_bf16(kf[5],qr[2],C1,0,0,0),   P1[6],P1[7],P1[8],P1[9],     pw2[2]=PKW(P1,4), pw2[3]=PKW(P1,6), pw2); \
    VRD(3); SBAR(); GAPA(C0=__builtin_amdgcn_mfma_f32_32x32x16_bf16(kf[6],qr[3],C0,0,0,0),   P1[10],P1[11],P1[12],P1[13], pw3[0]=PKW(P1,8), pw3[1]=PKW(P1,10), pw3); \
    VRD(7); SBAR(); GAPA(C1=__builtin_amdgcn_mfma_f32_32x32x16_bf16(kf[7],qr[3],C1,0,0,0),   P1[14],P1[15],0.f,0.f,       pw3[2]=PKW(P1,12),pw3[3]=PKW(P1,14), pw3); \
    C0=__builtin_amdgcn_mfma_f32_32x32x16_bf16(KX0,QX,C0,0,0,0); kx0[1]=jp1; C1=__builtin_amdgcn_mfma_f32_32x32x16_bf16(KX0,QX,C1,0,0,0); kx0[1]=jp0; SBAR(); \
    l_reg+=sacc; \
    if(GK){DMA_K((t)+3,sl_cur);} if(GV){DMA_V((t)+1,sl_next);} \
    CMASK(C0,C1,t); \
    { float a=MX3(C0[0],C0[1],C1[0]),b=MX3(C0[2],C0[3],C1[1]); a=MX3(a,C1[2],C1[3]); \
      _Pragma("unroll") for(int r=4;r<16;r+=4){a=MX3(a,C0[r],C0[r+1]);b=MX3(b,C0[r+2],C0[r+3]);a=MX3(a,C1[r],C1[r+1]);b=MX3(b,C1[r+2],C1[r+3]);} \
      float rm=__builtin_fmaxf(a,b); { auto rr=__builtin_amdgcn_permlane32_swap(__float_as_uint(rm),__float_as_uint(rm),false,false); rm=__builtin_fmaxf(__uint_as_float(rr[0]),__uint_as_float(rr[1])); } \
      resc=false; \
      if(__builtin_expect(__any(rm>(float)THRL),0)){ const float mold=mhat; const float mnew=mold+__builtin_fmaxf(rm,0.f); SETREF(mnew); const float dl=mhat-mold; \
        _Pragma("unroll") for(int r=0;r<16;++r){C0[r]-=dl;C1[r]-=dl;} \
        const float f=__builtin_amdgcn_exp2f(-dl); l_reg*=f; if(hi==0)wsf[r32]=f; resc=true; } } \
    SBAR(); \
    GAPB(o[0]=__builtin_amdgcn_mfma_f32_32x32x16_bf16(PAF(0),VFR(0),o[0],0,0,0), C0,0); \
    GAPB(o[1]=__builtin_amdgcn_mfma_f32_32x32x16_bf16(PAF(0),VFR(4),o[1],0,0,0), C0,4); \
    KRD(GL,0); GAPB(o[0]=__builtin_amdgcn_mfma_f32_32x32x16_bf16(PAF(1),VFR(1),o[0],0,0,0), C0,8); \
    KRD(GL,1); GAPB(o[1]=__builtin_amdgcn_mfma_f32_32x32x16_bf16(PAF(1),VFR(5),o[1],0,0,0), C0,12); \
    KRD(GL,2); GAPB(o[0]=__builtin_amdgcn_mfma_f32_32x32x16_bf16(PAF(2),VFR(2),o[0],0,0,0), C1,0); \
    KRD(GL,3); GAPB(o[1]=__builtin_amdgcn_mfma_f32_32x32x16_bf16(PAF(2),VFR(6),o[1],0,0,0), C1,4); \
    GAPB(o[0]=__builtin_amdgcn_mfma_f32_32x32x16_bf16(PAF(3),VFR(3),o[0],0,0,0), C1,8); \
    GAPB(o[1]=__builtin_amdgcn_mfma_f32_32x32x16_bf16(PAF(3),VFR(7),o[1],0,0,0), C1,12); \
    }while(0)
  int t=1;
  if(MODE==0){
    #undef CMASK
    #define CMASK(P0,P1,t) do{}while(0)
    for(;t+5<NT;t+=2){
      STEP(pB0,pB1,pA0,pA1,t,true,true,true);     WAIT_BAR(2); RESC(); ROT();
      STEP(pA0,pA1,pB0,pB1,t+1,true,true,true);   WAIT_BAR(2); RESC(); ROT();
    }
    #undef CMASK
    #define CMASK(P0,P1,t) do{ if(MODE!=0||(t)>=NT-4) wmask<W>(P0,P1,qrel-64*(t),NEG); }while(0)
  }
  #define ENDW(tt) do{ if(MODE==0){ if((tt)+3<NT){WAIT_BAR(2);} else if((tt)+2<NT){WAIT_BAR(1);} else {WAIT_BAR(0);} } }while(0)
  for(;t+1<NT;t+=2){
    STEP(pB0,pB1,pA0,pA1,t,(MODE==0&&t+3<NT),(MODE==0&&t+1<NT),(t+1<NT));       ENDW(t);   RESC(); ROT();
    STEP(pA0,pA1,pB0,pB1,t+1,(MODE==0&&t+4<NT),(MODE==0&&t+2<NT),(t+2<NT));     ENDW(t+1); RESC(); ROT();
  }
  STEP(pB0,pB1,pA0,pA1,NT-1,false,false,false); RESC();
  { float sacc=pB0[0]+pB0[1]; _Pragma("unroll") for(int r=2;r<16;++r)sacc+=pB0[r]; _Pragma("unroll") for(int r=0;r<16;++r)sacc+=pB1[r]; l_reg+=sacc;
    pw0=(u32x4){PKW(pB0,0),PKW(pB0,2),PKW(pB0,4),PKW(pB0,6)};pw1=(u32x4){PKW(pB0,8),PKW(pB0,10),PKW(pB0,12),PKW(pB0,14)};pw2=(u32x4){PKW(pB1,0),PKW(pB1,2),PKW(pB1,4),PKW(pB1,6)};pw3=(u32x4){PKW(pB1,8),PKW(pB1,10),PKW(pB1,12),PKW(pB1,14)};
    SBAR(); pv(o,(int)(lds0+LDS_V)+((lane>>4)&1)*32+(lane&3)*8+(4*hi+((lane&15)>>2))*64+sl_cur,PAF(0),PAF(1),PAF(2),PAF(3)); }
  #undef PKW
  #undef PAF
  #undef VFR
  #undef PIN
  #undef MX3
  #undef GAPA
  #undef GAPB
  #undef EX
  #undef VRD
  #undef KRD
  #undef STEP
  #undef ENDW
  {auto rr=__builtin_amdgcn_permlane32_swap(__float_as_uint(l_reg),__float_as_uint(l_reg),false,false);l_reg=__uint_as_float(rr[0])+__uint_as_float(rr[1]);}
  const float qposf=(float)(u.q0+wid*QBLK+r32);
  if(MODE==2) l_reg+=__builtin_amdgcn_exp2f(u.sink2+s2used*qposf-mhat);
  if(MODE==1){ if(hi==0) u.lse[(long)(wid*QBLK+r32)*(16*DIL)]=mhat-s2used*qposf+__builtin_amdgcn_logf(l_reg); }
  if(hi==0)wsf[32+r32]=l_reg;asm volatile("s_waitcnt lgkmcnt(0)":::"memory");
  float rli[16];
  #pragma unroll
  for(int r=0;r<16;++r)rli[r]=__builtin_amdgcn_rcpf(wsf[32+crow(r,hi)]);
  bf16*Ow=u.O+(long)(wid*QBLK)*OS;
  { int le=lane; asm volatile("":"+v"(le));
    const int r32e=le&31,hie=le>>5;
    __hip_bfloat16*stg=(__hip_bfloat16*)(shm+LDS_OST)+wid*2048;
    #pragma unroll
    for(int r=0;r<16;++r){const int orow=crow(r,hie);
      #pragma unroll
      for(int d0=0;d0<2;++d0)stg[orow*64+d0*32+r32e]=__float2bfloat16(o[d0][r]*rli[r]);}
    asm volatile("s_waitcnt lgkmcnt(0)":::"memory");
    #pragma unroll
    for(int i=0;i<4;++i){const int row=i*8+(le>>3),ch=le&7; const u32x4 v=*(const u32x4*)(stg+row*64+ch*8); *(u32x4*)(Ow+(long)row*OS+ch*8)=v;} }
  asm volatile("s_waitcnt lgkmcnt(0)\n\ts_barrier":::"memory");
  #undef DMA_K
  #undef DMA_V
  #undef CMASK
  #undef RESC
  #undef ROT
  #undef SETTG
  #undef SETREF
  #undef KX0
  #undef QX
}
#undef SBAR
#undef WAIT_BAR
}

namespace att128 {
using att::UnitDesc; using att::crow; using att::glds16; using att::max3f; using att::max2f; using att::fsub_s; using att::cvtpk_s; using att::kload8; using att::kload2; using att::vtr; using att::rowmax; using att::wmask; using att::lds_cptr;
using bf16=unsigned short;
using bf16x8=__attribute__((ext_vector_type(8)))short;
using s16x4=__attribute__((ext_vector_type(4)))short;
using f32x16=__attribute__((ext_vector_type(16)))float;
using u32x4=__attribute__((ext_vector_type(4)))unsigned;
constexpr int NW=8,QBLK=32,QB=QBLK*NW,KVBLK=64;
#define SBAR() __builtin_amdgcn_sched_barrier(0)
constexpr int NSLOT=3, SLOTB=8192, SLOTV=16384;
constexpr int LDS_K=0, LDS_V=NSLOT*SLOTB, LDS_WS=LDS_V+NSLOT*SLOTV, LDS_OST=LDS_WS+NW*64*4, LDS_BYTES=LDS_OST+NW*8192;
#define WAIT_BAR(N) asm volatile("s_waitcnt vmcnt(" #N ") lgkmcnt(0)\n\ts_barrier":::"memory")
__device__ __forceinline__ void pv4(f32x16*o,int vb,bf16x8 pa0,bf16x8 pa1,bf16x8 pa2,bf16x8 pa3){
  #pragma unroll
  for(int d0=0;d0<4;++d0){s16x4 lo[4],hi[4];
    #pragma unroll
    for(int ks=0;ks<4;++ks){
      asm volatile("ds_read_b64_tr_b16 %0,%1 offset:%c2":"=&v"(lo[ks]):"v"(vb),"i"(d0*4096+ks*1024):"memory");
      asm volatile("ds_read_b64_tr_b16 %0,%1 offset:%c2":"=&v"(hi[ks]):"v"(vb),"i"(d0*4096+ks*1024+512):"memory");}
    asm volatile("s_waitcnt lgkmcnt(0)":::"memory");SBAR();
    #define PK(k) (bf16x8){lo[k][0],lo[k][1],lo[k][2],lo[k][3],hi[k][0],hi[k][1],hi[k][2],hi[k][3]}
    o[d0]=__builtin_amdgcn_mfma_f32_32x32x16_bf16(pa0,PK(0),o[d0],0,0,0);
    o[d0]=__builtin_amdgcn_mfma_f32_32x32x16_bf16(pa1,PK(1),o[d0],0,0,0);
    o[d0]=__builtin_amdgcn_mfma_f32_32x32x16_bf16(pa2,PK(2),o[d0],0,0,0);
    o[d0]=__builtin_amdgcn_mfma_f32_32x32x16_bf16(pa3,PK(3),o[d0],0,0,0);
    #undef PK
  }
}
template<int MODE,int THRL,int DIL,int OS> __device__ __forceinline__ void attn_unit(const UnitDesc&u,char*shm){
  static_assert(MODE==0,"att128: causal mode only");
  constexpr int W=(MODE==0)?0x7fffffff:(MODE==1?128:127);
  const float NEG=(MODE==0)?-INFINITY:-1024.f;
  int tid=threadIdx.x; asm volatile("":"+v"(tid));
  const int lane=tid&63,r32=lane&31,hi=lane>>5; const int wid=__builtin_amdgcn_readfirstlane(tid>>6);
  constexpr long qs=64L*DIL,ks=64L*DIL,vs=64L*DIL;
  const bf16*Qw=u.Q+(long)(wid*QBLK)*qs;
  const unsigned lds0=(unsigned)(uintptr_t)shm;
  __attribute__((address_space(3))) float*wsf=(__attribute__((address_space(3))) float*)((__attribute__((address_space(3))) char*)shm+LDS_WS)+wid*64;
  const unsigned ksoff=(unsigned)(((long)(8*wid+(lane>>3))*ks+(((lane&7)^(lane>>3))*8))*2);
  const unsigned vsoff=(unsigned)(((long)(16*(wid&3)+(lane>>2))*vs+(wid>>2)*32+(lane&3)*8)*2);
  const unsigned kdst=lds0+LDS_K+wid*1024, vdst=lds0+LDS_V+wid*1024;
  #define DMA_K(t,slot) glds16(u.K+(long)(t)*KVBLK*ks,ksoff,(unsigned)__builtin_amdgcn_readfirstlane(kdst+(slot)))
  #define DMA_V(t,slot) do{ glds16(u.V+(long)(t)*KVBLK*vs,vsoff,(unsigned)__builtin_amdgcn_readfirstlane(vdst+2*(slot))); glds16(u.V+(long)(t)*KVBLK*vs+64*(long)M,vsoff,(unsigned)__builtin_amdgcn_readfirstlane(vdst+2*(slot)+8192)); }while(0)
  bf16x8 kf[8];
  const lds_cptr shm3=(lds_cptr)shm; const lds_cptr kp0=shm3+LDS_K+r32*128+((hi^(r32&1))*16); const int kbo=((r32>>1)&3)<<5; const lds_cptr vp0=shm3+LDS_V+((lane>>4)&1)*32+(lane&3)*8+(4*hi+((lane&15)>>2))*64;
  const int NT=u.NT;
  DMA_K(0,0);DMA_V(0,0);DMA_K(1,SLOTB);
  bf16x8 qr[4];
  #pragma unroll
  for(int d0=0;d0<4;++d0)qr[d0]=*reinterpret_cast<const bf16x8*>(&Qw[(long)r32*qs+d0*16+hi*8]);
  const unsigned s2hb=__float_as_uint(u.slope2)&0xffff0000u; const float s2hf=__uint_as_float(s2hb);
  const unsigned s2lb=__float_as_uint(u.slope2-s2hf)&0xffff0000u; const float s2used=s2hf+__uint_as_float(s2lb);
  u32x4 qx; qx[0]=hi?0u:((__float_as_uint(64.f*s2hf)>>16)|(__float_as_uint(64.f*__uint_as_float(s2lb))&0xffff0000u)); qx[1]=hi?0u:((s2hb>>16)|s2lb); qx[2]=0u; qx[3]=0u;
  u32x4 kx0; unsigned jp0,jp1; { const unsigned j0=__float_as_uint((float)r32)>>16, j1=__float_as_uint((float)(r32+32))>>16; jp0=j0|(j0<<16); jp1=j1|(j1<<16);
    kx0[0]=0u; kx0[1]=jp0; kx0[2]=0x3f803f80u; kx0[3]=0u; }
  #define SETTG(t) do{ const unsigned tb_=__float_as_uint((float)(u.tg0+(t)))>>16; kx0[0]=(tb_|(tb_<<16)); }while(0)
  #define KX0 __builtin_bit_cast(bf16x8,kx0)
  #define QX __builtin_bit_cast(bf16x8,qx)
  #define SETREF(m_) do{ const unsigned hb_=__float_as_uint(m_)&0xffff0000u; const float hf_=__uint_as_float(hb_); const unsigned lb_=__float_as_uint((m_)-hf_)&0xffff0000u; \
      mhat=hf_+__uint_as_float(lb_); qx[2]=hi?0u:(((hb_^0x80000000u)>>16)|(lb_^0x80000000u)); }while(0)
  float mhat=0.f,l_reg=0.f;f32x16 o[4];o[0]=f32x16{};o[1]=f32x16{};o[2]=f32x16{};o[3]=f32x16{};
  const int qrel=u.rel0+wid*QBLK+r32-4*hi;
  #define CMASK(P0,P1,t) do{ if(MODE!=0||(t)>=NT-4) wmask<W>(P0,P1,qrel-64*(t),NEG); }while(0)
  bool resc=false;
  f32x16 pA0,pA1,pB0,pB1;
  int sl_prev=0,sl_cur=0,sl_next=SLOTB;
  #define ROT() do{sl_prev=sl_cur;sl_cur=sl_next;sl_next=(sl_next==(NSLOT-1)*SLOTB)?0:sl_next+SLOTB;}while(0)
  #define RESC() do{ if(resc){ asm volatile("s_waitcnt lgkmcnt(0)":::"memory"); \
      _Pragma("unroll") for(int d_=0;d_<4;++d_) _Pragma("unroll") for(int r=0;r<16;++r)o[d_][r]*=wsf[crow(r,hi)]; } }while(0)
  DMA_K(2,2*SLOTB);
  WAIT_BAR(4);
  { SETTG(0); const f32x16 z=f32x16{}; const lds_cptr kb=kp0;
    #pragma unroll
    for(int d0=0;d0<4;++d0){
      const bf16x8 b0=*(const __attribute__((address_space(3))) bf16x8*)(kb+((d0*32)^kbo));
      const bf16x8 b1=*(const __attribute__((address_space(3))) bf16x8*)(kb+((d0*32)^kbo)+4096);
      if(d0==0){pA0=__builtin_amdgcn_mfma_f32_32x32x16_bf16(b0,qr[0],z,0,0,0);pA1=__builtin_amdgcn_mfma_f32_32x32x16_bf16(b1,qr[0],z,0,0,0);}
      else{pA0=__builtin_amdgcn_mfma_f32_32x32x16_bf16(b0,qr[d0],pA0,0,0,0);pA1=__builtin_amdgcn_mfma_f32_32x32x16_bf16(b1,qr[d0],pA1,0,0,0);}}
    pA0=__builtin_amdgcn_mfma_f32_32x32x16_bf16(KX0,QX,pA0,0,0,0); kx0[1]=jp1; pA1=__builtin_amdgcn_mfma_f32_32x32x16_bf16(KX0,QX,pA1,0,0,0); kx0[1]=jp0; }
  asm volatile("s_nop 15\n\ts_nop 7":"+v"(pA0),"+v"(pA1));CMASK(pA0,pA1,0);
  { const float rm=rowmax(pA0,pA1); SETREF(rm); const float dl=mhat;
    _Pragma("unroll") for(int r=0;r<16;++r){pA0[r]=fsub_s(pA0[r],dl);pA1[r]=fsub_s(pA1[r],dl);}
    _Pragma("unroll") for(int r=0;r<16;++r)pA0[r]=__builtin_amdgcn_exp2f(pA0[r]); }
  _Pragma("unroll") for(int r=0;r<16;++r)pA1[r]=__builtin_amdgcn_exp2f(pA1[r]);
  WAIT_BAR(0);
  DMA_K(3,0);DMA_V(1,SLOTB);
  ROT();
  kload8(kf,kp0+sl_cur,kbo);
  WAIT_BAR(3);
  s16x4 vlo[3],vhi[3]; u32x4 pw0,pw1,pw2,pw3;
  #define PKW(P,B) cvtpk_s(P[B],P[B+1])
  #define PAF(k) __builtin_bit_cast(bf16x8,pw##k)
  #define VFJ(b) (bf16x8){vlo[b][0],vlo[b][1],vlo[b][2],vlo[b][3],vhi[b][0],vhi[b][1],vhi[b][2],vhi[b][3]}
  #define PIN(x) asm volatile("":"+v"(x))
  #define MX3(a,b,c) __builtin_fmaxf(__builtin_fmaxf((a),(b)),(c))
  #define GAPA(MF,A0,A1,A2,A3,W0,W1,PW) do{ MF; sacc+=A0; sacc+=A1; sacc+=A2; sacc+=A3; PIN(sacc); W0; W1; PIN(PW); SBAR(); }while(0)
  #define EX(v) __builtin_amdgcn_exp2f(v)
  #define GAPB2(MF,X,B) do{ MF; X[B]=EX(X[B]); X[B+1]=EX(X[B+1]); PIN(X); SBAR(); }while(0)
  #define VRJ(b,n) do{ vlo[b]=vtr(vp_+(((n)&3)*4096+((n)>>2)*1024)); vhi[b]=vtr(vp_+(((n)&3)*4096+((n)>>2)*1024+512)); SBAR(); }while(0)
  #define KRD(G,j) do{ if(G){ kload2(kf,kp0+sl_next,j,kbo); SBAR(); } }while(0)
  #define STEP(C0,C1,P0,P1,t,GK,GV,GL) do{ SBAR(); SETTG(t); const f32x16 z_=f32x16{}; \
    const lds_cptr vp_=vp0+2*sl_prev; \
    float sacc=(P0[0]+P0[1]); \
    GAPA(C0=__builtin_amdgcn_mfma_f32_32x32x16_bf16(kf[0],qr[0],z_,0,0,0), P0[2],P0[3],P0[4],P0[5],     pw0[0]=PKW(P0,0), pw0[1]=PKW(P0,2), pw0); \
    GAPA(C1=__builtin_amdgcn_mfma_f32_32x32x16_bf16(kf[1],qr[0],z_,0,0,0), P0[6],P0[7],P0[8],P0[9],     pw0[2]=PKW(P0,4), pw0[3]=PKW(P0,6), pw0); \
    GAPA(C0=__builtin_amdgcn_mfma_f32_32x32x16_bf16(kf[2],qr[1],C0,0,0,0),   P0[10],P0[11],P0[12],P0[13], pw1[0]=PKW(P0,8), pw1[1]=PKW(P0,10), pw1); \
    GAPA(C1=__builtin_amdgcn_mfma_f32_32x32x16_bf16(kf[3],qr[1],C1,0,0,0),   P0[14],P0[15],P1[0],P1[1],   pw1[2]=PKW(P0,12),pw1[3]=PKW(P0,14), pw1); \
    GAPA(C0=__builtin_amdgcn_mfma_f32_32x32x16_bf16(kf[4],qr[2],C0,0,0,0),   P1[2],P1[3],P1[4],P1[5],     pw2[0]=PKW(P1,0), pw2[1]=PKW(P1,2), pw2); \
    GAPA(C1=__builtin_amdgcn_mfma_f32_32x32x16_bf16(kf[5],qr[2],C1,0,0,0),   P1[6],P1[7],P1[8],P1[9],     pw2[2]=PKW(P1,4), pw2[3]=PKW(P1,6), pw2); \
    VRJ(0,0); GAPA(C0=__builtin_amdgcn_mfma_f32_32x32x16_bf16(kf[6],qr[3],C0,0,0,0),   P1[10],P1[11],P1[12],P1[13], pw3[0]=PKW(P1,8), pw3[1]=PKW(P1,10), pw3); \
    VRJ(1,1); GAPA(C1=__builtin_amdgcn_mfma_f32_32x32x16_bf16(kf[7],qr[3],C1,0,0,0),   P1[14],P1[15],0.f,0.f,       pw3[2]=PKW(P1,12),pw3[3]=PKW(P1,14), pw3); \
    C0=__builtin_amdgcn_mfma_f32_32x32x16_bf16(KX0,QX,C0,0,0,0); kx0[1]=jp1; C1=__builtin_amdgcn_mfma_f32_32x32x16_bf16(KX0,QX,C1,0,0,0); kx0[1]=jp0; SBAR(); \
    l_reg+=sacc; \
    if(GK){DMA_K((t)+3,sl_cur);} if(GV){DMA_V((t)+1,sl_next);} \
    CMASK(C0,C1,t); \
    { float a=MX3(C0[0],C0[1],C1[0]),b=MX3(C0[2],C0[3],C1[1]); a=MX3(a,C1[2],C1[3]); \
      _Pragma("unroll") for(int r=4;r<16;r+=4){a=MX3(a,C0[r],C0[r+1]);b=MX3(b,C0[r+2],C0[r+3]);a=MX3(a,C1[r],C1[r+1]);b=MX3(b,C1[r+2],C1[r+3]);} \
      float rm=__builtin_fmaxf(a,b); { auto rr=__builtin_amdgcn_permlane32_swap(__float_as_uint(rm),__float_as_uint(rm),false,false); rm=__builtin_fmaxf(__uint_as_float(rr[0]),__uint_as_float(rr[1])); } \
      resc=false; \
      if(__builtin_expect(__any(rm>(float)THRL),0)){ const float mold=mhat; const float mnew=mold+__builtin_fmaxf(rm,0.f); SETREF(mnew); const float dl=mhat-mold; \
        _Pragma("unroll") for(int r=0;r<16;++r){C0[r]-=dl;C1[r]-=dl;} \
        const float f=__builtin_amdgcn_exp2f(-dl); l_reg*=f; if(hi==0)wsf[r32]=f; resc=true; } } \
    SBAR(); \
    VRJ(2,2);             GAPB2(o[0]=__builtin_amdgcn_mfma_f32_32x32x16_bf16(PAF(0),VFJ(0),o[0],0,0,0), C0,0); \
    VRJ(0,3);             GAPB2(o[1]=__builtin_amdgcn_mfma_f32_32x32x16_bf16(PAF(0),VFJ(1),o[1],0,0,0), C0,2); \
    VRJ(1,4);             GAPB2(o[2]=__builtin_amdgcn_mfma_f32_32x32x16_bf16(PAF(0),VFJ(2),o[2],0,0,0), C0,4); \
    VRJ(2,5);             GAPB2(o[3]=__builtin_amdgcn_mfma_f32_32x32x16_bf16(PAF(0),VFJ(0),o[3],0,0,0), C0,6); \
    VRJ(0,6);  KRD(GL,0); GAPB2(o[0]=__builtin_amdgcn_mfma_f32_32x32x16_bf16(PAF(1),VFJ(1),o[0],0,0,0), C0,8); \
    VRJ(1,7);             GAPB2(o[1]=__builtin_amdgcn_mfma_f32_32x32x16_bf16(PAF(1),VFJ(2),o[1],0,0,0), C0,10); \
    VRJ(2,8);  KRD(GL,1); GAPB2(o[2]=__builtin_amdgcn_mfma_f32_32x32x16_bf16(PAF(1),VFJ(0),o[2],0,0,0), C0,12); \
    VRJ(0,9);             GAPB2(o[3]=__builtin_amdgcn_mfma_f32_32x32x16_bf16(PAF(1),VFJ(1),o[3],0,0,0), C0,14); \
    VRJ(1,10); KRD(GL,2); GAPB2(o[0]=__builtin_amdgcn_mfma_f32_32x32x16_bf16(PAF(2),VFJ(2),o[0],0,0,0), C1,0); \
    VRJ(2,11);            GAPB2(o[1]=__builtin_amdgcn_mfma_f32_32x32x16_bf16(PAF(2),VFJ(0),o[1],0,0,0), C1,2); \
    VRJ(0,12); KRD(GL,3); GAPB2(o[2]=__builtin_amdgcn_mfma_f32_32x32x16_bf16(PAF(2),VFJ(1),o[2],0,0,0), C1,4); \
    VRJ(1,13);            GAPB2(o[3]=__builtin_amdgcn_mfma_f32_32x32x16_bf16(PAF(2),VFJ(2),o[3],0,0,0), C1,6); \
    VRJ(2,14);            GAPB2(o[0]=__builtin_amdgcn_mfma_f32_32x32x16_bf16(PAF(3),VFJ(0),o[0],0,0,0), C1,8); \
    VRJ(0,15);            GAPB2(o[1]=__builtin_amdgcn_mfma_f32_32x32x16_bf16(PAF(3),VFJ(1),o[1],0,0,0), C1,10); \
                          GAPB2(o[2]=__builtin_amdgcn_mfma_f32_32x32x16_bf16(PAF(3),VFJ(2),o[2],0,0,0), C1,12); \
                          GAPB2(o[3]=__builtin_amdgcn_mfma_f32_32x32x16_bf16(PAF(3),VFJ(0),o[3],0,0,0), C1,14); \
    }while(0)
  int t=1;
  if(MODE==0){
    #undef CMASK
    #define CMASK(P0,P1,t) do{}while(0)
    for(;t+5<NT;t+=2){
      STEP(pB0,pB1,pA0,pA1,t,true,true,true);     WAIT_BAR(3); RESC(); ROT();
      STEP(pA0,pA1,pB0,pB1,t+1,true,true,true);   WAIT_BAR(3); RESC(); ROT();
    }
    #undef CMASK
    #define CMASK(P0,P1,t) do{ if(MODE!=0||(t)>=NT-4) wmask<W>(P0,P1,qrel-64*(t),NEG); }while(0)
  }
  #define ENDW(tt) do{ if((tt)+3<NT){WAIT_BAR(3);} else if((tt)+2<NT){WAIT_BAR(2);} else {WAIT_BAR(0);} }while(0)
  for(;t+1<NT;t+=2){
    STEP(pB0,pB1,pA0,pA1,t,(t+3<NT),(t+1<NT),(t+1<NT));       ENDW(t);   RESC(); ROT();
    STEP(pA0,pA1,pB0,pB1,t+1,(t+4<NT),(t+2<NT),(t+2<NT));     ENDW(t+1); RESC(); ROT();
  }
  STEP(pB0,pB1,pA0,pA1,NT-1,false,false,false); RESC();
  { float sacc=pB0[0]+pB0[1]; _Pragma("unroll") for(int r=2;r<16;++r)sacc+=pB0[r]; _Pragma("unroll") for(int r=0;r<16;++r)sacc+=pB1[r]; l_reg+=sacc;
    pw0=(u32x4){PKW(pB0,0),PKW(pB0,2),PKW(pB0,4),PKW(pB0,6)};pw1=(u32x4){PKW(pB0,8),PKW(pB0,10),PKW(pB0,12),PKW(pB0,14)};pw2=(u32x4){PKW(pB1,0),PKW(pB1,2),PKW(pB1,4),PKW(pB1,6)};pw3=(u32x4){PKW(pB1,8),PKW(pB1,10),PKW(pB1,12),PKW(pB1,14)};
    SBAR(); pv4(o,(int)(lds0+LDS_V)+((lane>>4)&1)*32+(lane&3)*8+(4*hi+((lane&15)>>2))*64+2*sl_cur,PAF(0),PAF(1),PAF(2),PAF(3)); }
  #undef PKW
  #undef PAF
  #undef VFJ
  #undef PIN
  #undef MX3
  #undef GAPA
  #undef GAPB2
  #undef EX
  #undef VRJ
  #undef KRD
  #undef STEP
  #undef ENDW
  {auto rr=__builtin_amdgcn_permlane32_swap(__float_as_uint(l_reg),__float_as_uint(l_reg),false,false);l_reg=__uint_as_float(rr[0])+__uint_as_float(rr[1]);}
  const float qposf=(float)(u.q0+wid*QBLK+r32);
  if(MODE==2) l_reg+=__builtin_amdgcn_exp2f(u.sink2+s2used*qposf-mhat);
  if(MODE==1){ if(hi==0) u.lse[(long)(wid*QBLK+r32)*(16*DIL)]=mhat-s2used*qposf+__builtin_amdgcn_logf(l_reg); }
  if(hi==0)wsf[32+r32]=l_reg;asm volatile("s_waitcnt lgkmcnt(0)":::"memory");
  float rli[16];
  #pragma unroll
  for(int r=0;r<16;++r)rli[r]=__builtin_amdgcn_rcpf(wsf[32+crow(r,hi)]);
  bf16*Ow=u.O+(long)(wid*QBLK)*OS;
  { int le=lane; asm volatile("":"+v"(le));
    const int r32e=le&31,hie=le>>5;
    __hip_bfloat16*stg=(__hip_bfloat16*)(shm+LDS_OST)+wid*4096;
    #pragma unroll
    for(int r=0;r<16;++r){const int orow=crow(r,hie);
      #pragma unroll
      for(int d0=0;d0<4;++d0)stg[orow*128+d0*32+r32e]=__float2bfloat16(o[d0][r]*rli[r]);}
    asm volatile("s_waitcnt lgkmcnt(0)":::"memory");
    #pragma unroll
    for(int i=0;i<8;++i){const int row=i*4+(le>>4),ch=le&15; const u32x4 v=*(const u32x4*)(stg+row*128+ch*8); *(u32x4*)(Ow+(long)row*OS+ch*8)=v;} }
  asm volatile("s_waitcnt lgkmcnt(0)\n\ts_barrier":::"memory");
  #undef DMA_K
  #undef DMA_V
  #undef CMASK
  #undef RESC
  #undef ROT
  #undef SETTG
  #undef SETREF
  #undef KX0
  #undef QX
}
#undef SBAR
#undef WAIT_BAR
}

constexpr float LOG2E = 1.4426950408889634f;
__device__ __forceinline__ int vcu_of(int bx, int G) { return (G % 8 == 0) ? (bx % 8) * (G / 8) + bx / 8 : bx; }
constexpr int ATT1_LDS_TAB = 141312;
__device__ __forceinline__ void attn1_tuned_phase(const Ctx& c, const bf16* qkv, const float* qkg  , bf16* R, unsigned* qctr, const ExpertSrc& es, unsigned char* ws,
                                                  const float* lamp, const float* subln, bf16* Oout) {
    LAS int* order = (LAS int*)(c.lds + ATT1_LDS_TAB);
    LAS int* nts = order + 256;
    LAS int* t0s = nts + 256;
    volatile LAS unsigned* nextu = (volatile LAS unsigned*)(t0s + 256);
    LAS float* bnd = (LAS float*)(t0s + 256 + 4);
    const int G = gridDim.x;
    if (c.wave == 0) { float gq = fabsf(qkg[c.lane]), gk = fabsf(qkg[64 + c.lane]);
#pragma unroll
        for (int o = 1; o < 64; o <<= 1) { gq = fmaxf(gq, __shfl_xor(gq, o)); gk = fmaxf(gk, __shfl_xor(gk, o)); }
        if (c.lane == 0) bnd[0] = 8.f * gq * gk * 1.02f; }
    __syncthreads();
    if (c.tid < 256) { const int h = c.tid >> 4, qb = c.tid & 15; const float slope = exp2f(-0.5f * (float)(h + 1));
        const int dmax = (int)fminf(ceilf((2.f * bnd[0] + 25.f) / slope), 1.0e6f), lo_ = 256 * qb - dmax, t0 = lo_ <= 0 ? 0 : ((lo_ >> 6) & ~1);
        nts[c.tid] = 4 * (qb + 1) - t0; t0s[c.tid] = t0; }
    __syncthreads();
    if (c.tid < 256) { const int mine = nts[c.tid]; int rank = 0;
        for (int e = 0; e < 256; ++e) { const int o = nts[e]; rank += (o > mine || (o == mine && e < c.tid)) ? 1 : 0; }
        order[rank] = c.tid; }
    __syncthreads();
#if FUSE_FINISH
    constexpr int NCH = DEFER_CONV ? EXP_ITEMS / 65 : 0, NUNIT = NB * 16 * 16, NPOS = NUNIT + NCH;
    static_assert(!DEFER_CONV || EXP_ITEMS % 65 == 0, "chunking");
    if (c.tid == 0) { float s01 = 0.f, s23 = 0.f; for (int i = 0; i < 64; ++i) { s01 += lamp[i] * lamp[64 + i]; s23 += lamp[128 + i] * lamp[192 + i]; }
      const float li = 0.8f - 0.6f * expf(-0.3f * 1.0f); bnd[1] = expf(s01) - expf(s23) + li; bnd[2] = li; }
    __syncthreads();
    unsigned p = blockIdx.x;
    while (p < (unsigned)NPOS) {
        unsigned nreg = 0u;
        if (c.tid == 0) nreg = __hip_atomic_fetch_add(qctr, 1u, __ATOMIC_RELAXED, __HIP_MEMORY_SCOPE_AGENT) + (unsigned)G;
        const bool inter = p < (unsigned)(NCH * 2);
        if (inter && (p & 1u)) {
            expert_items_block(c, es, 1, ws, (int)(p >> 1) * 65, 65);
        } else {
#define ATT1_DECODE() const unsigned u = inter ? (p >> 1) : p - (unsigned)NCH; const int ent = order[u >> 2], h = ent >> 4, qb = ent & 15, b = (int)(u & 3u), t0 = t0s[ent]; \
            bf16* Rblk = R + ((size_t)(b * T + qb * 256) * 16 + h) * 256
#if USE_V128
#pragma unroll 1
            for (int pass = 0; pass < 2; ++pass) {
                ATT1_DECODE();
                const int i = pass; att::UnitDesc ud;
                ud.Q = qkv + ((size_t)(2 * h + i) * M + (size_t)(b * T + qb * 256)) * 64; ud.qs = 64;
                ud.K = qkv + ((size_t)(32 + 2 * h + i) * M + (size_t)(b * T + 64 * t0)) * 64; ud.ks = 64;
                ud.V = qkv + ((size_t)(64 + 2 * h) * M + (size_t)(b * T + 64 * t0)) * 64; ud.vs = 64;
                ud.O = Rblk + 128 * i; ud.os = 16 * 256;
                ud.lse = nullptr; ud.lses = 0; ud.NT = 4 * (qb + 1) - t0; ud.rel0 = qb * 256 - 64 * t0; ud.tg0 = t0; ud.q0 = qb * 256;
                ud.slope2 = exp2f(-0.5f * (float)(h + 1)) * LOG2E; ud.sink2 = 0.f;
                att128::attn_unit<0, 8, 1, 16 * 256>(ud, (char*)c.lds);
            }
#else
#pragma unroll 1
            for (int pass = 0; pass < 4; ++pass) {
                ATT1_DECODE();
                const int i = pass >> 1, j = pass & 1; att::UnitDesc ud;
#if QKV_HEADMAJOR
                ud.Q = qkv + ((size_t)(2 * h + i) * M + (size_t)(b * T + qb * 256)) * 64; ud.qs = 64;
                ud.K = qkv + ((size_t)(32 + 2 * h + i) * M + (size_t)(b * T + 64 * t0)) * 64; ud.ks = 64;
                ud.V = qkv + ((size_t)(64 + 2 * h + j) * M + (size_t)(b * T + 64 * t0)) * 64; ud.vs = 64;
#else
                ud.Q = qkv + (size_t)(b * T + qb * 256) * C_IN + 128 * h + 64 * i; ud.qs = C_IN;
                ud.K = qkv + (size_t)(b * T + 64 * t0) * C_IN + 2048 + 128 * h + 64 * i; ud.ks = C_IN;
                ud.V = qkv + (size_t)(b * T + 64 * t0) * C_IN + 4096 + 128 * h + 64 * j; ud.vs = C_IN;
#endif
                ud.O = Rblk + 128 * i + 64 * j; ud.os = 16 * 256;
                ud.lse = nullptr; ud.lses = 0; ud.NT = 4 * (qb + 1) - t0; ud.rel0 = qb * 256 - 64 * t0; ud.tg0 = t0; ud.q0 = qb * 256;
                ud.slope2 = exp2f(-0.5f * (float)(h + 1)) * LOG2E; ud.sink2 = 0.f;
                att::attn_unit<0, 8, 1, 16 * 256>(ud, (char*)c.lds);
            }
#endif
            asm volatile("s_waitcnt vmcnt(0)" ::: "memory"); __syncthreads();
            { ATT1_DECODE(); (void)t0; const float lam = bnd[1], lam_init = bnd[2];
              int ft_ = threadIdx.x; asm volatile("" : "+v"(ft_));
              const int row = ft_ >> 1, hf = ft_ & 1; const bf16* p1 = Rblk + (size_t)row * (16 * 256) + 64 * hf; const bf16* p2 = p1 + 128;
              float xv[64]; float ss = 0.f;
#pragma unroll
              for (int q8 = 0; q8 < 8; ++q8) { const u32x4 a = *(const u32x4*)(p1 + 8 * q8), bq = *(const u32x4*)(p2 + 8 * q8);
#pragma unroll
                  for (int k = 0; k < 4; ++k) { const float x0 = bf2f(a[k] & 0xffffu) - lam * bf2f(bq[k] & 0xffffu), x1 = bf2f(a[k] >> 16) - lam * bf2f(bq[k] >> 16);
                      xv[8 * q8 + 2 * k] = x0; xv[8 * q8 + 2 * k + 1] = x1; ss += x0 * x0 + x1 * x1; } }
              ss += __shfl_xor(ss, 1);
              const float rs = (1.f - lam_init) / sqrtf(ss * (1.f / 128.f) + RMS_EPS);
              bf16* op = Oout + (size_t)(b * T + qb * 256 + row) * D + 128 * h + 64 * hf; const float* sg = subln + 64 * hf;
#pragma unroll
              for (int q8 = 0; q8 < 8; ++q8) { u32x4 w;
#pragma unroll
                  for (int k = 0; k < 4; ++k) w[k] = pk2(xv[8 * q8 + 2 * k] * rs * sg[8 * q8 + 2 * k], xv[8 * q8 + 2 * k + 1] * rs * sg[8 * q8 + 2 * k + 1]);
                  *(u32x4*)(op + 8 * q8) = w; } }
#undef ATT1_DECODE
        }
        if (c.tid == 0) nextu[0] = nreg;
        __syncthreads();
        p = nextu[0];
    }
}
#else
    constexpr int NCH = DEFER_CONV ? EXP_ITEMS / 65 : 0, NPOS = NB * 16 * 4 * 16 + NCH;
    static_assert(!DEFER_CONV || EXP_ITEMS % 65 == 0, "chunking");
    unsigned p = blockIdx.x;
    while (p < (unsigned)NPOS) {
        unsigned nreg = 0u;
        if (c.tid == 0) nreg = __hip_atomic_fetch_add(qctr, 1u, __ATOMIC_RELAXED, __HIP_MEMORY_SCOPE_AGENT) + (unsigned)G;
        const bool inter = p < (unsigned)(NCH * 6);
        if (inter && (p % 6u) == 5u) {
            expert_items_block(c, es, 1, ws, (int)(p / 6u) * 65, 65);
        } else {
            const unsigned u = inter ? p - p / 6u : p - (unsigned)NCH;
            const int ent = order[u >> 4], h = ent >> 4, qb = ent & 15, bp = (int)(u & 15u), b = bp >> 2, i = (bp >> 1) & 1, j = bp & 1, t0 = t0s[ent];
            att::UnitDesc ud;
#if QKV_HEADMAJOR
            ud.Q = qkv + ((size_t)(2 * h + i) * M + (size_t)(b * T + qb * 256)) * 64; ud.qs = 64;
            ud.K = qkv + ((size_t)(32 + 2 * h + i) * M + (size_t)(b * T + 64 * t0)) * 64; ud.ks = 64;
            ud.V = qkv + ((size_t)(64 + 2 * h + j) * M + (size_t)(b * T + 64 * t0)) * 64; ud.vs = 64;
#else
            ud.Q = qkv + (size_t)(b * T + qb * 256) * C_IN + 128 * h + 64 * i; ud.qs = C_IN;
            ud.K = qkv + (size_t)(b * T + 64 * t0) * C_IN + 2048 + 128 * h + 64 * i; ud.ks = C_IN;
            ud.V = qkv + (size_t)(b * T + 64 * t0) * C_IN + 4096 + 128 * h + 64 * j; ud.vs = C_IN;
#endif
            ud.O = R + ((size_t)(b * T + qb * 256) * 16 + h) * 256 + 128 * i + 64 * j; ud.os = 16 * 256;
            ud.lse = nullptr; ud.lses = 0; ud.NT = 4 * (qb + 1) - t0; ud.rel0 = qb * 256 - 64 * t0; ud.tg0 = t0; ud.q0 = qb * 256;
            ud.slope2 = exp2f(-0.5f * (float)(h + 1)) * LOG2E; ud.sink2 = 0.f;
            att::attn_unit<0, 8, 1, 16 * 256>(ud, (char*)c.lds);
        }
        if (c.tid == 0) nextu[0] = nreg;
        __syncthreads();
        p = nextu[0];
    }
}
#endif
__device__ __forceinline__ void attn1_finish_bf16_phase(const Ctx& c, const bf16* R, const float* lamp, const float* subln, bf16* O) {
    float s01 = 0.f, s23 = 0.f;
    for (int i = 0; i < 64; ++i) { s01 += lamp[i] * lamp[64 + i]; s23 += lamp[128 + i] * lamp[192 + i]; }
    const float lam_init = 0.8f - 0.6f * expf(-0.3f * 1.0f);
    const float lam = expf(s01) - expf(s23) + lam_init;
    const long total = (long)M * 16;
    for (long id = gtid_now(); id < total; id += c.gsz) {
        const bf16* p1 = R + (size_t)id * 256; const bf16* p2 = p1 + 128;
        float ss = 0.f;
#pragma unroll 4
        for (int i = 0; i < 16; ++i) { const u32x4 a = *(const u32x4*)(p1 + 8 * i), bq = *(const u32x4*)(p2 + 8 * i);
#pragma unroll
            for (int k = 0; k < 4; ++k) { const float x0 = bf2f(a[k] & 0xffffu) - lam * bf2f(bq[k] & 0xffffu), x1 = bf2f(a[k] >> 16) - lam * bf2f(bq[k] >> 16); ss += x0 * x0 + x1 * x1; } }
        const float rs = (1.f - lam_init) / sqrtf(ss * (1.f / 128.f) + RMS_EPS);
        bf16* op = O + (size_t)id * 128;
#pragma unroll 4
        for (int i = 0; i < 16; ++i) { const u32x4 a = *(const u32x4*)(p1 + 8 * i), bq = *(const u32x4*)(p2 + 8 * i); u32x4 w;
#pragma unroll
            for (int k = 0; k < 4; ++k) { const float x0 = bf2f(a[k] & 0xffffu) - lam * bf2f(bq[k] & 0xffffu), x1 = bf2f(a[k] >> 16) - lam * bf2f(bq[k] >> 16);
                w[k] = pk2(x0 * rs * subln[8 * i + 2 * k], x1 * rs * subln[8 * i + 2 * k + 1]); }
            *(u32x4*)(op + 8 * i) = w; }
    }
}
__device__ __forceinline__ void attn0_tuned_phase(const Ctx& c, const bf16* qkv, const float* sinks, bf16* OBR  , float* LSE  , bf16* O, int xlo, int xhi) {
    const int G = gridDim.x, vcu = vcu_of(blockIdx.x, G);
    for (int gid = vcu; gid < NB * 64; gid += G) {
        const int b = gid / 64, kind = (gid % 64) / 16, h = gid % 16;
        const float slope2 = exp2f(-0.5f * (float)(h + 1)) * LOG2E;
        if (kind < 3) {
            const int dil = kind == 0 ? 1 : (kind == 1 ? 4 : 16), nblk = 16 / dil;
            for (int x = xlo; x < xhi; ++x) {
                const int r = x / nblk, blk = x % nblk, q0 = blk * 256, t0 = blk ? 4 * blk - 2 : 0; att::UnitDesc u;
                const size_t qrow = (size_t)(b * T + r + dil * q0), krow = (size_t)(b * T + r + dil * 64 * t0);
#if QKV_HEADMAJOR
                u.Q = qkv + ((size_t)(h) * M + qrow) * 64; u.qs = (long)dil * 64;
                u.K = qkv + ((size_t)(16 + h) * M + krow) * 64; u.ks = (long)dil * 64;
                u.V = qkv + ((size_t)(32 + h) * M + krow) * 64; u.vs = (long)dil * 64;
#else
                u.Q = qkv + qrow * AB_IN + 64 * h; u.qs = (long)dil * AB_IN;
                u.K = qkv + krow * AB_IN + 1024 + 64 * h; u.ks = (long)dil * AB_IN;
                u.V = qkv + krow * AB_IN + 2048 + 64 * h; u.vs = (long)dil * AB_IN;
#endif
                u.O = OBR + ((size_t)kind * M + qrow) * 1024 + 64 * h; u.os = (long)dil * 1024;
                u.lse = LSE + ((size_t)kind * M + qrow) * 16 + h; u.lses = (long)dil * 16;
                u.NT = blk ? 6 : 4; u.rel0 = q0 - 64 * t0; u.tg0 = t0; u.q0 = q0; u.slope2 = slope2 * (float)dil; u.sink2 = 0.f;
                if (dil == 1) att::attn_unit<1, 8, 1, 1024>(u, (char*)c.lds); else if (dil == 4) att::attn_unit<1, 8, 4, 4096>(u, (char*)c.lds); else att::attn_unit<1, 8, 16, 16384>(u, (char*)c.lds);
            }
        } else {
            const int kvh = h >> 3;
            for (int x = xlo; x < xhi; ++x) {
                const int q0 = x * 256, t0 = x ? 4 * x - 2 : 0; att::UnitDesc u;
                const size_t qrow = (size_t)(b * T + q0), krow = (size_t)(b * T + 64 * t0);
#if QKV_HEADMAJOR
                u.Q = qkv + ((size_t)(48 + h) * M + qrow) * 64; u.qs = 64;
                u.K = qkv + ((size_t)(64 + kvh) * M + krow) * 64; u.ks = 64;
                u.V = qkv + ((size_t)(66 + kvh) * M + krow) * 64; u.vs = 64;
#else
                u.Q = qkv + qrow * AB_IN + 3072 + 64 * h; u.qs = AB_IN;
                u.K = qkv + krow * AB_IN + 4096 + 64 * kvh; u.ks = AB_IN;
                u.V = qkv + krow * AB_IN + 4224 + 64 * kvh; u.vs = AB_IN;
#endif
                u.O = O + qrow * D + 1024 + 64 * h; u.os = D;
                u.lse = nullptr; u.lses = 0;
                u.NT = x ? 6 : 4; u.rel0 = q0 - 64 * t0; u.tg0 = t0; u.q0 = q0; u.slope2 = slope2; u.sink2 = sinks[h] * LOG2E;
                att::attn_unit<2, 8, 1, D>(u, (char*)c.lds);
            }
        }
    }
}
__device__ __forceinline__ void attn0_merge_phase(const Ctx& c, const bf16* OBR, const float* LSE, bf16* O) {
    const long total = (long)M * 16;
    for (long id = gtid_now(); id < total; id += c.gsz) {
        const long m = id / 16; const int h = (int)(id % 16);
        const float l0 = LSE[id], l1 = LSE[(size_t)M * 16 + id], l2 = LSE[(size_t)2 * M * 16 + id];
        const float mx = fmaxf(l0, fmaxf(l1, l2)); float w0 = exp2f(l0 - mx), w1 = exp2f(l1 - mx), w2 = exp2f(l2 - mx); const float inv = 1.f / (w0 + w1 + w2); w0 *= inv; w1 *= inv; w2 *= inv;
        const bf16* p0 = OBR + (size_t)m * 1024 + 64 * h; const bf16* p1 = p0 + (size_t)M * 1024; const bf16* p2 = p1 + (size_t)M * 1024;
        bf16* op = O + (size_t)m * D + 64 * h;
#pragma unroll
        for (int i = 0; i < 8; ++i) { const u32x4 a = *(const u32x4*)(p0 + 8 * i), bq = *(const u32x4*)(p1 + 8 * i), cq = *(const u32x4*)(p2 + 8 * i); u32x4 w;
#pragma unroll
            for (int k = 0; k < 4; ++k) w[k] = pk2(w0 * bf2f(a[k] & 0xffffu) + w1 * bf2f(bq[k] & 0xffffu) + w2 * bf2f(cq[k] & 0xffffu), w0 * bf2f(a[k] >> 16) + w1 * bf2f(bq[k] >> 16) + w2 * bf2f(cq[k] >> 16));
            *(u32x4*)(op + 8 * i) = w; }
    }
}

__device__ __forceinline__ void convert_router(const Ctx& c, const float* wr, bf16* wrt) {
    for (int id2 = gtid_now(); id2 < 2 * NE * D; id2 += c.gsz) { const int l = id2 / (NE * D), id = id2 % (NE * D), k = id / NE, n = id % NE; const float w = wr[id2];
        const unsigned hb = f2bf(w); const float hf = bf2f(hb);
        const int off = l * 2 * NE * D + (((((k >> 8) * 8 + ((k >> 5) & 7)) * 4 + (n >> 4)) * 2) * 64 + ((n & 15) + 16 * ((k >> 3) & 3))) * 8 + (k & 7);
        wrt[off] = (bf16)hb; wrt[off + 512] = (bf16)f2bf(w - hf); }
}
#define DPPF(old, v, ctrl, rm) __int_as_float(__builtin_amdgcn_update_dpp(__float_as_int(old), __float_as_int(v), ctrl, rm, 0xf, false))
__device__ __forceinline__ float dpp_max8(float v) {
    v = fmaxf(v, DPPF(v, v, 0xB1, 0xf)); v = fmaxf(v, DPPF(v, v, 0x4E, 0xf)); v = fmaxf(v, DPPF(v, v, 0x141, 0xf)); return v; }
__device__ __forceinline__ float wave_max_u(float v) {
    v = dpp_max8(v); v = fmaxf(v, DPPF(v, v, 0x140, 0xf)); v = fmaxf(v, DPPF(v, v, 0x142, 0xa)); v = fmaxf(v, DPPF(v, v, 0x143, 0xc));
    return __int_as_float(__builtin_amdgcn_readlane(__float_as_int(v), 63)); }
__device__ __forceinline__ float wave_sum_u(float v) {
    v += DPPF(0.f, v, 0xB1, 0xf); v += DPPF(0.f, v, 0x4E, 0xf); v += DPPF(0.f, v, 0x141, 0xf); v += DPPF(0.f, v, 0x140, 0xf); v += DPPF(0.f, v, 0x142, 0xa); v += DPPF(0.f, v, 0x143, 0xc);
    return __int_as_float(__builtin_amdgcn_readlane(__float_as_int(v), 63)); }
constexpr int RT_ROUTER = 2;
__device__ __forceinline__ void router2_phase(const Ctx& c, const float* x1, const float* g, const float* ada_l, const bf16* wrt, const float* rbias,
                                              bf16* HF, int* idx, float* gate, int* wcnt, bf16* HFB = nullptr) {
    constexpr int RT = RT_ROUTER, RU = 16 * RT, NU = M / RU;
    LAS float* red = (LAS float*)c.lds;
    LAS float* part = (LAS float*)(c.lds + 1024);
    LAS float* GA = (LAS float*)(c.lds + 1024 + RT * 32768);
    LAS float* GB = GA + D;
    const int w = __builtin_amdgcn_readfirstlane((int)threadIdx.x >> 6);
    const float rb = rbias[threadIdx.x & 63];
    unsigned cnt = 0u;
    const int per = (NU + (int)gridDim.x - 1) / (int)gridDim.x, u0 = blockIdx.x * per, u1 = (u0 + per < NU) ? u0 + per : NU;
    int bcur = -1;
#pragma unroll 1
    for (int u = u0; u < u1; ++u) {
        int tid = threadIdx.x; asm volatile("" : "+v"(tid));
        const int lane = tid & 63, r = lane & 15, q = lane >> 4, cb = 256 * w + 8 * q;
        const bf16* wf = wrt + (size_t)w * (8 * 4 * 2 * 512) + lane * 8;
        const int m0 = u * RU, b = m0 / T;
        if (b != bcur) { bcur = b; __syncthreads();
            for (int col = 4 * tid; col < D; col += 2048) { const f32x4 gg = *(const f32x4*)(g + col), sc = *(const f32x4*)(ada_l + (size_t)b * 6 * D + 4 * D + col), sh = *(const f32x4*)(ada_l + (size_t)b * 6 * D + 3 * D + col);
                *(LAS f32x4*)(GA + col) = gg * (sc + 1.f); *(LAS f32x4*)(GB + col) = sh; } }
        u32x4 xv[RT][8]; float rstd[RT];
#pragma unroll
        for (int t = 0; t < RT; ++t) { const bf16* xr = (const bf16*)x1 + (size_t)(m0 + 16 * t + r) * D + cb;
#pragma unroll
            for (int kk = 0; kk < 8; ++kk) xv[t][kk] = *(const u32x4*)(xr + 32 * kk); }
#pragma unroll
        for (int t = 0; t < RT; ++t) { float ss = 0.f;
#pragma unroll
            for (int kk = 0; kk < 8; ++kk)
#pragma unroll
                for (int j = 0; j < 4; ++j) { const float a0 = bf2f(xv[t][kk][j] & 0xffffu), a1 = bf2f(xv[t][kk][j] >> 16); ss += a0 * a0 + a1 * a1; }
            ss += __shfl_xor(ss, 16); ss += __shfl_xor(ss, 32);
            if (q == 0) red[(t * 8 + w) * 16 + r] = ss; }
        __syncthreads();
        f32x4 acc[RT][4];
#pragma unroll
        for (int t = 0; t < RT; ++t) { float tot = 0.f;
#pragma unroll
            for (int w2 = 0; w2 < 8; ++w2) tot += red[(t * 8 + w2) * 16 + r];
            rstd[t] = 1.f / sqrtf(tot * (1.f / D) + RMS_EPS);
#pragma unroll
            for (int nt = 0; nt < 4; ++nt) acc[t][nt] = (f32x4){0.f, 0.f, 0.f, 0.f}; }
#pragma unroll
        for (int kk = 0; kk < 8; ++kk) {
            const f32x4 ga0 = *(LAS f32x4*)(GA + cb + 32 * kk), ga1 = *(LAS f32x4*)(GA + cb + 32 * kk + 4), gb0 = *(LAS f32x4*)(GB + cb + 32 * kk), gb1 = *(LAS f32x4*)(GB + cb + 32 * kk + 4);
            bf16x8 ah[RT], al[RT];
#pragma unroll
            for (int t = 0; t < RT; ++t) { const u32x4 xw = xv[t][kk]; f32x4 hh[2];
                hh[0] = (f32x4){bf2f(xw.x & 0xffffu), bf2f(xw.x >> 16), bf2f(xw.y & 0xffffu), bf2f(xw.y >> 16)} * rstd[t] * ga0 + gb0;
                hh[1] = (f32x4){bf2f(xw.z & 0xffffu), bf2f(xw.z >> 16), bf2f(xw.w & 0xffffu), bf2f(xw.w >> 16)} * rstd[t] * ga1 + gb1;
                u32x4 hw, lw;
#pragma unroll
                for (int s2 = 0; s2 < 2; ++s2) { const unsigned h0 = f2bf(hh[s2].x), h1 = f2bf(hh[s2].y), h2 = f2bf(hh[s2].z), h3 = f2bf(hh[s2].w);
                    hw[2 * s2] = h0 | (h1 << 16); hw[2 * s2 + 1] = h2 | (h3 << 16);
                    lw[2 * s2] = pk2(hh[s2].x - bf2f(h0), hh[s2].y - bf2f(h1)); lw[2 * s2 + 1] = pk2(hh[s2].z - bf2f(h2), hh[s2].w - bf2f(h3)); }
#if USE_FP8_MOE
                { u32x2 q8; q8.x = pk4_fp8(hh[0].x * F8_HSCALE, hh[0].y * F8_HSCALE, hh[0].z * F8_HSCALE, hh[0].w * F8_HSCALE); q8.y = pk4_fp8(hh[1].x * F8_HSCALE, hh[1].y * F8_HSCALE, hh[1].z * F8_HSCALE, hh[1].w * F8_HSCALE);
                  *(u32x2*)((unsigned char*)HF + (size_t)(m0 + 16 * t + r) * D + cb + 32 * kk) = q8; }
#if SHARED_BF16
                *(u32x4*)(HFB + (size_t)(m0 + 16 * t + r) * D + cb + 32 * kk) = hw;
#endif
#else
                *(u32x4*)(HF + (size_t)(m0 + 16 * t + r) * D + cb + 32 * kk) = hw;
#endif
                ah[t] = __builtin_bit_cast(bf16x8, hw); al[t] = __builtin_bit_cast(bf16x8, lw); }
#pragma unroll
            for (int nt = 0; nt < 4; ++nt) { const bf16x8 bh = *(const bf16x8*)(wf + ((kk * 4 + nt) * 2) * 512), bl = *(const bf16x8*)(wf + ((kk * 4 + nt) * 2 + 1) * 512);
#pragma unroll
                for (int t = 0; t < RT; ++t) {
                    acc[t][nt] = __builtin_amdgcn_mfma_f32_16x16x32_bf16(ah[t], bh, acc[t][nt], 0, 0, 0);
                    acc[t][nt] = __builtin_amdgcn_mfma_f32_16x16x32_bf16(ah[t], bl, acc[t][nt], 0, 0, 0);
                    acc[t][nt] = __builtin_amdgcn_mfma_f32_16x16x32_bf16(al[t], bh, acc[t][nt], 0, 0, 0); } }
            if (kk & 1) asm volatile("" ::: "memory");
        }
#pragma unroll
        for (int t = 0; t < RT; ++t)
#pragma unroll
            for (int nt = 0; nt < 4; ++nt)
#pragma unroll
                for (int j = 0; j < 4; ++j) part[((t * 8 + w) * 16 + 4 * q + j) * 64 + 16 * nt + r] = acc[t][nt][j];
        __syncthreads();
#pragma unroll 1
        for (int rp = 0; rp < RT; ++rp) {
            float score[2], cur[2]; int rank[2];
#pragma unroll
            for (int x = 0; x < 2; ++x) { const int row = 2 * RT * w + 2 * rp + x; float logit = 0.f;
#pragma unroll
                for (int w2 = 0; w2 < 8; ++w2) logit += part[(((row >> 4) * 8 + w2) * 16 + (row & 15)) * 64 + lane];
                score[x] = 1.f / (1.f + expf(-logit));
                const float sel = score[x] + rb;
                const float m1 = dpp_max8(sel);
                const unsigned long long eqm = __ballot(sel == m1);
                const unsigned grp_eq = (unsigned)((eqm >> (lane & ~7)) & 0xffull);
                const int first = __builtin_ctz(grp_eq);
                const float m2 = dpp_max8(((lane & 7) == first) ? -3e38f : sel);
                const float gs = m1 + m2;
                int grank = 0; const int mygrp = lane >> 3;
#pragma unroll
                for (int g2 = 0; g2 < 8; ++g2) { const float o = __int_as_float(__builtin_amdgcn_readlane(__float_as_int(gs), g2 * 8)); grank += (o > gs || (o == gs && g2 < mygrp)) ? 1 : 0; }
                cur[x] = (grank < 4) ? sel : -1e30f; rank[x] = 64; }
#pragma unroll
            for (int it = 0; it < TOPK; ++it)
#pragma unroll
                for (int x = 0; x < 2; ++x) { const float mx = wave_max_u(cur[x]); const int f = (int)__builtin_ctzll(__ballot(cur[x] == mx));
                    if (lane == f) { rank[x] = it; cur[x] = -3e38f; } }
#pragma unroll
            for (int x = 0; x < 2; ++x) { const int m = m0 + 2 * RT * w + 2 * rp + x; const bool chosen = rank[x] < TOPK;
                const float gsum = wave_sum_u(chosen ? score[x] : 0.f);
                if (chosen) { idx[(size_t)m * 8 + rank[x]] = lane | (int)(cnt << 8); gate[(size_t)m * 8 + rank[x]] = score[x] / gsum * 2.5f; cnt += 1u; } }
        }
        __syncthreads();
    }
    wcnt[(size_t)(blockIdx.x * 8 + w) * 64 + (threadIdx.x & 63)] = (int)cnt;
}
__device__ __forceinline__ void slot2_phase(const Ctx& c, const int* idx, const int* wcnt, unsigned* nrt_out, int* pos, int* slot_tok, int* tile_exp) {
    LAS int* ST = (LAS int*)c.lds;
    LAS int* SB = ST + 512;
    LAS int* SO = SB + 512;
    LAS int* tot = SO + 512;
    LAS int* bef = tot + 64;
    LAS int* ps = bef + 64;
    LAS int* base = ps + 128;
    const int e = c.tid & 63, p = c.tid >> 6, G = gridDim.x, blk = blockIdx.x;
    { int Tp = 0, Bp = 0;
#pragma unroll 8
      for (int b2 = 0; b2 < G; ++b2) { const int v = wcnt[(size_t)(b2 * 8 + p) * 64 + e]; Tp += v; Bp += (b2 < blk) ? v : 0; }
      ST[p * 64 + e] = Tp; SB[p * 64 + e] = Bp; SO[p * 64 + e] = wcnt[(size_t)(blk * 8 + p) * 64 + e]; }
    __syncthreads();
    if (c.tid < 64) { int t = 0, bb = 0;
#pragma unroll
        for (int p2 = 0; p2 < 8; ++p2) { t += ST[p2 * 64 + e]; bb += SB[p2 * 64 + e]; }
        tot[e] = t; bef[e] = bb; }
    __syncthreads();
    if (c.tid == 0) { int acc = 0; for (int e2 = 0; e2 < NE; ++e2) { ps[e2] = acc; acc += (tot[e2] + 255) / 256 * 256; } ps[64] = acc; }
    __syncthreads();
    { int o = ps[e] + bef[e];
      for (int p2 = 0; p2 < p; ++p2) o += SO[p2 * 64 + e];
      base[p * 64 + e] = o; }
    __syncthreads();
    {
        constexpr int RU = 16 * RT_ROUTER, NU = M / RU; const int per = (NU + G - 1) / G, mlo = blk * per * RU, mhi = (mlo + per * RU < M) ? mlo + per * RU : M;
        for (int i = c.tid; i < (mhi - mlo) * 8; i += 512) {
            const int m = mlo + (i >> 3), k = i & 7, wv = (m % RU) / (2 * RT_ROUTER); const size_t a = (size_t)m * 8 + k;
            const int code = idx[a], ee = code & 255, rk = code >> 8, slot = base[wv * 64 + ee] + rk;
            slot_tok[slot] = m; pos[a] = slot; }
    }
    for (int t = gtid_now(); t < M; t += c.gsz) slot_tok[CAPR + t] = t;
    if (blk == 0) {
        if (c.tid < NE) { const int s0 = ps[e], cn = tot[e], pe = s0 + (cn + 255) / 256 * 256;
            for (int s = s0 + cn; s < pe; ++s) slot_tok[s] = 0;
            for (int tt = s0 / 256; tt < pe / 256; ++tt) tile_exp[tt] = e; }
        if (c.tid == 0) *nrt_out = (unsigned)(ps[64] / 256);
    }
    __syncthreads();
}

template <int L> __device__ __forceinline__ void moe_up_tuned(const Ctx& c, unsigned char* ws) {
    const int nrt = (int)c.ctl[CW_NRT + L];
#if USE_FP8_MOE && SHARED_BF16
    { pg8::PlainSched S; S.o.init(M / 256, UPN / 256, gridDim.x, blockIdx.x); S.Bt = (const char*)(ws + WS_WUPS) + (size_t)L * UPN * D * 2; S.K = D;
      pg8::EpiUp E{(bf16*)(ws + WS_ACTS)}; pg8::gemm_phase(c.lds, (const char*)(ws + WS_HFB), D, S, E); }
    const int ntile = nrt;
#else
    const int ntile = nrt + M / 256;
#endif
    pg8::GroupSched<true> S; S.o.init(ntile, UPN / 256, gridDim.x, blockIdx.x);
    { LAS int* te = (LAS int*)(c.lds + 132096);
      for (int i = threadIdx.x; i < nrt; i += 512) te[i] = ((const int*)(ws + WS_TILEEXP))[i];
      __syncthreads(); S.tile_exp = te; }
    S.nrt = nrt; S.slot_tok = (const int*)(ws + WS_SLOTTOK);
#if USE_FP8_MOE
    S.W = (const char*)(ws + WS_WUP) + (size_t)L * NEX * UPN * D; S.wstride = (size_t)UPN * D; S.K = D / 2;
    pg8::EpiUp8 E{ws + WS_ACT}; pg8::gemm_phase<pg8::EpiUp8, pg8::GroupSched<true>, true>(c.lds, (const char*)(ws + WS_HF), D / 2, S, E);
#else
    S.W = (const char*)(ws + WS_WUP) + (size_t)L * NEX * UPN * D * 2; S.wstride = (size_t)UPN * D * 2; S.K = D;
    pg8::EpiUp E{(bf16*)(ws + WS_ACT)}; pg8::gemm_phase(c.lds, (const char*)(ws + WS_HF), D, S, E);
#endif
}
template <int L> __device__ __forceinline__ void moe_down_tuned(const Ctx& c, unsigned char* ws) {
    const int nrt = (int)c.ctl[CW_NRT + L];
#if USE_FP8_MOE && SHARED_BF16
    { pg8::PlainSched S; S.o.init(M / 256, D / 256, gridDim.x, blockIdx.x); S.Bt = (const char*)(ws + WS_WDNS) + (size_t)L * D * ED * 2; S.K = ED;
      pg8::EpiDown E{(bf16*)(ws + WS_Y), CAPR}; pg8::gemm_phase(c.lds, (const char*)(ws + WS_ACTS), ED, S, E); }
    const int ntile = nrt;
#else
    const int ntile = nrt + M / 256;
#endif
    pg8::GroupSched<false> S; S.o.init(ntile, D / 256, gridDim.x, blockIdx.x);
    { LAS int* te = (LAS int*)(c.lds + 132096);
      for (int i = threadIdx.x; i < nrt; i += 512) te[i] = ((const int*)(ws + WS_TILEEXP))[i];
      __syncthreads(); S.tile_exp = te; }
    S.nrt = nrt; S.slot_tok = (const int*)(ws + WS_SLOTTOK);
#if USE_FP8_MOE
    S.W = (const char*)(ws + WS_WDN) + (size_t)L * NEX * D * ED; S.wstride = (size_t)D * ED; S.K = ED / 2;
    pg8::EpiDown8 E{(bf16*)(ws + WS_Y)}; pg8::gemm_phase<pg8::EpiDown8, pg8::GroupSched<false>, true>(c.lds, (const char*)(ws + WS_ACT), ED / 2, S, E);
#else
    S.W = (const char*)(ws + WS_WDN) + (size_t)L * NEX * D * ED * 2; S.wstride = (size_t)D * ED * 2; S.K = ED;
    pg8::EpiDown E{(bf16*)(ws + WS_Y)}; pg8::gemm_phase(c.lds, (const char*)(ws + WS_ACT), ED, S, E);
#endif
}
template <int L> __device__ __forceinline__ void qkv_tuned(const Ctx& c, unsigned char* ws, const float* gains) {
    constexpr int NCOL = L == 0 ? AB_IN : C_IN; constexpr bool TUNED_ATT = L == 0 ? (USE_ATT0 != 0) : (USE_ATT1 != 0);
    pg8::PlainSched S; S.o.init(M / 256, NCOL / 256, gridDim.x, blockIdx.x); S.Bt = (const char*)(ws + (L == 0 ? WS_W0IN : WS_W1IN));
#if USE_FP8_QKV
    S.K = D / 2; pg8::EpiQKV<L> E{(bf16*)(ws + WS_QKV), NCOL, gains, TUNED_ATT ? att::C2 : 1.f, 1.f / (F8_HSCALE * F8_WSCALE)};
    pg8::gemm_phase<pg8::EpiQKV<L>, pg8::PlainSched, true>(c.lds, (const char*)(ws + WS_XN), D / 2, S, E);
#else
    S.K = D; pg8::EpiQKV<L> E{(bf16*)(ws + WS_QKV), NCOL, gains, TUNED_ATT ? att::C2 : 1.f, 1.f};
    pg8::gemm_phase(c.lds, (const char*)(ws + WS_XN), D, S, E);
#endif
}

template <int L> __device__ __forceinline__ void outproj_epi(const Ctx& c, unsigned char* ws, const pg8::PlainSched& S, const float* xin_f32, const float* gm) {
#if RES_BF16
    if (L == 0) { pg8::EpiOutB<false> E{xin_f32, gm, (bf16*)(ws + WS_X1)}; pg8::gemm_phase(c.lds, (const char*)(ws + WS_O), D, S, E); }
    else { pg8::EpiOutB<true> E{ws + WS_X1 + (size_t)M * D * 2, gm, (bf16*)(ws + WS_X1)}; pg8::gemm_phase(c.lds, (const char*)(ws + WS_O), D, S, E); }
#else
    pg8::EpiOut E{xin_f32, gm, (float*)(ws + WS_X1)}; pg8::gemm_phase(c.lds, (const char*)(ws + WS_O), D, S, E);
#endif
}
__global__ void __launch_bounds__(512, 2) mega(Args args) {
    extern __shared__ __attribute__((aligned(16))) unsigned char lds_raw[];
    Ctx c;
    c.lds = (LAS unsigned char*)lds_raw;
    c.tid = threadIdx.x; c.lane = c.tid & 63; c.wave = __builtin_amdgcn_readfirstlane(c.tid >> 6);
    c.gw = blockIdx.x * 8 + c.wave; c.ngw = gridDim.x * 8; c.gsz = gridDim.x * 512;
    c.ws = args.ws; c.ctl = (unsigned*)(args.ws + WS_CTL);
    volatile LAS unsigned* xbw = (volatile LAS unsigned*)(c.lds + LDS_BYTES - 16);
    if (c.tid < 4) xbw[c.tid] = 0u;
    __syncthreads();
    const int lo = args.ph_lo, hi = args.ph_hi;
    XcdBarrier bar; bar.bar = c.ctl + CW_BAR; bar.x = 0; bar.st = xbw;
    if (hi - lo > 1) bar = xcd_barrier_post(c.ctl + CW_BAR, xbw);
#ifdef PHASE_ONLY
#define IN(k) ((k) == PHASE_ONLY && lo <= (k) && (k) < hi)
#else
#define IN(k) (lo <= (k) && (k) < hi)
#endif
#define PHASE(k, ...) do { if (IN(k)) { __VA_ARGS__ } if (IN(k) && ((REPMASK >> (k)) & 1u)) { __syncthreads(); __VA_ARGS__ } } while (0);
#if PROBE_SEL >= 0
    volatile LAS unsigned long long* stamp_ = (volatile LAS unsigned long long*)(c.lds + 146000);
    if (c.tid == 0) stamp_[0] = __builtin_amdgcn_s_memrealtime();
#define SEAM(k) do { if (c.tid == 0) stamp_[1 + 2 * (k)] = __builtin_amdgcn_s_memrealtime(); if (IN(k) && IN((k) + 1)) xcd_barrier(bar); else __syncthreads(); \
        if (c.tid == 0) stamp_[2 + 2 * (k)] = __builtin_amdgcn_s_memrealtime(); } while (0)
#else
#define SEAM(k) do { if (IN(k) && IN((k) + 1)) xcd_barrier(bar); else __syncthreads(); } while (0)
#endif
    unsigned char* ws = args.ws;
#define XIN (args.in[0])
#define cin (args.in[1])
#define norm_mix (args.in[2])
#define norm_ffn (args.in[3])
#define w_ada (args.in[4])
#define b_ada (args.in[5])
#define ada ((float*)(ws + WS_ADA))
#define W0IN ((bf16*)(ws + WS_W0IN))
#define W0OUT ((bf16*)(ws + WS_W0OUT))
#define W1IN ((bf16*)(ws + WS_W1IN))
#define W1OUT ((bf16*)(ws + WS_W1OUT))
#define WUP ((bf16*)(ws + WS_WUP))
#define WDN ((bf16*)(ws + WS_WDN))
#define XN ((bf16*)(ws + WS_XN))
#define QKV ((bf16*)(ws + WS_QKV))
#define OBUF ((bf16*)(ws + WS_O))
#define X1 ((float*)(ws + WS_X1))
#define HF ((bf16*)(ws + WS_HF))
#define IDX ((int*)(ws + WS_IDX))
#define GATE ((float*)(ws + WS_GATE))
#define POS ((int*)(ws + WS_POS))
#define SLOTTOK ((int*)(ws + WS_SLOTTOK))
#define TILEEXP ((int*)(ws + WS_TILEEXP))
#define ACT ((bf16*)(ws + WS_ACT))
#define Y ((bf16*)(ws + WS_Y))
#define TMP ((float*)(ws + WS_TMP))
#define OUTP (args.out)

    PHASE(0, {
        constexpr int QM = USE_PG8_QKV ? 1 : 0, UM = USE_PG8_MOE ? 2 : 0;
#if USE_CONV128 && USE_FP8_MOE
        convert_dense_all<QM, USE_FP8_QKV != 0>(c, args.in[6], args.in[10], args.in[9], args.in[14], (unsigned char*)W0IN, (unsigned char*)W1IN, (unsigned char*)W0OUT, (unsigned char*)W1OUT, USE_FP8_QKV ? F8_WSCALE : 1.f);
#if !(DEFER_CONV && USE_ATT0 && USE_ATT1 && !SHARED_BF16)
        for (int l = 0; l < 2; ++l) {
            convert_batch128<2, true>(c, args.in[17] + (size_t)l * NE * D * UPN, D, UPN, (unsigned char*)WUP + (size_t)l * NEX * UPN * D, NE, (size_t)UPN * D, F8_WSCALE);
            convert_batch128<0, true>(c, args.in[18] + (size_t)l * NE * ED * D, ED, D, (unsigned char*)WDN + (size_t)l * NEX * D * ED, NE, (size_t)D * ED, F8_WSCALE);
#if SHARED_BF16
            convert_batch128<2, false>(c, args.in[19] + (size_t)l * D * UPN, D, UPN, ws + WS_WUPS + (size_t)l * UPN * D * 2, 1, 0, 1.f);
            convert_batch128<0, false>(c, args.in[20] + (size_t)l * ED * D, ED, D, ws + WS_WDNS + (size_t)l * D * ED * 2, 1, 0, 1.f);
#else
            convert_batch128<2, true>(c, args.in[19] + (size_t)l * D * UPN, D, UPN, (unsigned char*)WUP + ((size_t)l * NEX + NE) * UPN * D, 1, 0, F8_WSCALE);
            convert_batch128<0, true>(c, args.in[20] + (size_t)l * ED * D, ED, D, (unsigned char*)WDN + ((size_t)l * NEX + NE) * D * ED, 1, 0, F8_WSCALE);
#endif
        }
#endif
#else
        convert_batch<QM>(c, args.in[6], D, AB_IN, W0IN, 1, 0);
        convert_batch<0>(c, args.in[9], D, D, W0OUT, 1, 0);
        convert_batch<QM>(c, args.in[10], D, C_IN, W1IN, 1, 0);
        convert_batch<0>(c, args.in[14], D, D, W1OUT, 1, 0);
        for (int l = 0; l < 2; ++l) {
#if USE_FP8_MOE
            convert_batch_f8<2>(c, args.in[17] + (size_t)l * NE * D * UPN, D, UPN, (unsigned char*)WUP + (size_t)l * NEX * UPN * D, NE, (size_t)UPN * D);
            convert_batch_f8<2>(c, args.in[19] + (size_t)l * D * UPN, D, UPN, (unsigned char*)WUP + ((size_t)l * NEX + NE) * UPN * D, 1, 0);
            convert_batch_f8<0>(c, args.in[18] + (size_t)l * NE * ED * D, ED, D, (unsigned char*)WDN + (size_t)l * NEX * D * ED, NE, (size_t)D * ED);
            convert_batch_f8<0>(c, args.in[20] + (size_t)l * ED * D, ED, D, (unsigned char*)WDN + ((size_t)l * NEX + NE) * D * ED, 1, 0);
#else
            convert_batch<UM>(c, args.in[17] + (size_t)l * NE * D * UPN, D, UPN, WUP + (size_t)l * NEX * UPN * D, NE, (size_t)UPN * D);
            convert_batch<UM>(c, args.in[19] + (size_t)l * D * UPN, D, UPN, WUP + ((size_t)l * NEX + NE) * UPN * D, 1, 0);
            convert_batch<0>(c, args.in[18] + (size_t)l * NE * ED * D, ED, D, WDN + (size_t)l * NEX * D * ED, NE, (size_t)D * ED);
            convert_batch<0>(c, args.in[20] + (size_t)l * ED * D, ED, D, WDN + ((size_t)l * NEX + NE) * D * ED, 1, 0);
#endif
        }
#endif
        convert_router(c, args.in[15], (bf16*)(ws + WS_WRT));
        __syncthreads();
        ada_phase(c, cin, w_ada, b_ada, ada);
    })
    SEAM(0);
    PHASE(1, norm_phase(c, XIN, norm_mix, ada, 0, D, XN);)
    SEAM(1);
#if USE_PG8_QKV
    PHASE(2, qkv_tuned<0>(c, ws, args.in[7]);)
    SEAM(2);
#else
    PHASE(2, gemm_plain_bf16(c, XN, W0IN, D, AB_IN, QKV);)
    SEAM(2);
#endif
#if USE_ATT0
    static_assert(USE_PG8_QKV, "the tuned attention needs Q pre-scaled by the QKV epilogue");
    #if DEFER_CONV
    PHASE(3, { const int xs_ = vcu_of(blockIdx.x, gridDim.x) & 15;
        attn0_tuned_phase(c, QKV, args.in[8], (bf16*)(ws + WS_TMP), (float*)(ws + WS_TMP + (size_t)3 * M * 1024 * 2), OBUF, 0, xs_ + 1);
        { const int cshare = (EXP_ITEMS + (int)gridDim.x - 1) / (int)gridDim.x, cfirst = blockIdx.x * cshare, ccount = (cfirst + cshare <= EXP_ITEMS) ? cshare : (EXP_ITEMS > cfirst ? EXP_ITEMS - cfirst : 0);
          expert_items_block(c, ExpertSrc{args.in[17], args.in[19], args.in[18], args.in[20]}, 0, ws, cfirst, ccount); __syncthreads(); }
        attn0_tuned_phase(c, QKV, args.in[8], (bf16*)(ws + WS_TMP), (float*)(ws + WS_TMP + (size_t)3 * M * 1024 * 2), OBUF, xs_ + 1, 16); })
#else
    PHASE(3, attn0_tuned_phase(c, QKV, args.in[8], (bf16*)(ws + WS_TMP), (float*)(ws + WS_TMP + (size_t)3 * M * 1024 * 2), OBUF, 0, 16);)
#endif
    SEAM(3);
    PHASE(4, attn0_merge_phase(c, (const bf16*)(ws + WS_TMP), (const float*)(ws + WS_TMP + (size_t)3 * M * 1024 * 2), OBUF);)
    SEAM(4);
#else
#if !USE_PG8_QKV
    PHASE(3, qknorm0_phase(c, QKV, args.in[7]);)
#endif
    SEAM(3);
    PHASE(4, attn0_phase(c, QKV, args.in[8], OBUF);)
    SEAM(4);
#endif
#if USE_PG8_OUT
    PHASE(5, { pg8::PlainSched S; S.o.init(M / 256, D / 256, gridDim.x, blockIdx.x); S.Bt = (const char*)W0OUT; S.K = D;
        outproj_epi<0>(c, ws, S, XIN, ada + 2 * D); })
#else
    PHASE(5, gemm_outproj(c, OBUF, W0OUT, XIN, ada + 2 * D, X1);)
#endif
    SEAM(5);
#if USE_ROUTER2
    PHASE(6, router2_phase(c, X1, norm_ffn, ada, (const bf16*)(ws + WS_WRT), args.in[16], HF, IDX, GATE, (int*)(ws + WS_WCNT), (bf16*)(ws + WS_HFB));)
    SEAM(6);
    PHASE(7, slot2_phase(c, IDX, (const int*)(ws + WS_WCNT), c.ctl + CW_NRT, POS, SLOTTOK, TILEEXP);)
#else
    PHASE(6, router_phase(c, X1, norm_ffn, ada, args.in[15], args.in[16], HF, IDX, GATE, c.ctl + CW_CNT);)
    SEAM(6);
    PHASE(7, slot_phase(c, IDX, c.ctl + CW_CNT, c.ctl + CW_CUR, c.ctl + CW_NRT, POS, SLOTTOK, TILEEXP);)
#endif
    SEAM(7);
#if USE_PG8_MOE
    PHASE(8, moe_up_tuned<0>(c, ws);)
    SEAM(8);
    PHASE(9, moe_down_tuned<0>(c, ws);)
#else
    PHASE(8, moe_up_phase(c, HF, WUP, SLOTTOK, TILEEXP, c.ctl + CW_NRT, ACT);)
    SEAM(8);
    PHASE(9, moe_down_phase(c, ACT, WDN, TILEEXP, c.ctl + CW_NRT, Y);)
#endif
    SEAM(9);
    PHASE(10, combine_phase<true>(c, X1, Y, POS, GATE, ada, RES_BF16 ? (float*)(ws + WS_X1 + (size_t)M * D * 2) : OUTP, norm_mix + D, ada + (size_t)4 * 6 * D, XN);)
    SEAM(10);
#define ada1 (ada + (size_t)4 * 6 * D)
#if USE_PG8_QKV
    PHASE(11, qkv_tuned<1>(c, ws, args.in[11]);)
    SEAM(11);
    SEAM(12);
#else
    PHASE(11, gemm_plain_bf16(c, XN, W1IN, D, C_IN, QKV);)
    SEAM(11);
    PHASE(12, qknorm1_phase(c, QKV, args.in[11]);)
    SEAM(12);
#endif
#if USE_ATT1
    PHASE(13, attn1_tuned_phase(c, QKV, args.in[11], (bf16*)TMP, c.ctl + CW_QCTR, ExpertSrc{args.in[17], args.in[19], args.in[18], args.in[20]}, ws, args.in[12], args.in[13], OBUF);)
    SEAM(13);
#if !FUSE_FINISH
    PHASE(14, attn1_finish_bf16_phase(c, (const bf16*)TMP, args.in[12], args.in[13], OBUF);)
#endif
    SEAM(14);
#else
    PHASE(13, attn1_phase(c, QKV, TMP);)
    SEAM(13);
    PHASE(14, attn1_finish_phase(c, TMP, args.in[12], args.in[13], OBUF);)
    SEAM(14);
#endif
#if USE_PG8_OUT
    PHASE(15, { pg8::PlainSched S; S.o.init(M / 256, D / 256, gridDim.x, blockIdx.x); S.Bt = (const char*)W1OUT; S.K = D;
        outproj_epi<1>(c, ws, S, OUTP, ada1 + 2 * D); })
#else
    PHASE(15, gemm_outproj(c, OBUF, W1OUT, OUTP, ada1 + 2 * D, X1);)
#endif
    SEAM(15);
#if USE_ROUTER2
    PHASE(16, router2_phase(c, X1, norm_ffn + D, ada1, (const bf16*)(ws + WS_WRT) + (size_t)2 * NE * D, args.in[16] + NE, HF, IDX, GATE, (int*)(ws + WS_WCNT), (bf16*)(ws + WS_HFB));)
    SEAM(16);
    PHASE(17, slot2_phase(c, IDX, (const int*)(ws + WS_WCNT), c.ctl + CW_NRT + 1, POS, SLOTTOK, TILEEXP);)
#else
    PHASE(16, router_phase(c, X1, norm_ffn + D, ada1, args.in[15] + (size_t)D * NE, args.in[16] + NE, HF, IDX, GATE, c.ctl + CW_CNT + 64);)
    SEAM(16);
    PHASE(17, slot_phase(c, IDX, c.ctl + CW_CNT + 64, c.ctl + CW_CUR + 64, c.ctl + CW_NRT + 1, POS, SLOTTOK, TILEEXP);)
#endif
    SEAM(17);
#if USE_PG8_MOE
    PHASE(18, moe_up_tuned<1>(c, ws);)
    SEAM(18);
    PHASE(19, moe_down_tuned<1>(c, ws);)
#else
    PHASE(18, moe_up_phase(c, HF, WUP + (size_t)NEX * UPN * D, SLOTTOK, TILEEXP, c.ctl + CW_NRT + 1, ACT);)
    SEAM(18);
    PHASE(19, moe_down_phase(c, ACT, WDN + (size_t)NEX * D * ED, TILEEXP, c.ctl + CW_NRT + 1, Y);)
#endif
    SEAM(19);
    PHASE(20, combine_phase<false>(c, X1, Y, POS, GATE, ada1, OUTP, nullptr, nullptr, nullptr);)
#if PROBE_SEL >= 0
    {
        __syncthreads();
        unsigned long long v = 0ull;
        if (c.tid == 0) {
            if (PROBE_SEL >= 100) { const int k = PROBE_SEL - 100; v = stamp_[2 + 2 * k] - (k == 0 ? stamp_[0] : stamp_[2 + 2 * (k - 1)]); }
            else if (PROBE_SEL == 1 || PROBE_SEL == 2) { for (int k = 0; k < NPHASE - 1; ++k) v += stamp_[2 + 2 * k] - stamp_[1 + 2 * k]; }
            else if (PROBE_SEL == 3) { v = stamp_[1 + 2 * 19] - stamp_[0]; }
        }
        if (PROBE_SEL == 2) {
            if (c.tid == 0) __hip_atomic_fetch_add((unsigned long long*)(c.ctl + CW_QCTR + 64), v, __ATOMIC_RELAXED, __HIP_MEMORY_SCOPE_AGENT);
            xcd_barrier(bar);
            if (c.tid == 0) v = __hip_atomic_load((unsigned long long*)(c.ctl + CW_QCTR + 64), __ATOMIC_RELAXED, __HIP_MEMORY_SCOPE_AGENT) / gridDim.x;
        }
        if (blockIdx.x == 0 && c.tid == 0) { const unsigned long long t0 = __builtin_amdgcn_s_memrealtime(), w = v * PROBE_GAIN;
            while (__builtin_amdgcn_s_memrealtime() - t0 < w) __builtin_amdgcn_s_sleep(8); }
    }
#endif
#undef IN
#undef SEAM
#undef ada
#undef ada1
#undef W0IN
#undef W0OUT
#undef W1IN
#undef W1OUT
#undef WUP
#undef WDN
#undef XN
#undef QKV
#undef OBUF
#undef X1
#undef HF
#undef IDX
#undef GATE
#undef POS
#undef SLOTTOK
#undef TILEEXP
#undef ACT
#undef Y
#undef TMP
#undef XIN
#undef cin
#undef norm_mix
#undef norm_ffn
#undef w_ada
#undef b_ada
#undef OUTP
}

extern "C" void kernel_launch(void* const* d_in, const int* in_sizes, int n_in, void* d_out, int out_size, void* d_ws, size_t ws_size, hipStream_t stream) {
    static int grid = 0;
    if (grid == 0) {
        if (n_in != 21 || out_size != M * D || ws_size < WS_END) { fprintf(stderr, "kernel_launch: unexpected sizes (n_in %d out %d ws %zu need %zu)\n", n_in, out_size, ws_size, (size_t)WS_END); grid = -1; return; }
        int dev = 0, cus = 0, per_cu = 0;
        hipGetDevice(&dev); hipDeviceGetAttribute(&cus, hipDeviceAttributeMultiprocessorCount, dev);
        if (hipFuncSetAttribute((const void*)mega, hipFuncAttributeMaxDynamicSharedMemorySize, LDS_BYTES) != hipSuccess) { fprintf(stderr, "kernel_launch: hipFuncSetAttribute failed\n"); grid = -1; return; }
        hipOccupancyMaxActiveBlocksPerMultiprocessor(&per_cu, (const void*)mega, 512, LDS_BYTES);
        (void)hipGetLastError();
        if (per_cu < 1) fprintf(stderr, "kernel_launch: occupancy query says %d blocks per CU\n", per_cu);
        grid = cus;
    }
    if (grid < 0) return;
    hipMemsetAsync((char*)d_ws + WS_CTL, 0, CTL_BYTES, stream);
    Args a{};
    for (int i = 0; i < 21; ++i) a.in[i] = (const float*)d_in[i];
    a.out = (float*)d_out; a.ws = (unsigned char*)d_ws;
#if MK_SPLIT
    for (int p = 0; p < NPHASE; ++p) { a.ph_lo = p; a.ph_hi = p + 1; hipLaunchKernelGGL(mega, dim3(grid), dim3(512), LDS_BYTES, stream, a); }
#else
    a.ph_lo = 0; a.ph_hi = NPHASE; hipLaunchKernelGGL(mega, dim3(grid), dim3(512), LDS_BYTES, stream, a);
#endif
}
```

```cpp
#include <hip/hip_runtime.h>
#include <cstdio>
#include <cstdint>
#include <hip/hip_bf16.h>

#ifndef USE_PG8_OUT
#define USE_PG8_OUT 1
#endif
#ifndef USE_PG8_QKV
#define USE_PG8_QKV 1
#endif
#ifndef USE_PG8_MOE
#define USE_PG8_MOE 1
#endif
#ifndef USE_ATT1
#define USE_ATT1 1
#endif
#ifndef USE_ATT0
#define USE_ATT0 1
#endif
#ifndef USE_ROUTER2
#define USE_ROUTER2 1
#endif
#ifndef REPMASK
#define REPMASK 0u
#endif
#ifndef USE_FP8_MOE
#define USE_FP8_MOE 1
#endif
#ifndef USE_CONV128
#define USE_CONV128 1
#endif
#ifndef USE_FP8_QKV
#define USE_FP8_QKV 1
#endif
#ifndef SHARED_BF16
#define SHARED_BF16 0
#endif
#ifndef Y_FP8
#define Y_FP8 1
#endif
#ifndef DEFER_CONV
#define DEFER_CONV 1
#endif
#ifndef RES_BF16
#define RES_BF16 1
#endif
#ifndef FUSE_FINISH
#define FUSE_FINISH 1
#endif
#ifndef PROBE_SEL
#define PROBE_SEL -1
#endif
#ifndef PROBE_GAIN
#define PROBE_GAIN 4
#endif
#ifndef QKV_HEADMAJOR
#define QKV_HEADMAJOR 1
#endif
#ifndef USE_V128
#define USE_V128 1
#endif
#ifndef MK_SPLIT
#define MK_SPLIT 0
#endif

constexpr int D = 2048, NB = 4, T = 4096, M = NB * T;
constexpr int HD = 64;
constexpr int AB_IN = 4352, C_IN = 6144;
constexpr int NE = 64, TOPK = 8, ED = 512;
constexpr int UPN = 2 * ED;
constexpr int NEX = NE + 1;
constexpr int CAPR = M * TOPK + NE * 256;
constexpr int CAP = CAPR + M;
constexpr int MAXTILES = CAP / 256;
constexpr float RMS_EPS = 1e-6f;
constexpr int NPHASE = 21;

typedef unsigned short bf16;
typedef short bf16x8 __attribute__((ext_vector_type(8)));
typedef float f32x4 __attribute__((ext_vector_type(4)));
typedef unsigned u32x4 __attribute__((ext_vector_type(4)));
typedef unsigned u32x2 __attribute__((ext_vector_type(2)));
#define LAS __attribute__((address_space(3)))

constexpr size_t MiB = 1u << 20;
constexpr size_t WS_CTL = 0, CTL_BYTES = 1 * MiB;
constexpr size_t WS_ADA = 1 * MiB;
constexpr size_t WS_W0IN = 2 * MiB;
constexpr size_t WS_W0OUT = WS_W0IN + (size_t)AB_IN * D * 2;
constexpr size_t WS_W1IN = WS_W0OUT + (size_t)D * D * 2;
constexpr size_t WS_W1OUT = WS_W1IN + (size_t)C_IN * D * 2;
constexpr size_t WS_WUP = WS_W1OUT + (size_t)D * D * 2;
constexpr size_t WS_WDN = WS_WUP + (size_t)2 * NEX * UPN * D * 2;
constexpr size_t WS_XN = WS_WDN + (size_t)2 * NEX * D * ED * 2;
constexpr size_t WS_QKV = WS_XN + (size_t)M * D * 2;
constexpr size_t WS_O = WS_QKV + (size_t)M * C_IN * 2;
constexpr size_t WS_X1 = WS_O + (size_t)M * D * 2;
constexpr size_t WS_HF = WS_X1 + (size_t)M * D * 4;
constexpr size_t WS_IDX = WS_HF + (size_t)M * D * 2;
constexpr size_t WS_GATE = WS_IDX + (size_t)M * 8 * 4;
constexpr size_t WS_POS = WS_GATE + (size_t)M * 8 * 4;
constexpr size_t WS_SLOTTOK = WS_POS + (size_t)M * 8 * 4;
constexpr size_t WS_TILEEXP = WS_SLOTTOK + (size_t)CAP * 4;
constexpr size_t WS_ACT = WS_TILEEXP + 4096;
constexpr size_t WS_Y = WS_ACT + (size_t)CAP * ED * 2;
constexpr size_t WS_TMP = WS_Y + (size_t)CAP * D * 2;
constexpr size_t WS_WRT = WS_TMP + (size_t)M * 16 * 2 * 128 * 4;
constexpr size_t WS_WCNT = WS_WRT + (size_t)2 * 2 * NE * D * 2;
constexpr size_t WS_HFB = WS_WCNT + (size_t)4096 * 64 * 4;
constexpr size_t WS_ACTS = WS_HFB + (size_t)M * D * 2;
constexpr size_t WS_WUPS = WS_ACTS + (size_t)M * ED * 2;
constexpr size_t WS_WDNS = WS_WUPS + (size_t)2 * UPN * D * 2;
constexpr size_t WS_END = WS_WDNS + (size_t)2 * D * ED * 2;
constexpr int CW_BAR = 4096;
constexpr int CW_CNT = 16384;
constexpr int CW_CUR = 16384 + 256;
constexpr int CW_NRT = 16384 + 512;
constexpr int CW_QCTR = 16384 + 1024;

constexpr int LDS_BYTES = 147456;

__device__ __forceinline__ unsigned pk4_fp8(float a, float b, float c2, float d);
constexpr float F8_WSCALE = 256.f, F8_HSCALE = 16.f, F8_ASCALE = 8.f, F8_YSCALE = 32.f;
__device__ __forceinline__ float bf2f(unsigned v) { return __uint_as_float(v << 16); }
__device__ __forceinline__ unsigned f2bf(float f) { unsigned u = __float_as_uint(f); return (u + 0x7fffu + ((u >> 16) & 1u)) >> 16; }
__device__ __forceinline__ unsigned pk2(float lo, float hi) { return f2bf(lo) | (f2bf(hi) << 16); }
__device__ __forceinline__ float wave_sum(float v) {
#pragma unroll
    for (int o = 1; o < 64; o <<= 1) v += __shfl_xor(v, o);
    return v;
}
__device__ __forceinline__ float siluf(float x) { return x / (1.f + __expf(-x)); }

#define XB_TMO      128
#define XB_XCNT(j)  (256  + 64 * (j))
#define XB_XSUB(j)  (1280 + 64 * (j))
#define XB_XGEN(j)  (2304 + 64 * (j))
#define XB_TOP      3328
#define XB_TOPGEN   3392
#define XCD_BAR_WORDS 3456
#define XB_SPIN_CAP (1u << 22)
__device__ __forceinline__ unsigned xb_ld(unsigned* p)              { return __hip_atomic_load(p, __ATOMIC_RELAXED, __HIP_MEMORY_SCOPE_AGENT); }
__device__ __forceinline__ unsigned xb_add(unsigned* p, unsigned v) { return __hip_atomic_fetch_add(p, v, __ATOMIC_RELAXED, __HIP_MEMORY_SCOPE_AGENT); }
__device__ __forceinline__ unsigned xb_xcc_id() { return (unsigned)__builtin_amdgcn_s_getreg((3 << 11) | 20) & 0xFu; }
#define XB_SPIN(cond, bar) do { unsigned _sp = 0; while (cond) { __builtin_amdgcn_s_sleep(1); \
    if ((++_sp & 255u) == 0u) { if (xb_ld(&(bar)[XB_TMO])) break; if (_sp > XB_SPIN_CAP) { atomicAdd(&(bar)[XB_TMO], 1u); break; } } } } while (0)
struct XcdBarrier { unsigned* bar; unsigned x; volatile LAS unsigned* st; };
__device__ __forceinline__ XcdBarrier xcd_barrier_post(unsigned* bar, volatile LAS unsigned* st) {
    XcdBarrier b; b.bar = bar; b.x = xb_xcc_id(); b.st = st;
    if (threadIdx.x == 0) (void)xb_add(&bar[XB_XCNT(b.x)], 1u);
    return b;
}
__device__ __forceinline__ void xcd_barrier_complete(unsigned* bar, unsigned x, unsigned& nloc, unsigned& nx) {
    const unsigned G = gridDim.x * gridDim.y * gridDim.z;
    unsigned sum, cnt, mine, sp = 0u;
    for (;;) {
        sum = 0u; cnt = 0u; mine = 0u;
#pragma unroll
        for (unsigned j = 0; j < 16; ++j) { const unsigned c = xb_ld(&bar[XB_XCNT(j)]); sum += c; cnt += (c > 0u) ? 1u : 0u; mine = (j == x) ? c : mine; }
        if (sum == G) break;
        __builtin_amdgcn_s_sleep(1);
        if ((++sp & 255u) == 0u) { if (xb_ld(&bar[XB_TMO])) break; if (sp > XB_SPIN_CAP) { atomicAdd(&bar[XB_TMO], 1u); break; } }
    }
    nloc = mine > 0u ? mine : 1u; nx = cnt > 0u ? cnt : 1u;
}
__device__ __forceinline__ void xcd_barrier(const XcdBarrier& b) {
    asm volatile("s_waitcnt vmcnt(0)" ::: "memory");
    __syncthreads();
    if (threadIdx.x == 0) {
        unsigned* bar = b.bar;
        __builtin_amdgcn_s_waitcnt(0);
        unsigned nloc = b.st[0], nx = b.st[1];
        if (nloc == 0u) { xcd_barrier_complete(bar, b.x, nloc, nx); b.st[0] = nloc; b.st[1] = nx; }
        const unsigned old = xb_add(&bar[XB_XSUB(b.x)], 1u);
        const unsigned gen = old / nloc;
        if (old + 1u == (gen + 1u) * nloc) {
            __builtin_amdgcn_fence(__ATOMIC_RELEASE, "agent");
            asm volatile("s_waitcnt vmcnt(0)" ::: "memory");
            const unsigned og = xb_add(&bar[XB_TOP], 1u);
            const unsigned tg = og / nx;
            if (og + 1u == (tg + 1u) * nx) xb_add(&bar[XB_TOPGEN], 1u);
            else XB_SPIN(xb_ld(&bar[XB_TOPGEN]) == tg, bar);
            __builtin_amdgcn_fence(__ATOMIC_ACQUIRE, "agent");
            xb_add(&bar[XB_XGEN(b.x)], 1u);
            asm volatile("s_waitcnt vmcnt(0)" ::: "memory");
        } else {
            XB_SPIN(xb_ld(&bar[XB_XGEN(b.x)]) == gen, bar);
            __builtin_amdgcn_fence(__ATOMIC_ACQUIRE, "agent");
            asm volatile("s_waitcnt vmcnt(0)" ::: "memory");
        }
    }
    __syncthreads();
}

struct Args {
    const float* in[21];
    float* out;
    unsigned char* ws;
    int ph_lo, ph_hi;
};

struct Ctx {
    int tid, lane, wave, gw, ngw, gsz;
    LAS unsigned char* lds;
    unsigned char* ws;
    unsigned* ctl;
};

__device__ __forceinline__ int gtid_now() { int t = (int)(blockIdx.x * 512u + threadIdx.x); asm volatile("" : "+v"(t)); return t; }
template <int MODE> __device__ __forceinline__ int perm_row(int n) {
    if (MODE == 1) { const int nl = n & 255; return (n & ~255) + 128 * ((nl >> 5) & 1) + 32 * (nl >> 6) + (nl & 31); }
    if (MODE == 2) { const int bj = n >> 9, rem = n & 511; return 256 * (rem >> 7) + 128 * bj + (rem & 127); }
    if (MODE == 3) { const int cl = n & 255; return (n & ~255) + 128 * ((cl >> 3) & 1) + 32 * (cl >> 6) + 8 * ((cl >> 4) & 3) + (cl & 7); }
    return n;
}
template <int MODE> __device__ __forceinline__ void transpose_item(const float* W, int K, int N, bf16* WT, LAS float* scr, int item, int lane) {
    const int nblk = N / 32, kb = item / nblk, nb = item % nblk, k0 = 64 * kb, n0 = 32 * nb, d0 = perm_row<MODE>(n0);
#pragma unroll 8
    for (int i = 0; i < 32; ++i) { const int kk = 2 * i + (lane >> 5); scr[kk * 33 + (lane & 31)] = W[(size_t)(k0 + kk) * N + n0 + (lane & 31)]; }
    asm volatile("s_waitcnt lgkmcnt(0)" ::: "memory");
    const int c = lane & 7;
#pragma unroll
    for (int j = 0; j < 4; ++j) { const int n = (lane >> 3) + 8 * j; const LAS float* s = scr + (8 * c) * 33 + n;
        u32x4 o; o.x = pk2(s[0 * 33], s[1 * 33]); o.y = pk2(s[2 * 33], s[3 * 33]); o.z = pk2(s[4 * 33], s[5 * 33]); o.w = pk2(s[6 * 33], s[7 * 33]);
        *(u32x4*)(WT + (size_t)(d0 + n) * K + k0 + 8 * c) = o; }
    asm volatile("s_waitcnt lgkmcnt(0)" ::: "memory");
}
template <int MODE> __device__ __forceinline__ void convert_batch(const Ctx& c, const float* src, int K, int N, bf16* dst, int nmat, size_t dst_stride) {
    LAS float* scr = (LAS float*)(c.lds + c.wave * 16384);
    const int per = (K / 64) * (N / 32); const long total = (long)per * nmat;
    for (long it = c.gw; it < total; it += c.ngw) {
        const int mat = (int)(it / per), item = (int)(it % per);
        transpose_item<MODE>(src + (size_t)mat * K * N, K, N, dst + (size_t)mat * dst_stride, scr, item, c.lane);
    }
}

__device__ __forceinline__ float clamp448(float v) { return __builtin_amdgcn_fmed3f(v, -448.f, 448.f); }
__device__ __forceinline__ unsigned pk4_fp8(float a, float b, float c2, float d) {
    unsigned w = 0u; w = __builtin_amdgcn_cvt_pk_fp8_f32(clamp448(a), clamp448(b), w, false); w = __builtin_amdgcn_cvt_pk_fp8_f32(clamp448(c2), clamp448(d), w, true); return w;
}
template <int MODE> __device__ __forceinline__ void transpose_item_f8(const float* W, int K, int N, unsigned char* WT, LAS float* scr, int item, int lane) {
    const int nblk = N / 32, kb = item / nblk, nb = item % nblk, k0 = 64 * kb, n0 = 32 * nb, d0 = perm_row<MODE>(n0);
#pragma unroll 8
    for (int i = 0; i < 32; ++i) { const int kk = 2 * i + (lane >> 5); scr[kk * 33 + (lane & 31)] = W[(size_t)(k0 + kk) * N + n0 + (lane & 31)]; }
    asm volatile("s_waitcnt lgkmcnt(0)" ::: "memory");
    const int n = lane & 31;
#pragma unroll
    for (int j = 0; j < 2; ++j) { const int ch = (lane >> 5) + 2 * j; const LAS float* s = scr + (16 * ch) * 33 + n; u32x4 o;
#pragma unroll
        for (int q = 0; q < 4; ++q) o[q] = pk4_fp8(s[(4 * q) * 33] * F8_WSCALE, s[(4 * q + 1) * 33] * F8_WSCALE, s[(4 * q + 2) * 33] * F8_WSCALE, s[(4 * q + 3) * 33] * F8_WSCALE);
        *(u32x4*)(WT + (size_t)(d0 + n) * K + k0 + 16 * ch) = o; }
    asm volatile("s_waitcnt lgkmcnt(0)" ::: "memory");
}
template <int MODE> __device__ __forceinline__ void convert_batch_f8(const Ctx& c, const float* src, int K, int N, unsigned char* dst, int nmat, size_t dst_stride) {
    LAS float* scr = (LAS float*)(c.lds + c.wave * 16384);
    const int per = (K / 64) * (N / 32); const long total = (long)per * nmat;
    for (long it = c.gw; it < total; it += c.ngw) {
        const int mat = (int)(it / per), item = (int)(it % per);
        transpose_item_f8<MODE>(src + (size_t)mat * K * N, K, N, dst + (size_t)mat * dst_stride, scr, item, c.lane);
    }
}

__device__ __forceinline__ void t128_load(f32x4 (&v)[16], const float* W, int N, int item, int lane) {
    const int nblk = N / 32, kb = item / nblk, nb = item % nblk, k0 = 128 * kb, n0 = 32 * nb;
    const int kr = lane >> 3, nq = lane & 7;
#pragma unroll
    for (int i = 0; i < 16; ++i) v[i] = *(const f32x4*)(W + (size_t)(k0 + 8 * i + kr) * N + n0 + 4 * nq);
}
template <int MODE, bool F8> __device__ __forceinline__ void t128_finish(const f32x4 (&v)[16], int K, int N, unsigned char* WT, LAS float* scr, int item, int lane, float scale) {
    const int nblk = N / 32, kb = item / nblk, nb = item % nblk, k0 = 128 * kb, n0 = 32 * nb, d0 = perm_row<MODE>(n0);
    const int kr = lane >> 3, nq = lane & 7;
#pragma unroll
    for (int i = 0; i < 16; ++i) { LAS float* s = scr + (8 * i + kr) * 33 + 4 * nq; s[0] = v[i].x; s[1] = v[i].y; s[2] = v[i].z; s[3] = v[i].w; }
    asm volatile("s_waitcnt lgkmcnt(0)" ::: "memory");
    const int n = lane & 31, half = lane >> 5; const LAS float* s0 = scr + (64 * half) * 33 + n;
    if (F8) {
        const int rs = lane >> 2, pc = lane & 3; (void)s0; (void)half;
#pragma unroll
        for (int it = 0; it < 4; ++it) { const int nn = rs + 16 * (it & 1), hs = it >> 1; const LAS float* s = scr + (64 * hs + 16 * pc) * 33 + nn; u32x4 o;
#pragma unroll
            for (int q = 0; q < 4; ++q) o[q] = pk4_fp8(s[(4 * q) * 33] * scale, s[(4 * q + 1) * 33] * scale, s[(4 * q + 2) * 33] * scale, s[(4 * q + 3) * 33] * scale);
            *(u32x4*)(WT + (size_t)(MODE == 3 ? perm_row<MODE>(n0 + nn) : d0 + nn) * K + k0 + 64 * hs + 16 * pc) = o; }
    } else {
        bf16* dst = (bf16*)WT + (size_t)(d0 + n) * K + k0 + 64 * half;
#pragma unroll
        for (int ch = 0; ch < 8; ++ch) { const LAS float* s = s0 + (8 * ch) * 33; u32x4 o;
#pragma unroll
            for (int q = 0; q < 4; ++q) o[q] = pk2(s[(2 * q) * 33], s[(2 * q + 1) * 33]);
            *(u32x4*)(dst + 8 * ch) = o; }
    }
    asm volatile("s_waitcnt lgkmcnt(0)" ::: "memory");
}
template <int MODE, bool F8> __device__ __forceinline__ void transpose_item128(const float* W, int K, int N, unsigned char* WT, LAS float* scr, int item, int lane, float scale) {
    asm volatile("" : "+v"(lane));
    f32x4 v[16];
    t128_load(v, W, N, item, lane);
    t128_finish<MODE, F8>(v, K, N, WT, scr, item, lane, scale);
}
template <int QM, bool F8Q> __device__ __forceinline__ void convert_dense_all(const Ctx& c, const float* w0in, const float* w1in, const float* w0out, const float* w1out,
                                                                              unsigned char* W0IN_, unsigned char* W1IN_, unsigned char* W0OUT_, unsigned char* W1OUT_, float sq) {
    constexpr int n0 = 16 * (AB_IN / 32), n1 = 16 * (C_IN / 32), n2 = 16 * (D / 32), TOT = n0 + n1 + 2 * n2;
    LAS float* scr = (LAS float*)(c.lds + c.wave * 16896);
    const int lane = c.lane, ngw = c.ngw;
#define DENSE_LOAD(v, it) do { if ((it) < n0) t128_load(v, w0in, AB_IN, (it), lane); else if ((it) < n0 + n1) t128_load(v, w1in, C_IN, (it) - n0, lane); \
        else if ((it) < n0 + n1 + n2) t128_load(v, w0out, D, (it) - n0 - n1, lane); else t128_load(v, w1out, D, (it) - n0 - n1 - n2, lane); } while (0)
#define DENSE_FIN(v, it) do { if ((it) < n0 + n1) { const bool f_ = (it) < n0; t128_finish<QM, F8Q>(v, D, f_ ? AB_IN : C_IN, f_ ? W0IN_ : W1IN_, scr, f_ ? (it) : (it) - n0, lane, sq); } \
        else { const bool f_ = (it) < n0 + n1 + n2; t128_finish<0, false>(v, D, D, f_ ? W0OUT_ : W1OUT_, scr, f_ ? (it) - n0 - n1 : (it) - n0 - n1 - n2, lane, 1.f); } } while (0)
    int it = c.gw;
    f32x4 va[16], vb[16];
    if (it < TOT) DENSE_LOAD(va, it);
    while (it < TOT) {
        const int it1 = it + ngw, it2 = it1 + ngw;
        if (it1 < TOT) DENSE_LOAD(vb, it1);
        DENSE_FIN(va, it);
        if (it2 < TOT) DENSE_LOAD(va, it2);
        if (it1 < TOT) DENSE_FIN(vb, it1);
        it = it2;
    }
#undef DENSE_LOAD
#undef DENSE_FIN
}
template <int MODE, bool F8> __device__ __forceinline__ void convert_batch128(const Ctx& c, const float* src, int K, int N, void* dst, int nmat, size_t dst_stride_bytes, float scale) {
    LAS float* scr = (LAS float*)(c.lds + c.wave * 16896);
    const int per = (K / 128) * (N / 32); const long total = (long)per * nmat;
    for (long it = c.gw; it < total; it += c.ngw) {
        const int mat = (int)(it / per), item = (int)(it % per);
        transpose_item128<MODE, F8>(src + (size_t)mat * K * N, K, N, (unsigned char*)dst + (size_t)mat * dst_stride_bytes, scr, item, c.lane, scale);
    }
}

struct ExpertSrc { const float* up; const float* sup; const float* dn; const float* sdn; };
constexpr int EXP_ITEMS_UP = NE * 512, EXP_ITEMS_SUP = 512, EXP_ITEMS_DN = NE * 256, EXP_ITEMS_SDN = 256, EXP_ITEMS = EXP_ITEMS_UP + EXP_ITEMS_SUP + EXP_ITEMS_DN + EXP_ITEMS_SDN;
__device__ __forceinline__ void expert_item(const ExpertSrc& s, int l, unsigned char* ws, LAS float* scr, int it, int lane) {
    unsigned char* wup = ws + WS_WUP + (size_t)l * NEX * UPN * D; unsigned char* wdn = ws + WS_WDN + (size_t)l * NEX * D * ED;
    if (it < EXP_ITEMS_UP) { const int mat = it >> 9; transpose_item128<2, true>(s.up + ((size_t)l * NE + mat) * D * UPN, D, UPN, wup + (size_t)mat * UPN * D, scr, it & 511, lane, F8_WSCALE); return; }
    it -= EXP_ITEMS_UP;
    if (it < EXP_ITEMS_SUP) { transpose_item128<2, true>(s.sup + (size_t)l * D * UPN, D, UPN, wup + (size_t)NE * UPN * D, scr, it, lane, F8_WSCALE); return; }
    it -= EXP_ITEMS_SUP;
    if (it < EXP_ITEMS_DN) { const int mat = it >> 8; transpose_item128<0, true>(s.dn + ((size_t)l * NE + mat) * ED * D, ED, D, wdn + (size_t)mat * D * ED, scr, it & 255, lane, F8_WSCALE); return; }
    it -= EXP_ITEMS_DN;
    transpose_item128<0, true>(s.sdn + (size_t)l * ED * D, ED, D, wdn + (size_t)NE * D * ED, scr, it, lane, F8_WSCALE);
}
struct ERef { const float* W; int N, item; };
__device__ __forceinline__ ERef expert_ref(const ExpertSrc& s, int l, int it) {
    if (it < EXP_ITEMS_UP) return ERef{s.up + ((size_t)l * NE + (it >> 9)) * D * UPN, UPN, it & 511};
    it -= EXP_ITEMS_UP;
    if (it < EXP_ITEMS_SUP) return ERef{s.sup + (size_t)l * D * UPN, UPN, it};
    it -= EXP_ITEMS_SUP;
    if (it < EXP_ITEMS_DN) return ERef{s.dn + ((size_t)l * NE + (it >> 8)) * ED * D, D, it & 255};
    it -= EXP_ITEMS_DN;
    return ERef{s.sdn + (size_t)l * ED * D, D, it};
}
__device__ __forceinline__ void expert_fin(const f32x4 (&v)[16], int l, unsigned char* ws, LAS float* scr, int it, int lane) {
    if (it < EXP_ITEMS_UP + EXP_ITEMS_SUP) { const bool r = it < EXP_ITEMS_UP; const int mat = r ? it >> 9 : NE, item = r ? it & 511 : it - EXP_ITEMS_UP;
        t128_finish<2, true>(v, D, UPN, ws + WS_WUP + ((size_t)l * NEX + mat) * UPN * D, scr, item, lane, F8_WSCALE); }
    else { it -= EXP_ITEMS_UP + EXP_ITEMS_SUP; const bool r = it < EXP_ITEMS_DN; const int mat = r ? it >> 8 : NE, item = r ? it & 255 : it - EXP_ITEMS_DN;
        t128_finish<Y_FP8 ? 3 : 0, true>(v, ED, D, ws + WS_WDN + ((size_t)l * NEX + mat) * D * ED, scr, item, lane, F8_WSCALE); }
}
__device__ __forceinline__ void expert_items_block(const Ctx& c, const ExpertSrc& s, int l, unsigned char* ws, int first, int count) {
    int tid = threadIdx.x; asm volatile("" : "+v"(tid));
    const int lane = tid & 63, wv = __builtin_amdgcn_readfirstlane(tid >> 6);
    LAS float* scr = (LAS float*)(c.lds + wv * 16896);
    f32x4 va[16], vb[16];
    int i = wv;
    if (i < count) { const ERef r = expert_ref(s, l, first + i); t128_load(va, r.W, r.N, r.item, lane); }
#pragma unroll 1
    while (i < count) {
        const int i1 = i + 8, i2 = i + 16;
        if (i1 < count) { const ERef r = expert_ref(s, l, first + i1); t128_load(vb, r.W, r.N, r.item, lane); }
        expert_fin(va, l, ws, scr, first + i, lane);
        if (i2 < count) { const ERef r = expert_ref(s, l, first + i2); t128_load(va, r.W, r.N, r.item, lane); }
        if (i1 < count) expert_fin(vb, l, ws, scr, first + i1, lane);
        i = i2;
    }
}
__device__ __forceinline__ void ada_phase(const Ctx& c, const float* cin, const float* w_ada, const float* b_ada, float* ada) {
    LAS float* red = (LAS float*)(c.lds);
    LAS float* sc = red + 1024;
    for (int i = c.tid; i < 4 * D; i += 512) sc[i] = siluf(cin[i]);
    __syncthreads();
    const int j = c.lane & 7, kr = c.lane >> 3;
    constexpr int NCG = 6 * D / 32;
    for (int u = blockIdx.x; u < 2 * NCG; u += gridDim.x) {
        const int l = u / NCG, cg = u % NCG;
        const int k0 = c.wave * 256 + kr;
        const float* w = w_ada + (size_t)l * D * 6 * D + (size_t)k0 * 6 * D + cg * 32 + 4 * j;
        f32x4 acc[4];
#pragma unroll
        for (int b = 0; b < 4; ++b) acc[b] = (f32x4){0.f, 0.f, 0.f, 0.f};
        f32x4 wv[32];
#pragma unroll
        for (int i = 0; i < 32; ++i) wv[i] = *(const f32x4*)(w + (size_t)(8 * i) * 6 * D);
#pragma unroll
        for (int i = 0; i < 32; ++i)
#pragma unroll
            for (int b = 0; b < 4; ++b) acc[b] += wv[i] * sc[b * D + k0 + 8 * i];
#pragma unroll
        for (int b = 0; b < 4; ++b)
#pragma unroll
            for (int q = 0; q < 4; ++q) { float t = acc[b][q]; t += __shfl_xor(t, 8); t += __shfl_xor(t, 16); t += __shfl_xor(t, 32); acc[b][q] = t; }
        if (kr == 0) {
#pragma unroll
            for (int b = 0; b < 4; ++b) *(LAS f32x4*)(red + (c.wave * 4 + b) * 32 + 4 * j) = acc[b]; }
        __syncthreads();
        if (c.tid < 128) {
            const int b = c.tid >> 5, cc = c.tid & 31; float s2 = b_ada[(size_t)l * 6 * D + cg * 32 + cc];
#pragma unroll
            for (int w8 = 0; w8 < 8; ++w8) s2 += red[(w8 * 4 + b) * 32 + cc];
            ada[((size_t)l * 4 + b) * 6 * D + cg * 32 + cc] = s2;
        }
        __syncthreads();
    }
}

__device__ __forceinline__ void load_row(const float* xrow, int lane, f32x4 (&v)[8]) {
#pragma unroll
    for (int j = 0; j < 8; ++j) v[j] = *(const f32x4*)(xrow + 4 * lane + 256 * j);
}
__device__ __forceinline__ float row_rstd(const f32x4 (&v)[8]) {
    float s = 0.f;
#pragma unroll
    for (int j = 0; j < 8; ++j) s += (v[j].x * v[j].x + v[j].y * v[j].y) + (v[j].z * v[j].z + v[j].w * v[j].w);
    return 1.f / sqrtf(wave_sum(s) * (1.f / D) + RMS_EPS);
}
__device__ __forceinline__ void modulate_row(f32x4 (&v)[8], float rstd, const float* g, const float* sh, const float* sc, int lane) {
#pragma unroll
    for (int j = 0; j < 8; ++j) { const int col = 4 * lane + 256 * j;
        const f32x4 gg = *(const f32x4*)(g + col), s1 = *(const f32x4*)(sc + col), s0 = *(const f32x4*)(sh + col);
        v[j] = v[j] * rstd * gg * (s1 + 1.f) + s0; }
}
__device__ __forceinline__ void store_row_bf16(bf16* orow, const f32x4 (&v)[8], int lane) {
#pragma unroll
    for (int j = 0; j < 8; ++j) { u32x2 w; w.x = pk2(v[j].x, v[j].y); w.y = pk2(v[j].z, v[j].w); *(u32x2*)(orow + 4 * lane + 256 * j) = w; }
}
__device__ __forceinline__ void store_row_fp8(unsigned char* orow, const f32x4 (&v)[8], int lane, float scale) {
#pragma unroll
    for (int j = 0; j < 8; ++j) *(unsigned*)(orow + 4 * lane + 256 * j) = pk4_fp8(v[j].x * scale, v[j].y * scale, v[j].z * scale, v[j].w * scale);
}
__device__ __forceinline__ void norm_phase(const Ctx& c, const float* x, const float* g, const float* ada_l  , int sh_off, int sc_off, bf16* out) {
    for (int m = c.gw; m < M; m += c.ngw) {
        const int b = m / T; f32x4 v[8]; load_row(x + (size_t)m * D, c.lane, v);
        const float rstd = row_rstd(v);
        modulate_row(v, rstd, g, ada_l + (size_t)b * 6 * D + sh_off, ada_l + (size_t)b * 6 * D + sc_off, c.lane);
#if USE_FP8_QKV
        store_row_fp8((unsigned char*)out + (size_t)m * D, v, c.lane, F8_HSCALE);
#else
        store_row_bf16(out + (size_t)m * D, v, c.lane);
#endif
    }
}

__device__ __forceinline__ void wave_gemm_32x64(const bf16* a0, const bf16* a1, const bf16* b, int K, int lane, f32x4 (&acc)[2][4]) {
    const int q8 = (lane >> 4) * 8;
    for (int k0 = 0; k0 < K; k0 += 32) {
        const bf16x8 fa0 = *(const bf16x8*)(a0 + k0 + q8), fa1 = *(const bf16x8*)(a1 + k0 + q8);
#pragma unroll
        for (int n = 0; n < 4; ++n) { const bf16x8 fb = *(const bf16x8*)(b + (size_t)n * 16 * K + k0 + q8);
            acc[0][n] = __builtin_amdgcn_mfma_f32_16x16x32_bf16(fa0, fb, acc[0][n], 0, 0, 0);
            acc[1][n] = __builtin_amdgcn_mfma_f32_16x16x32_bf16(fa1, fb, acc[1][n], 0, 0, 0); }
    }
}
#define ZERO_ACC(acc) do { _Pragma("unroll") for (int _a = 0; _a < 2; ++_a) _Pragma("unroll") for (int _b = 0; _b < 4; ++_b) acc[_a][_b] = (f32x4){0.f, 0.f, 0.f, 0.f}; } while (0)

__device__ __forceinline__ void gemm_plain_bf16(const Ctx& c, const bf16* A, const bf16* Bt, int K, int N, bf16* C) {
    const int ntn = N / 64, units = (M / 256) * ntn;
    for (int u = blockIdx.x; u < units; u += gridDim.x) {
        const int mt = u / ntn, nt = u % ntn, row0 = mt * 256 + c.wave * 32, n0 = nt * 64;
        f32x4 acc[2][4]; ZERO_ACC(acc);
        const int r = c.lane & 15;
        wave_gemm_32x64(A + (size_t)(row0 + r) * K, A + (size_t)(row0 + 16 + r) * K, Bt + (size_t)(n0 + r) * K, K, c.lane, acc);
#pragma unroll
        for (int mi = 0; mi < 2; ++mi)
#pragma unroll
            for (int n = 0; n < 4; ++n)
#pragma unroll
                for (int j = 0; j < 4; ++j) C[(size_t)(row0 + 16 * mi + 4 * (c.lane >> 4) + j) * N + n0 + 16 * n + r] = (bf16)f2bf(acc[mi][n][j]);
    }
}
__device__ __forceinline__ void gemm_outproj(const Ctx& c, const bf16* A, const bf16* Bt, const float* xin, const float* gm  , float* X1) {
    const int K = D, N = D, ntn = N / 64, units = (M / 256) * ntn;
    for (int u = blockIdx.x; u < units; u += gridDim.x) {
        const int mt = u / ntn, nt = u % ntn, row0 = mt * 256 + c.wave * 32, n0 = nt * 64;
        f32x4 acc[2][4]; ZERO_ACC(acc);
        const int r = c.lane & 15;
        wave_gemm_32x64(A + (size_t)(row0 + r) * K, A + (size_t)(row0 + 16 + r) * K, Bt + (size_t)(n0 + r) * K, K, c.lane, acc);
        const int b = row0 / T;
#pragma unroll
        for (int mi = 0; mi < 2; ++mi)
#pragma unroll
            for (int n = 0; n < 4; ++n)
#pragma unroll
                for (int j = 0; j < 4; ++j) { const size_t o = (size_t)(row0 + 16 * mi + 4 * (c.lane >> 4) + j) * N + n0 + 16 * n + r;
                    X1[o] = xin[o] + gm[(size_t)b * 6 * D + n0 + 16 * n + r] * acc[mi][n][j]; }
    }
}

__device__ __forceinline__ void qknorm_chunk(bf16* p, const float* g) {
    float v[64]; float ss = 0.f;
#pragma unroll
    for (int i = 0; i < 8; ++i) { const u32x4 w = *(const u32x4*)(p + 8 * i);
#pragma unroll
        for (int j = 0; j < 4; ++j) { v[8 * i + 2 * j] = bf2f(w[j] & 0xffffu); v[8 * i + 2 * j + 1] = bf2f(w[j] >> 16); } }
#pragma unroll
    for (int i = 0; i < 64; ++i) ss += v[i] * v[i];
    const float rs = 1.f / sqrtf(ss * (1.f / 64.f) + RMS_EPS);
#pragma unroll
    for (int i = 0; i < 8; ++i) { u32x4 w;
#pragma unroll
        for (int j = 0; j < 4; ++j) w[j] = pk2(v[8 * i + 2 * j] * rs * g[8 * i + 2 * j], v[8 * i + 2 * j + 1] * rs * g[8 * i + 2 * j + 1]);
        *(u32x4*)(p + 8 * i) = w; }
}
__device__ __forceinline__ void qknorm0_phase(const Ctx& c, bf16* qkv, const float* gains  ) {
    const long total = (long)M * 50;
    for (long id = gtid_now(); id < total; id += c.gsz) {
        const int m = (int)(id / 50), k = (int)(id % 50); int ch, gi;
        if (k < 16) { ch = k; gi = 0; } else if (k < 32) { ch = k; gi = 1; } else if (k < 48) { ch = k + 16; gi = 2; } else { ch = k + 16; gi = 3; }
        qknorm_chunk(qkv + (size_t)m * AB_IN + 64 * ch, gains + 64 * gi);
    }
}
__device__ __forceinline__ void qknorm1_phase(const Ctx& c, bf16* qkv, const float* gains  ) {
    const long total = (long)M * 64;
    for (long id = gtid_now(); id < total; id += c.gsz) {
        const int m = (int)(id / 64), ch = (int)(id % 64);
        qknorm_chunk(qkv + (size_t)m * C_IN + 64 * ch, gains + 64 * (ch >> 5));
    }
}

__device__ __forceinline__ void load64(const bf16* p, float (&v)[64], float scale) {
#pragma unroll
    for (int i = 0; i < 8; ++i) { const u32x4 w = *(const u32x4*)(p + 8 * i);
#pragma unroll
        for (int j = 0; j < 4; ++j) { v[8 * i + 2 * j] = bf2f(w[j] & 0xffffu) * scale; v[8 * i + 2 * j + 1] = bf2f(w[j] >> 16) * scale; } }
}
__device__ __forceinline__ float dot64(const float (&q)[64], const bf16* kp) {
    float s0 = 0.f, s1 = 0.f;
#pragma unroll
    for (int i = 0; i < 8; ++i) { const u32x4 w = *(const u32x4*)(kp + 8 * i);
#pragma unroll
        for (int j = 0; j < 4; ++j) { s0 += q[8 * i + 2 * j] * bf2f(w[j] & 0xffffu); s1 += q[8 * i + 2 * j + 1] * bf2f(w[j] >> 16); } }
    return s0 + s1;
}
__device__ __forceinline__ void axpy64(float (&o)[64], float a, float p, const bf16* vp) {
#pragma unroll
    for (int i = 0; i < 8; ++i) { const u32x4 w = *(const u32x4*)(vp + 8 * i);
#pragma unroll
        for (int j = 0; j < 4; ++j) { o[8 * i + 2 * j] = o[8 * i + 2 * j] * a + p * bf2f(w[j] & 0xffffu); o[8 * i + 2 * j + 1] = o[8 * i + 2 * j + 1] * a + p * bf2f(w[j] >> 16); } }
}
__device__ __forceinline__ void store64_bf16(bf16* p, const float (&o)[64], float s) {
#pragma unroll
    for (int i = 0; i < 8; ++i) { u32x4 w;
#pragma unroll
        for (int j = 0; j < 4; ++j) w[j] = pk2(o[8 * i + 2 * j] * s, o[8 * i + 2 * j + 1] * s);
        *(u32x4*)(p + 8 * i) = w; }
}
__device__ __forceinline__ void attn0_phase(const Ctx& c, const bf16* qkv, const float* sinks, bf16* O) {
    const long total = (long)32 * M;
    for (long id = gtid_now(); id < total; id += c.gsz) {
        const int hh = (int)(id / M), m = (int)(id % M), b = m / T, t = m % T;
        float q[64], o[64];
#pragma unroll
        for (int i = 0; i < 64; ++i) o[i] = 0.f;
        float mx = -1e30f, l = 0.f;
        if (hh < 16) {
            const int h = hh; const float slope = exp2f(-0.5f * (float)(h + 1));
            load64(qkv + (size_t)m * AB_IN + 64 * h, q, 0.125f);
            const bf16* kb = qkv + (size_t)b * T * AB_IN + 1024 + 64 * h;
            for (int br = 0; br < 3; ++br) {
                const int dil = br == 0 ? 1 : (br == 1 ? 4 : 16);
                for (int j = 0; j <= 128; ++j) {
                    const int s = t - dil * j; if (s < 0) break;
                    const bf16* kp = kb + (size_t)s * AB_IN;
                    const float sc = dot64(q, kp) - slope * (float)(dil * j);
                    const float mn = fmaxf(mx, sc), a = __expf(mx - mn), p = __expf(sc - mn);
                    l = l * a + p; axpy64(o, a, p, kp + 1024); mx = mn;
                }
            }
            store64_bf16(O + (size_t)m * D + 64 * h, o, 1.f / l);
        } else {
            const int h = hh - 16, kvh = h >> 3; const float slope = exp2f(-0.5f * (float)(h + 1));
            load64(qkv + (size_t)m * AB_IN + 3072 + 64 * h, q, 0.125f);
            const bf16* kb = qkv + (size_t)b * T * AB_IN + 4096 + 64 * kvh;
            for (int j = 0; j < 128; ++j) {
                const int s = t - j; if (s < 0) break;
                const bf16* kp = kb + (size_t)s * AB_IN;
                const float sc = dot64(q, kp) - slope * (float)j;
                const float mn = fmaxf(mx, sc), a = __expf(mx - mn), p = __expf(sc - mn);
                l = l * a + p; axpy64(o, a, p, kp + 128); mx = mn;
            }
            const float sk = sinks[h], mn = fmaxf(mx, sk), a = __expf(mx - mn);
            l = l * a + __expf(sk - mn);
            store64_bf16(O + (size_t)m * D + 1024 + 64 * h, o, a / l);
        }
    }
}
__device__ __forceinline__ void attn1_phase(const Ctx& c, const bf16* qkv, float* tmp) {
    const int items = NB * 16 * 2 * 2 * (T / 64);
    for (int it = c.gw; it < items; it += c.ngw) {
        const int tb = (T / 64 - 1) - it / (NB * 16 * 4); const int r = it % (NB * 16 * 4);
        const int b = r / 64, h = (r / 4) % 16, i = (r >> 1) & 1, j = r & 1;
        const int t = tb * 64 + c.lane, m = b * T + t;
        const float slope = exp2f(-0.5f * (float)(h + 1));
        float q[64], o[64];
#pragma unroll
        for (int d = 0; d < 64; ++d) o[d] = 0.f;
        float mx = -1e30f, l = 0.f;
        load64(qkv + (size_t)m * C_IN + 128 * h + 64 * i, q, 0.125f);
        const bf16* kb = qkv + (size_t)b * T * C_IN + 2048 + 128 * h + 64 * i;
        const bf16* vb = qkv + (size_t)b * T * C_IN + 4096 + 128 * h + 64 * j;
        const int smax = tb * 64 + 63;
        for (int s = 0; s <= smax; ++s) {
            const bf16* kp = kb + (size_t)s * C_IN;
            float sc = dot64(q, kp) - slope * (float)(t - s);
            if (s > t) sc = -1e30f;
            const float mn = fmaxf(mx, sc), a = __expf(mx - mn), p = (s > t) ? 0.f : __expf(sc - mn);
            l = l * a + p; axpy64(o, a, p, vb + (size_t)s * C_IN); mx = mn;
        }
        float* op = tmp + (((size_t)m * 16 + h) * 2 + i) * 128 + 64 * j; const float il = 1.f / l;
#pragma unroll
        for (int d = 0; d < 16; ++d) *(f32x4*)(op + 4 * d) = (f32x4){o[4 * d] * il, o[4 * d + 1] * il, o[4 * d + 2] * il, o[4 * d + 3] * il};
    }
}
__device__ __forceinline__ void attn1_finish_phase(const Ctx& c, const float* tmp, const float* lamp  , const float* subln  , bf16* O) {
    float s01 = 0.f, s23 = 0.f;
    for (int i = 0; i < 64; ++i) { s01 += lamp[i] * lamp[64 + i]; s23 += lamp[128 + i] * lamp[192 + i]; }
    const float lam_init = 0.8f - 0.6f * expf(-0.3f * 1.0f);
    const float lam = expf(s01) - expf(s23) + lam_init;
    const long total = (long)M * 16;
    for (long id = gtid_now(); id < total; id += c.gsz) {
        const float* p1 = tmp + (size_t)id * 256; const float* p2 = p1 + 128;
        float ss = 0.f;
        for (int d = 0; d < 128; ++d) { const float v = p1[d] - lam * p2[d]; ss += v * v; }
        const float rs = (1.f - lam_init) / sqrtf(ss * (1.f / 128.f) + RMS_EPS);
        bf16* op = O + (size_t)id * 128;
        for (int d = 0; d < 128; d += 2) { const float v0 = (p1[d] - lam * p2[d]) * rs * subln[d], v1 = (p1[d + 1] - lam * p2[d + 1]) * rs * subln[d + 1];
            *(unsigned*)(op + d) = pk2(v0, v1); }
    }
}

__device__ __forceinline__ void router_phase(const Ctx& c, const float* x1, const float* g, const float* ada_l, const float* wr  , const float* rbias  ,
                                             bf16* HF, int* idx, float* gate, unsigned* counts) {
    LAS float* hb = (LAS float*)(c.lds + c.wave * 8192);
    const int lane = c.lane;
    for (int m = c.gw; m < M; m += c.ngw) {
        const int b = m / T; f32x4 v[8]; load_row(x1 + (size_t)m * D, lane, v);
        const float rstd = row_rstd(v);
        modulate_row(v, rstd, g, ada_l + (size_t)b * 6 * D + 3 * D, ada_l + (size_t)b * 6 * D + 4 * D, lane);
        store_row_bf16(HF + (size_t)m * D, v, lane);
#pragma unroll
        for (int j = 0; j < 8; ++j) *(LAS f32x4*)(hb + 4 * lane + 256 * j) = v[j];
        asm volatile("s_waitcnt lgkmcnt(0)" ::: "memory");
        float a0 = 0.f, a1 = 0.f, a2 = 0.f, a3 = 0.f;
        for (int k = 0; k < D; k += 4) {
            const f32x4 hv = *(const LAS f32x4*)(hb + k);
            a0 += hv.x * wr[(size_t)(k + 0) * 64 + lane]; a1 += hv.y * wr[(size_t)(k + 1) * 64 + lane];
            a2 += hv.z * wr[(size_t)(k + 2) * 64 + lane]; a3 += hv.w * wr[(size_t)(k + 3) * 64 + lane];
        }
        const float logit = (a0 + a1) + (a2 + a3);
        const float score = 1.f / (1.f + expf(-logit));
        const float sel = score + rbias[lane];
        float m1 = sel;
        m1 = fmaxf(m1, __shfl_xor(m1, 1)); m1 = fmaxf(m1, __shfl_xor(m1, 2)); m1 = fmaxf(m1, __shfl_xor(m1, 4));
        const unsigned long long eqm = __ballot(sel == m1);
        const int gbase = lane & ~7;
        const unsigned grp_eq = (unsigned)((eqm >> gbase) & 0xffull);
        const int first = __builtin_ctz(grp_eq);
        float m2 = ((lane & 7) == first) ? -3e38f : sel;
        m2 = fmaxf(m2, __shfl_xor(m2, 1)); m2 = fmaxf(m2, __shfl_xor(m2, 2)); m2 = fmaxf(m2, __shfl_xor(m2, 4));
        const float gs = m1 + m2;
        int grank = 0; const int mygrp = lane >> 3;
#pragma unroll
        for (int g2 = 0; g2 < 8; ++g2) { const float o = __shfl(gs, g2 * 8); grank += (o > gs || (o == gs && g2 < mygrp)) ? 1 : 0; }
        const float msel = (grank < 4) ? sel : -1e30f;
        int rank = 0;
        for (int e2 = 0; e2 < 64; ++e2) { const float o = __shfl(msel, e2); rank += (o > msel || (o == msel && e2 < lane)) ? 1 : 0; }
        const bool chosen = rank < TOPK;
        const float gsum = wave_sum(chosen ? score : 0.f);
        if (chosen) { idx[(size_t)m * 8 + rank] = lane; gate[(size_t)m * 8 + rank] = score / gsum * 2.5f;
            __hip_atomic_fetch_add(counts + lane, 1u, __ATOMIC_RELAXED, __HIP_MEMORY_SCOPE_AGENT); }
    }
}
__device__ __forceinline__ void slot_phase(const Ctx& c, const int* idx, const unsigned* counts, unsigned* cursor, unsigned* nrt_out, int* pos, int* slot_tok, int* tile_exp) {
    LAS int* ps = (LAS int*)c.lds;
    if (c.tid == 0) { int acc = 0; for (int e = 0; e < NE; ++e) { const int cn = (int)counts[e]; ps[e] = acc; ps[64 + e] = cn; acc += (cn + 255) / 256 * 256; } ps[128] = acc; }
    __syncthreads();
    for (int a = gtid_now(); a < M * TOPK; a += c.gsz) {
        const int e = idx[a]; const unsigned r = __hip_atomic_fetch_add(cursor + e, 1u, __ATOMIC_RELAXED, __HIP_MEMORY_SCOPE_AGENT);
        const int slot = ps[e] + (int)r; slot_tok[slot] = a >> 3; pos[a] = slot;
    }
    for (int t = gtid_now(); t < M; t += c.gsz) slot_tok[CAPR + t] = t;
    if (blockIdx.x == 0) {
        if (c.tid < NE) { const int e = c.tid, s0 = ps[e], cn = ps[64 + e], pe = s0 + (cn + 255) / 256 * 256;
            for (int s = s0 + cn; s < pe; ++s) slot_tok[s] = 0;
            for (int tt = s0 / 256; tt < pe / 256; ++tt) tile_exp[tt] = e; }
        if (c.tid == 0) *nrt_out = (unsigned)(ps[128] / 256);
    }
    __syncthreads();
}
__device__ __forceinline__ void moe_up_phase(const Ctx& c, const bf16* HF, const bf16* Wup_l  , const int* slot_tok, const int* tile_exp, const unsigned* nrt_p, bf16* ACT) {
    const int nrt = (int)*nrt_p, ntiles = nrt + M / 256, units = ntiles * (ED / 64);
    for (int u = blockIdx.x; u < units; u += gridDim.x) {
        const int mt = u / (ED / 64), nt = u % (ED / 64), n0 = nt * 64;
        const int e = mt < nrt ? tile_exp[mt] : NE; const int slot0 = (mt < nrt ? mt * 256 : CAPR + (mt - nrt) * 256) + c.wave * 32;
        const int r = c.lane & 15;
        const bf16* a0 = HF + (size_t)slot_tok[slot0 + r] * D; const bf16* a1 = HF + (size_t)slot_tok[slot0 + 16 + r] * D;
        const bf16* W = Wup_l + (size_t)e * UPN * D;
        f32x4 ag[2][4], au[2][4]; ZERO_ACC(ag); ZERO_ACC(au);
        wave_gemm_32x64(a0, a1, W + (size_t)(n0 + r) * D, D, c.lane, ag);
        wave_gemm_32x64(a0, a1, W + (size_t)(ED + n0 + r) * D, D, c.lane, au);
#pragma unroll
        for (int mi = 0; mi < 2; ++mi)
#pragma unroll
            for (int n = 0; n < 4; ++n)
#pragma unroll
                for (int j = 0; j < 4; ++j) ACT[(size_t)(slot0 + 16 * mi + 4 * (c.lane >> 4) + j) * ED + n0 + 16 * n + r] = (bf16)f2bf(siluf(ag[mi][n][j]) * au[mi][n][j]);
    }
}
__device__ __forceinline__ void moe_down_phase(const Ctx& c, const bf16* ACT, const bf16* Wdn_l  , const int* tile_exp, const unsigned* nrt_p, bf16* Y) {
    const int nrt = (int)*nrt_p, ntiles = nrt + M / 256, units = ntiles * (D / 64);
    for (int u = blockIdx.x; u < units; u += gridDim.x) {
        const int mt = u / (D / 64), nt = u % (D / 64), n0 = nt * 64;
        const int e = mt < nrt ? tile_exp[mt] : NE; const int slot0 = (mt < nrt ? mt * 256 : CAPR + (mt - nrt) * 256) + c.wave * 32;
        const int r = c.lane & 15;
        const bf16* W = Wdn_l + (size_t)e * D * ED;
        f32x4 acc[2][4]; ZERO_ACC(acc);
        wave_gemm_32x64(ACT + (size_t)(slot0 + r) * ED, ACT + (size_t)(slot0 + 16 + r) * ED, W + (size_t)(n0 + r) * ED, ED, c.lane, acc);
#pragma unroll
        for (int mi = 0; mi < 2; ++mi)
#pragma unroll
            for (int n = 0; n < 4; ++n)
#pragma unroll
                for (int j = 0; j < 4; ++j) Y[(size_t)(slot0 + 16 * mi + 4 * (c.lane >> 4) + j) * D + n0 + 16 * n + r] = (bf16)f2bf(acc[mi][n][j]);
    }
}
__device__ __forceinline__ void add_row_bf16(f32x4 (&acc)[8], const bf16* yrow, float w, int lane) {
#pragma unroll
    for (int j = 0; j < 8; ++j) { const u32x2 v = *(const u32x2*)(yrow + 4 * lane + 256 * j);
        acc[j].x += w * bf2f(v.x & 0xffffu); acc[j].y += w * bf2f(v.x >> 16); acc[j].z += w * bf2f(v.y & 0xffffu); acc[j].w += w * bf2f(v.y >> 16); }
}
__device__ __forceinline__ void add_row_fp8(f32x4 (&acc)[8], const unsigned char* yrow, float w, int lane) {
#pragma unroll
    for (int j = 0; j < 8; ++j) { const unsigned v = *(const unsigned*)(yrow + 4 * lane + 256 * j);
        acc[j].x += w * __builtin_amdgcn_cvt_f32_fp8(v, 0); acc[j].y += w * __builtin_amdgcn_cvt_f32_fp8(v, 1); acc[j].z += w * __builtin_amdgcn_cvt_f32_fp8(v, 2); acc[j].w += w * __builtin_amdgcn_cvt_f32_fp8(v, 3); }
}
template <bool NEXT>
__device__ __forceinline__ void combine_phase(const Ctx& c, const float* x1, const bf16* Y, const int* pos, const float* gate, const float* ada_l, float* xo,
                                              const float* gnext, const float* ada_next, bf16* XN) {
    for (int m = c.gw; m < M; m += c.ngw) {
        const int b = m / T; f32x4 acc[8];
#pragma unroll
        for (int j = 0; j < 8; ++j) acc[j] = (f32x4){0.f, 0.f, 0.f, 0.f};
#if USE_FP8_MOE && Y_FP8
        for (int k = 0; k < TOPK; ++k) add_row_fp8(acc, (const unsigned char*)Y + (size_t)pos[(size_t)m * 8 + k] * D, gate[(size_t)m * 8 + k] * (1.f / F8_YSCALE), c.lane);
        add_row_fp8(acc, (const unsigned char*)Y + (size_t)(CAPR + m) * D, 1.f / F8_YSCALE, c.lane);
#else
        for (int k = 0; k < TOPK; ++k) add_row_bf16(acc, Y + (size_t)pos[(size_t)m * 8 + k] * D, gate[(size_t)m * 8 + k], c.lane);
        add_row_bf16(acc, Y + (size_t)(CAPR + m) * D, 1.f, c.lane);
#endif
        const float* gf = ada_l + (size_t)b * 6 * D + 5 * D;
        f32x4 v[8];
#pragma unroll
        for (int j = 0; j < 8; ++j) { const int col = 4 * c.lane + 256 * j;
#if RES_BF16
            { const u32x2 xw = *(const u32x2*)((const bf16*)x1 + (size_t)m * D + col);
              v[j] = (f32x4){bf2f(xw.x & 0xffffu), bf2f(xw.x >> 16), bf2f(xw.y & 0xffffu), bf2f(xw.y >> 16)} + *(const f32x4*)(gf + col) * acc[j]; }
            if (NEXT) { u32x2 ow; ow.x = pk2(v[j].x, v[j].y); ow.y = pk2(v[j].z, v[j].w); *(u32x2*)((bf16*)xo + (size_t)m * D + col) = ow; }
            else *(f32x4*)(xo + (size_t)m * D + col) = v[j];
#else
            v[j] = *(const f32x4*)(x1 + (size_t)m * D + col) + *(const f32x4*)(gf + col) * acc[j];
            *(f32x4*)(xo + (size_t)m * D + col) = v[j];
#endif
            }
        if (NEXT) {
            const float rstd = row_rstd(v);
            modulate_row(v, rstd, gnext, ada_next + (size_t)b * 6 * D, ada_next + (size_t)b * 6 * D + D, c.lane);
#if USE_FP8_QKV
            store_row_fp8((unsigned char*)XN + (size_t)m * D, v, c.lane, F8_HSCALE);
#else
            store_row_bf16(XN + (size_t)m * D, v, c.lane);
#endif
        }
    }
}


namespace pg8 {
constexpr int BM = 256, BK = 64, HALF = 128, HTB = HALF * BK * 2, STAGE_BYTES = 8 * HTB, NXCD = 8, WGM = 8;
__device__ __forceinline__ int lds_byte(int r, int c) { const int st = (r >> 4) * 2 + (c >> 5), rr = r & 15, cc = c & 31, ob = rr * 64 + cc * 2; return st * 1024 + (ob ^ (((ob >> 9) & 1) << 5)); }
__device__ __forceinline__ void stage_rc(int b, int& R, int& C) { const int st = b / 1024, sb = b % 1024, swz = sb ^ (((sb >> 9) & 1) << 5); R = (st >> 1) * 16 + swz / 64; C = (st & 1) * 32 + (swz % 64) / 2; }
__device__ __forceinline__ int perm32(int rho) { const int n = rho >> 4, i = rho & 15; return 8 * (i >> 2) + 4 * n + (i & 3); }
__device__ __forceinline__ unsigned cvt_pk_bf16(float lo, float hi) { unsigned r; asm volatile("v_cvt_pk_bf16_f32 %0, %1, %2" : "=v"(r) : "v"(lo), "v"(hi)); return r; }

struct Unit { int row0, pn; const char* Bp; };

struct TileOrder {
    int nM, nN, nwg, G, c;
    __device__ __forceinline__ void init(int nM_, int nN_, int G_, int c_) { nM = nM_; nN = nN_; nwg = nM * nN; G = G_; c = c_; }
    __device__ __forceinline__ bool tile(int i, int& pm, int& pn) const {
        const long L = (long)i * G + c; if (L >= nwg) return false;
        int wgid = (int)L; { const int q = nwg / NXCD, r = nwg % NXCD, xcd = wgid % NXCD, off = wgid / NXCD; wgid = (xcd < r ? xcd * (q + 1) : r * (q + 1) + (xcd - r) * q) + off; }
        const int nig = WGM * nN, gid = wgid / nig, fm = gid * WGM, gsz = (nM - fm) < WGM ? (nM - fm) : WGM;
        pm = fm + ((wgid % nig) % gsz); pn = (wgid % nig) / gsz; return true;
    }
};
struct PlainSched {
    static constexpr bool GATHER = false;
    TileOrder o; const char* Bt; int K;
    __device__ __forceinline__ bool next(int i, Unit& u) const { int pm, pn; if (!o.tile(i, pm, pn)) return false; u.row0 = pm * BM; u.pn = pn; u.Bp = Bt + (size_t)pn * BM * K * 2; return true; }
    __device__ __forceinline__ unsigned arow_off(const Unit& u, int rl) const { return (unsigned)(u.row0 + rl) * (unsigned)(K * 2); }
};
template <bool GATHER_> struct GroupSched {
    static constexpr bool GATHER = GATHER_;
    TileOrder o; const char* W; size_t wstride; int K, nrt; const LAS int* tile_exp; const int* slot_tok;
    __device__ __forceinline__ bool next(int i, Unit& u) const { int pm, pn; if (!o.tile(i, pm, pn)) return false;
        const int e = pm < nrt ? tile_exp[pm] : NE; u.row0 = pm < nrt ? pm * BM : CAPR + (pm - nrt) * BM; u.pn = pn; u.Bp = W + (size_t)e * wstride + (size_t)pn * BM * K * 2; return true; }
    __device__ __forceinline__ unsigned arow_off(const Unit& u, int rl) const { const int r = GATHER ? slot_tok[u.row0 + rl] : (u.row0 + rl); return (unsigned)r * (unsigned)(K * 2); }
};

template <int LAYER> struct EpiQKV {
    static constexpr bool PERM = true;
    bf16* O; int ldc; const float* gains; float qscale, ascale;
    __device__ __forceinline__ void operator()(const f32x4 (&acc)[2][2][4][2], const Unit& u, int wr, int wc, int fr, int fq) const {
        const int head = 4 * u.pn + wc; int gi;
        if (LAYER == 0) gi = head < 16 ? 0 : head < 32 ? 1 : head < 48 ? -1 : head < 64 ? 2 : head < 66 ? 3 : -1;
        else gi = head < 32 ? 0 : head < 64 ? 1 : -1;
        f32x4 gv[2][2];
#pragma unroll
        for (int bj = 0; bj < 2; ++bj)
#pragma unroll
            for (int n = 0; n < 2; ++n) gv[bj][n] = gi >= 0 ? *(const f32x4*)(gains + 64 * gi + 32 * bj + 8 * fq + 4 * n) : (f32x4){1.f, 1.f, 1.f, 1.f};
#if QKV_HEADMAJOR
        bf16* base = O + ((size_t)head * M + (size_t)(u.row0 + wr * 64 + fr)) * 64 + 8 * fq; const int ldo = 64;
#else
        bf16* base = O + (size_t)(u.row0 + wr * 64 + fr) * ldc + 64 * head + 8 * fq; const int ldo = ldc;
#endif
#pragma unroll
        for (int ai = 0; ai < 2; ++ai)
#pragma unroll
            for (int m = 0; m < 4; ++m) {
                float ss = 0.f;
#pragma unroll
                for (int bj = 0; bj < 2; ++bj)
#pragma unroll
                    for (int n = 0; n < 2; ++n) { const f32x4 x = acc[ai][bj][m][n]; ss += (x[0] * x[0] + x[1] * x[1]) + (x[2] * x[2] + x[3] * x[3]); }
                ss += __shfl_xor(ss, 16); ss += __shfl_xor(ss, 32); ss *= ascale * ascale;
                const bool isq = LAYER == 0 ? (gi == 0 || gi == 2) : (gi == 0);
                const float rs = ascale * (gi >= 0 ? (isq ? qscale : 1.f) / sqrtf(ss * (1.f / 64.f) + RMS_EPS) : 1.f);
                bf16* rowp = base + (size_t)(ai * HALF + m * 16) * ldo;
#pragma unroll
                for (int bj = 0; bj < 2; ++bj) { const f32x4 v0 = acc[ai][bj][m][0] * rs * gv[bj][0], v1 = acc[ai][bj][m][1] * rs * gv[bj][1];
                    u32x4 w; w.x = cvt_pk_bf16(v0[0], v0[1]); w.y = cvt_pk_bf16(v0[2], v0[3]); w.z = cvt_pk_bf16(v1[0], v1[1]); w.w = cvt_pk_bf16(v1[2], v1[3]);
                    *(u32x4*)(rowp + 32 * bj) = w; }
            }
    }
};
struct EpiOut {
    static constexpr bool PERM = false;
    const float* xin; const float* gm; float* X1;
    __device__ __forceinline__ void operator()(const f32x4 (&acc)[2][2][4][2], const Unit& u, int wr, int wc, int fr, int fq) const {
        const int col0 = u.pn * BM + wc * 32 + 4 * fq; const float* g = gm + (size_t)(u.row0 / T) * 6 * D + col0;
        f32x4 gv[2][2];
#pragma unroll
        for (int bj = 0; bj < 2; ++bj)
#pragma unroll
            for (int n = 0; n < 2; ++n) gv[bj][n] = *(const f32x4*)(g + bj * HALF + n * 16);
#pragma unroll
        for (int ai = 0; ai < 2; ++ai)
#pragma unroll
            for (int m = 0; m < 4; ++m) { const size_t off = (size_t)(u.row0 + wr * 64 + fr + ai * HALF + m * 16) * D + col0;
#pragma unroll
                for (int bj = 0; bj < 2; ++bj)
#pragma unroll
                    for (int n = 0; n < 2; ++n) *(f32x4*)(X1 + off + bj * HALF + n * 16) = *(const f32x4*)(xin + off + bj * HALF + n * 16) + gv[bj][n] * acc[ai][bj][m][n]; }
    }
};

template <bool XIN_BF16> struct EpiOutB {
    static constexpr bool PERM = true;
    const void* xin; const float* gm; bf16* X1b;
    __device__ __forceinline__ void operator()(const f32x4 (&acc)[2][2][4][2], const Unit& u, int wr, int wc, int fr, int fq) const {
        const int col0 = u.pn * BM + wc * 32 + 8 * fq; const float* g = gm + (size_t)(u.row0 / T) * 6 * D + col0;
        f32x4 gv[2][2];
#pragma unroll
        for (int bj = 0; bj < 2; ++bj)
#pragma unroll
            for (int n = 0; n < 2; ++n) gv[bj][n] = *(const f32x4*)(g + bj * HALF + 4 * n);
#pragma unroll
        for (int ai = 0; ai < 2; ++ai)
#pragma unroll
            for (int m = 0; m < 4; ++m) { const size_t off = (size_t)(u.row0 + wr * 64 + fr + ai * HALF + m * 16) * D + col0;
#pragma unroll
                for (int bj = 0; bj < 2; ++bj) { f32x4 x0, x1v;
                    if (XIN_BF16) { const u32x4 xw = *(const u32x4*)((const bf16*)xin + off + bj * HALF);
                        x0 = (f32x4){bf2f(xw.x & 0xffffu), bf2f(xw.x >> 16), bf2f(xw.y & 0xffffu), bf2f(xw.y >> 16)}; x1v = (f32x4){bf2f(xw.z & 0xffffu), bf2f(xw.z >> 16), bf2f(xw.w & 0xffffu), bf2f(xw.w >> 16)}; }
                    else { x0 = *(const f32x4*)((const float*)xin + off + bj * HALF); x1v = *(const f32x4*)((const float*)xin + off + bj * HALF + 4); }
                    const f32x4 v0 = x0 + gv[bj][0] * acc[ai][bj][m][0], v1 = x1v + gv[bj][1] * acc[ai][bj][m][1];
                    u32x4 w; w.x = cvt_pk_bf16(v0[0], v0[1]); w.y = cvt_pk_bf16(v0[2], v0[3]); w.z = cvt_pk_bf16(v1[0], v1[1]); w.w = cvt_pk_bf16(v1[2], v1[3]);
                    *(u32x4*)(X1b + off + bj * HALF) = w; } }
    }
};
__device__ __forceinline__ float silu_fast(float x) { return x * __builtin_amdgcn_rcpf(1.f + __builtin_amdgcn_exp2f(-1.4426950408889634f * x)); }
struct EpiUp {
    static constexpr bool PERM = true;
    bf16* ACT;
    __device__ __forceinline__ void operator()(const f32x4 (&acc)[2][2][4][2], const Unit& u, int wr, int wc, int fr, int fq) const {
        bf16* base = ACT + (size_t)(u.row0 + wr * 64 + fr) * ED + 128 * u.pn + 32 * wc + 8 * fq;
#pragma unroll
        for (int ai = 0; ai < 2; ++ai)
#pragma unroll
            for (int m = 0; m < 4; ++m) { f32x4 v[2];
#pragma unroll
                for (int n = 0; n < 2; ++n)
#pragma unroll
                    for (int i = 0; i < 4; ++i) v[n][i] = silu_fast(acc[ai][0][m][n][i]) * acc[ai][1][m][n][i];
                u32x4 w; w.x = cvt_pk_bf16(v[0][0], v[0][1]); w.y = cvt_pk_bf16(v[0][2], v[0][3]); w.z = cvt_pk_bf16(v[1][0], v[1][1]); w.w = cvt_pk_bf16(v[1][2], v[1][3]);
                *(u32x4*)(base + (size_t)(ai * HALF + m * 16) * ED) = w; }
    }
};
struct EpiDown {
    static constexpr bool PERM = true;
    bf16* Y; int orow = 0;
    __device__ __forceinline__ void operator()(const f32x4 (&acc)[2][2][4][2], const Unit& u, int wr, int wc, int fr, int fq) const {
        bf16* base = Y + (size_t)(orow + u.row0 + wr * 64 + fr) * D + u.pn * BM + wc * 32 + 8 * fq;
#pragma unroll
        for (int ai = 0; ai < 2; ++ai)
#pragma unroll
            for (int m = 0; m < 4; ++m) { bf16* rowp = base + (size_t)(ai * HALF + m * 16) * D;
#pragma unroll
                for (int bj = 0; bj < 2; ++bj) { const f32x4 v0 = acc[ai][bj][m][0], v1 = acc[ai][bj][m][1];
                    u32x4 w; w.x = cvt_pk_bf16(v0[0], v0[1]); w.y = cvt_pk_bf16(v0[2], v0[3]); w.z = cvt_pk_bf16(v1[0], v1[1]); w.w = cvt_pk_bf16(v1[2], v1[3]);
                    *(u32x4*)(rowp + bj * HALF) = w; } }
    }
};


struct EpiUp8 {
    static constexpr bool PERM = true;
    unsigned char* ACT8;
    __device__ __forceinline__ void operator()(const f32x4 (&acc)[2][2][4][2], const Unit& u, int wr, int wc, int fr, int fq) const {
        unsigned char* base = ACT8 + (size_t)(u.row0 + wr * 64 + fr) * ED + 128 * u.pn + 32 * wc + 8 * fq;
        constexpr float s = 1.f / (F8_HSCALE * F8_WSCALE);
#pragma unroll
        for (int ai = 0; ai < 2; ++ai)
#pragma unroll
            for (int m = 0; m < 4; ++m) { f32x4 v[2];
#pragma unroll
                for (int n = 0; n < 2; ++n)
#pragma unroll
                    for (int i = 0; i < 4; ++i) v[n][i] = silu_fast(acc[ai][0][m][n][i] * s) * (acc[ai][1][m][n][i] * (s * F8_ASCALE));
                u32x2 w; w.x = pk4_fp8(v[0][0], v[0][1], v[0][2], v[0][3]); w.y = pk4_fp8(v[1][0], v[1][1], v[1][2], v[1][3]);
                *(u32x2*)(base + (size_t)(ai * HALF + m * 16) * ED) = w; }
    }
};
struct EpiDown8 {
    static constexpr bool PERM = true;
    bf16* Y;
    __device__ __forceinline__ void operator()(const f32x4 (&acc)[2][2][4][2], const Unit& u, int wr, int wc, int fr, int fq) const {
#if Y_FP8
        unsigned char* base = (unsigned char*)Y + (size_t)(u.row0 + wr * 64 + fr) * D + u.pn * BM + wc * 64 + 16 * fq;
        constexpr float s = F8_YSCALE / (F8_ASCALE * F8_WSCALE);
#pragma unroll
        for (int ai = 0; ai < 2; ++ai)
#pragma unroll
            for (int m = 0; m < 4; ++m) { unsigned char* rowp = base + (size_t)(ai * HALF + m * 16) * D; u32x4 w;
#pragma unroll
                for (int bj = 0; bj < 2; ++bj) { const f32x4 v0 = acc[ai][bj][m][0] * s, v1 = acc[ai][bj][m][1] * s;
                    w[2 * bj] = pk4_fp8(v0[0], v0[1], v0[2], v0[3]); w[2 * bj + 1] = pk4_fp8(v1[0], v1[1], v1[2], v1[3]); }
                *(u32x4*)rowp = w; }
#else
        bf16* base = Y + (size_t)(u.row0 + wr * 64 + fr) * D + u.pn * BM + wc * 32 + 8 * fq;
        constexpr float s = 1.f / (F8_ASCALE * F8_WSCALE);
#pragma unroll
        for (int ai = 0; ai < 2; ++ai)
#pragma unroll
            for (int m = 0; m < 4; ++m) { bf16* rowp = base + (size_t)(ai * HALF + m * 16) * D;
#pragma unroll
                for (int bj = 0; bj < 2; ++bj) { const f32x4 v0 = acc[ai][bj][m][0] * s, v1 = acc[ai][bj][m][1] * s;
                    u32x4 w; w.x = cvt_pk_bf16(v0[0], v0[1]); w.y = cvt_pk_bf16(v0[2], v0[3]); w.z = cvt_pk_bf16(v1[0], v1[1]); w.w = cvt_pk_bf16(v1[2], v1[3]);
                    *(u32x4*)(rowp + bj * HALF) = w; } }
#endif
    }
};
__device__ __forceinline__ void glds16s(const void* sbase, unsigned voff, unsigned lds_dst) { unsigned keep;
    asm volatile("s_mov_b32 %0, m0\n\ts_mov_b32 m0, %3\n\ts_nop 0\n\tglobal_load_lds_dwordx4 %1, %2\n\ts_mov_b32 m0, %0" : "=&s"(keep) : "v"(voff), "s"(sbase), "s"(lds_dst) : "memory"); }
__device__ __forceinline__ void glds4s(const void* sbase, unsigned voff, unsigned lds_dst) { unsigned keep;
    asm volatile("s_mov_b32 %0, m0\n\ts_mov_b32 m0, %3\n\ts_nop 0\n\tglobal_load_lds_dword %1, %2\n\ts_mov_b32 m0, %0" : "=&s"(keep) : "v"(voff), "s"(sbase), "s"(lds_dst) : "memory"); }
typedef int i32x4 __attribute__((ext_vector_type(4)));
typedef int i32x8 __attribute__((ext_vector_type(8)));
__device__ __forceinline__ i32x8 cat8(bf16x8 a, bf16x8 b) { return __builtin_shufflevector(__builtin_bit_cast(i32x4, a), __builtin_bit_cast(i32x4, b), 0, 1, 2, 3, 4, 5, 6, 7); }
__device__ __forceinline__ void mfma8_inplace(f32x4& acc, i32x8 a, i32x8 b) { asm volatile("v_mfma_f32_16x16x128_f8f6f4 %0, %1, %2, %0" : "+v"(acc) : "v"(a), "v"(b)); }
template <class Epi, class Sched, bool FP8 = false>
__device__ __forceinline__ void gemm_phase(LAS unsigned char* lds, const char* Abase, const int K, const Sched& S, const Epi& E) {
    constexpr bool GATHER = Sched::GATHER;
    const int tid = threadIdx.x, wid = __builtin_amdgcn_readfirstlane(tid >> 6), lane = tid & 63, wr = wid >> 2, wc = wid & 3, fr = lane & 15, fq = lane >> 4;
    int nt = K / BK; asm volatile("" : "+s"(nt));
    int RA[2]; unsigned CA[2], voffB[2], vC[2];
#pragma unroll
    for (int i = 0; i < 2; ++i) { int R, C; stage_rc(tid * 16 + i * 8192, R, C); const int Rb = Epi::PERM ? ((R & ~31) + perm32(R & 31)) : R;
        RA[i] = R; CA[i] = (unsigned)C * 2u; voffB[i] = (unsigned)(Rb * K + C) * 2u; vC[i] = (unsigned)(R * K + C) * 2u; }
    const size_t kstep = (size_t)(BK * 2);
    const size_t hstep = (size_t)HALF * K * 2;
    const size_t ahstep = GATHER ? 0 : hstep;
    const unsigned ldsw = (unsigned)wid * 1024u;
    const unsigned lds0 = (unsigned)(uintptr_t)lds;
    const int aoff = lds_byte(wr * 64 + fr, fq * 8), boff = lds_byte(wc * 32 + fr, fq * 8);
#define PG8_SA(b, h) (((b) * 2 + (h)) * HTB)
#define PG8_SB(b, h) ((4 + (b) * 2 + (h)) * HTB)
#define PG8_STAGE(bufoff, gbase, voff) do { _Pragma("unroll") for (int _i = 0; _i < 2; ++_i) \
        glds16s((const void*)(gbase), (voff)[_i], (unsigned)__builtin_amdgcn_readfirstlane((int)(lds0 + (unsigned)(bufoff) + ldsw + (unsigned)(_i * 8192)))); } while (0)
#define PG8_STAGE_A(bufoff, gbase, h) do { if constexpr (GATHER) { PG8_STAGE(bufoff, gbase, vA[h]); } else { PG8_STAGE(bufoff, (gbase) + (h) * ahstep, vC); } } while (0)
#define PG8_LDA(dst, b, h) do { _Pragma("unroll") for (int m = 0; m < 4; ++m) _Pragma("unroll") for (int k = 0; k < 2; ++k) dst[m][k] = *(const LAS bf16x8*)(lds + PG8_SA(b, h) + aoff + m * 2048 + k * 1024); } while (0)
#define PG8_LDB(dst, b, h) do { _Pragma("unroll") for (int n = 0; n < 2; ++n) _Pragma("unroll") for (int k = 0; k < 2; ++k) dst[n][k] = *(const LAS bf16x8*)(lds + PG8_SB(b, h) + boff + n * 2048 + k * 1024); } while (0)
#define PG8_MMA(ai, bj, At, Bt) do { __builtin_amdgcn_s_setprio(1); if constexpr (FP8) { _Pragma("unroll") for (int m = 0; m < 4; ++m) _Pragma("unroll") for (int n = 0; n < 2; ++n) \
        mfma8_inplace(acc[ai][bj][m][n], cat8(Bt[n][0], Bt[n][1]), cat8(At[m][0], At[m][1])); } else { \
        _Pragma("unroll") for (int m = 0; m < 4; ++m) _Pragma("unroll") for (int n = 0; n < 2; ++n) _Pragma("unroll") for (int k = 0; k < 2; ++k) \
        acc[ai][bj][m][n] = __builtin_amdgcn_mfma_f32_16x16x32_bf16(Bt[n][k], At[m][k], acc[ai][bj][m][n], 0, 0, 0); } __builtin_amdgcn_s_setprio(0); } while (0)
#define PG8_WAIT_V(n) asm volatile("s_waitcnt vmcnt(" #n ")" ::: "memory")
#define PG8_WAIT_L(n) asm volatile("s_waitcnt lgkmcnt(0)" ::: "memory")
#define PG8_BAR __builtin_amdgcn_s_barrier()
#define PG8_SCHED __builtin_amdgcn_sched_barrier(0)
#define PG8_SETOFF(vo, u) do { _Pragma("unroll") for (int _h = 0; _h < 2; ++_h) _Pragma("unroll") for (int _i = 0; _i < 2; ++_i) vo[_h][_i] = S.arow_off(u, _h * HALF + RA[_i]) + CA[_i]; } while (0)
    Unit cur, nxt; int ui = 0;
    if (!S.next(0, cur)) return;
    f32x4 acc[2][2][4][2];
#pragma unroll
    for (int a = 0; a < 2; ++a)
#pragma unroll
        for (int b = 0; b < 2; ++b)
#pragma unroll
            for (int m = 0; m < 4; ++m)
#pragma unroll
                for (int n = 0; n < 2; ++n) acc[a][b][m][n] = (f32x4){0.f, 0.f, 0.f, 0.f};
    bf16x8 At[4][2], B0[2][2], B1[2][2];
    unsigned vA[2][2];
    LAS int* gidx = (LAS int*)(lds + STAGE_BYTES);
#define PG8_IDX_DMA(u) do { if (wid < 4) glds4s((const void*)(S.slot_tok + (u).row0), (unsigned)((wid * 64 + lane) * 4), (unsigned)__builtin_amdgcn_readfirstlane((int)(lds0 + (unsigned)STAGE_BYTES + (unsigned)wid * 256u))); } while (0)
#define PG8_IDX_READ() do { _Pragma("unroll") for (int _h = 0; _h < 2; ++_h) _Pragma("unroll") for (int _i = 0; _i < 2; ++_i) vA[_h][_i] = (unsigned)gidx[_h * HALF + RA[_i]] * (unsigned)(K * 2) + CA[_i]; } while (0)
    if constexpr (GATHER) { PG8_IDX_DMA(cur); asm volatile("s_waitcnt vmcnt(0)" ::: "memory"); __builtin_amdgcn_s_barrier(); asm volatile("" ::: "memory"); PG8_IDX_READ();
        asm volatile("s_waitcnt lgkmcnt(0)" ::: "memory"); __builtin_amdgcn_s_barrier(); asm volatile("" ::: "memory"); }
    const char* cA = GATHER ? Abase : Abase + (size_t)cur.row0 * K * 2;
    const char* cB = cur.Bp;
    PG8_STAGE(PG8_SB(0, 0), cB, voffB); PG8_STAGE(PG8_SB(0, 1), cB + hstep, voffB); PG8_STAGE_A(PG8_SA(0, 0), cA, 0); PG8_STAGE_A(PG8_SA(0, 1), cA, 1);
    if (wr == 1) PG8_BAR;
    PG8_WAIT_V(2); PG8_BAR;
    PG8_STAGE(PG8_SB(1, 0), cB + kstep, voffB); PG8_STAGE_A(PG8_SA(1, 0), cA + kstep, 0); PG8_STAGE(PG8_SB(1, 1), cB + hstep + kstep, voffB);
    PG8_WAIT_V(6); PG8_BAR;
    for (;;) {
        const bool has_next = S.next(ui + 1, nxt);
        if constexpr (GATHER) { if (has_next) PG8_IDX_DMA(nxt); }
        const char* nA = GATHER ? Abase : (has_next ? Abase + (size_t)nxt.row0 * K * 2 : cA);
        const char* nB = has_next ? nxt.Bp : cB;
#pragma unroll 1
        for (int t = 0; t < nt; t += 2) {
            const bool last = (t == nt - 2);
            const char* a1 = cA + (size_t)(t + 1) * kstep;
            const char* a2 = last ? nA : cA + (size_t)(t + 2) * kstep; const char* b2 = last ? nB : cB + (size_t)(t + 2) * kstep;
            const char* a3 = a2 + kstep; const char* b3 = b2 + kstep;
            PG8_LDB(B0, 0, 0); PG8_LDB(B1, 0, 1); PG8_SCHED; PG8_LDA(At, 0, 0); PG8_STAGE_A(PG8_SA(1, 1), a1, 1);
            if constexpr (GATHER) { if (last && has_next) PG8_IDX_READ(); }
            PG8_WAIT_V(8); PG8_WAIT_L(0); PG8_BAR; PG8_MMA(0, 0, At, B0); PG8_MMA(0, 1, At, B1); PG8_BAR; PG8_SCHED;
            PG8_LDA(At, 0, 1); PG8_STAGE(PG8_SB(0, 0), b2, voffB); PG8_STAGE(PG8_SB(0, 1), b2 + hstep, voffB); PG8_STAGE_A(PG8_SA(0, 0), a2, 0);
            PG8_WAIT_V(8); PG8_WAIT_L(0); PG8_BAR; PG8_MMA(1, 0, At, B0); PG8_MMA(1, 1, At, B1); PG8_BAR; PG8_SCHED;
            PG8_LDB(B0, 1, 0); PG8_LDB(B1, 1, 1); PG8_SCHED; PG8_LDA(At, 1, 0); PG8_STAGE_A(PG8_SA(0, 1), a2, 1);
            PG8_WAIT_V(8); PG8_WAIT_L(0); PG8_BAR; PG8_MMA(0, 0, At, B0); PG8_MMA(0, 1, At, B1); PG8_BAR; PG8_SCHED;
            PG8_LDA(At, 1, 1); PG8_STAGE(PG8_SB(1, 0), b3, voffB); PG8_STAGE(PG8_SB(1, 1), b3 + hstep, voffB); PG8_STAGE_A(PG8_SA(1, 0), a3, 0);
            PG8_WAIT_V(8); PG8_WAIT_L(0); PG8_BAR; PG8_MMA(1, 0, At, B0); PG8_MMA(1, 1, At, B1); PG8_BAR; PG8_SCHED;
        }
        if (wr == 0) PG8_BAR;
        if constexpr (FP8) asm volatile("s_nop 15\n\ts_nop 15" ::: "memory");
        E(acc, cur, wr, wc, fr, fq);
        if (!has_next) break;
#pragma unroll
        for (int a = 0; a < 2; ++a)
#pragma unroll
            for (int b = 0; b < 2; ++b)
#pragma unroll
                for (int m = 0; m < 4; ++m)
#pragma unroll
                    for (int n = 0; n < 2; ++n) acc[a][b][m][n] = (f32x4){0.f, 0.f, 0.f, 0.f};
        cur = nxt; cA = nA; cB = nB; ++ui;
        if (wr == 1) PG8_BAR;
    }
    PG8_WAIT_V(0);
    PG8_BAR;
#undef PG8_SA
#undef PG8_SB
#undef PG8_STAGE
#undef PG8_STAGE_A
#undef PG8_LDA
#undef PG8_LDB
#undef PG8_MMA
#undef PG8_WAIT_V
#undef PG8_WAIT_L
#undef PG8_BAR
#undef PG8_SCHED
#undef PG8_SETOFF
#undef PG8_IDX_DMA
#undef PG8_IDX_READ
}
}

namespace att {
using bf16=unsigned short;
using bf16x8=__attribute__((ext_vector_type(8)))short;
using s16x4=__attribute__((ext_vector_type(4)))short;
using f32x16=__attribute__((ext_vector_type(16)))float;
using u32x4=__attribute__((ext_vector_type(4)))unsigned;
constexpr int NW=8,QBLK=32,QB=QBLK*NW,KVBLK=64;
__device__ __forceinline__ int crow(int r,int hi){return (r&3)+8*(r>>2)+4*hi;}
#define SBAR() __builtin_amdgcn_sched_barrier(0)
constexpr int NSLOT=6, SLOTB=8192;
constexpr int LDS_K=0, LDS_V=NSLOT*SLOTB, LDS_WS=2*NSLOT*SLOTB, LDS_OST=LDS_WS+NW*64*4, LDS_BYTES=LDS_OST+NW*4096;
constexpr float C2=0.125f*1.4426950408889634f;
__device__ __forceinline__ void glds16(const void*sbase,unsigned voff,unsigned lds_dst){unsigned keep;
  asm volatile("s_mov_b32 %0, m0\n\ts_mov_b32 m0, %3\n\ts_nop 0\n\tglobal_load_lds_dwordx4 %1, %2\n\ts_mov_b32 m0, %0":"=&s"(keep):"v"(voff),"s"(sbase),"s"(lds_dst):"memory");}
__device__ __forceinline__ float max3f(float a,float b,float c){float r;asm("v_max3_f32 %0, %1, %2, %3":"=v"(r):"v"(a),"v"(b),"v"(c));return r;}
__device__ __forceinline__ float max2f(float a,float b){float r;asm("v_max_f32_e32 %0, %1, %2":"=v"(r):"v"(a),"v"(b));return r;}
__device__ __forceinline__ float fsub_s(float a,float b){float r;asm("v_sub_f32_e32 %0, %1, %2":"=v"(r):"v"(a),"v"(b));return r;}
typedef float f32x2_t __attribute__((ext_vector_type(2))); typedef __bf16 bf16x2_t __attribute__((ext_vector_type(2)));
__device__ __forceinline__ unsigned cvtpk_s(float lo,float hi){f32x2_t v={lo,hi};bf16x2_t b=__builtin_convertvector(v,bf16x2_t);return __builtin_bit_cast(unsigned,b);}
#define WAIT_BAR(N) asm volatile("s_waitcnt vmcnt(" #N ") lgkmcnt(0)\n\ts_barrier":::"memory")
typedef __attribute__((address_space(3))) const char* lds_cptr;
typedef short v4i16_t __attribute__((ext_vector_type(4)));
__device__ __forceinline__ void kload8(bf16x8*kf,lds_cptr kp,int bo){
  #pragma unroll
  for(int d0=0;d0<4;++d0){ const lds_cptr p=kp+((d0*32)^bo); kf[2*d0]=*(const __attribute__((address_space(3))) bf16x8*)(p); kf[2*d0+1]=*(const __attribute__((address_space(3))) bf16x8*)(p+4096); }
}
__device__ __forceinline__ void kload2(bf16x8*kf,lds_cptr kp,int j,int bo){ const lds_cptr p=kp+((j*32)^bo); kf[2*j]=*(const __attribute__((address_space(3))) bf16x8*)(p); kf[2*j+1]=*(const __attribute__((address_space(3))) bf16x8*)(p+4096); }
__device__ __forceinline__ s16x4 vtr(lds_cptr p){ return __builtin_bit_cast(s16x4,__builtin_amdgcn_ds_read_tr16_b64_v4i16((__attribute__((address_space(3))) v4i16_t*)p)); }
__device__ __forceinline__ float rowmax(const f32x16&p0,const f32x16&p1){
  float a=max3f(p0[0],p0[1],p1[0]),b=max3f(p0[2],p0[3],p1[1]);a=max3f(a,p1[2],p1[3]);
  #pragma unroll
  for(int r=4;r<16;r+=4){a=max3f(a,p0[r],p0[r+1]);b=max3f(b,p0[r+2],p0[r+3]);a=max3f(a,p1[r],p1[r+1]);b=max3f(b,p1[r+2],p1[r+3]);}
  const float m=max2f(a,b);
  auto rr=__builtin_amdgcn_permlane32_swap(__float_as_uint(m),__float_as_uint(m),false,false);
  return max2f(__uint_as_float(rr[0]),__uint_as_float(rr[1]));
}
__device__ __forceinline__ void pv(f32x16*o,int vb,bf16x8 pa0,bf16x8 pa1,bf16x8 pa2,bf16x8 pa3){
  #pragma unroll
  for(int d0=0;d0<2;++d0){s16x4 lo[4],hi[4];
    #pragma unroll
    for(int ks=0;ks<4;++ks){
      asm volatile("ds_read_b64_tr_b16 %0,%1 offset:%c2":"=&v"(lo[ks]):"v"(vb),"i"(d0*4096+ks*1024):"memory");
      asm volatile("ds_read_b64_tr_b16 %0,%1 offset:%c2":"=&v"(hi[ks]):"v"(vb),"i"(d0*4096+ks*1024+512):"memory");}
    asm volatile("s_waitcnt lgkmcnt(0)":::"memory");SBAR();
    #define PK(k) (bf16x8){lo[k][0],lo[k][1],lo[k][2],lo[k][3],hi[k][0],hi[k][1],hi[k][2],hi[k][3]}
    o[d0]=__builtin_amdgcn_mfma_f32_32x32x16_bf16(pa0,PK(0),o[d0],0,0,0);
    o[d0]=__builtin_amdgcn_mfma_f32_32x32x16_bf16(pa1,PK(1),o[d0],0,0,0);
    o[d0]=__builtin_amdgcn_mfma_f32_32x32x16_bf16(pa2,PK(2),o[d0],0,0,0);
    o[d0]=__builtin_amdgcn_mfma_f32_32x32x16_bf16(pa3,PK(3),o[d0],0,0,0);
    #undef PK
  }
}
template<int W> __device__ __forceinline__ void wmask(f32x16&p0,f32x16&p1,int d,float NEG){
  asm volatile("":"+v"(d));
  #pragma unroll
  for(int r=0;r<16;++r){const int c=(r&3)+8*(r>>2);
    if(W==0x7fffffff){ if(d<c)p0[r]=NEG; if(d<c+32)p1[r]=NEG; }
    else{ if((unsigned)(d-c)>(unsigned)W)p0[r]=NEG; if((unsigned)(d-c-32)>(unsigned)W)p1[r]=NEG; } }
}
struct UnitDesc {
  const bf16* Q; long qs;
  const bf16* K; long ks;
  const bf16* V; long vs;
  bf16* O; long os;
  float* lse; long lses;
  int NT;
  int rel0;
  int tg0;
  int q0;
  float slope2;
  float sink2;
};
template<int MODE,int THRL,int DIL,int OS> __device__ __forceinline__ void attn_unit(const UnitDesc&u,char*shm){
  constexpr int W=(MODE==0)?0x7fffffff:(MODE==1?128:127);
  const float NEG=(MODE==0)?-INFINITY:-1024.f;
  int tid=threadIdx.x; asm volatile("":"+v"(tid));
  const int lane=tid&63,r32=lane&31,hi=lane>>5; const int wid=__builtin_amdgcn_readfirstlane(tid>>6);
  constexpr long qs=64L*DIL,ks=64L*DIL,vs=64L*DIL;
  const bf16*Qw=u.Q+(long)(wid*QBLK)*qs;
  const unsigned lds0=(unsigned)(uintptr_t)shm;
  __attribute__((address_space(3))) float*wsf=(__attribute__((address_space(3))) float*)((__attribute__((address_space(3))) char*)shm+LDS_WS)+wid*64;
  const unsigned ksoff=(unsigned)(((long)(8*wid+(lane>>3))*ks+(((lane&7)^(lane>>3))*8))*2);
  const unsigned vsoff=(unsigned)(((long)(16*(wid&3)+(lane>>2))*vs+(wid>>2)*32+(lane&3)*8)*2);
  const unsigned kdst=lds0+LDS_K+wid*1024, vdst=lds0+LDS_V+wid*1024;
  #define DMA_K(t,slot) glds16(u.K+(long)(t)*KVBLK*ks,ksoff,(unsigned)__builtin_amdgcn_readfirstlane(kdst+(slot)))
  #define DMA_V(t,slot) glds16(u.V+(long)(t)*KVBLK*vs,vsoff,(unsigned)__builtin_amdgcn_readfirstlane(vdst+(slot)))
  bf16x8 kf[8];
  const lds_cptr shm3=(lds_cptr)shm; const lds_cptr kp0=shm3+LDS_K+r32*128+((hi^(r32&1))*16); const int kbo=((r32>>1)&3)<<5; const lds_cptr vp0=shm3+LDS_V+((lane>>4)&1)*32+(lane&3)*8+(4*hi+((lane&15)>>2))*64;
  const int NT=u.NT;
  if(MODE==0){DMA_K(0,0);DMA_V(0,0);DMA_K(1,SLOTB);} else {DMA_K(0,0);}
  bf16x8 qr[4];
  #pragma unroll
  for(int d0=0;d0<4;++d0)qr[d0]=*reinterpret_cast<const bf16x8*>(&Qw[(long)r32*qs+d0*16+hi*8]);
  const unsigned s2hb=__float_as_uint(u.slope2)&0xffff0000u; const float s2hf=__uint_as_float(s2hb);
  const unsigned s2lb=__float_as_uint(u.slope2-s2hf)&0xffff0000u; const float s2used=s2hf+__uint_as_float(s2lb);
  u32x4 qx; qx[0]=hi?0u:((__float_as_uint(64.f*s2hf)>>16)|(__float_as_uint(64.f*__uint_as_float(s2lb))&0xffff0000u)); qx[1]=hi?0u:((s2hb>>16)|s2lb); qx[2]=0u; qx[3]=0u;
  u32x4 kx0; unsigned jp0,jp1; { const unsigned j0=__float_as_uint((float)r32)>>16, j1=__float_as_uint((float)(r32+32))>>16; jp0=j0|(j0<<16); jp1=j1|(j1<<16);
    kx0[0]=0u; kx0[1]=jp0; kx0[2]=0x3f803f80u; kx0[3]=0u; }
  #define SETTG(t) do{ const unsigned tb_=__float_as_uint((float)(u.tg0+(t)))>>16; kx0[0]=(tb_|(tb_<<16)); }while(0)
  #define KX0 __builtin_bit_cast(bf16x8,kx0)
  #define QX __builtin_bit_cast(bf16x8,qx)
  #define SETREF(m_) do{ const unsigned hb_=__float_as_uint(m_)&0xffff0000u; const float hf_=__uint_as_float(hb_); const unsigned lb_=__float_as_uint((m_)-hf_)&0xffff0000u; \
      mhat=hf_+__uint_as_float(lb_); qx[2]=hi?0u:(((hb_^0x80000000u)>>16)|(lb_^0x80000000u)); }while(0)
  float mhat=0.f,l_reg=0.f;f32x16 o[2];o[0]=f32x16{};o[1]=f32x16{};
  const int qrel=u.rel0+wid*QBLK+r32-4*hi;
  #define CMASK(P0,P1,t) do{ if(MODE!=0||(t)>=NT-4) wmask<W>(P0,P1,qrel-64*(t),NEG); }while(0)
  bool resc=false;
  f32x16 pA0,pA1,pB0,pB1;
  int sl_prev=0,sl_cur=0,sl_next=SLOTB;
  #define ROT() do{sl_prev=sl_cur;sl_cur=sl_next;sl_next=(sl_next==(NSLOT-1)*SLOTB)?0:sl_next+SLOTB;}while(0)
  #define RESC() do{ if(resc){ asm volatile("s_waitcnt lgkmcnt(0)":::"memory"); \
      _Pragma("unroll") for(int d_=0;d_<2;++d_) _Pragma("unroll") for(int r=0;r<16;++r)o[d_][r]*=wsf[crow(r,hi)]; } }while(0)
  if(MODE==0){ DMA_K(2,2*SLOTB); WAIT_BAR(3); }
  else{ DMA_K(1,SLOTB);DMA_V(0,0);DMA_K(2,2*SLOTB);DMA_V(1,SLOTB);DMA_K(3,3*SLOTB);DMA_V(2,2*SLOTB);DMA_V(3,3*SLOTB);
    if(NT>4){DMA_K(4,4*SLOTB);DMA_K(5,5*SLOTB);DMA_V(4,4*SLOTB);DMA_V(5,5*SLOTB);}
    WAIT_BAR(0); }
  { SETTG(0); const f32x16 z=f32x16{}; const lds_cptr kb=kp0;
    #pragma unroll
    for(int d0=0;d0<4;++d0){
      const bf16x8 b0=*(const __attribute__((address_space(3))) bf16x8*)(kb+((d0*32)^kbo));
      const bf16x8 b1=*(const __attribute__((address_space(3))) bf16x8*)(kb+((d0*32)^kbo)+4096);
      if(d0==0){pA0=__builtin_amdgcn_mfma_f32_32x32x16_bf16(b0,qr[0],z,0,0,0);pA1=__builtin_amdgcn_mfma_f32_32x32x16_bf16(b1,qr[0],z,0,0,0);}
      else{pA0=__builtin_amdgcn_mfma_f32_32x32x16_bf16(b0,qr[d0],pA0,0,0,0);pA1=__builtin_amdgcn_mfma_f32_32x32x16_bf16(b1,qr[d0],pA1,0,0,0);}}
    pA0=__builtin_amdgcn_mfma_f32_32x32x16_bf16(KX0,QX,pA0,0,0,0); kx0[1]=jp1; pA1=__builtin_amdgcn_mfma_f32_32x32x16_bf16(KX0,QX,pA1,0,0,0); kx0[1]=jp0; }
  asm volatile("s_nop 15\n\ts_nop 7":"+v"(pA0),"+v"(pA1));CMASK(pA0,pA1,0);
  { const float rm=rowmax(pA0,pA1); SETREF(rm); const float dl=mhat;
    _Pragma("unroll") for(int r=0;r<16;++r){pA0[r]=fsub_s(pA0[r],dl);pA1[r]=fsub_s(pA1[r],dl);}
    _Pragma("unroll") for(int r=0;r<16;++r)pA0[r]=__builtin_amdgcn_exp2f(pA0[r]); }
  _Pragma("unroll") for(int r=0;r<16;++r)pA1[r]=__builtin_amdgcn_exp2f(pA1[r]);
  if(MODE==0){ WAIT_BAR(0); DMA_K(3,0);DMA_V(1,SLOTB); }
  ROT();
  kload8(kf,kp0+sl_cur,kbo);
  if(MODE==0){ WAIT_BAR(2); }
  s16x4 vlo[8],vhi[8]; u32x4 pw0,pw1,pw2,pw3;
  #define PKW(P,B) cvtpk_s(P[B],P[B+1])
  #define PAF(k) __builtin_bit_cast(bf16x8,pw##k)
  #define VFR(i) (bf16x8){vlo[i][0],vlo[i][1],vlo[i][2],vlo[i][3],vhi[i][0],vhi[i][1],vhi[i][2],vhi[i][3]}
  #define PIN(x) asm volatile("":"+v"(x))
  #define MX3(a,b,c) __builtin_fmaxf(__builtin_fmaxf((a),(b)),(c))
  #define GAPA(MF,A0,A1,A2,A3,W0,W1,PW) do{ MF; sacc+=A0; sacc+=A1; sacc+=A2; sacc+=A3; PIN(sacc); W0; W1; PIN(PW); SBAR(); }while(0)
  #define EX(v) __builtin_amdgcn_exp2f(v)
  #define GAPB(MF,X,B) do{ MF; X[B]=EX(X[B]); X[B+1]=EX(X[B+1]); X[B+2]=EX(X[B+2]); X[B+3]=EX(X[B+3]); PIN(X); SBAR(); }while(0)
  #define VRD(i) do{ vlo[i]=vtr(vp_+(((i)>>2)*4096+((i)&3)*1024)); vhi[i]=vtr(vp_+(((i)>>2)*4096+((i)&3)*1024+512)); }while(0)
  #define KRD(G,j) do{ if(G){ kload2(kf,kp0+sl_next,j,kbo); SBAR(); } }while(0)
  #define STEP(C0,C1,P0,P1,t,GK,GV,GL) do{ SBAR(); SETTG(t); const f32x16 z_=f32x16{}; \
    const lds_cptr vp_=vp0+sl_prev; \
    VRD(0); SBAR(); float sacc=(P0[0]+P0[1]); \
    GAPA(C0=__builtin_amdgcn_mfma_f32_32x32x16_bf16(kf[0],qr[0],z_,0,0,0), P0[2],P0[3],P0[4],P0[5],     pw0[0]=PKW(P0,0), pw0[1]=PKW(P0,2), pw0); \
    VRD(4); SBAR(); GAPA(C1=__builtin_amdgcn_mfma_f32_32x32x16_bf16(kf[1],qr[0],z_,0,0,0), P0[6],P0[7],P0[8],P0[9],     pw0[2]=PKW(P0,4), pw0[3]=PKW(P0,6), pw0); \
    VRD(1); SBAR(); GAPA(C0=__builtin_amdgcn_mfma_f32_32x32x16_bf16(kf[2],qr[1],C0,0,0,0),   P0[10],P0[11],P0[12],P0[13], pw1[0]=PKW(P0,8), pw1[1]=PKW(P0,10), pw1); \
    VRD(5); SBAR(); GAPA(C1=__builtin_amdgcn_mfma_f32_32x32x16_bf16(kf[3],qr[1],C1,0,0,0),   P0[14],P0[15],P1[0],P1[1],   pw1[2]=PKW(P0,12),pw1[3]=PKW(P0,14), pw1); \
    VRD(2); SBAR(); GAPA(C0=__builtin_amdgcn_mfma_f32_32x32x16_bf16(kf[4],qr[2],C0,0,0,0),   P1[2],P1[3],P1[4],P1[5],     pw2[0]=PKW(P1,0), pw2[1]=PKW(P1,2), pw2); \
    VRD(6); SBAR(); GAPA(C1=__builtin_amdgcn_mfma_f32_32x32x16_bf16(kf[5],qr[2],C1,0,0,0),   P1[6],P1[7],P1[8],P1[9],     pw2[2]=PKW(P1,4), pw2[3]=PKW(P1,6), pw2); \
    VRD(3); SBAR(); GAPA(C0=__builtin_amdgcn_mfma_f32_32x32x16_bf16(kf[6],qr[3],C0,0,0,0),   P1[10],P1[11],P1[12],P1[13], pw3[0]=PKW(P1,8), pw3[1]=PKW(P1,10), pw3); \
    VRD(7); SBAR(); GAPA(C1=__builtin_amdgcn_mfma_f32_32x32x16_bf16(kf[7],qr[3],C1,0,0,0),   P1[14],P1[15],0.f,0.f,       pw3[2]=PKW(P1,12),pw3[3]=PKW(P1,14), pw3); \
    C0=__builtin_amdgcn_mfma_f32_32x32x16_bf16(KX0,QX,C0,0,0,0); kx0[1]=jp1; C1=__builtin_amdgcn_mfma_f32_32x32x16_bf16(KX0,QX,C1,0,0,0); kx0[1]=jp0; SBAR(); \
    l_reg+=sacc; \
    if(GK){DMA_K((t)+3,sl_cur);} if(GV){DMA_V((t)+1,sl_next);} \
    CMASK(C0,C1,t); \
    { float a=MX3(C0[0],C0[1],C1[0]),b=MX3(C0[2],C0[3],C1[1]); a=MX3(a,C1[2],C1[3]); \
      _Pragma("unroll") for(int r=4;r<16;r+=4){a=MX3(a,C0[r],C0[r+1]);b=MX3(b,C0[r+2],C0[r+3]);a=MX3(a,C1[r],C1[r+1]);b=MX3(b,C1[r+2],C1[r+3]);} \
      float rm=__builtin_fmaxf(a,b); { auto rr=__builtin_amdgcn_permlane32_swap(__float_as_uint(rm),__float_as_uint(rm),false,false); rm=__builtin_fmaxf(__uint_as_float(rr[0]),__uint_as_float(rr[1])); } \
      resc=false; \
      if(__builtin_expect(__any(rm>(float)THRL),0)){ const float mold=mhat; const float mnew=mold+__builtin_fmaxf(rm,0.f); SETREF(mnew); const float dl=mhat-mold; \
        _Pragma("unroll") for(int r=0;r<16;++r){C0[r]-=dl;C1[r]-=dl;} \
        const float f=__builtin_amdgcn_exp2f(-dl); l_reg*=f; if(hi==0)wsf[r32]=f; resc=true; } } \
    SBAR(); \
    GAPB(o[0]=__builtin_amdgcn_mfma_f32_32x32x16_bf16(PAF(0),VFR(0),o[0],0,0,0), C0,0); \
    GAPB(o[1]=__builtin_amdgcn_mfma_f32_32x32x16_bf16(PAF(0),VFR(4),o[1],0,0,0), C0,4); \
    KRD(GL,0); GAPB(o[0]=__builtin_amdgcn_mfma_f32_32x32x16_bf16(PAF(1),VFR(1),o[0],0,0,0), C0,8); \
    KRD(GL,1); GAPB(o[1]=__builtin_amdgcn_mfma_f32_32x32x16_bf16(PAF(1),VFR(5),o[1],0,0,0), C0,12); \
    KRD(GL,2); GAPB(o[0]=__builtin_amdgcn_mfma_f32_32x32x16_bf16(PAF(2),VFR(2),o[0],0,0,0), C1,0); \
    KRD(GL,3); GAPB(o[1]=__builtin_amdgcn_mfma_f32_32x32x16_bf16(PAF(2),VFR(6),o[1],0,0,0), C1,4); \
    GAPB(o[0]=__builtin_amdgcn_mfma_f32_32x32x16_bf16(PAF(3),VFR(3),o[0],0,0,0), C1,8); \
    GAPB(o[1]=__builtin_amdgcn_mfma_f32_32x32x16_bf16(PAF(3),VFR(7),o[1],0,0,0), C1,12); \
    }while(0)
  int t=1;
  if(MODE==0){
    #undef CMASK
    #define CMASK(P0,P1,t) do{}while(0)
    for(;t+5<NT;t+=2){
      STEP(pB0,pB1,pA0,pA1,t,true,true,true);     WAIT_BAR(2); RESC(); ROT();
      STEP(pA0,pA1,pB0,pB1,t+1,true,true,true);   WAIT_BAR(2); RESC(); ROT();
    }
    #undef CMASK
    #define CMASK(P0,P1,t) do{ if(MODE!=0||(t)>=NT-4) wmask<W>(P0,P1,qrel-64*(t),NEG); }while(0)
  }
  #define ENDW(tt) do{ if(MODE==0){ if((tt)+3<NT){WAIT_BAR(2);} else if((tt)+2<NT){WAIT_BAR(1);} else {WAIT_BAR(0);} } }while(0)
  for(;t+1<NT;t+=2){
    STEP(pB0,pB1,pA0,pA1,t,(MODE==0&&t+3<NT),(MODE==0&&t+1<NT),(t+1<NT));       ENDW(t);   RESC(); ROT();
    STEP(pA0,pA1,pB0,pB1,t+1,(MODE==0&&t+4<NT),(MODE==0&&t+2<NT),(t+2<NT));     ENDW(t+1); RESC(); ROT();
  }
  STEP(pB0,pB1,pA0,pA1,NT-1,false,false,false); RESC();
  { float sacc=pB0[0]+pB0[1]; _Pragma("unroll") for(int r=2;r<16;++r)sacc+=pB0[r]; _Pragma("unroll") for(int r=0;r<16;++r)sacc+=pB1[r]; l_reg+=sacc;
    pw0=(u32x4){PKW(pB0,0),PKW(pB0,2),PKW(pB0,4),PKW(pB0,6)};pw1=(u32x4){PKW(pB0,8),PKW(pB0,10),PKW(pB0,12),PKW(pB0,14)};pw2=(u32x4){PKW(pB1,0),PKW(pB1,2),PKW(pB1,4),PKW(pB1,6)};pw3=(u32x4){PKW(pB1,8),PKW(pB1,10),PKW(pB1,12),PKW(pB1,14)};
    SBAR(); pv(o,(int)(lds0+LDS_V)+((lane>>4)&1)*32+(lane&3)*8+(4*hi+((lane&15)>>2))*64+sl_cur,PAF(0),PAF(1),PAF(2),PAF(3)); }
  #undef PKW
  #undef PAF
  #undef VFR
  #undef PIN
  #undef MX3
  #undef GAPA
  #undef GAPB
  #undef EX
  #undef VRD
  #undef KRD
  #undef STEP
  #undef ENDW
  {auto rr=__builtin_amdgcn_permlane32_swap(__float_as_uint(l_reg),__float_as_uint(l_reg),false,false);l_reg=__uint_as_float(rr[0])+__uint_as_float(rr[1]);}
  const float qposf=(float)(u.q0+wid*QBLK+r32);
  if(MODE==2) l_reg+=__builtin_amdgcn_exp2f(u.sink2+s2used*qposf-mhat);
  if(MODE==1){ if(hi==0) u.lse[(long)(wid*QBLK+r32)*(16*DIL)]=mhat-s2used*qposf+__builtin_amdgcn_logf(l_reg); }
  if(hi==0)wsf[32+r32]=l_reg;asm volatile("s_waitcnt lgkmcnt(0)":::"memory");
  float rli[16];
  #pragma unroll
  for(int r=0;r<16;++r)rli[r]=__builtin_amdgcn_rcpf(wsf[32+crow(r,hi)]);
  bf16*Ow=u.O+(long)(wid*QBLK)*OS;
  { int le=lane; asm volatile("":"+v"(le));
    const int r32e=le&31,hie=le>>5;
    __hip_bfloat16*stg=(__hip_bfloat16*)(shm+LDS_OST)+wid*2048;
    #pragma unroll
    for(int r=0;r<16;++r){const int orow=crow(r,hie);
      #pragma unroll
      for(int d0=0;d0<2;++d0)stg[orow*64+d0*32+r32e]=__float2bfloat16(o[d0][r]*rli[r]);}
    asm volatile("s_waitcnt lgkmcnt(0)":::"memory");
    #pragma unroll
    for(int i=0;i<4;++i){const int row=i*8+(le>>3),ch=le&7; const u32x4 v=*(const u32x4*)(stg+row*64+ch*8); *(u32x4*)(Ow+(long)row*OS+ch*8)=v;} }
  asm volatile("s_waitcnt lgkmcnt(0)\n\ts_barrier":::"memory");
  #undef DMA_K
  #undef DMA_V
  #undef CMASK
  #undef RESC
  #undef ROT
  #undef SETTG
  #undef SETREF
  #undef KX0
  #undef QX
}
#undef SBAR
#undef WAIT_BAR
}

namespace att128 {
using att::UnitDesc; using att::crow; using att::glds16; using att::max3f; using att::max2f; using att::fsub_s; using att::cvtpk_s; using att::kload8; using att::kload2; using att::vtr; using att::rowmax; using att::wmask; using att::lds_cptr;
using bf16=unsigned short;
using bf16x8=__attribute__((ext_vector_type(8)))short;
using s16x4=__attribute__((ext_vector_type(4)))short;
using f32x16=__attribute__((ext_vector_type(16)))float;
using u32x4=__attribute__((ext_vector_type(4)))unsigned;
constexpr int NW=8,QBLK=32,QB=QBLK*NW,KVBLK=64;
#define SBAR() __builtin_amdgcn_sched_barrier(0)
constexpr int NSLOT=3, SLOTB=8192, SLOTV=16384;
constexpr int LDS_K=0, LDS_V=NSLOT*SLOTB, LDS_WS=LDS_V+NSLOT*SLOTV, LDS_OST=LDS_WS+NW*64*4, LDS_BYTES=LDS_OST+NW*8192;
#define WAIT_BAR(N) asm volatile("s_waitcnt vmcnt(" #N ") lgkmcnt(0)\n\ts_barrier":::"memory")
__device__ __forceinline__ void pv4(f32x16*o,int vb,bf16x8 pa0,bf16x8 pa1,bf16x8 pa2,bf16x8 pa3){
  #pragma unroll
  for(int d0=0;d0<4;++d0){s16x4 lo[4],hi[4];
    #pragma unroll
    for(int ks=0;ks<4;++ks){
      asm volatile("ds_read_b64_tr_b16 %0,%1 offset:%c2":"=&v"(lo[ks]):"v"(vb),"i"(d0*4096+ks*1024):"memory");
      asm volatile("ds_read_b64_tr_b16 %0,%1 offset:%c2":"=&v"(hi[ks]):"v"(vb),"i"(d0*4096+ks*1024+512):"memory");}
    asm volatile("s_waitcnt lgkmcnt(0)":::"memory");SBAR();
    #define PK(k) (bf16x8){lo[k][0],lo[k][1],lo[k][2],lo[k][3],hi[k][0],hi[k][1],hi[k][2],hi[k][3]}
    o[d0]=__builtin_amdgcn_mfma_f32_32x32x16_bf16(pa0,PK(0),o[d0],0,0,0);
    o[d0]=__builtin_amdgcn_mfma_f32_32x32x16_bf16(pa1,PK(1),o[d0],0,0,0);
    o[d0]=__builtin_amdgcn_mfma_f32_32x32x16_bf16(pa2,PK(2),o[d0],0,0,0);
    o[d0]=__builtin_amdgcn_mfma_f32_32x32x16_bf16(pa3,PK(3),o[d0],0,0,0);
    #undef PK
  }
}
template<int MODE,int THRL,int DIL,int OS> __device__ __forceinline__ void attn_unit(const UnitDesc&u,char*shm){
  static_assert(MODE==0,"att128: causal mode only");
  constexpr int W=(MODE==0)?0x7fffffff:(MODE==1?128:127);
  const float NEG=(MODE==0)?-INFINITY:-1024.f;
  int tid=threadIdx.x; asm volatile("":"+v"(tid));
  const int lane=tid&63,r32=lane&31,hi=lane>>5; const int wid=__builtin_amdgcn_readfirstlane(tid>>6);
  constexpr long qs=64L*DIL,ks=64L*DIL,vs=64L*DIL;
  const bf16*Qw=u.Q+(long)(wid*QBLK)*qs;
  const unsigned lds0=(unsigned)(uintptr_t)shm;
  __attribute__((address_space(3))) float*wsf=(__attribute__((address_space(3))) float*)((__attribute__((address_space(3))) char*)shm+LDS_WS)+wid*64;
  const unsigned ksoff=(unsigned)(((long)(8*wid+(lane>>3))*ks+(((lane&7)^(lane>>3))*8))*2);
  const unsigned vsoff=(unsigned)(((long)(16*(wid&3)+(lane>>2))*vs+(wid>>2)*32+(lane&3)*8)*2);
  const unsigned kdst=lds0+LDS_K+wid*1024, vdst=lds0+LDS_V+wid*1024;
  #define DMA_K(t,slot) glds16(u.K+(long)(t)*KVBLK*ks,ksoff,(unsigned)__builtin_amdgcn_readfirstlane(kdst+(slot)))
  #define DMA_V(t,slot) do{ glds16(u.V+(long)(t)*KVBLK*vs,vsoff,(unsigned)__builtin_amdgcn_readfirstlane(vdst+2*(slot))); glds16(u.V+(long)(t)*KVBLK*vs+64*(long)M,vsoff,(unsigned)__builtin_amdgcn_readfirstlane(vdst+2*(slot)+8192)); }while(0)
  bf16x8 kf[8];
  const lds_cptr shm3=(lds_cptr)shm; const lds_cptr kp0=shm3+LDS_K+r32*128+((hi^(r32&1))*16); const int kbo=((r32>>1)&3)<<5; const lds_cptr vp0=shm3+LDS_V+((lane>>4)&1)*32+(lane&3)*8+(4*hi+((lane&15)>>2))*64;
  const int NT=u.NT;
  DMA_K(0,0);DMA_V(0,0);DMA_K(1,SLOTB);
  bf16x8 qr[4];
  #pragma unroll
  for(int d0=0;d0<4;++d0)qr[d0]=*reinterpret_cast<const bf16x8*>(&Qw[(long)r32*qs+d0*16+hi*8]);
  const unsigned s2hb=__float_as_uint(u.slope2)&0xffff0000u; const float s2hf=__uint_as_float(s2hb);
  const unsigned s2lb=__float_as_uint(u.slope2-s2hf)&0xffff0000u; const float s2used=s2hf+__uint_as_float(s2lb);
  u32x4 qx; qx[0]=hi?0u:((__float_as_uint(64.f*s2hf)>>16)|(__float_as_uint(64.f*__uint_as_float(s2lb))&0xffff0000u)); qx[1]=hi?0u:((s2hb>>16)|s2lb); qx[2]=0u; qx[3]=0u;
  u32x4 kx0; unsigned jp0,jp1; { const unsigned j0=__float_as_uint((float)r32)>>16, j1=__float_as_uint((float)(r32+32))>>16; jp0=j0|(j0<<16); jp1=j1|(j1<<16);
    kx0[0]=0u; kx0[1]=jp0; kx0[2]=0x3f803f80u; kx0[3]=0u; }
  #define SETTG(t) do{ const unsigned tb_=__float_as_uint((float)(u.tg0+(t)))>>16; kx0[0]=(tb_|(tb_<<16)); }while(0)
  #define KX0 __builtin_bit_cast(bf16x8,kx0)
  #define QX __builtin_bit_cast(bf16x8,qx)
  #define SETREF(m_) do{ const unsigned hb_=__float_as_uint(m_)&0xffff0000u; const float hf_=__uint_as_float(hb_); const unsigned lb_=__float_as_uint((m_)-hf_)&0xffff0000u; \
      mhat=hf_+__uint_as_float(lb_); qx[2]=hi?0u:(((hb_^0x80000000u)>>16)|(lb_^0x80000000u)); }while(0)
  float mhat=0.f,l_reg=0.f;f32x16 o[4];o[0]=f32x16{};o[1]=f32x16{};o[2]=f32x16{};o[3]=f32x16{};
  const int qrel=u.rel0+wid*QBLK+r32-4*hi;
  #define CMASK(P0,P1,t) do{ if(MODE!=0||(t)>=NT-4) wmask<W>(P0,P1,qrel-64*(t),NEG); }while(0)
  bool resc=false;
  f32x16 pA0,pA1,pB0,pB1;
  int sl_prev=0,sl_cur=0,sl_next=SLOTB;
  #define ROT() do{sl_prev=sl_cur;sl_cur=sl_next;sl_next=(sl_next==(NSLOT-1)*SLOTB)?0:sl_next+SLOTB;}while(0)
  #define RESC() do{ if(resc){ asm volatile("s_waitcnt lgkmcnt(0)":::"memory"); \
      _Pragma("unroll") for(int d_=0;d_<4;++d_) _Pragma("unroll") for(int r=0;r<16;++r)o[d_][r]*=wsf[crow(r,hi)]; } }while(0)
  DMA_K(2,2*SLOTB);
  WAIT_BAR(4);
  { SETTG(0); const f32x16 z=f32x16{}; const lds_cptr kb=kp0;
    #pragma unroll
    for(int d0=0;d0<4;++d0){
      const bf16x8 b0=*(const __attribute__((address_space(3))) bf16x8*)(kb+((d0*32)^kbo));
      const bf16x8 b1=*(const __attribute__((address_space(3))) bf16x8*)(kb+((d0*32)^kbo)+4096);
      if(d0==0){pA0=__builtin_amdgcn_mfma_f32_32x32x16_bf16(b0,qr[0],z,0,0,0);pA1=__builtin_amdgcn_mfma_f32_32x32x16_bf16(b1,qr[0],z,0,0,0);}
      else{pA0=__builtin_amdgcn_mfma_f32_32x32x16_bf16(b0,qr[d0],pA0,0,0,0);pA1=__builtin_amdgcn_mfma_f32_32x32x16_bf16(b1,qr[d0],pA1,0,0,0);}}
    pA0=__builtin_amdgcn_mfma_f32_32x32x16_bf16(KX0,QX,pA0,0,0,0); kx0[1]=jp1; pA1=__builtin_amdgcn_mfma_f32_32x32x16_bf16(KX0,QX,pA1,0,0,0); kx0[1]=jp0; }
  asm volatile("s_nop 15\n\ts_nop 7":"+v"(pA0),"+v"(pA1));CMASK(pA0,pA1,0);
  { const float rm=rowmax(pA0,pA1); SETREF(rm); const float dl=mhat;
    _Pragma("unroll") for(int r=0;r<16;++r){pA0[r]=fsub_s(pA0[r],dl);pA1[r]=fsub_s(pA1[r],dl);}
    _Pragma("unroll") for(int r=0;r<16;++r)pA0[r]=__builtin_amdgcn_exp2f(pA0[r]); }
  _Pragma("unroll") for(int r=0;r<16;++r)pA1[r]=__builtin_amdgcn_exp2f(pA1[r]);
  WAIT_BAR(0);
  DMA_K(3,0);DMA_V(1,SLOTB);
  ROT();
  kload8(kf,kp0+sl_cur,kbo);
  WAIT_BAR(3);
  s16x4 vlo[3],vhi[3]; u32x4 pw0,pw1,pw2,pw3;
  #define PKW(P,B) cvtpk_s(P[B],P[B+1])
  #define PAF(k) __builtin_bit_cast(bf16x8,pw##k)
  #define VFJ(b) (bf16x8){vlo[b][0],vlo[b][1],vlo[b][2],vlo[b][3],vhi[b][0],vhi[b][1],vhi[b][2],vhi[b][3]}
  #define PIN(x) asm volatile("":"+v"(x))
  #define MX3(a,b,c) __builtin_fmaxf(__builtin_fmaxf((a),(b)),(c))
  #define GAPA(MF,A0,A1,A2,A3,W0,W1,PW) do{ MF; sacc+=A0; sacc+=A1; sacc+=A2; sacc+=A3; PIN(sacc); W0; W1; PIN(PW); SBAR(); }while(0)
  #define EX(v) __builtin_amdgcn_exp2f(v)
  #define GAPB2(MF,X,B) do{ MF; X[B]=EX(X[B]); X[B+1]=EX(X[B+1]); PIN(X); SBAR(); }while(0)
  #define VRJ(b,n) do{ vlo[b]=vtr(vp_+(((n)&3)*4096+((n)>>2)*1024)); vhi[b]=vtr(vp_+(((n)&3)*4096+((n)>>2)*1024+512)); SBAR(); }while(0)
  #define KRD(G,j) do{ if(G){ kload2(kf,kp0+sl_next,j,kbo); SBAR(); } }while(0)
  #define STEP(C0,C1,P0,P1,t,GK,GV,GL) do{ SBAR(); SETTG(t); const f32x16 z_=f32x16{}; \
    const lds_cptr vp_=vp0+2*sl_prev; \
    float sacc=(P0[0]+P0[1]); \
    GAPA(C0=__builtin_amdgcn_mfma_f32_32x32x16_bf16(kf[0],qr[0],z_,0,0,0), P0[2],P0[3],P0[4],P0[5],     pw0[0]=PKW(P0,0), pw0[1]=PKW(P0,2), pw0); \
    GAPA(C1=__builtin_amdgcn_mfma_f32_32x32x16_bf16(kf[1],qr[0],z_,0,0,0), P0[6],P0[7],P0[8],P0[9],     pw0[2]=PKW(P0,4), pw0[3]=PKW(P0,6), pw0); \
    GAPA(C0=__builtin_amdgcn_mfma_f32_32x32x16_bf16(kf[2],qr[1],C0,0,0,0),   P0[10],P0[11],P0[12],P0[13], pw1[0]=PKW(P0,8), pw1[1]=PKW(P0,10), pw1); \
    GAPA(C1=__builtin_amdgcn_mfma_f32_32x32x16_bf16(kf[3],qr[1],C1,0,0,0),   P0[14],P0[15],P1[0],P1[1],   pw1[2]=PKW(P0,12),pw1[3]=PKW(P0,14), pw1); \
    GAPA(C0=__builtin_amdgcn_mfma_f32_32x32x16_bf16(kf[4],qr[2],C0,0,0,0),   P1[2],P1[3],P1[4],P1[5],     pw2[0]=PKW(P1,0), pw2[1]=PKW(P1,2), pw2); \
    GAPA(C1=__builtin_amdgcn_mfma_f32_32x32x16_bf16(kf[5],qr[2],C1,0,0,0),   P1[6],P1[7],P1[8],P1[9],     pw2[2]=PKW(P1,4), pw2[3]=PKW(P1,6), pw2); \
    VRJ(0,0); GAPA(C0=__builtin_amdgcn_mfma_f32_32x32x16_bf16(kf[6],qr[3],C0,0,0,0),   P1[10],P1[11],P1[12],P1[13], pw3[0]=PKW(P1,8), pw3[1]=PKW(P1,10), pw3); \
    VRJ(1,1); GAPA(C1=__builtin_amdgcn_mfma_f32_32x32x16_bf16(kf[7],qr[3],C1,0,0,0),   P1[14],P1[15],0.f,0.f,       pw3[2]=PKW(P1,12),pw3[3]=PKW(P1,14), pw3); \
    C0=__builtin_amdgcn_mfma_f32_32x32x16_bf16(KX0,QX,C0,0,0,0); kx0[1]=jp1; C1=__builtin_amdgcn_mfma_f32_32x32x16_bf16(KX0,QX,C1,0,0,0); kx0[1]=jp0; SBAR(); \
    l_reg+=sacc; \
    if(GK){DMA_K((t)+3,sl_cur);} if(GV){DMA_V((t)+1,sl_next);} \
    CMASK(C0,C1,t); \
    { float a=MX3(C0[0],C0[1],C1[0]),b=MX3(C0[2],C0[3],C1[1]); a=MX3(a,C1[2],C1[3]); \
      _Pragma("unroll") for(int r=4;r<16;r+=4){a=MX3(a,C0[r],C0[r+1]);b=MX3(b,C0[r+2],C0[r+3]);a=MX3(a,C1[r],C1[r+1]);b=MX3(b,C1[r+2],C1[r+3]);} \
      float rm=__builtin_fmaxf(a,b); { auto rr=__builtin_amdgcn_permlane32_swap(__float_as_uint(rm),__float_as_uint(rm),false,false); rm=__builtin_fmaxf(__uint_as_float(rr[0]),__uint_as_float(rr[1])); } \
      resc=false; \
      if(__builtin_expect(__any(rm>(float)THRL),0)){ const float mold=mhat; const float mnew=mold+__builtin_fmaxf(rm,0.f); SETREF(mnew); const float dl=mhat-mold; \
        _Pragma("unroll") for(int r=0;r<16;++r){C0[r]-=dl;C1[r]-=dl;} \
        const float f=__builtin_amdgcn_exp2f(-dl); l_reg*=f; if(hi==0)wsf[r32]=f; resc=true; } } \
    SBAR(); \
    VRJ(2,2);             GAPB2(o[0]=__builtin_amdgcn_mfma_f32_32x32x16_bf16(PAF(0),VFJ(0),o[0],0,0,0), C0,0); \
    VRJ(0,3);             GAPB2(o[1]=__builtin_amdgcn_mfma_f32_32x32x16_bf16(PAF(0),VFJ(1),o[1],0,0,0), C0,2); \
    VRJ(1,4);             GAPB2(o[2]=__builtin_amdgcn_mfma_f32_32x32x16_bf16(PAF(0),VFJ(2),o[2],0,0,0), C0,4); \
    VRJ(2,5);             GAPB2(o[3]=__builtin_amdgcn_mfma_f32_32x32x16_bf16(PAF(0),VFJ(0),o[3],0,0,0), C0,6); \
    VRJ(0,6);  KRD(GL,0); GAPB2(o[0]=__builtin_amdgcn_mfma_f32_32x32x16_bf16(PAF(1),VFJ(1),o[0],0,0,0), C0,8); \
    VRJ(1,7);             GAPB2(o[1]=__builtin_amdgcn_mfma_f32_32x32x16_bf16(PAF(1),VFJ(2),o[1],0,0,0), C0,10); \
    VRJ(2,8);  KRD(GL,1); GAPB2(o[2]=__builtin_amdgcn_mfma_f32_32x32x16_bf16(PAF(1),VFJ(0),o[2],0,0,0), C0,12); \
    VRJ(0,9);             GAPB2(o[3]=__builtin_amdgcn_mfma_f32_32x32x16_bf16(PAF(1),VFJ(1),o[3],0,0,0), C0,14); \
    VRJ(1,10); KRD(GL,2); GAPB2(o[0]=__builtin_amdgcn_mfma_f32_32x32x16_bf16(PAF(2),VFJ(2),o[0],0,0,0), C1,0); \
    VRJ(2,11);            GAPB2(o[1]=__builtin_amdgcn_mfma_f32_32x32x16_bf16(PAF(2),VFJ(0),o[1],0,0,0), C1,2); \
    VRJ(0,12); KRD(GL,3); GAPB2(o[2]=__builtin_amdgcn_mfma_f32_32x32x16_bf16(PAF(2),VFJ(1),o[2],0,0,0), C1,4); \
    VRJ(1,13);            GAPB2(o[3]=__builtin_amdgcn_mfma_f32_32x32x16_bf16(PAF(2),VFJ(2),o[3],0,0,0), C1,6); \
    VRJ(2,14);            GAPB2(o[0]=__builtin_amdgcn_mfma_f32_32x32x16_bf16(PAF(3),VFJ(0),o[0],0,0,0), C1,8); \
    VRJ(0,15);            GAPB2(o[1]=__builtin_amdgcn_mfma_f32_32x32x16_bf16(PAF(3),VFJ(1),o[1],0,0,0), C1,10); \
                          GAPB2(o[2]=__builtin_amdgcn_mfma_f32_32x32x16_bf16(PAF(3),VFJ(2),o[2],0,0,0), C1,12); \
                          GAPB2(o[3]=__builtin_amdgcn_mfma_f32_32x32x16_bf16(PAF(3),VFJ(0),o[3],0,0,0), C1,14); \
    }while(0)
  int t=1;
  if(MODE==0){
    #undef CMASK
    #define CMASK(P0,P1,t) do{}while(0)
    for(;t+5<NT;t+=2){
      STEP(pB0,pB1,pA0,pA1,t,true,true,true);     WAIT_BAR(3); RESC(); ROT();
      STEP(pA0,pA1,pB0,pB1,t+1,true,true,true);   WAIT_BAR(3); RESC(); ROT();
    }
    #undef CMASK
    #define CMASK(P0,P1,t) do{ if(MODE!=0||(t)>=NT-4) wmask<W>(P0,P1,qrel-64*(t),NEG); }while(0)
  }
  #define ENDW(tt) do{ if((tt)+3<NT){WAIT_BAR(3);} else if((tt)+2<NT){WAIT_BAR(2);} else {WAIT_BAR(0);} }while(0)
  for(;t+1<NT;t+=2){
    STEP(pB0,pB1,pA0,pA1,t,(t+3<NT),(t+1<NT),(t+1<NT));       ENDW(t);   RESC(); ROT();
    STEP(pA0,pA1,pB0,pB1,t+1,(t+4<NT),(t+2<NT),(t+2<NT));     ENDW(t+1); RESC(); ROT();
  }
  STEP(pB0,pB1,pA0,pA1,NT-1,false,false,false); RESC();
  { float sacc=pB0[0]+pB0[1]; _Pragma("unroll") for(int r=2;r<16;++r)sacc+=pB0[r]; _Pragma("unroll") for(int r=0;r<16;++r)sacc+=pB1[r]; l_reg+=sacc;
    pw0=(u32x4){PKW(pB0,0),PKW(pB0,2),PKW(pB0,4),PKW(pB0,6)};pw1=(u32x4){PKW(pB0,8),PKW(pB0,10),PKW(pB0,12),PKW(pB0,14)};pw2=(u32x4){PKW(pB1,0),PKW(pB1,2),PKW(pB1,4),PKW(pB1,6)};pw3=(u32x4){PKW(pB1,8),PKW(pB1,10),PKW(pB1,12),PKW(pB1,14)};
    SBAR(); pv4(o,(int)(lds0+LDS_V)+((lane>>4)&1)*32+(lane&3)*8+(4*hi+((lane&15)>>2))*64+2*sl_cur,PAF(0),PAF(1),PAF(2),PAF(3)); }
  #undef PKW
  #undef PAF
  #undef VFJ
  #undef PIN
  #undef MX3
  #undef GAPA
  #undef GAPB2
  #undef EX
  #undef VRJ
  #undef KRD
  #undef STEP
  #undef ENDW
  {auto rr=__builtin_amdgcn_permlane32_swap(__float_as_uint(l_reg),__float_as_uint(l_reg),false,false);l_reg=__uint_as_float(rr[0])+__uint_as_float(rr[1]);}
  const float qposf=(float)(u.q0+wid*QBLK+r32);
  if(MODE==2) l_reg+=__builtin_amdgcn_exp2f(u.sink2+s2used*qposf-mhat);
  if(MODE==1){ if(hi==0) u.lse[(long)(wid*QBLK+r32)*(16*DIL)]=mhat-s2used*qposf+__builtin_amdgcn_logf(l_reg); }
  if(hi==0)wsf[32+r32]=l_reg;asm volatile("s_waitcnt lgkmcnt(0)":::"memory");
  float rli[16];
  #pragma unroll
  for(int r=0;r<16;++r)rli[r]=__builtin_amdgcn_rcpf(wsf[32+crow(r,hi)]);
  bf16*Ow=u.O+(long)(wid*QBLK)*OS;
  { int le=lane; asm volatile("":"+v"(le));
    const int r32e=le&31,hie=le>>5;
    __hip_bfloat16*stg=(__hip_bfloat16*)(shm+LDS_OST)+wid*4096;
    #pragma unroll
    for(int r=0;r<16;++r){const int orow=crow(r,hie);
      #pragma unroll
      for(int d0=0;d0<4;++d0)stg[orow*128+d0*32+r32e]=__float2bfloat16(o[d0][r]*rli[r]);}
    asm volatile("s_waitcnt lgkmcnt(0)":::"memory");
    #pragma unroll
    for(int i=0;i<8;++i){const int row=i*4+(le>>4),ch=le&15; const u32x4 v=*(const u32x4*)(stg+row*128+ch*8); *(u32x4*)(Ow+(long)row*OS+ch*8)=v;} }
  asm volatile("s_waitcnt lgkmcnt(0)\n\ts_barrier":::"memory");
  #undef DMA_K
  #undef DMA_V
  #undef CMASK
  #undef RESC
  #undef ROT
  #undef SETTG
  #undef SETREF
  #undef KX0
  #undef QX
}
#undef SBAR
#undef WAIT_BAR
}

constexpr float LOG2E = 1.4426950408889634f;
__device__ __forceinline__ int vcu_of(int bx, int G) { return (G % 8 == 0) ? (bx % 8) * (G / 8) + bx / 8 : bx; }
constexpr int ATT1_LDS_TAB = 141312;
__device__ __forceinline__ void attn1_tuned_phase(const Ctx& c, const bf16* qkv, const float* qkg  , bf16* R, unsigned* qctr, const ExpertSrc& es, unsigned char* ws,
                                                  const float* lamp, const float* subln, bf16* Oout) {
    LAS int* order = (LAS int*)(c.lds + ATT1_LDS_TAB);
    LAS int* nts = order + 256;
    LAS int* t0s = nts + 256;
    volatile LAS unsigned* nextu = (volatile LAS unsigned*)(t0s + 256);
    LAS float* bnd = (LAS float*)(t0s + 256 + 4);
    const int G = gridDim.x;
    if (c.wave == 0) { float gq = fabsf(qkg[c.lane]), gk = fabsf(qkg[64 + c.lane]);
#pragma unroll
        for (int o = 1; o < 64; o <<= 1) { gq = fmaxf(gq, __shfl_xor(gq, o)); gk = fmaxf(gk, __shfl_xor(gk, o)); }
        if (c.lane == 0) bnd[0] = 8.f * gq * gk * 1.02f; }
    __syncthreads();
    if (c.tid < 256) { const int h = c.tid >> 4, qb = c.tid & 15; const float slope = exp2f(-0.5f * (float)(h + 1));
        const int dmax = (int)fminf(ceilf((2.f * bnd[0] + 25.f) / slope), 1.0e6f), lo_ = 256 * qb - dmax, t0 = lo_ <= 0 ? 0 : ((lo_ >> 6) & ~1);
        nts[c.tid] = 4 * (qb + 1) - t0; t0s[c.tid] = t0; }
    __syncthreads();
    if (c.tid < 256) { const int mine = nts[c.tid]; int rank = 0;
        for (int e = 0; e < 256; ++e) { const int o = nts[e]; rank += (o > mine || (o == mine && e < c.tid)) ? 1 : 0; }
        order[rank] = c.tid; }
    __syncthreads();
#if FUSE_FINISH
    constexpr int NCH = DEFER_CONV ? EXP_ITEMS / 65 : 0, NUNIT = NB * 16 * 16, NPOS = NUNIT + NCH;
    static_assert(!DEFER_CONV || EXP_ITEMS % 65 == 0, "chunking");
    if (c.tid == 0) { float s01 = 0.f, s23 = 0.f; for (int i = 0; i < 64; ++i) { s01 += lamp[i] * lamp[64 + i]; s23 += lamp[128 + i] * lamp[192 + i]; }
      const float li = 0.8f - 0.6f * expf(-0.3f * 1.0f); bnd[1] = expf(s01) - expf(s23) + li; bnd[2] = li; }
    __syncthreads();
    unsigned p = blockIdx.x;
    while (p < (unsigned)NPOS) {
        unsigned nreg = 0u;
        if (c.tid == 0) nreg = __hip_atomic_fetch_add(qctr, 1u, __ATOMIC_RELAXED, __HIP_MEMORY_SCOPE_AGENT) + (unsigned)G;
        const bool inter = p < (unsigned)(NCH * 2);
        if (inter && (p & 1u)) {
            expert_items_block(c, es, 1, ws, (int)(p >> 1) * 65, 65);
        } else {
#define ATT1_DECODE() const unsigned u = inter ? (p >> 1) : p - (unsigned)NCH; const int ent = order[u >> 2], h = ent >> 4, qb = ent & 15, b = (int)(u & 3u), t0 = t0s[ent]; \
            bf16* Rblk = R + ((size_t)(b * T + qb * 256) * 16 + h) * 256
#if USE_V128
#pragma unroll 1
            for (int pass = 0; pass < 2; ++pass) {
                ATT1_DECODE();
                const int i = pass; att::UnitDesc ud;
                ud.Q = qkv + ((size_t)(2 * h + i) * M + (size_t)(b * T + qb * 256)) * 64; ud.qs = 64;
                ud.K = qkv + ((size_t)(32 + 2 * h + i) * M + (size_t)(b * T + 64 * t0)) * 64; ud.ks = 64;
                ud.V = qkv + ((size_t)(64 + 2 * h) * M + (size_t)(b * T + 64 * t0)) * 64; ud.vs = 64;
                ud.O = Rblk + 128 * i; ud.os = 16 * 256;
                ud.lse = nullptr; ud.lses = 0; ud.NT = 4 * (qb + 1) - t0; ud.rel0 = qb * 256 - 64 * t0; ud.tg0 = t0; ud.q0 = qb * 256;
                ud.slope2 = exp2f(-0.5f * (float)(h + 1)) * LOG2E; ud.sink2 = 0.f;
                att128::attn_unit<0, 8, 1, 16 * 256>(ud, (char*)c.lds);
            }
#else
#pragma unroll 1
            for (int pass = 0; pass < 4; ++pass) {
                ATT1_DECODE();
                const int i = pass >> 1, j = pass & 1; att::UnitDesc ud;
#if QKV_HEADMAJOR
                ud.Q = qkv + ((size_t)(2 * h + i) * M + (size_t)(b * T + qb * 256)) * 64; ud.qs = 64;
                ud.K = qkv + ((size_t)(32 + 2 * h + i) * M + (size_t)(b * T + 64 * t0)) * 64; ud.ks = 64;
                ud.V = qkv + ((size_t)(64 + 2 * h + j) * M + (size_t)(b * T + 64 * t0)) * 64; ud.vs = 64;
#else
                ud.Q = qkv + (size_t)(b * T + qb * 256) * C_IN + 128 * h + 64 * i; ud.qs = C_IN;
                ud.K = qkv + (size_t)(b * T + 64 * t0) * C_IN + 2048 + 128 * h + 64 * i; ud.ks = C_IN;
                ud.V = qkv + (size_t)(b * T + 64 * t0) * C_IN + 4096 + 128 * h + 64 * j; ud.vs = C_IN;
#endif
                ud.O = Rblk + 128 * i + 64 * j; ud.os = 16 * 256;
                ud.lse = nullptr; ud.lses = 0; ud.NT = 4 * (qb + 1) - t0; ud.rel0 = qb * 256 - 64 * t0; ud.tg0 = t0; ud.q0 = qb * 256;
                ud.slope2 = exp2f(-0.5f * (float)(h + 1)) * LOG2E; ud.sink2 = 0.f;
                att::attn_unit<0, 8, 1, 16 * 256>(ud, (char*)c.lds);
            }
#endif
            asm volatile("s_waitcnt vmcnt(0)" ::: "memory"); __syncthreads();
            { ATT1_DECODE(); (void)t0; const float lam = bnd[1], lam_init = bnd[2];
              int ft_ = threadIdx.x; asm volatile("" : "+v"(ft_));
              const int row = ft_ >> 1, hf = ft_ & 1; const bf16* p1 = Rblk + (size_t)row * (16 * 256) + 64 * hf; const bf16* p2 = p1 + 128;
              float xv[64]; float ss = 0.f;
#pragma unroll
              for (int q8 = 0; q8 < 8; ++q8) { const u32x4 a = *(const u32x4*)(p1 + 8 * q8), bq = *(const u32x4*)(p2 + 8 * q8);
#pragma unroll
                  for (int k = 0; k < 4; ++k) { const float x0 = bf2f(a[k] & 0xffffu) - lam * bf2f(bq[k] & 0xffffu), x1 = bf2f(a[k] >> 16) - lam * bf2f(bq[k] >> 16);
                      xv[8 * q8 + 2 * k] = x0; xv[8 * q8 + 2 * k + 1] = x1; ss += x0 * x0 + x1 * x1; } }
              ss += __shfl_xor(ss, 1);
              const float rs = (1.f - lam_init) / sqrtf(ss * (1.f / 128.f) + RMS_EPS);
              bf16* op = Oout + (size_t)(b * T + qb * 256 + row) * D + 128 * h + 64 * hf; const float* sg = subln + 64 * hf;
#pragma unroll
              for (int q8 = 0; q8 < 8; ++q8) { u32x4 w;
#pragma unroll
                  for (int k = 0; k < 4; ++k) w[k] = pk2(xv[8 * q8 + 2 * k] * rs * sg[8 * q8 + 2 * k], xv[8 * q8 + 2 * k + 1] * rs * sg[8 * q8 + 2 * k + 1]);
                  *(u32x4*)(op + 8 * q8) = w; } }
#undef ATT1_DECODE
        }
        if (c.tid == 0) nextu[0] = nreg;
        __syncthreads();
        p = nextu[0];
    }
}
#else
    constexpr int NCH = DEFER_CONV ? EXP_ITEMS / 65 : 0, NPOS = NB * 16 * 4 * 16 + NCH;
    static_assert(!DEFER_CONV || EXP_ITEMS % 65 == 0, "chunking");
    unsigned p = blockIdx.x;
    while (p < (unsigned)NPOS) {
        unsigned nreg = 0u;
        if (c.tid == 0) nreg = __hip_atomic_fetch_add(qctr, 1u, __ATOMIC_RELAXED, __HIP_MEMORY_SCOPE_AGENT) + (unsigned)G;
        const bool inter = p < (unsigned)(NCH * 6);
        if (inter && (p % 6u) == 5u) {
            expert_items_block(c, es, 1, ws, (int)(p / 6u) * 65, 65);
        } else {
            const unsigned u = inter ? p - p / 6u : p - (unsigned)NCH;
            const int ent = order[u >> 4], h = ent >> 4, qb = ent & 15, bp = (int)(u & 15u), b = bp >> 2, i = (bp >> 1) & 1, j = bp & 1, t0 = t0s[ent];
            att::UnitDesc ud;
#if QKV_HEADMAJOR
            ud.Q = qkv + ((size_t)(2 * h + i) * M + (size_t)(b * T + qb * 256)) * 64; ud.qs = 64;
            ud.K = qkv + ((size_t)(32 + 2 * h + i) * M + (size_t)(b * T + 64 * t0)) * 64; ud.ks = 64;
            ud.V = qkv + ((size_t)(64 + 2 * h + j) * M + (size_t)(b * T + 64 * t0)) * 64; ud.vs = 64;
#else
            ud.Q = qkv + (size_t)(b * T + qb * 256) * C_IN + 128 * h + 64 * i; ud.qs = C_IN;
            ud.K = qkv + (size_t)(b * T + 64 * t0) * C_IN + 2048 + 128 * h + 64 * i; ud.ks = C_IN;
            ud.V = qkv + (size_t)(b * T + 64 * t0) * C_IN + 4096 + 128 * h + 64 * j; ud.vs = C_IN;
#endif
            ud.O = R + ((size_t)(b * T + qb * 256) * 16 + h) * 256 + 128 * i + 64 * j; ud.os = 16 * 256;
            ud.lse = nullptr; ud.lses = 0; ud.NT = 4 * (qb + 1) - t0; ud.rel0 = qb * 256 - 64 * t0; ud.tg0 = t0; ud.q0 = qb * 256;
            ud.slope2 = exp2f(-0.5f * (float)(h + 1)) * LOG2E; ud.sink2 = 0.f;
            att::attn_unit<0, 8, 1, 16 * 256>(ud, (char*)c.lds);
        }
        if (c.tid == 0) nextu[0] = nreg;
        __syncthreads();
        p = nextu[0];
    }
}
#endif
__device__ __forceinline__ void attn1_finish_bf16_phase(const Ctx& c, const bf16* R, const float* lamp, const float* subln, bf16* O) {
    float s01 = 0.f, s23 = 0.f;
    for (int i = 0; i < 64; ++i) { s01 += lamp[i] * lamp[64 + i]; s23 += lamp[128 + i] * lamp[192 + i]; }
    const float lam_init = 0.8f - 0.6f * expf(-0.3f * 1.0f);
    const float lam = expf(s01) - expf(s23) + lam_init;
    const long total = (long)M * 16;
    for (long id = gtid_now(); id < total; id += c.gsz) {
        const bf16* p1 = R + (size_t)id * 256; const bf16* p2 = p1 + 128;
        float ss = 0.f;
#pragma unroll 4
        for (int i = 0; i < 16; ++i) { const u32x4 a = *(const u32x4*)(p1 + 8 * i), bq = *(const u32x4*)(p2 + 8 * i);
#pragma unroll
            for (int k = 0; k < 4; ++k) { const float x0 = bf2f(a[k] & 0xffffu) - lam * bf2f(bq[k] & 0xffffu), x1 = bf2f(a[k] >> 16) - lam * bf2f(bq[k] >> 16); ss += x0 * x0 + x1 * x1; } }
        const float rs = (1.f - lam_init) / sqrtf(ss * (1.f / 128.f) + RMS_EPS);
        bf16* op = O + (size_t)id * 128;
#pragma unroll 4
        for (int i = 0; i < 16; ++i) { const u32x4 a = *(const u32x4*)(p1 + 8 * i), bq = *(const u32x4*)(p2 + 8 * i); u32x4 w;
#pragma unroll
            for (int k = 0; k < 4; ++k) { const float x0 = bf2f(a[k] & 0xffffu) - lam * bf2f(bq[k] & 0xffffu), x1 = bf2f(a[k] >> 16) - lam * bf2f(bq[k] >> 16);
                w[k] = pk2(x0 * rs * subln[8 * i + 2 * k], x1 * rs * subln[8 * i + 2 * k + 1]); }
            *(u32x4*)(op + 8 * i) = w; }
    }
}
__device__ __forceinline__ void attn0_tuned_phase(const Ctx& c, const bf16* qkv, const float* sinks, bf16* OBR  , float* LSE  , bf16* O, int xlo, int xhi) {
    const int G = gridDim.x, vcu = vcu_of(blockIdx.x, G);
    for (int gid = vcu; gid < NB * 64; gid += G) {
        const int b = gid / 64, kind = (gid % 64) / 16, h = gid % 16;
        const float slope2 = exp2f(-0.5f * (float)(h + 1)) * LOG2E;
        if (kind < 3) {
            const int dil = kind == 0 ? 1 : (kind == 1 ? 4 : 16), nblk = 16 / dil;
            for (int x = xlo; x < xhi; ++x) {
                const int r = x / nblk, blk = x % nblk, q0 = blk * 256, t0 = blk ? 4 * blk - 2 : 0; att::UnitDesc u;
                const size_t qrow = (size_t)(b * T + r + dil * q0), krow = (size_t)(b * T + r + dil * 64 * t0);
#if QKV_HEADMAJOR
                u.Q = qkv + ((size_t)(h) * M + qrow) * 64; u.qs = (long)dil * 64;
                u.K = qkv + ((size_t)(16 + h) * M + krow) * 64; u.ks = (long)dil * 64;
                u.V = qkv + ((size_t)(32 + h) * M + krow) * 64; u.vs = (long)dil * 64;
#else
                u.Q = qkv + qrow * AB_IN + 64 * h; u.qs = (long)dil * AB_IN;
                u.K = qkv + krow * AB_IN + 1024 + 64 * h; u.ks = (long)dil * AB_IN;
                u.V = qkv + krow * AB_IN + 2048 + 64 * h; u.vs = (long)dil * AB_IN;
#endif
                u.O = OBR + ((size_t)kind * M + qrow) * 1024 + 64 * h; u.os = (long)dil * 1024;
                u.lse = LSE + ((size_t)kind * M + qrow) * 16 + h; u.lses = (long)dil * 16;
                u.NT = blk ? 6 : 4; u.rel0 = q0 - 64 * t0; u.tg0 = t0; u.q0 = q0; u.slope2 = slope2 * (float)dil; u.sink2 = 0.f;
                if (dil == 1) att::attn_unit<1, 8, 1, 1024>(u, (char*)c.lds); else if (dil == 4) att::attn_unit<1, 8, 4, 4096>(u, (char*)c.lds); else att::attn_unit<1, 8, 16, 16384>(u, (char*)c.lds);
            }
        } else {
            const int kvh = h >> 3;
            for (int x = xlo; x < xhi; ++x) {
                const int q0 = x * 256, t0 = x ? 4 * x - 2 : 0; att::UnitDesc u;
                const size_t qrow = (size_t)(b * T + q0), krow = (size_t)(b * T + 64 * t0);
#if QKV_HEADMAJOR
                u.Q = qkv + ((size_t)(48 + h) * M + qrow) * 64; u.qs = 64;
                u.K = qkv + ((size_t)(64 + kvh) * M + krow) * 64; u.ks = 64;
                u.V = qkv + ((size_t)(66 + kvh) * M + krow) * 64; u.vs = 64;
#else
                u.Q = qkv + qrow * AB_IN + 3072 + 64 * h; u.qs = AB_IN;
                u.K = qkv + krow * AB_IN + 4096 + 64 * kvh; u.ks = AB_IN;
                u.V = qkv + krow * AB_IN + 4224 + 64 * kvh; u.vs = AB_IN;
#endif
                u.O = O + qrow * D + 1024 + 64 * h; u.os = D;
                u.lse = nullptr; u.lses = 0;
                u.NT = x ? 6 : 4; u.rel0 = q0 - 64 * t0; u.tg0 = t0; u.q0 = q0; u.slope2 = slope2; u.sink2 = sinks[h] * LOG2E;
                att::attn_unit<2, 8, 1, D>(u, (char*)c.lds);
            }
        }
    }
}
__device__ __forceinline__ void attn0_merge_phase(const Ctx& c, const bf16* OBR, const float* LSE, bf16* O) {
    const long total = (long)M * 16;
    for (long id = gtid_now(); id < total; id += c.gsz) {
        const long m = id / 16; const int h = (int)(id % 16);
        const float l0 = LSE[id], l1 = LSE[(size_t)M * 16 + id], l2 = LSE[(size_t)2 * M * 16 + id];
        const float mx = fmaxf(l0, fmaxf(l1, l2)); float w0 = exp2f(l0 - mx), w1 = exp2f(l1 - mx), w2 = exp2f(l2 - mx); const float inv = 1.f / (w0 + w1 + w2); w0 *= inv; w1 *= inv; w2 *= inv;
        const bf16* p0 = OBR + (size_t)m * 1024 + 64 * h; const bf16* p1 = p0 + (size_t)M * 1024; const bf16* p2 = p1 + (size_t)M * 1024;
        bf16* op = O + (size_t)m * D + 64 * h;
#pragma unroll
        for (int i = 0; i < 8; ++i) { const u32x4 a = *(const u32x4*)(p0 + 8 * i), bq = *(const u32x4*)(p1 + 8 * i), cq = *(const u32x4*)(p2 + 8 * i); u32x4 w;
#pragma unroll
            for (int k = 0; k < 4; ++k) w[k] = pk2(w0 * bf2f(a[k] & 0xffffu) + w1 * bf2f(bq[k] & 0xffffu) + w2 * bf2f(cq[k] & 0xffffu), w0 * bf2f(a[k] >> 16) + w1 * bf2f(bq[k] >> 16) + w2 * bf2f(cq[k] >> 16));
            *(u32x4*)(op + 8 * i) = w; }
    }
}

__device__ __forceinline__ void convert_router(const Ctx& c, const float* wr, bf16* wrt) {
    for (int id2 = gtid_now(); id2 < 2 * NE * D; id2 += c.gsz) { const int l = id2 / (NE * D), id = id2 % (NE * D), k = id / NE, n = id % NE; const float w = wr[id2];
        const unsigned hb = f2bf(w); const float hf = bf2f(hb);
        const int off = l * 2 * NE * D + (((((k >> 8) * 8 + ((k >> 5) & 7)) * 4 + (n >> 4)) * 2) * 64 + ((n & 15) + 16 * ((k >> 3) & 3))) * 8 + (k & 7);
        wrt[off] = (bf16)hb; wrt[off + 512] = (bf16)f2bf(w - hf); }
}
#define DPPF(old, v, ctrl, rm) __int_as_float(__builtin_amdgcn_update_dpp(__float_as_int(old), __float_as_int(v), ctrl, rm, 0xf, false))
__device__ __forceinline__ float dpp_max8(float v) {
    v = fmaxf(v, DPPF(v, v, 0xB1, 0xf)); v = fmaxf(v, DPPF(v, v, 0x4E, 0xf)); v = fmaxf(v, DPPF(v, v, 0x141, 0xf)); return v; }
__device__ __forceinline__ float wave_max_u(float v) {
    v = dpp_max8(v); v = fmaxf(v, DPPF(v, v, 0x140, 0xf)); v = fmaxf(v, DPPF(v, v, 0x142, 0xa)); v = fmaxf(v, DPPF(v, v, 0x143, 0xc));
    return __int_as_float(__builtin_amdgcn_readlane(__float_as_int(v), 63)); }
__device__ __forceinline__ float wave_sum_u(float v) {
    v += DPPF(0.f, v, 0xB1, 0xf); v += DPPF(0.f, v, 0x4E, 0xf); v += DPPF(0.f, v, 0x141, 0xf); v += DPPF(0.f, v, 0x140, 0xf); v += DPPF(0.f, v, 0x142, 0xa); v += DPPF(0.f, v, 0x143, 0xc);
    return __int_as_float(__builtin_amdgcn_readlane(__float_as_int(v), 63)); }
constexpr int RT_ROUTER = 2;
__device__ __forceinline__ void router2_phase(const Ctx& c, const float* x1, const float* g, const float* ada_l, const bf16* wrt, const float* rbias,
                                              bf16* HF, int* idx, float* gate, int* wcnt, bf16* HFB = nullptr) {
    constexpr int RT = RT_ROUTER, RU = 16 * RT, NU = M / RU;
    LAS float* red = (LAS float*)c.lds;
    LAS float* part = (LAS float*)(c.lds + 1024);
    LAS float* GA = (LAS float*)(c.lds + 1024 + RT * 32768);
    LAS float* GB = GA + D;
    const int w = __builtin_amdgcn_readfirstlane((int)threadIdx.x >> 6);
    const float rb = rbias[threadIdx.x & 63];
    unsigned cnt = 0u;
    const int per = (NU + (int)gridDim.x - 1) / (int)gridDim.x, u0 = blockIdx.x * per, u1 = (u0 + per < NU) ? u0 + per : NU;
    int bcur = -1;
#pragma unroll 1
    for (int u = u0; u < u1; ++u) {
        int tid = threadIdx.x; asm volatile("" : "+v"(tid));
        const int lane = tid & 63, r = lane & 15, q = lane >> 4, cb = 256 * w + 8 * q;
        const bf16* wf = wrt + (size_t)w * (8 * 4 * 2 * 512) + lane * 8;
        const int m0 = u * RU, b = m0 / T;
        if (b != bcur) { bcur = b; __syncthreads();
            for (int col = 4 * tid; col < D; col += 2048) { const f32x4 gg = *(const f32x4*)(g + col), sc = *(const f32x4*)(ada_l + (size_t)b * 6 * D + 4 * D + col), sh = *(const f32x4*)(ada_l + (size_t)b * 6 * D + 3 * D + col);
                *(LAS f32x4*)(GA + col) = gg * (sc + 1.f); *(LAS f32x4*)(GB + col) = sh; } }
        u32x4 xv[RT][8]; float rstd[RT];
#pragma unroll
        for (int t = 0; t < RT; ++t) { const bf16* xr = (const bf16*)x1 + (size_t)(m0 + 16 * t + r) * D + cb;
#pragma unroll
            for (int kk = 0; kk < 8; ++kk) xv[t][kk] = *(const u32x4*)(xr + 32 * kk); }
#pragma unroll
        for (int t = 0; t < RT; ++t) { float ss = 0.f;
#pragma unroll
            for (int kk = 0; kk < 8; ++kk)
#pragma unroll
                for (int j = 0; j < 4; ++j) { const float a0 = bf2f(xv[t][kk][j] & 0xffffu), a1 = bf2f(xv[t][kk][j] >> 16); ss += a0 * a0 + a1 * a1; }
            ss += __shfl_xor(ss, 16); ss += __shfl_xor(ss, 32);
            if (q == 0) red[(t * 8 + w) * 16 + r] = ss; }
        __syncthreads();
        f32x4 acc[RT][4];
#pragma unroll
        for (int t = 0; t < RT; ++t) { float tot = 0.f;
#pragma unroll
            for (int w2 = 0; w2 < 8; ++w2) tot += red[(t * 8 + w2) * 16 + r];
            rstd[t] = 1.f / sqrtf(tot * (1.f / D) + RMS_EPS);
#pragma unroll
            for (int nt = 0; nt < 4; ++nt) acc[t][nt] = (f32x4){0.f, 0.f, 0.f, 0.f}; }
#pragma unroll
        for (int kk = 0; kk < 8; ++kk) {
            const f32x4 ga0 = *(LAS f32x4*)(GA + cb + 32 * kk), ga1 = *(LAS f32x4*)(GA + cb + 32 * kk + 4), gb0 = *(LAS f32x4*)(GB + cb + 32 * kk), gb1 = *(LAS f32x4*)(GB + cb + 32 * kk + 4);
            bf16x8 ah[RT], al[RT];
#pragma unroll
            for (int t = 0; t < RT; ++t) { const u32x4 xw = xv[t][kk]; f32x4 hh[2];
                hh[0] = (f32x4){bf2f(xw.x & 0xffffu), bf2f(xw.x >> 16), bf2f(xw.y & 0xffffu), bf2f(xw.y >> 16)} * rstd[t] * ga0 + gb0;
                hh[1] = (f32x4){bf2f(xw.z & 0xffffu), bf2f(xw.z >> 16), bf2f(xw.w & 0xffffu), bf2f(xw.w >> 16)} * rstd[t] * ga1 + gb1;
                u32x4 hw, lw;
#pragma unroll
                for (int s2 = 0; s2 < 2; ++s2) { const unsigned h0 = f2bf(hh[s2].x), h1 = f2bf(hh[s2].y), h2 = f2bf(hh[s2].z), h3 = f2bf(hh[s2].w);
                    hw[2 * s2] = h0 | (h1 << 16); hw[2 * s2 + 1] = h2 | (h3 << 16);
                    lw[2 * s2] = pk2(hh[s2].x - bf2f(h0), hh[s2].y - bf2f(h1)); lw[2 * s2 + 1] = pk2(hh[s2].z - bf2f(h2), hh[s2].w - bf2f(h3)); }
#if USE_FP8_MOE
                { u32x2 q8; q8.x = pk4_fp8(hh[0].x * F8_HSCALE, hh[0].y * F8_HSCALE, hh[0].z * F8_HSCALE, hh[0].w * F8_HSCALE); q8.y = pk4_fp8(hh[1].x * F8_HSCALE, hh[1].y * F8_HSCALE, hh[1].z * F8_HSCALE, hh[1].w * F8_HSCALE);
                  *(u32x2*)((unsigned char*)HF + (size_t)(m0 + 16 * t + r) * D + cb + 32 * kk) = q8; }
#if SHARED_BF16
                *(u32x4*)(HFB + (size_t)(m0 + 16 * t + r) * D + cb + 32 * kk) = hw;
#endif
#else
                *(u32x4*)(HF + (size_t)(m0 + 16 * t + r) * D + cb + 32 * kk) = hw;
#endif
                ah[t] = __builtin_bit_cast(bf16x8, hw); al[t] = __builtin_bit_cast(bf16x8, lw); }
#pragma unroll
            for (int nt = 0; nt < 4; ++nt) { const bf16x8 bh = *(const bf16x8*)(wf + ((kk * 4 + nt) * 2) * 512), bl = *(const bf16x8*)(wf + ((kk * 4 + nt) * 2 + 1) * 512);
#pragma unroll
                for (int t = 0; t < RT; ++t) {
                    acc[t][nt] = __builtin_amdgcn_mfma_f32_16x16x32_bf16(ah[t], bh, acc[t][nt], 0, 0, 0);
                    acc[t][nt] = __builtin_amdgcn_mfma_f32_16x16x32_bf16(ah[t], bl, acc[t][nt], 0, 0, 0);
                    acc[t][nt] = __builtin_amdgcn_mfma_f32_16x16x32_bf16(al[t], bh, acc[t][nt], 0, 0, 0); } }
            if (kk & 1) asm volatile("" ::: "memory");
        }
#pragma unroll
        for (int t = 0; t < RT; ++t)
#pragma unroll
            for (int nt = 0; nt < 4; ++nt)
#pragma unroll
                for (int j = 0; j < 4; ++j) part[((t * 8 + w) * 16 + 4 * q + j) * 64 + 16 * nt + r] = acc[t][nt][j];
        __syncthreads();
#pragma unroll 1
        for (int rp = 0; rp < RT; ++rp) {
            float score[2], cur[2]; int rank[2];
#pragma unroll
            for (int x = 0; x < 2; ++x) { const int row = 2 * RT * w + 2 * rp + x; float logit = 0.f;
#pragma unroll
                for (int w2 = 0; w2 < 8; ++w2) logit += part[(((row >> 4) * 8 + w2) * 16 + (row & 15)) * 64 + lane];
                score[x] = 1.f / (1.f + expf(-logit));
                const float sel = score[x] + rb;
                const float m1 = dpp_max8(sel);
                const unsigned long long eqm = __ballot(sel == m1);
                const unsigned grp_eq = (unsigned)((eqm >> (lane & ~7)) & 0xffull);
                const int first = __builtin_ctz(grp_eq);
                const float m2 = dpp_max8(((lane & 7) == first) ? -3e38f : sel);
                const float gs = m1 + m2;
                int grank = 0; const int mygrp = lane >> 3;
#pragma unroll
                for (int g2 = 0; g2 < 8; ++g2) { const float o = __int_as_float(__builtin_amdgcn_readlane(__float_as_int(gs), g2 * 8)); grank += (o > gs || (o == gs && g2 < mygrp)) ? 1 : 0; }
                cur[x] = (grank < 4) ? sel : -1e30f; rank[x] = 64; }
#pragma unroll
            for (int it = 0; it < TOPK; ++it)
#pragma unroll
                for (int x = 0; x < 2; ++x) { const float mx = wave_max_u(cur[x]); const int f = (int)__builtin_ctzll(__ballot(cur[x] == mx));
                    if (lane == f) { rank[x] = it; cur[x] = -3e38f; } }
#pragma unroll
            for (int x = 0; x < 2; ++x) { const int m = m0 + 2 * RT * w + 2 * rp + x; const bool chosen = rank[x] < TOPK;
                const float gsum = wave_sum_u(chosen ? score[x] : 0.f);
                if (chosen) { idx[(size_t)m * 8 + rank[x]] = lane | (int)(cnt << 8); gate[(size_t)m * 8 + rank[x]] = score[x] / gsum * 2.5f; cnt += 1u; } }
        }
        __syncthreads();
    }
    wcnt[(size_t)(blockIdx.x * 8 + w) * 64 + (threadIdx.x & 63)] = (int)cnt;
}
__device__ __forceinline__ void slot2_phase(const Ctx& c, const int* idx, const int* wcnt, unsigned* nrt_out, int* pos, int* slot_tok, int* tile_exp) {
    LAS int* ST = (LAS int*)c.lds;
    LAS int* SB = ST + 512;
    LAS int* SO = SB + 512;
    LAS int* tot = SO + 512;
    LAS int* bef = tot + 64;
    LAS int* ps = bef + 64;
    LAS int* base = ps + 128;
    const int e = c.tid & 63, p = c.tid >> 6, G = gridDim.x, blk = blockIdx.x;
    { int Tp = 0, Bp = 0;
#pragma unroll 8
      for (int b2 = 0; b2 < G; ++b2) { const int v = wcnt[(size_t)(b2 * 8 + p) * 64 + e]; Tp += v; Bp += (b2 < blk) ? v : 0; }
      ST[p * 64 + e] = Tp; SB[p * 64 + e] = Bp; SO[p * 64 + e] = wcnt[(size_t)(blk * 8 + p) * 64 + e]; }
    __syncthreads();
    if (c.tid < 64) { int t = 0, bb = 0;
#pragma unroll
        for (int p2 = 0; p2 < 8; ++p2) { t += ST[p2 * 64 + e]; bb += SB[p2 * 64 + e]; }
        tot[e] = t; bef[e] = bb; }
    __syncthreads();
    if (c.tid == 0) { int acc = 0; for (int e2 = 0; e2 < NE; ++e2) { ps[e2] = acc; acc += (tot[e2] + 255) / 256 * 256; } ps[64] = acc; }
    __syncthreads();
    { int o = ps[e] + bef[e];
      for (int p2 = 0; p2 < p; ++p2) o += SO[p2 * 64 + e];
      base[p * 64 + e] = o; }
    __syncthreads();
    {
        constexpr int RU = 16 * RT_ROUTER, NU = M / RU; const int per = (NU + G - 1) / G, mlo = blk * per * RU, mhi = (mlo + per * RU < M) ? mlo + per * RU : M;
        for (int i = c.tid; i < (mhi - mlo) * 8; i += 512) {
            const int m = mlo + (i >> 3), k = i & 7, wv = (m % RU) / (2 * RT_ROUTER); const size_t a = (size_t)m * 8 + k;
            const int code = idx[a], ee = code & 255, rk = code >> 8, slot = base[wv * 64 + ee] + rk;
            slot_tok[slot] = m; pos[a] = slot; }
    }
    for (int t = gtid_now(); t < M; t += c.gsz) slot_tok[CAPR + t] = t;
    if (blk == 0) {
        if (c.tid < NE) { const int s0 = ps[e], cn = tot[e], pe = s0 + (cn + 255) / 256 * 256;
            for (int s = s0 + cn; s < pe; ++s) slot_tok[s] = 0;
            for (int tt = s0 / 256; tt < pe / 256; ++tt) tile_exp[tt] = e; }
        if (c.tid == 0) *nrt_out = (unsigned)(ps[64] / 256);
    }
    __syncthreads();
}

template <int L> __device__ __forceinline__ void moe_up_tuned(const Ctx& c, unsigned char* ws) {
    const int nrt = (int)c.ctl[CW_NRT + L];
#if USE_FP8_MOE && SHARED_BF16
    { pg8::PlainSched S; S.o.init(M / 256, UPN / 256, gridDim.x, blockIdx.x); S.Bt = (const char*)(ws + WS_WUPS) + (size_t)L * UPN * D * 2; S.K = D;
      pg8::EpiUp E{(bf16*)(ws + WS_ACTS)}; pg8::gemm_phase(c.lds, (const char*)(ws + WS_HFB), D, S, E); }
    const int ntile = nrt;
#else
    const int ntile = nrt + M / 256;
#endif
    pg8::GroupSched<true> S; S.o.init(ntile, UPN / 256, gridDim.x, blockIdx.x);
    { LAS int* te = (LAS int*)(c.lds + 132096);
      for (int i = threadIdx.x; i < nrt; i += 512) te[i] = ((const int*)(ws + WS_TILEEXP))[i];
      __syncthreads(); S.tile_exp = te; }
    S.nrt = nrt; S.slot_tok = (const int*)(ws + WS_SLOTTOK);
#if USE_FP8_MOE
    S.W = (const char*)(ws + WS_WUP) + (size_t)L * NEX * UPN * D; S.wstride = (size_t)UPN * D; S.K = D / 2;
    pg8::EpiUp8 E{ws + WS_ACT}; pg8::gemm_phase<pg8::EpiUp8, pg8::GroupSched<true>, true>(c.lds, (const char*)(ws + WS_HF), D / 2, S, E);
#else
    S.W = (const char*)(ws + WS_WUP) + (size_t)L * NEX * UPN * D * 2; S.wstride = (size_t)UPN * D * 2; S.K = D;
    pg8::EpiUp E{(bf16*)(ws + WS_ACT)}; pg8::gemm_phase(c.lds, (const char*)(ws + WS_HF), D, S, E);
#endif
}
template <int L> __device__ __forceinline__ void moe_down_tuned(const Ctx& c, unsigned char* ws) {
    const int nrt = (int)c.ctl[CW_NRT + L];
#if USE_FP8_MOE && SHARED_BF16
    { pg8::PlainSched S; S.o.init(M / 256, D / 256, gridDim.x, blockIdx.x); S.Bt = (const char*)(ws + WS_WDNS) + (size_t)L * D * ED * 2; S.K = ED;
      pg8::EpiDown E{(bf16*)(ws + WS_Y), CAPR}; pg8::gemm_phase(c.lds, (const char*)(ws + WS_ACTS), ED, S, E); }
    const int ntile = nrt;
#else
    const int ntile = nrt + M / 256;
#endif
    pg8::GroupSched<false> S; S.o.init(ntile, D / 256, gridDim.x, blockIdx.x);
    { LAS int* te = (LAS int*)(c.lds + 132096);
      for (int i = threadIdx.x; i < nrt; i += 512) te[i] = ((const int*)(ws + WS_TILEEXP))[i];
      __syncthreads(); S.tile_exp = te; }
    S.nrt = nrt; S.slot_tok = (const int*)(ws + WS_SLOTTOK);
#if USE_FP8_MOE
    S.W = (const char*)(ws + WS_WDN) + (size_t)L * NEX * D * ED; S.wstride = (size_t)D * ED; S.K = ED / 2;
    pg8::EpiDown8 E{(bf16*)(ws + WS_Y)}; pg8::gemm_phase<pg8::EpiDown8, pg8::GroupSched<false>, true>(c.lds, (const char*)(ws + WS_ACT), ED / 2, S, E);
#else
    S.W = (const char*)(ws + WS_WDN) + (size_t)L * NEX * D * ED * 2; S.wstride = (size_t)D * ED * 2; S.K = ED;
    pg8::EpiDown E{(bf16*)(ws + WS_Y)}; pg8::gemm_phase(c.lds, (const char*)(ws + WS_ACT), ED, S, E);
#endif
}
template <int L> __device__ __forceinline__ void qkv_tuned(const Ctx& c, unsigned char* ws, const float* gains) {
    constexpr int NCOL = L == 0 ? AB_IN : C_IN; constexpr bool TUNED_ATT = L == 0 ? (USE_ATT0 != 0) : (USE_ATT1 != 0);
    pg8::PlainSched S; S.o.init(M / 256, NCOL / 256, gridDim.x, blockIdx.x); S.Bt = (const char*)(ws + (L == 0 ? WS_W0IN : WS_W1IN));
#if USE_FP8_QKV
    S.K = D / 2; pg8::EpiQKV<L> E{(bf16*)(ws + WS_QKV), NCOL, gains, TUNED_ATT ? att::C2 : 1.f, 1.f / (F8_HSCALE * F8_WSCALE)};
    pg8::gemm_phase<pg8::EpiQKV<L>, pg8::PlainSched, true>(c.lds, (const char*)(ws + WS_XN), D / 2, S, E);
#else
    S.K = D; pg8::EpiQKV<L> E{(bf16*)(ws + WS_QKV), NCOL, gains, TUNED_ATT ? att::C2 : 1.f, 1.f};
    pg8::gemm_phase(c.lds, (const char*)(ws + WS_XN), D, S, E);
#endif
}

template <int L> __device__ __forceinline__ void outproj_epi(const Ctx& c, unsigned char* ws, const pg8::PlainSched& S, const float* xin_f32, const float* gm) {
#if RES_BF16
    if (L == 0) { pg8::EpiOutB<false> E{xin_f32, gm, (bf16*)(ws + WS_X1)}; pg8::gemm_phase(c.lds, (const char*)(ws + WS_O), D, S, E); }
    else { pg8::EpiOutB<true> E{ws + WS_X1 + (size_t)M * D * 2, gm, (bf16*)(ws + WS_X1)}; pg8::gemm_phase(c.lds, (const char*)(ws + WS_O), D, S, E); }
#else
    pg8::EpiOut E{xin_f32, gm, (float*)(ws + WS_X1)}; pg8::gemm_phase(c.lds, (const char*)(ws + WS_O), D, S, E);
#endif
}
__global__ void __launch_bounds__(512, 2) mega(Args args) {
    extern __shared__ __attribute__((aligned(16))) unsigned char lds_raw[];
    Ctx c;
    c.lds = (LAS unsigned char*)lds_raw;
    c.tid = threadIdx.x; c.lane = c.tid & 63; c.wave = __builtin_amdgcn_readfirstlane(c.tid >> 6);
    c.gw = blockIdx.x * 8 + c.wave; c.ngw = gridDim.x * 8; c.gsz = gridDim.x * 512;
    c.ws = args.ws; c.ctl = (unsigned*)(args.ws + WS_CTL);
    volatile LAS unsigned* xbw = (volatile LAS unsigned*)(c.lds + LDS_BYTES - 16);
    if (c.tid < 4) xbw[c.tid] = 0u;
    __syncthreads();
    const int lo = args.ph_lo, hi = args.ph_hi;
    XcdBarrier bar; bar.bar = c.ctl + CW_BAR; bar.x = 0; bar.st = xbw;
    if (hi - lo > 1) bar = xcd_barrier_post(c.ctl + CW_BAR, xbw);
#ifdef PHASE_ONLY
#define IN(k) ((k) == PHASE_ONLY && lo <= (k) && (k) < hi)
#else
#define IN(k) (lo <= (k) && (k) < hi)
#endif
#define PHASE(k, ...) do { if (IN(k)) { __VA_ARGS__ } if (IN(k) && ((REPMASK >> (k)) & 1u)) { __syncthreads(); __VA_ARGS__ } } while (0);
#if PROBE_SEL >= 0
    volatile LAS unsigned long long* stamp_ = (volatile LAS unsigned long long*)(c.lds + 146000);
    if (c.tid == 0) stamp_[0] = __builtin_amdgcn_s_memrealtime();
#define SEAM(k) do { if (c.tid == 0) stamp_[1 + 2 * (k)] = __builtin_amdgcn_s_memrealtime(); if (IN(k) && IN((k) + 1)) xcd_barrier(bar); else __syncthreads(); \
        if (c.tid == 0) stamp_[2 + 2 * (k)] = __builtin_amdgcn_s_memrealtime(); } while (0)
#else
#define SEAM(k) do { if (IN(k) && IN((k) + 1)) xcd_barrier(bar); else __syncthreads(); } while (0)
#endif
    unsigned char* ws = args.ws;
#define XIN (args.in[0])
#define cin (args.in[1])
#define norm_mix (args.in[2])
#define norm_ffn (args.in[3])
#define w_ada (args.in[4])
#define b_ada (args.in[5])
#define ada ((float*)(ws + WS_ADA))
#define W0IN ((bf16*)(ws + WS_W0IN))
#define W0OUT ((bf16*)(ws + WS_W0OUT))
#define W1IN ((bf16*)(ws + WS_W1IN))
#define W1OUT ((bf16*)(ws + WS_W1OUT))
#define WUP ((bf16*)(ws + WS_WUP))
#define WDN ((bf16*)(ws + WS_WDN))
#define XN ((bf16*)(ws + WS_XN))
#define QKV ((bf16*)(ws + WS_QKV))
#define OBUF ((bf16*)(ws + WS_O))
#define X1 ((float*)(ws + WS_X1))
#define HF ((bf16*)(ws + WS_HF))
#define IDX ((int*)(ws + WS_IDX))
#define GATE ((float*)(ws + WS_GATE))
#define POS ((int*)(ws + WS_POS))
#define SLOTTOK ((int*)(ws + WS_SLOTTOK))
#define TILEEXP ((int*)(ws + WS_TILEEXP))
#define ACT ((bf16*)(ws + WS_ACT))
#define Y ((bf16*)(ws + WS_Y))
#define TMP ((float*)(ws + WS_TMP))
#define OUTP (args.out)

    PHASE(0, {
        constexpr int QM = USE_PG8_QKV ? 1 : 0, UM = USE_PG8_MOE ? 2 : 0;
#if USE_CONV128 && USE_FP8_MOE
        convert_dense_all<QM, USE_FP8_QKV != 0>(c, args.in[6], args.in[10], args.in[9], args.in[14], (unsigned char*)W0IN, (unsigned char*)W1IN, (unsigned char*)W0OUT, (unsigned char*)W1OUT, USE_FP8_QKV ? F8_WSCALE : 1.f);
#if !(DEFER_CONV && USE_ATT0 && USE_ATT1 && !SHARED_BF16)
        for (int l = 0; l < 2; ++l) {
            convert_batch128<2, true>(c, args.in[17] + (size_t)l * NE * D * UPN, D, UPN, (unsigned char*)WUP + (size_t)l * NEX * UPN * D, NE, (size_t)UPN * D, F8_WSCALE);
            convert_batch128<0, true>(c, args.in[18] + (size_t)l * NE * ED * D, ED, D, (unsigned char*)WDN + (size_t)l * NEX * D * ED, NE, (size_t)D * ED, F8_WSCALE);
#if SHARED_BF16
            convert_batch128<2, false>(c, args.in[19] + (size_t)l * D * UPN, D, UPN, ws + WS_WUPS + (size_t)l * UPN * D * 2, 1, 0, 1.f);
            convert_batch128<0, false>(c, args.in[20] + (size_t)l * ED * D, ED, D, ws + WS_WDNS + (size_t)l * D * ED * 2, 1, 0, 1.f);
#else
            convert_batch128<2, true>(c, args.in[19] + (size_t)l * D * UPN, D, UPN, (unsigned char*)WUP + ((size_t)l * NEX + NE) * UPN * D, 1, 0, F8_WSCALE);
            convert_batch128<0, true>(c, args.in[20] + (size_t)l * ED * D, ED, D, (unsigned char*)WDN + ((size_t)l * NEX + NE) * D * ED, 1, 0, F8_WSCALE);
#endif
        }
#endif
#else
        convert_batch<QM>(c, args.in[6], D, AB_IN, W0IN, 1, 0);
        convert_batch<0>(c, args.in[9], D, D, W0OUT, 1, 0);
        convert_batch<QM>(c, args.in[10], D, C_IN, W1IN, 1, 0);
        convert_batch<0>(c, args.in[14], D, D, W1OUT, 1, 0);
        for (int l = 0; l < 2; ++l) {
#if USE_FP8_MOE
            convert_batch_f8<2>(c, args.in[17] + (size_t)l * NE * D * UPN, D, UPN, (unsigned char*)WUP + (size_t)l * NEX * UPN * D, NE, (size_t)UPN * D);
            convert_batch_f8<2>(c, args.in[19] + (size_t)l * D * UPN, D, UPN, (unsigned char*)WUP + ((size_t)l * NEX + NE) * UPN * D, 1, 0);
            convert_batch_f8<0>(c, args.in[18] + (size_t)l * NE * ED * D, ED, D, (unsigned char*)WDN + (size_t)l * NEX * D * ED, NE, (size_t)D * ED);
            convert_batch_f8<0>(c, args.in[20] + (size_t)l * ED * D, ED, D, (unsigned char*)WDN + ((size_t)l * NEX + NE) * D * ED, 1, 0);
#else
            convert_batch<UM>(c, args.in[17] + (size_t)l * NE * D * UPN, D, UPN, WUP + (size_t)l * NEX * UPN * D, NE, (size_t)UPN * D);
            convert_batch<UM>(c, args.in[19] + (size_t)l * D * UPN, D, UPN, WUP + ((size_t)l * NEX + NE) * UPN * D, 1, 0);
            convert_batch<0>(c, args.in[18] + (size_t)l * NE * ED * D, ED, D, WDN + (size_t)l * NEX * D * ED, NE, (size_t)D * ED);
            convert_batch<0>(c, args.in[20] + (size_t)l * ED * D, ED, D, WDN + ((size_t)l * NEX + NE) * D * ED, 1, 0);
#endif
        }
#endif
        convert_router(c, args.in[15], (bf16*)(ws + WS_WRT));
        __syncthreads();
        ada_phase(c, cin, w_ada, b_ada, ada);
    })
    SEAM(0);
    PHASE(1, norm_phase(c, XIN, norm_mix, ada, 0, D, XN);)
    SEAM(1);
#if USE_PG8_QKV
    PHASE(2, qkv_tuned<0>(c, ws, args.in[7]);)
    SEAM(2);
#else
    PHASE(2, gemm_plain_bf16(c, XN, W0IN, D, AB_IN, QKV);)
    SEAM(2);
#endif
#if USE_ATT0
    static_assert(USE_PG8_QKV, "the tuned attention needs Q pre-scaled by the QKV epilogue");
    #if DEFER_CONV
    PHASE(3, { const int xs_ = vcu_of(blockIdx.x, gridDim.x) & 15;
        attn0_tuned_phase(c, QKV, args.in[8], (bf16*)(ws + WS_TMP), (float*)(ws + WS_TMP + (size_t)3 * M * 1024 * 2), OBUF, 0, xs_ + 1);
        { const int cshare = (EXP_ITEMS + (int)gridDim.x - 1) / (int)gridDim.x, cfirst = blockIdx.x * cshare, ccount = (cfirst + cshare <= EXP_ITEMS) ? cshare : (EXP_ITEMS > cfirst ? EXP_ITEMS - cfirst : 0);
          expert_items_block(c, ExpertSrc{args.in[17], args.in[19], args.in[18], args.in[20]}, 0, ws, cfirst, ccount); __syncthreads(); }
        attn0_tuned_phase(c, QKV, args.in[8], (bf16*)(ws + WS_TMP), (float*)(ws + WS_TMP + (size_t)3 * M * 1024 * 2), OBUF, xs_ + 1, 16); })
#else
    PHASE(3, attn0_tuned_phase(c, QKV, args.in[8], (bf16*)(ws + WS_TMP), (float*)(ws + WS_TMP + (size_t)3 * M * 1024 * 2), OBUF, 0, 16);)
#endif
    SEAM(3);
    PHASE(4, attn0_merge_phase(c, (const bf16*)(ws + WS_TMP), (const float*)(ws + WS_TMP + (size_t)3 * M * 1024 * 2), OBUF);)
    SEAM(4);
#else
#if !USE_PG8_QKV
    PHASE(3, qknorm0_phase(c, QKV, args.in[7]);)
#endif
    SEAM(3);
    PHASE(4, attn0_phase(c, QKV, args.in[8], OBUF);)
    SEAM(4);
#endif
#if USE_PG8_OUT
    PHASE(5, { pg8::PlainSched S; S.o.init(M / 256, D / 256, gridDim.x, blockIdx.x); S.Bt = (const char*)W0OUT; S.K = D;
        outproj_epi<0>(c, ws, S, XIN, ada + 2 * D); })
#else
    PHASE(5, gemm_outproj(c, OBUF, W0OUT, XIN, ada + 2 * D, X1);)
#endif
    SEAM(5);
#if USE_ROUTER2
    PHASE(6, router2_phase(c, X1, norm_ffn, ada, (const bf16*)(ws + WS_WRT), args.in[16], HF, IDX, GATE, (int*)(ws + WS_WCNT), (bf16*)(ws + WS_HFB));)
    SEAM(6);
    PHASE(7, slot2_phase(c, IDX, (const int*)(ws + WS_WCNT), c.ctl + CW_NRT, POS, SLOTTOK, TILEEXP);)
#else
    PHASE(6, router_phase(c, X1, norm_ffn, ada, args.in[15], args.in[16], HF, IDX, GATE, c.ctl + CW_CNT);)
    SEAM(6);
    PHASE(7, slot_phase(c, IDX, c.ctl + CW_CNT, c.ctl + CW_CUR, c.ctl + CW_NRT, POS, SLOTTOK, TILEEXP);)
#endif
    SEAM(7);
#if USE_PG8_MOE
    PHASE(8, moe_up_tuned<0>(c, ws);)
    SEAM(8);
    PHASE(9, moe_down_tuned<0>(c, ws);)
#else
    PHASE(8, moe_up_phase(c, HF, WUP, SLOTTOK, TILEEXP, c.ctl + CW_NRT, ACT);)
    SEAM(8);
    PHASE(9, moe_down_phase(c, ACT, WDN, TILEEXP, c.ctl + CW_NRT, Y);)
#endif
    SEAM(9);
    PHASE(10, combine_phase<true>(c, X1, Y, POS, GATE, ada, RES_BF16 ? (float*)(ws + WS_X1 + (size_t)M * D * 2) : OUTP, norm_mix + D, ada + (size_t)4 * 6 * D, XN);)
    SEAM(10);
#define ada1 (ada + (size_t)4 * 6 * D)
#if USE_PG8_QKV
    PHASE(11, qkv_tuned<1>(c, ws, args.in[11]);)
    SEAM(11);
    SEAM(12);
#else
    PHASE(11, gemm_plain_bf16(c, XN, W1IN, D, C_IN, QKV);)
    SEAM(11);
    PHASE(12, qknorm1_phase(c, QKV, args.in[11]);)
    SEAM(12);
#endif
#if USE_ATT1
    PHASE(13, attn1_tuned_phase(c, QKV, args.in[11], (bf16*)TMP, c.ctl + CW_QCTR, ExpertSrc{args.in[17], args.in[19], args.in[18], args.in[20]}, ws, args.in[12], args.in[13], OBUF);)
    SEAM(13);
#if !FUSE_FINISH
    PHASE(14, attn1_finish_bf16_phase(c, (const bf16*)TMP, args.in[12], args.in[13], OBUF);)
#endif
    SEAM(14);
#else
    PHASE(13, attn1_phase(c, QKV, TMP);)
    SEAM(13);
    PHASE(14, attn1_finish_phase(c, TMP, args.in[12], args.in[13], OBUF);)
    SEAM(14);
#endif
#if USE_PG8_OUT
    PHASE(15, { pg8::PlainSched S; S.o.init(M / 256, D / 256, gridDim.x, blockIdx.x); S.Bt = (const char*)W1OUT; S.K = D;
        outproj_epi<1>(c, ws, S, OUTP, ada1 + 2 * D); })
#else
    PHASE(15, gemm_outproj(c, OBUF, W1OUT, OUTP, ada1 + 2 * D, X1);)
#endif
    SEAM(15);
#if USE_ROUTER2
    PHASE(16, router2_phase(c, X1, norm_ffn + D, ada1, (const bf16*)(ws + WS_WRT) + (size_t)2 * NE * D, args.in[16] + NE, HF, IDX, GATE, (int*)(ws + WS_WCNT), (bf16*)(ws + WS_HFB));)
    SEAM(16);
    PHASE(17, slot2_phase(c, IDX, (const int*)(ws + WS_WCNT), c.ctl + CW_NRT + 1, POS, SLOTTOK, TILEEXP);)
#else
    PHASE(16, router_phase(c, X1, norm_ffn + D, ada1, args.in[15] + (size_t)D * NE, args.in[16] + NE, HF, IDX, GATE, c.ctl + CW_CNT + 64);)
    SEAM(16);
    PHASE(17, slot_phase(c, IDX, c.ctl + CW_CNT + 64, c.ctl + CW_CUR + 64, c.ctl + CW_NRT + 1, POS, SLOTTOK, TILEEXP);)
#endif
    SEAM(17);
#if USE_PG8_MOE
    PHASE(18, moe_up_tuned<1>(c, ws);)
    SEAM(18);
    PHASE(19, moe_down_tuned<1>(c, ws);)
#else
    PHASE(18, moe_up_phase(c, HF, WUP + (size_t)NEX * UPN * D, SLOTTOK, TILEEXP, c.ctl + CW_NRT + 1, ACT);)
    SEAM(18);
    PHASE(19, moe_down_phase(c, ACT, WDN + (size_t)NEX * D * ED, TILEEXP, c.ctl + CW_NRT + 1, Y);)
#endif
    SEAM(19);
    PHASE(20, combine_phase<false>(c, X1, Y, POS, GATE, ada1, OUTP, nullptr, nullptr, nullptr);)
#if PROBE_SEL >= 0
    {
        __syncthreads();
        unsigned long long v = 0ull;
        if (c.tid == 0) {
            if (PROBE_SEL >= 100) { const int k = PROBE_SEL - 100; v = stamp_[2 + 2 * k] - (k == 0 ? stamp_[0] : stamp_[2 + 2 * (k - 1)]); }
            else if (PROBE_SEL == 1 || PROBE_SEL == 2) { for (int k = 0; k < NPHASE - 1; ++k) v += stamp_[2 + 2 * k] - stamp_[1 + 2 * k]; }
            else if (PROBE_SEL == 3) { v = stamp_[1 + 2 * 19] - stamp_[0]; }
        }
        if (PROBE_SEL == 2) {
            if (c.tid == 0) __hip_atomic_fetch_add((unsigned long long*)(c.ctl + CW_QCTR + 64), v, __ATOMIC_RELAXED, __HIP_MEMORY_SCOPE_AGENT);
            xcd_barrier(bar);
            if (c.tid == 0) v = __hip_atomic_load((unsigned long long*)(c.ctl + CW_QCTR + 64), __ATOMIC_RELAXED, __HIP_MEMORY_SCOPE_AGENT) / gridDim.x;
        }
        if (blockIdx.x == 0 && c.tid == 0) { const unsigned long long t0 = __builtin_amdgcn_s_memrealtime(), w = v * PROBE_GAIN;
            while (__builtin_amdgcn_s_memrealtime() - t0 < w) __builtin_amdgcn_s_sleep(8); }
    }
#endif
#undef IN
#undef SEAM
#undef ada
#undef ada1
#undef W0IN
#undef W0OUT
#undef W1IN
#undef W1OUT
#undef WUP
#undef WDN
#undef XN
#undef QKV
#undef OBUF
#undef X1
#undef HF
#undef IDX
#undef GATE
#undef POS
#undef SLOTTOK
#undef TILEEXP
#undef ACT
#undef Y
#undef TMP
#undef XIN
#undef cin
#undef norm_mix
#undef norm_ffn
#undef w_ada
#undef b_ada
#undef OUTP
}

extern "C" void kernel_launch(void* const* d_in, const int* in_sizes, int n_in, void* d_out, int out_size, void* d_ws, size_t ws_size, hipStream_t stream) {
    static int grid = 0;
    if (grid == 0) {
        if (n_in != 21 || out_size != M * D || ws_size < WS_END) { fprintf(stderr, "kernel_launch: unexpected sizes (n_in %d out %d ws %zu need %zu)\n", n_in, out_size, ws_size, (size_t)WS_END); grid = -1; return; }
        int dev = 0, cus = 0, per_cu = 0;
        hipGetDevice(&dev); hipDeviceGetAttribute(&cus, hipDeviceAttributeMultiprocessorCount, dev);
        if (hipFuncSetAttribute((const void*)mega, hipFuncAttributeMaxDynamicSharedMemorySize, LDS_BYTES) != hipSuccess) { fprintf(stderr, "kernel_launch: hipFuncSetAttribute failed\n"); grid = -1; return; }
        hipOccupancyMaxActiveBlocksPerMultiprocessor(&per_cu, (const void*)mega, 512, LDS_BYTES);
        (void)hipGetLastError();
        if (per_cu < 1) fprintf(stderr, "kernel_launch: occupancy query says %d blocks per CU\n", per_cu);
        grid = cus;
    }
    if (grid < 0) return;
    hipMemsetAsync((char*)d_ws + WS_CTL, 0, CTL_BYTES, stream);
    Args a{};
    for (int i = 0; i < 21; ++i) a.in[i] = (const float*)d_in[i];
    a.out = (float*)d_out; a.ws = (unsigned char*)d_ws;
#if MK_SPLIT
    for (int p = 0; p < NPHASE; ++p) { a.ph_lo = p; a.ph_hi = p + 1; hipLaunchKernelGGL(mega, dim3(grid), dim3(512), LDS_BYTES, stream, a); }
#else
    a.ph_lo = 0; a.ph_hi = NPHASE; hipLaunchKernelGGL(mega, dim3(grid), dim3(512), LDS_BYTES, stream, a);
#endif
}
```

```cpp
#include <hip/hip_runtime.h>
#include <cstdio>
#include <cstdint>
#include <hip/hip_bf16.h>

#ifndef USE_PG8_OUT
#define USE_PG8_OUT 1
#endif
#ifndef USE_PG8_QKV
#define USE_PG8_QKV 1
#endif
#ifndef USE_PG8_MOE
#define USE_PG8_MOE 1
#endif
#ifndef USE_ATT1
#define USE_ATT1 1
#endif
#ifndef USE_ATT0
#define USE_ATT0 1
#endif
#ifndef USE_ROUTER2
#define USE_ROUTER2 1
#endif
#ifndef REPMASK
#define REPMASK 0u
#endif
#ifndef USE_FP8_MOE
#define USE_FP8_MOE 1
#endif
#ifndef USE_CONV128
#define USE_CONV128 1
#endif
#ifndef USE_FP8_QKV
#define USE_FP8_QKV 1
#endif
#ifndef SHARED_BF16
#define SHARED_BF16 0
#endif
#ifndef Y_FP8
#define Y_FP8 1
#endif
#ifndef DEFER_CONV
#define DEFER_CONV 1
#endif
#ifndef RES_BF16
#define RES_BF16 1
#endif
#ifndef FUSE_FINISH
#define FUSE_FINISH 1
#endif
#ifndef PROBE_SEL
#define PROBE_SEL -1
#endif
#ifndef PROBE_GAIN
#define PROBE_GAIN 4
#endif
#ifndef QKV_HEADMAJOR
#define QKV_HEADMAJOR 1
#endif
#ifndef USE_V128
#define USE_V128 1
#endif
#ifndef MK_SPLIT
#define MK_SPLIT 0
#endif

constexpr int D = 2048, NB = 4, T = 4096, M = NB * T;
constexpr int HD = 64;
constexpr int AB_IN = 4352, C_IN = 6144;
constexpr int NE = 64, TOPK = 8, ED = 512;
constexpr int UPN = 2 * ED;
constexpr int NEX = NE + 1;
constexpr int CAPR = M * TOPK + NE * 256;
constexpr int CAP = CAPR + M;
constexpr int MAXTILES = CAP / 256;
constexpr float RMS_EPS = 1e-6f;
constexpr int NPHASE = 21;

typedef unsigned short bf16;
typedef short bf16x8 __attribute__((ext_vector_type(8)));
typedef float f32x4 __attribute__((ext_vector_type(4)));
typedef unsigned u32x4 __attribute__((ext_vector_type(4)));
typedef unsigned u32x2 __attribute__((ext_vector_type(2)));
#define LAS __attribute__((address_space(3)))

constexpr size_t MiB = 1u << 20;
constexpr size_t WS_CTL = 0, CTL_BYTES = 1 * MiB;
constexpr size_t WS_ADA = 1 * MiB;
constexpr size_t WS_W0IN = 2 * MiB;
constexpr size_t WS_W0OUT = WS_W0IN + (size_t)AB_IN * D * 2;
constexpr size_t WS_W1IN = WS_W0OUT + (size_t)D * D * 2;
constexpr size_t WS_W1OUT = WS_W1IN + (size_t)C_IN * D * 2;
constexpr size_t WS_WUP = WS_W1OUT + (size_t)D * D * 2;
constexpr size_t WS_WDN = WS_WUP + (size_t)2 * NEX * UPN * D * 2;
constexpr size_t WS_XN = WS_WDN + (size_t)2 * NEX * D * ED * 2;
constexpr size_t WS_QKV = WS_XN + (size_t)M * D * 2;
constexpr size_t WS_O = WS_QKV + (size_t)M * C_IN * 2;
constexpr size_t WS_X1 = WS_O + (size_t)M * D * 2;
constexpr size_t WS_HF = WS_X1 + (size_t)M * D * 4;
constexpr size_t WS_IDX = WS_HF + (size_t)M * D * 2;
constexpr size_t WS_GATE = WS_IDX + (size_t)M * 8 * 4;
constexpr size_t WS_POS = WS_GATE + (size_t)M * 8 * 4;
constexpr size_t WS_SLOTTOK = WS_POS + (size_t)M * 8 * 4;
constexpr size_t WS_TILEEXP = WS_SLOTTOK + (size_t)CAP * 4;
constexpr size_t WS_ACT = WS_TILEEXP + 4096;
constexpr size_t WS_Y = WS_ACT + (size_t)CAP * ED * 2;
constexpr size_t WS_TMP = WS_Y + (size_t)CAP * D * 2;
constexpr size_t WS_WRT = WS_TMP + (size_t)M * 16 * 2 * 128 * 4;
constexpr size_t WS_WCNT = WS_WRT + (size_t)2 * 2 * NE * D * 2;
constexpr size_t WS_HFB = WS_WCNT + (size_t)4096 * 64 * 4;
constexpr size_t WS_ACTS = WS_HFB + (size_t)M * D * 2;
constexpr size_t WS_WUPS = WS_ACTS + (size_t)M * ED * 2;
constexpr size_t WS_WDNS = WS_WUPS + (size_t)2 * UPN * D * 2;
constexpr size_t WS_END = WS_WDNS + (size_t)2 * D * ED * 2;
constexpr int CW_BAR = 4096;
constexpr int CW_CNT = 16384;
constexpr int CW_CUR = 16384 + 256;
constexpr int CW_NRT = 16384 + 512;
constexpr int CW_QCTR = 16384 + 1024;

constexpr int LDS_BYTES = 147456;

__device__ __forceinline__ unsigned pk4_fp8(float a, float b, float c2, float d);
constexpr float F8_WSCALE = 256.f, F8_HSCALE = 16.f, F8_ASCALE = 8.f, F8_YSCALE = 32.f;
__device__ __forceinline__ float bf2f(unsigned v) { return __uint_as_float(v << 16); }
__device__ __forceinline__ unsigned f2bf(float f) { unsigned u = __float_as_uint(f); return (u + 0x7fffu + ((u >> 16) & 1u)) >> 16; }
__device__ __forceinline__ unsigned pk2(float lo, float hi) { return f2bf(lo) | (f2bf(hi) << 16); }
__device__ __forceinline__ float wave_sum(float v) {
#pragma unroll
    for (int o = 1; o < 64; o <<= 1) v += __shfl_xor(v, o);
    return v;
}
__device__ __forceinline__ float siluf(float x) { return x / (1.f + __expf(-x)); }

#define XB_TMO      128
#define XB_XCNT(j)  (256  + 64 * (j))
#define XB_XSUB(j)  (1280 + 64 * (j))
#define XB_XGEN(j)  (2304 + 64 * (j))
#define XB_TOP      3328
#define XB_TOPGEN   3392
#define XCD_BAR_WORDS 3456
#define XB_SPIN_CAP (1u << 22)
__device__ __forceinline__ unsigned xb_ld(unsigned* p)              { return __hip_atomic_load(p, __ATOMIC_RELAXED, __HIP_MEMORY_SCOPE_AGENT); }
__device__ __forceinline__ unsigned xb_add(unsigned* p, unsigned v) { return __hip_atomic_fetch_add(p, v, __ATOMIC_RELAXED, __HIP_MEMORY_SCOPE_AGENT); }
__device__ __forceinline__ unsigned xb_xcc_id() { return (unsigned)__builtin_amdgcn_s_getreg((3 << 11) | 20) & 0xFu; }
#define XB_SPIN(cond, bar) do { unsigned _sp = 0; while (cond) { __builtin_amdgcn_s_sleep(1); \
    if ((++_sp & 255u) == 0u) { if (xb_ld(&(bar)[XB_TMO])) break; if (_sp > XB_SPIN_CAP) { atomicAdd(&(bar)[XB_TMO], 1u); break; } } } } while (0)
struct XcdBarrier { unsigned* bar; unsigned x; volatile LAS unsigned* st; };
__device__ __forceinline__ XcdBarrier xcd_barrier_post(unsigned* bar, volatile LAS unsigned* st) {
    XcdBarrier b; b.bar = bar; b.x = xb_xcc_id(); b.st = st;
    if (threadIdx.x == 0) (void)xb_add(&bar[XB_XCNT(b.x)], 1u);
    return b;
}
__device__ __forceinline__ void xcd_barrier_complete(unsigned* bar, unsigned x, unsigned& nloc, unsigned& nx) {
    const unsigned G = gridDim.x * gridDim.y * gridDim.z;
    unsigned sum, cnt, mine, sp = 0u;
    for (;;) {
        sum = 0u; cnt = 0u; mine = 0u;
#pragma unroll
        for (unsigned j = 0; j < 16; ++j) { const unsigned c = xb_ld(&bar[XB_XCNT(j)]); sum += c; cnt += (c > 0u) ? 1u : 0u; mine = (j == x) ? c : mine; }
        if (sum == G) break;
        __builtin_amdgcn_s_sleep(1);
        if ((++sp & 255u) == 0u) { if (xb_ld(&bar[XB_TMO])) break; if (sp > XB_SPIN_CAP) { atomicAdd(&bar[XB_TMO], 1u); break; } }
    }
    nloc = mine > 0u ? mine : 1u; nx = cnt > 0u ? cnt : 1u;
}
__device__ __forceinline__ void xcd_barrier(const XcdBarrier& b) {
    asm volatile("s_waitcnt vmcnt(0)" ::: "memory");
    __syncthreads();
    if (threadIdx.x == 0) {
        unsigned* bar = b.bar;
        __builtin_amdgcn_s_waitcnt(0);
        unsigned nloc = b.st[0], nx = b.st[1];
        if (nloc == 0u) { xcd_barrier_complete(bar, b.x, nloc, nx); b.st[0] = nloc; b.st[1] = nx; }
        const unsigned old = xb_add(&bar[XB_XSUB(b.x)], 1u);
        const unsigned gen = old / nloc;
        if (old + 1u == (gen + 1u) * nloc) {
            __builtin_amdgcn_fence(__ATOMIC_RELEASE, "agent");
            asm volatile("s_waitcnt vmcnt(0)" ::: "memory");
            const unsigned og = xb_add(&bar[XB_TOP], 1u);
            const unsigned tg = og / nx;
            if (og + 1u == (tg + 1u) * nx) xb_add(&bar[XB_TOPGEN], 1u);
            else XB_SPIN(xb_ld(&bar[XB_TOPGEN]) == tg, bar);
            __builtin_amdgcn_fence(__ATOMIC_ACQUIRE, "agent");
            xb_add(&bar[XB_XGEN(b.x)], 1u);
            asm volatile("s_waitcnt vmcnt(0)" ::: "memory");
        } else {
            XB_SPIN(xb_ld(&bar[XB_XGEN(b.x)]) == gen, bar);
            __builtin_amdgcn_fence(__ATOMIC_ACQUIRE, "agent");
            asm volatile("s_waitcnt vmcnt(0)" ::: "memory");
        }
    }
    __syncthreads();
}

struct Args {
    const float* in[21];
    float* out;
    unsigned char* ws;
    int ph_lo, ph_hi;
};

struct Ctx {
    int tid, lane, wave, gw, ngw, gsz;
    LAS unsigned char* lds;
    unsigned char* ws;
    unsigned* ctl;
};

__device__ __forceinline__ int gtid_now() { int t = (int)(blockIdx.x * 512u + threadIdx.x); asm volatile("" : "+v"(t)); return t; }
template <int MODE> __device__ __forceinline__ int perm_row(int n) {
    if (MODE == 1) { const int nl = n & 255; return (n & ~255) + 128 * ((nl >> 5) & 1) + 32 * (nl >> 6) + (nl & 31); }
    if (MODE == 2) { const int bj = n >> 9, rem = n & 511; return 256 * (rem >> 7) + 128 * bj + (rem & 127); }
    if (MODE == 3) { const int cl = n & 255; return (n & ~255) + 128 * ((cl >> 3) & 1) + 32 * (cl >> 6) + 8 * ((cl >> 4) & 3) + (cl & 7); }
    return n;
}
template <int MODE> __device__ __forceinline__ void transpose_item(const float* W, int K, int N, bf16* WT, LAS float* scr, int item, int lane) {
    const int nblk = N / 32, kb = item / nblk, nb = item % nblk, k0 = 64 * kb, n0 = 32 * nb, d0 = perm_row<MODE>(n0);
#pragma unroll 8
    for (int i = 0; i < 32; ++i) { const int kk = 2 * i + (lane >> 5); scr[kk * 33 + (lane & 31)] = W[(size_t)(k0 + kk) * N + n0 + (lane & 31)]; }
    asm volatile("s_waitcnt lgkmcnt(0)" ::: "memory");
    const int c = lane & 7;
#pragma unroll
    for (int j = 0; j < 4; ++j) { const int n = (lane >> 3) + 8 * j; const LAS float* s = scr + (8 * c) * 33 + n;
        u32x4 o; o.x = pk2(s[0 * 33], s[1 * 33]); o.y = pk2(s[2 * 33], s[3 * 33]); o.z = pk2(s[4 * 33], s[5 * 33]); o.w = pk2(s[6 * 33], s[7 * 33]);
        *(u32x4*)(WT + (size_t)(d0 + n) * K + k0 + 8 * c) = o; }
    asm volatile("s_waitcnt lgkmcnt(0)" ::: "memory");
}
template <int MODE> __device__ __forceinline__ void convert_batch(const Ctx& c, const float* src, int K, int N, bf16* dst, int nmat, size_t dst_stride) {
    LAS float* scr = (LAS float*)(c.lds + c.wave * 16384);
    const int per = (K / 64) * (N / 32); const long total = (long)per * nmat;
    for (long it = c.gw; it < total; it += c.ngw) {
        const int mat = (int)(it / per), item = (int)(it % per);
        transpose_item<MODE>(src + (size_t)mat * K * N, K, N, dst + (size_t)mat * dst_stride, scr, item, c.lane);
    }
}

__device__ __forceinline__ float clamp448(float v) { return __builtin_amdgcn_fmed3f(v, -448.f, 448.f); }
__device__ __forceinline__ unsigned pk4_fp8(float a, float b, float c2, float d) {
    unsigned w = 0u; w = __builtin_amdgcn_cvt_pk_fp8_f32(clamp448(a), clamp448(b), w, false); w = __builtin_amdgcn_cvt_pk_fp8_f32(clamp448(c2), clamp448(d), w, true); return w;
}
template <int MODE> __device__ __forceinline__ void transpose_item_f8(const float* W, int K, int N, unsigned char* WT, LAS float* scr, int item, int lane) {
    const int nblk = N / 32, kb = item / nblk, nb = item % nblk, k0 = 64 * kb, n0 = 32 * nb, d0 = perm_row<MODE>(n0);
#pragma unroll 8
    for (int i = 0; i < 32; ++i) { const int kk = 2 * i + (lane >> 5); scr[kk * 33 + (lane & 31)] = W[(size_t)(k0 + kk) * N + n0 + (lane & 31)]; }
    asm volatile("s_waitcnt lgkmcnt(0)" ::: "memory");
    const int n = lane & 31;
#pragma unroll
    for (int j = 0; j < 2; ++j) { const int ch = (lane >> 5) + 2 * j; const LAS float* s = scr + (16 * ch) * 33 + n; u32x4 o;
#pragma unroll
        for (int q = 0; q < 4; ++q) o[q] = pk4_fp8(s[(4 * q) * 33] * F8_WSCALE, s[(4 * q + 1) * 33] * F8_WSCALE, s[(4 * q + 2) * 33] * F8_WSCALE, s[(4 * q + 3) * 33] * F8_WSCALE);
        *(u32x4*)(WT + (size_t)(d0 + n) * K + k0 + 16 * ch) = o; }
    asm volatile("s_waitcnt lgkmcnt(0)" ::: "memory");
}
template <int MODE> __device__ __forceinline__ void convert_batch_f8(const Ctx& c, const float* src, int K, int N, unsigned char* dst, int nmat, size_t dst_stride) {
    LAS float* scr = (LAS float*)(c.lds + c.wave * 16384);
    const int per = (K / 64) * (N / 32); const long total = (long)per * nmat;
    for (long it = c.gw; it < total; it += c.ngw) {
        const int mat = (int)(it / per), item = (int)(it % per);
        transpose_item_f8<MODE>(src + (size_t)mat * K * N, K, N, dst + (size_t)mat * dst_stride, scr, item, c.lane);
    }
}

__device__ __forceinline__ void t128_load(f32x4 (&v)[16], const float* W, int N, int item, int lane) {
    const int nblk = N / 32, kb = item / nblk, nb = item % nblk, k0 = 128 * kb, n0 = 32 * nb;
    const int kr = lane >> 3, nq = lane & 7;
#pragma unroll
    for (int i = 0; i < 16; ++i) v[i] = *(const f32x4*)(W + (size_t)(k0 + 8 * i + kr) * N + n0 + 4 * nq);
}
template <int MODE, bool F8> __device__ __forceinline__ void t128_finish(const f32x4 (&v)[16], int K, int N, unsigned char* WT, LAS float* scr, int item, int lane, float scale) {
    const int nblk = N / 32, kb = item / nblk, nb = item % nblk, k0 = 128 * kb, n0 = 32 * nb, d0 = perm_row<MODE>(n0);
    const int kr = lane >> 3, nq = lane & 7;
#pragma unroll
    for (int i = 0; i < 16; ++i) { LAS float* s = scr + (8 * i + kr) * 33 + 4 * nq; s[0] = v[i].x; s[1] = v[i].y; s[2] = v[i].z; s[3] = v[i].w; }
    asm volatile("s_waitcnt lgkmcnt(0)" ::: "memory");
    const int n = lane & 31, half = lane >> 5; const LAS float* s0 = scr + (64 * half) * 33 + n;
    if (F8) {
        const int rs = lane >> 2, pc = lane & 3; (void)s0; (void)half;
#pragma unroll
        for (int it = 0; it < 4; ++it) { const int nn = rs + 16 * (it & 1), hs = it >> 1; const LAS float* s = scr + (64 * hs + 16 * pc) * 33 + nn; u32x4 o;
#pragma unroll
            for (int q = 0; q < 4; ++q) o[q] = pk4_fp8(s[(4 * q) * 33] * scale, s[(4 * q + 1) * 33] * scale, s[(4 * q + 2) * 33] * scale, s[(4 * q + 3) * 33] * scale);
            *(u32x4*)(WT + (size_t)(MODE == 3 ? perm_row<MODE>(n0 + nn) : d0 + nn) * K + k0 + 64 * hs + 16 * pc) = o; }
    } else {
        bf16* dst = (bf16*)WT + (size_t)(d0 + n) * K + k0 + 64 * half;
#pragma unroll
        for (int ch = 0; ch < 8; ++ch) { const LAS float* s = s0 + (8 * ch) * 33; u32x4 o;
#pragma unroll
            for (int q = 0; q < 4; ++q) o[q] = pk2(s[(2 * q) * 33], s[(2 * q + 1) * 33]);
            *(u32x4*)(dst + 8 * ch) = o; }
    }
    asm volatile("s_waitcnt lgkmcnt(0)" ::: "memory");
}
template <int MODE, bool F8> __device__ __forceinline__ void transpose_item128(const float* W, int K, int N, unsigned char* WT, LAS float* scr, int item, int lane, float scale) {
    asm volatile("" : "+v"(lane));
    f32x4 v[16];
    t128_load(v, W, N, item, lane);
    t128_finish<MODE, F8>(v, K, N, WT, scr, item, lane, scale);
}
template <int QM, bool F8Q> __device__ __forceinline__ void convert_dense_all(const Ctx& c, const float* w0in, const float* w1in, const float* w0out, const float* w1out,
                                                                              unsigned char* W0IN_, unsigned char* W1IN_, unsigned char* W0OUT_, unsigned char* W1OUT_, float sq) {
    constexpr int n0 = 16 * (AB_IN / 32), n1 = 16 * (C_IN / 32), n2 = 16 * (D / 32), TOT = n0 + n1 + 2 * n2;
    LAS float* scr = (LAS float*)(c.lds + c.wave * 16896);
    const int lane = c.lane, ngw = c.ngw;
#define DENSE_LOAD(v, it) do { if ((it) < n0) t128_load(v, w0in, AB_IN, (it), lane); else if ((it) < n0 + n1) t128_load(v, w1in, C_IN, (it) - n0, lane); \
        else if ((it) < n0 + n1 + n2) t128_load(v, w0out, D, (it) - n0 - n1, lane); else t128_load(v, w1out, D, (it) - n0 - n1 - n2, lane); } while (0)
#define DENSE_FIN(v, it) do { if ((it) < n0 + n1) { const bool f_ = (it) < n0; t128_finish<QM, F8Q>(v, D, f_ ? AB_IN : C_IN, f_ ? W0IN_ : W1IN_, scr, f_ ? (it) : (it) - n0, lane, sq); } \
        else { const bool f_ = (it) < n0 + n1 + n2; t128_finish<0, false>(v, D, D, f_ ? W0OUT_ : W1OUT_, scr, f_ ? (it) - n0 - n1 : (it) - n0 - n1 - n2, lane, 1.f); } } while (0)
    int it = c.gw;
    f32x4 va[16], vb[16];
    if (it < TOT) DENSE_LOAD(va, it);
    while (it < TOT) {
        const int it1 = it + ngw, it2 = it1 + ngw;
        if (it1 < TOT) DENSE_LOAD(vb, it1);
        DENSE_FIN(va, it);
        if (it2 < TOT) DENSE_LOAD(va, it2);
        if (it1 < TOT) DENSE_FIN(vb, it1);
        it = it2;
    }
#undef DENSE_LOAD
#undef DENSE_FIN
}
template <int MODE, bool F8> __device__ __forceinline__ void convert_batch128(const Ctx& c, const float* src, int K, int N, void* dst, int nmat, size_t dst_stride_bytes, float scale) {
    LAS float* scr = (LAS float*)(c.lds + c.wave * 16896);
    const int per = (K / 128) * (N / 32); const long total = (long)per * nmat;
    for (long it = c.gw; it < total; it += c.ngw) {
        const int mat = (int)(it / per), item = (int)(it % per);
        transpose_item128<MODE, F8>(src + (size_t)mat * K * N, K, N, (unsigned char*)dst + (size_t)mat * dst_stride_bytes, scr, item, c.lane, scale);
    }
}

struct ExpertSrc { const float* up; const float* sup; const float* dn; const float* sdn; };
constexpr int EXP_ITEMS_UP = NE * 512, EXP_ITEMS_SUP = 512, EXP_ITEMS_DN = NE * 256, EXP_ITEMS_SDN = 256, EXP_ITEMS = EXP_ITEMS_UP + EXP_ITEMS_SUP + EXP_ITEMS_DN + EXP_ITEMS_SDN;
__device__ __forceinline__ void expert_item(const ExpertSrc& s, int l, unsigned char* ws, LAS float* scr, int it, int lane) {
    unsigned char* wup = ws + WS_WUP + (size_t)l * NEX * UPN * D; unsigned char* wdn = ws + WS_WDN + (size_t)l * NEX * D * ED;
    if (it < EXP_ITEMS_UP) { const int mat = it >> 9; transpose_item128<2, true>(s.up + ((size_t)l * NE + mat) * D * UPN, D, UPN, wup + (size_t)mat * UPN * D, scr, it & 511, lane, F8_WSCALE); return; }
    it -= EXP_ITEMS_UP;
    if (it < EXP_ITEMS_SUP) { transpose_item128<2, true>(s.sup + (size_t)l * D * UPN, D, UPN, wup + (size_t)NE * UPN * D, scr, it, lane, F8_WSCALE); return; }
    it -= EXP_ITEMS_SUP;
    if (it < EXP_ITEMS_DN) { const int mat = it >> 8; transpose_item128<0, true>(s.dn + ((size_t)l * NE + mat) * ED * D, ED, D, wdn + (size_t)mat * D * ED, scr, it & 255, lane, F8_WSCALE); return; }
    it -= EXP_ITEMS_DN;
    transpose_item128<0, true>(s.sdn + (size_t)l * ED * D, ED, D, wdn + (size_t)NE * D * ED, scr, it, lane, F8_WSCALE);
}
struct ERef { const float* W; int N, item; };
__device__ __forceinline__ ERef expert_ref(const ExpertSrc& s, int l, int it) {
    if (it < EXP_ITEMS_UP) return ERef{s.up + ((size_t)l * NE + (it >> 9)) * D * UPN, UPN, it & 511};
    it -= EXP_ITEMS_UP;
    if (it < EXP_ITEMS_SUP) return ERef{s.sup + (size_t)l * D * UPN, UPN, it};
    it -= EXP_ITEMS_SUP;
    if (it < EXP_ITEMS_DN) return ERef{s.dn + ((size_t)l * NE + (it >> 8)) * ED * D, D, it & 255};
    it -= EXP_ITEMS_DN;
    return ERef{s.sdn + (size_t)l * ED * D, D, it};
}
__device__ __forceinline__ void expert_fin(const f32x4 (&v)[16], int l, unsigned char* ws, LAS float* scr, int it, int lane) {
    if (it < EXP_ITEMS_UP + EXP_ITEMS_SUP) { const bool r = it < EXP_ITEMS_UP; const int mat = r ? it >> 9 : NE, item = r ? it & 511 : it - EXP_ITEMS_UP;
        t128_finish<2, true>(v, D, UPN, ws + WS_WUP + ((size_t)l * NEX + mat) * UPN * D, scr, item, lane, F8_WSCALE); }
    else { it -= EXP_ITEMS_UP + EXP_ITEMS_SUP; const bool r = it < EXP_ITEMS_DN; const int mat = r ? it >> 8 : NE, item = r ? it & 255 : it - EXP_ITEMS_DN;
        t128_finish<Y_FP8 ? 3 : 0, true>(v, ED, D, ws + WS_WDN + ((size_t)l * NEX + mat) * D * ED, scr, item, lane, F8_WSCALE); }
}
__device__ __forceinline__ void expert_items_block(const Ctx& c, const ExpertSrc& s, int l, unsigned char* ws, int first, int count) {
    int tid = threadIdx.x; asm volatile("" : "+v"(tid));
    const int lane = tid & 63, wv = __builtin_amdgcn_readfirstlane(tid >> 6);
    LAS float* scr = (LAS float*)(c.lds + wv * 16896);
    f32x4 va[16], vb[16];
    int i = wv;
    if (i < count) { const ERef r = expert_ref(s, l, first + i); t128_load(va, r.W, r.N, r.item, lane); }
#pragma unroll 1
    while (i < count) {
        const int i1 = i + 8, i2 = i + 16;
        if (i1 < count) { const ERef r = expert_ref(s, l, first + i1); t128_load(vb, r.W, r.N, r.item, lane); }
        expert_fin(va, l, ws, scr, first + i, lane);
        if (i2 < count) { const ERef r = expert_ref(s, l, first + i2); t128_load(va, r.W, r.N, r.item, lane); }
        if (i1 < count) expert_fin(vb, l, ws, scr, first + i1, lane);
        i = i2;
    }
}
__device__ __forceinline__ void ada_phase(const Ctx& c, const float* cin, const float* w_ada, const float* b_ada, float* ada) {
    LAS float* red = (LAS float*)(c.lds);
    LAS float* sc = red + 1024;
    for (int i = c.tid; i < 4 * D; i += 512) sc[i] = siluf(cin[i]);
    __syncthreads();
    const int j = c.lane & 7, kr = c.lane >> 3;
    constexpr int NCG = 6 * D / 32;
    for (int u = blockIdx.x; u < 2 * NCG; u += gridDim.x) {
        const int l = u / NCG, cg = u % NCG;
        const int k0 = c.wave * 256 + kr;
        const float* w = w_ada + (size_t)l * D * 6 * D + (size_t)k0 * 6 * D + cg * 32 + 4 * j;
        f32x4 acc[4];
#pragma unroll
        for (int b = 0; b < 4; ++b) acc[b] = (f32x4){0.f, 0.f, 0.f, 0.f};
        f32x4 wv[32];
#pragma unroll
        for (int i = 0; i < 32; ++i) wv[i] = *(const f32x4*)(w + (size_t)(8 * i) * 6 * D);
#pragma unroll
        for (int i = 0; i < 32; ++i)
#pragma unroll
            for (int b = 0; b < 4; ++b) acc[b] += wv[i] * sc[b * D + k0 + 8 * i];
#pragma unroll
        for (int b = 0; b < 4; ++b)
#pragma unroll
            for (int q = 0; q < 4; ++q) { float t = acc[b][q]; t += __shfl_xor(t, 8); t += __shfl_xor(t, 16); t += __shfl_xor(t, 32); acc[b][q] = t; }
        if (kr == 0) {
#pragma unroll
            for (int b = 0; b < 4; ++b) *(LAS f32x4*)(red + (c.wave * 4 + b) * 32 + 4 * j) = acc[b]; }
        __syncthreads();
        if (c.tid < 128) {
            const int b = c.tid >> 5, cc = c.tid & 31; float s2 = b_ada[(size_t)l * 6 * D + cg * 32 + cc];
#pragma unroll
            for (int w8 = 0; w8 < 8; ++w8) s2 += red[(w8 * 4 + b) * 32 + cc];
            ada[((size_t)l * 4 + b) * 6 * D + cg * 32 + cc] = s2;
        }
        __syncthreads();
    }
}

__device__ __forceinline__ void load_row(const float* xrow, int lane, f32x4 (&v)[8]) {
#pragma unroll
    for (int j = 0; j < 8; ++j) v[j] = *(const f32x4*)(xrow + 4 * lane + 256 * j);
}
__device__ __forceinline__ float row_rstd(const f32x4 (&v)[8]) {
    float s = 0.f;
#pragma unroll
    for (int j = 0; j < 8; ++j) s += (v[j].x * v[j].x + v[j].y * v[j].y) + (v[j].z * v[j].z + v[j].w * v[j].w);
    return 1.f / sqrtf(wave_sum(s) * (1.f / D) + RMS_EPS);
}
__device__ __forceinline__ void modulate_row(f32x4 (&v)[8], float rstd, const float* g, const float* sh, const float* sc, int lane) {
#pragma unroll
    for (int j = 0; j < 8; ++j) { const int col = 4 * lane + 256 * j;
        const f32x4 gg = *(const f32x4*)(g + col), s1 = *(const f32x4*)(sc + col), s0 = *(const f32x4*)(sh + col);
        v[j] = v[j] * rstd * gg * (s1 + 1.f) + s0; }
}
__device__ __forceinline__ void store_row_bf16(bf16* orow, const f32x4 (&v)[8], int lane) {
#pragma unroll
    for (int j = 0; j < 8; ++j) { u32x2 w; w.x = pk2(v[j].x, v[j].y); w.y = pk2(v[j].z, v[j].w); *(u32x2*)(orow + 4 * lane + 256 * j) = w; }
}
__device__ __forceinline__ void store_row_fp8(unsigned char* orow, const f32x4 (&v)[8], int lane, float scale) {
#pragma unroll
    for (int j = 0; j < 8; ++j) *(unsigned*)(orow + 4 * lane + 256 * j) = pk4_fp8(v[j].x * scale, v[j].y * scale, v[j].z * scale, v[j].w * scale);
}
__device__ __forceinline__ void norm_phase(const Ctx& c, const float* x, const float* g, const float* ada_l  , int sh_off, int sc_off, bf16* out) {
    for (int m = c.gw; m < M; m += c.ngw) {
        const int b = m / T; f32x4 v[8]; load_row(x + (size_t)m * D, c.lane, v);
        const float rstd = row_rstd(v);
        modulate_row(v, rstd, g, ada_l + (size_t)b * 6 * D + sh_off, ada_l + (size_t)b * 6 * D + sc_off, c.lane);
#if USE_FP8_QKV
        store_row_fp8((unsigned char*)out + (size_t)m * D, v, c.lane, F8_HSCALE);
#else
        store_row_bf16(out + (size_t)m * D, v, c.lane);
#endif
    }
}

__device__ __forceinline__ void wave_gemm_32x64(const bf16* a0, const bf16* a1, const bf16* b, int K, int lane, f32x4 (&acc)[2][4]) {
    const int q8 = (lane >> 4) * 8;
    for (int k0 = 0; k0 < K; k0 += 32) {
        const bf16x8 fa0 = *(const bf16x8*)(a0 + k0 + q8), fa1 = *(const bf16x8*)(a1 + k0 + q8);
#pragma unroll
        for (int n = 0; n < 4; ++n) { const bf16x8 fb = *(const bf16x8*)(b + (size_t)n * 16 * K + k0 + q8);
            acc[0][n] = __builtin_amdgcn_mfma_f32_16x16x32_bf16(fa0, fb, acc[0][n], 0, 0, 0);
            acc[1][n] = __builtin_amdgcn_mfma_f32_16x16x32_bf16(fa1, fb, acc[1][n], 0, 0, 0); }
    }
}
#define ZERO_ACC(acc) do { _Pragma("unroll") for (int _a = 0; _a < 2; ++_a) _Pragma("unroll") for (int _b = 0; _b < 4; ++_b) acc[_a][_b] = (f32x4){0.f, 0.f, 0.f, 0.f}; } while (0)

__device__ __forceinline__ void gemm_plain_bf16(const Ctx& c, const bf16* A, const bf16* Bt, int K, int N, bf16* C) {
    const int ntn = N / 64, units = (M / 256) * ntn;
    for (int u = blockIdx.x; u < units; u += gridDim.x) {
        const int mt = u / ntn, nt = u % ntn, row0 = mt * 256 + c.wave * 32, n0 = nt * 64;
        f32x4 acc[2][4]; ZERO_ACC(acc);
        const int r = c.lane & 15;
        wave_gemm_32x64(A + (size_t)(row0 + r) * K, A + (size_t)(row0 + 16 + r) * K, Bt + (size_t)(n0 + r) * K, K, c.lane, acc);
#pragma unroll
        for (int mi = 0; mi < 2; ++mi)
#pragma unroll
            for (int n = 0; n < 4; ++n)
#pragma unroll
                for (int j = 0; j < 4; ++j) C[(size_t)(row0 + 16 * mi + 4 * (c.lane >> 4) + j) * N + n0 + 16 * n + r] = (bf16)f2bf(acc[mi][n][j]);
    }
}
__device__ __forceinline__ void gemm_outproj(const Ctx& c, const bf16* A, const bf16* Bt, const float* xin, const float* gm  , float* X1) {
    const int K = D, N = D, ntn = N / 64, units = (M / 256) * ntn;
    for (int u = blockIdx.x; u < units; u += gridDim.x) {
        const int mt = u / ntn, nt = u % ntn, row0 = mt * 256 + c.wave * 32, n0 = nt * 64;
        f32x4 acc[2][4]; ZERO_ACC(acc);
        const int r = c.lane & 15;
        wave_gemm_32x64(A + (size_t)(row0 + r) * K, A + (size_t)(row0 + 16 + r) * K, Bt + (size_t)(n0 + r) * K, K, c.lane, acc);
        const int b = row0 / T;
#pragma unroll
        for (int mi = 0; mi < 2; ++mi)
#pragma unroll
            for (int n = 0; n < 4; ++n)
#pragma unroll
                for (int j = 0; j < 4; ++j) { const size_t o = (size_t)(row0 + 16 * mi + 4 * (c.lane >> 4) + j) * N + n0 + 16 * n + r;
                    X1[o] = xin[o] + gm[(size_t)b * 6 * D + n0 + 16 * n + r] * acc[mi][n][j]; }
    }
}

__device__ __forceinline__ void qknorm_chunk(bf16* p, const float* g) {
    float v[64]; float ss = 0.f;
#pragma unroll
    for (int i = 0; i < 8; ++i) { const u32x4 w = *(const u32x4*)(p + 8 * i);
#pragma unroll
        for (int j = 0; j < 4; ++j) { v[8 * i + 2 * j] = bf2f(w[j] & 0xffffu); v[8 * i + 2 * j + 1] = bf2f(w[j] >> 16); } }
#pragma unroll
    for (int i = 0; i < 64; ++i) ss += v[i] * v[i];
    const float rs = 1.f / sqrtf(ss * (1.f / 64.f) + RMS_EPS);
#pragma unroll
    for (int i = 0; i < 8; ++i) { u32x4 w;
#pragma unroll
        for (int j = 0; j < 4; ++j) w[j] = pk2(v[8 * i + 2 * j] * rs * g[8 * i + 2 * j], v[8 * i + 2 * j + 1] * rs * g[8 * i + 2 * j + 1]);
        *(u32x4*)(p + 8 * i) = w; }
}
__device__ __forceinline__ void qknorm0_phase(const Ctx& c, bf16* qkv, const float* gains  ) {
    const long total = (long)M * 50;
    for (long id = gtid_now(); id < total; id += c.gsz) {
        const int m = (int)(id / 50), k = (int)(id % 50); int ch, gi;
        if (k < 16) { ch = k; gi = 0; } else if (k < 32) { ch = k; gi = 1; } else if (k < 48) { ch = k + 16; gi = 2; } else { ch = k + 16; gi = 3; }
        qknorm_chunk(qkv + (size_t)m * AB_IN + 64 * ch, gains + 64 * gi);
    }
}
__device__ __forceinline__ void qknorm1_phase(const Ctx& c, bf16* qkv, const float* gains  ) {
    const long total = (long)M * 64;
    for (long id = gtid_now(); id < total; id += c.gsz) {
        const int m = (int)(id / 64), ch = (int)(id % 64);
        qknorm_chunk(qkv + (size_t)m * C_IN + 64 * ch, gains + 64 * (ch >> 5));
    }
}

__device__ __forceinline__ void load64(const bf16* p, float (&v)[64], float scale) {
#pragma unroll
    for (int i = 0; i < 8; ++i) { const u32x4 w = *(const u32x4*)(p + 8 * i);
#pragma unroll
        for (int j = 0; j < 4; ++j) { v[8 * i + 2 * j] = bf2f(w[j] & 0xffffu) * scale; v[8 * i + 2 * j + 1] = bf2f(w[j] >> 16) * scale; } }
}
__device__ __forceinline__ float dot64(const float (&q)[64], const bf16* kp) {
    float s0 = 0.f, s1 = 0.f;
#pragma unroll
    for (int i = 0; i < 8; ++i) { const u32x4 w = *(const u32x4*)(kp + 8 * i);
#pragma unroll
        for (int j = 0; j < 4; ++j) { s0 += q[8 * i + 2 * j] * bf2f(w[j] & 0xffffu); s1 += q[8 * i + 2 * j + 1] * bf2f(w[j] >> 16); } }
    return s0 + s1;
}
__device__ __forceinline__ void axpy64(float (&o)[64], float a, float p, const bf16* vp) {
#pragma unroll
    for (int i = 0; i < 8; ++i) { const u32x4 w = *(const u32x4*)(vp + 8 * i);
#pragma unroll
        for (int j = 0; j < 4; ++j) { o[8 * i + 2 * j] = o[8 * i + 2 * j] * a + p * bf2f(w[j] & 0xffffu); o[8 * i + 2 * j + 1] = o[8 * i + 2 * j + 1] * a + p * bf2f(w[j] >> 16); } }
}
__device__ __forceinline__ void store64_bf16(bf16* p, const float (&o)[64], float s) {
#pragma unroll
    for (int i = 0; i < 8; ++i) { u32x4 w;
#pragma unroll
        for (int j = 0; j < 4; ++j) w[j] = pk2(o[8 * i + 2 * j] * s, o[8 * i + 2 * j + 1] * s);
        *(u32x4*)(p + 8 * i) = w; }
}
__device__ __forceinline__ void attn0_phase(const Ctx& c, const bf16* qkv, const float* sinks, bf16* O) {
    const long total = (long)32 * M;
    for (long id = gtid_now(); id < total; id += c.gsz) {
        const int hh = (int)(id / M), m = (int)(id % M), b = m / T, t = m % T;
        float q[64], o[64];
#pragma unroll
        for (int i = 0; i < 64; ++i) o[i] = 0.f;
        float mx = -1e30f, l = 0.f;
        if (hh < 16) {
            const int h = hh; const float slope = exp2f(-0.5f * (float)(h + 1));
            load64(qkv + (size_t)m * AB_IN + 64 * h, q, 0.125f);
            const bf16* kb = qkv + (size_t)b * T * AB_IN + 1024 + 64 * h;
            for (int br = 0; br < 3; ++br) {
                const int dil = br == 0 ? 1 : (br == 1 ? 4 : 16);
                for (int j = 0; j <= 128; ++j) {
                    const int s = t - dil * j; if (s < 0) break;
                    const bf16* kp = kb + (size_t)s * AB_IN;
                    const float sc = dot64(q, kp) - slope * (float)(dil * j);
                    const float mn = fmaxf(mx, sc), a = __expf(mx - mn), p = __expf(sc - mn);
                    l = l * a + p; axpy64(o, a, p, kp + 1024); mx = mn;
                }
            }
            store64_bf16(O + (size_t)m * D + 64 * h, o, 1.f / l);
        } else {
            const int h = hh - 16, kvh = h >> 3; const float slope = exp2f(-0.5f * (float)(h + 1));
            load64(qkv + (size_t)m * AB_IN + 3072 + 64 * h, q, 0.125f);
            const bf16* kb = qkv + (size_t)b * T * AB_IN + 4096 + 64 * kvh;
            for (int j = 0; j < 128; ++j) {
                const int s = t - j; if (s < 0) break;
                const bf16* kp = kb + (size_t)s * AB_IN;
                const float sc = dot64(q, kp) - slope * (float)j;
                const float mn = fmaxf(mx, sc), a = __expf(mx - mn), p = __expf(sc - mn);
                l = l * a + p; axpy64(o, a, p, kp + 128); mx = mn;
            }
            const float sk = sinks[h], mn = fmaxf(mx, sk), a = __expf(mx - mn);
            l = l * a + __expf(sk - mn);
            store64_bf16(O + (size_t)m * D + 1024 + 64 * h, o, a / l);
        }
    }
}
__device__ __forceinline__ void attn1_phase(const Ctx& c, const bf16* qkv, float* tmp) {
    const int items = NB * 16 * 2 * 2 * (T / 64);
    for (int it = c.gw; it < items; it += c.ngw) {
        const int tb = (T / 64 - 1) - it / (NB * 16 * 4); const int r = it % (NB * 16 * 4);
        const int b = r / 64, h = (r / 4) % 16, i = (r >> 1) & 1, j = r & 1;
        const int t = tb * 64 + c.lane, m = b * T + t;
        const float slope = exp2f(-0.5f * (float)(h + 1));
        float q[64], o[64];
#pragma unroll
        for (int d = 0; d < 64; ++d) o[d] = 0.f;
        float mx = -1e30f, l = 0.f;
        load64(qkv + (size_t)m * C_IN + 128 * h + 64 * i, q, 0.125f);
        const bf16* kb = qkv + (size_t)b * T * C_IN + 2048 + 128 * h + 64 * i;
        const bf16* vb = qkv + (size_t)b * T * C_IN + 4096 + 128 * h + 64 * j;
        const int smax = tb * 64 + 63;
        for (int s = 0; s <= smax; ++s) {
            const bf16* kp = kb + (size_t)s * C_IN;
            float sc = dot64(q, kp) - slope * (float)(t - s);
            if (s > t) sc = -1e30f;
            const float mn = fmaxf(mx, sc), a = __expf(mx - mn), p = (s > t) ? 0.f : __expf(sc - mn);
            l = l * a + p; axpy64(o, a, p, vb + (size_t)s * C_IN); mx = mn;
        }
        float* op = tmp + (((size_t)m * 16 + h) * 2 + i) * 128 + 64 * j; const float il = 1.f / l;
#pragma unroll
        for (int d = 0; d < 16; ++d) *(f32x4*)(op + 4 * d) = (f32x4){o[4 * d] * il, o[4 * d + 1] * il, o[4 * d + 2] * il, o[4 * d + 3] * il};
    }
}
__device__ __forceinline__ void attn1_finish_phase(const Ctx& c, const float* tmp, const float* lamp  , const float* subln  , bf16* O) {
    float s01 = 0.f, s23 = 0.f;
    for (int i = 0; i < 64; ++i) { s01 += lamp[i] * lamp[64 + i]; s23 += lamp[128 + i] * lamp[192 + i]; }
    const float lam_init = 0.8f - 0.6f * expf(-0.3f * 1.0f);
    const float lam = expf(s01) - expf(s23) + lam_init;
    const long total = (long)M * 16;
    for (long id = gtid_now(); id < total; id += c.gsz) {
        const float* p1 = tmp + (size_t)id * 256; const float* p2 = p1 + 128;
        float ss = 0.f;
        for (int d = 0; d < 128; ++d) { const float v = p1[d] - lam * p2[d]; ss += v * v; }
        const float rs = (1.f - lam_init) / sqrtf(ss * (1.f / 128.f) + RMS_EPS);
        bf16* op = O + (size_t)id * 128;
        for (int d = 0; d < 128; d += 2) { const float v0 = (p1[d] - lam * p2[d]) * rs * subln[d], v1 = (p1[d + 1] - lam * p2[d + 1]) * rs * subln[d + 1];
            *(unsigned*)(op + d) = pk2(v0, v1); }
    }
}

__device__ __forceinline__ void router_phase(const Ctx& c, const float* x1, const float* g, const float* ada_l, const float* wr  , const float* rbias  ,
                                             bf16* HF, int* idx, float* gate, unsigned* counts) {
    LAS float* hb = (LAS float*)(c.lds + c.wave * 8192);
    const int lane = c.lane;
    for (int m = c.gw; m < M; m += c.ngw) {
        const int b = m / T; f32x4 v[8]; load_row(x1 + (size_t)m * D, lane, v);
        const float rstd = row_rstd(v);
        modulate_row(v, rstd, g, ada_l + (size_t)b * 6 * D + 3 * D, ada_l + (size_t)b * 6 * D + 4 * D, lane);
        store_row_bf16(HF + (size_t)m * D, v, lane);
#pragma unroll
        for (int j = 0; j < 8; ++j) *(LAS f32x4*)(hb + 4 * lane + 256 * j) = v[j];
        asm volatile("s_waitcnt lgkmcnt(0)" ::: "memory");
        float a0 = 0.f, a1 = 0.f, a2 = 0.f, a3 = 0.f;
        for (int k = 0; k < D; k += 4) {
            const f32x4 hv = *(const LAS f32x4*)(hb + k);
            a0 += hv.x * wr[(size_t)(k + 0) * 64 + lane]; a1 += hv.y * wr[(size_t)(k + 1) * 64 + lane];
            a2 += hv.z * wr[(size_t)(k + 2) * 64 + lane]; a3 += hv.w * wr[(size_t)(k + 3) * 64 + lane];
        }
        const float logit = (a0 + a1) + (a2 + a3);
        const float score = 1.f / (1.f + expf(-logit));
        const float sel = score + rbias[lane];
        float m1 = sel;
        m1 = fmaxf(m1, __shfl_xor(m1, 1)); m1 = fmaxf(m1, __shfl_xor(m1, 2)); m1 = fmaxf(m1, __shfl_xor(m1, 4));
        const unsigned long long eqm = __ballot(sel == m1);
        const int gbase = lane & ~7;
        const unsigned grp_eq = (unsigned)((eqm >> gbase) & 0xffull);
        const int first = __builtin_ctz(grp_eq);
        float m2 = ((lane & 7) == first) ? -3e38f : sel;
        m2 = fmaxf(m2, __shfl_xor(m2, 1)); m2 = fmaxf(m2, __shfl_xor(m2, 2)); m2 = fmaxf(m2, __shfl_xor(m2, 4));
        const float gs = m1 + m2;
        int grank = 0; const int mygrp = lane >> 3;
#pragma unroll
        for (int g2 = 0; g2 < 8; ++g2) { const float o = __shfl(gs, g2 * 8); grank += (o > gs || (o == gs && g2 < mygrp)) ? 1 : 0; }
        const float msel = (grank < 4) ? sel : -1e30f;
        int rank = 0;
        for (int e2 = 0; e2 < 64; ++e2) { const float o = __shfl(msel, e2); rank += (o > msel || (o == msel && e2 < lane)) ? 1 : 0; }
        const bool chosen = rank < TOPK;
        const float gsum = wave_sum(chosen ? score : 0.f);
        if (chosen) { idx[(size_t)m * 8 + rank] = lane; gate[(size_t)m * 8 + rank] = score / gsum * 2.5f;
            __hip_atomic_fetch_add(counts + lane, 1u, __ATOMIC_RELAXED, __HIP_MEMORY_SCOPE_AGENT); }
    }
}
__device__ __forceinline__ void slot_phase(const Ctx& c, const int* idx, const unsigned* counts, unsigned* cursor, unsigned* nrt_out, int* pos, int* slot_tok, int* tile_exp) {
    LAS int* ps = (LAS int*)c.lds;
    if (c.tid == 0) { int acc = 0; for (int e = 0; e < NE; ++e) { const int cn = (int)counts[e]; ps[e] = acc; ps[64 + e] = cn; acc += (cn + 255) / 256 * 256; } ps[128] = acc; }
    __syncthreads();
    for (int a = gtid_now(); a < M * TOPK; a += c.gsz) {
        const int e = idx[a]; const unsigned r = __hip_atomic_fetch_add(cursor + e, 1u, __ATOMIC_RELAXED, __HIP_MEMORY_SCOPE_AGENT);
        const int slot = ps[e] + (int)r; slot_tok[slot] = a >> 3; pos[a] = slot;
    }
    for (int t = gtid_now(); t < M; t += c.gsz) slot_tok[CAPR + t] = t;
    if (blockIdx.x == 0) {
        if (c.tid < NE) { const int e = c.tid, s0 = ps[e], cn = ps[64 + e], pe = s0 + (cn + 255) / 256 * 256;
            for (int s = s0 + cn; s < pe; ++s) slot_tok[s] = 0;
            for (int tt = s0 / 256; tt < pe / 256; ++tt) tile_exp[tt] = e; }
        if (c.tid == 0) *nrt_out = (unsigned)(ps[128] / 256);
    }
    __syncthreads();
}
__device__ __forceinline__ void moe_up_phase(const Ctx& c, const bf16* HF, const bf16* Wup_l  , const int* slot_tok, const int* tile_exp, const unsigned* nrt_p, bf16* ACT) {
    const int nrt = (int)*nrt_p, ntiles = nrt + M / 256, units = ntiles * (ED / 64);
    for (int u = blockIdx.x; u < units; u += gridDim.x) {
        const int mt = u / (ED / 64), nt = u % (ED / 64), n0 = nt * 64;
        const int e = mt < nrt ? tile_exp[mt] : NE; const int slot0 = (mt < nrt ? mt * 256 : CAPR + (mt - nrt) * 256) + c.wave * 32;
        const int r = c.lane & 15;
        const bf16* a0 = HF + (size_t)slot_tok[slot0 + r] * D; const bf16* a1 = HF + (size_t)slot_tok[slot0 + 16 + r] * D;
        const bf16* W = Wup_l + (size_t)e * UPN * D;
        f32x4 ag[2][4], au[2][4]; ZERO_ACC(ag); ZERO_ACC(au);
        wave_gemm_32x64(a0, a1, W + (size_t)(n0 + r) * D, D, c.lane, ag);
        wave_gemm_32x64(a0, a1, W + (size_t)(ED + n0 + r) * D, D, c.lane, au);
#pragma unroll
        for (int mi = 0; mi < 2; ++mi)
#pragma unroll
            for (int n = 0; n < 4; ++n)
#pragma unroll
                for (int j = 0; j < 4; ++j) ACT[(size_t)(slot0 + 16 * mi + 4 * (c.lane >> 4) + j) * ED + n0 + 16 * n + r] = (bf16)f2bf(siluf(ag[mi][n][j]) * au[mi][n][j]);
    }
}
__device__ __forceinline__ void moe_down_phase(const Ctx& c, const bf16* ACT, const bf16* Wdn_l  , const int* tile_exp, const unsigned* nrt_p, bf16* Y) {
    const int nrt = (int)*nrt_p, ntiles = nrt + M / 256, units = ntiles * (D / 64);
    for (int u = blockIdx.x; u < units; u += gridDim.x) {
        const int mt = u / (D / 64), nt = u % (D / 64), n0 = nt * 64;
        const int e = mt < nrt ? tile_exp[mt] : NE; const int slot0 = (mt < nrt ? mt * 256 : CAPR + (mt - nrt) * 256) + c.wave * 32;
        const int r = c.lane & 15;
        const bf16* W = Wdn_l + (size_t)e * D * ED;
        f32x4 acc[2][4]; ZERO_ACC(acc);
        wave_gemm_32x64(ACT + (size_t)(slot0 + r) * ED, ACT + (size_t)(slot0 + 16 + r) * ED, W + (size_t)(n0 + r) * ED, ED, c.lane, acc);
#pragma unroll
        for (int mi = 0; mi < 2; ++mi)
#pragma unroll
            for (int n = 0; n < 4; ++n)
#pragma unroll
                for (int j = 0; j < 4; ++j) Y[(size_t)(slot0 + 16 * mi + 4 * (c.lane >> 4) + j) * D + n0 + 16 * n + r] = (bf16)f2bf(acc[mi][n][j]);
    }
}
__device__ __forceinline__ void add_row_bf16(f32x4 (&acc)[8], const bf16* yrow, float w, int lane) {
#pragma unroll
    for (int j = 0; j < 8; ++j) { const u32x2 v = *(const u32x2*)(yrow + 4 * lane + 256 * j);
        acc[j].x += w * bf2f(v.x & 0xffffu); acc[j].y += w * bf2f(v.x >> 16); acc[j].z += w * bf2f(v.y & 0xffffu); acc[j].w += w * bf2f(v.y >> 16); }
}
__device__ __forceinline__ void add_row_fp8(f32x4 (&acc)[8], const unsigned char* yrow, float w, int lane) {
#pragma unroll
    for (int j = 0; j < 8; ++j) { const unsigned v = *(const unsigned*)(yrow + 4 * lane + 256 * j);
        acc[j].x += w * __builtin_amdgcn_cvt_f32_fp8(v, 0); acc[j].y += w * __builtin_amdgcn_cvt_f32_fp8(v, 1); acc[j].z += w * __builtin_amdgcn_cvt_f32_fp8(v, 2); acc[j].w += w * __builtin_amdgcn_cvt_f32_fp8(v, 3); }
}
template <bool NEXT>
__device__ __forceinline__ void combine_phase(const Ctx& c, const float* x1, const bf16* Y, const int* pos, const float* gate, const float* ada_l, float* xo,
                                              const float* gnext, const float* ada_next, bf16* XN) {
    for (int m = c.gw; m < M; m += c.ngw) {
        const int b = m / T; f32x4 acc[8];
#pragma unroll
        for (int j = 0; j < 8; ++j) acc[j] = (f32x4){0.f, 0.f, 0.f, 0.f};
#if USE_FP8_MOE && Y_FP8
        for (int k = 0; k < TOPK; ++k) add_row_fp8(acc, (const unsigned char*)Y + (size_t)pos[(size_t)m * 8 + k] * D, gate[(size_t)m * 8 + k] * (1.f / F8_YSCALE), c.lane);
        add_row_fp8(acc, (const unsigned char*)Y + (size_t)(CAPR + m) * D, 1.f / F8_YSCALE, c.lane);
#else
        for (int k = 0; k < TOPK; ++k) add_row_bf16(acc, Y + (size_t)pos[(size_t)m * 8 + k] * D, gate[(size_t)m * 8 + k], c.lane);
        add_row_bf16(acc, Y + (size_t)(CAPR + m) * D, 1.f, c.lane);
#endif
        const float* gf = ada_l + (size_t)b * 6 * D + 5 * D;
        f32x4 v[8];
#pragma unroll
        for (int j = 0; j < 8; ++j) { const int col = 4 * c.lane + 256 * j;
#if RES_BF16
            { const u32x2 xw = *(const u32x2*)((const bf16*)x1 + (size_t)m * D + col);
              v[j] = (f32x4){bf2f(xw.x & 0xffffu), bf2f(xw.x >> 16), bf2f(xw.y & 0xffffu), bf2f(xw.y >> 16)} + *(const f32x4*)(gf + col) * acc[j]; }
            if (NEXT) { u32x2 ow; ow.x = pk2(v[j].x, v[j].y); ow.y = pk2(v[j].z, v[j].w); *(u32x2*)((bf16*)xo + (size_t)m * D + col) = ow; }
            else *(f32x4*)(xo + (size_t)m * D + col) = v[j];
#else
            v[j] = *(const f32x4*)(x1 + (size_t)m * D + col) + *(const f32x4*)(gf + col) * acc[j];
            *(f32x4*)(xo + (size_t)m * D + col) = v[j];
#endif
            }
        if (NEXT) {
            const float rstd = row_rstd(v);
            modulate_row(v, rstd, gnext, ada_next + (size_t)b * 6 * D, ada_next + (size_t)b * 6 * D + D, c.lane);
#if USE_FP8_QKV
            store_row_fp8((unsigned char*)XN + (size_t)m * D, v, c.lane, F8_HSCALE);
#else
            store_row_bf16(XN + (size_t)m * D, v, c.lane);
#endif
        }
    }
}


namespace pg8 {
constexpr int BM = 256, BK = 64, HALF = 128, HTB = HALF * BK * 2, STAGE_BYTES = 8 * HTB, NXCD = 8, WGM = 8;
__device__ __forceinline__ int lds_byte(int r, int c) { const int st = (r >> 4) * 2 + (c >> 5), rr = r & 15, cc = c & 31, ob = rr * 64 + cc * 2; return st * 1024 + (ob ^ (((ob >> 9) & 1) << 5)); }
__device__ __forceinline__ void stage_rc(int b, int& R, int& C) { const int st = b / 1024, sb = b % 1024, swz = sb ^ (((sb >> 9) & 1) << 5); R = (st >> 1) * 16 + swz / 64; C = (st & 1) * 32 + (swz % 64) / 2; }
__device__ __forceinline__ int perm32(int rho) { const int n = rho >> 4, i = rho & 15; return 8 * (i >> 2) + 4 * n + (i & 3); }
__device__ __forceinline__ unsigned cvt_pk_bf16(float lo, float hi) { unsigned r; asm volatile("v_cvt_pk_bf16_f32 %0, %1, %2" : "=v"(r) : "v"(lo), "v"(hi)); return r; }

struct Unit { int row0, pn; const char* Bp; };

struct TileOrder {
    int nM, nN, nwg, G, c;
    __device__ __forceinline__ void init(int nM_, int nN_, int G_, int c_) { nM = nM_; nN = nN_; nwg = nM * nN; G = G_; c = c_; }
    __device__ __forceinline__ bool tile(int i, int& pm, int& pn) const {
        const long L = (long)i * G + c; if (L >= nwg) return false;
        int wgid = (int)L; { const int q = nwg / NXCD, r = nwg % NXCD, xcd = wgid % NXCD, off = wgid / NXCD; wgid = (xcd < r ? xcd * (q + 1) : r * (q + 1) + (xcd - r) * q) + off; }
        const int nig = WGM * nN, gid = wgid / nig, fm = gid * WGM, gsz = (nM - fm) < WGM ? (nM - fm) : WGM;
        pm = fm + ((wgid % nig) % gsz); pn = (wgid % nig) / gsz; return true;
    }
};
struct PlainSched {
    static constexpr bool GATHER = false;
    TileOrder o; const char* Bt; int K;
    __device__ __forceinline__ bool next(int i, Unit& u) const { int pm, pn; if (!o.tile(i, pm, pn)) return false; u.row0 = pm * BM; u.pn = pn; u.Bp = Bt + (size_t)pn * BM * K * 2; return true; }
    __device__ __forceinline__ unsigned arow_off(const Unit& u, int rl) const { return (unsigned)(u.row0 + rl) * (unsigned)(K * 2); }
};
template <bool GATHER_> struct GroupSched {
    static constexpr bool GATHER = GATHER_;
    TileOrder o; const char* W; size_t wstride; int K, nrt; const LAS int* tile_exp; const int* slot_tok;
    __device__ __forceinline__ bool next(int i, Unit& u) const { int pm, pn; if (!o.tile(i, pm, pn)) return false;
        const int e = pm < nrt ? tile_exp[pm] : NE; u.row0 = pm < nrt ? pm * BM : CAPR + (pm - nrt) * BM; u.pn = pn; u.Bp = W + (size_t)e * wstride + (size_t)pn * BM * K * 2; return true; }
    __device__ __forceinline__ unsigned arow_off(const Unit& u, int rl) const { const int r = GATHER ? slot_tok[u.row0 + rl] : (u.row0 + rl); return (unsigned)r * (unsigned)(K * 2); }
};

template <int LAYER> struct EpiQKV {
    static constexpr bool PERM = true;
    bf16* O; int ldc; const float* gains; float qscale, ascale;
    __device__ __forceinline__ void operator()(const f32x4 (&acc)[2][2][4][2], const Unit& u, int wr, int wc, int fr, int fq) const {
        const int head = 4 * u.pn + wc; int gi;
        if (LAYER == 0) gi = head < 16 ? 0 : head < 32 ? 1 : head < 48 ? -1 : head < 64 ? 2 : head < 66 ? 3 : -1;
        else gi = head < 32 ? 0 : head < 64 ? 1 : -1;
        f32x4 gv[2][2];
#pragma unroll
        for (int bj = 0; bj < 2; ++bj)
#pragma unroll
            for (int n = 0; n < 2; ++n) gv[bj][n] = gi >= 0 ? *(const f32x4*)(gains + 64 * gi + 32 * bj + 8 * fq + 4 * n) : (f32x4){1.f, 1.f, 1.f, 1.f};
#if QKV_HEADMAJOR
        bf16* base = O + ((size_t)head * M + (size_t)(u.row0 + wr * 64 + fr)) * 64 + 8 * fq; const int ldo = 64;
#else
        bf16* base = O + (size_t)(u.row0 + wr * 64 + fr) * ldc + 64 * head + 8 * fq; const int ldo = ldc;
#endif
#pragma unroll
        for (int ai = 0; ai < 2; ++ai)
#pragma unroll
            for (int m = 0; m < 4; ++m) {
                float ss = 0.f;
#pragma unroll
                for (int bj = 0; bj < 2; ++bj)
#pragma unroll
                    for (int n = 0; n < 2; ++n) { const f32x4 x = acc[ai][bj][m][n]; ss += (x[0] * x[0] + x[1] * x[1]) + (x[2] * x[2] + x[3] * x[3]); }
                ss += __shfl_xor(ss, 16); ss += __shfl_xor(ss, 32); ss *= ascale * ascale;
                const bool isq = LAYER == 0 ? (gi == 0 || gi == 2) : (gi == 0);
                const float rs = ascale * (gi >= 0 ? (isq ? qscale : 1.f) / sqrtf(ss * (1.f / 64.f) + RMS_EPS) : 1.f);
                bf16* rowp = base + (size_t)(ai * HALF + m * 16) * ldo;
#pragma unroll
                for (int bj = 0; bj < 2; ++bj) { const f32x4 v0 = acc[ai][bj][m][0] * rs * gv[bj][0], v1 = acc[ai][bj][m][1] * rs * gv[bj][1];
                    u32x4 w; w.x = cvt_pk_bf16(v0[0], v0[1]); w.y = cvt_pk_bf16(v0[2], v0[3]); w.z = cvt_pk_bf16(v1[0], v1[1]); w.w = cvt_pk_bf16(v1[2], v1[3]);
                    *(u32x4*)(rowp + 32 * bj) = w; }
            }
    }
};
struct EpiOut {
    static constexpr bool PERM = false;
    const float* xin; const float* gm; float* X1;
    __device__ __forceinline__ void operator()(const f32x4 (&acc)[2][2][4][2], const Unit& u, int wr, int wc, int fr, int fq) const {
        const int col0 = u.pn * BM + wc * 32 + 4 * fq; const float* g = gm + (size_t)(u.row0 / T) * 6 * D + col0;
        f32x4 gv[2][2];
#pragma unroll
        for (int bj = 0; bj < 2; ++bj)
#pragma unroll
            for (int n = 0; n < 2; ++n) gv[bj][n] = *(const f32x4*)(g + bj * HALF + n * 16);
#pragma unroll
        for (int ai = 0; ai < 2; ++ai)
#pragma unroll
            for (int m = 0; m < 4; ++m) { const size_t off = (size_t)(u.row0 + wr * 64 + fr + ai * HALF + m * 16) * D + col0;
#pragma unroll
                for (int bj = 0; bj < 2; ++bj)
#pragma unroll
                    for (int n = 0; n < 2; ++n) *(f32x4*)(X1 + off + bj * HALF + n * 16) = *(const f32x4*)(xin + off + bj * HALF + n * 16) + gv[bj][n] * acc[ai][bj][m][n]; }
    }
};

template <bool XIN_BF16> struct EpiOutB {
    static constexpr bool PERM = true;
    const void* xin; const float* gm; bf16* X1b;
    __device__ __forceinline__ void operator()(const f32x4 (&acc)[2][2][4][2], const Unit& u, int wr, int wc, int fr, int fq) const {
        const int col0 = u.pn * BM + wc * 32 + 8 * fq; const float* g = gm + (size_t)(u.row0 / T) * 6 * D + col0;
        f32x4 gv[2][2];
#pragma unroll
        for (int bj = 0; bj < 2; ++bj)
#pragma unroll
            for (int n = 0; n < 2; ++n) gv[bj][n] = *(const f32x4*)(g + bj * HALF + 4 * n);
#pragma unroll
        for (int ai = 0; ai < 2; ++ai)
#pragma unroll
            for (int m = 0; m < 4; ++m) { const size_t off = (size_t)(u.row0 + wr * 64 + fr + ai * HALF + m * 16) * D + col0;
#pragma unroll
                for (int bj = 0; bj < 2; ++bj) { f32x4 x0, x1v;
                    if (XIN_BF16) { const u32x4 xw = *(const u32x4*)((const bf16*)xin + off + bj * HALF);
                        x0 = (f32x4){bf2f(xw.x & 0xffffu), bf2f(xw.x >> 16), bf2f(xw.y & 0xffffu), bf2f(xw.y >> 16)}; x1v = (f32x4){bf2f(xw.z & 0xffffu), bf2f(xw.z >> 16), bf2f(xw.w & 0xffffu), bf2f(xw.w >> 16)}; }
                    else { x0 = *(const f32x4*)((const float*)xin + off + bj * HALF); x1v = *(const f32x4*)((const float*)xin + off + bj * HALF + 4); }
                    const f32x4 v0 = x0 + gv[bj][0] * acc[ai][bj][m][0], v1 = x1v + gv[bj][1] * acc[ai][bj][m][1];
                    u32x4 w; w.x = cvt_pk_bf16(v0[0], v0[1]); w.y = cvt_pk_bf16(v0[2], v0[3]); w.z = cvt_pk_bf16(v1[0], v1[1]); w.w = cvt_pk_bf16(v1[2], v1[3]);
                    *(u32x4*)(X1b + off + bj * HALF) = w; } }
    }
};
__device__ __forceinline__ float silu_fast(float x) { return x * __builtin_amdgcn_rcpf(1.f + __builtin_amdgcn_exp2f(-1.4426950408889634f * x)); }
struct EpiUp {
    static constexpr bool PERM = true;
    bf16* ACT;
    __device__ __forceinline__ void operator()(const f32x4 (&acc)[2][2][4][2], const Unit& u, int wr, int wc, int fr, int fq) const {
        bf16* base = ACT + (size_t)(u.row0 + wr * 64 + fr) * ED + 128 * u.pn + 32 * wc + 8 * fq;
#pragma unroll
        for (int ai = 0; ai < 2; ++ai)
#pragma unroll
            for (int m = 0; m < 4; ++m) { f32x4 v[2];
#pragma unroll
                for (int n = 0; n < 2; ++n)
#pragma unroll
                    for (int i = 0; i < 4; ++i) v[n][i] = silu_fast(acc[ai][0][m][n][i]) * acc[ai][1][m][n][i];
                u32x4 w; w.x = cvt_pk_bf16(v[0][0], v[0][1]); w.y = cvt_pk_bf16(v[0][2], v[0][3]); w.z = cvt_pk_bf16(v[1][0], v[1][1]); w.w = cvt_pk_bf16(v[1][2], v[1][3]);
                *(u32x4*)(base + (size_t)(ai * HALF + m * 16) * ED) = w; }
    }
};
struct EpiDown {
    static constexpr bool PERM = true;
    bf16* Y; int orow = 0;
    __device__ __forceinline__ void operator()(const f32x4 (&acc)[2][2][4][2], const Unit& u, int wr, int wc, int fr, int fq) const {
        bf16* base = Y + (size_t)(orow + u.row0 + wr * 64 + fr) * D + u.pn * BM + wc * 32 + 8 * fq;
#pragma unroll
        for (int ai = 0; ai < 2; ++ai)
#pragma unroll
            for (int m = 0; m < 4; ++m) { bf16* rowp = base + (size_t)(ai * HALF + m * 16) * D;
#pragma unroll
                for (int bj = 0; bj < 2; ++bj) { const f32x4 v0 = acc[ai][bj][m][0], v1 = acc[ai][bj][m][1];
                    u32x4 w; w.x = cvt_pk_bf16(v0[0], v0[1]); w.y = cvt_pk_bf16(v0[2], v0[3]); w.z = cvt_pk_bf16(v1[0], v1[1]); w.w = cvt_pk_bf16(v1[2], v1[3]);
                    *(u32x4*)(rowp + bj * HALF) = w; } }
    }
};


struct EpiUp8 {
    static constexpr bool PERM = true;
    unsigned char* ACT8;
    __device__ __forceinline__ void operator()(const f32x4 (&acc)[2][2][4][2], const Unit& u, int wr, int wc, int fr, int fq) const {
        unsigned char* base = ACT8 + (size_t)(u.row0 + wr * 64 + fr) * ED + 128 * u.pn + 32 * wc + 8 * fq;
        constexpr float s = 1.f / (F8_HSCALE * F8_WSCALE);
#pragma unroll
        for (int ai = 0; ai < 2; ++ai)
#pragma unroll
            for (int m = 0; m < 4; ++m) { f32x4 v[2];
#pragma unroll
                for (int n = 0; n < 2; ++n)
#pragma unroll
                    for (int i = 0; i < 4; ++i) v[n][i] = silu_fast(acc[ai][0][m][n][i] * s) * (acc[ai][1][m][n][i] * (s * F8_ASCALE));
                u32x2 w; w.x = pk4_fp8(v[0][0], v[0][1], v[0][2], v[0][3]); w.y = pk4_fp8(v[1][0], v[1][1], v[1][2], v[1][3]);
                *(u32x2*)(base + (size_t)(ai * HALF + m * 16) * ED) = w; }
    }
};
struct EpiDown8 {
    static constexpr bool PERM = true;
    bf16* Y;
    __device__ __forceinline__ void operator()(const f32x4 (&acc)[2][2][4][2], const Unit& u, int wr, int wc, int fr, int fq) const {
#if Y_FP8
        unsigned char* base = (unsigned char*)Y + (size_t)(u.row0 + wr * 64 + fr) * D + u.pn * BM + wc * 64 + 16 * fq;
        constexpr float s = F8_YSCALE / (F8_ASCALE * F8_WSCALE);
#pragma unroll
        for (int ai = 0; ai < 2; ++ai)
#pragma unroll
            for (int m = 0; m < 4; ++m) { unsigned char* rowp = base + (size_t)(ai * HALF + m * 16) * D; u32x4 w;
#pragma unroll
                for (int bj = 0; bj < 2; ++bj) { const f32x4 v0 = acc[ai][bj][m][0] * s, v1 = acc[ai][bj][m][1] * s;
                    w[2 * bj] = pk4_fp8(v0[0], v0[1], v0[2], v0[3]); w[2 * bj + 1] = pk4_fp8(v1[0], v1[1], v1[2], v1[3]); }
                *(u32x4*)rowp = w; }
#else
        bf16* base = Y + (size_t)(u.row0 + wr * 64 + fr) * D + u.pn * BM + wc * 32 + 8 * fq;
        constexpr float s = 1.f / (F8_ASCALE * F8_WSCALE);
#pragma unroll
        for (int ai = 0; ai < 2; ++ai)
#pragma unroll
            for (int m = 0; m < 4; ++m) { bf16* rowp = base + (size_t)(ai * HALF + m * 16) * D;
#pragma unroll
                for (int bj = 0; bj < 2; ++bj) { const f32x4 v0 = acc[ai][bj][m][0] * s, v1 = acc[ai][bj][m][1] * s;
                    u32x4 w; w.x = cvt_pk_bf16(v0[0], v0[1]); w.y = cvt_pk_bf16(v0[2], v0[3]); w.z = cvt_pk_bf16(v1[0], v1[1]); w.w = cvt_pk_bf16(v1[2], v1[3]);
                    *(u32x4*)(rowp + bj * HALF) = w; } }
#endif
    }
};
__device__ __forceinline__ void glds16s(const void* sbase, unsigned voff, unsigned lds_dst) { unsigned keep;
    asm volatile("s_mov_b32 %0, m0\n\ts_mov_b32 m0, %3\n\ts_nop 0\n\tglobal_load_lds_dwordx4 %1, %2\n\ts_mov_b32 m0, %0" : "=&s"(keep) : "v"(voff), "s"(sbase), "s"(lds_dst) : "memory"); }
__device__ __forceinline__ void glds4s(const void* sbase, unsigned voff, unsigned lds_dst) { unsigned keep;
    asm volatile("s_mov_b32 %0, m0\n\ts_mov_b32 m0, %3\n\ts_nop 0\n\tglobal_load_lds_dword %1, %2\n\ts_mov_b32 m0, %0" : "=&s"(keep) : "v"(voff), "s"(sbase), "s"(lds_dst) : "memory"); }
typedef int i32x4 __attribute__((ext_vector_type(4)));
typedef int i32x8 __attribute__((ext_vector_type(8)));
__device__ __forceinline__ i32x8 cat8(bf16x8 a, bf16x8 b) { return __builtin_shufflevector(__builtin_bit_cast(i32x4, a), __builtin_bit_cast(i32x4, b), 0, 1, 2, 3, 4, 5, 6, 7); }
__device__ __forceinline__ void mfma8_inplace(f32x4& acc, i32x8 a, i32x8 b) { asm volatile("v_mfma_f32_16x16x128_f8f6f4 %0, %1, %2, %0" : "+v"(acc) : "v"(a), "v"(b)); }
template <class Epi, class Sched, bool FP8 = false>
__device__ __forceinline__ void gemm_phase(LAS unsigned char* lds, const char* Abase, const int K, const Sched& S, const Epi& E) {
    constexpr bool GATHER = Sched::GATHER;
    const int tid = threadIdx.x, wid = __builtin_amdgcn_readfirstlane(tid >> 6), lane = tid & 63, wr = wid >> 2, wc = wid & 3, fr = lane & 15, fq = lane >> 4;
    int nt = K / BK; asm volatile("" : "+s"(nt));
    int RA[2]; unsigned CA[2], voffB[2], vC[2];
#pragma unroll
    for (int i = 0; i < 2; ++i) { int R, C; stage_rc(tid * 16 + i * 8192, R, C); const int Rb = Epi::PERM ? ((R & ~31) + perm32(R & 31)) : R;
        RA[i] = R; CA[i] = (unsigned)C * 2u; voffB[i] = (unsigned)(Rb * K + C) * 2u; vC[i] = (unsigned)(R * K + C) * 2u; }
    const size_t kstep = (size_t)(BK * 2);
    const size_t hstep = (size_t)HALF * K * 2;
    const size_t ahstep = GATHER ? 0 : hstep;
    const unsigned ldsw = (unsigned)wid * 1024u;
    const unsigned lds0 = (unsigned)(uintptr_t)lds;
    const int aoff = lds_byte(wr * 64 + fr, fq * 8), boff = lds_byte(wc * 32 + fr, fq * 8);
#define PG8_SA(b, h) (((b) * 2 + (h)) * HTB)
#define PG8_SB(b, h) ((4 + (b) * 2 + (h)) * HTB)
#define PG8_STAGE(bufoff, gbase, voff) do { _Pragma("unroll") for (int _i = 0; _i < 2; ++_i) \
        glds16s((const void*)(gbase), (voff)[_i], (unsigned)__builtin_amdgcn_readfirstlane((int)(lds0 + (unsigned)(bufoff) + ldsw + (unsigned)(_i * 8192)))); } while (0)
#define PG8_STAGE_A(bufoff, gbase, h) do { if constexpr (GATHER) { PG8_STAGE(bufoff, gbase, vA[h]); } else { PG8_STAGE(bufoff, (gbase) + (h) * ahstep, vC); } } while (0)
#define PG8_LDA(dst, b, h) do { _Pragma("unroll") for (int m = 0; m < 4; ++m) _Pragma("unroll") for (int k = 0; k < 2; ++k) dst[m][k] = *(const LAS bf16x8*)(lds + PG8_SA(b, h) + aoff + m * 2048 + k * 1024); } while (0)
#define PG8_LDB(dst, b, h) do { _Pragma("unroll") for (int n = 0; n < 2; ++n) _Pragma("unroll") for (int k = 0; k < 2; ++k) dst[n][k] = *(const LAS bf16x8*)(lds + PG8_SB(b, h) + boff + n * 2048 + k * 1024); } while (0)
#define PG8_MMA(ai, bj, At, Bt) do { __builtin_amdgcn_s_setprio(1); if constexpr (FP8) { _Pragma("unroll") for (int m = 0; m < 4; ++m) _Pragma("unroll") for (int n = 0; n < 2; ++n) \
        mfma8_inplace(acc[ai][bj][m][n], cat8(Bt[n][0], Bt[n][1]), cat8(At[m][0], At[m][1])); } else { \
        _Pragma("unroll") for (int m = 0; m < 4; ++m) _Pragma("unroll") for (int n = 0; n < 2; ++n) _Pragma("unroll") for (int k = 0; k < 2; ++k) \
        acc[ai][bj][m][n] = __builtin_amdgcn_mfma_f32_16x16x32_bf16(Bt[n][k], At[m][k], acc[ai][bj][m][n], 0, 0, 0); } __builtin_amdgcn_s_setprio(0); } while (0)
#define PG8_WAIT_V(n) asm volatile("s_waitcnt vmcnt(" #n ")" ::: "memory")
#define PG8_WAIT_L(n) asm volatile("s_waitcnt lgkmcnt(0)" ::: "memory")
#define PG8_BAR __builtin_amdgcn_s_barrier()
#define PG8_SCHED __builtin_amdgcn_sched_barrier(0)
#define PG8_SETOFF(vo, u) do { _Pragma("unroll") for (int _h = 0; _h < 2; ++_h) _Pragma("unroll") for (int _i = 0; _i < 2; ++_i) vo[_h][_i] = S.arow_off(u, _h * HALF + RA[_i]) + CA[_i]; } while (0)
    Unit cur, nxt; int ui = 0;
    if (!S.next(0, cur)) return;
    f32x4 acc[2][2][4][2];
#pragma unroll
    for (int a = 0; a < 2; ++a)
#pragma unroll
        for (int b = 0; b < 2; ++b)
#pragma unroll
            for (int m = 0; m < 4; ++m)
#pragma unroll
                for (int n = 0; n < 2; ++n) acc[a][b][m][n] = (f32x4){0.f, 0.f, 0.f, 0.f};
    bf16x8 At[4][2], B0[2][2], B1[2][2];
    unsigned vA[2][2];
    LAS int* gidx = (LAS int*)(lds + STAGE_BYTES);
#define PG8_IDX_DMA(u) do { if (wid < 4) glds4s((const void*)(S.slot_tok + (u).row0), (unsigned)((wid * 64 + lane) * 4), (unsigned)__builtin_amdgcn_readfirstlane((int)(lds0 + (unsigned)STAGE_BYTES + (unsigned)wid * 256u))); } while (0)
#define PG8_IDX_READ() do { _Pragma("unroll") for (int _h = 0; _h < 2; ++_h) _Pragma("unroll") for (int _i = 0; _i < 2; ++_i) vA[_h][_i] = (unsigned)gidx[_h * HALF + RA[_i]] * (unsigned)(K * 2) + CA[_i]; } while (0)
    if constexpr (GATHER) { PG8_IDX_DMA(cur); asm volatile("s_waitcnt vmcnt(0)" ::: "memory"); __builtin_amdgcn_s_barrier(); asm volatile("" ::: "memory"); PG8_IDX_READ();
        asm volatile("s_waitcnt lgkmcnt(0)" ::: "memory"); __builtin_amdgcn_s_barrier(); asm volatile("" ::: "memory"); }
    const char* cA = GATHER ? Abase : Abase + (size_t)cur.row0 * K * 2;
    const char* cB = cur.Bp;
    PG8_STAGE(PG8_SB(0, 0), cB, voffB); PG8_STAGE(PG8_SB(0, 1), cB + hstep, voffB); PG8_STAGE_A(PG8_SA(0, 0), cA, 0); PG8_STAGE_A(PG8_SA(0, 1), cA, 1);
    if (wr == 1) PG8_BAR;
    PG8_WAIT_V(2); PG8_BAR;
    PG8_STAGE(PG8_SB(1, 0), cB + kstep, voffB); PG8_STAGE_A(PG8_SA(1, 0), cA + kstep, 0); PG8_STAGE(PG8_SB(1, 1), cB + hstep + kstep, voffB);
    PG8_WAIT_V(6); PG8_BAR;
    for (;;) {
        const bool has_next = S.next(ui + 1, nxt);
        if constexpr (GATHER) { if (has_next) PG8_IDX_DMA(nxt); }
        const char* nA = GATHER ? Abase : (has_next ? Abase + (size_t)nxt.row0 * K * 2 : cA);
        const char* nB = has_next ? nxt.Bp : cB;
#pragma unroll 1
        for (int t = 0; t < nt; t += 2) {
            const bool last = (t == nt - 2);
            const char* a1 = cA + (size_t)(t + 1) * kstep;
            const char* a2 = last ? nA : cA + (size_t)(t + 2) * kstep; const char* b2 = last ? nB : cB + (size_t)(t + 2) * kstep;
            const char* a3 = a2 + kstep; const char* b3 = b2 + kstep;
            PG8_LDB(B0, 0, 0); PG8_LDB(B1, 0, 1); PG8_SCHED; PG8_LDA(At, 0, 0); PG8_STAGE_A(PG8_SA(1, 1), a1, 1);
            if constexpr (GATHER) { if (last && has_next) PG8_IDX_READ(); }
            PG8_WAIT_V(8); PG8_WAIT_L(0); PG8_BAR; PG8_MMA(0, 0, At, B0); PG8_MMA(0, 1, At, B1); PG8_BAR; PG8_SCHED;
            PG8_LDA(At, 0, 1); PG8_STAGE(PG8_SB(0, 0), b2, voffB); PG8_STAGE(PG8_SB(0, 1), b2 + hstep, voffB); PG8_STAGE_A(PG8_SA(0, 0), a2, 0);
            PG8_WAIT_V(8); PG8_WAIT_L(0); PG8_BAR; PG8_MMA(1, 0, At, B0); PG8_MMA(1, 1, At, B1); PG8_BAR; PG8_SCHED;
            PG8_LDB(B0, 1, 0); PG8_LDB(B1, 1, 1); PG8_SCHED; PG8_LDA(At, 1, 0); PG8_STAGE_A(PG8_SA(0, 1), a2, 1);
            PG8_WAIT_V(8); PG8_WAIT_L(0); PG8_BAR; PG8_MMA(0, 0, At, B0); PG8_MMA(0, 1, At, B1); PG8_BAR; PG8_SCHED;
            PG8_LDA(At, 1, 1); PG8_STAGE(PG8_SB(1, 0), b3, voffB); PG8_STAGE(PG8_SB(1, 1), b3 + hstep, voffB); PG8_STAGE_A(PG8_SA(1, 0), a3, 0);
            PG8_WAIT_V(8); PG8_WAIT_L(0); PG8_BAR; PG8_MMA(1, 0, At, B0); PG8_MMA(1, 1, At, B1); PG8_BAR; PG8_SCHED;
        }
        if (wr == 0) PG8_BAR;
        if constexpr (FP8) asm volatile("s_nop 15\n\ts_nop 15" ::: "memory");
        E(acc, cur, wr, wc, fr, fq);
        if (!has_next) break;
#pragma unroll
        for (int a = 0; a < 2; ++a)
#pragma unroll
            for (int b = 0; b < 2; ++b)
#pragma unroll
                for (int m = 0; m < 4; ++m)
#pragma unroll
                    for (int n = 0; n < 2; ++n) acc[a][b][m][n] = (f32x4){0.f, 0.f, 0.f, 0.f};
        cur = nxt; cA = nA; cB = nB; ++ui;
        if (wr == 1) PG8_BAR;
    }
    PG8_WAIT_V(0);
    PG8_BAR;
#undef PG8_SA
#undef PG8_SB
#undef PG8_STAGE
#undef PG8_STAGE_A
#undef PG8_LDA
#undef PG8_LDB
#undef PG8_MMA
#undef PG8_WAIT_V
#undef PG8_WAIT_L
#undef PG8_BAR
#undef PG8_SCHED
#undef PG8_SETOFF
#undef PG8_IDX_DMA
#undef PG8_IDX_READ
}
}

namespace att {
using bf16=unsigned short;
using bf16x8=__attribute__((ext_vector_type(8)))short;
using s16x4=__attribute__((ext_vector_type(4)))short;
using f32x16=__attribute__((ext_vector_type(16)))float;
using u32x4=__attribute__((ext_vector_type(4)))unsigned;
constexpr int NW=8,QBLK=32,QB=QBLK*NW,KVBLK=64;
__device__ __forceinline__ int crow(int r,int hi){return (r&3)+8*(r>>2)+4*hi;}
#define SBAR() __builtin_amdgcn_sched_barrier(0)
constexpr int NSLOT=6, SLOTB=8192;
constexpr int LDS_K=0, LDS_V=NSLOT*SLOTB, LDS_WS=2*NSLOT*SLOTB, LDS_OST=LDS_WS+NW*64*4, LDS_BYTES=LDS_OST+NW*4096;
constexpr float C2=0.125f*1.4426950408889634f;
__device__ __forceinline__ void glds16(const void*sbase,unsigned voff,unsigned lds_dst){unsigned keep;
  asm volatile("s_mov_b32 %0, m0\n\ts_mov_b32 m0, %3\n\ts_nop 0\n\tglobal_load_lds_dwordx4 %1, %2\n\ts_mov_b32 m0, %0":"=&s"(keep):"v"(voff),"s"(sbase),"s"(lds_dst):"memory");}
__device__ __forceinline__ float max3f(float a,float b,float c){float r;asm("v_max3_f32 %0, %1, %2, %3":"=v"(r):"v"(a),"v"(b),"v"(c));return r;}
__device__ __forceinline__ float max2f(float a,float b){float r;asm("v_max_f32_e32 %0, %1, %2":"=v"(r):"v"(a),"v"(b));return r;}
__device__ __forceinline__ float fsub_s(float a,float b){float r;asm("v_sub_f32_e32 %0, %1, %2":"=v"(r):"v"(a),"v"(b));return r;}
typedef float f32x2_t __attribute__((ext_vector_type(2))); typedef __bf16 bf16x2_t __attribute__((ext_vector_type(2)));
__device__ __forceinline__ unsigned cvtpk_s(float lo,float hi){f32x2_t v={lo,hi};bf16x2_t b=__builtin_convertvector(v,bf16x2_t);return __builtin_bit_cast(unsigned,b);}
#define WAIT_BAR(N) asm volatile("s_waitcnt vmcnt(" #N ") lgkmcnt(0)\n\ts_barrier":::"memory")
typedef __attribute__((address_space(3))) const char* lds_cptr;
typedef short v4i16_t __attribute__((ext_vector_type(4)));
__device__ __forceinline__ void kload8(bf16x8*kf,lds_cptr kp,int bo){
  #pragma unroll
  for(int d0=0;d0<4;++d0){ const lds_cptr p=kp+((d0*32)^bo); kf[2*d0]=*(const __attribute__((address_space(3))) bf16x8*)(p); kf[2*d0+1]=*(const __attribute__((address_space(3))) bf16x8*)(p+4096); }
}
__device__ __forceinline__ void kload2(bf16x8*kf,lds_cptr kp,int j,int bo){ const lds_cptr p=kp+((j*32)^bo); kf[2*j]=*(const __attribute__((address_space(3))) bf16x8*)(p); kf[2*j+1]=*(const __attribute__((address_space(3))) bf16x8*)(p+4096); }
__device__ __forceinline__ s16x4 vtr(lds_cptr p){ return __builtin_bit_cast(s16x4,__builtin_amdgcn_ds_read_tr16_b64_v4i16((__attribute__((address_space(3))) v4i16_t*)p)); }
__device__ __forceinline__ float rowmax(const f32x16&p0,const f32x16&p1){
  float a=max3f(p0[0],p0[1],p1[0]),b=max3f(p0[2],p0[3],p1[1]);a=max3f(a,p1[2],p1[3]);
  #pragma unroll
  for(int r=4;r<16;r+=4){a=max3f(a,p0[r],p0[r+1]);b=max3f(b,p0[r+2],p0[r+3]);a=max3f(a,p1[r],p1[r+1]);b=max3f(b,p1[r+2],p1[r+3]);}
  const float m=max2f(a,b);
  auto rr=__builtin_amdgcn_permlane32_swap(__float_as_uint(m),__float_as_uint(m),false,false);
  return max2f(__uint_as_float(rr[0]),__uint_as_float(rr[1]));
}
__device__ __forceinline__ void pv(f32x16*o,int vb,bf16x8 pa0,bf16x8 pa1,bf16x8 pa2,bf16x8 pa3){
  #pragma unroll
  for(int d0=0;d0<2;++d0){s16x4 lo[4],hi[4];
    #pragma unroll
    for(int ks=0;ks<4;++ks){
      asm volatile("ds_read_b64_tr_b16 %0,%1 offset:%c2":"=&v"(lo[ks]):"v"(vb),"i"(d0*4096+ks*1024):"memory");
      asm volatile("ds_read_b64_tr_b16 %0,%1 offset:%c2":"=&v"(hi[ks]):"v"(vb),"i"(d0*4096+ks*1024+512):"memory");}
    asm volatile("s_waitcnt lgkmcnt(0)":::"memory");SBAR();
    #define PK(k) (bf16x8){lo[k][0],lo[k][1],lo[k][2],lo[k][3],hi[k][0],hi[k][1],hi[k][2],hi[k][3]}
    o[d0]=__builtin_amdgcn_mfma_f32_32x32x16_bf16(pa0,PK(0),o[d0],0,0,0);
    o[d0]=__builtin_amdgcn_mfma_f32_32x32x16_bf16(pa1,PK(1),o[d0],0,0,0);
    o[d0]=__builtin_amdgcn_mfma_f32_32x32x16_bf16(pa2,PK(2),o[d0],0,0,0);
    o[d0]=__builtin_amdgcn_mfma_f32_32x32x16_bf16(pa3,PK(3),o[d0],0,0,0);
    #undef PK
  }
}
template<int W> __device__ __forceinline__ void wmask(f32x16&p0,f32x16&p1,int d,float NEG){
  asm volatile("":"+v"(d));
  #pragma unroll
  for(int r=0;r<16;++r){const int c=(r&3)+8*(r>>2);
    if(W==0x7fffffff){ if(d<c)p0[r]=NEG; if(d<c+32)p1[r]=NEG; }
    else{ if((unsigned)(d-c)>(unsigned)W)p0[r]=NEG; if((unsigned)(d-c-32)>(unsigned)W)p1[r]=NEG; } }
}
struct UnitDesc {
  const bf16* Q; long qs;
  const bf16* K; long ks;
  const bf16* V; long vs;
  bf16* O; long os;
  float* lse; long lses;
  int NT;
  int rel0;
  int tg0;
  int q0;
  float slope2;
  float sink2;
  int fin;
  float lam, lam1;
  const float* sg; bf16* Of;
};
template<int MODE,int THRL,int DIL,int OS> __device__ __forceinline__ void attn_unit(const UnitDesc&u,char*shm){
  constexpr int W=(MODE==0)?0x7fffffff:(MODE==1?128:127);
  const float NEG=(MODE==0)?-INFINITY:-1024.f;
  int tid=threadIdx.x; asm volatile("":"+v"(tid));
  const int lane=tid&63,r32=lane&31,hi=lane>>5; const int wid=__builtin_amdgcn_readfirstlane(tid>>6);
  constexpr long qs=64L*DIL,ks=64L*DIL,vs=64L*DIL;
  const bf16*Qw=u.Q+(long)(wid*QBLK)*qs;
  const unsigned lds0=(unsigned)(uintptr_t)shm;
  __attribute__((address_space(3))) float*wsf=(__attribute__((address_space(3))) float*)((__attribute__((address_space(3))) char*)shm+LDS_WS)+wid*64;
  const unsigned ksoff=(unsigned)(((long)(8*wid+(lane>>3))*ks+(((lane&7)^(lane>>3))*8))*2);
  const unsigned vsoff=(unsigned)(((long)(16*(wid&3)+(lane>>2))*vs+(wid>>2)*32+(lane&3)*8)*2);
  const unsigned kdst=lds0+LDS_K+wid*1024, vdst=lds0+LDS_V+wid*1024;
  #define DMA_K(t,slot) glds16(u.K+(long)(t)*KVBLK*ks,ksoff,(unsigned)__builtin_amdgcn_readfirstlane(kdst+(slot)))
  #define DMA_V(t,slot) glds16(u.V+(long)(t)*KVBLK*vs,vsoff,(unsigned)__builtin_amdgcn_readfirstlane(vdst+(slot)))
  bf16x8 kf[8];
  const lds_cptr shm3=(lds_cptr)shm; const lds_cptr kp0=shm3+LDS_K+r32*128+((hi^(r32&1))*16); const int kbo=((r32>>1)&3)<<5; const lds_cptr vp0=shm3+LDS_V+((lane>>4)&1)*32+(lane&3)*8+(4*hi+((lane&15)>>2))*64;
  const int NT=u.NT;
  if(MODE==0){DMA_K(0,0);DMA_V(0,0);DMA_K(1,SLOTB);} else {DMA_K(0,0);}
  bf16x8 qr[4];
  #pragma unroll
  for(int d0=0;d0<4;++d0)qr[d0]=*reinterpret_cast<const bf16x8*>(&Qw[(long)r32*qs+d0*16+hi*8]);
  const unsigned s2hb=__float_as_uint(u.slope2)&0xffff0000u; const float s2hf=__uint_as_float(s2hb);
  const unsigned s2lb=__float_as_uint(u.slope2-s2hf)&0xffff0000u; const float s2used=s2hf+__uint_as_float(s2lb);
  u32x4 qx; qx[0]=hi?0u:((__float_as_uint(64.f*s2hf)>>16)|(__float_as_uint(64.f*__uint_as_float(s2lb))&0xffff0000u)); qx[1]=hi?0u:((s2hb>>16)|s2lb); qx[2]=0u; qx[3]=0u;
  u32x4 kx0; unsigned jp0,jp1; { const unsigned j0=__float_as_uint((float)r32)>>16, j1=__float_as_uint((float)(r32+32))>>16; jp0=j0|(j0<<16); jp1=j1|(j1<<16);
    kx0[0]=0u; kx0[1]=jp0; kx0[2]=0x3f803f80u; kx0[3]=0u; }
  #define SETTG(t) do{ const unsigned tb_=__float_as_uint((float)(u.tg0+(t)))>>16; kx0[0]=(tb_|(tb_<<16)); }while(0)
  #define KX0 __builtin_bit_cast(bf16x8,kx0)
  #define QX __builtin_bit_cast(bf16x8,qx)
  #define SETREF(m_) do{ const unsigned hb_=__float_as_uint(m_)&0xffff0000u; const float hf_=__uint_as_float(hb_); const unsigned lb_=__float_as_uint((m_)-hf_)&0xffff0000u; \
      mhat=hf_+__uint_as_float(lb_); qx[2]=hi?0u:(((hb_^0x80000000u)>>16)|(lb_^0x80000000u)); }while(0)
  float mhat=0.f,l_reg=0.f;f32x16 o[2];o[0]=f32x16{};o[1]=f32x16{};
  const int qrel=u.rel0+wid*QBLK+r32-4*hi;
  #define CMASK(P0,P1,t) do{ if(MODE!=0||(t)>=NT-4) wmask<W>(P0,P1,qrel-64*(t),NEG); }while(0)
  bool resc=false;
  f32x16 pA0,pA1,pB0,pB1;
  int sl_prev=0,sl_cur=0,sl_next=SLOTB;
  #define ROT() do{sl_prev=sl_cur;sl_cur=sl_next;sl_next=(sl_next==(NSLOT-1)*SLOTB)?0:sl_next+SLOTB;}while(0)
  #define RESC() do{ if(resc){ asm volatile("s_waitcnt lgkmcnt(0)":::"memory"); \
      _Pragma("unroll") for(int d_=0;d_<2;++d_) _Pragma("unroll") for(int r=0;r<16;++r)o[d_][r]*=wsf[crow(r,hi)]; } }while(0)
  if(MODE==0){ DMA_K(2,2*SLOTB); WAIT_BAR(3); }
  else{ DMA_K(1,SLOTB);DMA_V(0,0);DMA_K(2,2*SLOTB);DMA_V(1,SLOTB);DMA_K(3,3*SLOTB);DMA_V(2,2*SLOTB);DMA_V(3,3*SLOTB);
    if(NT>4){DMA_K(4,4*SLOTB);DMA_K(5,5*SLOTB);DMA_V(4,4*SLOTB);DMA_V(5,5*SLOTB);}
    WAIT_BAR(0); }
  { SETTG(0); const f32x16 z=f32x16{}; const lds_cptr kb=kp0;
    #pragma unroll
    for(int d0=0;d0<4;++d0){
      const bf16x8 b0=*(const __attribute__((address_space(3))) bf16x8*)(kb+((d0*32)^kbo));
      const bf16x8 b1=*(const __attribute__((address_space(3))) bf16x8*)(kb+((d0*32)^kbo)+4096);
      if(d0==0){pA0=__builtin_amdgcn_mfma_f32_32x32x16_bf16(b0,qr[0],z,0,0,0);pA1=__builtin_amdgcn_mfma_f32_32x32x16_bf16(b1,qr[0],z,0,0,0);}
      else{pA0=__builtin_amdgcn_mfma_f32_32x32x16_bf16(b0,qr[d0],pA0,0,0,0);pA1=__builtin_amdgcn_mfma_f32_32x32x16_bf16(b1,qr[d0],pA1,0,0,0);}}
    pA0=__builtin_amdgcn_mfma_f32_32x32x16_bf16(KX0,QX,pA0,0,0,0); kx0[1]=jp1; pA1=__builtin_amdgcn_mfma_f32_32x32x16_bf16(KX0,QX,pA1,0,0,0); kx0[1]=jp0; }
  asm volatile("s_nop 15\n\ts_nop 7":"+v"(pA0),"+v"(pA1));CMASK(pA0,pA1,0);
  { const float rm=rowmax(pA0,pA1); SETREF(rm); const float dl=mhat;
    _Pragma("unroll") for(int r=0;r<16;++r){pA0[r]=fsub_s(pA0[r],dl);pA1[r]=fsub_s(pA1[r],dl);}
    _Pragma("unroll") for(int r=0;r<16;++r)pA0[r]=__builtin_amdgcn_exp2f(pA0[r]); }
  _Pragma("unroll") for(int r=0;r<16;++r)pA1[r]=__builtin_amdgcn_exp2f(pA1[r]);
  if(MODE==0){ WAIT_BAR(0); DMA_K(3,0);DMA_V(1,SLOTB); }
  ROT();
  kload8(kf,kp0+sl_cur,kbo);
  if(MODE==0){ WAIT_BAR(2); }
  s16x4 vlo[8],vhi[8]; u32x4 pw0,pw1,pw2,pw3;
  #define PKW(P,B) cvtpk_s(P[B],P[B+1])
  #define PAF(k) __builtin_bit_cast(bf16x8,pw##k)
  #define VFR(i) (bf16x8){vlo[i][0],vlo[i][1],vlo[i][2],vlo[i][3],vhi[i][0],vhi[i][1],vhi[i][2],vhi[i][3]}
  #define PIN(x) asm volatile("":"+v"(x))
  #define MX3(a,b,c) __builtin_fmaxf(__builtin_fmaxf((a),(b)),(c))
  #define GAPA(MF,A0,A1,A2,A3,W0,W1,PW) do{ MF; sacc+=A0; sacc+=A1; sacc+=A2; sacc+=A3; PIN(sacc); W0; W1; PIN(PW); SBAR(); }while(0)
  #define EX(v) __builtin_amdgcn_exp2f(v)
  #define GAPB(MF,X,B) do{ MF; X[B]=EX(X[B]); X[B+1]=EX(X[B+1]); X[B+2]=EX(X[B+2]); X[B+3]=EX(X[B+3]); PIN(X); SBAR(); }while(0)
  #define VRD(i) do{ vlo[i]=vtr(vp_+(((i)>>2)*4096+((i)&3)*1024)); vhi[i]=vtr(vp_+(((i)>>2)*4096+((i)&3)*1024+512)); }while(0)
  #define KRD(G,j) do{ if(G){ kload2(kf,kp0+sl_next,j,kbo); SBAR(); } }while(0)
  #define STEP(C0,C1,P0,P1,t,GK,GV,GL) do{ SBAR(); SETTG(t); const f32x16 z_=f32x16{}; \
    const lds_cptr vp_=vp0+sl_prev; \
    VRD(0); SBAR(); float sacc=(P0[0]+P0[1]); \
    GAPA(C0=__builtin_amdgcn_mfma_f32_32x32x16_bf16(kf[0],qr[0],z_,0,0,0), P0[2],P0[3],P0[4],P0[5],     pw0[0]=PKW(P0,0), pw0[1]=PKW(P0,2), pw0); \
    VRD(4); SBAR(); GAPA(C1=__builtin_amdgcn_mfma_f32_32x32x16_bf16(kf[1],qr[0],z_,0,0,0), P0[6],P0[7],P0[8],P0[9],     pw0[2]=PKW(P0,4), pw0[3]=PKW(P0,6), pw0); \
    VRD(1); SBAR(); GAPA(C0=__builtin_amdgcn_mfma_f32_32x32x16_bf16(kf[2],qr[1],C0,0,0,0),   P0[10],P0[11],P0[12],P0[13], pw1[0]=PKW(P0,8), pw1[1]=PKW(P0,10), pw1); \
    VRD(5); SBAR(); GAPA(C1=__builtin_amdgcn_mfma_f32_32x32x16_bf16(kf[3],qr[1],C1,0,0,0),   P0[14],P0[15],P1[0],P1[1],   pw1[2]=PKW(P0,12),pw1[3]=PKW(P0,14), pw1); \
    VRD(2); SBAR(); GAPA(C0=__builtin_amdgcn_mfma_f32_32x32x16_bf16(kf[4],qr[2],C0,0,0,0),   P1[2],P1[3],P1[4],P1[5],     pw2[0]=PKW(P1,0), pw2[1]=PKW(P1,2), pw2); \
    VRD(6); SBAR(); GAPA(C1=__builtin_amdgcn_mfma_f32_32x32x16_bf16(kf[5],qr[2],C1,0,0,0),   P1[6],P1[7],P1[8],P1[9],     pw2[2]=PKW(P1,4), pw2[3]=PKW(P1,6), pw2); \
    VRD(3); SBAR(); GAPA(C0=__builtin_amdgcn_mfma_f32_32x32x16_bf16(kf[6],qr[3],C0,0,0,0),   P1[10],P1[11],P1[12],P1[13], pw3[0]=PKW(P1,8), pw3[1]=PKW(P1,10), pw3); \
    VRD(7); SBAR(); GAPA(C1=__builtin_amdgcn_mfma_f32_32x32x16_bf16(kf[7],qr[3],C1,0,0,0),   P1[14],P1[15],0.f,0.f,       pw3[2]=PKW(P1,12),pw3[3]=PKW(P1,14), pw3); \
    C0=__builtin_amdgcn_mfma_f32_32x32x16_bf16(KX0,QX,C0,0,0,0); kx0[1]=jp1; C1=__builtin_amdgcn_mfma_f32_32x32x16_bf16(KX0,QX,C1,0,0,0); kx0[1]=jp0; SBAR(); \
    l_reg+=sacc; \
    if(GK){DMA_K((t)+3,sl_cur);} if(GV){DMA_V((t)+1,sl_next);} \
    CMASK(C0,C1,t); \
    { float a=MX3(C0[0],C0[1],C1[0]),b=MX3(C0[2],C0[3],C1[1]); a=MX3(a,C1[2],C1[3]); \
      _Pragma("unroll") for(int r=4;r<16;r+=4){a=MX3(a,C0[r],C0[r+1]);b=MX3(b,C0[r+2],C0[r+3]);a=MX3(a,C1[r],C1[r+1]);b=MX3(b,C1[r+2],C1[r+3]);} \
      float rm=__builtin_fmaxf(a,b); { auto rr=__builtin_amdgcn_permlane32_swap(__float_as_uint(rm),__float_as_uint(rm),false,false); rm=__builtin_fmaxf(__uint_as_float(rr[0]),__uint_as_float(rr[1])); } \
      resc=false; \
      if(__builtin_expect(__any(rm>(float)THRL),0)){ const float mold=mhat; const float mnew=mold+__builtin_fmaxf(rm,0.f); SETREF(mnew); const float dl=mhat-mold; \
        _Pragma("unroll") for(int r=0;r<16;++r){C0[r]-=dl;C1[r]-=dl;} \
        const float f=__builtin_amdgcn_exp2f(-dl); l_reg*=f; if(hi==0)wsf[r32]=f; resc=true; } } \
    SBAR(); \
    GAPB(o[0]=__builtin_amdgcn_mfma_f32_32x32x16_bf16(PAF(0),VFR(0),o[0],0,0,0), C0,0); \
    GAPB(o[1]=__builtin_amdgcn_mfma_f32_32x32x16_bf16(PAF(0),VFR(4),o[1],0,0,0), C0,4); \
    KRD(GL,0); GAPB(o[0]=__builtin_amdgcn_mfma_f32_32x32x16_bf16(PAF(1),VFR(1),o[0],0,0,0), C0,8); \
    KRD(GL,1); GAPB(o[1]=__builtin_amdgcn_mfma_f32_32x32x16_bf16(PAF(1),VFR(5),o[1],0,0,0), C0,12); \
    KRD(GL,2); GAPB(o[0]=__builtin_amdgcn_mfma_f32_32x32x16_bf16(PAF(2),VFR(2),o[0],0,0,0), C1,0); \
    KRD(GL,3); GAPB(o[1]=__builtin_amdgcn_mfma_f32_32x32x16_bf16(PAF(2),VFR(6),o[1],0,0,0), C1,4); \
    GAPB(o[0]=__builtin_amdgcn_mfma_f32_32x32x16_bf16(PAF(3),VFR(3),o[0],0,0,0), C1,8); \
    GAPB(o[1]=__builtin_amdgcn_mfma_f32_32x32x16_bf16(PAF(3),VFR(7),o[1],0,0,0), C1,12); \
    }while(0)
  int t=1;
  if(MODE==0){
    #undef CMASK
    #define CMASK(P0,P1,t) do{}while(0)
    for(;t+5<NT;t+=2){
      STEP(pB0,pB1,pA0,pA1,t,true,true,true);     WAIT_BAR(2); RESC(); ROT();
      STEP(pA0,pA1,pB0,pB1,t+1,true,true,true);   WAIT_BAR(2); RESC(); ROT();
    }
    #undef CMASK
    #define CMASK(P0,P1,t) do{ if(MODE!=0||(t)>=NT-4) wmask<W>(P0,P1,qrel-64*(t),NEG); }while(0)
  }
  #define ENDW(tt) do{ if(MODE==0){ if((tt)+3<NT){WAIT_BAR(2);} else if((tt)+2<NT){WAIT_BAR(1);} else {WAIT_BAR(0);} } }while(0)
  for(;t+1<NT;t+=2){
    STEP(pB0,pB1,pA0,pA1,t,(MODE==0&&t+3<NT),(MODE==0&&t+1<NT),(t+1<NT));       ENDW(t);   RESC(); ROT();
    STEP(pA0,pA1,pB0,pB1,t+1,(MODE==0&&t+4<NT),(MODE==0&&t+2<NT),(t+2<NT));     ENDW(t+1); RESC(); ROT();
  }
  STEP(pB0,pB1,pA0,pA1,NT-1,false,false,false); RESC();
  { float sacc=pB0[0]+pB0[1]; _Pragma("unroll") for(int r=2;r<16;++r)sacc+=pB0[r]; _Pragma("unroll") for(int r=0;r<16;++r)sacc+=pB1[r]; l_reg+=sacc;
    pw0=(u32x4){PKW(pB0,0),PKW(pB0,2),PKW(pB0,4),PKW(pB0,6)};pw1=(u32x4){PKW(pB0,8),PKW(pB0,10),PKW(pB0,12),PKW(pB0,14)};pw2=(u32x4){PKW(pB1,0),PKW(pB1,2),PKW(pB1,4),PKW(pB1,6)};pw3=(u32x4){PKW(pB1,8),PKW(pB1,10),PKW(pB1,12),PKW(pB1,14)};
    SBAR(); pv(o,(int)(lds0+LDS_V)+((lane>>4)&1)*32+(lane&3)*8+(4*hi+((lane&15)>>2))*64+sl_cur,PAF(0),PAF(1),PAF(2),PAF(3)); }
  #undef PKW
  #undef PAF
  #undef VFR
  #undef PIN
  #undef MX3
  #undef GAPA
  #undef GAPB
  #undef EX
  #undef VRD
  #undef KRD
  #undef STEP
  #undef ENDW
  {auto rr=__builtin_amdgcn_permlane32_swap(__float_as_uint(l_reg),__float_as_uint(l_reg),false,false);l_reg=__uint_as_float(rr[0])+__uint_as_float(rr[1]);}
  const float qposf=(float)(u.q0+wid*QBLK+r32);
  if(MODE==2) l_reg+=__builtin_amdgcn_exp2f(u.sink2+s2used*qposf-mhat);
  if(MODE==1){ if(hi==0) u.lse[(long)(wid*QBLK+r32)*(16*DIL)]=mhat-s2used*qposf+__builtin_amdgcn_logf(l_reg); }
  if(hi==0)wsf[32+r32]=l_reg;asm volatile("s_waitcnt lgkmcnt(0)":::"memory");
  float rli[16];
  #pragma unroll
  for(int r=0;r<16;++r)rli[r]=__builtin_amdgcn_rcpf(wsf[32+crow(r,hi)]);
  bf16*Ow=u.O+(long)(wid*QBLK)*OS;
  { int le=lane; asm volatile("":"+v"(le));
    const int r32e=le&31,hie=le>>5;
    __hip_bfloat16*stg=(__hip_bfloat16*)(shm+LDS_OST)+wid*2048;
    #pragma unroll
    for(int r=0;r<16;++r){const int orow=crow(r,hie);
      #pragma unroll
      for(int d0=0;d0<2;++d0)stg[orow*64+d0*32+r32e]=__float2bfloat16(o[d0][r]*rli[r]);}
    asm volatile("s_waitcnt lgkmcnt(0)":::"memory");
    #pragma unroll
    for(int i=0;i<4;++i){const int row=i*8+(le>>3),ch=le&7; const u32x4 v=*(const u32x4*)(stg+row*64+ch*8); *(u32x4*)(Ow+(long)row*OS+ch*8)=v;} }
  asm volatile("s_waitcnt lgkmcnt(0)\n\ts_barrier":::"memory");
  #undef DMA_K
  #undef DMA_V
  #undef CMASK
  #undef RESC
  #undef ROT
  #undef SETTG
  #undef SETREF
  #undef KX0
  #undef QX
}
#undef SBAR
#undef WAIT_BAR
}

namespace att128 {
using att::UnitDesc; using att::crow; using att::glds16; using att::max3f; using att::max2f; using att::fsub_s; using att::cvtpk_s; using att::kload8; using att::kload2; using att::vtr; using att::rowmax; using att::wmask; using att::lds_cptr;
using bf16=unsigned short;
using bf16x8=__attribute__((ext_vector_type(8)))short;
using s16x4=__attribute__((ext_vector_type(4)))short;
using f32x16=__attribute__((ext_vector_type(16)))float;
using u32x4=__attribute__((ext_vector_type(4)))unsigned;
constexpr int NW=8,QBLK=32,QB=QBLK*NW,KVBLK=64;
#define SBAR() __builtin_amdgcn_sched_barrier(0)
constexpr int NSLOT=3, SLOTB=8192, SLOTV=16384;
constexpr int LDS_K=0, LDS_V=NSLOT*SLOTB, LDS_WS=LDS_V+NSLOT*SLOTV, LDS_OST=LDS_WS+NW*64*4, LDS_BYTES=LDS_OST+NW*8192;
#define WAIT_BAR(N) asm volatile("s_waitcnt vmcnt(" #N ") lgkmcnt(0)\n\ts_barrier":::"memory")
__device__ __forceinline__ void pv4(f32x16*o,int vb,bf16x8 pa0,bf16x8 pa1,bf16x8 pa2,bf16x8 pa3){
  #pragma unroll
  for(int d0=0;d0<4;++d0){s16x4 lo[4],hi[4];
    #pragma unroll
    for(int ks=0;ks<4;++ks){
      asm volatile("ds_read_b64_tr_b16 %0,%1 offset:%c2":"=&v"(lo[ks]):"v"(vb),"i"(d0*4096+ks*1024):"memory");
      asm volatile("ds_read_b64_tr_b16 %0,%1 offset:%c2":"=&v"(hi[ks]):"v"(vb),"i"(d0*4096+ks*1024+512):"memory");}
    asm volatile("s_waitcnt lgkmcnt(0)":::"memory");SBAR();
    #define PK(k) (bf16x8){lo[k][0],lo[k][1],lo[k][2],lo[k][3],hi[k][0],hi[k][1],hi[k][2],hi[k][3]}
    o[d0]=__builtin_amdgcn_mfma_f32_32x32x16_bf16(pa0,PK(0),o[d0],0,0,0);
    o[d0]=__builtin_amdgcn_mfma_f32_32x32x16_bf16(pa1,PK(1),o[d0],0,0,0);
    o[d0]=__builtin_amdgcn_mfma_f32_32x32x16_bf16(pa2,PK(2),o[d0],0,0,0);
    o[d0]=__builtin_amdgcn_mfma_f32_32x32x16_bf16(pa3,PK(3),o[d0],0,0,0);
    #undef PK
  }
}
template<int MODE,int THRL,int DIL,int OS> __device__ __forceinline__ void attn_unit(const UnitDesc&u,char*shm){
  static_assert(MODE==0,"att128: causal mode only");
  constexpr int W=(MODE==0)?0x7fffffff:(MODE==1?128:127);
  const float NEG=(MODE==0)?-INFINITY:-1024.f;
  int tid=threadIdx.x; asm volatile("":"+v"(tid));
  const int lane=tid&63,r32=lane&31,hi=lane>>5; const int wid=__builtin_amdgcn_readfirstlane(tid>>6);
  constexpr long qs=64L*DIL,ks=64L*DIL,vs=64L*DIL;
  const bf16*Qw=u.Q+(long)(wid*QBLK)*qs;
  const unsigned lds0=(unsigned)(uintptr_t)shm;
  __attribute__((address_space(3))) float*wsf=(__attribute__((address_space(3))) float*)((__attribute__((address_space(3))) char*)shm+LDS_WS)+wid*64;
  const unsigned ksoff=(unsigned)(((long)(8*wid+(lane>>3))*ks+(((lane&7)^(lane>>3))*8))*2);
  const unsigned vsoff=(unsigned)(((long)(16*(wid&3)+(lane>>2))*vs+(wid>>2)*32+(lane&3)*8)*2);
  const unsigned kdst=lds0+LDS_K+wid*1024, vdst=lds0+LDS_V+wid*1024;
  #define DMA_K(t,slot) glds16(u.K+(long)(t)*KVBLK*ks,ksoff,(unsigned)__builtin_amdgcn_readfirstlane(kdst+(slot)))
  #define DMA_V(t,slot) do{ glds16(u.V+(long)(t)*KVBLK*vs,vsoff,(unsigned)__builtin_amdgcn_readfirstlane(vdst+2*(slot))); glds16(u.V+(long)(t)*KVBLK*vs+64*(long)M,vsoff,(unsigned)__builtin_amdgcn_readfirstlane(vdst+2*(slot)+8192)); }while(0)
  bf16x8 kf[8];
  const lds_cptr shm3=(lds_cptr)shm; const lds_cptr kp0=shm3+LDS_K+r32*128+((hi^(r32&1))*16); const int kbo=((r32>>1)&3)<<5; const lds_cptr vp0=shm3+LDS_V+((lane>>4)&1)*32+(lane&3)*8+(4*hi+((lane&15)>>2))*64;
  const int NT=u.NT;
  DMA_K(0,0);DMA_V(0,0);DMA_K(1,SLOTB);
  bf16x8 qr[4];
  #pragma unroll
  for(int d0=0;d0<4;++d0)qr[d0]=*reinterpret_cast<const bf16x8*>(&Qw[(long)r32*qs+d0*16+hi*8]);
  const unsigned s2hb=__float_as_uint(u.slope2)&0xffff0000u; const float s2hf=__uint_as_float(s2hb);
  const unsigned s2lb=__float_as_uint(u.slope2-s2hf)&0xffff0000u; const float s2used=s2hf+__uint_as_float(s2lb);
  u32x4 qx; qx[0]=hi?0u:((__float_as_uint(64.f*s2hf)>>16)|(__float_as_uint(64.f*__uint_as_float(s2lb))&0xffff0000u)); qx[1]=hi?0u:((s2hb>>16)|s2lb); qx[2]=0u; qx[3]=0u;
  u32x4 kx0; unsigned jp0,jp1; { const unsigned j0=__float_as_uint((float)r32)>>16, j1=__float_as_uint((float)(r32+32))>>16; jp0=j0|(j0<<16); jp1=j1|(j1<<16);
    kx0[0]=0u; kx0[1]=jp0; kx0[2]=0x3f803f80u; kx0[3]=0u; }
  #define SETTG(t) do{ const unsigned tb_=__float_as_uint((float)(u.tg0+(t)))>>16; kx0[0]=(tb_|(tb_<<16)); }while(0)
  #define KX0 __builtin_bit_cast(bf16x8,kx0)
  #define QX __builtin_bit_cast(bf16x8,qx)
  #define SETREF(m_) do{ const unsigned hb_=__float_as_uint(m_)&0xffff0000u; const float hf_=__uint_as_float(hb_); const unsigned lb_=__float_as_uint((m_)-hf_)&0xffff0000u; \
      mhat=hf_+__uint_as_float(lb_); qx[2]=hi?0u:(((hb_^0x80000000u)>>16)|(lb_^0x80000000u)); }while(0)
  float mhat=0.f,l_reg=0.f;f32x16 o[4];o[0]=f32x16{};o[1]=f32x16{};o[2]=f32x16{};o[3]=f32x16{};
  const int qrel=u.rel0+wid*QBLK+r32-4*hi;
  #define CMASK(P0,P1,t) do{ if(MODE!=0||(t)>=NT-4) wmask<W>(P0,P1,qrel-64*(t),NEG); }while(0)
  bool resc=false;
  f32x16 pA0,pA1,pB0,pB1;
  int sl_prev=0,sl_cur=0,sl_next=SLOTB;
  #define ROT() do{sl_prev=sl_cur;sl_cur=sl_next;sl_next=(sl_next==(NSLOT-1)*SLOTB)?0:sl_next+SLOTB;}while(0)
  #define RESC() do{ if(resc){ asm volatile("s_waitcnt lgkmcnt(0)":::"memory"); \
      _Pragma("unroll") for(int d_=0;d_<4;++d_) _Pragma("unroll") for(int r=0;r<16;++r)o[d_][r]*=wsf[crow(r,hi)]; } }while(0)
  DMA_K(2,2*SLOTB);
  WAIT_BAR(4);
  { SETTG(0); const f32x16 z=f32x16{}; const lds_cptr kb=kp0;
    #pragma unroll
    for(int d0=0;d0<4;++d0){
      const bf16x8 b0=*(const __attribute__((address_space(3))) bf16x8*)(kb+((d0*32)^kbo));
      const bf16x8 b1=*(const __attribute__((address_space(3))) bf16x8*)(kb+((d0*32)^kbo)+4096);
      if(d0==0){pA0=__builtin_amdgcn_mfma_f32_32x32x16_bf16(b0,qr[0],z,0,0,0);pA1=__builtin_amdgcn_mfma_f32_32x32x16_bf16(b1,qr[0],z,0,0,0);}
      else{pA0=__builtin_amdgcn_mfma_f32_32x32x16_bf16(b0,qr[d0],pA0,0,0,0);pA1=__builtin_amdgcn_mfma_f32_32x32x16_bf16(b1,qr[d0],pA1,0,0,0);}}
    pA0=__builtin_amdgcn_mfma_f32_32x32x16_bf16(KX0,QX,pA0,0,0,0); kx0[1]=jp1; pA1=__builtin_amdgcn_mfma_f32_32x32x16_bf16(KX0,QX,pA1,0,0,0); kx0[1]=jp0; }
  asm volatile("s_nop 15\n\ts_nop 7":"+v"(pA0),"+v"(pA1));CMASK(pA0,pA1,0);
  { const float rm=rowmax(pA0,pA1); SETREF(rm); const float dl=mhat;
    _Pragma("unroll") for(int r=0;r<16;++r){pA0[r]=fsub_s(pA0[r],dl);pA1[r]=fsub_s(pA1[r],dl);}
    _Pragma("unroll") for(int r=0;r<16;++r)pA0[r]=__builtin_amdgcn_exp2f(pA0[r]); }
  _Pragma("unroll") for(int r=0;r<16;++r)pA1[r]=__builtin_amdgcn_exp2f(pA1[r]);
  WAIT_BAR(0);
  DMA_K(3,0);DMA_V(1,SLOTB);
  ROT();
  kload8(kf,kp0+sl_cur,kbo);
  WAIT_BAR(3);
  s16x4 vlo[3],vhi[3]; u32x4 pw0,pw1,pw2,pw3;
  #define PKW(P,B) cvtpk_s(P[B],P[B+1])
  #define PAF(k) __builtin_bit_cast(bf16x8,pw##k)
  #define VFJ(b) (bf16x8){vlo[b][0],vlo[b][1],vlo[b][2],vlo[b][3],vhi[b][0],vhi[b][1],vhi[b][2],vhi[b][3]}
  #define PIN(x) asm volatile("":"+v"(x))
  #define MX3(a,b,c) __builtin_fmaxf(__builtin_fmaxf((a),(b)),(c))
  #define GAPA(MF,A0,A1,A2,A3,W0,W1,PW) do{ MF; sacc+=A0; sacc+=A1; sacc+=A2; sacc+=A3; PIN(sacc); W0; W1; PIN(PW); SBAR(); }while(0)
  #define EX(v) __builtin_amdgcn_exp2f(v)
  #define GAPB2(MF,X,B) do{ MF; X[B]=EX(X[B]); X[B+1]=EX(X[B+1]); PIN(X); SBAR(); }while(0)
  #define VRJ(b,n) do{ vlo[b]=vtr(vp_+(((n)&3)*4096+((n)>>2)*1024)); vhi[b]=vtr(vp_+(((n)&3)*4096+((n)>>2)*1024+512)); SBAR(); }while(0)
  #define KRD(G,j) do{ if(G){ kload2(kf,kp0+sl_next,j,kbo); SBAR(); } }while(0)
  #define STEP(C0,C1,P0,P1,t,GK,GV,GL) do{ SBAR(); SETTG(t); const f32x16 z_=f32x16{}; \
    const lds_cptr vp_=vp0+2*sl_prev; \
    float sacc=(P0[0]+P0[1]); \
    GAPA(C0=__builtin_amdgcn_mfma_f32_32x32x16_bf16(kf[0],qr[0],z_,0,0,0), P0[2],P0[3],P0[4],P0[5],     pw0[0]=PKW(P0,0), pw0[1]=PKW(P0,2), pw0); \
    GAPA(C1=__builtin_amdgcn_mfma_f32_32x32x16_bf16(kf[1],qr[0],z_,0,0,0), P0[6],P0[7],P0[8],P0[9],     pw0[2]=PKW(P0,4), pw0[3]=PKW(P0,6), pw0); \
    GAPA(C0=__builtin_amdgcn_mfma_f32_32x32x16_bf16(kf[2],qr[1],C0,0,0,0),   P0[10],P0[11],P0[12],P0[13], pw1[0]=PKW(P0,8), pw1[1]=PKW(P0,10), pw1); \
    GAPA(C1=__builtin_amdgcn_mfma_f32_32x32x16_bf16(kf[3],qr[1],C1,0,0,0),   P0[14],P0[15],P1[0],P1[1],   pw1[2]=PKW(P0,12),pw1[3]=PKW(P0,14), pw1); \
    GAPA(C0=__builtin_amdgcn_mfma_f32_32x32x16_bf16(kf[4],qr[2],C0,0,0,0),   P1[2],P1[3],P1[4],P1[5],     pw2[0]=PKW(P1,0), pw2[1]=PKW(P1,2), pw2); \
    GAPA(C1=__builtin_amdgcn_mfma_f32_32x32x16_bf16(kf[5],qr[2],C1,0,0,0),   P1[6],P1[7],P1[8],P1[9],     pw2[2]=PKW(P1,4), pw2[3]=PKW(P1,6), pw2); \
    VRJ(0,0); GAPA(C0=__builtin_amdgcn_mfma_f32_32x32x16_bf16(kf[6],qr[3],C0,0,0,0),   P1[10],P1[11],P1[12],P1[13], pw3[0]=PKW(P1,8), pw3[1]=PKW(P1,10), pw3); \
    VRJ(1,1); GAPA(C1=__builtin_amdgcn_mfma_f32_32x32x16_bf16(kf[7],qr[3],C1,0,0,0),   P1[14],P1[15],0.f,0.f,       pw3[2]=PKW(P1,12),pw3[3]=PKW(P1,14), pw3); \
    C0=__builtin_amdgcn_mfma_f32_32x32x16_bf16(KX0,QX,C0,0,0,0); kx0[1]=jp1; C1=__builtin_amdgcn_mfma_f32_32x32x16_bf16(KX0,QX,C1,0,0,0); kx0[1]=jp0; SBAR(); \
    l_reg+=sacc; \
    if(GK){DMA_K((t)+3,sl_cur);} if(GV){DMA_V((t)+1,sl_next);} \
    CMASK(C0,C1,t); \
    { float a=MX3(C0[0],C0[1],C1[0]),b=MX3(C0[2],C0[3],C1[1]); a=MX3(a,C1[2],C1[3]); \
      _Pragma("unroll") for(int r=4;r<16;r+=4){a=MX3(a,C0[r],C0[r+1]);b=MX3(b,C0[r+2],C0[r+3]);a=MX3(a,C1[r],C1[r+1]);b=MX3(b,C1[r+2],C1[r+3]);} \
      float rm=__builtin_fmaxf(a,b); { auto rr=__builtin_amdgcn_permlane32_swap(__float_as_uint(rm),__float_as_uint(rm),false,false); rm=__builtin_fmaxf(__uint_as_float(rr[0]),__uint_as_float(rr[1])); } \
      resc=false; \
      if(__builtin_expect(__any(rm>(float)THRL),0)){ const float mold=mhat; const float mnew=mold+__builtin_fmaxf(rm,0.f); SETREF(mnew); const float dl=mhat-mold; \
        _Pragma("unroll") for(int r=0;r<16;++r){C0[r]-=dl;C1[r]-=dl;} \
        const float f=__builtin_amdgcn_exp2f(-dl); l_reg*=f; if(hi==0)wsf[r32]=f; resc=true; } } \
    SBAR(); \
    VRJ(2,2);             GAPB2(o[0]=__builtin_amdgcn_mfma_f32_32x32x16_bf16(PAF(0),VFJ(0),o[0],0,0,0), C0,0); \
    VRJ(0,3);             GAPB2(o[1]=__builtin_amdgcn_mfma_f32_32x32x16_bf16(PAF(0),VFJ(1),o[1],0,0,0), C0,2); \
    VRJ(1,4);             GAPB2(o[2]=__builtin_amdgcn_mfma_f32_32x32x16_bf16(PAF(0),VFJ(2),o[2],0,0,0), C0,4); \
    VRJ(2,5);             GAPB2(o[3]=__builtin_amdgcn_mfma_f32_32x32x16_bf16(PAF(0),VFJ(0),o[3],0,0,0), C0,6); \
    VRJ(0,6);  KRD(GL,0); GAPB2(o[0]=__builtin_amdgcn_mfma_f32_32x32x16_bf16(PAF(1),VFJ(1),o[0],0,0,0), C0,8); \
    VRJ(1,7);             GAPB2(o[1]=__builtin_amdgcn_mfma_f32_32x32x16_bf16(PAF(1),VFJ(2),o[1],0,0,0), C0,10); \
    VRJ(2,8);  KRD(GL,1); GAPB2(o[2]=__builtin_amdgcn_mfma_f32_32x32x16_bf16(PAF(1),VFJ(0),o[2],0,0,0), C0,12); \
    VRJ(0,9);             GAPB2(o[3]=__builtin_amdgcn_mfma_f32_32x32x16_bf16(PAF(1),VFJ(1),o[3],0,0,0), C0,14); \
    VRJ(1,10); KRD(GL,2); GAPB2(o[0]=__builtin_amdgcn_mfma_f32_32x32x16_bf16(PAF(2),VFJ(2),o[0],0,0,0), C1,0); \
    VRJ(2,11);            GAPB2(o[1]=__builtin_amdgcn_mfma_f32_32x32x16_bf16(PAF(2),VFJ(0),o[1],0,0,0), C1,2); \
    VRJ(0,12); KRD(GL,3); GAPB2(o[2]=__builtin_amdgcn_mfma_f32_32x32x16_bf16(PAF(2),VFJ(1),o[2],0,0,0), C1,4); \
    VRJ(1,13);            GAPB2(o[3]=__builtin_amdgcn_mfma_f32_32x32x16_bf16(PAF(2),VFJ(2),o[3],0,0,0), C1,6); \
    VRJ(2,14);            GAPB2(o[0]=__builtin_amdgcn_mfma_f32_32x32x16_bf16(PAF(3),VFJ(0),o[0],0,0,0), C1,8); \
    VRJ(0,15);            GAPB2(o[1]=__builtin_amdgcn_mfma_f32_32x32x16_bf16(PAF(3),VFJ(1),o[1],0,0,0), C1,10); \
                          GAPB2(o[2]=__builtin_amdgcn_mfma_f32_32x32x16_bf16(PAF(3),VFJ(2),o[2],0,0,0), C1,12); \
                          GAPB2(o[3]=__builtin_amdgcn_mfma_f32_32x32x16_bf16(PAF(3),VFJ(0),o[3],0,0,0), C1,14); \
    }while(0)
  int t=1;
  if(MODE==0){
    #undef CMASK
    #define CMASK(P0,P1,t) do{}while(0)
    for(;t+5<NT;t+=2){
      STEP(pB0,pB1,pA0,pA1,t,true,true,true);     WAIT_BAR(3); RESC(); ROT();
      STEP(pA0,pA1,pB0,pB1,t+1,true,true,true);   WAIT_BAR(3); RESC(); ROT();
    }
    #undef CMASK
    #define CMASK(P0,P1,t) do{ if(MODE!=0||(t)>=NT-4) wmask<W>(P0,P1,qrel-64*(t),NEG); }while(0)
  }
  #define ENDW(tt) do{ if((tt)+3<NT){WAIT_BAR(3);} else if((tt)+2<NT){WAIT_BAR(2);} else {WAIT_BAR(0);} }while(0)
  for(;t+1<NT;t+=2){
    STEP(pB0,pB1,pA0,pA1,t,(t+3<NT),(t+1<NT),(t+1<NT));       ENDW(t);   RESC(); ROT();
    STEP(pA0,pA1,pB0,pB1,t+1,(t+4<NT),(t+2<NT),(t+2<NT));     ENDW(t+1); RESC(); ROT();
  }
  STEP(pB0,pB1,pA0,pA1,NT-1,false,false,false); RESC();
  { float sacc=pB0[0]+pB0[1]; _Pragma("unroll") for(int r=2;r<16;++r)sacc+=pB0[r]; _Pragma("unroll") for(int r=0;r<16;++r)sacc+=pB1[r]; l_reg+=sacc;
    pw0=(u32x4){PKW(pB0,0),PKW(pB0,2),PKW(pB0,4),PKW(pB0,6)};pw1=(u32x4){PKW(pB0,8),PKW(pB0,10),PKW(pB0,12),PKW(pB0,14)};pw2=(u32x4){PKW(pB1,0),PKW(pB1,2),PKW(pB1,4),PKW(pB1,6)};pw3=(u32x4){PKW(pB1,8),PKW(pB1,10),PKW(pB1,12),PKW(pB1,14)};
    SBAR(); pv4(o,(int)(lds0+LDS_V)+((lane>>4)&1)*32+(lane&3)*8+(4*hi+((lane&15)>>2))*64+2*sl_cur,PAF(0),PAF(1),PAF(2),PAF(3)); }
  #undef PKW
  #undef PAF
  #undef VFJ
  #undef PIN
  #undef MX3
  #undef GAPA
  #undef GAPB2
  #undef EX
  #undef VRJ
  #undef KRD
  #undef STEP
  #undef ENDW
  {auto rr=__builtin_amdgcn_permlane32_swap(__float_as_uint(l_reg),__float_as_uint(l_reg),false,false);l_reg=__uint_as_float(rr[0])+__uint_as_float(rr[1]);}
  const float qposf=(float)(u.q0+wid*QBLK+r32);
  if(MODE==2) l_reg+=__builtin_amdgcn_exp2f(u.sink2+s2used*qposf-mhat);
  if(MODE==1){ if(hi==0) u.lse[(long)(wid*QBLK+r32)*(16*DIL)]=mhat-s2used*qposf+__builtin_amdgcn_logf(l_reg); }
  if(hi==0)wsf[32+r32]=l_reg;asm volatile("s_waitcnt lgkmcnt(0)":::"memory");
  float rli[16];
  #pragma unroll
  for(int r=0;r<16;++r)rli[r]=__builtin_amdgcn_rcpf(wsf[32+crow(r,hi)]);
  { int le=lane; asm volatile("":"+v"(le));
    const int r32e=le&31,hie=le>>5;
    __hip_bfloat16*stg=(__hip_bfloat16*)(shm+LDS_OST)+wid*4096;
    if(u.fin==0){
      #pragma unroll
      for(int r=0;r<16;++r){const int orow=crow(r,hie);
        #pragma unroll
        for(int d0=0;d0<4;++d0)stg[orow*128+d0*32+r32e]=__float2bfloat16(o[d0][r]*rli[r]);}
    } else {
      const float lam=u.lam;
      #pragma unroll
      for(int r=0;r<16;++r){const int orow=crow(r,hie);
        #pragma unroll
        for(int d0=0;d0<4;++d0){ const int ix=orow*128+d0*32+r32e; const float o2=__bfloat162float(__float2bfloat16(o[d0][r]*rli[r])); stg[ix]=__float2bfloat16(__bfloat162float(stg[ix])-lam*o2); } }
      asm volatile("s_waitcnt lgkmcnt(0)":::"memory");
      const int ch=le&15; const float* sgp=u.sg+8*ch; const float g0=sgp[0],g1=sgp[1],g2=sgp[2],g3=sgp[3],g4=sgp[4],g5=sgp[5],g6=sgp[6],g7=sgp[7];
      bf16*Of=u.Of+(long)(wid*QBLK)*D+ch*8;
      #pragma unroll
      for(int i=0;i<8;++i){ const int row=i*4+(le>>4); const u32x4 v=*(const u32x4*)(stg+row*128+ch*8);
        const float x0=__uint_as_float(v[0]<<16),x1=__uint_as_float(v[0]&0xffff0000u),x2=__uint_as_float(v[1]<<16),x3=__uint_as_float(v[1]&0xffff0000u),
                    x4=__uint_as_float(v[2]<<16),x5=__uint_as_float(v[2]&0xffff0000u),x6=__uint_as_float(v[3]<<16),x7=__uint_as_float(v[3]&0xffff0000u);
        float ss=(x0*x0+x1*x1)+(x2*x2+x3*x3)+(x4*x4+x5*x5)+(x6*x6+x7*x7);
        ss+=__shfl_xor(ss,1); ss+=__shfl_xor(ss,2); ss+=__shfl_xor(ss,4); ss+=__shfl_xor(ss,8);
        const float rs=u.lam1/sqrtf(ss*(1.f/128.f)+1e-6f);
        u32x4 w; w[0]=cvtpk_s(x0*rs*g0,x1*rs*g1); w[1]=cvtpk_s(x2*rs*g2,x3*rs*g3); w[2]=cvtpk_s(x4*rs*g4,x5*rs*g5); w[3]=cvtpk_s(x6*rs*g6,x7*rs*g7);
        *(u32x4*)(Of+(long)row*D)=w; }
    } }
  asm volatile("s_waitcnt lgkmcnt(0)\n\ts_barrier":::"memory");
  #undef DMA_K
  #undef DMA_V
  #undef CMASK
  #undef RESC
  #undef ROT
  #undef SETTG
  #undef SETREF
  #undef KX0
  #undef QX
}
#undef SBAR
#undef WAIT_BAR
}

constexpr float LOG2E = 1.4426950408889634f;
__device__ __forceinline__ int vcu_of(int bx, int G) { return (G % 8 == 0) ? (bx % 8) * (G / 8) + bx / 8 : bx; }
constexpr int ATT1_LDS_TAB = 141312;
__device__ __forceinline__ void attn1_tuned_phase(const Ctx& c, const bf16* qkv, const float* qkg  , bf16* R, unsigned* qctr, const ExpertSrc& es, unsigned char* ws,
                                                  const float* lamp, const float* subln, bf16* Oout) {
    LAS int* order = (LAS int*)(c.lds + ATT1_LDS_TAB);
    LAS int* nts = order + 256;
    LAS int* t0s = nts + 256;
    volatile LAS unsigned* nextu = (volatile LAS unsigned*)(t0s + 256);
    LAS float* bnd = (LAS float*)(t0s + 256 + 4);
    const int G = gridDim.x;
    if (c.wave == 0) { float gq = fabsf(qkg[c.lane]), gk = fabsf(qkg[64 + c.lane]);
#pragma unroll
        for (int o = 1; o < 64; o <<= 1) { gq = fmaxf(gq, __shfl_xor(gq, o)); gk = fmaxf(gk, __shfl_xor(gk, o)); }
        if (c.lane == 0) bnd[0] = 8.f * gq * gk * 1.02f; }
    __syncthreads();
    if (c.tid < 256) { const int h = c.tid >> 4, qb = c.tid & 15; const float slope = exp2f(-0.5f * (float)(h + 1));
        const int dmax = (int)fminf(ceilf((2.f * bnd[0] + 25.f) / slope), 1.0e6f), lo_ = 256 * qb - dmax, t0 = lo_ <= 0 ? 0 : ((lo_ >> 6) & ~1);
        nts[c.tid] = 4 * (qb + 1) - t0; t0s[c.tid] = t0; }
    __syncthreads();
    if (c.tid < 256) { const int mine = nts[c.tid]; int rank = 0;
        for (int e = 0; e < 256; ++e) { const int o = nts[e]; rank += (o > mine || (o == mine && e < c.tid)) ? 1 : 0; }
        order[rank] = c.tid; }
    __syncthreads();
#if FUSE_FINISH
    constexpr int NCH = DEFER_CONV ? EXP_ITEMS / 65 : 0, NUNIT = NB * 16 * 16, NPOS = NUNIT + NCH;
    static_assert(!DEFER_CONV || EXP_ITEMS % 65 == 0, "chunking");
    if (c.tid == 0) { float s01 = 0.f, s23 = 0.f; for (int i = 0; i < 64; ++i) { s01 += lamp[i] * lamp[64 + i]; s23 += lamp[128 + i] * lamp[192 + i]; }
      const float li = 0.8f - 0.6f * expf(-0.3f * 1.0f); bnd[1] = expf(s01) - expf(s23) + li; bnd[2] = li; }
    __syncthreads();
    unsigned p = blockIdx.x;
    while (p < (unsigned)NPOS) {
        unsigned nreg = 0u;
        if (c.tid == 0) nreg = __hip_atomic_fetch_add(qctr, 1u, __ATOMIC_RELAXED, __HIP_MEMORY_SCOPE_AGENT) + (unsigned)G;
        const bool inter = p < (unsigned)(NCH * 2);
        if (inter && (p & 1u)) {
            expert_items_block(c, es, 1, ws, (int)(p >> 1) * 65, 65);
        } else {
#define ATT1_DECODE() const unsigned u = inter ? (p >> 1) : p - (unsigned)NCH; const int ent = order[u >> 2], h = ent >> 4, qb = ent & 15, b = (int)(u & 3u), t0 = t0s[ent]; \
            bf16* Rblk = R + ((size_t)(b * T + qb * 256) * 16 + h) * 256
#if USE_V128
#pragma unroll 1
            for (int pass = 0; pass < 2; ++pass) {
                ATT1_DECODE();
                const int i = pass; att::UnitDesc ud;
                ud.Q = qkv + ((size_t)(2 * h + i) * M + (size_t)(b * T + qb * 256)) * 64; ud.qs = 64;
                ud.K = qkv + ((size_t)(32 + 2 * h + i) * M + (size_t)(b * T + 64 * t0)) * 64; ud.ks = 64;
                ud.V = qkv + ((size_t)(64 + 2 * h) * M + (size_t)(b * T + 64 * t0)) * 64; ud.vs = 64;
                ud.O = Rblk + 128 * i; ud.os = 16 * 256;
                ud.lse = nullptr; ud.lses = 0; ud.NT = 4 * (qb + 1) - t0; ud.rel0 = qb * 256 - 64 * t0; ud.tg0 = t0; ud.q0 = qb * 256;
                ud.slope2 = exp2f(-0.5f * (float)(h + 1)) * LOG2E; ud.sink2 = 0.f;
                ud.fin = pass; ud.lam = bnd[1]; ud.lam1 = 1.f - bnd[2]; ud.sg = subln; ud.Of = Oout + (size_t)(b * T + qb * 256) * D + 128 * h;
                att128::attn_unit<0, 8, 1, 16 * 256>(ud, (char*)c.lds);
            }
#else
#pragma unroll 1
            for (int pass = 0; pass < 4; ++pass) {
                ATT1_DECODE();
                const int i = pass >> 1, j = pass & 1; att::UnitDesc ud;
#if QKV_HEADMAJOR
                ud.Q = qkv + ((size_t)(2 * h + i) * M + (size_t)(b * T + qb * 256)) * 64; ud.qs = 64;
                ud.K = qkv + ((size_t)(32 + 2 * h + i) * M + (size_t)(b * T + 64 * t0)) * 64; ud.ks = 64;
                ud.V = qkv + ((size_t)(64 + 2 * h + j) * M + (size_t)(b * T + 64 * t0)) * 64; ud.vs = 64;
#else
                ud.Q = qkv + (size_t)(b * T + qb * 256) * C_IN + 128 * h + 64 * i; ud.qs = C_IN;
                ud.K = qkv + (size_t)(b * T + 64 * t0) * C_IN + 2048 + 128 * h + 64 * i; ud.ks = C_IN;
                ud.V = qkv + (size_t)(b * T + 64 * t0) * C_IN + 4096 + 128 * h + 64 * j; ud.vs = C_IN;
#endif
                ud.O = Rblk + 128 * i + 64 * j; ud.os = 16 * 256;
                ud.lse = nullptr; ud.lses = 0; ud.NT = 4 * (qb + 1) - t0; ud.rel0 = qb * 256 - 64 * t0; ud.tg0 = t0; ud.q0 = qb * 256;
                ud.slope2 = exp2f(-0.5f * (float)(h + 1)) * LOG2E; ud.sink2 = 0.f;
                att::attn_unit<0, 8, 1, 16 * 256>(ud, (char*)c.lds);
            }
#endif
#if !USE_V128
            asm volatile("s_waitcnt vmcnt(0)" ::: "memory"); __syncthreads();
            { ATT1_DECODE(); (void)t0; const float lam = bnd[1], lam_init = bnd[2];
              int ft_ = threadIdx.x; asm volatile("" : "+v"(ft_));
              const int row = ft_ >> 1, hf = ft_ & 1; const bf16* p1 = Rblk + (size_t)row * (16 * 256) + 64 * hf; const bf16* p2 = p1 + 128;
              float xv[64]; float ss = 0.f;
#pragma unroll
              for (int q8 = 0; q8 < 8; ++q8) { const u32x4 a = *(const u32x4*)(p1 + 8 * q8), bq = *(const u32x4*)(p2 + 8 * q8);
#pragma unroll
                  for (int k = 0; k < 4; ++k) { const float x0 = bf2f(a[k] & 0xffffu) - lam * bf2f(bq[k] & 0xffffu), x1 = bf2f(a[k] >> 16) - lam * bf2f(bq[k] >> 16);
                      xv[8 * q8 + 2 * k] = x0; xv[8 * q8 + 2 * k + 1] = x1; ss += x0 * x0 + x1 * x1; } }
              ss += __shfl_xor(ss, 1);
              const float rs = (1.f - lam_init) / sqrtf(ss * (1.f / 128.f) + RMS_EPS);
              bf16* op = Oout + (size_t)(b * T + qb * 256 + row) * D + 128 * h + 64 * hf; const float* sg = subln + 64 * hf;
#pragma unroll
              for (int q8 = 0; q8 < 8; ++q8) { u32x4 w;
#pragma unroll
                  for (int k = 0; k < 4; ++k) w[k] = pk2(xv[8 * q8 + 2 * k] * rs * sg[8 * q8 + 2 * k], xv[8 * q8 + 2 * k + 1] * rs * sg[8 * q8 + 2 * k + 1]);
                  *(u32x4*)(op + 8 * q8) = w; } }
#endif
#undef ATT1_DECODE
        }
        if (c.tid == 0) nextu[0] = nreg;
        __syncthreads();
        p = nextu[0];
    }
}
#else
    constexpr int NCH = DEFER_CONV ? EXP_ITEMS / 65 : 0, NPOS = NB * 16 * 4 * 16 + NCH;
    static_assert(!DEFER_CONV || EXP_ITEMS % 65 == 0, "chunking");
    unsigned p = blockIdx.x;
    while (p < (unsigned)NPOS) {
        unsigned nreg = 0u;
        if (c.tid == 0) nreg = __hip_atomic_fetch_add(qctr, 1u, __ATOMIC_RELAXED, __HIP_MEMORY_SCOPE_AGENT) + (unsigned)G;
        const bool inter = p < (unsigned)(NCH * 6);
        if (inter && (p % 6u) == 5u) {
            expert_items_block(c, es, 1, ws, (int)(p / 6u) * 65, 65);
        } else {
            const unsigned u = inter ? p - p / 6u : p - (unsigned)NCH;
            const int ent = order[u >> 4], h = ent >> 4, qb = ent & 15, bp = (int)(u & 15u), b = bp >> 2, i = (bp >> 1) & 1, j = bp & 1, t0 = t0s[ent];
            att::UnitDesc ud;
#if QKV_HEADMAJOR
            ud.Q = qkv + ((size_t)(2 * h + i) * M + (size_t)(b * T + qb * 256)) * 64; ud.qs = 64;
            ud.K = qkv + ((size_t)(32 + 2 * h + i) * M + (size_t)(b * T + 64 * t0)) * 64; ud.ks = 64;
            ud.V = qkv + ((size_t)(64 + 2 * h + j) * M + (size_t)(b * T + 64 * t0)) * 64; ud.vs = 64;
#else
            ud.Q = qkv + (size_t)(b * T + qb * 256) * C_IN + 128 * h + 64 * i; ud.qs = C_IN;
            ud.K = qkv + (size_t)(b * T + 64 * t0) * C_IN + 2048 + 128 * h + 64 * i; ud.ks = C_IN;
            ud.V = qkv + (size_t)(b * T + 64 * t0) * C_IN + 4096 + 128 * h + 64 * j; ud.vs = C_IN;
#endif
            ud.O = R + ((size_t)(b * T + qb * 256) * 16 + h) * 256 + 128 * i + 64 * j; ud.os = 16 * 256;
            ud.lse = nullptr; ud.lses = 0; ud.NT = 4 * (qb + 1) - t0; ud.rel0 = qb * 256 - 64 * t0; ud.tg0 = t0; ud.q0 = qb * 256;
            ud.slope2 = exp2f(-0.5f * (float)(h + 1)) * LOG2E; ud.sink2 = 0.f;
            att::attn_unit<0, 8, 1, 16 * 256>(ud, (char*)c.lds);
        }
        if (c.tid == 0) nextu[0] = nreg;
        __syncthreads();
        p = nextu[0];
    }
}
#endif
__device__ __forceinline__ void attn1_finish_bf16_phase(const Ctx& c, const bf16* R, const float* lamp, const float* subln, bf16* O) {
    float s01 = 0.f, s23 = 0.f;
    for (int i = 0; i < 64; ++i) { s01 += lamp[i] * lamp[64 + i]; s23 += lamp[128 + i] * lamp[192 + i]; }
    const float lam_init = 0.8f - 0.6f * expf(-0.3f * 1.0f);
    const float lam = expf(s01) - expf(s23) + lam_init;
    const long total = (long)M * 16;
    for (long id = gtid_now(); id < total; id += c.gsz) {
        const bf16* p1 = R + (size_t)id * 256; const bf16* p2 = p1 + 128;
        float ss = 0.f;
#pragma unroll 4
        for (int i = 0; i < 16; ++i) { const u32x4 a = *(const u32x4*)(p1 + 8 * i), bq = *(const u32x4*)(p2 + 8 * i);
#pragma unroll
            for (int k = 0; k < 4; ++k) { const float x0 = bf2f(a[k] & 0xffffu) - lam * bf2f(bq[k] & 0xffffu), x1 = bf2f(a[k] >> 16) - lam * bf2f(bq[k] >> 16); ss += x0 * x0 + x1 * x1; } }
        const float rs = (1.f - lam_init) / sqrtf(ss * (1.f / 128.f) + RMS_EPS);
        bf16* op = O + (size_t)id * 128;
#pragma unroll 4
        for (int i = 0; i < 16; ++i) { const u32x4 a = *(const u32x4*)(p1 + 8 * i), bq = *(const u32x4*)(p2 + 8 * i); u32x4 w;
#pragma unroll
            for (int k = 0; k < 4; ++k) { const float x0 = bf2f(a[k] & 0xffffu) - lam * bf2f(bq[k] & 0xffffu), x1 = bf2f(a[k] >> 16) - lam * bf2f(bq[k] >> 16);
                w[k] = pk2(x0 * rs * subln[8 * i + 2 * k], x1 * rs * subln[8 * i + 2 * k + 1]); }
            *(u32x4*)(op + 8 * i) = w; }
    }
}
__device__ __forceinline__ void attn0_tuned_phase(const Ctx& c, const bf16* qkv, const float* sinks, bf16* OBR  , float* LSE  , bf16* O, int xlo, int xhi) {
    const int G = gridDim.x, vcu = vcu_of(blockIdx.x, G);
    for (int gid = vcu; gid < NB * 64; gid += G) {
        const int b = gid / 64, kind = (gid % 64) / 16, h = gid % 16;
        const float slope2 = exp2f(-0.5f * (float)(h + 1)) * LOG2E;
        if (kind < 3) {
            const int dil = kind == 0 ? 1 : (kind == 1 ? 4 : 16), nblk = 16 / dil;
            for (int x = xlo; x < xhi; ++x) {
                const int r = x / nblk, blk = x % nblk, q0 = blk * 256, t0 = blk ? 4 * blk - 2 : 0; att::UnitDesc u;
                const size_t qrow = (size_t)(b * T + r + dil * q0), krow = (size_t)(b * T + r + dil * 64 * t0);
#if QKV_HEADMAJOR
                u.Q = qkv + ((size_t)(h) * M + qrow) * 64; u.qs = (long)dil * 64;
                u.K = qkv + ((size_t)(16 + h) * M + krow) * 64; u.ks = (long)dil * 64;
                u.V = qkv + ((size_t)(32 + h) * M + krow) * 64; u.vs = (long)dil * 64;
#else
                u.Q = qkv + qrow * AB_IN + 64 * h; u.qs = (long)dil * AB_IN;
                u.K = qkv + krow * AB_IN + 1024 + 64 * h; u.ks = (long)dil * AB_IN;
                u.V = qkv + krow * AB_IN + 2048 + 64 * h; u.vs = (long)dil * AB_IN;
#endif
                u.O = OBR + ((size_t)kind * M + qrow) * 1024 + 64 * h; u.os = (long)dil * 1024;
                u.lse = LSE + ((size_t)kind * M + qrow) * 16 + h; u.lses = (long)dil * 16;
                u.NT = blk ? 6 : 4; u.rel0 = q0 - 64 * t0; u.tg0 = t0; u.q0 = q0; u.slope2 = slope2 * (float)dil; u.sink2 = 0.f;
                if (dil == 1) att::attn_unit<1, 8, 1, 1024>(u, (char*)c.lds); else if (dil == 4) att::attn_unit<1, 8, 4, 4096>(u, (char*)c.lds); else att::attn_unit<1, 8, 16, 16384>(u, (char*)c.lds);
            }
        } else {
            const int kvh = h >> 3;
            for (int x = xlo; x < xhi; ++x) {
                const int q0 = x * 256, t0 = x ? 4 * x - 2 : 0; att::UnitDesc u;
                const size_t qrow = (size_t)(b * T + q0), krow = (size_t)(b * T + 64 * t0);
#if QKV_HEADMAJOR
                u.Q = qkv + ((size_t)(48 + h) * M + qrow) * 64; u.qs = 64;
                u.K = qkv + ((size_t)(64 + kvh) * M + krow) * 64; u.ks = 64;
                u.V = qkv + ((size_t)(66 + kvh) * M + krow) * 64; u.vs = 64;
#else
                u.Q = qkv + qrow * AB_IN + 3072 + 64 * h; u.qs = AB_IN;
                u.K = qkv + krow * AB_IN + 4096 + 64 * kvh; u.ks = AB_IN;
                u.V = qkv + krow * AB_IN + 4224 + 64 * kvh; u.vs = AB_IN;
#endif
                u.O = O + qrow * D + 1024 + 64 * h; u.os = D;
                u.lse = nullptr; u.lses = 0;
                u.NT = x ? 6 : 4; u.rel0 = q0 - 64 * t0; u.tg0 = t0; u.q0 = q0; u.slope2 = slope2; u.sink2 = sinks[h] * LOG2E;
                att::attn_unit<2, 8, 1, D>(u, (char*)c.lds);
            }
        }
    }
}
__device__ __forceinline__ void attn0_merge_phase(const Ctx& c, const bf16* OBR, const float* LSE, bf16* O) {
    const long total = (long)M * 16;
    for (long id = gtid_now(); id < total; id += c.gsz) {
        const long m = id / 16; const int h = (int)(id % 16);
        const float l0 = LSE[id], l1 = LSE[(size_t)M * 16 + id], l2 = LSE[(size_t)2 * M * 16 + id];
        const float mx = fmaxf(l0, fmaxf(l1, l2)); float w0 = exp2f(l0 - mx), w1 = exp2f(l1 - mx), w2 = exp2f(l2 - mx); const float inv = 1.f / (w0 + w1 + w2); w0 *= inv; w1 *= inv; w2 *= inv;
        const bf16* p0 = OBR + (size_t)m * 1024 + 64 * h; const bf16* p1 = p0 + (size_t)M * 1024; const bf16* p2 = p1 + (size_t)M * 1024;
        bf16* op = O + (size_t)m * D + 64 * h;
#pragma unroll
        for (int i = 0; i < 8; ++i) { const u32x4 a = *(const u32x4*)(p0 + 8 * i), bq = *(const u32x4*)(p1 + 8 * i), cq = *(const u32x4*)(p2 + 8 * i); u32x4 w;
#pragma unroll
            for (int k = 0; k < 4; ++k) w[k] = pk2(w0 * bf2f(a[k] & 0xffffu) + w1 * bf2f(bq[k] & 0xffffu) + w2 * bf2f(cq[k] & 0xffffu), w0 * bf2f(a[k] >> 16) + w1 * bf2f(bq[k] >> 16) + w2 * bf2f(cq[k] >> 16));
            *(u32x4*)(op + 8 * i) = w; }
    }
}

__device__ __forceinline__ void convert_router(const Ctx& c, const float* wr, bf16* wrt) {
    for (int id2 = gtid_now(); id2 < 2 * NE * D; id2 += c.gsz) { const int l = id2 / (NE * D), id = id2 % (NE * D), k = id / NE, n = id % NE; const float w = wr[id2];
        const unsigned hb = f2bf(w); const float hf = bf2f(hb);
        const int off = l * 2 * NE * D + (((((k >> 8) * 8 + ((k >> 5) & 7)) * 4 + (n >> 4)) * 2) * 64 + ((n & 15) + 16 * ((k >> 3) & 3))) * 8 + (k & 7);
        wrt[off] = (bf16)hb; wrt[off + 512] = (bf16)f2bf(w - hf); }
}
#define DPPF(old, v, ctrl, rm) __int_as_float(__builtin_amdgcn_update_dpp(__float_as_int(old), __float_as_int(v), ctrl, rm, 0xf, false))
__device__ __forceinline__ float dpp_max8(float v) {
    v = fmaxf(v, DPPF(v, v, 0xB1, 0xf)); v = fmaxf(v, DPPF(v, v, 0x4E, 0xf)); v = fmaxf(v, DPPF(v, v, 0x141, 0xf)); return v; }
__device__ __forceinline__ float wave_max_u(float v) {
    v = dpp_max8(v); v = fmaxf(v, DPPF(v, v, 0x140, 0xf)); v = fmaxf(v, DPPF(v, v, 0x142, 0xa)); v = fmaxf(v, DPPF(v, v, 0x143, 0xc));
    return __int_as_float(__builtin_amdgcn_readlane(__float_as_int(v), 63)); }
__device__ __forceinline__ float wave_sum_u(float v) {
    v += DPPF(0.f, v, 0xB1, 0xf); v += DPPF(0.f, v, 0x4E, 0xf); v += DPPF(0.f, v, 0x141, 0xf); v += DPPF(0.f, v, 0x140, 0xf); v += DPPF(0.f, v, 0x142, 0xa); v += DPPF(0.f, v, 0x143, 0xc);
    return __int_as_float(__builtin_amdgcn_readlane(__float_as_int(v), 63)); }
constexpr int RT_ROUTER = 2;
__device__ __forceinline__ void router2_phase(const Ctx& c, const float* x1, const float* g, const float* ada_l, const bf16* wrt, const float* rbias,
                                              bf16* HF, int* idx, float* gate, int* wcnt, bf16* HFB = nullptr) {
    constexpr int RT = RT_ROUTER, RU = 16 * RT, NU = M / RU;
    LAS float* red = (LAS float*)c.lds;
    LAS float* part = (LAS float*)(c.lds + 1024);
    LAS float* GA = (LAS float*)(c.lds + 1024 + RT * 32768);
    LAS float* GB = GA + D;
    const int w = __builtin_amdgcn_readfirstlane((int)threadIdx.x >> 6);
    const float rb = rbias[threadIdx.x & 63];
    unsigned cnt = 0u;
    const int per = (NU + (int)gridDim.x - 1) / (int)gridDim.x, u0 = blockIdx.x * per, u1 = (u0 + per < NU) ? u0 + per : NU;
    int bcur = -1;
#pragma unroll 1
    for (int u = u0; u < u1; ++u) {
        int tid = threadIdx.x; asm volatile("" : "+v"(tid));
        const int lane = tid & 63, r = lane & 15, q = lane >> 4, cb = 256 * w + 8 * q;
        const bf16* wf = wrt + (size_t)w * (8 * 4 * 2 * 512) + lane * 8;
        const int m0 = u * RU, b = m0 / T;
        if (b != bcur) { bcur = b; __syncthreads();
            for (int col = 4 * tid; col < D; col += 2048) { const f32x4 gg = *(const f32x4*)(g + col), sc = *(const f32x4*)(ada_l + (size_t)b * 6 * D + 4 * D + col), sh = *(const f32x4*)(ada_l + (size_t)b * 6 * D + 3 * D + col);
                *(LAS f32x4*)(GA + col) = gg * (sc + 1.f); *(LAS f32x4*)(GB + col) = sh; } }
        u32x4 xv[RT][8]; float rstd[RT];
#pragma unroll
        for (int t = 0; t < RT; ++t) { const bf16* xr = (const bf16*)x1 + (size_t)(m0 + 16 * t + r) * D + cb;
#pragma unroll
            for (int kk = 0; kk < 8; ++kk) xv[t][kk] = *(const u32x4*)(xr + 32 * kk); }
#pragma unroll
        for (int t = 0; t < RT; ++t) { float ss = 0.f;
#pragma unroll
            for (int kk = 0; kk < 8; ++kk)
#pragma unroll
                for (int j = 0; j < 4; ++j) { const float a0 = bf2f(xv[t][kk][j] & 0xffffu), a1 = bf2f(xv[t][kk][j] >> 16); ss += a0 * a0 + a1 * a1; }
            ss += __shfl_xor(ss, 16); ss += __shfl_xor(ss, 32);
            if (q == 0) red[(t * 8 + w) * 16 + r] = ss; }
        __syncthreads();
        f32x4 acc[RT][4];
#pragma unroll
        for (int t = 0; t < RT; ++t) { float tot = 0.f;
#pragma unroll
            for (int w2 = 0; w2 < 8; ++w2) tot += red[(t * 8 + w2) * 16 + r];
            rstd[t] = 1.f / sqrtf(tot * (1.f / D) + RMS_EPS);
#pragma unroll
            for (int nt = 0; nt < 4; ++nt) acc[t][nt] = (f32x4){0.f, 0.f, 0.f, 0.f}; }
#pragma unroll
        for (int kk = 0; kk < 8; ++kk) {
            const f32x4 ga0 = *(LAS f32x4*)(GA + cb + 32 * kk), ga1 = *(LAS f32x4*)(GA + cb + 32 * kk + 4), gb0 = *(LAS f32x4*)(GB + cb + 32 * kk), gb1 = *(LAS f32x4*)(GB + cb + 32 * kk + 4);
            bf16x8 ah[RT], al[RT];
#pragma unroll
            for (int t = 0; t < RT; ++t) { const u32x4 xw = xv[t][kk]; f32x4 hh[2];
                hh[0] = (f32x4){bf2f(xw.x & 0xffffu), bf2f(xw.x >> 16), bf2f(xw.y & 0xffffu), bf2f(xw.y >> 16)} * rstd[t] * ga0 + gb0;
                hh[1] = (f32x4){bf2f(xw.z & 0xffffu), bf2f(xw.z >> 16), bf2f(xw.w & 0xffffu), bf2f(xw.w >> 16)} * rstd[t] * ga1 + gb1;
                u32x4 hw, lw;
#pragma unroll
                for (int s2 = 0; s2 < 2; ++s2) { const unsigned h0 = f2bf(hh[s2].x), h1 = f2bf(hh[s2].y), h2 = f2bf(hh[s2].z), h3 = f2bf(hh[s2].w);
                    hw[2 * s2] = h0 | (h1 << 16); hw[2 * s2 + 1] = h2 | (h3 << 16);
                    lw[2 * s2] = pk2(hh[s2].x - bf2f(h0), hh[s2].y - bf2f(h1)); lw[2 * s2 + 1] = pk2(hh[s2].z - bf2f(h2), hh[s2].w - bf2f(h3)); }
#if USE_FP8_MOE
                { u32x2 q8; q8.x = pk4_fp8(hh[0].x * F8_HSCALE, hh[0].y * F8_HSCALE, hh[0].z * F8_HSCALE, hh[0].w * F8_HSCALE); q8.y = pk4_fp8(hh[1].x * F8_HSCALE, hh[1].y * F8_HSCALE, hh[1].z * F8_HSCALE, hh[1].w * F8_HSCALE);
                  *(u32x2*)((unsigned char*)HF + (size_t)(m0 + 16 * t + r) * D + cb + 32 * kk) = q8; }
#if SHARED_BF16
                *(u32x4*)(HFB + (size_t)(m0 + 16 * t + r) * D + cb + 32 * kk) = hw;
#endif
#else
                *(u32x4*)(HF + (size_t)(m0 + 16 * t + r) * D + cb + 32 * kk) = hw;
#endif
                ah[t] = __builtin_bit_cast(bf16x8, hw); al[t] = __builtin_bit_cast(bf16x8, lw); }
#pragma unroll
            for (int nt = 0; nt < 4; ++nt) { const bf16x8 bh = *(const bf16x8*)(wf + ((kk * 4 + nt) * 2) * 512), bl = *(const bf16x8*)(wf + ((kk * 4 + nt) * 2 + 1) * 512);
#pragma unroll
                for (int t = 0; t < RT; ++t) {
                    acc[t][nt] = __builtin_amdgcn_mfma_f32_16x16x32_bf16(ah[t], bh, acc[t][nt], 0, 0, 0);
                    acc[t][nt] = __builtin_amdgcn_mfma_f32_16x16x32_bf16(ah[t], bl, acc[t][nt], 0, 0, 0);
                    acc[t][nt] = __builtin_amdgcn_mfma_f32_16x16x32_bf16(al[t], bh, acc[t][nt], 0, 0, 0); } }
            if (kk & 1) asm volatile("" ::: "memory");
        }
#pragma unroll
        for (int t = 0; t < RT; ++t)
#pragma unroll
            for (int nt = 0; nt < 4; ++nt)
#pragma unroll
                for (int j = 0; j < 4; ++j) part[((t * 8 + w) * 16 + 4 * q + j) * 64 + 16 * nt + r] = acc[t][nt][j];
        __syncthreads();
#pragma unroll 1
        for (int rp = 0; rp < RT; ++rp) {
            float score[2], cur[2]; int rank[2];
#pragma unroll
            for (int x = 0; x < 2; ++x) { const int row = 2 * RT * w + 2 * rp + x; float logit = 0.f;
#pragma unroll
                for (int w2 = 0; w2 < 8; ++w2) logit += part[(((row >> 4) * 8 + w2) * 16 + (row & 15)) * 64 + lane];
                score[x] = 1.f / (1.f + expf(-logit));
                const float sel = score[x] + rb;
                const float m1 = dpp_max8(sel);
                const unsigned long long eqm = __ballot(sel == m1);
                const unsigned grp_eq = (unsigned)((eqm >> (lane & ~7)) & 0xffull);
                const int first = __builtin_ctz(grp_eq);
                const float m2 = dpp_max8(((lane & 7) == first) ? -3e38f : sel);
                const float gs = m1 + m2;
                int grank = 0; const int mygrp = lane >> 3;
#pragma unroll
                for (int g2 = 0; g2 < 8; ++g2) { const float o = __int_as_float(__builtin_amdgcn_readlane(__float_as_int(gs), g2 * 8)); grank += (o > gs || (o == gs && g2 < mygrp)) ? 1 : 0; }
                cur[x] = (grank < 4) ? sel : -1e30f; rank[x] = 64; }
#pragma unroll
            for (int it = 0; it < TOPK; ++it)
#pragma unroll
                for (int x = 0; x < 2; ++x) { const float mx = wave_max_u(cur[x]); const int f = (int)__builtin_ctzll(__ballot(cur[x] == mx));
                    if (lane == f) { rank[x] = it; cur[x] = -3e38f; } }
#pragma unroll
            for (int x = 0; x < 2; ++x) { const int m = m0 + 2 * RT * w + 2 * rp + x; const bool chosen = rank[x] < TOPK;
                const float gsum = wave_sum_u(chosen ? score[x] : 0.f);
                if (chosen) { idx[(size_t)m * 8 + rank[x]] = lane | (int)(cnt << 8); gate[(size_t)m * 8 + rank[x]] = score[x] / gsum * 2.5f; cnt += 1u; } }
        }
        __syncthreads();
    }
    wcnt[(size_t)(blockIdx.x * 8 + w) * 64 + (threadIdx.x & 63)] = (int)cnt;
}
__device__ __forceinline__ void slot2_phase(const Ctx& c, const int* idx, const int* wcnt, unsigned* nrt_out, int* pos, int* slot_tok, int* tile_exp) {
    LAS int* ST = (LAS int*)c.lds;
    LAS int* SB = ST + 512;
    LAS int* SO = SB + 512;
    LAS int* tot = SO + 512;
    LAS int* bef = tot + 64;
    LAS int* ps = bef + 64;
    LAS int* base = ps + 128;
    const int e = c.tid & 63, p = c.tid >> 6, G = gridDim.x, blk = blockIdx.x;
    { int Tp = 0, Bp = 0;
#pragma unroll 8
      for (int b2 = 0; b2 < G; ++b2) { const int v = wcnt[(size_t)(b2 * 8 + p) * 64 + e]; Tp += v; Bp += (b2 < blk) ? v : 0; }
      ST[p * 64 + e] = Tp; SB[p * 64 + e] = Bp; SO[p * 64 + e] = wcnt[(size_t)(blk * 8 + p) * 64 + e]; }
    __syncthreads();
    if (c.tid < 64) { int t = 0, bb = 0;
#pragma unroll
        for (int p2 = 0; p2 < 8; ++p2) { t += ST[p2 * 64 + e]; bb += SB[p2 * 64 + e]; }
        tot[e] = t; bef[e] = bb; }
    __syncthreads();
    if (c.tid == 0) { int acc = 0; for (int e2 = 0; e2 < NE; ++e2) { ps[e2] = acc; acc += (tot[e2] + 255) / 256 * 256; } ps[64] = acc; }
    __syncthreads();
    { int o = ps[e] + bef[e];
      for (int p2 = 0; p2 < p; ++p2) o += SO[p2 * 64 + e];
      base[p * 64 + e] = o; }
    __syncthreads();
    {
        constexpr int RU = 16 * RT_ROUTER, NU = M / RU; const int per = (NU + G - 1) / G, mlo = blk * per * RU, mhi = (mlo + per * RU < M) ? mlo + per * RU : M;
        for (int i = c.tid; i < (mhi - mlo) * 8; i += 512) {
            const int m = mlo + (i >> 3), k = i & 7, wv = (m % RU) / (2 * RT_ROUTER); const size_t a = (size_t)m * 8 + k;
            const int code = idx[a], ee = code & 255, rk = code >> 8, slot = base[wv * 64 + ee] + rk;
            slot_tok[slot] = m; pos[a] = slot; }
    }
    for (int t = gtid_now(); t < M; t += c.gsz) slot_tok[CAPR + t] = t;
    if (blk == 0) {
        if (c.tid < NE) { const int s0 = ps[e], cn = tot[e], pe = s0 + (cn + 255) / 256 * 256;
            for (int s = s0 + cn; s < pe; ++s) slot_tok[s] = 0;
            for (int tt = s0 / 256; tt < pe / 256; ++tt) tile_exp[tt] = e; }
        if (c.tid == 0) *nrt_out = (unsigned)(ps[64] / 256);
    }
    __syncthreads();
}

template <int L> __device__ __forceinline__ void moe_up_tuned(const Ctx& c, unsigned char* ws) {
    const int nrt = (int)c.ctl[CW_NRT + L];
#if USE_FP8_MOE && SHARED_BF16
    { pg8::PlainSched S; S.o.init(M / 256, UPN / 256, gridDim.x, blockIdx.x); S.Bt = (const char*)(ws + WS_WUPS) + (size_t)L * UPN * D * 2; S.K = D;
      pg8::EpiUp E{(bf16*)(ws + WS_ACTS)}; pg8::gemm_phase(c.lds, (const char*)(ws + WS_HFB), D, S, E); }
    const int ntile = nrt;
#else
    const int ntile = nrt + M / 256;
#endif
    pg8::GroupSched<true> S; S.o.init(ntile, UPN / 256, gridDim.x, blockIdx.x);
    { LAS int* te = (LAS int*)(c.lds + 132096);
      for (int i = threadIdx.x; i < nrt; i += 512) te[i] = ((const int*)(ws + WS_TILEEXP))[i];
      __syncthreads(); S.tile_exp = te; }
    S.nrt = nrt; S.slot_tok = (const int*)(ws + WS_SLOTTOK);
#if USE_FP8_MOE
    S.W = (const char*)(ws + WS_WUP) + (size_t)L * NEX * UPN * D; S.wstride = (size_t)UPN * D; S.K = D / 2;
    pg8::EpiUp8 E{ws + WS_ACT}; pg8::gemm_phase<pg8::EpiUp8, pg8::GroupSched<true>, true>(c.lds, (const char*)(ws + WS_HF), D / 2, S, E);
#else
    S.W = (const char*)(ws + WS_WUP) + (size_t)L * NEX * UPN * D * 2; S.wstride = (size_t)UPN * D * 2; S.K = D;
    pg8::EpiUp E{(bf16*)(ws + WS_ACT)}; pg8::gemm_phase(c.lds, (const char*)(ws + WS_HF), D, S, E);
#endif
}
template <int L> __device__ __forceinline__ void moe_down_tuned(const Ctx& c, unsigned char* ws) {
    const int nrt = (int)c.ctl[CW_NRT + L];
#if USE_FP8_MOE && SHARED_BF16
    { pg8::PlainSched S; S.o.init(M / 256, D / 256, gridDim.x, blockIdx.x); S.Bt = (const char*)(ws + WS_WDNS) + (size_t)L * D * ED * 2; S.K = ED;
      pg8::EpiDown E{(bf16*)(ws + WS_Y), CAPR}; pg8::gemm_phase(c.lds, (const char*)(ws + WS_ACTS), ED, S, E); }
    const int ntile = nrt;
#else
    const int ntile = nrt + M / 256;
#endif
    pg8::GroupSched<false> S; S.o.init(ntile, D / 256, gridDim.x, blockIdx.x);
    { LAS int* te = (LAS int*)(c.lds + 132096);
      for (int i = threadIdx.x; i < nrt; i += 512) te[i] = ((const int*)(ws + WS_TILEEXP))[i];
      __syncthreads(); S.tile_exp = te; }
    S.nrt = nrt; S.slot_tok = (const int*)(ws + WS_SLOTTOK);
#if USE_FP8_MOE
    S.W = (const char*)(ws + WS_WDN) + (size_t)L * NEX * D * ED; S.wstride = (size_t)D * ED; S.K = ED / 2;
    pg8::EpiDown8 E{(bf16*)(ws + WS_Y)}; pg8::gemm_phase<pg8::EpiDown8, pg8::GroupSched<false>, true>(c.lds, (const char*)(ws + WS_ACT), ED / 2, S, E);
#else
    S.W = (const char*)(ws + WS_WDN) + (size_t)L * NEX * D * ED * 2; S.wstride = (size_t)D * ED * 2; S.K = ED;
    pg8::EpiDown E{(bf16*)(ws + WS_Y)}; pg8::gemm_phase(c.lds, (const char*)(ws + WS_ACT), ED, S, E);
#endif
}
template <int L> __device__ __forceinline__ void qkv_tuned(const Ctx& c, unsigned char* ws, const float* gains) {
    constexpr int NCOL = L == 0 ? AB_IN : C_IN; constexpr bool TUNED_ATT = L == 0 ? (USE_ATT0 != 0) : (USE_ATT1 != 0);
    pg8::PlainSched S; S.o.init(M / 256, NCOL / 256, gridDim.x, blockIdx.x); S.Bt = (const char*)(ws + (L == 0 ? WS_W0IN : WS_W1IN));
#if USE_FP8_QKV
    S.K = D / 2; pg8::EpiQKV<L> E{(bf16*)(ws + WS_QKV), NCOL, gains, TUNED_ATT ? att::C2 : 1.f, 1.f / (F8_HSCALE * F8_WSCALE)};
    pg8::gemm_phase<pg8::EpiQKV<L>, pg8::PlainSched, true>(c.lds, (const char*)(ws + WS_XN), D / 2, S, E);
#else
    S.K = D; pg8::EpiQKV<L> E{(bf16*)(ws + WS_QKV), NCOL, gains, TUNED_ATT ? att::C2 : 1.f, 1.f};
    pg8::gemm_phase(c.lds, (const char*)(ws + WS_XN), D, S, E);
#endif
}

template <int L> __device__ __forceinline__ void outproj_epi(const Ctx& c, unsigned char* ws, const pg8::PlainSched& S, const float* xin_f32, const float* gm) {
#if RES_BF16
    if (L == 0) { pg8::EpiOutB<false> E{xin_f32, gm, (bf16*)(ws + WS_X1)}; pg8::gemm_phase(c.lds, (const char*)(ws + WS_O), D, S, E); }
    else { pg8::EpiOutB<true> E{ws + WS_X1 + (size_t)M * D * 2, gm, (bf16*)(ws + WS_X1)}; pg8::gemm_phase(c.lds, (const char*)(ws + WS_O), D, S, E); }
#else
    pg8::EpiOut E{xin_f32, gm, (float*)(ws + WS_X1)}; pg8::gemm_phase(c.lds, (const char*)(ws + WS_O), D, S, E);
#endif
}
__global__ void __launch_bounds__(512, 2) mega(Args args) {
    extern __shared__ __attribute__((aligned(16))) unsigned char lds_raw[];
    Ctx c;
    c.lds = (LAS unsigned char*)lds_raw;
    c.tid = threadIdx.x; c.lane = c.tid & 63; c.wave = __builtin_amdgcn_readfirstlane(c.tid >> 6);
    c.gw = blockIdx.x * 8 + c.wave; c.ngw = gridDim.x * 8; c.gsz = gridDim.x * 512;
    c.ws = args.ws; c.ctl = (unsigned*)(args.ws + WS_CTL);
    volatile LAS unsigned* xbw = (volatile LAS unsigned*)(c.lds + LDS_BYTES - 16);
    if (c.tid < 4) xbw[c.tid] = 0u;
    __syncthreads();
    const int lo = args.ph_lo, hi = args.ph_hi;
    XcdBarrier bar; bar.bar = c.ctl + CW_BAR; bar.x = 0; bar.st = xbw;
    if (hi - lo > 1) bar = xcd_barrier_post(c.ctl + CW_BAR, xbw);
#ifdef PHASE_ONLY
#define IN(k) ((k) == PHASE_ONLY && lo <= (k) && (k) < hi)
#else
#define IN(k) (lo <= (k) && (k) < hi)
#endif
#define PHASE(k, ...) do { if (IN(k)) { __VA_ARGS__ } if (IN(k) && ((REPMASK >> (k)) & 1u)) { __syncthreads(); __VA_ARGS__ } } while (0);
#if PROBE_SEL >= 0
    volatile LAS unsigned long long* stamp_ = (volatile LAS unsigned long long*)(c.lds + 146000);
    if (c.tid == 0) stamp_[0] = __builtin_amdgcn_s_memrealtime();
#define SEAM(k) do { if (c.tid == 0) stamp_[1 + 2 * (k)] = __builtin_amdgcn_s_memrealtime(); if (IN(k) && IN((k) + 1)) xcd_barrier(bar); else __syncthreads(); \
        if (c.tid == 0) stamp_[2 + 2 * (k)] = __builtin_amdgcn_s_memrealtime(); } while (0)
#else
#define SEAM(k) do { if (IN(k) && IN((k) + 1)) xcd_barrier(bar); else __syncthreads(); } while (0)
#endif
    unsigned char* ws = args.ws;
#define XIN (args.in[0])
#define cin (args.in[1])
#define norm_mix (args.in[2])
#define norm_ffn (args.in[3])
#define w_ada (args.in[4])
#define b_ada (args.in[5])
#define ada ((float*)(ws + WS_ADA))
#define W0IN ((bf16*)(ws + WS_W0IN))
#define W0OUT ((bf16*)(ws + WS_W0OUT))
#define W1IN ((bf16*)(ws + WS_W1IN))
#define W1OUT ((bf16*)(ws + WS_W1OUT))
#define WUP ((bf16*)(ws + WS_WUP))
#define WDN ((bf16*)(ws + WS_WDN))
#define XN ((bf16*)(ws + WS_XN))
#define QKV ((bf16*)(ws + WS_QKV))
#define OBUF ((bf16*)(ws + WS_O))
#define X1 ((float*)(ws + WS_X1))
#define HF ((bf16*)(ws + WS_HF))
#define IDX ((int*)(ws + WS_IDX))
#define GATE ((float*)(ws + WS_GATE))
#define POS ((int*)(ws + WS_POS))
#define SLOTTOK ((int*)(ws + WS_SLOTTOK))
#define TILEEXP ((int*)(ws + WS_TILEEXP))
#define ACT ((bf16*)(ws + WS_ACT))
#define Y ((bf16*)(ws + WS_Y))
#define TMP ((float*)(ws + WS_TMP))
#define OUTP (args.out)

    PHASE(0, {
        constexpr int QM = USE_PG8_QKV ? 1 : 0, UM = USE_PG8_MOE ? 2 : 0;
#if USE_CONV128 && USE_FP8_MOE
        convert_dense_all<QM, USE_FP8_QKV != 0>(c, args.in[6], args.in[10], args.in[9], args.in[14], (unsigned char*)W0IN, (unsigned char*)W1IN, (unsigned char*)W0OUT, (unsigned char*)W1OUT, USE_FP8_QKV ? F8_WSCALE : 1.f);
#if !(DEFER_CONV && USE_ATT0 && USE_ATT1 && !SHARED_BF16)
        for (int l = 0; l < 2; ++l) {
            convert_batch128<2, true>(c, args.in[17] + (size_t)l * NE * D * UPN, D, UPN, (unsigned char*)WUP + (size_t)l * NEX * UPN * D, NE, (size_t)UPN * D, F8_WSCALE);
            convert_batch128<0, true>(c, args.in[18] + (size_t)l * NE * ED * D, ED, D, (unsigned char*)WDN + (size_t)l * NEX * D * ED, NE, (size_t)D * ED, F8_WSCALE);
#if SHARED_BF16
            convert_batch128<2, false>(c, args.in[19] + (size_t)l * D * UPN, D, UPN, ws + WS_WUPS + (size_t)l * UPN * D * 2, 1, 0, 1.f);
            convert_batch128<0, false>(c, args.in[20] + (size_t)l * ED * D, ED, D, ws + WS_WDNS + (size_t)l * D * ED * 2, 1, 0, 1.f);
#else
            convert_batch128<2, true>(c, args.in[19] + (size_t)l * D * UPN, D, UPN, (unsigned char*)WUP + ((size_t)l * NEX + NE) * UPN * D, 1, 0, F8_WSCALE);
            convert_batch128<0, true>(c, args.in[20] + (size_t)l * ED * D, ED, D, (unsigned char*)WDN + ((size_t)l * NEX + NE) * D * ED, 1, 0, F8_WSCALE);
#endif
        }
#endif
#else
        convert_batch<QM>(c, args.in[6], D, AB_IN, W0IN, 1, 0);
        convert_batch<0>(c, args.in[9], D, D, W0OUT, 1, 0);
        convert_batch<QM>(c, args.in[10], D, C_IN, W1IN, 1, 0);
        convert_batch<0>(c, args.in[14], D, D, W1OUT, 1, 0);
        for (int l = 0; l < 2; ++l) {
#if USE_FP8_MOE
            convert_batch_f8<2>(c, args.in[17] + (size_t)l * NE * D * UPN, D, UPN, (unsigned char*)WUP + (size_t)l * NEX * UPN * D, NE, (size_t)UPN * D);
            convert_batch_f8<2>(c, args.in[19] + (size_t)l * D * UPN, D, UPN, (unsigned char*)WUP + ((size_t)l * NEX + NE) * UPN * D, 1, 0);
            convert_batch_f8<0>(c, args.in[18] + (size_t)l * NE * ED * D, ED, D, (unsigned char*)WDN + (size_t)l * NEX * D * ED, NE, (size_t)D * ED);
            convert_batch_f8<0>(c, args.in[20] + (size_t)l * ED * D, ED, D, (unsigned char*)WDN + ((size_t)l * NEX + NE) * D * ED, 1, 0);
#else
            convert_batch<UM>(c, args.in[17] + (size_t)l * NE * D * UPN, D, UPN, WUP + (size_t)l * NEX * UPN * D, NE, (size_t)UPN * D);
            convert_batch<UM>(c, args.in[19] + (size_t)l * D * UPN, D, UPN, WUP + ((size_t)l * NEX + NE) * UPN * D, 1, 0);
            convert_batch<0>(c, args.in[18] + (size_t)l * NE * ED * D, ED, D, WDN + (size_t)l * NEX * D * ED, NE, (size_t)D * ED);
            convert_batch<0>(c, args.in[20] + (size_t)l * ED * D, ED, D, WDN + ((size_t)l * NEX + NE) * D * ED, 1, 0);
#endif
        }
#endif
        convert_router(c, args.in[15], (bf16*)(ws + WS_WRT));
        __syncthreads();
        ada_phase(c, cin, w_ada, b_ada, ada);
    })
    SEAM(0);
    PHASE(1, norm_phase(c, XIN, norm_mix, ada, 0, D, XN);)
    SEAM(1);
#if USE_PG8_QKV
    PHASE(2, qkv_tuned<0>(c, ws, args.in[7]);)
    SEAM(2);
#else
    PHASE(2, gemm_plain_bf16(c, XN, W0IN, D, AB_IN, QKV);)
    SEAM(2);
#endif
#if USE_ATT0
    static_assert(USE_PG8_QKV, "the tuned attention needs Q pre-scaled by the QKV epilogue");
    #if DEFER_CONV
    PHASE(3, { const int xs_ = vcu_of(blockIdx.x, gridDim.x) & 15;
        attn0_tuned_phase(c, QKV, args.in[8], (bf16*)(ws + WS_TMP), (float*)(ws + WS_TMP + (size_t)3 * M * 1024 * 2), OBUF, 0, xs_ + 1);
        { const int cshare = (EXP_ITEMS + (int)gridDim.x - 1) / (int)gridDim.x, cfirst = blockIdx.x * cshare, ccount = (cfirst + cshare <= EXP_ITEMS) ? cshare : (EXP_ITEMS > cfirst ? EXP_ITEMS - cfirst : 0);
          expert_items_block(c, ExpertSrc{args.in[17], args.in[19], args.in[18], args.in[20]}, 0, ws, cfirst, ccount); __syncthreads(); }
        attn0_tuned_phase(c, QKV, args.in[8], (bf16*)(ws + WS_TMP), (float*)(ws + WS_TMP + (size_t)3 * M * 1024 * 2), OBUF, xs_ + 1, 16); })
#else
    PHASE(3, attn0_tuned_phase(c, QKV, args.in[8], (bf16*)(ws + WS_TMP), (float*)(ws + WS_TMP + (size_t)3 * M * 1024 * 2), OBUF, 0, 16);)
#endif
    SEAM(3);
    PHASE(4, attn0_merge_phase(c, (const bf16*)(ws + WS_TMP), (const float*)(ws + WS_TMP + (size_t)3 * M * 1024 * 2), OBUF);)
    SEAM(4);
#else
#if !USE_PG8_QKV
    PHASE(3, qknorm0_phase(c, QKV, args.in[7]);)
#endif
    SEAM(3);
    PHASE(4, attn0_phase(c, QKV, args.in[8], OBUF);)
    SEAM(4);
#endif
#if USE_PG8_OUT
    PHASE(5, { pg8::PlainSched S; S.o.init(M / 256, D / 256, gridDim.x, blockIdx.x); S.Bt = (const char*)W0OUT; S.K = D;
        outproj_epi<0>(c, ws, S, XIN, ada + 2 * D); })
#else
    PHASE(5, gemm_outproj(c, OBUF, W0OUT, XIN, ada + 2 * D, X1);)
#endif
    SEAM(5);
#if USE_ROUTER2
    PHASE(6, router2_phase(c, X1, norm_ffn, ada, (const bf16*)(ws + WS_WRT), args.in[16], HF, IDX, GATE, (int*)(ws + WS_WCNT), (bf16*)(ws + WS_HFB));)
    SEAM(6);
    PHASE(7, slot2_phase(c, IDX, (const int*)(ws + WS_WCNT), c.ctl + CW_NRT, POS, SLOTTOK, TILEEXP);)
#else
    PHASE(6, router_phase(c, X1, norm_ffn, ada, args.in[15], args.in[16], HF, IDX, GATE, c.ctl + CW_CNT);)
    SEAM(6);
    PHASE(7, slot_phase(c, IDX, c.ctl + CW_CNT, c.ctl + CW_CUR, c.ctl + CW_NRT, POS, SLOTTOK, TILEEXP);)
#endif
    SEAM(7);
#if USE_PG8_MOE
    PHASE(8, moe_up_tuned<0>(c, ws);)
    SEAM(8);
    PHASE(9, moe_down_tuned<0>(c, ws);)
#else
    PHASE(8, moe_up_phase(c, HF, WUP, SLOTTOK, TILEEXP, c.ctl + CW_NRT, ACT);)
    SEAM(8);
    PHASE(9, moe_down_phase(c, ACT, WDN, TILEEXP, c.ctl + CW_NRT, Y);)
#endif
    SEAM(9);
    PHASE(10, combine_phase<true>(c, X1, Y, POS, GATE, ada, RES_BF16 ? (float*)(ws + WS_X1 + (size_t)M * D * 2) : OUTP, norm_mix + D, ada + (size_t)4 * 6 * D, XN);)
    SEAM(10);
#define ada1 (ada + (size_t)4 * 6 * D)
#if USE_PG8_QKV
    PHASE(11, qkv_tuned<1>(c, ws, args.in[11]);)
    SEAM(11);
    SEAM(12);
#else
    PHASE(11, gemm_plain_bf16(c, XN, W1IN, D, C_IN, QKV);)
    SEAM(11);
    PHASE(12, qknorm1_phase(c, QKV, args.in[11]);)
    SEAM(12);
#endif
#if USE_ATT1
    PHASE(13, attn1_tuned_phase(c, QKV, args.in[11], (bf16*)TMP, c.ctl + CW_QCTR, ExpertSrc{args.in[17], args.in[19], args.in[18], args.in[20]}, ws, args.in[12], args.in[13], OBUF);)
    SEAM(13);
#if !FUSE_FINISH
    PHASE(14, attn1_finish_bf16_phase(c, (const bf16*)TMP, args.in[12], args.in[13], OBUF);)
#endif
    SEAM(14);
#else
    PHASE(13, attn1_phase(c, QKV, TMP);)
    SEAM(13);
    PHASE(14, attn1_finish_phase(c, TMP, args.in[12], args.in[13], OBUF);)
    SEAM(14);
#endif
#if USE_PG8_OUT
    PHASE(15, { pg8::PlainSched S; S.o.init(M / 256, D / 256, gridDim.x, blockIdx.x); S.Bt = (const char*)W1OUT; S.K = D;
        outproj_epi<1>(c, ws, S, OUTP, ada1 + 2 * D); })
#else
    PHASE(15, gemm_outproj(c, OBUF, W1OUT, OUTP, ada1 + 2 * D, X1);)
#endif
    SEAM(15);
#if USE_ROUTER2
    PHASE(16, router2_phase(c, X1, norm_ffn + D, ada1, (const bf16*)(ws + WS_WRT) + (size_t)2 * NE * D, args.in[16] + NE, HF, IDX, GATE, (int*)(ws + WS_WCNT), (bf16*)(ws + WS_HFB));)
    SEAM(16);
    PHASE(17, slot2_phase(c, IDX, (const int*)(ws + WS_WCNT), c.ctl + CW_NRT + 1, POS, SLOTTOK, TILEEXP);)
#else
    PHASE(16, router_phase(c, X1, norm_ffn + D, ada1, args.in[15] + (size_t)D * NE, args.in[16] + NE, HF, IDX, GATE, c.ctl + CW_CNT + 64);)
    SEAM(16);
    PHASE(17, slot_phase(c, IDX, c.ctl + CW_CNT + 64, c.ctl + CW_CUR + 64, c.ctl + CW_NRT + 1, POS, SLOTTOK, TILEEXP);)
#endif
    SEAM(17);
#if USE_PG8_MOE
    PHASE(18, moe_up_tuned<1>(c, ws);)
    SEAM(18);
    PHASE(19, moe_down_tuned<1>(c, ws);)
#else
    PHASE(18, moe_up_phase(c, HF, WUP + (size_t)NEX * UPN * D, SLOTTOK, TILEEXP, c.ctl + CW_NRT + 1, ACT);)
    SEAM(18);
    PHASE(19, moe_down_phase(c, ACT, WDN + (size_t)NEX * D * ED, TILEEXP, c.ctl + CW_NRT + 1, Y);)
#endif
    SEAM(19);
    PHASE(20, combine_phase<false>(c, X1, Y, POS, GATE, ada1, OUTP, nullptr, nullptr, nullptr);)
#if PROBE_SEL >= 0
    {
        __syncthreads();
        unsigned long long v = 0ull;
        if (c.tid == 0) {
            if (PROBE_SEL >= 100) { const int k = PROBE_SEL - 100; v = stamp_[2 + 2 * k] - (k == 0 ? stamp_[0] : stamp_[2 + 2 * (k - 1)]); }
            else if (PROBE_SEL == 1 || PROBE_SEL == 2) { for (int k = 0; k < NPHASE - 1; ++k) v += stamp_[2 + 2 * k] - stamp_[1 + 2 * k]; }
            else if (PROBE_SEL == 3) { v = stamp_[1 + 2 * 19] - stamp_[0]; }
        }
        if (PROBE_SEL == 2) {
            if (c.tid == 0) __hip_atomic_fetch_add((unsigned long long*)(c.ctl + CW_QCTR + 64), v, __ATOMIC_RELAXED, __HIP_MEMORY_SCOPE_AGENT);
            xcd_barrier(bar);
            if (c.tid == 0) v = __hip_atomic_load((unsigned long long*)(c.ctl + CW_QCTR + 64), __ATOMIC_RELAXED, __HIP_MEMORY_SCOPE_AGENT) / gridDim.x;
        }
        if (blockIdx.x == 0 && c.tid == 0) { const unsigned long long t0 = __builtin_amdgcn_s_memrealtime(), w = v * PROBE_GAIN;
            while (__builtin_amdgcn_s_memrealtime() - t0 < w) __builtin_amdgcn_s_sleep(8); }
    }
#endif
#undef IN
#undef SEAM
#undef ada
#undef ada1
#undef W0IN
#undef W0OUT
#undef W1IN
#undef W1OUT
#undef WUP
#undef WDN
#undef XN
#undef QKV
#undef OBUF
#undef X1
#undef HF
#undef IDX
#undef GATE
#undef POS
#undef SLOTTOK
#undef TILEEXP
#undef ACT
#undef Y
#undef TMP
#undef XIN
#undef cin
#undef norm_mix
#undef norm_ffn
#undef w_ada
#undef b_ada
#undef OUTP
}

extern "C" void kernel_launch(void* const* d_in, const int* in_sizes, int n_in, void* d_out, int out_size, void* d_ws, size_t ws_size, hipStream_t stream) {
    static int grid = 0;
    if (grid == 0) {
        if (n_in != 21 || out_size != M * D || ws_size < WS_END) { fprintf(stderr, "kernel_launch: unexpected sizes (n_in %d out %d ws %zu need %zu)\n", n_in, out_size, ws_size, (size_t)WS_END); grid = -1; return; }
        int dev = 0, cus = 0, per_cu = 0;
        hipGetDevice(&dev); hipDeviceGetAttribute(&cus, hipDeviceAttributeMultiprocessorCount, dev);
        if (hipFuncSetAttribute((const void*)mega, hipFuncAttributeMaxDynamicSharedMemorySize, LDS_BYTES) != hipSuccess) { fprintf(stderr, "kernel_launch: hipFuncSetAttribute failed\n"); grid = -1; return; }
        hipOccupancyMaxActiveBlocksPerMultiprocessor(&per_cu, (const void*)mega, 512, LDS_BYTES);
        (void)hipGetLastError();
        if (per_cu < 1) fprintf(stderr, "kernel_launch: occupancy query says %d blocks per CU\n", per_cu);
        grid = cus;
    }
    if (grid < 0) return;
    hipMemsetAsync((char*)d_ws + WS_CTL, 0, CTL_BYTES, stream);
    Args a{};
    for (int i = 0; i < 21; ++i) a.in[i] = (const float*)d_in[i];
    a.out = (float*)d_out; a.ws = (unsigned char*)d_ws;
#if MK_SPLIT
    for (int p = 0; p < NPHASE; ++p) { a.ph_lo = p; a.ph_hi = p + 1; hipLaunchKernelGGL(mega, dim3(grid), dim3(512), LDS_BYTES, stream, a); }
#else
    a.ph_lo = 0; a.ph_hi = NPHASE; hipLaunchKernelGGL(mega, dim3(grid), dim3(512), LDS_BYTES, stream, a);
#endif
}
```

```cpp
#include <hip/hip_runtime.h>
#include <cstdio>
#include <cstdint>
#include <hip/hip_bf16.h>

#ifndef USE_PG8_OUT
#define USE_PG8_OUT 1
#endif
#ifndef USE_PG8_QKV
#define USE_PG8_QKV 1
#endif
#ifndef USE_PG8_MOE
#define USE_PG8_MOE 1
#endif
#ifndef USE_ATT1
#define USE_ATT1 1
#endif
#ifndef USE_ATT0
#define USE_ATT0 1
#endif
#ifndef USE_ROUTER2
#define USE_ROUTER2 1
#endif
#ifndef REPMASK
#define REPMASK 0u
#endif
#ifndef USE_FP8_MOE
#define USE_FP8_MOE 1
#endif
#ifndef USE_CONV128
#define USE_CONV128 1
#endif
#ifndef USE_FP8_QKV
#define USE_FP8_QKV 1
#endif
#ifndef SHARED_BF16
#define SHARED_BF16 0
#endif
#ifndef Y_FP8
#define Y_FP8 1
#endif
#ifndef DEFER_CONV
#define DEFER_CONV 1
#endif
#ifndef RES_BF16
#define RES_BF16 1
#endif
#ifndef FUSE_FINISH
#define FUSE_FINISH 1
#endif
#ifndef PROBE_SEL
#define PROBE_SEL -1
#endif
#ifndef PROBE_GAIN
#define PROBE_GAIN 4
#endif
#ifndef QKV_HEADMAJOR
#define QKV_HEADMAJOR 1
#endif
#ifndef USE_V128
#define USE_V128 1
#endif
#ifndef MK_SPLIT
#define MK_SPLIT 0
#endif

constexpr int D = 2048, NB = 4, T = 4096, M = NB * T;
constexpr int HD = 64;
constexpr int AB_IN = 4352, C_IN = 6144;
constexpr int NE = 64, TOPK = 8, ED = 512;
constexpr int UPN = 2 * ED;
constexpr int NEX = NE + 1;
constexpr int CAPR = M * TOPK + NE * 256;
constexpr int CAP = CAPR + M;
constexpr int MAXTILES = CAP / 256;
constexpr float RMS_EPS = 1e-6f;
constexpr int NPHASE = 21;

typedef unsigned short bf16;
typedef short bf16x8 __attribute__((ext_vector_type(8)));
typedef float f32x4 __attribute__((ext_vector_type(4)));
typedef unsigned u32x4 __attribute__((ext_vector_type(4)));
typedef unsigned u32x2 __attribute__((ext_vector_type(2)));
#define LAS __attribute__((address_space(3)))

constexpr size_t MiB = 1u << 20;
constexpr size_t WS_CTL = 0, CTL_BYTES = 1 * MiB;
constexpr size_t WS_ADA = 1 * MiB;
constexpr size_t WS_W0IN = 2 * MiB;
constexpr size_t WS_W0OUT = WS_W0IN + (size_t)AB_IN * D * 2;
constexpr size_t WS_W1IN = WS_W0OUT + (size_t)D * D * 2;
constexpr size_t WS_W1OUT = WS_W1IN + (size_t)C_IN * D * 2;
constexpr size_t WS_WUP = WS_W1OUT + (size_t)D * D * 2;
constexpr size_t WS_WDN = WS_WUP + (size_t)2 * NEX * UPN * D * 2;
constexpr size_t WS_XN = WS_WDN + (size_t)2 * NEX * D * ED * 2;
constexpr size_t WS_QKV = WS_XN + (size_t)M * D * 2;
constexpr size_t WS_O = WS_QKV + (size_t)M * C_IN * 2;
constexpr size_t WS_X1 = WS_O + (size_t)M * D * 2;
constexpr size_t WS_HF = WS_X1 + (size_t)M * D * 4;
constexpr size_t WS_IDX = WS_HF + (size_t)M * D * 2;
constexpr size_t WS_GATE = WS_IDX + (size_t)M * 8 * 4;
constexpr size_t WS_POS = WS_GATE + (size_t)M * 8 * 4;
constexpr size_t WS_SLOTTOK = WS_POS + (size_t)M * 8 * 4;
constexpr size_t WS_TILEEXP = WS_SLOTTOK + (size_t)CAP * 4;
constexpr size_t WS_ACT = WS_TILEEXP + 4096;
constexpr size_t WS_Y = WS_ACT + (size_t)CAP * ED * 2;
constexpr size_t WS_TMP = WS_Y + (size_t)CAP * D * 2;
constexpr size_t WS_WRT = WS_TMP + (size_t)M * 16 * 2 * 128 * 4;
constexpr size_t WS_WCNT = WS_WRT + (size_t)2 * 2 * NE * D * 2;
constexpr size_t WS_HFB = WS_WCNT + (size_t)4096 * 64 * 4;
constexpr size_t WS_ACTS = WS_HFB + (size_t)M * D * 2;
constexpr size_t WS_WUPS = WS_ACTS + (size_t)M * ED * 2;
constexpr size_t WS_WDNS = WS_WUPS + (size_t)2 * UPN * D * 2;
constexpr size_t WS_END = WS_WDNS + (size_t)2 * D * ED * 2;
constexpr int CW_BAR = 4096;
constexpr int CW_CNT = 16384;
constexpr int CW_CUR = 16384 + 256;
constexpr int CW_NRT = 16384 + 512;
constexpr int CW_QCTR = 16384 + 1024;

constexpr int LDS_BYTES = 147456;

__device__ __forceinline__ unsigned pk4_fp8(float a, float b, float c2, float d);
constexpr float F8_WSCALE = 256.f, F8_HSCALE = 16.f, F8_ASCALE = 8.f, F8_YSCALE = 32.f;
__device__ __forceinline__ float bf2f(unsigned v) { return __uint_as_float(v << 16); }
__device__ __forceinline__ unsigned f2bf(float f) { unsigned u = __float_as_uint(f); return (u + 0x7fffu + ((u >> 16) & 1u)) >> 16; }
__device__ __forceinline__ unsigned pk2(float lo, float hi) { return f2bf(lo) | (f2bf(hi) << 16); }
__device__ __forceinline__ float wave_sum(float v) {
#pragma unroll
    for (int o = 1; o < 64; o <<= 1) v += __shfl_xor(v, o);
    return v;
}
__device__ __forceinline__ float siluf(float x) { return x / (1.f + __expf(-x)); }

#define XB_TMO      128
#define XB_XCNT(j)  (256  + 64 * (j))
#define XB_XSUB(j)  (1280 + 64 * (j))
#define XB_XGEN(j)  (2304 + 64 * (j))
#define XB_TOP      3328
#define XB_TOPGEN   3392
#define XCD_BAR_WORDS 3456
#define XB_SPIN_CAP (1u << 22)
__device__ __forceinline__ unsigned xb_ld(unsigned* p)              { return __hip_atomic_load(p, __ATOMIC_RELAXED, __HIP_MEMORY_SCOPE_AGENT); }
__device__ __forceinline__ unsigned xb_add(unsigned* p, unsigned v) { return __hip_atomic_fetch_add(p, v, __ATOMIC_RELAXED, __HIP_MEMORY_SCOPE_AGENT); }
__device__ __forceinline__ unsigned xb_xcc_id() { return (unsigned)__builtin_amdgcn_s_getreg((3 << 11) | 20) & 0xFu; }
#define XB_SPIN(cond, bar) do { unsigned _sp = 0; while (cond) { __builtin_amdgcn_s_sleep(1); \
    if ((++_sp & 255u) == 0u) { if (xb_ld(&(bar)[XB_TMO])) break; if (_sp > XB_SPIN_CAP) { atomicAdd(&(bar)[XB_TMO], 1u); break; } } } } while (0)
struct XcdBarrier { unsigned* bar; unsigned x; volatile LAS unsigned* st; };
__device__ __forceinline__ XcdBarrier xcd_barrier_post(unsigned* bar, volatile LAS unsigned* st) {
    XcdBarrier b; b.bar = bar; b.x = xb_xcc_id(); b.st = st;
    if (threadIdx.x == 0) (void)xb_add(&bar[XB_XCNT(b.x)], 1u);
    return b;
}
__device__ __forceinline__ void xcd_barrier_complete(unsigned* bar, unsigned x, unsigned& nloc, unsigned& nx) {
    const unsigned G = gridDim.x * gridDim.y * gridDim.z;
    unsigned sum, cnt, mine, sp = 0u;
    for (;;) {
        sum = 0u; cnt = 0u; mine = 0u;
#pragma unroll
        for (unsigned j = 0; j < 16; ++j) { const unsigned c = xb_ld(&bar[XB_XCNT(j)]); sum += c; cnt += (c > 0u) ? 1u : 0u; mine = (j == x) ? c : mine; }
        if (sum == G) break;
        __builtin_amdgcn_s_sleep(1);
        if ((++sp & 255u) == 0u) { if (xb_ld(&bar[XB_TMO])) break; if (sp > XB_SPIN_CAP) { atomicAdd(&bar[XB_TMO], 1u); break; } }
    }
    nloc = mine > 0u ? mine : 1u; nx = cnt > 0u ? cnt : 1u;
}
__device__ __forceinline__ void xcd_barrier(const XcdBarrier& b) {
    asm volatile("s_waitcnt vmcnt(0)" ::: "memory");
    __syncthreads();
    if (threadIdx.x == 0) {
        unsigned* bar = b.bar;
        __builtin_amdgcn_s_waitcnt(0);
        unsigned nloc = b.st[0], nx = b.st[1];
        if (nloc == 0u) { xcd_barrier_complete(bar, b.x, nloc, nx); b.st[0] = nloc; b.st[1] = nx; }
        const unsigned old = xb_add(&bar[XB_XSUB(b.x)], 1u);
        const unsigned gen = old / nloc;
        if (old + 1u == (gen + 1u) * nloc) {
            __builtin_amdgcn_fence(__ATOMIC_RELEASE, "agent");
            asm volatile("s_waitcnt vmcnt(0)" ::: "memory");
            const unsigned og = xb_add(&bar[XB_TOP], 1u);
            const unsigned tg = og / nx;
            if (og + 1u == (tg + 1u) * nx) xb_add(&bar[XB_TOPGEN], 1u);
            else XB_SPIN(xb_ld(&bar[XB_TOPGEN]) == tg, bar);
            __builtin_amdgcn_fence(__ATOMIC_ACQUIRE, "agent");
            xb_add(&bar[XB_XGEN(b.x)], 1u);
            asm volatile("s_waitcnt vmcnt(0)" ::: "memory");
        } else {
            XB_SPIN(xb_ld(&bar[XB_XGEN(b.x)]) == gen, bar);
            __builtin_amdgcn_fence(__ATOMIC_ACQUIRE, "agent");
            asm volatile("s_waitcnt vmcnt(0)" ::: "memory");
        }
    }
    __syncthreads();
}

struct Args {
    const float* in[21];
    float* out;
    unsigned char* ws;
    int ph_lo, ph_hi;
};

struct Ctx {
    int tid, lane, wave, gw, ngw, gsz;
    LAS unsigned char* lds;
    unsigned char* ws;
    unsigned* ctl;
};

__device__ __forceinline__ int gtid_now() { int t = (int)(blockIdx.x * 512u + threadIdx.x); asm volatile("" : "+v"(t)); return t; }
template <int MODE> __device__ __forceinline__ int perm_row(int n) {
    if (MODE == 1) { const int nl = n & 255; return (n & ~255) + 128 * ((nl >> 5) & 1) + 32 * (nl >> 6) + (nl & 31); }
    if (MODE == 2) { const int bj = n >> 9, rem = n & 511; return 256 * (rem >> 7) + 128 * bj + (rem & 127); }
    if (MODE == 3) { const int cl = n & 255; return (n & ~255) + 128 * ((cl >> 3) & 1) + 32 * (cl >> 6) + 8 * ((cl >> 4) & 3) + (cl & 7); }
    return n;
}
template <int MODE> __device__ __forceinline__ void transpose_item(const float* W, int K, int N, bf16* WT, LAS float* scr, int item, int lane) {
    const int nblk = N / 32, kb = item / nblk, nb = item % nblk, k0 = 64 * kb, n0 = 32 * nb, d0 = perm_row<MODE>(n0);
#pragma unroll 8
    for (int i = 0; i < 32; ++i) { const int kk = 2 * i + (lane >> 5); scr[kk * 33 + (lane & 31)] = W[(size_t)(k0 + kk) * N + n0 + (lane & 31)]; }
    asm volatile("s_waitcnt lgkmcnt(0)" ::: "memory");
    const int c = lane & 7;
#pragma unroll
    for (int j = 0; j < 4; ++j) { const int n = (lane >> 3) + 8 * j; const LAS float* s = scr + (8 * c) * 33 + n;
        u32x4 o; o.x = pk2(s[0 * 33], s[1 * 33]); o.y = pk2(s[2 * 33], s[3 * 33]); o.z = pk2(s[4 * 33], s[5 * 33]); o.w = pk2(s[6 * 33], s[7 * 33]);
        *(u32x4*)(WT + (size_t)(d0 + n) * K + k0 + 8 * c) = o; }
    asm volatile("s_waitcnt lgkmcnt(0)" ::: "memory");
}
template <int MODE> __device__ __forceinline__ void convert_batch(const Ctx& c, const float* src, int K, int N, bf16* dst, int nmat, size_t dst_stride) {
    LAS float* scr = (LAS float*)(c.lds + c.wave * 16384);
    const int per = (K / 64) * (N / 32); const long total = (long)per * nmat;
    for (long it = c.gw; it < total; it += c.ngw) {
        const int mat = (int)(it / per), item = (int)(it % per);
        transpose_item<MODE>(src + (size_t)mat * K * N, K, N, dst + (size_t)mat * dst_stride, scr, item, c.lane);
    }
}

__device__ __forceinline__ float clamp448(float v) { return __builtin_amdgcn_fmed3f(v, -448.f, 448.f); }
__device__ __forceinline__ unsigned pk4_fp8(float a, float b, float c2, float d) {
    unsigned w = 0u; w = __builtin_amdgcn_cvt_pk_fp8_f32(clamp448(a), clamp448(b), w, false); w = __builtin_amdgcn_cvt_pk_fp8_f32(clamp448(c2), clamp448(d), w, true); return w;
}
template <int MODE> __device__ __forceinline__ void transpose_item_f8(const float* W, int K, int N, unsigned char* WT, LAS float* scr, int item, int lane) {
    const int nblk = N / 32, kb = item / nblk, nb = item % nblk, k0 = 64 * kb, n0 = 32 * nb, d0 = perm_row<MODE>(n0);
#pragma unroll 8
    for (int i = 0; i < 32; ++i) { const int kk = 2 * i + (lane >> 5); scr[kk * 33 + (lane & 31)] = W[(size_t)(k0 + kk) * N + n0 + (lane & 31)]; }
    asm volatile("s_waitcnt lgkmcnt(0)" ::: "memory");
    const int n = lane & 31;
#pragma unroll
    for (int j = 0; j < 2; ++j) { const int ch = (lane >> 5) + 2 * j; const LAS float* s = scr + (16 * ch) * 33 + n; u32x4 o;
#pragma unroll
        for (int q = 0; q < 4; ++q) o[q] = pk4_fp8(s[(4 * q) * 33] * F8_WSCALE, s[(4 * q + 1) * 33] * F8_WSCALE, s[(4 * q + 2) * 33] * F8_WSCALE, s[(4 * q + 3) * 33] * F8_WSCALE);
        *(u32x4*)(WT + (size_t)(d0 + n) * K + k0 + 16 * ch) = o; }
    asm volatile("s_waitcnt lgkmcnt(0)" ::: "memory");
}
template <int MODE> __device__ __forceinline__ void convert_batch_f8(const Ctx& c, const float* src, int K, int N, unsigned char* dst, int nmat, size_t dst_stride) {
    LAS float* scr = (LAS float*)(c.lds + c.wave * 16384);
    const int per = (K / 64) * (N / 32); const long total = (long)per * nmat;
    for (long it = c.gw; it < total; it += c.ngw) {
        const int mat = (int)(it / per), item = (int)(it % per);
        transpose_item_f8<MODE>(src + (size_t)mat * K * N, K, N, dst + (size_t)mat * dst_stride, scr, item, c.lane);
    }
}

__device__ __forceinline__ void t128_load(f32x4 (&v)[16], const float* W, int N, int item, int lane) {
    const int nblk = N / 32, kb = item / nblk, nb = item % nblk, k0 = 128 * kb, n0 = 32 * nb;
    const int kr = lane >> 3, nq = lane & 7;
#pragma unroll
    for (int i = 0; i < 16; ++i) v[i] = *(const f32x4*)(W + (size_t)(k0 + 8 * i + kr) * N + n0 + 4 * nq);
}
template <int MODE, bool F8> __device__ __forceinline__ void t128_finish(const f32x4 (&v)[16], int K, int N, unsigned char* WT, LAS float* scr, int item, int lane, float scale) {
    const int nblk = N / 32, kb = item / nblk, nb = item % nblk, k0 = 128 * kb, n0 = 32 * nb, d0 = perm_row<MODE>(n0);
    const int kr = lane >> 3, nq = lane & 7;
#pragma unroll
    for (int i = 0; i < 16; ++i) { LAS float* s = scr + (8 * i + kr) * 33 + 4 * nq; s[0] = v[i].x; s[1] = v[i].y; s[2] = v[i].z; s[3] = v[i].w; }
    asm volatile("s_waitcnt lgkmcnt(0)" ::: "memory");
    const int n = lane & 31, half = lane >> 5; const LAS float* s0 = scr + (64 * half) * 33 + n;
    if (F8) {
        const int rs = lane >> 2, pc = lane & 3; (void)s0; (void)half;
#pragma unroll
        for (int it = 0; it < 4; ++it) { const int nn = rs + 16 * (it & 1), hs = it >> 1; const LAS float* s = scr + (64 * hs + 16 * pc) * 33 + nn; u32x4 o;
#pragma unroll
            for (int q = 0; q < 4; ++q) o[q] = pk4_fp8(s[(4 * q) * 33] * scale, s[(4 * q + 1) * 33] * scale, s[(4 * q + 2) * 33] * scale, s[(4 * q + 3) * 33] * scale);
            *(u32x4*)(WT + (size_t)(MODE == 3 ? perm_row<MODE>(n0 + nn) : d0 + nn) * K + k0 + 64 * hs + 16 * pc) = o; }
    } else {
        bf16* dst = (bf16*)WT + (size_t)(d0 + n) * K + k0 + 64 * half;
#pragma unroll
        for (int ch = 0; ch < 8; ++ch) { const LAS float* s = s0 + (8 * ch) * 33; u32x4 o;
#pragma unroll
            for (int q = 0; q < 4; ++q) o[q] = pk2(s[(2 * q) * 33], s[(2 * q + 1) * 33]);
            *(u32x4*)(dst + 8 * ch) = o; }
    }
    asm volatile("s_waitcnt lgkmcnt(0)" ::: "memory");
}
template <int MODE, bool F8> __device__ __forceinline__ void transpose_item128(const float* W, int K, int N, unsigned char* WT, LAS float* scr, int item, int lane, float scale) {
    asm volatile("" : "+v"(lane));
    f32x4 v[16];
    t128_load(v, W, N, item, lane);
    t128_finish<MODE, F8>(v, K, N, WT, scr, item, lane, scale);
}
template <int QM, bool F8Q> __device__ __forceinline__ void convert_dense_all(const Ctx& c, const float* w0in, const float* w1in, const float* w0out, const float* w1out,
                                                                              unsigned char* W0IN_, unsigned char* W1IN_, unsigned char* W0OUT_, unsigned char* W1OUT_, float sq) {
    constexpr int n0 = 16 * (AB_IN / 32), n1 = 16 * (C_IN / 32), n2 = 16 * (D / 32), TOT = n0 + n1 + 2 * n2;
    LAS float* scr = (LAS float*)(c.lds + c.wave * 16896);
    const int lane = c.lane, ngw = c.ngw;
#define DENSE_LOAD(v, it) do { if ((it) < n0) t128_load(v, w0in, AB_IN, (it), lane); else if ((it) < n0 + n1) t128_load(v, w1in, C_IN, (it) - n0, lane); \
        else if ((it) < n0 + n1 + n2) t128_load(v, w0out, D, (it) - n0 - n1, lane); else t128_load(v, w1out, D, (it) - n0 - n1 - n2, lane); } while (0)
#define DENSE_FIN(v, it) do { if ((it) < n0 + n1) { const bool f_ = (it) < n0; t128_finish<QM, F8Q>(v, D, f_ ? AB_IN : C_IN, f_ ? W0IN_ : W1IN_, scr, f_ ? (it) : (it) - n0, lane, sq); } \
        else { const bool f_ = (it) < n0 + n1 + n2; t128_finish<0, false>(v, D, D, f_ ? W0OUT_ : W1OUT_, scr, f_ ? (it) - n0 - n1 : (it) - n0 - n1 - n2, lane, 1.f); } } while (0)
    int it = c.gw;
    f32x4 va[16], vb[16];
    if (it < TOT) DENSE_LOAD(va, it);
    while (it < TOT) {
        const int it1 = it + ngw, it2 = it1 + ngw;
        if (it1 < TOT) DENSE_LOAD(vb, it1);
        DENSE_FIN(va, it);
        if (it2 < TOT) DENSE_LOAD(va, it2);
        if (it1 < TOT) DENSE_FIN(vb, it1);
        it = it2;
    }
#undef DENSE_LOAD
#undef DENSE_FIN
}
template <int MODE, bool F8> __device__ __forceinline__ void convert_batch128(const Ctx& c, const float* src, int K, int N, void* dst, int nmat, size_t dst_stride_bytes, float scale) {
    LAS float* scr = (LAS float*)(c.lds + c.wave * 16896);
    const int per = (K / 128) * (N / 32); const long total = (long)per * nmat;
    for (long it = c.gw; it < total; it += c.ngw) {
        const int mat = (int)(it / per), item = (int)(it % per);
        transpose_item128<MODE, F8>(src + (size_t)mat * K * N, K, N, (unsigned char*)dst + (size_t)mat * dst_stride_bytes, scr, item, c.lane, scale);
    }
}

struct ExpertSrc { const float* up; const float* sup; const float* dn; const float* sdn; };
constexpr int EXP_ITEMS_UP = NE * 512, EXP_ITEMS_SUP = 512, EXP_ITEMS_DN = NE * 256, EXP_ITEMS_SDN = 256, EXP_ITEMS = EXP_ITEMS_UP + EXP_ITEMS_SUP + EXP_ITEMS_DN + EXP_ITEMS_SDN;
__device__ __forceinline__ void expert_item(const ExpertSrc& s, int l, unsigned char* ws, LAS float* scr, int it, int lane) {
    unsigned char* wup = ws + WS_WUP + (size_t)l * NEX * UPN * D; unsigned char* wdn = ws + WS_WDN + (size_t)l * NEX * D * ED;
    if (it < EXP_ITEMS_UP) { const int mat = it >> 9; transpose_item128<2, true>(s.up + ((size_t)l * NE + mat) * D * UPN, D, UPN, wup + (size_t)mat * UPN * D, scr, it & 511, lane, F8_WSCALE); return; }
    it -= EXP_ITEMS_UP;
    if (it < EXP_ITEMS_SUP) { transpose_item128<2, true>(s.sup + (size_t)l * D * UPN, D, UPN, wup + (size_t)NE * UPN * D, scr, it, lane, F8_WSCALE); return; }
    it -= EXP_ITEMS_SUP;
    if (it < EXP_ITEMS_DN) { const int mat = it >> 8; transpose_item128<0, true>(s.dn + ((size_t)l * NE + mat) * ED * D, ED, D, wdn + (size_t)mat * D * ED, scr, it & 255, lane, F8_WSCALE); return; }
    it -= EXP_ITEMS_DN;
    transpose_item128<0, true>(s.sdn + (size_t)l * ED * D, ED, D, wdn + (size_t)NE * D * ED, scr, it, lane, F8_WSCALE);
}
struct ERef { const float* W; int N, item; };
__device__ __forceinline__ ERef expert_ref(const ExpertSrc& s, int l, int it) {
    if (it < EXP_ITEMS_UP) return ERef{s.up + ((size_t)l * NE + (it >> 9)) * D * UPN, UPN, it & 511};
    it -= EXP_ITEMS_UP;
    if (it < EXP_ITEMS_SUP) return ERef{s.sup + (size_t)l * D * UPN, UPN, it};
    it -= EXP_ITEMS_SUP;
    if (it < EXP_ITEMS_DN) return ERef{s.dn + ((size_t)l * NE + (it >> 8)) * ED * D, D, it & 255};
    it -= EXP_ITEMS_DN;
    return ERef{s.sdn + (size_t)l * ED * D, D, it};
}
__device__ __forceinline__ void expert_fin(const f32x4 (&v)[16], int l, unsigned char* ws, LAS float* scr, int it, int lane) {
    if (it < EXP_ITEMS_UP + EXP_ITEMS_SUP) { const bool r = it < EXP_ITEMS_UP; const int mat = r ? it >> 9 : NE, item = r ? it & 511 : it - EXP_ITEMS_UP;
        t128_finish<2, true>(v, D, UPN, ws + WS_WUP + ((size_t)l * NEX + mat) * UPN * D, scr, item, lane, F8_WSCALE); }
    else { it -= EXP_ITEMS_UP + EXP_ITEMS_SUP; const bool r = it < EXP_ITEMS_DN; const int mat = r ? it >> 8 : NE, item = r ? it & 255 : it - EXP_ITEMS_DN;
        t128_finish<Y_FP8 ? 3 : 0, true>(v, ED, D, ws + WS_WDN + ((size_t)l * NEX + mat) * D * ED, scr, item, lane, F8_WSCALE); }
}
__device__ __forceinline__ void expert_items_block(const Ctx& c, const ExpertSrc& s, int l, unsigned char* ws, int first, int count) {
    int tid = threadIdx.x; asm volatile("" : "+v"(tid));
    const int lane = tid & 63, wv = __builtin_amdgcn_readfirstlane(tid >> 6);
    LAS float* scr = (LAS float*)(c.lds + wv * 16896);
    f32x4 va[16], vb[16];
    int i = wv;
    if (i < count) { const ERef r = expert_ref(s, l, first + i); t128_load(va, r.W, r.N, r.item, lane); }
#pragma unroll 1
    while (i < count) {
        const int i1 = i + 8, i2 = i + 16;
        if (i1 < count) { const ERef r = expert_ref(s, l, first + i1); t128_load(vb, r.W, r.N, r.item, lane); }
        expert_fin(va, l, ws, scr, first + i, lane);
        if (i2 < count) { const ERef r = expert_ref(s, l, first + i2); t128_load(va, r.W, r.N, r.item, lane); }
        if (i1 < count) expert_fin(vb, l, ws, scr, first + i1, lane);
        i = i2;
    }
}
__device__ __forceinline__ void ada_phase(const Ctx& c, const float* cin, const float* w_ada, const float* b_ada, float* ada) {
    LAS float* red = (LAS float*)(c.lds);
    LAS float* sc = red + 1024;
    for (int i = c.tid; i < 4 * D; i += 512) sc[i] = siluf(cin[i]);
    __syncthreads();
    const int j = c.lane & 7, kr = c.lane >> 3;
    constexpr int NCG = 6 * D / 32;
    for (int u = blockIdx.x; u < 2 * NCG; u += gridDim.x) {
        const int l = u / NCG, cg = u % NCG;
        const int k0 = c.wave * 256 + kr;
        const float* w = w_ada + (size_t)l * D * 6 * D + (size_t)k0 * 6 * D + cg * 32 + 4 * j;
        f32x4 acc[4];
#pragma unroll
        for (int b = 0; b < 4; ++b) acc[b] = (f32x4){0.f, 0.f, 0.f, 0.f};
        f32x4 wv[32];
#pragma unroll
        for (int i = 0; i < 32; ++i) wv[i] = *(const f32x4*)(w + (size_t)(8 * i) * 6 * D);
#pragma unroll
        for (int i = 0; i < 32; ++i)
#pragma unroll
            for (int b = 0; b < 4; ++b) acc[b] += wv[i] * sc[b * D + k0 + 8 * i];
#pragma unroll
        for (int b = 0; b < 4; ++b)
#pragma unroll
            for (int q = 0; q < 4; ++q) { float t = acc[b][q]; t += __shfl_xor(t, 8); t += __shfl_xor(t, 16); t += __shfl_xor(t, 32); acc[b][q] = t; }
        if (kr == 0) {
#pragma unroll
            for (int b = 0; b < 4; ++b) *(LAS f32x4*)(red + (c.wave * 4 + b) * 32 + 4 * j) = acc[b]; }
        __syncthreads();
        if (c.tid < 128) {
            const int b = c.tid >> 5, cc = c.tid & 31; float s2 = b_ada[(size_t)l * 6 * D + cg * 32 + cc];
#pragma unroll
            for (int w8 = 0; w8 < 8; ++w8) s2 += red[(w8 * 4 + b) * 32 + cc];
            ada[((size_t)l * 4 + b) * 6 * D + cg * 32 + cc] = s2;
        }
        __syncthreads();
    }
}

__device__ __forceinline__ void load_row(const float* xrow, int lane, f32x4 (&v)[8]) {
#pragma unroll
    for (int j = 0; j < 8; ++j) v[j] = *(const f32x4*)(xrow + 4 * lane + 256 * j);
}
__device__ __forceinline__ float row_rstd(const f32x4 (&v)[8]) {
    float s = 0.f;
#pragma unroll
    for (int j = 0; j < 8; ++j) s += (v[j].x * v[j].x + v[j].y * v[j].y) + (v[j].z * v[j].z + v[j].w * v[j].w);
    return 1.f / sqrtf(wave_sum(s) * (1.f / D) + RMS_EPS);
}
__device__ __forceinline__ void modulate_row(f32x4 (&v)[8], float rstd, const float* g, const float* sh, const float* sc, int lane) {
#pragma unroll
    for (int j = 0; j < 8; ++j) { const int col = 4 * lane + 256 * j;
        const f32x4 gg = *(const f32x4*)(g + col), s1 = *(const f32x4*)(sc + col), s0 = *(const f32x4*)(sh + col);
        v[j] = v[j] * rstd * gg * (s1 + 1.f) + s0; }
}
__device__ __forceinline__ void store_row_bf16(bf16* orow, const f32x4 (&v)[8], int lane) {
#pragma unroll
    for (int j = 0; j < 8; ++j) { u32x2 w; w.x = pk2(v[j].x, v[j].y); w.y = pk2(v[j].z, v[j].w); *(u32x2*)(orow + 4 * lane + 256 * j) = w; }
}
__device__ __forceinline__ void store_row_fp8(unsigned char* orow, const f32x4 (&v)[8], int lane, float scale) {
#pragma unroll
    for (int j = 0; j < 8; ++j) *(unsigned*)(orow + 4 * lane + 256 * j) = pk4_fp8(v[j].x * scale, v[j].y * scale, v[j].z * scale, v[j].w * scale);
}
__device__ __forceinline__ void norm_phase(const Ctx& c, const float* x, const float* g, const float* ada_l  , int sh_off, int sc_off, bf16* out) {
    for (int m = c.gw; m < M; m += c.ngw) {
        const int b = m / T; f32x4 v[8]; load_row(x + (size_t)m * D, c.lane, v);
        const float rstd = row_rstd(v);
        modulate_row(v, rstd, g, ada_l + (size_t)b * 6 * D + sh_off, ada_l + (size_t)b * 6 * D + sc_off, c.lane);
#if USE_FP8_QKV
        store_row_fp8((unsigned char*)out + (size_t)m * D, v, c.lane, F8_HSCALE);
#else
        store_row_bf16(out + (size_t)m * D, v, c.lane);
#endif
    }
}

__device__ __forceinline__ void wave_gemm_32x64(const bf16* a0, const bf16* a1, const bf16* b, int K, int lane, f32x4 (&acc)[2][4]) {
    const int q8 = (lane >> 4) * 8;
    for (int k0 = 0; k0 < K; k0 += 32) {
        const bf16x8 fa0 = *(const bf16x8*)(a0 + k0 + q8), fa1 = *(const bf16x8*)(a1 + k0 + q8);
#pragma unroll
        for (int n = 0; n < 4; ++n) { const bf16x8 fb = *(const bf16x8*)(b + (size_t)n * 16 * K + k0 + q8);
            acc[0][n] = __builtin_amdgcn_mfma_f32_16x16x32_bf16(fa0, fb, acc[0][n], 0, 0, 0);
            acc[1][n] = __builtin_amdgcn_mfma_f32_16x16x32_bf16(fa1, fb, acc[1][n], 0, 0, 0); }
    }
}
#define ZERO_ACC(acc) do { _Pragma("unroll") for (int _a = 0; _a < 2; ++_a) _Pragma("unroll") for (int _b = 0; _b < 4; ++_b) acc[_a][_b] = (f32x4){0.f, 0.f, 0.f, 0.f}; } while (0)

__device__ __forceinline__ void gemm_plain_bf16(const Ctx& c, const bf16* A, const bf16* Bt, int K, int N, bf16* C) {
    const int ntn = N / 64, units = (M / 256) * ntn;
    for (int u = blockIdx.x; u < units; u += gridDim.x) {
        const int mt = u / ntn, nt = u % ntn, row0 = mt * 256 + c.wave * 32, n0 = nt * 64;
        f32x4 acc[2][4]; ZERO_ACC(acc);
        const int r = c.lane & 15;
        wave_gemm_32x64(A + (size_t)(row0 + r) * K, A + (size_t)(row0 + 16 + r) * K, Bt + (size_t)(n0 + r) * K, K, c.lane, acc);
#pragma unroll
        for (int mi = 0; mi < 2; ++mi)
#pragma unroll
            for (int n = 0; n < 4; ++n)
#pragma unroll
                for (int j = 0; j < 4; ++j) C[(size_t)(row0 + 16 * mi + 4 * (c.lane >> 4) + j) * N + n0 + 16 * n + r] = (bf16)f2bf(acc[mi][n][j]);
    }
}
__device__ __forceinline__ void gemm_outproj(const Ctx& c, const bf16* A, const bf16* Bt, const float* xin, const float* gm  , float* X1) {
    const int K = D, N = D, ntn = N / 64, units = (M / 256) * ntn;
    for (int u = blockIdx.x; u < units; u += gridDim.x) {
        const int mt = u / ntn, nt = u % ntn, row0 = mt * 256 + c.wave * 32, n0 = nt * 64;
        f32x4 acc[2][4]; ZERO_ACC(acc);
        const int r = c.lane & 15;
        wave_gemm_32x64(A + (size_t)(row0 + r) * K, A + (size_t)(row0 + 16 + r) * K, Bt + (size_t)(n0 + r) * K, K, c.lane, acc);
        const int b = row0 / T;
#pragma unroll
        for (int mi = 0; mi < 2; ++mi)
#pragma unroll
            for (int n = 0; n < 4; ++n)
#pragma unroll
                for (int j = 0; j < 4; ++j) { const size_t o = (size_t)(row0 + 16 * mi + 4 * (c.lane >> 4) + j) * N + n0 + 16 * n + r;
                    X1[o] = xin[o] + gm[(size_t)b * 6 * D + n0 + 16 * n + r] * acc[mi][n][j]; }
    }
}

__device__ __forceinline__ void qknorm_chunk(bf16* p, const float* g) {
    float v[64]; float ss = 0.f;
#pragma unroll
    for (int i = 0; i < 8; ++i) { const u32x4 w = *(const u32x4*)(p + 8 * i);
#pragma unroll
        for (int j = 0; j < 4; ++j) { v[8 * i + 2 * j] = bf2f(w[j] & 0xffffu); v[8 * i + 2 * j + 1] = bf2f(w[j] >> 16); } }
#pragma unroll
    for (int i = 0; i < 64; ++i) ss += v[i] * v[i];
    const float rs = 1.f / sqrtf(ss * (1.f / 64.f) + RMS_EPS);
#pragma unroll
    for (int i = 0; i < 8; ++i) { u32x4 w;
#pragma unroll
        for (int j = 0; j < 4; ++j) w[j] = pk2(v[8 * i + 2 * j] * rs * g[8 * i + 2 * j], v[8 * i + 2 * j + 1] * rs * g[8 * i + 2 * j + 1]);
        *(u32x4*)(p + 8 * i) = w; }
}
__device__ __forceinline__ void qknorm0_phase(const Ctx& c, bf16* qkv, const float* gains  ) {
    const long total = (long)M * 50;
    for (long id = gtid_now(); id < total; id += c.gsz) {
        const int m = (int)(id / 50), k = (int)(id % 50); int ch, gi;
        if (k < 16) { ch = k; gi = 0; } else if (k < 32) { ch = k; gi = 1; } else if (k < 48) { ch = k + 16; gi = 2; } else { ch = k + 16; gi = 3; }
        qknorm_chunk(qkv + (size_t)m * AB_IN + 64 * ch, gains + 64 * gi);
    }
}
__device__ __forceinline__ void qknorm1_phase(const Ctx& c, bf16* qkv, const float* gains  ) {
    const long total = (long)M * 64;
    for (long id = gtid_now(); id < total; id += c.gsz) {
        const int m = (int)(id / 64), ch = (int)(id % 64);
        qknorm_chunk(qkv + (size_t)m * C_IN + 64 * ch, gains + 64 * (ch >> 5));
    }
}

__device__ __forceinline__ void load64(const bf16* p, float (&v)[64], float scale) {
#pragma unroll
    for (int i = 0; i < 8; ++i) { const u32x4 w = *(const u32x4*)(p + 8 * i);
#pragma unroll
        for (int j = 0; j < 4; ++j) { v[8 * i + 2 * j] = bf2f(w[j] & 0xffffu) * scale; v[8 * i + 2 * j + 1] = bf2f(w[j] >> 16) * scale; } }
}
__device__ __forceinline__ float dot64(const float (&q)[64], const bf16* kp) {
    float s0 = 0.f, s1 = 0.f;
#pragma unroll
    for (int i = 0; i < 8; ++i) { const u32x4 w = *(const u32x4*)(kp + 8 * i);
#pragma unroll
        for (int j = 0; j < 4; ++j) { s0 += q[8 * i + 2 * j] * bf2f(w[j] & 0xffffu); s1 += q[8 * i + 2 * j + 1] * bf2f(w[j] >> 16); } }
    return s0 + s1;
}
__device__ __forceinline__ void axpy64(float (&o)[64], float a, float p, const bf16* vp) {
#pragma unroll
    for (int i = 0; i < 8; ++i) { const u32x4 w = *(const u32x4*)(vp + 8 * i);
#pragma unroll
        for (int j = 0; j < 4; ++j) { o[8 * i + 2 * j] = o[8 * i + 2 * j] * a + p * bf2f(w[j] & 0xffffu); o[8 * i + 2 * j + 1] = o[8 * i + 2 * j + 1] * a + p * bf2f(w[j] >> 16); } }
}
__device__ __forceinline__ void store64_bf16(bf16* p, const float (&o)[64], float s) {
#pragma unroll
    for (int i = 0; i < 8; ++i) { u32x4 w;
#pragma unroll
        for (int j = 0; j < 4; ++j) w[j] = pk2(o[8 * i + 2 * j] * s, o[8 * i + 2 * j + 1] * s);
        *(u32x4*)(p + 8 * i) = w; }
}
__device__ __forceinline__ void attn0_phase(const Ctx& c, const bf16* qkv, const float* sinks, bf16* O) {
    const long total = (long)32 * M;
    for (long id = gtid_now(); id < total; id += c.gsz) {
        const int hh = (int)(id / M), m = (int)(id % M), b = m / T, t = m % T;
        float q[64], o[64];
#pragma unroll
        for (int i = 0; i < 64; ++i) o[i] = 0.f;
        float mx = -1e30f, l = 0.f;
        if (hh < 16) {
            const int h = hh; const float slope = exp2f(-0.5f * (float)(h + 1));
            load64(qkv + (size_t)m * AB_IN + 64 * h, q, 0.125f);
            const bf16* kb = qkv + (size_t)b * T * AB_IN + 1024 + 64 * h;
            for (int br = 0; br < 3; ++br) {
                const int dil = br == 0 ? 1 : (br == 1 ? 4 : 16);
                for (int j = 0; j <= 128; ++j) {
                    const int s = t - dil * j; if (s < 0) break;
                    const bf16* kp = kb + (size_t)s * AB_IN;
                    const float sc = dot64(q, kp) - slope * (float)(dil * j);
                    const float mn = fmaxf(mx, sc), a = __expf(mx - mn), p = __expf(sc - mn);
                    l = l * a + p; axpy64(o, a, p, kp + 1024); mx = mn;
                }
            }
            store64_bf16(O + (size_t)m * D + 64 * h, o, 1.f / l);
        } else {
            const int h = hh - 16, kvh = h >> 3; const float slope = exp2f(-0.5f * (float)(h + 1));
            load64(qkv + (size_t)m * AB_IN + 3072 + 64 * h, q, 0.125f);
            const bf16* kb = qkv + (size_t)b * T * AB_IN + 4096 + 64 * kvh;
            for (int j = 0; j < 128; ++j) {
                const int s = t - j; if (s < 0) break;
                const bf16* kp = kb + (size_t)s * AB_IN;
                const float sc = dot64(q, kp) - slope * (float)j;
                const float mn = fmaxf(mx, sc), a = __expf(mx - mn), p = __expf(sc - mn);
                l = l * a + p; axpy64(o, a, p, kp + 128); mx = mn;
            }
            const float sk = sinks[h], mn = fmaxf(mx, sk), a = __expf(mx - mn);
            l = l * a + __expf(sk - mn);
            store64_bf16(O + (size_t)m * D + 1024 + 64 * h, o, a / l);
        }
    }
}
__device__ __forceinline__ void attn1_phase(const Ctx& c, const bf16* qkv, float* tmp) {
    const int items = NB * 16 * 2 * 2 * (T / 64);
    for (int it = c.gw; it < items; it += c.ngw) {
        const int tb = (T / 64 - 1) - it / (NB * 16 * 4); const int r = it % (NB * 16 * 4);
        const int b = r / 64, h = (r / 4) % 16, i = (r >> 1) & 1, j = r & 1;
        const int t = tb * 64 + c.lane, m = b * T + t;
        const float slope = exp2f(-0.5f * (float)(h + 1));
        float q[64], o[64];
#pragma unroll
        for (int d = 0; d < 64; ++d) o[d] = 0.f;
        float mx = -1e30f, l = 0.f;
        load64(qkv + (size_t)m * C_IN + 128 * h + 64 * i, q, 0.125f);
        const bf16* kb = qkv + (size_t)b * T * C_IN + 2048 + 128 * h + 64 * i;
        const bf16* vb = qkv + (size_t)b * T * C_IN + 4096 + 128 * h + 64 * j;
        const int smax = tb * 64 + 63;
        for (int s = 0; s <= smax; ++s) {
            const bf16* kp = kb + (size_t)s * C_IN;
            float sc = dot64(q, kp) - slope * (float)(t - s);
            if (s > t) sc = -1e30f;
            const float mn = fmaxf(mx, sc), a = __expf(mx - mn), p = (s > t) ? 0.f : __expf(sc - mn);
            l = l * a + p; axpy64(o, a, p, vb + (size_t)s * C_IN); mx = mn;
        }
        float* op = tmp + (((size_t)m * 16 + h) * 2 + i) * 128 + 64 * j; const float il = 1.f / l;
#pragma unroll
        for (int d = 0; d < 16; ++d) *(f32x4*)(op + 4 * d) = (f32x4){o[4 * d] * il, o[4 * d + 1] * il, o[4 * d + 2] * il, o[4 * d + 3] * il};
    }
}
__device__ __forceinline__ void attn1_finish_phase(const Ctx& c, const float* tmp, const float* lamp  , const float* subln  , bf16* O) {
    float s01 = 0.f, s23 = 0.f;
    for (int i = 0; i < 64; ++i) { s01 += lamp[i] * lamp[64 + i]; s23 += lamp[128 + i] * lamp[192 + i]; }
    const float lam_init = 0.8f - 0.6f * expf(-0.3f * 1.0f);
    const float lam = expf(s01) - expf(s23) + lam_init;
    const long total = (long)M * 16;
    for (long id = gtid_now(); id < total; id += c.gsz) {
        const float* p1 = tmp + (size_t)id * 256; const float* p2 = p1 + 128;
        float ss = 0.f;
        for (int d = 0; d < 128; ++d) { const float v = p1[d] - lam * p2[d]; ss += v * v; }
        const float rs = (1.f - lam_init) / sqrtf(ss * (1.f / 128.f) + RMS_EPS);
        bf16* op = O + (size_t)id * 128;
        for (int d = 0; d < 128; d += 2) { const float v0 = (p1[d] - lam * p2[d]) * rs * subln[d], v1 = (p1[d + 1] - lam * p2[d + 1]) * rs * subln[d + 1];
            *(unsigned*)(op + d) = pk2(v0, v1); }
    }
}

__device__ __forceinline__ void router_phase(const Ctx& c, const float* x1, const float* g, const float* ada_l, const float* wr  , const float* rbias  ,
                                             bf16* HF, int* idx, float* gate, unsigned* counts) {
    LAS float* hb = (LAS float*)(c.lds + c.wave * 8192);
    const int lane = c.lane;
    for (int m = c.gw; m < M; m += c.ngw) {
        const int b = m / T; f32x4 v[8]; load_row(x1 + (size_t)m * D, lane, v);
        const float rstd = row_rstd(v);
        modulate_row(v, rstd, g, ada_l + (size_t)b * 6 * D + 3 * D, ada_l + (size_t)b * 6 * D + 4 * D, lane);
        store_row_bf16(HF + (size_t)m * D, v, lane);
#pragma unroll
        for (int j = 0; j < 8; ++j) *(LAS f32x4*)(hb + 4 * lane + 256 * j) = v[j];
        asm volatile("s_waitcnt lgkmcnt(0)" ::: "memory");
        float a0 = 0.f, a1 = 0.f, a2 = 0.f, a3 = 0.f;
        for (int k = 0; k < D; k += 4) {
            const f32x4 hv = *(const LAS f32x4*)(hb + k);
            a0 += hv.x * wr[(size_t)(k + 0) * 64 + lane]; a1 += hv.y * wr[(size_t)(k + 1) * 64 + lane];
            a2 += hv.z * wr[(size_t)(k + 2) * 64 + lane]; a3 += hv.w * wr[(size_t)(k + 3) * 64 + lane];
        }
        const float logit = (a0 + a1) + (a2 + a3);
        const float score = 1.f / (1.f + expf(-logit));
        const float sel = score + rbias[lane];
        float m1 = sel;
        m1 = fmaxf(m1, __shfl_xor(m1, 1)); m1 = fmaxf(m1, __shfl_xor(m1, 2)); m1 = fmaxf(m1, __shfl_xor(m1, 4));
        const unsigned long long eqm = __ballot(sel == m1);
        const int gbase = lane & ~7;
        const unsigned grp_eq = (unsigned)((eqm >> gbase) & 0xffull);
        const int first = __builtin_ctz(grp_eq);
        float m2 = ((lane & 7) == first) ? -3e38f : sel;
        m2 = fmaxf(m2, __shfl_xor(m2, 1)); m2 = fmaxf(m2, __shfl_xor(m2, 2)); m2 = fmaxf(m2, __shfl_xor(m2, 4));
        const float gs = m1 + m2;
        int grank = 0; const int mygrp = lane >> 3;
#pragma unroll
        for (int g2 = 0; g2 < 8; ++g2) { const float o = __shfl(gs, g2 * 8); grank += (o > gs || (o == gs && g2 < mygrp)) ? 1 : 0; }
        const float msel = (grank < 4) ? sel : -1e30f;
        int rank = 0;
        for (int e2 = 0; e2 < 64; ++e2) { const float o = __shfl(msel, e2); rank += (o > msel || (o == msel && e2 < lane)) ? 1 : 0; }
        const bool chosen = rank < TOPK;
        const float gsum = wave_sum(chosen ? score : 0.f);
        if (chosen) { idx[(size_t)m * 8 + rank] = lane; gate[(size_t)m * 8 + rank] = score / gsum * 2.5f;
            __hip_atomic_fetch_add(counts + lane, 1u, __ATOMIC_RELAXED, __HIP_MEMORY_SCOPE_AGENT); }
    }
}
__device__ __forceinline__ void slot_phase(const Ctx& c, const int* idx, const unsigned* counts, unsigned* cursor, unsigned* nrt_out, int* pos, int* slot_tok, int* tile_exp) {
    LAS int* ps = (LAS int*)c.lds;
    if (c.tid == 0) { int acc = 0; for (int e = 0; e < NE; ++e) { const int cn = (int)counts[e]; ps[e] = acc; ps[64 + e] = cn; acc += (cn + 255) / 256 * 256; } ps[128] = acc; }
    __syncthreads();
    for (int a = gtid_now(); a < M * TOPK; a += c.gsz) {
        const int e = idx[a]; const unsigned r = __hip_atomic_fetch_add(cursor + e, 1u, __ATOMIC_RELAXED, __HIP_MEMORY_SCOPE_AGENT);
        const int slot = ps[e] + (int)r; slot_tok[slot] = a >> 3; pos[a] = slot;
    }
    for (int t = gtid_now(); t < M; t += c.gsz) slot_tok[CAPR + t] = t;
    if (blockIdx.x == 0) {
        if (c.tid < NE) { const int e = c.tid, s0 = ps[e], cn = ps[64 + e], pe = s0 + (cn + 255) / 256 * 256;
            for (int s = s0 + cn; s < pe; ++s) slot_tok[s] = 0;
            for (int tt = s0 / 256; tt < pe / 256; ++tt) tile_exp[tt] = e; }
        if (c.tid == 0) *nrt_out = (unsigned)(ps[128] / 256);
    }
    __syncthreads();
}
__device__ __forceinline__ void moe_up_phase(const Ctx& c, const bf16* HF, const bf16* Wup_l  , const int* slot_tok, const int* tile_exp, const unsigned* nrt_p, bf16* ACT) {
    const int nrt = (int)*nrt_p, ntiles = nrt + M / 256, units = ntiles * (ED / 64);
    for (int u = blockIdx.x; u < units; u += gridDim.x) {
        const int mt = u / (ED / 64), nt = u % (ED / 64), n0 = nt * 64;
        const int e = mt < nrt ? tile_exp[mt] : NE; const int slot0 = (mt < nrt ? mt * 256 : CAPR + (mt - nrt) * 256) + c.wave * 32;
        const int r = c.lane & 15;
        const bf16* a0 = HF + (size_t)slot_tok[slot0 + r] * D; const bf16* a1 = HF + (size_t)slot_tok[slot0 + 16 + r] * D;
        const bf16* W = Wup_l + (size_t)e * UPN * D;
        f32x4 ag[2][4], au[2][4]; ZERO_ACC(ag); ZERO_ACC(au);
        wave_gemm_32x64(a0, a1, W + (size_t)(n0 + r) * D, D, c.lane, ag);
        wave_gemm_32x64(a0, a1, W + (size_t)(ED + n0 + r) * D, D, c.lane, au);
#pragma unroll
        for (int mi = 0; mi < 2; ++mi)
#pragma unroll
            for (int n = 0; n < 4; ++n)
#pragma unroll
                for (int j = 0; j < 4; ++j) ACT[(size_t)(slot0 + 16 * mi + 4 * (c.lane >> 4) + j) * ED + n0 + 16 * n + r] = (bf16)f2bf(siluf(ag[mi][n][j]) * au[mi][n][j]);
    }
}
__device__ __forceinline__ void moe_down_phase(const Ctx& c, const bf16* ACT, const bf16* Wdn_l  , const int* tile_exp, const unsigned* nrt_p, bf16* Y) {
    const int nrt = (int)*nrt_p, ntiles = nrt + M / 256, units = ntiles * (D / 64);
    for (int u = blockIdx.x; u < units; u += gridDim.x) {
        const int mt = u / (D / 64), nt = u % (D / 64), n0 = nt * 64;
        const int e = mt < nrt ? tile_exp[mt] : NE; const int slot0 = (mt < nrt ? mt * 256 : CAPR + (mt - nrt) * 256) + c.wave * 32;
        const int r = c.lane & 15;
        const bf16* W = Wdn_l + (size_t)e * D * ED;
        f32x4 acc[2][4]; ZERO_ACC(acc);
        wave_gemm_32x64(ACT + (size_t)(slot0 + r) * ED, ACT + (size_t)(slot0 + 16 + r) * ED, W + (size_t)(n0 + r) * ED, ED, c.lane, acc);
#pragma unroll
        for (int mi = 0; mi < 2; ++mi)
#pragma unroll
            for (int n = 0; n < 4; ++n)
#pragma unroll
                for (int j = 0; j < 4; ++j) Y[(size_t)(slot0 + 16 * mi + 4 * (c.lane >> 4) + j) * D + n0 + 16 * n + r] = (bf16)f2bf(acc[mi][n][j]);
    }
}
__device__ __forceinline__ void add_row_bf16(f32x4 (&acc)[8], const bf16* yrow, float w, int lane) {
#pragma unroll
    for (int j = 0; j < 8; ++j) { const u32x2 v = *(const u32x2*)(yrow + 4 * lane + 256 * j);
        acc[j].x += w * bf2f(v.x & 0xffffu); acc[j].y += w * bf2f(v.x >> 16); acc[j].z += w * bf2f(v.y & 0xffffu); acc[j].w += w * bf2f(v.y >> 16); }
}
__device__ __forceinline__ void add_row_fp8(f32x4 (&acc)[8], const unsigned char* yrow, float w, int lane) {
#pragma unroll
    for (int j = 0; j < 8; ++j) { const unsigned v = *(const unsigned*)(yrow + 4 * lane + 256 * j);
        acc[j].x += w * __builtin_amdgcn_cvt_f32_fp8(v, 0); acc[j].y += w * __builtin_amdgcn_cvt_f32_fp8(v, 1); acc[j].z += w * __builtin_amdgcn_cvt_f32_fp8(v, 2); acc[j].w += w * __builtin_amdgcn_cvt_f32_fp8(v, 3); }
}
template <bool NEXT>
__device__ __forceinline__ void combine_phase(const Ctx& c, const float* x1, const bf16* Y, const int* pos, const float* gate, const float* ada_l, float* xo,
                                              const float* gnext, const float* ada_next, bf16* XN) {
    for (int m = c.gw; m < M; m += c.ngw) {
        const int b = m / T; f32x4 acc[8];
#pragma unroll
        for (int j = 0; j < 8; ++j) acc[j] = (f32x4){0.f, 0.f, 0.f, 0.f};
#if USE_FP8_MOE && Y_FP8
        for (int k = 0; k < TOPK; ++k) add_row_fp8(acc, (const unsigned char*)Y + (size_t)pos[(size_t)m * 8 + k] * D, gate[(size_t)m * 8 + k] * (1.f / F8_YSCALE), c.lane);
        add_row_fp8(acc, (const unsigned char*)Y + (size_t)(CAPR + m) * D, 1.f / F8_YSCALE, c.lane);
#else
        for (int k = 0; k < TOPK; ++k) add_row_bf16(acc, Y + (size_t)pos[(size_t)m * 8 + k] * D, gate[(size_t)m * 8 + k], c.lane);
        add_row_bf16(acc, Y + (size_t)(CAPR + m) * D, 1.f, c.lane);
#endif
        const float* gf = ada_l + (size_t)b * 6 * D + 5 * D;
        f32x4 v[8];
#pragma unroll
        for (int j = 0; j < 8; ++j) { const int col = 4 * c.lane + 256 * j;
#if RES_BF16
            { const u32x2 xw = *(const u32x2*)((const bf16*)x1 + (size_t)m * D + col);
              v[j] = (f32x4){bf2f(xw.x & 0xffffu), bf2f(xw.x >> 16), bf2f(xw.y & 0xffffu), bf2f(xw.y >> 16)} + *(const f32x4*)(gf + col) * acc[j]; }
            if (NEXT) { u32x2 ow; ow.x = pk2(v[j].x, v[j].y); ow.y = pk2(v[j].z, v[j].w); *(u32x2*)((bf16*)xo + (size_t)m * D + col) = ow; }
            else *(f32x4*)(xo + (size_t)m * D + col) = v[j];
#else
            v[j] = *(const f32x4*)(x1 + (size_t)m * D + col) + *(const f32x4*)(gf + col) * acc[j];
            *(f32x4*)(xo + (size_t)m * D + col) = v[j];
#endif
            }
        if (NEXT) {
            const float rstd = row_rstd(v);
            modulate_row(v, rstd, gnext, ada_next + (size_t)b * 6 * D, ada_next + (size_t)b * 6 * D + D, c.lane);
#if USE_FP8_QKV
            store_row_fp8((unsigned char*)XN + (size_t)m * D, v, c.lane, F8_HSCALE);
#else
            store_row_bf16(XN + (size_t)m * D, v, c.lane);
#endif
        }
    }
}


namespace pg8 {
constexpr int BM = 256, BK = 64, HALF = 128, HTB = HALF * BK * 2, STAGE_BYTES = 8 * HTB, NXCD = 8, WGM = 8;
__device__ __forceinline__ int lds_byte(int r, int c) { const int st = (r >> 4) * 2 + (c >> 5), rr = r & 15, cc = c & 31, ob = rr * 64 + cc * 2; return st * 1024 + (ob ^ (((ob >> 9) & 1) << 5)); }
__device__ __forceinline__ void stage_rc(int b, int& R, int& C) { const int st = b / 1024, sb = b % 1024, swz = sb ^ (((sb >> 9) & 1) << 5); R = (st >> 1) * 16 + swz / 64; C = (st & 1) * 32 + (swz % 64) / 2; }
__device__ __forceinline__ int perm32(int rho) { const int n = rho >> 4, i = rho & 15; return 8 * (i >> 2) + 4 * n + (i & 3); }
__device__ __forceinline__ unsigned cvt_pk_bf16(float lo, float hi) { unsigned r; asm volatile("v_cvt_pk_bf16_f32 %0, %1, %2" : "=v"(r) : "v"(lo), "v"(hi)); return r; }

struct Unit { int row0, pn; const char* Bp; };

struct TileOrder {
    int nM, nN, nwg, G, c;
    __device__ __forceinline__ void init(int nM_, int nN_, int G_, int c_) { nM = nM_; nN = nN_; nwg = nM * nN; G = G_; c = c_; }
    __device__ __forceinline__ bool tile(int i, int& pm, int& pn) const {
        const long L = (long)i * G + c; if (L >= nwg) return false;
        int wgid = (int)L; { const int q = nwg / NXCD, r = nwg % NXCD, xcd = wgid % NXCD, off = wgid / NXCD; wgid = (xcd < r ? xcd * (q + 1) : r * (q + 1) + (xcd - r) * q) + off; }
        const int nig = WGM * nN, gid = wgid / nig, fm = gid * WGM, gsz = (nM - fm) < WGM ? (nM - fm) : WGM;
        pm = fm + ((wgid % nig) % gsz); pn = (wgid % nig) / gsz; return true;
    }
};
struct PlainSched {
    static constexpr bool GATHER = false;
    TileOrder o; const char* Bt; int K;
    __device__ __forceinline__ bool next(int i, Unit& u) const { int pm, pn; if (!o.tile(i, pm, pn)) return false; u.row0 = pm * BM; u.pn = pn; u.Bp = Bt + (size_t)pn * BM * K * 2; return true; }
    __device__ __forceinline__ unsigned arow_off(const Unit& u, int rl) const { return (unsigned)(u.row0 + rl) * (unsigned)(K * 2); }
};
template <bool GATHER_> struct GroupSched {
    static constexpr bool GATHER = GATHER_;
    TileOrder o; const char* W; size_t wstride; int K, nrt; const LAS int* tile_exp; const int* slot_tok;
    __device__ __forceinline__ bool next(int i, Unit& u) const { int pm, pn; if (!o.tile(i, pm, pn)) return false;
        const int e = pm < nrt ? tile_exp[pm] : NE; u.row0 = pm < nrt ? pm * BM : CAPR + (pm - nrt) * BM; u.pn = pn; u.Bp = W + (size_t)e * wstride + (size_t)pn * BM * K * 2; return true; }
    __device__ __forceinline__ unsigned arow_off(const Unit& u, int rl) const { const int r = GATHER ? slot_tok[u.row0 + rl] : (u.row0 + rl); return (unsigned)r * (unsigned)(K * 2); }
};

template <int LAYER> struct EpiQKV {
    static constexpr bool PERM = true;
    bf16* O; int ldc; const float* gains; float qscale, ascale;
    __device__ __forceinline__ void operator()(const f32x4 (&acc)[2][2][4][2], const Unit& u, int wr, int wc, int fr, int fq) const {
        const int head = 4 * u.pn + wc; int gi;
        if (LAYER == 0) gi = head < 16 ? 0 : head < 32 ? 1 : head < 48 ? -1 : head < 64 ? 2 : head < 66 ? 3 : -1;
        else gi = head < 32 ? 0 : head < 64 ? 1 : -1;
        f32x4 gv[2][2];
#pragma unroll
        for (int bj = 0; bj < 2; ++bj)
#pragma unroll
            for (int n = 0; n < 2; ++n) gv[bj][n] = gi >= 0 ? *(const f32x4*)(gains + 64 * gi + 32 * bj + 8 * fq + 4 * n) : (f32x4){1.f, 1.f, 1.f, 1.f};
#if QKV_HEADMAJOR
        bf16* base = O + ((size_t)head * M + (size_t)(u.row0 + wr * 64 + fr)) * 64 + 8 * fq; const int ldo = 64;
#else
        bf16* base = O + (size_t)(u.row0 + wr * 64 + fr) * ldc + 64 * head + 8 * fq; const int ldo = ldc;
#endif
#pragma unroll
        for (int ai = 0; ai < 2; ++ai)
#pragma unroll
            for (int m = 0; m < 4; ++m) {
                float ss = 0.f;
#pragma unroll
                for (int bj = 0; bj < 2; ++bj)
#pragma unroll
                    for (int n = 0; n < 2; ++n) { const f32x4 x = acc[ai][bj][m][n]; ss += (x[0] * x[0] + x[1] * x[1]) + (x[2] * x[2] + x[3] * x[3]); }
                ss += __shfl_xor(ss, 16); ss += __shfl_xor(ss, 32); ss *= ascale * ascale;
                const bool isq = LAYER == 0 ? (gi == 0 || gi == 2) : (gi == 0);
                const float rs = ascale * (gi >= 0 ? (isq ? qscale : 1.f) / sqrtf(ss * (1.f / 64.f) + RMS_EPS) : 1.f);
                bf16* rowp = base + (size_t)(ai * HALF + m * 16) * ldo;
#pragma unroll
                for (int bj = 0; bj < 2; ++bj) { const f32x4 v0 = acc[ai][bj][m][0] * rs * gv[bj][0], v1 = acc[ai][bj][m][1] * rs * gv[bj][1];
                    u32x4 w; w.x = cvt_pk_bf16(v0[0], v0[1]); w.y = cvt_pk_bf16(v0[2], v0[3]); w.z = cvt_pk_bf16(v1[0], v1[1]); w.w = cvt_pk_bf16(v1[2], v1[3]);
                    *(u32x4*)(rowp + 32 * bj) = w; }
            }
    }
};
struct EpiOut {
    static constexpr bool PERM = false;
    const float* xin; const float* gm; float* X1;
    __device__ __forceinline__ void operator()(const f32x4 (&acc)[2][2][4][2], const Unit& u, int wr, int wc, int fr, int fq) const {
        const int col0 = u.pn * BM + wc * 32 + 4 * fq; const float* g = gm + (size_t)(u.row0 / T) * 6 * D + col0;
        f32x4 gv[2][2];
#pragma unroll
        for (int bj = 0; bj < 2; ++bj)
#pragma unroll
            for (int n = 0; n < 2; ++n) gv[bj][n] = *(const f32x4*)(g + bj * HALF + n * 16);
#pragma unroll
        for (int ai = 0; ai < 2; ++ai)
#pragma unroll
            for (int m = 0; m < 4; ++m) { const size_t off = (size_t)(u.row0 + wr * 64 + fr + ai * HALF + m * 16) * D + col0;
#pragma unroll
                for (int bj = 0; bj < 2; ++bj)
#pragma unroll
                    for (int n = 0; n < 2; ++n) *(f32x4*)(X1 + off + bj * HALF + n * 16) = *(const f32x4*)(xin + off + bj * HALF + n * 16) + gv[bj][n] * acc[ai][bj][m][n]; }
    }
};

template <bool XIN_BF16> struct EpiOutB {
    static constexpr bool PERM = true;
    const void* xin; const float* gm; bf16* X1b;
    __device__ __forceinline__ void operator()(const f32x4 (&acc)[2][2][4][2], const Unit& u, int wr, int wc, int fr, int fq) const {
        const int col0 = u.pn * BM + wc * 32 + 8 * fq; const float* g = gm + (size_t)(u.row0 / T) * 6 * D + col0;
        f32x4 gv[2][2];
#pragma unroll
        for (int bj = 0; bj < 2; ++bj)
#pragma unroll
            for (int n = 0; n < 2; ++n) gv[bj][n] = *(const f32x4*)(g + bj * HALF + 4 * n);
#pragma unroll
        for (int ai = 0; ai < 2; ++ai)
#pragma unroll
            for (int m = 0; m < 4; ++m) { const size_t off = (size_t)(u.row0 + wr * 64 + fr + ai * HALF + m * 16) * D + col0;
#pragma unroll
                for (int bj = 0; bj < 2; ++bj) { f32x4 x0, x1v;
                    if (XIN_BF16) { const u32x4 xw = *(const u32x4*)((const bf16*)xin + off + bj * HALF);
                        x0 = (f32x4){bf2f(xw.x & 0xffffu), bf2f(xw.x >> 16), bf2f(xw.y & 0xffffu), bf2f(xw.y >> 16)}; x1v = (f32x4){bf2f(xw.z & 0xffffu), bf2f(xw.z >> 16), bf2f(xw.w & 0xffffu), bf2f(xw.w >> 16)}; }
                    else { x0 = *(const f32x4*)((const float*)xin + off + bj * HALF); x1v = *(const f32x4*)((const float*)xin + off + bj * HALF + 4); }
                    const f32x4 v0 = x0 + gv[bj][0] * acc[ai][bj][m][0], v1 = x1v + gv[bj][1] * acc[ai][bj][m][1];
                    u32x4 w; w.x = cvt_pk_bf16(v0[0], v0[1]); w.y = cvt_pk_bf16(v0[2], v0[3]); w.z = cvt_pk_bf16(v1[0], v1[1]); w.w = cvt_pk_bf16(v1[2], v1[3]);
                    *(u32x4*)(X1b + off + bj * HALF) = w; } }
    }
};
__device__ __forceinline__ float silu_fast(float x) { return x * __builtin_amdgcn_rcpf(1.f + __builtin_amdgcn_exp2f(-1.4426950408889634f * x)); }
struct EpiUp {
    static constexpr bool PERM = true;
    bf16* ACT;
    __device__ __forceinline__ void operator()(const f32x4 (&acc)[2][2][4][2], const Unit& u, int wr, int wc, int fr, int fq) const {
        bf16* base = ACT + (size_t)(u.row0 + wr * 64 + fr) * ED + 128 * u.pn + 32 * wc + 8 * fq;
#pragma unroll
        for (int ai = 0; ai < 2; ++ai)
#pragma unroll
            for (int m = 0; m < 4; ++m) { f32x4 v[2];
#pragma unroll
                for (int n = 0; n < 2; ++n)
#pragma unroll
                    for (int i = 0; i < 4; ++i) v[n][i] = silu_fast(acc[ai][0][m][n][i]) * acc[ai][1][m][n][i];
                u32x4 w; w.x = cvt_pk_bf16(v[0][0], v[0][1]); w.y = cvt_pk_bf16(v[0][2], v[0][3]); w.z = cvt_pk_bf16(v[1][0], v[1][1]); w.w = cvt_pk_bf16(v[1][2], v[1][3]);
                *(u32x4*)(base + (size_t)(ai * HALF + m * 16) * ED) = w; }
    }
};
struct EpiDown {
    static constexpr bool PERM = true;
    bf16* Y; int orow = 0;
    __device__ __forceinline__ void operator()(const f32x4 (&acc)[2][2][4][2], const Unit& u, int wr, int wc, int fr, int fq) const {
        bf16* base = Y + (size_t)(orow + u.row0 + wr * 64 + fr) * D + u.pn * BM + wc * 32 + 8 * fq;
#pragma unroll
        for (int ai = 0; ai < 2; ++ai)
#pragma unroll
            for (int m = 0; m < 4; ++m) { bf16* rowp = base + (size_t)(ai * HALF + m * 16) * D;
#pragma unroll
                for (int bj = 0; bj < 2; ++bj) { const f32x4 v0 = acc[ai][bj][m][0], v1 = acc[ai][bj][m][1];
                    u32x4 w; w.x = cvt_pk_bf16(v0[0], v0[1]); w.y = cvt_pk_bf16(v0[2], v0[3]); w.z = cvt_pk_bf16(v1[0], v1[1]); w.w = cvt_pk_bf16(v1[2], v1[3]);
                    *(u32x4*)(rowp + bj * HALF) = w; } }
    }
};


struct EpiUp8 {
    static constexpr bool PERM = true;
    unsigned char* ACT8;
    __device__ __forceinline__ void operator()(const f32x4 (&acc)[2][2][4][2], const Unit& u, int wr, int wc, int fr, int fq) const {
        unsigned char* base = ACT8 + (size_t)(u.row0 + wr * 64 + fr) * ED + 128 * u.pn + 32 * wc + 8 * fq;
        constexpr float s = 1.f / (F8_HSCALE * F8_WSCALE);
#pragma unroll
        for (int ai = 0; ai < 2; ++ai)
#pragma unroll
            for (int m = 0; m < 4; ++m) { f32x4 v[2];
#pragma unroll
                for (int n = 0; n < 2; ++n)
#pragma unroll
                    for (int i = 0; i < 4; ++i) v[n][i] = silu_fast(acc[ai][0][m][n][i] * s) * (acc[ai][1][m][n][i] * (s * F8_ASCALE));
                u32x2 w; w.x = pk4_fp8(v[0][0], v[0][1], v[0][2], v[0][3]); w.y = pk4_fp8(v[1][0], v[1][1], v[1][2], v[1][3]);
                *(u32x2*)(base + (size_t)(ai * HALF + m * 16) * ED) = w; }
    }
};
struct EpiDown8 {
    static constexpr bool PERM = true;
    bf16* Y;
    __device__ __forceinline__ void operator()(const f32x4 (&acc)[2][2][4][2], const Unit& u, int wr, int wc, int fr, int fq) const {
#if Y_FP8
        unsigned char* base = (unsigned char*)Y + (size_t)(u.row0 + wr * 64 + fr) * D + u.pn * BM + wc * 64 + 16 * fq;
        constexpr float s = F8_YSCALE / (F8_ASCALE * F8_WSCALE);
#pragma unroll
        for (int ai = 0; ai < 2; ++ai)
#pragma unroll
            for (int m = 0; m < 4; ++m) { unsigned char* rowp = base + (size_t)(ai * HALF + m * 16) * D; u32x4 w;
#pragma unroll
                for (int bj = 0; bj < 2; ++bj) { const f32x4 v0 = acc[ai][bj][m][0] * s, v1 = acc[ai][bj][m][1] * s;
                    w[2 * bj] = pk4_fp8(v0[0], v0[1], v0[2], v0[3]); w[2 * bj + 1] = pk4_fp8(v1[0], v1[1], v1[2], v1[3]); }
                *(u32x4*)rowp = w; }
#else
        bf16* base = Y + (size_t)(u.row0 + wr * 64 + fr) * D + u.pn * BM + wc * 32 + 8 * fq;
        constexpr float s = 1.f / (F8_ASCALE * F8_WSCALE);
#pragma unroll
        for (int ai = 0; ai < 2; ++ai)
#pragma unroll
            for (int m = 0; m < 4; ++m) { bf16* rowp = base + (size_t)(ai * HALF + m * 16) * D;
#pragma unroll
                for (int bj = 0; bj < 2; ++bj) { const f32x4 v0 = acc[ai][bj][m][0] * s, v1 = acc[ai][bj][m][1] * s;
                    u32x4 w; w.x = cvt_pk_bf16(v0[0], v0[1]); w.y = cvt_pk_bf16(v0[2], v0[3]); w.z = cvt_pk_bf16(v1[0], v1[1]); w.w = cvt_pk_bf16(v1[2], v1[3]);
                    *(u32x4*)(rowp + bj * HALF) = w; } }
#endif
    }
};
__device__ __forceinline__ void glds16s(const void* sbase, unsigned voff, unsigned lds_dst) { unsigned keep;
    asm volatile("s_mov_b32 %0, m0\n\ts_mov_b32 m0, %3\n\ts_nop 0\n\tglobal_load_lds_dwordx4 %1, %2\n\ts_mov_b32 m0, %0" : "=&s"(keep) : "v"(voff), "s"(sbase), "s"(lds_dst) : "memory"); }
__device__ __forceinline__ void glds4s(const void* sbase, unsigned voff, unsigned lds_dst) { unsigned keep;
    asm volatile("s_mov_b32 %0, m0\n\ts_mov_b32 m0, %3\n\ts_nop 0\n\tglobal_load_lds_dword %1, %2\n\ts_mov_b32 m0, %0" : "=&s"(keep) : "v"(voff), "s"(sbase), "s"(lds_dst) : "memory"); }
typedef int i32x4 __attribute__((ext_vector_type(4)));
typedef int i32x8 __attribute__((ext_vector_type(8)));
__device__ __forceinline__ i32x8 cat8(bf16x8 a, bf16x8 b) { return __builtin_shufflevector(__builtin_bit_cast(i32x4, a), __builtin_bit_cast(i32x4, b), 0, 1, 2, 3, 4, 5, 6, 7); }
__device__ __forceinline__ void mfma8_inplace(f32x4& acc, i32x8 a, i32x8 b) { asm volatile("v_mfma_f32_16x16x128_f8f6f4 %0, %1, %2, %0" : "+v"(acc) : "v"(a), "v"(b)); }
template <class Epi, class Sched, bool FP8 = false>
__device__ __forceinline__ void gemm_phase(LAS unsigned char* lds, const char* Abase, const int K, const Sched& S, const Epi& E) {
    constexpr bool GATHER = Sched::GATHER;
    const int tid = threadIdx.x, wid = __builtin_amdgcn_readfirstlane(tid >> 6), lane = tid & 63, wr = wid >> 2, wc = wid & 3, fr = lane & 15, fq = lane >> 4;
    int nt = K / BK; asm volatile("" : "+s"(nt));
    int RA[2]; unsigned CA[2], voffB[2], vC[2];
#pragma unroll
    for (int i = 0; i < 2; ++i) { int R, C; stage_rc(tid * 16 + i * 8192, R, C); const int Rb = Epi::PERM ? ((R & ~31) + perm32(R & 31)) : R;
        RA[i] = R; CA[i] = (unsigned)C * 2u; voffB[i] = (unsigned)(Rb * K + C) * 2u; vC[i] = (unsigned)(R * K + C) * 2u; }
    const size_t kstep = (size_t)(BK * 2);
    const size_t hstep = (size_t)HALF * K * 2;
    const size_t ahstep = GATHER ? 0 : hstep;
    const unsigned ldsw = (unsigned)wid * 1024u;
    const unsigned lds0 = (unsigned)(uintptr_t)lds;
    const int aoff = lds_byte(wr * 64 + fr, fq * 8), boff = lds_byte(wc * 32 + fr, fq * 8);
#define PG8_SA(b, h) (((b) * 2 + (h)) * HTB)
#define PG8_SB(b, h) ((4 + (b) * 2 + (h)) * HTB)
#define PG8_STAGE(bufoff, gbase, voff) do { _Pragma("unroll") for (int _i = 0; _i < 2; ++_i) \
        glds16s((const void*)(gbase), (voff)[_i], (unsigned)__builtin_amdgcn_readfirstlane((int)(lds0 + (unsigned)(bufoff) + ldsw + (unsigned)(_i * 8192)))); } while (0)
#define PG8_STAGE_A(bufoff, gbase, h) do { if constexpr (GATHER) { PG8_STAGE(bufoff, gbase, vA[h]); } else { PG8_STAGE(bufoff, (gbase) + (h) * ahstep, vC); } } while (0)
#define PG8_LDA(dst, b, h) do { _Pragma("unroll") for (int m = 0; m < 4; ++m) _Pragma("unroll") for (int k = 0; k < 2; ++k) dst[m][k] = *(const LAS bf16x8*)(lds + PG8_SA(b, h) + aoff + m * 2048 + k * 1024); } while (0)
#define PG8_LDB(dst, b, h) do { _Pragma("unroll") for (int n = 0; n < 2; ++n) _Pragma("unroll") for (int k = 0; k < 2; ++k) dst[n][k] = *(const LAS bf16x8*)(lds + PG8_SB(b, h) + boff + n * 2048 + k * 1024); } while (0)
#define PG8_MMA(ai, bj, At, Bt) do { __builtin_amdgcn_s_setprio(1); if constexpr (FP8) { _Pragma("unroll") for (int m = 0; m < 4; ++m) _Pragma("unroll") for (int n = 0; n < 2; ++n) \
        mfma8_inplace(acc[ai][bj][m][n], cat8(Bt[n][0], Bt[n][1]), cat8(At[m][0], At[m][1])); } else { \
        _Pragma("unroll") for (int m = 0; m < 4; ++m) _Pragma("unroll") for (int n = 0; n < 2; ++n) _Pragma("unroll") for (int k = 0; k < 2; ++k) \
        acc[ai][bj][m][n] = __builtin_amdgcn_mfma_f32_16x16x32_bf16(Bt[n][k], At[m][k], acc[ai][bj][m][n], 0, 0, 0); } __builtin_amdgcn_s_setprio(0); } while (0)
#define PG8_WAIT_V(n) asm volatile("s_waitcnt vmcnt(" #n ")" ::: "memory")
#define PG8_WAIT_L(n) asm volatile("s_waitcnt lgkmcnt(0)" ::: "memory")
#define PG8_BAR __builtin_amdgcn_s_barrier()
#define PG8_SCHED __builtin_amdgcn_sched_barrier(0)
#define PG8_SETOFF(vo, u) do { _Pragma("unroll") for (int _h = 0; _h < 2; ++_h) _Pragma("unroll") for (int _i = 0; _i < 2; ++_i) vo[_h][_i] = S.arow_off(u, _h * HALF + RA[_i]) + CA[_i]; } while (0)
    Unit cur, nxt; int ui = 0;
    if (!S.next(0, cur)) return;
    f32x4 acc[2][2][4][2];
#pragma unroll
    for (int a = 0; a < 2; ++a)
#pragma unroll
        for (int b = 0; b < 2; ++b)
#pragma unroll
            for (int m = 0; m < 4; ++m)
#pragma unroll
                for (int n = 0; n < 2; ++n) acc[a][b][m][n] = (f32x4){0.f, 0.f, 0.f, 0.f};
    bf16x8 At[4][2], B0[2][2], B1[2][2];
    unsigned vA[2][2];
    LAS int* gidx = (LAS int*)(lds + STAGE_BYTES);
#define PG8_IDX_DMA(u) do { if (wid < 4) glds4s((const void*)(S.slot_tok + (u).row0), (unsigned)((wid * 64 + lane) * 4), (unsigned)__builtin_amdgcn_readfirstlane((int)(lds0 + (unsigned)STAGE_BYTES + (unsigned)wid * 256u))); } while (0)
#define PG8_IDX_READ() do { _Pragma("unroll") for (int _h = 0; _h < 2; ++_h) _Pragma("unroll") for (int _i = 0; _i < 2; ++_i) vA[_h][_i] = (unsigned)gidx[_h * HALF + RA[_i]] * (unsigned)(K * 2) + CA[_i]; } while (0)
    if constexpr (GATHER) { PG8_IDX_DMA(cur); asm volatile("s_waitcnt vmcnt(0)" ::: "memory"); __builtin_amdgcn_s_barrier(); asm volatile("" ::: "memory"); PG8_IDX_READ();
        asm volatile("s_waitcnt lgkmcnt(0)" ::: "memory"); __builtin_amdgcn_s_barrier(); asm volatile("" ::: "memory"); }
    const char* cA = GATHER ? Abase : Abase + (size_t)cur.row0 * K * 2;
    const char* cB = cur.Bp;
    PG8_STAGE(PG8_SB(0, 0), cB, voffB); PG8_STAGE(PG8_SB(0, 1), cB + hstep, voffB); PG8_STAGE_A(PG8_SA(0, 0), cA, 0); PG8_STAGE_A(PG8_SA(0, 1), cA, 1);
    if (wr == 1) PG8_BAR;
    PG8_WAIT_V(2); PG8_BAR;
    PG8_STAGE(PG8_SB(1, 0), cB + kstep, voffB); PG8_STAGE_A(PG8_SA(1, 0), cA + kstep, 0); PG8_STAGE(PG8_SB(1, 1), cB + hstep + kstep, voffB);
    PG8_WAIT_V(6); PG8_BAR;
    for (;;) {
        const bool has_next = S.next(ui + 1, nxt);
        if constexpr (GATHER) { if (has_next) PG8_IDX_DMA(nxt); }
        const char* nA = GATHER ? Abase : (has_next ? Abase + (size_t)nxt.row0 * K * 2 : cA);
        const char* nB = has_next ? nxt.Bp : cB;
#pragma unroll 1
        for (int t = 0; t < nt; t += 2) {
            const bool last = (t == nt - 2);
            const char* a1 = cA + (size_t)(t + 1) * kstep;
            const char* a2 = last ? nA : cA + (size_t)(t + 2) * kstep; const char* b2 = last ? nB : cB + (size_t)(t + 2) * kstep;
            const char* a3 = a2 + kstep; const char* b3 = b2 + kstep;
            PG8_LDB(B0, 0, 0); PG8_LDB(B1, 0, 1); PG8_SCHED; PG8_LDA(At, 0, 0); PG8_STAGE_A(PG8_SA(1, 1), a1, 1);
            if constexpr (GATHER) { if (last && has_next) PG8_IDX_READ(); }
            PG8_WAIT_V(8); PG8_WAIT_L(0); PG8_BAR; PG8_MMA(0, 0, At, B0); PG8_MMA(0, 1, At, B1); PG8_BAR; PG8_SCHED;
            PG8_LDA(At, 0, 1); PG8_STAGE(PG8_SB(0, 0), b2, voffB); PG8_STAGE(PG8_SB(0, 1), b2 + hstep, voffB); PG8_STAGE_A(PG8_SA(0, 0), a2, 0);
            PG8_WAIT_V(8); PG8_WAIT_L(0); PG8_BAR; PG8_MMA(1, 0, At, B0); PG8_MMA(1, 1, At, B1); PG8_BAR; PG8_SCHED;
            PG8_LDB(B0, 1, 0); PG8_LDB(B1, 1, 1); PG8_SCHED; PG8_LDA(At, 1, 0); PG8_STAGE_A(PG8_SA(0, 1), a2, 1);
            PG8_WAIT_V(8); PG8_WAIT_L(0); PG8_BAR; PG8_MMA(0, 0, At, B0); PG8_MMA(0, 1, At, B1); PG8_BAR; PG8_SCHED;
            PG8_LDA(At, 1, 1); PG8_STAGE(PG8_SB(1, 0), b3, voffB); PG8_STAGE(PG8_SB(1, 1), b3 + hstep, voffB); PG8_STAGE_A(PG8_SA(1, 0), a3, 0);
            PG8_WAIT_V(8); PG8_WAIT_L(0); PG8_BAR; PG8_MMA(1, 0, At, B0); PG8_MMA(1, 1, At, B1); PG8_BAR; PG8_SCHED;
        }
        if (wr == 0) PG8_BAR;
        if constexpr (FP8) asm volatile("s_nop 15\n\ts_nop 15" ::: "memory");
        E(acc, cur, wr, wc, fr, fq);
        if (!has_next) break;
#pragma unroll
        for (int a = 0; a < 2; ++a)
#pragma unroll
            for (int b = 0; b < 2; ++b)
#pragma unroll
                for (int m = 0; m < 4; ++m)
#pragma unroll
                    for (int n = 0; n < 2; ++n) acc[a][b][m][n] = (f32x4){0.f, 0.f, 0.f, 0.f};
        cur = nxt; cA = nA; cB = nB; ++ui;
        if (wr == 1) PG8_BAR;
    }
    PG8_WAIT_V(0);
    PG8_BAR;
#undef PG8_SA
#undef PG8_SB
#undef PG8_STAGE
#undef PG8_STAGE_A
#undef PG8_LDA
#undef PG8_LDB
#undef PG8_MMA
#undef PG8_WAIT_V
#undef PG8_WAIT_L
#undef PG8_BAR
#undef PG8_SCHED
#undef PG8_SETOFF
#undef PG8_IDX_DMA
#undef PG8_IDX_READ
}
}

namespace att {
using bf16=unsigned short;
using bf16x8=__attribute__((ext_vector_type(8)))short;
using s16x4=__attribute__((ext_vector_type(4)))short;
using f32x16=__attribute__((ext_vector_type(16)))float;
using u32x4=__attribute__((ext_vector_type(4)))unsigned;
constexpr int NW=8,QBLK=32,QB=QBLK*NW,KVBLK=64;
__device__ __forceinline__ int crow(int r,int hi){return (r&3)+8*(r>>2)+4*hi;}
#define SBAR() __builtin_amdgcn_sched_barrier(0)
constexpr int NSLOT=6, SLOTB=8192;
constexpr int LDS_K=0, LDS_V=NSLOT*SLOTB, LDS_WS=2*NSLOT*SLOTB, LDS_OST=LDS_WS+NW*64*4, LDS_BYTES=LDS_OST+NW*4096;
constexpr float C2=0.125f*1.4426950408889634f;
__device__ __forceinline__ void glds16(const void*sbase,unsigned voff,unsigned lds_dst){unsigned keep;
  asm volatile("s_mov_b32 %0, m0\n\ts_mov_b32 m0, %3\n\ts_nop 0\n\tglobal_load_lds_dwordx4 %1, %2\n\ts_mov_b32 m0, %0":"=&s"(keep):"v"(voff),"s"(sbase),"s"(lds_dst):"memory");}
__device__ __forceinline__ float max3f(float a,float b,float c){float r;asm("v_max3_f32 %0, %1, %2, %3":"=v"(r):"v"(a),"v"(b),"v"(c));return r;}
__device__ __forceinline__ float max2f(float a,float b){float r;asm("v_max_f32_e32 %0, %1, %2":"=v"(r):"v"(a),"v"(b));return r;}
__device__ __forceinline__ float fsub_s(float a,float b){float r;asm("v_sub_f32_e32 %0, %1, %2":"=v"(r):"v"(a),"v"(b));return r;}
typedef float f32x2_t __attribute__((ext_vector_type(2))); typedef __bf16 bf16x2_t __attribute__((ext_vector_type(2)));
__device__ __forceinline__ unsigned cvtpk_s(float lo,float hi){f32x2_t v={lo,hi};bf16x2_t b=__builtin_convertvector(v,bf16x2_t);return __builtin_bit_cast(unsigned,b);}
#define WAIT_BAR(N) asm volatile("s_waitcnt vmcnt(" #N ") lgkmcnt(0)\n\ts_barrier":::"memory")
typedef __attribute__((address_space(3))) const char* lds_cptr;
typedef short v4i16_t __attribute__((ext_vector_type(4)));
__device__ __forceinline__ void kload8(bf16x8*kf,lds_cptr kp,int bo){
  #pragma unroll
  for(int d0=0;d0<4;++d0){ const lds_cptr p=kp+((d0*32)^bo); kf[2*d0]=*(const __attribute__((address_space(3))) bf16x8*)(p); kf[2*d0+1]=*(const __attribute__((address_space(3))) bf16x8*)(p+4096); }
}
__device__ __forceinline__ void kload2(bf16x8*kf,lds_cptr kp,int j,int bo){ const lds_cptr p=kp+((j*32)^bo); kf[2*j]=*(const __attribute__((address_space(3))) bf16x8*)(p); kf[2*j+1]=*(const __attribute__((address_space(3))) bf16x8*)(p+4096); }
__device__ __forceinline__ s16x4 vtr(lds_cptr p){ return __builtin_bit_cast(s16x4,__builtin_amdgcn_ds_read_tr16_b64_v4i16((__attribute__((address_space(3))) v4i16_t*)p)); }
__device__ __forceinline__ float rowmax(const f32x16&p0,const f32x16&p1){
  float a=max3f(p0[0],p0[1],p1[0]),b=max3f(p0[2],p0[3],p1[1]);a=max3f(a,p1[2],p1[3]);
  #pragma unroll
  for(int r=4;r<16;r+=4){a=max3f(a,p0[r],p0[r+1]);b=max3f(b,p0[r+2],p0[r+3]);a=max3f(a,p1[r],p1[r+1]);b=max3f(b,p1[r+2],p1[r+3]);}
  const float m=max2f(a,b);
  auto rr=__builtin_amdgcn_permlane32_swap(__float_as_uint(m),__float_as_uint(m),false,false);
  return max2f(__uint_as_float(rr[0]),__uint_as_float(rr[1]));
}
__device__ __forceinline__ void pv(f32x16*o,int vb,bf16x8 pa0,bf16x8 pa1,bf16x8 pa2,bf16x8 pa3){
  #pragma unroll
  for(int d0=0;d0<2;++d0){s16x4 lo[4],hi[4];
    #pragma unroll
    for(int ks=0;ks<4;++ks){
      asm volatile("ds_read_b64_tr_b16 %0,%1 offset:%c2":"=&v"(lo[ks]):"v"(vb),"i"(d0*4096+ks*1024):"memory");
      asm volatile("ds_read_b64_tr_b16 %0,%1 offset:%c2":"=&v"(hi[ks]):"v"(vb),"i"(d0*4096+ks*1024+512):"memory");}
    asm volatile("s_waitcnt lgkmcnt(0)":::"memory");SBAR();
    #define PK(k) (bf16x8){lo[k][0],lo[k][1],lo[k][2],lo[k][3],hi[k][0],hi[k][1],hi[k][2],hi[k][3]}
    o[d0]=__builtin_amdgcn_mfma_f32_32x32x16_bf16(pa0,PK(0),o[d0],0,0,0);
    o[d0]=__builtin_amdgcn_mfma_f32_32x32x16_bf16(pa1,PK(1),o[d0],0,0,0);
    o[d0]=__builtin_amdgcn_mfma_f32_32x32x16_bf16(pa2,PK(2),o[d0],0,0,0);
    o[d0]=__builtin_amdgcn_mfma_f32_32x32x16_bf16(pa3,PK(3),o[d0],0,0,0);
    #undef PK
  }
}
template<int W> __device__ __forceinline__ void wmask(f32x16&p0,f32x16&p1,int d,float NEG){
  asm volatile("":"+v"(d));
  #pragma unroll
  for(int r=0;r<16;++r){const int c=(r&3)+8*(r>>2);
    if(W==0x7fffffff){ if(d<c)p0[r]=NEG; if(d<c+32)p1[r]=NEG; }
    else{ if((unsigned)(d-c)>(unsigned)W)p0[r]=NEG; if((unsigned)(d-c-32)>(unsigned)W)p1[r]=NEG; } }
}
struct UnitDesc {
  const bf16* Q; long qs;
  const bf16* K; long ks;
  const bf16* V; long vs;
  bf16* O; long os;
  float* lse; long lses;
  int NT;
  int rel0;
  int tg0;
  int q0;
  float slope2;
  float sink2;
  int fin;
  float lam, lam1;
  const float* sg; bf16* Of;
};
template<int MODE,int THRL,int DIL,int OS> __device__ __forceinline__ void attn_unit(const UnitDesc&u,char*shm){
  constexpr int W=(MODE==0)?0x7fffffff:(MODE==1?128:127);
  const float NEG=(MODE==0)?-INFINITY:-1024.f;
  int tid=threadIdx.x; asm volatile("":"+v"(tid));
  const int lane=tid&63,r32=lane&31,hi=lane>>5; const int wid=__builtin_amdgcn_readfirstlane(tid>>6);
  constexpr long qs=64L*DIL,ks=64L*DIL,vs=64L*DIL;
  const bf16*Qw=u.Q+(long)(wid*QBLK)*qs;
  const unsigned lds0=(unsigned)(uintptr_t)shm;
  __attribute__((address_space(3))) float*wsf=(__attribute__((address_space(3))) float*)((__attribute__((address_space(3))) char*)shm+LDS_WS)+wid*64;
  const unsigned ksoff=(unsigned)(((long)(8*wid+(lane>>3))*ks+(((lane&7)^(lane>>3))*8))*2);
  const unsigned vsoff=(unsigned)(((long)(16*(wid&3)+(lane>>2))*vs+(wid>>2)*32+(lane&3)*8)*2);
  const unsigned kdst=lds0+LDS_K+wid*1024, vdst=lds0+LDS_V+wid*1024;
  #define DMA_K(t,slot) glds16(u.K+(long)(t)*KVBLK*ks,ksoff,(unsigned)__builtin_amdgcn_readfirstlane(kdst+(slot)))
  #define DMA_V(t,slot) glds16(u.V+(long)(t)*KVBLK*vs,vsoff,(unsigned)__builtin_amdgcn_readfirstlane(vdst+(slot)))
  bf16x8 kf[8];
  const lds_cptr shm3=(lds_cptr)shm; const lds_cptr kp0=shm3+LDS_K+r32*128+((hi^(r32&1))*16); const int kbo=((r32>>1)&3)<<5; const lds_cptr vp0=shm3+LDS_V+((lane>>4)&1)*32+(lane&3)*8+(4*hi+((lane&15)>>2))*64;
  const int NT=u.NT;
  if(MODE==0){DMA_K(0,0);DMA_V(0,0);DMA_K(1,SLOTB);} else {DMA_K(0,0);}
  bf16x8 qr[4];
  #pragma unroll
  for(int d0=0;d0<4;++d0)qr[d0]=*reinterpret_cast<const bf16x8*>(&Qw[(long)r32*qs+d0*16+hi*8]);
  const unsigned s2hb=__float_as_uint(u.slope2)&0xffff0000u; const float s2hf=__uint_as_float(s2hb);
  const unsigned s2lb=__float_as_uint(u.slope2-s2hf)&0xffff0000u; const float s2used=s2hf+__uint_as_float(s2lb);
  u32x4 qx; qx[0]=hi?0u:((__float_as_uint(64.f*s2hf)>>16)|(__float_as_uint(64.f*__uint_as_float(s2lb))&0xffff0000u)); qx[1]=hi?0u:((s2hb>>16)|s2lb); qx[2]=0u; qx[3]=0u;
  u32x4 kx0; unsigned jp0,jp1; { const unsigned j0=__float_as_uint((float)r32)>>16, j1=__float_as_uint((float)(r32+32))>>16; jp0=j0|(j0<<16); jp1=j1|(j1<<16);
    kx0[0]=0u; kx0[1]=jp0; kx0[2]=0x3f803f80u; kx0[3]=0u; }
  #define SETTG(t) do{ const unsigned tb_=__float_as_uint((float)(u.tg0+(t)))>>16; kx0[0]=(tb_|(tb_<<16)); }while(0)
  #define KX0 __builtin_bit_cast(bf16x8,kx0)
  #define QX __builtin_bit_cast(bf16x8,qx)
  #define SETREF(m_) do{ const unsigned hb_=__float_as_uint(m_)&0xffff0000u; const float hf_=__uint_as_float(hb_); const unsigned lb_=__float_as_uint((m_)-hf_)&0xffff0000u; \
      mhat=hf_+__uint_as_float(lb_); qx[2]=hi?0u:(((hb_^0x80000000u)>>16)|(lb_^0x80000000u)); }while(0)
  float mhat=0.f,l_reg=0.f;f32x16 o[2];o[0]=f32x16{};o[1]=f32x16{};
  const int qrel=u.rel0+wid*QBLK+r32-4*hi;
  #define CMASK(P0,P1,t) do{ if(MODE!=0||(t)>=NT-4) wmask<W>(P0,P1,qrel-64*(t),NEG); }while(0)
  bool resc=false;
  f32x16 pA0,pA1,pB0,pB1;
  int sl_prev=0,sl_cur=0,sl_next=SLOTB;
  #define ROT() do{sl_prev=sl_cur;sl_cur=sl_next;sl_next=(sl_next==(NSLOT-1)*SLOTB)?0:sl_next+SLOTB;}while(0)
  #define RESC() do{ if(resc){ asm volatile("s_waitcnt lgkmcnt(0)":::"memory"); \
      _Pragma("unroll") for(int d_=0;d_<2;++d_) _Pragma("unroll") for(int r=0;r<16;++r)o[d_][r]*=wsf[crow(r,hi)]; } }while(0)
  if(MODE==0){ DMA_K(2,2*SLOTB); WAIT_BAR(3); }
  else{ DMA_K(1,SLOTB);DMA_V(0,0);DMA_K(2,2*SLOTB);DMA_V(1,SLOTB);DMA_K(3,3*SLOTB);DMA_V(2,2*SLOTB);DMA_V(3,3*SLOTB);
    if(NT>4){DMA_K(4,4*SLOTB);DMA_K(5,5*SLOTB);DMA_V(4,4*SLOTB);DMA_V(5,5*SLOTB);}
    WAIT_BAR(0); }
  { SETTG(0); const f32x16 z=f32x16{}; const lds_cptr kb=kp0;
    #pragma unroll
    for(int d0=0;d0<4;++d0){
      const bf16x8 b0=*(const __attribute__((address_space(3))) bf16x8*)(kb+((d0*32)^kbo));
      const bf16x8 b1=*(const __attribute__((address_space(3))) bf16x8*)(kb+((d0*32)^kbo)+4096);
      if(d0==0){pA0=__builtin_amdgcn_mfma_f32_32x32x16_bf16(b0,qr[0],z,0,0,0);pA1=__builtin_amdgcn_mfma_f32_32x32x16_bf16(b1,qr[0],z,0,0,0);}
      else{pA0=__builtin_amdgcn_mfma_f32_32x32x16_bf16(b0,qr[d0],pA0,0,0,0);pA1=__builtin_amdgcn_mfma_f32_32x32x16_bf16(b1,qr[d0],pA1,0,0,0);}}
    pA0=__builtin_amdgcn_mfma_f32_32x32x16_bf16(KX0,QX,pA0,0,0,0); kx0[1]=jp1; pA1=__builtin_amdgcn_mfma_f32_32x32x16_bf16(KX0,QX,pA1,0,0,0); kx0[1]=jp0; }
  asm volatile("s_nop 15\n\ts_nop 7":"+v"(pA0),"+v"(pA1));CMASK(pA0,pA1,0);
  { const float rm=rowmax(pA0,pA1); SETREF(rm); const float dl=mhat;
    _Pragma("unroll") for(int r=0;r<16;++r){pA0[r]=fsub_s(pA0[r],dl);pA1[r]=fsub_s(pA1[r],dl);}
    _Pragma("unroll") for(int r=0;r<16;++r)pA0[r]=__builtin_amdgcn_exp2f(pA0[r]); }
  _Pragma("unroll") for(int r=0;r<16;++r)pA1[r]=__builtin_amdgcn_exp2f(pA1[r]);
  if(MODE==0){ WAIT_BAR(0); DMA_K(3,0);DMA_V(1,SLOTB); }
  ROT();
  kload8(kf,kp0+sl_cur,kbo);
  if(MODE==0){ WAIT_BAR(2); }
  s16x4 vlo[8],vhi[8]; u32x4 pw0,pw1,pw2,pw3;
  #define PKW(P,B) cvtpk_s(P[B],P[B+1])
  #define PAF(k) __builtin_bit_cast(bf16x8,pw##k)
  #define VFR(i) (bf16x8){vlo[i][0],vlo[i][1],vlo[i][2],vlo[i][3],vhi[i][0],vhi[i][1],vhi[i][2],vhi[i][3]}
  #define PIN(x) asm volatile("":"+v"(x))
  #define MX3(a,b,c) __builtin_fmaxf(__builtin_fmaxf((a),(b)),(c))
  #define GAPA(MF,A0,A1,A2,A3,W0,W1,PW) do{ MF; sacc+=A0; sacc+=A1; sacc+=A2; sacc+=A3; PIN(sacc); W0; W1; PIN(PW); SBAR(); }while(0)
  #define EX(v) __builtin_amdgcn_exp2f(v)
  #define GAPB(MF,X,B) do{ MF; X[B]=EX(X[B]); X[B+1]=EX(X[B+1]); X[B+2]=EX(X[B+2]); X[B+3]=EX(X[B+3]); PIN(X); SBAR(); }while(0)
  #define VRD(i) do{ vlo[i]=vtr(vp_+(((i)>>2)*4096+((i)&3)*1024)); vhi[i]=vtr(vp_+(((i)>>2)*4096+((i)&3)*1024+512)); }while(0)
  #define KRD(G,j) do{ if(G){ kload2(kf,kp0+sl_next,j,kbo); SBAR(); } }while(0)
  #define STEP(C0,C1,P0,P1,t,GK,GV,GL) do{ SBAR(); SETTG(t); const f32x16 z_=f32x16{}; \
    const lds_cptr vp_=vp0+sl_prev; \
    VRD(0); SBAR(); float sacc=(P0[0]+P0[1]); \
    GAPA(C0=__builtin_amdgcn_mfma_f32_32x32x16_bf16(kf[0],qr[0],z_,0,0,0), P0[2],P0[3],P0[4],P0[5],     pw0[0]=PKW(P0,0), pw0[1]=PKW(P0,2), pw0); \
    VRD(4); SBAR(); GAPA(C1=__builtin_amdgcn_mfma_f32_32x32x16_bf16(kf[1],qr[0],z_,0,0,0), P0[6],P0[7],P0[8],P0[9],     pw0[2]=PKW(P0,4), pw0[3]=PKW(P0,6), pw0); \
    VRD(1); SBAR(); GAPA(C0=__builtin_amdgcn_mfma_f32_32x32x16_bf16(kf[2],qr[1],C0,0,0,0),   P0[10],P0[11],P0[12],P0[13], pw1[0]=PKW(P0,8), pw1[1]=PKW(P0,10), pw1); \
    VRD(5); SBAR(); GAPA(C1=__builtin_amdgcn_mfma_f32_32x32x16_bf16(kf[3],qr[1],C1,0,0,0),   P0[14],P0[15],P1[0],P1[1],   pw1[2]=PKW(P0,12),pw1[3]=PKW(P0,14), pw1); \
    VRD(2); SBAR(); GAPA(C0=__builtin_amdgcn_mfma_f32_32x32x16_bf16(kf[4],qr[2],C0,0,0,0),   P1[2],P1[3],P1[4],P1[5],     pw2[0]=PKW(P1,0), pw2[1]=PKW(P1,2), pw2); \
    VRD(6); SBAR(); GAPA(C1=__builtin_amdgcn_mfma_f32_32x32x16_bf16(kf[5],qr[2],C1,0,0,0),   P1[6],P1[7],P1[8],P1[9],     pw2[2]=PKW(P1,4), pw2[3]=PKW(P1,6), pw2); \
    VRD(3); SBAR(); GAPA(C0=__builtin_amdgcn_mfma_f32_32x32x16_bf16(kf[6],qr[3],C0,0,0,0),   P1[10],P1[11],P1[12],P1[13], pw3[0]=PKW(P1,8), pw3[1]=PKW(P1,10), pw3); \
    VRD(7); SBAR(); GAPA(C1=__builtin_amdgcn_mfma_f32_32x32x16_bf16(kf[7],qr[3],C1,0,0,0),   P1[14],P1[15],0.f,0.f,       pw3[2]=PKW(P1,12),pw3[3]=PKW(P1,14), pw3); \
    C0=__builtin_amdgcn_mfma_f32_32x32x16_bf16(KX0,QX,C0,0,0,0); kx0[1]=jp1; C1=__builtin_amdgcn_mfma_f32_32x32x16_bf16(KX0,QX,C1,0,0,0); kx0[1]=jp0; SBAR(); \
    l_reg+=sacc; \
    if(GK){DMA_K((t)+3,sl_cur);} if(GV){DMA_V((t)+1,sl_next);} \
    CMASK(C0,C1,t); \
    { float a=MX3(C0[0],C0[1],C1[0]),b=MX3(C0[2],C0[3],C1[1]); a=MX3(a,C1[2],C1[3]); \
      _Pragma("unroll") for(int r=4;r<16;r+=4){a=MX3(a,C0[r],C0[r+1]);b=MX3(b,C0[r+2],C0[r+3]);a=MX3(a,C1[r],C1[r+1]);b=MX3(b,C1[r+2],C1[r+3]);} \
      float rm=__builtin_fmaxf(a,b); { auto rr=__builtin_amdgcn_permlane32_swap(__float_as_uint(rm),__float_as_uint(rm),false,false); rm=__builtin_fmaxf(__uint_as_float(rr[0]),__uint_as_float(rr[1])); } \
      resc=false; \
      if(__builtin_expect(__any(rm>(float)THRL),0)){ const float mold=mhat; const float mnew=mold+__builtin_fmaxf(rm,0.f); SETREF(mnew); const float dl=mhat-mold; \
        _Pragma("unroll") for(int r=0;r<16;++r){C0[r]-=dl;C1[r]-=dl;} \
        const float f=__builtin_amdgcn_exp2f(-dl); l_reg*=f; if(hi==0)wsf[r32]=f; resc=true; } } \
    SBAR(); \
    GAPB(o[0]=__builtin_amdgcn_mfma_f32_32x32x16_bf16(PAF(0),VFR(0),o[0],0,0,0), C0,0); \
    GAPB(o[1]=__builtin_amdgcn_mfma_f32_32x32x16_bf16(PAF(0),VFR(4),o[1],0,0,0), C0,4); \
    KRD(GL,0); GAPB(o[0]=__builtin_amdgcn_mfma_f32_32x32x16_bf16(PAF(1),VFR(1),o[0],0,0,0), C0,8); \
    KRD(GL,1); GAPB(o[1]=__builtin_amdgcn_mfma_f32_32x32x16_bf16(PAF(1),VFR(5),o[1],0,0,0), C0,12); \
    KRD(GL,2); GAPB(o[0]=__builtin_amdgcn_mfma_f32_32x32x16_bf16(PAF(2),VFR(2),o[0],0,0,0), C1,0); \
    KRD(GL,3); GAPB(o[1]=__builtin_amdgcn_mfma_f32_32x32x16_bf16(PAF(2),VFR(6),o[1],0,0,0), C1,4); \
    GAPB(o[0]=__builtin_amdgcn_mfma_f32_32x32x16_bf16(PAF(3),VFR(3),o[0],0,0,0), C1,8); \
    GAPB(o[1]=__builtin_amdgcn_mfma_f32_32x32x16_bf16(PAF(3),VFR(7),o[1],0,0,0), C1,12); \
    }while(0)
  int t=1;
  if(MODE==0){
    #undef CMASK
    #define CMASK(P0,P1,t) do{}while(0)
    for(;t+5<NT;t+=2){
      STEP(pB0,pB1,pA0,pA1,t,true,true,true);     WAIT_BAR(2); RESC(); ROT();
      STEP(pA0,pA1,pB0,pB1,t+1,true,true,true);   WAIT_BAR(2); RESC(); ROT();
    }
    #undef CMASK
    #define CMASK(P0,P1,t) do{ if(MODE!=0||(t)>=NT-4) wmask<W>(P0,P1,qrel-64*(t),NEG); }while(0)
  }
  #define ENDW(tt) do{ if(MODE==0){ if((tt)+3<NT){WAIT_BAR(2);} else if((tt)+2<NT){WAIT_BAR(1);} else {WAIT_BAR(0);} } }while(0)
  for(;t+1<NT;t+=2){
    STEP(pB0,pB1,pA0,pA1,t,(MODE==0&&t+3<NT),(MODE==0&&t+1<NT),(t+1<NT));       ENDW(t);   RESC(); ROT();
    STEP(pA0,pA1,pB0,pB1,t+1,(MODE==0&&t+4<NT),(MODE==0&&t+2<NT),(t+2<NT));     ENDW(t+1); RESC(); ROT();
  }
  STEP(pB0,pB1,pA0,pA1,NT-1,false,false,false); RESC();
  { float sacc=pB0[0]+pB0[1]; _Pragma("unroll") for(int r=2;r<16;++r)sacc+=pB0[r]; _Pragma("unroll") for(int r=0;r<16;++r)sacc+=pB1[r]; l_reg+=sacc;
    pw0=(u32x4){PKW(pB0,0),PKW(pB0,2),PKW(pB0,4),PKW(pB0,6)};pw1=(u32x4){PKW(pB0,8),PKW(pB0,10),PKW(pB0,12),PKW(pB0,14)};pw2=(u32x4){PKW(pB1,0),PKW(pB1,2),PKW(pB1,4),PKW(pB1,6)};pw3=(u32x4){PKW(pB1,8),PKW(pB1,10),PKW(pB1,12),PKW(pB1,14)};
    SBAR(); pv(o,(int)(lds0+LDS_V)+((lane>>4)&1)*32+(lane&3)*8+(4*hi+((lane&15)>>2))*64+sl_cur,PAF(0),PAF(1),PAF(2),PAF(3)); }
  #undef PKW
  #undef PAF
  #undef VFR
  #undef PIN
  #undef MX3
  #undef GAPA
  #undef GAPB
  #undef EX
  #undef VRD
  #undef KRD
  #undef STEP
  #undef ENDW
  {auto rr=__builtin_amdgcn_permlane32_swap(__float_as_uint(l_reg),__float_as_uint(l_reg),false,false);l_reg=__uint_as_float(rr[0])+__uint_as_float(rr[1]);}
  const float qposf=(float)(u.q0+wid*QBLK+r32);
  if(MODE==2) l_reg+=__builtin_amdgcn_exp2f(u.sink2+s2used*qposf-mhat);
  if(MODE==1){ if(hi==0) u.lse[(long)(wid*QBLK+r32)*(16*DIL)]=mhat-s2used*qposf+__builtin_amdgcn_logf(l_reg); }
  if(hi==0)wsf[32+r32]=l_reg;asm volatile("s_waitcnt lgkmcnt(0)":::"memory");
  float rli[16];
  #pragma unroll
  for(int r=0;r<16;++r)rli[r]=__builtin_amdgcn_rcpf(wsf[32+crow(r,hi)]);
  bf16*Ow=u.O+(long)(wid*QBLK)*OS;
  { int le=lane; asm volatile("":"+v"(le));
    const int r32e=le&31,hie=le>>5;
    __hip_bfloat16*stg=(__hip_bfloat16*)(shm+LDS_OST)+wid*2048;
    #pragma unroll
    for(int r=0;r<16;++r){const int orow=crow(r,hie);
      #pragma unroll
      for(int d0=0;d0<2;++d0)stg[orow*64+d0*32+r32e]=__float2bfloat16(o[d0][r]*rli[r]);}
    asm volatile("s_waitcnt lgkmcnt(0)":::"memory");
    #pragma unroll
    for(int i=0;i<4;++i){const int row=i*8+(le>>3),ch=le&7; const u32x4 v=*(const u32x4*)(stg+row*64+ch*8); *(u32x4*)(Ow+(long)row*OS+ch*8)=v;} }
  asm volatile("s_waitcnt lgkmcnt(0)\n\ts_barrier":::"memory");
  #undef DMA_K
  #undef DMA_V
  #undef CMASK
  #undef RESC
  #undef ROT
  #undef SETTG
  #undef SETREF
  #undef KX0
  #undef QX
}
#undef SBAR
#undef WAIT_BAR
}

namespace att128 {
using att::UnitDesc; using att::crow; using att::glds16; using att::max3f; using att::max2f; using att::fsub_s; using att::cvtpk_s; using att::kload8; using att::kload2; using att::vtr; using att::rowmax; using att::wmask; using att::lds_cptr;
using bf16=unsigned short;
using bf16x8=__attribute__((ext_vector_type(8)))short;
using s16x4=__attribute__((ext_vector_type(4)))short;
using f32x16=__attribute__((ext_vector_type(16)))float;
using u32x4=__attribute__((ext_vector_type(4)))unsigned;
constexpr int NW=8,QBLK=32,QB=QBLK*NW,KVBLK=64;
#define SBAR() __builtin_amdgcn_sched_barrier(0)
constexpr int NSLOT=3, SLOTB=8192, SLOTV=16384;
constexpr int LDS_K=0, LDS_V=NSLOT*SLOTB, LDS_WS=LDS_V+NSLOT*SLOTV, LDS_OST=LDS_WS+NW*64*4, LDS_BYTES=LDS_OST+NW*8192;
#define WAIT_BAR(N) asm volatile("s_waitcnt vmcnt(" #N ") lgkmcnt(0)\n\ts_barrier":::"memory")
__device__ __forceinline__ void pv4(f32x16*o,int vb,bf16x8 pa0,bf16x8 pa1,bf16x8 pa2,bf16x8 pa3){
  #pragma unroll
  for(int d0=0;d0<4;++d0){s16x4 lo[4],hi[4];
    #pragma unroll
    for(int ks=0;ks<4;++ks){
      asm volatile("ds_read_b64_tr_b16 %0,%1 offset:%c2":"=&v"(lo[ks]):"v"(vb),"i"(d0*4096+ks*1024):"memory");
      asm volatile("ds_read_b64_tr_b16 %0,%1 offset:%c2":"=&v"(hi[ks]):"v"(vb),"i"(d0*4096+ks*1024+512):"memory");}
    asm volatile("s_waitcnt lgkmcnt(0)":::"memory");SBAR();
    #define PK(k) (bf16x8){lo[k][0],lo[k][1],lo[k][2],lo[k][3],hi[k][0],hi[k][1],hi[k][2],hi[k][3]}
    o[d0]=__builtin_amdgcn_mfma_f32_32x32x16_bf16(pa0,PK(0),o[d0],0,0,0);
    o[d0]=__builtin_amdgcn_mfma_f32_32x32x16_bf16(pa1,PK(1),o[d0],0,0,0);
    o[d0]=__builtin_amdgcn_mfma_f32_32x32x16_bf16(pa2,PK(2),o[d0],0,0,0);
    o[d0]=__builtin_amdgcn_mfma_f32_32x32x16_bf16(pa3,PK(3),o[d0],0,0,0);
    #undef PK
  }
}
template<int MODE,int THRL,int DIL,int OS> __device__ __forceinline__ void attn_unit(const UnitDesc&u,char*shm){
  static_assert(MODE==0,"att128: causal mode only");
  constexpr int W=(MODE==0)?0x7fffffff:(MODE==1?128:127);
  const float NEG=(MODE==0)?-INFINITY:-1024.f;
  int tid=threadIdx.x; asm volatile("":"+v"(tid));
  const int lane=tid&63,r32=lane&31,hi=lane>>5; const int wid=__builtin_amdgcn_readfirstlane(tid>>6);
  constexpr long qs=64L*DIL,ks=64L*DIL,vs=64L*DIL;
  const bf16*Qw=u.Q+(long)(wid*QBLK)*qs;
  const unsigned lds0=(unsigned)(uintptr_t)shm;
  __attribute__((address_space(3))) float*wsf=(__attribute__((address_space(3))) float*)((__attribute__((address_space(3))) char*)shm+LDS_WS)+wid*64;
  const unsigned ksoff=(unsigned)(((long)(8*wid+(lane>>3))*ks+(((lane&7)^(lane>>3))*8))*2);
  const unsigned vsoff=(unsigned)(((long)(16*(wid&3)+(lane>>2))*vs+(wid>>2)*32+(lane&3)*8)*2);
  const unsigned kdst=lds0+LDS_K+wid*1024, vdst=lds0+LDS_V+wid*1024;
  #define DMA_K(t,slot) glds16(u.K+(long)(t)*KVBLK*ks,ksoff,(unsigned)__builtin_amdgcn_readfirstlane(kdst+(slot)))
  #define DMA_V(t,slot) do{ glds16(u.V+(long)(t)*KVBLK*vs,vsoff,(unsigned)__builtin_amdgcn_readfirstlane(vdst+2*(slot))); glds16(u.V+(long)(t)*KVBLK*vs+64*(long)M,vsoff,(unsigned)__builtin_amdgcn_readfirstlane(vdst+2*(slot)+8192)); }while(0)
  bf16x8 kf[8];
  const lds_cptr shm3=(lds_cptr)shm; const lds_cptr kp0=shm3+LDS_K+r32*128+((hi^(r32&1))*16); const int kbo=((r32>>1)&3)<<5; const lds_cptr vp0=shm3+LDS_V+((lane>>4)&1)*32+(lane&3)*8+(4*hi+((lane&15)>>2))*64;
  const int NT=u.NT;
  DMA_K(0,0);DMA_V(0,0);DMA_K(1,SLOTB);
  bf16x8 qr[4];
  #pragma unroll
  for(int d0=0;d0<4;++d0)qr[d0]=*reinterpret_cast<const bf16x8*>(&Qw[(long)r32*qs+d0*16+hi*8]);
  const unsigned s2hb=__float_as_uint(u.slope2)&0xffff0000u; const float s2hf=__uint_as_float(s2hb);
  const unsigned s2lb=__float_as_uint(u.slope2-s2hf)&0xffff0000u; const float s2used=s2hf+__uint_as_float(s2lb);
  u32x4 qx; qx[0]=hi?0u:((__float_as_uint(64.f*s2hf)>>16)|(__float_as_uint(64.f*__uint_as_float(s2lb))&0xffff0000u)); qx[1]=hi?0u:((s2hb>>16)|s2lb); qx[2]=0u; qx[3]=0u;
  u32x4 kx0; unsigned jp0,jp1; { const unsigned j0=__float_as_uint((float)r32)>>16, j1=__float_as_uint((float)(r32+32))>>16; jp0=j0|(j0<<16); jp1=j1|(j1<<16);
    kx0[0]=0u; kx0[1]=jp0; kx0[2]=0x3f803f80u; kx0[3]=0u; }
  #define SETTG(t) do{ const unsigned tb_=__float_as_uint((float)(u.tg0+(t)))>>16; kx0[0]=(tb_|(tb_<<16)); }while(0)
  #define KX0 __builtin_bit_cast(bf16x8,kx0)
  #define QX __builtin_bit_cast(bf16x8,qx)
  #define SETREF(m_) do{ const unsigned hb_=__float_as_uint(m_)&0xffff0000u; const float hf_=__uint_as_float(hb_); const unsigned lb_=__float_as_uint((m_)-hf_)&0xffff0000u; \
      mhat=hf_+__uint_as_float(lb_); qx[2]=hi?0u:(((hb_^0x80000000u)>>16)|(lb_^0x80000000u)); }while(0)
  float mhat=0.f,l_reg=0.f;f32x16 o[4];o[0]=f32x16{};o[1]=f32x16{};o[2]=f32x16{};o[3]=f32x16{};
  const int qrel=u.rel0+wid*QBLK+r32-4*hi;
  #define CMASK(P0,P1,t) do{ if(MODE!=0||(t)>=NT-4) wmask<W>(P0,P1,qrel-64*(t),NEG); }while(0)
  bool resc=false;
  f32x16 pA0,pA1,pB0,pB1;
  int sl_prev=0,sl_cur=0,sl_next=SLOTB;
  #define ROT() do{sl_prev=sl_cur;sl_cur=sl_next;sl_next=(sl_next==(NSLOT-1)*SLOTB)?0:sl_next+SLOTB;}while(0)
  #define RESC() do{ if(resc){ asm volatile("s_waitcnt lgkmcnt(0)":::"memory"); \
      _Pragma("unroll") for(int d_=0;d_<4;++d_) _Pragma("unroll") for(int r=0;r<16;++r)o[d_][r]*=wsf[crow(r,hi)]; } }while(0)
  DMA_K(2,2*SLOTB);
  WAIT_BAR(4);
  { SETTG(0); const f32x16 z=f32x16{}; const lds_cptr kb=kp0;
    #pragma unroll
    for(int d0=0;d0<4;++d0){
      const bf16x8 b0=*(const __attribute__((address_space(3))) bf16x8*)(kb+((d0*32)^kbo));
      const bf16x8 b1=*(const __attribute__((address_space(3))) bf16x8*)(kb+((d0*32)^kbo)+4096);
      if(d0==0){pA0=__builtin_amdgcn_mfma_f32_32x32x16_bf16(b0,qr[0],z,0,0,0);pA1=__builtin_amdgcn_mfma_f32_32x32x16_bf16(b1,qr[0],z,0,0,0);}
      else{pA0=__builtin_amdgcn_mfma_f32_32x32x16_bf16(b0,qr[d0],pA0,0,0,0);pA1=__builtin_amdgcn_mfma_f32_32x32x16_bf16(b1,qr[d0],pA1,0,0,0);}}
    pA0=__builtin_amdgcn_mfma_f32_32x32x16_bf16(KX0,QX,pA0,0,0,0); kx0[1]=jp1; pA1=__builtin_amdgcn_mfma_f32_32x32x16_bf16(KX0,QX,pA1,0,0,0); kx0[1]=jp0; }
  asm volatile("s_nop 15\n\ts_nop 7":"+v"(pA0),"+v"(pA1));CMASK(pA0,pA1,0);
  { const float rm=rowmax(pA0,pA1); SETREF(rm); const float dl=mhat;
    _Pragma("unroll") for(int r=0;r<16;++r){pA0[r]=fsub_s(pA0[r],dl);pA1[r]=fsub_s(pA1[r],dl);}
    _Pragma("unroll") for(int r=0;r<16;++r)pA0[r]=__builtin_amdgcn_exp2f(pA0[r]); }
  _Pragma("unroll") for(int r=0;r<16;++r)pA1[r]=__builtin_amdgcn_exp2f(pA1[r]);
  WAIT_BAR(0);
  DMA_K(3,0);DMA_V(1,SLOTB);
  ROT();
  kload8(kf,kp0+sl_cur,kbo);
  WAIT_BAR(3);
  s16x4 vlo[3],vhi[3]; u32x4 pw0,pw1,pw2,pw3;
  #define PKW(P,B) cvtpk_s(P[B],P[B+1])
  #define PAF(k) __builtin_bit_cast(bf16x8,pw##k)
  #define VFJ(b) (bf16x8){vlo[b][0],vlo[b][1],vlo[b][2],vlo[b][3],vhi[b][0],vhi[b][1],vhi[b][2],vhi[b][3]}
  #define PIN(x) asm volatile("":"+v"(x))
  #define MX3(a,b,c) __builtin_fmaxf(__builtin_fmaxf((a),(b)),(c))
  #define GAPA(MF,A0,A1,A2,A3,W0,W1,PW) do{ MF; sacc+=A0; sacc+=A1; sacc+=A2; sacc+=A3; PIN(sacc); W0; W1; PIN(PW); SBAR(); }while(0)
  #define EX(v) __builtin_amdgcn_exp2f(v)
  #define GAPB2(MF,X,B) do{ MF; X[B]=EX(X[B]); X[B+1]=EX(X[B+1]); PIN(X); SBAR(); }while(0)
  #define VRJ(b,n) do{ vlo[b]=vtr(vp_+(((n)&3)*4096+((n)>>2)*1024)); vhi[b]=vtr(vp_+(((n)&3)*4096+((n)>>2)*1024+512)); SBAR(); }while(0)
  #define KRD(G,j) do{ if(G){ kload2(kf,kp0+sl_next,j,kbo); SBAR(); } }while(0)
  #define STEP(C0,C1,P0,P1,t,GK,GV,GL) do{ SBAR(); SETTG(t); const f32x16 z_=f32x16{}; \
    const lds_cptr vp_=vp0+2*sl_prev; \
    float sacc=(P0[0]+P0[1]); \
    GAPA(C0=__builtin_amdgcn_mfma_f32_32x32x16_bf16(kf[0],qr[0],z_,0,0,0), P0[2],P0[3],P0[4],P0[5],     pw0[0]=PKW(P0,0), pw0[1]=PKW(P0,2), pw0); \
    GAPA(C1=__builtin_amdgcn_mfma_f32_32x32x16_bf16(kf[1],qr[0],z_,0,0,0), P0[6],P0[7],P0[8],P0[9],     pw0[2]=PKW(P0,4), pw0[3]=PKW(P0,6), pw0); \
    GAPA(C0=__builtin_amdgcn_mfma_f32_32x32x16_bf16(kf[2],qr[1],C0,0,0,0),   P0[10],P0[11],P0[12],P0[13], pw1[0]=PKW(P0,8), pw1[1]=PKW(P0,10), pw1); \
    GAPA(C1=__builtin_amdgcn_mfma_f32_32x32x16_bf16(kf[3],qr[1],C1,0,0,0),   P0[14],P0[15],P1[0],P1[1],   pw1[2]=PKW(P0,12),pw1[3]=PKW(P0,14), pw1); \
    GAPA(C0=__builtin_amdgcn_mfma_f32_32x32x16_bf16(kf[4],qr[2],C0,0,0,0),   P1[2],P1[3],P1[4],P1[5],     pw2[0]=PKW(P1,0), pw2[1]=PKW(P1,2), pw2); \
    GAPA(C1=__builtin_amdgcn_mfma_f32_32x32x16_bf16(kf[5],qr[2],C1,0,0,0),   P1[6],P1[7],P1[8],P1[9],     pw2[2]=PKW(P1,4), pw2[3]=PKW(P1,6), pw2); \
    VRJ(0,0); GAPA(C0=__builtin_amdgcn_mfma_f32_32x32x16_bf16(kf[6],qr[3],C0,0,0,0),   P1[10],P1[11],P1[12],P1[13], pw3[0]=PKW(P1,8), pw3[1]=PKW(P1,10), pw3); \
    VRJ(1,1); GAPA(C1=__builtin_amdgcn_mfma_f32_32x32x16_bf16(kf[7],qr[3],C1,0,0,0),   P1[14],P1[15],0.f,0.f,       pw3[2]=PKW(P1,12),pw3[3]=PKW(P1,14), pw3); \
    C0=__builtin_amdgcn_mfma_f32_32x32x16_bf16(KX0,QX,C0,0,0,0); kx0[1]=jp1; C1=__builtin_amdgcn_mfma_f32_32x32x16_bf16(KX0,QX,C1,0,0,0); kx0[1]=jp0; SBAR(); \
    l_reg+=sacc; \
    if(GK){DMA_K((t)+3,sl_cur);} if(GV){DMA_V((t)+1,sl_next);} \
    CMASK(C0,C1,t); \
    { float a=MX3(C0[0],C0[1],C1[0]),b=MX3(C0[2],C0[3],C1[1]); a=MX3(a,C1[2],C1[3]); \
      _Pragma("unroll") for(int r=4;r<16;r+=4){a=MX3(a,C0[r],C0[r+1]);b=MX3(b,C0[r+2],C0[r+3]);a=MX3(a,C1[r],C1[r+1]);b=MX3(b,C1[r+2],C1[r+3]);} \
      float rm=__builtin_fmaxf(a,b); { auto rr=__builtin_amdgcn_permlane32_swap(__float_as_uint(rm),__float_as_uint(rm),false,false); rm=__builtin_fmaxf(__uint_as_float(rr[0]),__uint_as_float(rr[1])); } \
      resc=false; \
      if(__builtin_expect(__any(rm>(float)THRL),0)){ const float mold=mhat; const float mnew=mold+__builtin_fmaxf(rm,0.f); SETREF(mnew); const float dl=mhat-mold; \
        _Pragma("unroll") for(int r=0;r<16;++r){C0[r]-=dl;C1[r]-=dl;} \
        const float f=__builtin_amdgcn_exp2f(-dl); l_reg*=f; if(hi==0)wsf[r32]=f; resc=true; } } \
    SBAR(); \
    VRJ(2,2);             GAPB2(o[0]=__builtin_amdgcn_mfma_f32_32x32x16_bf16(PAF(0),VFJ(0),o[0],0,0,0), C0,0); \
    VRJ(0,3);             GAPB2(o[1]=__builtin_amdgcn_mfma_f32_32x32x16_bf16(PAF(0),VFJ(1),o[1],0,0,0), C0,2); \
    VRJ(1,4);             GAPB2(o[2]=__builtin_amdgcn_mfma_f32_32x32x16_bf16(PAF(0),VFJ(2),o[2],0,0,0), C0,4); \
    VRJ(2,5);             GAPB2(o[3]=__builtin_amdgcn_mfma_f32_32x32x16_bf16(PAF(0),VFJ(0),o[3],0,0,0), C0,6); \
    VRJ(0,6);  KRD(GL,0); GAPB2(o[0]=__builtin_amdgcn_mfma_f32_32x32x16_bf16(PAF(1),VFJ(1),o[0],0,0,0), C0,8); \
    VRJ(1,7);             GAPB2(o[1]=__builtin_amdgcn_mfma_f32_32x32x16_bf16(PAF(1),VFJ(2),o[1],0,0,0), C0,10); \
    VRJ(2,8);  KRD(GL,1); GAPB2(o[2]=__builtin_amdgcn_mfma_f32_32x32x16_bf16(PAF(1),VFJ(0),o[2],0,0,0), C0,12); \
    VRJ(0,9);             GAPB2(o[3]=__builtin_amdgcn_mfma_f32_32x32x16_bf16(PAF(1),VFJ(1),o[3],0,0,0), C0,14); \
    VRJ(1,10); KRD(GL,2); GAPB2(o[0]=__builtin_amdgcn_mfma_f32_32x32x16_bf16(PAF(2),VFJ(2),o[0],0,0,0), C1,0); \
    VRJ(2,11);            GAPB2(o[1]=__builtin_amdgcn_mfma_f32_32x32x16_bf16(PAF(2),VFJ(0),o[1],0,0,0), C1,2); \
    VRJ(0,12); KRD(GL,3); GAPB2(o[2]=__builtin_amdgcn_mfma_f32_32x32x16_bf16(PAF(2),VFJ(1),o[2],0,0,0), C1,4); \
    VRJ(1,13);            GAPB2(o[3]=__builtin_amdgcn_mfma_f32_32x32x16_bf16(PAF(2),VFJ(2),o[3],0,0,0), C1,6); \
    VRJ(2,14);            GAPB2(o[0]=__builtin_amdgcn_mfma_f32_32x32x16_bf16(PAF(3),VFJ(0),o[0],0,0,0), C1,8); \
    VRJ(0,15);            GAPB2(o[1]=__builtin_amdgcn_mfma_f32_32x32x16_bf16(PAF(3),VFJ(1),o[1],0,0,0), C1,10); \
                          GAPB2(o[2]=__builtin_amdgcn_mfma_f32_32x32x16_bf16(PAF(3),VFJ(2),o[2],0,0,0), C1,12); \
                          GAPB2(o[3]=__builtin_amdgcn_mfma_f32_32x32x16_bf16(PAF(3),VFJ(0),o[3],0,0,0), C1,14); \
    }while(0)
  int t=1;
  if(MODE==0){
    #undef CMASK
    #define CMASK(P0,P1,t) do{}while(0)
    for(;t+5<NT;t+=2){
      STEP(pB0,pB1,pA0,pA1,t,true,true,true);     WAIT_BAR(3); RESC(); ROT();
      STEP(pA0,pA1,pB0,pB1,t+1,true,true,true);   WAIT_BAR(3); RESC(); ROT();
    }
    #undef CMASK
    #define CMASK(P0,P1,t) do{ if(MODE!=0||(t)>=NT-4) wmask<W>(P0,P1,qrel-64*(t),NEG); }while(0)
  }
  #define ENDW(tt) do{ if((tt)+3<NT){WAIT_BAR(3);} else if((tt)+2<NT){WAIT_BAR(2);} else {WAIT_BAR(0);} }while(0)
  for(;t+1<NT;t+=2){
    STEP(pB0,pB1,pA0,pA1,t,(t+3<NT),(t+1<NT),(t+1<NT));       ENDW(t);   RESC(); ROT();
    STEP(pA0,pA1,pB0,pB1,t+1,(t+4<NT),(t+2<NT),(t+2<NT));     ENDW(t+1); RESC(); ROT();
  }
  STEP(pB0,pB1,pA0,pA1,NT-1,false,false,false); RESC();
  { float sacc=pB0[0]+pB0[1]; _Pragma("unroll") for(int r=2;r<16;++r)sacc+=pB0[r]; _Pragma("unroll") for(int r=0;r<16;++r)sacc+=pB1[r]; l_reg+=sacc;
    pw0=(u32x4){PKW(pB0,0),PKW(pB0,2),PKW(pB0,4),PKW(pB0,6)};pw1=(u32x4){PKW(pB0,8),PKW(pB0,10),PKW(pB0,12),PKW(pB0,14)};pw2=(u32x4){PKW(pB1,0),PKW(pB1,2),PKW(pB1,4),PKW(pB1,6)};pw3=(u32x4){PKW(pB1,8),PKW(pB1,10),PKW(pB1,12),PKW(pB1,14)};
    SBAR(); pv4(o,(int)(lds0+LDS_V)+((lane>>4)&1)*32+(lane&3)*8+(4*hi+((lane&15)>>2))*64+2*sl_cur,PAF(0),PAF(1),PAF(2),PAF(3)); }
  #undef PKW
  #undef PAF
  #undef VFJ
  #undef PIN
  #undef MX3
  #undef GAPA
  #undef GAPB2
  #undef EX
  #undef VRJ
  #undef KRD
  #undef STEP
  #undef ENDW
  {auto rr=__builtin_amdgcn_permlane32_swap(__float_as_uint(l_reg),__float_as_uint(l_reg),false,false);l_reg=__uint_as_float(rr[0])+__uint_as_float(rr[1]);}
  const float qposf=(float)(u.q0+wid*QBLK+r32);
  if(MODE==2) l_reg+=__builtin_amdgcn_exp2f(u.sink2+s2used*qposf-mhat);
  if(MODE==1){ if(hi==0) u.lse[(long)(wid*QBLK+r32)*(16*DIL)]=mhat-s2used*qposf+__builtin_amdgcn_logf(l_reg); }
  if(hi==0)wsf[32+r32]=l_reg;asm volatile("s_waitcnt lgkmcnt(0)":::"memory");
  float rli[16];
  #pragma unroll
  for(int r=0;r<16;++r)rli[r]=__builtin_amdgcn_rcpf(wsf[32+crow(r,hi)]);
  { int le=lane; asm volatile("":"+v"(le));
    const int r32e=le&31,hie=le>>5;
    __hip_bfloat16*stg=(__hip_bfloat16*)(shm+LDS_OST)+wid*4096;
    if(u.fin==0){
      #pragma unroll
      for(int r=0;r<16;++r){const int orow=crow(r,hie);
        #pragma unroll
        for(int d0=0;d0<4;++d0)stg[orow*128+d0*32+r32e]=__float2bfloat16(o[d0][r]*rli[r]);}
    } else {
      const float lam=u.lam;
      #pragma unroll
      for(int r=0;r<16;++r){const int orow=crow(r,hie);
        #pragma unroll
        for(int d0=0;d0<4;++d0){ const int ix=orow*128+d0*32+r32e; const float o2=__bfloat162float(__float2bfloat16(o[d0][r]*rli[r])); stg[ix]=__float2bfloat16(__bfloat162float(stg[ix])-lam*o2); } }
      asm volatile("s_waitcnt lgkmcnt(0)":::"memory");
      const int ch=le&15; const float* sgp=u.sg+8*ch; const float g0=sgp[0],g1=sgp[1],g2=sgp[2],g3=sgp[3],g4=sgp[4],g5=sgp[5],g6=sgp[6],g7=sgp[7];
      bf16*Of=u.Of+(long)(wid*QBLK)*D+ch*8;
      #pragma unroll
      for(int i=0;i<8;++i){ const int row=i*4+(le>>4); const u32x4 v=*(const u32x4*)(stg+row*128+ch*8);
        const float x0=__uint_as_float(v[0]<<16),x1=__uint_as_float(v[0]&0xffff0000u),x2=__uint_as_float(v[1]<<16),x3=__uint_as_float(v[1]&0xffff0000u),
                    x4=__uint_as_float(v[2]<<16),x5=__uint_as_float(v[2]&0xffff0000u),x6=__uint_as_float(v[3]<<16),x7=__uint_as_float(v[3]&0xffff0000u);
        float ss=(x0*x0+x1*x1)+(x2*x2+x3*x3)+(x4*x4+x5*x5)+(x6*x6+x7*x7);
        ss+=__shfl_xor(ss,1); ss+=__shfl_xor(ss,2); ss+=__shfl_xor(ss,4); ss+=__shfl_xor(ss,8);
        const float rs=u.lam1/sqrtf(ss*(1.f/128.f)+1e-6f);
        u32x4 w; w[0]=cvtpk_s(x0*rs*g0,x1*rs*g1); w[1]=cvtpk_s(x2*rs*g2,x3*rs*g3); w[2]=cvtpk_s(x4*rs*g4,x5*rs*g5); w[3]=cvtpk_s(x6*rs*g6,x7*rs*g7);
        *(u32x4*)(Of+(long)row*D)=w; }
    } }
  asm volatile("s_waitcnt lgkmcnt(0)\n\ts_barrier":::"memory");
  #undef DMA_K
  #undef DMA_V
  #undef CMASK
  #undef RESC
  #undef ROT
  #undef SETTG
  #undef SETREF
  #undef KX0
  #undef QX
}
#undef SBAR
#undef WAIT_BAR
}

constexpr float LOG2E = 1.4426950408889634f;
__device__ __forceinline__ int vcu_of(int bx, int G) { return (G % 8 == 0) ? (bx % 8) * (G / 8) + bx / 8 : bx; }
constexpr int ATT1_LDS_TAB = 141312;
__device__ __forceinline__ void attn1_tuned_phase(const Ctx& c, const bf16* qkv, const float* qkg  , bf16* R, unsigned* qctr, const ExpertSrc& es, unsigned char* ws,
                                                  const float* lamp, const float* subln, bf16* Oout) {
    LAS int* order = (LAS int*)(c.lds + ATT1_LDS_TAB);
    LAS int* nts = order + 256;
    LAS int* t0s = nts + 256;
    volatile LAS unsigned* nextu = (volatile LAS unsigned*)(t0s + 256);
    LAS float* bnd = (LAS float*)(t0s + 256 + 4);
    const int G = gridDim.x;
    if (c.wave == 0) { float gq = fabsf(qkg[c.lane]), gk = fabsf(qkg[64 + c.lane]);
#pragma unroll
        for (int o = 1; o < 64; o <<= 1) { gq = fmaxf(gq, __shfl_xor(gq, o)); gk = fmaxf(gk, __shfl_xor(gk, o)); }
        if (c.lane == 0) bnd[0] = 8.f * gq * gk * 1.02f; }
    __syncthreads();
    if (c.tid < 256) { const int h = c.tid >> 4, qb = c.tid & 15; const float slope = exp2f(-0.5f * (float)(h + 1));
        const int dmax = (int)fminf(ceilf((2.f * bnd[0] + 25.f) / slope), 1.0e6f), lo_ = 256 * qb - dmax, t0 = lo_ <= 0 ? 0 : ((lo_ >> 6) & ~1);
        nts[c.tid] = 4 * (qb + 1) - t0; t0s[c.tid] = t0; }
    __syncthreads();
    if (c.tid < 256) { const int mine = nts[c.tid]; int rank = 0;
        for (int e = 0; e < 256; ++e) { const int o = nts[e]; rank += (o > mine || (o == mine && e < c.tid)) ? 1 : 0; }
        order[rank] = c.tid; }
    __syncthreads();
#if FUSE_FINISH
    constexpr int NCH = DEFER_CONV ? EXP_ITEMS / 65 : 0, NUNIT = NB * 16 * 16, NPOS = NUNIT + NCH;
    static_assert(!DEFER_CONV || EXP_ITEMS % 65 == 0, "chunking");
    if (c.tid == 0) { float s01 = 0.f, s23 = 0.f; for (int i = 0; i < 64; ++i) { s01 += lamp[i] * lamp[64 + i]; s23 += lamp[128 + i] * lamp[192 + i]; }
      const float li = 0.8f - 0.6f * expf(-0.3f * 1.0f); bnd[1] = expf(s01) - expf(s23) + li; bnd[2] = li; }
    __syncthreads();
    unsigned p = blockIdx.x;
    while (p < (unsigned)NPOS) {
        unsigned nreg = 0u;
        if (c.tid == 0) nreg = __hip_atomic_fetch_add(qctr, 1u, __ATOMIC_RELAXED, __HIP_MEMORY_SCOPE_AGENT) + (unsigned)G;
        const bool inter = p < (unsigned)(NCH * 2);
        if (inter && (p & 1u)) {
            expert_items_block(c, es, 1, ws, (int)(p >> 1) * 65, 65);
        } else {
#define ATT1_DECODE() const unsigned u = inter ? (p >> 1) : p - (unsigned)NCH; const int ent = order[u >> 2], h = ent >> 4, qb = ent & 15, b = (int)(u & 3u), t0 = t0s[ent]; \
            bf16* Rblk = R + ((size_t)(b * T + qb * 256) * 16 + h) * 256
#if USE_V128
#pragma unroll 1
            for (int pass = 0; pass < 2; ++pass) {
                ATT1_DECODE();
                const int i = pass; att::UnitDesc ud;
                ud.Q = qkv + ((size_t)(2 * h + i) * M + (size_t)(b * T + qb * 256)) * 64; ud.qs = 64;
                ud.K = qkv + ((size_t)(32 + 2 * h + i) * M + (size_t)(b * T + 64 * t0)) * 64; ud.ks = 64;
                ud.V = qkv + ((size_t)(64 + 2 * h) * M + (size_t)(b * T + 64 * t0)) * 64; ud.vs = 64;
                ud.O = Rblk + 128 * i; ud.os = 16 * 256;
                ud.lse = nullptr; ud.lses = 0; ud.NT = 4 * (qb + 1) - t0; ud.rel0 = qb * 256 - 64 * t0; ud.tg0 = t0; ud.q0 = qb * 256;
                ud.slope2 = exp2f(-0.5f * (float)(h + 1)) * LOG2E; ud.sink2 = 0.f;
                ud.fin = pass; ud.lam = bnd[1]; ud.lam1 = 1.f - bnd[2]; ud.sg = subln; ud.Of = Oout + (size_t)(b * T + qb * 256) * D + 128 * h;
                att128::attn_unit<0, 8, 1, 16 * 256>(ud, (char*)c.lds);
            }
#else
#pragma unroll 1
            for (int pass = 0; pass < 4; ++pass) {
                ATT1_DECODE();
                const int i = pass >> 1, j = pass & 1; att::UnitDesc ud;
#if QKV_HEADMAJOR
                ud.Q = qkv + ((size_t)(2 * h + i) * M + (size_t)(b * T + qb * 256)) * 64; ud.qs = 64;
                ud.K = qkv + ((size_t)(32 + 2 * h + i) * M + (size_t)(b * T + 64 * t0)) * 64; ud.ks = 64;
                ud.V = qkv + ((size_t)(64 + 2 * h + j) * M + (size_t)(b * T + 64 * t0)) * 64; ud.vs = 64;
#else
                ud.Q = qkv + (size_t)(b * T + qb * 256) * C_IN + 128 * h + 64 * i; ud.qs = C_IN;
                ud.K = qkv + (size_t)(b * T + 64 * t0) * C_IN + 2048 + 128 * h + 64 * i; ud.ks = C_IN;
                ud.V = qkv + (size_t)(b * T + 64 * t0) * C_IN + 4096 + 128 * h + 64 * j; ud.vs = C_IN;
#endif
                ud.O = Rblk + 128 * i + 64 * j; ud.os = 16 * 256;
                ud.lse = nullptr; ud.lses = 0; ud.NT = 4 * (qb + 1) - t0; ud.rel0 = qb * 256 - 64 * t0; ud.tg0 = t0; ud.q0 = qb * 256;
                ud.slope2 = exp2f(-0.5f * (float)(h + 1)) * LOG2E; ud.sink2 = 0.f;
                att::attn_unit<0, 8, 1, 16 * 256>(ud, (char*)c.lds);
            }
#endif
#if !USE_V128
            asm volatile("s_waitcnt vmcnt(0)" ::: "memory"); __syncthreads();
            { ATT1_DECODE(); (void)t0; const float lam = bnd[1], lam_init = bnd[2];
              int ft_ = threadIdx.x; asm volatile("" : "+v"(ft_));
              const int row = ft_ >> 1, hf = ft_ & 1; const bf16* p1 = Rblk + (size_t)row * (16 * 256) + 64 * hf; const bf16* p2 = p1 + 128;
              float xv[64]; float ss = 0.f;
#pragma unroll
              for (int q8 = 0; q8 < 8; ++q8) { const u32x4 a = *(const u32x4*)(p1 + 8 * q8), bq = *(const u32x4*)(p2 + 8 * q8);
#pragma unroll
                  for (int k = 0; k < 4; ++k) { const float x0 = bf2f(a[k] & 0xffffu) - lam * bf2f(bq[k] & 0xffffu), x1 = bf2f(a[k] >> 16) - lam * bf2f(bq[k] >> 16);
                      xv[8 * q8 + 2 * k] = x0; xv[8 * q8 + 2 * k + 1] = x1; ss += x0 * x0 + x1 * x1; } }
              ss += __shfl_xor(ss, 1);
              const float rs = (1.f - lam_init) / sqrtf(ss * (1.f / 128.f) + RMS_EPS);
              bf16* op = Oout + (size_t)(b * T + qb * 256 + row) * D + 128 * h + 64 * hf; const float* sg = subln + 64 * hf;
#pragma unroll
              for (int q8 = 0; q8 < 8; ++q8) { u32x4 w;
#pragma unroll
                  for (int k = 0; k < 4; ++k) w[k] = pk2(xv[8 * q8 + 2 * k] * rs * sg[8 * q8 + 2 * k], xv[8 * q8 + 2 * k + 1] * rs * sg[8 * q8 + 2 * k + 1]);
                  *(u32x4*)(op + 8 * q8) = w; } }
#endif
#undef ATT1_DECODE
        }
        if (c.tid == 0) nextu[0] = nreg;
        __syncthreads();
        p = nextu[0];
    }
}
#else
    constexpr int NCH = DEFER_CONV ? EXP_ITEMS / 65 : 0, NPOS = NB * 16 * 4 * 16 + NCH;
    static_assert(!DEFER_CONV || EXP_ITEMS % 65 == 0, "chunking");
    unsigned p = blockIdx.x;
    while (p < (unsigned)NPOS) {
        unsigned nreg = 0u;
        if (c.tid == 0) nreg = __hip_atomic_fetch_add(qctr, 1u, __ATOMIC_RELAXED, __HIP_MEMORY_SCOPE_AGENT) + (unsigned)G;
        const bool inter = p < (unsigned)(NCH * 6);
        if (inter && (p % 6u) == 5u) {
            expert_items_block(c, es, 1, ws, (int)(p / 6u) * 65, 65);
        } else {
            const unsigned u = inter ? p - p / 6u : p - (unsigned)NCH;
            const int ent = order[u >> 4], h = ent >> 4, qb = ent & 15, bp = (int)(u & 15u), b = bp >> 2, i = (bp >> 1) & 1, j = bp & 1, t0 = t0s[ent];
            att::UnitDesc ud;
#if QKV_HEADMAJOR
            ud.Q = qkv + ((size_t)(2 * h + i) * M + (size_t)(b * T + qb * 256)) * 64; ud.qs = 64;
            ud.K = qkv + ((size_t)(32 + 2 * h + i) * M + (size_t)(b * T + 64 * t0)) * 64; ud.ks = 64;
            ud.V = qkv + ((size_t)(64 + 2 * h + j) * M + (size_t)(b * T + 64 * t0)) * 64; ud.vs = 64;
#else
            ud.Q = qkv + (size_t)(b * T + qb * 256) * C_IN + 128 * h + 64 * i; ud.qs = C_IN;
            ud.K = qkv + (size_t)(b * T + 64 * t0) * C_IN + 2048 + 128 * h + 64 * i; ud.ks = C_IN;
            ud.V = qkv + (size_t)(b * T + 64 * t0) * C_IN + 4096 + 128 * h + 64 * j; ud.vs = C_IN;
#endif
            ud.O = R + ((size_t)(b * T + qb * 256) * 16 + h) * 256 + 128 * i + 64 * j; ud.os = 16 * 256;
            ud.lse = nullptr; ud.lses = 0; ud.NT = 4 * (qb + 1) - t0; ud.rel0 = qb * 256 - 64 * t0; ud.tg0 = t0; ud.q0 = qb * 256;
            ud.slope2 = exp2f(-0.5f * (float)(h + 1)) * LOG2E; ud.sink2 = 0.f;
            att::attn_unit<0, 8, 1, 16 * 256>(ud, (char*)c.lds);
        }
        if (c.tid == 0) nextu[0] = nreg;
        __syncthreads();
        p = nextu[0];
    }
}
#endif
__device__ __forceinline__ void attn1_finish_bf16_phase(const Ctx& c, const bf16* R, const float* lamp, const float* subln, bf16* O) {
    float s01 = 0.f, s23 = 0.f;
    for (int i = 0; i < 64; ++i) { s01 += lamp[i] * lamp[64 + i]; s23 += lamp[128 + i] * lamp[192 + i]; }
    const float lam_init = 0.8f - 0.6f * expf(-0.3f * 1.0f);
    const float lam = expf(s01) - expf(s23) + lam_init;
    const long total = (long)M * 16;
    for (long id = gtid_now(); id < total; id += c.gsz) {
        const bf16* p1 = R + (size_t)id * 256; const bf16* p2 = p1 + 128;
        float ss = 0.f;
#pragma unroll 4
        for (int i = 0; i < 16; ++i) { const u32x4 a = *(const u32x4*)(p1 + 8 * i), bq = *(const u32x4*)(p2 + 8 * i);
#pragma unroll
            for (int k = 0; k < 4; ++k) { const float x0 = bf2f(a[k] & 0xffffu) - lam * bf2f(bq[k] & 0xffffu), x1 = bf2f(a[k] >> 16) - lam * bf2f(bq[k] >> 16); ss += x0 * x0 + x1 * x1; } }
        const float rs = (1.f - lam_init) / sqrtf(ss * (1.f / 128.f) + RMS_EPS);
        bf16* op = O + (size_t)id * 128;
#pragma unroll 4
        for (int i = 0; i < 16; ++i) { const u32x4 a = *(const u32x4*)(p1 + 8 * i), bq = *(const u32x4*)(p2 + 8 * i); u32x4 w;
#pragma unroll
            for (int k = 0; k < 4; ++k) { const float x0 = bf2f(a[k] & 0xffffu) - lam * bf2f(bq[k] & 0xffffu), x1 = bf2f(a[k] >> 16) - lam * bf2f(bq[k] >> 16);
                w[k] = pk2(x0 * rs * subln[8 * i + 2 * k], x1 * rs * subln[8 * i + 2 * k + 1]); }
            *(u32x4*)(op + 8 * i) = w; }
    }
}
__device__ __forceinline__ void attn0_tuned_phase(const Ctx& c, const bf16* qkv, const float* sinks, bf16* OBR  , float* LSE  , bf16* O, int xlo, int xhi) {
    const int G = gridDim.x, vcu = vcu_of(blockIdx.x, G);
    for (int gid = vcu; gid < NB * 64; gid += G) {
        const int b = gid / 64, kind = (gid % 64) / 16, h = gid % 16;
        const float slope2 = exp2f(-0.5f * (float)(h + 1)) * LOG2E;
        if (kind < 3) {
            const int dil = kind == 0 ? 1 : (kind == 1 ? 4 : 16), nblk = 16 / dil;
            for (int x = xlo; x < xhi; ++x) {
                const int r = x / nblk, blk = x % nblk, q0 = blk * 256, t0 = blk ? 4 * blk - 2 : 0; att::UnitDesc u;
                const size_t qrow = (size_t)(b * T + r + dil * q0), krow = (size_t)(b * T + r + dil * 64 * t0);
#if QKV_HEADMAJOR
                u.Q = qkv + ((size_t)(h) * M + qrow) * 64; u.qs = (long)dil * 64;
                u.K = qkv + ((size_t)(16 + h) * M + krow) * 64; u.ks = (long)dil * 64;
                u.V = qkv + ((size_t)(32 + h) * M + krow) * 64; u.vs = (long)dil * 64;
#else
                u.Q = qkv + qrow * AB_IN + 64 * h; u.qs = (long)dil * AB_IN;
                u.K = qkv + krow * AB_IN + 1024 + 64 * h; u.ks = (long)dil * AB_IN;
                u.V = qkv + krow * AB_IN + 2048 + 64 * h; u.vs = (long)dil * AB_IN;
#endif
                u.O = OBR + ((size_t)kind * M + qrow) * 1024 + 64 * h; u.os = (long)dil * 1024;
                u.lse = LSE + ((size_t)kind * M + qrow) * 16 + h; u.lses = (long)dil * 16;
                u.NT = blk ? 6 : 4; u.rel0 = q0 - 64 * t0; u.tg0 = t0; u.q0 = q0; u.slope2 = slope2 * (float)dil; u.sink2 = 0.f;
                if (dil == 1) att::attn_unit<1, 8, 1, 1024>(u, (char*)c.lds); else if (dil == 4) att::attn_unit<1, 8, 4, 4096>(u, (char*)c.lds); else att::attn_unit<1, 8, 16, 16384>(u, (char*)c.lds);
            }
        } else {
            const int kvh = h >> 3;
            for (int x = xlo; x < xhi; ++x) {
                const int q0 = x * 256, t0 = x ? 4 * x - 2 : 0; att::UnitDesc u;
                const size_t qrow = (size_t)(b * T + q0), krow = (size_t)(b * T + 64 * t0);
#if QKV_HEADMAJOR
                u.Q = qkv + ((size_t)(48 + h) * M + qrow) * 64; u.qs = 64;
                u.K = qkv + ((size_t)(64 + kvh) * M + krow) * 64; u.ks = 64;
                u.V = qkv + ((size_t)(66 + kvh) * M + krow) * 64; u.vs = 64;
#else
                u.Q = qkv + qrow * AB_IN + 3072 + 64 * h; u.qs = AB_IN;
                u.K = qkv + krow * AB_IN + 4096 + 64 * kvh; u.ks = AB_IN;
                u.V = qkv + krow * AB_IN + 4224 + 64 * kvh; u.vs = AB_IN;
#endif
                u.O = O + qrow * D + 1024 + 64 * h; u.os = D;
                u.lse = nullptr; u.lses = 0;
                u.NT = x ? 6 : 4; u.rel0 = q0 - 64 * t0; u.tg0 = t0; u.q0 = q0; u.slope2 = slope2; u.sink2 = sinks[h] * LOG2E;
                att::attn_unit<2, 8, 1, D>(u, (char*)c.lds);
            }
        }
    }
}
__device__ __forceinline__ void attn0_merge_phase(const Ctx& c, const bf16* OBR, const float* LSE, bf16* O) {
    const long total = (long)M * 16;
    for (long id = gtid_now(); id < total; id += c.gsz) {
        const long m = id / 16; const int h = (int)(id % 16);
        const float l0 = LSE[id], l1 = LSE[(size_t)M * 16 + id], l2 = LSE[(size_t)2 * M * 16 + id];
        const float mx = fmaxf(l0, fmaxf(l1, l2)); float w0 = exp2f(l0 - mx), w1 = exp2f(l1 - mx), w2 = exp2f(l2 - mx); const float inv = 1.f / (w0 + w1 + w2); w0 *= inv; w1 *= inv; w2 *= inv;
        const bf16* p0 = OBR + (size_t)m * 1024 + 64 * h; const bf16* p1 = p0 + (size_t)M * 1024; const bf16* p2 = p1 + (size_t)M * 1024;
        bf16* op = O + (size_t)m * D + 64 * h;
#pragma unroll
        for (int i = 0; i < 8; ++i) { const u32x4 a = *(const u32x4*)(p0 + 8 * i), bq = *(const u32x4*)(p1 + 8 * i), cq = *(const u32x4*)(p2 + 8 * i); u32x4 w;
#pragma unroll
            for (int k = 0; k < 4; ++k) w[k] = pk2(w0 * bf2f(a[k] & 0xffffu) + w1 * bf2f(bq[k] & 0xffffu) + w2 * bf2f(cq[k] & 0xffffu), w0 * bf2f(a[k] >> 16) + w1 * bf2f(bq[k] >> 16) + w2 * bf2f(cq[k] >> 16));
            *(u32x4*)(op + 8 * i) = w; }
    }
}

__device__ __forceinline__ void convert_router(const Ctx& c, const float* wr, bf16* wrt) {
    for (int id2 = gtid_now(); id2 < 2 * NE * D; id2 += c.gsz) { const int l = id2 / (NE * D), id = id2 % (NE * D), k = id / NE, n = id % NE; const float w = wr[id2];
        const unsigned hb = f2bf(w); const float hf = bf2f(hb);
        const int kkn = 2 * ((k >> 6) & 3) + ((k >> 3) & 1), qn = (k >> 4) & 3;
        const int off = l * 2 * NE * D + (((((k >> 8) * 8 + kkn) * 4 + (n >> 4)) * 2) * 64 + ((n & 15) + 16 * qn)) * 8 + (k & 7);
        wrt[off] = (bf16)hb; wrt[off + 512] = (bf16)f2bf(w - hf); }
}
#define DPPF(old, v, ctrl, rm) __int_as_float(__builtin_amdgcn_update_dpp(__float_as_int(old), __float_as_int(v), ctrl, rm, 0xf, false))
__device__ __forceinline__ float dpp_max8(float v) {
    v = fmaxf(v, DPPF(v, v, 0xB1, 0xf)); v = fmaxf(v, DPPF(v, v, 0x4E, 0xf)); v = fmaxf(v, DPPF(v, v, 0x141, 0xf)); return v; }
__device__ __forceinline__ float wave_max_u(float v) {
    v = dpp_max8(v); v = fmaxf(v, DPPF(v, v, 0x140, 0xf)); v = fmaxf(v, DPPF(v, v, 0x142, 0xa)); v = fmaxf(v, DPPF(v, v, 0x143, 0xc));
    return __int_as_float(__builtin_amdgcn_readlane(__float_as_int(v), 63)); }
__device__ __forceinline__ float wave_sum_u(float v) {
    v += DPPF(0.f, v, 0xB1, 0xf); v += DPPF(0.f, v, 0x4E, 0xf); v += DPPF(0.f, v, 0x141, 0xf); v += DPPF(0.f, v, 0x140, 0xf); v += DPPF(0.f, v, 0x142, 0xa); v += DPPF(0.f, v, 0x143, 0xc);
    return __int_as_float(__builtin_amdgcn_readlane(__float_as_int(v), 63)); }
constexpr int RT_ROUTER = 2;
__device__ __forceinline__ void router2_phase(const Ctx& c, const float* x1, const float* g, const float* ada_l, const bf16* wrt, const float* rbias,
                                              bf16* HF, int* idx, float* gate, int* wcnt, bf16* HFB = nullptr) {
    constexpr int RT = RT_ROUTER, RU = 16 * RT, NU = M / RU;
    LAS float* red = (LAS float*)c.lds;
    LAS float* part = (LAS float*)(c.lds + 1024);
    LAS float* GA = (LAS float*)(c.lds + 1024 + RT * 32768);
    LAS float* GB = GA + D;
    const int w = __builtin_amdgcn_readfirstlane((int)threadIdx.x >> 6);
    const float rb = rbias[threadIdx.x & 63];
    unsigned cnt = 0u;
    const int per = (NU + (int)gridDim.x - 1) / (int)gridDim.x, u0 = blockIdx.x * per, u1 = (u0 + per < NU) ? u0 + per : NU;
    int bcur = -1;
#pragma unroll 1
    for (int u = u0; u < u1; ++u) {
        int tid = threadIdx.x; asm volatile("" : "+v"(tid));
        const int lane = tid & 63, r = lane & 15, q = lane >> 4, cb = 256 * w + 16 * q;
#define KOFF(kk_) (64 * ((kk_) >> 1) + 8 * ((kk_) & 1))
        const bf16* wf = wrt + (size_t)w * (8 * 4 * 2 * 512) + lane * 8;
        const int m0 = u * RU, b = m0 / T;
        if (b != bcur) { bcur = b; __syncthreads();
            for (int col = 4 * tid; col < D; col += 2048) { const f32x4 gg = *(const f32x4*)(g + col), sc = *(const f32x4*)(ada_l + (size_t)b * 6 * D + 4 * D + col), sh = *(const f32x4*)(ada_l + (size_t)b * 6 * D + 3 * D + col);
                *(LAS f32x4*)(GA + col) = gg * (sc + 1.f); *(LAS f32x4*)(GB + col) = sh; } }
        u32x4 xv[RT][8]; float rstd[RT];
#pragma unroll
        for (int t = 0; t < RT; ++t) { const bf16* xr = (const bf16*)x1 + (size_t)(m0 + 16 * t + r) * D + cb;
#pragma unroll
            for (int kk = 0; kk < 8; ++kk) xv[t][kk] = *(const u32x4*)(xr + KOFF(kk)); }
#pragma unroll
        for (int t = 0; t < RT; ++t) { float ss = 0.f;
#pragma unroll
            for (int kk = 0; kk < 8; ++kk)
#pragma unroll
                for (int j = 0; j < 4; ++j) { const float a0 = bf2f(xv[t][kk][j] & 0xffffu), a1 = bf2f(xv[t][kk][j] >> 16); ss += a0 * a0 + a1 * a1; }
            ss += __shfl_xor(ss, 16); ss += __shfl_xor(ss, 32);
            if (q == 0) red[(t * 8 + w) * 16 + r] = ss; }
        __syncthreads();
        f32x4 acc[RT][4]; u32x2 q8keep[RT];
#pragma unroll
        for (int t = 0; t < RT; ++t) { float tot = 0.f;
#pragma unroll
            for (int w2 = 0; w2 < 8; ++w2) tot += red[(t * 8 + w2) * 16 + r];
            rstd[t] = 1.f / sqrtf(tot * (1.f / D) + RMS_EPS);
#pragma unroll
            for (int nt = 0; nt < 4; ++nt) acc[t][nt] = (f32x4){0.f, 0.f, 0.f, 0.f}; }
#pragma unroll
        for (int kk = 0; kk < 8; ++kk) {
            const f32x4 ga0 = *(LAS f32x4*)(GA + cb + KOFF(kk)), ga1 = *(LAS f32x4*)(GA + cb + KOFF(kk) + 4), gb0 = *(LAS f32x4*)(GB + cb + KOFF(kk)), gb1 = *(LAS f32x4*)(GB + cb + KOFF(kk) + 4);
            bf16x8 ah[RT], al[RT];
#pragma unroll
            for (int t = 0; t < RT; ++t) { const u32x4 xw = xv[t][kk]; f32x4 hh[2];
                hh[0] = (f32x4){bf2f(xw.x & 0xffffu), bf2f(xw.x >> 16), bf2f(xw.y & 0xffffu), bf2f(xw.y >> 16)} * rstd[t] * ga0 + gb0;
                hh[1] = (f32x4){bf2f(xw.z & 0xffffu), bf2f(xw.z >> 16), bf2f(xw.w & 0xffffu), bf2f(xw.w >> 16)} * rstd[t] * ga1 + gb1;
                u32x4 hw, lw;
#pragma unroll
                for (int s2 = 0; s2 < 2; ++s2) { const unsigned h0 = f2bf(hh[s2].x), h1 = f2bf(hh[s2].y), h2 = f2bf(hh[s2].z), h3 = f2bf(hh[s2].w);
                    hw[2 * s2] = h0 | (h1 << 16); hw[2 * s2 + 1] = h2 | (h3 << 16);
                    lw[2 * s2] = pk2(hh[s2].x - bf2f(h0), hh[s2].y - bf2f(h1)); lw[2 * s2 + 1] = pk2(hh[s2].z - bf2f(h2), hh[s2].w - bf2f(h3)); }
#if USE_FP8_MOE
                { const unsigned qa = pk4_fp8(hh[0].x * F8_HSCALE, hh[0].y * F8_HSCALE, hh[0].z * F8_HSCALE, hh[0].w * F8_HSCALE), qb2 = pk4_fp8(hh[1].x * F8_HSCALE, hh[1].y * F8_HSCALE, hh[1].z * F8_HSCALE, hh[1].w * F8_HSCALE);
                  if (kk & 1) { u32x4 q16; q16.x = q8keep[t].x; q16.y = q8keep[t].y; q16.z = qa; q16.w = qb2; *(u32x4*)((unsigned char*)HF + (size_t)(m0 + 16 * t + r) * D + cb + KOFF(kk - 1)) = q16; }
                  else { q8keep[t].x = qa; q8keep[t].y = qb2; } }
#if SHARED_BF16
                *(u32x4*)(HFB + (size_t)(m0 + 16 * t + r) * D + cb + KOFF(kk)) = hw;
#endif
#else
                *(u32x4*)(HF + (size_t)(m0 + 16 * t + r) * D + cb + KOFF(kk)) = hw;
#endif
                ah[t] = __builtin_bit_cast(bf16x8, hw); al[t] = __builtin_bit_cast(bf16x8, lw); }
#pragma unroll
            for (int nt = 0; nt < 4; ++nt) { const bf16x8 bh = *(const bf16x8*)(wf + ((kk * 4 + nt) * 2) * 512), bl = *(const bf16x8*)(wf + ((kk * 4 + nt) * 2 + 1) * 512);
#pragma unroll
                for (int t = 0; t < RT; ++t) {
                    acc[t][nt] = __builtin_amdgcn_mfma_f32_16x16x32_bf16(ah[t], bh, acc[t][nt], 0, 0, 0);
                    acc[t][nt] = __builtin_amdgcn_mfma_f32_16x16x32_bf16(ah[t], bl, acc[t][nt], 0, 0, 0);
                    acc[t][nt] = __builtin_amdgcn_mfma_f32_16x16x32_bf16(al[t], bh, acc[t][nt], 0, 0, 0); } }
            if (kk & 1) asm volatile("" ::: "memory");
        }
#pragma unroll
        for (int t = 0; t < RT; ++t)
#pragma unroll
            for (int nt = 0; nt < 4; ++nt)
#pragma unroll
                for (int j = 0; j < 4; ++j) part[((t * 8 + w) * 16 + 4 * q + j) * 64 + 16 * nt + r] = acc[t][nt][j];
        __syncthreads();
#pragma unroll 1
        for (int rp = 0; rp < RT; ++rp) {
            float score[2], cur[2]; int rank[2];
#pragma unroll
            for (int x = 0; x < 2; ++x) { const int row = 2 * RT * w + 2 * rp + x; float logit = 0.f;
#pragma unroll
                for (int w2 = 0; w2 < 8; ++w2) logit += part[(((row >> 4) * 8 + w2) * 16 + (row & 15)) * 64 + lane];
                score[x] = 1.f / (1.f + expf(-logit));
                const float sel = score[x] + rb;
                const float m1 = dpp_max8(sel);
                const unsigned long long eqm = __ballot(sel == m1);
                const unsigned grp_eq = (unsigned)((eqm >> (lane & ~7)) & 0xffull);
                const int first = __builtin_ctz(grp_eq);
                const float m2 = dpp_max8(((lane & 7) == first) ? -3e38f : sel);
                const float gs = m1 + m2;
                int grank = 0; const int mygrp = lane >> 3;
#pragma unroll
                for (int g2 = 0; g2 < 8; ++g2) { const float o = __int_as_float(__builtin_amdgcn_readlane(__float_as_int(gs), g2 * 8)); grank += (o > gs || (o == gs && g2 < mygrp)) ? 1 : 0; }
                cur[x] = (grank < 4) ? sel : -1e30f; rank[x] = 64; }
#pragma unroll
            for (int it = 0; it < TOPK; ++it)
#pragma unroll
                for (int x = 0; x < 2; ++x) { const float mx = wave_max_u(cur[x]); const int f = (int)__builtin_ctzll(__ballot(cur[x] == mx));
                    if (lane == f) { rank[x] = it; cur[x] = -3e38f; } }
#pragma unroll
            for (int x = 0; x < 2; ++x) { const int m = m0 + 2 * RT * w + 2 * rp + x; const bool chosen = rank[x] < TOPK;
                const float gsum = wave_sum_u(chosen ? score[x] : 0.f);
                if (chosen) { idx[(size_t)m * 8 + rank[x]] = lane | (int)(cnt << 8); gate[(size_t)m * 8 + rank[x]] = score[x] / gsum * 2.5f; cnt += 1u; } }
        }
        __syncthreads();
    }
    wcnt[(size_t)(blockIdx.x * 8 + w) * 64 + (threadIdx.x & 63)] = (int)cnt;
}
#undef KOFF
__device__ __forceinline__ void slot2_phase(const Ctx& c, const int* idx, const int* wcnt, unsigned* nrt_out, int* pos, int* slot_tok, int* tile_exp) {
    LAS int* ST = (LAS int*)c.lds;
    LAS int* SB = ST + 512;
    LAS int* SO = SB + 512;
    LAS int* tot = SO + 512;
    LAS int* bef = tot + 64;
    LAS int* ps = bef + 64;
    LAS int* base = ps + 128;
    const int e = c.tid & 63, p = c.tid >> 6, G = gridDim.x, blk = blockIdx.x;
    { int Tp = 0, Bp = 0;
#pragma unroll 8
      for (int b2 = 0; b2 < G; ++b2) { const int v = wcnt[(size_t)(b2 * 8 + p) * 64 + e]; Tp += v; Bp += (b2 < blk) ? v : 0; }
      ST[p * 64 + e] = Tp; SB[p * 64 + e] = Bp; SO[p * 64 + e] = wcnt[(size_t)(blk * 8 + p) * 64 + e]; }
    __syncthreads();
    if (c.tid < 64) { int t = 0, bb = 0;
#pragma unroll
        for (int p2 = 0; p2 < 8; ++p2) { t += ST[p2 * 64 + e]; bb += SB[p2 * 64 + e]; }
        tot[e] = t; bef[e] = bb; }
    __syncthreads();
    if (c.tid == 0) { int acc = 0; for (int e2 = 0; e2 < NE; ++e2) { ps[e2] = acc; acc += (tot[e2] + 255) / 256 * 256; } ps[64] = acc; }
    __syncthreads();
    { int o = ps[e] + bef[e];
      for (int p2 = 0; p2 < p; ++p2) o += SO[p2 * 64 + e];
      base[p * 64 + e] = o; }
    __syncthreads();
    {
        constexpr int RU = 16 * RT_ROUTER, NU = M / RU; const int per = (NU + G - 1) / G, mlo = blk * per * RU, mhi = (mlo + per * RU < M) ? mlo + per * RU : M;
        for (int i = c.tid; i < (mhi - mlo) * 8; i += 512) {
            const int m = mlo + (i >> 3), k = i & 7, wv = (m % RU) / (2 * RT_ROUTER); const size_t a = (size_t)m * 8 + k;
            const int code = idx[a], ee = code & 255, rk = code >> 8, slot = base[wv * 64 + ee] + rk;
            slot_tok[slot] = m; pos[a] = slot; }
    }
    for (int t = gtid_now(); t < M; t += c.gsz) slot_tok[CAPR + t] = t;
    if (blk == 0) {
        if (c.tid < NE) { const int s0 = ps[e], cn = tot[e], pe = s0 + (cn + 255) / 256 * 256;
            for (int s = s0 + cn; s < pe; ++s) slot_tok[s] = 0;
            for (int tt = s0 / 256; tt < pe / 256; ++tt) tile_exp[tt] = e; }
        if (c.tid == 0) *nrt_out = (unsigned)(ps[64] / 256);
    }
    __syncthreads();
}

template <int L> __device__ __forceinline__ void moe_up_tuned(const Ctx& c, unsigned char* ws) {
    const int nrt = (int)c.ctl[CW_NRT + L];
#if USE_FP8_MOE && SHARED_BF16
    { pg8::PlainSched S; S.o.init(M / 256, UPN / 256, gridDim.x, blockIdx.x); S.Bt = (const char*)(ws + WS_WUPS) + (size_t)L * UPN * D * 2; S.K = D;
      pg8::EpiUp E{(bf16*)(ws + WS_ACTS)}; pg8::gemm_phase(c.lds, (const char*)(ws + WS_HFB), D, S, E); }
    const int ntile = nrt;
#else
    const int ntile = nrt + M / 256;
#endif
    pg8::GroupSched<true> S; S.o.init(ntile, UPN / 256, gridDim.x, blockIdx.x);
    { LAS int* te = (LAS int*)(c.lds + 132096);
      for (int i = threadIdx.x; i < nrt; i += 512) te[i] = ((const int*)(ws + WS_TILEEXP))[i];
      __syncthreads(); S.tile_exp = te; }
    S.nrt = nrt; S.slot_tok = (const int*)(ws + WS_SLOTTOK);
#if USE_FP8_MOE
    S.W = (const char*)(ws + WS_WUP) + (size_t)L * NEX * UPN * D; S.wstride = (size_t)UPN * D; S.K = D / 2;
    pg8::EpiUp8 E{ws + WS_ACT}; pg8::gemm_phase<pg8::EpiUp8, pg8::GroupSched<true>, true>(c.lds, (const char*)(ws + WS_HF), D / 2, S, E);
#else
    S.W = (const char*)(ws + WS_WUP) + (size_t)L * NEX * UPN * D * 2; S.wstride = (size_t)UPN * D * 2; S.K = D;
    pg8::EpiUp E{(bf16*)(ws + WS_ACT)}; pg8::gemm_phase(c.lds, (const char*)(ws + WS_HF), D, S, E);
#endif
}
template <int L> __device__ __forceinline__ void moe_down_tuned(const Ctx& c, unsigned char* ws) {
    const int nrt = (int)c.ctl[CW_NRT + L];
#if USE_FP8_MOE && SHARED_BF16
    { pg8::PlainSched S; S.o.init(M / 256, D / 256, gridDim.x, blockIdx.x); S.Bt = (const char*)(ws + WS_WDNS) + (size_t)L * D * ED * 2; S.K = ED;
      pg8::EpiDown E{(bf16*)(ws + WS_Y), CAPR}; pg8::gemm_phase(c.lds, (const char*)(ws + WS_ACTS), ED, S, E); }
    const int ntile = nrt;
#else
    const int ntile = nrt + M / 256;
#endif
    pg8::GroupSched<false> S; S.o.init(ntile, D / 256, gridDim.x, blockIdx.x);
    { LAS int* te = (LAS int*)(c.lds + 132096);
      for (int i = threadIdx.x; i < nrt; i += 512) te[i] = ((const int*)(ws + WS_TILEEXP))[i];
      __syncthreads(); S.tile_exp = te; }
    S.nrt = nrt; S.slot_tok = (const int*)(ws + WS_SLOTTOK);
#if USE_FP8_MOE
    S.W = (const char*)(ws + WS_WDN) + (size_t)L * NEX * D * ED; S.wstride = (size_t)D * ED; S.K = ED / 2;
    pg8::EpiDown8 E{(bf16*)(ws + WS_Y)}; pg8::gemm_phase<pg8::EpiDown8, pg8::GroupSched<false>, true>(c.lds, (const char*)(ws + WS_ACT), ED / 2, S, E);
#else
    S.W = (const char*)(ws + WS_WDN) + (size_t)L * NEX * D * ED * 2; S.wstride = (size_t)D * ED * 2; S.K = ED;
    pg8::EpiDown E{(bf16*)(ws + WS_Y)}; pg8::gemm_phase(c.lds, (const char*)(ws + WS_ACT), ED, S, E);
#endif
}
template <int L> __device__ __forceinline__ void qkv_tuned(const Ctx& c, unsigned char* ws, const float* gains) {
    constexpr int NCOL = L == 0 ? AB_IN : C_IN; constexpr bool TUNED_ATT = L == 0 ? (USE_ATT0 != 0) : (USE_ATT1 != 0);
    pg8::PlainSched S; S.o.init(M / 256, NCOL / 256, gridDim.x, blockIdx.x); S.Bt = (const char*)(ws + (L == 0 ? WS_W0IN : WS_W1IN));
#if USE_FP8_QKV
    S.K = D / 2; pg8::EpiQKV<L> E{(bf16*)(ws + WS_QKV), NCOL, gains, TUNED_ATT ? att::C2 : 1.f, 1.f / (F8_HSCALE * F8_WSCALE)};
    pg8::gemm_phase<pg8::EpiQKV<L>, pg8::PlainSched, true>(c.lds, (const char*)(ws + WS_XN), D / 2, S, E);
#else
    S.K = D; pg8::EpiQKV<L> E{(bf16*)(ws + WS_QKV), NCOL, gains, TUNED_ATT ? att::C2 : 1.f, 1.f};
    pg8::gemm_phase(c.lds, (const char*)(ws + WS_XN), D, S, E);
#endif
}

template <int L> __device__ __forceinline__ void outproj_epi(const Ctx& c, unsigned char* ws, const pg8::PlainSched& S, const float* xin_f32, const float* gm) {
#if RES_BF16
    if (L == 0) { pg8::EpiOutB<false> E{xin_f32, gm, (bf16*)(ws + WS_X1)}; pg8::gemm_phase(c.lds, (const char*)(ws + WS_O), D, S, E); }
    else { pg8::EpiOutB<true> E{ws + WS_X1 + (size_t)M * D * 2, gm, (bf16*)(ws + WS_X1)}; pg8::gemm_phase(c.lds, (const char*)(ws + WS_O), D, S, E); }
#else
    pg8::EpiOut E{xin_f32, gm, (float*)(ws + WS_X1)}; pg8::gemm_phase(c.lds, (const char*)(ws + WS_O), D, S, E);
#endif
}
__global__ void __launch_bounds__(512, 2) mega(Args args) {
    extern __shared__ __attribute__((aligned(16))) unsigned char lds_raw[];
    Ctx c;
    c.lds = (LAS unsigned char*)lds_raw;
    c.tid = threadIdx.x; c.lane = c.tid & 63; c.wave = __builtin_amdgcn_readfirstlane(c.tid >> 6);
    c.gw = blockIdx.x * 8 + c.wave; c.ngw = gridDim.x * 8; c.gsz = gridDim.x * 512;
    c.ws = args.ws; c.ctl = (unsigned*)(args.ws + WS_CTL);
    volatile LAS unsigned* xbw = (volatile LAS unsigned*)(c.lds + LDS_BYTES - 16);
    if (c.tid < 4) xbw[c.tid] = 0u;
    __syncthreads();
    const int lo = args.ph_lo, hi = args.ph_hi;
    XcdBarrier bar; bar.bar = c.ctl + CW_BAR; bar.x = 0; bar.st = xbw;
    if (hi - lo > 1) bar = xcd_barrier_post(c.ctl + CW_BAR, xbw);
#ifdef PHASE_ONLY
#define IN(k) ((k) == PHASE_ONLY && lo <= (k) && (k) < hi)
#else
#define IN(k) (lo <= (k) && (k) < hi)
#endif
#define PHASE(k, ...) do { if (IN(k)) { __VA_ARGS__ } if (IN(k) && ((REPMASK >> (k)) & 1u)) { __syncthreads(); __VA_ARGS__ } } while (0);
#if PROBE_SEL >= 0
    volatile LAS unsigned long long* stamp_ = (volatile LAS unsigned long long*)(c.lds + 146000);
    if (c.tid == 0) stamp_[0] = __builtin_amdgcn_s_memrealtime();
#define SEAM(k) do { if (c.tid == 0) stamp_[1 + 2 * (k)] = __builtin_amdgcn_s_memrealtime(); if (IN(k) && IN((k) + 1)) xcd_barrier(bar); else __syncthreads(); \
        if (c.tid == 0) stamp_[2 + 2 * (k)] = __builtin_amdgcn_s_memrealtime(); } while (0)
#else
#define SEAM(k) do { if (IN(k) && IN((k) + 1)) xcd_barrier(bar); else __syncthreads(); } while (0)
#endif
    unsigned char* ws = args.ws;
#define XIN (args.in[0])
#define cin (args.in[1])
#define norm_mix (args.in[2])
#define norm_ffn (args.in[3])
#define w_ada (args.in[4])
#define b_ada (args.in[5])
#define ada ((float*)(ws + WS_ADA))
#define W0IN ((bf16*)(ws + WS_W0IN))
#define W0OUT ((bf16*)(ws + WS_W0OUT))
#define W1IN ((bf16*)(ws + WS_W1IN))
#define W1OUT ((bf16*)(ws + WS_W1OUT))
#define WUP ((bf16*)(ws + WS_WUP))
#define WDN ((bf16*)(ws + WS_WDN))
#define XN ((bf16*)(ws + WS_XN))
#define QKV ((bf16*)(ws + WS_QKV))
#define OBUF ((bf16*)(ws + WS_O))
#define X1 ((float*)(ws + WS_X1))
#define HF ((bf16*)(ws + WS_HF))
#define IDX ((int*)(ws + WS_IDX))
#define GATE ((float*)(ws + WS_GATE))
#define POS ((int*)(ws + WS_POS))
#define SLOTTOK ((int*)(ws + WS_SLOTTOK))
#define TILEEXP ((int*)(ws + WS_TILEEXP))
#define ACT ((bf16*)(ws + WS_ACT))
#define Y ((bf16*)(ws + WS_Y))
#define TMP ((float*)(ws + WS_TMP))
#define OUTP (args.out)

    PHASE(0, {
        constexpr int QM = USE_PG8_QKV ? 1 : 0, UM = USE_PG8_MOE ? 2 : 0;
#if USE_CONV128 && USE_FP8_MOE
        convert_dense_all<QM, USE_FP8_QKV != 0>(c, args.in[6], args.in[10], args.in[9], args.in[14], (unsigned char*)W0IN, (unsigned char*)W1IN, (unsigned char*)W0OUT, (unsigned char*)W1OUT, USE_FP8_QKV ? F8_WSCALE : 1.f);
#if !(DEFER_CONV && USE_ATT0 && USE_ATT1 && !SHARED_BF16)
        for (int l = 0; l < 2; ++l) {
            convert_batch128<2, true>(c, args.in[17] + (size_t)l * NE * D * UPN, D, UPN, (unsigned char*)WUP + (size_t)l * NEX * UPN * D, NE, (size_t)UPN * D, F8_WSCALE);
            convert_batch128<0, true>(c, args.in[18] + (size_t)l * NE * ED * D, ED, D, (unsigned char*)WDN + (size_t)l * NEX * D * ED, NE, (size_t)D * ED, F8_WSCALE);
#if SHARED_BF16
            convert_batch128<2, false>(c, args.in[19] + (size_t)l * D * UPN, D, UPN, ws + WS_WUPS + (size_t)l * UPN * D * 2, 1, 0, 1.f);
            convert_batch128<0, false>(c, args.in[20] + (size_t)l * ED * D, ED, D, ws + WS_WDNS + (size_t)l * D * ED * 2, 1, 0, 1.f);
#else
            convert_batch128<2, true>(c, args.in[19] + (size_t)l * D * UPN, D, UPN, (unsigned char*)WUP + ((size_t)l * NEX + NE) * UPN * D, 1, 0, F8_WSCALE);
            convert_batch128<0, true>(c, args.in[20] + (size_t)l * ED * D, ED, D, (unsigned char*)WDN + ((size_t)l * NEX + NE) * D * ED, 1, 0, F8_WSCALE);
#endif
        }
#endif
#else
        convert_batch<QM>(c, args.in[6], D, AB_IN, W0IN, 1, 0);
        convert_batch<0>(c, args.in[9], D, D, W0OUT, 1, 0);
        convert_batch<QM>(c, args.in[10], D, C_IN, W1IN, 1, 0);
        convert_batch<0>(c, args.in[14], D, D, W1OUT, 1, 0);
        for (int l = 0; l < 2; ++l) {
#if USE_FP8_MOE
            convert_batch_f8<2>(c, args.in[17] + (size_t)l * NE * D * UPN, D, UPN, (unsigned char*)WUP + (size_t)l * NEX * UPN * D, NE, (size_t)UPN * D);
            convert_batch_f8<2>(c, args.in[19] + (size_t)l * D * UPN, D, UPN, (unsigned char*)WUP + ((size_t)l * NEX + NE) * UPN * D, 1, 0);
            convert_batch_f8<0>(c, args.in[18] + (size_t)l * NE * ED * D, ED, D, (unsigned char*)WDN + (size_t)l * NEX * D * ED, NE, (size_t)D * ED);
            convert_batch_f8<0>(c, args.in[20] + (size_t)l * ED * D, ED, D, (unsigned char*)WDN + ((size_t)l * NEX + NE) * D * ED, 1, 0);
#else
            convert_batch<UM>(c, args.in[17] + (size_t)l * NE * D * UPN, D, UPN, WUP + (size_t)l * NEX * UPN * D, NE, (size_t)UPN * D);
            convert_batch<UM>(c, args.in[19] + (size_t)l * D * UPN, D, UPN, WUP + ((size_t)l * NEX + NE) * UPN * D, 1, 0);
            convert_batch<0>(c, args.in[18] + (size_t)l * NE * ED * D, ED, D, WDN + (size_t)l * NEX * D * ED, NE, (size_t)D * ED);
            convert_batch<0>(c, args.in[20] + (size_t)l * ED * D, ED, D, WDN + ((size_t)l * NEX + NE) * D * ED, 1, 0);
#endif
        }
#endif
        convert_router(c, args.in[15], (bf16*)(ws + WS_WRT));
        __syncthreads();
        ada_phase(c, cin, w_ada, b_ada, ada);
    })
    SEAM(0);
    PHASE(1, norm_phase(c, XIN, norm_mix, ada, 0, D, XN);)
    SEAM(1);
#if USE_PG8_QKV
    PHASE(2, qkv_tuned<0>(c, ws, args.in[7]);)
    SEAM(2);
#else
    PHASE(2, gemm_plain_bf16(c, XN, W0IN, D, AB_IN, QKV);)
    SEAM(2);
#endif
#if USE_ATT0
    static_assert(USE_PG8_QKV, "the tuned attention needs Q pre-scaled by the QKV epilogue");
    #if DEFER_CONV
    PHASE(3, { const int xs_ = vcu_of(blockIdx.x, gridDim.x) & 15;
        attn0_tuned_phase(c, QKV, args.in[8], (bf16*)(ws + WS_TMP), (float*)(ws + WS_TMP + (size_t)3 * M * 1024 * 2), OBUF, 0, xs_ + 1);
        { const int cshare = (EXP_ITEMS + (int)gridDim.x - 1) / (int)gridDim.x, cfirst = blockIdx.x * cshare, ccount = (cfirst + cshare <= EXP_ITEMS) ? cshare : (EXP_ITEMS > cfirst ? EXP_ITEMS - cfirst : 0);
          expert_items_block(c, ExpertSrc{args.in[17], args.in[19], args.in[18], args.in[20]}, 0, ws, cfirst, ccount); __syncthreads(); }
        attn0_tuned_phase(c, QKV, args.in[8], (bf16*)(ws + WS_TMP), (float*)(ws + WS_TMP + (size_t)3 * M * 1024 * 2), OBUF, xs_ + 1, 16); })
#else
    PHASE(3, attn0_tuned_phase(c, QKV, args.in[8], (bf16*)(ws + WS_TMP), (float*)(ws + WS_TMP + (size_t)3 * M * 1024 * 2), OBUF, 0, 16);)
#endif
    SEAM(3);
    PHASE(4, attn0_merge_phase(c, (const bf16*)(ws + WS_TMP), (const float*)(ws + WS_TMP + (size_t)3 * M * 1024 * 2), OBUF);)
    SEAM(4);
#else
#if !USE_PG8_QKV
    PHASE(3, qknorm0_phase(c, QKV, args.in[7]);)
#endif
    SEAM(3);
    PHASE(4, attn0_phase(c, QKV, args.in[8], OBUF);)
    SEAM(4);
#endif
#if USE_PG8_OUT
    PHASE(5, { pg8::PlainSched S; S.o.init(M / 256, D / 256, gridDim.x, blockIdx.x); S.Bt = (const char*)W0OUT; S.K = D;
        outproj_epi<0>(c, ws, S, XIN, ada + 2 * D); })
#else
    PHASE(5, gemm_outproj(c, OBUF, W0OUT, XIN, ada + 2 * D, X1);)
#endif
    SEAM(5);
#if USE_ROUTER2
    PHASE(6, router2_phase(c, X1, norm_ffn, ada, (const bf16*)(ws + WS_WRT), args.in[16], HF, IDX, GATE, (int*)(ws + WS_WCNT), (bf16*)(ws + WS_HFB));)
    SEAM(6);
    PHASE(7, slot2_phase(c, IDX, (const int*)(ws + WS_WCNT), c.ctl + CW_NRT, POS, SLOTTOK, TILEEXP);)
#else
    PHASE(6, router_phase(c, X1, norm_ffn, ada, args.in[15], args.in[16], HF, IDX, GATE, c.ctl + CW_CNT);)
    SEAM(6);
    PHASE(7, slot_phase(c, IDX, c.ctl + CW_CNT, c.ctl + CW_CUR, c.ctl + CW_NRT, POS, SLOTTOK, TILEEXP);)
#endif
    SEAM(7);
#if USE_PG8_MOE
    PHASE(8, moe_up_tuned<0>(c, ws);)
    SEAM(8);
    PHASE(9, moe_down_tuned<0>(c, ws);)
#else
    PHASE(8, moe_up_phase(c, HF, WUP, SLOTTOK, TILEEXP, c.ctl + CW_NRT, ACT);)
    SEAM(8);
    PHASE(9, moe_down_phase(c, ACT, WDN, TILEEXP, c.ctl + CW_NRT, Y);)
#endif
    SEAM(9);
    PHASE(10, combine_phase<true>(c, X1, Y, POS, GATE, ada, RES_BF16 ? (float*)(ws + WS_X1 + (size_t)M * D * 2) : OUTP, norm_mix + D, ada + (size_t)4 * 6 * D, XN);)
    SEAM(10);
#define ada1 (ada + (size_t)4 * 6 * D)
#if USE_PG8_QKV
    PHASE(11, qkv_tuned<1>(c, ws, args.in[11]);)
    SEAM(11);
    SEAM(12);
#else
    PHASE(11, gemm_plain_bf16(c, XN, W1IN, D, C_IN, QKV);)
    SEAM(11);
    PHASE(12, qknorm1_phase(c, QKV, args.in[11]);)
    SEAM(12);
#endif
#if USE_ATT1
    PHASE(13, attn1_tuned_phase(c, QKV, args.in[11], (bf16*)TMP, c.ctl + CW_QCTR, ExpertSrc{args.in[17], args.in[19], args.in[18], args.in[20]}, ws, args.in[12], args.in[13], OBUF);)
    SEAM(13);
#if !FUSE_FINISH
    PHASE(14, attn1_finish_bf16_phase(c, (const bf16*)TMP, args.in[12], args.in[13], OBUF);)
#endif
    SEAM(14);
#else
    PHASE(13, attn1_phase(c, QKV, TMP);)
    SEAM(13);
    PHASE(14, attn1_finish_phase(c, TMP, args.in[12], args.in[13], OBUF);)
    SEAM(14);
#endif
#if USE_PG8_OUT
    PHASE(15, { pg8::PlainSched S; S.o.init(M / 256, D / 256, gridDim.x, blockIdx.x); S.Bt = (const char*)W1OUT; S.K = D;
        outproj_epi<1>(c, ws, S, OUTP, ada1 + 2 * D); })
#else
    PHASE(15, gemm_outproj(c, OBUF, W1OUT, OUTP, ada1 + 2 * D, X1);)
#endif
    SEAM(15);
#if USE_ROUTER2
    PHASE(16, router2_phase(c, X1, norm_ffn + D, ada1, (const bf16*)(ws + WS_WRT) + (size_t)2 * NE * D, args.in[16] + NE, HF, IDX, GATE, (int*)(ws + WS_WCNT), (bf16*)(ws + WS_HFB));)
    SEAM(16);
    PHASE(17, slot2_phase(c, IDX, (const int*)(ws + WS_WCNT), c.ctl + CW_NRT + 1, POS, SLOTTOK, TILEEXP);)
#else
    PHASE(16, router_phase(c, X1, norm_ffn + D, ada1, args.in[15] + (size_t)D * NE, args.in[16] + NE, HF, IDX, GATE, c.ctl + CW_CNT + 64);)
    SEAM(16);
    PHASE(17, slot_phase(c, IDX, c.ctl + CW_CNT + 64, c.ctl + CW_CUR + 64, c.ctl + CW_NRT + 1, POS, SLOTTOK, TILEEXP);)
#endif
    SEAM(17);
#if USE_PG8_MOE
    PHASE(18, moe_up_tuned<1>(c, ws);)
    SEAM(18);
    PHASE(19, moe_down_tuned<1>(c, ws);)
#else
    PHASE(18, moe_up_phase(c, HF, WUP + (size_t)NEX * UPN * D, SLOTTOK, TILEEXP, c.ctl + CW_NRT + 1, ACT);)
    SEAM(18);
    PHASE(19, moe_down_phase(c, ACT, WDN + (size_t)NEX * D * ED, TILEEXP, c.ctl + CW_NRT + 1, Y);)
#endif
    SEAM(19);
    PHASE(20, combine_phase<false>(c, X1, Y, POS, GATE, ada1, OUTP, nullptr, nullptr, nullptr);)
#if PROBE_SEL >= 0
    {
        __syncthreads();
        unsigned long long v = 0ull;
        if (c.tid == 0) {
            if (PROBE_SEL >= 100) { const int k = PROBE_SEL - 100; v = stamp_[2 + 2 * k] - (k == 0 ? stamp_[0] : stamp_[2 + 2 * (k - 1)]); }
            else if (PROBE_SEL == 1 || PROBE_SEL == 2) { for (int k = 0; k < NPHASE - 1; ++k) v += stamp_[2 + 2 * k] - stamp_[1 + 2 * k]; }
            else if (PROBE_SEL == 3) { v = stamp_[1 + 2 * 19] - stamp_[0]; }
        }
        if (PROBE_SEL == 2) {
            if (c.tid == 0) __hip_atomic_fetch_add((unsigned long long*)(c.ctl + CW_QCTR + 64), v, __ATOMIC_RELAXED, __HIP_MEMORY_SCOPE_AGENT);
            xcd_barrier(bar);
            if (c.tid == 0) v = __hip_atomic_load((unsigned long long*)(c.ctl + CW_QCTR + 64), __ATOMIC_RELAXED, __HIP_MEMORY_SCOPE_AGENT) / gridDim.x;
        }
        if (blockIdx.x == 0 && c.tid == 0) { const unsigned long long t0 = __builtin_amdgcn_s_memrealtime(), w = v * PROBE_GAIN;
            while (__builtin_amdgcn_s_memrealtime() - t0 < w) __builtin_amdgcn_s_sleep(8); }
    }
#endif
#undef IN
#undef SEAM
#undef ada
#undef ada1
#undef W0IN
#undef W0OUT
#undef W1IN
#undef W1OUT
#undef WUP
#undef WDN
#undef XN
#undef QKV
#undef OBUF
#undef X1
#undef HF
#undef IDX
#undef GATE
#undef POS
#undef SLOTTOK
#undef TILEEXP
#undef ACT
#undef Y
#undef TMP
#undef XIN
#undef cin
#undef norm_mix
#undef norm_ffn
#undef w_ada
#undef b_ada
#undef OUTP
}

extern "C" void kernel_launch(void* const* d_in, const int* in_sizes, int n_in, void* d_out, int out_size, void* d_ws, size_t ws_size, hipStream_t stream) {
    static int grid = 0;
    if (grid == 0) {
        if (n_in != 21 || out_size != M * D || ws_size < WS_END) { fprintf(stderr, "kernel_launch: unexpected sizes (n_in %d out %d ws %zu need %zu)\n", n_in, out_size, ws_size, (size_t)WS_END); grid = -1; return; }
        int dev = 0, cus = 0, per_cu = 0;
        hipGetDevice(&dev); hipDeviceGetAttribute(&cus, hipDeviceAttributeMultiprocessorCount, dev);
        if (hipFuncSetAttribute((const void*)mega, hipFuncAttributeMaxDynamicSharedMemorySize, LDS_BYTES) != hipSuccess) { fprintf(stderr, "kernel_launch: hipFuncSetAttribute failed\n"); grid = -1; return; }
        hipOccupancyMaxActiveBlocksPerMultiprocessor(&per_cu, (const void*)mega, 512, LDS_BYTES);
        (void)hipGetLastError();
        if (per_cu < 1) fprintf(stderr, "kernel_launch: occupancy query says %d blocks per CU\n", per_cu);
        grid = cus;
    }
    if (grid < 0) return;
    hipMemsetAsync((char*)d_ws + WS_CTL, 0, CTL_BYTES, stream);
    Args a{};
    for (int i = 0; i < 21; ++i) a.in[i] = (const float*)d_in[i];
    a.out = (float*)d_out; a.ws = (unsigned char*)d_ws;
#if MK_SPLIT
    for (int p = 0; p < NPHASE; ++p) { a.ph_lo = p; a.ph_hi = p + 1; hipLaunchKernelGGL(mega, dim3(grid), dim3(512), LDS_BYTES, stream, a); }
#else
    a.ph_lo = 0; a.ph_hi = NPHASE; hipLaunchKernelGGL(mega, dim3(grid), dim3(512), LDS_BYTES, stream, a);
#endif
}
```

```cpp
#include <hip/hip_runtime.h>
#include <cstdio>
#include <cstdint>
#include <hip/hip_bf16.h>

#ifndef USE_PG8_OUT
#define USE_PG8_OUT 1
#endif
#ifndef USE_PG8_QKV
#define USE_PG8_QKV 1
#endif
#ifndef USE_PG8_MOE
#define USE_PG8_MOE 1
#endif
#ifndef USE_ATT1
#define USE_ATT1 1
#endif
#ifndef USE_ATT0
#define USE_ATT0 1
#endif
#ifndef USE_ROUTER2
#define USE_ROUTER2 1
#endif
#ifndef REPMASK
#define REPMASK 0u
#endif
#ifndef USE_FP8_MOE
#define USE_FP8_MOE 1
#endif
#ifndef USE_CONV128
#define USE_CONV128 1
#endif
#ifndef USE_FP8_QKV
#define USE_FP8_QKV 1
#endif
#ifndef SHARED_BF16
#define SHARED_BF16 0
#endif
#ifndef Y_FP8
#define Y_FP8 1
#endif
#ifndef DEFER_CONV
#define DEFER_CONV 1
#endif
#ifndef RES_BF16
#define RES_BF16 1
#endif
#ifndef FUSE_FINISH
#define FUSE_FINISH 1
#endif
#ifndef PROBE_SEL
#define PROBE_SEL -1
#endif
#ifndef PROBE_GAIN
#define PROBE_GAIN 4
#endif
#ifndef QKV_HEADMAJOR
#define QKV_HEADMAJOR 1
#endif
#ifndef USE_V128
#define USE_V128 1
#endif
#ifndef MK_SPLIT
#define MK_SPLIT 0
#endif

constexpr int D = 2048, NB = 4, T = 4096, M = NB * T;
constexpr int HD = 64;
constexpr int AB_IN = 4352, C_IN = 6144;
constexpr int NE = 64, TOPK = 8, ED = 512;
constexpr int UPN = 2 * ED;
constexpr int NEX = NE + 1;
constexpr int CAPR = M * TOPK + NE * 256;
constexpr int CAP = CAPR + M;
constexpr int MAXTILES = CAP / 256;
constexpr float RMS_EPS = 1e-6f;
constexpr int NPHASE = 21;

typedef unsigned short bf16;
typedef short bf16x8 __attribute__((ext_vector_type(8)));
typedef float f32x4 __attribute__((ext_vector_type(4)));
typedef unsigned u32x4 __attribute__((ext_vector_type(4)));
typedef unsigned u32x2 __attribute__((ext_vector_type(2)));
#define LAS __attribute__((address_space(3)))

constexpr size_t MiB = 1u << 20;
constexpr size_t WS_CTL = 0, CTL_BYTES = 1 * MiB;
constexpr size_t WS_ADA = 1 * MiB;
constexpr size_t WS_W0IN = 2 * MiB;
constexpr size_t WS_W0OUT = WS_W0IN + (size_t)AB_IN * D * 2;
constexpr size_t WS_W1IN = WS_W0OUT + (size_t)D * D * 2;
constexpr size_t WS_W1OUT = WS_W1IN + (size_t)C_IN * D * 2;
constexpr size_t WS_WUP = WS_W1OUT + (size_t)D * D * 2;
constexpr size_t WS_WDN = WS_WUP + (size_t)2 * NEX * UPN * D * 2;
constexpr size_t WS_XN = WS_WDN + (size_t)2 * NEX * D * ED * 2;
constexpr size_t WS_QKV = WS_XN + (size_t)M * D * 2;
constexpr size_t WS_O = WS_QKV + (size_t)M * C_IN * 2;
constexpr size_t WS_X1 = WS_O + (size_t)M * D * 2;
constexpr size_t WS_HF = WS_X1 + (size_t)M * D * 4;
constexpr size_t WS_IDX = WS_HF + (size_t)M * D * 2;
constexpr size_t WS_GATE = WS_IDX + (size_t)M * 8 * 4;
constexpr size_t WS_POS = WS_GATE + (size_t)M * 8 * 4;
constexpr size_t WS_SLOTTOK = WS_POS + (size_t)M * 8 * 4;
constexpr size_t WS_TILEEXP = WS_SLOTTOK + (size_t)CAP * 4;
constexpr size_t WS_ACT = WS_TILEEXP + 4096;
constexpr size_t WS_Y = WS_ACT + (size_t)CAP * ED * 2;
constexpr size_t WS_TMP = WS_Y + (size_t)CAP * D * 2;
constexpr size_t WS_WRT = WS_TMP + (size_t)M * 16 * 2 * 128 * 4;
constexpr size_t WS_WCNT = WS_WRT + (size_t)2 * 2 * NE * D * 2;
constexpr size_t WS_HFB = WS_WCNT + (size_t)4096 * 64 * 4;
constexpr size_t WS_ACTS = WS_HFB + (size_t)M * D * 2;
constexpr size_t WS_WUPS = WS_ACTS + (size_t)M * ED * 2;
constexpr size_t WS_WDNS = WS_WUPS + (size_t)2 * UPN * D * 2;
constexpr size_t WS_END = WS_WDNS + (size_t)2 * D * ED * 2;
constexpr int CW_BAR = 4096;
constexpr int CW_CNT = 16384;
constexpr int CW_CUR = 16384 + 256;
constexpr int CW_NRT = 16384 + 512;
constexpr int CW_QCTR = 16384 + 1024;

constexpr int LDS_BYTES = 147456;

__device__ __forceinline__ unsigned pk4_fp8(float a, float b, float c2, float d);
constexpr float F8_WSCALE = 256.f, F8_HSCALE = 16.f, F8_ASCALE = 8.f, F8_YSCALE = 32.f;
__device__ __forceinline__ float bf2f(unsigned v) { return __uint_as_float(v << 16); }
__device__ __forceinline__ unsigned f2bf(float f) { unsigned u = __float_as_uint(f); return (u + 0x7fffu + ((u >> 16) & 1u)) >> 16; }
__device__ __forceinline__ unsigned pk2(float lo, float hi) { return f2bf(lo) | (f2bf(hi) << 16); }
__device__ __forceinline__ float wave_sum(float v) {
#pragma unroll
    for (int o = 1; o < 64; o <<= 1) v += __shfl_xor(v, o);
    return v;
}
__device__ __forceinline__ float siluf(float x) { return x / (1.f + __expf(-x)); }

#define XB_TMO      128
#define XB_XCNT(j)  (256  + 64 * (j))
#define XB_XSUB(j)  (1280 + 64 * (j))
#define XB_XGEN(j)  (2304 + 64 * (j))
#define XB_TOP      3328
#define XB_TOPGEN   3392
#define XCD_BAR_WORDS 3456
#define XB_SPIN_CAP (1u << 22)
__device__ __forceinline__ unsigned xb_ld(unsigned* p)              { return __hip_atomic_load(p, __ATOMIC_RELAXED, __HIP_MEMORY_SCOPE_AGENT); }
__device__ __forceinline__ unsigned xb_add(unsigned* p, unsigned v) { return __hip_atomic_fetch_add(p, v, __ATOMIC_RELAXED, __HIP_MEMORY_SCOPE_AGENT); }
__device__ __forceinline__ unsigned xb_xcc_id() { return (unsigned)__builtin_amdgcn_s_getreg((3 << 11) | 20) & 0xFu; }
#define XB_SPIN(cond, bar) do { unsigned _sp = 0; while (cond) { __builtin_amdgcn_s_sleep(1); \
    if ((++_sp & 255u) == 0u) { if (xb_ld(&(bar)[XB_TMO])) break; if (_sp > XB_SPIN_CAP) { atomicAdd(&(bar)[XB_TMO], 1u); break; } } } } while (0)
struct XcdBarrier { unsigned* bar; unsigned x; volatile LAS unsigned* st; };
__device__ __forceinline__ XcdBarrier xcd_barrier_post(unsigned* bar, volatile LAS unsigned* st) {
    XcdBarrier b; b.bar = bar; b.x = xb_xcc_id(); b.st = st;
    if (threadIdx.x == 0) (void)xb_add(&bar[XB_XCNT(b.x)], 1u);
    return b;
}
__device__ __forceinline__ void xcd_barrier_complete(unsigned* bar, unsigned x, unsigned& nloc, unsigned& nx) {
    const unsigned G = gridDim.x * gridDim.y * gridDim.z;
    unsigned sum, cnt, mine, sp = 0u;
    for (;;) {
        sum = 0u; cnt = 0u; mine = 0u;
#pragma unroll
        for (unsigned j = 0; j < 16; ++j) { const unsigned c = xb_ld(&bar[XB_XCNT(j)]); sum += c; cnt += (c > 0u) ? 1u : 0u; mine = (j == x) ? c : mine; }
        if (sum == G) break;
        __builtin_amdgcn_s_sleep(1);
        if ((++sp & 255u) == 0u) { if (xb_ld(&bar[XB_TMO])) break; if (sp > XB_SPIN_CAP) { atomicAdd(&bar[XB_TMO], 1u); break; } }
    }
    nloc = mine > 0u ? mine : 1u; nx = cnt > 0u ? cnt : 1u;
}
__device__ __forceinline__ void xcd_barrier(const XcdBarrier& b) {
    asm volatile("s_waitcnt vmcnt(0)" ::: "memory");
    __syncthreads();
    if (threadIdx.x == 0) {
        unsigned* bar = b.bar;
        __builtin_amdgcn_s_waitcnt(0);
        unsigned nloc = b.st[0], nx = b.st[1];
        if (nloc == 0u) { xcd_barrier_complete(bar, b.x, nloc, nx); b.st[0] = nloc; b.st[1] = nx; }
        const unsigned old = xb_add(&bar[XB_XSUB(b.x)], 1u);
        const unsigned gen = old / nloc;
        if (old + 1u == (gen + 1u) * nloc) {
            __builtin_amdgcn_fence(__ATOMIC_RELEASE, "agent");
            asm volatile("s_waitcnt vmcnt(0)" ::: "memory");
            const unsigned og = xb_add(&bar[XB_TOP], 1u);
            const unsigned tg = og / nx;
            if (og + 1u == (tg + 1u) * nx) xb_add(&bar[XB_TOPGEN], 1u);
            else XB_SPIN(xb_ld(&bar[XB_TOPGEN]) == tg, bar);
            __builtin_amdgcn_fence(__ATOMIC_ACQUIRE, "agent");
            xb_add(&bar[XB_XGEN(b.x)], 1u);
            asm volatile("s_waitcnt vmcnt(0)" ::: "memory");
        } else {
            XB_SPIN(xb_ld(&bar[XB_XGEN(b.x)]) == gen, bar);
            __builtin_amdgcn_fence(__ATOMIC_ACQUIRE, "agent");
            asm volatile("s_waitcnt vmcnt(0)" ::: "memory");
        }
    }
    __syncthreads();
}

struct Args {
    const float* in[21];
    float* out;
    unsigned char* ws;
    int ph_lo, ph_hi;
};

struct Ctx {
    int tid, lane, wave, gw, ngw, gsz;
    LAS unsigned char* lds;
    unsigned char* ws;
    unsigned* ctl;
};

__device__ __forceinline__ int gtid_now() { int t = (int)(blockIdx.x * 512u + threadIdx.x); asm volatile("" : "+v"(t)); return t; }
template <int MODE> __device__ __forceinline__ int perm_row(int n) {
    if (MODE == 1) { const int nl = n & 255; return (n & ~255) + 128 * ((nl >> 5) & 1) + 32 * (nl >> 6) + (nl & 31); }
    if (MODE == 2) { const int bj = n >> 9, rem = n & 511; return 256 * (rem >> 7) + 128 * bj + (rem & 127); }
    if (MODE == 3) { const int cl = n & 255; return (n & ~255) + 128 * ((cl >> 3) & 1) + 32 * (cl >> 6) + 8 * ((cl >> 4) & 3) + (cl & 7); }
    return n;
}
template <int MODE> __device__ __forceinline__ void transpose_item(const float* W, int K, int N, bf16* WT, LAS float* scr, int item, int lane) {
    const int nblk = N / 32, kb = item / nblk, nb = item % nblk, k0 = 64 * kb, n0 = 32 * nb, d0 = perm_row<MODE>(n0);
#pragma unroll 8
    for (int i = 0; i < 32; ++i) { const int kk = 2 * i + (lane >> 5); scr[kk * 33 + (lane & 31)] = W[(size_t)(k0 + kk) * N + n0 + (lane & 31)]; }
    asm volatile("s_waitcnt lgkmcnt(0)" ::: "memory");
    const int c = lane & 7;
#pragma unroll
    for (int j = 0; j < 4; ++j) { const int n = (lane >> 3) + 8 * j; const LAS float* s = scr + (8 * c) * 33 + n;
        u32x4 o; o.x = pk2(s[0 * 33], s[1 * 33]); o.y = pk2(s[2 * 33], s[3 * 33]); o.z = pk2(s[4 * 33], s[5 * 33]); o.w = pk2(s[6 * 33], s[7 * 33]);
        *(u32x4*)(WT + (size_t)(d0 + n) * K + k0 + 8 * c) = o; }
    asm volatile("s_waitcnt lgkmcnt(0)" ::: "memory");
}
template <int MODE> __device__ __forceinline__ void convert_batch(const Ctx& c, const float* src, int K, int N, bf16* dst, int nmat, size_t dst_stride) {
    LAS float* scr = (LAS float*)(c.lds + c.wave * 16384);
    const int per = (K / 64) * (N / 32); const long total = (long)per * nmat;
    for (long it = c.gw; it < total; it += c.ngw) {
        const int mat = (int)(it / per), item = (int)(it % per);
        transpose_item<MODE>(src + (size_t)mat * K * N, K, N, dst + (size_t)mat * dst_stride, scr, item, c.lane);
    }
}

__device__ __forceinline__ float clamp448(float v) { return __builtin_amdgcn_fmed3f(v, -448.f, 448.f); }
__device__ __forceinline__ unsigned pk4_fp8(float a, float b, float c2, float d) {
    unsigned w = 0u; w = __builtin_amdgcn_cvt_pk_fp8_f32(clamp448(a), clamp448(b), w, false); w = __builtin_amdgcn_cvt_pk_fp8_f32(clamp448(c2), clamp448(d), w, true); return w;
}
template <int MODE> __device__ __forceinline__ void transpose_item_f8(const float* W, int K, int N, unsigned char* WT, LAS float* scr, int item, int lane) {
    const int nblk = N / 32, kb = item / nblk, nb = item % nblk, k0 = 64 * kb, n0 = 32 * nb, d0 = perm_row<MODE>(n0);
#pragma unroll 8
    for (int i = 0; i < 32; ++i) { const int kk = 2 * i + (lane >> 5); scr[kk * 33 + (lane & 31)] = W[(size_t)(k0 + kk) * N + n0 + (lane & 31)]; }
    asm volatile("s_waitcnt lgkmcnt(0)" ::: "memory");
    const int n = lane & 31;
#pragma unroll
    for (int j = 0; j < 2; ++j) { const int ch = (lane >> 5) + 2 * j; const LAS float* s = scr + (16 * ch) * 33 + n; u32x4 o;
#pragma unroll
        for (int q = 0; q < 4; ++q) o[q] = pk4_fp8(s[(4 * q) * 33] * F8_WSCALE, s[(4 * q + 1) * 33] * F8_WSCALE, s[(4 * q + 2) * 33] * F8_WSCALE, s[(4 * q + 3) * 33] * F8_WSCALE);
        *(u32x4*)(WT + (size_t)(d0 + n) * K + k0 + 16 * ch) = o; }
    asm volatile("s_waitcnt lgkmcnt(0)" ::: "memory");
}
template <int MODE> __device__ __forceinline__ void convert_batch_f8(const Ctx& c, const float* src, int K, int N, unsigned char* dst, int nmat, size_t dst_stride) {
    LAS float* scr = (LAS float*)(c.lds + c.wave * 16384);
    const int per = (K / 64) * (N / 32); const long total = (long)per * nmat;
    for (long it = c.gw; it < total; it += c.ngw) {
        const int mat = (int)(it / per), item = (int)(it % per);
        transpose_item_f8<MODE>(src + (size_t)mat * K * N, K, N, dst + (size_t)mat * dst_stride, scr, item, c.lane);
    }
}

__device__ __forceinline__ void t128_load(f32x4 (&v)[16], const float* W, int N, int item, int lane) {
    const int nblk = N / 32, kb = item / nblk, nb = item % nblk, k0 = 128 * kb, n0 = 32 * nb;
    const int kr = lane >> 3, nq = lane & 7;
#pragma unroll
    for (int i = 0; i < 16; ++i) v[i] = *(const f32x4*)(W + (size_t)(k0 + 8 * i + kr) * N + n0 + 4 * nq);
}
template <int MODE, bool F8> __device__ __forceinline__ void t128_finish(const f32x4 (&v)[16], int K, int N, unsigned char* WT, LAS float* scr, int item, int lane, float scale) {
    const int nblk = N / 32, kb = item / nblk, nb = item % nblk, k0 = 128 * kb, n0 = 32 * nb, d0 = perm_row<MODE>(n0);
    const int kr = lane >> 3, nq = lane & 7;
#pragma unroll
    for (int i = 0; i < 16; ++i) { LAS float* s = scr + (8 * i + kr) * 33 + 4 * nq; s[0] = v[i].x; s[1] = v[i].y; s[2] = v[i].z; s[3] = v[i].w; }
    asm volatile("s_waitcnt lgkmcnt(0)" ::: "memory");
    const int n = lane & 31, half = lane >> 5; const LAS float* s0 = scr + (64 * half) * 33 + n;
    if (F8) {
        const int rs = lane >> 2, pc = lane & 3; (void)s0; (void)half;
#pragma unroll
        for (int it = 0; it < 4; ++it) { const int nn = rs + 16 * (it & 1), hs = it >> 1; const LAS float* s = scr + (64 * hs + 16 * pc) * 33 + nn; u32x4 o;
#pragma unroll
            for (int q = 0; q < 4; ++q) o[q] = pk4_fp8(s[(4 * q) * 33] * scale, s[(4 * q + 1) * 33] * scale, s[(4 * q + 2) * 33] * scale, s[(4 * q + 3) * 33] * scale);
            *(u32x4*)(WT + (size_t)(MODE == 3 ? perm_row<MODE>(n0 + nn) : d0 + nn) * K + k0 + 64 * hs + 16 * pc) = o; }
    } else {
        bf16* dst = (bf16*)WT + (size_t)(d0 + n) * K + k0 + 64 * half;
#pragma unroll
        for (int ch = 0; ch < 8; ++ch) { const LAS float* s = s0 + (8 * ch) * 33; u32x4 o;
#pragma unroll
            for (int q = 0; q < 4; ++q) o[q] = pk2(s[(2 * q) * 33], s[(2 * q + 1) * 33]);
            *(u32x4*)(dst + 8 * ch) = o; }
    }
    asm volatile("s_waitcnt lgkmcnt(0)" ::: "memory");
}
template <int MODE, bool F8> __device__ __forceinline__ void transpose_item128(const float* W, int K, int N, unsigned char* WT, LAS float* scr, int item, int lane, float scale) {
    asm volatile("" : "+v"(lane));
    f32x4 v[16];
    t128_load(v, W, N, item, lane);
    t128_finish<MODE, F8>(v, K, N, WT, scr, item, lane, scale);
}
template <int QM, bool F8Q> __device__ __forceinline__ void convert_dense_all(const Ctx& c, const float* w0in, const float* w1in, const float* w0out, const float* w1out,
                                                                              unsigned char* W0IN_, unsigned char* W1IN_, unsigned char* W0OUT_, unsigned char* W1OUT_, float sq) {
    constexpr int n0 = 16 * (AB_IN / 32), n1 = 16 * (C_IN / 32), n2 = 16 * (D / 32), TOT = n0 + n1 + 2 * n2;
    LAS float* scr = (LAS float*)(c.lds + c.wave * 16896);
    const int lane = c.lane, ngw = c.ngw;
#define DENSE_LOAD(v, it) do { if ((it) < n0) t128_load(v, w0in, AB_IN, (it), lane); else if ((it) < n0 + n1) t128_load(v, w1in, C_IN, (it) - n0, lane); \
        else if ((it) < n0 + n1 + n2) t128_load(v, w0out, D, (it) - n0 - n1, lane); else t128_load(v, w1out, D, (it) - n0 - n1 - n2, lane); } while (0)
#define DENSE_FIN(v, it) do { if ((it) < n0 + n1) { const bool f_ = (it) < n0; t128_finish<QM, F8Q>(v, D, f_ ? AB_IN : C_IN, f_ ? W0IN_ : W1IN_, scr, f_ ? (it) : (it) - n0, lane, sq); } \
        else { const bool f_ = (it) < n0 + n1 + n2; t128_finish<0, false>(v, D, D, f_ ? W0OUT_ : W1OUT_, scr, f_ ? (it) - n0 - n1 : (it) - n0 - n1 - n2, lane, 1.f); } } while (0)
    int it = c.gw;
    f32x4 va[16], vb[16];
    if (it < TOT) DENSE_LOAD(va, it);
    while (it < TOT) {
        const int it1 = it + ngw, it2 = it1 + ngw;
        if (it1 < TOT) DENSE_LOAD(vb, it1);
        DENSE_FIN(va, it);
        if (it2 < TOT) DENSE_LOAD(va, it2);
        if (it1 < TOT) DENSE_FIN(vb, it1);
        it = it2;
    }
#undef DENSE_LOAD
#undef DENSE_FIN
}
template <int MODE, bool F8> __device__ __forceinline__ void convert_batch128(const Ctx& c, const float* src, int K, int N, void* dst, int nmat, size_t dst_stride_bytes, float scale) {
    LAS float* scr = (LAS float*)(c.lds + c.wave * 16896);
    const int per = (K / 128) * (N / 32); const long total = (long)per * nmat;
    for (long it = c.gw; it < total; it += c.ngw) {
        const int mat = (int)(it / per), item = (int)(it % per);
        transpose_item128<MODE, F8>(src + (size_t)mat * K * N, K, N, (unsigned char*)dst + (size_t)mat * dst_stride_bytes, scr, item, c.lane, scale);
    }
}

struct ExpertSrc { const float* up; const float* sup; const float* dn; const float* sdn; };
constexpr int EXP_ITEMS_UP = NE * 512, EXP_ITEMS_SUP = 512, EXP_ITEMS_DN = NE * 256, EXP_ITEMS_SDN = 256, EXP_ITEMS = EXP_ITEMS_UP + EXP_ITEMS_SUP + EXP_ITEMS_DN + EXP_ITEMS_SDN;
__device__ __forceinline__ void expert_item(const ExpertSrc& s, int l, unsigned char* ws, LAS float* scr, int it, int lane) {
    unsigned char* wup = ws + WS_WUP + (size_t)l * NEX * UPN * D; unsigned char* wdn = ws + WS_WDN + (size_t)l * NEX * D * ED;
    if (it < EXP_ITEMS_UP) { const int mat = it >> 9; transpose_item128<2, true>(s.up + ((size_t)l * NE + mat) * D * UPN, D, UPN, wup + (size_t)mat * UPN * D, scr, it & 511, lane, F8_WSCALE); return; }
    it -= EXP_ITEMS_UP;
    if (it < EXP_ITEMS_SUP) { transpose_item128<2, true>(s.sup + (size_t)l * D * UPN, D, UPN, wup + (size_t)NE * UPN * D, scr, it, lane, F8_WSCALE); return; }
    it -= EXP_ITEMS_SUP;
    if (it < EXP_ITEMS_DN) { const int mat = it >> 8; transpose_item128<0, true>(s.dn + ((size_t)l * NE + mat) * ED * D, ED, D, wdn + (size_t)mat * D * ED, scr, it & 255, lane, F8_WSCALE); return; }
    it -= EXP_ITEMS_DN;
    transpose_item128<0, true>(s.sdn + (size_t)l * ED * D, ED, D, wdn + (size_t)NE * D * ED, scr, it, lane, F8_WSCALE);
}
struct ERef { const float* W; int N, item; };
__device__ __forceinline__ ERef expert_ref(const ExpertSrc& s, int l, int it) {
    if (it < EXP_ITEMS_UP) return ERef{s.up + ((size_t)l * NE + (it >> 9)) * D * UPN, UPN, it & 511};
    it -= EXP_ITEMS_UP;
    if (it < EXP_ITEMS_SUP) return ERef{s.sup + (size_t)l * D * UPN, UPN, it};
    it -= EXP_ITEMS_SUP;
    if (it < EXP_ITEMS_DN) return ERef{s.dn + ((size_t)l * NE + (it >> 8)) * ED * D, D, it & 255};
    it -= EXP_ITEMS_DN;
    return ERef{s.sdn + (size_t)l * ED * D, D, it};
}
__device__ __forceinline__ void expert_fin(const f32x4 (&v)[16], int l, unsigned char* ws, LAS float* scr, int it, int lane) {
    if (it < EXP_ITEMS_UP + EXP_ITEMS_SUP) { const bool r = it < EXP_ITEMS_UP; const int mat = r ? it >> 9 : NE, item = r ? it & 511 : it - EXP_ITEMS_UP;
        t128_finish<2, true>(v, D, UPN, ws + WS_WUP + ((size_t)l * NEX + mat) * UPN * D, scr, item, lane, F8_WSCALE); }
    else { it -= EXP_ITEMS_UP + EXP_ITEMS_SUP; const bool r = it < EXP_ITEMS_DN; const int mat = r ? it >> 8 : NE, item = r ? it & 255 : it - EXP_ITEMS_DN;
        t128_finish<Y_FP8 ? 3 : 0, true>(v, ED, D, ws + WS_WDN + ((size_t)l * NEX + mat) * D * ED, scr, item, lane, F8_WSCALE); }
}
__device__ __forceinline__ void expert_items_block(const Ctx& c, const ExpertSrc& s, int l, unsigned char* ws, int first, int count) {
    int tid = threadIdx.x; asm volatile("" : "+v"(tid));
    const int lane = tid & 63, wv = __builtin_amdgcn_readfirstlane(tid >> 6);
    LAS float* scr = (LAS float*)(c.lds + wv * 16896);
    f32x4 va[16], vb[16];
    int i = wv;
    if (i < count) { const ERef r = expert_ref(s, l, first + i); t128_load(va, r.W, r.N, r.item, lane); }
#pragma unroll 1
    while (i < count) {
        const int i1 = i + 8, i2 = i + 16;
        if (i1 < count) { const ERef r = expert_ref(s, l, first + i1); t128_load(vb, r.W, r.N, r.item, lane); }
        expert_fin(va, l, ws, scr, first + i, lane);
        if (i2 < count) { const ERef r = expert_ref(s, l, first + i2); t128_load(va, r.W, r.N, r.item, lane); }
        if (i1 < count) expert_fin(vb, l, ws, scr, first + i1, lane);
        i = i2;
    }
}
__device__ __forceinline__ void ada_phase(const Ctx& c, const float* cin, const float* w_ada, const float* b_ada, float* ada) {
    LAS float* red = (LAS float*)(c.lds);
    LAS float* sc = red + 1024;
    for (int i = c.tid; i < 4 * D; i += 512) sc[i] = siluf(cin[i]);
    __syncthreads();
    const int j = c.lane & 7, kr = c.lane >> 3;
    constexpr int NCG = 6 * D / 32;
    for (int u = blockIdx.x; u < 2 * NCG; u += gridDim.x) {
        const int l = u / NCG, cg = u % NCG;
        const int k0 = c.wave * 256 + kr;
        const float* w = w_ada + (size_t)l * D * 6 * D + (size_t)k0 * 6 * D + cg * 32 + 4 * j;
        f32x4 acc[4];
#pragma unroll
        for (int b = 0; b < 4; ++b) acc[b] = (f32x4){0.f, 0.f, 0.f, 0.f};
        f32x4 wv[32];
#pragma unroll
        for (int i = 0; i < 32; ++i) wv[i] = *(const f32x4*)(w + (size_t)(8 * i) * 6 * D);
#pragma unroll
        for (int i = 0; i < 32; ++i)
#pragma unroll
            for (int b = 0; b < 4; ++b) acc[b] += wv[i] * sc[b * D + k0 + 8 * i];
#pragma unroll
        for (int b = 0; b < 4; ++b)
#pragma unroll
            for (int q = 0; q < 4; ++q) { float t = acc[b][q]; t += __shfl_xor(t, 8); t += __shfl_xor(t, 16); t += __shfl_xor(t, 32); acc[b][q] = t; }
        if (kr == 0) {
#pragma unroll
            for (int b = 0; b < 4; ++b) *(LAS f32x4*)(red + (c.wave * 4 + b) * 32 + 4 * j) = acc[b]; }
        __syncthreads();
        if (c.tid < 128) {
            const int b = c.tid >> 5, cc = c.tid & 31; float s2 = b_ada[(size_t)l * 6 * D + cg * 32 + cc];
#pragma unroll
            for (int w8 = 0; w8 < 8; ++w8) s2 += red[(w8 * 4 + b) * 32 + cc];
            ada[((size_t)l * 4 + b) * 6 * D + cg * 32 + cc] = s2;
        }
        __syncthreads();
    }
}

__device__ __forceinline__ void load_row(const float* xrow, int lane, f32x4 (&v)[8]) {
#pragma unroll
    for (int j = 0; j < 8; ++j) v[j] = *(const f32x4*)(xrow + 4 * lane + 256 * j);
}
__device__ __forceinline__ float row_rstd(const f32x4 (&v)[8]) {
    float s = 0.f;
#pragma unroll
    for (int j = 0; j < 8; ++j) s += (v[j].x * v[j].x + v[j].y * v[j].y) + (v[j].z * v[j].z + v[j].w * v[j].w);
    return 1.f / sqrtf(wave_sum(s) * (1.f / D) + RMS_EPS);
}
__device__ __forceinline__ void modulate_row(f32x4 (&v)[8], float rstd, const float* g, const float* sh, const float* sc, int lane) {
#pragma unroll
    for (int j = 0; j < 8; ++j) { const int col = 4 * lane + 256 * j;
        const f32x4 gg = *(const f32x4*)(g + col), s1 = *(const f32x4*)(sc + col), s0 = *(const f32x4*)(sh + col);
        v[j] = v[j] * rstd * gg * (s1 + 1.f) + s0; }
}
__device__ __forceinline__ void store_row_bf16(bf16* orow, const f32x4 (&v)[8], int lane) {
#pragma unroll
    for (int j = 0; j < 8; ++j) { u32x2 w; w.x = pk2(v[j].x, v[j].y); w.y = pk2(v[j].z, v[j].w); *(u32x2*)(orow + 4 * lane + 256 * j) = w; }
}
__device__ __forceinline__ void store_row_fp8(unsigned char* orow, const f32x4 (&v)[8], int lane, float scale) {
#pragma unroll
    for (int j = 0; j < 8; ++j) *(unsigned*)(orow + 4 * lane + 256 * j) = pk4_fp8(v[j].x * scale, v[j].y * scale, v[j].z * scale, v[j].w * scale);
}
__device__ __forceinline__ void norm_phase(const Ctx& c, const float* x, const float* g, const float* ada_l  , int sh_off, int sc_off, bf16* out) {
    for (int m = c.gw; m < M; m += c.ngw) {
        const int b = m / T; f32x4 v[8]; load_row(x + (size_t)m * D, c.lane, v);
        const float rstd = row_rstd(v);
        modulate_row(v, rstd, g, ada_l + (size_t)b * 6 * D + sh_off, ada_l + (size_t)b * 6 * D + sc_off, c.lane);
#if USE_FP8_QKV
        store_row_fp8((unsigned char*)out + (size_t)m * D, v, c.lane, F8_HSCALE);
#else
        store_row_bf16(out + (size_t)m * D, v, c.lane);
#endif
    }
}

__device__ __forceinline__ void wave_gemm_32x64(const bf16* a0, const bf16* a1, const bf16* b, int K, int lane, f32x4 (&acc)[2][4]) {
    const int q8 = (lane >> 4) * 8;
    for (int k0 = 0; k0 < K; k0 += 32) {
        const bf16x8 fa0 = *(const bf16x8*)(a0 + k0 + q8), fa1 = *(const bf16x8*)(a1 + k0 + q8);
#pragma unroll
        for (int n = 0; n < 4; ++n) { const bf16x8 fb = *(const bf16x8*)(b + (size_t)n * 16 * K + k0 + q8);
            acc[0][n] = __builtin_amdgcn_mfma_f32_16x16x32_bf16(fa0, fb, acc[0][n], 0, 0, 0);
            acc[1][n] = __builtin_amdgcn_mfma_f32_16x16x32_bf16(fa1, fb, acc[1][n], 0, 0, 0); }
    }
}
#define ZERO_ACC(acc) do { _Pragma("unroll") for (int _a = 0; _a < 2; ++_a) _Pragma("unroll") for (int _b = 0; _b < 4; ++_b) acc[_a][_b] = (f32x4){0.f, 0.f, 0.f, 0.f}; } while (0)

__device__ __forceinline__ void gemm_plain_bf16(const Ctx& c, const bf16* A, const bf16* Bt, int K, int N, bf16* C) {
    const int ntn = N / 64, units = (M / 256) * ntn;
    for (int u = blockIdx.x; u < units; u += gridDim.x) {
        const int mt = u / ntn, nt = u % ntn, row0 = mt * 256 + c.wave * 32, n0 = nt * 64;
        f32x4 acc[2][4]; ZERO_ACC(acc);
        const int r = c.lane & 15;
        wave_gemm_32x64(A + (size_t)(row0 + r) * K, A + (size_t)(row0 + 16 + r) * K, Bt + (size_t)(n0 + r) * K, K, c.lane, acc);
#pragma unroll
        for (int mi = 0; mi < 2; ++mi)
#pragma unroll
            for (int n = 0; n < 4; ++n)
#pragma unroll
                for (int j = 0; j < 4; ++j) C[(size_t)(row0 + 16 * mi + 4 * (c.lane >> 4) + j) * N + n0 + 16 * n + r] = (bf16)f2bf(acc[mi][n][j]);
    }
}
__device__ __forceinline__ void gemm_outproj(const Ctx& c, const bf16* A, const bf16* Bt, const float* xin, const float* gm  , float* X1) {
    const int K = D, N = D, ntn = N / 64, units = (M / 256) * ntn;
    for (int u = blockIdx.x; u < units; u += gridDim.x) {
        const int mt = u / ntn, nt = u % ntn, row0 = mt * 256 + c.wave * 32, n0 = nt * 64;
        f32x4 acc[2][4]; ZERO_ACC(acc);
        const int r = c.lane & 15;
        wave_gemm_32x64(A + (size_t)(row0 + r) * K, A + (size_t)(row0 + 16 + r) * K, Bt + (size_t)(n0 + r) * K, K, c.lane, acc);
        const int b = row0 / T;
#pragma unroll
        for (int mi = 0; mi < 2; ++mi)
#pragma unroll
            for (int n = 0; n < 4; ++n)
#pragma unroll
                for (int j = 0; j < 4; ++j) { const size_t o = (size_t)(row0 + 16 * mi + 4 * (c.lane >> 4) + j) * N + n0 + 16 * n + r;
                    X1[o] = xin[o] + gm[(size_t)b * 6 * D + n0 + 16 * n + r] * acc[mi][n][j]; }
    }
}

__device__ __forceinline__ void qknorm_chunk(bf16* p, const float* g) {
    float v[64]; float ss = 0.f;
#pragma unroll
    for (int i = 0; i < 8; ++i) { const u32x4 w = *(const u32x4*)(p + 8 * i);
#pragma unroll
        for (int j = 0; j < 4; ++j) { v[8 * i + 2 * j] = bf2f(w[j] & 0xffffu); v[8 * i + 2 * j + 1] = bf2f(w[j] >> 16); } }
#pragma unroll
    for (int i = 0; i < 64; ++i) ss += v[i] * v[i];
    const float rs = 1.f / sqrtf(ss * (1.f / 64.f) + RMS_EPS);
#pragma unroll
    for (int i = 0; i < 8; ++i) { u32x4 w;
#pragma unroll
        for (int j = 0; j < 4; ++j) w[j] = pk2(v[8 * i + 2 * j] * rs * g[8 * i + 2 * j], v[8 * i + 2 * j + 1] * rs * g[8 * i + 2 * j + 1]);
        *(u32x4*)(p + 8 * i) = w; }
}
__device__ __forceinline__ void qknorm0_phase(const Ctx& c, bf16* qkv, const float* gains  ) {
    const long total = (long)M * 50;
    for (long id = gtid_now(); id < total; id += c.gsz) {
        const int m = (int)(id / 50), k = (int)(id % 50); int ch, gi;
        if (k < 16) { ch = k; gi = 0; } else if (k < 32) { ch = k; gi = 1; } else if (k < 48) { ch = k + 16; gi = 2; } else { ch = k + 16; gi = 3; }
        qknorm_chunk(qkv + (size_t)m * AB_IN + 64 * ch, gains + 64 * gi);
    }
}
__device__ __forceinline__ void qknorm1_phase(const Ctx& c, bf16* qkv, const float* gains  ) {
    const long total = (long)M * 64;
    for (long id = gtid_now(); id < total; id += c.gsz) {
        const int m = (int)(id / 64), ch = (int)(id % 64);
        qknorm_chunk(qkv + (size_t)m * C_IN + 64 * ch, gains + 64 * (ch >> 5));
    }
}

__device__ __forceinline__ void load64(const bf16* p, float (&v)[64], float scale) {
#pragma unroll
    for (int i = 0; i < 8; ++i) { const u32x4 w = *(const u32x4*)(p + 8 * i);
#pragma unroll
        for (int j = 0; j < 4; ++j) { v[8 * i + 2 * j] = bf2f(w[j] & 0xffffu) * scale; v[8 * i + 2 * j + 1] = bf2f(w[j] >> 16) * scale; } }
}
__device__ __forceinline__ float dot64(const float (&q)[64], const bf16* kp) {
    float s0 = 0.f, s1 = 0.f;
#pragma unroll
    for (int i = 0; i < 8; ++i) { const u32x4 w = *(const u32x4*)(kp + 8 * i);
#pragma unroll
        for (int j = 0; j < 4; ++j) { s0 += q[8 * i + 2 * j] * bf2f(w[j] & 0xffffu); s1 += q[8 * i + 2 * j + 1] * bf2f(w[j] >> 16); } }
    return s0 + s1;
}
__device__ __forceinline__ void axpy64(float (&o)[64], float a, float p, const bf16* vp) {
#pragma unroll
    for (int i = 0; i < 8; ++i) { const u32x4 w = *(const u32x4*)(vp + 8 * i);
#pragma unroll
        for (int j = 0; j < 4; ++j) { o[8 * i + 2 * j] = o[8 * i + 2 * j] * a + p * bf2f(w[j] & 0xffffu); o[8 * i + 2 * j + 1] = o[8 * i + 2 * j + 1] * a + p * bf2f(w[j] >> 16); } }
}
__device__ __forceinline__ void store64_bf16(bf16* p, const float (&o)[64], float s) {
#pragma unroll
    for (int i = 0; i < 8; ++i) { u32x4 w;
#pragma unroll
        for (int j = 0; j < 4; ++j) w[j] = pk2(o[8 * i + 2 * j] * s, o[8 * i + 2 * j + 1] * s);
        *(u32x4*)(p + 8 * i) = w; }
}
__device__ __forceinline__ void attn0_phase(const Ctx& c, const bf16* qkv, const float* sinks, bf16* O) {
    const long total = (long)32 * M;
    for (long id = gtid_now(); id < total; id += c.gsz) {
        const int hh = (int)(id / M), m = (int)(id % M), b = m / T, t = m % T;
        float q[64], o[64];
#pragma unroll
        for (int i = 0; i < 64; ++i) o[i] = 0.f;
        float mx = -1e30f, l = 0.f;
        if (hh < 16) {
            const int h = hh; const float slope = exp2f(-0.5f * (float)(h + 1));
            load64(qkv + (size_t)m * AB_IN + 64 * h, q, 0.125f);
            const bf16* kb = qkv + (size_t)b * T * AB_IN + 1024 + 64 * h;
            for (int br = 0; br < 3; ++br) {
                const int dil = br == 0 ? 1 : (br == 1 ? 4 : 16);
                for (int j = 0; j <= 128; ++j) {
                    const int s = t - dil * j; if (s < 0) break;
                    const bf16* kp = kb + (size_t)s * AB_IN;
                    const float sc = dot64(q, kp) - slope * (float)(dil * j);
                    const float mn = fmaxf(mx, sc), a = __expf(mx - mn), p = __expf(sc - mn);
                    l = l * a + p; axpy64(o, a, p, kp + 1024); mx = mn;
                }
            }
            store64_bf16(O + (size_t)m * D + 64 * h, o, 1.f / l);
        } else {
            const int h = hh - 16, kvh = h >> 3; const float slope = exp2f(-0.5f * (float)(h + 1));
            load64(qkv + (size_t)m * AB_IN + 3072 + 64 * h, q, 0.125f);
            const bf16* kb = qkv + (size_t)b * T * AB_IN + 4096 + 64 * kvh;
            for (int j = 0; j < 128; ++j) {
                const int s = t - j; if (s < 0) break;
                const bf16* kp = kb + (size_t)s * AB_IN;
                const float sc = dot64(q, kp) - slope * (float)j;
                const float mn = fmaxf(mx, sc), a = __expf(mx - mn), p = __expf(sc - mn);
                l = l * a + p; axpy64(o, a, p, kp + 128); mx = mn;
            }
            const float sk = sinks[h], mn = fmaxf(mx, sk), a = __expf(mx - mn);
            l = l * a + __expf(sk - mn);
            store64_bf16(O + (size_t)m * D + 1024 + 64 * h, o, a / l);
        }
    }
}
__device__ __forceinline__ void attn1_phase(const Ctx& c, const bf16* qkv, float* tmp) {
    const int items = NB * 16 * 2 * 2 * (T / 64);
    for (int it = c.gw; it < items; it += c.ngw) {
        const int tb = (T / 64 - 1) - it / (NB * 16 * 4); const int r = it % (NB * 16 * 4);
        const int b = r / 64, h = (r / 4) % 16, i = (r >> 1) & 1, j = r & 1;
        const int t = tb * 64 + c.lane, m = b * T + t;
        const float slope = exp2f(-0.5f * (float)(h + 1));
        float q[64], o[64];
#pragma unroll
        for (int d = 0; d < 64; ++d) o[d] = 0.f;
        float mx = -1e30f, l = 0.f;
        load64(qkv + (size_t)m * C_IN + 128 * h + 64 * i, q, 0.125f);
        const bf16* kb = qkv + (size_t)b * T * C_IN + 2048 + 128 * h + 64 * i;
        const bf16* vb = qkv + (size_t)b * T * C_IN + 4096 + 128 * h + 64 * j;
        const int smax = tb * 64 + 63;
        for (int s = 0; s <= smax; ++s) {
            const bf16* kp = kb + (size_t)s * C_IN;
            float sc = dot64(q, kp) - slope * (float)(t - s);
            if (s > t) sc = -1e30f;
            const float mn = fmaxf(mx, sc), a = __expf(mx - mn), p = (s > t) ? 0.f : __expf(sc - mn);
            l = l * a + p; axpy64(o, a, p, vb + (size_t)s * C_IN); mx = mn;
        }
        float* op = tmp + (((size_t)m * 16 + h) * 2 + i) * 128 + 64 * j; const float il = 1.f / l;
#pragma unroll
        for (int d = 0; d < 16; ++d) *(f32x4*)(op + 4 * d) = (f32x4){o[4 * d] * il, o[4 * d + 1] * il, o[4 * d + 2] * il, o[4 * d + 3] * il};
    }
}
__device__ __forceinline__ void attn1_finish_phase(const Ctx& c, const float* tmp, const float* lamp  , const float* subln  , bf16* O) {
    float s01 = 0.f, s23 = 0.f;
    for (int i = 0; i < 64; ++i) { s01 += lamp[i] * lamp[64 + i]; s23 += lamp[128 + i] * lamp[192 + i]; }
    const float lam_init = 0.8f - 0.6f * expf(-0.3f * 1.0f);
    const float lam = expf(s01) - expf(s23) + lam_init;
    const long total = (long)M * 16;
    for (long id = gtid_now(); id < total; id += c.gsz) {
        const float* p1 = tmp + (size_t)id * 256; const float* p2 = p1 + 128;
        float ss = 0.f;
        for (int d = 0; d < 128; ++d) { const float v = p1[d] - lam * p2[d]; ss += v * v; }
        const float rs = (1.f - lam_init) / sqrtf(ss * (1.f / 128.f) + RMS_EPS);
        bf16* op = O + (size_t)id * 128;
        for (int d = 0; d < 128; d += 2) { const float v0 = (p1[d] - lam * p2[d]) * rs * subln[d], v1 = (p1[d + 1] - lam * p2[d + 1]) * rs * subln[d + 1];
            *(unsigned*)(op + d) = pk2(v0, v1); }
    }
}

__device__ __forceinline__ void router_phase(const Ctx& c, const float* x1, const float* g, const float* ada_l, const float* wr  , const float* rbias  ,
                                             bf16* HF, int* idx, float* gate, unsigned* counts) {
    LAS float* hb = (LAS float*)(c.lds + c.wave * 8192);
    const int lane = c.lane;
    for (int m = c.gw; m < M; m += c.ngw) {
        const int b = m / T; f32x4 v[8]; load_row(x1 + (size_t)m * D, lane, v);
        const float rstd = row_rstd(v);
        modulate_row(v, rstd, g, ada_l + (size_t)b * 6 * D + 3 * D, ada_l + (size_t)b * 6 * D + 4 * D, lane);
        store_row_bf16(HF + (size_t)m * D, v, lane);
#pragma unroll
        for (int j = 0; j < 8; ++j) *(LAS f32x4*)(hb + 4 * lane + 256 * j) = v[j];
        asm volatile("s_waitcnt lgkmcnt(0)" ::: "memory");
        float a0 = 0.f, a1 = 0.f, a2 = 0.f, a3 = 0.f;
        for (int k = 0; k < D; k += 4) {
            const f32x4 hv = *(const LAS f32x4*)(hb + k);
            a0 += hv.x * wr[(size_t)(k + 0) * 64 + lane]; a1 += hv.y * wr[(size_t)(k + 1) * 64 + lane];
            a2 += hv.z * wr[(size_t)(k + 2) * 64 + lane]; a3 += hv.w * wr[(size_t)(k + 3) * 64 + lane];
        }
        const float logit = (a0 + a1) + (a2 + a3);
        const float score = 1.f / (1.f + expf(-logit));
        const float sel = score + rbias[lane];
        float m1 = sel;
        m1 = fmaxf(m1, __shfl_xor(m1, 1)); m1 = fmaxf(m1, __shfl_xor(m1, 2)); m1 = fmaxf(m1, __shfl_xor(m1, 4));
        const unsigned long long eqm = __ballot(sel == m1);
        const int gbase = lane & ~7;
        const unsigned grp_eq = (unsigned)((eqm >> gbase) & 0xffull);
        const int first = __builtin_ctz(grp_eq);
        float m2 = ((lane & 7) == first) ? -3e38f : sel;
        m2 = fmaxf(m2, __shfl_xor(m2, 1)); m2 = fmaxf(m2, __shfl_xor(m2, 2)); m2 = fmaxf(m2, __shfl_xor(m2, 4));
        const float gs = m1 + m2;
        int grank = 0; const int mygrp = lane >> 3;
#pragma unroll
        for (int g2 = 0; g2 < 8; ++g2) { const float o = __shfl(gs, g2 * 8); grank += (o > gs || (o == gs && g2 < mygrp)) ? 1 : 0; }
        const float msel = (grank < 4) ? sel : -1e30f;
        int rank = 0;
        for (int e2 = 0; e2 < 64; ++e2) { const float o = __shfl(msel, e2); rank += (o > msel || (o == msel && e2 < lane)) ? 1 : 0; }
        const bool chosen = rank < TOPK;
        const float gsum = wave_sum(chosen ? score : 0.f);
        if (chosen) { idx[(size_t)m * 8 + rank] = lane; gate[(size_t)m * 8 + rank] = score / gsum * 2.5f;
            __hip_atomic_fetch_add(counts + lane, 1u, __ATOMIC_RELAXED, __HIP_MEMORY_SCOPE_AGENT); }
    }
}
__device__ __forceinline__ void slot_phase(const Ctx& c, const int* idx, const unsigned* counts, unsigned* cursor, unsigned* nrt_out, int* pos, int* slot_tok, int* tile_exp) {
    LAS int* ps = (LAS int*)c.lds;
    if (c.tid == 0) { int acc = 0; for (int e = 0; e < NE; ++e) { const int cn = (int)counts[e]; ps[e] = acc; ps[64 + e] = cn; acc += (cn + 255) / 256 * 256; } ps[128] = acc; }
    __syncthreads();
    for (int a = gtid_now(); a < M * TOPK; a += c.gsz) {
        const int e = idx[a]; const unsigned r = __hip_atomic_fetch_add(cursor + e, 1u, __ATOMIC_RELAXED, __HIP_MEMORY_SCOPE_AGENT);
        const int slot = ps[e] + (int)r; slot_tok[slot] = a >> 3; pos[a] = slot;
    }
    for (int t = gtid_now(); t < M; t += c.gsz) slot_tok[CAPR + t] = t;
    if (blockIdx.x == 0) {
        if (c.tid < NE) { const int e = c.tid, s0 = ps[e], cn = ps[64 + e], pe = s0 + (cn + 255) / 256 * 256;
            for (int s = s0 + cn; s < pe; ++s) slot_tok[s] = 0;
            for (int tt = s0 / 256; tt < pe / 256; ++tt) tile_exp[tt] = e; }
        if (c.tid == 0) *nrt_out = (unsigned)(ps[128] / 256);
    }
    __syncthreads();
}
__device__ __forceinline__ void moe_up_phase(const Ctx& c, const bf16* HF, const bf16* Wup_l  , const int* slot_tok, const int* tile_exp, const unsigned* nrt_p, bf16* ACT) {
    const int nrt = (int)*nrt_p, ntiles = nrt + M / 256, units = ntiles * (ED / 64);
    for (int u = blockIdx.x; u < units; u += gridDim.x) {
        const int mt = u / (ED / 64), nt = u % (ED / 64), n0 = nt * 64;
        const int e = mt < nrt ? tile_exp[mt] : NE; const int slot0 = (mt < nrt ? mt * 256 : CAPR + (mt - nrt) * 256) + c.wave * 32;
        const int r = c.lane & 15;
        const bf16* a0 = HF + (size_t)slot_tok[slot0 + r] * D; const bf16* a1 = HF + (size_t)slot_tok[slot0 + 16 + r] * D;
        const bf16* W = Wup_l + (size_t)e * UPN * D;
        f32x4 ag[2][4], au[2][4]; ZERO_ACC(ag); ZERO_ACC(au);
        wave_gemm_32x64(a0, a1, W + (size_t)(n0 + r) * D, D, c.lane, ag);
        wave_gemm_32x64(a0, a1, W + (size_t)(ED + n0 + r) * D, D, c.lane, au);
#pragma unroll
        for (int mi = 0; mi < 2; ++mi)
#pragma unroll
            for (int n = 0; n < 4; ++n)
#pragma unroll
                for (int j = 0; j < 4; ++j) ACT[(size_t)(slot0 + 16 * mi + 4 * (c.lane >> 4) + j) * ED + n0 + 16 * n + r] = (bf16)f2bf(siluf(ag[mi][n][j]) * au[mi][n][j]);
    }
}
__device__ __forceinline__ void moe_down_phase(const Ctx& c, const bf16* ACT, const bf16* Wdn_l  , const int* tile_exp, const unsigned* nrt_p, bf16* Y) {
    const int nrt = (int)*nrt_p, ntiles = nrt + M / 256, units = ntiles * (D / 64);
    for (int u = blockIdx.x; u < units; u += gridDim.x) {
        const int mt = u / (D / 64), nt = u % (D / 64), n0 = nt * 64;
        const int e = mt < nrt ? tile_exp[mt] : NE; const int slot0 = (mt < nrt ? mt * 256 : CAPR + (mt - nrt) * 256) + c.wave * 32;
        const int r = c.lane & 15;
        const bf16* W = Wdn_l + (size_t)e * D * ED;
        f32x4 acc[2][4]; ZERO_ACC(acc);
        wave_gemm_32x64(ACT + (size_t)(slot0 + r) * ED, ACT + (size_t)(slot0 + 16 + r) * ED, W + (size_t)(n0 + r) * ED, ED, c.lane, acc);
#pragma unroll
        for (int mi = 0; mi < 2; ++mi)
#pragma unroll
            for (int n = 0; n < 4; ++n)
#pragma unroll
                for (int j = 0; j < 4; ++j) Y[(size_t)(slot0 + 16 * mi + 4 * (c.lane >> 4) + j) * D + n0 + 16 * n + r] = (bf16)f2bf(acc[mi][n][j]);
    }
}
__device__ __forceinline__ void add_row_bf16(f32x4 (&acc)[8], const bf16* yrow, float w, int lane) {
#pragma unroll
    for (int j = 0; j < 8; ++j) { const u32x2 v = *(const u32x2*)(yrow + 4 * lane + 256 * j);
        acc[j].x += w * bf2f(v.x & 0xffffu); acc[j].y += w * bf2f(v.x >> 16); acc[j].z += w * bf2f(v.y & 0xffffu); acc[j].w += w * bf2f(v.y >> 16); }
}
__device__ __forceinline__ void add_row_fp8(f32x4 (&acc)[8], const unsigned char* yrow, float w, int lane) {
#pragma unroll
    for (int j = 0; j < 8; ++j) { const unsigned v = *(const unsigned*)(yrow + 4 * lane + 256 * j);
        acc[j].x += w * __builtin_amdgcn_cvt_f32_fp8(v, 0); acc[j].y += w * __builtin_amdgcn_cvt_f32_fp8(v, 1); acc[j].z += w * __builtin_amdgcn_cvt_f32_fp8(v, 2); acc[j].w += w * __builtin_amdgcn_cvt_f32_fp8(v, 3); }
}
template <bool NEXT>
__device__ __forceinline__ void combine_phase(const Ctx& c, const float* x1, const bf16* Y, const int* pos, const float* gate, const float* ada_l, float* xo,
                                              const float* gnext, const float* ada_next, bf16* XN) {
    for (int m = c.gw; m < M; m += c.ngw) {
        const int b = m / T; f32x4 acc[8];
#pragma unroll
        for (int j = 0; j < 8; ++j) acc[j] = (f32x4){0.f, 0.f, 0.f, 0.f};
#if USE_FP8_MOE && Y_FP8
        for (int k = 0; k < TOPK; ++k) add_row_fp8(acc, (const unsigned char*)Y + (size_t)pos[(size_t)m * 8 + k] * D, gate[(size_t)m * 8 + k] * (1.f / F8_YSCALE), c.lane);
        add_row_fp8(acc, (const unsigned char*)Y + (size_t)(CAPR + m) * D, 1.f / F8_YSCALE, c.lane);
#else
        for (int k = 0; k < TOPK; ++k) add_row_bf16(acc, Y + (size_t)pos[(size_t)m * 8 + k] * D, gate[(size_t)m * 8 + k], c.lane);
        add_row_bf16(acc, Y + (size_t)(CAPR + m) * D, 1.f, c.lane);
#endif
        const float* gf = ada_l + (size_t)b * 6 * D + 5 * D;
        f32x4 v[8];
#pragma unroll
        for (int j = 0; j < 8; ++j) { const int col = 4 * c.lane + 256 * j;
#if RES_BF16
            { const u32x2 xw = *(const u32x2*)((const bf16*)x1 + (size_t)m * D + col);
              v[j] = (f32x4){bf2f(xw.x & 0xffffu), bf2f(xw.x >> 16), bf2f(xw.y & 0xffffu), bf2f(xw.y >> 16)} + *(const f32x4*)(gf + col) * acc[j]; }
            if (NEXT) { u32x2 ow; ow.x = pk2(v[j].x, v[j].y); ow.y = pk2(v[j].z, v[j].w); *(u32x2*)((bf16*)xo + (size_t)m * D + col) = ow; }
            else *(f32x4*)(xo + (size_t)m * D + col) = v[j];
#else
            v[j] = *(const f32x4*)(x1 + (size_t)m * D + col) + *(const f32x4*)(gf + col) * acc[j];
            *(f32x4*)(xo + (size_t)m * D + col) = v[j];
#endif
            }
        if (NEXT) {
            const float rstd = row_rstd(v);
            modulate_row(v, rstd, gnext, ada_next + (size_t)b * 6 * D, ada_next + (size_t)b * 6 * D + D, c.lane);
#if USE_FP8_QKV
            store_row_fp8((unsigned char*)XN + (size_t)m * D, v, c.lane, F8_HSCALE);
#else
            store_row_bf16(XN + (size_t)m * D, v, c.lane);
#endif
        }
    }
}


namespace pg8 {
constexpr int BM = 256, BK = 64, HALF = 128, HTB = HALF * BK * 2, STAGE_BYTES = 8 * HTB, NXCD = 8, WGM = 8;
__device__ __forceinline__ int lds_byte(int r, int c) { const int st = (r >> 4) * 2 + (c >> 5), rr = r & 15, cc = c & 31, ob = rr * 64 + cc * 2; return st * 1024 + (ob ^ (((ob >> 9) & 1) << 5)); }
__device__ __forceinline__ void stage_rc(int b, int& R, int& C) { const int st = b / 1024, sb = b % 1024, swz = sb ^ (((sb >> 9) & 1) << 5); R = (st >> 1) * 16 + swz / 64; C = (st & 1) * 32 + (swz % 64) / 2; }
__device__ __forceinline__ int perm32(int rho) { const int n = rho >> 4, i = rho & 15; return 8 * (i >> 2) + 4 * n + (i & 3); }
__device__ __forceinline__ unsigned cvt_pk_bf16(float lo, float hi) { unsigned r; asm volatile("v_cvt_pk_bf16_f32 %0, %1, %2" : "=v"(r) : "v"(lo), "v"(hi)); return r; }

struct Unit { int row0, pn; const char* Bp; };

struct TileOrder {
    int nM, nN, nwg, G, c;
    __device__ __forceinline__ void init(int nM_, int nN_, int G_, int c_) { nM = nM_; nN = nN_; nwg = nM * nN; G = G_; c = c_; }
    __device__ __forceinline__ bool tile(int i, int& pm, int& pn) const {
        const long L = (long)i * G + c; if (L >= nwg) return false;
        int wgid = (int)L; { const int q = nwg / NXCD, r = nwg % NXCD, xcd = wgid % NXCD, off = wgid / NXCD; wgid = (xcd < r ? xcd * (q + 1) : r * (q + 1) + (xcd - r) * q) + off; }
        const int nig = WGM * nN, gid = wgid / nig, fm = gid * WGM, gsz = (nM - fm) < WGM ? (nM - fm) : WGM;
        pm = fm + ((wgid % nig) % gsz); pn = (wgid % nig) / gsz; return true;
    }
};
struct PlainSched {
    static constexpr bool GATHER = false;
    TileOrder o; const char* Bt; int K;
    __device__ __forceinline__ bool next(int i, Unit& u) const { int pm, pn; if (!o.tile(i, pm, pn)) return false; u.row0 = pm * BM; u.pn = pn; u.Bp = Bt + (size_t)pn * BM * K * 2; return true; }
    __device__ __forceinline__ unsigned arow_off(const Unit& u, int rl) const { return (unsigned)(u.row0 + rl) * (unsigned)(K * 2); }
};
template <bool GATHER_> struct GroupSched {
    static constexpr bool GATHER = GATHER_;
    TileOrder o; const char* W; size_t wstride; int K, nrt; const LAS int* tile_exp; const int* slot_tok;
    __device__ __forceinline__ bool next(int i, Unit& u) const { int pm, pn; if (!o.tile(i, pm, pn)) return false;
        const int e = pm < nrt ? tile_exp[pm] : NE; u.row0 = pm < nrt ? pm * BM : CAPR + (pm - nrt) * BM; u.pn = pn; u.Bp = W + (size_t)e * wstride + (size_t)pn * BM * K * 2; return true; }
    __device__ __forceinline__ unsigned arow_off(const Unit& u, int rl) const { const int r = GATHER ? slot_tok[u.row0 + rl] : (u.row0 + rl); return (unsigned)r * (unsigned)(K * 2); }
};

template <int LAYER> struct EpiQKV {
    static constexpr bool PERM = true;
    bf16* O; int ldc; const float* gains; float qscale, ascale;
    __device__ __forceinline__ void operator()(const f32x4 (&acc)[2][2][4][2], const Unit& u, int wr, int wc, int fr, int fq) const {
        const int head = 4 * u.pn + wc; int gi;
        if (LAYER == 0) gi = head < 16 ? 0 : head < 32 ? 1 : head < 48 ? -1 : head < 64 ? 2 : head < 66 ? 3 : -1;
        else gi = head < 32 ? 0 : head < 64 ? 1 : -1;
        f32x4 gv[2][2];
#pragma unroll
        for (int bj = 0; bj < 2; ++bj)
#pragma unroll
            for (int n = 0; n < 2; ++n) gv[bj][n] = gi >= 0 ? *(const f32x4*)(gains + 64 * gi + 32 * bj + 8 * fq + 4 * n) : (f32x4){1.f, 1.f, 1.f, 1.f};
#if QKV_HEADMAJOR
        bf16* base = O + ((size_t)head * M + (size_t)(u.row0 + wr * 64 + fr)) * 64 + 8 * fq; const int ldo = 64;
#else
        bf16* base = O + (size_t)(u.row0 + wr * 64 + fr) * ldc + 64 * head + 8 * fq; const int ldo = ldc;
#endif
#pragma unroll
        for (int ai = 0; ai < 2; ++ai)
#pragma unroll
            for (int m = 0; m < 4; ++m) {
                float ss = 0.f;
#pragma unroll
                for (int bj = 0; bj < 2; ++bj)
#pragma unroll
                    for (int n = 0; n < 2; ++n) { const f32x4 x = acc[ai][bj][m][n]; ss += (x[0] * x[0] + x[1] * x[1]) + (x[2] * x[2] + x[3] * x[3]); }
                ss += __shfl_xor(ss, 16); ss += __shfl_xor(ss, 32); ss *= ascale * ascale;
                const bool isq = LAYER == 0 ? (gi == 0 || gi == 2) : (gi == 0);
                const float rs = ascale * (gi >= 0 ? (isq ? qscale : 1.f) / sqrtf(ss * (1.f / 64.f) + RMS_EPS) : 1.f);
                bf16* rowp = base + (size_t)(ai * HALF + m * 16) * ldo;
#pragma unroll
                for (int bj = 0; bj < 2; ++bj) { const f32x4 v0 = acc[ai][bj][m][0] * rs * gv[bj][0], v1 = acc[ai][bj][m][1] * rs * gv[bj][1];
                    u32x4 w; w.x = cvt_pk_bf16(v0[0], v0[1]); w.y = cvt_pk_bf16(v0[2], v0[3]); w.z = cvt_pk_bf16(v1[0], v1[1]); w.w = cvt_pk_bf16(v1[2], v1[3]);
                    *(u32x4*)(rowp + 32 * bj) = w; }
            }
    }
};
struct EpiOut {
    static constexpr bool PERM = false;
    const float* xin; const float* gm; float* X1;
    __device__ __forceinline__ void operator()(const f32x4 (&acc)[2][2][4][2], const Unit& u, int wr, int wc, int fr, int fq) const {
        const int col0 = u.pn * BM + wc * 32 + 4 * fq; const float* g = gm + (size_t)(u.row0 / T) * 6 * D + col0;
        f32x4 gv[2][2];
#pragma unroll
        for (int bj = 0; bj < 2; ++bj)
#pragma unroll
            for (int n = 0; n < 2; ++n) gv[bj][n] = *(const f32x4*)(g + bj * HALF + n * 16);
#pragma unroll
        for (int ai = 0; ai < 2; ++ai)
#pragma unroll
            for (int m = 0; m < 4; ++m) { const size_t off = (size_t)(u.row0 + wr * 64 + fr + ai * HALF + m * 16) * D + col0;
#pragma unroll
                for (int bj = 0; bj < 2; ++bj)
#pragma unroll
                    for (int n = 0; n < 2; ++n) *(f32x4*)(X1 + off + bj * HALF + n * 16) = *(const f32x4*)(xin + off + bj * HALF + n * 16) + gv[bj][n] * acc[ai][bj][m][n]; }
    }
};

template <bool XIN_BF16> struct EpiOutB {
    static constexpr bool PERM = true;
    const void* xin; const float* gm; bf16* X1b;
    __device__ __forceinline__ void operator()(const f32x4 (&acc)[2][2][4][2], const Unit& u, int wr, int wc, int fr, int fq) const {
        const int col0 = u.pn * BM + wc * 32 + 8 * fq; const float* g = gm + (size_t)(u.row0 / T) * 6 * D + col0;
        f32x4 gv[2][2];
#pragma unroll
        for (int bj = 0; bj < 2; ++bj)
#pragma unroll
            for (int n = 0; n < 2; ++n) gv[bj][n] = *(const f32x4*)(g + bj * HALF + 4 * n);
#pragma unroll
        for (int ai = 0; ai < 2; ++ai)
#pragma unroll
            for (int m = 0; m < 4; ++m) { const size_t off = (size_t)(u.row0 + wr * 64 + fr + ai * HALF + m * 16) * D + col0;
#pragma unroll
                for (int bj = 0; bj < 2; ++bj) { f32x4 x0, x1v;
                    if (XIN_BF16) { const u32x4 xw = *(const u32x4*)((const bf16*)xin + off + bj * HALF);
                        x0 = (f32x4){bf2f(xw.x & 0xffffu), bf2f(xw.x >> 16), bf2f(xw.y & 0xffffu), bf2f(xw.y >> 16)}; x1v = (f32x4){bf2f(xw.z & 0xffffu), bf2f(xw.z >> 16), bf2f(xw.w & 0xffffu), bf2f(xw.w >> 16)}; }
                    else { x0 = *(const f32x4*)((const float*)xin + off + bj * HALF); x1v = *(const f32x4*)((const float*)xin + off + bj * HALF + 4); }
                    const f32x4 v0 = x0 + gv[bj][0] * acc[ai][bj][m][0], v1 = x1v + gv[bj][1] * acc[ai][bj][m][1];
                    u32x4 w; w.x = cvt_pk_bf16(v0[0], v0[1]); w.y = cvt_pk_bf16(v0[2], v0[3]); w.z = cvt_pk_bf16(v1[0], v1[1]); w.w = cvt_pk_bf16(v1[2], v1[3]);
                    *(u32x4*)(X1b + off + bj * HALF) = w; } }
    }
};
__device__ __forceinline__ float silu_fast(float x) { return x * __builtin_amdgcn_rcpf(1.f + __builtin_amdgcn_exp2f(-1.4426950408889634f * x)); }
struct EpiUp {
    static constexpr bool PERM = true;
    bf16* ACT;
    __device__ __forceinline__ void operator()(const f32x4 (&acc)[2][2][4][2], const Unit& u, int wr, int wc, int fr, int fq) const {
        bf16* base = ACT + (size_t)(u.row0 + wr * 64 + fr) * ED + 128 * u.pn + 32 * wc + 8 * fq;
#pragma unroll
        for (int ai = 0; ai < 2; ++ai)
#pragma unroll
            for (int m = 0; m < 4; ++m) { f32x4 v[2];
#pragma unroll
                for (int n = 0; n < 2; ++n)
#pragma unroll
                    for (int i = 0; i < 4; ++i) v[n][i] = silu_fast(acc[ai][0][m][n][i]) * acc[ai][1][m][n][i];
                u32x4 w; w.x = cvt_pk_bf16(v[0][0], v[0][1]); w.y = cvt_pk_bf16(v[0][2], v[0][3]); w.z = cvt_pk_bf16(v[1][0], v[1][1]); w.w = cvt_pk_bf16(v[1][2], v[1][3]);
                *(u32x4*)(base + (size_t)(ai * HALF + m * 16) * ED) = w; }
    }
};
struct EpiDown {
    static constexpr bool PERM = true;
    bf16* Y; int orow = 0;
    __device__ __forceinline__ void operator()(const f32x4 (&acc)[2][2][4][2], const Unit& u, int wr, int wc, int fr, int fq) const {
        bf16* base = Y + (size_t)(orow + u.row0 + wr * 64 + fr) * D + u.pn * BM + wc * 32 + 8 * fq;
#pragma unroll
        for (int ai = 0; ai < 2; ++ai)
#pragma unroll
            for (int m = 0; m < 4; ++m) { bf16* rowp = base + (size_t)(ai * HALF + m * 16) * D;
#pragma unroll
                for (int bj = 0; bj < 2; ++bj) { const f32x4 v0 = acc[ai][bj][m][0], v1 = acc[ai][bj][m][1];
                    u32x4 w; w.x = cvt_pk_bf16(v0[0], v0[1]); w.y = cvt_pk_bf16(v0[2], v0[3]); w.z = cvt_pk_bf16(v1[0], v1[1]); w.w = cvt_pk_bf16(v1[2], v1[3]);
                    *(u32x4*)(rowp + bj * HALF) = w; } }
    }
};


struct EpiUp8 {
    static constexpr bool PERM = true;
    unsigned char* ACT8;
    __device__ __forceinline__ void operator()(const f32x4 (&acc)[2][2][4][2], const Unit& u, int wr, int wc, int fr, int fq) const {
        unsigned char* base = ACT8 + (size_t)(u.row0 + wr * 64 + fr) * ED + 128 * u.pn + 32 * wc + 8 * fq;
        constexpr float s = 1.f / (F8_HSCALE * F8_WSCALE);
#pragma unroll
        for (int ai = 0; ai < 2; ++ai)
#pragma unroll
            for (int m = 0; m < 4; ++m) { f32x4 v[2];
#pragma unroll
                for (int n = 0; n < 2; ++n)
#pragma unroll
                    for (int i = 0; i < 4; ++i) v[n][i] = silu_fast(acc[ai][0][m][n][i] * s) * (acc[ai][1][m][n][i] * (s * F8_ASCALE));
                u32x2 w; w.x = pk4_fp8(v[0][0], v[0][1], v[0][2], v[0][3]); w.y = pk4_fp8(v[1][0], v[1][1], v[1][2], v[1][3]);
                *(u32x2*)(base + (size_t)(ai * HALF + m * 16) * ED) = w; }
    }
};
struct EpiDown8 {
    static constexpr bool PERM = true;
    bf16* Y;
    __device__ __forceinline__ void operator()(const f32x4 (&acc)[2][2][4][2], const Unit& u, int wr, int wc, int fr, int fq) const {
#if Y_FP8
        unsigned char* base = (unsigned char*)Y + (size_t)(u.row0 + wr * 64 + fr) * D + u.pn * BM + wc * 64 + 16 * fq;
        constexpr float s = F8_YSCALE / (F8_ASCALE * F8_WSCALE);
#pragma unroll
        for (int ai = 0; ai < 2; ++ai)
#pragma unroll
            for (int m = 0; m < 4; ++m) { unsigned char* rowp = base + (size_t)(ai * HALF + m * 16) * D; u32x4 w;
#pragma unroll
                for (int bj = 0; bj < 2; ++bj) { const f32x4 v0 = acc[ai][bj][m][0] * s, v1 = acc[ai][bj][m][1] * s;
                    w[2 * bj] = pk4_fp8(v0[0], v0[1], v0[2], v0[3]); w[2 * bj + 1] = pk4_fp8(v1[0], v1[1], v1[2], v1[3]); }
                *(u32x4*)rowp = w; }
#else
        bf16* base = Y + (size_t)(u.row0 + wr * 64 + fr) * D + u.pn * BM + wc * 32 + 8 * fq;
        constexpr float s = 1.f / (F8_ASCALE * F8_WSCALE);
#pragma unroll
        for (int ai = 0; ai < 2; ++ai)
#pragma unroll
            for (int m = 0; m < 4; ++m) { bf16* rowp = base + (size_t)(ai * HALF + m * 16) * D;
#pragma unroll
                for (int bj = 0; bj < 2; ++bj) { const f32x4 v0 = acc[ai][bj][m][0] * s, v1 = acc[ai][bj][m][1] * s;
                    u32x4 w; w.x = cvt_pk_bf16(v0[0], v0[1]); w.y = cvt_pk_bf16(v0[2], v0[3]); w.z = cvt_pk_bf16(v1[0], v1[1]); w.w = cvt_pk_bf16(v1[2], v1[3]);
                    *(u32x4*)(rowp + bj * HALF) = w; } }
#endif
    }
};
__device__ __forceinline__ void glds16s(const void* sbase, unsigned voff, unsigned lds_dst) { unsigned keep;
    asm volatile("s_mov_b32 %0, m0\n\ts_mov_b32 m0, %3\n\ts_nop 0\n\tglobal_load_lds_dwordx4 %1, %2\n\ts_mov_b32 m0, %0" : "=&s"(keep) : "v"(voff), "s"(sbase), "s"(lds_dst) : "memory"); }
__device__ __forceinline__ void glds4s(const void* sbase, unsigned voff, unsigned lds_dst) { unsigned keep;
    asm volatile("s_mov_b32 %0, m0\n\ts_mov_b32 m0, %3\n\ts_nop 0\n\tglobal_load_lds_dword %1, %2\n\ts_mov_b32 m0, %0" : "=&s"(keep) : "v"(voff), "s"(sbase), "s"(lds_dst) : "memory"); }
typedef int i32x4 __attribute__((ext_vector_type(4)));
typedef int i32x8 __attribute__((ext_vector_type(8)));
__device__ __forceinline__ i32x8 cat8(bf16x8 a, bf16x8 b) { return __builtin_shufflevector(__builtin_bit_cast(i32x4, a), __builtin_bit_cast(i32x4, b), 0, 1, 2, 3, 4, 5, 6, 7); }
__device__ __forceinline__ void mfma8_inplace(f32x4& acc, i32x8 a, i32x8 b) { asm volatile("v_mfma_f32_16x16x128_f8f6f4 %0, %1, %2, %0" : "+v"(acc) : "v"(a), "v"(b)); }
template <class Epi, class Sched, bool FP8 = false>
__device__ __forceinline__ void gemm_phase(LAS unsigned char* lds, const char* Abase, const int K, const Sched& S, const Epi& E) {
    constexpr bool GATHER = Sched::GATHER;
    const int tid = threadIdx.x, wid = __builtin_amdgcn_readfirstlane(tid >> 6), lane = tid & 63, wr = wid >> 2, wc = wid & 3, fr = lane & 15, fq = lane >> 4;
    int nt = K / BK; asm volatile("" : "+s"(nt));
    int RA[2]; unsigned CA[2], voffB[2], vC[2];
#pragma unroll
    for (int i = 0; i < 2; ++i) { int R, C; stage_rc(tid * 16 + i * 8192, R, C); const int Rb = Epi::PERM ? ((R & ~31) + perm32(R & 31)) : R;
        RA[i] = R; CA[i] = (unsigned)C * 2u; voffB[i] = (unsigned)(Rb * K + C) * 2u; vC[i] = (unsigned)(R * K + C) * 2u; }
    const size_t kstep = (size_t)(BK * 2);
    const size_t hstep = (size_t)HALF * K * 2;
    const size_t ahstep = GATHER ? 0 : hstep;
    const unsigned ldsw = (unsigned)wid * 1024u;
    const unsigned lds0 = (unsigned)(uintptr_t)lds;
    const int aoff = lds_byte(wr * 64 + fr, fq * 8), boff = lds_byte(wc * 32 + fr, fq * 8);
#define PG8_SA(b, h) (((b) * 2 + (h)) * HTB)
#define PG8_SB(b, h) ((4 + (b) * 2 + (h)) * HTB)
#define PG8_STAGE(bufoff, gbase, voff) do { _Pragma("unroll") for (int _i = 0; _i < 2; ++_i) \
        glds16s((const void*)(gbase), (voff)[_i], (unsigned)__builtin_amdgcn_readfirstlane((int)(lds0 + (unsigned)(bufoff) + ldsw + (unsigned)(_i * 8192)))); } while (0)
#define PG8_STAGE_A(bufoff, gbase, h) do { if constexpr (GATHER) { PG8_STAGE(bufoff, gbase, vA[h]); } else { PG8_STAGE(bufoff, (gbase) + (h) * ahstep, vC); } } while (0)
#define PG8_LDA(dst, b, h) do { _Pragma("unroll") for (int m = 0; m < 4; ++m) _Pragma("unroll") for (int k = 0; k < 2; ++k) dst[m][k] = *(const LAS bf16x8*)(lds + PG8_SA(b, h) + aoff + m * 2048 + k * 1024); } while (0)
#define PG8_LDB(dst, b, h) do { _Pragma("unroll") for (int n = 0; n < 2; ++n) _Pragma("unroll") for (int k = 0; k < 2; ++k) dst[n][k] = *(const LAS bf16x8*)(lds + PG8_SB(b, h) + boff + n * 2048 + k * 1024); } while (0)
#define PG8_MMA(ai, bj, At, Bt) do { __builtin_amdgcn_s_setprio(1); if constexpr (FP8) { _Pragma("unroll") for (int m = 0; m < 4; ++m) _Pragma("unroll") for (int n = 0; n < 2; ++n) \
        mfma8_inplace(acc[ai][bj][m][n], cat8(Bt[n][0], Bt[n][1]), cat8(At[m][0], At[m][1])); } else { \
        _Pragma("unroll") for (int m = 0; m < 4; ++m) _Pragma("unroll") for (int n = 0; n < 2; ++n) _Pragma("unroll") for (int k = 0; k < 2; ++k) \
        acc[ai][bj][m][n] = __builtin_amdgcn_mfma_f32_16x16x32_bf16(Bt[n][k], At[m][k], acc[ai][bj][m][n], 0, 0, 0); } __builtin_amdgcn_s_setprio(0); } while (0)
#define PG8_WAIT_V(n) asm volatile("s_waitcnt vmcnt(" #n ")" ::: "memory")
#define PG8_WAIT_L(n) asm volatile("s_waitcnt lgkmcnt(0)" ::: "memory")
#define PG8_BAR __builtin_amdgcn_s_barrier()
#define PG8_SCHED __builtin_amdgcn_sched_barrier(0)
#define PG8_SETOFF(vo, u) do { _Pragma("unroll") for (int _h = 0; _h < 2; ++_h) _Pragma("unroll") for (int _i = 0; _i < 2; ++_i) vo[_h][_i] = S.arow_off(u, _h * HALF + RA[_i]) + CA[_i]; } while (0)
    Unit cur, nxt; int ui = 0;
    if (!S.next(0, cur)) return;
    f32x4 acc[2][2][4][2];
#pragma unroll
    for (int a = 0; a < 2; ++a)
#pragma unroll
        for (int b = 0; b < 2; ++b)
#pragma unroll
            for (int m = 0; m < 4; ++m)
#pragma unroll
                for (int n = 0; n < 2; ++n) acc[a][b][m][n] = (f32x4){0.f, 0.f, 0.f, 0.f};
    bf16x8 At[4][2], B0[2][2], B1[2][2];
    unsigned vA[2][2];
    LAS int* gidx = (LAS int*)(lds + STAGE_BYTES);
#define PG8_IDX_DMA(u) do { if (wid < 4) glds4s((const void*)(S.slot_tok + (u).row0), (unsigned)((wid * 64 + lane) * 4), (unsigned)__builtin_amdgcn_readfirstlane((int)(lds0 + (unsigned)STAGE_BYTES + (unsigned)wid * 256u))); } while (0)
#define PG8_IDX_READ() do { _Pragma("unroll") for (int _h = 0; _h < 2; ++_h) _Pragma("unroll") for (int _i = 0; _i < 2; ++_i) vA[_h][_i] = (unsigned)gidx[_h * HALF + RA[_i]] * (unsigned)(K * 2) + CA[_i]; } while (0)
    if constexpr (GATHER) { PG8_IDX_DMA(cur); asm volatile("s_waitcnt vmcnt(0)" ::: "memory"); __builtin_amdgcn_s_barrier(); asm volatile("" ::: "memory"); PG8_IDX_READ();
        asm volatile("s_waitcnt lgkmcnt(0)" ::: "memory"); __builtin_amdgcn_s_barrier(); asm volatile("" ::: "memory"); }
    const char* cA = GATHER ? Abase : Abase + (size_t)cur.row0 * K * 2;
    const char* cB = cur.Bp;
    PG8_STAGE(PG8_SB(0, 0), cB, voffB); PG8_STAGE(PG8_SB(0, 1), cB + hstep, voffB); PG8_STAGE_A(PG8_SA(0, 0), cA, 0); PG8_STAGE_A(PG8_SA(0, 1), cA, 1);
    if (wr == 1) PG8_BAR;
    PG8_WAIT_V(2); PG8_BAR;
    PG8_STAGE(PG8_SB(1, 0), cB + kstep, voffB); PG8_STAGE_A(PG8_SA(1, 0), cA + kstep, 0); PG8_STAGE(PG8_SB(1, 1), cB + hstep + kstep, voffB);
    PG8_WAIT_V(6); PG8_BAR;
    for (;;) {
        const bool has_next = S.next(ui + 1, nxt);
        if constexpr (GATHER) { if (has_next) PG8_IDX_DMA(nxt); }
        const char* nA = GATHER ? Abase : (has_next ? Abase + (size_t)nxt.row0 * K * 2 : cA);
        const char* nB = has_next ? nxt.Bp : cB;
#pragma unroll 1
        for (int t = 0; t < nt; t += 2) {
            const bool last = (t == nt - 2);
            const char* a1 = cA + (size_t)(t + 1) * kstep;
            const char* a2 = last ? nA : cA + (size_t)(t + 2) * kstep; const char* b2 = last ? nB : cB + (size_t)(t + 2) * kstep;
            const char* a3 = a2 + kstep; const char* b3 = b2 + kstep;
            PG8_LDB(B0, 0, 0); PG8_LDB(B1, 0, 1); PG8_SCHED; PG8_LDA(At, 0, 0); PG8_STAGE_A(PG8_SA(1, 1), a1, 1);
            if constexpr (GATHER) { if (last && has_next) PG8_IDX_READ(); }
            PG8_WAIT_V(8); PG8_WAIT_L(0); PG8_BAR; PG8_MMA(0, 0, At, B0); PG8_MMA(0, 1, At, B1); PG8_BAR; PG8_SCHED;
            PG8_LDA(At, 0, 1); PG8_STAGE(PG8_SB(0, 0), b2, voffB); PG8_STAGE(PG8_SB(0, 1), b2 + hstep, voffB); PG8_STAGE_A(PG8_SA(0, 0), a2, 0);
            PG8_WAIT_V(8); PG8_WAIT_L(0); PG8_BAR; PG8_MMA(1, 0, At, B0); PG8_MMA(1, 1, At, B1); PG8_BAR; PG8_SCHED;
            PG8_LDB(B0, 1, 0); PG8_LDB(B1, 1, 1); PG8_SCHED; PG8_LDA(At, 1, 0); PG8_STAGE_A(PG8_SA(0, 1), a2, 1);
            PG8_WAIT_V(8); PG8_WAIT_L(0); PG8_BAR; PG8_MMA(0, 0, At, B0); PG8_MMA(0, 1, At, B1); PG8_BAR; PG8_SCHED;
            PG8_LDA(At, 1, 1); PG8_STAGE(PG8_SB(1, 0), b3, voffB); PG8_STAGE(PG8_SB(1, 1), b3 + hstep, voffB); PG8_STAGE_A(PG8_SA(1, 0), a3, 0);
            PG8_WAIT_V(8); PG8_WAIT_L(0); PG8_BAR; PG8_MMA(1, 0, At, B0); PG8_MMA(1, 1, At, B1); PG8_BAR; PG8_SCHED;
        }
        if (wr == 0) PG8_BAR;
        if constexpr (FP8) asm volatile("s_nop 15\n\ts_nop 15" ::: "memory");
        E(acc, cur, wr, wc, fr, fq);
        if (!has_next) break;
#pragma unroll
        for (int a = 0; a < 2; ++a)
#pragma unroll
            for (int b = 0; b < 2; ++b)
#pragma unroll
                for (int m = 0; m < 4; ++m)
#pragma unroll
                    for (int n = 0; n < 2; ++n) acc[a][b][m][n] = (f32x4){0.f, 0.f, 0.f, 0.f};
        cur = nxt; cA = nA; cB = nB; ++ui;
        if (wr == 1) PG8_BAR;
    }
    PG8_WAIT_V(0);
    PG8_BAR;
#undef PG8_SA
#undef PG8_SB
#undef PG8_STAGE
#undef PG8_STAGE_A
#undef PG8_LDA
#undef PG8_LDB
#undef PG8_MMA
#undef PG8_WAIT_V
#undef PG8_WAIT_L
#undef PG8_BAR
#undef PG8_SCHED
#undef PG8_SETOFF
#undef PG8_IDX_DMA
#undef PG8_IDX_READ
}
}

namespace att {
using bf16=unsigned short;
using bf16x8=__attribute__((ext_vector_type(8)))short;
using s16x4=__attribute__((ext_vector_type(4)))short;
using f32x16=__attribute__((ext_vector_type(16)))float;
using u32x4=__attribute__((ext_vector_type(4)))unsigned;
constexpr int NW=8,QBLK=32,QB=QBLK*NW,KVBLK=64;
__device__ __forceinline__ int crow(int r,int hi){return (r&3)+8*(r>>2)+4*hi;}
#define SBAR() __builtin_amdgcn_sched_barrier(0)
constexpr int NSLOT=6, SLOTB=8192;
constexpr int LDS_K=0, LDS_V=NSLOT*SLOTB, LDS_WS=2*NSLOT*SLOTB, LDS_OST=LDS_WS+NW*64*4, LDS_BYTES=LDS_OST+NW*4096;
constexpr float C2=0.125f*1.4426950408889634f;
__device__ __forceinline__ void glds16(const void*sbase,unsigned voff,unsigned lds_dst){unsigned keep;
  asm volatile("s_mov_b32 %0, m0\n\ts_mov_b32 m0, %3\n\ts_nop 0\n\tglobal_load_lds_dwordx4 %1, %2\n\ts_mov_b32 m0, %0":"=&s"(keep):"v"(voff),"s"(sbase),"s"(lds_dst):"memory");}
__device__ __forceinline__ float max3f(float a,float b,float c){float r;asm("v_max3_f32 %0, %1, %2, %3":"=v"(r):"v"(a),"v"(b),"v"(c));return r;}
__device__ __forceinline__ float max2f(float a,float b){float r;asm("v_max_f32_e32 %0, %1, %2":"=v"(r):"v"(a),"v"(b));return r;}
__device__ __forceinline__ float fsub_s(float a,float b){float r;asm("v_sub_f32_e32 %0, %1, %2":"=v"(r):"v"(a),"v"(b));return r;}
typedef float f32x2_t __attribute__((ext_vector_type(2))); typedef __bf16 bf16x2_t __attribute__((ext_vector_type(2)));
__device__ __forceinline__ unsigned cvtpk_s(float lo,float hi){f32x2_t v={lo,hi};bf16x2_t b=__builtin_convertvector(v,bf16x2_t);return __builtin_bit_cast(unsigned,b);}
#define WAIT_BAR(N) asm volatile("s_waitcnt vmcnt(" #N ") lgkmcnt(0)\n\ts_barrier":::"memory")
typedef __attribute__((address_space(3))) const char* lds_cptr;
typedef short v4i16_t __attribute__((ext_vector_type(4)));
__device__ __forceinline__ void kload8(bf16x8*kf,lds_cptr kp,int bo){
  #pragma unroll
  for(int d0=0;d0<4;++d0){ const lds_cptr p=kp+((d0*32)^bo); kf[2*d0]=*(const __attribute__((address_space(3))) bf16x8*)(p); kf[2*d0+1]=*(const __attribute__((address_space(3))) bf16x8*)(p+4096); }
}
__device__ __forceinline__ void kload2(bf16x8*kf,lds_cptr kp,int j,int bo){ const lds_cptr p=kp+((j*32)^bo); kf[2*j]=*(const __attribute__((address_space(3))) bf16x8*)(p); kf[2*j+1]=*(const __attribute__((address_space(3))) bf16x8*)(p+4096); }
__device__ __forceinline__ s16x4 vtr(lds_cptr p){ return __builtin_bit_cast(s16x4,__builtin_amdgcn_ds_read_tr16_b64_v4i16((__attribute__((address_space(3))) v4i16_t*)p)); }
__device__ __forceinline__ float rowmax(const f32x16&p0,const f32x16&p1){
  float a=max3f(p0[0],p0[1],p1[0]),b=max3f(p0[2],p0[3],p1[1]);a=max3f(a,p1[2],p1[3]);
  #pragma unroll
  for(int r=4;r<16;r+=4){a=max3f(a,p0[r],p0[r+1]);b=max3f(b,p0[r+2],p0[r+3]);a=max3f(a,p1[r],p1[r+1]);b=max3f(b,p1[r+2],p1[r+3]);}
  const float m=max2f(a,b);
  auto rr=__builtin_amdgcn_permlane32_swap(__float_as_uint(m),__float_as_uint(m),false,false);
  return max2f(__uint_as_float(rr[0]),__uint_as_float(rr[1]));
}
__device__ __forceinline__ void pv(f32x16*o,int vb,bf16x8 pa0,bf16x8 pa1,bf16x8 pa2,bf16x8 pa3){
  #pragma unroll
  for(int d0=0;d0<2;++d0){s16x4 lo[4],hi[4];
    #pragma unroll
    for(int ks=0;ks<4;++ks){
      asm volatile("ds_read_b64_tr_b16 %0,%1 offset:%c2":"=&v"(lo[ks]):"v"(vb),"i"(d0*4096+ks*1024):"memory");
      asm volatile("ds_read_b64_tr_b16 %0,%1 offset:%c2":"=&v"(hi[ks]):"v"(vb),"i"(d0*4096+ks*1024+512):"memory");}
    asm volatile("s_waitcnt lgkmcnt(0)":::"memory");SBAR();
    #define PK(k) (bf16x8){lo[k][0],lo[k][1],lo[k][2],lo[k][3],hi[k][0],hi[k][1],hi[k][2],hi[k][3]}
    o[d0]=__builtin_amdgcn_mfma_f32_32x32x16_bf16(pa0,PK(0),o[d0],0,0,0);
    o[d0]=__builtin_amdgcn_mfma_f32_32x32x16_bf16(pa1,PK(1),o[d0],0,0,0);
    o[d0]=__builtin_amdgcn_mfma_f32_32x32x16_bf16(pa2,PK(2),o[d0],0,0,0);
    o[d0]=__builtin_amdgcn_mfma_f32_32x32x16_bf16(pa3,PK(3),o[d0],0,0,0);
    #undef PK
  }
}
template<int W> __device__ __forceinline__ void wmask(f32x16&p0,f32x16&p1,int d,float NEG){
  asm volatile("":"+v"(d));
  #pragma unroll
  for(int r=0;r<16;++r){const int c=(r&3)+8*(r>>2);
    if(W==0x7fffffff){ if(d<c)p0[r]=NEG; if(d<c+32)p1[r]=NEG; }
    else{ if((unsigned)(d-c)>(unsigned)W)p0[r]=NEG; if((unsigned)(d-c-32)>(unsigned)W)p1[r]=NEG; } }
}
struct UnitDesc {
  const bf16* Q; long qs;
  const bf16* K; long ks;
  const bf16* V; long vs;
  bf16* O; long os;
  float* lse; long lses;
  int NT;
  int rel0;
  int tg0;
  int q0;
  float slope2;
  float sink2;
  int fin;
  float lam, lam1;
  const float* sg; bf16* Of;
};
template<int MODE,int THRL,int DIL,int OS> __device__ __forceinline__ void attn_unit(const UnitDesc&u,char*shm){
  constexpr int W=(MODE==0)?0x7fffffff:(MODE==1?128:127);
  const float NEG=(MODE==0)?-INFINITY:-1024.f;
  int tid=threadIdx.x; asm volatile("":"+v"(tid));
  const int lane=tid&63,r32=lane&31,hi=lane>>5; const int wid=__builtin_amdgcn_readfirstlane(tid>>6);
  constexpr long qs=64L*DIL,ks=64L*DIL,vs=64L*DIL;
  const bf16*Qw=u.Q+(long)(wid*QBLK)*qs;
  const unsigned lds0=(unsigned)(uintptr_t)shm;
  __attribute__((address_space(3))) float*wsf=(__attribute__((address_space(3))) float*)((__attribute__((address_space(3))) char*)shm+LDS_WS)+wid*64;
  const unsigned ksoff=(unsigned)(((long)(8*wid+(lane>>3))*ks+(((lane&7)^(lane>>3))*8))*2);
  const unsigned vsoff=(unsigned)(((long)(16*(wid&3)+(lane>>2))*vs+(wid>>2)*32+(lane&3)*8)*2);
  const unsigned kdst=lds0+LDS_K+wid*1024, vdst=lds0+LDS_V+wid*1024;
  #define DMA_K(t,slot) glds16(u.K+(long)(t)*KVBLK*ks,ksoff,(unsigned)__builtin_amdgcn_readfirstlane(kdst+(slot)))
  #define DMA_V(t,slot) glds16(u.V+(long)(t)*KVBLK*vs,vsoff,(unsigned)__builtin_amdgcn_readfirstlane(vdst+(slot)))
  bf16x8 kf[8];
  const lds_cptr shm3=(lds_cptr)shm; const lds_cptr kp0=shm3+LDS_K+r32*128+((hi^(r32&1))*16); const int kbo=((r32>>1)&3)<<5; const lds_cptr vp0=shm3+LDS_V+((lane>>4)&1)*32+(lane&3)*8+(4*hi+((lane&15)>>2))*64;
  const int NT=u.NT;
  if(MODE==0){DMA_K(0,0);DMA_V(0,0);DMA_K(1,SLOTB);} else {DMA_K(0,0);}
  bf16x8 qr[4];
  #pragma unroll
  for(int d0=0;d0<4;++d0)qr[d0]=*reinterpret_cast<const bf16x8*>(&Qw[(long)r32*qs+d0*16+hi*8]);
  const unsigned s2hb=__float_as_uint(u.slope2)&0xffff0000u; const float s2hf=__uint_as_float(s2hb);
  const unsigned s2lb=__float_as_uint(u.slope2-s2hf)&0xffff0000u; const float s2used=s2hf+__uint_as_float(s2lb);
  u32x4 qx; qx[0]=hi?0u:((__float_as_uint(64.f*s2hf)>>16)|(__float_as_uint(64.f*__uint_as_float(s2lb))&0xffff0000u)); qx[1]=hi?0u:((s2hb>>16)|s2lb); qx[2]=0u; qx[3]=0u;
  u32x4 kx0; unsigned jp0,jp1; { const unsigned j0=__float_as_uint((float)r32)>>16, j1=__float_as_uint((float)(r32+32))>>16; jp0=j0|(j0<<16); jp1=j1|(j1<<16);
    kx0[0]=0u; kx0[1]=jp0; kx0[2]=0x3f803f80u; kx0[3]=0u; }
  #define SETTG(t) do{ const unsigned tb_=__float_as_uint((float)(u.tg0+(t)))>>16; kx0[0]=(tb_|(tb_<<16)); }while(0)
  #define KX0 __builtin_bit_cast(bf16x8,kx0)
  #define QX __builtin_bit_cast(bf16x8,qx)
  #define SETREF(m_) do{ const unsigned hb_=__float_as_uint(m_)&0xffff0000u; const float hf_=__uint_as_float(hb_); const unsigned lb_=__float_as_uint((m_)-hf_)&0xffff0000u; \
      mhat=hf_+__uint_as_float(lb_); qx[2]=hi?0u:(((hb_^0x80000000u)>>16)|(lb_^0x80000000u)); }while(0)
  float mhat=0.f,l_reg=0.f;f32x16 o[2];o[0]=f32x16{};o[1]=f32x16{};
  const int qrel=u.rel0+wid*QBLK+r32-4*hi;
  #define CMASK(P0,P1,t) do{ if(MODE!=0||(t)>=NT-4) wmask<W>(P0,P1,qrel-64*(t),NEG); }while(0)
  bool resc=false;
  f32x16 pA0,pA1,pB0,pB1;
  int sl_prev=0,sl_cur=0,sl_next=SLOTB;
  #define ROT() do{sl_prev=sl_cur;sl_cur=sl_next;sl_next=(sl_next==(NSLOT-1)*SLOTB)?0:sl_next+SLOTB;}while(0)
  #define RESC() do{ if(resc){ asm volatile("s_waitcnt lgkmcnt(0)":::"memory"); \
      _Pragma("unroll") for(int d_=0;d_<2;++d_) _Pragma("unroll") for(int r=0;r<16;++r)o[d_][r]*=wsf[crow(r,hi)]; } }while(0)
  if(MODE==0){ DMA_K(2,2*SLOTB); WAIT_BAR(3); }
  else{ DMA_K(1,SLOTB);DMA_V(0,0);DMA_K(2,2*SLOTB);DMA_V(1,SLOTB);DMA_K(3,3*SLOTB);DMA_V(2,2*SLOTB);DMA_V(3,3*SLOTB);
    if(NT>4){DMA_K(4,4*SLOTB);DMA_K(5,5*SLOTB);DMA_V(4,4*SLOTB);DMA_V(5,5*SLOTB);}
    WAIT_BAR(0); }
  { SETTG(0); const f32x16 z=f32x16{}; const lds_cptr kb=kp0;
    #pragma unroll
    for(int d0=0;d0<4;++d0){
      const bf16x8 b0=*(const __attribute__((address_space(3))) bf16x8*)(kb+((d0*32)^kbo));
      const bf16x8 b1=*(const __attribute__((address_space(3))) bf16x8*)(kb+((d0*32)^kbo)+4096);
      if(d0==0){pA0=__builtin_amdgcn_mfma_f32_32x32x16_bf16(b0,qr[0],z,0,0,0);pA1=__builtin_amdgcn_mfma_f32_32x32x16_bf16(b1,qr[0],z,0,0,0);}
      else{pA0=__builtin_amdgcn_mfma_f32_32x32x16_bf16(b0,qr[d0],pA0,0,0,0);pA1=__builtin_amdgcn_mfma_f32_32x32x16_bf16(b1,qr[d0],pA1,0,0,0);}}
    pA0=__builtin_amdgcn_mfma_f32_32x32x16_bf16(KX0,QX,pA0,0,0,0); kx0[1]=jp1; pA1=__builtin_amdgcn_mfma_f32_32x32x16_bf16(KX0,QX,pA1,0,0,0); kx0[1]=jp0; }
  asm volatile("s_nop 15\n\ts_nop 7":"+v"(pA0),"+v"(pA1));CMASK(pA0,pA1,0);
  { const float rm=rowmax(pA0,pA1); SETREF(rm); const float dl=mhat;
    _Pragma("unroll") for(int r=0;r<16;++r){pA0[r]=fsub_s(pA0[r],dl);pA1[r]=fsub_s(pA1[r],dl);}
    _Pragma("unroll") for(int r=0;r<16;++r)pA0[r]=__builtin_amdgcn_exp2f(pA0[r]); }
  _Pragma("unroll") for(int r=0;r<16;++r)pA1[r]=__builtin_amdgcn_exp2f(pA1[r]);
  if(MODE==0){ WAIT_BAR(0); DMA_K(3,0);DMA_V(1,SLOTB); }
  ROT();
  kload8(kf,kp0+sl_cur,kbo);
  if(MODE==0){ WAIT_BAR(2); }
  s16x4 vlo[8],vhi[8]; u32x4 pw0,pw1,pw2,pw3;
  #define PKW(P,B) cvtpk_s(P[B],P[B+1])
  #define PAF(k) __builtin_bit_cast(bf16x8,pw##k)
  #define VFR(i) (bf16x8){vlo[i][0],vlo[i][1],vlo[i][2],vlo[i][3],vhi[i][0],vhi[i][1],vhi[i][2],vhi[i][3]}
  #define PIN(x) asm volatile("":"+v"(x))
  #define MX3(a,b,c) __builtin_fmaxf(__builtin_fmaxf((a),(b)),(c))
  #define GAPA(MF,A0,A1,A2,A3,W0,W1,PW) do{ MF; sacc+=A0; sacc+=A1; sacc+=A2; sacc+=A3; PIN(sacc); W0; W1; PIN(PW); SBAR(); }while(0)
  #define EX(v) __builtin_amdgcn_exp2f(v)
  #define GAPB(MF,X,B) do{ MF; X[B]=EX(X[B]); X[B+1]=EX(X[B+1]); X[B+2]=EX(X[B+2]); X[B+3]=EX(X[B+3]); PIN(X); SBAR(); }while(0)
  #define VRD(i) do{ vlo[i]=vtr(vp_+(((i)>>2)*4096+((i)&3)*1024)); vhi[i]=vtr(vp_+(((i)>>2)*4096+((i)&3)*1024+512)); }while(0)
  #define KRD(G,j) do{ if(G){ kload2(kf,kp0+sl_next,j,kbo); SBAR(); } }while(0)
  #define STEP(C0,C1,P0,P1,t,GK,GV,GL) do{ SBAR(); SETTG(t); const f32x16 z_=f32x16{}; \
    const lds_cptr vp_=vp0+sl_prev; \
    VRD(0); SBAR(); float sacc=(P0[0]+P0[1]); \
    GAPA(C0=__builtin_amdgcn_mfma_f32_32x32x16_bf16(kf[0],qr[0],z_,0,0,0), P0[2],P0[3],P0[4],P0[5],     pw0[0]=PKW(P0,0), pw0[1]=PKW(P0,2), pw0); \
    VRD(4); SBAR(); GAPA(C1=__builtin_amdgcn_mfma_f32_32x32x16_bf16(kf[1],qr[0],z_,0,0,0), P0[6],P0[7],P0[8],P0[9],     pw0[2]=PKW(P0,4), pw0[3]=PKW(P0,6), pw0); \
    VRD(1); SBAR(); GAPA(C0=__builtin_amdgcn_mfma_f32_32x32x16_bf16(kf[2],qr[1],C0,0,0,0),   P0[10],P0[11],P0[12],P0[13], pw1[0]=PKW(P0,8), pw1[1]=PKW(P0,10), pw1); \
    VRD(5); SBAR(); GAPA(C1=__builtin_amdgcn_mfma_f32_32x32x16_bf16(kf[3],qr[1],C1,0,0,0),   P0[14],P0[15],P1[0],P1[1],   pw1[2]=PKW(P0,12),pw1[3]=PKW(P0,14), pw1); \
    VRD(2); SBAR(); GAPA(C0=__builtin_amdgcn_mfma_f32_32x32x16_bf16(kf[4],qr[2],C0,0,0,0),   P1[2],P1[3],P1[4],P1[5],     pw2[0]=PKW(P1,0), pw2[1]=PKW(P1,2), pw2); \
    VRD(6); SBAR(); GAPA(C1=__builtin_amdgcn_mfma_f32_32x32x16_bf16(kf[5],qr[2],C1,0,0,0),   P1[6],P1[7],P1[8],P1[9],     pw2[2]=PKW(P1,4), pw2[3]=PKW(P1,6), pw2); \
    VRD(3); SBAR(); GAPA(C0=__builtin_amdgcn_mfma_f32_32x32x16_bf16(kf[6],qr[3],C0,0,0,0),   P1[10],P1[11],P1[12],P1[13], pw3[0]=PKW(P1,8), pw3[1]=PKW(P1,10), pw3); \
    VRD(7); SBAR(); GAPA(C1=__builtin_amdgcn_mfma_f32_32x32x16_bf16(kf[7],qr[3],C1,0,0,0),   P1[14],P1[15],0.f,0.f,       pw3[2]=PKW(P1,12),pw3[3]=PKW(P1,14), pw3); \
    C0=__builtin_amdgcn_mfma_f32_32x32x16_bf16(KX0,QX,C0,0,0,0); kx0[1]=jp1; C1=__builtin_amdgcn_mfma_f32_32x32x16_bf16(KX0,QX,C1,0,0,0); kx0[1]=jp0; SBAR(); \
    l_reg+=sacc; \
    if(GK){DMA_K((t)+3,sl_cur);} if(GV){DMA_V((t)+1,sl_next);} \
    CMASK(C0,C1,t); \
    { float a=MX3(C0[0],C0[1],C1[0]),b=MX3(C0[2],C0[3],C1[1]); a=MX3(a,C1[2],C1[3]); \
      _Pragma("unroll") for(int r=4;r<16;r+=4){a=MX3(a,C0[r],C0[r+1]);b=MX3(b,C0[r+2],C0[r+3]);a=MX3(a,C1[r],C1[r+1]);b=MX3(b,C1[r+2],C1[r+3]);} \
      float rm=__builtin_fmaxf(a,b); { auto rr=__builtin_amdgcn_permlane32_swap(__float_as_uint(rm),__float_as_uint(rm),false,false); rm=__builtin_fmaxf(__uint_as_float(rr[0]),__uint_as_float(rr[1])); } \
      resc=false; \
      if(__builtin_expect(__any(rm>(float)THRL),0)){ const float mold=mhat; const float mnew=mold+__builtin_fmaxf(rm,0.f); SETREF(mnew); const float dl=mhat-mold; \
        _Pragma("unroll") for(int r=0;r<16;++r){C0[r]-=dl;C1[r]-=dl;} \
        const float f=__builtin_amdgcn_exp2f(-dl); l_reg*=f; if(hi==0)wsf[r32]=f; resc=true; } } \
    SBAR(); \
    GAPB(o[0]=__builtin_amdgcn_mfma_f32_32x32x16_bf16(PAF(0),VFR(0),o[0],0,0,0), C0,0); \
    GAPB(o[1]=__builtin_amdgcn_mfma_f32_32x32x16_bf16(PAF(0),VFR(4),o[1],0,0,0), C0,4); \
    KRD(GL,0); GAPB(o[0]=__builtin_amdgcn_mfma_f32_32x32x16_bf16(PAF(1),VFR(1),o[0],0,0,0), C0,8); \
    KRD(GL,1); GAPB(o[1]=__builtin_amdgcn_mfma_f32_32x32x16_bf16(PAF(1),VFR(5),o[1],0,0,0), C0,12); \
    KRD(GL,2); GAPB(o[0]=__builtin_amdgcn_mfma_f32_32x32x16_bf16(PAF(2),VFR(2),o[0],0,0,0), C1,0); \
    KRD(GL,3); GAPB(o[1]=__builtin_amdgcn_mfma_f32_32x32x16_bf16(PAF(2),VFR(6),o[1],0,0,0), C1,4); \
    GAPB(o[0]=__builtin_amdgcn_mfma_f32_32x32x16_bf16(PAF(3),VFR(3),o[0],0,0,0), C1,8); \
    GAPB(o[1]=__builtin_amdgcn_mfma_f32_32x32x16_bf16(PAF(3),VFR(7),o[1],0,0,0), C1,12); \
    }while(0)
  int t=1;
  if(MODE==0){
    #undef CMASK
    #define CMASK(P0,P1,t) do{}while(0)
    for(;t+5<NT;t+=2){
      STEP(pB0,pB1,pA0,pA1,t,true,true,true);     WAIT_BAR(2); RESC(); ROT();
      STEP(pA0,pA1,pB0,pB1,t+1,true,true,true);   WAIT_BAR(2); RESC(); ROT();
    }
    #undef CMASK
    #define CMASK(P0,P1,t) do{ if(MODE!=0||(t)>=NT-4) wmask<W>(P0,P1,qrel-64*(t),NEG); }while(0)
  }
  #define ENDW(tt) do{ if(MODE==0){ if((tt)+3<NT){WAIT_BAR(2);} else if((tt)+2<NT){WAIT_BAR(1);} else {WAIT_BAR(0);} } }while(0)
  for(;t+1<NT;t+=2){
    STEP(pB0,pB1,pA0,pA1,t,(MODE==0&&t+3<NT),(MODE==0&&t+1<NT),(t+1<NT));       ENDW(t);   RESC(); ROT();
    STEP(pA0,pA1,pB0,pB1,t+1,(MODE==0&&t+4<NT),(MODE==0&&t+2<NT),(t+2<NT));     ENDW(t+1); RESC(); ROT();
  }
  STEP(pB0,pB1,pA0,pA1,NT-1,false,false,false); RESC();
  { float sacc=pB0[0]+pB0[1]; _Pragma("unroll") for(int r=2;r<16;++r)sacc+=pB0[r]; _Pragma("unroll") for(int r=0;r<16;++r)sacc+=pB1[r]; l_reg+=sacc;
    pw0=(u32x4){PKW(pB0,0),PKW(pB0,2),PKW(pB0,4),PKW(pB0,6)};pw1=(u32x4){PKW(pB0,8),PKW(pB0,10),PKW(pB0,12),PKW(pB0,14)};pw2=(u32x4){PKW(pB1,0),PKW(pB1,2),PKW(pB1,4),PKW(pB1,6)};pw3=(u32x4){PKW(pB1,8),PKW(pB1,10),PKW(pB1,12),PKW(pB1,14)};
    SBAR(); pv(o,(int)(lds0+LDS_V)+((lane>>4)&1)*32+(lane&3)*8+(4*hi+((lane&15)>>2))*64+sl_cur,PAF(0),PAF(1),PAF(2),PAF(3)); }
  #undef PKW
  #undef PAF
  #undef VFR
  #undef PIN
  #undef MX3
  #undef GAPA
  #undef GAPB
  #undef EX
  #undef VRD
  #undef KRD
  #undef STEP
  #undef ENDW
  {auto rr=__builtin_amdgcn_permlane32_swap(__float_as_uint(l_reg),__float_as_uint(l_reg),false,false);l_reg=__uint_as_float(rr[0])+__uint_as_float(rr[1]);}
  const float qposf=(float)(u.q0+wid*QBLK+r32);
  if(MODE==2) l_reg+=__builtin_amdgcn_exp2f(u.sink2+s2used*qposf-mhat);
  if(MODE==1){ if(hi==0) u.lse[(long)(wid*QBLK+r32)*(16*DIL)]=mhat-s2used*qposf+__builtin_amdgcn_logf(l_reg); }
  if(hi==0)wsf[32+r32]=l_reg;asm volatile("s_waitcnt lgkmcnt(0)":::"memory");
  float rli[16];
  #pragma unroll
  for(int r=0;r<16;++r)rli[r]=__builtin_amdgcn_rcpf(wsf[32+crow(r,hi)]);
  bf16*Ow=u.O+(long)(wid*QBLK)*OS;
  { int le=lane; asm volatile("":"+v"(le));
    const int r32e=le&31,hie=le>>5;
    __hip_bfloat16*stg=(__hip_bfloat16*)(shm+LDS_OST)+wid*2048;
    #pragma unroll
    for(int r=0;r<16;++r){const int orow=crow(r,hie);
      #pragma unroll
      for(int d0=0;d0<2;++d0)stg[orow*64+d0*32+r32e]=__float2bfloat16(o[d0][r]*rli[r]);}
    asm volatile("s_waitcnt lgkmcnt(0)":::"memory");
    #pragma unroll
    for(int i=0;i<4;++i){const int row=i*8+(le>>3),ch=le&7; const u32x4 v=*(const u32x4*)(stg+row*64+ch*8); *(u32x4*)(Ow+(long)row*OS+ch*8)=v;} }
  asm volatile("s_waitcnt lgkmcnt(0)\n\ts_barrier":::"memory");
  #undef DMA_K
  #undef DMA_V
  #undef CMASK
  #undef RESC
  #undef ROT
  #undef SETTG
  #undef SETREF
  #undef KX0
  #undef QX
}
#undef SBAR
#undef WAIT_BAR
}

namespace att128 {
using att::UnitDesc; using att::crow; using att::glds16; using att::max3f; using att::max2f; using att::fsub_s; using att::cvtpk_s; using att::kload8; using att::kload2; using att::vtr; using att::rowmax; using att::wmask; using att::lds_cptr;
using bf16=unsigned short;
using bf16x8=__attribute__((ext_vector_type(8)))short;
using s16x4=__attribute__((ext_vector_type(4)))short;
using f32x16=__attribute__((ext_vector_type(16)))float;
using u32x4=__attribute__((ext_vector_type(4)))unsigned;
constexpr int NW=8,QBLK=32,QB=QBLK*NW,KVBLK=64;
#define SBAR() __builtin_amdgcn_sched_barrier(0)
constexpr int NSLOT=3, SLOTB=8192, SLOTV=16384;
constexpr int LDS_K=0, LDS_V=NSLOT*SLOTB, LDS_WS=LDS_V+NSLOT*SLOTV, LDS_OST=LDS_WS+NW*64*4, LDS_BYTES=LDS_OST+NW*8192;
#define WAIT_BAR(N) asm volatile("s_waitcnt vmcnt(" #N ") lgkmcnt(0)\n\ts_barrier":::"memory")
__device__ __forceinline__ void pv4(f32x16*o,int vb,bf16x8 pa0,bf16x8 pa1,bf16x8 pa2,bf16x8 pa3){
  #pragma unroll
  for(int d0=0;d0<4;++d0){s16x4 lo[4],hi[4];
    #pragma unroll
    for(int ks=0;ks<4;++ks){
      asm volatile("ds_read_b64_tr_b16 %0,%1 offset:%c2":"=&v"(lo[ks]):"v"(vb),"i"(d0*4096+ks*1024):"memory");
      asm volatile("ds_read_b64_tr_b16 %0,%1 offset:%c2":"=&v"(hi[ks]):"v"(vb),"i"(d0*4096+ks*1024+512):"memory");}
    asm volatile("s_waitcnt lgkmcnt(0)":::"memory");SBAR();
    #define PK(k) (bf16x8){lo[k][0],lo[k][1],lo[k][2],lo[k][3],hi[k][0],hi[k][1],hi[k][2],hi[k][3]}
    o[d0]=__builtin_amdgcn_mfma_f32_32x32x16_bf16(pa0,PK(0),o[d0],0,0,0);
    o[d0]=__builtin_amdgcn_mfma_f32_32x32x16_bf16(pa1,PK(1),o[d0],0,0,0);
    o[d0]=__builtin_amdgcn_mfma_f32_32x32x16_bf16(pa2,PK(2),o[d0],0,0,0);
    o[d0]=__builtin_amdgcn_mfma_f32_32x32x16_bf16(pa3,PK(3),o[d0],0,0,0);
    #undef PK
  }
}
template<int MODE,int THRL,int DIL,int OS> __device__ __forceinline__ void attn_unit(const UnitDesc&u,char*shm){
  static_assert(MODE==0,"att128: causal mode only");
  constexpr int W=(MODE==0)?0x7fffffff:(MODE==1?128:127);
  const float NEG=(MODE==0)?-INFINITY:-1024.f;
  int tid=threadIdx.x; asm volatile("":"+v"(tid));
  const int lane=tid&63,r32=lane&31,hi=lane>>5; const int wid=__builtin_amdgcn_readfirstlane(tid>>6);
  constexpr long qs=64L*DIL,ks=64L*DIL,vs=64L*DIL;
  const bf16*Qw=u.Q+(long)(wid*QBLK)*qs;
  const unsigned lds0=(unsigned)(uintptr_t)shm;
  __attribute__((address_space(3))) float*wsf=(__attribute__((address_space(3))) float*)((__attribute__((address_space(3))) char*)shm+LDS_WS)+wid*64;
  const unsigned ksoff=(unsigned)(((long)(8*wid+(lane>>3))*ks+(((lane&7)^(lane>>3))*8))*2);
  const unsigned vsoff=(unsigned)(((long)(16*(wid&3)+(lane>>2))*vs+(wid>>2)*32+(lane&3)*8)*2);
  const unsigned kdst=lds0+LDS_K+wid*1024, vdst=lds0+LDS_V+wid*1024;
  #define DMA_K(t,slot) glds16(u.K+(long)(t)*KVBLK*ks,ksoff,(unsigned)__builtin_amdgcn_readfirstlane(kdst+(slot)))
  #define DMA_V(t,slot) do{ glds16(u.V+(long)(t)*KVBLK*vs,vsoff,(unsigned)__builtin_amdgcn_readfirstlane(vdst+2*(slot))); glds16(u.V+(long)(t)*KVBLK*vs+64*(long)M,vsoff,(unsigned)__builtin_amdgcn_readfirstlane(vdst+2*(slot)+8192)); }while(0)
  bf16x8 kf[8];
  const lds_cptr shm3=(lds_cptr)shm; const lds_cptr kp0=shm3+LDS_K+r32*128+((hi^(r32&1))*16); const int kbo=((r32>>1)&3)<<5; const lds_cptr vp0=shm3+LDS_V+((lane>>4)&1)*32+(lane&3)*8+(4*hi+((lane&15)>>2))*64;
  const int NT=u.NT;
  DMA_K(0,0);DMA_V(0,0);DMA_K(1,SLOTB);
  bf16x8 qr[4];
  #pragma unroll
  for(int d0=0;d0<4;++d0)qr[d0]=*reinterpret_cast<const bf16x8*>(&Qw[(long)r32*qs+d0*16+hi*8]);
  const unsigned s2hb=__float_as_uint(u.slope2)&0xffff0000u; const float s2hf=__uint_as_float(s2hb);
  const unsigned s2lb=__float_as_uint(u.slope2-s2hf)&0xffff0000u; const float s2used=s2hf+__uint_as_float(s2lb);
  u32x4 qx; qx[0]=hi?0u:((__float_as_uint(64.f*s2hf)>>16)|(__float_as_uint(64.f*__uint_as_float(s2lb))&0xffff0000u)); qx[1]=hi?0u:((s2hb>>16)|s2lb); qx[2]=0u; qx[3]=0u;
  u32x4 kx0; unsigned jp0,jp1; { const unsigned j0=__float_as_uint((float)r32)>>16, j1=__float_as_uint((float)(r32+32))>>16; jp0=j0|(j0<<16); jp1=j1|(j1<<16);
    kx0[0]=0u; kx0[1]=jp0; kx0[2]=0x3f803f80u; kx0[3]=0u; }
  #define SETTG(t) do{ const unsigned tb_=__float_as_uint((float)(u.tg0+(t)))>>16; kx0[0]=(tb_|(tb_<<16)); }while(0)
  #define KX0 __builtin_bit_cast(bf16x8,kx0)
  #define QX __builtin_bit_cast(bf16x8,qx)
  #define SETREF(m_) do{ const unsigned hb_=__float_as_uint(m_)&0xffff0000u; const float hf_=__uint_as_float(hb_); const unsigned lb_=__float_as_uint((m_)-hf_)&0xffff0000u; \
      mhat=hf_+__uint_as_float(lb_); qx[2]=hi?0u:(((hb_^0x80000000u)>>16)|(lb_^0x80000000u)); }while(0)
  float mhat=0.f,l_reg=0.f;f32x16 o[4];o[0]=f32x16{};o[1]=f32x16{};o[2]=f32x16{};o[3]=f32x16{};
  const int qrel=u.rel0+wid*QBLK+r32-4*hi;
  #define CMASK(P0,P1,t) do{ if(MODE!=0||(t)>=NT-4) wmask<W>(P0,P1,qrel-64*(t),NEG); }while(0)
  bool resc=false;
  f32x16 pA0,pA1,pB0,pB1;
  int sl_prev=0,sl_cur=0,sl_next=SLOTB;
  #define ROT() do{sl_prev=sl_cur;sl_cur=sl_next;sl_next=(sl_next==(NSLOT-1)*SLOTB)?0:sl_next+SLOTB;}while(0)
  #define RESC() do{ if(resc){ asm volatile("s_waitcnt lgkmcnt(0)":::"memory"); \
      _Pragma("unroll") for(int d_=0;d_<4;++d_) _Pragma("unroll") for(int r=0;r<16;++r)o[d_][r]*=wsf[crow(r,hi)]; } }while(0)
  DMA_K(2,2*SLOTB);
  WAIT_BAR(4);
  { SETTG(0); const f32x16 z=f32x16{}; const lds_cptr kb=kp0;
    #pragma unroll
    for(int d0=0;d0<4;++d0){
      const bf16x8 b0=*(const __attribute__((address_space(3))) bf16x8*)(kb+((d0*32)^kbo));
      const bf16x8 b1=*(const __attribute__((address_space(3))) bf16x8*)(kb+((d0*32)^kbo)+4096);
      if(d0==0){pA0=__builtin_amdgcn_mfma_f32_32x32x16_bf16(b0,qr[0],z,0,0,0);pA1=__builtin_amdgcn_mfma_f32_32x32x16_bf16(b1,qr[0],z,0,0,0);}
      else{pA0=__builtin_amdgcn_mfma_f32_32x32x16_bf16(b0,qr[d0],pA0,0,0,0);pA1=__builtin_amdgcn_mfma_f32_32x32x16_bf16(b1,qr[d0],pA1,0,0,0);}}
    pA0=__builtin_amdgcn_mfma_f32_32x32x16_bf16(KX0,QX,pA0,0,0,0); kx0[1]=jp1; pA1=__builtin_amdgcn_mfma_f32_32x32x16_bf16(KX0,QX,pA1,0,0,0); kx0[1]=jp0; }
  asm volatile("s_nop 15\n\ts_nop 7":"+v"(pA0),"+v"(pA1));CMASK(pA0,pA1,0);
  { const float rm=rowmax(pA0,pA1); SETREF(rm); const float dl=mhat;
    _Pragma("unroll") for(int r=0;r<16;++r){pA0[r]=fsub_s(pA0[r],dl);pA1[r]=fsub_s(pA1[r],dl);}
    _Pragma("unroll") for(int r=0;r<16;++r)pA0[r]=__builtin_amdgcn_exp2f(pA0[r]); }
  _Pragma("unroll") for(int r=0;r<16;++r)pA1[r]=__builtin_amdgcn_exp2f(pA1[r]);
  WAIT_BAR(0);
  DMA_K(3,0);DMA_V(1,SLOTB);
  ROT();
  kload8(kf,kp0+sl_cur,kbo);
  WAIT_BAR(3);
  s16x4 vlo[3],vhi[3]; u32x4 pw0,pw1,pw2,pw3;
  #define PKW(P,B) cvtpk_s(P[B],P[B+1])
  #define PAF(k) __builtin_bit_cast(bf16x8,pw##k)
  #define VFJ(b) (bf16x8){vlo[b][0],vlo[b][1],vlo[b][2],vlo[b][3],vhi[b][0],vhi[b][1],vhi[b][2],vhi[b][3]}
  #define PIN(x) asm volatile("":"+v"(x))
  #define MX3(a,b,c) __builtin_fmaxf(__builtin_fmaxf((a),(b)),(c))
  #define GAPA(MF,A0,A1,A2,A3,W0,W1,PW) do{ MF; sacc+=A0; sacc+=A1; sacc+=A2; sacc+=A3; PIN(sacc); W0; W1; PIN(PW); SBAR(); }while(0)
  #define EX(v) __builtin_amdgcn_exp2f(v)
  #define GAPB2(MF,X,B) do{ MF; X[B]=EX(X[B]); X[B+1]=EX(X[B+1]); PIN(X); SBAR(); }while(0)
  #define VRJ(b,n) do{ vlo[b]=vtr(vp_+(((n)&3)*4096+((n)>>2)*1024)); vhi[b]=vtr(vp_+(((n)&3)*4096+((n)>>2)*1024+512)); SBAR(); }while(0)
  #define KRD(G,j) do{ if(G){ kload2(kf,kp0+sl_next,j,kbo); SBAR(); } }while(0)
  #define STEP(C0,C1,P0,P1,t,GK,GV,GL) do{ SBAR(); SETTG(t); const f32x16 z_=f32x16{}; \
    const lds_cptr vp_=vp0+2*sl_prev; \
    float sacc=(P0[0]+P0[1]); \
    GAPA(C0=__builtin_amdgcn_mfma_f32_32x32x16_bf16(kf[0],qr[0],z_,0,0,0), P0[2],P0[3],P0[4],P0[5],     pw0[0]=PKW(P0,0), pw0[1]=PKW(P0,2), pw0); \
    GAPA(C1=__builtin_amdgcn_mfma_f32_32x32x16_bf16(kf[1],qr[0],z_,0,0,0), P0[6],P0[7],P0[8],P0[9],     pw0[2]=PKW(P0,4), pw0[3]=PKW(P0,6), pw0); \
    GAPA(C0=__builtin_amdgcn_mfma_f32_32x32x16_bf16(kf[2],qr[1],C0,0,0,0),   P0[10],P0[11],P0[12],P0[13], pw1[0]=PKW(P0,8), pw1[1]=PKW(P0,10), pw1); \
    GAPA(C1=__builtin_amdgcn_mfma_f32_32x32x16_bf16(kf[3],qr[1],C1,0,0,0),   P0[14],P0[15],P1[0],P1[1],   pw1[2]=PKW(P0,12),pw1[3]=PKW(P0,14), pw1); \
    GAPA(C0=__builtin_amdgcn_mfma_f32_32x32x16_bf16(kf[4],qr[2],C0,0,0,0),   P1[2],P1[3],P1[4],P1[5],     pw2[0]=PKW(P1,0), pw2[1]=PKW(P1,2), pw2); \
    GAPA(C1=__builtin_amdgcn_mfma_f32_32x32x16_bf16(kf[5],qr[2],C1,0,0,0),   P1[6],P1[7],P1[8],P1[9],     pw2[2]=PKW(P1,4), pw2[3]=PKW(P1,6), pw2); \
    VRJ(0,0); GAPA(C0=__builtin_amdgcn_mfma_f32_32x32x16_bf16(kf[6],qr[3],C0,0,0,0),   P1[10],P1[11],P1[12],P1[13], pw3[0]=PKW(P1,8), pw3[1]=PKW(P1,10), pw3); \
    VRJ(1,1); GAPA(C1=__builtin_amdgcn_mfma_f32_32x32x16_bf16(kf[7],qr[3],C1,0,0,0),   P1[14],P1[15],0.f,0.f,       pw3[2]=PKW(P1,12),pw3[3]=PKW(P1,14), pw3); \
    C0=__builtin_amdgcn_mfma_f32_32x32x16_bf16(KX0,QX,C0,0,0,0); kx0[1]=jp1; C1=__builtin_amdgcn_mfma_f32_32x32x16_bf16(KX0,QX,C1,0,0,0); kx0[1]=jp0; SBAR(); \
    l_reg+=sacc; \
    if(GK){DMA_K((t)+3,sl_cur);} if(GV){DMA_V((t)+1,sl_next);} \
    CMASK(C0,C1,t); \
    { float a=MX3(C0[0],C0[1],C1[0]),b=MX3(C0[2],C0[3],C1[1]); a=MX3(a,C1[2],C1[3]); \
      _Pragma("unroll") for(int r=4;r<16;r+=4){a=MX3(a,C0[r],C0[r+1]);b=MX3(b,C0[r+2],C0[r+3]);a=MX3(a,C1[r],C1[r+1]);b=MX3(b,C1[r+2],C1[r+3]);} \
      float rm=__builtin_fmaxf(a,b); { auto rr=__builtin_amdgcn_permlane32_swap(__float_as_uint(rm),__float_as_uint(rm),false,false); rm=__builtin_fmaxf(__uint_as_float(rr[0]),__uint_as_float(rr[1])); } \
      resc=false; \
      if(__builtin_expect(__any(rm>(float)THRL),0)){ const float mold=mhat; const float mnew=mold+__builtin_fmaxf(rm,0.f); SETREF(mnew); const float dl=mhat-mold; \
        _Pragma("unroll") for(int r=0;r<16;++r){C0[r]-=dl;C1[r]-=dl;} \
        const float f=__builtin_amdgcn_exp2f(-dl); l_reg*=f; if(hi==0)wsf[r32]=f; resc=true; } } \
    SBAR(); \
    VRJ(2,2);             GAPB2(o[0]=__builtin_amdgcn_mfma_f32_32x32x16_bf16(PAF(0),VFJ(0),o[0],0,0,0), C0,0); \
    VRJ(0,3);             GAPB2(o[1]=__builtin_amdgcn_mfma_f32_32x32x16_bf16(PAF(0),VFJ(1),o[1],0,0,0), C0,2); \
    VRJ(1,4);             GAPB2(o[2]=__builtin_amdgcn_mfma_f32_32x32x16_bf16(PAF(0),VFJ(2),o[2],0,0,0), C0,4); \
    VRJ(2,5);             GAPB2(o[3]=__builtin_amdgcn_mfma_f32_32x32x16_bf16(PAF(0),VFJ(0),o[3],0,0,0), C0,6); \
    VRJ(0,6);  KRD(GL,0); GAPB2(o[0]=__builtin_amdgcn_mfma_f32_32x32x16_bf16(PAF(1),VFJ(1),o[0],0,0,0), C0,8); \
    VRJ(1,7);             GAPB2(o[1]=__builtin_amdgcn_mfma_f32_32x32x16_bf16(PAF(1),VFJ(2),o[1],0,0,0), C0,10); \
    VRJ(2,8);  KRD(GL,1); GAPB2(o[2]=__builtin_amdgcn_mfma_f32_32x32x16_bf16(PAF(1),VFJ(0),o[2],0,0,0), C0,12); \
    VRJ(0,9);             GAPB2(o[3]=__builtin_amdgcn_mfma_f32_32x32x16_bf16(PAF(1),VFJ(1),o[3],0,0,0), C0,14); \
    VRJ(1,10); KRD(GL,2); GAPB2(o[0]=__builtin_amdgcn_mfma_f32_32x32x16_bf16(PAF(2),VFJ(2),o[0],0,0,0), C1,0); \
    VRJ(2,11);            GAPB2(o[1]=__builtin_amdgcn_mfma_f32_32x32x16_bf16(PAF(2),VFJ(0),o[1],0,0,0), C1,2); \
    VRJ(0,12); KRD(GL,3); GAPB2(o[2]=__builtin_amdgcn_mfma_f32_32x32x16_bf16(PAF(2),VFJ(1),o[2],0,0,0), C1,4); \
    VRJ(1,13);            GAPB2(o[3]=__builtin_amdgcn_mfma_f32_32x32x16_bf16(PAF(2),VFJ(2),o[3],0,0,0), C1,6); \
    VRJ(2,14);            GAPB2(o[0]=__builtin_amdgcn_mfma_f32_32x32x16_bf16(PAF(3),VFJ(0),o[0],0,0,0), C1,8); \
    VRJ(0,15);            GAPB2(o[1]=__builtin_amdgcn_mfma_f32_32x32x16_bf16(PAF(3),VFJ(1),o[1],0,0,0), C1,10); \
                          GAPB2(o[2]=__builtin_amdgcn_mfma_f32_32x32x16_bf16(PAF(3),VFJ(2),o[2],0,0,0), C1,12); \
                          GAPB2(o[3]=__builtin_amdgcn_mfma_f32_32x32x16_bf16(PAF(3),VFJ(0),o[3],0,0,0), C1,14); \
    }while(0)
  int t=1;
  if(MODE==0){
    #undef CMASK
    #define CMASK(P0,P1,t) do{}while(0)
    for(;t+5<NT;t+=2){
      STEP(pB0,pB1,pA0,pA1,t,true,true,true);     WAIT_BAR(3); RESC(); ROT();
      STEP(pA0,pA1,pB0,pB1,t+1,true,true,true);   WAIT_BAR(3); RESC(); ROT();
    }
    #undef CMASK
    #define CMASK(P0,P1,t) do{ if(MODE!=0||(t)>=NT-4) wmask<W>(P0,P1,qrel-64*(t),NEG); }while(0)
  }
  #define ENDW(tt) do{ if((tt)+3<NT){WAIT_BAR(3);} else if((tt)+2<NT){WAIT_BAR(2);} else {WAIT_BAR(0);} }while(0)
  for(;t+1<NT;t+=2){
    STEP(pB0,pB1,pA0,pA1,t,(t+3<NT),(t+1<NT),(t+1<NT));       ENDW(t);   RESC(); ROT();
    STEP(pA0,pA1,pB0,pB1,t+1,(t+4<NT),(t+2<NT),(t+2<NT));     ENDW(t+1); RESC(); ROT();
  }
  STEP(pB0,pB1,pA0,pA1,NT-1,false,false,false); RESC();
  { float sacc=pB0[0]+pB0[1]; _Pragma("unroll") for(int r=2;r<16;++r)sacc+=pB0[r]; _Pragma("unroll") for(int r=0;r<16;++r)sacc+=pB1[r]; l_reg+=sacc;
    pw0=(u32x4){PKW(pB0,0),PKW(pB0,2),PKW(pB0,4),PKW(pB0,6)};pw1=(u32x4){PKW(pB0,8),PKW(pB0,10),PKW(pB0,12),PKW(pB0,14)};pw2=(u32x4){PKW(pB1,0),PKW(pB1,2),PKW(pB1,4),PKW(pB1,6)};pw3=(u32x4){PKW(pB1,8),PKW(pB1,10),PKW(pB1,12),PKW(pB1,14)};
    SBAR(); pv4(o,(int)(lds0+LDS_V)+((lane>>4)&1)*32+(lane&3)*8+(4*hi+((lane&15)>>2))*64+2*sl_cur,PAF(0),PAF(1),PAF(2),PAF(3)); }
  #undef PKW
  #undef PAF
  #undef VFJ
  #undef PIN
  #undef MX3
  #undef GAPA
  #undef GAPB2
  #undef EX
  #undef VRJ
  #undef KRD
  #undef STEP
  #undef ENDW
  {auto rr=__builtin_amdgcn_permlane32_swap(__float_as_uint(l_reg),__float_as_uint(l_reg),false,false);l_reg=__uint_as_float(rr[0])+__uint_as_float(rr[1]);}
  const float qposf=(float)(u.q0+wid*QBLK+r32);
  if(MODE==2) l_reg+=__builtin_amdgcn_exp2f(u.sink2+s2used*qposf-mhat);
  if(MODE==1){ if(hi==0) u.lse[(long)(wid*QBLK+r32)*(16*DIL)]=mhat-s2used*qposf+__builtin_amdgcn_logf(l_reg); }
  if(hi==0)wsf[32+r32]=l_reg;asm volatile("s_waitcnt lgkmcnt(0)":::"memory");
  float rli[16];
  #pragma unroll
  for(int r=0;r<16;++r)rli[r]=__builtin_amdgcn_rcpf(wsf[32+crow(r,hi)]);
  { int le=lane; asm volatile("":"+v"(le));
    const int r32e=le&31,hie=le>>5;
    __hip_bfloat16*stg=(__hip_bfloat16*)(shm+LDS_OST)+wid*4096;
    if(u.fin==0){
      #pragma unroll
      for(int r=0;r<16;++r){const int orow=crow(r,hie);
        #pragma unroll
        for(int d0=0;d0<4;++d0)stg[orow*128+d0*32+r32e]=__float2bfloat16(o[d0][r]*rli[r]);}
    } else {
      const float lam=u.lam;
      #pragma unroll
      for(int r=0;r<16;++r){const int orow=crow(r,hie);
        #pragma unroll
        for(int d0=0;d0<4;++d0){ const int ix=orow*128+d0*32+r32e; const float o2=__bfloat162float(__float2bfloat16(o[d0][r]*rli[r])); stg[ix]=__float2bfloat16(__bfloat162float(stg[ix])-lam*o2); } }
      asm volatile("s_waitcnt lgkmcnt(0)":::"memory");
      const int ch=le&15; const float* sgp=u.sg+8*ch; const float g0=sgp[0],g1=sgp[1],g2=sgp[2],g3=sgp[3],g4=sgp[4],g5=sgp[5],g6=sgp[6],g7=sgp[7];
      bf16*Of=u.Of+(long)(wid*QBLK)*D+ch*8;
      #pragma unroll
      for(int i=0;i<8;++i){ const int row=i*4+(le>>4); const u32x4 v=*(const u32x4*)(stg+row*128+ch*8);
        const float x0=__uint_as_float(v[0]<<16),x1=__uint_as_float(v[0]&0xffff0000u),x2=__uint_as_float(v[1]<<16),x3=__uint_as_float(v[1]&0xffff0000u),
                    x4=__uint_as_float(v[2]<<16),x5=__uint_as_float(v[2]&0xffff0000u),x6=__uint_as_float(v[3]<<16),x7=__uint_as_float(v[3]&0xffff0000u);
        float ss=(x0*x0+x1*x1)+(x2*x2+x3*x3)+(x4*x4+x5*x5)+(x6*x6+x7*x7);
        ss+=__shfl_xor(ss,1); ss+=__shfl_xor(ss,2); ss+=__shfl_xor(ss,4); ss+=__shfl_xor(ss,8);
        const float rs=u.lam1/sqrtf(ss*(1.f/128.f)+1e-6f);
        u32x4 w; w[0]=cvtpk_s(x0*rs*g0,x1*rs*g1); w[1]=cvtpk_s(x2*rs*g2,x3*rs*g3); w[2]=cvtpk_s(x4*rs*g4,x5*rs*g5); w[3]=cvtpk_s(x6*rs*g6,x7*rs*g7);
        *(u32x4*)(Of+(long)row*D)=w; }
    } }
  asm volatile("s_waitcnt lgkmcnt(0)\n\ts_barrier":::"memory");
  #undef DMA_K
  #undef DMA_V
  #undef CMASK
  #undef RESC
  #undef ROT
  #undef SETTG
  #undef SETREF
  #undef KX0
  #undef QX
}
#undef SBAR
#undef WAIT_BAR
}

constexpr float LOG2E = 1.4426950408889634f;
__device__ __forceinline__ int vcu_of(int bx, int G) { return (G % 8 == 0) ? (bx % 8) * (G / 8) + bx / 8 : bx; }
constexpr int ATT1_LDS_TAB = 141312;
__device__ __forceinline__ void attn1_tuned_phase(const Ctx& c, const bf16* qkv, const float* qkg  , bf16* R, unsigned* qctr, const ExpertSrc& es, unsigned char* ws,
                                                  const float* lamp, const float* subln, bf16* Oout) {
    LAS int* order = (LAS int*)(c.lds + ATT1_LDS_TAB);
    LAS int* nts = order + 256;
    LAS int* t0s = nts + 256;
    volatile LAS unsigned* nextu = (volatile LAS unsigned*)(t0s + 256);
    LAS float* bnd = (LAS float*)(t0s + 256 + 4);
    const int G = gridDim.x;
    if (c.wave == 0) { float gq = fabsf(qkg[c.lane]), gk = fabsf(qkg[64 + c.lane]);
#pragma unroll
        for (int o = 1; o < 64; o <<= 1) { gq = fmaxf(gq, __shfl_xor(gq, o)); gk = fmaxf(gk, __shfl_xor(gk, o)); }
        if (c.lane == 0) bnd[0] = 8.f * gq * gk * 1.02f; }
    __syncthreads();
    if (c.tid < 256) { const int h = c.tid >> 4, qb = c.tid & 15; const float slope = exp2f(-0.5f * (float)(h + 1));
        const int dmax = (int)fminf(ceilf((2.f * bnd[0] + 25.f) / slope), 1.0e6f), lo_ = 256 * qb - dmax, t0 = lo_ <= 0 ? 0 : ((lo_ >> 6) & ~1);
        nts[c.tid] = 4 * (qb + 1) - t0; t0s[c.tid] = t0; }
    __syncthreads();
    if (c.tid < 256) { const int mine = nts[c.tid]; int rank = 0;
        for (int e = 0; e < 256; ++e) { const int o = nts[e]; rank += (o > mine || (o == mine && e < c.tid)) ? 1 : 0; }
        order[rank] = c.tid; }
    __syncthreads();
#if FUSE_FINISH
    constexpr int NCH = DEFER_CONV ? EXP_ITEMS / 65 : 0, NUNIT = NB * 16 * 16, NPOS = NUNIT + NCH;
    static_assert(!DEFER_CONV || EXP_ITEMS % 65 == 0, "chunking");
    if (c.tid == 0) { float s01 = 0.f, s23 = 0.f; for (int i = 0; i < 64; ++i) { s01 += lamp[i] * lamp[64 + i]; s23 += lamp[128 + i] * lamp[192 + i]; }
      const float li = 0.8f - 0.6f * expf(-0.3f * 1.0f); bnd[1] = expf(s01) - expf(s23) + li; bnd[2] = li; }
    __syncthreads();
    unsigned p = blockIdx.x;
    while (p < (unsigned)NPOS) {
        unsigned nreg = 0u;
        if (c.tid == 0) nreg = __hip_atomic_fetch_add(qctr, 1u, __ATOMIC_RELAXED, __HIP_MEMORY_SCOPE_AGENT) + (unsigned)G;
        const bool inter = p < (unsigned)(NCH * 2);
        if (inter && (p & 1u)) {
            expert_items_block(c, es, 1, ws, (int)(p >> 1) * 65, 65);
        } else {
#define ATT1_DECODE() const unsigned u = inter ? (p >> 1) : p - (unsigned)NCH; const int ent = order[u >> 2], h = ent >> 4, qb = ent & 15, b = (int)(u & 3u), t0 = t0s[ent]; \
            bf16* Rblk = R + ((size_t)(b * T + qb * 256) * 16 + h) * 256
#if USE_V128
#pragma unroll 1
            for (int pass = 0; pass < 2; ++pass) {
                ATT1_DECODE();
                const int i = pass; att::UnitDesc ud;
                ud.Q = qkv + ((size_t)(2 * h + i) * M + (size_t)(b * T + qb * 256)) * 64; ud.qs = 64;
                ud.K = qkv + ((size_t)(32 + 2 * h + i) * M + (size_t)(b * T + 64 * t0)) * 64; ud.ks = 64;
                ud.V = qkv + ((size_t)(64 + 2 * h) * M + (size_t)(b * T + 64 * t0)) * 64; ud.vs = 64;
                ud.O = Rblk + 128 * i; ud.os = 16 * 256;
                ud.lse = nullptr; ud.lses = 0; ud.NT = 4 * (qb + 1) - t0; ud.rel0 = qb * 256 - 64 * t0; ud.tg0 = t0; ud.q0 = qb * 256;
                ud.slope2 = exp2f(-0.5f * (float)(h + 1)) * LOG2E; ud.sink2 = 0.f;
                ud.fin = pass; ud.lam = bnd[1]; ud.lam1 = 1.f - bnd[2]; ud.sg = subln; ud.Of = Oout + (size_t)(b * T + qb * 256) * D + 128 * h;
                att128::attn_unit<0, 8, 1, 16 * 256>(ud, (char*)c.lds);
            }
#else
#pragma unroll 1
            for (int pass = 0; pass < 4; ++pass) {
                ATT1_DECODE();
                const int i = pass >> 1, j = pass & 1; att::UnitDesc ud;
#if QKV_HEADMAJOR
                ud.Q = qkv + ((size_t)(2 * h + i) * M + (size_t)(b * T + qb * 256)) * 64; ud.qs = 64;
                ud.K = qkv + ((size_t)(32 + 2 * h + i) * M + (size_t)(b * T + 64 * t0)) * 64; ud.ks = 64;
                ud.V = qkv + ((size_t)(64 + 2 * h + j) * M + (size_t)(b * T + 64 * t0)) * 64; ud.vs = 64;
#else
                ud.Q = qkv + (size_t)(b * T + qb * 256) * C_IN + 128 * h + 64 * i; ud.qs = C_IN;
                ud.K = qkv + (size_t)(b * T + 64 * t0) * C_IN + 2048 + 128 * h + 64 * i; ud.ks = C_IN;
                ud.V = qkv + (size_t)(b * T + 64 * t0) * C_IN + 4096 + 128 * h + 64 * j; ud.vs = C_IN;
#endif
                ud.O = Rblk + 128 * i + 64 * j; ud.os = 16 * 256;
                ud.lse = nullptr; ud.lses = 0; ud.NT = 4 * (qb + 1) - t0; ud.rel0 = qb * 256 - 64 * t0; ud.tg0 = t0; ud.q0 = qb * 256;
                ud.slope2 = exp2f(-0.5f * (float)(h + 1)) * LOG2E; ud.sink2 = 0.f;
                att::attn_unit<0, 8, 1, 16 * 256>(ud, (char*)c.lds);
            }
#endif
#if !USE_V128
            asm volatile("s_waitcnt vmcnt(0)" ::: "memory"); __syncthreads();
            { ATT1_DECODE(); (void)t0; const float lam = bnd[1], lam_init = bnd[2];
              int ft_ = threadIdx.x; asm volatile("" : "+v"(ft_));
              const int row = ft_ >> 1, hf = ft_ & 1; const bf16* p1 = Rblk + (size_t)row * (16 * 256) + 64 * hf; const bf16* p2 = p1 + 128;
              float xv[64]; float ss = 0.f;
#pragma unroll
              for (int q8 = 0; q8 < 8; ++q8) { const u32x4 a = *(const u32x4*)(p1 + 8 * q8), bq = *(const u32x4*)(p2 + 8 * q8);
#pragma unroll
                  for (int k = 0; k < 4; ++k) { const float x0 = bf2f(a[k] & 0xffffu) - lam * bf2f(bq[k] & 0xffffu), x1 = bf2f(a[k] >> 16) - lam * bf2f(bq[k] >> 16);
                      xv[8 * q8 + 2 * k] = x0; xv[8 * q8 + 2 * k + 1] = x1; ss += x0 * x0 + x1 * x1; } }
              ss += __shfl_xor(ss, 1);
              const float rs = (1.f - lam_init) / sqrtf(ss * (1.f / 128.f) + RMS_EPS);
              bf16* op = Oout + (size_t)(b * T + qb * 256 + row) * D + 128 * h + 64 * hf; const float* sg = subln + 64 * hf;
#pragma unroll
              for (int q8 = 0; q8 < 8; ++q8) { u32x4 w;
#pragma unroll
                  for (int k = 0; k < 4; ++k) w[k] = pk2(xv[8 * q8 + 2 * k] * rs * sg[8 * q8 + 2 * k], xv[8 * q8 + 2 * k + 1] * rs * sg[8 * q8 + 2 * k + 1]);
                  *(u32x4*)(op + 8 * q8) = w; } }
#endif
#undef ATT1_DECODE
        }
        if (c.tid == 0) nextu[0] = nreg;
        __syncthreads();
        p = nextu[0];
    }
}
#else
    constexpr int NCH = DEFER_CONV ? EXP_ITEMS / 65 : 0, NPOS = NB * 16 * 4 * 16 + NCH;
    static_assert(!DEFER_CONV || EXP_ITEMS % 65 == 0, "chunking");
    unsigned p = blockIdx.x;
    while (p < (unsigned)NPOS) {
        unsigned nreg = 0u;
        if (c.tid == 0) nreg = __hip_atomic_fetch_add(qctr, 1u, __ATOMIC_RELAXED, __HIP_MEMORY_SCOPE_AGENT) + (unsigned)G;
        const bool inter = p < (unsigned)(NCH * 6);
        if (inter && (p % 6u) == 5u) {
            expert_items_block(c, es, 1, ws, (int)(p / 6u) * 65, 65);
        } else {
            const unsigned u = inter ? p - p / 6u : p - (unsigned)NCH;
            const int ent = order[u >> 4], h = ent >> 4, qb = ent & 15, bp = (int)(u & 15u), b = bp >> 2, i = (bp >> 1) & 1, j = bp & 1, t0 = t0s[ent];
            att::UnitDesc ud;
#if QKV_HEADMAJOR
            ud.Q = qkv + ((size_t)(2 * h + i) * M + (size_t)(b * T + qb * 256)) * 64; ud.qs = 64;
            ud.K = qkv + ((size_t)(32 + 2 * h + i) * M + (size_t)(b * T + 64 * t0)) * 64; ud.ks = 64;
            ud.V = qkv + ((size_t)(64 + 2 * h + j) * M + (size_t)(b * T + 64 * t0)) * 64; ud.vs = 64;
#else
            ud.Q = qkv + (size_t)(b * T + qb * 256) * C_IN + 128 * h + 64 * i; ud.qs = C_IN;
            ud.K = qkv + (size_t)(b * T + 64 * t0) * C_IN + 2048 + 128 * h + 64 * i; ud.ks = C_IN;
            ud.V = qkv + (size_t)(b * T + 64 * t0) * C_IN + 4096 + 128 * h + 64 * j; ud.vs = C_IN;
#endif
            ud.O = R + ((size_t)(b * T + qb * 256) * 16 + h) * 256 + 128 * i + 64 * j; ud.os = 16 * 256;
            ud.lse = nullptr; ud.lses = 0; ud.NT = 4 * (qb + 1) - t0; ud.rel0 = qb * 256 - 64 * t0; ud.tg0 = t0; ud.q0 = qb * 256;
            ud.slope2 = exp2f(-0.5f * (float)(h + 1)) * LOG2E; ud.sink2 = 0.f;
            att::attn_unit<0, 8, 1, 16 * 256>(ud, (char*)c.lds);
        }
        if (c.tid == 0) nextu[0] = nreg;
        __syncthreads();
        p = nextu[0];
    }
}
#endif
__device__ __forceinline__ void attn1_finish_bf16_phase(const Ctx& c, const bf16* R, const float* lamp, const float* subln, bf16* O) {
    float s01 = 0.f, s23 = 0.f;
    for (int i = 0; i < 64; ++i) { s01 += lamp[i] * lamp[64 + i]; s23 += lamp[128 + i] * lamp[192 + i]; }
    const float lam_init = 0.8f - 0.6f * expf(-0.3f * 1.0f);
    const float lam = expf(s01) - expf(s23) + lam_init;
    const long total = (long)M * 16;
    for (long id = gtid_now(); id < total; id += c.gsz) {
        const bf16* p1 = R + (size_t)id * 256; const bf16* p2 = p1 + 128;
        float ss = 0.f;
#pragma unroll 4
        for (int i = 0; i < 16; ++i) { const u32x4 a = *(const u32x4*)(p1 + 8 * i), bq = *(const u32x4*)(p2 + 8 * i);
#pragma unroll
            for (int k = 0; k < 4; ++k) { const float x0 = bf2f(a[k] & 0xffffu) - lam * bf2f(bq[k] & 0xffffu), x1 = bf2f(a[k] >> 16) - lam * bf2f(bq[k] >> 16); ss += x0 * x0 + x1 * x1; } }
        const float rs = (1.f - lam_init) / sqrtf(ss * (1.f / 128.f) + RMS_EPS);
        bf16* op = O + (size_t)id * 128;
#pragma unroll 4
        for (int i = 0; i < 16; ++i) { const u32x4 a = *(const u32x4*)(p1 + 8 * i), bq = *(const u32x4*)(p2 + 8 * i); u32x4 w;
#pragma unroll
            for (int k = 0; k < 4; ++k) { const float x0 = bf2f(a[k] & 0xffffu) - lam * bf2f(bq[k] & 0xffffu), x1 = bf2f(a[k] >> 16) - lam * bf2f(bq[k] >> 16);
                w[k] = pk2(x0 * rs * subln[8 * i + 2 * k], x1 * rs * subln[8 * i + 2 * k + 1]); }
            *(u32x4*)(op + 8 * i) = w; }
    }
}
__device__ __forceinline__ void attn0_tuned_phase(const Ctx& c, const bf16* qkv, const float* sinks, bf16* OBR  , float* LSE  , bf16* O, int xlo, int xhi) {
    const int G = gridDim.x, vcu = vcu_of(blockIdx.x, G);
    for (int gid = vcu; gid < NB * 64; gid += G) {
        const int b = gid / 64, kind = (gid % 64) / 16, h = gid % 16;
        const float slope2 = exp2f(-0.5f * (float)(h + 1)) * LOG2E;
        if (kind < 3) {
            const int dil = kind == 0 ? 1 : (kind == 1 ? 4 : 16), nblk = 16 / dil;
            for (int x = xlo; x < xhi; ++x) {
                const int r = x / nblk, blk = x % nblk, q0 = blk * 256, t0 = blk ? 4 * blk - 2 : 0; att::UnitDesc u;
                const size_t qrow = (size_t)(b * T + r + dil * q0), krow = (size_t)(b * T + r + dil * 64 * t0);
#if QKV_HEADMAJOR
                u.Q = qkv + ((size_t)(h) * M + qrow) * 64; u.qs = (long)dil * 64;
                u.K = qkv + ((size_t)(16 + h) * M + krow) * 64; u.ks = (long)dil * 64;
                u.V = qkv + ((size_t)(32 + h) * M + krow) * 64; u.vs = (long)dil * 64;
#else
                u.Q = qkv + qrow * AB_IN + 64 * h; u.qs = (long)dil * AB_IN;
                u.K = qkv + krow * AB_IN + 1024 + 64 * h; u.ks = (long)dil * AB_IN;
                u.V = qkv + krow * AB_IN + 2048 + 64 * h; u.vs = (long)dil * AB_IN;
#endif
                u.O = OBR + ((size_t)kind * M + qrow) * 1024 + 64 * h; u.os = (long)dil * 1024;
                u.lse = LSE + ((size_t)kind * M + qrow) * 16 + h; u.lses = (long)dil * 16;
                u.NT = blk ? 6 : 4; u.rel0 = q0 - 64 * t0; u.tg0 = t0; u.q0 = q0; u.slope2 = slope2 * (float)dil; u.sink2 = 0.f;
                if (dil == 1) att::attn_unit<1, 8, 1, 1024>(u, (char*)c.lds); else if (dil == 4) att::attn_unit<1, 8, 4, 4096>(u, (char*)c.lds); else att::attn_unit<1, 8, 16, 16384>(u, (char*)c.lds);
            }
        } else {
            const int kvh = h >> 3;
            for (int x = xlo; x < xhi; ++x) {
                const int q0 = x * 256, t0 = x ? 4 * x - 2 : 0; att::UnitDesc u;
                const size_t qrow = (size_t)(b * T + q0), krow = (size_t)(b * T + 64 * t0);
#if QKV_HEADMAJOR
                u.Q = qkv + ((size_t)(48 + h) * M + qrow) * 64; u.qs = 64;
                u.K = qkv + ((size_t)(64 + kvh) * M + krow) * 64; u.ks = 64;
                u.V = qkv + ((size_t)(66 + kvh) * M + krow) * 64; u.vs = 64;
#else
                u.Q = qkv + qrow * AB_IN + 3072 + 64 * h; u.qs = AB_IN;
                u.K = qkv + krow * AB_IN + 4096 + 64 * kvh; u.ks = AB_IN;
                u.V = qkv + krow * AB_IN + 4224 + 64 * kvh; u.vs = AB_IN;
#endif
                u.O = O + qrow * D + 1024 + 64 * h; u.os = D;
                u.lse = nullptr; u.lses = 0;
                u.NT = x ? 6 : 4; u.rel0 = q0 - 64 * t0; u.tg0 = t0; u.q0 = q0; u.slope2 = slope2; u.sink2 = sinks[h] * LOG2E;
                att::attn_unit<2, 8, 1, D>(u, (char*)c.lds);
            }
        }
    }
}
__device__ __forceinline__ void attn0_merge_phase(const Ctx& c, const bf16* __restrict__ OBR, const float* __restrict__ LSE, bf16* __restrict__ O) {
    const long total = (long)M * 16 * 8;
#pragma unroll 4
    for (long id8 = gtid_now(); id8 < total; id8 += c.gsz) {
        const long id = id8 >> 3; const int pc = (int)(id8 & 7);
        const long m = id / 16; const int h = (int)(id % 16);
        const float l0 = LSE[id], l1 = LSE[(size_t)M * 16 + id], l2 = LSE[(size_t)2 * M * 16 + id];
        const float mx = fmaxf(l0, fmaxf(l1, l2)); float w0 = exp2f(l0 - mx), w1 = exp2f(l1 - mx), w2 = exp2f(l2 - mx); const float inv = 1.f / (w0 + w1 + w2); w0 *= inv; w1 *= inv; w2 *= inv;
        const bf16* p0 = OBR + (size_t)m * 1024 + 64 * h + 8 * pc; const bf16* p1 = p0 + (size_t)M * 1024; const bf16* p2 = p1 + (size_t)M * 1024;
        const u32x4 a = *(const u32x4*)p0, bq = *(const u32x4*)p1, cq = *(const u32x4*)p2; u32x4 w;
#pragma unroll
        for (int k = 0; k < 4; ++k) w[k] = pk2(w0 * bf2f(a[k] & 0xffffu) + w1 * bf2f(bq[k] & 0xffffu) + w2 * bf2f(cq[k] & 0xffffu), w0 * bf2f(a[k] >> 16) + w1 * bf2f(bq[k] >> 16) + w2 * bf2f(cq[k] >> 16));
        *(u32x4*)(O + (size_t)m * D + 64 * h + 8 * pc) = w;
    }
}

__device__ __forceinline__ void convert_router(const Ctx& c, const float* wr, bf16* wrt) {
    for (int id2 = gtid_now(); id2 < 2 * NE * D; id2 += c.gsz) { const int l = id2 / (NE * D), id = id2 % (NE * D), k = id / NE, n = id % NE; const float w = wr[id2];
        const unsigned hb = f2bf(w); const float hf = bf2f(hb);
        const int kkn = 2 * ((k >> 6) & 3) + ((k >> 3) & 1), qn = (k >> 4) & 3;
        const int off = l * 2 * NE * D + (((((k >> 8) * 8 + kkn) * 4 + (n >> 4)) * 2) * 64 + ((n & 15) + 16 * qn)) * 8 + (k & 7);
        wrt[off] = (bf16)hb; wrt[off + 512] = (bf16)f2bf(w - hf); }
}
#define DPPF(old, v, ctrl, rm) __int_as_float(__builtin_amdgcn_update_dpp(__float_as_int(old), __float_as_int(v), ctrl, rm, 0xf, false))
__device__ __forceinline__ float dpp_max8(float v) {
    v = fmaxf(v, DPPF(v, v, 0xB1, 0xf)); v = fmaxf(v, DPPF(v, v, 0x4E, 0xf)); v = fmaxf(v, DPPF(v, v, 0x141, 0xf)); return v; }
__device__ __forceinline__ float wave_max_u(float v) {
    v = dpp_max8(v); v = fmaxf(v, DPPF(v, v, 0x140, 0xf)); v = fmaxf(v, DPPF(v, v, 0x142, 0xa)); v = fmaxf(v, DPPF(v, v, 0x143, 0xc));
    return __int_as_float(__builtin_amdgcn_readlane(__float_as_int(v), 63)); }
__device__ __forceinline__ float wave_sum_u(float v) {
    v += DPPF(0.f, v, 0xB1, 0xf); v += DPPF(0.f, v, 0x4E, 0xf); v += DPPF(0.f, v, 0x141, 0xf); v += DPPF(0.f, v, 0x140, 0xf); v += DPPF(0.f, v, 0x142, 0xa); v += DPPF(0.f, v, 0x143, 0xc);
    return __int_as_float(__builtin_amdgcn_readlane(__float_as_int(v), 63)); }
constexpr int RT_ROUTER = 2;
__device__ __forceinline__ void router2_phase(const Ctx& c, const float* x1, const float* g, const float* ada_l, const bf16* wrt, const float* rbias,
                                              bf16* HF, int* idx, float* gate, int* wcnt, bf16* HFB = nullptr) {
    constexpr int RT = RT_ROUTER, RU = 16 * RT, NU = M / RU;
    LAS float* red = (LAS float*)c.lds;
    LAS float* part = (LAS float*)(c.lds + 1024);
    LAS float* GA = (LAS float*)(c.lds + 1024 + RT * 32768);
    LAS float* GB = GA + D;
    const int w = __builtin_amdgcn_readfirstlane((int)threadIdx.x >> 6);
    const float rb = rbias[threadIdx.x & 63];
    unsigned cnt = 0u;
    const int per = (NU + (int)gridDim.x - 1) / (int)gridDim.x, u0 = blockIdx.x * per, u1 = (u0 + per < NU) ? u0 + per : NU;
    int bcur = -1;
#pragma unroll 1
    for (int u = u0; u < u1; ++u) {
        int tid = threadIdx.x; asm volatile("" : "+v"(tid));
        const int lane = tid & 63, r = lane & 15, q = lane >> 4, cb = 256 * w + 16 * q;
#define KOFF(kk_) (64 * ((kk_) >> 1) + 8 * ((kk_) & 1))
        const bf16* wf = wrt + (size_t)w * (8 * 4 * 2 * 512) + lane * 8;
        const int m0 = u * RU, b = m0 / T;
        if (b != bcur) { bcur = b; __syncthreads();
            for (int col = 4 * tid; col < D; col += 2048) { const f32x4 gg = *(const f32x4*)(g + col), sc = *(const f32x4*)(ada_l + (size_t)b * 6 * D + 4 * D + col), sh = *(const f32x4*)(ada_l + (size_t)b * 6 * D + 3 * D + col);
                *(LAS f32x4*)(GA + col) = gg * (sc + 1.f); *(LAS f32x4*)(GB + col) = sh; } }
        u32x4 xv[RT][8]; float rstd[RT];
#pragma unroll
        for (int t = 0; t < RT; ++t) { const bf16* xr = (const bf16*)x1 + (size_t)(m0 + 16 * t + r) * D + cb;
#pragma unroll
            for (int kk = 0; kk < 8; ++kk) xv[t][kk] = *(const u32x4*)(xr + KOFF(kk)); }
#pragma unroll
        for (int t = 0; t < RT; ++t) { float ss = 0.f;
#pragma unroll
            for (int kk = 0; kk < 8; ++kk)
#pragma unroll
                for (int j = 0; j < 4; ++j) { const float a0 = bf2f(xv[t][kk][j] & 0xffffu), a1 = bf2f(xv[t][kk][j] >> 16); ss += a0 * a0 + a1 * a1; }
            ss += __shfl_xor(ss, 16); ss += __shfl_xor(ss, 32);
            if (q == 0) red[(t * 8 + w) * 16 + r] = ss; }
        __syncthreads();
        f32x4 acc[RT][4]; u32x2 q8keep[RT];
#pragma unroll
        for (int t = 0; t < RT; ++t) { float tot = 0.f;
#pragma unroll
            for (int w2 = 0; w2 < 8; ++w2) tot += red[(t * 8 + w2) * 16 + r];
            rstd[t] = 1.f / sqrtf(tot * (1.f / D) + RMS_EPS);
#pragma unroll
            for (int nt = 0; nt < 4; ++nt) acc[t][nt] = (f32x4){0.f, 0.f, 0.f, 0.f}; }
#pragma unroll
        for (int kk = 0; kk < 8; ++kk) {
            const f32x4 ga0 = *(LAS f32x4*)(GA + cb + KOFF(kk)), ga1 = *(LAS f32x4*)(GA + cb + KOFF(kk) + 4), gb0 = *(LAS f32x4*)(GB + cb + KOFF(kk)), gb1 = *(LAS f32x4*)(GB + cb + KOFF(kk) + 4);
            bf16x8 ah[RT], al[RT];
#pragma unroll
            for (int t = 0; t < RT; ++t) { const u32x4 xw = xv[t][kk]; f32x4 hh[2];
                hh[0] = (f32x4){bf2f(xw.x & 0xffffu), bf2f(xw.x >> 16), bf2f(xw.y & 0xffffu), bf2f(xw.y >> 16)} * rstd[t] * ga0 + gb0;
                hh[1] = (f32x4){bf2f(xw.z & 0xffffu), bf2f(xw.z >> 16), bf2f(xw.w & 0xffffu), bf2f(xw.w >> 16)} * rstd[t] * ga1 + gb1;
                u32x4 hw, lw;
#pragma unroll
                for (int s2 = 0; s2 < 2; ++s2) { const unsigned h0 = f2bf(hh[s2].x), h1 = f2bf(hh[s2].y), h2 = f2bf(hh[s2].z), h3 = f2bf(hh[s2].w);
                    hw[2 * s2] = h0 | (h1 << 16); hw[2 * s2 + 1] = h2 | (h3 << 16);
                    lw[2 * s2] = pk2(hh[s2].x - bf2f(h0), hh[s2].y - bf2f(h1)); lw[2 * s2 + 1] = pk2(hh[s2].z - bf2f(h2), hh[s2].w - bf2f(h3)); }
#if USE_FP8_MOE
                { const unsigned qa = pk4_fp8(hh[0].x * F8_HSCALE, hh[0].y * F8_HSCALE, hh[0].z * F8_HSCALE, hh[0].w * F8_HSCALE), qb2 = pk4_fp8(hh[1].x * F8_HSCALE, hh[1].y * F8_HSCALE, hh[1].z * F8_HSCALE, hh[1].w * F8_HSCALE);
                  if (kk & 1) { u32x4 q16; q16.x = q8keep[t].x; q16.y = q8keep[t].y; q16.z = qa; q16.w = qb2; *(u32x4*)((unsigned char*)HF + (size_t)(m0 + 16 * t + r) * D + cb + KOFF(kk - 1)) = q16; }
                  else { q8keep[t].x = qa; q8keep[t].y = qb2; } }
#if SHARED_BF16
                *(u32x4*)(HFB + (size_t)(m0 + 16 * t + r) * D + cb + KOFF(kk)) = hw;
#endif
#else
                *(u32x4*)(HF + (size_t)(m0 + 16 * t + r) * D + cb + KOFF(kk)) = hw;
#endif
                ah[t] = __builtin_bit_cast(bf16x8, hw); al[t] = __builtin_bit_cast(bf16x8, lw); }
#pragma unroll
            for (int nt = 0; nt < 4; ++nt) { const bf16x8 bh = *(const bf16x8*)(wf + ((kk * 4 + nt) * 2) * 512), bl = *(const bf16x8*)(wf + ((kk * 4 + nt) * 2 + 1) * 512);
#pragma unroll
                for (int t = 0; t < RT; ++t) {
                    acc[t][nt] = __builtin_amdgcn_mfma_f32_16x16x32_bf16(ah[t], bh, acc[t][nt], 0, 0, 0);
                    acc[t][nt] = __builtin_amdgcn_mfma_f32_16x16x32_bf16(ah[t], bl, acc[t][nt], 0, 0, 0);
                    acc[t][nt] = __builtin_amdgcn_mfma_f32_16x16x32_bf16(al[t], bh, acc[t][nt], 0, 0, 0); } }
            if (kk & 1) asm volatile("" ::: "memory");
        }
#pragma unroll
        for (int t = 0; t < RT; ++t)
#pragma unroll
            for (int nt = 0; nt < 4; ++nt)
#pragma unroll
                for (int j = 0; j < 4; ++j) part[((t * 8 + w) * 16 + 4 * q + j) * 64 + 16 * nt + r] = acc[t][nt][j];
        __syncthreads();
#pragma unroll 1
        for (int rp = 0; rp < RT; ++rp) {
            float score[2], cur[2]; int rank[2];
#pragma unroll
            for (int x = 0; x < 2; ++x) { const int row = 2 * RT * w + 2 * rp + x; float logit = 0.f;
#pragma unroll
                for (int w2 = 0; w2 < 8; ++w2) logit += part[(((row >> 4) * 8 + w2) * 16 + (row & 15)) * 64 + lane];
                score[x] = 1.f / (1.f + expf(-logit));
                const float sel = score[x] + rb;
                const float m1 = dpp_max8(sel);
                const unsigned long long eqm = __ballot(sel == m1);
                const unsigned grp_eq = (unsigned)((eqm >> (lane & ~7)) & 0xffull);
                const int first = __builtin_ctz(grp_eq);
                const float m2 = dpp_max8(((lane & 7) == first) ? -3e38f : sel);
                const float gs = m1 + m2;
                int grank = 0; const int mygrp = lane >> 3;
#pragma unroll
                for (int g2 = 0; g2 < 8; ++g2) { const float o = __int_as_float(__builtin_amdgcn_readlane(__float_as_int(gs), g2 * 8)); grank += (o > gs || (o == gs && g2 < mygrp)) ? 1 : 0; }
                cur[x] = (grank < 4) ? sel : -1e30f; rank[x] = 64; }
#pragma unroll
            for (int it = 0; it < TOPK; ++it)
#pragma unroll
                for (int x = 0; x < 2; ++x) { const float mx = wave_max_u(cur[x]); const int f = (int)__builtin_ctzll(__ballot(cur[x] == mx));
                    if (lane == f) { rank[x] = it; cur[x] = -3e38f; } }
#pragma unroll
            for (int x = 0; x < 2; ++x) { const int m = m0 + 2 * RT * w + 2 * rp + x; const bool chosen = rank[x] < TOPK;
                const float gsum = wave_sum_u(chosen ? score[x] : 0.f);
                if (chosen) { idx[(size_t)m * 8 + rank[x]] = lane | (int)(cnt << 8); gate[(size_t)m * 8 + rank[x]] = score[x] / gsum * 2.5f; cnt += 1u; } }
        }
        __syncthreads();
    }
    wcnt[(size_t)(blockIdx.x * 8 + w) * 64 + (threadIdx.x & 63)] = (int)cnt;
}
#undef KOFF
__device__ __forceinline__ void slot2_phase(const Ctx& c, const int* idx, const int* wcnt, unsigned* nrt_out, int* pos, int* slot_tok, int* tile_exp) {
    LAS int* ST = (LAS int*)c.lds;
    LAS int* SB = ST + 512;
    LAS int* SO = SB + 512;
    LAS int* tot = SO + 512;
    LAS int* bef = tot + 64;
    LAS int* ps = bef + 64;
    LAS int* base = ps + 128;
    const int e = c.tid & 63, p = c.tid >> 6, G = gridDim.x, blk = blockIdx.x;
    { int Tp = 0, Bp = 0;
#pragma unroll 8
      for (int b2 = 0; b2 < G; ++b2) { const int v = wcnt[(size_t)(b2 * 8 + p) * 64 + e]; Tp += v; Bp += (b2 < blk) ? v : 0; }
      ST[p * 64 + e] = Tp; SB[p * 64 + e] = Bp; SO[p * 64 + e] = wcnt[(size_t)(blk * 8 + p) * 64 + e]; }
    __syncthreads();
    if (c.tid < 64) { int t = 0, bb = 0;
#pragma unroll
        for (int p2 = 0; p2 < 8; ++p2) { t += ST[p2 * 64 + e]; bb += SB[p2 * 64 + e]; }
        tot[e] = t; bef[e] = bb; }
    __syncthreads();
    if (c.tid == 0) { int acc = 0; for (int e2 = 0; e2 < NE; ++e2) { ps[e2] = acc; acc += (tot[e2] + 255) / 256 * 256; } ps[64] = acc; }
    __syncthreads();
    { int o = ps[e] + bef[e];
      for (int p2 = 0; p2 < p; ++p2) o += SO[p2 * 64 + e];
      base[p * 64 + e] = o; }
    __syncthreads();
    {
        constexpr int RU = 16 * RT_ROUTER, NU = M / RU; const int per = (NU + G - 1) / G, mlo = blk * per * RU, mhi = (mlo + per * RU < M) ? mlo + per * RU : M;
        for (int i = c.tid; i < (mhi - mlo) * 8; i += 512) {
            const int m = mlo + (i >> 3), k = i & 7, wv = (m % RU) / (2 * RT_ROUTER); const size_t a = (size_t)m * 8 + k;
            const int code = idx[a], ee = code & 255, rk = code >> 8, slot = base[wv * 64 + ee] + rk;
            slot_tok[slot] = m; pos[a] = slot; }
    }
    for (int t = gtid_now(); t < M; t += c.gsz) slot_tok[CAPR + t] = t;
    if (blk == 0) {
        if (c.tid < NE) { const int s0 = ps[e], cn = tot[e], pe = s0 + (cn + 255) / 256 * 256;
            for (int s = s0 + cn; s < pe; ++s) slot_tok[s] = 0;
            for (int tt = s0 / 256; tt < pe / 256; ++tt) tile_exp[tt] = e; }
        if (c.tid == 0) *nrt_out = (unsigned)(ps[64] / 256);
    }
    __syncthreads();
}

template <int L> __device__ __forceinline__ void moe_up_tuned(const Ctx& c, unsigned char* ws) {
    const int nrt = (int)c.ctl[CW_NRT + L];
#if USE_FP8_MOE && SHARED_BF16
    { pg8::PlainSched S; S.o.init(M / 256, UPN / 256, gridDim.x, blockIdx.x); S.Bt = (const char*)(ws + WS_WUPS) + (size_t)L * UPN * D * 2; S.K = D;
      pg8::EpiUp E{(bf16*)(ws + WS_ACTS)}; pg8::gemm_phase(c.lds, (const char*)(ws + WS_HFB), D, S, E); }
    const int ntile = nrt;
#else
    const int ntile = nrt + M / 256;
#endif
    pg8::GroupSched<true> S; S.o.init(ntile, UPN / 256, gridDim.x, blockIdx.x);
    { LAS int* te = (LAS int*)(c.lds + 132096);
      for (int i = threadIdx.x; i < nrt; i += 512) te[i] = ((const int*)(ws + WS_TILEEXP))[i];
      __syncthreads(); S.tile_exp = te; }
    S.nrt = nrt; S.slot_tok = (const int*)(ws + WS_SLOTTOK);
#if USE_FP8_MOE
    S.W = (const char*)(ws + WS_WUP) + (size_t)L * NEX * UPN * D; S.wstride = (size_t)UPN * D; S.K = D / 2;
    pg8::EpiUp8 E{ws + WS_ACT}; pg8::gemm_phase<pg8::EpiUp8, pg8::GroupSched<true>, true>(c.lds, (const char*)(ws + WS_HF), D / 2, S, E);
#else
    S.W = (const char*)(ws + WS_WUP) + (size_t)L * NEX * UPN * D * 2; S.wstride = (size_t)UPN * D * 2; S.K = D;
    pg8::EpiUp E{(bf16*)(ws + WS_ACT)}; pg8::gemm_phase(c.lds, (const char*)(ws + WS_HF), D, S, E);
#endif
}
template <int L> __device__ __forceinline__ void moe_down_tuned(const Ctx& c, unsigned char* ws) {
    const int nrt = (int)c.ctl[CW_NRT + L];
#if USE_FP8_MOE && SHARED_BF16
    { pg8::PlainSched S; S.o.init(M / 256, D / 256, gridDim.x, blockIdx.x); S.Bt = (const char*)(ws + WS_WDNS) + (size_t)L * D * ED * 2; S.K = ED;
      pg8::EpiDown E{(bf16*)(ws + WS_Y), CAPR}; pg8::gemm_phase(c.lds, (const char*)(ws + WS_ACTS), ED, S, E); }
    const int ntile = nrt;
#else
    const int ntile = nrt + M / 256;
#endif
    pg8::GroupSched<false> S; S.o.init(ntile, D / 256, gridDim.x, blockIdx.x);
    { LAS int* te = (LAS int*)(c.lds + 132096);
      for (int i = threadIdx.x; i < nrt; i += 512) te[i] = ((const int*)(ws + WS_TILEEXP))[i];
      __syncthreads(); S.tile_exp = te; }
    S.nrt = nrt; S.slot_tok = (const int*)(ws + WS_SLOTTOK);
#if USE_FP8_MOE
    S.W = (const char*)(ws + WS_WDN) + (size_t)L * NEX * D * ED; S.wstride = (size_t)D * ED; S.K = ED / 2;
    pg8::EpiDown8 E{(bf16*)(ws + WS_Y)}; pg8::gemm_phase<pg8::EpiDown8, pg8::GroupSched<false>, true>(c.lds, (const char*)(ws + WS_ACT), ED / 2, S, E);
#else
    S.W = (const char*)(ws + WS_WDN) + (size_t)L * NEX * D * ED * 2; S.wstride = (size_t)D * ED * 2; S.K = ED;
    pg8::EpiDown E{(bf16*)(ws + WS_Y)}; pg8::gemm_phase(c.lds, (const char*)(ws + WS_ACT), ED, S, E);
#endif
}
template <int L> __device__ __forceinline__ void qkv_tuned(const Ctx& c, unsigned char* ws, const float* gains) {
    constexpr int NCOL = L == 0 ? AB_IN : C_IN; constexpr bool TUNED_ATT = L == 0 ? (USE_ATT0 != 0) : (USE_ATT1 != 0);
    pg8::PlainSched S; S.o.init(M / 256, NCOL / 256, gridDim.x, blockIdx.x); S.Bt = (const char*)(ws + (L == 0 ? WS_W0IN : WS_W1IN));
#if USE_FP8_QKV
    S.K = D / 2; pg8::EpiQKV<L> E{(bf16*)(ws + WS_QKV), NCOL, gains, TUNED_ATT ? att::C2 : 1.f, 1.f / (F8_HSCALE * F8_WSCALE)};
    pg8::gemm_phase<pg8::EpiQKV<L>, pg8::PlainSched, true>(c.lds, (const char*)(ws + WS_XN), D / 2, S, E);
#else
    S.K = D; pg8::EpiQKV<L> E{(bf16*)(ws + WS_QKV), NCOL, gains, TUNED_ATT ? att::C2 : 1.f, 1.f};
    pg8::gemm_phase(c.lds, (const char*)(ws + WS_XN), D, S, E);
#endif
}

template <int L> __device__ __forceinline__ void outproj_epi(const Ctx& c, unsigned char* ws, const pg8::PlainSched& S, const float* xin_f32, const float* gm) {
#if RES_BF16
    if (L == 0) { pg8::EpiOutB<false> E{xin_f32, gm, (bf16*)(ws + WS_X1)}; pg8::gemm_phase(c.lds, (const char*)(ws + WS_O), D, S, E); }
    else { pg8::EpiOutB<true> E{ws + WS_X1 + (size_t)M * D * 2, gm, (bf16*)(ws + WS_X1)}; pg8::gemm_phase(c.lds, (const char*)(ws + WS_O), D, S, E); }
#else
    pg8::EpiOut E{xin_f32, gm, (float*)(ws + WS_X1)}; pg8::gemm_phase(c.lds, (const char*)(ws + WS_O), D, S, E);
#endif
}
__global__ void __launch_bounds__(512, 2) mega(Args args) {
    extern __shared__ __attribute__((aligned(16))) unsigned char lds_raw[];
    Ctx c;
    c.lds = (LAS unsigned char*)lds_raw;
    c.tid = threadIdx.x; c.lane = c.tid & 63; c.wave = __builtin_amdgcn_readfirstlane(c.tid >> 6);
    c.gw = blockIdx.x * 8 + c.wave; c.ngw = gridDim.x * 8; c.gsz = gridDim.x * 512;
    c.ws = args.ws; c.ctl = (unsigned*)(args.ws + WS_CTL);
    volatile LAS unsigned* xbw = (volatile LAS unsigned*)(c.lds + LDS_BYTES - 16);
    if (c.tid < 4) xbw[c.tid] = 0u;
    __syncthreads();
    const int lo = args.ph_lo, hi = args.ph_hi;
    XcdBarrier bar; bar.bar = c.ctl + CW_BAR; bar.x = 0; bar.st = xbw;
    if (hi - lo > 1) bar = xcd_barrier_post(c.ctl + CW_BAR, xbw);
#ifdef PHASE_ONLY
#define IN(k) ((k) == PHASE_ONLY && lo <= (k) && (k) < hi)
#else
#define IN(k) (lo <= (k) && (k) < hi)
#endif
#define PHASE(k, ...) do { if (IN(k)) { __VA_ARGS__ } if (IN(k) && ((REPMASK >> (k)) & 1u)) { __syncthreads(); __VA_ARGS__ } } while (0);
#if PROBE_SEL >= 0
    volatile LAS unsigned long long* stamp_ = (volatile LAS unsigned long long*)(c.lds + 146000);
    if (c.tid == 0) stamp_[0] = __builtin_amdgcn_s_memrealtime();
#define SEAM(k) do { if (c.tid == 0) stamp_[1 + 2 * (k)] = __builtin_amdgcn_s_memrealtime(); if (IN(k) && IN((k) + 1)) xcd_barrier(bar); else __syncthreads(); \
        if (c.tid == 0) stamp_[2 + 2 * (k)] = __builtin_amdgcn_s_memrealtime(); } while (0)
#else
#define SEAM(k) do { if (IN(k) && IN((k) + 1)) xcd_barrier(bar); else __syncthreads(); } while (0)
#endif
    unsigned char* ws = args.ws;
#define XIN (args.in[0])
#define cin (args.in[1])
#define norm_mix (args.in[2])
#define norm_ffn (args.in[3])
#define w_ada (args.in[4])
#define b_ada (args.in[5])
#define ada ((float*)(ws + WS_ADA))
#define W0IN ((bf16*)(ws + WS_W0IN))
#define W0OUT ((bf16*)(ws + WS_W0OUT))
#define W1IN ((bf16*)(ws + WS_W1IN))
#define W1OUT ((bf16*)(ws + WS_W1OUT))
#define WUP ((bf16*)(ws + WS_WUP))
#define WDN ((bf16*)(ws + WS_WDN))
#define XN ((bf16*)(ws + WS_XN))
#define QKV ((bf16*)(ws + WS_QKV))
#define OBUF ((bf16*)(ws + WS_O))
#define X1 ((float*)(ws + WS_X1))
#define HF ((bf16*)(ws + WS_HF))
#define IDX ((int*)(ws + WS_IDX))
#define GATE ((float*)(ws + WS_GATE))
#define POS ((int*)(ws + WS_POS))
#define SLOTTOK ((int*)(ws + WS_SLOTTOK))
#define TILEEXP ((int*)(ws + WS_TILEEXP))
#define ACT ((bf16*)(ws + WS_ACT))
#define Y ((bf16*)(ws + WS_Y))
#define TMP ((float*)(ws + WS_TMP))
#define OUTP (args.out)

    PHASE(0, {
        constexpr int QM = USE_PG8_QKV ? 1 : 0, UM = USE_PG8_MOE ? 2 : 0;
#if USE_CONV128 && USE_FP8_MOE
        convert_dense_all<QM, USE_FP8_QKV != 0>(c, args.in[6], args.in[10], args.in[9], args.in[14], (unsigned char*)W0IN, (unsigned char*)W1IN, (unsigned char*)W0OUT, (unsigned char*)W1OUT, USE_FP8_QKV ? F8_WSCALE : 1.f);
#if !(DEFER_CONV && USE_ATT0 && USE_ATT1 && !SHARED_BF16)
        for (int l = 0; l < 2; ++l) {
            convert_batch128<2, true>(c, args.in[17] + (size_t)l * NE * D * UPN, D, UPN, (unsigned char*)WUP + (size_t)l * NEX * UPN * D, NE, (size_t)UPN * D, F8_WSCALE);
            convert_batch128<0, true>(c, args.in[18] + (size_t)l * NE * ED * D, ED, D, (unsigned char*)WDN + (size_t)l * NEX * D * ED, NE, (size_t)D * ED, F8_WSCALE);
#if SHARED_BF16
            convert_batch128<2, false>(c, args.in[19] + (size_t)l * D * UPN, D, UPN, ws + WS_WUPS + (size_t)l * UPN * D * 2, 1, 0, 1.f);
            convert_batch128<0, false>(c, args.in[20] + (size_t)l * ED * D, ED, D, ws + WS_WDNS + (size_t)l * D * ED * 2, 1, 0, 1.f);
#else
            convert_batch128<2, true>(c, args.in[19] + (size_t)l * D * UPN, D, UPN, (unsigned char*)WUP + ((size_t)l * NEX + NE) * UPN * D, 1, 0, F8_WSCALE);
            convert_batch128<0, true>(c, args.in[20] + (size_t)l * ED * D, ED, D, (unsigned char*)WDN + ((size_t)l * NEX + NE) * D * ED, 1, 0, F8_WSCALE);
#endif
        }
#endif
#else
        convert_batch<QM>(c, args.in[6], D, AB_IN, W0IN, 1, 0);
        convert_batch<0>(c, args.in[9], D, D, W0OUT, 1, 0);
        convert_batch<QM>(c, args.in[10], D, C_IN, W1IN, 1, 0);
        convert_batch<0>(c, args.in[14], D, D, W1OUT, 1, 0);
        for (int l = 0; l < 2; ++l) {
#if USE_FP8_MOE
            convert_batch_f8<2>(c, args.in[17] + (size_t)l * NE * D * UPN, D, UPN, (unsigned char*)WUP + (size_t)l * NEX * UPN * D, NE, (size_t)UPN * D);
            convert_batch_f8<2>(c, args.in[19] + (size_t)l * D * UPN, D, UPN, (unsigned char*)WUP + ((size_t)l * NEX + NE) * UPN * D, 1, 0);
            convert_batch_f8<0>(c, args.in[18] + (size_t)l * NE * ED * D, ED, D, (unsigned char*)WDN + (size_t)l * NEX * D * ED, NE, (size_t)D * ED);
            convert_batch_f8<0>(c, args.in[20] + (size_t)l * ED * D, ED, D, (unsigned char*)WDN + ((size_t)l * NEX + NE) * D * ED, 1, 0);
#else
            convert_batch<UM>(c, args.in[17] + (size_t)l * NE * D * UPN, D, UPN, WUP + (size_t)l * NEX * UPN * D, NE, (size_t)UPN * D);
            convert_batch<UM>(c, args.in[19] + (size_t)l * D * UPN, D, UPN, WUP + ((size_t)l * NEX + NE) * UPN * D, 1, 0);
            convert_batch<0>(c, args.in[18] + (size_t)l * NE * ED * D, ED, D, WDN + (size_t)l * NEX * D * ED, NE, (size_t)D * ED);
            convert_batch<0>(c, args.in[20] + (size_t)l * ED * D, ED, D, WDN + ((size_t)l * NEX + NE) * D * ED, 1, 0);
#endif
        }
#endif
        convert_router(c, args.in[15], (bf16*)(ws + WS_WRT));
        __syncthreads();
        ada_phase(c, cin, w_ada, b_ada, ada);
    })
    SEAM(0);
    PHASE(1, norm_phase(c, XIN, norm_mix, ada, 0, D, XN);)
    SEAM(1);
#if USE_PG8_QKV
    PHASE(2, qkv_tuned<0>(c, ws, args.in[7]);)
    SEAM(2);
#else
    PHASE(2, gemm_plain_bf16(c, XN, W0IN, D, AB_IN, QKV);)
    SEAM(2);
#endif
#if USE_ATT0
    static_assert(USE_PG8_QKV, "the tuned attention needs Q pre-scaled by the QKV epilogue");
    #if DEFER_CONV
    PHASE(3, { const int xs_ = vcu_of(blockIdx.x, gridDim.x) & 15;
        attn0_tuned_phase(c, QKV, args.in[8], (bf16*)(ws + WS_TMP), (float*)(ws + WS_TMP + (size_t)3 * M * 1024 * 2), OBUF, 0, xs_ + 1);
        { const int cshare = (EXP_ITEMS + (int)gridDim.x - 1) / (int)gridDim.x, cfirst = blockIdx.x * cshare, ccount = (cfirst + cshare <= EXP_ITEMS) ? cshare : (EXP_ITEMS > cfirst ? EXP_ITEMS - cfirst : 0);
          expert_items_block(c, ExpertSrc{args.in[17], args.in[19], args.in[18], args.in[20]}, 0, ws, cfirst, ccount); __syncthreads(); }
        attn0_tuned_phase(c, QKV, args.in[8], (bf16*)(ws + WS_TMP), (float*)(ws + WS_TMP + (size_t)3 * M * 1024 * 2), OBUF, xs_ + 1, 16); })
#else
    PHASE(3, attn0_tuned_phase(c, QKV, args.in[8], (bf16*)(ws + WS_TMP), (float*)(ws + WS_TMP + (size_t)3 * M * 1024 * 2), OBUF, 0, 16);)
#endif
    SEAM(3);
    PHASE(4, attn0_merge_phase(c, (const bf16*)(ws + WS_TMP), (const float*)(ws + WS_TMP + (size_t)3 * M * 1024 * 2), OBUF);)
    SEAM(4);
#else
#if !USE_PG8_QKV
    PHASE(3, qknorm0_phase(c, QKV, args.in[7]);)
#endif
    SEAM(3);
    PHASE(4, attn0_phase(c, QKV, args.in[8], OBUF);)
    SEAM(4);
#endif
#if USE_PG8_OUT
    PHASE(5, { pg8::PlainSched S; S.o.init(M / 256, D / 256, gridDim.x, blockIdx.x); S.Bt = (const char*)W0OUT; S.K = D;
        outproj_epi<0>(c, ws, S, XIN, ada + 2 * D); })
#else
    PHASE(5, gemm_outproj(c, OBUF, W0OUT, XIN, ada + 2 * D, X1);)
#endif
    SEAM(5);
#if USE_ROUTER2
    PHASE(6, router2_phase(c, X1, norm_ffn, ada, (const bf16*)(ws + WS_WRT), args.in[16], HF, IDX, GATE, (int*)(ws + WS_WCNT), (bf16*)(ws + WS_HFB));)
    SEAM(6);
    PHASE(7, slot2_phase(c, IDX, (const int*)(ws + WS_WCNT), c.ctl + CW_NRT, POS, SLOTTOK, TILEEXP);)
#else
    PHASE(6, router_phase(c, X1, norm_ffn, ada, args.in[15], args.in[16], HF, IDX, GATE, c.ctl + CW_CNT);)
    SEAM(6);
    PHASE(7, slot_phase(c, IDX, c.ctl + CW_CNT, c.ctl + CW_CUR, c.ctl + CW_NRT, POS, SLOTTOK, TILEEXP);)
#endif
    SEAM(7);
#if USE_PG8_MOE
    PHASE(8, moe_up_tuned<0>(c, ws);)
    SEAM(8);
    PHASE(9, moe_down_tuned<0>(c, ws);)
#else
    PHASE(8, moe_up_phase(c, HF, WUP, SLOTTOK, TILEEXP, c.ctl + CW_NRT, ACT);)
    SEAM(8);
    PHASE(9, moe_down_phase(c, ACT, WDN, TILEEXP, c.ctl + CW_NRT, Y);)
#endif
    SEAM(9);
    PHASE(10, combine_phase<true>(c, X1, Y, POS, GATE, ada, RES_BF16 ? (float*)(ws + WS_X1 + (size_t)M * D * 2) : OUTP, norm_mix + D, ada + (size_t)4 * 6 * D, XN);)
    SEAM(10);
#define ada1 (ada + (size_t)4 * 6 * D)
#if USE_PG8_QKV
    PHASE(11, qkv_tuned<1>(c, ws, args.in[11]);)
    SEAM(11);
    SEAM(12);
#else
    PHASE(11, gemm_plain_bf16(c, XN, W1IN, D, C_IN, QKV);)
    SEAM(11);
    PHASE(12, qknorm1_phase(c, QKV, args.in[11]);)
    SEAM(12);
#endif
#if USE_ATT1
    PHASE(13, attn1_tuned_phase(c, QKV, args.in[11], (bf16*)TMP, c.ctl + CW_QCTR, ExpertSrc{args.in[17], args.in[19], args.in[18], args.in[20]}, ws, args.in[12], args.in[13], OBUF);)
    SEAM(13);
#if !FUSE_FINISH
    PHASE(14, attn1_finish_bf16_phase(c, (const bf16*)TMP, args.in[12], args.in[13], OBUF);)
#endif
    SEAM(14);
#else
    PHASE(13, attn1_phase(c, QKV, TMP);)
    SEAM(13);
    PHASE(14, attn1_finish_phase(c, TMP, args.in[12], args.in[13], OBUF);)
    SEAM(14);
#endif
#if USE_PG8_OUT
    PHASE(15, { pg8::PlainSched S; S.o.init(M / 256, D / 256, gridDim.x, blockIdx.x); S.Bt = (const char*)W1OUT; S.K = D;
        outproj_epi<1>(c, ws, S, OUTP, ada1 + 2 * D); })
#else
    PHASE(15, gemm_outproj(c, OBUF, W1OUT, OUTP, ada1 + 2 * D, X1);)
#endif
    SEAM(15);
#if USE_ROUTER2
    PHASE(16, router2_phase(c, X1, norm_ffn + D, ada1, (const bf16*)(ws + WS_WRT) + (size_t)2 * NE * D, args.in[16] + NE, HF, IDX, GATE, (int*)(ws + WS_WCNT), (bf16*)(ws + WS_HFB));)
    SEAM(16);
    PHASE(17, slot2_phase(c, IDX, (const int*)(ws + WS_WCNT), c.ctl + CW_NRT + 1, POS, SLOTTOK, TILEEXP);)
#else
    PHASE(16, router_phase(c, X1, norm_ffn + D, ada1, args.in[15] + (size_t)D * NE, args.in[16] + NE, HF, IDX, GATE, c.ctl + CW_CNT + 64);)
    SEAM(16);
    PHASE(17, slot_phase(c, IDX, c.ctl + CW_CNT + 64, c.ctl + CW_CUR + 64, c.ctl + CW_NRT + 1, POS, SLOTTOK, TILEEXP);)
#endif
    SEAM(17);
#if USE_PG8_MOE
    PHASE(18, moe_up_tuned<1>(c, ws);)
    SEAM(18);
    PHASE(19, moe_down_tuned<1>(c, ws);)
#else
    PHASE(18, moe_up_phase(c, HF, WUP + (size_t)NEX * UPN * D, SLOTTOK, TILEEXP, c.ctl + CW_NRT + 1, ACT);)
    SEAM(18);
    PHASE(19, moe_down_phase(c, ACT, WDN + (size_t)NEX * D * ED, TILEEXP, c.ctl + CW_NRT + 1, Y);)
#endif
    SEAM(19);
    PHASE(20, combine_phase<false>(c, X1, Y, POS, GATE, ada1, OUTP, nullptr, nullptr, nullptr);)
#if PROBE_SEL >= 0
    {
        __syncthreads();
        unsigned long long v = 0ull;
        if (c.tid == 0) {
            if (PROBE_SEL >= 100) { const int k = PROBE_SEL - 100; v = stamp_[2 + 2 * k] - (k == 0 ? stamp_[0] : stamp_[2 + 2 * (k - 1)]); }
            else if (PROBE_SEL == 1 || PROBE_SEL == 2) { for (int k = 0; k < NPHASE - 1; ++k) v += stamp_[2 + 2 * k] - stamp_[1 + 2 * k]; }
            else if (PROBE_SEL == 3) { v = stamp_[1 + 2 * 19] - stamp_[0]; }
        }
        if (PROBE_SEL == 2) {
            if (c.tid == 0) __hip_atomic_fetch_add((unsigned long long*)(c.ctl + CW_QCTR + 64), v, __ATOMIC_RELAXED, __HIP_MEMORY_SCOPE_AGENT);
            xcd_barrier(bar);
            if (c.tid == 0) v = __hip_atomic_load((unsigned long long*)(c.ctl + CW_QCTR + 64), __ATOMIC_RELAXED, __HIP_MEMORY_SCOPE_AGENT) / gridDim.x;
        }
        if (blockIdx.x == 0 && c.tid == 0) { const unsigned long long t0 = __builtin_amdgcn_s_memrealtime(), w = v * PROBE_GAIN;
            while (__builtin_amdgcn_s_memrealtime() - t0 < w) __builtin_amdgcn_s_sleep(8); }
    }
#endif
#undef IN
#undef SEAM
#undef ada
#undef ada1
#undef W0IN
#undef W0OUT
#undef W1IN
#undef W1OUT
#undef WUP
#undef WDN
#undef XN
#undef QKV
#undef OBUF
#undef X1
#undef HF
#undef IDX
#undef GATE
#undef POS
#undef SLOTTOK
#undef TILEEXP
#undef ACT
#undef Y
#undef TMP
#undef XIN
#undef cin
#undef norm_mix
#undef norm_ffn
#undef w_ada
#undef b_ada
#undef OUTP
}

extern "C" void kernel_launch(void* const* d_in, const int* in_sizes, int n_in, void* d_out, int out_size, void* d_ws, size_t ws_size, hipStream_t stream) {
    static int grid = 0;
    if (grid == 0) {
        if (n_in != 21 || out_size != M * D || ws_size < WS_END) { fprintf(stderr, "kernel_launch: unexpected sizes (n_in %d out %d ws %zu need %zu)\n", n_in, out_size, ws_size, (size_t)WS_END); grid = -1; return; }
        int dev = 0, cus = 0, per_cu = 0;
        hipGetDevice(&dev); hipDeviceGetAttribute(&cus, hipDeviceAttributeMultiprocessorCount, dev);
        if (hipFuncSetAttribute((const void*)mega, hipFuncAttributeMaxDynamicSharedMemorySize, LDS_BYTES) != hipSuccess) { fprintf(stderr, "kernel_launch: hipFuncSetAttribute failed\n"); grid = -1; return; }
        hipOccupancyMaxActiveBlocksPerMultiprocessor(&per_cu, (const void*)mega, 512, LDS_BYTES);
        (void)hipGetLastError();
        if (per_cu < 1) fprintf(stderr, "kernel_launch: occupancy query says %d blocks per CU\n", per_cu);
        grid = cus;
    }
    if (grid < 0) return;
    hipMemsetAsync((char*)d_ws + WS_CTL, 0, CTL_BYTES, stream);
    Args a{};
    for (int i = 0; i < 21; ++i) a.in[i] = (const float*)d_in[i];
    a.out = (float*)d_out; a.ws = (unsigned char*)d_ws;
#if MK_SPLIT
    for (int p = 0; p < NPHASE; ++p) { a.ph_lo = p; a.ph_hi = p + 1; hipLaunchKernelGGL(mega, dim3(grid), dim3(512), LDS_BYTES, stream, a); }
#else
    a.ph_lo = 0; a.ph_hi = NPHASE; hipLaunchKernelGGL(mega, dim3(grid), dim3(512), LDS_BYTES, stream, a);
#endif
}
```

```cpp
#include <hip/hip_runtime.h>
#include <cstdio>
#include <cstdint>
#include <hip/hip_bf16.h>

#ifndef USE_PG8_OUT
#define USE_PG8_OUT 1
#endif
#ifndef USE_PG8_QKV
#define USE_PG8_QKV 1
#endif
#ifndef USE_PG8_MOE
#define USE_PG8_MOE 1
#endif
#ifndef USE_ATT1
#define USE_ATT1 1
#endif
#ifndef USE_ATT0
#define USE_ATT0 1
#endif
#ifndef USE_ROUTER2
#define USE_ROUTER2 1
#endif
#ifndef REPMASK
#define REPMASK 0u
#endif
#ifndef USE_FP8_MOE
#define USE_FP8_MOE 1
#endif
#ifndef USE_CONV128
#define USE_CONV128 1
#endif
#ifndef USE_FP8_QKV
#define USE_FP8_QKV 1
#endif
#ifndef SHARED_BF16
#define SHARED_BF16 0
#endif
#ifndef Y_FP8
#define Y_FP8 1
#endif
#ifndef DEFER_CONV
#define DEFER_CONV 1
#endif
#ifndef RES_BF16
#define RES_BF16 1
#endif
#ifndef FUSE_FINISH
#define FUSE_FINISH 1
#endif
#ifndef PROBE_SEL
#define PROBE_SEL -1
#endif
#ifndef PROBE_GAIN
#define PROBE_GAIN 4
#endif
#ifndef QKV_HEADMAJOR
#define QKV_HEADMAJOR 1
#endif
#ifndef USE_V128
#define USE_V128 1
#endif
#ifndef MK_SPLIT
#define MK_SPLIT 0
#endif

constexpr int D = 2048, NB = 4, T = 4096, M = NB * T;
constexpr int HD = 64;
constexpr int AB_IN = 4352, C_IN = 6144;
constexpr int NE = 64, TOPK = 8, ED = 512;
constexpr int UPN = 2 * ED;
constexpr int NEX = NE + 1;
constexpr int CAPR = M * TOPK + NE * 256;
constexpr int CAP = CAPR + M;
constexpr int MAXTILES = CAP / 256;
constexpr float RMS_EPS = 1e-6f;
constexpr int NPHASE = 21;

typedef unsigned short bf16;
typedef short bf16x8 __attribute__((ext_vector_type(8)));
typedef float f32x4 __attribute__((ext_vector_type(4)));
typedef unsigned u32x4 __attribute__((ext_vector_type(4)));
typedef unsigned u32x2 __attribute__((ext_vector_type(2)));
#define LAS __attribute__((address_space(3)))

constexpr size_t MiB = 1u << 20;
constexpr size_t WS_CTL = 0, CTL_BYTES = 1 * MiB;
constexpr size_t WS_ADA = 1 * MiB;
constexpr size_t WS_W0IN = 2 * MiB;
constexpr size_t WS_W0OUT = WS_W0IN + (size_t)AB_IN * D * 2;
constexpr size_t WS_W1IN = WS_W0OUT + (size_t)D * D * 2;
constexpr size_t WS_W1OUT = WS_W1IN + (size_t)C_IN * D * 2;
constexpr size_t WS_WUP = WS_W1OUT + (size_t)D * D * 2;
constexpr size_t WS_WDN = WS_WUP + (size_t)2 * NEX * UPN * D * 2;
constexpr size_t WS_XN = WS_WDN + (size_t)2 * NEX * D * ED * 2;
constexpr size_t WS_QKV = WS_XN + (size_t)M * D * 2;
constexpr size_t WS_O = WS_QKV + (size_t)M * C_IN * 2;
constexpr size_t WS_X1 = WS_O + (size_t)M * D * 2;
constexpr size_t WS_HF = WS_X1 + (size_t)M * D * 4;
constexpr size_t WS_IDX = WS_HF + (size_t)M * D * 2;
constexpr size_t WS_GATE = WS_IDX + (size_t)M * 8 * 4;
constexpr size_t WS_POS = WS_GATE + (size_t)M * 8 * 4;
constexpr size_t WS_SLOTTOK = WS_POS + (size_t)M * 8 * 4;
constexpr size_t WS_TILEEXP = WS_SLOTTOK + (size_t)CAP * 4;
constexpr size_t WS_ACT = WS_TILEEXP + 4096;
constexpr size_t WS_Y = WS_ACT + (size_t)CAP * ED * 2;
constexpr size_t WS_TMP = WS_Y + (size_t)CAP * D * 2;
constexpr size_t WS_WRT = WS_TMP + (size_t)M * 16 * 2 * 128 * 4;
constexpr size_t WS_WCNT = WS_WRT + (size_t)2 * 2 * NE * D * 2;
constexpr size_t WS_HFB = WS_WCNT + (size_t)4096 * 64 * 4;
constexpr size_t WS_ACTS = WS_HFB + (size_t)M * D * 2;
constexpr size_t WS_WUPS = WS_ACTS + (size_t)M * ED * 2;
constexpr size_t WS_WDNS = WS_WUPS + (size_t)2 * UPN * D * 2;
constexpr size_t WS_END = WS_WDNS + (size_t)2 * D * ED * 2;
constexpr int CW_BAR = 4096;
constexpr int CW_CNT = 16384;
constexpr int CW_CUR = 16384 + 256;
constexpr int CW_NRT = 16384 + 512;
constexpr int CW_QCTR = 16384 + 1024;

constexpr int LDS_BYTES = 147456;

__device__ __forceinline__ unsigned pk4_fp8(float a, float b, float c2, float d);
constexpr float F8_WSCALE = 256.f, F8_HSCALE = 16.f, F8_ASCALE = 8.f, F8_YSCALE = 32.f;
__device__ __forceinline__ float bf2f(unsigned v) { return __uint_as_float(v << 16); }
__device__ __forceinline__ unsigned f2bf(float f) { unsigned u = __float_as_uint(f); return (u + 0x7fffu + ((u >> 16) & 1u)) >> 16; }
__device__ __forceinline__ unsigned pk2(float lo, float hi) { return f2bf(lo) | (f2bf(hi) << 16); }
__device__ __forceinline__ float wave_sum(float v) {
#pragma unroll
    for (int o = 1; o < 64; o <<= 1) v += __shfl_xor(v, o);
    return v;
}
__device__ __forceinline__ float siluf(float x) { return x / (1.f + __expf(-x)); }

#define XB_TMO      128
#define XB_XCNT(j)  (256  + 64 * (j))
#define XB_XSUB(j)  (1280 + 64 * (j))
#define XB_XGEN(j)  (2304 + 64 * (j))
#define XB_TOP      3328
#define XB_TOPGEN   3392
#define XCD_BAR_WORDS 3456
#define XB_SPIN_CAP (1u << 22)
__device__ __forceinline__ unsigned xb_ld(unsigned* p)              { return __hip_atomic_load(p, __ATOMIC_RELAXED, __HIP_MEMORY_SCOPE_AGENT); }
__device__ __forceinline__ unsigned xb_add(unsigned* p, unsigned v) { return __hip_atomic_fetch_add(p, v, __ATOMIC_RELAXED, __HIP_MEMORY_SCOPE_AGENT); }
__device__ __forceinline__ unsigned xb_xcc_id() { return (unsigned)__builtin_amdgcn_s_getreg((3 << 11) | 20) & 0xFu; }
#define XB_SPIN(cond, bar) do { unsigned _sp = 0; while (cond) { __builtin_amdgcn_s_sleep(1); \
    if ((++_sp & 255u) == 0u) { if (xb_ld(&(bar)[XB_TMO])) break; if (_sp > XB_SPIN_CAP) { atomicAdd(&(bar)[XB_TMO], 1u); break; } } } } while (0)
struct XcdBarrier { unsigned* bar; unsigned x; volatile LAS unsigned* st; };
__device__ __forceinline__ XcdBarrier xcd_barrier_post(unsigned* bar, volatile LAS unsigned* st) {
    XcdBarrier b; b.bar = bar; b.x = xb_xcc_id(); b.st = st;
    if (threadIdx.x == 0) (void)xb_add(&bar[XB_XCNT(b.x)], 1u);
    return b;
}
__device__ __forceinline__ void xcd_barrier_complete(unsigned* bar, unsigned x, unsigned& nloc, unsigned& nx) {
    const unsigned G = gridDim.x * gridDim.y * gridDim.z;
    unsigned sum, cnt, mine, sp = 0u;
    for (;;) {
        sum = 0u; cnt = 0u; mine = 0u;
#pragma unroll
        for (unsigned j = 0; j < 16; ++j) { const unsigned c = xb_ld(&bar[XB_XCNT(j)]); sum += c; cnt += (c > 0u) ? 1u : 0u; mine = (j == x) ? c : mine; }
        if (sum == G) break;
        __builtin_amdgcn_s_sleep(1);
        if ((++sp & 255u) == 0u) { if (xb_ld(&bar[XB_TMO])) break; if (sp > XB_SPIN_CAP) { atomicAdd(&bar[XB_TMO], 1u); break; } }
    }
    nloc = mine > 0u ? mine : 1u; nx = cnt > 0u ? cnt : 1u;
}
__device__ __forceinline__ void xcd_barrier(const XcdBarrier& b) {
    asm volatile("s_waitcnt vmcnt(0)" ::: "memory");
    __syncthreads();
    if (threadIdx.x == 0) {
        unsigned* bar = b.bar;
        __builtin_amdgcn_s_waitcnt(0);
        unsigned nloc = b.st[0], nx = b.st[1];
        if (nloc == 0u) { xcd_barrier_complete(bar, b.x, nloc, nx); b.st[0] = nloc; b.st[1] = nx; }
        const unsigned old = xb_add(&bar[XB_XSUB(b.x)], 1u);
        const unsigned gen = old / nloc;
        if (old + 1u == (gen + 1u) * nloc) {
            __builtin_amdgcn_fence(__ATOMIC_RELEASE, "agent");
            asm volatile("s_waitcnt vmcnt(0)" ::: "memory");
            const unsigned og = xb_add(&bar[XB_TOP], 1u);
            const unsigned tg = og / nx;
            if (og + 1u == (tg + 1u) * nx) xb_add(&bar[XB_TOPGEN], 1u);
            else XB_SPIN(xb_ld(&bar[XB_TOPGEN]) == tg, bar);
            __builtin_amdgcn_fence(__ATOMIC_ACQUIRE, "agent");
            xb_add(&bar[XB_XGEN(b.x)], 1u);
            asm volatile("s_waitcnt vmcnt(0)" ::: "memory");
        } else {
            XB_SPIN(xb_ld(&bar[XB_XGEN(b.x)]) == gen, bar);
            __builtin_amdgcn_fence(__ATOMIC_ACQUIRE, "agent");
            asm volatile("s_waitcnt vmcnt(0)" ::: "memory");
        }
    }
    __syncthreads();
}

struct Args {
    const float* in[21];
    float* out;
    unsigned char* ws;
    int ph_lo, ph_hi;
};

struct Ctx {
    int tid, lane, wave, gw, ngw, gsz;
    LAS unsigned char* lds;
    unsigned char* ws;
    unsigned* ctl;
};

__device__ __forceinline__ int gtid_now() { int t = (int)(blockIdx.x * 512u + threadIdx.x); asm volatile("" : "+v"(t)); return t; }
template <int MODE> __device__ __forceinline__ int perm_row(int n) {
    if (MODE == 1) { const int nl = n & 255; return (n & ~255) + 128 * ((nl >> 5) & 1) + 32 * (nl >> 6) + (nl & 31); }
    if (MODE == 2) { const int bj = n >> 9, rem = n & 511; return 256 * (rem >> 7) + 128 * bj + (rem & 127); }
    if (MODE == 3) { const int cl = n & 255; return (n & ~255) + 128 * ((cl >> 3) & 1) + 32 * (cl >> 6) + 8 * ((cl >> 4) & 3) + (cl & 7); }
    return n;
}
template <int MODE> __device__ __forceinline__ void transpose_item(const float* W, int K, int N, bf16* WT, LAS float* scr, int item, int lane) {
    const int nblk = N / 32, kb = item / nblk, nb = item % nblk, k0 = 64 * kb, n0 = 32 * nb, d0 = perm_row<MODE>(n0);
#pragma unroll 8
    for (int i = 0; i < 32; ++i) { const int kk = 2 * i + (lane >> 5); scr[kk * 33 + (lane & 31)] = W[(size_t)(k0 + kk) * N + n0 + (lane & 31)]; }
    asm volatile("s_waitcnt lgkmcnt(0)" ::: "memory");
    const int c = lane & 7;
#pragma unroll
    for (int j = 0; j < 4; ++j) { const int n = (lane >> 3) + 8 * j; const LAS float* s = scr + (8 * c) * 33 + n;
        u32x4 o; o.x = pk2(s[0 * 33], s[1 * 33]); o.y = pk2(s[2 * 33], s[3 * 33]); o.z = pk2(s[4 * 33], s[5 * 33]); o.w = pk2(s[6 * 33], s[7 * 33]);
        *(u32x4*)(WT + (size_t)(d0 + n) * K + k0 + 8 * c) = o; }
    asm volatile("s_waitcnt lgkmcnt(0)" ::: "memory");
}
template <int MODE> __device__ __forceinline__ void convert_batch(const Ctx& c, const float* src, int K, int N, bf16* dst, int nmat, size_t dst_stride) {
    LAS float* scr = (LAS float*)(c.lds + c.wave * 16384);
    const int per = (K / 64) * (N / 32); const long total = (long)per * nmat;
    for (long it = c.gw; it < total; it += c.ngw) {
        const int mat = (int)(it / per), item = (int)(it % per);
        transpose_item<MODE>(src + (size_t)mat * K * N, K, N, dst + (size_t)mat * dst_stride, scr, item, c.lane);
    }
}

__device__ __forceinline__ float clamp448(float v) { return __builtin_amdgcn_fmed3f(v, -448.f, 448.f); }
__device__ __forceinline__ unsigned pk4_fp8(float a, float b, float c2, float d) {
    unsigned w = 0u; w = __builtin_amdgcn_cvt_pk_fp8_f32(clamp448(a), clamp448(b), w, false); w = __builtin_amdgcn_cvt_pk_fp8_f32(clamp448(c2), clamp448(d), w, true); return w;
}
template <int MODE> __device__ __forceinline__ void transpose_item_f8(const float* W, int K, int N, unsigned char* WT, LAS float* scr, int item, int lane) {
    const int nblk = N / 32, kb = item / nblk, nb = item % nblk, k0 = 64 * kb, n0 = 32 * nb, d0 = perm_row<MODE>(n0);
#pragma unroll 8
    for (int i = 0; i < 32; ++i) { const int kk = 2 * i + (lane >> 5); scr[kk * 33 + (lane & 31)] = W[(size_t)(k0 + kk) * N + n0 + (lane & 31)]; }
    asm volatile("s_waitcnt lgkmcnt(0)" ::: "memory");
    const int n = lane & 31;
#pragma unroll
    for (int j = 0; j < 2; ++j) { const int ch = (lane >> 5) + 2 * j; const LAS float* s = scr + (16 * ch) * 33 + n; u32x4 o;
#pragma unroll
        for (int q = 0; q < 4; ++q) o[q] = pk4_fp8(s[(4 * q) * 33] * F8_WSCALE, s[(4 * q + 1) * 33] * F8_WSCALE, s[(4 * q + 2) * 33] * F8_WSCALE, s[(4 * q + 3) * 33] * F8_WSCALE);
        *(u32x4*)(WT + (size_t)(d0 + n) * K + k0 + 16 * ch) = o; }
    asm volatile("s_waitcnt lgkmcnt(0)" ::: "memory");
}
template <int MODE> __device__ __forceinline__ void convert_batch_f8(const Ctx& c, const float* src, int K, int N, unsigned char* dst, int nmat, size_t dst_stride) {
    LAS float* scr = (LAS float*)(c.lds + c.wave * 16384);
    const int per = (K / 64) * (N / 32); const long total = (long)per * nmat;
    for (long it = c.gw; it < total; it += c.ngw) {
        const int mat = (int)(it / per), item = (int)(it % per);
        transpose_item_f8<MODE>(src + (size_t)mat * K * N, K, N, dst + (size_t)mat * dst_stride, scr, item, c.lane);
    }
}

__device__ __forceinline__ void t128_load(f32x4 (&v)[16], const float* W, int N, int item, int lane) {
    const int nblk = N / 32, kb = item / nblk, nb = item % nblk, k0 = 128 * kb, n0 = 32 * nb;
    const int kr = lane >> 3, nq = lane & 7;
#pragma unroll
    for (int i = 0; i < 16; ++i) v[i] = *(const f32x4*)(W + (size_t)(k0 + 8 * i + kr) * N + n0 + 4 * nq);
}
template <int MODE, bool F8> __device__ __forceinline__ void t128_finish(const f32x4 (&v)[16], int K, int N, unsigned char* WT, LAS float* scr, int item, int lane, float scale) {
    const int nblk = N / 32, kb = item / nblk, nb = item % nblk, k0 = 128 * kb, n0 = 32 * nb, d0 = perm_row<MODE>(n0);
    const int kr = lane >> 3, nq = lane & 7;
#pragma unroll
    for (int i = 0; i < 16; ++i) { LAS float* s = scr + (8 * i + kr) * 33 + 4 * nq; s[0] = v[i].x; s[1] = v[i].y; s[2] = v[i].z; s[3] = v[i].w; }
    asm volatile("s_waitcnt lgkmcnt(0)" ::: "memory");
    const int n = lane & 31, half = lane >> 5; const LAS float* s0 = scr + (64 * half) * 33 + n;
    if (F8) {
        const int rs = lane >> 2, pc = lane & 3; (void)s0; (void)half;
#pragma unroll
        for (int it = 0; it < 4; ++it) { const int nn = rs + 16 * (it & 1), hs = it >> 1; const LAS float* s = scr + (64 * hs + 16 * pc) * 33 + nn; u32x4 o;
#pragma unroll
            for (int q = 0; q < 4; ++q) o[q] = pk4_fp8(s[(4 * q) * 33] * scale, s[(4 * q + 1) * 33] * scale, s[(4 * q + 2) * 33] * scale, s[(4 * q + 3) * 33] * scale);
            *(u32x4*)(WT + (size_t)(MODE == 3 ? perm_row<MODE>(n0 + nn) : d0 + nn) * K + k0 + 64 * hs + 16 * pc) = o; }
    } else {
        bf16* dst = (bf16*)WT + (size_t)(d0 + n) * K + k0 + 64 * half;
#pragma unroll
        for (int ch = 0; ch < 8; ++ch) { const LAS float* s = s0 + (8 * ch) * 33; u32x4 o;
#pragma unroll
            for (int q = 0; q < 4; ++q) o[q] = pk2(s[(2 * q) * 33], s[(2 * q + 1) * 33]);
            *(u32x4*)(dst + 8 * ch) = o; }
    }
    asm volatile("s_waitcnt lgkmcnt(0)" ::: "memory");
}
template <int MODE, bool F8> __device__ __forceinline__ void transpose_item128(const float* W, int K, int N, unsigned char* WT, LAS float* scr, int item, int lane, float scale) {
    asm volatile("" : "+v"(lane));
    f32x4 v[16];
    t128_load(v, W, N, item, lane);
    t128_finish<MODE, F8>(v, K, N, WT, scr, item, lane, scale);
}
template <int QM, bool F8Q> __device__ __forceinline__ void convert_dense_all(const Ctx& c, const float* w0in, const float* w1in, const float* w0out, const float* w1out,
                                                                              unsigned char* W0IN_, unsigned char* W1IN_, unsigned char* W0OUT_, unsigned char* W1OUT_, float sq) {
    constexpr int n0 = 16 * (AB_IN / 32), n1 = 16 * (C_IN / 32), n2 = 16 * (D / 32), TOT = n0 + n1 + 2 * n2;
    LAS float* scr = (LAS float*)(c.lds + c.wave * 16896);
    const int lane = c.lane, ngw = c.ngw;
#define DENSE_LOAD(v, it) do { if ((it) < n0) t128_load(v, w0in, AB_IN, (it), lane); else if ((it) < n0 + n1) t128_load(v, w1in, C_IN, (it) - n0, lane); \
        else if ((it) < n0 + n1 + n2) t128_load(v, w0out, D, (it) - n0 - n1, lane); else t128_load(v, w1out, D, (it) - n0 - n1 - n2, lane); } while (0)
#define DENSE_FIN(v, it) do { if ((it) < n0 + n1) { const bool f_ = (it) < n0; t128_finish<QM, F8Q>(v, D, f_ ? AB_IN : C_IN, f_ ? W0IN_ : W1IN_, scr, f_ ? (it) : (it) - n0, lane, sq); } \
        else { const bool f_ = (it) < n0 + n1 + n2; t128_finish<0, false>(v, D, D, f_ ? W0OUT_ : W1OUT_, scr, f_ ? (it) - n0 - n1 : (it) - n0 - n1 - n2, lane, 1.f); } } while (0)
    int it = c.gw;
    f32x4 va[16], vb[16];
    if (it < TOT) DENSE_LOAD(va, it);
    while (it < TOT) {
        const int it1 = it + ngw, it2 = it1 + ngw;
        if (it1 < TOT) DENSE_LOAD(vb, it1);
        DENSE_FIN(va, it);
        if (it2 < TOT) DENSE_LOAD(va, it2);
        if (it1 < TOT) DENSE_FIN(vb, it1);
        it = it2;
    }
#undef DENSE_LOAD
#undef DENSE_FIN
}
template <int MODE, bool F8> __device__ __forceinline__ void convert_batch128(const Ctx& c, const float* src, int K, int N, void* dst, int nmat, size_t dst_stride_bytes, float scale) {
    LAS float* scr = (LAS float*)(c.lds + c.wave * 16896);
    const int per = (K / 128) * (N / 32); const long total = (long)per * nmat;
    for (long it = c.gw; it < total; it += c.ngw) {
        const int mat = (int)(it / per), item = (int)(it % per);
        transpose_item128<MODE, F8>(src + (size_t)mat * K * N, K, N, (unsigned char*)dst + (size_t)mat * dst_stride_bytes, scr, item, c.lane, scale);
    }
}

struct ExpertSrc { const float* up; const float* sup; const float* dn; const float* sdn; };
constexpr int EXP_ITEMS_UP = NE * 512, EXP_ITEMS_SUP = 512, EXP_ITEMS_DN = NE * 256, EXP_ITEMS_SDN = 256, EXP_ITEMS = EXP_ITEMS_UP + EXP_ITEMS_SUP + EXP_ITEMS_DN + EXP_ITEMS_SDN;
__device__ __forceinline__ void expert_item(const ExpertSrc& s, int l, unsigned char* ws, LAS float* scr, int it, int lane) {
    unsigned char* wup = ws + WS_WUP + (size_t)l * NEX * UPN * D; unsigned char* wdn = ws + WS_WDN + (size_t)l * NEX * D * ED;
    if (it < EXP_ITEMS_UP) { const int mat = it >> 9; transpose_item128<2, true>(s.up + ((size_t)l * NE + mat) * D * UPN, D, UPN, wup + (size_t)mat * UPN * D, scr, it & 511, lane, F8_WSCALE); return; }
    it -= EXP_ITEMS_UP;
    if (it < EXP_ITEMS_SUP) { transpose_item128<2, true>(s.sup + (size_t)l * D * UPN, D, UPN, wup + (size_t)NE * UPN * D, scr, it, lane, F8_WSCALE); return; }
    it -= EXP_ITEMS_SUP;
    if (it < EXP_ITEMS_DN) { const int mat = it >> 8; transpose_item128<0, true>(s.dn + ((size_t)l * NE + mat) * ED * D, ED, D, wdn + (size_t)mat * D * ED, scr, it & 255, lane, F8_WSCALE); return; }
    it -= EXP_ITEMS_DN;
    transpose_item128<0, true>(s.sdn + (size_t)l * ED * D, ED, D, wdn + (size_t)NE * D * ED, scr, it, lane, F8_WSCALE);
}
struct ERef { const float* W; int N, item; };
__device__ __forceinline__ ERef expert_ref(const ExpertSrc& s, int l, int it) {
    if (it < EXP_ITEMS_UP) return ERef{s.up + ((size_t)l * NE + (it >> 9)) * D * UPN, UPN, it & 511};
    it -= EXP_ITEMS_UP;
    if (it < EXP_ITEMS_SUP) return ERef{s.sup + (size_t)l * D * UPN, UPN, it};
    it -= EXP_ITEMS_SUP;
    if (it < EXP_ITEMS_DN) return ERef{s.dn + ((size_t)l * NE + (it >> 8)) * ED * D, D, it & 255};
    it -= EXP_ITEMS_DN;
    return ERef{s.sdn + (size_t)l * ED * D, D, it};
}
__device__ __forceinline__ void expert_fin(const f32x4 (&v)[16], int l, unsigned char* ws, LAS float* scr, int it, int lane) {
    if (it < EXP_ITEMS_UP + EXP_ITEMS_SUP) { const bool r = it < EXP_ITEMS_UP; const int mat = r ? it >> 9 : NE, item = r ? it & 511 : it - EXP_ITEMS_UP;
        t128_finish<2, true>(v, D, UPN, ws + WS_WUP + ((size_t)l * NEX + mat) * UPN * D, scr, item, lane, F8_WSCALE); }
    else { it -= EXP_ITEMS_UP + EXP_ITEMS_SUP; const bool r = it < EXP_ITEMS_DN; const int mat = r ? it >> 8 : NE, item = r ? it & 255 : it - EXP_ITEMS_DN;
        t128_finish<Y_FP8 ? 3 : 0, true>(v, ED, D, ws + WS_WDN + ((size_t)l * NEX + mat) * D * ED, scr, item, lane, F8_WSCALE); }
}
__device__ __forceinline__ void expert_items_block(const Ctx& c, const ExpertSrc& s, int l, unsigned char* ws, int first, int count) {
    int tid = threadIdx.x; asm volatile("" : "+v"(tid));
    const int lane = tid & 63, wv = __builtin_amdgcn_readfirstlane(tid >> 6);
    LAS float* scr = (LAS float*)(c.lds + wv * 16896);
    f32x4 va[16], vb[16];
    int i = wv;
    if (i < count) { const ERef r = expert_ref(s, l, first + i); t128_load(va, r.W, r.N, r.item, lane); }
#pragma unroll 1
    while (i < count) {
        const int i1 = i + 8, i2 = i + 16;
        if (i1 < count) { const ERef r = expert_ref(s, l, first + i1); t128_load(vb, r.W, r.N, r.item, lane); }
        expert_fin(va, l, ws, scr, first + i, lane);
        if (i2 < count) { const ERef r = expert_ref(s, l, first + i2); t128_load(va, r.W, r.N, r.item, lane); }
        if (i1 < count) expert_fin(vb, l, ws, scr, first + i1, lane);
        i = i2;
    }
}
__device__ __forceinline__ void ada_phase(const Ctx& c, const float* cin, const float* w_ada, const float* b_ada, float* ada) {
    LAS float* red = (LAS float*)(c.lds);
    LAS float* sc = red + 1024;
    for (int i = c.tid; i < 4 * D; i += 512) sc[i] = siluf(cin[i]);
    __syncthreads();
    const int j = c.lane & 7, kr = c.lane >> 3;
    constexpr int NCG = 6 * D / 32;
    for (int u = blockIdx.x; u < 2 * NCG; u += gridDim.x) {
        const int l = u / NCG, cg = u % NCG;
        const int k0 = c.wave * 256 + kr;
        const float* w = w_ada + (size_t)l * D * 6 * D + (size_t)k0 * 6 * D + cg * 32 + 4 * j;
        f32x4 acc[4];
#pragma unroll
        for (int b = 0; b < 4; ++b) acc[b] = (f32x4){0.f, 0.f, 0.f, 0.f};
        f32x4 wv[32];
#pragma unroll
        for (int i = 0; i < 32; ++i) wv[i] = *(const f32x4*)(w + (size_t)(8 * i) * 6 * D);
#pragma unroll
        for (int i = 0; i < 32; ++i)
#pragma unroll
            for (int b = 0; b < 4; ++b) acc[b] += wv[i] * sc[b * D + k0 + 8 * i];
#pragma unroll
        for (int b = 0; b < 4; ++b)
#pragma unroll
            for (int q = 0; q < 4; ++q) { float t = acc[b][q]; t += __shfl_xor(t, 8); t += __shfl_xor(t, 16); t += __shfl_xor(t, 32); acc[b][q] = t; }
        if (kr == 0) {
#pragma unroll
            for (int b = 0; b < 4; ++b) *(LAS f32x4*)(red + (c.wave * 4 + b) * 32 + 4 * j) = acc[b]; }
        __syncthreads();
        if (c.tid < 128) {
            const int b = c.tid >> 5, cc = c.tid & 31; float s2 = b_ada[(size_t)l * 6 * D + cg * 32 + cc];
#pragma unroll
            for (int w8 = 0; w8 < 8; ++w8) s2 += red[(w8 * 4 + b) * 32 + cc];
            ada[((size_t)l * 4 + b) * 6 * D + cg * 32 + cc] = s2;
        }
        __syncthreads();
    }
}

__device__ __forceinline__ void load_row(const float* xrow, int lane, f32x4 (&v)[8]) {
#pragma unroll
    for (int j = 0; j < 8; ++j) v[j] = *(const f32x4*)(xrow + 4 * lane + 256 * j);
}
__device__ __forceinline__ float row_rstd(const f32x4 (&v)[8]) {
    float s = 0.f;
#pragma unroll
    for (int j = 0; j < 8; ++j) s += (v[j].x * v[j].x + v[j].y * v[j].y) + (v[j].z * v[j].z + v[j].w * v[j].w);
    return 1.f / sqrtf(wave_sum(s) * (1.f / D) + RMS_EPS);
}
__device__ __forceinline__ void modulate_row(f32x4 (&v)[8], float rstd, const float* g, const float* sh, const float* sc, int lane) {
#pragma unroll
    for (int j = 0; j < 8; ++j) { const int col = 4 * lane + 256 * j;
        const f32x4 gg = *(const f32x4*)(g + col), s1 = *(const f32x4*)(sc + col), s0 = *(const f32x4*)(sh + col);
        v[j] = v[j] * rstd * gg * (s1 + 1.f) + s0; }
}
__device__ __forceinline__ void store_row_bf16(bf16* orow, const f32x4 (&v)[8], int lane) {
#pragma unroll
    for (int j = 0; j < 8; ++j) { u32x2 w; w.x = pk2(v[j].x, v[j].y); w.y = pk2(v[j].z, v[j].w); *(u32x2*)(orow + 4 * lane + 256 * j) = w; }
}
__device__ __forceinline__ void store_row_fp8(unsigned char* orow, const f32x4 (&v)[8], int lane, float scale) {
#pragma unroll
    for (int j = 0; j < 8; ++j) *(unsigned*)(orow + 4 * lane + 256 * j) = pk4_fp8(v[j].x * scale, v[j].y * scale, v[j].z * scale, v[j].w * scale);
}
__device__ __forceinline__ void norm_phase(const Ctx& c, const float* x, const float* g, const float* ada_l  , int sh_off, int sc_off, bf16* out) {
    for (int m = c.gw; m < M; m += c.ngw) {
        const int b = m / T; f32x4 v[8]; load_row(x + (size_t)m * D, c.lane, v);
        const float rstd = row_rstd(v);
        modulate_row(v, rstd, g, ada_l + (size_t)b * 6 * D + sh_off, ada_l + (size_t)b * 6 * D + sc_off, c.lane);
#if USE_FP8_QKV
        store_row_fp8((unsigned char*)out + (size_t)m * D, v, c.lane, F8_HSCALE);
#else
        store_row_bf16(out + (size_t)m * D, v, c.lane);
#endif
    }
}

__device__ __forceinline__ void wave_gemm_32x64(const bf16* a0, const bf16* a1, const bf16* b, int K, int lane, f32x4 (&acc)[2][4]) {
    const int q8 = (lane >> 4) * 8;
    for (int k0 = 0; k0 < K; k0 += 32) {
        const bf16x8 fa0 = *(const bf16x8*)(a0 + k0 + q8), fa1 = *(const bf16x8*)(a1 + k0 + q8);
#pragma unroll
        for (int n = 0; n < 4; ++n) { const bf16x8 fb = *(const bf16x8*)(b + (size_t)n * 16 * K + k0 + q8);
            acc[0][n] = __builtin_amdgcn_mfma_f32_16x16x32_bf16(fa0, fb, acc[0][n], 0, 0, 0);
            acc[1][n] = __builtin_amdgcn_mfma_f32_16x16x32_bf16(fa1, fb, acc[1][n], 0, 0, 0); }
    }
}
#define ZERO_ACC(acc) do { _Pragma("unroll") for (int _a = 0; _a < 2; ++_a) _Pragma("unroll") for (int _b = 0; _b < 4; ++_b) acc[_a][_b] = (f32x4){0.f, 0.f, 0.f, 0.f}; } while (0)

__device__ __forceinline__ void gemm_plain_bf16(const Ctx& c, const bf16* A, const bf16* Bt, int K, int N, bf16* C) {
    const int ntn = N / 64, units = (M / 256) * ntn;
    for (int u = blockIdx.x; u < units; u += gridDim.x) {
        const int mt = u / ntn, nt = u % ntn, row0 = mt * 256 + c.wave * 32, n0 = nt * 64;
        f32x4 acc[2][4]; ZERO_ACC(acc);
        const int r = c.lane & 15;
        wave_gemm_32x64(A + (size_t)(row0 + r) * K, A + (size_t)(row0 + 16 + r) * K, Bt + (size_t)(n0 + r) * K, K, c.lane, acc);
#pragma unroll
        for (int mi = 0; mi < 2; ++mi)
#pragma unroll
            for (int n = 0; n < 4; ++n)
#pragma unroll
                for (int j = 0; j < 4; ++j) C[(size_t)(row0 + 16 * mi + 4 * (c.lane >> 4) + j) * N + n0 + 16 * n + r] = (bf16)f2bf(acc[mi][n][j]);
    }
}
__device__ __forceinline__ void gemm_outproj(const Ctx& c, const bf16* A, const bf16* Bt, const float* xin, const float* gm  , float* X1) {
    const int K = D, N = D, ntn = N / 64, units = (M / 256) * ntn;
    for (int u = blockIdx.x; u < units; u += gridDim.x) {
        const int mt = u / ntn, nt = u % ntn, row0 = mt * 256 + c.wave * 32, n0 = nt * 64;
        f32x4 acc[2][4]; ZERO_ACC(acc);
        const int r = c.lane & 15;
        wave_gemm_32x64(A + (size_t)(row0 + r) * K, A + (size_t)(row0 + 16 + r) * K, Bt + (size_t)(n0 + r) * K, K, c.lane, acc);
        const int b = row0 / T;
#pragma unroll
        for (int mi = 0; mi < 2; ++mi)
#pragma unroll
            for (int n = 0; n < 4; ++n)
#pragma unroll
                for (int j = 0; j < 4; ++j) { const size_t o = (size_t)(row0 + 16 * mi + 4 * (c.lane >> 4) + j) * N + n0 + 16 * n + r;
                    X1[o] = xin[o] + gm[(size_t)b * 6 * D + n0 + 16 * n + r] * acc[mi][n][j]; }
    }
}

__device__ __forceinline__ void qknorm_chunk(bf16* p, const float* g) {
    float v[64]; float ss = 0.f;
#pragma unroll
    for (int i = 0; i < 8; ++i) { const u32x4 w = *(const u32x4*)(p + 8 * i);
#pragma unroll
        for (int j = 0; j < 4; ++j) { v[8 * i + 2 * j] = bf2f(w[j] & 0xffffu); v[8 * i + 2 * j + 1] = bf2f(w[j] >> 16); } }
#pragma unroll
    for (int i = 0; i < 64; ++i) ss += v[i] * v[i];
    const float rs = 1.f / sqrtf(ss * (1.f / 64.f) + RMS_EPS);
#pragma unroll
    for (int i = 0; i < 8; ++i) { u32x4 w;
#pragma unroll
        for (int j = 0; j < 4; ++j) w[j] = pk2(v[8 * i + 2 * j] * rs * g[8 * i + 2 * j], v[8 * i + 2 * j + 1] * rs * g[8 * i + 2 * j + 1]);
        *(u32x4*)(p + 8 * i) = w; }
}
__device__ __forceinline__ void qknorm0_phase(const Ctx& c, bf16* qkv, const float* gains  ) {
    const long total = (long)M * 50;
    for (long id = gtid_now(); id < total; id += c.gsz) {
        const int m = (int)(id / 50), k = (int)(id % 50); int ch, gi;
        if (k < 16) { ch = k; gi = 0; } else if (k < 32) { ch = k; gi = 1; } else if (k < 48) { ch = k + 16; gi = 2; } else { ch = k + 16; gi = 3; }
        qknorm_chunk(qkv + (size_t)m * AB_IN + 64 * ch, gains + 64 * gi);
    }
}
__device__ __forceinline__ void qknorm1_phase(const Ctx& c, bf16* qkv, const float* gains  ) {
    const long total = (long)M * 64;
    for (long id = gtid_now(); id < total; id += c.gsz) {
        const int m = (int)(id / 64), ch = (int)(id % 64);
        qknorm_chunk(qkv + (size_t)m * C_IN + 64 * ch, gains + 64 * (ch >> 5));
    }
}

__device__ __forceinline__ void load64(const bf16* p, float (&v)[64], float scale) {
#pragma unroll
    for (int i = 0; i < 8; ++i) { const u32x4 w = *(const u32x4*)(p + 8 * i);
#pragma unroll
        for (int j = 0; j < 4; ++j) { v[8 * i + 2 * j] = bf2f(w[j] & 0xffffu) * scale; v[8 * i + 2 * j + 1] = bf2f(w[j] >> 16) * scale; } }
}
__device__ __forceinline__ float dot64(const float (&q)[64], const bf16* kp) {
    float s0 = 0.f, s1 = 0.f;
#pragma unroll
    for (int i = 0; i < 8; ++i) { const u32x4 w = *(const u32x4*)(kp + 8 * i);
#pragma unroll
        for (int j = 0; j < 4; ++j) { s0 += q[8 * i + 2 * j] * bf2f(w[j] & 0xffffu); s1 += q[8 * i + 2 * j + 1] * bf2f(w[j] >> 16); } }
    return s0 + s1;
}
__device__ __forceinline__ void axpy64(float (&o)[64], float a, float p, const bf16* vp) {
#pragma unroll
    for (int i = 0; i < 8; ++i) { const u32x4 w = *(const u32x4*)(vp + 8 * i);
#pragma unroll
        for (int j = 0; j < 4; ++j) { o[8 * i + 2 * j] = o[8 * i + 2 * j] * a + p * bf2f(w[j] & 0xffffu); o[8 * i + 2 * j + 1] = o[8 * i + 2 * j + 1] * a + p * bf2f(w[j] >> 16); } }
}
__device__ __forceinline__ void store64_bf16(bf16* p, const float (&o)[64], float s) {
#pragma unroll
    for (int i = 0; i < 8; ++i) { u32x4 w;
#pragma unroll
        for (int j = 0; j < 4; ++j) w[j] = pk2(o[8 * i + 2 * j] * s, o[8 * i + 2 * j + 1] * s);
        *(u32x4*)(p + 8 * i) = w; }
}
__device__ __forceinline__ void attn0_phase(const Ctx& c, const bf16* qkv, const float* sinks, bf16* O) {
    const long total = (long)32 * M;
    for (long id = gtid_now(); id < total; id += c.gsz) {
        const int hh = (int)(id / M), m = (int)(id % M), b = m / T, t = m % T;
        float q[64], o[64];
#pragma unroll
        for (int i = 0; i < 64; ++i) o[i] = 0.f;
        float mx = -1e30f, l = 0.f;
        if (hh < 16) {
            const int h = hh; const float slope = exp2f(-0.5f * (float)(h + 1));
            load64(qkv + (size_t)m * AB_IN + 64 * h, q, 0.125f);
            const bf16* kb = qkv + (size_t)b * T * AB_IN + 1024 + 64 * h;
            for (int br = 0; br < 3; ++br) {
                const int dil = br == 0 ? 1 : (br == 1 ? 4 : 16);
                for (int j = 0; j <= 128; ++j) {
                    const int s = t - dil * j; if (s < 0) break;
                    const bf16* kp = kb + (size_t)s * AB_IN;
                    const float sc = dot64(q, kp) - slope * (float)(dil * j);
                    const float mn = fmaxf(mx, sc), a = __expf(mx - mn), p = __expf(sc - mn);
                    l = l * a + p; axpy64(o, a, p, kp + 1024); mx = mn;
                }
            }
            store64_bf16(O + (size_t)m * D + 64 * h, o, 1.f / l);
        } else {
            const int h = hh - 16, kvh = h >> 3; const float slope = exp2f(-0.5f * (float)(h + 1));
            load64(qkv + (size_t)m * AB_IN + 3072 + 64 * h, q, 0.125f);
            const bf16* kb = qkv + (size_t)b * T * AB_IN + 4096 + 64 * kvh;
            for (int j = 0; j < 128; ++j) {
                const int s = t - j; if (s < 0) break;
                const bf16* kp = kb + (size_t)s * AB_IN;
                const float sc = dot64(q, kp) - slope * (float)j;
                const float mn = fmaxf(mx, sc), a = __expf(mx - mn), p = __expf(sc - mn);
                l = l * a + p; axpy64(o, a, p, kp + 128); mx = mn;
            }
            const float sk = sinks[h], mn = fmaxf(mx, sk), a = __expf(mx - mn);
            l = l * a + __expf(sk - mn);
            store64_bf16(O + (size_t)m * D + 1024 + 64 * h, o, a / l);
        }
    }
}
__device__ __forceinline__ void attn1_phase(const Ctx& c, const bf16* qkv, float* tmp) {
    const int items = NB * 16 * 2 * 2 * (T / 64);
    for (int it = c.gw; it < items; it += c.ngw) {
        const int tb = (T / 64 - 1) - it / (NB * 16 * 4); const int r = it % (NB * 16 * 4);
        const int b = r / 64, h = (r / 4) % 16, i = (r >> 1) & 1, j = r & 1;
        const int t = tb * 64 + c.lane, m = b * T + t;
        const float slope = exp2f(-0.5f * (float)(h + 1));
        float q[64], o[64];
#pragma unroll
        for (int d = 0; d < 64; ++d) o[d] = 0.f;
        float mx = -1e30f, l = 0.f;
        load64(qkv + (size_t)m * C_IN + 128 * h + 64 * i, q, 0.125f);
        const bf16* kb = qkv + (size_t)b * T * C_IN + 2048 + 128 * h + 64 * i;
        const bf16* vb = qkv + (size_t)b * T * C_IN + 4096 + 128 * h + 64 * j;
        const int smax = tb * 64 + 63;
        for (int s = 0; s <= smax; ++s) {
            const bf16* kp = kb + (size_t)s * C_IN;
            float sc = dot64(q, kp) - slope * (float)(t - s);
            if (s > t) sc = -1e30f;
            const float mn = fmaxf(mx, sc), a = __expf(mx - mn), p = (s > t) ? 0.f : __expf(sc - mn);
            l = l * a + p; axpy64(o, a, p, vb + (size_t)s * C_IN); mx = mn;
        }
        float* op = tmp + (((size_t)m * 16 + h) * 2 + i) * 128 + 64 * j; const float il = 1.f / l;
#pragma unroll
        for (int d = 0; d < 16; ++d) *(f32x4*)(op + 4 * d) = (f32x4){o[4 * d] * il, o[4 * d + 1] * il, o[4 * d + 2] * il, o[4 * d + 3] * il};
    }
}
__device__ __forceinline__ void attn1_finish_phase(const Ctx& c, const float* tmp, const float* lamp  , const float* subln  , bf16* O) {
    float s01 = 0.f, s23 = 0.f;
    for (int i = 0; i < 64; ++i) { s01 += lamp[i] * lamp[64 + i]; s23 += lamp[128 + i] * lamp[192 + i]; }
    const float lam_init = 0.8f - 0.6f * expf(-0.3f * 1.0f);
    const float lam = expf(s01) - expf(s23) + lam_init;
    const long total = (long)M * 16;
    for (long id = gtid_now(); id < total; id += c.gsz) {
        const float* p1 = tmp + (size_t)id * 256; const float* p2 = p1 + 128;
        float ss = 0.f;
        for (int d = 0; d < 128; ++d) { const float v = p1[d] - lam * p2[d]; ss += v * v; }
        const float rs = (1.f - lam_init) / sqrtf(ss * (1.f / 128.f) + RMS_EPS);
        bf16* op = O + (size_t)id * 128;
        for (int d = 0; d < 128; d += 2) { const float v0 = (p1[d] - lam * p2[d]) * rs * subln[d], v1 = (p1[d + 1] - lam * p2[d + 1]) * rs * subln[d + 1];
            *(unsigned*)(op + d) = pk2(v0, v1); }
    }
}

__device__ __forceinline__ void router_phase(const Ctx& c, const float* x1, const float* g, const float* ada_l, const float* wr  , const float* rbias  ,
                                             bf16* HF, int* idx, float* gate, unsigned* counts) {
    LAS float* hb = (LAS float*)(c.lds + c.wave * 8192);
    const int lane = c.lane;
    for (int m = c.gw; m < M; m += c.ngw) {
        const int b = m / T; f32x4 v[8]; load_row(x1 + (size_t)m * D, lane, v);
        const float rstd = row_rstd(v);
        modulate_row(v, rstd, g, ada_l + (size_t)b * 6 * D + 3 * D, ada_l + (size_t)b * 6 * D + 4 * D, lane);
        store_row_bf16(HF + (size_t)m * D, v, lane);
#pragma unroll
        for (int j = 0; j < 8; ++j) *(LAS f32x4*)(hb + 4 * lane + 256 * j) = v[j];
        asm volatile("s_waitcnt lgkmcnt(0)" ::: "memory");
        float a0 = 0.f, a1 = 0.f, a2 = 0.f, a3 = 0.f;
        for (int k = 0; k < D; k += 4) {
            const f32x4 hv = *(const LAS f32x4*)(hb + k);
            a0 += hv.x * wr[(size_t)(k + 0) * 64 + lane]; a1 += hv.y * wr[(size_t)(k + 1) * 64 + lane];
            a2 += hv.z * wr[(size_t)(k + 2) * 64 + lane]; a3 += hv.w * wr[(size_t)(k + 3) * 64 + lane];
        }
        const float logit = (a0 + a1) + (a2 + a3);
        const float score = 1.f / (1.f + expf(-logit));
        const float sel = score + rbias[lane];
        float m1 = sel;
        m1 = fmaxf(m1, __shfl_xor(m1, 1)); m1 = fmaxf(m1, __shfl_xor(m1, 2)); m1 = fmaxf(m1, __shfl_xor(m1, 4));
        const unsigned long long eqm = __ballot(sel == m1);
        const int gbase = lane & ~7;
        const unsigned grp_eq = (unsigned)((eqm >> gbase) & 0xffull);
        const int first = __builtin_ctz(grp_eq);
        float m2 = ((lane & 7) == first) ? -3e38f : sel;
        m2 = fmaxf(m2, __shfl_xor(m2, 1)); m2 = fmaxf(m2, __shfl_xor(m2, 2)); m2 = fmaxf(m2, __shfl_xor(m2, 4));
        const float gs = m1 + m2;
        int grank = 0; const int mygrp = lane >> 3;
#pragma unroll
        for (int g2 = 0; g2 < 8; ++g2) { const float o = __shfl(gs, g2 * 8); grank += (o > gs || (o == gs && g2 < mygrp)) ? 1 : 0; }
        const float msel = (grank < 4) ? sel : -1e30f;
        int rank = 0;
        for (int e2 = 0; e2 < 64; ++e2) { const float o = __shfl(msel, e2); rank += (o > msel || (o == msel && e2 < lane)) ? 1 : 0; }
        const bool chosen = rank < TOPK;
        const float gsum = wave_sum(chosen ? score : 0.f);
        if (chosen) { idx[(size_t)m * 8 + rank] = lane; gate[(size_t)m * 8 + rank] = score / gsum * 2.5f;
            __hip_atomic_fetch_add(counts + lane, 1u, __ATOMIC_RELAXED, __HIP_MEMORY_SCOPE_AGENT); }
    }
}
__device__ __forceinline__ void slot_phase(const Ctx& c, const int* idx, const unsigned* counts, unsigned* cursor, unsigned* nrt_out, int* pos, int* slot_tok, int* tile_exp) {
    LAS int* ps = (LAS int*)c.lds;
    if (c.tid == 0) { int acc = 0; for (int e = 0; e < NE; ++e) { const int cn = (int)counts[e]; ps[e] = acc; ps[64 + e] = cn; acc += (cn + 255) / 256 * 256; } ps[128] = acc; }
    __syncthreads();
    for (int a = gtid_now(); a < M * TOPK; a += c.gsz) {
        const int e = idx[a]; const unsigned r = __hip_atomic_fetch_add(cursor + e, 1u, __ATOMIC_RELAXED, __HIP_MEMORY_SCOPE_AGENT);
        const int slot = ps[e] + (int)r; slot_tok[slot] = a >> 3; pos[a] = slot;
    }
    for (int t = gtid_now(); t < M; t += c.gsz) slot_tok[CAPR + t] = t;
    if (blockIdx.x == 0) {
        if (c.tid < NE) { const int e = c.tid, s0 = ps[e], cn = ps[64 + e], pe = s0 + (cn + 255) / 256 * 256;
            for (int s = s0 + cn; s < pe; ++s) slot_tok[s] = 0;
            for (int tt = s0 / 256; tt < pe / 256; ++tt) tile_exp[tt] = e; }
        if (c.tid == 0) *nrt_out = (unsigned)(ps[128] / 256);
    }
    __syncthreads();
}
__device__ __forceinline__ void moe_up_phase(const Ctx& c, const bf16* HF, const bf16* Wup_l  , const int* slot_tok, const int* tile_exp, const unsigned* nrt_p, bf16* ACT) {
    const int nrt = (int)*nrt_p, ntiles = nrt + M / 256, units = ntiles * (ED / 64);
    for (int u = blockIdx.x; u < units; u += gridDim.x) {
        const int mt = u / (ED / 64), nt = u % (ED / 64), n0 = nt * 64;
        const int e = mt < nrt ? tile_exp[mt] : NE; const int slot0 = (mt < nrt ? mt * 256 : CAPR + (mt - nrt) * 256) + c.wave * 32;
        const int r = c.lane & 15;
        const bf16* a0 = HF + (size_t)slot_tok[slot0 + r] * D; const bf16* a1 = HF + (size_t)slot_tok[slot0 + 16 + r] * D;
        const bf16* W = Wup_l + (size_t)e * UPN * D;
        f32x4 ag[2][4], au[2][4]; ZERO_ACC(ag); ZERO_ACC(au);
        wave_gemm_32x64(a0, a1, W + (size_t)(n0 + r) * D, D, c.lane, ag);
        wave_gemm_32x64(a0, a1, W + (size_t)(ED + n0 + r) * D, D, c.lane, au);
#pragma unroll
        for (int mi = 0; mi < 2; ++mi)
#pragma unroll
            for (int n = 0; n < 4; ++n)
#pragma unroll
                for (int j = 0; j < 4; ++j) ACT[(size_t)(slot0 + 16 * mi + 4 * (c.lane >> 4) + j) * ED + n0 + 16 * n + r] = (bf16)f2bf(siluf(ag[mi][n][j]) * au[mi][n][j]);
    }
}
__device__ __forceinline__ void moe_down_phase(const Ctx& c, const bf16* ACT, const bf16* Wdn_l  , const int* tile_exp, const unsigned* nrt_p, bf16* Y) {
    const int nrt = (int)*nrt_p, ntiles = nrt + M / 256, units = ntiles * (D / 64);
    for (int u = blockIdx.x; u < units; u += gridDim.x) {
        const int mt = u / (D / 64), nt = u % (D / 64), n0 = nt * 64;
        const int e = mt < nrt ? tile_exp[mt] : NE; const int slot0 = (mt < nrt ? mt * 256 : CAPR + (mt - nrt) * 256) + c.wave * 32;
        const int r = c.lane & 15;
        const bf16* W = Wdn_l + (size_t)e * D * ED;
        f32x4 acc[2][4]; ZERO_ACC(acc);
        wave_gemm_32x64(ACT + (size_t)(slot0 + r) * ED, ACT + (size_t)(slot0 + 16 + r) * ED, W + (size_t)(n0 + r) * ED, ED, c.lane, acc);
#pragma unroll
        for (int mi = 0; mi < 2; ++mi)
#pragma unroll
            for (int n = 0; n < 4; ++n)
#pragma unroll
                for (int j = 0; j < 4; ++j) Y[(size_t)(slot0 + 16 * mi + 4 * (c.lane >> 4) + j) * D + n0 + 16 * n + r] = (bf16)f2bf(acc[mi][n][j]);
    }
}
__device__ __forceinline__ void add_row_bf16(f32x4 (&acc)[8], const bf16* yrow, float w, int lane) {
#pragma unroll
    for (int j = 0; j < 8; ++j) { const u32x2 v = *(const u32x2*)(yrow + 4 * lane + 256 * j);
        acc[j].x += w * bf2f(v.x & 0xffffu); acc[j].y += w * bf2f(v.x >> 16); acc[j].z += w * bf2f(v.y & 0xffffu); acc[j].w += w * bf2f(v.y >> 16); }
}
__device__ __forceinline__ void add_row_fp8(f32x4 (&acc)[8], const unsigned char* yrow, float w, int lane) {
#pragma unroll
    for (int j = 0; j < 8; ++j) { const unsigned v = *(const unsigned*)(yrow + 4 * lane + 256 * j);
        acc[j].x += w * __builtin_amdgcn_cvt_f32_fp8(v, 0); acc[j].y += w * __builtin_amdgcn_cvt_f32_fp8(v, 1); acc[j].z += w * __builtin_amdgcn_cvt_f32_fp8(v, 2); acc[j].w += w * __builtin_amdgcn_cvt_f32_fp8(v, 3); }
}
template <bool NEXT>
__device__ __forceinline__ void combine_phase(const Ctx& c, const float* x1, const bf16* Y, const int* pos, const float* gate, const float* ada_l, float* xo,
                                              const float* gnext, const float* ada_next, bf16* XN) {
    for (int m = c.gw; m < M; m += c.ngw) {
        const int b = m / T; f32x4 acc[8];
#pragma unroll
        for (int j = 0; j < 8; ++j) acc[j] = (f32x4){0.f, 0.f, 0.f, 0.f};
#if USE_FP8_MOE && Y_FP8
        for (int k = 0; k < TOPK; ++k) add_row_fp8(acc, (const unsigned char*)Y + (size_t)pos[(size_t)m * 8 + k] * D, gate[(size_t)m * 8 + k] * (1.f / F8_YSCALE), c.lane);
        add_row_fp8(acc, (const unsigned char*)Y + (size_t)(CAPR + m) * D, 1.f / F8_YSCALE, c.lane);
#else
        for (int k = 0; k < TOPK; ++k) add_row_bf16(acc, Y + (size_t)pos[(size_t)m * 8 + k] * D, gate[(size_t)m * 8 + k], c.lane);
        add_row_bf16(acc, Y + (size_t)(CAPR + m) * D, 1.f, c.lane);
#endif
        const float* gf = ada_l + (size_t)b * 6 * D + 5 * D;
        f32x4 v[8];
#pragma unroll
        for (int j = 0; j < 8; ++j) { const int col = 4 * c.lane + 256 * j;
#if RES_BF16
            { const u32x2 xw = *(const u32x2*)((const bf16*)x1 + (size_t)m * D + col);
              v[j] = (f32x4){bf2f(xw.x & 0xffffu), bf2f(xw.x >> 16), bf2f(xw.y & 0xffffu), bf2f(xw.y >> 16)} + *(const f32x4*)(gf + col) * acc[j]; }
            if (NEXT) { u32x2 ow; ow.x = pk2(v[j].x, v[j].y); ow.y = pk2(v[j].z, v[j].w); *(u32x2*)((bf16*)xo + (size_t)m * D + col) = ow; }
            else *(f32x4*)(xo + (size_t)m * D + col) = v[j];
#else
            v[j] = *(const f32x4*)(x1 + (size_t)m * D + col) + *(const f32x4*)(gf + col) * acc[j];
            *(f32x4*)(xo + (size_t)m * D + col) = v[j];
#endif
            }
        if (NEXT) {
            const float rstd = row_rstd(v);
            modulate_row(v, rstd, gnext, ada_next + (size_t)b * 6 * D, ada_next + (size_t)b * 6 * D + D, c.lane);
#if USE_FP8_QKV
            store_row_fp8((unsigned char*)XN + (size_t)m * D, v, c.lane, F8_HSCALE);
#else
            store_row_bf16(XN + (size_t)m * D, v, c.lane);
#endif
        }
    }
}


namespace pg8 {
constexpr int BM = 256, BK = 64, HALF = 128, HTB = HALF * BK * 2, STAGE_BYTES = 8 * HTB, NXCD = 8, WGM = 8;
__device__ __forceinline__ int lds_byte(int r, int c) { const int st = (r >> 4) * 2 + (c >> 5), rr = r & 15, cc = c & 31, ob = rr * 64 + cc * 2; return st * 1024 + (ob ^ (((ob >> 9) & 1) << 5)); }
__device__ __forceinline__ void stage_rc(int b, int& R, int& C) { const int st = b / 1024, sb = b % 1024, swz = sb ^ (((sb >> 9) & 1) << 5); R = (st >> 1) * 16 + swz / 64; C = (st & 1) * 32 + (swz % 64) / 2; }
__device__ __forceinline__ int perm32(int rho) { const int n = rho >> 4, i = rho & 15; return 8 * (i >> 2) + 4 * n + (i & 3); }
__device__ __forceinline__ unsigned cvt_pk_bf16(float lo, float hi) { unsigned r; asm volatile("v_cvt_pk_bf16_f32 %0, %1, %2" : "=v"(r) : "v"(lo), "v"(hi)); return r; }

struct Unit { int row0, pn; const char* Bp; };

struct TileOrder {
    int nM, nN, nwg, G, c;
    __device__ __forceinline__ void init(int nM_, int nN_, int G_, int c_) { nM = nM_; nN = nN_; nwg = nM * nN; G = G_; c = c_; }
    __device__ __forceinline__ bool tile(int i, int& pm, int& pn) const {
        const long L = (long)i * G + c; if (L >= nwg) return false;
        int wgid = (int)L; { const int q = nwg / NXCD, r = nwg % NXCD, xcd = wgid % NXCD, off = wgid / NXCD; wgid = (xcd < r ? xcd * (q + 1) : r * (q + 1) + (xcd - r) * q) + off; }
        const int nig = WGM * nN, gid = wgid / nig, fm = gid * WGM, gsz = (nM - fm) < WGM ? (nM - fm) : WGM;
        pm = fm + ((wgid % nig) % gsz); pn = (wgid % nig) / gsz; return true;
    }
};
struct PlainSched {
    static constexpr bool GATHER = false;
    TileOrder o; const char* Bt; int K;
    __device__ __forceinline__ bool next(int i, Unit& u) const { int pm, pn; if (!o.tile(i, pm, pn)) return false; u.row0 = pm * BM; u.pn = pn; u.Bp = Bt + (size_t)pn * BM * K * 2; return true; }
    __device__ __forceinline__ unsigned arow_off(const Unit& u, int rl) const { return (unsigned)(u.row0 + rl) * (unsigned)(K * 2); }
};
template <bool GATHER_> struct GroupSched {
    static constexpr bool GATHER = GATHER_;
    TileOrder o; const char* W; size_t wstride; int K, nrt; const LAS int* tile_exp; const int* slot_tok;
    __device__ __forceinline__ bool next(int i, Unit& u) const { int pm, pn; if (!o.tile(i, pm, pn)) return false;
        const int e = pm < nrt ? tile_exp[pm] : NE; u.row0 = pm < nrt ? pm * BM : CAPR + (pm - nrt) * BM; u.pn = pn; u.Bp = W + (size_t)e * wstride + (size_t)pn * BM * K * 2; return true; }
    __device__ __forceinline__ unsigned arow_off(const Unit& u, int rl) const { const int r = GATHER ? slot_tok[u.row0 + rl] : (u.row0 + rl); return (unsigned)r * (unsigned)(K * 2); }
};

template <int LAYER> struct EpiQKV {
    static constexpr bool PERM = true;
    bf16* O; int ldc; const float* gains; float qscale, ascale;
    __device__ __forceinline__ void operator()(const f32x4 (&acc)[2][2][4][2], const Unit& u, int wr, int wc, int fr, int fq) const {
        const int head = 4 * u.pn + wc; int gi;
        if (LAYER == 0) gi = head < 16 ? 0 : head < 32 ? 1 : head < 48 ? -1 : head < 64 ? 2 : head < 66 ? 3 : -1;
        else gi = head < 32 ? 0 : head < 64 ? 1 : -1;
        f32x4 gv[2][2];
#pragma unroll
        for (int bj = 0; bj < 2; ++bj)
#pragma unroll
            for (int n = 0; n < 2; ++n) gv[bj][n] = gi >= 0 ? *(const f32x4*)(gains + 64 * gi + 32 * bj + 8 * fq + 4 * n) : (f32x4){1.f, 1.f, 1.f, 1.f};
#if QKV_HEADMAJOR
        bf16* base = O + ((size_t)head * M + (size_t)(u.row0 + wr * 64 + fr)) * 64 + 8 * fq; const int ldo = 64;
#else
        bf16* base = O + (size_t)(u.row0 + wr * 64 + fr) * ldc + 64 * head + 8 * fq; const int ldo = ldc;
#endif
#pragma unroll
        for (int ai = 0; ai < 2; ++ai)
#pragma unroll
            for (int m = 0; m < 4; ++m) {
                float ss = 0.f;
#pragma unroll
                for (int bj = 0; bj < 2; ++bj)
#pragma unroll
                    for (int n = 0; n < 2; ++n) { const f32x4 x = acc[ai][bj][m][n]; ss += (x[0] * x[0] + x[1] * x[1]) + (x[2] * x[2] + x[3] * x[3]); }
                ss += __shfl_xor(ss, 16); ss += __shfl_xor(ss, 32); ss *= ascale * ascale;
                const bool isq = LAYER == 0 ? (gi == 0 || gi == 2) : (gi == 0);
                const float rs = ascale * (gi >= 0 ? (isq ? qscale : 1.f) / sqrtf(ss * (1.f / 64.f) + RMS_EPS) : 1.f);
                bf16* rowp = base + (size_t)(ai * HALF + m * 16) * ldo;
#pragma unroll
                for (int bj = 0; bj < 2; ++bj) { const f32x4 v0 = acc[ai][bj][m][0] * rs * gv[bj][0], v1 = acc[ai][bj][m][1] * rs * gv[bj][1];
                    u32x4 w; w.x = cvt_pk_bf16(v0[0], v0[1]); w.y = cvt_pk_bf16(v0[2], v0[3]); w.z = cvt_pk_bf16(v1[0], v1[1]); w.w = cvt_pk_bf16(v1[2], v1[3]);
                    *(u32x4*)(rowp + 32 * bj) = w; }
            }
    }
};
struct EpiOut {
    static constexpr bool PERM = false;
    const float* xin; const float* gm; float* X1;
    __device__ __forceinline__ void operator()(const f32x4 (&acc)[2][2][4][2], const Unit& u, int wr, int wc, int fr, int fq) const {
        const int col0 = u.pn * BM + wc * 32 + 4 * fq; const float* g = gm + (size_t)(u.row0 / T) * 6 * D + col0;
        f32x4 gv[2][2];
#pragma unroll
        for (int bj = 0; bj < 2; ++bj)
#pragma unroll
            for (int n = 0; n < 2; ++n) gv[bj][n] = *(const f32x4*)(g + bj * HALF + n * 16);
#pragma unroll
        for (int ai = 0; ai < 2; ++ai)
#pragma unroll
            for (int m = 0; m < 4; ++m) { const size_t off = (size_t)(u.row0 + wr * 64 + fr + ai * HALF + m * 16) * D + col0;
#pragma unroll
                for (int bj = 0; bj < 2; ++bj)
#pragma unroll
                    for (int n = 0; n < 2; ++n) *(f32x4*)(X1 + off + bj * HALF + n * 16) = *(const f32x4*)(xin + off + bj * HALF + n * 16) + gv[bj][n] * acc[ai][bj][m][n]; }
    }
};

template <bool XIN_BF16> struct EpiOutB {
    static constexpr bool PERM = true;
    const void* xin; const float* gm; bf16* X1b;
    __device__ __forceinline__ void operator()(const f32x4 (&acc)[2][2][4][2], const Unit& u, int wr, int wc, int fr, int fq) const {
        const int col0 = u.pn * BM + wc * 32 + 8 * fq; const float* g = gm + (size_t)(u.row0 / T) * 6 * D + col0;
        f32x4 gv[2][2];
#pragma unroll
        for (int bj = 0; bj < 2; ++bj)
#pragma unroll
            for (int n = 0; n < 2; ++n) gv[bj][n] = *(const f32x4*)(g + bj * HALF + 4 * n);
#pragma unroll
        for (int ai = 0; ai < 2; ++ai)
#pragma unroll
            for (int m = 0; m < 4; ++m) { const size_t off = (size_t)(u.row0 + wr * 64 + fr + ai * HALF + m * 16) * D + col0;
#pragma unroll
                for (int bj = 0; bj < 2; ++bj) { f32x4 x0, x1v;
                    if (XIN_BF16) { const u32x4 xw = *(const u32x4*)((const bf16*)xin + off + bj * HALF);
                        x0 = (f32x4){bf2f(xw.x & 0xffffu), bf2f(xw.x >> 16), bf2f(xw.y & 0xffffu), bf2f(xw.y >> 16)}; x1v = (f32x4){bf2f(xw.z & 0xffffu), bf2f(xw.z >> 16), bf2f(xw.w & 0xffffu), bf2f(xw.w >> 16)}; }
                    else { x0 = *(const f32x4*)((const float*)xin + off + bj * HALF); x1v = *(const f32x4*)((const float*)xin + off + bj * HALF + 4); }
                    const f32x4 v0 = x0 + gv[bj][0] * acc[ai][bj][m][0], v1 = x1v + gv[bj][1] * acc[ai][bj][m][1];
                    u32x4 w; w.x = cvt_pk_bf16(v0[0], v0[1]); w.y = cvt_pk_bf16(v0[2], v0[3]); w.z = cvt_pk_bf16(v1[0], v1[1]); w.w = cvt_pk_bf16(v1[2], v1[3]);
                    *(u32x4*)(X1b + off + bj * HALF) = w; } }
    }
};
__device__ __forceinline__ float silu_fast(float x) { return x * __builtin_amdgcn_rcpf(1.f + __builtin_amdgcn_exp2f(-1.4426950408889634f * x)); }
struct EpiUp {
    static constexpr bool PERM = true;
    bf16* ACT;
    __device__ __forceinline__ void operator()(const f32x4 (&acc)[2][2][4][2], const Unit& u, int wr, int wc, int fr, int fq) const {
        bf16* base = ACT + (size_t)(u.row0 + wr * 64 + fr) * ED + 128 * u.pn + 32 * wc + 8 * fq;
#pragma unroll
        for (int ai = 0; ai < 2; ++ai)
#pragma unroll
            for (int m = 0; m < 4; ++m) { f32x4 v[2];
#pragma unroll
                for (int n = 0; n < 2; ++n)
#pragma unroll
                    for (int i = 0; i < 4; ++i) v[n][i] = silu_fast(acc[ai][0][m][n][i]) * acc[ai][1][m][n][i];
                u32x4 w; w.x = cvt_pk_bf16(v[0][0], v[0][1]); w.y = cvt_pk_bf16(v[0][2], v[0][3]); w.z = cvt_pk_bf16(v[1][0], v[1][1]); w.w = cvt_pk_bf16(v[1][2], v[1][3]);
                *(u32x4*)(base + (size_t)(ai * HALF + m * 16) * ED) = w; }
    }
};
struct EpiDown {
    static constexpr bool PERM = true;
    bf16* Y; int orow = 0;
    __device__ __forceinline__ void operator()(const f32x4 (&acc)[2][2][4][2], const Unit& u, int wr, int wc, int fr, int fq) const {
        bf16* base = Y + (size_t)(orow + u.row0 + wr * 64 + fr) * D + u.pn * BM + wc * 32 + 8 * fq;
#pragma unroll
        for (int ai = 0; ai < 2; ++ai)
#pragma unroll
            for (int m = 0; m < 4; ++m) { bf16* rowp = base + (size_t)(ai * HALF + m * 16) * D;
#pragma unroll
                for (int bj = 0; bj < 2; ++bj) { const f32x4 v0 = acc[ai][bj][m][0], v1 = acc[ai][bj][m][1];
                    u32x4 w; w.x = cvt_pk_bf16(v0[0], v0[1]); w.y = cvt_pk_bf16(v0[2], v0[3]); w.z = cvt_pk_bf16(v1[0], v1[1]); w.w = cvt_pk_bf16(v1[2], v1[3]);
                    *(u32x4*)(rowp + bj * HALF) = w; } }
    }
};


struct EpiUp8 {
    static constexpr bool PERM = true;
    unsigned char* ACT8;
    __device__ __forceinline__ void operator()(const f32x4 (&acc)[2][2][4][2], const Unit& u, int wr, int wc, int fr, int fq) const {
        unsigned char* base = ACT8 + (size_t)(u.row0 + wr * 64 + fr) * ED + 128 * u.pn + 32 * wc + 8 * fq;
        constexpr float s = 1.f / (F8_HSCALE * F8_WSCALE);
#pragma unroll
        for (int ai = 0; ai < 2; ++ai)
#pragma unroll
            for (int m = 0; m < 4; ++m) { f32x4 v[2];
#pragma unroll
                for (int n = 0; n < 2; ++n)
#pragma unroll
                    for (int i = 0; i < 4; ++i) v[n][i] = silu_fast(acc[ai][0][m][n][i] * s) * (acc[ai][1][m][n][i] * (s * F8_ASCALE));
                u32x2 w; w.x = pk4_fp8(v[0][0], v[0][1], v[0][2], v[0][3]); w.y = pk4_fp8(v[1][0], v[1][1], v[1][2], v[1][3]);
                *(u32x2*)(base + (size_t)(ai * HALF + m * 16) * ED) = w; }
    }
};
struct EpiDown8 {
    static constexpr bool PERM = true;
    bf16* Y;
    __device__ __forceinline__ void operator()(const f32x4 (&acc)[2][2][4][2], const Unit& u, int wr, int wc, int fr, int fq) const {
#if Y_FP8
        unsigned char* base = (unsigned char*)Y + (size_t)(u.row0 + wr * 64 + fr) * D + u.pn * BM + wc * 64 + 16 * fq;
        constexpr float s = F8_YSCALE / (F8_ASCALE * F8_WSCALE);
#pragma unroll
        for (int ai = 0; ai < 2; ++ai)
#pragma unroll
            for (int m = 0; m < 4; ++m) { unsigned char* rowp = base + (size_t)(ai * HALF + m * 16) * D; u32x4 w;
#pragma unroll
                for (int bj = 0; bj < 2; ++bj) { const f32x4 v0 = acc[ai][bj][m][0] * s, v1 = acc[ai][bj][m][1] * s;
                    w[2 * bj] = pk4_fp8(v0[0], v0[1], v0[2], v0[3]); w[2 * bj + 1] = pk4_fp8(v1[0], v1[1], v1[2], v1[3]); }
                *(u32x4*)rowp = w; }
#else
        bf16* base = Y + (size_t)(u.row0 + wr * 64 + fr) * D + u.pn * BM + wc * 32 + 8 * fq;
        constexpr float s = 1.f / (F8_ASCALE * F8_WSCALE);
#pragma unroll
        for (int ai = 0; ai < 2; ++ai)
#pragma unroll
            for (int m = 0; m < 4; ++m) { bf16* rowp = base + (size_t)(ai * HALF + m * 16) * D;
#pragma unroll
                for (int bj = 0; bj < 2; ++bj) { const f32x4 v0 = acc[ai][bj][m][0] * s, v1 = acc[ai][bj][m][1] * s;
                    u32x4 w; w.x = cvt_pk_bf16(v0[0], v0[1]); w.y = cvt_pk_bf16(v0[2], v0[3]); w.z = cvt_pk_bf16(v1[0], v1[1]); w.w = cvt_pk_bf16(v1[2], v1[3]);
                    *(u32x4*)(rowp + bj * HALF) = w; } }
#endif
    }
};
__device__ __forceinline__ void glds16s(const void* sbase, unsigned voff, unsigned lds_dst) { unsigned keep;
    asm volatile("s_mov_b32 %0, m0\n\ts_mov_b32 m0, %3\n\ts_nop 0\n\tglobal_load_lds_dwordx4 %1, %2\n\ts_mov_b32 m0, %0" : "=&s"(keep) : "v"(voff), "s"(sbase), "s"(lds_dst) : "memory"); }
__device__ __forceinline__ void glds4s(const void* sbase, unsigned voff, unsigned lds_dst) { unsigned keep;
    asm volatile("s_mov_b32 %0, m0\n\ts_mov_b32 m0, %3\n\ts_nop 0\n\tglobal_load_lds_dword %1, %2\n\ts_mov_b32 m0, %0" : "=&s"(keep) : "v"(voff), "s"(sbase), "s"(lds_dst) : "memory"); }
typedef int i32x4 __attribute__((ext_vector_type(4)));
typedef int i32x8 __attribute__((ext_vector_type(8)));
__device__ __forceinline__ i32x8 cat8(bf16x8 a, bf16x8 b) { return __builtin_shufflevector(__builtin_bit_cast(i32x4, a), __builtin_bit_cast(i32x4, b), 0, 1, 2, 3, 4, 5, 6, 7); }
__device__ __forceinline__ void mfma8_inplace(f32x4& acc, i32x8 a, i32x8 b) { asm volatile("v_mfma_f32_16x16x128_f8f6f4 %0, %1, %2, %0" : "+v"(acc) : "v"(a), "v"(b)); }
template <class Epi, class Sched, bool FP8 = false>
__device__ __forceinline__ void gemm_phase(LAS unsigned char* lds, const char* Abase, const int K, const Sched& S, const Epi& E) {
    constexpr bool GATHER = Sched::GATHER;
    const int tid = threadIdx.x, wid = __builtin_amdgcn_readfirstlane(tid >> 6), lane = tid & 63, wr = wid >> 2, wc = wid & 3, fr = lane & 15, fq = lane >> 4;
    int nt = K / BK; asm volatile("" : "+s"(nt));
    int RA[2]; unsigned CA[2], voffB[2], vC[2];
#pragma unroll
    for (int i = 0; i < 2; ++i) { int R, C; stage_rc(tid * 16 + i * 8192, R, C); const int Rb = Epi::PERM ? ((R & ~31) + perm32(R & 31)) : R;
        RA[i] = R; CA[i] = (unsigned)C * 2u; voffB[i] = (unsigned)(Rb * K + C) * 2u; vC[i] = (unsigned)(R * K + C) * 2u; }
    const size_t kstep = (size_t)(BK * 2);
    const size_t hstep = (size_t)HALF * K * 2;
    const size_t ahstep = GATHER ? 0 : hstep;
    const unsigned ldsw = (unsigned)wid * 1024u;
    const unsigned lds0 = (unsigned)(uintptr_t)lds;
    const int aoff = lds_byte(wr * 64 + fr, fq * 8), boff = lds_byte(wc * 32 + fr, fq * 8);
#define PG8_SA(b, h) (((b) * 2 + (h)) * HTB)
#define PG8_SB(b, h) ((4 + (b) * 2 + (h)) * HTB)
#define PG8_STAGE(bufoff, gbase, voff) do { _Pragma("unroll") for (int _i = 0; _i < 2; ++_i) \
        glds16s((const void*)(gbase), (voff)[_i], (unsigned)__builtin_amdgcn_readfirstlane((int)(lds0 + (unsigned)(bufoff) + ldsw + (unsigned)(_i * 8192)))); } while (0)
#define PG8_STAGE_A(bufoff, gbase, h) do { if constexpr (GATHER) { PG8_STAGE(bufoff, gbase, vA[h]); } else { PG8_STAGE(bufoff, (gbase) + (h) * ahstep, vC); } } while (0)
#define PG8_LDA(dst, b, h) do { _Pragma("unroll") for (int m = 0; m < 4; ++m) _Pragma("unroll") for (int k = 0; k < 2; ++k) dst[m][k] = *(const LAS bf16x8*)(lds + PG8_SA(b, h) + aoff + m * 2048 + k * 1024); } while (0)
#define PG8_LDB(dst, b, h) do { _Pragma("unroll") for (int n = 0; n < 2; ++n) _Pragma("unroll") for (int k = 0; k < 2; ++k) dst[n][k] = *(const LAS bf16x8*)(lds + PG8_SB(b, h) + boff + n * 2048 + k * 1024); } while (0)
#define PG8_MMA(ai, bj, At, Bt) do { __builtin_amdgcn_s_setprio(1); if constexpr (FP8) { _Pragma("unroll") for (int m = 0; m < 4; ++m) _Pragma("unroll") for (int n = 0; n < 2; ++n) \
        mfma8_inplace(acc[ai][bj][m][n], cat8(Bt[n][0], Bt[n][1]), cat8(At[m][0], At[m][1])); } else { \
        _Pragma("unroll") for (int m = 0; m < 4; ++m) _Pragma("unroll") for (int n = 0; n < 2; ++n) _Pragma("unroll") for (int k = 0; k < 2; ++k) \
        acc[ai][bj][m][n] = __builtin_amdgcn_mfma_f32_16x16x32_bf16(Bt[n][k], At[m][k], acc[ai][bj][m][n], 0, 0, 0); } __builtin_amdgcn_s_setprio(0); } while (0)
#define PG8_WAIT_V(n) asm volatile("s_waitcnt vmcnt(" #n ")" ::: "memory")
#define PG8_WAIT_L(n) asm volatile("s_waitcnt lgkmcnt(0)" ::: "memory")
#define PG8_BAR __builtin_amdgcn_s_barrier()
#define PG8_SCHED __builtin_amdgcn_sched_barrier(0)
#define PG8_SETOFF(vo, u) do { _Pragma("unroll") for (int _h = 0; _h < 2; ++_h) _Pragma("unroll") for (int _i = 0; _i < 2; ++_i) vo[_h][_i] = S.arow_off(u, _h * HALF + RA[_i]) + CA[_i]; } while (0)
    Unit cur, nxt; int ui = 0;
    if (!S.next(0, cur)) return;
    f32x4 acc[2][2][4][2];
#pragma unroll
    for (int a = 0; a < 2; ++a)
#pragma unroll
        for (int b = 0; b < 2; ++b)
#pragma unroll
            for (int m = 0; m < 4; ++m)
#pragma unroll
                for (int n = 0; n < 2; ++n) acc[a][b][m][n] = (f32x4){0.f, 0.f, 0.f, 0.f};
    bf16x8 At[4][2], B0[2][2], B1[2][2];
    unsigned vA[2][2];
    LAS int* gidx = (LAS int*)(lds + STAGE_BYTES);
#define PG8_IDX_DMA(u) do { if (wid < 4) glds4s((const void*)(S.slot_tok + (u).row0), (unsigned)((wid * 64 + lane) * 4), (unsigned)__builtin_amdgcn_readfirstlane((int)(lds0 + (unsigned)STAGE_BYTES + (unsigned)wid * 256u))); } while (0)
#define PG8_IDX_READ() do { _Pragma("unroll") for (int _h = 0; _h < 2; ++_h) _Pragma("unroll") for (int _i = 0; _i < 2; ++_i) vA[_h][_i] = (unsigned)gidx[_h * HALF + RA[_i]] * (unsigned)(K * 2) + CA[_i]; } while (0)
    if constexpr (GATHER) { PG8_IDX_DMA(cur); asm volatile("s_waitcnt vmcnt(0)" ::: "memory"); __builtin_amdgcn_s_barrier(); asm volatile("" ::: "memory"); PG8_IDX_READ();
        asm volatile("s_waitcnt lgkmcnt(0)" ::: "memory"); __builtin_amdgcn_s_barrier(); asm volatile("" ::: "memory"); }
    const char* cA = GATHER ? Abase : Abase + (size_t)cur.row0 * K * 2;
    const char* cB = cur.Bp;
    PG8_STAGE(PG8_SB(0, 0), cB, voffB); PG8_STAGE(PG8_SB(0, 1), cB + hstep, voffB); PG8_STAGE_A(PG8_SA(0, 0), cA, 0); PG8_STAGE_A(PG8_SA(0, 1), cA, 1);
    if (wr == 1) PG8_BAR;
    PG8_WAIT_V(2); PG8_BAR;
    PG8_STAGE(PG8_SB(1, 0), cB + kstep, voffB); PG8_STAGE_A(PG8_SA(1, 0), cA + kstep, 0); PG8_STAGE(PG8_SB(1, 1), cB + hstep + kstep, voffB);
    PG8_WAIT_V(6); PG8_BAR;
    for (;;) {
        const bool has_next = S.next(ui + 1, nxt);
        if constexpr (GATHER) { if (has_next) PG8_IDX_DMA(nxt); }
        const char* nA = GATHER ? Abase : (has_next ? Abase + (size_t)nxt.row0 * K * 2 : cA);
        const char* nB = has_next ? nxt.Bp : cB;
#pragma unroll 1
        for (int t = 0; t < nt; t += 2) {
            const bool last = (t == nt - 2);
            const char* a1 = cA + (size_t)(t + 1) * kstep;
            const char* a2 = last ? nA : cA + (size_t)(t + 2) * kstep; const char* b2 = last ? nB : cB + (size_t)(t + 2) * kstep;
            const char* a3 = a2 + kstep; const char* b3 = b2 + kstep;
            PG8_LDB(B0, 0, 0); PG8_LDB(B1, 0, 1); PG8_SCHED; PG8_LDA(At, 0, 0); PG8_STAGE_A(PG8_SA(1, 1), a1, 1);
            if constexpr (GATHER) { if (last && has_next) PG8_IDX_READ(); }
            PG8_WAIT_V(8); PG8_WAIT_L(0); PG8_BAR; PG8_MMA(0, 0, At, B0); PG8_MMA(0, 1, At, B1); PG8_BAR; PG8_SCHED;
            PG8_LDA(At, 0, 1); PG8_STAGE(PG8_SB(0, 0), b2, voffB); PG8_STAGE(PG8_SB(0, 1), b2 + hstep, voffB); PG8_STAGE_A(PG8_SA(0, 0), a2, 0);
            PG8_WAIT_V(8); PG8_WAIT_L(0); PG8_BAR; PG8_MMA(1, 0, At, B0); PG8_MMA(1, 1, At, B1); PG8_BAR; PG8_SCHED;
            PG8_LDB(B0, 1, 0); PG8_LDB(B1, 1, 1); PG8_SCHED; PG8_LDA(At, 1, 0); PG8_STAGE_A(PG8_SA(0, 1), a2, 1);
            PG8_WAIT_V(8); PG8_WAIT_L(0); PG8_BAR; PG8_MMA(0, 0, At, B0); PG8_MMA(0, 1, At, B1); PG8_BAR; PG8_SCHED;
            PG8_LDA(At, 1, 1); PG8_STAGE(PG8_SB(1, 0), b3, voffB); PG8_STAGE(PG8_SB(1, 1), b3 + hstep, voffB); PG8_STAGE_A(PG8_SA(1, 0), a3, 0);
            PG8_WAIT_V(8); PG8_WAIT_L(0); PG8_BAR; PG8_MMA(1, 0, At, B0); PG8_MMA(1, 1, At, B1); PG8_BAR; PG8_SCHED;
        }
        if (wr == 0) PG8_BAR;
        if constexpr (FP8) asm volatile("s_nop 15\n\ts_nop 15" ::: "memory");
        E(acc, cur, wr, wc, fr, fq);
        if (!has_next) break;
#pragma unroll
        for (int a = 0; a < 2; ++a)
#pragma unroll
            for (int b = 0; b < 2; ++b)
#pragma unroll
                for (int m = 0; m < 4; ++m)
#pragma unroll
                    for (int n = 0; n < 2; ++n) acc[a][b][m][n] = (f32x4){0.f, 0.f, 0.f, 0.f};
        cur = nxt; cA = nA; cB = nB; ++ui;
        if (wr == 1) PG8_BAR;
    }
    PG8_WAIT_V(0);
    PG8_BAR;
#undef PG8_SA
#undef PG8_SB
#undef PG8_STAGE
#undef PG8_STAGE_A
#undef PG8_LDA
#undef PG8_LDB
#undef PG8_MMA
#undef PG8_WAIT_V
#undef PG8_WAIT_L
#undef PG8_BAR
#undef PG8_SCHED
#undef PG8_SETOFF
#undef PG8_IDX_DMA
#undef PG8_IDX_READ
}
}

namespace att {
using bf16=unsigned short;
using bf16x8=__attribute__((ext_vector_type(8)))short;
using s16x4=__attribute__((ext_vector_type(4)))short;
using f32x16=__attribute__((ext_vector_type(16)))float;
using u32x4=__attribute__((ext_vector_type(4)))unsigned;
constexpr int NW=8,QBLK=32,QB=QBLK*NW,KVBLK=64;
__device__ __forceinline__ int crow(int r,int hi){return (r&3)+8*(r>>2)+4*hi;}
#define SBAR() __builtin_amdgcn_sched_barrier(0)
constexpr int NSLOT=6, SLOTB=8192;
constexpr int LDS_K=0, LDS_V=NSLOT*SLOTB, LDS_WS=2*NSLOT*SLOTB, LDS_OST=LDS_WS+NW*64*4, LDS_BYTES=LDS_OST+NW*4096;
constexpr float C2=0.125f*1.4426950408889634f;
__device__ __forceinline__ void glds16(const void*sbase,unsigned voff,unsigned lds_dst){unsigned keep;
  asm volatile("s_mov_b32 %0, m0\n\ts_mov_b32 m0, %3\n\ts_nop 0\n\tglobal_load_lds_dwordx4 %1, %2\n\ts_mov_b32 m0, %0":"=&s"(keep):"v"(voff),"s"(sbase),"s"(lds_dst):"memory");}
__device__ __forceinline__ float max3f(float a,float b,float c){float r;asm("v_max3_f32 %0, %1, %2, %3":"=v"(r):"v"(a),"v"(b),"v"(c));return r;}
__device__ __forceinline__ float max2f(float a,float b){float r;asm("v_max_f32_e32 %0, %1, %2":"=v"(r):"v"(a),"v"(b));return r;}
__device__ __forceinline__ float fsub_s(float a,float b){float r;asm("v_sub_f32_e32 %0, %1, %2":"=v"(r):"v"(a),"v"(b));return r;}
typedef float f32x2_t __attribute__((ext_vector_type(2))); typedef __bf16 bf16x2_t __attribute__((ext_vector_type(2)));
__device__ __forceinline__ unsigned cvtpk_s(float lo,float hi){f32x2_t v={lo,hi};bf16x2_t b=__builtin_convertvector(v,bf16x2_t);return __builtin_bit_cast(unsigned,b);}
#define WAIT_BAR(N) asm volatile("s_waitcnt vmcnt(" #N ") lgkmcnt(0)\n\ts_barrier":::"memory")
typedef __attribute__((address_space(3))) const char* lds_cptr;
typedef short v4i16_t __attribute__((ext_vector_type(4)));
__device__ __forceinline__ void kload8(bf16x8*kf,lds_cptr kp,int bo){
  #pragma unroll
  for(int d0=0;d0<4;++d0){ const lds_cptr p=kp+((d0*32)^bo); kf[2*d0]=*(const __attribute__((address_space(3))) bf16x8*)(p); kf[2*d0+1]=*(const __attribute__((address_space(3))) bf16x8*)(p+4096); }
}
__device__ __forceinline__ void kload2(bf16x8*kf,lds_cptr kp,int j,int bo){ const lds_cptr p=kp+((j*32)^bo); kf[2*j]=*(const __attribute__((address_space(3))) bf16x8*)(p); kf[2*j+1]=*(const __attribute__((address_space(3))) bf16x8*)(p+4096); }
__device__ __forceinline__ s16x4 vtr(lds_cptr p){ return __builtin_bit_cast(s16x4,__builtin_amdgcn_ds_read_tr16_b64_v4i16((__attribute__((address_space(3))) v4i16_t*)p)); }
__device__ __forceinline__ float rowmax(const f32x16&p0,const f32x16&p1){
  float a=max3f(p0[0],p0[1],p1[0]),b=max3f(p0[2],p0[3],p1[1]);a=max3f(a,p1[2],p1[3]);
  #pragma unroll
  for(int r=4;r<16;r+=4){a=max3f(a,p0[r],p0[r+1]);b=max3f(b,p0[r+2],p0[r+3]);a=max3f(a,p1[r],p1[r+1]);b=max3f(b,p1[r+2],p1[r+3]);}
  const float m=max2f(a,b);
  auto rr=__builtin_amdgcn_permlane32_swap(__float_as_uint(m),__float_as_uint(m),false,false);
  return max2f(__uint_as_float(rr[0]),__uint_as_float(rr[1]));
}
__device__ __forceinline__ void pv(f32x16*o,int vb,bf16x8 pa0,bf16x8 pa1,bf16x8 pa2,bf16x8 pa3){
  #pragma unroll
  for(int d0=0;d0<2;++d0){s16x4 lo[4],hi[4];
    #pragma unroll
    for(int ks=0;ks<4;++ks){
      asm volatile("ds_read_b64_tr_b16 %0,%1 offset:%c2":"=&v"(lo[ks]):"v"(vb),"i"(d0*4096+ks*1024):"memory");
      asm volatile("ds_read_b64_tr_b16 %0,%1 offset:%c2":"=&v"(hi[ks]):"v"(vb),"i"(d0*4096+ks*1024+512):"memory");}
    asm volatile("s_waitcnt lgkmcnt(0)":::"memory");SBAR();
    #define PK(k) (bf16x8){lo[k][0],lo[k][1],lo[k][2],lo[k][3],hi[k][0],hi[k][1],hi[k][2],hi[k][3]}
    o[d0]=__builtin_amdgcn_mfma_f32_32x32x16_bf16(pa0,PK(0),o[d0],0,0,0);
    o[d0]=__builtin_amdgcn_mfma_f32_32x32x16_bf16(pa1,PK(1),o[d0],0,0,0);
    o[d0]=__builtin_amdgcn_mfma_f32_32x32x16_bf16(pa2,PK(2),o[d0],0,0,0);
    o[d0]=__builtin_amdgcn_mfma_f32_32x32x16_bf16(pa3,PK(3),o[d0],0,0,0);
    #undef PK
  }
}
template<int W> __device__ __forceinline__ void wmask(f32x16&p0,f32x16&p1,int d,float NEG){
  asm volatile("":"+v"(d));
  #pragma unroll
  for(int r=0;r<16;++r){const int c=(r&3)+8*(r>>2);
    if(W==0x7fffffff){ if(d<c)p0[r]=NEG; if(d<c+32)p1[r]=NEG; }
    else{ if((unsigned)(d-c)>(unsigned)W)p0[r]=NEG; if((unsigned)(d-c-32)>(unsigned)W)p1[r]=NEG; } }
}
struct UnitDesc {
  const bf16* Q; long qs;
  const bf16* K; long ks;
  const bf16* V; long vs;
  bf16* O; long os;
  float* lse; long lses;
  int NT;
  int rel0;
  int tg0;
  int q0;
  float slope2;
  float sink2;
  int fin;
  float lam, lam1;
  const float* sg; bf16* Of;
};
template<int MODE,int THRL,int DIL,int OS> __device__ __forceinline__ void attn_unit(const UnitDesc&u,char*shm){
  constexpr int W=(MODE==0)?0x7fffffff:(MODE==1?128:127);
  const float NEG=(MODE==0)?-INFINITY:-1024.f;
  int tid=threadIdx.x; asm volatile("":"+v"(tid));
  const int lane=tid&63,r32=lane&31,hi=lane>>5; const int wid=__builtin_amdgcn_readfirstlane(tid>>6);
  constexpr long qs=64L*DIL,ks=64L*DIL,vs=64L*DIL;
  const bf16*Qw=u.Q+(long)(wid*QBLK)*qs;
  const unsigned lds0=(unsigned)(uintptr_t)shm;
  __attribute__((address_space(3))) float*wsf=(__attribute__((address_space(3))) float*)((__attribute__((address_space(3))) char*)shm+LDS_WS)+wid*64;
  const unsigned ksoff=(unsigned)(((long)(8*wid+(lane>>3))*ks+(((lane&7)^(lane>>3))*8))*2);
  const unsigned vsoff=(unsigned)(((long)(16*(wid&3)+(lane>>2))*vs+(wid>>2)*32+(lane&3)*8)*2);
  const unsigned kdst=lds0+LDS_K+wid*1024, vdst=lds0+LDS_V+wid*1024;
  #define DMA_K(t,slot) glds16(u.K+(long)(t)*KVBLK*ks,ksoff,(unsigned)__builtin_amdgcn_readfirstlane(kdst+(slot)))
  #define DMA_V(t,slot) glds16(u.V+(long)(t)*KVBLK*vs,vsoff,(unsigned)__builtin_amdgcn_readfirstlane(vdst+(slot)))
  bf16x8 kf[8];
  const lds_cptr shm3=(lds_cptr)shm; const lds_cptr kp0=shm3+LDS_K+r32*128+((hi^(r32&1))*16); const int kbo=((r32>>1)&3)<<5; const lds_cptr vp0=shm3+LDS_V+((lane>>4)&1)*32+(lane&3)*8+(4*hi+((lane&15)>>2))*64;
  const int NT=u.NT;
  if(MODE==0){DMA_K(0,0);DMA_V(0,0);DMA_K(1,SLOTB);} else {DMA_K(0,0);}
  bf16x8 qr[4];
  #pragma unroll
  for(int d0=0;d0<4;++d0)qr[d0]=*reinterpret_cast<const bf16x8*>(&Qw[(long)r32*qs+d0*16+hi*8]);
  const unsigned s2hb=__float_as_uint(u.slope2)&0xffff0000u; const float s2hf=__uint_as_float(s2hb);
  const unsigned s2lb=__float_as_uint(u.slope2-s2hf)&0xffff0000u; const float s2used=s2hf+__uint_as_float(s2lb);
  u32x4 qx; qx[0]=hi?0u:((__float_as_uint(64.f*s2hf)>>16)|(__float_as_uint(64.f*__uint_as_float(s2lb))&0xffff0000u)); qx[1]=hi?0u:((s2hb>>16)|s2lb); qx[2]=0u; qx[3]=0u;
  u32x4 kx0; unsigned jp0,jp1; { const unsigned j0=__float_as_uint((float)r32)>>16, j1=__float_as_uint((float)(r32+32))>>16; jp0=j0|(j0<<16); jp1=j1|(j1<<16);
    kx0[0]=0u; kx0[1]=jp0; kx0[2]=0x3f803f80u; kx0[3]=0u; }
  #define SETTG(t) do{ const unsigned tb_=__float_as_uint((float)(u.tg0+(t)))>>16; kx0[0]=(tb_|(tb_<<16)); }while(0)
  #define KX0 __builtin_bit_cast(bf16x8,kx0)
  #define QX __builtin_bit_cast(bf16x8,qx)
  #define SETREF(m_) do{ const unsigned hb_=__float_as_uint(m_)&0xffff0000u; const float hf_=__uint_as_float(hb_); const unsigned lb_=__float_as_uint((m_)-hf_)&0xffff0000u; \
      mhat=hf_+__uint_as_float(lb_); qx[2]=hi?0u:(((hb_^0x80000000u)>>16)|(lb_^0x80000000u)); }while(0)
  float mhat=0.f,l_reg=0.f;f32x16 o[2];o[0]=f32x16{};o[1]=f32x16{};
  const int qrel=u.rel0+wid*QBLK+r32-4*hi;
  #define CMASK(P0,P1,t) do{ if(MODE!=0||(t)>=NT-4) wmask<W>(P0,P1,qrel-64*(t),NEG); }while(0)
  bool resc=false;
  f32x16 pA0,pA1,pB0,pB1;
  int sl_prev=0,sl_cur=0,sl_next=SLOTB;
  #define ROT() do{sl_prev=sl_cur;sl_cur=sl_next;sl_next=(sl_next==(NSLOT-1)*SLOTB)?0:sl_next+SLOTB;}while(0)
  #define RESC() do{ if(resc){ asm volatile("s_waitcnt lgkmcnt(0)":::"memory"); \
      _Pragma("unroll") for(int d_=0;d_<2;++d_) _Pragma("unroll") for(int r=0;r<16;++r)o[d_][r]*=wsf[crow(r,hi)]; } }while(0)
  if(MODE==0){ DMA_K(2,2*SLOTB); WAIT_BAR(3); }
  else{ DMA_K(1,SLOTB);DMA_V(0,0);DMA_K(2,2*SLOTB);DMA_V(1,SLOTB);DMA_K(3,3*SLOTB);DMA_V(2,2*SLOTB);DMA_V(3,3*SLOTB);
    if(NT>4){DMA_K(4,4*SLOTB);DMA_K(5,5*SLOTB);DMA_V(4,4*SLOTB);DMA_V(5,5*SLOTB);}
    WAIT_BAR(0); }
  { SETTG(0); const f32x16 z=f32x16{}; const lds_cptr kb=kp0;
    #pragma unroll
    for(int d0=0;d0<4;++d0){
      const bf16x8 b0=*(const __attribute__((address_space(3))) bf16x8*)(kb+((d0*32)^kbo));
      const bf16x8 b1=*(const __attribute__((address_space(3))) bf16x8*)(kb+((d0*32)^kbo)+4096);
      if(d0==0){pA0=__builtin_amdgcn_mfma_f32_32x32x16_bf16(b0,qr[0],z,0,0,0);pA1=__builtin_amdgcn_mfma_f32_32x32x16_bf16(b1,qr[0],z,0,0,0);}
      else{pA0=__builtin_amdgcn_mfma_f32_32x32x16_bf16(b0,qr[d0],pA0,0,0,0);pA1=__builtin_amdgcn_mfma_f32_32x32x16_bf16(b1,qr[d0],pA1,0,0,0);}}
    pA0=__builtin_amdgcn_mfma_f32_32x32x16_bf16(KX0,QX,pA0,0,0,0); kx0[1]=jp1; pA1=__builtin_amdgcn_mfma_f32_32x32x16_bf16(KX0,QX,pA1,0,0,0); kx0[1]=jp0; }
  asm volatile("s_nop 15\n\ts_nop 7":"+v"(pA0),"+v"(pA1));CMASK(pA0,pA1,0);
  { const float rm=rowmax(pA0,pA1); SETREF(rm); const float dl=mhat;
    _Pragma("unroll") for(int r=0;r<16;++r){pA0[r]=fsub_s(pA0[r],dl);pA1[r]=fsub_s(pA1[r],dl);}
    _Pragma("unroll") for(int r=0;r<16;++r)pA0[r]=__builtin_amdgcn_exp2f(pA0[r]); }
  _Pragma("unroll") for(int r=0;r<16;++r)pA1[r]=__builtin_amdgcn_exp2f(pA1[r]);
  if(MODE==0){ WAIT_BAR(0); DMA_K(3,0);DMA_V(1,SLOTB); }
  ROT();
  kload8(kf,kp0+sl_cur,kbo);
  if(MODE==0){ WAIT_BAR(2); }
  s16x4 vlo[8],vhi[8]; u32x4 pw0,pw1,pw2,pw3;
  #define PKW(P,B) cvtpk_s(P[B],P[B+1])
  #define PAF(k) __builtin_bit_cast(bf16x8,pw##k)
  #define VFR(i) (bf16x8){vlo[i][0],vlo[i][1],vlo[i][2],vlo[i][3],vhi[i][0],vhi[i][1],vhi[i][2],vhi[i][3]}
  #define PIN(x) asm volatile("":"+v"(x))
  #define MX3(a,b,c) __builtin_fmaxf(__builtin_fmaxf((a),(b)),(c))
  #define GAPA(MF,A0,A1,A2,A3,W0,W1,PW) do{ MF; sacc+=A0; sacc+=A1; sacc+=A2; sacc+=A3; PIN(sacc); W0; W1; PIN(PW); SBAR(); }while(0)
  #define EX(v) __builtin_amdgcn_exp2f(v)
  #define GAPB(MF,X,B) do{ MF; X[B]=EX(X[B]); X[B+1]=EX(X[B+1]); X[B+2]=EX(X[B+2]); X[B+3]=EX(X[B+3]); PIN(X); SBAR(); }while(0)
  #define VRD(i) do{ vlo[i]=vtr(vp_+(((i)>>2)*4096+((i)&3)*1024)); vhi[i]=vtr(vp_+(((i)>>2)*4096+((i)&3)*1024+512)); }while(0)
  #define KRD(G,j) do{ if(G){ kload2(kf,kp0+sl_next,j,kbo); SBAR(); } }while(0)
  #define STEP(C0,C1,P0,P1,t,GK,GV,GL) do{ SBAR(); SETTG(t); const f32x16 z_=f32x16{}; \
    const lds_cptr vp_=vp0+sl_prev; \
    VRD(0); SBAR(); float sacc=(P0[0]+P0[1]); \
    GAPA(C0=__builtin_amdgcn_mfma_f32_32x32x16_bf16(kf[0],qr[0],z_,0,0,0), P0[2],P0[3],P0[4],P0[5],     pw0[0]=PKW(P0,0), pw0[1]=PKW(P0,2), pw0); \
    VRD(4); SBAR(); GAPA(C1=__builtin_amdgcn_mfma_f32_32x32x16_bf16(kf[1],qr[0],z_,0,0,0), P0[6],P0[7],P0[8],P0[9],     pw0[2]=PKW(P0,4), pw0[3]=PKW(P0,6), pw0); \
    VRD(1); SBAR(); GAPA(C0=__builtin_amdgcn_mfma_f32_32x32x16_bf16(kf[2],qr[1],C0,0,0,0),   P0[10],P0[11],P0[12],P0[13], pw1[0]=PKW(P0,8), pw1[1]=PKW(P0,10), pw1); \
    VRD(5); SBAR(); GAPA(C1=__builtin_amdgcn_mfma_f32_32x32x16_bf16(kf[3],qr[1],C1,0,0,0),   P0[14],P0[15],P1[0],P1[1],   pw1[2]=PKW(P0,12),pw1[3]=PKW(P0,14), pw1); \
    VRD(2); SBAR(); GAPA(C0=__builtin_amdgcn_mfma_f32_32x32x16_bf16(kf[4],qr[2],C0,0,0,0),   P1[2],P1[3],P1[4],P1[5],     pw2[0]=PKW(P1,0), pw2[1]=PKW(P1,2), pw2); \
    VRD(6); SBAR(); GAPA(C1=__builtin_amdgcn_mfma_f32_32x32x16_bf16(kf[5],qr[2],C1,0,0,0),   P1[6],P1[7],P1[8],P1[9],     pw2[2]=PKW(P1,4), pw2[3]=PKW(P1,6), pw2); \
    VRD(3); SBAR(); GAPA(C0=__builtin_amdgcn_mfma_f32_32x32x16_bf16(kf[6],qr[3],C0,0,0,0),   P1[10],P1[11],P1[12],P1[13], pw3[0]=PKW(P1,8), pw3[1]=PKW(P1,10), pw3); \
    VRD(7); SBAR(); GAPA(C1=__builtin_amdgcn_mfma_f32_32x32x16_bf16(kf[7],qr[3],C1,0,0,0),   P1[14],P1[15],0.f,0.f,       pw3[2]=PKW(P1,12),pw3[3]=PKW(P1,14), pw3); \
    C0=__builtin_amdgcn_mfma_f32_32x32x16_bf16(KX0,QX,C0,0,0,0); kx0[1]=jp1; C1=__builtin_amdgcn_mfma_f32_32x32x16_bf16(KX0,QX,C1,0,0,0); kx0[1]=jp0; SBAR(); \
    l_reg+=sacc; \
    if(GK){DMA_K((t)+3,sl_cur);} if(GV){DMA_V((t)+1,sl_next);} \
    CMASK(C0,C1,t); \
    { float a=MX3(C0[0],C0[1],C1[0]),b=MX3(C0[2],C0[3],C1[1]); a=MX3(a,C1[2],C1[3]); \
      _Pragma("unroll") for(int r=4;r<16;r+=4){a=MX3(a,C0[r],C0[r+1]);b=MX3(b,C0[r+2],C0[r+3]);a=MX3(a,C1[r],C1[r+1]);b=MX3(b,C1[r+2],C1[r+3]);} \
      float rm=__builtin_fmaxf(a,b); { auto rr=__builtin_amdgcn_permlane32_swap(__float_as_uint(rm),__float_as_uint(rm),false,false); rm=__builtin_fmaxf(__uint_as_float(rr[0]),__uint_as_float(rr[1])); } \
      resc=false; \
      if(__builtin_expect(__any(rm>(float)THRL),0)){ const float mold=mhat; const float mnew=mold+__builtin_fmaxf(rm,0.f); SETREF(mnew); const float dl=mhat-mold; \
        _Pragma("unroll") for(int r=0;r<16;++r){C0[r]-=dl;C1[r]-=dl;} \
        const float f=__builtin_amdgcn_exp2f(-dl); l_reg*=f; if(hi==0)wsf[r32]=f; resc=true; } } \
    SBAR(); \
    GAPB(o[0]=__builtin_amdgcn_mfma_f32_32x32x16_bf16(PAF(0),VFR(0),o[0],0,0,0), C0,0); \
    GAPB(o[1]=__builtin_amdgcn_mfma_f32_32x32x16_bf16(PAF(0),VFR(4),o[1],0,0,0), C0,4); \
    KRD(GL,0); GAPB(o[0]=__builtin_amdgcn_mfma_f32_32x32x16_bf16(PAF(1),VFR(1),o[0],0,0,0), C0,8); \
    KRD(GL,1); GAPB(o[1]=__builtin_amdgcn_mfma_f32_32x32x16_bf16(PAF(1),VFR(5),o[1],0,0,0), C0,12); \
    KRD(GL,2); GAPB(o[0]=__builtin_amdgcn_mfma_f32_32x32x16_bf16(PAF(2),VFR(2),o[0],0,0,0), C1,0); \
    KRD(GL,3); GAPB(o[1]=__builtin_amdgcn_mfma_f32_32x32x16_bf16(PAF(2),VFR(6),o[1],0,0,0), C1,4); \
    GAPB(o[0]=__builtin_amdgcn_mfma_f32_32x32x16_bf16(PAF(3),VFR(3),o[0],0,0,0), C1,8); \
    GAPB(o[1]=__builtin_amdgcn_mfma_f32_32x32x16_bf16(PAF(3),VFR(7),o[1],0,0,0), C1,12); \
    }while(0)
  int t=1;
  if(MODE==0){
    #undef CMASK
    #define CMASK(P0,P1,t) do{}while(0)
    for(;t+5<NT;t+=2){
      STEP(pB0,pB1,pA0,pA1,t,true,true,true);     WAIT_BAR(2); RESC(); ROT();
      STEP(pA0,pA1,pB0,pB1,t+1,true,true,true);   WAIT_BAR(2); RESC(); ROT();
    }
    #undef CMASK
    #define CMASK(P0,P1,t) do{ if(MODE!=0||(t)>=NT-4) wmask<W>(P0,P1,qrel-64*(t),NEG); }while(0)
  }
  #define ENDW(tt) do{ if(MODE==0){ if((tt)+3<NT){WAIT_BAR(2);} else if((tt)+2<NT){WAIT_BAR(1);} else {WAIT_BAR(0);} } }while(0)
  for(;t+1<NT;t+=2){
    STEP(pB0,pB1,pA0,pA1,t,(MODE==0&&t+3<NT),(MODE==0&&t+1<NT),(t+1<NT));       ENDW(t);   RESC(); ROT();
    STEP(pA0,pA1,pB0,pB1,t+1,(MODE==0&&t+4<NT),(MODE==0&&t+2<NT),(t+2<NT));     ENDW(t+1); RESC(); ROT();
  }
  STEP(pB0,pB1,pA0,pA1,NT-1,false,false,false); RESC();
  { float sacc=pB0[0]+pB0[1]; _Pragma("unroll") for(int r=2;r<16;++r)sacc+=pB0[r]; _Pragma("unroll") for(int r=0;r<16;++r)sacc+=pB1[r]; l_reg+=sacc;
    pw0=(u32x4){PKW(pB0,0),PKW(pB0,2),PKW(pB0,4),PKW(pB0,6)};pw1=(u32x4){PKW(pB0,8),PKW(pB0,10),PKW(pB0,12),PKW(pB0,14)};pw2=(u32x4){PKW(pB1,0),PKW(pB1,2),PKW(pB1,4),PKW(pB1,6)};pw3=(u32x4){PKW(pB1,8),PKW(pB1,10),PKW(pB1,12),PKW(pB1,14)};
    SBAR(); pv(o,(int)(lds0+LDS_V)+((lane>>4)&1)*32+(lane&3)*8+(4*hi+((lane&15)>>2))*64+sl_cur,PAF(0),PAF(1),PAF(2),PAF(3)); }
  #undef PKW
  #undef PAF
  #undef VFR
  #undef PIN
  #undef MX3
  #undef GAPA
  #undef GAPB
  #undef EX
  #undef VRD
  #undef KRD
  #undef STEP
  #undef ENDW
  {auto rr=__builtin_amdgcn_permlane32_swap(__float_as_uint(l_reg),__float_as_uint(l_reg),false,false);l_reg=__uint_as_float(rr[0])+__uint_as_float(rr[1]);}
  const float qposf=(float)(u.q0+wid*QBLK+r32);
  if(MODE==2) l_reg+=__builtin_amdgcn_exp2f(u.sink2+s2used*qposf-mhat);
  if(MODE==1){ if(hi==0) u.lse[(long)(wid*QBLK+r32)*DIL]=mhat-s2used*qposf+__builtin_amdgcn_logf(l_reg); }
  if(hi==0)wsf[32+r32]=l_reg;asm volatile("s_waitcnt lgkmcnt(0)":::"memory");
  float rli[16];
  #pragma unroll
  for(int r=0;r<16;++r)rli[r]=__builtin_amdgcn_rcpf(wsf[32+crow(r,hi)]);
  bf16*Ow=u.O+(long)(wid*QBLK)*OS;
  { int le=lane; asm volatile("":"+v"(le));
    const int r32e=le&31,hie=le>>5;
    __hip_bfloat16*stg=(__hip_bfloat16*)(shm+LDS_OST)+wid*2048;
    #pragma unroll
    for(int r=0;r<16;++r){const int orow=crow(r,hie);
      #pragma unroll
      for(int d0=0;d0<2;++d0)stg[orow*64+d0*32+r32e]=__float2bfloat16(o[d0][r]*rli[r]);}
    asm volatile("s_waitcnt lgkmcnt(0)":::"memory");
    #pragma unroll
    for(int i=0;i<4;++i){const int row=i*8+(le>>3),ch=le&7; const u32x4 v=*(const u32x4*)(stg+row*64+ch*8); *(u32x4*)(Ow+(long)row*OS+ch*8)=v;} }
  asm volatile("s_waitcnt lgkmcnt(0)\n\ts_barrier":::"memory");
  #undef DMA_K
  #undef DMA_V
  #undef CMASK
  #undef RESC
  #undef ROT
  #undef SETTG
  #undef SETREF
  #undef KX0
  #undef QX
}
#undef SBAR
#undef WAIT_BAR
}

namespace att128 {
using att::UnitDesc; using att::crow; using att::glds16; using att::max3f; using att::max2f; using att::fsub_s; using att::cvtpk_s; using att::kload8; using att::kload2; using att::vtr; using att::rowmax; using att::wmask; using att::lds_cptr;
using bf16=unsigned short;
using bf16x8=__attribute__((ext_vector_type(8)))short;
using s16x4=__attribute__((ext_vector_type(4)))short;
using f32x16=__attribute__((ext_vector_type(16)))float;
using u32x4=__attribute__((ext_vector_type(4)))unsigned;
constexpr int NW=8,QBLK=32,QB=QBLK*NW,KVBLK=64;
#define SBAR() __builtin_amdgcn_sched_barrier(0)
constexpr int NSLOT=3, SLOTB=8192, SLOTV=16384;
constexpr int LDS_K=0, LDS_V=NSLOT*SLOTB, LDS_WS=LDS_V+NSLOT*SLOTV, LDS_OST=LDS_WS+NW*64*4, LDS_BYTES=LDS_OST+NW*8192;
#define WAIT_BAR(N) asm volatile("s_waitcnt vmcnt(" #N ") lgkmcnt(0)\n\ts_barrier":::"memory")
__device__ __forceinline__ void pv4(f32x16*o,int vb,bf16x8 pa0,bf16x8 pa1,bf16x8 pa2,bf16x8 pa3){
  #pragma unroll
  for(int d0=0;d0<4;++d0){s16x4 lo[4],hi[4];
    #pragma unroll
    for(int ks=0;ks<4;++ks){
      asm volatile("ds_read_b64_tr_b16 %0,%1 offset:%c2":"=&v"(lo[ks]):"v"(vb),"i"(d0*4096+ks*1024):"memory");
      asm volatile("ds_read_b64_tr_b16 %0,%1 offset:%c2":"=&v"(hi[ks]):"v"(vb),"i"(d0*4096+ks*1024+512):"memory");}
    asm volatile("s_waitcnt lgkmcnt(0)":::"memory");SBAR();
    #define PK(k) (bf16x8){lo[k][0],lo[k][1],lo[k][2],lo[k][3],hi[k][0],hi[k][1],hi[k][2],hi[k][3]}
    o[d0]=__builtin_amdgcn_mfma_f32_32x32x16_bf16(pa0,PK(0),o[d0],0,0,0);
    o[d0]=__builtin_amdgcn_mfma_f32_32x32x16_bf16(pa1,PK(1),o[d0],0,0,0);
    o[d0]=__builtin_amdgcn_mfma_f32_32x32x16_bf16(pa2,PK(2),o[d0],0,0,0);
    o[d0]=__builtin_amdgcn_mfma_f32_32x32x16_bf16(pa3,PK(3),o[d0],0,0,0);
    #undef PK
  }
}
template<int MODE,int THRL,int DIL,int OS> __device__ __forceinline__ void attn_unit(const UnitDesc&u,char*shm){
  static_assert(MODE==0,"att128: causal mode only");
  constexpr int W=(MODE==0)?0x7fffffff:(MODE==1?128:127);
  const float NEG=(MODE==0)?-INFINITY:-1024.f;
  int tid=threadIdx.x; asm volatile("":"+v"(tid));
  const int lane=tid&63,r32=lane&31,hi=lane>>5; const int wid=__builtin_amdgcn_readfirstlane(tid>>6);
  constexpr long qs=64L*DIL,ks=64L*DIL,vs=64L*DIL;
  const bf16*Qw=u.Q+(long)(wid*QBLK)*qs;
  const unsigned lds0=(unsigned)(uintptr_t)shm;
  __attribute__((address_space(3))) float*wsf=(__attribute__((address_space(3))) float*)((__attribute__((address_space(3))) char*)shm+LDS_WS)+wid*64;
  const unsigned ksoff=(unsigned)(((long)(8*wid+(lane>>3))*ks+(((lane&7)^(lane>>3))*8))*2);
  const unsigned vsoff=(unsigned)(((long)(16*(wid&3)+(lane>>2))*vs+(wid>>2)*32+(lane&3)*8)*2);
  const unsigned kdst=lds0+LDS_K+wid*1024, vdst=lds0+LDS_V+wid*1024;
  #define DMA_K(t,slot) glds16(u.K+(long)(t)*KVBLK*ks,ksoff,(unsigned)__builtin_amdgcn_readfirstlane(kdst+(slot)))
  #define DMA_V(t,slot) do{ glds16(u.V+(long)(t)*KVBLK*vs,vsoff,(unsigned)__builtin_amdgcn_readfirstlane(vdst+2*(slot))); glds16(u.V+(long)(t)*KVBLK*vs+64*(long)M,vsoff,(unsigned)__builtin_amdgcn_readfirstlane(vdst+2*(slot)+8192)); }while(0)
  bf16x8 kf[8];
  const lds_cptr shm3=(lds_cptr)shm; const lds_cptr kp0=shm3+LDS_K+r32*128+((hi^(r32&1))*16); const int kbo=((r32>>1)&3)<<5; const lds_cptr vp0=shm3+LDS_V+((lane>>4)&1)*32+(lane&3)*8+(4*hi+((lane&15)>>2))*64;
  const int NT=u.NT;
  DMA_K(0,0);DMA_V(0,0);DMA_K(1,SLOTB);
  bf16x8 qr[4];
  #pragma unroll
  for(int d0=0;d0<4;++d0)qr[d0]=*reinterpret_cast<const bf16x8*>(&Qw[(long)r32*qs+d0*16+hi*8]);
  const unsigned s2hb=__float_as_uint(u.slope2)&0xffff0000u; const float s2hf=__uint_as_float(s2hb);
  const unsigned s2lb=__float_as_uint(u.slope2-s2hf)&0xffff0000u; const float s2used=s2hf+__uint_as_float(s2lb);
  u32x4 qx; qx[0]=hi?0u:((__float_as_uint(64.f*s2hf)>>16)|(__float_as_uint(64.f*__uint_as_float(s2lb))&0xffff0000u)); qx[1]=hi?0u:((s2hb>>16)|s2lb); qx[2]=0u; qx[3]=0u;
  u32x4 kx0; unsigned jp0,jp1; { const unsigned j0=__float_as_uint((float)r32)>>16, j1=__float_as_uint((float)(r32+32))>>16; jp0=j0|(j0<<16); jp1=j1|(j1<<16);
    kx0[0]=0u; kx0[1]=jp0; kx0[2]=0x3f803f80u; kx0[3]=0u; }
  #define SETTG(t) do{ const unsigned tb_=__float_as_uint((float)(u.tg0+(t)))>>16; kx0[0]=(tb_|(tb_<<16)); }while(0)
  #define KX0 __builtin_bit_cast(bf16x8,kx0)
  #define QX __builtin_bit_cast(bf16x8,qx)
  #define SETREF(m_) do{ const unsigned hb_=__float_as_uint(m_)&0xffff0000u; const float hf_=__uint_as_float(hb_); const unsigned lb_=__float_as_uint((m_)-hf_)&0xffff0000u; \
      mhat=hf_+__uint_as_float(lb_); qx[2]=hi?0u:(((hb_^0x80000000u)>>16)|(lb_^0x80000000u)); }while(0)
  float mhat=0.f,l_reg=0.f;f32x16 o[4];o[0]=f32x16{};o[1]=f32x16{};o[2]=f32x16{};o[3]=f32x16{};
  const int qrel=u.rel0+wid*QBLK+r32-4*hi;
  #define CMASK(P0,P1,t) do{ if(MODE!=0||(t)>=NT-4) wmask<W>(P0,P1,qrel-64*(t),NEG); }while(0)
  bool resc=false;
  f32x16 pA0,pA1,pB0,pB1;
  int sl_prev=0,sl_cur=0,sl_next=SLOTB;
  #define ROT() do{sl_prev=sl_cur;sl_cur=sl_next;sl_next=(sl_next==(NSLOT-1)*SLOTB)?0:sl_next+SLOTB;}while(0)
  #define RESC() do{ if(resc){ asm volatile("s_waitcnt lgkmcnt(0)":::"memory"); \
      _Pragma("unroll") for(int d_=0;d_<4;++d_) _Pragma("unroll") for(int r=0;r<16;++r)o[d_][r]*=wsf[crow(r,hi)]; } }while(0)
  DMA_K(2,2*SLOTB);
  WAIT_BAR(4);
  { SETTG(0); const f32x16 z=f32x16{}; const lds_cptr kb=kp0;
    #pragma unroll
    for(int d0=0;d0<4;++d0){
      const bf16x8 b0=*(const __attribute__((address_space(3))) bf16x8*)(kb+((d0*32)^kbo));
      const bf16x8 b1=*(const __attribute__((address_space(3))) bf16x8*)(kb+((d0*32)^kbo)+4096);
      if(d0==0){pA0=__builtin_amdgcn_mfma_f32_32x32x16_bf16(b0,qr[0],z,0,0,0);pA1=__builtin_amdgcn_mfma_f32_32x32x16_bf16(b1,qr[0],z,0,0,0);}
      else{pA0=__builtin_amdgcn_mfma_f32_32x32x16_bf16(b0,qr[d0],pA0,0,0,0);pA1=__builtin_amdgcn_mfma_f32_32x32x16_bf16(b1,qr[d0],pA1,0,0,0);}}
    pA0=__builtin_amdgcn_mfma_f32_32x32x16_bf16(KX0,QX,pA0,0,0,0); kx0[1]=jp1; pA1=__builtin_amdgcn_mfma_f32_32x32x16_bf16(KX0,QX,pA1,0,0,0); kx0[1]=jp0; }
  asm volatile("s_nop 15\n\ts_nop 7":"+v"(pA0),"+v"(pA1));CMASK(pA0,pA1,0);
  { const float rm=rowmax(pA0,pA1); SETREF(rm); const float dl=mhat;
    _Pragma("unroll") for(int r=0;r<16;++r){pA0[r]=fsub_s(pA0[r],dl);pA1[r]=fsub_s(pA1[r],dl);}
    _Pragma("unroll") for(int r=0;r<16;++r)pA0[r]=__builtin_amdgcn_exp2f(pA0[r]); }
  _Pragma("unroll") for(int r=0;r<16;++r)pA1[r]=__builtin_amdgcn_exp2f(pA1[r]);
  WAIT_BAR(0);
  DMA_K(3,0);DMA_V(1,SLOTB);
  ROT();
  kload8(kf,kp0+sl_cur,kbo);
  WAIT_BAR(3);
  s16x4 vlo[3],vhi[3]; u32x4 pw0,pw1,pw2,pw3;
  #define PKW(P,B) cvtpk_s(P[B],P[B+1])
  #define PAF(k) __builtin_bit_cast(bf16x8,pw##k)
  #define VFJ(b) (bf16x8){vlo[b][0],vlo[b][1],vlo[b][2],vlo[b][3],vhi[b][0],vhi[b][1],vhi[b][2],vhi[b][3]}
  #define PIN(x) asm volatile("":"+v"(x))
  #define MX3(a,b,c) __builtin_fmaxf(__builtin_fmaxf((a),(b)),(c))
  #define GAPA(MF,A0,A1,A2,A3,W0,W1,PW) do{ MF; sacc+=A0; sacc+=A1; sacc+=A2; sacc+=A3; PIN(sacc); W0; W1; PIN(PW); SBAR(); }while(0)
  #define EX(v) __builtin_amdgcn_exp2f(v)
  #define GAPB2(MF,X,B) do{ MF; X[B]=EX(X[B]); X[B+1]=EX(X[B+1]); PIN(X); SBAR(); }while(0)
  #define VRJ(b,n) do{ vlo[b]=vtr(vp_+(((n)&3)*4096+((n)>>2)*1024)); vhi[b]=vtr(vp_+(((n)&3)*4096+((n)>>2)*1024+512)); SBAR(); }while(0)
  #define KRD(G,j) do{ if(G){ kload2(kf,kp0+sl_next,j,kbo); SBAR(); } }while(0)
  #define STEP(C0,C1,P0,P1,t,GK,GV,GL) do{ SBAR(); SETTG(t); const f32x16 z_=f32x16{}; \
    const lds_cptr vp_=vp0+2*sl_prev; \
    float sacc=(P0[0]+P0[1]); \
    GAPA(C0=__builtin_amdgcn_mfma_f32_32x32x16_bf16(kf[0],qr[0],z_,0,0,0), P0[2],P0[3],P0[4],P0[5],     pw0[0]=PKW(P0,0), pw0[1]=PKW(P0,2), pw0); \
    GAPA(C1=__builtin_amdgcn_mfma_f32_32x32x16_bf16(kf[1],qr[0],z_,0,0,0), P0[6],P0[7],P0[8],P0[9],     pw0[2]=PKW(P0,4), pw0[3]=PKW(P0,6), pw0); \
    GAPA(C0=__builtin_amdgcn_mfma_f32_32x32x16_bf16(kf[2],qr[1],C0,0,0,0),   P0[10],P0[11],P0[12],P0[13], pw1[0]=PKW(P0,8), pw1[1]=PKW(P0,10), pw1); \
    GAPA(C1=__builtin_amdgcn_mfma_f32_32x32x16_bf16(kf[3],qr[1],C1,0,0,0),   P0[14],P0[15],P1[0],P1[1],   pw1[2]=PKW(P0,12),pw1[3]=PKW(P0,14), pw1); \
    GAPA(C0=__builtin_amdgcn_mfma_f32_32x32x16_bf16(kf[4],qr[2],C0,0,0,0),   P1[2],P1[3],P1[4],P1[5],     pw2[0]=PKW(P1,0), pw2[1]=PKW(P1,2), pw2); \
    GAPA(C1=__builtin_amdgcn_mfma_f32_32x32x16_bf16(kf[5],qr[2],C1,0,0,0),   P1[6],P1[7],P1[8],P1[9],     pw2[2]=PKW(P1,4), pw2[3]=PKW(P1,6), pw2); \
    VRJ(0,0); GAPA(C0=__builtin_amdgcn_mfma_f32_32x32x16_bf16(kf[6],qr[3],C0,0,0,0),   P1[10],P1[11],P1[12],P1[13], pw3[0]=PKW(P1,8), pw3[1]=PKW(P1,10), pw3); \
    VRJ(1,1); GAPA(C1=__builtin_amdgcn_mfma_f32_32x32x16_bf16(kf[7],qr[3],C1,0,0,0),   P1[14],P1[15],0.f,0.f,       pw3[2]=PKW(P1,12),pw3[3]=PKW(P1,14), pw3); \
    C0=__builtin_amdgcn_mfma_f32_32x32x16_bf16(KX0,QX,C0,0,0,0); kx0[1]=jp1; C1=__builtin_amdgcn_mfma_f32_32x32x16_bf16(KX0,QX,C1,0,0,0); kx0[1]=jp0; SBAR(); \
    l_reg+=sacc; \
    if(GK){DMA_K((t)+3,sl_cur);} if(GV){DMA_V((t)+1,sl_next);} \
    CMASK(C0,C1,t); \
    { float a=MX3(C0[0],C0[1],C1[0]),b=MX3(C0[2],C0[3],C1[1]); a=MX3(a,C1[2],C1[3]); \
      _Pragma("unroll") for(int r=4;r<16;r+=4){a=MX3(a,C0[r],C0[r+1]);b=MX3(b,C0[r+2],C0[r+3]);a=MX3(a,C1[r],C1[r+1]);b=MX3(b,C1[r+2],C1[r+3]);} \
      float rm=__builtin_fmaxf(a,b); { auto rr=__builtin_amdgcn_permlane32_swap(__float_as_uint(rm),__float_as_uint(rm),false,false); rm=__builtin_fmaxf(__uint_as_float(rr[0]),__uint_as_float(rr[1])); } \
      resc=false; \
      if(__builtin_expect(__any(rm>(float)THRL),0)){ const float mold=mhat; const float mnew=mold+__builtin_fmaxf(rm,0.f); SETREF(mnew); const float dl=mhat-mold; \
        _Pragma("unroll") for(int r=0;r<16;++r){C0[r]-=dl;C1[r]-=dl;} \
        const float f=__builtin_amdgcn_exp2f(-dl); l_reg*=f; if(hi==0)wsf[r32]=f; resc=true; } } \
    SBAR(); \
    VRJ(2,2);             GAPB2(o[0]=__builtin_amdgcn_mfma_f32_32x32x16_bf16(PAF(0),VFJ(0),o[0],0,0,0), C0,0); \
    VRJ(0,3);             GAPB2(o[1]=__builtin_amdgcn_mfma_f32_32x32x16_bf16(PAF(0),VFJ(1),o[1],0,0,0), C0,2); \
    VRJ(1,4);             GAPB2(o[2]=__builtin_amdgcn_mfma_f32_32x32x16_bf16(PAF(0),VFJ(2),o[2],0,0,0), C0,4); \
    VRJ(2,5);             GAPB2(o[3]=__builtin_amdgcn_mfma_f32_32x32x16_bf16(PAF(0),VFJ(0),o[3],0,0,0), C0,6); \
    VRJ(0,6);  KRD(GL,0); GAPB2(o[0]=__builtin_amdgcn_mfma_f32_32x32x16_bf16(PAF(1),VFJ(1),o[0],0,0,0), C0,8); \
    VRJ(1,7);             GAPB2(o[1]=__builtin_amdgcn_mfma_f32_32x32x16_bf16(PAF(1),VFJ(2),o[1],0,0,0), C0,10); \
    VRJ(2,8);  KRD(GL,1); GAPB2(o[2]=__builtin_amdgcn_mfma_f32_32x32x16_bf16(PAF(1),VFJ(0),o[2],0,0,0), C0,12); \
    VRJ(0,9);             GAPB2(o[3]=__builtin_amdgcn_mfma_f32_32x32x16_bf16(PAF(1),VFJ(1),o[3],0,0,0), C0,14); \
    VRJ(1,10); KRD(GL,2); GAPB2(o[0]=__builtin_amdgcn_mfma_f32_32x32x16_bf16(PAF(2),VFJ(2),o[0],0,0,0), C1,0); \
    VRJ(2,11);            GAPB2(o[1]=__builtin_amdgcn_mfma_f32_32x32x16_bf16(PAF(2),VFJ(0),o[1],0,0,0), C1,2); \
    VRJ(0,12); KRD(GL,3); GAPB2(o[2]=__builtin_amdgcn_mfma_f32_32x32x16_bf16(PAF(2),VFJ(1),o[2],0,0,0), C1,4); \
    VRJ(1,13);            GAPB2(o[3]=__builtin_amdgcn_mfma_f32_32x32x16_bf16(PAF(2),VFJ(2),o[3],0,0,0), C1,6); \
    VRJ(2,14);            GAPB2(o[0]=__builtin_amdgcn_mfma_f32_32x32x16_bf16(PAF(3),VFJ(0),o[0],0,0,0), C1,8); \
    VRJ(0,15);            GAPB2(o[1]=__builtin_amdgcn_mfma_f32_32x32x16_bf16(PAF(3),VFJ(1),o[1],0,0,0), C1,10); \
                          GAPB2(o[2]=__builtin_amdgcn_mfma_f32_32x32x16_bf16(PAF(3),VFJ(2),o[2],0,0,0), C1,12); \
                          GAPB2(o[3]=__builtin_amdgcn_mfma_f32_32x32x16_bf16(PAF(3),VFJ(0),o[3],0,0,0), C1,14); \
    }while(0)
  int t=1;
  if(MODE==0){
    #undef CMASK
    #define CMASK(P0,P1,t) do{}while(0)
    for(;t+5<NT;t+=2){
      STEP(pB0,pB1,pA0,pA1,t,true,true,true);     WAIT_BAR(3); RESC(); ROT();
      STEP(pA0,pA1,pB0,pB1,t+1,true,true,true);   WAIT_BAR(3); RESC(); ROT();
    }
    #undef CMASK
    #define CMASK(P0,P1,t) do{ if(MODE!=0||(t)>=NT-4) wmask<W>(P0,P1,qrel-64*(t),NEG); }while(0)
  }
  #define ENDW(tt) do{ if((tt)+3<NT){WAIT_BAR(3);} else if((tt)+2<NT){WAIT_BAR(2);} else {WAIT_BAR(0);} }while(0)
  for(;t+1<NT;t+=2){
    STEP(pB0,pB1,pA0,pA1,t,(t+3<NT),(t+1<NT),(t+1<NT));       ENDW(t);   RESC(); ROT();
    STEP(pA0,pA1,pB0,pB1,t+1,(t+4<NT),(t+2<NT),(t+2<NT));     ENDW(t+1); RESC(); ROT();
  }
  STEP(pB0,pB1,pA0,pA1,NT-1,false,false,false); RESC();
  { float sacc=pB0[0]+pB0[1]; _Pragma("unroll") for(int r=2;r<16;++r)sacc+=pB0[r]; _Pragma("unroll") for(int r=0;r<16;++r)sacc+=pB1[r]; l_reg+=sacc;
    pw0=(u32x4){PKW(pB0,0),PKW(pB0,2),PKW(pB0,4),PKW(pB0,6)};pw1=(u32x4){PKW(pB0,8),PKW(pB0,10),PKW(pB0,12),PKW(pB0,14)};pw2=(u32x4){PKW(pB1,0),PKW(pB1,2),PKW(pB1,4),PKW(pB1,6)};pw3=(u32x4){PKW(pB1,8),PKW(pB1,10),PKW(pB1,12),PKW(pB1,14)};
    SBAR(); pv4(o,(int)(lds0+LDS_V)+((lane>>4)&1)*32+(lane&3)*8+(4*hi+((lane&15)>>2))*64+2*sl_cur,PAF(0),PAF(1),PAF(2),PAF(3)); }
  #undef PKW
  #undef PAF
  #undef VFJ
  #undef PIN
  #undef MX3
  #undef GAPA
  #undef GAPB2
  #undef EX
  #undef VRJ
  #undef KRD
  #undef STEP
  #undef ENDW
  {auto rr=__builtin_amdgcn_permlane32_swap(__float_as_uint(l_reg),__float_as_uint(l_reg),false,false);l_reg=__uint_as_float(rr[0])+__uint_as_float(rr[1]);}
  const float qposf=(float)(u.q0+wid*QBLK+r32);
  if(MODE==2) l_reg+=__builtin_amdgcn_exp2f(u.sink2+s2used*qposf-mhat);
  if(MODE==1){ if(hi==0) u.lse[(long)(wid*QBLK+r32)*DIL]=mhat-s2used*qposf+__builtin_amdgcn_logf(l_reg); }
  if(hi==0)wsf[32+r32]=l_reg;asm volatile("s_waitcnt lgkmcnt(0)":::"memory");
  float rli[16];
  #pragma unroll
  for(int r=0;r<16;++r)rli[r]=__builtin_amdgcn_rcpf(wsf[32+crow(r,hi)]);
  { int le=lane; asm volatile("":"+v"(le));
    const int r32e=le&31,hie=le>>5;
    __hip_bfloat16*stg=(__hip_bfloat16*)(shm+LDS_OST)+wid*4096;
    if(u.fin==0){
      #pragma unroll
      for(int r=0;r<16;++r){const int orow=crow(r,hie);
        #pragma unroll
        for(int d0=0;d0<4;++d0)stg[orow*128+d0*32+r32e]=__float2bfloat16(o[d0][r]*rli[r]);}
    } else {
      const float lam=u.lam;
      #pragma unroll
      for(int r=0;r<16;++r){const int orow=crow(r,hie);
        #pragma unroll
        for(int d0=0;d0<4;++d0){ const int ix=orow*128+d0*32+r32e; const float o2=__bfloat162float(__float2bfloat16(o[d0][r]*rli[r])); stg[ix]=__float2bfloat16(__bfloat162float(stg[ix])-lam*o2); } }
      asm volatile("s_waitcnt lgkmcnt(0)":::"memory");
      const int ch=le&15; const float* sgp=u.sg+8*ch; const float g0=sgp[0],g1=sgp[1],g2=sgp[2],g3=sgp[3],g4=sgp[4],g5=sgp[5],g6=sgp[6],g7=sgp[7];
      bf16*Of=u.Of+(long)(wid*QBLK)*D+ch*8;
      #pragma unroll
      for(int i=0;i<8;++i){ const int row=i*4+(le>>4); const u32x4 v=*(const u32x4*)(stg+row*128+ch*8);
        const float x0=__uint_as_float(v[0]<<16),x1=__uint_as_float(v[0]&0xffff0000u),x2=__uint_as_float(v[1]<<16),x3=__uint_as_float(v[1]&0xffff0000u),
                    x4=__uint_as_float(v[2]<<16),x5=__uint_as_float(v[2]&0xffff0000u),x6=__uint_as_float(v[3]<<16),x7=__uint_as_float(v[3]&0xffff0000u);
        float ss=(x0*x0+x1*x1)+(x2*x2+x3*x3)+(x4*x4+x5*x5)+(x6*x6+x7*x7);
        ss+=__shfl_xor(ss,1); ss+=__shfl_xor(ss,2); ss+=__shfl_xor(ss,4); ss+=__shfl_xor(ss,8);
        const float rs=u.lam1/sqrtf(ss*(1.f/128.f)+1e-6f);
        u32x4 w; w[0]=cvtpk_s(x0*rs*g0,x1*rs*g1); w[1]=cvtpk_s(x2*rs*g2,x3*rs*g3); w[2]=cvtpk_s(x4*rs*g4,x5*rs*g5); w[3]=cvtpk_s(x6*rs*g6,x7*rs*g7);
        *(u32x4*)(Of+(long)row*D)=w; }
    } }
  asm volatile("s_waitcnt lgkmcnt(0)\n\ts_barrier":::"memory");
  #undef DMA_K
  #undef DMA_V
  #undef CMASK
  #undef RESC
  #undef ROT
  #undef SETTG
  #undef SETREF
  #undef KX0
  #undef QX
}
#undef SBAR
#undef WAIT_BAR
}

constexpr float LOG2E = 1.4426950408889634f;
__device__ __forceinline__ int vcu_of(int bx, int G) { return (G % 8 == 0) ? (bx % 8) * (G / 8) + bx / 8 : bx; }
constexpr int ATT1_LDS_TAB = 141312;
__device__ __forceinline__ void attn1_tuned_phase(const Ctx& c, const bf16* qkv, const float* qkg  , bf16* R, unsigned* qctr, const ExpertSrc& es, unsigned char* ws,
                                                  const float* lamp, const float* subln, bf16* Oout) {
    LAS int* order = (LAS int*)(c.lds + ATT1_LDS_TAB);
    LAS int* nts = order + 256;
    LAS int* t0s = nts + 256;
    volatile LAS unsigned* nextu = (volatile LAS unsigned*)(t0s + 256);
    LAS float* bnd = (LAS float*)(t0s + 256 + 4);
    const int G = gridDim.x;
    if (c.wave == 0) { float gq = fabsf(qkg[c.lane]), gk = fabsf(qkg[64 + c.lane]);
#pragma unroll
        for (int o = 1; o < 64; o <<= 1) { gq = fmaxf(gq, __shfl_xor(gq, o)); gk = fmaxf(gk, __shfl_xor(gk, o)); }
        if (c.lane == 0) bnd[0] = 8.f * gq * gk * 1.02f; }
    __syncthreads();
    if (c.tid < 256) { const int h = c.tid >> 4, qb = c.tid & 15; const float slope = exp2f(-0.5f * (float)(h + 1));
        const int dmax = (int)fminf(ceilf((2.f * bnd[0] + 25.f) / slope), 1.0e6f), lo_ = 256 * qb - dmax, t0 = lo_ <= 0 ? 0 : ((lo_ >> 6) & ~1);
        nts[c.tid] = 4 * (qb + 1) - t0; t0s[c.tid] = t0; }
    __syncthreads();
    if (c.tid < 256) { const int mine = nts[c.tid]; int rank = 0;
        for (int e = 0; e < 256; ++e) { const int o = nts[e]; rank += (o > mine || (o == mine && e < c.tid)) ? 1 : 0; }
        order[rank] = c.tid; }
    __syncthreads();
#if FUSE_FINISH
    constexpr int NCH = DEFER_CONV ? EXP_ITEMS / 65 : 0, NUNIT = NB * 16 * 16, NPOS = NUNIT + NCH;
    static_assert(!DEFER_CONV || EXP_ITEMS % 65 == 0, "chunking");
    if (c.tid == 0) { float s01 = 0.f, s23 = 0.f; for (int i = 0; i < 64; ++i) { s01 += lamp[i] * lamp[64 + i]; s23 += lamp[128 + i] * lamp[192 + i]; }
      const float li = 0.8f - 0.6f * expf(-0.3f * 1.0f); bnd[1] = expf(s01) - expf(s23) + li; bnd[2] = li; }
    __syncthreads();
    unsigned p = blockIdx.x;
    while (p < (unsigned)NPOS) {
        unsigned nreg = 0u;
        if (c.tid == 0) nreg = __hip_atomic_fetch_add(qctr, 1u, __ATOMIC_RELAXED, __HIP_MEMORY_SCOPE_AGENT) + (unsigned)G;
        const bool inter = p < (unsigned)(NCH * 2);
        if (inter && (p & 1u)) {
            expert_items_block(c, es, 1, ws, (int)(p >> 1) * 65, 65);
        } else {
#define ATT1_DECODE() const unsigned u = inter ? (p >> 1) : p - (unsigned)NCH; const int ent = order[u >> 2], h = ent >> 4, qb = ent & 15, b = (int)(u & 3u), t0 = t0s[ent]; \
            bf16* Rblk = R + ((size_t)(b * T + qb * 256) * 16 + h) * 256
#if USE_V128
#pragma unroll 1
            for (int pass = 0; pass < 2; ++pass) {
                ATT1_DECODE();
                const int i = pass; att::UnitDesc ud;
                ud.Q = qkv + ((size_t)(2 * h + i) * M + (size_t)(b * T + qb * 256)) * 64; ud.qs = 64;
                ud.K = qkv + ((size_t)(32 + 2 * h + i) * M + (size_t)(b * T + 64 * t0)) * 64; ud.ks = 64;
                ud.V = qkv + ((size_t)(64 + 2 * h) * M + (size_t)(b * T + 64 * t0)) * 64; ud.vs = 64;
                ud.O = Rblk + 128 * i; ud.os = 16 * 256;
                ud.lse = nullptr; ud.lses = 0; ud.NT = 4 * (qb + 1) - t0; ud.rel0 = qb * 256 - 64 * t0; ud.tg0 = t0; ud.q0 = qb * 256;
                ud.slope2 = exp2f(-0.5f * (float)(h + 1)) * LOG2E; ud.sink2 = 0.f;
                ud.fin = pass; ud.lam = bnd[1]; ud.lam1 = 1.f - bnd[2]; ud.sg = subln; ud.Of = Oout + (size_t)(b * T + qb * 256) * D + 128 * h;
                att128::attn_unit<0, 8, 1, 16 * 256>(ud, (char*)c.lds);
            }
#else
#pragma unroll 1
            for (int pass = 0; pass < 4; ++pass) {
                ATT1_DECODE();
                const int i = pass >> 1, j = pass & 1; att::UnitDesc ud;
#if QKV_HEADMAJOR
                ud.Q = qkv + ((size_t)(2 * h + i) * M + (size_t)(b * T + qb * 256)) * 64; ud.qs = 64;
                ud.K = qkv + ((size_t)(32 + 2 * h + i) * M + (size_t)(b * T + 64 * t0)) * 64; ud.ks = 64;
                ud.V = qkv + ((size_t)(64 + 2 * h + j) * M + (size_t)(b * T + 64 * t0)) * 64; ud.vs = 64;
#else
                ud.Q = qkv + (size_t)(b * T + qb * 256) * C_IN + 128 * h + 64 * i; ud.qs = C_IN;
                ud.K = qkv + (size_t)(b * T + 64 * t0) * C_IN + 2048 + 128 * h + 64 * i; ud.ks = C_IN;
                ud.V = qkv + (size_t)(b * T + 64 * t0) * C_IN + 4096 + 128 * h + 64 * j; ud.vs = C_IN;
#endif
                ud.O = Rblk + 128 * i + 64 * j; ud.os = 16 * 256;
                ud.lse = nullptr; ud.lses = 0; ud.NT = 4 * (qb + 1) - t0; ud.rel0 = qb * 256 - 64 * t0; ud.tg0 = t0; ud.q0 = qb * 256;
                ud.slope2 = exp2f(-0.5f * (float)(h + 1)) * LOG2E; ud.sink2 = 0.f;
                att::attn_unit<0, 8, 1, 16 * 256>(ud, (char*)c.lds);
            }
#endif
#if !USE_V128
            asm volatile("s_waitcnt vmcnt(0)" ::: "memory"); __syncthreads();
            { ATT1_DECODE(); (void)t0; const float lam = bnd[1], lam_init = bnd[2];
              int ft_ = threadIdx.x; asm volatile("" : "+v"(ft_));
              const int row = ft_ >> 1, hf = ft_ & 1; const bf16* p1 = Rblk + (size_t)row * (16 * 256) + 64 * hf; const bf16* p2 = p1 + 128;
              float xv[64]; float ss = 0.f;
#pragma unroll
              for (int q8 = 0; q8 < 8; ++q8) { const u32x4 a = *(const u32x4*)(p1 + 8 * q8), bq = *(const u32x4*)(p2 + 8 * q8);
#pragma unroll
                  for (int k = 0; k < 4; ++k) { const float x0 = bf2f(a[k] & 0xffffu) - lam * bf2f(bq[k] & 0xffffu), x1 = bf2f(a[k] >> 16) - lam * bf2f(bq[k] >> 16);
                      xv[8 * q8 + 2 * k] = x0; xv[8 * q8 + 2 * k + 1] = x1; ss += x0 * x0 + x1 * x1; } }
              ss += __shfl_xor(ss, 1);
              const float rs = (1.f - lam_init) / sqrtf(ss * (1.f / 128.f) + RMS_EPS);
              bf16* op = Oout + (size_t)(b * T + qb * 256 + row) * D + 128 * h + 64 * hf; const float* sg = subln + 64 * hf;
#pragma unroll
              for (int q8 = 0; q8 < 8; ++q8) { u32x4 w;
#pragma unroll
                  for (int k = 0; k < 4; ++k) w[k] = pk2(xv[8 * q8 + 2 * k] * rs * sg[8 * q8 + 2 * k], xv[8 * q8 + 2 * k + 1] * rs * sg[8 * q8 + 2 * k + 1]);
                  *(u32x4*)(op + 8 * q8) = w; } }
#endif
#undef ATT1_DECODE
        }
        if (c.tid == 0) nextu[0] = nreg;
        __syncthreads();
        p = nextu[0];
    }
}
#else
    constexpr int NCH = DEFER_CONV ? EXP_ITEMS / 65 : 0, NPOS = NB * 16 * 4 * 16 + NCH;
    static_assert(!DEFER_CONV || EXP_ITEMS % 65 == 0, "chunking");
    unsigned p = blockIdx.x;
    while (p < (unsigned)NPOS) {
        unsigned nreg = 0u;
        if (c.tid == 0) nreg = __hip_atomic_fetch_add(qctr, 1u, __ATOMIC_RELAXED, __HIP_MEMORY_SCOPE_AGENT) + (unsigned)G;
        const bool inter = p < (unsigned)(NCH * 6);
        if (inter && (p % 6u) == 5u) {
            expert_items_block(c, es, 1, ws, (int)(p / 6u) * 65, 65);
        } else {
            const unsigned u = inter ? p - p / 6u : p - (unsigned)NCH;
            const int ent = order[u >> 4], h = ent >> 4, qb = ent & 15, bp = (int)(u & 15u), b = bp >> 2, i = (bp >> 1) & 1, j = bp & 1, t0 = t0s[ent];
            att::UnitDesc ud;
#if QKV_HEADMAJOR
            ud.Q = qkv + ((size_t)(2 * h + i) * M + (size_t)(b * T + qb * 256)) * 64; ud.qs = 64;
            ud.K = qkv + ((size_t)(32 + 2 * h + i) * M + (size_t)(b * T + 64 * t0)) * 64; ud.ks = 64;
            ud.V = qkv + ((size_t)(64 + 2 * h + j) * M + (size_t)(b * T + 64 * t0)) * 64; ud.vs = 64;
#else
            ud.Q = qkv + (size_t)(b * T + qb * 256) * C_IN + 128 * h + 64 * i; ud.qs = C_IN;
            ud.K = qkv + (size_t)(b * T + 64 * t0) * C_IN + 2048 + 128 * h + 64 * i; ud.ks = C_IN;
            ud.V = qkv + (size_t)(b * T + 64 * t0) * C_IN + 4096 + 128 * h + 64 * j; ud.vs = C_IN;
#endif
            ud.O = R + ((size_t)(b * T + qb * 256) * 16 + h) * 256 + 128 * i + 64 * j; ud.os = 16 * 256;
            ud.lse = nullptr; ud.lses = 0; ud.NT = 4 * (qb + 1) - t0; ud.rel0 = qb * 256 - 64 * t0; ud.tg0 = t0; ud.q0 = qb * 256;
            ud.slope2 = exp2f(-0.5f * (float)(h + 1)) * LOG2E; ud.sink2 = 0.f;
            att::attn_unit<0, 8, 1, 16 * 256>(ud, (char*)c.lds);
        }
        if (c.tid == 0) nextu[0] = nreg;
        __syncthreads();
        p = nextu[0];
    }
}
#endif
__device__ __forceinline__ void attn1_finish_bf16_phase(const Ctx& c, const bf16* R, const float* lamp, const float* subln, bf16* O) {
    float s01 = 0.f, s23 = 0.f;
    for (int i = 0; i < 64; ++i) { s01 += lamp[i] * lamp[64 + i]; s23 += lamp[128 + i] * lamp[192 + i]; }
    const float lam_init = 0.8f - 0.6f * expf(-0.3f * 1.0f);
    const float lam = expf(s01) - expf(s23) + lam_init;
    const long total = (long)M * 16;
    for (long id = gtid_now(); id < total; id += c.gsz) {
        const bf16* p1 = R + (size_t)id * 256; const bf16* p2 = p1 + 128;
        float ss = 0.f;
#pragma unroll 4
        for (int i = 0; i < 16; ++i) { const u32x4 a = *(const u32x4*)(p1 + 8 * i), bq = *(const u32x4*)(p2 + 8 * i);
#pragma unroll
            for (int k = 0; k < 4; ++k) { const float x0 = bf2f(a[k] & 0xffffu) - lam * bf2f(bq[k] & 0xffffu), x1 = bf2f(a[k] >> 16) - lam * bf2f(bq[k] >> 16); ss += x0 * x0 + x1 * x1; } }
        const float rs = (1.f - lam_init) / sqrtf(ss * (1.f / 128.f) + RMS_EPS);
        bf16* op = O + (size_t)id * 128;
#pragma unroll 4
        for (int i = 0; i < 16; ++i) { const u32x4 a = *(const u32x4*)(p1 + 8 * i), bq = *(const u32x4*)(p2 + 8 * i); u32x4 w;
#pragma unroll
            for (int k = 0; k < 4; ++k) { const float x0 = bf2f(a[k] & 0xffffu) - lam * bf2f(bq[k] & 0xffffu), x1 = bf2f(a[k] >> 16) - lam * bf2f(bq[k] >> 16);
                w[k] = pk2(x0 * rs * subln[8 * i + 2 * k], x1 * rs * subln[8 * i + 2 * k + 1]); }
            *(u32x4*)(op + 8 * i) = w; }
    }
}
__device__ __forceinline__ void attn0_tuned_phase(const Ctx& c, const bf16* qkv, const float* sinks, bf16* OBR  , float* LSE  , bf16* O, int xlo, int xhi) {
    const int G = gridDim.x, vcu = vcu_of(blockIdx.x, G);
    for (int gid = vcu; gid < NB * 64; gid += G) {
        const int b = gid / 64, kind = (gid % 64) / 16, h = gid % 16;
        const float slope2 = exp2f(-0.5f * (float)(h + 1)) * LOG2E;
        if (kind < 3) {
            const int dil = kind == 0 ? 1 : (kind == 1 ? 4 : 16), nblk = 16 / dil;
            for (int x = xlo; x < xhi; ++x) {
                const int r = x / nblk, blk = x % nblk, q0 = blk * 256, t0 = blk ? 4 * blk - 2 : 0; att::UnitDesc u;
                const size_t qrow = (size_t)(b * T + r + dil * q0), krow = (size_t)(b * T + r + dil * 64 * t0);
#if QKV_HEADMAJOR
                u.Q = qkv + ((size_t)(h) * M + qrow) * 64; u.qs = (long)dil * 64;
                u.K = qkv + ((size_t)(16 + h) * M + krow) * 64; u.ks = (long)dil * 64;
                u.V = qkv + ((size_t)(32 + h) * M + krow) * 64; u.vs = (long)dil * 64;
#else
                u.Q = qkv + qrow * AB_IN + 64 * h; u.qs = (long)dil * AB_IN;
                u.K = qkv + krow * AB_IN + 1024 + 64 * h; u.ks = (long)dil * AB_IN;
                u.V = qkv + krow * AB_IN + 2048 + 64 * h; u.vs = (long)dil * AB_IN;
#endif
                u.O = OBR + ((size_t)kind * M + qrow) * 1024 + 64 * h; u.os = (long)dil * 1024;
                u.lse = LSE + ((size_t)kind * 16 + h) * M + qrow; u.lses = (long)dil;
                u.NT = blk ? 6 : 4; u.rel0 = q0 - 64 * t0; u.tg0 = t0; u.q0 = q0; u.slope2 = slope2 * (float)dil; u.sink2 = 0.f;
                if (dil == 1) att::attn_unit<1, 8, 1, 1024>(u, (char*)c.lds); else if (dil == 4) att::attn_unit<1, 8, 4, 4096>(u, (char*)c.lds); else att::attn_unit<1, 8, 16, 16384>(u, (char*)c.lds);
            }
        } else {
            const int kvh = h >> 3;
            for (int x = xlo; x < xhi; ++x) {
                const int q0 = x * 256, t0 = x ? 4 * x - 2 : 0; att::UnitDesc u;
                const size_t qrow = (size_t)(b * T + q0), krow = (size_t)(b * T + 64 * t0);
#if QKV_HEADMAJOR
                u.Q = qkv + ((size_t)(48 + h) * M + qrow) * 64; u.qs = 64;
                u.K = qkv + ((size_t)(64 + kvh) * M + krow) * 64; u.ks = 64;
                u.V = qkv + ((size_t)(66 + kvh) * M + krow) * 64; u.vs = 64;
#else
                u.Q = qkv + qrow * AB_IN + 3072 + 64 * h; u.qs = AB_IN;
                u.K = qkv + krow * AB_IN + 4096 + 64 * kvh; u.ks = AB_IN;
                u.V = qkv + krow * AB_IN + 4224 + 64 * kvh; u.vs = AB_IN;
#endif
                u.O = O + qrow * D + 1024 + 64 * h; u.os = D;
                u.lse = nullptr; u.lses = 0;
                u.NT = x ? 6 : 4; u.rel0 = q0 - 64 * t0; u.tg0 = t0; u.q0 = q0; u.slope2 = slope2; u.sink2 = sinks[h] * LOG2E;
                att::attn_unit<2, 8, 1, D>(u, (char*)c.lds);
            }
        }
    }
}
__device__ __forceinline__ void attn0_merge_phase(const Ctx& c, const bf16* __restrict__ OBR, const float* __restrict__ LSE, bf16* __restrict__ O) {
    const long total = (long)M * 16 * 8;
#pragma unroll 4
    for (long id8 = gtid_now(); id8 < total; id8 += c.gsz) {
        const long id = id8 >> 3; const int pc = (int)(id8 & 7);
        const long m = id / 16; const int h = (int)(id % 16);
        const size_t li = (size_t)h * M + (size_t)m; const float l0 = LSE[li], l1 = LSE[(size_t)M * 16 + li], l2 = LSE[(size_t)2 * M * 16 + li];
        const float mx = fmaxf(l0, fmaxf(l1, l2)); float w0 = exp2f(l0 - mx), w1 = exp2f(l1 - mx), w2 = exp2f(l2 - mx); const float inv = 1.f / (w0 + w1 + w2); w0 *= inv; w1 *= inv; w2 *= inv;
        const bf16* p0 = OBR + (size_t)m * 1024 + 64 * h + 8 * pc; const bf16* p1 = p0 + (size_t)M * 1024; const bf16* p2 = p1 + (size_t)M * 1024;
        const u32x4 a = *(const u32x4*)p0, bq = *(const u32x4*)p1, cq = *(const u32x4*)p2; u32x4 w;
#pragma unroll
        for (int k = 0; k < 4; ++k) w[k] = pk2(w0 * bf2f(a[k] & 0xffffu) + w1 * bf2f(bq[k] & 0xffffu) + w2 * bf2f(cq[k] & 0xffffu), w0 * bf2f(a[k] >> 16) + w1 * bf2f(bq[k] >> 16) + w2 * bf2f(cq[k] >> 16));
        *(u32x4*)(O + (size_t)m * D + 64 * h + 8 * pc) = w;
    }
}

__device__ __forceinline__ void convert_router(const Ctx& c, const float* wr, bf16* wrt) {
    for (int id2 = gtid_now(); id2 < 2 * NE * D; id2 += c.gsz) { const int l = id2 / (NE * D), id = id2 % (NE * D), k = id / NE, n = id % NE; const float w = wr[id2];
        const unsigned hb = f2bf(w); const float hf = bf2f(hb);
        const int kkn = 2 * ((k >> 6) & 3) + ((k >> 3) & 1), qn = (k >> 4) & 3;
        const int off = l * 2 * NE * D + (((((k >> 8) * 8 + kkn) * 4 + (n >> 4)) * 2) * 64 + ((n & 15) + 16 * qn)) * 8 + (k & 7);
        wrt[off] = (bf16)hb; wrt[off + 512] = (bf16)f2bf(w - hf); }
}
#define DPPF(old, v, ctrl, rm) __int_as_float(__builtin_amdgcn_update_dpp(__float_as_int(old), __float_as_int(v), ctrl, rm, 0xf, false))
__device__ __forceinline__ float dpp_max8(float v) {
    v = fmaxf(v, DPPF(v, v, 0xB1, 0xf)); v = fmaxf(v, DPPF(v, v, 0x4E, 0xf)); v = fmaxf(v, DPPF(v, v, 0x141, 0xf)); return v; }
__device__ __forceinline__ float wave_max_u(float v) {
    v = dpp_max8(v); v = fmaxf(v, DPPF(v, v, 0x140, 0xf)); v = fmaxf(v, DPPF(v, v, 0x142, 0xa)); v = fmaxf(v, DPPF(v, v, 0x143, 0xc));
    return __int_as_float(__builtin_amdgcn_readlane(__float_as_int(v), 63)); }
__device__ __forceinline__ float wave_sum_u(float v) {
    v += DPPF(0.f, v, 0xB1, 0xf); v += DPPF(0.f, v, 0x4E, 0xf); v += DPPF(0.f, v, 0x141, 0xf); v += DPPF(0.f, v, 0x140, 0xf); v += DPPF(0.f, v, 0x142, 0xa); v += DPPF(0.f, v, 0x143, 0xc);
    return __int_as_float(__builtin_amdgcn_readlane(__float_as_int(v), 63)); }
constexpr int RT_ROUTER = 2;
__device__ __forceinline__ void router2_phase(const Ctx& c, const float* x1, const float* g, const float* ada_l, const bf16* wrt, const float* rbias,
                                              bf16* HF, int* idx, float* gate, int* wcnt, bf16* HFB = nullptr) {
    constexpr int RT = RT_ROUTER, RU = 16 * RT, NU = M / RU;
    LAS float* red = (LAS float*)c.lds;
    LAS float* part = (LAS float*)(c.lds + 1024);
    LAS float* GA = (LAS float*)(c.lds + 1024 + RT * 32768);
    LAS float* GB = GA + D;
    const int w = __builtin_amdgcn_readfirstlane((int)threadIdx.x >> 6);
    const float rb = rbias[threadIdx.x & 63];
    unsigned cnt = 0u;
    const int per = (NU + (int)gridDim.x - 1) / (int)gridDim.x, u0 = blockIdx.x * per, u1 = (u0 + per < NU) ? u0 + per : NU;
    int bcur = -1;
#pragma unroll 1
    for (int u = u0; u < u1; ++u) {
        int tid = threadIdx.x; asm volatile("" : "+v"(tid));
        const int lane = tid & 63, r = lane & 15, q = lane >> 4, cb = 256 * w + 16 * q;
#define KOFF(kk_) (64 * ((kk_) >> 1) + 8 * ((kk_) & 1))
        const bf16* wf = wrt + (size_t)w * (8 * 4 * 2 * 512) + lane * 8;
        const int m0 = u * RU, b = m0 / T;
        if (b != bcur) { bcur = b; __syncthreads();
            for (int col = 4 * tid; col < D; col += 2048) { const f32x4 gg = *(const f32x4*)(g + col), sc = *(const f32x4*)(ada_l + (size_t)b * 6 * D + 4 * D + col), sh = *(const f32x4*)(ada_l + (size_t)b * 6 * D + 3 * D + col);
                *(LAS f32x4*)(GA + col) = gg * (sc + 1.f); *(LAS f32x4*)(GB + col) = sh; } }
        u32x4 xv[RT][8]; float rstd[RT];
#pragma unroll
        for (int t = 0; t < RT; ++t) { const bf16* xr = (const bf16*)x1 + (size_t)(m0 + 16 * t + r) * D + cb;
#pragma unroll
            for (int kk = 0; kk < 8; ++kk) xv[t][kk] = *(const u32x4*)(xr + KOFF(kk)); }
#pragma unroll
        for (int t = 0; t < RT; ++t) { float ss = 0.f;
#pragma unroll
            for (int kk = 0; kk < 8; ++kk)
#pragma unroll
                for (int j = 0; j < 4; ++j) { const float a0 = bf2f(xv[t][kk][j] & 0xffffu), a1 = bf2f(xv[t][kk][j] >> 16); ss += a0 * a0 + a1 * a1; }
            ss += __shfl_xor(ss, 16); ss += __shfl_xor(ss, 32);
            if (q == 0) red[(t * 8 + w) * 16 + r] = ss; }
        __syncthreads();
        f32x4 acc[RT][4]; u32x2 q8keep[RT];
#pragma unroll
        for (int t = 0; t < RT; ++t) { float tot = 0.f;
#pragma unroll
            for (int w2 = 0; w2 < 8; ++w2) tot += red[(t * 8 + w2) * 16 + r];
            rstd[t] = 1.f / sqrtf(tot * (1.f / D) + RMS_EPS);
#pragma unroll
            for (int nt = 0; nt < 4; ++nt) acc[t][nt] = (f32x4){0.f, 0.f, 0.f, 0.f}; }
#pragma unroll
        for (int kk = 0; kk < 8; ++kk) {
            const f32x4 ga0 = *(LAS f32x4*)(GA + cb + KOFF(kk)), ga1 = *(LAS f32x4*)(GA + cb + KOFF(kk) + 4), gb0 = *(LAS f32x4*)(GB + cb + KOFF(kk)), gb1 = *(LAS f32x4*)(GB + cb + KOFF(kk) + 4);
            bf16x8 ah[RT], al[RT];
#pragma unroll
            for (int t = 0; t < RT; ++t) { const u32x4 xw = xv[t][kk]; f32x4 hh[2];
                hh[0] = (f32x4){bf2f(xw.x & 0xffffu), bf2f(xw.x >> 16), bf2f(xw.y & 0xffffu), bf2f(xw.y >> 16)} * rstd[t] * ga0 + gb0;
                hh[1] = (f32x4){bf2f(xw.z & 0xffffu), bf2f(xw.z >> 16), bf2f(xw.w & 0xffffu), bf2f(xw.w >> 16)} * rstd[t] * ga1 + gb1;
                u32x4 hw, lw;
#pragma unroll
                for (int s2 = 0; s2 < 2; ++s2) { const unsigned h0 = f2bf(hh[s2].x), h1 = f2bf(hh[s2].y), h2 = f2bf(hh[s2].z), h3 = f2bf(hh[s2].w);
                    hw[2 * s2] = h0 | (h1 << 16); hw[2 * s2 + 1] = h2 | (h3 << 16);
                    lw[2 * s2] = pk2(hh[s2].x - bf2f(h0), hh[s2].y - bf2f(h1)); lw[2 * s2 + 1] = pk2(hh[s2].z - bf2f(h2), hh[s2].w - bf2f(h3)); }
#if USE_FP8_MOE
                { const unsigned qa = pk4_fp8(hh[0].x * F8_HSCALE, hh[0].y * F8_HSCALE, hh[0].z * F8_HSCALE, hh[0].w * F8_HSCALE), qb2 = pk4_fp8(hh[1].x * F8_HSCALE, hh[1].y * F8_HSCALE, hh[1].z * F8_HSCALE, hh[1].w * F8_HSCALE);
                  if (kk & 1) { u32x4 q16; q16.x = q8keep[t].x; q16.y = q8keep[t].y; q16.z = qa; q16.w = qb2; *(u32x4*)((unsigned char*)HF + (size_t)(m0 + 16 * t + r) * D + cb + KOFF(kk - 1)) = q16; }
                  else { q8keep[t].x = qa; q8keep[t].y = qb2; } }
#if SHARED_BF16
                *(u32x4*)(HFB + (size_t)(m0 + 16 * t + r) * D + cb + KOFF(kk)) = hw;
#endif
#else
                *(u32x4*)(HF + (size_t)(m0 + 16 * t + r) * D + cb + KOFF(kk)) = hw;
#endif
                ah[t] = __builtin_bit_cast(bf16x8, hw); al[t] = __builtin_bit_cast(bf16x8, lw); }
#pragma unroll
            for (int nt = 0; nt < 4; ++nt) { const bf16x8 bh = *(const bf16x8*)(wf + ((kk * 4 + nt) * 2) * 512), bl = *(const bf16x8*)(wf + ((kk * 4 + nt) * 2 + 1) * 512);
#pragma unroll
                for (int t = 0; t < RT; ++t) {
                    acc[t][nt] = __builtin_amdgcn_mfma_f32_16x16x32_bf16(ah[t], bh, acc[t][nt], 0, 0, 0);
                    acc[t][nt] = __builtin_amdgcn_mfma_f32_16x16x32_bf16(ah[t], bl, acc[t][nt], 0, 0, 0);
                    acc[t][nt] = __builtin_amdgcn_mfma_f32_16x16x32_bf16(al[t], bh, acc[t][nt], 0, 0, 0); } }
            if (kk & 1) asm volatile("" ::: "memory");
        }
#pragma unroll
        for (int t = 0; t < RT; ++t)
#pragma unroll
            for (int nt = 0; nt < 4; ++nt)
#pragma unroll
                for (int j = 0; j < 4; ++j) part[((t * 8 + w) * 16 + 4 * q + j) * 64 + 16 * nt + r] = acc[t][nt][j];
        __syncthreads();
#pragma unroll 1
        for (int rp = 0; rp < RT; ++rp) {
            float score[2], cur[2]; int rank[2];
#pragma unroll
            for (int x = 0; x < 2; ++x) { const int row = 2 * RT * w + 2 * rp + x; float logit = 0.f;
#pragma unroll
                for (int w2 = 0; w2 < 8; ++w2) logit += part[(((row >> 4) * 8 + w2) * 16 + (row & 15)) * 64 + lane];
                score[x] = 1.f / (1.f + expf(-logit));
                const float sel = score[x] + rb;
                const float m1 = dpp_max8(sel);
                const unsigned long long eqm = __ballot(sel == m1);
                const unsigned grp_eq = (unsigned)((eqm >> (lane & ~7)) & 0xffull);
                const int first = __builtin_ctz(grp_eq);
                const float m2 = dpp_max8(((lane & 7) == first) ? -3e38f : sel);
                const float gs = m1 + m2;
                int grank = 0; const int mygrp = lane >> 3;
#pragma unroll
                for (int g2 = 0; g2 < 8; ++g2) { const float o = __int_as_float(__builtin_amdgcn_readlane(__float_as_int(gs), g2 * 8)); grank += (o > gs || (o == gs && g2 < mygrp)) ? 1 : 0; }
                cur[x] = (grank < 4) ? sel : -1e30f; rank[x] = 64; }
#pragma unroll
            for (int it = 0; it < TOPK; ++it)
#pragma unroll
                for (int x = 0; x < 2; ++x) { const float mx = wave_max_u(cur[x]); const int f = (int)__builtin_ctzll(__ballot(cur[x] == mx));
                    if (lane == f) { rank[x] = it; cur[x] = -3e38f; } }
#pragma unroll
            for (int x = 0; x < 2; ++x) { const int m = m0 + 2 * RT * w + 2 * rp + x; const bool chosen = rank[x] < TOPK;
                const float gsum = wave_sum_u(chosen ? score[x] : 0.f);
                if (chosen) { idx[(size_t)m * 8 + rank[x]] = lane | (int)(cnt << 8); gate[(size_t)m * 8 + rank[x]] = score[x] / gsum * 2.5f; cnt += 1u; } }
        }
        __syncthreads();
    }
    wcnt[(size_t)(blockIdx.x * 8 + w) * 64 + (threadIdx.x & 63)] = (int)cnt;
}
#undef KOFF
__device__ __forceinline__ void slot2_phase(const Ctx& c, const int* idx, const int* wcnt, unsigned* nrt_out, int* pos, int* slot_tok, int* tile_exp) {
    LAS int* ST = (LAS int*)c.lds;
    LAS int* SB = ST + 512;
    LAS int* SO = SB + 512;
    LAS int* tot = SO + 512;
    LAS int* bef = tot + 64;
    LAS int* ps = bef + 64;
    LAS int* base = ps + 128;
    const int e = c.tid & 63, p = c.tid >> 6, G = gridDim.x, blk = blockIdx.x;
    { int Tp = 0, Bp = 0;
#pragma unroll 8
      for (int b2 = 0; b2 < G; ++b2) { const int v = wcnt[(size_t)(b2 * 8 + p) * 64 + e]; Tp += v; Bp += (b2 < blk) ? v : 0; }
      ST[p * 64 + e] = Tp; SB[p * 64 + e] = Bp; SO[p * 64 + e] = wcnt[(size_t)(blk * 8 + p) * 64 + e]; }
    __syncthreads();
    if (c.tid < 64) { int t = 0, bb = 0;
#pragma unroll
        for (int p2 = 0; p2 < 8; ++p2) { t += ST[p2 * 64 + e]; bb += SB[p2 * 64 + e]; }
        tot[e] = t; bef[e] = bb; }
    __syncthreads();
    if (c.tid == 0) { int acc = 0; for (int e2 = 0; e2 < NE; ++e2) { ps[e2] = acc; acc += (tot[e2] + 255) / 256 * 256; } ps[64] = acc; }
    __syncthreads();
    { int o = ps[e] + bef[e];
      for (int p2 = 0; p2 < p; ++p2) o += SO[p2 * 64 + e];
      base[p * 64 + e] = o; }
    __syncthreads();
    {
        constexpr int RU = 16 * RT_ROUTER, NU = M / RU; const int per = (NU + G - 1) / G, mlo = blk * per * RU, mhi = (mlo + per * RU < M) ? mlo + per * RU : M;
        for (int i = c.tid; i < (mhi - mlo) * 8; i += 512) {
            const int m = mlo + (i >> 3), k = i & 7, wv = (m % RU) / (2 * RT_ROUTER); const size_t a = (size_t)m * 8 + k;
            const int code = idx[a], ee = code & 255, rk = code >> 8, slot = base[wv * 64 + ee] + rk;
            slot_tok[slot] = m; pos[a] = slot; }
    }
    for (int t = gtid_now(); t < M; t += c.gsz) slot_tok[CAPR + t] = t;
    if (blk == 0) {
        if (c.tid < NE) { const int s0 = ps[e], cn = tot[e], pe = s0 + (cn + 255) / 256 * 256;
            for (int s = s0 + cn; s < pe; ++s) slot_tok[s] = 0;
            for (int tt = s0 / 256; tt < pe / 256; ++tt) tile_exp[tt] = e; }
        if (c.tid == 0) *nrt_out = (unsigned)(ps[64] / 256);
    }
    __syncthreads();
}

template <int L> __device__ __forceinline__ void moe_up_tuned(const Ctx& c, unsigned char* ws) {
    const int nrt = (int)c.ctl[CW_NRT + L];
#if USE_FP8_MOE && SHARED_BF16
    { pg8::PlainSched S; S.o.init(M / 256, UPN / 256, gridDim.x, blockIdx.x); S.Bt = (const char*)(ws + WS_WUPS) + (size_t)L * UPN * D * 2; S.K = D;
      pg8::EpiUp E{(bf16*)(ws + WS_ACTS)}; pg8::gemm_phase(c.lds, (const char*)(ws + WS_HFB), D, S, E); }
    const int ntile = nrt;
#else
    const int ntile = nrt + M / 256;
#endif
    pg8::GroupSched<true> S; S.o.init(ntile, UPN / 256, gridDim.x, blockIdx.x);
    { LAS int* te = (LAS int*)(c.lds + 132096);
      for (int i = threadIdx.x; i < nrt; i += 512) te[i] = ((const int*)(ws + WS_TILEEXP))[i];
      __syncthreads(); S.tile_exp = te; }
    S.nrt = nrt; S.slot_tok = (const int*)(ws + WS_SLOTTOK);
#if USE_FP8_MOE
    S.W = (const char*)(ws + WS_WUP) + (size_t)L * NEX * UPN * D; S.wstride = (size_t)UPN * D; S.K = D / 2;
    pg8::EpiUp8 E{ws + WS_ACT}; pg8::gemm_phase<pg8::EpiUp8, pg8::GroupSched<true>, true>(c.lds, (const char*)(ws + WS_HF), D / 2, S, E);
#else
    S.W = (const char*)(ws + WS_WUP) + (size_t)L * NEX * UPN * D * 2; S.wstride = (size_t)UPN * D * 2; S.K = D;
    pg8::EpiUp E{(bf16*)(ws + WS_ACT)}; pg8::gemm_phase(c.lds, (const char*)(ws + WS_HF), D, S, E);
#endif
}
template <int L> __device__ __forceinline__ void moe_down_tuned(const Ctx& c, unsigned char* ws) {
    const int nrt = (int)c.ctl[CW_NRT + L];
#if USE_FP8_MOE && SHARED_BF16
    { pg8::PlainSched S; S.o.init(M / 256, D / 256, gridDim.x, blockIdx.x); S.Bt = (const char*)(ws + WS_WDNS) + (size_t)L * D * ED * 2; S.K = ED;
      pg8::EpiDown E{(bf16*)(ws + WS_Y), CAPR}; pg8::gemm_phase(c.lds, (const char*)(ws + WS_ACTS), ED, S, E); }
    const int ntile = nrt;
#else
    const int ntile = nrt + M / 256;
#endif
    pg8::GroupSched<false> S; S.o.init(ntile, D / 256, gridDim.x, blockIdx.x);
    { LAS int* te = (LAS int*)(c.lds + 132096);
      for (int i = threadIdx.x; i < nrt; i += 512) te[i] = ((const int*)(ws + WS_TILEEXP))[i];
      __syncthreads(); S.tile_exp = te; }
    S.nrt = nrt; S.slot_tok = (const int*)(ws + WS_SLOTTOK);
#if USE_FP8_MOE
    S.W = (const char*)(ws + WS_WDN) + (size_t)L * NEX * D * ED; S.wstride = (size_t)D * ED; S.K = ED / 2;
    pg8::EpiDown8 E{(bf16*)(ws + WS_Y)}; pg8::gemm_phase<pg8::EpiDown8, pg8::GroupSched<false>, true>(c.lds, (const char*)(ws + WS_ACT), ED / 2, S, E);
#else
    S.W = (const char*)(ws + WS_WDN) + (size_t)L * NEX * D * ED * 2; S.wstride = (size_t)D * ED * 2; S.K = ED;
    pg8::EpiDown E{(bf16*)(ws + WS_Y)}; pg8::gemm_phase(c.lds, (const char*)(ws + WS_ACT), ED, S, E);
#endif
}
template <int L> __device__ __forceinline__ void qkv_tuned(const Ctx& c, unsigned char* ws, const float* gains) {
    constexpr int NCOL = L == 0 ? AB_IN : C_IN; constexpr bool TUNED_ATT = L == 0 ? (USE_ATT0 != 0) : (USE_ATT1 != 0);
    pg8::PlainSched S; S.o.init(M / 256, NCOL / 256, gridDim.x, blockIdx.x); S.Bt = (const char*)(ws + (L == 0 ? WS_W0IN : WS_W1IN));
#if USE_FP8_QKV
    S.K = D / 2; pg8::EpiQKV<L> E{(bf16*)(ws + WS_QKV), NCOL, gains, TUNED_ATT ? att::C2 : 1.f, 1.f / (F8_HSCALE * F8_WSCALE)};
    pg8::gemm_phase<pg8::EpiQKV<L>, pg8::PlainSched, true>(c.lds, (const char*)(ws + WS_XN), D / 2, S, E);
#else
    S.K = D; pg8::EpiQKV<L> E{(bf16*)(ws + WS_QKV), NCOL, gains, TUNED_ATT ? att::C2 : 1.f, 1.f};
    pg8::gemm_phase(c.lds, (const char*)(ws + WS_XN), D, S, E);
#endif
}

template <int L> __device__ __forceinline__ void outproj_epi(const Ctx& c, unsigned char* ws, const pg8::PlainSched& S, const float* xin_f32, const float* gm) {
#if RES_BF16
    if (L == 0) { pg8::EpiOutB<false> E{xin_f32, gm, (bf16*)(ws + WS_X1)}; pg8::gemm_phase(c.lds, (const char*)(ws + WS_O), D, S, E); }
    else { pg8::EpiOutB<true> E{ws + WS_X1 + (size_t)M * D * 2, gm, (bf16*)(ws + WS_X1)}; pg8::gemm_phase(c.lds, (const char*)(ws + WS_O), D, S, E); }
#else
    pg8::EpiOut E{xin_f32, gm, (float*)(ws + WS_X1)}; pg8::gemm_phase(c.lds, (const char*)(ws + WS_O), D, S, E);
#endif
}
__global__ void __launch_bounds__(512, 2) mega(Args args) {
    extern __shared__ __attribute__((aligned(16))) unsigned char lds_raw[];
    Ctx c;
    c.lds = (LAS unsigned char*)lds_raw;
    c.tid = threadIdx.x; c.lane = c.tid & 63; c.wave = __builtin_amdgcn_readfirstlane(c.tid >> 6);
    c.gw = blockIdx.x * 8 + c.wave; c.ngw = gridDim.x * 8; c.gsz = gridDim.x * 512;
    c.ws = args.ws; c.ctl = (unsigned*)(args.ws + WS_CTL);
    volatile LAS unsigned* xbw = (volatile LAS unsigned*)(c.lds + LDS_BYTES - 16);
    if (c.tid < 4) xbw[c.tid] = 0u;
    __syncthreads();
    const int lo = args.ph_lo, hi = args.ph_hi;
    XcdBarrier bar; bar.bar = c.ctl + CW_BAR; bar.x = 0; bar.st = xbw;
    if (hi - lo > 1) bar = xcd_barrier_post(c.ctl + CW_BAR, xbw);
#ifdef PHASE_ONLY
#define IN(k) ((k) == PHASE_ONLY && lo <= (k) && (k) < hi)
#else
#define IN(k) (lo <= (k) && (k) < hi)
#endif
#define PHASE(k, ...) do { if (IN(k)) { __VA_ARGS__ } if (IN(k) && ((REPMASK >> (k)) & 1u)) { __syncthreads(); __VA_ARGS__ } } while (0);
#if PROBE_SEL >= 0
    volatile LAS unsigned long long* stamp_ = (volatile LAS unsigned long long*)(c.lds + 146000);
    if (c.tid == 0) stamp_[0] = __builtin_amdgcn_s_memrealtime();
#define SEAM(k) do { if (c.tid == 0) stamp_[1 + 2 * (k)] = __builtin_amdgcn_s_memrealtime(); if (IN(k) && IN((k) + 1)) xcd_barrier(bar); else __syncthreads(); \
        if (c.tid == 0) stamp_[2 + 2 * (k)] = __builtin_amdgcn_s_memrealtime(); } while (0)
#else
#define SEAM(k) do { if (IN(k) && IN((k) + 1)) xcd_barrier(bar); else __syncthreads(); } while (0)
#endif
    unsigned char* ws = args.ws;
#define XIN (args.in[0])
#define cin (args.in[1])
#define norm_mix (args.in[2])
#define norm_ffn (args.in[3])
#define w_ada (args.in[4])
#define b_ada (args.in[5])
#define ada ((float*)(ws + WS_ADA))
#define W0IN ((bf16*)(ws + WS_W0IN))
#define W0OUT ((bf16*)(ws + WS_W0OUT))
#define W1IN ((bf16*)(ws + WS_W1IN))
#define W1OUT ((bf16*)(ws + WS_W1OUT))
#define WUP ((bf16*)(ws + WS_WUP))
#define WDN ((bf16*)(ws + WS_WDN))
#define XN ((bf16*)(ws + WS_XN))
#define QKV ((bf16*)(ws + WS_QKV))
#define OBUF ((bf16*)(ws + WS_O))
#define X1 ((float*)(ws + WS_X1))
#define HF ((bf16*)(ws + WS_HF))
#define IDX ((int*)(ws + WS_IDX))
#define GATE ((float*)(ws + WS_GATE))
#define POS ((int*)(ws + WS_POS))
#define SLOTTOK ((int*)(ws + WS_SLOTTOK))
#define TILEEXP ((int*)(ws + WS_TILEEXP))
#define ACT ((bf16*)(ws + WS_ACT))
#define Y ((bf16*)(ws + WS_Y))
#define TMP ((float*)(ws + WS_TMP))
#define OUTP (args.out)

    PHASE(0, {
        constexpr int QM = USE_PG8_QKV ? 1 : 0, UM = USE_PG8_MOE ? 2 : 0;
#if USE_CONV128 && USE_FP8_MOE
        convert_dense_all<QM, USE_FP8_QKV != 0>(c, args.in[6], args.in[10], args.in[9], args.in[14], (unsigned char*)W0IN, (unsigned char*)W1IN, (unsigned char*)W0OUT, (unsigned char*)W1OUT, USE_FP8_QKV ? F8_WSCALE : 1.f);
#if !(DEFER_CONV && USE_ATT0 && USE_ATT1 && !SHARED_BF16)
        for (int l = 0; l < 2; ++l) {
            convert_batch128<2, true>(c, args.in[17] + (size_t)l * NE * D * UPN, D, UPN, (unsigned char*)WUP + (size_t)l * NEX * UPN * D, NE, (size_t)UPN * D, F8_WSCALE);
            convert_batch128<0, true>(c, args.in[18] + (size_t)l * NE * ED * D, ED, D, (unsigned char*)WDN + (size_t)l * NEX * D * ED, NE, (size_t)D * ED, F8_WSCALE);
#if SHARED_BF16
            convert_batch128<2, false>(c, args.in[19] + (size_t)l * D * UPN, D, UPN, ws + WS_WUPS + (size_t)l * UPN * D * 2, 1, 0, 1.f);
            convert_batch128<0, false>(c, args.in[20] + (size_t)l * ED * D, ED, D, ws + WS_WDNS + (size_t)l * D * ED * 2, 1, 0, 1.f);
#else
            convert_batch128<2, true>(c, args.in[19] + (size_t)l * D * UPN, D, UPN, (unsigned char*)WUP + ((size_t)l * NEX + NE) * UPN * D, 1, 0, F8_WSCALE);
            convert_batch128<0, true>(c, args.in[20] + (size_t)l * ED * D, ED, D, (unsigned char*)WDN + ((size_t)l * NEX + NE) * D * ED, 1, 0, F8_WSCALE);
#endif
        }
#endif
#else
        convert_batch<QM>(c, args.in[6], D, AB_IN, W0IN, 1, 0);
        convert_batch<0>(c, args.in[9], D, D, W0OUT, 1, 0);
        convert_batch<QM>(c, args.in[10], D, C_IN, W1IN, 1, 0);
        convert_batch<0>(c, args.in[14], D, D, W1OUT, 1, 0);
        for (int l = 0; l < 2; ++l) {
#if USE_FP8_MOE
            convert_batch_f8<2>(c, args.in[17] + (size_t)l * NE * D * UPN, D, UPN, (unsigned char*)WUP + (size_t)l * NEX * UPN * D, NE, (size_t)UPN * D);
            convert_batch_f8<2>(c, args.in[19] + (size_t)l * D * UPN, D, UPN, (unsigned char*)WUP + ((size_t)l * NEX + NE) * UPN * D, 1, 0);
            convert_batch_f8<0>(c, args.in[18] + (size_t)l * NE * ED * D, ED, D, (unsigned char*)WDN + (size_t)l * NEX * D * ED, NE, (size_t)D * ED);
            convert_batch_f8<0>(c, args.in[20] + (size_t)l * ED * D, ED, D, (unsigned char*)WDN + ((size_t)l * NEX + NE) * D * ED, 1, 0);
#else
            convert_batch<UM>(c, args.in[17] + (size_t)l * NE * D * UPN, D, UPN, WUP + (size_t)l * NEX * UPN * D, NE, (size_t)UPN * D);
            convert_batch<UM>(c, args.in[19] + (size_t)l * D * UPN, D, UPN, WUP + ((size_t)l * NEX + NE) * UPN * D, 1, 0);
            convert_batch<0>(c, args.in[18] + (size_t)l * NE * ED * D, ED, D, WDN + (size_t)l * NEX * D * ED, NE, (size_t)D * ED);
            convert_batch<0>(c, args.in[20] + (size_t)l * ED * D, ED, D, WDN + ((size_t)l * NEX + NE) * D * ED, 1, 0);
#endif
        }
#endif
        convert_router(c, args.in[15], (bf16*)(ws + WS_WRT));
        __syncthreads();
        ada_phase(c, cin, w_ada, b_ada, ada);
    })
    SEAM(0);
    PHASE(1, norm_phase(c, XIN, norm_mix, ada, 0, D, XN);)
    SEAM(1);
#if USE_PG8_QKV
    PHASE(2, qkv_tuned<0>(c, ws, args.in[7]);)
    SEAM(2);
#else
    PHASE(2, gemm_plain_bf16(c, XN, W0IN, D, AB_IN, QKV);)
    SEAM(2);
#endif
#if USE_ATT0
    static_assert(USE_PG8_QKV, "the tuned attention needs Q pre-scaled by the QKV epilogue");
    #if DEFER_CONV
    PHASE(3, { const int xs_ = vcu_of(blockIdx.x, gridDim.x) & 15;
        attn0_tuned_phase(c, QKV, args.in[8], (bf16*)(ws + WS_TMP), (float*)(ws + WS_TMP + (size_t)3 * M * 1024 * 2), OBUF, 0, xs_ + 1);
        { const int cshare = (EXP_ITEMS + (int)gridDim.x - 1) / (int)gridDim.x, cfirst = blockIdx.x * cshare, ccount = (cfirst + cshare <= EXP_ITEMS) ? cshare : (EXP_ITEMS > cfirst ? EXP_ITEMS - cfirst : 0);
          expert_items_block(c, ExpertSrc{args.in[17], args.in[19], args.in[18], args.in[20]}, 0, ws, cfirst, ccount); __syncthreads(); }
        attn0_tuned_phase(c, QKV, args.in[8], (bf16*)(ws + WS_TMP), (float*)(ws + WS_TMP + (size_t)3 * M * 1024 * 2), OBUF, xs_ + 1, 16); })
#else
    PHASE(3, attn0_tuned_phase(c, QKV, args.in[8], (bf16*)(ws + WS_TMP), (float*)(ws + WS_TMP + (size_t)3 * M * 1024 * 2), OBUF, 0, 16);)
#endif
    SEAM(3);
    PHASE(4, attn0_merge_phase(c, (const bf16*)(ws + WS_TMP), (const float*)(ws + WS_TMP + (size_t)3 * M * 1024 * 2), OBUF);)
    SEAM(4);
#else
#if !USE_PG8_QKV
    PHASE(3, qknorm0_phase(c, QKV, args.in[7]);)
#endif
    SEAM(3);
    PHASE(4, attn0_phase(c, QKV, args.in[8], OBUF);)
    SEAM(4);
#endif
#if USE_PG8_OUT
    PHASE(5, { pg8::PlainSched S; S.o.init(M / 256, D / 256, gridDim.x, blockIdx.x); S.Bt = (const char*)W0OUT; S.K = D;
        outproj_epi<0>(c, ws, S, XIN, ada + 2 * D); })
#else
    PHASE(5, gemm_outproj(c, OBUF, W0OUT, XIN, ada + 2 * D, X1);)
#endif
    SEAM(5);
#if USE_ROUTER2
    PHASE(6, router2_phase(c, X1, norm_ffn, ada, (const bf16*)(ws + WS_WRT), args.in[16], HF, IDX, GATE, (int*)(ws + WS_WCNT), (bf16*)(ws + WS_HFB));)
    SEAM(6);
    PHASE(7, slot2_phase(c, IDX, (const int*)(ws + WS_WCNT), c.ctl + CW_NRT, POS, SLOTTOK, TILEEXP);)
#else
    PHASE(6, router_phase(c, X1, norm_ffn, ada, args.in[15], args.in[16], HF, IDX, GATE, c.ctl + CW_CNT);)
    SEAM(6);
    PHASE(7, slot_phase(c, IDX, c.ctl + CW_CNT, c.ctl + CW_CUR, c.ctl + CW_NRT, POS, SLOTTOK, TILEEXP);)
#endif
    SEAM(7);
#if USE_PG8_MOE
    PHASE(8, moe_up_tuned<0>(c, ws);)
    SEAM(8);
    PHASE(9, moe_down_tuned<0>(c, ws);)
#else
    PHASE(8, moe_up_phase(c, HF, WUP, SLOTTOK, TILEEXP, c.ctl + CW_NRT, ACT);)
    SEAM(8);
    PHASE(9, moe_down_phase(c, ACT, WDN, TILEEXP, c.ctl + CW_NRT, Y);)
#endif
    SEAM(9);
    PHASE(10, combine_phase<true>(c, X1, Y, POS, GATE, ada, RES_BF16 ? (float*)(ws + WS_X1 + (size_t)M * D * 2) : OUTP, norm_mix + D, ada + (size_t)4 * 6 * D, XN);)
    SEAM(10);
#define ada1 (ada + (size_t)4 * 6 * D)
#if USE_PG8_QKV
    PHASE(11, qkv_tuned<1>(c, ws, args.in[11]);)
    SEAM(11);
    SEAM(12);
#else
    PHASE(11, gemm_plain_bf16(c, XN, W1IN, D, C_IN, QKV);)
    SEAM(11);
    PHASE(12, qknorm1_phase(c, QKV, args.in[11]);)
    SEAM(12);
#endif
#if USE_ATT1
    PHASE(13, attn1_tuned_phase(c, QKV, args.in[11], (bf16*)TMP, c.ctl + CW_QCTR, ExpertSrc{args.in[17], args.in[19], args.in[18], args.in[20]}, ws, args.in[12], args.in[13], OBUF);)
    SEAM(13);
#if !FUSE_FINISH
    PHASE(14, attn1_finish_bf16_phase(c, (const bf16*)TMP, args.in[12], args.in[13], OBUF);)
#endif
    SEAM(14);
#else
    PHASE(13, attn1_phase(c, QKV, TMP);)
    SEAM(13);
    PHASE(14, attn1_finish_phase(c, TMP, args.in[12], args.in[13], OBUF);)
    SEAM(14);
#endif
#if USE_PG8_OUT
    PHASE(15, { pg8::PlainSched S; S.o.init(M / 256, D / 256, gridDim.x, blockIdx.x); S.Bt = (const char*)W1OUT; S.K = D;
        outproj_epi<1>(c, ws, S, OUTP, ada1 + 2 * D); })
#else
    PHASE(15, gemm_outproj(c, OBUF, W1OUT, OUTP, ada1 + 2 * D, X1);)
#endif
    SEAM(15);
#if USE_ROUTER2
    PHASE(16, router2_phase(c, X1, norm_ffn + D, ada1, (const bf16*)(ws + WS_WRT) + (size_t)2 * NE * D, args.in[16] + NE, HF, IDX, GATE, (int*)(ws + WS_WCNT), (bf16*)(ws + WS_HFB));)
    SEAM(16);
    PHASE(17, slot2_phase(c, IDX, (const int*)(ws + WS_WCNT), c.ctl + CW_NRT + 1, POS, SLOTTOK, TILEEXP);)
#else
    PHASE(16, router_phase(c, X1, norm_ffn + D, ada1, args.in[15] + (size_t)D * NE, args.in[16] + NE, HF, IDX, GATE, c.ctl + CW_CNT + 64);)
    SEAM(16);
    PHASE(17, slot_phase(c, IDX, c.ctl + CW_CNT + 64, c.ctl + CW_CUR + 64, c.ctl + CW_NRT + 1, POS, SLOTTOK, TILEEXP);)
#endif
    SEAM(17);
#if USE_PG8_MOE
    PHASE(18, moe_up_tuned<1>(c, ws);)
    SEAM(18);
    PHASE(19, moe_down_tuned<1>(c, ws);)
#else
    PHASE(18, moe_up_phase(c, HF, WUP + (size_t)NEX * UPN * D, SLOTTOK, TILEEXP, c.ctl + CW_NRT + 1, ACT);)
    SEAM(18);
    PHASE(19, moe_down_phase(c, ACT, WDN + (size_t)NEX * D * ED, TILEEXP, c.ctl + CW_NRT + 1, Y);)
#endif
    SEAM(19);
    PHASE(20, combine_phase<false>(c, X1, Y, POS, GATE, ada1, OUTP, nullptr, nullptr, nullptr);)
#if PROBE_SEL >= 0
    {
        __syncthreads();
        unsigned long long v = 0ull;
        if (c.tid == 0) {
            if (PROBE_SEL >= 100) { const int k = PROBE_SEL - 100; v = stamp_[2 + 2 * k] - (k == 0 ? stamp_[0] : stamp_[2 + 2 * (k - 1)]); }
            else if (PROBE_SEL == 1 || PROBE_SEL == 2) { for (int k = 0; k < NPHASE - 1; ++k) v += stamp_[2 + 2 * k] - stamp_[1 + 2 * k]; }
            else if (PROBE_SEL == 3) { v = stamp_[1 + 2 * 19] - stamp_[0]; }
        }
        if (PROBE_SEL == 2) {
            if (c.tid == 0) __hip_atomic_fetch_add((unsigned long long*)(c.ctl + CW_QCTR + 64), v, __ATOMIC_RELAXED, __HIP_MEMORY_SCOPE_AGENT);
            xcd_barrier(bar);
            if (c.tid == 0) v = __hip_atomic_load((unsigned long long*)(c.ctl + CW_QCTR + 64), __ATOMIC_RELAXED, __HIP_MEMORY_SCOPE_AGENT) / gridDim.x;
        }
        if (blockIdx.x == 0 && c.tid == 0) { const unsigned long long t0 = __builtin_amdgcn_s_memrealtime(), w = v * PROBE_GAIN;
            while (__builtin_amdgcn_s_memrealtime() - t0 < w) __builtin_amdgcn_s_sleep(8); }
    }
#endif
#undef IN
#undef SEAM
#undef ada
#undef ada1
#undef W0IN
#undef W0OUT
#undef W1IN
#undef W1OUT
#undef WUP
#undef WDN
#undef XN
#undef QKV
#undef OBUF
#undef X1
#undef HF
#undef IDX
#undef GATE
#undef POS
#undef SLOTTOK
#undef TILEEXP
#undef ACT
#undef Y
#undef TMP
#undef XIN
#undef cin
#undef norm_mix
#undef norm_ffn
#undef w_ada
#undef b_ada
#undef OUTP
}

extern "C" void kernel_launch(void* const* d_in, const int* in_sizes, int n_in, void* d_out, int out_size, void* d_ws, size_t ws_size, hipStream_t stream) {
    static int grid = 0;
    if (grid == 0) {
        if (n_in != 21 || out_size != M * D || ws_size < WS_END) { fprintf(stderr, "kernel_launch: unexpected sizes (n_in %d out %d ws %zu need %zu)\n", n_in, out_size, ws_size, (size_t)WS_END); grid = -1; return; }
        int dev = 0, cus = 0, per_cu = 0;
        hipGetDevice(&dev); hipDeviceGetAttribute(&cus, hipDeviceAttributeMultiprocessorCount, dev);
        if (hipFuncSetAttribute((const void*)mega, hipFuncAttributeMaxDynamicSharedMemorySize, LDS_BYTES) != hipSuccess) { fprintf(stderr, "kernel_launch: hipFuncSetAttribute failed\n"); grid = -1; return; }
        hipOccupancyMaxActiveBlocksPerMultiprocessor(&per_cu, (const void*)mega, 512, LDS_BYTES);
        (void)hipGetLastError();
        if (per_cu < 1) fprintf(stderr, "kernel_launch: occupancy query says %d blocks per CU\n", per_cu);
        grid = cus;
    }
    if (grid < 0) return;
    hipMemsetAsync((char*)d_ws + WS_CTL, 0, CTL_BYTES, stream);
    Args a{};
    for (int i = 0; i < 21; ++i) a.in[i] = (const float*)d_in[i];
    a.out = (float*)d_out; a.ws = (unsigned char*)d_ws;
#if MK_SPLIT
    for (int p = 0; p < NPHASE; ++p) { a.ph_lo = p; a.ph_hi = p + 1; hipLaunchKernelGGL(mega, dim3(grid), dim3(512), LDS_BYTES, stream, a); }
#else
    a.ph_lo = 0; a.ph_hi = NPHASE; hipLaunchKernelGGL(mega, dim3(grid), dim3(512), LDS_BYTES, stream, a);
#endif
}
```

```cpp
#include <hip/hip_runtime.h>
#include <cstdio>
#include <cstdint>
#include <hip/hip_bf16.h>

#ifndef USE_PG8_OUT
#define USE_PG8_OUT 1
#endif
#ifndef USE_PG8_QKV
#define USE_PG8_QKV 1
#endif
#ifndef USE_PG8_MOE
#define USE_PG8_MOE 1
#endif
#ifndef USE_ATT1
#define USE_ATT1 1
#endif
#ifndef USE_ATT0
#define USE_ATT0 1
#endif
#ifndef USE_ROUTER2
#define USE_ROUTER2 1
#endif
#ifndef REPMASK
#define REPMASK 0u
#endif
#ifndef USE_FP8_MOE
#define USE_FP8_MOE 1
#endif
#ifndef USE_CONV128
#define USE_CONV128 1
#endif
#ifndef USE_FP8_QKV
#define USE_FP8_QKV 1
#endif
#ifndef SHARED_BF16
#define SHARED_BF16 0
#endif
#ifndef Y_FP8
#define Y_FP8 1
#endif
#ifndef DEFER_CONV
#define DEFER_CONV 1
#endif
#ifndef RES_BF16
#define RES_BF16 1
#endif
#ifndef FUSE_FINISH
#define FUSE_FINISH 1
#endif
#ifndef PROBE_SEL
#define PROBE_SEL -1
#endif
#ifndef PROBE_GAIN
#define PROBE_GAIN 4
#endif
#ifndef QKV_HEADMAJOR
#define QKV_HEADMAJOR 1
#endif
#ifndef USE_V128
#define USE_V128 1
#endif
#ifndef MK_SPLIT
#define MK_SPLIT 0
#endif

constexpr int D = 2048, NB = 4, T = 4096, M = NB * T;
constexpr int HD = 64;
constexpr int AB_IN = 4352, C_IN = 6144;
constexpr int NE = 64, TOPK = 8, ED = 512;
constexpr int UPN = 2 * ED;
constexpr int NEX = NE + 1;
constexpr int CAPR = M * TOPK + NE * 256;
constexpr int CAP = CAPR + M;
constexpr int MAXTILES = CAP / 256;
constexpr float RMS_EPS = 1e-6f;
constexpr int NPHASE = 21;

typedef unsigned short bf16;
typedef short bf16x8 __attribute__((ext_vector_type(8)));
typedef float f32x4 __attribute__((ext_vector_type(4)));
typedef unsigned u32x4 __attribute__((ext_vector_type(4)));
typedef unsigned u32x2 __attribute__((ext_vector_type(2)));
#define LAS __attribute__((address_space(3)))

constexpr size_t MiB = 1u << 20;
constexpr size_t WS_CTL = 0, CTL_BYTES = 1 * MiB;
constexpr size_t WS_ADA = 1 * MiB;
constexpr size_t WS_W0IN = 2 * MiB;
constexpr size_t WS_W0OUT = WS_W0IN + (size_t)AB_IN * D * 2;
constexpr size_t WS_W1IN = WS_W0OUT + (size_t)D * D * 2;
constexpr size_t WS_W1OUT = WS_W1IN + (size_t)C_IN * D * 2;
constexpr size_t WS_WUP = WS_W1OUT + (size_t)D * D * 2;
constexpr size_t WS_WDN = WS_WUP + (size_t)2 * NEX * UPN * D * 2;
constexpr size_t WS_XN = WS_WDN + (size_t)2 * NEX * D * ED * 2;
constexpr size_t WS_QKV = WS_XN + (size_t)M * D * 2;
constexpr size_t WS_O = WS_QKV + (size_t)M * C_IN * 2;
constexpr size_t WS_X1 = WS_O + (size_t)M * D * 2;
constexpr size_t WS_HF = WS_X1 + (size_t)M * D * 4;
constexpr size_t WS_IDX = WS_HF + (size_t)M * D * 2;
constexpr size_t WS_GATE = WS_IDX + (size_t)M * 8 * 4;
constexpr size_t WS_POS = WS_GATE + (size_t)M * 8 * 4;
constexpr size_t WS_SLOTTOK = WS_POS + (size_t)M * 8 * 4;
constexpr size_t WS_TILEEXP = WS_SLOTTOK + (size_t)CAP * 4;
constexpr size_t WS_ACT = WS_TILEEXP + 4096;
constexpr size_t WS_Y = WS_ACT + (size_t)CAP * ED * 2;
constexpr size_t WS_TMP = WS_Y + (size_t)CAP * D * 2;
constexpr size_t WS_WRT = WS_TMP + (size_t)M * 16 * 2 * 128 * 4;
constexpr size_t WS_WCNT = WS_WRT + (size_t)2 * 2 * NE * D * 2;
constexpr size_t WS_HFB = WS_WCNT + (size_t)4096 * 64 * 4;
constexpr size_t WS_ACTS = WS_HFB + (size_t)M * D * 2;
constexpr size_t WS_WUPS = WS_ACTS + (size_t)M * ED * 2;
constexpr size_t WS_WDNS = WS_WUPS + (size_t)2 * UPN * D * 2;
constexpr size_t WS_END = WS_WDNS + (size_t)2 * D * ED * 2;
constexpr int CW_BAR = 4096;
constexpr int CW_CNT = 16384;
constexpr int CW_CUR = 16384 + 256;
constexpr int CW_NRT = 16384 + 512;
constexpr int CW_QCTR = 16384 + 1024;

constexpr int LDS_BYTES = 147456;

__device__ __forceinline__ unsigned pk4_fp8(float a, float b, float c2, float d);
constexpr float F8_WSCALE = 256.f, F8_HSCALE = 16.f, F8_ASCALE = 8.f, F8_YSCALE = 32.f;
__device__ __forceinline__ float bf2f(unsigned v) { return __uint_as_float(v << 16); }
__device__ __forceinline__ unsigned f2bf(float f) { unsigned u = __float_as_uint(f); return (u + 0x7fffu + ((u >> 16) & 1u)) >> 16; }
typedef float pk2_f32x2 __attribute__((ext_vector_type(2))); typedef __bf16 pk2_bf16x2 __attribute__((ext_vector_type(2)));
__device__ __forceinline__ unsigned pk2(float lo, float hi) { pk2_f32x2 v = {lo, hi}; return __builtin_bit_cast(unsigned, __builtin_convertvector(v, pk2_bf16x2)); }
__device__ __forceinline__ float wave_sum(float v) {
#pragma unroll
    for (int o = 1; o < 64; o <<= 1) v += __shfl_xor(v, o);
    return v;
}
__device__ __forceinline__ float siluf(float x) { return x / (1.f + __expf(-x)); }

#define XB_TMO      128
#define XB_XCNT(j)  (256  + 64 * (j))
#define XB_XSUB(j)  (1280 + 64 * (j))
#define XB_XGEN(j)  (2304 + 64 * (j))
#define XB_TOP      3328
#define XB_TOPGEN   3392
#define XCD_BAR_WORDS 3456
#define XB_SPIN_CAP (1u << 22)
__device__ __forceinline__ unsigned xb_ld(unsigned* p)              { return __hip_atomic_load(p, __ATOMIC_RELAXED, __HIP_MEMORY_SCOPE_AGENT); }
__device__ __forceinline__ unsigned xb_add(unsigned* p, unsigned v) { return __hip_atomic_fetch_add(p, v, __ATOMIC_RELAXED, __HIP_MEMORY_SCOPE_AGENT); }
__device__ __forceinline__ unsigned xb_xcc_id() { return (unsigned)__builtin_amdgcn_s_getreg((3 << 11) | 20) & 0xFu; }
#define XB_SPIN(cond, bar) do { unsigned _sp = 0; while (cond) { __builtin_amdgcn_s_sleep(1); \
    if ((++_sp & 255u) == 0u) { if (xb_ld(&(bar)[XB_TMO])) break; if (_sp > XB_SPIN_CAP) { atomicAdd(&(bar)[XB_TMO], 1u); break; } } } } while (0)
struct XcdBarrier { unsigned* bar; unsigned x; volatile LAS unsigned* st; };
__device__ __forceinline__ XcdBarrier xcd_barrier_post(unsigned* bar, volatile LAS unsigned* st) {
    XcdBarrier b; b.bar = bar; b.x = xb_xcc_id(); b.st = st;
    if (threadIdx.x == 0) (void)xb_add(&bar[XB_XCNT(b.x)], 1u);
    return b;
}
__device__ __forceinline__ void xcd_barrier_complete(unsigned* bar, unsigned x, unsigned& nloc, unsigned& nx) {
    const unsigned G = gridDim.x * gridDim.y * gridDim.z;
    unsigned sum, cnt, mine, sp = 0u;
    for (;;) {
        sum = 0u; cnt = 0u; mine = 0u;
#pragma unroll
        for (unsigned j = 0; j < 16; ++j) { const unsigned c = xb_ld(&bar[XB_XCNT(j)]); sum += c; cnt += (c > 0u) ? 1u : 0u; mine = (j == x) ? c : mine; }
        if (sum == G) break;
        __builtin_amdgcn_s_sleep(1);
        if ((++sp & 255u) == 0u) { if (xb_ld(&bar[XB_TMO])) break; if (sp > XB_SPIN_CAP) { atomicAdd(&bar[XB_TMO], 1u); break; } }
    }
    nloc = mine > 0u ? mine : 1u; nx = cnt > 0u ? cnt : 1u;
}
__device__ __forceinline__ void xcd_barrier(const XcdBarrier& b) {
    asm volatile("s_waitcnt vmcnt(0)" ::: "memory");
    __syncthreads();
    if (threadIdx.x == 0) {
        unsigned* bar = b.bar;
        __builtin_amdgcn_s_waitcnt(0);
        unsigned nloc = b.st[0], nx = b.st[1];
        if (nloc == 0u) { xcd_barrier_complete(bar, b.x, nloc, nx); b.st[0] = nloc; b.st[1] = nx; }
        const unsigned old = xb_add(&bar[XB_XSUB(b.x)], 1u);
        const unsigned gen = old / nloc;
        if (old + 1u == (gen + 1u) * nloc) {
            __builtin_amdgcn_fence(__ATOMIC_RELEASE, "agent");
            asm volatile("s_waitcnt vmcnt(0)" ::: "memory");
            const unsigned og = xb_add(&bar[XB_TOP], 1u);
            const unsigned tg = og / nx;
            if (og + 1u == (tg + 1u) * nx) xb_add(&bar[XB_TOPGEN], 1u);
            else XB_SPIN(xb_ld(&bar[XB_TOPGEN]) == tg, bar);
            __builtin_amdgcn_fence(__ATOMIC_ACQUIRE, "agent");
            xb_add(&bar[XB_XGEN(b.x)], 1u);
            asm volatile("s_waitcnt vmcnt(0)" ::: "memory");
        } else {
            XB_SPIN(xb_ld(&bar[XB_XGEN(b.x)]) == gen, bar);
            __builtin_amdgcn_fence(__ATOMIC_ACQUIRE, "agent");
            asm volatile("s_waitcnt vmcnt(0)" ::: "memory");
        }
    }
    __syncthreads();
}

struct Args {
    const float* in[21];
    float* out;
    unsigned char* ws;
    int ph_lo, ph_hi;
};

struct Ctx {
    int tid, lane, wave, gw, ngw, gsz;
    LAS unsigned char* lds;
    unsigned char* ws;
    unsigned* ctl;
};

__device__ __forceinline__ int gtid_now() { int t = (int)(blockIdx.x * 512u + threadIdx.x); asm volatile("" : "+v"(t)); return t; }
template <int MODE> __device__ __forceinline__ int perm_row(int n) {
    if (MODE == 1) { const int nl = n & 255; return (n & ~255) + 128 * ((nl >> 5) & 1) + 32 * (nl >> 6) + (nl & 31); }
    if (MODE == 2) { const int bj = n >> 9, rem = n & 511; return 256 * (rem >> 7) + 128 * bj + (rem & 127); }
    if (MODE == 3) { const int cl = n & 255; return (n & ~255) + 128 * ((cl >> 3) & 1) + 32 * (cl >> 6) + 8 * ((cl >> 4) & 3) + (cl & 7); }
    return n;
}
template <int MODE> __device__ __forceinline__ void transpose_item(const float* W, int K, int N, bf16* WT, LAS float* scr, int item, int lane) {
    const int nblk = N / 32, kb = item / nblk, nb = item % nblk, k0 = 64 * kb, n0 = 32 * nb, d0 = perm_row<MODE>(n0);
#pragma unroll 8
    for (int i = 0; i < 32; ++i) { const int kk = 2 * i + (lane >> 5); scr[kk * 33 + (lane & 31)] = W[(size_t)(k0 + kk) * N + n0 + (lane & 31)]; }
    asm volatile("s_waitcnt lgkmcnt(0)" ::: "memory");
    const int c = lane & 7;
#pragma unroll
    for (int j = 0; j < 4; ++j) { const int n = (lane >> 3) + 8 * j; const LAS float* s = scr + (8 * c) * 33 + n;
        u32x4 o; o.x = pk2(s[0 * 33], s[1 * 33]); o.y = pk2(s[2 * 33], s[3 * 33]); o.z = pk2(s[4 * 33], s[5 * 33]); o.w = pk2(s[6 * 33], s[7 * 33]);
        *(u32x4*)(WT + (size_t)(d0 + n) * K + k0 + 8 * c) = o; }
    asm volatile("s_waitcnt lgkmcnt(0)" ::: "memory");
}
template <int MODE> __device__ __forceinline__ void convert_batch(const Ctx& c, const float* src, int K, int N, bf16* dst, int nmat, size_t dst_stride) {
    LAS float* scr = (LAS float*)(c.lds + c.wave * 16384);
    const int per = (K / 64) * (N / 32); const long total = (long)per * nmat;
    for (long it = c.gw; it < total; it += c.ngw) {
        const int mat = (int)(it / per), item = (int)(it % per);
        transpose_item<MODE>(src + (size_t)mat * K * N, K, N, dst + (size_t)mat * dst_stride, scr, item, c.lane);
    }
}

__device__ __forceinline__ float clamp448(float v) { return __builtin_amdgcn_fmed3f(v, -448.f, 448.f); }
__device__ __forceinline__ unsigned pk4_fp8(float a, float b, float c2, float d) {
    unsigned w = 0u; w = __builtin_amdgcn_cvt_pk_fp8_f32(clamp448(a), clamp448(b), w, false); w = __builtin_amdgcn_cvt_pk_fp8_f32(clamp448(c2), clamp448(d), w, true); return w;
}
template <int MODE> __device__ __forceinline__ void transpose_item_f8(const float* W, int K, int N, unsigned char* WT, LAS float* scr, int item, int lane) {
    const int nblk = N / 32, kb = item / nblk, nb = item % nblk, k0 = 64 * kb, n0 = 32 * nb, d0 = perm_row<MODE>(n0);
#pragma unroll 8
    for (int i = 0; i < 32; ++i) { const int kk = 2 * i + (lane >> 5); scr[kk * 33 + (lane & 31)] = W[(size_t)(k0 + kk) * N + n0 + (lane & 31)]; }
    asm volatile("s_waitcnt lgkmcnt(0)" ::: "memory");
    const int n = lane & 31;
#pragma unroll
    for (int j = 0; j < 2; ++j) { const int ch = (lane >> 5) + 2 * j; const LAS float* s = scr + (16 * ch) * 33 + n; u32x4 o;
#pragma unroll
        for (int q = 0; q < 4; ++q) o[q] = pk4_fp8(s[(4 * q) * 33] * F8_WSCALE, s[(4 * q + 1) * 33] * F8_WSCALE, s[(4 * q + 2) * 33] * F8_WSCALE, s[(4 * q + 3) * 33] * F8_WSCALE);
        *(u32x4*)(WT + (size_t)(d0 + n) * K + k0 + 16 * ch) = o; }
    asm volatile("s_waitcnt lgkmcnt(0)" ::: "memory");
}
template <int MODE> __device__ __forceinline__ void convert_batch_f8(const Ctx& c, const float* src, int K, int N, unsigned char* dst, int nmat, size_t dst_stride) {
    LAS float* scr = (LAS float*)(c.lds + c.wave * 16384);
    const int per = (K / 64) * (N / 32); const long total = (long)per * nmat;
    for (long it = c.gw; it < total; it += c.ngw) {
        const int mat = (int)(it / per), item = (int)(it % per);
        transpose_item_f8<MODE>(src + (size_t)mat * K * N, K, N, dst + (size_t)mat * dst_stride, scr, item, c.lane);
    }
}

__device__ __forceinline__ void t128_load(f32x4 (&v)[16], const float* W, int N, int item, int lane) {
    const int nblk = N / 32, kb = item / nblk, nb = item % nblk, k0 = 128 * kb, n0 = 32 * nb;
    const int kr = lane >> 3, nq = lane & 7;
#pragma unroll
    for (int i = 0; i < 16; ++i) v[i] = __builtin_nontemporal_load((const f32x4*)(W + (size_t)(k0 + 8 * i + kr) * N + n0 + 4 * nq));
}
template <int MODE, bool F8> __device__ __forceinline__ void t128_finish(const f32x4 (&v)[16], int K, int N, unsigned char* WT, LAS float* scr, int item, int lane, float scale) {
    const int nblk = N / 32, kb = item / nblk, nb = item % nblk, k0 = 128 * kb, n0 = 32 * nb, d0 = perm_row<MODE>(n0);
    const int kr = lane >> 3, nq = lane & 7;
#pragma unroll
    for (int i = 0; i < 16; ++i) { LAS float* s = scr + (8 * i + kr) * 33 + 4 * nq; s[0] = v[i].x; s[1] = v[i].y; s[2] = v[i].z; s[3] = v[i].w; }
    asm volatile("s_waitcnt lgkmcnt(0)" ::: "memory");
    const int n = lane & 31, half = lane >> 5; const LAS float* s0 = scr + (64 * half) * 33 + n;
    if (F8) {
        const int rs = lane >> 2, pc = lane & 3; (void)s0; (void)half;
#pragma unroll
        for (int it = 0; it < 4; ++it) { const int nn = rs + 16 * (it & 1), hs = it >> 1; const LAS float* s = scr + (64 * hs + 16 * pc) * 33 + nn; u32x4 o;
#pragma unroll
            for (int q = 0; q < 4; ++q) o[q] = pk4_fp8(s[(4 * q) * 33] * scale, s[(4 * q + 1) * 33] * scale, s[(4 * q + 2) * 33] * scale, s[(4 * q + 3) * 33] * scale);
            *(u32x4*)(WT + (size_t)(MODE == 3 ? perm_row<MODE>(n0 + nn) : d0 + nn) * K + k0 + 64 * hs + 16 * pc) = o; }
    } else {
        bf16* dst = (bf16*)WT + (size_t)(d0 + n) * K + k0 + 64 * half;
#pragma unroll
        for (int ch = 0; ch < 8; ++ch) { const LAS float* s = s0 + (8 * ch) * 33; u32x4 o;
#pragma unroll
            for (int q = 0; q < 4; ++q) o[q] = pk2(s[(2 * q) * 33], s[(2 * q + 1) * 33]);
            *(u32x4*)(dst + 8 * ch) = o; }
    }
    asm volatile("s_waitcnt lgkmcnt(0)" ::: "memory");
}
template <int MODE, bool F8> __device__ __forceinline__ void transpose_item128(const float* W, int K, int N, unsigned char* WT, LAS float* scr, int item, int lane, float scale) {
    asm volatile("" : "+v"(lane));
    f32x4 v[16];
    t128_load(v, W, N, item, lane);
    t128_finish<MODE, F8>(v, K, N, WT, scr, item, lane, scale);
}
template <int QM, bool F8Q> __device__ __forceinline__ void convert_dense_all(const Ctx& c, const float* w0in, const float* w1in, const float* w0out, const float* w1out,
                                                                              unsigned char* W0IN_, unsigned char* W1IN_, unsigned char* W0OUT_, unsigned char* W1OUT_, float sq,
                                                                              int part, int gw_, int ngw_) {
    constexpr int n0 = 16 * (AB_IN / 32), n1 = 16 * (C_IN / 32), n2 = 16 * (D / 32), TOTALL = n0 + n1 + 2 * n2;
    const int TOT = part == 0 ? n0 : TOTALL;
    LAS float* scr = (LAS float*)(c.lds + c.wave * 16896);
    const int lane = c.lane, ngw = ngw_;
#define DENSE_LOAD(v, it) do { if ((it) < n0) t128_load(v, w0in, AB_IN, (it), lane); else if ((it) < n0 + n1) t128_load(v, w1in, C_IN, (it) - n0, lane); \
        else if ((it) < n0 + n1 + n2) t128_load(v, w0out, D, (it) - n0 - n1, lane); else t128_load(v, w1out, D, (it) - n0 - n1 - n2, lane); } while (0)
#define DENSE_FIN(v, it) do { if ((it) < n0 + n1) { const bool f_ = (it) < n0; t128_finish<QM, F8Q>(v, D, f_ ? AB_IN : C_IN, f_ ? W0IN_ : W1IN_, scr, f_ ? (it) : (it) - n0, lane, sq); } \
        else { const bool f_ = (it) < n0 + n1 + n2; t128_finish<0, false>(v, D, D, f_ ? W0OUT_ : W1OUT_, scr, f_ ? (it) - n0 - n1 : (it) - n0 - n1 - n2, lane, 1.f); } } while (0)
    int it = (part == 0 ? 0 : n0) + gw_;
    f32x4 va[16], vb[16];
    if (it < TOT) DENSE_LOAD(va, it);
    while (it < TOT) {
        const int it1 = it + ngw, it2 = it1 + ngw;
        if (it1 < TOT) DENSE_LOAD(vb, it1);
        DENSE_FIN(va, it);
        if (it2 < TOT) DENSE_LOAD(va, it2);
        if (it1 < TOT) DENSE_FIN(vb, it1);
        it = it2;
    }
#undef DENSE_LOAD
#undef DENSE_FIN
}
template <int MODE, bool F8> __device__ __forceinline__ void convert_batch128(const Ctx& c, const float* src, int K, int N, void* dst, int nmat, size_t dst_stride_bytes, float scale) {
    LAS float* scr = (LAS float*)(c.lds + c.wave * 16896);
    const int per = (K / 128) * (N / 32); const long total = (long)per * nmat;
    for (long it = c.gw; it < total; it += c.ngw) {
        const int mat = (int)(it / per), item = (int)(it % per);
        transpose_item128<MODE, F8>(src + (size_t)mat * K * N, K, N, (unsigned char*)dst + (size_t)mat * dst_stride_bytes, scr, item, c.lane, scale);
    }
}

struct ExpertSrc { const float* up; const float* sup; const float* dn; const float* sdn; };
constexpr int EXP_ITEMS_UP = NE * 512, EXP_ITEMS_SUP = 512, EXP_ITEMS_DN = NE * 256, EXP_ITEMS_SDN = 256, EXP_ITEMS = EXP_ITEMS_UP + EXP_ITEMS_SUP + EXP_ITEMS_DN + EXP_ITEMS_SDN;
__device__ __forceinline__ void expert_item(const ExpertSrc& s, int l, unsigned char* ws, LAS float* scr, int it, int lane) {
    unsigned char* wup = ws + WS_WUP + (size_t)l * NEX * UPN * D; unsigned char* wdn = ws + WS_WDN + (size_t)l * NEX * D * ED;
    if (it < EXP_ITEMS_UP) { const int mat = it >> 9; transpose_item128<2, true>(s.up + ((size_t)l * NE + mat) * D * UPN, D, UPN, wup + (size_t)mat * UPN * D, scr, it & 511, lane, F8_WSCALE); return; }
    it -= EXP_ITEMS_UP;
    if (it < EXP_ITEMS_SUP) { transpose_item128<2, true>(s.sup + (size_t)l * D * UPN, D, UPN, wup + (size_t)NE * UPN * D, scr, it, lane, F8_WSCALE); return; }
    it -= EXP_ITEMS_SUP;
    if (it < EXP_ITEMS_DN) { const int mat = it >> 8; transpose_item128<0, true>(s.dn + ((size_t)l * NE + mat) * ED * D, ED, D, wdn + (size_t)mat * D * ED, scr, it & 255, lane, F8_WSCALE); return; }
    it -= EXP_ITEMS_DN;
    transpose_item128<0, true>(s.sdn + (size_t)l * ED * D, ED, D, wdn + (size_t)NE * D * ED, scr, it, lane, F8_WSCALE);
}
struct ERef { const float* W; int N, item; };
__device__ __forceinline__ ERef expert_ref(const ExpertSrc& s, int l, int it) {
    if (it < EXP_ITEMS_UP) return ERef{s.up + ((size_t)l * NE + (it >> 9)) * D * UPN, UPN, it & 511};
    it -= EXP_ITEMS_UP;
    if (it < EXP_ITEMS_SUP) return ERef{s.sup + (size_t)l * D * UPN, UPN, it};
    it -= EXP_ITEMS_SUP;
    if (it < EXP_ITEMS_DN) return ERef{s.dn + ((size_t)l * NE + (it >> 8)) * ED * D, D, it & 255};
    it -= EXP_ITEMS_DN;
    return ERef{s.sdn + (size_t)l * ED * D, D, it};
}
__device__ __forceinline__ void expert_fin(const f32x4 (&v)[16], int l, unsigned char* ws, LAS float* scr, int it, int lane) {
    if (it < EXP_ITEMS_UP + EXP_ITEMS_SUP) { const bool r = it < EXP_ITEMS_UP; const int mat = r ? it >> 9 : NE, item = r ? it & 511 : it - EXP_ITEMS_UP;
        t128_finish<2, true>(v, D, UPN, ws + WS_WUP + ((size_t)l * NEX + mat) * UPN * D, scr, item, lane, F8_WSCALE); }
    else { it -= EXP_ITEMS_UP + EXP_ITEMS_SUP; const bool r = it < EXP_ITEMS_DN; const int mat = r ? it >> 8 : NE, item = r ? it & 255 : it - EXP_ITEMS_DN;
        t128_finish<Y_FP8 ? 3 : 0, true>(v, ED, D, ws + WS_WDN + ((size_t)l * NEX + mat) * D * ED, scr, item, lane, F8_WSCALE); }
}
__device__ __forceinline__ void expert_items_block(const Ctx& c, const ExpertSrc& s, int l, unsigned char* ws, int first, int count) {
    int tid = threadIdx.x; asm volatile("" : "+v"(tid));
    const int lane = tid & 63, wv = __builtin_amdgcn_readfirstlane(tid >> 6);
    LAS float* scr = (LAS float*)(c.lds + wv * 16896);
    f32x4 va[16], vb[16];
    int i = wv;
    if (i < count) { const ERef r = expert_ref(s, l, first + i); t128_load(va, r.W, r.N, r.item, lane); }
#pragma unroll 1
    while (i < count) {
        const int i1 = i + 8, i2 = i + 16;
        if (i1 < count) { const ERef r = expert_ref(s, l, first + i1); t128_load(vb, r.W, r.N, r.item, lane); }
        expert_fin(va, l, ws, scr, first + i, lane);
        if (i2 < count) { const ERef r = expert_ref(s, l, first + i2); t128_load(va, r.W, r.N, r.item, lane); }
        if (i1 < count) expert_fin(vb, l, ws, scr, first + i1, lane);
        i = i2;
    }
}
__device__ __forceinline__ void ada_phase(const Ctx& c, const float* cin, const float* w_ada, const float* b_ada, float* ada) {
    LAS float* red = (LAS float*)(c.lds);
    LAS float* sc = red + 1024;
    for (int i = c.tid; i < 4 * D; i += 512) sc[i] = siluf(cin[i]);
    __syncthreads();
    const int j = c.lane & 7, kr = c.lane >> 3;
    constexpr int NCG = 6 * D / 32;
    for (int u = blockIdx.x; u < 2 * NCG; u += gridDim.x) {
        const int l = u / NCG, cg = u % NCG;
        const int k0 = c.wave * 256 + kr;
        const float* w = w_ada + (size_t)l * D * 6 * D + (size_t)k0 * 6 * D + cg * 32 + 4 * j;
        f32x4 acc[4];
#pragma unroll
        for (int b = 0; b < 4; ++b) acc[b] = (f32x4){0.f, 0.f, 0.f, 0.f};
        f32x4 wv[32];
#pragma unroll
        for (int i = 0; i < 32; ++i) wv[i] = *(const f32x4*)(w + (size_t)(8 * i) * 6 * D);
#pragma unroll
        for (int i = 0; i < 32; ++i)
#pragma unroll
            for (int b = 0; b < 4; ++b) acc[b] += wv[i] * sc[b * D + k0 + 8 * i];
#pragma unroll
        for (int b = 0; b < 4; ++b)
#pragma unroll
            for (int q = 0; q < 4; ++q) { float t = acc[b][q]; t += __shfl_xor(t, 8); t += __shfl_xor(t, 16); t += __shfl_xor(t, 32); acc[b][q] = t; }
        if (kr == 0) {
#pragma unroll
            for (int b = 0; b < 4; ++b) *(LAS f32x4*)(red + (c.wave * 4 + b) * 32 + 4 * j) = acc[b]; }
        __syncthreads();
        if (c.tid < 128) {
            const int b = c.tid >> 5, cc = c.tid & 31; float s2 = b_ada[(size_t)l * 6 * D + cg * 32 + cc];
#pragma unroll
            for (int w8 = 0; w8 < 8; ++w8) s2 += red[(w8 * 4 + b) * 32 + cc];
            ada[((size_t)l * 4 + b) * 6 * D + cg * 32 + cc] = s2;
        }
        __syncthreads();
    }
}

__device__ __forceinline__ void load_row(const float* xrow, int lane, f32x4 (&v)[8]) {
#pragma unroll
    for (int j = 0; j < 8; ++j) v[j] = *(const f32x4*)(xrow + 4 * lane + 256 * j);
}
__device__ __forceinline__ float row_rstd(const f32x4 (&v)[8]) {
    float s = 0.f;
#pragma unroll
    for (int j = 0; j < 8; ++j) s += (v[j].x * v[j].x + v[j].y * v[j].y) + (v[j].z * v[j].z + v[j].w * v[j].w);
    return 1.f / sqrtf(wave_sum(s) * (1.f / D) + RMS_EPS);
}
__device__ __forceinline__ void modulate_row(f32x4 (&v)[8], float rstd, const float* g, const float* sh, const float* sc, int lane) {
#pragma unroll
    for (int j = 0; j < 8; ++j) { const int col = 4 * lane + 256 * j;
        const f32x4 gg = *(const f32x4*)(g + col), s1 = *(const f32x4*)(sc + col), s0 = *(const f32x4*)(sh + col);
        v[j] = v[j] * rstd * gg * (s1 + 1.f) + s0; }
}
__device__ __forceinline__ void store_row_bf16(bf16* orow, const f32x4 (&v)[8], int lane) {
#pragma unroll
    for (int j = 0; j < 8; ++j) { u32x2 w; w.x = pk2(v[j].x, v[j].y); w.y = pk2(v[j].z, v[j].w); *(u32x2*)(orow + 4 * lane + 256 * j) = w; }
}
__device__ __forceinline__ void store_row_fp8(unsigned char* orow, const f32x4 (&v)[8], int lane, float scale) {
#pragma unroll
    for (int j = 0; j < 8; ++j) *(unsigned*)(orow + 4 * lane + 256 * j) = pk4_fp8(v[j].x * scale, v[j].y * scale, v[j].z * scale, v[j].w * scale);
}
__device__ __forceinline__ void norm_phase(const Ctx& c, const float* x, const float* g, const float* ada_l  , int sh_off, int sc_off, bf16* out) {
    for (int m = c.gw; m < M; m += c.ngw) {
        const int b = m / T; f32x4 v[8]; load_row(x + (size_t)m * D, c.lane, v);
        const float rstd = row_rstd(v);
        modulate_row(v, rstd, g, ada_l + (size_t)b * 6 * D + sh_off, ada_l + (size_t)b * 6 * D + sc_off, c.lane);
#if USE_FP8_QKV
        store_row_fp8((unsigned char*)out + (size_t)m * D, v, c.lane, F8_HSCALE);
#else
        store_row_bf16(out + (size_t)m * D, v, c.lane);
#endif
    }
}

__device__ __forceinline__ void wave_gemm_32x64(const bf16* a0, const bf16* a1, const bf16* b, int K, int lane, f32x4 (&acc)[2][4]) {
    const int q8 = (lane >> 4) * 8;
    for (int k0 = 0; k0 < K; k0 += 32) {
        const bf16x8 fa0 = *(const bf16x8*)(a0 + k0 + q8), fa1 = *(const bf16x8*)(a1 + k0 + q8);
#pragma unroll
        for (int n = 0; n < 4; ++n) { const bf16x8 fb = *(const bf16x8*)(b + (size_t)n * 16 * K + k0 + q8);
            acc[0][n] = __builtin_amdgcn_mfma_f32_16x16x32_bf16(fa0, fb, acc[0][n], 0, 0, 0);
            acc[1][n] = __builtin_amdgcn_mfma_f32_16x16x32_bf16(fa1, fb, acc[1][n], 0, 0, 0); }
    }
}
#define ZERO_ACC(acc) do { _Pragma("unroll") for (int _a = 0; _a < 2; ++_a) _Pragma("unroll") for (int _b = 0; _b < 4; ++_b) acc[_a][_b] = (f32x4){0.f, 0.f, 0.f, 0.f}; } while (0)

__device__ __forceinline__ void gemm_plain_bf16(const Ctx& c, const bf16* A, const bf16* Bt, int K, int N, bf16* C) {
    const int ntn = N / 64, units = (M / 256) * ntn;
    for (int u = blockIdx.x; u < units; u += gridDim.x) {
        const int mt = u / ntn, nt = u % ntn, row0 = mt * 256 + c.wave * 32, n0 = nt * 64;
        f32x4 acc[2][4]; ZERO_ACC(acc);
        const int r = c.lane & 15;
        wave_gemm_32x64(A + (size_t)(row0 + r) * K, A + (size_t)(row0 + 16 + r) * K, Bt + (size_t)(n0 + r) * K, K, c.lane, acc);
#pragma unroll
        for (int mi = 0; mi < 2; ++mi)
#pragma unroll
            for (int n = 0; n < 4; ++n)
#pragma unroll
                for (int j = 0; j < 4; ++j) C[(size_t)(row0 + 16 * mi + 4 * (c.lane >> 4) + j) * N + n0 + 16 * n + r] = (bf16)f2bf(acc[mi][n][j]);
    }
}
__device__ __forceinline__ void gemm_outproj(const Ctx& c, const bf16* A, const bf16* Bt, const float* xin, const float* gm  , float* X1) {
    const int K = D, N = D, ntn = N / 64, units = (M / 256) * ntn;
    for (int u = blockIdx.x; u < units; u += gridDim.x) {
        const int mt = u / ntn, nt = u % ntn, row0 = mt * 256 + c.wave * 32, n0 = nt * 64;
        f32x4 acc[2][4]; ZERO_ACC(acc);
        const int r = c.lane & 15;
        wave_gemm_32x64(A + (size_t)(row0 + r) * K, A + (size_t)(row0 + 16 + r) * K, Bt + (size_t)(n0 + r) * K, K, c.lane, acc);
        const int b = row0 / T;
#pragma unroll
        for (int mi = 0; mi < 2; ++mi)
#pragma unroll
            for (int n = 0; n < 4; ++n)
#pragma unroll
                for (int j = 0; j < 4; ++j) { const size_t o = (size_t)(row0 + 16 * mi + 4 * (c.lane >> 4) + j) * N + n0 + 16 * n + r;
                    X1[o] = xin[o] + gm[(size_t)b * 6 * D + n0 + 16 * n + r] * acc[mi][n][j]; }
    }
}

__device__ __forceinline__ void qknorm_chunk(bf16* p, const float* g) {
    float v[64]; float ss = 0.f;
#pragma unroll
    for (int i = 0; i < 8; ++i) { const u32x4 w = *(const u32x4*)(p + 8 * i);
#pragma unroll
        for (int j = 0; j < 4; ++j) { v[8 * i + 2 * j] = bf2f(w[j] & 0xffffu); v[8 * i + 2 * j + 1] = bf2f(w[j] >> 16); } }
#pragma unroll
    for (int i = 0; i < 64; ++i) ss += v[i] * v[i];
    const float rs = 1.f / sqrtf(ss * (1.f / 64.f) + RMS_EPS);
#pragma unroll
    for (int i = 0; i < 8; ++i) { u32x4 w;
#pragma unroll
        for (int j = 0; j < 4; ++j) w[j] = pk2(v[8 * i + 2 * j] * rs * g[8 * i + 2 * j], v[8 * i + 2 * j + 1] * rs * g[8 * i + 2 * j + 1]);
        *(u32x4*)(p + 8 * i) = w; }
}
__device__ __forceinline__ void qknorm0_phase(const Ctx& c, bf16* qkv, const float* gains  ) {
    const long total = (long)M * 50;
    for (long id = gtid_now(); id < total; id += c.gsz) {
        const int m = (int)(id / 50), k = (int)(id % 50); int ch, gi;
        if (k < 16) { ch = k; gi = 0; } else if (k < 32) { ch = k; gi = 1; } else if (k < 48) { ch = k + 16; gi = 2; } else { ch = k + 16; gi = 3; }
        qknorm_chunk(qkv + (size_t)m * AB_IN + 64 * ch, gains + 64 * gi);
    }
}
__device__ __forceinline__ void qknorm1_phase(const Ctx& c, bf16* qkv, const float* gains  ) {
    const long total = (long)M * 64;
    for (long id = gtid_now(); id < total; id += c.gsz) {
        const int m = (int)(id / 64), ch = (int)(id % 64);
        qknorm_chunk(qkv + (size_t)m * C_IN + 64 * ch, gains + 64 * (ch >> 5));
    }
}

__device__ __forceinline__ void load64(const bf16* p, float (&v)[64], float scale) {
#pragma unroll
    for (int i = 0; i < 8; ++i) { const u32x4 w = *(const u32x4*)(p + 8 * i);
#pragma unroll
        for (int j = 0; j < 4; ++j) { v[8 * i + 2 * j] = bf2f(w[j] & 0xffffu) * scale; v[8 * i + 2 * j + 1] = bf2f(w[j] >> 16) * scale; } }
}
__device__ __forceinline__ float dot64(const float (&q)[64], const bf16* kp) {
    float s0 = 0.f, s1 = 0.f;
#pragma unroll
    for (int i = 0; i < 8; ++i) { const u32x4 w = *(const u32x4*)(kp + 8 * i);
#pragma unroll
        for (int j = 0; j < 4; ++j) { s0 += q[8 * i + 2 * j] * bf2f(w[j] & 0xffffu); s1 += q[8 * i + 2 * j + 1] * bf2f(w[j] >> 16); } }
    return s0 + s1;
}
__device__ __forceinline__ void axpy64(float (&o)[64], float a, float p, const bf16* vp) {
#pragma unroll
    for (int i = 0; i < 8; ++i) { const u32x4 w = *(const u32x4*)(vp + 8 * i);
#pragma unroll
        for (int j = 0; j < 4; ++j) { o[8 * i + 2 * j] = o[8 * i + 2 * j] * a + p * bf2f(w[j] & 0xffffu); o[8 * i + 2 * j + 1] = o[8 * i + 2 * j + 1] * a + p * bf2f(w[j] >> 16); } }
}
__device__ __forceinline__ void store64_bf16(bf16* p, const float (&o)[64], float s) {
#pragma unroll
    for (int i = 0; i < 8; ++i) { u32x4 w;
#pragma unroll
        for (int j = 0; j < 4; ++j) w[j] = pk2(o[8 * i + 2 * j] * s, o[8 * i + 2 * j + 1] * s);
        *(u32x4*)(p + 8 * i) = w; }
}
__device__ __forceinline__ void attn0_phase(const Ctx& c, const bf16* qkv, const float* sinks, bf16* O) {
    const long total = (long)32 * M;
    for (long id = gtid_now(); id < total; id += c.gsz) {
        const int hh = (int)(id / M), m = (int)(id % M), b = m / T, t = m % T;
        float q[64], o[64];
#pragma unroll
        for (int i = 0; i < 64; ++i) o[i] = 0.f;
        float mx = -1e30f, l = 0.f;
        if (hh < 16) {
            const int h = hh; const float slope = exp2f(-0.5f * (float)(h + 1));
            load64(qkv + (size_t)m * AB_IN + 64 * h, q, 0.125f);
            const bf16* kb = qkv + (size_t)b * T * AB_IN + 1024 + 64 * h;
            for (int br = 0; br < 3; ++br) {
                const int dil = br == 0 ? 1 : (br == 1 ? 4 : 16);
                for (int j = 0; j <= 128; ++j) {
                    const int s = t - dil * j; if (s < 0) break;
                    const bf16* kp = kb + (size_t)s * AB_IN;
                    const float sc = dot64(q, kp) - slope * (float)(dil * j);
                    const float mn = fmaxf(mx, sc), a = __expf(mx - mn), p = __expf(sc - mn);
                    l = l * a + p; axpy64(o, a, p, kp + 1024); mx = mn;
                }
            }
            store64_bf16(O + (size_t)m * D + 64 * h, o, 1.f / l);
        } else {
            const int h = hh - 16, kvh = h >> 3; const float slope = exp2f(-0.5f * (float)(h + 1));
            load64(qkv + (size_t)m * AB_IN + 3072 + 64 * h, q, 0.125f);
            const bf16* kb = qkv + (size_t)b * T * AB_IN + 4096 + 64 * kvh;
            for (int j = 0; j < 128; ++j) {
                const int s = t - j; if (s < 0) break;
                const bf16* kp = kb + (size_t)s * AB_IN;
                const float sc = dot64(q, kp) - slope * (float)j;
                const float mn = fmaxf(mx, sc), a = __expf(mx - mn), p = __expf(sc - mn);
                l = l * a + p; axpy64(o, a, p, kp + 128); mx = mn;
            }
            const float sk = sinks[h], mn = fmaxf(mx, sk), a = __expf(mx - mn);
            l = l * a + __expf(sk - mn);
            store64_bf16(O + (size_t)m * D + 1024 + 64 * h, o, a / l);
        }
    }
}
__device__ __forceinline__ void attn1_phase(const Ctx& c, const bf16* qkv, float* tmp) {
    const int items = NB * 16 * 2 * 2 * (T / 64);
    for (int it = c.gw; it < items; it += c.ngw) {
        const int tb = (T / 64 - 1) - it / (NB * 16 * 4); const int r = it % (NB * 16 * 4);
        const int b = r / 64, h = (r / 4) % 16, i = (r >> 1) & 1, j = r & 1;
        const int t = tb * 64 + c.lane, m = b * T + t;
        const float slope = exp2f(-0.5f * (float)(h + 1));
        float q[64], o[64];
#pragma unroll
        for (int d = 0; d < 64; ++d) o[d] = 0.f;
        float mx = -1e30f, l = 0.f;
        load64(qkv + (size_t)m * C_IN + 128 * h + 64 * i, q, 0.125f);
        const bf16* kb = qkv + (size_t)b * T * C_IN + 2048 + 128 * h + 64 * i;
        const bf16* vb = qkv + (size_t)b * T * C_IN + 4096 + 128 * h + 64 * j;
        const int smax = tb * 64 + 63;
        for (int s = 0; s <= smax; ++s) {
            const bf16* kp = kb + (size_t)s * C_IN;
            float sc = dot64(q, kp) - slope * (float)(t - s);
            if (s > t) sc = -1e30f;
            const float mn = fmaxf(mx, sc), a = __expf(mx - mn), p = (s > t) ? 0.f : __expf(sc - mn);
            l = l * a + p; axpy64(o, a, p, vb + (size_t)s * C_IN); mx = mn;
        }
        float* op = tmp + (((size_t)m * 16 + h) * 2 + i) * 128 + 64 * j; const float il = 1.f / l;
#pragma unroll
        for (int d = 0; d < 16; ++d) *(f32x4*)(op + 4 * d) = (f32x4){o[4 * d] * il, o[4 * d + 1] * il, o[4 * d + 2] * il, o[4 * d + 3] * il};
    }
}
__device__ __forceinline__ void attn1_finish_phase(const Ctx& c, const float* tmp, const float* lamp  , const float* subln  , bf16* O) {
    float s01 = 0.f, s23 = 0.f;
    for (int i = 0; i < 64; ++i) { s01 += lamp[i] * lamp[64 + i]; s23 += lamp[128 + i] * lamp[192 + i]; }
    const float lam_init = 0.8f - 0.6f * expf(-0.3f * 1.0f);
    const float lam = expf(s01) - expf(s23) + lam_init;
    const long total = (long)M * 16;
    for (long id = gtid_now(); id < total; id += c.gsz) {
        const float* p1 = tmp + (size_t)id * 256; const float* p2 = p1 + 128;
        float ss = 0.f;
        for (int d = 0; d < 128; ++d) { const float v = p1[d] - lam * p2[d]; ss += v * v; }
        const float rs = (1.f - lam_init) / sqrtf(ss * (1.f / 128.f) + RMS_EPS);
        bf16* op = O + (size_t)id * 128;
        for (int d = 0; d < 128; d += 2) { const float v0 = (p1[d] - lam * p2[d]) * rs * subln[d], v1 = (p1[d + 1] - lam * p2[d + 1]) * rs * subln[d + 1];
            *(unsigned*)(op + d) = pk2(v0, v1); }
    }
}

__device__ __forceinline__ void router_phase(const Ctx& c, const float* x1, const float* g, const float* ada_l, const float* wr  , const float* rbias  ,
                                             bf16* HF, int* idx, float* gate, unsigned* counts) {
    LAS float* hb = (LAS float*)(c.lds + c.wave * 8192);
    const int lane = c.lane;
    for (int m = c.gw; m < M; m += c.ngw) {
        const int b = m / T; f32x4 v[8]; load_row(x1 + (size_t)m * D, lane, v);
        const float rstd = row_rstd(v);
        modulate_row(v, rstd, g, ada_l + (size_t)b * 6 * D + 3 * D, ada_l + (size_t)b * 6 * D + 4 * D, lane);
        store_row_bf16(HF + (size_t)m * D, v, lane);
#pragma unroll
        for (int j = 0; j < 8; ++j) *(LAS f32x4*)(hb + 4 * lane + 256 * j) = v[j];
        asm volatile("s_waitcnt lgkmcnt(0)" ::: "memory");
        float a0 = 0.f, a1 = 0.f, a2 = 0.f, a3 = 0.f;
        for (int k = 0; k < D; k += 4) {
            const f32x4 hv = *(const LAS f32x4*)(hb + k);
            a0 += hv.x * wr[(size_t)(k + 0) * 64 + lane]; a1 += hv.y * wr[(size_t)(k + 1) * 64 + lane];
            a2 += hv.z * wr[(size_t)(k + 2) * 64 + lane]; a3 += hv.w * wr[(size_t)(k + 3) * 64 + lane];
        }
        const float logit = (a0 + a1) + (a2 + a3);
        const float score = 1.f / (1.f + expf(-logit));
        const float sel = score + rbias[lane];
        float m1 = sel;
        m1 = fmaxf(m1, __shfl_xor(m1, 1)); m1 = fmaxf(m1, __shfl_xor(m1, 2)); m1 = fmaxf(m1, __shfl_xor(m1, 4));
        const unsigned long long eqm = __ballot(sel == m1);
        const int gbase = lane & ~7;
        const unsigned grp_eq = (unsigned)((eqm >> gbase) & 0xffull);
        const int first = __builtin_ctz(grp_eq);
        float m2 = ((lane & 7) == first) ? -3e38f : sel;
        m2 = fmaxf(m2, __shfl_xor(m2, 1)); m2 = fmaxf(m2, __shfl_xor(m2, 2)); m2 = fmaxf(m2, __shfl_xor(m2, 4));
        const float gs = m1 + m2;
        int grank = 0; const int mygrp = lane >> 3;
#pragma unroll
        for (int g2 = 0; g2 < 8; ++g2) { const float o = __shfl(gs, g2 * 8); grank += (o > gs || (o == gs && g2 < mygrp)) ? 1 : 0; }
        const float msel = (grank < 4) ? sel : -1e30f;
        int rank = 0;
        for (int e2 = 0; e2 < 64; ++e2) { const float o = __shfl(msel, e2); rank += (o > msel || (o == msel && e2 < lane)) ? 1 : 0; }
        const bool chosen = rank < TOPK;
        const float gsum = wave_sum(chosen ? score : 0.f);
        if (chosen) { idx[(size_t)m * 8 + rank] = lane; gate[(size_t)m * 8 + rank] = score / gsum * 2.5f;
            __hip_atomic_fetch_add(counts + lane, 1u, __ATOMIC_RELAXED, __HIP_MEMORY_SCOPE_AGENT); }
    }
}
__device__ __forceinline__ void slot_phase(const Ctx& c, const int* idx, const unsigned* counts, unsigned* cursor, unsigned* nrt_out, int* pos, int* slot_tok, int* tile_exp) {
    LAS int* ps = (LAS int*)c.lds;
    if (c.tid == 0) { int acc = 0; for (int e = 0; e < NE; ++e) { const int cn = (int)counts[e]; ps[e] = acc; ps[64 + e] = cn; acc += (cn + 255) / 256 * 256; } ps[128] = acc; }
    __syncthreads();
    for (int a = gtid_now(); a < M * TOPK; a += c.gsz) {
        const int e = idx[a]; const unsigned r = __hip_atomic_fetch_add(cursor + e, 1u, __ATOMIC_RELAXED, __HIP_MEMORY_SCOPE_AGENT);
        const int slot = ps[e] + (int)r; slot_tok[slot] = a >> 3; pos[a] = slot;
    }
    for (int t = gtid_now(); t < M; t += c.gsz) slot_tok[CAPR + t] = t;
    if (blockIdx.x == 0) {
        if (c.tid < NE) { const int e = c.tid, s0 = ps[e], cn = ps[64 + e], pe = s0 + (cn + 255) / 256 * 256;
            for (int s = s0 + cn; s < pe; ++s) slot_tok[s] = 0;
            for (int tt = s0 / 256; tt < pe / 256; ++tt) tile_exp[tt] = e; }
        if (c.tid == 0) *nrt_out = (unsigned)(ps[128] / 256);
    }
    __syncthreads();
}
__device__ __forceinline__ void moe_up_phase(const Ctx& c, const bf16* HF, const bf16* Wup_l  , const int* slot_tok, const int* tile_exp, const unsigned* nrt_p, bf16* ACT) {
    const int nrt = (int)*nrt_p, ntiles = nrt + M / 256, units = ntiles * (ED / 64);
    for (int u = blockIdx.x; u < units; u += gridDim.x) {
        const int mt = u / (ED / 64), nt = u % (ED / 64), n0 = nt * 64;
        const int e = mt < nrt ? tile_exp[mt] : NE; const int slot0 = (mt < nrt ? mt * 256 : CAPR + (mt - nrt) * 256) + c.wave * 32;
        const int r = c.lane & 15;
        const bf16* a0 = HF + (size_t)slot_tok[slot0 + r] * D; const bf16* a1 = HF + (size_t)slot_tok[slot0 + 16 + r] * D;
        const bf16* W = Wup_l + (size_t)e * UPN * D;
        f32x4 ag[2][4], au[2][4]; ZERO_ACC(ag); ZERO_ACC(au);
        wave_gemm_32x64(a0, a1, W + (size_t)(n0 + r) * D, D, c.lane, ag);
        wave_gemm_32x64(a0, a1, W + (size_t)(ED + n0 + r) * D, D, c.lane, au);
#pragma unroll
        for (int mi = 0; mi < 2; ++mi)
#pragma unroll
            for (int n = 0; n < 4; ++n)
#pragma unroll
                for (int j = 0; j < 4; ++j) ACT[(size_t)(slot0 + 16 * mi + 4 * (c.lane >> 4) + j) * ED + n0 + 16 * n + r] = (bf16)f2bf(siluf(ag[mi][n][j]) * au[mi][n][j]);
    }
}
__device__ __forceinline__ void moe_down_phase(const Ctx& c, const bf16* ACT, const bf16* Wdn_l  , const int* tile_exp, const unsigned* nrt_p, bf16* Y) {
    const int nrt = (int)*nrt_p, ntiles = nrt + M / 256, units = ntiles * (D / 64);
    for (int u = blockIdx.x; u < units; u += gridDim.x) {
        const int mt = u / (D / 64), nt = u % (D / 64), n0 = nt * 64;
        const int e = mt < nrt ? tile_exp[mt] : NE; const int slot0 = (mt < nrt ? mt * 256 : CAPR + (mt - nrt) * 256) + c.wave * 32;
        const int r = c.lane & 15;
        const bf16* W = Wdn_l + (size_t)e * D * ED;
        f32x4 acc[2][4]; ZERO_ACC(acc);
        wave_gemm_32x64(ACT + (size_t)(slot0 + r) * ED, ACT + (size_t)(slot0 + 16 + r) * ED, W + (size_t)(n0 + r) * ED, ED, c.lane, acc);
#pragma unroll
        for (int mi = 0; mi < 2; ++mi)
#pragma unroll
            for (int n = 0; n < 4; ++n)
#pragma unroll
                for (int j = 0; j < 4; ++j) Y[(size_t)(slot0 + 16 * mi + 4 * (c.lane >> 4) + j) * D + n0 + 16 * n + r] = (bf16)f2bf(acc[mi][n][j]);
    }
}
__device__ __forceinline__ void add_row_bf16(f32x4 (&acc)[8], const bf16* yrow, float w, int lane) {
#pragma unroll
    for (int j = 0; j < 8; ++j) { const u32x2 v = *(const u32x2*)(yrow + 4 * lane + 256 * j);
        acc[j].x += w * bf2f(v.x & 0xffffu); acc[j].y += w * bf2f(v.x >> 16); acc[j].z += w * bf2f(v.y & 0xffffu); acc[j].w += w * bf2f(v.y >> 16); }
}
__device__ __forceinline__ void add_row_fp8(f32x4 (&acc)[8], const unsigned char* yrow, float w, int lane) {
#pragma unroll
    for (int j = 0; j < 8; ++j) { const unsigned v = *(const unsigned*)(yrow + 4 * lane + 256 * j);
        acc[j].x += w * __builtin_amdgcn_cvt_f32_fp8(v, 0); acc[j].y += w * __builtin_amdgcn_cvt_f32_fp8(v, 1); acc[j].z += w * __builtin_amdgcn_cvt_f32_fp8(v, 2); acc[j].w += w * __builtin_amdgcn_cvt_f32_fp8(v, 3); }
}
template <bool NEXT>
__device__ __forceinline__ void combine_phase(const Ctx& c, const float* x1, const bf16* Y, const int* pos, const float* gate, const float* ada_l, float* xo,
                                              const float* gnext, const float* ada_next, bf16* XN) {
    LAS float* LGF = (LAS float*)c.lds; LAS float* LGA = LGF + D; LAS float* LGB = LGA + D;
    for (int b = 0; b < NB; ++b) {
    __syncthreads();
    for (int col = 4 * c.tid; col < D; col += 2048) { *(LAS f32x4*)(LGF + col) = *(const f32x4*)(ada_l + (size_t)b * 6 * D + 5 * D + col);
        if (NEXT) { const f32x4 gg = *(const f32x4*)(gnext + col), s0 = *(const f32x4*)(ada_next + (size_t)b * 6 * D + col), s1 = *(const f32x4*)(ada_next + (size_t)b * 6 * D + D + col);
            *(LAS f32x4*)(LGA + col) = gg * (s1 + 1.f); *(LAS f32x4*)(LGB + col) = s0; } }
    __syncthreads();
    for (int m = b * T + c.gw; m < (b + 1) * T; m += c.ngw) {
        f32x4 acc[8];
#pragma unroll
        for (int j = 0; j < 8; ++j) acc[j] = (f32x4){0.f, 0.f, 0.f, 0.f};
#if USE_FP8_MOE && Y_FP8
        for (int k = 0; k < TOPK; ++k) add_row_fp8(acc, (const unsigned char*)Y + (size_t)pos[(size_t)m * 8 + k] * D, gate[(size_t)m * 8 + k] * (1.f / F8_YSCALE), c.lane);
        add_row_fp8(acc, (const unsigned char*)Y + (size_t)(CAPR + m) * D, 1.f / F8_YSCALE, c.lane);
#else
        for (int k = 0; k < TOPK; ++k) add_row_bf16(acc, Y + (size_t)pos[(size_t)m * 8 + k] * D, gate[(size_t)m * 8 + k], c.lane);
        add_row_bf16(acc, Y + (size_t)(CAPR + m) * D, 1.f, c.lane);
#endif
        f32x4 v[8];
#pragma unroll
        for (int j = 0; j < 8; ++j) { const int col = 4 * c.lane + 256 * j;
#if RES_BF16
            { const u32x2 xw = *(const u32x2*)((const bf16*)x1 + (size_t)m * D + col);
              v[j] = (f32x4){bf2f(xw.x & 0xffffu), bf2f(xw.x >> 16), bf2f(xw.y & 0xffffu), bf2f(xw.y >> 16)} + *(LAS f32x4*)(LGF + col) * acc[j]; }
            if (NEXT) { u32x2 ow; ow.x = pk2(v[j].x, v[j].y); ow.y = pk2(v[j].z, v[j].w); *(u32x2*)((bf16*)xo + (size_t)m * D + col) = ow; }
            else *(f32x4*)(xo + (size_t)m * D + col) = v[j];
#else
            v[j] = *(const f32x4*)(x1 + (size_t)m * D + col) + *(LAS f32x4*)(LGF + col) * acc[j];
            *(f32x4*)(xo + (size_t)m * D + col) = v[j];
#endif
            }
        if (NEXT) {
            const float rstd = row_rstd(v);
#pragma unroll
            for (int j = 0; j < 8; ++j) { const int col = 4 * c.lane + 256 * j; v[j] = v[j] * rstd * *(LAS f32x4*)(LGA + col) + *(LAS f32x4*)(LGB + col); }
#if USE_FP8_QKV
            store_row_fp8((unsigned char*)XN + (size_t)m * D, v, c.lane, F8_HSCALE);
#else
            store_row_bf16(XN + (size_t)m * D, v, c.lane);
#endif
        }
    }
    }
}


namespace pg8 {
constexpr int BM = 256, BK = 64, HALF = 128, HTB = HALF * BK * 2, STAGE_BYTES = 8 * HTB, NXCD = 8, WGM = 8;
__device__ __forceinline__ int lds_byte(int r, int c) { const int st = (r >> 4) * 2 + (c >> 5), rr = r & 15, cc = c & 31, ob = rr * 64 + cc * 2; return st * 1024 + (ob ^ (((ob >> 9) & 1) << 5)); }
__device__ __forceinline__ void stage_rc(int b, int& R, int& C) { const int st = b / 1024, sb = b % 1024, swz = sb ^ (((sb >> 9) & 1) << 5); R = (st >> 1) * 16 + swz / 64; C = (st & 1) * 32 + (swz % 64) / 2; }
__device__ __forceinline__ int perm32(int rho) { const int n = rho >> 4, i = rho & 15; return 8 * (i >> 2) + 4 * n + (i & 3); }
__device__ __forceinline__ unsigned cvt_pk_bf16(float lo, float hi) { unsigned r; asm volatile("v_cvt_pk_bf16_f32 %0, %1, %2" : "=v"(r) : "v"(lo), "v"(hi)); return r; }

struct Unit { int row0, pn; const char* Bp; };

struct TileOrder {
    int nM, nN, nwg, G, c;
    __device__ __forceinline__ void init(int nM_, int nN_, int G_, int c_) { nM = nM_; nN = nN_; nwg = nM * nN; G = G_; c = c_; }
    __device__ __forceinline__ bool tile(int i, int& pm, int& pn) const {
        const long L = (long)i * G + c; if (L >= nwg) return false;
        int wgid = (int)L; { const int q = nwg / NXCD, r = nwg % NXCD, xcd = wgid % NXCD, off = wgid / NXCD; wgid = (xcd < r ? xcd * (q + 1) : r * (q + 1) + (xcd - r) * q) + off; }
        const int nig = WGM * nN, gid = wgid / nig, fm = gid * WGM, gsz = (nM - fm) < WGM ? (nM - fm) : WGM;
        pm = fm + ((wgid % nig) % gsz); pn = (wgid % nig) / gsz; return true;
    }
};
struct PlainSched {
    static constexpr bool GATHER = false; static constexpr bool APLANE = false;
    TileOrder o; const char* Bt; int K;
    __device__ __forceinline__ bool next(int i, Unit& u) const { int pm, pn; if (!o.tile(i, pm, pn)) return false; u.row0 = pm * BM; u.pn = pn; u.Bp = Bt + (size_t)pn * BM * K * 2; return true; }
    __device__ __forceinline__ unsigned arow_off(const Unit& u, int rl) const { return (unsigned)(u.row0 + rl) * (unsigned)(K * 2); }
};
template <bool GATHER_, bool APLANE_ = false> struct GroupSched {
    static constexpr bool GATHER = GATHER_; static constexpr bool APLANE = APLANE_; unsigned aplane = 0;
    TileOrder o; const char* W; size_t wstride; int K, nrt; const LAS int* tile_exp; const int* slot_tok;
    __device__ __forceinline__ bool next(int i, Unit& u) const { int pm, pn; if (!o.tile(i, pm, pn)) return false;
        const int e = pm < nrt ? tile_exp[pm] : NE; u.row0 = pm < nrt ? pm * BM : CAPR + (pm - nrt) * BM; u.pn = pn; u.Bp = W + (size_t)e * wstride + (size_t)pn * BM * K * 2; return true; }
    __device__ __forceinline__ unsigned arow_off(const Unit& u, int rl) const { const int r = GATHER ? slot_tok[u.row0 + rl] : (u.row0 + rl); return (unsigned)r * (unsigned)(K * 2); }
};

template <int LAYER> struct EpiQKV {
    static constexpr bool PERM = true;
    bf16* O; int ldc; const float* gains; float qscale, ascale;
    __device__ __forceinline__ void operator()(const f32x4 (&acc)[2][2][4][2], const Unit& u, int wr, int wc, int fr, int fq) const {
        const int head = 4 * u.pn + wc; int gi;
        if (LAYER == 0) gi = head < 16 ? 0 : head < 32 ? 1 : head < 48 ? -1 : head < 64 ? 2 : head < 66 ? 3 : -1;
        else gi = head < 32 ? 0 : head < 64 ? 1 : -1;
        f32x4 gv[2][2];
#pragma unroll
        for (int bj = 0; bj < 2; ++bj)
#pragma unroll
            for (int n = 0; n < 2; ++n) gv[bj][n] = gi >= 0 ? *(const f32x4*)(gains + 64 * gi + 32 * bj + 8 * fq + 4 * n) : (f32x4){1.f, 1.f, 1.f, 1.f};
#if QKV_HEADMAJOR
        bf16* base = O + ((size_t)head * M + (size_t)(u.row0 + wr * 64 + fr)) * 64 + 8 * fq; const int ldo = 64;
#else
        bf16* base = O + (size_t)(u.row0 + wr * 64 + fr) * ldc + 64 * head + 8 * fq; const int ldo = ldc;
#endif
#pragma unroll
        for (int ai = 0; ai < 2; ++ai)
#pragma unroll
            for (int m = 0; m < 4; ++m) {
                float ss = 0.f;
#pragma unroll
                for (int bj = 0; bj < 2; ++bj)
#pragma unroll
                    for (int n = 0; n < 2; ++n) { const f32x4 x = acc[ai][bj][m][n]; ss += (x[0] * x[0] + x[1] * x[1]) + (x[2] * x[2] + x[3] * x[3]); }
                ss += __shfl_xor(ss, 16); ss += __shfl_xor(ss, 32); ss *= ascale * ascale;
                const bool isq = LAYER == 0 ? (gi == 0 || gi == 2) : (gi == 0);
                const float rs = ascale * (gi >= 0 ? (isq ? qscale : 1.f) / sqrtf(ss * (1.f / 64.f) + RMS_EPS) : 1.f);
                bf16* rowp = base + (size_t)(ai * HALF + m * 16) * ldo;
#pragma unroll
                for (int bj = 0; bj < 2; ++bj) { const f32x4 v0 = acc[ai][bj][m][0] * rs * gv[bj][0], v1 = acc[ai][bj][m][1] * rs * gv[bj][1];
                    u32x4 w; w.x = cvt_pk_bf16(v0[0], v0[1]); w.y = cvt_pk_bf16(v0[2], v0[3]); w.z = cvt_pk_bf16(v1[0], v1[1]); w.w = cvt_pk_bf16(v1[2], v1[3]);
                    *(u32x4*)(rowp + 32 * bj) = w; }
            }
    }
};
struct EpiOut {
    static constexpr bool PERM = false;
    const float* xin; const float* gm; float* X1;
    __device__ __forceinline__ void operator()(const f32x4 (&acc)[2][2][4][2], const Unit& u, int wr, int wc, int fr, int fq) const {
        const int col0 = u.pn * BM + wc * 32 + 4 * fq; const float* g = gm + (size_t)(u.row0 / T) * 6 * D + col0;
        f32x4 gv[2][2];
#pragma unroll
        for (int bj = 0; bj < 2; ++bj)
#pragma unroll
            for (int n = 0; n < 2; ++n) gv[bj][n] = *(const f32x4*)(g + bj * HALF + n * 16);
#pragma unroll
        for (int ai = 0; ai < 2; ++ai)
#pragma unroll
            for (int m = 0; m < 4; ++m) { const size_t off = (size_t)(u.row0 + wr * 64 + fr + ai * HALF + m * 16) * D + col0;
#pragma unroll
                for (int bj = 0; bj < 2; ++bj)
#pragma unroll
                    for (int n = 0; n < 2; ++n) *(f32x4*)(X1 + off + bj * HALF + n * 16) = *(const f32x4*)(xin + off + bj * HALF + n * 16) + gv[bj][n] * acc[ai][bj][m][n]; }
    }
};

template <bool XIN_BF16> struct EpiOutB {
    static constexpr bool PERM = true;
    const void* xin; const float* gm; bf16* X1b;
    __device__ __forceinline__ void operator()(const f32x4 (&acc)[2][2][4][2], const Unit& u, int wr, int wc, int fr, int fq) const {
        const int col0 = u.pn * BM + wc * 32 + 8 * fq; const float* g = gm + (size_t)(u.row0 / T) * 6 * D + col0;
        f32x4 gv[2][2];
#pragma unroll
        for (int bj = 0; bj < 2; ++bj)
#pragma unroll
            for (int n = 0; n < 2; ++n) gv[bj][n] = *(const f32x4*)(g + bj * HALF + 4 * n);
#pragma unroll
        for (int ai = 0; ai < 2; ++ai)
#pragma unroll
            for (int m = 0; m < 4; ++m) { const size_t off = (size_t)(u.row0 + wr * 64 + fr + ai * HALF + m * 16) * D + col0;
#pragma unroll
                for (int bj = 0; bj < 2; ++bj) { f32x4 x0, x1v;
                    if (XIN_BF16) { const u32x4 xw = *(const u32x4*)((const bf16*)xin + off + bj * HALF);
                        x0 = (f32x4){bf2f(xw.x & 0xffffu), bf2f(xw.x >> 16), bf2f(xw.y & 0xffffu), bf2f(xw.y >> 16)}; x1v = (f32x4){bf2f(xw.z & 0xffffu), bf2f(xw.z >> 16), bf2f(xw.w & 0xffffu), bf2f(xw.w >> 16)}; }
                    else { x0 = *(const f32x4*)((const float*)xin + off + bj * HALF); x1v = *(const f32x4*)((const float*)xin + off + bj * HALF + 4); }
                    const f32x4 v0 = x0 + gv[bj][0] * acc[ai][bj][m][0], v1 = x1v + gv[bj][1] * acc[ai][bj][m][1];
                    u32x4 w; w.x = cvt_pk_bf16(v0[0], v0[1]); w.y = cvt_pk_bf16(v0[2], v0[3]); w.z = cvt_pk_bf16(v1[0], v1[1]); w.w = cvt_pk_bf16(v1[2], v1[3]);
                    *(u32x4*)(X1b + off + bj * HALF) = w; } }
    }
};
__device__ __forceinline__ float silu_fast(float x) { return x * __builtin_amdgcn_rcpf(1.f + __builtin_amdgcn_exp2f(-1.4426950408889634f * x)); }
struct EpiUp {
    static constexpr bool PERM = true;
    bf16* ACT;
    __device__ __forceinline__ void operator()(const f32x4 (&acc)[2][2][4][2], const Unit& u, int wr, int wc, int fr, int fq) const {
        bf16* base = ACT + (size_t)(u.row0 + wr * 64 + fr) * ED + 128 * u.pn + 32 * wc + 8 * fq;
#pragma unroll
        for (int ai = 0; ai < 2; ++ai)
#pragma unroll
            for (int m = 0; m < 4; ++m) { f32x4 v[2];
#pragma unroll
                for (int n = 0; n < 2; ++n)
#pragma unroll
                    for (int i = 0; i < 4; ++i) v[n][i] = silu_fast(acc[ai][0][m][n][i]) * acc[ai][1][m][n][i];
                u32x4 w; w.x = cvt_pk_bf16(v[0][0], v[0][1]); w.y = cvt_pk_bf16(v[0][2], v[0][3]); w.z = cvt_pk_bf16(v[1][0], v[1][1]); w.w = cvt_pk_bf16(v[1][2], v[1][3]);
                *(u32x4*)(base + (size_t)(ai * HALF + m * 16) * ED) = w; }
    }
};
struct EpiDown {
    static constexpr bool PERM = true;
    bf16* Y; int orow = 0;
    __device__ __forceinline__ void operator()(const f32x4 (&acc)[2][2][4][2], const Unit& u, int wr, int wc, int fr, int fq) const {
        bf16* base = Y + (size_t)(orow + u.row0 + wr * 64 + fr) * D + u.pn * BM + wc * 32 + 8 * fq;
#pragma unroll
        for (int ai = 0; ai < 2; ++ai)
#pragma unroll
            for (int m = 0; m < 4; ++m) { bf16* rowp = base + (size_t)(ai * HALF + m * 16) * D;
#pragma unroll
                for (int bj = 0; bj < 2; ++bj) { const f32x4 v0 = acc[ai][bj][m][0], v1 = acc[ai][bj][m][1];
                    u32x4 w; w.x = cvt_pk_bf16(v0[0], v0[1]); w.y = cvt_pk_bf16(v0[2], v0[3]); w.z = cvt_pk_bf16(v1[0], v1[1]); w.w = cvt_pk_bf16(v1[2], v1[3]);
                    *(u32x4*)(rowp + bj * HALF) = w; } }
    }
};


struct EpiUp8 {
    static constexpr bool PERM = true;
    unsigned char* ACT8;
    __device__ __forceinline__ void operator()(const f32x4 (&acc)[2][2][4][2], const Unit& u, int wr, int wc, int fr, int fq) const {
        unsigned char* base = ACT8 + ((size_t)(4 * u.pn + wc) * CAP + (size_t)(u.row0 + wr * 64 + fr)) * 32 + 8 * fq;
        constexpr float s = 1.f / (F8_HSCALE * F8_WSCALE);
#pragma unroll
        for (int ai = 0; ai < 2; ++ai)
#pragma unroll
            for (int m = 0; m < 4; ++m) { f32x4 v[2];
#pragma unroll
                for (int n = 0; n < 2; ++n)
#pragma unroll
                    for (int i = 0; i < 4; ++i) v[n][i] = silu_fast(acc[ai][0][m][n][i] * s) * (acc[ai][1][m][n][i] * (s * F8_ASCALE));
                u32x2 w; w.x = pk4_fp8(v[0][0], v[0][1], v[0][2], v[0][3]); w.y = pk4_fp8(v[1][0], v[1][1], v[1][2], v[1][3]);
                *(u32x2*)(base + (size_t)(ai * HALF + m * 16) * 32) = w; }
    }
};
struct EpiDown8 {
    static constexpr bool PERM = true;
    bf16* Y;
    __device__ __forceinline__ void operator()(const f32x4 (&acc)[2][2][4][2], const Unit& u, int wr, int wc, int fr, int fq) const {
#if Y_FP8
        unsigned char* base = (unsigned char*)Y + (size_t)(u.row0 + wr * 64 + fr) * D + u.pn * BM + wc * 64 + 16 * fq;
        constexpr float s = F8_YSCALE / (F8_ASCALE * F8_WSCALE);
#pragma unroll
        for (int ai = 0; ai < 2; ++ai)
#pragma unroll
            for (int m = 0; m < 4; ++m) { unsigned char* rowp = base + (size_t)(ai * HALF + m * 16) * D; u32x4 w;
#pragma unroll
                for (int bj = 0; bj < 2; ++bj) { const f32x4 v0 = acc[ai][bj][m][0] * s, v1 = acc[ai][bj][m][1] * s;
                    w[2 * bj] = pk4_fp8(v0[0], v0[1], v0[2], v0[3]); w[2 * bj + 1] = pk4_fp8(v1[0], v1[1], v1[2], v1[3]); }
                *(u32x4*)rowp = w; }
#else
        bf16* base = Y + (size_t)(u.row0 + wr * 64 + fr) * D + u.pn * BM + wc * 32 + 8 * fq;
        constexpr float s = 1.f / (F8_ASCALE * F8_WSCALE);
#pragma unroll
        for (int ai = 0; ai < 2; ++ai)
#pragma unroll
            for (int m = 0; m < 4; ++m) { bf16* rowp = base + (size_t)(ai * HALF + m * 16) * D;
#pragma unroll
                for (int bj = 0; bj < 2; ++bj) { const f32x4 v0 = acc[ai][bj][m][0] * s, v1 = acc[ai][bj][m][1] * s;
                    u32x4 w; w.x = cvt_pk_bf16(v0[0], v0[1]); w.y = cvt_pk_bf16(v0[2], v0[3]); w.z = cvt_pk_bf16(v1[0], v1[1]); w.w = cvt_pk_bf16(v1[2], v1[3]);
                    *(u32x4*)(rowp + bj * HALF) = w; } }
#endif
    }
};
__device__ __forceinline__ void glds16s(const void* sbase, unsigned voff, unsigned lds_dst) { unsigned keep;
    asm volatile("s_mov_b32 %0, m0\n\ts_mov_b32 m0, %3\n\ts_nop 0\n\tglobal_load_lds_dwordx4 %1, %2\n\ts_mov_b32 m0, %0" : "=&s"(keep) : "v"(voff), "s"(sbase), "s"(lds_dst) : "memory"); }
__device__ __forceinline__ void glds4s(const void* sbase, unsigned voff, unsigned lds_dst) { unsigned keep;
    asm volatile("s_mov_b32 %0, m0\n\ts_mov_b32 m0, %3\n\ts_nop 0\n\tglobal_load_lds_dword %1, %2\n\ts_mov_b32 m0, %0" : "=&s"(keep) : "v"(voff), "s"(sbase), "s"(lds_dst) : "memory"); }
typedef int i32x4 __attribute__((ext_vector_type(4)));
typedef int i32x8 __attribute__((ext_vector_type(8)));
__device__ __forceinline__ i32x8 cat8(bf16x8 a, bf16x8 b) { return __builtin_shufflevector(__builtin_bit_cast(i32x4, a), __builtin_bit_cast(i32x4, b), 0, 1, 2, 3, 4, 5, 6, 7); }
__device__ __forceinline__ void mfma8_inplace(f32x4& acc, i32x8 a, i32x8 b) { asm volatile("v_mfma_f32_16x16x128_f8f6f4 %0, %1, %2, %0" : "+v"(acc) : "v"(a), "v"(b)); }
template <class Epi, class Sched, bool FP8 = false>
__device__ __forceinline__ void gemm_phase(LAS unsigned char* lds, const char* Abase, const int K, const Sched& S, const Epi& E) {
    constexpr bool GATHER = Sched::GATHER;
    const int tid = threadIdx.x, wid = __builtin_amdgcn_readfirstlane(tid >> 6), lane = tid & 63, wr = wid >> 2, wc = wid & 3, fr = lane & 15, fq = lane >> 4;
    int nt = K / BK; asm volatile("" : "+s"(nt));
    int RA[2]; unsigned CA[2], voffB[2], vC[2];
#pragma unroll
    for (int i = 0; i < 2; ++i) { int R, C; stage_rc(tid * 16 + i * 8192, R, C); const int Rb = Epi::PERM ? ((R & ~31) + perm32(R & 31)) : R;
        RA[i] = R; CA[i] = (unsigned)C * 2u; voffB[i] = (unsigned)(Rb * K + C) * 2u;
        if constexpr (Sched::APLANE) vC[i] = (unsigned)(R * 32 + ((C * 2) & 31)) + (unsigned)((C * 2) >> 5) * S.aplane; else vC[i] = (unsigned)(R * K + C) * 2u; }
    const size_t kstep = (size_t)(BK * 2);
    const size_t hstep = (size_t)HALF * K * 2;
    size_t ahstep = GATHER ? 0 : hstep;
    size_t kstepA = kstep; size_t arow = (size_t)K * 2;
    if constexpr (Sched::APLANE) { ahstep = (size_t)HALF * 32; kstepA = (size_t)4 * S.aplane; arow = 32; }
    const unsigned ldsw = (unsigned)wid * 1024u;
    const unsigned lds0 = (unsigned)(uintptr_t)lds;
    const int aoff = lds_byte(wr * 64 + fr, fq * 8), boff = lds_byte(wc * 32 + fr, fq * 8);
#define PG8_SA(b, h) (((b) * 2 + (h)) * HTB)
#define PG8_SB(b, h) ((4 + (b) * 2 + (h)) * HTB)
#define PG8_STAGE(bufoff, gbase, voff) do { _Pragma("unroll") for (int _i = 0; _i < 2; ++_i) \
        glds16s((const void*)(gbase), (voff)[_i], (unsigned)__builtin_amdgcn_readfirstlane((int)(lds0 + (unsigned)(bufoff) + ldsw + (unsigned)(_i * 8192)))); } while (0)
#define PG8_STAGE_A(bufoff, gbase, h) do { if constexpr (GATHER) { PG8_STAGE(bufoff, gbase, vA[h]); } else { PG8_STAGE(bufoff, (gbase) + (h) * ahstep, vC); } } while (0)
#define PG8_LDA(dst, b, h) do { _Pragma("unroll") for (int m = 0; m < 4; ++m) _Pragma("unroll") for (int k = 0; k < 2; ++k) dst[m][k] = *(const LAS bf16x8*)(lds + PG8_SA(b, h) + aoff + m * 2048 + k * 1024); } while (0)
#define PG8_LDB(dst, b, h) do { _Pragma("unroll") for (int n = 0; n < 2; ++n) _Pragma("unroll") for (int k = 0; k < 2; ++k) dst[n][k] = *(const LAS bf16x8*)(lds + PG8_SB(b, h) + boff + n * 2048 + k * 1024); } while (0)
#define PG8_MMA(ai, bj, At, Bt) do { __builtin_amdgcn_s_setprio(1); if constexpr (FP8) { _Pragma("unroll") for (int m = 0; m < 4; ++m) _Pragma("unroll") for (int n = 0; n < 2; ++n) \
        mfma8_inplace(acc[ai][bj][m][n], cat8(Bt[n][0], Bt[n][1]), cat8(At[m][0], At[m][1])); } else { \
        _Pragma("unroll") for (int m = 0; m < 4; ++m) _Pragma("unroll") for (int n = 0; n < 2; ++n) _Pragma("unroll") for (int k = 0; k < 2; ++k) \
        acc[ai][bj][m][n] = __builtin_amdgcn_mfma_f32_16x16x32_bf16(Bt[n][k], At[m][k], acc[ai][bj][m][n], 0, 0, 0); } __builtin_amdgcn_s_setprio(0); } while (0)
#define PG8_WAIT_V(n) asm volatile("s_waitcnt vmcnt(" #n ")" ::: "memory")
#define PG8_WAIT_L(n) asm volatile("s_waitcnt lgkmcnt(0)" ::: "memory")
#define PG8_BAR __builtin_amdgcn_s_barrier()
#define PG8_SCHED __builtin_amdgcn_sched_barrier(0)
#define PG8_SETOFF(vo, u) do { _Pragma("unroll") for (int _h = 0; _h < 2; ++_h) _Pragma("unroll") for (int _i = 0; _i < 2; ++_i) vo[_h][_i] = S.arow_off(u, _h * HALF + RA[_i]) + CA[_i]; } while (0)
    Unit cur, nxt; int ui = 0;
    if (!S.next(0, cur)) return;
    f32x4 acc[2][2][4][2];
#pragma unroll
    for (int a = 0; a < 2; ++a)
#pragma unroll
        for (int b = 0; b < 2; ++b)
#pragma unroll
            for (int m = 0; m < 4; ++m)
#pragma unroll
                for (int n = 0; n < 2; ++n) acc[a][b][m][n] = (f32x4){0.f, 0.f, 0.f, 0.f};
    bf16x8 At[4][2], B0[2][2], B1[2][2];
    unsigned vA[2][2];
    LAS int* gidx = (LAS int*)(lds + STAGE_BYTES);
#define PG8_IDX_DMA(u) do { if (wid < 4) glds4s((const void*)(S.slot_tok + (u).row0), (unsigned)((wid * 64 + lane) * 4), (unsigned)__builtin_amdgcn_readfirstlane((int)(lds0 + (unsigned)STAGE_BYTES + (unsigned)wid * 256u))); } while (0)
#define PG8_IDX_READ() do { _Pragma("unroll") for (int _h = 0; _h < 2; ++_h) _Pragma("unroll") for (int _i = 0; _i < 2; ++_i) vA[_h][_i] = (unsigned)gidx[_h * HALF + RA[_i]] * (unsigned)(K * 2) + CA[_i]; } while (0)
    if constexpr (GATHER) { PG8_IDX_DMA(cur); asm volatile("s_waitcnt vmcnt(0)" ::: "memory"); __builtin_amdgcn_s_barrier(); asm volatile("" ::: "memory"); PG8_IDX_READ();
        asm volatile("s_waitcnt lgkmcnt(0)" ::: "memory"); __builtin_amdgcn_s_barrier(); asm volatile("" ::: "memory"); }
    const char* cA = GATHER ? Abase : Abase + (size_t)cur.row0 * arow;
    const char* cB = cur.Bp;
    PG8_STAGE(PG8_SB(0, 0), cB, voffB); PG8_STAGE(PG8_SB(0, 1), cB + hstep, voffB); PG8_STAGE_A(PG8_SA(0, 0), cA, 0); PG8_STAGE_A(PG8_SA(0, 1), cA, 1);
    if (wr == 1) PG8_BAR;
    PG8_WAIT_V(2); PG8_BAR;
    PG8_STAGE(PG8_SB(1, 0), cB + kstep, voffB); PG8_STAGE_A(PG8_SA(1, 0), cA + kstepA, 0); PG8_STAGE(PG8_SB(1, 1), cB + hstep + kstep, voffB);
    PG8_WAIT_V(6); PG8_BAR;
    for (;;) {
        const bool has_next = S.next(ui + 1, nxt);
        if constexpr (GATHER) { if (has_next) PG8_IDX_DMA(nxt); }
        const char* nA = GATHER ? Abase : (has_next ? Abase + (size_t)nxt.row0 * arow : cA);
        const char* nB = has_next ? nxt.Bp : cB;
#pragma unroll 1
        for (int t = 0; t < nt; t += 2) {
            const bool last = (t == nt - 2);
            const char* a1 = cA + (size_t)(t + 1) * kstepA;
            const char* a2 = last ? nA : cA + (size_t)(t + 2) * kstepA; const char* b2 = last ? nB : cB + (size_t)(t + 2) * kstep;
            const char* a3 = a2 + kstepA; const char* b3 = b2 + kstep;
            PG8_LDB(B0, 0, 0); PG8_LDB(B1, 0, 1); PG8_SCHED; PG8_LDA(At, 0, 0); PG8_STAGE_A(PG8_SA(1, 1), a1, 1);
            if constexpr (GATHER) { if (last && has_next) PG8_IDX_READ(); }
            PG8_WAIT_V(8); PG8_WAIT_L(0); PG8_BAR; PG8_MMA(0, 0, At, B0); PG8_MMA(0, 1, At, B1); PG8_BAR; PG8_SCHED;
            PG8_LDA(At, 0, 1); PG8_STAGE(PG8_SB(0, 0), b2, voffB); PG8_STAGE(PG8_SB(0, 1), b2 + hstep, voffB); PG8_STAGE_A(PG8_SA(0, 0), a2, 0);
            PG8_WAIT_V(8); PG8_WAIT_L(0); PG8_BAR; PG8_MMA(1, 0, At, B0); PG8_MMA(1, 1, At, B1); PG8_BAR; PG8_SCHED;
            PG8_LDB(B0, 1, 0); PG8_LDB(B1, 1, 1); PG8_SCHED; PG8_LDA(At, 1, 0); PG8_STAGE_A(PG8_SA(0, 1), a2, 1);
            PG8_WAIT_V(8); PG8_WAIT_L(0); PG8_BAR; PG8_MMA(0, 0, At, B0); PG8_MMA(0, 1, At, B1); PG8_BAR; PG8_SCHED;
            PG8_LDA(At, 1, 1); PG8_STAGE(PG8_SB(1, 0), b3, voffB); PG8_STAGE(PG8_SB(1, 1), b3 + hstep, voffB); PG8_STAGE_A(PG8_SA(1, 0), a3, 0);
            PG8_WAIT_V(8); PG8_WAIT_L(0); PG8_BAR; PG8_MMA(1, 0, At, B0); PG8_MMA(1, 1, At, B1); PG8_BAR; PG8_SCHED;
        }
        if (wr == 0) PG8_BAR;
        if constexpr (FP8) asm volatile("s_nop 15\n\ts_nop 15" ::: "memory");
        E(acc, cur, wr, wc, fr, fq);
        if (!has_next) break;
#pragma unroll
        for (int a = 0; a < 2; ++a)
#pragma unroll
            for (int b = 0; b < 2; ++b)
#pragma unroll
                for (int m = 0; m < 4; ++m)
#pragma unroll
                    for (int n = 0; n < 2; ++n) acc[a][b][m][n] = (f32x4){0.f, 0.f, 0.f, 0.f};
        cur = nxt; cA = nA; cB = nB; ++ui;
        if (wr == 1) PG8_BAR;
    }
    PG8_WAIT_V(0);
    PG8_BAR;
#undef PG8_SA
#undef PG8_SB
#undef PG8_STAGE
#undef PG8_STAGE_A
#undef PG8_LDA
#undef PG8_LDB
#undef PG8_MMA
#undef PG8_WAIT_V
#undef PG8_WAIT_L
#undef PG8_BAR
#undef PG8_SCHED
#undef PG8_SETOFF
#undef PG8_IDX_DMA
#undef PG8_IDX_READ
}
}

namespace att {
using bf16=unsigned short;
using bf16x8=__attribute__((ext_vector_type(8)))short;
using s16x4=__attribute__((ext_vector_type(4)))short;
using f32x16=__attribute__((ext_vector_type(16)))float;
using u32x4=__attribute__((ext_vector_type(4)))unsigned;
constexpr int NW=8,QBLK=32,QB=QBLK*NW,KVBLK=64;
__device__ __forceinline__ int crow(int r,int hi){return (r&3)+8*(r>>2)+4*hi;}
#define SBAR() __builtin_amdgcn_sched_barrier(0)
constexpr int NSLOT=6, SLOTB=8192;
constexpr int LDS_K=0, LDS_V=NSLOT*SLOTB, LDS_WS=2*NSLOT*SLOTB, LDS_OST=LDS_WS+NW*64*4, LDS_BYTES=LDS_OST+NW*4096;
constexpr float C2=0.125f*1.4426950408889634f;
__device__ __forceinline__ void glds16(const void*sbase,unsigned voff,unsigned lds_dst){unsigned keep;
  asm volatile("s_mov_b32 %0, m0\n\ts_mov_b32 m0, %3\n\ts_nop 0\n\tglobal_load_lds_dwordx4 %1, %2\n\ts_mov_b32 m0, %0":"=&s"(keep):"v"(voff),"s"(sbase),"s"(lds_dst):"memory");}
__device__ __forceinline__ float max3f(float a,float b,float c){float r;asm("v_max3_f32 %0, %1, %2, %3":"=v"(r):"v"(a),"v"(b),"v"(c));return r;}
__device__ __forceinline__ float max2f(float a,float b){float r;asm("v_max_f32_e32 %0, %1, %2":"=v"(r):"v"(a),"v"(b));return r;}
__device__ __forceinline__ float fsub_s(float a,float b){float r;asm("v_sub_f32_e32 %0, %1, %2":"=v"(r):"v"(a),"v"(b));return r;}
typedef float f32x2_t __attribute__((ext_vector_type(2))); typedef __bf16 bf16x2_t __attribute__((ext_vector_type(2)));
__device__ __forceinline__ unsigned cvtpk_s(float lo,float hi){f32x2_t v={lo,hi};bf16x2_t b=__builtin_convertvector(v,bf16x2_t);return __builtin_bit_cast(unsigned,b);}
#define WAIT_BAR(N) asm volatile("s_waitcnt vmcnt(" #N ") lgkmcnt(0)\n\ts_barrier":::"memory")
typedef __attribute__((address_space(3))) const char* lds_cptr;
typedef short v4i16_t __attribute__((ext_vector_type(4)));
__device__ __forceinline__ void kload8(bf16x8*kf,lds_cptr kp,int bo){
  #pragma unroll
  for(int d0=0;d0<4;++d0){ const lds_cptr p=kp+((d0*32)^bo); kf[2*d0]=*(const __attribute__((address_space(3))) bf16x8*)(p); kf[2*d0+1]=*(const __attribute__((address_space(3))) bf16x8*)(p+4096); }
}
__device__ __forceinline__ void kload2(bf16x8*kf,lds_cptr kp,int j,int bo){ const lds_cptr p=kp+((j*32)^bo); kf[2*j]=*(const __attribute__((address_space(3))) bf16x8*)(p); kf[2*j+1]=*(const __attribute__((address_space(3))) bf16x8*)(p+4096); }
__device__ __forceinline__ s16x4 vtr(lds_cptr p){ return __builtin_bit_cast(s16x4,__builtin_amdgcn_ds_read_tr16_b64_v4i16((__attribute__((address_space(3))) v4i16_t*)p)); }
__device__ __forceinline__ float rowmax(const f32x16&p0,const f32x16&p1){
  float a=max3f(p0[0],p0[1],p1[0]),b=max3f(p0[2],p0[3],p1[1]);a=max3f(a,p1[2],p1[3]);
  #pragma unroll
  for(int r=4;r<16;r+=4){a=max3f(a,p0[r],p0[r+1]);b=max3f(b,p0[r+2],p0[r+3]);a=max3f(a,p1[r],p1[r+1]);b=max3f(b,p1[r+2],p1[r+3]);}
  const float m=max2f(a,b);
  auto rr=__builtin_amdgcn_permlane32_swap(__float_as_uint(m),__float_as_uint(m),false,false);
  return max2f(__uint_as_float(rr[0]),__uint_as_float(rr[1]));
}
__device__ __forceinline__ void pv(f32x16*o,int vb,bf16x8 pa0,bf16x8 pa1,bf16x8 pa2,bf16x8 pa3){
  #pragma unroll
  for(int d0=0;d0<2;++d0){s16x4 lo[4],hi[4];
    #pragma unroll
    for(int ks=0;ks<4;++ks){
      asm volatile("ds_read_b64_tr_b16 %0,%1 offset:%c2":"=&v"(lo[ks]):"v"(vb),"i"(d0*4096+ks*1024):"memory");
      asm volatile("ds_read_b64_tr_b16 %0,%1 offset:%c2":"=&v"(hi[ks]):"v"(vb),"i"(d0*4096+ks*1024+512):"memory");}
    asm volatile("s_waitcnt lgkmcnt(0)":::"memory");SBAR();
    #define PK(k) (bf16x8){lo[k][0],lo[k][1],lo[k][2],lo[k][3],hi[k][0],hi[k][1],hi[k][2],hi[k][3]}
    o[d0]=__builtin_amdgcn_mfma_f32_32x32x16_bf16(pa0,PK(0),o[d0],0,0,0);
    o[d0]=__builtin_amdgcn_mfma_f32_32x32x16_bf16(pa1,PK(1),o[d0],0,0,0);
    o[d0]=__builtin_amdgcn_mfma_f32_32x32x16_bf16(pa2,PK(2),o[d0],0,0,0);
    o[d0]=__builtin_amdgcn_mfma_f32_32x32x16_bf16(pa3,PK(3),o[d0],0,0,0);
    #undef PK
  }
}
template<int W> __device__ __forceinline__ void wmask(f32x16&p0,f32x16&p1,int d,float NEG){
  asm volatile("":"+v"(d));
  #pragma unroll
  for(int r=0;r<16;++r){const int c=(r&3)+8*(r>>2);
    if(W==0x7fffffff){ if(d<c)p0[r]=NEG; if(d<c+32)p1[r]=NEG; }
    else{ if((unsigned)(d-c)>(unsigned)W)p0[r]=NEG; if((unsigned)(d-c-32)>(unsigned)W)p1[r]=NEG; } }
}
struct UnitDesc {
  const bf16* Q; long qs;
  const bf16* K; long ks;
  const bf16* V; long vs;
  bf16* O; long os;
  float* lse; long lses;
  int NT;
  int rel0;
  int tg0;
  int q0;
  float slope2;
  float sink2;
  int fin;
  float lam, lam1;
  const float* sg; bf16* Of;
};
template<int MODE,int THRL,int DIL,int OS> __device__ __forceinline__ void attn_unit(const UnitDesc&u,char*shm){
  constexpr int W=(MODE==0)?0x7fffffff:(MODE==1?128:127);
  const float NEG=(MODE==0)?-INFINITY:-1024.f;
  int tid=threadIdx.x; asm volatile("":"+v"(tid));
  const int lane=tid&63,r32=lane&31,hi=lane>>5; const int wid=__builtin_amdgcn_readfirstlane(tid>>6);
  constexpr long qs=64L*DIL,ks=64L*DIL,vs=64L*DIL;
  const bf16*Qw=u.Q+(long)(wid*QBLK)*qs;
  const unsigned lds0=(unsigned)(uintptr_t)shm;
  __attribute__((address_space(3))) float*wsf=(__attribute__((address_space(3))) float*)((__attribute__((address_space(3))) char*)shm+LDS_WS)+wid*64;
  const unsigned ksoff=(unsigned)(((long)(8*wid+(lane>>3))*ks+(((lane&7)^(lane>>3))*8))*2);
  const unsigned vsoff=(unsigned)(((long)(16*(wid&3)+(lane>>2))*vs+(wid>>2)*32+(lane&3)*8)*2);
  const unsigned kdst=lds0+LDS_K+wid*1024, vdst=lds0+LDS_V+wid*1024;
  #define DMA_K(t,slot) glds16(u.K+(long)(t)*KVBLK*ks,ksoff,(unsigned)__builtin_amdgcn_readfirstlane(kdst+(slot)))
  #define DMA_V(t,slot) glds16(u.V+(long)(t)*KVBLK*vs,vsoff,(unsigned)__builtin_amdgcn_readfirstlane(vdst+(slot)))
  bf16x8 kf[8];
  const lds_cptr shm3=(lds_cptr)shm; const lds_cptr kp0=shm3+LDS_K+r32*128+((hi^(r32&1))*16); const int kbo=((r32>>1)&3)<<5; const lds_cptr vp0=shm3+LDS_V+((lane>>4)&1)*32+(lane&3)*8+(4*hi+((lane&15)>>2))*64;
  const int NT=u.NT;
  int tb=0, NTL=NT;
  if(MODE!=0&&NT==6){ const int raw_=(u.rel0+wid*QBLK-W)>>6; int lo_=raw_<0?0:(raw_>NT-4?NT-4:raw_); const int hi_=(u.rel0+wid*QBLK+QBLK-1)>>6; if(hi_<=lo_+3){ tb=lo_; NTL=4; } }
  if(MODE==0){DMA_K(0,0);DMA_V(0,0);DMA_K(1,SLOTB);} else {DMA_K(0,0);}
  bf16x8 qr[4];
  #pragma unroll
  for(int d0=0;d0<4;++d0)qr[d0]=*reinterpret_cast<const bf16x8*>(&Qw[(long)r32*qs+d0*16+hi*8]);
  const unsigned s2hb=__float_as_uint(u.slope2)&0xffff0000u; const float s2hf=__uint_as_float(s2hb);
  const unsigned s2lb=__float_as_uint(u.slope2-s2hf)&0xffff0000u; const float s2used=s2hf+__uint_as_float(s2lb);
  u32x4 qx; qx[0]=hi?0u:((__float_as_uint(64.f*s2hf)>>16)|(__float_as_uint(64.f*__uint_as_float(s2lb))&0xffff0000u)); qx[1]=hi?0u:((s2hb>>16)|s2lb); qx[2]=0u; qx[3]=0u;
  u32x4 kx0; unsigned jp0,jp1; { const unsigned j0=__float_as_uint((float)r32)>>16, j1=__float_as_uint((float)(r32+32))>>16; jp0=j0|(j0<<16); jp1=j1|(j1<<16);
    kx0[0]=0u; kx0[1]=jp0; kx0[2]=0x3f803f80u; kx0[3]=0u; }
  #define SETTG(t) do{ const unsigned tb_=__float_as_uint((float)(u.tg0+tb+(t)))>>16; kx0[0]=(tb_|(tb_<<16)); }while(0)
  #define KX0 __builtin_bit_cast(bf16x8,kx0)
  #define QX __builtin_bit_cast(bf16x8,qx)
  #define SETREF(m_) do{ const unsigned hb_=__float_as_uint(m_)&0xffff0000u; const float hf_=__uint_as_float(hb_); const unsigned lb_=__float_as_uint((m_)-hf_)&0xffff0000u; \
      mhat=hf_+__uint_as_float(lb_); qx[2]=hi?0u:(((hb_^0x80000000u)>>16)|(lb_^0x80000000u)); }while(0)
  float mhat=0.f,l_reg=0.f;f32x16 o[2];o[0]=f32x16{};o[1]=f32x16{};
  const int qrel=u.rel0+wid*QBLK+r32-4*hi-64*tb;
  #define CMASK(P0,P1,t) do{ if(MODE!=0||(t)>=NTL-4) wmask<W>(P0,P1,qrel-64*(t),NEG); }while(0)
  bool resc=false;
  f32x16 pA0,pA1,pB0,pB1;
  int sl_prev=tb*SLOTB,sl_cur=sl_prev,sl_next=sl_prev+SLOTB;
  #define ROT() do{sl_prev=sl_cur;sl_cur=sl_next;sl_next=(sl_next==(NSLOT-1)*SLOTB)?0:sl_next+SLOTB;}while(0)
  #define RESC() do{ if(resc){ asm volatile("s_waitcnt lgkmcnt(0)":::"memory"); \
      _Pragma("unroll") for(int d_=0;d_<2;++d_) _Pragma("unroll") for(int r=0;r<16;++r)o[d_][r]*=wsf[crow(r,hi)]; } }while(0)
  if(MODE==0){ DMA_K(2,2*SLOTB); WAIT_BAR(3); }
  else{ DMA_K(1,SLOTB);DMA_V(0,0);DMA_K(2,2*SLOTB);DMA_V(1,SLOTB);DMA_K(3,3*SLOTB);DMA_V(2,2*SLOTB);DMA_V(3,3*SLOTB);
    if(NT>4){DMA_K(4,4*SLOTB);DMA_K(5,5*SLOTB);DMA_V(4,4*SLOTB);DMA_V(5,5*SLOTB);}
    WAIT_BAR(0); }
  { SETTG(0); const f32x16 z=f32x16{}; const lds_cptr kb=kp0+sl_cur;
    #pragma unroll
    for(int d0=0;d0<4;++d0){
      const bf16x8 b0=*(const __attribute__((address_space(3))) bf16x8*)(kb+((d0*32)^kbo));
      const bf16x8 b1=*(const __attribute__((address_space(3))) bf16x8*)(kb+((d0*32)^kbo)+4096);
      if(d0==0){pA0=__builtin_amdgcn_mfma_f32_32x32x16_bf16(b0,qr[0],z,0,0,0);pA1=__builtin_amdgcn_mfma_f32_32x32x16_bf16(b1,qr[0],z,0,0,0);}
      else{pA0=__builtin_amdgcn_mfma_f32_32x32x16_bf16(b0,qr[d0],pA0,0,0,0);pA1=__builtin_amdgcn_mfma_f32_32x32x16_bf16(b1,qr[d0],pA1,0,0,0);}}
    pA0=__builtin_amdgcn_mfma_f32_32x32x16_bf16(KX0,QX,pA0,0,0,0); kx0[1]=jp1; pA1=__builtin_amdgcn_mfma_f32_32x32x16_bf16(KX0,QX,pA1,0,0,0); kx0[1]=jp0; }
  asm volatile("s_nop 15\n\ts_nop 7":"+v"(pA0),"+v"(pA1));CMASK(pA0,pA1,0);
  { const float rm=rowmax(pA0,pA1); SETREF(rm); const float dl=mhat;
    _Pragma("unroll") for(int r=0;r<16;++r){pA0[r]=fsub_s(pA0[r],dl);pA1[r]=fsub_s(pA1[r],dl);}
    _Pragma("unroll") for(int r=0;r<16;++r)pA0[r]=__builtin_amdgcn_exp2f(pA0[r]); }
  _Pragma("unroll") for(int r=0;r<16;++r)pA1[r]=__builtin_amdgcn_exp2f(pA1[r]);
  if(MODE==0){ WAIT_BAR(0); DMA_K(3,0);DMA_V(1,SLOTB); }
  ROT();
  kload8(kf,kp0+sl_cur,kbo);
  if(MODE==0){ WAIT_BAR(2); }
  s16x4 vlo[8],vhi[8]; u32x4 pw0,pw1,pw2,pw3;
  #define PKW(P,B) cvtpk_s(P[B],P[B+1])
  #define PAF(k) __builtin_bit_cast(bf16x8,pw##k)
  #define VFR(i) (bf16x8){vlo[i][0],vlo[i][1],vlo[i][2],vlo[i][3],vhi[i][0],vhi[i][1],vhi[i][2],vhi[i][3]}
  #define PIN(x) asm volatile("":"+v"(x))
  #define MX3(a,b,c) __builtin_fmaxf(__builtin_fmaxf((a),(b)),(c))
  #define GAPA(MF,A0,A1,A2,A3,W0,W1,PW) do{ MF; sacc+=A0; sacc+=A1; sacc+=A2; sacc+=A3; PIN(sacc); W0; W1; PIN(PW); SBAR(); }while(0)
  #define EX(v) __builtin_amdgcn_exp2f(v)
  #define GAPB(MF,X,B) do{ MF; X[B]=EX(X[B]); X[B+1]=EX(X[B+1]); X[B+2]=EX(X[B+2]); X[B+3]=EX(X[B+3]); PIN(X); SBAR(); }while(0)
  #define VRD(i) do{ vlo[i]=vtr(vp_+(((i)>>2)*4096+((i)&3)*1024)); vhi[i]=vtr(vp_+(((i)>>2)*4096+((i)&3)*1024+512)); }while(0)
  #define KRD(G,j) do{ if(G){ kload2(kf,kp0+sl_next,j,kbo); SBAR(); } }while(0)
  #define STEP(C0,C1,P0,P1,t,GK,GV,GL) do{ SBAR(); SETTG(t); const f32x16 z_=f32x16{}; \
    const lds_cptr vp_=vp0+sl_prev; \
    VRD(0); SBAR(); float sacc=(P0[0]+P0[1]); \
    GAPA(C0=__builtin_amdgcn_mfma_f32_32x32x16_bf16(kf[0],qr[0],z_,0,0,0), P0[2],P0[3],P0[4],P0[5],     pw0[0]=PKW(P0,0), pw0[1]=PKW(P0,2), pw0); \
    VRD(4); SBAR(); GAPA(C1=__builtin_amdgcn_mfma_f32_32x32x16_bf16(kf[1],qr[0],z_,0,0,0), P0[6],P0[7],P0[8],P0[9],     pw0[2]=PKW(P0,4), pw0[3]=PKW(P0,6), pw0); \
    VRD(1); SBAR(); GAPA(C0=__builtin_amdgcn_mfma_f32_32x32x16_bf16(kf[2],qr[1],C0,0,0,0),   P0[10],P0[11],P0[12],P0[13], pw1[0]=PKW(P0,8), pw1[1]=PKW(P0,10), pw1); \
    VRD(5); SBAR(); GAPA(C1=__builtin_amdgcn_mfma_f32_32x32x16_bf16(kf[3],qr[1],C1,0,0,0),   P0[14],P0[15],P1[0],P1[1],   pw1[2]=PKW(P0,12),pw1[3]=PKW(P0,14), pw1); \
    VRD(2); SBAR(); GAPA(C0=__builtin_amdgcn_mfma_f32_32x32x16_bf16(kf[4],qr[2],C0,0,0,0),   P1[2],P1[3],P1[4],P1[5],     pw2[0]=PKW(P1,0), pw2[1]=PKW(P1,2), pw2); \
    VRD(6); SBAR(); GAPA(C1=__builtin_amdgcn_mfma_f32_32x32x16_bf16(kf[5],qr[2],C1,0,0,0),   P1[6],P1[7],P1[8],P1[9],     pw2[2]=PKW(P1,4), pw2[3]=PKW(P1,6), pw2); \
    VRD(3); SBAR(); GAPA(C0=__builtin_amdgcn_mfma_f32_32x32x16_bf16(kf[6],qr[3],C0,0,0,0),   P1[10],P1[11],P1[12],P1[13], pw3[0]=PKW(P1,8), pw3[1]=PKW(P1,10), pw3); \
    VRD(7); SBAR(); GAPA(C1=__builtin_amdgcn_mfma_f32_32x32x16_bf16(kf[7],qr[3],C1,0,0,0),   P1[14],P1[15],0.f,0.f,       pw3[2]=PKW(P1,12),pw3[3]=PKW(P1,14), pw3); \
    C0=__builtin_amdgcn_mfma_f32_32x32x16_bf16(KX0,QX,C0,0,0,0); kx0[1]=jp1; C1=__builtin_amdgcn_mfma_f32_32x32x16_bf16(KX0,QX,C1,0,0,0); kx0[1]=jp0; SBAR(); \
    l_reg+=sacc; \
    if(GK){DMA_K((t)+3,sl_cur);} if(GV){DMA_V((t)+1,sl_next);} \
    CMASK(C0,C1,t); \
    { float a=MX3(C0[0],C0[1],C1[0]),b=MX3(C0[2],C0[3],C1[1]); a=MX3(a,C1[2],C1[3]); \
      _Pragma("unroll") for(int r=4;r<16;r+=4){a=MX3(a,C0[r],C0[r+1]);b=MX3(b,C0[r+2],C0[r+3]);a=MX3(a,C1[r],C1[r+1]);b=MX3(b,C1[r+2],C1[r+3]);} \
      float rm=__builtin_fmaxf(a,b); { auto rr=__builtin_amdgcn_permlane32_swap(__float_as_uint(rm),__float_as_uint(rm),false,false); rm=__builtin_fmaxf(__uint_as_float(rr[0]),__uint_as_float(rr[1])); } \
      resc=false; \
      if(__builtin_expect(__any(rm>(float)THRL),0)){ const float mold=mhat; const float mnew=mold+__builtin_fmaxf(rm,0.f); SETREF(mnew); const float dl=mhat-mold; \
        _Pragma("unroll") for(int r=0;r<16;++r){C0[r]-=dl;C1[r]-=dl;} \
        const float f=__builtin_amdgcn_exp2f(-dl); l_reg*=f; if(hi==0)wsf[r32]=f; resc=true; } } \
    SBAR(); \
    GAPB(o[0]=__builtin_amdgcn_mfma_f32_32x32x16_bf16(PAF(0),VFR(0),o[0],0,0,0), C0,0); \
    GAPB(o[1]=__builtin_amdgcn_mfma_f32_32x32x16_bf16(PAF(0),VFR(4),o[1],0,0,0), C0,4); \
    KRD(GL,0); GAPB(o[0]=__builtin_amdgcn_mfma_f32_32x32x16_bf16(PAF(1),VFR(1),o[0],0,0,0), C0,8); \
    KRD(GL,1); GAPB(o[1]=__builtin_amdgcn_mfma_f32_32x32x16_bf16(PAF(1),VFR(5),o[1],0,0,0), C0,12); \
    KRD(GL,2); GAPB(o[0]=__builtin_amdgcn_mfma_f32_32x32x16_bf16(PAF(2),VFR(2),o[0],0,0,0), C1,0); \
    KRD(GL,3); GAPB(o[1]=__builtin_amdgcn_mfma_f32_32x32x16_bf16(PAF(2),VFR(6),o[1],0,0,0), C1,4); \
    GAPB(o[0]=__builtin_amdgcn_mfma_f32_32x32x16_bf16(PAF(3),VFR(3),o[0],0,0,0), C1,8); \
    GAPB(o[1]=__builtin_amdgcn_mfma_f32_32x32x16_bf16(PAF(3),VFR(7),o[1],0,0,0), C1,12); \
    }while(0)
  int t=1;
  if(MODE==0){
    #undef CMASK
    #define CMASK(P0,P1,t) do{}while(0)
    for(;t+5<NTL;t+=2){
      STEP(pB0,pB1,pA0,pA1,t,true,true,true);     WAIT_BAR(2); RESC(); ROT();
      STEP(pA0,pA1,pB0,pB1,t+1,true,true,true);   WAIT_BAR(2); RESC(); ROT();
    }
    #undef CMASK
    #define CMASK(P0,P1,t) do{ if(MODE!=0||(t)>=NTL-4) wmask<W>(P0,P1,qrel-64*(t),NEG); }while(0)
  }
  #define ENDW(tt) do{ if(MODE==0){ if((tt)+3<NTL){WAIT_BAR(2);} else if((tt)+2<NTL){WAIT_BAR(1);} else {WAIT_BAR(0);} } }while(0)
  for(;t+1<NTL;t+=2){
    STEP(pB0,pB1,pA0,pA1,t,(MODE==0&&t+3<NTL),(MODE==0&&t+1<NTL),(t+1<NTL));       ENDW(t);   RESC(); ROT();
    STEP(pA0,pA1,pB0,pB1,t+1,(MODE==0&&t+4<NTL),(MODE==0&&t+2<NTL),(t+2<NTL));     ENDW(t+1); RESC(); ROT();
  }
  STEP(pB0,pB1,pA0,pA1,NTL-1,false,false,false); RESC();
  { float sacc=pB0[0]+pB0[1]; _Pragma("unroll") for(int r=2;r<16;++r)sacc+=pB0[r]; _Pragma("unroll") for(int r=0;r<16;++r)sacc+=pB1[r]; l_reg+=sacc;
    pw0=(u32x4){PKW(pB0,0),PKW(pB0,2),PKW(pB0,4),PKW(pB0,6)};pw1=(u32x4){PKW(pB0,8),PKW(pB0,10),PKW(pB0,12),PKW(pB0,14)};pw2=(u32x4){PKW(pB1,0),PKW(pB1,2),PKW(pB1,4),PKW(pB1,6)};pw3=(u32x4){PKW(pB1,8),PKW(pB1,10),PKW(pB1,12),PKW(pB1,14)};
    SBAR(); pv(o,(int)(lds0+LDS_V)+((lane>>4)&1)*32+(lane&3)*8+(4*hi+((lane&15)>>2))*64+sl_cur,PAF(0),PAF(1),PAF(2),PAF(3)); }
  #undef PKW
  #undef PAF
  #undef VFR
  #undef PIN
  #undef MX3
  #undef GAPA
  #undef GAPB
  #undef EX
  #undef VRD
  #undef KRD
  #undef STEP
  #undef ENDW
  {auto rr=__builtin_amdgcn_permlane32_swap(__float_as_uint(l_reg),__float_as_uint(l_reg),false,false);l_reg=__uint_as_float(rr[0])+__uint_as_float(rr[1]);}
  const float qposf=(float)(u.q0+wid*QBLK+r32);
  if(MODE==2) l_reg+=__builtin_amdgcn_exp2f(u.sink2+s2used*qposf-mhat);
  if(MODE==1){ if(hi==0) u.lse[(long)(wid*QBLK+r32)*DIL]=mhat-s2used*qposf+__builtin_amdgcn_logf(l_reg); }
  if(hi==0)wsf[32+r32]=l_reg;asm volatile("s_waitcnt lgkmcnt(0)":::"memory");
  float rli[16];
  #pragma unroll
  for(int r=0;r<16;++r)rli[r]=__builtin_amdgcn_rcpf(wsf[32+crow(r,hi)]);
  bf16*Ow=u.O+(long)(wid*QBLK)*OS;
  { int le=lane; asm volatile("":"+v"(le));
    const int r32e=le&31,hie=le>>5;
    __hip_bfloat16*stg=(__hip_bfloat16*)(shm+LDS_OST)+wid*2048;
    #pragma unroll
    for(int r=0;r<16;++r){const int orow=crow(r,hie);
      #pragma unroll
      for(int d0=0;d0<2;++d0)stg[orow*64+d0*32+r32e]=__float2bfloat16(o[d0][r]*rli[r]);}
    asm volatile("s_waitcnt lgkmcnt(0)":::"memory");
    #pragma unroll
    for(int i=0;i<4;++i){const int row=i*8+(le>>3),ch=le&7; const u32x4 v=*(const u32x4*)(stg+row*64+ch*8); *(u32x4*)(Ow+(long)row*OS+ch*8)=v;} }
  asm volatile("s_waitcnt lgkmcnt(0)\n\ts_barrier":::"memory");
  #undef DMA_K
  #undef DMA_V
  #undef CMASK
  #undef RESC
  #undef ROT
  #undef SETTG
  #undef SETREF
  #undef KX0
  #undef QX
}
#undef SBAR
#undef WAIT_BAR
}

namespace att128 {
using att::UnitDesc; using att::crow; using att::glds16; using att::max3f; using att::max2f; using att::fsub_s; using att::cvtpk_s; using att::kload8; using att::kload2; using att::vtr; using att::rowmax; using att::wmask; using att::lds_cptr;
using bf16=unsigned short;
using bf16x8=__attribute__((ext_vector_type(8)))short;
using s16x4=__attribute__((ext_vector_type(4)))short;
using f32x16=__attribute__((ext_vector_type(16)))float;
using u32x4=__attribute__((ext_vector_type(4)))unsigned;
constexpr int NW=8,QBLK=32,QB=QBLK*NW,KVBLK=64;
#define SBAR() __builtin_amdgcn_sched_barrier(0)
constexpr int NSLOT=3, SLOTB=8192, SLOTV=16384;
constexpr int LDS_K=0, LDS_V=NSLOT*SLOTB, LDS_WS=LDS_V+NSLOT*SLOTV, LDS_OST=LDS_WS+NW*64*4, LDS_BYTES=LDS_OST+NW*8192;
#define WAIT_BAR(N) asm volatile("s_waitcnt vmcnt(" #N ") lgkmcnt(0)\n\ts_barrier":::"memory")
__device__ __forceinline__ void pv4(f32x16*o,int vb,bf16x8 pa0,bf16x8 pa1,bf16x8 pa2,bf16x8 pa3){
  #pragma unroll
  for(int d0=0;d0<4;++d0){s16x4 lo[4],hi[4];
    #pragma unroll
    for(int ks=0;ks<4;++ks){
      asm volatile("ds_read_b64_tr_b16 %0,%1 offset:%c2":"=&v"(lo[ks]):"v"(vb),"i"(d0*4096+ks*1024):"memory");
      asm volatile("ds_read_b64_tr_b16 %0,%1 offset:%c2":"=&v"(hi[ks]):"v"(vb),"i"(d0*4096+ks*1024+512):"memory");}
    asm volatile("s_waitcnt lgkmcnt(0)":::"memory");SBAR();
    #define PK(k) (bf16x8){lo[k][0],lo[k][1],lo[k][2],lo[k][3],hi[k][0],hi[k][1],hi[k][2],hi[k][3]}
    o[d0]=__builtin_amdgcn_mfma_f32_32x32x16_bf16(pa0,PK(0),o[d0],0,0,0);
    o[d0]=__builtin_amdgcn_mfma_f32_32x32x16_bf16(pa1,PK(1),o[d0],0,0,0);
    o[d0]=__builtin_amdgcn_mfma_f32_32x32x16_bf16(pa2,PK(2),o[d0],0,0,0);
    o[d0]=__builtin_amdgcn_mfma_f32_32x32x16_bf16(pa3,PK(3),o[d0],0,0,0);
    #undef PK
  }
}
template<int MODE,int THRL,int DIL,int OS> __device__ __forceinline__ void attn_unit(const UnitDesc&u,char*shm){
  static_assert(MODE==0,"att128: causal mode only");
  constexpr int W=(MODE==0)?0x7fffffff:(MODE==1?128:127);
  const float NEG=(MODE==0)?-INFINITY:-1024.f;
  int tid=threadIdx.x; asm volatile("":"+v"(tid));
  const int lane=tid&63,r32=lane&31,hi=lane>>5; const int wid=__builtin_amdgcn_readfirstlane(tid>>6);
  constexpr long qs=64L*DIL,ks=64L*DIL,vs=64L*DIL;
  const bf16*Qw=u.Q+(long)(wid*QBLK)*qs;
  const unsigned lds0=(unsigned)(uintptr_t)shm;
  __attribute__((address_space(3))) float*wsf=(__attribute__((address_space(3))) float*)((__attribute__((address_space(3))) char*)shm+LDS_WS)+wid*64;
  const unsigned ksoff=(unsigned)(((long)(8*wid+(lane>>3))*ks+(((lane&7)^(lane>>3))*8))*2);
  const unsigned vsoff=(unsigned)(((long)(16*(wid&3)+(lane>>2))*vs+(wid>>2)*32+(lane&3)*8)*2);
  const unsigned kdst=lds0+LDS_K+wid*1024, vdst=lds0+LDS_V+wid*1024;
  #define DMA_K(t,slot) glds16(u.K+(long)(t)*KVBLK*ks,ksoff,(unsigned)__builtin_amdgcn_readfirstlane(kdst+(slot)))
  #define DMA_V(t,slot) do{ glds16(u.V+(long)(t)*KVBLK*vs,vsoff,(unsigned)__builtin_amdgcn_readfirstlane(vdst+2*(slot))); glds16(u.V+(long)(t)*KVBLK*vs+64*(long)M,vsoff,(unsigned)__builtin_amdgcn_readfirstlane(vdst+2*(slot)+8192)); }while(0)
  bf16x8 kf[8];
  const lds_cptr shm3=(lds_cptr)shm; const lds_cptr kp0=shm3+LDS_K+r32*128+((hi^(r32&1))*16); const int kbo=((r32>>1)&3)<<5; const lds_cptr vp0=shm3+LDS_V+((lane>>4)&1)*32+(lane&3)*8+(4*hi+((lane&15)>>2))*64;
  const int NT=u.NT;
  DMA_K(0,0);DMA_V(0,0);DMA_K(1,SLOTB);
  bf16x8 qr[4];
  #pragma unroll
  for(int d0=0;d0<4;++d0)qr[d0]=*reinterpret_cast<const bf16x8*>(&Qw[(long)r32*qs+d0*16+hi*8]);
  const unsigned s2hb=__float_as_uint(u.slope2)&0xffff0000u; const float s2hf=__uint_as_float(s2hb);
  const unsigned s2lb=__float_as_uint(u.slope2-s2hf)&0xffff0000u; const float s2used=s2hf+__uint_as_float(s2lb);
  u32x4 qx; qx[0]=hi?0u:((__float_as_uint(64.f*s2hf)>>16)|(__float_as_uint(64.f*__uint_as_float(s2lb))&0xffff0000u)); qx[1]=hi?0u:((s2hb>>16)|s2lb); qx[2]=0u; qx[3]=0u;
  u32x4 kx0; unsigned jp0,jp1; { const unsigned j0=__float_as_uint((float)r32)>>16, j1=__float_as_uint((float)(r32+32))>>16; jp0=j0|(j0<<16); jp1=j1|(j1<<16);
    kx0[0]=0u; kx0[1]=jp0; kx0[2]=0x3f803f80u; kx0[3]=0u; }
  #define SETTG(t) do{ const unsigned tb_=__float_as_uint((float)(u.tg0+(t)))>>16; kx0[0]=(tb_|(tb_<<16)); }while(0)
  #define KX0 __builtin_bit_cast(bf16x8,kx0)
  #define QX __builtin_bit_cast(bf16x8,qx)
  #define SETREF(m_) do{ const unsigned hb_=__float_as_uint(m_)&0xffff0000u; const float hf_=__uint_as_float(hb_); const unsigned lb_=__float_as_uint((m_)-hf_)&0xffff0000u; \
      mhat=hf_+__uint_as_float(lb_); qx[2]=hi?0u:(((hb_^0x80000000u)>>16)|(lb_^0x80000000u)); }while(0)
  float mhat=0.f,l_reg=0.f;f32x16 o[4];o[0]=f32x16{};o[1]=f32x16{};o[2]=f32x16{};o[3]=f32x16{};
  const int qrel=u.rel0+wid*QBLK+r32-4*hi;
  #define CMASK(P0,P1,t) do{ if(MODE!=0||(t)>=NT-4) wmask<W>(P0,P1,qrel-64*(t),NEG); }while(0)
  bool resc=false;
  f32x16 pA0,pA1,pB0,pB1;
  int sl_prev=0,sl_cur=0,sl_next=SLOTB;
  #define ROT() do{sl_prev=sl_cur;sl_cur=sl_next;sl_next=(sl_next==(NSLOT-1)*SLOTB)?0:sl_next+SLOTB;}while(0)
  #define RESC() do{ if(resc){ asm volatile("s_waitcnt lgkmcnt(0)":::"memory"); \
      _Pragma("unroll") for(int d_=0;d_<4;++d_) _Pragma("unroll") for(int r=0;r<16;++r)o[d_][r]*=wsf[crow(r,hi)]; } }while(0)
  DMA_K(2,2*SLOTB);
  WAIT_BAR(4);
  { SETTG(0); const f32x16 z=f32x16{}; const lds_cptr kb=kp0;
    #pragma unroll
    for(int d0=0;d0<4;++d0){
      const bf16x8 b0=*(const __attribute__((address_space(3))) bf16x8*)(kb+((d0*32)^kbo));
      const bf16x8 b1=*(const __attribute__((address_space(3))) bf16x8*)(kb+((d0*32)^kbo)+4096);
      if(d0==0){pA0=__builtin_amdgcn_mfma_f32_32x32x16_bf16(b0,qr[0],z,0,0,0);pA1=__builtin_amdgcn_mfma_f32_32x32x16_bf16(b1,qr[0],z,0,0,0);}
      else{pA0=__builtin_amdgcn_mfma_f32_32x32x16_bf16(b0,qr[d0],pA0,0,0,0);pA1=__builtin_amdgcn_mfma_f32_32x32x16_bf16(b1,qr[d0],pA1,0,0,0);}}
    pA0=__builtin_amdgcn_mfma_f32_32x32x16_bf16(KX0,QX,pA0,0,0,0); kx0[1]=jp1; pA1=__builtin_amdgcn_mfma_f32_32x32x16_bf16(KX0,QX,pA1,0,0,0); kx0[1]=jp0; }
  asm volatile("s_nop 15\n\ts_nop 7":"+v"(pA0),"+v"(pA1));CMASK(pA0,pA1,0);
  { const float rm=rowmax(pA0,pA1); SETREF(rm); const float dl=mhat;
    _Pragma("unroll") for(int r=0;r<16;++r){pA0[r]=fsub_s(pA0[r],dl);pA1[r]=fsub_s(pA1[r],dl);}
    _Pragma("unroll") for(int r=0;r<16;++r)pA0[r]=__builtin_amdgcn_exp2f(pA0[r]); }
  _Pragma("unroll") for(int r=0;r<16;++r)pA1[r]=__builtin_amdgcn_exp2f(pA1[r]);
  WAIT_BAR(0);
  DMA_K(3,0);DMA_V(1,SLOTB);
  ROT();
  kload8(kf,kp0+sl_cur,kbo);
  WAIT_BAR(3);
  s16x4 vlo[3],vhi[3]; u32x4 pw0,pw1,pw2,pw3;
  #define PKW(P,B) cvtpk_s(P[B],P[B+1])
  #define PAF(k) __builtin_bit_cast(bf16x8,pw##k)
  #define VFJ(b) (bf16x8){vlo[b][0],vlo[b][1],vlo[b][2],vlo[b][3],vhi[b][0],vhi[b][1],vhi[b][2],vhi[b][3]}
  #define PIN(x) asm volatile("":"+v"(x))
  #define MX3(a,b,c) __builtin_fmaxf(__builtin_fmaxf((a),(b)),(c))
  #define GAPA(MF,A0,A1,A2,A3,W0,W1,PW) do{ MF; sacc+=A0; sacc+=A1; sacc+=A2; sacc+=A3; PIN(sacc); W0; W1; PIN(PW); SBAR(); }while(0)
  #define EX(v) __builtin_amdgcn_exp2f(v)
  #define GAPB2(MF,X,B) do{ MF; X[B]=EX(X[B]); X[B+1]=EX(X[B+1]); PIN(X); SBAR(); }while(0)
  #define VRJ(b,n) do{ vlo[b]=vtr(vp_+(((n)&3)*4096+((n)>>2)*1024)); vhi[b]=vtr(vp_+(((n)&3)*4096+((n)>>2)*1024+512)); SBAR(); }while(0)
  #define KRD(G,j) do{ if(G){ kload2(kf,kp0+sl_next,j,kbo); SBAR(); } }while(0)
  #define STEP(C0,C1,P0,P1,t,GK,GV,GL) do{ SBAR(); SETTG(t); const f32x16 z_=f32x16{}; \
    const lds_cptr vp_=vp0+2*sl_prev; \
    float sacc=(P0[0]+P0[1]); \
    GAPA(C0=__builtin_amdgcn_mfma_f32_32x32x16_bf16(kf[0],qr[0],z_,0,0,0), P0[2],P0[3],P0[4],P0[5],     pw0[0]=PKW(P0,0), pw0[1]=PKW(P0,2), pw0); \
    GAPA(C1=__builtin_amdgcn_mfma_f32_32x32x16_bf16(kf[1],qr[0],z_,0,0,0), P0[6],P0[7],P0[8],P0[9],     pw0[2]=PKW(P0,4), pw0[3]=PKW(P0,6), pw0); \
    GAPA(C0=__builtin_amdgcn_mfma_f32_32x32x16_bf16(kf[2],qr[1],C0,0,0,0),   P0[10],P0[11],P0[12],P0[13], pw1[0]=PKW(P0,8), pw1[1]=PKW(P0,10), pw1); \
    GAPA(C1=__builtin_amdgcn_mfma_f32_32x32x16_bf16(kf[3],qr[1],C1,0,0,0),   P0[14],P0[15],P1[0],P1[1],   pw1[2]=PKW(P0,12),pw1[3]=PKW(P0,14), pw1); \
    GAPA(C0=__builtin_amdgcn_mfma_f32_32x32x16_bf16(kf[4],qr[2],C0,0,0,0),   P1[2],P1[3],P1[4],P1[5],     pw2[0]=PKW(P1,0), pw2[1]=PKW(P1,2), pw2); \
    GAPA(C1=__builtin_amdgcn_mfma_f32_32x32x16_bf16(kf[5],qr[2],C1,0,0,0),   P1[6],P1[7],P1[8],P1[9],     pw2[2]=PKW(P1,4), pw2[3]=PKW(P1,6), pw2); \
    VRJ(0,0); GAPA(C0=__builtin_amdgcn_mfma_f32_32x32x16_bf16(kf[6],qr[3],C0,0,0,0),   P1[10],P1[11],P1[12],P1[13], pw3[0]=PKW(P1,8), pw3[1]=PKW(P1,10), pw3); \
    VRJ(1,1); GAPA(C1=__builtin_amdgcn_mfma_f32_32x32x16_bf16(kf[7],qr[3],C1,0,0,0),   P1[14],P1[15],0.f,0.f,       pw3[2]=PKW(P1,12),pw3[3]=PKW(P1,14), pw3); \
    C0=__builtin_amdgcn_mfma_f32_32x32x16_bf16(KX0,QX,C0,0,0,0); kx0[1]=jp1; C1=__builtin_amdgcn_mfma_f32_32x32x16_bf16(KX0,QX,C1,0,0,0); kx0[1]=jp0; SBAR(); \
    l_reg+=sacc; \
    if(GK){DMA_K((t)+3,sl_cur);} if(GV){DMA_V((t)+1,sl_next);} \
    CMASK(C0,C1,t); \
    { float a=MX3(C0[0],C0[1],C1[0]),b=MX3(C0[2],C0[3],C1[1]); a=MX3(a,C1[2],C1[3]); \
      _Pragma("unroll") for(int r=4;r<16;r+=4){a=MX3(a,C0[r],C0[r+1]);b=MX3(b,C0[r+2],C0[r+3]);a=MX3(a,C1[r],C1[r+1]);b=MX3(b,C1[r+2],C1[r+3]);} \
      float rm=__builtin_fmaxf(a,b); { auto rr=__builtin_amdgcn_permlane32_swap(__float_as_uint(rm),__float_as_uint(rm),false,false); rm=__builtin_fmaxf(__uint_as_float(rr[0]),__uint_as_float(rr[1])); } \
      resc=false; \
      if(__builtin_expect(__any(rm>(float)THRL),0)){ const float mold=mhat; const float mnew=mold+__builtin_fmaxf(rm,0.f); SETREF(mnew); const float dl=mhat-mold; \
        _Pragma("unroll") for(int r=0;r<16;++r){C0[r]-=dl;C1[r]-=dl;} \
        const float f=__builtin_amdgcn_exp2f(-dl); l_reg*=f; if(hi==0)wsf[r32]=f; resc=true; } } \
    SBAR(); \
    VRJ(2,2);             GAPB2(o[0]=__builtin_amdgcn_mfma_f32_32x32x16_bf16(PAF(0),VFJ(0),o[0],0,0,0), C0,0); \
    VRJ(0,3);             GAPB2(o[1]=__builtin_amdgcn_mfma_f32_32x32x16_bf16(PAF(0),VFJ(1),o[1],0,0,0), C0,2); \
    VRJ(1,4);             GAPB2(o[2]=__builtin_amdgcn_mfma_f32_32x32x16_bf16(PAF(0),VFJ(2),o[2],0,0,0), C0,4); \
    VRJ(2,5);             GAPB2(o[3]=__builtin_amdgcn_mfma_f32_32x32x16_bf16(PAF(0),VFJ(0),o[3],0,0,0), C0,6); \
    VRJ(0,6);  KRD(GL,0); GAPB2(o[0]=__builtin_amdgcn_mfma_f32_32x32x16_bf16(PAF(1),VFJ(1),o[0],0,0,0), C0,8); \
    VRJ(1,7);             GAPB2(o[1]=__builtin_amdgcn_mfma_f32_32x32x16_bf16(PAF(1),VFJ(2),o[1],0,0,0), C0,10); \
    VRJ(2,8);  KRD(GL,1); GAPB2(o[2]=__builtin_amdgcn_mfma_f32_32x32x16_bf16(PAF(1),VFJ(0),o[2],0,0,0), C0,12); \
    VRJ(0,9);             GAPB2(o[3]=__builtin_amdgcn_mfma_f32_32x32x16_bf16(PAF(1),VFJ(1),o[3],0,0,0), C0,14); \
    VRJ(1,10); KRD(GL,2); GAPB2(o[0]=__builtin_amdgcn_mfma_f32_32x32x16_bf16(PAF(2),VFJ(2),o[0],0,0,0), C1,0); \
    VRJ(2,11);            GAPB2(o[1]=__builtin_amdgcn_mfma_f32_32x32x16_bf16(PAF(2),VFJ(0),o[1],0,0,0), C1,2); \
    VRJ(0,12); KRD(GL,3); GAPB2(o[2]=__builtin_amdgcn_mfma_f32_32x32x16_bf16(PAF(2),VFJ(1),o[2],0,0,0), C1,4); \
    VRJ(1,13);            GAPB2(o[3]=__builtin_amdgcn_mfma_f32_32x32x16_bf16(PAF(2),VFJ(2),o[3],0,0,0), C1,6); \
    VRJ(2,14);            GAPB2(o[0]=__builtin_amdgcn_mfma_f32_32x32x16_bf16(PAF(3),VFJ(0),o[0],0,0,0), C1,8); \
    VRJ(0,15);            GAPB2(o[1]=__builtin_amdgcn_mfma_f32_32x32x16_bf16(PAF(3),VFJ(1),o[1],0,0,0), C1,10); \
                          GAPB2(o[2]=__builtin_amdgcn_mfma_f32_32x32x16_bf16(PAF(3),VFJ(2),o[2],0,0,0), C1,12); \
                          GAPB2(o[3]=__builtin_amdgcn_mfma_f32_32x32x16_bf16(PAF(3),VFJ(0),o[3],0,0,0), C1,14); \
    }while(0)
  int t=1;
  if(MODE==0){
    #undef CMASK
    #define CMASK(P0,P1,t) do{}while(0)
    for(;t+5<NT;t+=2){
      STEP(pB0,pB1,pA0,pA1,t,true,true,true);     WAIT_BAR(3); RESC(); ROT();
      STEP(pA0,pA1,pB0,pB1,t+1,true,true,true);   WAIT_BAR(3); RESC(); ROT();
    }
    #undef CMASK
    #define CMASK(P0,P1,t) do{ if(MODE!=0||(t)>=NT-4) wmask<W>(P0,P1,qrel-64*(t),NEG); }while(0)
  }
  #define ENDW(tt) do{ if((tt)+3<NT){WAIT_BAR(3);} else if((tt)+2<NT){WAIT_BAR(2);} else {WAIT_BAR(0);} }while(0)
  for(;t+1<NT;t+=2){
    STEP(pB0,pB1,pA0,pA1,t,(t+3<NT),(t+1<NT),(t+1<NT));       ENDW(t);   RESC(); ROT();
    STEP(pA0,pA1,pB0,pB1,t+1,(t+4<NT),(t+2<NT),(t+2<NT));     ENDW(t+1); RESC(); ROT();
  }
  STEP(pB0,pB1,pA0,pA1,NT-1,false,false,false); RESC();
  { float sacc=pB0[0]+pB0[1]; _Pragma("unroll") for(int r=2;r<16;++r)sacc+=pB0[r]; _Pragma("unroll") for(int r=0;r<16;++r)sacc+=pB1[r]; l_reg+=sacc;
    pw0=(u32x4){PKW(pB0,0),PKW(pB0,2),PKW(pB0,4),PKW(pB0,6)};pw1=(u32x4){PKW(pB0,8),PKW(pB0,10),PKW(pB0,12),PKW(pB0,14)};pw2=(u32x4){PKW(pB1,0),PKW(pB1,2),PKW(pB1,4),PKW(pB1,6)};pw3=(u32x4){PKW(pB1,8),PKW(pB1,10),PKW(pB1,12),PKW(pB1,14)};
    SBAR(); pv4(o,(int)(lds0+LDS_V)+((lane>>4)&1)*32+(lane&3)*8+(4*hi+((lane&15)>>2))*64+2*sl_cur,PAF(0),PAF(1),PAF(2),PAF(3)); }
  #undef PKW
  #undef PAF
  #undef VFJ
  #undef PIN
  #undef MX3
  #undef GAPA
  #undef GAPB2
  #undef EX
  #undef VRJ
  #undef KRD
  #undef STEP
  #undef ENDW
  {auto rr=__builtin_amdgcn_permlane32_swap(__float_as_uint(l_reg),__float_as_uint(l_reg),false,false);l_reg=__uint_as_float(rr[0])+__uint_as_float(rr[1]);}
  const float qposf=(float)(u.q0+wid*QBLK+r32);
  if(MODE==2) l_reg+=__builtin_amdgcn_exp2f(u.sink2+s2used*qposf-mhat);
  if(MODE==1){ if(hi==0) u.lse[(long)(wid*QBLK+r32)*DIL]=mhat-s2used*qposf+__builtin_amdgcn_logf(l_reg); }
  if(hi==0)wsf[32+r32]=l_reg;asm volatile("s_waitcnt lgkmcnt(0)":::"memory");
  float rli[16];
  #pragma unroll
  for(int r=0;r<16;++r)rli[r]=__builtin_amdgcn_rcpf(wsf[32+crow(r,hi)]);
  { int le=lane; asm volatile("":"+v"(le));
    const int r32e=le&31,hie=le>>5;
    __hip_bfloat16*stg=(__hip_bfloat16*)(shm+LDS_OST)+wid*4096;
    if(u.fin==0){
      #pragma unroll
      for(int r=0;r<16;++r){const int orow=crow(r,hie);
        #pragma unroll
        for(int d0=0;d0<4;++d0)stg[orow*128+d0*32+r32e]=__float2bfloat16(o[d0][r]*rli[r]);}
    } else {
      const float lam=u.lam;
      #pragma unroll
      for(int r=0;r<16;++r){const int orow=crow(r,hie);
        #pragma unroll
        for(int d0=0;d0<4;++d0){ const int ix=orow*128+d0*32+r32e; const float o2=__bfloat162float(__float2bfloat16(o[d0][r]*rli[r])); stg[ix]=__float2bfloat16(__bfloat162float(stg[ix])-lam*o2); } }
      asm volatile("s_waitcnt lgkmcnt(0)":::"memory");
      const int ch=le&15; const float* sgp=u.sg+8*ch; const float g0=sgp[0],g1=sgp[1],g2=sgp[2],g3=sgp[3],g4=sgp[4],g5=sgp[5],g6=sgp[6],g7=sgp[7];
      bf16*Of=u.Of+(long)(wid*QBLK)*D+ch*8;
      #pragma unroll
      for(int i=0;i<8;++i){ const int row=i*4+(le>>4); const u32x4 v=*(const u32x4*)(stg+row*128+ch*8);
        const float x0=__uint_as_float(v[0]<<16),x1=__uint_as_float(v[0]&0xffff0000u),x2=__uint_as_float(v[1]<<16),x3=__uint_as_float(v[1]&0xffff0000u),
                    x4=__uint_as_float(v[2]<<16),x5=__uint_as_float(v[2]&0xffff0000u),x6=__uint_as_float(v[3]<<16),x7=__uint_as_float(v[3]&0xffff0000u);
        float ss=(x0*x0+x1*x1)+(x2*x2+x3*x3)+(x4*x4+x5*x5)+(x6*x6+x7*x7);
        ss+=__shfl_xor(ss,1); ss+=__shfl_xor(ss,2); ss+=__shfl_xor(ss,4); ss+=__shfl_xor(ss,8);
        const float rs=u.lam1/sqrtf(ss*(1.f/128.f)+1e-6f);
        u32x4 w; w[0]=cvtpk_s(x0*rs*g0,x1*rs*g1); w[1]=cvtpk_s(x2*rs*g2,x3*rs*g3); w[2]=cvtpk_s(x4*rs*g4,x5*rs*g5); w[3]=cvtpk_s(x6*rs*g6,x7*rs*g7);
        *(u32x4*)(Of+(long)row*D)=w; }
    } }
  asm volatile("s_waitcnt lgkmcnt(0)\n\ts_barrier":::"memory");
  #undef DMA_K
  #undef DMA_V
  #undef CMASK
  #undef RESC
  #undef ROT
  #undef SETTG
  #undef SETREF
  #undef KX0
  #undef QX
}
#undef SBAR
#undef WAIT_BAR
}

constexpr float LOG2E = 1.4426950408889634f;
__device__ __forceinline__ int vcu_of(int bx, int G) { return (G % 8 == 0) ? (bx % 8) * (G / 8) + bx / 8 : bx; }
constexpr int ATT1_LDS_TAB = 141312;
__device__ __forceinline__ void attn1_tuned_phase(const Ctx& c, const bf16* qkv, const float* qkg  , bf16* R, unsigned* qctr, const ExpertSrc& es, unsigned char* ws,
                                                  const float* lamp, const float* subln, bf16* Oout) {
    LAS int* order = (LAS int*)(c.lds + ATT1_LDS_TAB);
    LAS int* nts = order + 256;
    LAS int* t0s = nts + 256;
    volatile LAS unsigned* nextu = (volatile LAS unsigned*)(t0s + 256);
    LAS float* bnd = (LAS float*)(t0s + 256 + 4);
    const int G = gridDim.x;
    if (c.wave == 0) { float gq = fabsf(qkg[c.lane]), gk = fabsf(qkg[64 + c.lane]);
#pragma unroll
        for (int o = 1; o < 64; o <<= 1) { gq = fmaxf(gq, __shfl_xor(gq, o)); gk = fmaxf(gk, __shfl_xor(gk, o)); }
        if (c.lane == 0) bnd[0] = 8.f * gq * gk * 1.02f; }
    __syncthreads();
    if (c.tid < 256) { const int h = c.tid >> 4, qb = c.tid & 15; const float slope = exp2f(-0.5f * (float)(h + 1));
        const int dmax = (int)fminf(ceilf((2.f * bnd[0] + 25.f) / slope), 1.0e6f), lo_ = 256 * qb - dmax, t0 = lo_ <= 0 ? 0 : ((lo_ >> 6) & ~1);
        nts[c.tid] = 4 * (qb + 1) - t0; t0s[c.tid] = t0; }
    __syncthreads();
    if (c.tid < 256) { const int mine = nts[c.tid]; int rank = 0;
        for (int e = 0; e < 256; ++e) { const int o = nts[e]; rank += (o > mine || (o == mine && e < c.tid)) ? 1 : 0; }
        order[rank] = c.tid; }
    __syncthreads();
#if FUSE_FINISH
    constexpr int NCH = DEFER_CONV ? EXP_ITEMS / 65 : 0, NUNIT = NB * 16 * 16, NPOS = NUNIT + NCH;
    static_assert(!DEFER_CONV || EXP_ITEMS % 65 == 0, "chunking");
    if (c.tid == 0) { float s01 = 0.f, s23 = 0.f; for (int i = 0; i < 64; ++i) { s01 += lamp[i] * lamp[64 + i]; s23 += lamp[128 + i] * lamp[192 + i]; }
      const float li = 0.8f - 0.6f * expf(-0.3f * 1.0f); bnd[1] = expf(s01) - expf(s23) + li; bnd[2] = li; }
    __syncthreads();
    unsigned p = blockIdx.x;
    while (p < (unsigned)NPOS) {
        unsigned nreg = 0u;
        if (c.tid == 0) nreg = __hip_atomic_fetch_add(qctr, 1u, __ATOMIC_RELAXED, __HIP_MEMORY_SCOPE_AGENT) + (unsigned)G;
        const bool inter = p < (unsigned)(NCH * 2);
        if (inter && (p & 1u)) {
            expert_items_block(c, es, 1, ws, (int)(p >> 1) * 65, 65);
        } else {
#define ATT1_DECODE() const unsigned u = inter ? (p >> 1) : p - (unsigned)NCH; const int ent = order[u >> 2], h = ent >> 4, qb = ent & 15, b = (int)(u & 3u), t0 = t0s[ent]; \
            bf16* Rblk = R + ((size_t)(b * T + qb * 256) * 16 + h) * 256
#if USE_V128
#pragma unroll 1
            for (int pass = 0; pass < 2; ++pass) {
                ATT1_DECODE();
                const int i = pass; att::UnitDesc ud;
                ud.Q = qkv + ((size_t)(2 * h + i) * M + (size_t)(b * T + qb * 256)) * 64; ud.qs = 64;
                ud.K = qkv + ((size_t)(32 + 2 * h + i) * M + (size_t)(b * T + 64 * t0)) * 64; ud.ks = 64;
                ud.V = qkv + ((size_t)(64 + 2 * h) * M + (size_t)(b * T + 64 * t0)) * 64; ud.vs = 64;
                ud.O = Rblk + 128 * i; ud.os = 16 * 256;
                ud.lse = nullptr; ud.lses = 0; ud.NT = 4 * (qb + 1) - t0; ud.rel0 = qb * 256 - 64 * t0; ud.tg0 = t0; ud.q0 = qb * 256;
                ud.slope2 = exp2f(-0.5f * (float)(h + 1)) * LOG2E; ud.sink2 = 0.f;
                ud.fin = pass; ud.lam = bnd[1]; ud.lam1 = 1.f - bnd[2]; ud.sg = subln; ud.Of = Oout + (size_t)(b * T + qb * 256) * D + 128 * h;
                att128::attn_unit<0, 24, 1, 16 * 256>(ud, (char*)c.lds);
            }
#else
#pragma unroll 1
            for (int pass = 0; pass < 4; ++pass) {
                ATT1_DECODE();
                const int i = pass >> 1, j = pass & 1; att::UnitDesc ud;
#if QKV_HEADMAJOR
                ud.Q = qkv + ((size_t)(2 * h + i) * M + (size_t)(b * T + qb * 256)) * 64; ud.qs = 64;
                ud.K = qkv + ((size_t)(32 + 2 * h + i) * M + (size_t)(b * T + 64 * t0)) * 64; ud.ks = 64;
                ud.V = qkv + ((size_t)(64 + 2 * h + j) * M + (size_t)(b * T + 64 * t0)) * 64; ud.vs = 64;
#else
                ud.Q = qkv + (size_t)(b * T + qb * 256) * C_IN + 128 * h + 64 * i; ud.qs = C_IN;
                ud.K = qkv + (size_t)(b * T + 64 * t0) * C_IN + 2048 + 128 * h + 64 * i; ud.ks = C_IN;
                ud.V = qkv + (size_t)(b * T + 64 * t0) * C_IN + 4096 + 128 * h + 64 * j; ud.vs = C_IN;
#endif
                ud.O = Rblk + 128 * i + 64 * j; ud.os = 16 * 256;
                ud.lse = nullptr; ud.lses = 0; ud.NT = 4 * (qb + 1) - t0; ud.rel0 = qb * 256 - 64 * t0; ud.tg0 = t0; ud.q0 = qb * 256;
                ud.slope2 = exp2f(-0.5f * (float)(h + 1)) * LOG2E; ud.sink2 = 0.f;
                att::attn_unit<0, 8, 1, 16 * 256>(ud, (char*)c.lds);
            }
#endif
#if !USE_V128
            asm volatile("s_waitcnt vmcnt(0)" ::: "memory"); __syncthreads();
            { ATT1_DECODE(); (void)t0; const float lam = bnd[1], lam_init = bnd[2];
              int ft_ = threadIdx.x; asm volatile("" : "+v"(ft_));
              const int row = ft_ >> 1, hf = ft_ & 1; const bf16* p1 = Rblk + (size_t)row * (16 * 256) + 64 * hf; const bf16* p2 = p1 + 128;
              float xv[64]; float ss = 0.f;
#pragma unroll
              for (int q8 = 0; q8 < 8; ++q8) { const u32x4 a = *(const u32x4*)(p1 + 8 * q8), bq = *(const u32x4*)(p2 + 8 * q8);
#pragma unroll
                  for (int k = 0; k < 4; ++k) { const float x0 = bf2f(a[k] & 0xffffu) - lam * bf2f(bq[k] & 0xffffu), x1 = bf2f(a[k] >> 16) - lam * bf2f(bq[k] >> 16);
                      xv[8 * q8 + 2 * k] = x0; xv[8 * q8 + 2 * k + 1] = x1; ss += x0 * x0 + x1 * x1; } }
              ss += __shfl_xor(ss, 1);
              const float rs = (1.f - lam_init) / sqrtf(ss * (1.f / 128.f) + RMS_EPS);
              bf16* op = Oout + (size_t)(b * T + qb * 256 + row) * D + 128 * h + 64 * hf; const float* sg = subln + 64 * hf;
#pragma unroll
              for (int q8 = 0; q8 < 8; ++q8) { u32x4 w;
#pragma unroll
                  for (int k = 0; k < 4; ++k) w[k] = pk2(xv[8 * q8 + 2 * k] * rs * sg[8 * q8 + 2 * k], xv[8 * q8 + 2 * k + 1] * rs * sg[8 * q8 + 2 * k + 1]);
                  *(u32x4*)(op + 8 * q8) = w; } }
#endif
#undef ATT1_DECODE
        }
        if (c.tid == 0) nextu[0] = nreg;
        __syncthreads();
        p = nextu[0];
    }
}
#else
    constexpr int NCH = DEFER_CONV ? EXP_ITEMS / 65 : 0, NPOS = NB * 16 * 4 * 16 + NCH;
    static_assert(!DEFER_CONV || EXP_ITEMS % 65 == 0, "chunking");
    unsigned p = blockIdx.x;
    while (p < (unsigned)NPOS) {
        unsigned nreg = 0u;
        if (c.tid == 0) nreg = __hip_atomic_fetch_add(qctr, 1u, __ATOMIC_RELAXED, __HIP_MEMORY_SCOPE_AGENT) + (unsigned)G;
        const bool inter = p < (unsigned)(NCH * 6);
        if (inter && (p % 6u) == 5u) {
            expert_items_block(c, es, 1, ws, (int)(p / 6u) * 65, 65);
        } else {
            const unsigned u = inter ? p - p / 6u : p - (unsigned)NCH;
            const int ent = order[u >> 4], h = ent >> 4, qb = ent & 15, bp = (int)(u & 15u), b = bp >> 2, i = (bp >> 1) & 1, j = bp & 1, t0 = t0s[ent];
            att::UnitDesc ud;
#if QKV_HEADMAJOR
            ud.Q = qkv + ((size_t)(2 * h + i) * M + (size_t)(b * T + qb * 256)) * 64; ud.qs = 64;
            ud.K = qkv + ((size_t)(32 + 2 * h + i) * M + (size_t)(b * T + 64 * t0)) * 64; ud.ks = 64;
            ud.V = qkv + ((size_t)(64 + 2 * h + j) * M + (size_t)(b * T + 64 * t0)) * 64; ud.vs = 64;
#else
            ud.Q = qkv + (size_t)(b * T + qb * 256) * C_IN + 128 * h + 64 * i; ud.qs = C_IN;
            ud.K = qkv + (size_t)(b * T + 64 * t0) * C_IN + 2048 + 128 * h + 64 * i; ud.ks = C_IN;
            ud.V = qkv + (size_t)(b * T + 64 * t0) * C_IN + 4096 + 128 * h + 64 * j; ud.vs = C_IN;
#endif
            ud.O = R + ((size_t)(b * T + qb * 256) * 16 + h) * 256 + 128 * i + 64 * j; ud.os = 16 * 256;
            ud.lse = nullptr; ud.lses = 0; ud.NT = 4 * (qb + 1) - t0; ud.rel0 = qb * 256 - 64 * t0; ud.tg0 = t0; ud.q0 = qb * 256;
            ud.slope2 = exp2f(-0.5f * (float)(h + 1)) * LOG2E; ud.sink2 = 0.f;
            att::attn_unit<0, 8, 1, 16 * 256>(ud, (char*)c.lds);
        }
        if (c.tid == 0) nextu[0] = nreg;
        __syncthreads();
        p = nextu[0];
    }
}
#endif
__device__ __forceinline__ void attn1_finish_bf16_phase(const Ctx& c, const bf16* R, const float* lamp, const float* subln, bf16* O) {
    float s01 = 0.f, s23 = 0.f;
    for (int i = 0; i < 64; ++i) { s01 += lamp[i] * lamp[64 + i]; s23 += lamp[128 + i] * lamp[192 + i]; }
    const float lam_init = 0.8f - 0.6f * expf(-0.3f * 1.0f);
    const float lam = expf(s01) - expf(s23) + lam_init;
    const long total = (long)M * 16;
    for (long id = gtid_now(); id < total; id += c.gsz) {
        const bf16* p1 = R + (size_t)id * 256; const bf16* p2 = p1 + 128;
        float ss = 0.f;
#pragma unroll 4
        for (int i = 0; i < 16; ++i) { const u32x4 a = *(const u32x4*)(p1 + 8 * i), bq = *(const u32x4*)(p2 + 8 * i);
#pragma unroll
            for (int k = 0; k < 4; ++k) { const float x0 = bf2f(a[k] & 0xffffu) - lam * bf2f(bq[k] & 0xffffu), x1 = bf2f(a[k] >> 16) - lam * bf2f(bq[k] >> 16); ss += x0 * x0 + x1 * x1; } }
        const float rs = (1.f - lam_init) / sqrtf(ss * (1.f / 128.f) + RMS_EPS);
        bf16* op = O + (size_t)id * 128;
#pragma unroll 4
        for (int i = 0; i < 16; ++i) { const u32x4 a = *(const u32x4*)(p1 + 8 * i), bq = *(const u32x4*)(p2 + 8 * i); u32x4 w;
#pragma unroll
            for (int k = 0; k < 4; ++k) { const float x0 = bf2f(a[k] & 0xffffu) - lam * bf2f(bq[k] & 0xffffu), x1 = bf2f(a[k] >> 16) - lam * bf2f(bq[k] >> 16);
                w[k] = pk2(x0 * rs * subln[8 * i + 2 * k], x1 * rs * subln[8 * i + 2 * k + 1]); }
            *(u32x4*)(op + 8 * i) = w; }
    }
}
__device__ __forceinline__ void attn0_tuned_phase(const Ctx& c, const bf16* qkv, const float* sinks, bf16* OBR  , float* LSE  , bf16* O, int xlo, int xhi) {
    const int G = gridDim.x, vcu = vcu_of(blockIdx.x, G);
    for (int gid = vcu; gid < NB * 64; gid += G) {
        const int b = gid / 64, kind = (gid % 64) / 16, h = gid % 16;
        const float slope2 = exp2f(-0.5f * (float)(h + 1)) * LOG2E;
        if (kind < 3) {
            const int dil = kind == 0 ? 1 : (kind == 1 ? 4 : 16), nblk = 16 / dil;
            for (int x = xlo; x < xhi; ++x) {
                const int r = x / nblk, blk = x % nblk, q0 = blk * 256, t0 = blk ? 4 * blk - 2 : 0; att::UnitDesc u;
                const size_t qrow = (size_t)(b * T + r + dil * q0), krow = (size_t)(b * T + r + dil * 64 * t0);
#if QKV_HEADMAJOR
                u.Q = qkv + ((size_t)(h) * M + qrow) * 64; u.qs = (long)dil * 64;
                u.K = qkv + ((size_t)(16 + h) * M + krow) * 64; u.ks = (long)dil * 64;
                u.V = qkv + ((size_t)(32 + h) * M + krow) * 64; u.vs = (long)dil * 64;
#else
                u.Q = qkv + qrow * AB_IN + 64 * h; u.qs = (long)dil * AB_IN;
                u.K = qkv + krow * AB_IN + 1024 + 64 * h; u.ks = (long)dil * AB_IN;
                u.V = qkv + krow * AB_IN + 2048 + 64 * h; u.vs = (long)dil * AB_IN;
#endif
                u.O = OBR + ((size_t)kind * M + qrow) * 1024 + 64 * h; u.os = (long)dil * 1024;
                u.lse = LSE + ((size_t)kind * 16 + h) * M + qrow; u.lses = (long)dil;
                u.NT = blk ? 6 : 4; u.rel0 = q0 - 64 * t0; u.tg0 = t0; u.q0 = q0; u.slope2 = slope2 * (float)dil; u.sink2 = 0.f;
                if (dil == 1) att::attn_unit<1, 8, 1, 1024>(u, (char*)c.lds); else if (dil == 4) att::attn_unit<1, 8, 4, 4096>(u, (char*)c.lds); else att::attn_unit<1, 8, 16, 16384>(u, (char*)c.lds);
            }
        } else {
            const int kvh = h >> 3;
            for (int x = xlo; x < xhi; ++x) {
                const int q0 = x * 256, t0 = x ? 4 * x - 2 : 0; att::UnitDesc u;
                const size_t qrow = (size_t)(b * T + q0), krow = (size_t)(b * T + 64 * t0);
#if QKV_HEADMAJOR
                u.Q = qkv + ((size_t)(48 + h) * M + qrow) * 64; u.qs = 64;
                u.K = qkv + ((size_t)(64 + kvh) * M + krow) * 64; u.ks = 64;
                u.V = qkv + ((size_t)(66 + kvh) * M + krow) * 64; u.vs = 64;
#else
                u.Q = qkv + qrow * AB_IN + 3072 + 64 * h; u.qs = AB_IN;
                u.K = qkv + krow * AB_IN + 4096 + 64 * kvh; u.ks = AB_IN;
                u.V = qkv + krow * AB_IN + 4224 + 64 * kvh; u.vs = AB_IN;
#endif
                u.O = O + qrow * D + 1024 + 64 * h; u.os = D;
                u.lse = nullptr; u.lses = 0;
                u.NT = x ? 6 : 4; u.rel0 = q0 - 64 * t0; u.tg0 = t0; u.q0 = q0; u.slope2 = slope2; u.sink2 = sinks[h] * LOG2E;
                att::attn_unit<2, 8, 1, D>(u, (char*)c.lds);
            }
        }
    }
}
__device__ __forceinline__ void attn0_merge_phase(const Ctx& c, const bf16* __restrict__ OBR, const float* __restrict__ LSE, bf16* __restrict__ O) {
    const long total = (long)M * 16 * 8;
#pragma unroll 4
    for (long id8 = gtid_now(); id8 < total; id8 += c.gsz) {
        const long id = id8 >> 3; const int pc = (int)(id8 & 7);
        const long m = id / 16; const int h = (int)(id % 16);
        const size_t li = (size_t)h * M + (size_t)m; const float l0 = LSE[li], l1 = LSE[(size_t)M * 16 + li], l2 = LSE[(size_t)2 * M * 16 + li];
        const float mx = fmaxf(l0, fmaxf(l1, l2)); float w0 = exp2f(l0 - mx), w1 = exp2f(l1 - mx), w2 = exp2f(l2 - mx); const float inv = 1.f / (w0 + w1 + w2); w0 *= inv; w1 *= inv; w2 *= inv;
        const bf16* p0 = OBR + (size_t)m * 1024 + 64 * h + 8 * pc; const bf16* p1 = p0 + (size_t)M * 1024; const bf16* p2 = p1 + (size_t)M * 1024;
        const u32x4 a = *(const u32x4*)p0, bq = *(const u32x4*)p1, cq = *(const u32x4*)p2; u32x4 w;
#pragma unroll
        for (int k = 0; k < 4; ++k) w[k] = pk2(w0 * bf2f(a[k] & 0xffffu) + w1 * bf2f(bq[k] & 0xffffu) + w2 * bf2f(cq[k] & 0xffffu), w0 * bf2f(a[k] >> 16) + w1 * bf2f(bq[k] >> 16) + w2 * bf2f(cq[k] >> 16));
        *(u32x4*)(O + (size_t)m * D + 64 * h + 8 * pc) = w;
    }
}

__device__ __forceinline__ void convert_router(const Ctx& c, const float* wr, bf16* wrt) {
    for (int id2 = gtid_now(); id2 < 2 * NE * D; id2 += c.gsz) { const int l = id2 / (NE * D), id = id2 % (NE * D), k = id / NE, n = id % NE; const float w = wr[id2];
        const unsigned hb = f2bf(w); const float hf = bf2f(hb);
        const int kkn = 2 * ((k >> 6) & 3) + ((k >> 3) & 1), qn = (k >> 4) & 3;
        const int off = l * 2 * NE * D + (((((k >> 8) * 8 + kkn) * 4 + (n >> 4)) * 2) * 64 + ((n & 15) + 16 * qn)) * 8 + (k & 7);
        wrt[off] = (bf16)hb; wrt[off + 512] = (bf16)f2bf(w - hf); }
}
#define DPPF(old, v, ctrl, rm) __int_as_float(__builtin_amdgcn_update_dpp(__float_as_int(old), __float_as_int(v), ctrl, rm, 0xf, false))
__device__ __forceinline__ float dpp_max8(float v) {
    v = fmaxf(v, DPPF(v, v, 0xB1, 0xf)); v = fmaxf(v, DPPF(v, v, 0x4E, 0xf)); v = fmaxf(v, DPPF(v, v, 0x141, 0xf)); return v; }
__device__ __forceinline__ float wave_max_u(float v) {
    v = dpp_max8(v); v = fmaxf(v, DPPF(v, v, 0x140, 0xf)); v = fmaxf(v, DPPF(v, v, 0x142, 0xa)); v = fmaxf(v, DPPF(v, v, 0x143, 0xc));
    return __int_as_float(__builtin_amdgcn_readlane(__float_as_int(v), 63)); }
__device__ __forceinline__ float wave_sum_u(float v) {
    v += DPPF(0.f, v, 0xB1, 0xf); v += DPPF(0.f, v, 0x4E, 0xf); v += DPPF(0.f, v, 0x141, 0xf); v += DPPF(0.f, v, 0x140, 0xf); v += DPPF(0.f, v, 0x142, 0xa); v += DPPF(0.f, v, 0x143, 0xc);
    return __int_as_float(__builtin_amdgcn_readlane(__float_as_int(v), 63)); }
constexpr int RT_ROUTER = 2;
__device__ __forceinline__ void router2_phase(const Ctx& c, const float* x1, const float* g, const float* ada_l, const bf16* wrt, const float* rbias,
                                              bf16* HF, int* idx, float* gate, int* wcnt, bf16* HFB = nullptr) {
    constexpr int RT = RT_ROUTER, RU = 16 * RT, NU = M / RU;
    LAS float* red = (LAS float*)c.lds;
    LAS float* part = (LAS float*)(c.lds + 1024);
    LAS float* GA = (LAS float*)(c.lds + 1024 + RT * 32768);
    LAS float* GB = GA + D;
    const int w = __builtin_amdgcn_readfirstlane((int)threadIdx.x >> 6);
    const float rb = rbias[threadIdx.x & 63];
    unsigned cnt = 0u;
    const int per = (NU + (int)gridDim.x - 1) / (int)gridDim.x, u0 = blockIdx.x * per, u1 = (u0 + per < NU) ? u0 + per : NU;
    int bcur = -1;
#pragma unroll 1
    for (int u = u0; u < u1; ++u) {
        int tid = threadIdx.x; asm volatile("" : "+v"(tid));
        const int lane = tid & 63, r = lane & 15, q = lane >> 4, cb = 256 * w + 16 * q;
#define KOFF(kk_) (64 * ((kk_) >> 1) + 8 * ((kk_) & 1))
        const bf16* wf = wrt + (size_t)w * (8 * 4 * 2 * 512) + lane * 8;
        const int m0 = u * RU, b = m0 / T;
        if (b != bcur) { bcur = b; __syncthreads();
            for (int col = 4 * tid; col < D; col += 2048) { const f32x4 gg = *(const f32x4*)(g + col), sc = *(const f32x4*)(ada_l + (size_t)b * 6 * D + 4 * D + col), sh = *(const f32x4*)(ada_l + (size_t)b * 6 * D + 3 * D + col);
                *(LAS f32x4*)(GA + col) = gg * (sc + 1.f); *(LAS f32x4*)(GB + col) = sh; } }
        u32x4 xv[RT][8]; float rstd[RT];
#pragma unroll
        for (int t = 0; t < RT; ++t) { const bf16* xr = (const bf16*)x1 + (size_t)(m0 + 16 * t + r) * D + cb;
#pragma unroll
            for (int kk = 0; kk < 8; ++kk) xv[t][kk] = *(const u32x4*)(xr + KOFF(kk)); }
#pragma unroll
        for (int t = 0; t < RT; ++t) { float ss = 0.f;
#pragma unroll
            for (int kk = 0; kk < 8; ++kk)
#pragma unroll
                for (int j = 0; j < 4; ++j) { const float a0 = bf2f(xv[t][kk][j] & 0xffffu), a1 = bf2f(xv[t][kk][j] >> 16); ss += a0 * a0 + a1 * a1; }
            ss += __shfl_xor(ss, 16); ss += __shfl_xor(ss, 32);
            if (q == 0) red[(t * 8 + w) * 16 + r] = ss; }
        __syncthreads();
        f32x4 acc[RT][4]; u32x2 q8keep[RT];
#pragma unroll
        for (int t = 0; t < RT; ++t) { float tot = 0.f;
#pragma unroll
            for (int w2 = 0; w2 < 8; ++w2) tot += red[(t * 8 + w2) * 16 + r];
            rstd[t] = 1.f / sqrtf(tot * (1.f / D) + RMS_EPS);
#pragma unroll
            for (int nt = 0; nt < 4; ++nt) acc[t][nt] = (f32x4){0.f, 0.f, 0.f, 0.f}; }
#pragma unroll
        for (int kk = 0; kk < 8; ++kk) {
            const f32x4 ga0 = *(LAS f32x4*)(GA + cb + KOFF(kk)), ga1 = *(LAS f32x4*)(GA + cb + KOFF(kk) + 4), gb0 = *(LAS f32x4*)(GB + cb + KOFF(kk)), gb1 = *(LAS f32x4*)(GB + cb + KOFF(kk) + 4);
            bf16x8 ah[RT], al[RT];
#pragma unroll
            for (int t = 0; t < RT; ++t) { const u32x4 xw = xv[t][kk]; f32x4 hh[2];
                hh[0] = (f32x4){bf2f(xw.x & 0xffffu), bf2f(xw.x >> 16), bf2f(xw.y & 0xffffu), bf2f(xw.y >> 16)} * rstd[t] * ga0 + gb0;
                hh[1] = (f32x4){bf2f(xw.z & 0xffffu), bf2f(xw.z >> 16), bf2f(xw.w & 0xffffu), bf2f(xw.w >> 16)} * rstd[t] * ga1 + gb1;
                u32x4 hw, lw;
#pragma unroll
                for (int s2 = 0; s2 < 2; ++s2) { const unsigned ha = pk2(hh[s2].x, hh[s2].y), hb2 = pk2(hh[s2].z, hh[s2].w);
                    hw[2 * s2] = ha; hw[2 * s2 + 1] = hb2;
                    lw[2 * s2] = pk2(hh[s2].x - __uint_as_float(ha << 16), hh[s2].y - __uint_as_float(ha & 0xffff0000u)); lw[2 * s2 + 1] = pk2(hh[s2].z - __uint_as_float(hb2 << 16), hh[s2].w - __uint_as_float(hb2 & 0xffff0000u)); }
#if USE_FP8_MOE
                { const unsigned qa = pk4_fp8(hh[0].x * F8_HSCALE, hh[0].y * F8_HSCALE, hh[0].z * F8_HSCALE, hh[0].w * F8_HSCALE), qb2 = pk4_fp8(hh[1].x * F8_HSCALE, hh[1].y * F8_HSCALE, hh[1].z * F8_HSCALE, hh[1].w * F8_HSCALE);
                  if (kk & 1) { u32x4 q16; q16.x = q8keep[t].x; q16.y = q8keep[t].y; q16.z = qa; q16.w = qb2; *(u32x4*)((unsigned char*)HF + (size_t)(m0 + 16 * t + r) * D + cb + KOFF(kk - 1)) = q16; }
                  else { q8keep[t].x = qa; q8keep[t].y = qb2; } }
#if SHARED_BF16
                *(u32x4*)(HFB + (size_t)(m0 + 16 * t + r) * D + cb + KOFF(kk)) = hw;
#endif
#else
                *(u32x4*)(HF + (size_t)(m0 + 16 * t + r) * D + cb + KOFF(kk)) = hw;
#endif
                ah[t] = __builtin_bit_cast(bf16x8, hw); al[t] = __builtin_bit_cast(bf16x8, lw); }
#pragma unroll
            for (int nt = 0; nt < 4; ++nt) { const bf16x8 bh = *(const bf16x8*)(wf + ((kk * 4 + nt) * 2) * 512), bl = *(const bf16x8*)(wf + ((kk * 4 + nt) * 2 + 1) * 512);
#pragma unroll
                for (int t = 0; t < RT; ++t) {
                    acc[t][nt] = __builtin_amdgcn_mfma_f32_16x16x32_bf16(ah[t], bh, acc[t][nt], 0, 0, 0);
                    acc[t][nt] = __builtin_amdgcn_mfma_f32_16x16x32_bf16(ah[t], bl, acc[t][nt], 0, 0, 0);
                    acc[t][nt] = __builtin_amdgcn_mfma_f32_16x16x32_bf16(al[t], bh, acc[t][nt], 0, 0, 0); } }
            if (kk & 1) asm volatile("" ::: "memory");
        }
#pragma unroll
        for (int t = 0; t < RT; ++t)
#pragma unroll
            for (int nt = 0; nt < 4; ++nt)
#pragma unroll
                for (int j = 0; j < 4; ++j) part[((t * 8 + w) * 16 + 4 * q + j) * 64 + 16 * nt + r] = acc[t][nt][j];
        __syncthreads();
#pragma unroll 1
        for (int rp = 0; rp < RT; ++rp) {
            float score[2], cur[2]; int rank[2];
#pragma unroll
            for (int x = 0; x < 2; ++x) { const int row = 2 * RT * w + 2 * rp + x; float logit = 0.f;
#pragma unroll
                for (int w2 = 0; w2 < 8; ++w2) logit += part[(((row >> 4) * 8 + w2) * 16 + (row & 15)) * 64 + lane];
                score[x] = 1.f / (1.f + expf(-logit));
                const float sel = score[x] + rb;
                const float m1 = dpp_max8(sel);
                const unsigned long long eqm = __ballot(sel == m1);
                const unsigned grp_eq = (unsigned)((eqm >> (lane & ~7)) & 0xffull);
                const int first = __builtin_ctz(grp_eq);
                const float m2 = dpp_max8(((lane & 7) == first) ? -3e38f : sel);
                const float gs = m1 + m2;
                int grank = 0; const int mygrp = lane >> 3;
#pragma unroll
                for (int g2 = 0; g2 < 8; ++g2) { const float o = __int_as_float(__builtin_amdgcn_readlane(__float_as_int(gs), g2 * 8)); grank += (o > gs || (o == gs && g2 < mygrp)) ? 1 : 0; }
                cur[x] = (grank < 4) ? sel : -1e30f; rank[x] = 64; }
#pragma unroll
            for (int it = 0; it < TOPK; ++it)
#pragma unroll
                for (int x = 0; x < 2; ++x) { const float mx = wave_max_u(cur[x]); const int f = (int)__builtin_ctzll(__ballot(cur[x] == mx));
                    if (lane == f) { rank[x] = it; cur[x] = -3e38f; } }
#pragma unroll
            for (int x = 0; x < 2; ++x) { const int m = m0 + 2 * RT * w + 2 * rp + x; const bool chosen = rank[x] < TOPK;
                const float gsum = wave_sum_u(chosen ? score[x] : 0.f);
                if (chosen) { idx[(size_t)m * 8 + rank[x]] = lane | (int)(cnt << 8); gate[(size_t)m * 8 + rank[x]] = score[x] / gsum * 2.5f; cnt += 1u; } }
        }
        __syncthreads();
    }
    wcnt[(size_t)(blockIdx.x * 8 + w) * 64 + (threadIdx.x & 63)] = (int)cnt;
    { LAS int* bc = (LAS int*)c.lds; __syncthreads(); bc[w * 64 + (threadIdx.x & 63)] = (int)cnt; __syncthreads();
      if (w == 0) { int t2 = 0;
#pragma unroll
          for (int p2 = 0; p2 < 8; ++p2) t2 += bc[p2 * 64 + (threadIdx.x & 63)];
          wcnt[(size_t)(2048 + blockIdx.x) * 64 + (threadIdx.x & 63)] = t2; } }
}
#undef KOFF
__device__ __forceinline__ void slot2_phase(const Ctx& c, const int* idx, const int* wcnt, unsigned* nrt_out, int* pos, int* slot_tok, int* tile_exp) {
    LAS int* ST = (LAS int*)c.lds;
    LAS int* SB = ST + 512;
    LAS int* SO = SB + 512;
    LAS int* tot = SO + 512;
    LAS int* bef = tot + 64;
    LAS int* ps = bef + 64;
    LAS int* base = ps + 128;
    const int e = c.tid & 63, p = c.tid >> 6, G = gridDim.x, blk = blockIdx.x;
    { int Tp = 0, Bp = 0;
#pragma unroll 8
      for (int b2 = p; b2 < G; b2 += 8) { const int v = wcnt[(size_t)(2048 + b2) * 64 + e]; Tp += v; Bp += (b2 < blk) ? v : 0; }
      ST[p * 64 + e] = Tp; SB[p * 64 + e] = Bp; SO[p * 64 + e] = wcnt[(size_t)(blk * 8 + p) * 64 + e]; }
    __syncthreads();
    if (c.tid < 64) { int t = 0, bb = 0;
#pragma unroll
        for (int p2 = 0; p2 < 8; ++p2) { t += ST[p2 * 64 + e]; bb += SB[p2 * 64 + e]; }
        tot[e] = t; bef[e] = bb; }
    __syncthreads();
    if (c.tid == 0) { int acc = 0; for (int e2 = 0; e2 < NE; ++e2) { ps[e2] = acc; acc += (tot[e2] + 255) / 256 * 256; } ps[64] = acc; }
    __syncthreads();
    { int o = ps[e] + bef[e];
      for (int p2 = 0; p2 < p; ++p2) o += SO[p2 * 64 + e];
      base[p * 64 + e] = o; }
    __syncthreads();
    {
        constexpr int RU = 16 * RT_ROUTER, NU = M / RU; const int per = (NU + G - 1) / G, mlo = blk * per * RU, mhi = (mlo + per * RU < M) ? mlo + per * RU : M;
        for (int i = c.tid; i < (mhi - mlo) * 8; i += 512) {
            const int m = mlo + (i >> 3), k = i & 7, wv = (m % RU) / (2 * RT_ROUTER); const size_t a = (size_t)m * 8 + k;
            const int code = idx[a], ee = code & 255, rk = code >> 8, slot = base[wv * 64 + ee] + rk;
            slot_tok[slot] = m; pos[a] = slot; }
    }
    for (int t = gtid_now(); t < M; t += c.gsz) slot_tok[CAPR + t] = t;
    if (blk == 0) {
        if (c.tid < NE) { const int s0 = ps[e], cn = tot[e], pe = s0 + (cn + 255) / 256 * 256;
            for (int s = s0 + cn; s < pe; ++s) slot_tok[s] = 0;
            for (int tt = s0 / 256; tt < pe / 256; ++tt) tile_exp[tt] = e; }
        if (c.tid == 0) *nrt_out = (unsigned)(ps[64] / 256);
    }
    __syncthreads();
}

template <int L> __device__ __forceinline__ void moe_up_tuned(const Ctx& c, unsigned char* ws) {
    const int nrt = (int)c.ctl[CW_NRT + L];
#if USE_FP8_MOE && SHARED_BF16
    { pg8::PlainSched S; S.o.init(M / 256, UPN / 256, gridDim.x, blockIdx.x); S.Bt = (const char*)(ws + WS_WUPS) + (size_t)L * UPN * D * 2; S.K = D;
      pg8::EpiUp E{(bf16*)(ws + WS_ACTS)}; pg8::gemm_phase(c.lds, (const char*)(ws + WS_HFB), D, S, E); }
    const int ntile = nrt;
#else
    const int ntile = nrt + M / 256;
#endif
    pg8::GroupSched<true> S; S.o.init(ntile, UPN / 256, gridDim.x, blockIdx.x);
    { LAS int* te = (LAS int*)(c.lds + 132096);
      for (int i = threadIdx.x; i < nrt; i += 512) te[i] = ((const int*)(ws + WS_TILEEXP))[i];
      __syncthreads(); S.tile_exp = te; }
    S.nrt = nrt; S.slot_tok = (const int*)(ws + WS_SLOTTOK);
#if USE_FP8_MOE
    S.W = (const char*)(ws + WS_WUP) + (size_t)L * NEX * UPN * D; S.wstride = (size_t)UPN * D; S.K = D / 2;
    pg8::EpiUp8 E{ws + WS_ACT}; pg8::gemm_phase<pg8::EpiUp8, pg8::GroupSched<true>, true>(c.lds, (const char*)(ws + WS_HF), D / 2, S, E);
#else
    S.W = (const char*)(ws + WS_WUP) + (size_t)L * NEX * UPN * D * 2; S.wstride = (size_t)UPN * D * 2; S.K = D;
    pg8::EpiUp E{(bf16*)(ws + WS_ACT)}; pg8::gemm_phase(c.lds, (const char*)(ws + WS_HF), D, S, E);
#endif
}
template <int L> __device__ __forceinline__ void moe_down_tuned(const Ctx& c, unsigned char* ws) {
    const int nrt = (int)c.ctl[CW_NRT + L];
#if USE_FP8_MOE && SHARED_BF16
    { pg8::PlainSched S; S.o.init(M / 256, D / 256, gridDim.x, blockIdx.x); S.Bt = (const char*)(ws + WS_WDNS) + (size_t)L * D * ED * 2; S.K = ED;
      pg8::EpiDown E{(bf16*)(ws + WS_Y), CAPR}; pg8::gemm_phase(c.lds, (const char*)(ws + WS_ACTS), ED, S, E); }
    const int ntile = nrt;
#else
    const int ntile = nrt + M / 256;
#endif
    pg8::GroupSched<false, USE_FP8_MOE != 0> S; S.aplane = (unsigned)CAP * 32u; S.o.init(ntile, D / 256, gridDim.x, blockIdx.x);
    { LAS int* te = (LAS int*)(c.lds + 132096);
      for (int i = threadIdx.x; i < nrt; i += 512) te[i] = ((const int*)(ws + WS_TILEEXP))[i];
      __syncthreads(); S.tile_exp = te; }
    S.nrt = nrt; S.slot_tok = (const int*)(ws + WS_SLOTTOK);
#if USE_FP8_MOE
    S.W = (const char*)(ws + WS_WDN) + (size_t)L * NEX * D * ED; S.wstride = (size_t)D * ED; S.K = ED / 2;
    pg8::EpiDown8 E{(bf16*)(ws + WS_Y)}; pg8::gemm_phase<pg8::EpiDown8, pg8::GroupSched<false, true>, true>(c.lds, (const char*)(ws + WS_ACT), ED / 2, S, E);
#else
    S.W = (const char*)(ws + WS_WDN) + (size_t)L * NEX * D * ED * 2; S.wstride = (size_t)D * ED * 2; S.K = ED;
    pg8::EpiDown E{(bf16*)(ws + WS_Y)}; pg8::gemm_phase(c.lds, (const char*)(ws + WS_ACT), ED, S, E);
#endif
}
template <int L> __device__ __forceinline__ void qkv_tuned(const Ctx& c, unsigned char* ws, const float* gains) {
    constexpr int NCOL = L == 0 ? AB_IN : C_IN; constexpr bool TUNED_ATT = L == 0 ? (USE_ATT0 != 0) : (USE_ATT1 != 0);
    pg8::PlainSched S; S.o.init(M / 256, NCOL / 256, gridDim.x, blockIdx.x); S.Bt = (const char*)(ws + (L == 0 ? WS_W0IN : WS_W1IN));
#if USE_FP8_QKV
    S.K = D / 2; pg8::EpiQKV<L> E{(bf16*)(ws + WS_QKV), NCOL, gains, TUNED_ATT ? att::C2 : 1.f, 1.f / (F8_HSCALE * F8_WSCALE)};
    pg8::gemm_phase<pg8::EpiQKV<L>, pg8::PlainSched, true>(c.lds, (const char*)(ws + WS_XN), D / 2, S, E);
#else
    S.K = D; pg8::EpiQKV<L> E{(bf16*)(ws + WS_QKV), NCOL, gains, TUNED_ATT ? att::C2 : 1.f, 1.f};
    pg8::gemm_phase(c.lds, (const char*)(ws + WS_XN), D, S, E);
#endif
}

template <int L> __device__ __forceinline__ void outproj_epi(const Ctx& c, unsigned char* ws, const pg8::PlainSched& S, const float* xin_f32, const float* gm) {
#if RES_BF16
    if (L == 0) { pg8::EpiOutB<false> E{xin_f32, gm, (bf16*)(ws + WS_X1)}; pg8::gemm_phase(c.lds, (const char*)(ws + WS_O), D, S, E); }
    else { pg8::EpiOutB<true> E{ws + WS_X1 + (size_t)M * D * 2, gm, (bf16*)(ws + WS_X1)}; pg8::gemm_phase(c.lds, (const char*)(ws + WS_O), D, S, E); }
#else
    pg8::EpiOut E{xin_f32, gm, (float*)(ws + WS_X1)}; pg8::gemm_phase(c.lds, (const char*)(ws + WS_O), D, S, E);
#endif
}
__global__ void __launch_bounds__(512, 2) mega(Args args) {
    extern __shared__ __attribute__((aligned(16))) unsigned char lds_raw[];
    Ctx c;
    c.lds = (LAS unsigned char*)lds_raw;
    c.tid = threadIdx.x; c.lane = c.tid & 63; c.wave = __builtin_amdgcn_readfirstlane(c.tid >> 6);
    c.gw = blockIdx.x * 8 + c.wave; c.ngw = gridDim.x * 8; c.gsz = gridDim.x * 512;
    c.ws = args.ws; c.ctl = (unsigned*)(args.ws + WS_CTL);
    volatile LAS unsigned* xbw = (volatile LAS unsigned*)(c.lds + LDS_BYTES - 16);
    if (c.tid < 4) xbw[c.tid] = 0u;
    __syncthreads();
    const int lo = args.ph_lo, hi = args.ph_hi;
    XcdBarrier bar; bar.bar = c.ctl + CW_BAR; bar.x = 0; bar.st = xbw;
    if (hi - lo > 1) bar = xcd_barrier_post(c.ctl + CW_BAR, xbw);
#ifdef PHASE_ONLY
#define IN(k) ((k) == PHASE_ONLY && lo <= (k) && (k) < hi)
#else
#define IN(k) (lo <= (k) && (k) < hi)
#endif
#define PHASE(k, ...) do { if (IN(k)) { __VA_ARGS__ } if (IN(k) && ((REPMASK >> (k)) & 1u)) { __syncthreads(); __VA_ARGS__ } } while (0);
#if PROBE_SEL >= 0
    volatile LAS unsigned long long* stamp_ = (volatile LAS unsigned long long*)(c.lds + 146000);
    if (c.tid == 0) stamp_[0] = __builtin_amdgcn_s_memrealtime();
#define SEAM(k) do { if (c.tid == 0) stamp_[1 + 2 * (k)] = __builtin_amdgcn_s_memrealtime(); if (IN(k) && IN((k) + 1)) xcd_barrier(bar); else __syncthreads(); \
        if (c.tid == 0) stamp_[2 + 2 * (k)] = __builtin_amdgcn_s_memrealtime(); } while (0)
#else
#define SEAM(k) do { if (IN(k) && IN((k) + 1)) xcd_barrier(bar); else __syncthreads(); } while (0)
#endif
    unsigned char* ws = args.ws;
#define XIN (args.in[0])
#define cin (args.in[1])
#define norm_mix (args.in[2])
#define norm_ffn (args.in[3])
#define w_ada (args.in[4])
#define b_ada (args.in[5])
#define ada ((float*)(ws + WS_ADA))
#define W0IN ((bf16*)(ws + WS_W0IN))
#define W0OUT ((bf16*)(ws + WS_W0OUT))
#define W1IN ((bf16*)(ws + WS_W1IN))
#define W1OUT ((bf16*)(ws + WS_W1OUT))
#define WUP ((bf16*)(ws + WS_WUP))
#define WDN ((bf16*)(ws + WS_WDN))
#define XN ((bf16*)(ws + WS_XN))
#define QKV ((bf16*)(ws + WS_QKV))
#define OBUF ((bf16*)(ws + WS_O))
#define X1 ((float*)(ws + WS_X1))
#define HF ((bf16*)(ws + WS_HF))
#define IDX ((int*)(ws + WS_IDX))
#define GATE ((float*)(ws + WS_GATE))
#define POS ((int*)(ws + WS_POS))
#define SLOTTOK ((int*)(ws + WS_SLOTTOK))
#define TILEEXP ((int*)(ws + WS_TILEEXP))
#define ACT ((bf16*)(ws + WS_ACT))
#define Y ((bf16*)(ws + WS_Y))
#define TMP ((float*)(ws + WS_TMP))
#define OUTP (args.out)

    PHASE(0, {
        constexpr int QM = USE_PG8_QKV ? 1 : 0, UM = USE_PG8_MOE ? 2 : 0;
#if USE_CONV128 && USE_FP8_MOE
        convert_dense_all<QM, USE_FP8_QKV != 0>(c, args.in[6], args.in[10], args.in[9], args.in[14], (unsigned char*)W0IN, (unsigned char*)W1IN, (unsigned char*)W0OUT, (unsigned char*)W1OUT, USE_FP8_QKV ? F8_WSCALE : 1.f, 0, c.gw, c.ngw);
#if !(DEFER_CONV && USE_ATT0 && USE_ATT1 && !SHARED_BF16)
        for (int l = 0; l < 2; ++l) {
            convert_batch128<2, true>(c, args.in[17] + (size_t)l * NE * D * UPN, D, UPN, (unsigned char*)WUP + (size_t)l * NEX * UPN * D, NE, (size_t)UPN * D, F8_WSCALE);
            convert_batch128<0, true>(c, args.in[18] + (size_t)l * NE * ED * D, ED, D, (unsigned char*)WDN + (size_t)l * NEX * D * ED, NE, (size_t)D * ED, F8_WSCALE);
#if SHARED_BF16
            convert_batch128<2, false>(c, args.in[19] + (size_t)l * D * UPN, D, UPN, ws + WS_WUPS + (size_t)l * UPN * D * 2, 1, 0, 1.f);
            convert_batch128<0, false>(c, args.in[20] + (size_t)l * ED * D, ED, D, ws + WS_WDNS + (size_t)l * D * ED * 2, 1, 0, 1.f);
#else
            convert_batch128<2, true>(c, args.in[19] + (size_t)l * D * UPN, D, UPN, (unsigned char*)WUP + ((size_t)l * NEX + NE) * UPN * D, 1, 0, F8_WSCALE);
            convert_batch128<0, true>(c, args.in[20] + (size_t)l * ED * D, ED, D, (unsigned char*)WDN + ((size_t)l * NEX + NE) * D * ED, 1, 0, F8_WSCALE);
#endif
        }
#endif
#else
        convert_batch<QM>(c, args.in[6], D, AB_IN, W0IN, 1, 0);
        convert_batch<0>(c, args.in[9], D, D, W0OUT, 1, 0);
        convert_batch<QM>(c, args.in[10], D, C_IN, W1IN, 1, 0);
        convert_batch<0>(c, args.in[14], D, D, W1OUT, 1, 0);
        for (int l = 0; l < 2; ++l) {
#if USE_FP8_MOE
            convert_batch_f8<2>(c, args.in[17] + (size_t)l * NE * D * UPN, D, UPN, (unsigned char*)WUP + (size_t)l * NEX * UPN * D, NE, (size_t)UPN * D);
            convert_batch_f8<2>(c, args.in[19] + (size_t)l * D * UPN, D, UPN, (unsigned char*)WUP + ((size_t)l * NEX + NE) * UPN * D, 1, 0);
            convert_batch_f8<0>(c, args.in[18] + (size_t)l * NE * ED * D, ED, D, (unsigned char*)WDN + (size_t)l * NEX * D * ED, NE, (size_t)D * ED);
            convert_batch_f8<0>(c, args.in[20] + (size_t)l * ED * D, ED, D, (unsigned char*)WDN + ((size_t)l * NEX + NE) * D * ED, 1, 0);
#else
            convert_batch<UM>(c, args.in[17] + (size_t)l * NE * D * UPN, D, UPN, WUP + (size_t)l * NEX * UPN * D, NE, (size_t)UPN * D);
            convert_batch<UM>(c, args.in[19] + (size_t)l * D * UPN, D, UPN, WUP + ((size_t)l * NEX + NE) * UPN * D, 1, 0);
            convert_batch<0>(c, args.in[18] + (size_t)l * NE * ED * D, ED, D, WDN + (size_t)l * NEX * D * ED, NE, (size_t)D * ED);
            convert_batch<0>(c, args.in[20] + (size_t)l * ED * D, ED, D, WDN + ((size_t)l * NEX + NE) * D * ED, 1, 0);
#endif
        }
#endif
        convert_router(c, args.in[15], (bf16*)(ws + WS_WRT));
        __syncthreads();
        ada_phase(c, cin, w_ada, b_ada, ada);
    })
    SEAM(0);
    PHASE(1, norm_phase(c, XIN, norm_mix, ada, 0, D, XN);)
    SEAM(1);
#if USE_PG8_QKV
    PHASE(2, { qkv_tuned<0>(c, ws, args.in[7]);
        { constexpr int QM2 = USE_PG8_QKV ? 1 : 0; const int G_ = (int)gridDim.x, rem_ = ((M / 256) * (AB_IN / 256)) % G_, first_ = rem_ ? rem_ : 0, nblk_ = G_ - first_;
          __syncthreads();
          if ((int)blockIdx.x >= first_) convert_dense_all<QM2, USE_FP8_QKV != 0>(c, args.in[6], args.in[10], args.in[9], args.in[14], (unsigned char*)W0IN, (unsigned char*)W1IN, (unsigned char*)W0OUT, (unsigned char*)W1OUT,
                                                                                  USE_FP8_QKV ? F8_WSCALE : 1.f, 1, ((int)blockIdx.x - first_) * 8 + c.wave, nblk_ * 8); } })
    SEAM(2);
#else
    PHASE(2, gemm_plain_bf16(c, XN, W0IN, D, AB_IN, QKV);)
    SEAM(2);
#endif
#if USE_ATT0
    static_assert(USE_PG8_QKV, "the tuned attention needs Q pre-scaled by the QKV epilogue");
    #if DEFER_CONV
    PHASE(3, { constexpr int NSEG = 4, SEGS = 16 / NSEG;
        const int xs_ = vcu_of(blockIdx.x, gridDim.x) & (SEGS - 1);
        const int cshare = (EXP_ITEMS + (int)gridDim.x - 1) / (int)gridDim.x, cfirst = blockIdx.x * cshare, ccount = (cfirst + cshare <= EXP_ITEMS) ? cshare : (EXP_ITEMS > cfirst ? EXP_ITEMS - cfirst : 0);
        int xlo_ = 0;
        _Pragma("unroll 1") for (int sg_ = 0; sg_ <= NSEG; ++sg_) {
            const int xhi_ = sg_ < NSEG ? xs_ + 1 + sg_ * SEGS : 16;
            attn0_tuned_phase(c, QKV, args.in[8], (bf16*)(ws + WS_TMP), (float*)(ws + WS_TMP + (size_t)3 * M * 1024 * 2), OBUF, xlo_, xhi_);
            xlo_ = xhi_;
            if (sg_ < NSEG) { const int p0_ = (int)((long)ccount * sg_ / NSEG), p1_ = (int)((long)ccount * (sg_ + 1) / NSEG);
                expert_items_block(c, ExpertSrc{args.in[17], args.in[19], args.in[18], args.in[20]}, 0, ws, cfirst + p0_, p1_ - p0_); __syncthreads(); }
        } })
#else
    PHASE(3, attn0_tuned_phase(c, QKV, args.in[8], (bf16*)(ws + WS_TMP), (float*)(ws + WS_TMP + (size_t)3 * M * 1024 * 2), OBUF, 0, 16);)
#endif
    SEAM(3);
    PHASE(4, attn0_merge_phase(c, (const bf16*)(ws + WS_TMP), (const float*)(ws + WS_TMP + (size_t)3 * M * 1024 * 2), OBUF);)
    SEAM(4);
#else
#if !USE_PG8_QKV
    PHASE(3, qknorm0_phase(c, QKV, args.in[7]);)
#endif
    SEAM(3);
    PHASE(4, attn0_phase(c, QKV, args.in[8], OBUF);)
    SEAM(4);
#endif
#if USE_PG8_OUT
    PHASE(5, { pg8::PlainSched S; S.o.init(M / 256, D / 256, gridDim.x, blockIdx.x); S.Bt = (const char*)W0OUT; S.K = D;
        outproj_epi<0>(c, ws, S, XIN, ada + 2 * D); })
#else
    PHASE(5, gemm_outproj(c, OBUF, W0OUT, XIN, ada + 2 * D, X1);)
#endif
    SEAM(5);
#if USE_ROUTER2
    PHASE(6, router2_phase(c, X1, norm_ffn, ada, (const bf16*)(ws + WS_WRT), args.in[16], HF, IDX, GATE, (int*)(ws + WS_WCNT), (bf16*)(ws + WS_HFB));)
    SEAM(6);
    PHASE(7, slot2_phase(c, IDX, (const int*)(ws + WS_WCNT), c.ctl + CW_NRT, POS, SLOTTOK, TILEEXP);)
#else
    PHASE(6, router_phase(c, X1, norm_ffn, ada, args.in[15], args.in[16], HF, IDX, GATE, c.ctl + CW_CNT);)
    SEAM(6);
    PHASE(7, slot_phase(c, IDX, c.ctl + CW_CNT, c.ctl + CW_CUR, c.ctl + CW_NRT, POS, SLOTTOK, TILEEXP);)
#endif
    SEAM(7);
#if USE_PG8_MOE
    PHASE(8, moe_up_tuned<0>(c, ws);)
    SEAM(8);
    PHASE(9, moe_down_tuned<0>(c, ws);)
#else
    PHASE(8, moe_up_phase(c, HF, WUP, SLOTTOK, TILEEXP, c.ctl + CW_NRT, ACT);)
    SEAM(8);
    PHASE(9, moe_down_phase(c, ACT, WDN, TILEEXP, c.ctl + CW_NRT, Y);)
#endif
    SEAM(9);
    PHASE(10, combine_phase<true>(c, X1, Y, POS, GATE, ada, RES_BF16 ? (float*)(ws + WS_X1 + (size_t)M * D * 2) : OUTP, norm_mix + D, ada + (size_t)4 * 6 * D, XN);)
    SEAM(10);
#define ada1 (ada + (size_t)4 * 6 * D)
#if USE_PG8_QKV
    PHASE(11, qkv_tuned<1>(c, ws, args.in[11]);)
    SEAM(11);
    SEAM(12);
#else
    PHASE(11, gemm_plain_bf16(c, XN, W1IN, D, C_IN, QKV);)
    SEAM(11);
    PHASE(12, qknorm1_phase(c, QKV, args.in[11]);)
    SEAM(12);
#endif
#if USE_ATT1
    PHASE(13, attn1_tuned_phase(c, QKV, args.in[11], (bf16*)TMP, c.ctl + CW_QCTR, ExpertSrc{args.in[17], args.in[19], args.in[18], args.in[20]}, ws, args.in[12], args.in[13], OBUF);)
    SEAM(13);
#if !FUSE_FINISH
    PHASE(14, attn1_finish_bf16_phase(c, (const bf16*)TMP, args.in[12], args.in[13], OBUF);)
#endif
    SEAM(14);
#else
    PHASE(13, attn1_phase(c, QKV, TMP);)
    SEAM(13);
    PHASE(14, attn1_finish_phase(c, TMP, args.in[12], args.in[13], OBUF);)
    SEAM(14);
#endif
#if USE_PG8_OUT
    PHASE(15, { pg8::PlainSched S; S.o.init(M / 256, D / 256, gridDim.x, blockIdx.x); S.Bt = (const char*)W1OUT; S.K = D;
        outproj_epi<1>(c, ws, S, OUTP, ada1 + 2 * D); })
#else
    PHASE(15, gemm_outproj(c, OBUF, W1OUT, OUTP, ada1 + 2 * D, X1);)
#endif
    SEAM(15);
#if USE_ROUTER2
    PHASE(16, router2_phase(c, X1, norm_ffn + D, ada1, (const bf16*)(ws + WS_WRT) + (size_t)2 * NE * D, args.in[16] + NE, HF, IDX, GATE, (int*)(ws + WS_WCNT), (bf16*)(ws + WS_HFB));)
    SEAM(16);
    PHASE(17, slot2_phase(c, IDX, (const int*)(ws + WS_WCNT), c.ctl + CW_NRT + 1, POS, SLOTTOK, TILEEXP);)
#else
    PHASE(16, router_phase(c, X1, norm_ffn + D, ada1, args.in[15] + (size_t)D * NE, args.in[16] + NE, HF, IDX, GATE, c.ctl + CW_CNT + 64);)
    SEAM(16);
    PHASE(17, slot_phase(c, IDX, c.ctl + CW_CNT + 64, c.ctl + CW_CUR + 64, c.ctl + CW_NRT + 1, POS, SLOTTOK, TILEEXP);)
#endif
    SEAM(17);
#if USE_PG8_MOE
    PHASE(18, moe_up_tuned<1>(c, ws);)
    SEAM(18);
    PHASE(19, moe_down_tuned<1>(c, ws);)
#else
    PHASE(18, moe_up_phase(c, HF, WUP + (size_t)NEX * UPN * D, SLOTTOK, TILEEXP, c.ctl + CW_NRT + 1, ACT);)
    SEAM(18);
    PHASE(19, moe_down_phase(c, ACT, WDN + (size_t)NEX * D * ED, TILEEXP, c.ctl + CW_NRT + 1, Y);)
#endif
    SEAM(19);
    PHASE(20, combine_phase<false>(c, X1, Y, POS, GATE, ada1, OUTP, nullptr, nullptr, nullptr);)
#if PROBE_SEL >= 0
    {
        __syncthreads();
        unsigned long long v = 0ull;
        if (c.tid == 0) {
            if (PROBE_SEL >= 100) { const int k = PROBE_SEL - 100; v = stamp_[2 + 2 * k] - (k == 0 ? stamp_[0] : stamp_[2 + 2 * (k - 1)]); }
            else if (PROBE_SEL == 1 || PROBE_SEL == 2) { for (int k = 0; k < NPHASE - 1; ++k) v += stamp_[2 + 2 * k] - stamp_[1 + 2 * k]; }
            else if (PROBE_SEL == 3) { v = stamp_[1 + 2 * 19] - stamp_[0]; }
        }
        if (PROBE_SEL == 2) {
            if (c.tid == 0) __hip_atomic_fetch_add((unsigned long long*)(c.ctl + CW_QCTR + 64), v, __ATOMIC_RELAXED, __HIP_MEMORY_SCOPE_AGENT);
            xcd_barrier(bar);
            if (c.tid == 0) v = __hip_atomic_load((unsigned long long*)(c.ctl + CW_QCTR + 64), __ATOMIC_RELAXED, __HIP_MEMORY_SCOPE_AGENT) / gridDim.x;
        }
        if (blockIdx.x == 0 && c.tid == 0) { const unsigned long long t0 = __builtin_amdgcn_s_memrealtime(), w = v * PROBE_GAIN;
            while (__builtin_amdgcn_s_memrealtime() - t0 < w) __builtin_amdgcn_s_sleep(8); }
    }
#endif
#undef IN
#undef SEAM
#undef ada
#undef ada1
#undef W0IN
#undef W0OUT
#undef W1IN
#undef W1OUT
#undef WUP
#undef WDN
#undef XN
#undef QKV
#undef OBUF
#undef X1
#undef HF
#undef IDX
#undef GATE
#undef POS
#undef SLOTTOK
#undef TILEEXP
#undef ACT
#undef Y
#undef TMP
#undef XIN
#undef cin
#undef norm_mix
#undef norm_ffn
#undef w_ada
#undef b_ada
#undef OUTP
}

extern "C" void kernel_launch(void* const* d_in, const int* in_sizes, int n_in, void* d_out, int out_size, void* d_ws, size_t ws_size, hipStream_t stream) {
    static int grid = 0;
    if (grid == 0) {
        if (n_in != 21 || out_size != M * D || ws_size < WS_END) { fprintf(stderr, "kernel_launch: unexpected sizes (n_in %d out %d ws %zu need %zu)\n", n_in, out_size, ws_size, (size_t)WS_END); grid = -1; return; }
        int dev = 0, cus = 0, per_cu = 0;
        hipGetDevice(&dev); hipDeviceGetAttribute(&cus, hipDeviceAttributeMultiprocessorCount, dev);
        if (hipFuncSetAttribute((const void*)mega, hipFuncAttributeMaxDynamicSharedMemorySize, LDS_BYTES) != hipSuccess) { fprintf(stderr, "kernel_launch: hipFuncSetAttribute failed\n"); grid = -1; return; }
        hipOccupancyMaxActiveBlocksPerMultiprocessor(&per_cu, (const void*)mega, 512, LDS_BYTES);
        (void)hipGetLastError();
        if (per_cu < 1) fprintf(stderr, "kernel_launch: occupancy query says %d blocks per CU\n", per_cu);
        grid = cus;
    }
    if (grid < 0) return;
    hipMemsetAsync((char*)d_ws + WS_CTL, 0, CTL_BYTES, stream);
    Args a{};
    for (int i = 0; i < 21; ++i) a.in[i] = (const float*)d_in[i];
    a.out = (float*)d_out; a.ws = (unsigned char*)d_ws;
#if MK_SPLIT
    for (int p = 0; p < NPHASE; ++p) { a.ph_lo = p; a.ph_hi = p + 1; hipLaunchKernelGGL(mega, dim3(grid), dim3(512), LDS_BYTES, stream, a); }
#else
    a.ph_lo = 0; a.ph_hi = NPHASE; hipLaunchKernelGGL(mega, dim3(grid), dim3(512), LDS_BYTES, stream, a);
#endif
}
```
